# Optimizing an MI355X kernel written in HIP

```python
import math
import jax
import jax.numpy as jnp
from jax import lax
import numpy as np

D_MODEL = 1024
BATCH = 16
SEQ = 4096
DEPTH = 2

HEAD_DIM = 64
Q_BLOCK = 128
RMS_EPS = 1e-6
NEG_INF = -1e30
FORCE_SCORE = 1e9

N_BUCKETS = 32
BUCKET_EXACT = 16
BUCKET_MAX_DIST = 2048

A_HEADS = 4
A_CMP_LEN = 32
A_CMP_STRIDE = 16
A_PHI_HIDDEN = 128
A_SEL_BLOCK = 64
A_SEL_TOPK = 16
A_WINDOW = 512

B_GROUPS = ((128, 1), (512, 4), (2048, 16))
B_HEADS_PER_GROUP = 2
B_HEADS = B_HEADS_PER_GROUP * len(B_GROUPS)

C_HEADS = 4

D_HEADS = 4
D_Q_LORA = 256
D_KV_LORA = 128
D_NOPE = 64
D_ROPE = 32
D_VDIM = 64
ROPE_THETA = 10000.0

D_FF = 2816
FFN_CONV_WIDTH = 3

N_BRANCHES = 4
IN_SPLITS = (
    A_HEADS * HEAD_DIM,
    6 * HEAD_DIM,
    3 * A_HEADS,
    3 * B_HEADS * HEAD_DIM,
    3 * C_HEADS * HEAD_DIM,
    C_HEADS,
    D_Q_LORA,
    D_KV_LORA,
    D_ROPE,
)
D_IN = sum(IN_SPLITS)
A_OUT = A_HEADS * HEAD_DIM
B_OUT = B_HEADS_PER_GROUP * HEAD_DIM
C_OUT = C_HEADS * HEAD_DIM
D_OUT = D_HEADS * D_VDIM

kernel_name = 'hybrid_nsa_dilated_fox_mla_block'


def rms_norm(x, gain):
    xf = x.astype(jnp.float32)
    y = xf * lax.rsqrt(jnp.mean(xf * xf, axis=-1, keepdims=True) + RMS_EPS)
    return (y * gain.astype(jnp.float32)).astype(x.dtype)


def split_cols(a, sizes):
    return jnp.split(a, np.cumsum(sizes)[:-1].tolist(), axis=-1)


def rel_bucket(dist):
    dist = jnp.maximum(dist, 0)
    d = jnp.maximum(dist, 1).astype(jnp.float32)
    large = BUCKET_EXACT + (jnp.log(d / BUCKET_EXACT) / math.log(BUCKET_MAX_DIST / BUCKET_EXACT)
                            * (N_BUCKETS - BUCKET_EXACT)).astype(jnp.int32)
    large = jnp.minimum(large, N_BUCKETS - 1)
    return jnp.where(dist < BUCKET_EXACT, dist, large)


def masked_softmax(logits, mask):
    logits = jnp.where(mask, logits, NEG_INF)
    m = jnp.max(logits, axis=-1, keepdims=True)
    p = jnp.where(mask, jnp.exp(logits - m), 0.0)
    den = jnp.sum(p, axis=-1, keepdims=True)
    den_safe = jnp.maximum(den, 1e-30)
    return p / den_safe, m[..., 0] + jnp.log(den_safe[..., 0])


def sweep_query_blocks(fn, *q_arrays):
    b, s = q_arrays[0].shape[:2]
    nb = s // Q_BLOCK
    blocked = tuple(jnp.moveaxis(a.reshape((b, nb, Q_BLOCK) + a.shape[2:]), 1, 0) for a in q_arrays)
    out = lax.map(lambda args: fn(args[0], *args[1:]), (jnp.arange(nb, dtype=jnp.int32),) + blocked)
    return jnp.moveaxis(out, 0, 1).reshape((b, s) + out.shape[3:])


def rope(x, cos, sin):
    x1, x2 = jnp.split(x, 2, axis=-1)
    return jnp.concatenate([x1 * cos - x2 * sin, x2 * cos + x1 * sin], axis=-1)


def nsa_mixer(q, kv_a, gate_logits, cmp_pos, phi_k_w1, phi_k_w2, phi_v_w1, phi_v_w2, rel_table):
    b, s = q.shape[:2]
    k_cmp, v_cmp, k_slc, v_slc, k_win, v_win = jnp.split(kv_a, 6, axis=-1)
    scale = HEAD_DIM ** -0.5
    n_cmp = (s - A_CMP_LEN) // A_CMP_STRIDE + 1

    def compress(kv, w1, w2):
        ch = kv.reshape(b, s // A_CMP_STRIDE, A_CMP_STRIDE, HEAD_DIM)
        blocks = jnp.concatenate([ch[:, j:j + n_cmp] for j in range(A_CMP_LEN // A_CMP_STRIDE)], axis=2)
        blocks = (blocks + cmp_pos).reshape(b, n_cmp, A_CMP_LEN * HEAD_DIM)
        return jax.nn.gelu(blocks @ w1) @ w2

    kc = compress(k_cmp, phi_k_w1, phi_k_w2)
    vc = compress(v_cmp, phi_v_w1, phi_v_w2)
    cmp_start = jnp.arange(n_cmp) * A_CMP_STRIDE
    cmp_end = cmp_start + A_CMP_LEN - 1
    n_sel = s // A_SEL_BLOCK
    sel_start = jnp.arange(n_sel) * A_SEL_BLOCK
    overlap = ((cmp_start[:, None] <= sel_start[None, :] + A_SEL_BLOCK - 1)
               & (cmp_end[:, None] >= sel_start[None, :])).astype(jnp.float32)
    n_top = min(A_SEL_TOPK, n_sel)
    ks_blocks = k_slc.reshape(b, n_sel, A_SEL_BLOCK, HEAD_DIM)
    vs_blocks = v_slc.reshape(b, n_sel, A_SEL_BLOCK, HEAD_DIM)
    kw_pad = jnp.pad(k_win, ((0, 0), (A_WINDOW, 0), (0, 0)))
    vw_pad = jnp.pad(v_win, ((0, 0), (A_WINDOW, 0), (0, 0)))
    tab = rel_table[:, :A_HEADS]
    batch_ix = jnp.arange(b)[:, None, None]

    def block(bi, q_blk, g_blk):
        t = bi * Q_BLOCK + jnp.arange(Q_BLOCK)
        lc = jnp.einsum('bqhd,bcd->bhqc', q_blk, kc, preferred_element_type=jnp.float32) * scale
        p_c, _ = masked_softmax(lc, cmp_end[None, :] <= t[:, None])
        o_c = jnp.einsum('bhqc,bcd->bqhd', p_c.astype(vc.dtype), vc)
        imp = jnp.einsum('bhqc,cj->bqj', p_c, overlap)
        cur = (t // A_SEL_BLOCK)[:, None]
        j = jnp.arange(n_sel)[None, :]
        imp = jnp.where((j == 0) | (j == cur) | (j == cur - 1), FORCE_SCORE,
                        jnp.where(j > cur, -FORCE_SCORE, imp))
        _, sel = lax.top_k(imp, n_top)
        ks = ks_blocks[batch_ix, sel].reshape(b, Q_BLOCK, n_top * A_SEL_BLOCK, HEAD_DIM)
        vs = vs_blocks[batch_ix, sel].reshape(b, Q_BLOCK, n_top * A_SEL_BLOCK, HEAD_DIM)
        pos = (sel[..., None] * A_SEL_BLOCK + jnp.arange(A_SEL_BLOCK)).reshape(b, Q_BLOCK, n_top * A_SEL_BLOCK)
        dist = t[None, :, None] - pos
        ls = (jnp.einsum('bqhd,bqkd->bhqk', q_blk, ks, preferred_element_type=jnp.float32) * scale
              + jnp.moveaxis(tab[rel_bucket(dist)], -1, 1))
        p_s, _ = masked_softmax(ls, (dist >= 0)[:, None])
        o_s = jnp.einsum('bhqk,bqkd->bqhd', p_s.astype(vs.dtype), vs)
        kw = lax.dynamic_slice_in_dim(kw_pad, bi * Q_BLOCK, A_WINDOW + Q_BLOCK, axis=1)
        vw = lax.dynamic_slice_in_dim(vw_pad, bi * Q_BLOCK, A_WINDOW + Q_BLOCK, axis=1)
        kpos = bi * Q_BLOCK - A_WINDOW + jnp.arange(A_WINDOW + Q_BLOCK)
        dist_w = t[:, None] - kpos[None, :]
        mask_w = (kpos[None, :] >= 0) & (dist_w >= 0) & (dist_w < A_WINDOW)
        lw = (jnp.einsum('bqhd,bkd->bhqk', q_blk, kw, preferred_element_type=jnp.float32) * scale
              + jnp.moveaxis(tab[rel_bucket(dist_w)], -1, 0)[None])
        p_w, _ = masked_softmax(lw, mask_w)
        o_w = jnp.einsum('bhqk,bkd->bqhd', p_w.astype(vw.dtype), vw)
        g = jax.nn.sigmoid(g_blk.astype(jnp.float32)).astype(q_blk.dtype)
        return g[..., 0:1] * o_c + g[..., 1:2] * o_s + g[..., 2:3] * o_w

    return sweep_query_blocks(block, q, gate_logits)


def dilated_mixer(q, k, v, rel_table):
    scale = HEAD_DIM ** -0.5
    tab = rel_table[:, A_HEADS:]
    hsl = [slice(g * B_HEADS_PER_GROUP, (g + 1) * B_HEADS_PER_GROUP) for g in range(len(B_GROUPS))]
    k_groups = [k[:, :, hs] for hs in hsl]
    v_groups = [v[:, :, hs] for hs in hsl]

    def block(bi, q_blk):
        t = bi * Q_BLOCK + jnp.arange(Q_BLOCK)
        outs, lses = [], []
        for g, (window, dilation) in enumerate(B_GROUPS):
            offs = dilation * jnp.arange(window // dilation + 1)
            idx = t[:, None] - offs[None, :]
            safe = jnp.maximum(idx, 0)
            kg = k_groups[g][:, safe]
            vg = v_groups[g][:, safe]
            bias = jnp.moveaxis(tab[rel_bucket(offs), hsl[g]], -1, 0)
            logits = (jnp.einsum('bqhd,bqkhd->bhqk', q_blk[:, :, hsl[g]], kg, preferred_element_type=jnp.float32)
                      * scale + bias[None, :, None, :])
            p, lse = masked_softmax(logits, (idx >= 0)[None, None])
            outs.append(jnp.einsum('bhqk,bqkhd->bqhd', p.astype(vg.dtype), vg))
            lses.append(jnp.moveaxis(lse, -1, 1))
        wts = jax.nn.softmax(jnp.stack(lses), axis=0)
        return jnp.einsum('gbqh,gbqhd->bqhd', wts.astype(q_blk.dtype), jnp.stack(outs))

    return sweep_query_blocks(block, q)


def forgetting_mixer(q, k, v, f_logits, f_bias):
    s = q.shape[1]
    scale = HEAD_DIM ** -0.5
    log_f = jax.nn.log_sigmoid(f_logits.astype(jnp.float32) + f_bias.astype(jnp.float32))
    cum = jnp.cumsum(log_f, axis=1)
    cum_keys = jnp.moveaxis(cum, 1, 2)
    kpos = jnp.arange(s)

    def block(bi, q_blk, cum_blk):
        t = bi * Q_BLOCK + jnp.arange(Q_BLOCK)
        logits = (jnp.einsum('bqhd,bkhd->bhqk', q_blk, k, preferred_element_type=jnp.float32) * scale
                  + jnp.moveaxis(cum_blk, 1, 2)[..., None] - cum_keys[:, :, None, :])
        p, _ = masked_softmax(logits, kpos[None, :] <= t[:, None])
        return jnp.einsum('bhqk,bkhd->bqhd', p.astype(v.dtype), v)

    return sweep_query_blocks(block, q, cum)


def mla_mixer(q_lat, kv_lat, k_rope, q_norm, kv_norm, w_uq, w_ukv):
    b, s = q_lat.shape[:2]
    scale = (D_NOPE + D_ROPE) ** -0.5
    q = (rms_norm(q_lat, q_norm) @ w_uq).reshape(b, s, D_HEADS, D_NOPE + D_ROPE)
    kv = (rms_norm(kv_lat, kv_norm) @ w_ukv).reshape(b, s, D_HEADS, D_NOPE + D_VDIM)
    q_nope, q_rot = q[..., :D_NOPE], q[..., D_NOPE:]
    k_nope, v = kv[..., :D_NOPE], kv[..., D_NOPE:]
    inv_freq = ROPE_THETA ** (-jnp.arange(0, D_ROPE, 2, dtype=jnp.float32) / D_ROPE)
    ang = jnp.arange(s, dtype=jnp.float32)[:, None] * inv_freq[None, :]
    cos, sin = jnp.cos(ang).astype(q.dtype), jnp.sin(ang).astype(q.dtype)
    q_rot = rope(q_rot, cos[:, None], sin[:, None])
    k_rot = rope(k_rope, cos, sin)
    kpos = jnp.arange(s)

    def block(bi, qn_blk, qr_blk):
        t = bi * Q_BLOCK + jnp.arange(Q_BLOCK)
        logits = (jnp.einsum('bqhd,bkhd->bhqk', qn_blk, k_nope, preferred_element_type=jnp.float32)
                  + jnp.einsum('bqhr,bkr->bhqk', qr_blk, k_rot, preferred_element_type=jnp.float32)) * scale
        p, _ = masked_softmax(logits, kpos[None, :] <= t[:, None])
        return jnp.einsum('bhqk,bkhd->bqhd', p.astype(v.dtype), v)

    return sweep_query_blocks(block, q_nope, q_rot)


def setup_inputs(seed: int = 0) -> dict:
    key = jax.random.key(seed)
    ks = iter(list(jax.random.split(key, 32)))
    f32 = jnp.float32

    def nrm(shape, fan_in, scale=1.0):
        return scale * jax.random.normal(next(ks), shape, f32) * fan_in ** -0.5

    def gain(shape):
        return 1.0 + 0.05 * jax.random.normal(next(ks), shape, f32)

    return {
        'x': jax.random.normal(next(ks), (BATCH, SEQ, D_MODEL), f32),
        'rel_bias_table': 0.5 * jax.random.normal(next(ks), (N_BUCKETS, A_HEADS + B_HEADS), f32),
        'norm_attn_pre': gain((DEPTH, D_MODEL)),
        'norm_attn_post': gain((DEPTH, D_MODEL)),
        'norm_ffn_pre': gain((DEPTH, D_MODEL)),
        'norm_ffn_post': gain((DEPTH, D_MODEL)),
        'w_in': nrm((DEPTH, D_MODEL, D_IN), D_MODEL),
        'nsa_cmp_pos': 0.1 * jax.random.normal(next(ks), (DEPTH, A_CMP_LEN, HEAD_DIM), f32),
        'nsa_phi_k_w1': nrm((DEPTH, A_CMP_LEN * HEAD_DIM, A_PHI_HIDDEN), A_CMP_LEN * HEAD_DIM),
        'nsa_phi_k_w2': nrm((DEPTH, A_PHI_HIDDEN, HEAD_DIM), A_PHI_HIDDEN),
        'nsa_phi_v_w1': nrm((DEPTH, A_CMP_LEN * HEAD_DIM, A_PHI_HIDDEN), A_CMP_LEN * HEAD_DIM),
        'nsa_phi_v_w2': nrm((DEPTH, A_PHI_HIDDEN, HEAD_DIM), A_PHI_HIDDEN),
        'fox_forget_bias': 2.0 + 0.5 * jax.random.normal(next(ks), (DEPTH, C_HEADS), f32),
        'mla_q_norm': gain((DEPTH, D_Q_LORA)),
        'mla_kv_norm': gain((DEPTH, D_KV_LORA)),
        'mla_w_uq': nrm((DEPTH, D_Q_LORA, D_HEADS * (D_NOPE + D_ROPE)), D_Q_LORA),
        'mla_w_ukv': nrm((DEPTH, D_KV_LORA, D_HEADS * (D_NOPE + D_VDIM)), D_KV_LORA),
        'w_branch_a': nrm((DEPTH, A_OUT, D_MODEL), A_OUT),
        'w_branch_b': nrm((DEPTH, B_OUT, D_MODEL), B_OUT),
        'w_branch_c': nrm((DEPTH, C_OUT, D_MODEL), C_OUT),
        'w_branch_d': nrm((DEPTH, D_OUT, D_MODEL), D_OUT),
        'w_merge_gate': nrm((DEPTH, N_BRANCHES, D_MODEL, D_MODEL), D_MODEL),
        'w_o': nrm((DEPTH, D_MODEL, D_MODEL), D_MODEL),
        'ffn_w_up': nrm((DEPTH, D_MODEL, 2 * D_FF), D_MODEL),
        'ffn_conv_w': nrm((DEPTH, FFN_CONV_WIDTH, 2 * D_FF), FFN_CONV_WIDTH),
        'ffn_conv_b': 0.02 * jax.random.normal(next(ks), (DEPTH, 2 * D_FF), f32),
        'ffn_w_down': nrm((DEPTH, D_FF, D_MODEL), D_FF),
    }


def reference(x, rel_bias_table, norm_attn_pre, norm_attn_post, norm_ffn_pre, norm_ffn_post,
              w_in, nsa_cmp_pos, nsa_phi_k_w1, nsa_phi_k_w2, nsa_phi_v_w1, nsa_phi_v_w2,
              fox_forget_bias, mla_q_norm, mla_kv_norm, mla_w_uq, mla_w_ukv,
              w_branch_a, w_branch_b, w_branch_c, w_branch_d, w_merge_gate, w_o,
              ffn_w_up, ffn_conv_w, ffn_conv_b, ffn_w_down):
    batch, seq = x.shape[:2]
    for l in range(DEPTH):
        h = rms_norm(x, norm_attn_pre[l])
        (a_q, a_kv, a_g, b_qkv, c_qkv, c_f, d_qlat, d_kvlat, d_krope) = split_cols(h @ w_in[l], IN_SPLITS)
        o_a = nsa_mixer(a_q.reshape(batch, seq, A_HEADS, HEAD_DIM), a_kv,
                        a_g.reshape(batch, seq, A_HEADS, 3), nsa_cmp_pos[l],
                        nsa_phi_k_w1[l], nsa_phi_k_w2[l], nsa_phi_v_w1[l], nsa_phi_v_w2[l],
                        rel_bias_table)
        b_qkv = b_qkv.reshape(batch, seq, 3, B_HEADS, HEAD_DIM)
        o_b = dilated_mixer(b_qkv[:, :, 0], b_qkv[:, :, 1], b_qkv[:, :, 2], rel_bias_table)
        c_qkv = c_qkv.reshape(batch, seq, 3, C_HEADS, HEAD_DIM)
        o_c = forgetting_mixer(c_qkv[:, :, 0], c_qkv[:, :, 1], c_qkv[:, :, 2], c_f, fox_forget_bias[l])
        o_d = mla_mixer(d_qlat, d_kvlat, d_krope, mla_q_norm[l], mla_kv_norm[l], mla_w_uq[l], mla_w_ukv[l])
        branches = (
            (o_a.reshape(batch, seq, A_OUT), w_branch_a[l]),
            (o_b.reshape(batch, seq, B_OUT), w_branch_b[l]),
            (o_c.reshape(batch, seq, C_OUT), w_branch_c[l]),
            (o_d.reshape(batch, seq, D_OUT), w_branch_d[l]),
        )
        merged = None
        for i, (o_i, w_i) in enumerate(branches):
            term = jax.nn.sigmoid(h @ w_merge_gate[l, i]) * (o_i @ w_i)
            merged = term if i == 0 else merged + term
        x = x + rms_norm(merged @ w_o[l], norm_attn_post[l])
        h = rms_norm(x, norm_ffn_pre[l])
        u = h @ ffn_w_up[l]
        u_pad = jnp.pad(u, ((0, 0), (FFN_CONV_WIDTH - 1, 0), (0, 0)))
        conv = ffn_conv_b[l]
        for j in range(FFN_CONV_WIDTH):
            conv = conv + ffn_conv_w[l, j] * u_pad[:, j:j + seq]
        gate, val = jnp.split(conv, 2, axis=-1)
        y = (jax.nn.silu(gate) * val) @ ffn_w_down[l]
        x = x + rms_norm(y, norm_ffn_post[l])
    return x
```

```cpp
#include <hip/hip_runtime.h>
#include <hip/hip_bf16.h>
#include <cstdio>
#include <cstdint>
#include <cmath>

#define GAS __attribute__((address_space(1)))
#define LAS __attribute__((address_space(3)))
typedef unsigned short bf16_t;
typedef short bf16x8 __attribute__((ext_vector_type(8)));
typedef short s16x4 __attribute__((ext_vector_type(4)));
typedef float f32x4 __attribute__((ext_vector_type(4)));
typedef float f32x2 __attribute__((ext_vector_type(2)));
typedef float f32x16 __attribute__((ext_vector_type(16)));
typedef unsigned u32x4 __attribute__((ext_vector_type(4)));
typedef unsigned u32x2 __attribute__((ext_vector_type(2)));
typedef GAS unsigned gu32;

constexpr int BATCH = 16, SEQ = 4096, DM = 1024, M = BATCH * SEQ, DEPTH = 2;
constexpr int DIN = 2992, PW = 3072;
constexpr int DFF = 2816, DFF2 = 5632;
constexpr float LOG2E = 1.4426950408889634f;
constexpr float C2A = 0.125f * LOG2E;
constexpr float C2D = 0.10206207261596575f * LOG2E;
constexpr float RMS_EPS = 1e-6f;
constexpr int PC_AQ = 0, PC_KCMP = 256, PC_VCMP = 320, PC_KSLC = 384, PC_VSLC = 448, PC_KWIN = 512, PC_VWIN = 576,
              PC_MISC = 640, PC_KROPE = 672, PC_BQ = 768, PC_BK = 1152, PC_BV = 1536, PC_DKV = 1920,
              PC_CQ = 2048, PC_CK = 2304, PC_CV = 2560, PC_DQL = 2816;
constexpr int OCW = 896;
constexpr int NSA_DFAR = 1536, NSA_DMAX = 1664, NSA_TL = 1728;

__device__ __forceinline__ unsigned f2bf(float f) { unsigned u = __float_as_uint(f); return (u + 0x7fffu + ((u >> 16) & 1u)) >> 16; }
__device__ __forceinline__ unsigned pk2(float lo, float hi) { return f2bf(lo) | (f2bf(hi) << 16); }
__device__ __forceinline__ float bf2f(unsigned short b) { return __uint_as_float((unsigned)b << 16); }
typedef __bf16 bf16x2_t __attribute__((ext_vector_type(2)));
__device__ __forceinline__ unsigned cvtpk(float lo, float hi) { f32x2 v = {lo, hi}; bf16x2_t b = __builtin_convertvector(v, bf16x2_t); return __builtin_bit_cast(unsigned, b); }
__device__ __forceinline__ float fast_exp2(float x) { return __builtin_amdgcn_exp2f(x); }
__device__ __forceinline__ float fast_rcp(float x) { return __builtin_amdgcn_rcpf(x); }
template <int MASK> __device__ __forceinline__ float xor_lane_lt32(float v) { return __uint_as_float(__builtin_amdgcn_ds_swizzle((int)__float_as_uint(v), (MASK << 10) | 0x1f)); }
__device__ __forceinline__ float sum_halves(float v) { auto rr = __builtin_amdgcn_permlane32_swap(__float_as_uint(v), __float_as_uint(v), false, false); return __uint_as_float(rr[0]) + __uint_as_float(rr[1]); }
__device__ __forceinline__ float sigmoid_f(float x) { return fast_rcp(1.0f + fast_exp2(-x * LOG2E)); }

namespace pg8 {
constexpr int BM = 256, BK = 64, HALF = 128, HTB = HALF * BK * 2  , STAGE_BYTES = 8 * HTB, NXCD = 8, WGM = 8;
__host__ __device__ __forceinline__ int lds_byte(int r, int c) { const int st = (r >> 4) * 2 + (c >> 5), rr = r & 15, cc = c & 31, ob = rr * 64 + cc * 2; return st * 1024 + (ob ^ (((ob >> 9) & 1) << 5)); }
__host__ __device__ __forceinline__ void stage_rc(int b, int& R, int& C) { const int st = b / 1024, sb = b % 1024, swz = sb ^ (((sb >> 9) & 1) << 5); R = (st >> 1) * 16 + swz / 64; C = (st & 1) * 32 + (swz % 64) / 2; }
__host__ __device__ __forceinline__ int perm32(int rho) { const int n = rho >> 4, i = rho & 15; return 8 * (i >> 2) + 4 * n + (i & 3); }

struct GUnit { const char* A; const char* B; int lda, ldb, nt, pm, pn, id; };

struct TileOrder {
    int nM, nN, nwg, G, c;
    __device__ void init(int nM_, int nN_, int G_, int c_) { nM = nM_; nN = nN_; nwg = nM * nN; G = G_; c = c_; }
    __device__ bool tile(int i, int& pm, int& pn) const {
        const long L = (long)i * G + c; if (L >= nwg) return false;
        int wgid = (int)L; { const int q = nwg / NXCD, r = nwg % NXCD, xcd = wgid % NXCD, off = wgid / NXCD; wgid = (xcd < r ? xcd * (q + 1) : r * (q + 1) + (xcd - r) * q) + off; }
        const int nig = WGM * nN, gid = wgid / nig, fm = gid * WGM, gsz = (nM - fm) < WGM ? (nM - fm) : WGM;
        pm = fm + ((wgid % nig) % gsz); pn = (wgid % nig) / gsz; return true;
    }
};

template <class Epi, class Sched, bool ALIGN_EPI>
__device__ __forceinline__ void gemm_phase(LAS unsigned char* lds, const Sched& S, const Epi& E) {
    int tid_o = threadIdx.x; asm volatile("" : "+v"(tid_o));
    const int tid = tid_o, wid = __builtin_amdgcn_readfirstlane(tid >> 6), lane = tid & 63, wr = wid >> 2, wc = wid & 3; int fr = lane & 15, fq = lane >> 4;
    int sR[2], sC[2], sRb[2];
#pragma unroll
    for (int i = 0; i < 2; ++i) { stage_rc(tid * 16 + i * 8192, sR[i], sC[i]); sRb[i] = Epi::PERM ? ((sR[i] & ~31) + perm32(sR[i] & 31)) : sR[i]; sC[i] *= 2; }
    const size_t kstep = (size_t)(BK * 2);
    const unsigned ldsw = (unsigned)wid * 1024u;
    const int aoff = lds_byte(wr * 64 + fr, fq * 8), boff = lds_byte(wc * 32 + fr, fq * 8);
#define PG8_SA(b, h) (((b) * 2 + (h)) * HTB)
#define PG8_SB(b, h) ((4 + (b) * 2 + (h)) * HTB)
#define PG8_STAGE(bufoff, gbase, rows, ld) do { _Pragma("unroll") for (int _i = 0; _i < 2; ++_i) \
        __builtin_amdgcn_global_load_lds((const unsigned*)((const char*)(gbase) + (unsigned)((rows)[_i] * (ld) + sC[_i])), (LAS unsigned*)(lds + (bufoff) + ldsw + _i * 8192), 16, 0, 0); } while (0)
#define PG8_LDA(dst, b, h) do { _Pragma("unroll") for (int m = 0; m < 4; ++m) _Pragma("unroll") for (int k = 0; k < 2; ++k) dst[m][k] = *(const LAS bf16x8*)(lds + PG8_SA(b, h) + aoff + m * 2048 + k * 1024); } while (0)
#define PG8_LDB(dst, b, h) do { _Pragma("unroll") for (int n = 0; n < 2; ++n) _Pragma("unroll") for (int k = 0; k < 2; ++k) dst[n][k] = *(const LAS bf16x8*)(lds + PG8_SB(b, h) + boff + n * 2048 + k * 1024); } while (0)
#define PG8_MMA(ai, bj, At, Bt) do { __builtin_amdgcn_s_setprio(1); _Pragma("unroll") for (int m = 0; m < 4; ++m) _Pragma("unroll") for (int n = 0; n < 2; ++n) _Pragma("unroll") for (int k = 0; k < 2; ++k) \
        acc[ai][bj][m][n] = __builtin_amdgcn_mfma_f32_16x16x32_bf16(Bt[n][k], At[m][k], acc[ai][bj][m][n], 0, 0, 0); __builtin_amdgcn_s_setprio(0); } while (0)
#define PG8_WAIT_V(n) asm volatile("s_waitcnt vmcnt(" #n ")" ::: "memory")
#define PG8_WAIT_L(n) asm volatile("s_waitcnt lgkmcnt(" #n ")" ::: "memory")
#define PG8_BAR __builtin_amdgcn_s_barrier()
#define PG8_SCHED __builtin_amdgcn_sched_barrier(0)
    GUnit cur, nxt; int ui = 0;
    if (!S.next(0, cur)) return;
    f32x4 acc[2][2][4][2];
#pragma unroll
    for (int a = 0; a < 2; ++a)
#pragma unroll
        for (int b = 0; b < 2; ++b)
#pragma unroll
            for (int m = 0; m < 4; ++m)
#pragma unroll
                for (int n = 0; n < 2; ++n) acc[a][b][m][n] = (f32x4){0.f, 0.f, 0.f, 0.f};
    bf16x8 At[4][2], B0[2][2], B1[2][2];
    int ldAc = cur.lda, ldBc = cur.ldb; size_t hAc = (size_t)HALF * ldAc, hBc = (size_t)HALF * ldBc;
    const char* cA = cur.A; const char* cB = cur.B;
    PG8_STAGE(PG8_SB(0, 0), cB, sRb, ldBc); PG8_STAGE(PG8_SB(0, 1), cB + hBc, sRb, ldBc); PG8_STAGE(PG8_SA(0, 0), cA, sR, ldAc); PG8_STAGE(PG8_SA(0, 1), cA + hAc, sR, ldAc);
    if (wr == 1) PG8_BAR;
    PG8_WAIT_V(2); PG8_BAR;
    PG8_STAGE(PG8_SB(1, 0), cB + kstep, sRb, ldBc); PG8_STAGE(PG8_SA(1, 0), cA + kstep, sR, ldAc); PG8_STAGE(PG8_SB(1, 1), cB + hBc + kstep, sRb, ldBc);
    PG8_WAIT_V(6); PG8_BAR;
    for (;;) {
        const bool has_next = S.next(ui + 1, nxt);
        int ldAn, ldBn; const char* nA; const char* nB;
        if (has_next) { ldAn = nxt.lda; ldBn = nxt.ldb; nA = nxt.A; nB = nxt.B; } else { ldAn = ldAc; ldBn = ldBc; nA = cA; nB = cB; }
        const size_t hAn = (size_t)HALF * ldAn, hBn = (size_t)HALF * ldBn;
        int nt = cur.nt; asm volatile("" : "+s"(nt));
        for (int t = 0; t < nt; t += 2) {
            const bool last = (t == nt - 2);
            const char* a1 = cA + (size_t)(t + 1) * kstep;
            const char* a2 = last ? nA : cA + (size_t)(t + 2) * kstep; const char* b2 = last ? nB : cB + (size_t)(t + 2) * kstep;
            const char* a3 = a2 + kstep; const char* b3 = b2 + kstep;
            const int ldA2 = last ? ldAn : ldAc, ldB2 = last ? ldBn : ldBc;
            const size_t hA2 = last ? hAn : hAc, hB2 = last ? hBn : hBc;
            PG8_LDB(B0, 0, 0); PG8_LDB(B1, 0, 1); PG8_SCHED; PG8_LDA(At, 0, 0); PG8_STAGE(PG8_SA(1, 1), a1 + hAc, sR, ldAc);
            PG8_WAIT_V(8); PG8_WAIT_L(0); PG8_BAR; PG8_MMA(0, 0, At, B0); PG8_MMA(0, 1, At, B1); PG8_BAR; PG8_SCHED;
            PG8_LDA(At, 0, 1); PG8_STAGE(PG8_SB(0, 0), b2, sRb, ldB2); PG8_STAGE(PG8_SB(0, 1), b2 + hB2, sRb, ldB2); PG8_STAGE(PG8_SA(0, 0), a2, sR, ldA2);
            PG8_WAIT_V(8); PG8_WAIT_L(0); PG8_BAR; PG8_MMA(1, 0, At, B0); PG8_MMA(1, 1, At, B1); PG8_BAR; PG8_SCHED;
            PG8_LDB(B0, 1, 0); PG8_LDB(B1, 1, 1); PG8_SCHED; PG8_LDA(At, 1, 0); PG8_STAGE(PG8_SA(0, 1), a2 + hA2, sR, ldA2);
            PG8_WAIT_V(8); PG8_WAIT_L(0); PG8_BAR; PG8_MMA(0, 0, At, B0); PG8_MMA(0, 1, At, B1); PG8_BAR; PG8_SCHED;
            PG8_LDA(At, 1, 1); PG8_STAGE(PG8_SB(1, 0), b3, sRb, ldB2); PG8_STAGE(PG8_SB(1, 1), b3 + hB2, sRb, ldB2); PG8_STAGE(PG8_SA(1, 0), a3, sR, ldA2);
            PG8_WAIT_V(8); PG8_WAIT_L(0); PG8_BAR; PG8_MMA(1, 0, At, B0); PG8_MMA(1, 1, At, B1); PG8_BAR; PG8_SCHED;
        }
        if constexpr (ALIGN_EPI) { if (wr == 0) PG8_BAR; }
        E(acc, cur, wr, wc, fr, fq);
        if (!has_next) break;
#pragma unroll
        for (int a = 0; a < 2; ++a)
#pragma unroll
            for (int b = 0; b < 2; ++b)
#pragma unroll
                for (int m = 0; m < 4; ++m)
#pragma unroll
                    for (int n = 0; n < 2; ++n) acc[a][b][m][n] = (f32x4){0.f, 0.f, 0.f, 0.f};
        cur = nxt; cA = nA; cB = nB; ++ui;
        ldAc = ldAn; ldBc = ldBn; hAc = hAn; hBc = hBn;
        if constexpr (ALIGN_EPI) { if (wr == 1) PG8_BAR; }
    }
    PG8_WAIT_V(0);
    if constexpr (!ALIGN_EPI) { if (wr == 0) PG8_BAR; }
    PG8_BAR;
#undef PG8_SA
#undef PG8_SB
#undef PG8_STAGE
#undef PG8_LDA
#undef PG8_LDB
#undef PG8_MMA
#undef PG8_WAIT_V
#undef PG8_WAIT_L
#undef PG8_BAR
#undef PG8_SCHED
}
}
using pg8::GUnit;
namespace pg8 {
#define EPI_OPAQUE() asm volatile("" : "+v"(fr), "+v"(fq))
struct EpiBf16 {
    static constexpr bool PERM = true;
    bf16_t* O; int ldc;
    __device__ __forceinline__ void operator()(const f32x4 (&acc)[2][2][4][2], const GUnit& u, int wr, int wc, int fr, int fq) const {
        EPI_OPAQUE();
        const int row0 = u.pm * BM + wr * 64 + fr, col0 = u.pn * BM + wc * 32 + 8 * fq;
#pragma unroll
        for (int ai = 0; ai < 2; ++ai)
#pragma unroll
            for (int m = 0; m < 4; ++m) { bf16_t* rowp = O + (size_t)(row0 + ai * HALF + m * 16) * ldc + col0;
#pragma unroll
                for (int bj = 0; bj < 2; ++bj) { const f32x4 v0 = acc[ai][bj][m][0], v1 = acc[ai][bj][m][1];
                    u32x4 w; w.x = cvtpk(v0[0], v0[1]); w.y = cvtpk(v0[2], v0[3]); w.z = cvtpk(v1[0], v1[1]); w.w = cvtpk(v1[2], v1[3]);
                    *(u32x4*)(rowp + bj * HALF) = w; } }
    }
};
struct EpiF32 {
    static constexpr bool PERM = false;
    float* O; int ldc;
    __device__ __forceinline__ void operator()(const f32x4 (&acc)[2][2][4][2], const GUnit& u, int wr, int wc, int fr, int fq) const {
        EPI_OPAQUE();
        const int row0 = u.pm * BM + wr * 64 + fr, col0 = u.pn * BM + wc * 32 + 4 * fq;
#pragma unroll
        for (int ai = 0; ai < 2; ++ai)
#pragma unroll
            for (int m = 0; m < 4; ++m) { float* rowp = O + (size_t)(row0 + ai * HALF + m * 16) * ldc + col0;
#pragma unroll
                for (int bj = 0; bj < 2; ++bj)
#pragma unroll
                    for (int n = 0; n < 2; ++n) *(f32x4*)(rowp + bj * HALF + n * 16) = acc[ai][bj][m][n]; }
    }
};
__device__ __forceinline__ void rope8(f32x4& v0, f32x4& v1, const float* cs  ) {
    const f32x4 a = *(const f32x4*)cs, b = *(const f32x4*)(cs + 4);
    f32x4 r0, r1;
    r0[0] = v0[0] * a[0] - v0[1] * a[1]; r0[1] = v0[1] * a[0] + v0[0] * a[1];
    r0[2] = v0[2] * a[2] - v0[3] * a[3]; r0[3] = v0[3] * a[2] + v0[2] * a[3];
    r1[0] = v1[0] * b[0] - v1[1] * b[1]; r1[1] = v1[1] * b[0] + v1[0] * b[1];
    r1[2] = v1[2] * b[2] - v1[3] * b[3]; r1[3] = v1[3] * b[2] + v1[2] * b[3];
    v0 = r0; v1 = r1;
}
struct EpiInProj {
    static constexpr bool PERM = true;
    bf16_t* P; bf16_t* kcmp; bf16_t* vcmp; float* side; bf16_t* krot; const float* rope; float* ssq_q; float* ssq_kv;
    __device__ __forceinline__ void operator()(const f32x4 (&acc)[2][2][4][2], const GUnit& u, int wr, int wc, int fr, int fq) const {
        EPI_OPAQUE();
        const int row0 = u.pm * BM + wr * 64 + fr, col0 = u.pn * BM + wc * 32 + 8 * fq;
#pragma unroll
        for (int ai = 0; ai < 2; ++ai)
#pragma unroll
            for (int m = 0; m < 4; ++m) { const int row = row0 + ai * HALF + m * 16; bf16_t* rowp = P + (size_t)row * PW + col0;
                float ssq = 0.f;
#pragma unroll
                for (int bj = 0; bj < 2; ++bj) { f32x4 v0 = acc[ai][bj][m][0], v1 = acc[ai][bj][m][1];
                    if (u.pn == 2 && bj == 1) {
                        if (wc == 0 && fq < 2) { float* sp = side + (size_t)row * 16 + 8 * fq; *(f32x4*)sp = v0; *(f32x4*)(sp + 4) = v1; }
                        if (wc == 1) { rope8(v0, v1, rope + (size_t)(row & (SEQ - 1)) * 32 + 8 * fq);
                            u32x4 w; w.x = cvtpk(v0[0], v0[1]); w.y = cvtpk(v0[2], v0[3]); w.z = cvtpk(v1[0], v1[1]); w.w = cvtpk(v1[2], v1[3]);
                            *(u32x4*)(krot + (size_t)row * 32 + 8 * fq) = w; }
                    }
                    u32x4 w; w.x = cvtpk(v0[0], v0[1]); w.y = cvtpk(v0[2], v0[3]); w.z = cvtpk(v1[0], v1[1]); w.w = cvtpk(v1[2], v1[3]);
                    *(u32x4*)(rowp + bj * HALF) = w;
                    if (u.pn == 1 && bj == 0) { bf16_t* cp = (wc < 2 ? kcmp : vcmp) + (size_t)row * 64 + (wc & 1) * 32 + 8 * fq; *(u32x4*)cp = w; }
                    if (u.pn == 11 || (u.pn == 7 && bj == 1)) ssq += (v0[0] * v0[0] + v0[1] * v0[1]) + (v0[2] * v0[2] + v0[3] * v0[3]) + (v1[0] * v1[0] + v1[1] * v1[1]) + (v1[2] * v1[2] + v1[3] * v1[3]);
                }
                if (u.pn == 11 || u.pn == 7) { ssq += xor_lane_lt32<16>(ssq); ssq = sum_halves(ssq);
                    if (fq == 0) (u.pn == 11 ? ssq_q : ssq_kv)[(size_t)row * 4 + wc] = ssq; }
                asm volatile("" ::: "memory");
            }
    }
};
struct EpiQup {
    static constexpr bool PERM = true;
    bf16_t* O; const float* ssq_q; const float* rope;
    __device__ __forceinline__ void operator()(const f32x4 (&acc)[2][2][4][2], const GUnit& u, int wr, int wc, int fr, int fq) const {
        EPI_OPAQUE();
        const int row0 = u.pm * BM + wr * 64 + fr, col0 = u.pn * BM + wc * 32 + 8 * fq;
#pragma unroll
        for (int ai = 0; ai < 2; ++ai)
#pragma unroll
            for (int m = 0; m < 4; ++m) { const int row = row0 + ai * HALF + m * 16; bf16_t* rowp = O + (size_t)row * 512 + col0;
                const f32x4 pq = *(const f32x4*)(ssq_q + (size_t)row * 4);
                const float rstd = 1.0f / sqrtf(((pq[0] + pq[1]) + (pq[2] + pq[3])) * (1.0f / 256.0f) + RMS_EPS);
#pragma unroll
                for (int bj = 0; bj < 2; ++bj) { f32x4 v0 = acc[ai][bj][m][0] * rstd, v1 = acc[ai][bj][m][1] * rstd;
                    const int c8 = col0 + bj * HALF, within = c8 % 96;
                    if (c8 < 384 && within >= 64) rope8(v0, v1, rope + (size_t)(row & (SEQ - 1)) * 32 + (within - 64));
                    u32x4 w; w.x = cvtpk(v0[0], v0[1]); w.y = cvtpk(v0[2], v0[3]); w.z = cvtpk(v1[0], v1[1]); w.w = cvtpk(v1[2], v1[3]);
                    *(u32x4*)(rowp + bj * HALF) = w; }
                asm volatile("" ::: "memory"); }
    }
};
struct EpiKVup {
    static constexpr bool PERM = true;
    bf16_t* O; const float* ssq_kv;
    __device__ __forceinline__ void operator()(const f32x4 (&acc)[2][2][4][2], const GUnit& u, int wr, int wc, int fr, int fq) const {
        EPI_OPAQUE();
        const int row0 = u.pm * BM + wr * 64 + fr, col0 = u.pn * BM + wc * 32 + 8 * fq;
#pragma unroll
        for (int ai = 0; ai < 2; ++ai)
#pragma unroll
            for (int m = 0; m < 4; ++m) { const int row = row0 + ai * HALF + m * 16; bf16_t* rowp = O + (size_t)row * 512 + col0;
                const f32x4 pq = *(const f32x4*)(ssq_kv + (size_t)row * 4);
                const float rstd = 1.0f / sqrtf(((pq[0] + pq[1]) + (pq[2] + pq[3])) * (1.0f / 128.0f) + RMS_EPS);
#pragma unroll
                for (int bj = 0; bj < 2; ++bj) { const f32x4 v0 = acc[ai][bj][m][0] * rstd, v1 = acc[ai][bj][m][1] * rstd;
                    u32x4 w; w.x = cvtpk(v0[0], v0[1]); w.y = cvtpk(v0[2], v0[3]); w.z = cvtpk(v1[0], v1[1]); w.w = cvtpk(v1[2], v1[3]);
                    *(u32x4*)(rowp + bj * HALF) = w; }
                asm volatile("" ::: "memory"); }
    }
};
__device__ __forceinline__ float gelu_tanh(float x) { const float u2 = 2.0f * 0.7978845608028654f * (x + 0.044715f * x * x * x); return x * fast_rcp(1.0f + fast_exp2(-u2 * LOG2E)); }
struct EpiCmp1 {
    static constexpr bool PERM = true;
    bf16_t* O; const float* bias1;
    __device__ __forceinline__ void operator()(const f32x4 (&acc)[2][2][4][2], const GUnit& u, int wr, int wc, int fr, int fq) const {
        EPI_OPAQUE();
        const int row0 = u.pm * BM + wr * 64 + fr, col0 = wc * 32 + 8 * fq;
        f32x4 bv[2][2];
#pragma unroll
        for (int bj = 0; bj < 2; ++bj)
#pragma unroll
            for (int n = 0; n < 2; ++n) bv[bj][n] = *(const f32x4*)(bias1 + col0 + bj * HALF + 4 * n);
#pragma unroll
        for (int ai = 0; ai < 2; ++ai)
#pragma unroll
            for (int m = 0; m < 4; ++m) { bf16_t* rowp = O + (size_t)(row0 + ai * HALF + m * 16) * 256 + col0;
#pragma unroll
                for (int bj = 0; bj < 2; ++bj) { f32x4 v0 = acc[ai][bj][m][0] + bv[bj][0], v1 = acc[ai][bj][m][1] + bv[bj][1];
#pragma unroll
                    for (int e = 0; e < 4; ++e) { v0[e] = gelu_tanh(v0[e]); v1[e] = gelu_tanh(v1[e]); }
                    u32x4 w; w.x = cvtpk(v0[0], v0[1]); w.y = cvtpk(v0[2], v0[3]); w.z = cvtpk(v1[0], v1[1]); w.w = cvtpk(v1[2], v1[3]);
                    *(u32x4*)(rowp + bj * HALF) = w; } }
    }
};
typedef __amdgpu_buffer_rsrc_t rsrc_t;
struct EpiMerge {
    static constexpr bool PERM = true;
    bf16_t* O;
    unsigned char* scr;
    __device__ __forceinline__ void operator()(const f32x4 (&acc)[2][2][4][2], const GUnit& u, int wr, int wc, int fr, int fq) const {
        EPI_OPAQUE();
        const int tid = (wr * 4 + wc) * 64 + fq * 16 + fr;
        const int sub = u.id;
        const rsrc_t rs = __builtin_amdgcn_make_buffer_rsrc(scr, 0, 131072, 0x00020000), rp = __builtin_amdgcn_make_buffer_rsrc(scr + 131072, 0, 262144, 0x00020000);
        if ((sub & 1) == 0) {
#pragma unroll
            for (int ai = 0; ai < 2; ++ai)
#pragma unroll
                for (int bj = 0; bj < 2; ++bj)
#pragma unroll
                    for (int m = 0; m < 4; ++m)
#pragma unroll
                        for (int n = 0; n < 2; ++n) { const int q = ((ai * 2 + bj) * 4 + m) * 2 + n; const f32x4 v = acc[ai][bj][m][n];
                            u32x2 w; w.x = cvtpk(v[0], v[1]); w.y = cvtpk(v[2], v[3]);
                            __builtin_amdgcn_raw_buffer_store_b64(w, rs, tid * 8, q * 4096, 0); }
            return;
        }
        const int row0 = u.pm * BM + wr * 64 + fr, col0 = u.pn * BM + wc * 32 + 8 * fq;
#pragma unroll
        for (int ai = 0; ai < 2; ++ai)
#pragma unroll
            for (int m = 0; m < 4; ++m) { bf16_t* rowp = O + (size_t)(row0 + ai * HALF + m * 16) * DM + col0;
#pragma unroll
                for (int bj = 0; bj < 2; ++bj) { f32x4 t[2];
#pragma unroll
                    for (int n = 0; n < 2; ++n) { const int q = ((ai * 2 + bj) * 4 + m) * 2 + n; const f32x4 g = acc[ai][bj][m][n];
                        const u32x2 s = __builtin_amdgcn_raw_buffer_load_b64(rs, tid * 8, q * 4096, 0);
                        f32x4 b; b[0] = __uint_as_float(s.x << 16); b[1] = __uint_as_float(s.x & 0xffff0000u); b[2] = __uint_as_float(s.y << 16); b[3] = __uint_as_float(s.y & 0xffff0000u);
                        f32x4 r;
#pragma unroll
                        for (int e = 0; e < 4; ++e) r[e] = sigmoid_f(g[e]) * b[e];
                        if (sub != 1) { const u32x4 pr = __builtin_amdgcn_raw_buffer_load_b128(rp, tid * 16, q * 8192, 0);
#pragma unroll
                            for (int e = 0; e < 4; ++e) r[e] += __uint_as_float(pr[e]); }
                        if (sub != 7) { u32x4 pw;
#pragma unroll
                            for (int e = 0; e < 4; ++e) pw[e] = __float_as_uint(r[e]);
                            __builtin_amdgcn_raw_buffer_store_b128(pw, rp, tid * 16, q * 8192, 0); }
                        t[n] = r; }
                    if (sub == 7) { u32x4 w; w.x = cvtpk(t[0][0], t[0][1]); w.y = cvtpk(t[0][2], t[0][3]); w.z = cvtpk(t[1][0], t[1][1]); w.w = cvtpk(t[1][2], t[1][3]);
                        *(u32x4*)(rowp + bj * HALF) = w; }
                    asm volatile("" ::: "memory"); } }
    }
};
}
#define XB_TMO      128
#define XB_XCNT(j)  (256  + 64 * (j))
#define XB_XSUB(j)  (1280 + 64 * (j))
#define XB_XGEN(j)  (2304 + 64 * (j))
#define XB_TOP      3328
#define XB_TOPGEN   3392
#define XCD_BAR_WORDS 3456
#define XB_SPIN_CAP (1u << 22)
__device__ __forceinline__ unsigned xb_ld(unsigned* p)              { return __hip_atomic_load(p, __ATOMIC_RELAXED, __HIP_MEMORY_SCOPE_AGENT); }
__device__ __forceinline__ unsigned xb_add(unsigned* p, unsigned v) { return __hip_atomic_fetch_add(p, v, __ATOMIC_RELAXED, __HIP_MEMORY_SCOPE_AGENT); }
__device__ __forceinline__ unsigned xb_xcc_id() { return (unsigned)__builtin_amdgcn_s_getreg((3 << 11) | 20) & 0xFu; }
#define XB_SPIN(cond, bar) do { unsigned _sp = 0; while (cond) { __builtin_amdgcn_s_sleep(1); \
    if ((++_sp & 255u) == 0u) { if (xb_ld(&(bar)[XB_TMO])) break; if (_sp > XB_SPIN_CAP) { atomicAdd(&(bar)[XB_TMO], 1u); break; } } } } while (0)
struct XcdBarrier { unsigned* bar; unsigned x; volatile LAS unsigned* st; };
__device__ __forceinline__ XcdBarrier xcd_barrier_post(unsigned* bar, volatile LAS unsigned* st) {
    XcdBarrier b; b.bar = bar; b.x = xb_xcc_id(); b.st = st;
    if (threadIdx.x == 0) (void)xb_add(&bar[XB_XCNT(b.x)], 1u);
    return b;
}
__device__ __forceinline__ void xcd_barrier_complete(unsigned* bar, unsigned x, unsigned& nloc, unsigned& nx) {
    const unsigned G = gridDim.x * gridDim.y * gridDim.z;
    unsigned sum, cnt, mine, sp = 0u;
    for (;;) {
        sum = 0u; cnt = 0u; mine = 0u;
#pragma unroll
        for (unsigned j = 0; j < 16; ++j) { const unsigned c = xb_ld(&bar[XB_XCNT(j)]); sum += c; cnt += (c > 0u) ? 1u : 0u; mine = (j == x) ? c : mine; }
        if (sum == G) break;
        __builtin_amdgcn_s_sleep(1);
        if ((++sp & 255u) == 0u) { if (xb_ld(&bar[XB_TMO])) break; if (sp > XB_SPIN_CAP) { atomicAdd(&bar[XB_TMO], 1u); break; } }
    }
    nloc = mine > 0u ? mine : 1u; nx = cnt > 0u ? cnt : 1u;
}
__device__ __forceinline__ void xcd_barrier(const XcdBarrier& b) {
    asm volatile("s_waitcnt vmcnt(0)" ::: "memory");
    __syncthreads();
    if (threadIdx.x == 0) {
        unsigned* bar = b.bar; unsigned bx = b.x;
        asm volatile("" : "+s"(bx));
        __builtin_amdgcn_s_waitcnt(0);
        unsigned nloc = b.st[0], nx = b.st[1];
        if (nloc == 0u) { xcd_barrier_complete(bar, bx, nloc, nx); b.st[0] = nloc; b.st[1] = nx; }
        const unsigned old = xb_add(&bar[XB_XSUB(bx)], 1u);
        const unsigned gen = old / nloc;
        if (old + 1u == (gen + 1u) * nloc) {
            __builtin_amdgcn_fence(__ATOMIC_RELEASE, "agent");
            asm volatile("s_waitcnt vmcnt(0)" ::: "memory");
            const unsigned og = xb_add(&bar[XB_TOP], 1u);
            const unsigned tg = og / nx;
            if (og + 1u == (tg + 1u) * nx) xb_add(&bar[XB_TOPGEN], 1u);
            else XB_SPIN(xb_ld(&bar[XB_TOPGEN]) == tg, bar);
            __builtin_amdgcn_fence(__ATOMIC_ACQUIRE, "agent");
            xb_add(&bar[XB_XGEN(bx)], 1u);
            asm volatile("s_waitcnt vmcnt(0)" ::: "memory");
        } else {
            XB_SPIN(xb_ld(&bar[XB_XGEN(bx)]) == gen, bar);
            __builtin_amdgcn_fence(__ATOMIC_ACQUIRE, "agent");
            asm volatile("s_waitcnt vmcnt(0)" ::: "memory");
        }
    }
    __syncthreads();
}

#define MFMA32(a, b, c) __builtin_amdgcn_mfma_f32_32x32x16_bf16(a, b, c, 0, 0, 0)
typedef short v4i16_t __attribute__((ext_vector_type(4)));
typedef LAS const char* lds_cptr;
typedef LAS char* lds_ptr;
__device__ __forceinline__ int crow(int r, int hi) { return (r & 3) + 8 * (r >> 2) + 4 * hi; }
__device__ __forceinline__ s16x4 vtr(lds_cptr p) { return __builtin_bit_cast(s16x4, __builtin_amdgcn_ds_read_tr16_b64_v4i16((LAS v4i16_t*)p)); }
__device__ __forceinline__ float other_half(float x, int hi) { auto rr = __builtin_amdgcn_permlane32_swap(__float_as_uint(x), __float_as_uint(x), false, false); return __uint_as_float(hi ? rr[0] : rr[1]); }
constexpr float NEG_INF = -INFINITY;

constexpr int TB_V = 12288, TB_KB = 20480, TB_SIZE = 20992;
struct Stg { u32x4 k, k2, v; float kb; };

template <int NKS> __device__ __forceinline__ void qk64(lds_cptr kbuf, const bf16x8* qf, int r32, int hi, f32x16& p0, f32x16& p1) {
    lds_cptr kp = kbuf + hi * 1024 + r32 * 16;
#pragma unroll
    for (int ks = 0; ks < NKS; ++ks) {
        const bf16x8 a0 = *(const LAS bf16x8*)(kp + ks * 2048), a1 = *(const LAS bf16x8*)(kp + ks * 2048 + 512);
        p0 = MFMA32(a0, qf[ks], p0); p1 = MFMA32(a1, qf[ks], p1);
    }
}
struct AState { f32x16 o0, o1; float m, l; };
__device__ __forceinline__ void astate_init(AState& s) {
#pragma unroll
    for (int r = 0; r < 16; ++r) { s.o0[r] = 0.f; s.o1[r] = 0.f; }
    s.m = NEG_INF; s.l = 0.f;
}
__device__ __forceinline__ void pv64(f32x16& o0, f32x16& o1, lds_cptr vp, const bf16x8 (&pf)[4]) {
#pragma unroll
    for (int ks = 0; ks < 4; ++ks) {
        const s16x4 l0 = vtr(vp + ks * 1024), h0 = vtr(vp + ks * 1024 + 512), l1 = vtr(vp + 4096 + ks * 1024), h1 = vtr(vp + 4096 + ks * 1024 + 512);
        const bf16x8 v0 = (bf16x8){l0[0], l0[1], l0[2], l0[3], h0[0], h0[1], h0[2], h0[3]}, v1 = (bf16x8){l1[0], l1[1], l1[2], l1[3], h1[0], h1[1], h1[2], h1[3]};
        o0 = MFMA32(v0, pf[ks], o0); o1 = MFMA32(v1, pf[ks], o1);
    }
}
__device__ __forceinline__ void pack_p(const f32x16& p0, const f32x16& p1, bf16x8 (&pf)[4]) {
    u32x4 w0, w1, w2, w3;
    w0.x = cvtpk(p0[0], p0[1]); w0.y = cvtpk(p0[2], p0[3]); w0.z = cvtpk(p0[4], p0[5]); w0.w = cvtpk(p0[6], p0[7]);
    w1.x = cvtpk(p0[8], p0[9]); w1.y = cvtpk(p0[10], p0[11]); w1.z = cvtpk(p0[12], p0[13]); w1.w = cvtpk(p0[14], p0[15]);
    w2.x = cvtpk(p1[0], p1[1]); w2.y = cvtpk(p1[2], p1[3]); w2.z = cvtpk(p1[4], p1[5]); w2.w = cvtpk(p1[6], p1[7]);
    w3.x = cvtpk(p1[8], p1[9]); w3.y = cvtpk(p1[10], p1[11]); w3.z = cvtpk(p1[12], p1[13]); w3.w = cvtpk(p1[14], p1[15]);
    pf[0] = __builtin_bit_cast(bf16x8, w0); pf[1] = __builtin_bit_cast(bf16x8, w1); pf[2] = __builtin_bit_cast(bf16x8, w2); pf[3] = __builtin_bit_cast(bf16x8, w3);
}
__device__ __forceinline__ void softmax_pv64(f32x16& p0, f32x16& p1, AState& s, lds_cptr vp, int hi) {
    float mx = fmaxf(p0[0], p1[0]);
#pragma unroll
    for (int r = 1; r < 16; ++r) mx = fmaxf(mx, fmaxf(p0[r], p1[r]));
    mx = fmaxf(mx, other_half(mx, hi));
    const float mn = fmaxf(s.m, mx), ms = (mn == NEG_INF) ? 0.f : mn;
    const float alpha = fast_exp2(s.m - ms);
    float rs = 0.f;
#pragma unroll
    for (int r = 0; r < 16; ++r) { p0[r] = fast_exp2(p0[r] - ms); p1[r] = fast_exp2(p1[r] - ms); rs += p0[r] + p1[r]; }
    rs += other_half(rs, hi);
    s.l = s.l * alpha + rs; s.m = mn;
#pragma unroll
    for (int r = 0; r < 16; ++r) { s.o0[r] *= alpha; s.o1[r] *= alpha; }
    bf16x8 pf[4]; pack_p(p0, p1, pf);
    pv64(s.o0, s.o1, vp, pf);
}
__device__ __forceinline__ void mask_causal(f32x16& p0, f32x16& p1, int kpos0, int tq, int hi) {
#pragma unroll
    for (int r = 0; r < 16; ++r) { const int kp = kpos0 + crow(r, hi); if (kp > tq) p0[r] = NEG_INF; if (kp + 32 > tq) p1[r] = NEG_INF; }
}
__device__ __forceinline__ void add_table(f32x16& p0, f32x16& p1, const LAS float* tb) {
#pragma unroll
    for (int r = 0; r < 16; ++r) { const int o = (r & 3) + 8 * (r >> 2); p0[r] += tb[o]; p1[r] += tb[o + 32]; }
}
__device__ __forceinline__ void store_o_bf16(bf16_t* orow, const f32x16& o0, const f32x16& o1, float sc, int hi) {
#pragma unroll
    for (int g = 0; g < 4; ++g) {
        u32x2 w0, w1; w0.x = cvtpk(o0[4 * g] * sc, o0[4 * g + 1] * sc); w0.y = cvtpk(o0[4 * g + 2] * sc, o0[4 * g + 3] * sc);
        w1.x = cvtpk(o1[4 * g] * sc, o1[4 * g + 1] * sc); w1.y = cvtpk(o1[4 * g + 2] * sc, o1[4 * g + 3] * sc);
        *(u32x2*)(orow + 8 * g + 4 * hi) = w0; *(u32x2*)(orow + 32 + 8 * g + 4 * hi) = w1;
    }
}
constexpr size_t MiB = 1u << 20, KiB = 1u << 10;
constexpr size_t WS_CTL = 0, CTL_ZERO_BYTES = 1 * MiB;
constexpr size_t WS_ROPE = 1 * MiB, WS_NSATAB = WS_ROPE + 512 * KiB, WS_DILTAB = WS_NSATAB + 32 * KiB, WS_CMPB = WS_DILTAB + 8 * KiB, WS_FARB = WS_CMPB + 4 * KiB;
constexpr size_t WS_WT = 4 * MiB, LW = 38 * MiB;
constexpr size_t LW_IN = 0, LW_G = 6 * MiB, LW_BR = 14 * MiB, LW_O = 16 * MiB, LW_UP = 18 * MiB, LW_DN = 29 * MiB, LW_UQ = 35 * MiB, LW_UKV = 35 * MiB + 256 * KiB, LW_PHI = 36 * MiB;
constexpr size_t BR_A = 0, BR_B = 512 * KiB, BR_C = 768 * KiB, BR_D = 1280 * KiB;
constexpr size_t WS_SIDE = 80 * MiB, WS_SSQQ = 84 * MiB, WS_SSQKV = 85 * MiB, WS_KB = 86 * MiB, WS_KROT = 87 * MiB, WS_KCMP = 91 * MiB, WS_VCMP = 100 * MiB,
                 WS_HID = 109 * MiB, WS_KC = 113 * MiB, WS_VC = 113 * MiB + 512 * KiB, WS_DLSE = 114 * MiB, WS_DOG = 116 * MiB;
constexpr size_t WS_H = 164 * MiB, WS_OCAT = 292 * MiB, WS_QM = 404 * MiB, WS_KVM = 468 * MiB, WS_P = 532 * MiB;
constexpr size_t WS_MERGED = 532 * MiB, WS_MSCR = 660 * MiB, WS_Y = 164 * MiB, WS_H2 = 756 * MiB, WS_U = 164 * MiB, WS_ACT = 532 * MiB, WS_Y2 = 884 * MiB, WS_END = 1024 * MiB;
constexpr size_t MSCR_PER_WG = 384 * KiB;
static_assert(WS_WT + 2 * LW <= WS_SIDE && WS_DOG + 48 * MiB <= WS_H && WS_P + 384 * MiB <= WS_END && WS_MSCR + 256 * MSCR_PER_WG <= WS_H2 && WS_H2 + 128 * MiB <= WS_Y2 && WS_Y2 + 128 * MiB <= WS_END, "ws map");
static_assert(WS_U + 352 * MiB <= WS_ACT && WS_ACT + 176 * MiB <= WS_H2 && WS_Y + 256 * MiB <= WS_MERGED, "ws overlays");
constexpr int CW_BAR = 4096;
constexpr int CW_Q = 16384;

constexpr int RING_BYTES = 131072, LDSCTL_OFF = RING_BYTES, MISC_OFF = LDSCTL_OFF + 320, LDS_BYTES = 147456;
constexpr int NSA_SLAB = 49152, NSA_SLAB_BYTES = 4 * 64 * 65 * 4, NSA_SEL = NSA_SLAB + NSA_SLAB_BYTES;
static_assert(NSA_SEL + 512 <= RING_BYTES && 4 * NSA_TL * 4 <= NSA_SLAB_BYTES && 2 * TB_SIZE <= NSA_SLAB, "NSA LDS map");

struct Frame {
    LAS unsigned char* lds; volatile LAS unsigned* MISC; gu32* ctl;
    int tid, lane, wave, G;
    const float* in[27]; float* out; unsigned char* ws;
};
#define WSP(T, off) ((T*)(F.ws + (off)))
#define VM_WAIT() asm volatile("s_waitcnt vmcnt(0)" ::: "memory")
#define LDS_WAIT() asm volatile("s_waitcnt lgkmcnt(0)" ::: "memory")

__device__ __forceinline__ int queue_grab(Frame& F, gu32* ctr) {
    if (F.tid == 0) F.MISC[0] = __hip_atomic_fetch_add(ctr, 1u, __ATOMIC_RELAXED, __HIP_MEMORY_SCOPE_AGENT);
    __syncthreads();
    const int v = (int)F.MISC[0];
    __syncthreads();
    return v;
}

template <bool FOX> __device__ __forceinline__ void causal_unit(Frame& F, int b, int h, int qb) {
    constexpr int NKS = FOX ? 4 : 6;
    int lane_o = F.lane; asm volatile("" : "+v"(lane_o));
    const int wid = F.wave, lane = lane_o, r32 = lane & 31, hi = lane >> 5;
    const size_t rowbase = (size_t)b * SEQ;
    const int q0 = qb * 256, tq = q0 + wid * 32 + r32, NT = qb * 4 + 4;
    const bf16_t* P = WSP(const bf16_t, WS_P);
    const bf16_t *Kb, *Vb, *Qrow; int kpitch, vpitch;
    const bf16_t* Kr = WSP(const bf16_t, WS_KROT) + rowbase * 32;
    const float* kbsrc = WSP(const float, WS_KB) + (size_t)(b * 4 + h) * SEQ;
    if (FOX) { Kb = P + rowbase * PW + PC_CK + h * 64; Vb = P + rowbase * PW + PC_CV + h * 64; kpitch = PW; vpitch = PW; Qrow = P + (rowbase + tq) * PW + PC_CQ + h * 64; }
    else { const bf16_t* KV = WSP(const bf16_t, WS_KVM) + rowbase * 512 + h * 128; Kb = KV; Vb = KV + 64; kpitch = 512; vpitch = 512; Qrow = WSP(const bf16_t, WS_QM) + (rowbase + tq) * 512 + h * 96; }
    bf16x8 qf[NKS];
#pragma unroll
    for (int ks = 0; ks < NKS; ++ks) qf[ks] = *(const bf16x8*)(Qrow + ks * 16 + hi * 8);
    AState st; astate_init(st);
    lds_ptr lds = (lds_ptr)F.lds;
    const int vpo = ((lane >> 4) & 1) * 32 + (lane & 3) * 8 + (4 * hi + ((lane & 15) >> 2)) * 64;
    Stg s;
#define CU_LOAD(t) do { s.k = *(const u32x4*)(Kb + (size_t)((t) * 64 + lane) * kpitch + wid * 8); \
        if (!FOX) { if (wid < 4) s.k2 = *(const u32x4*)(Kr + (size_t)((t) * 64 + lane) * 32 + wid * 8); } \
        s.v = *(const u32x4*)(Vb + (size_t)((t) * 64 + 16 * (wid & 3) + (lane >> 2)) * vpitch + (wid >> 2) * 32 + (lane & 3) * 8); \
        if (FOX) { if (wid == 0) s.kb = kbsrc[(t) * 64 + lane]; } } while (0)
#define CU_WRITE(bi) do { lds_ptr bp = lds + (bi) * TB_SIZE; *(LAS u32x4*)(bp + wid * 1024 + lane * 16) = s.k; \
        if (!FOX) { if (wid < 4) *(LAS u32x4*)(bp + (8 + wid) * 1024 + lane * 16) = s.k2; } \
        *(LAS u32x4*)(bp + TB_V + wid * 1024 + lane * 16) = s.v; \
        if (FOX) { if (wid == 0) *(LAS float*)(bp + TB_KB + lane * 4) = s.kb; } } while (0)
    CU_LOAD(0); CU_WRITE(0);
    __syncthreads();
    const int tq_lo = q0 + wid * 32;
    for (int t = 0; t < NT; ++t) {
        const int bi = t & 1;
        if (t + 1 < NT) CU_LOAD(t + 1);
        if (64 * t <= tq_lo + 31) {
            lds_cptr bp = (lds_cptr)(lds + bi * TB_SIZE);
            f32x16 p0, p1;
#pragma unroll
            for (int r = 0; r < 16; ++r) { p0[r] = 0.f; p1[r] = 0.f; }
            qk64<NKS>(bp, qf, r32, hi, p0, p1);
            if (FOX) {
                const LAS float* kbt = (const LAS float*)(bp + TB_KB) + 4 * hi;
#pragma unroll
                for (int g = 0; g < 4; ++g) { const f32x4 a = *(const LAS f32x4*)(kbt + 8 * g), c = *(const LAS f32x4*)(kbt + 32 + 8 * g);
#pragma unroll
                    for (int e = 0; e < 4; ++e) { p0[4 * g + e] += a[e]; p1[4 * g + e] += c[e]; } }
            }
            if (64 * t + 63 > tq_lo) mask_causal(p0, p1, 64 * t, tq, hi);
            softmax_pv64(p0, p1, st, bp + TB_V + vpo, hi);
        }
        if (t + 1 < NT) CU_WRITE(bi ^ 1);
        __syncthreads();
    }
#undef CU_LOAD
#undef CU_WRITE
    bf16_t* orow = WSP(bf16_t, WS_OCAT) + (rowbase + tq) * OCW + (FOX ? 384 : 640) + h * 64;
    store_o_bf16(orow, st.o0, st.o1, 1.0f / st.l, hi);
}
__device__ __forceinline__ void nsa_unit(Frame& F, int b, int qblk) {
    int lane_o = F.lane; asm volatile("" : "+v"(lane_o));
    const int wid = F.wave, lane = lane_o, r32 = lane & 31, hi = lane >> 5, tid = wid * 64 + lane;
    const int h = wid & 3, qs = wid >> 2;
    const int q0 = qblk * 64, cur = qblk, tq = q0 + 32 * qs + r32, tq_lo = q0 + 32 * qs;
    const size_t rowbase = (size_t)b * SEQ, row = rowbase + tq;
    const bf16_t* P = WSP(const bf16_t, WS_P);
    lds_ptr lds = (lds_ptr)F.lds;
    const int vpo = ((lane >> 4) & 1) * 32 + (lane & 3) * 8 + (4 * hi + ((lane & 15) >> 2)) * 64;
    bf16x8 qf[4];
    { const bf16_t* Qrow = P + row * PW + PC_AQ + h * 64;
#pragma unroll
      for (int ks = 0; ks < 4; ++ks) qf[ks] = *(const bf16x8*)(Qrow + ks * 16 + hi * 8); }
    Stg s; int ln;
#define NS_LOAD(Kb, kp, Vb, vp_, t) do { s.k = *(const u32x4*)((Kb) + (size_t)((t) * 64 + ln) * (kp) + wid * 8); \
        s.v = *(const u32x4*)((Vb) + (size_t)((t) * 64 + 16 * (wid & 3) + (ln >> 2)) * (vp_) + (wid >> 2) * 32 + (ln & 3) * 8); } while (0)
#define NS_FRESH() do { ln = lane; asm volatile("" : "+v"(ln)); } while (0)
#define NS_WRITE(bi) do { lds_ptr bp_ = lds + (bi) * TB_SIZE; *(LAS u32x4*)(bp_ + wid * 1024 + lane * 16) = s.k; *(LAS u32x4*)(bp_ + TB_V + wid * 1024 + lane * 16) = s.v; } while (0)
    const bf16_t* KC = WSP(const bf16_t, WS_KC) + (size_t)b * 256 * 64; const bf16_t* VC = WSP(const bf16_t, WS_VC) + (size_t)b * 256 * 64;
    const int cmax_u = (q0 + 63 - 31) >> 4, NTc = (cmax_u >> 6) + 1;
    const int cmax = (tq - 31) >> 4;
    float cm = NEG_INF, cl = 0.f;
    NS_FRESH(); NS_LOAD(KC, 64, VC, 64, 0); NS_WRITE(0);
    __syncthreads();
    for (int t = 0; t < NTc; ++t) {
        const int bi = t & 1;
        if (t + 1 < NTc) NS_LOAD(KC, 64, VC, 64, t + 1);
        { lds_cptr bp = (lds_cptr)(lds + bi * TB_SIZE); f32x16 p0, p1;
#pragma unroll
          for (int r = 0; r < 16; ++r) { p0[r] = 0.f; p1[r] = 0.f; }
          qk64<4>(bp, qf, r32, hi, p0, p1);
          float mx = NEG_INF;
#pragma unroll
          for (int r = 0; r < 16; ++r) { const int c = 64 * t + crow(r, hi); if (c > cmax) p0[r] = NEG_INF; if (c + 32 > cmax) p1[r] = NEG_INF; mx = fmaxf(mx, fmaxf(p0[r], p1[r])); }
          mx = fmaxf(mx, other_half(mx, hi));
          const float mn = fmaxf(cm, mx), ms = (mn == NEG_INF) ? 0.f : mn; float rs = 0.f;
#pragma unroll
          for (int r = 0; r < 16; ++r) rs += fast_exp2(p0[r] - ms) + fast_exp2(p1[r] - ms);
          rs += other_half(rs, hi);
          cl = cl * fast_exp2(cm - ms) + rs; cm = mn; }
        if (t + 1 < NTc) NS_WRITE(bi ^ 1);
        __syncthreads();
    }
    const float cms = (cm == NEG_INF) ? 0.f : cm, cinv = 1.0f / fmaxf(cl, 1e-30f);
    f32x16 oc0, oc1;
#pragma unroll
    for (int r = 0; r < 16; ++r) { oc0[r] = 0.f; oc1[r] = 0.f; }
    float G[32]; float carry = 0.f;
#pragma unroll
    for (int i = 0; i < 32; ++i) G[i] = 0.f;
    NS_FRESH(); NS_LOAD(KC, 64, VC, 64, 0); NS_WRITE(0);
    __syncthreads();
#pragma unroll
    for (int t = 0; t < 4; ++t) {
        if (t < NTc) {
            const int bi = t & 1;
            if (t + 1 < NTc) NS_LOAD(KC, 64, VC, 64, t + 1);
            { lds_cptr bp = (lds_cptr)(lds + bi * TB_SIZE); f32x16 p0, p1;
#pragma unroll
              for (int r = 0; r < 16; ++r) { p0[r] = 0.f; p1[r] = 0.f; }
              qk64<4>(bp, qf, r32, hi, p0, p1);
#pragma unroll
              for (int r = 0; r < 16; ++r) { const int c = 64 * t + crow(r, hi);
                  p0[r] = (c > cmax) ? 0.f : fast_exp2(p0[r] - cms) * cinv; p1[r] = (c + 32 > cmax) ? 0.f : fast_exp2(p1[r] - cms) * cinv; }
#pragma unroll
              for (int g = 0; g < 4; ++g) { const float oth = other_half(p0[4 * g + 3], hi);
                  G[t * 8 + g] = ((p0[4 * g] + p0[4 * g + 1]) + (p0[4 * g + 2] + p0[4 * g + 3])) + (hi ? oth : carry); carry = oth; }
#pragma unroll
              for (int g = 0; g < 4; ++g) { const float oth = other_half(p1[4 * g + 3], hi);
                  G[t * 8 + 4 + g] = ((p1[4 * g] + p1[4 * g + 1]) + (p1[4 * g + 2] + p1[4 * g + 3])) + (hi ? oth : carry); carry = oth; }
              bf16x8 pf[4]; pack_p(p0, p1, pf);
              pv64(oc0, oc1, bp + TB_V + vpo, pf); }
            if (t + 1 < NTc) NS_WRITE(bi ^ 1);
            __syncthreads();
        }
    }
    { LAS float* slab = (LAS float*)(lds + NSA_SLAB) + (size_t)(h * 64 + 32 * qs + r32) * 65;
#pragma unroll
      for (int i = 0; i < 32; ++i) slab[2 * i + hi] = G[i]; }
    __syncthreads();
    { const int q = tid >> 3, jg = tid & 7;
      const LAS float* s0 = (const LAS float*)(lds + NSA_SLAB) + (size_t)q * 65;
      float v[64];
#pragma unroll
      for (int k = 0; k < 64; ++k) { const float x = (s0[k] + s0[64 * 65 + k]) + (s0[2 * 64 * 65 + k] + s0[3 * 64 * 65 + k]);
          v[k] = (k == 0 || k == cur || k == cur - 1) ? 1e9f : ((k > cur) ? -1e9f : x); if ((k & 7) == 7) asm volatile("" ::: "memory"); }
      unsigned bits = 0u;
#pragma unroll
      for (int e = 0; e < 8; ++e) { const int j = 8 * jg + e;
          const float xj = (s0[j] + s0[64 * 65 + j]) + (s0[2 * 64 * 65 + j] + s0[3 * 64 * 65 + j]);
          const float vj = (j == 0 || j == cur || j == cur - 1) ? 1e9f : ((j > cur) ? -1e9f : xj);
          int rank = 0;
#pragma unroll
          for (int k = 0; k < 64; ++k) rank += (v[k] > vj || (v[k] == vj && k < j)) ? 1 : 0;
          bits |= (rank < 16 ? 1u : 0u) << e; }
      *((LAS unsigned char*)(lds + NSA_SEL) + q * 8 + jg) = (unsigned char)bits; }
    __syncthreads();
    const unsigned mlo = *(const LAS unsigned*)(lds + NSA_SEL + (32 * qs + r32) * 8), mhi = *(const LAS unsigned*)(lds + NSA_SEL + (32 * qs + r32) * 8 + 4);
    { const u32x4* src = WSP(const u32x4, WS_NSATAB); LAS u32x4* dst = (LAS u32x4*)(lds + NSA_SLAB);
      for (int i = tid; i < 4 * NSA_TL / 4; i += 512) dst[i] = src[i]; }
    const LAS float* tabh = (const LAS float*)(lds + NSA_SLAB) + h * NSA_TL;
    const float farb = WSP(const float, WS_FARB)[h];
    float g0, g1, g2;
    { int tq_ = tq; asm volatile("" : "+v"(tq_)); const float* sd = WSP(const float, WS_SIDE) + (rowbase + tq_) * 16 + h * 3; g0 = sigmoid_f(sd[0]); g1 = sigmoid_f(sd[1]); g2 = sigmoid_f(sd[2]); }
    AState st; astate_init(st);
    { const bf16_t* Kb = P + rowbase * PW + PC_KSLC; const bf16_t* Vb = P + rowbase * PW + PC_VSLC;
      NS_FRESH(); NS_LOAD(Kb, PW, Vb, PW, 0); NS_WRITE(0);
      __syncthreads();
      for (int j = 0; j <= cur; ++j) {
          const int bi = j & 1;
          if (j < cur) NS_LOAD(Kb, PW, Vb, PW, j + 1);
          const bool mine = ((j < 32) ? (mlo >> j) : (mhi >> (j - 32))) & 1u;
          if (__any(mine)) {
              lds_cptr bp = (lds_cptr)(lds + bi * TB_SIZE); f32x16 p0, p1;
#pragma unroll
              for (int r = 0; r < 16; ++r) { p0[r] = 0.f; p1[r] = 0.f; }
              qk64<4>(bp, qf, r32, hi, p0, p1);
              if (q0 - 64 * j - 63 >= NSA_DFAR) {
#pragma unroll
                  for (int r = 0; r < 16; ++r) { p0[r] += farb; p1[r] += farb; }
              } else add_table(p0, p1, tabh + (NSA_DMAX - tq + 64 * j + 4 * hi));
              if (j == cur) mask_causal(p0, p1, 64 * j, tq, hi);
              if (!mine) {
#pragma unroll
                  for (int r = 0; r < 16; ++r) { p0[r] = NEG_INF; p1[r] = NEG_INF; } }
              softmax_pv64(p0, p1, st, bp + TB_V + vpo, hi);
          }
          if (j < cur) NS_WRITE(bi ^ 1);
          __syncthreads();
      } }
    f32x16 oa0, oa1;
    { const float sc = g1 / st.l;
#pragma unroll
      for (int r = 0; r < 16; ++r) { oa0[r] = g0 * oc0[r] + sc * st.o0[r]; oa1[r] = g0 * oc1[r] + sc * st.o1[r]; } }
    astate_init(st);
    { const bf16_t* Kb = P + rowbase * PW + PC_KWIN; const bf16_t* Vb = P + rowbase * PW + PC_VWIN;
      const int jlo = cur >= 8 ? cur - 8 : 0;
      NS_FRESH(); NS_LOAD(Kb, PW, Vb, PW, jlo); NS_WRITE(0);
      __syncthreads();
      for (int j = jlo; j <= cur; ++j) {
          const int bi = (j - jlo) & 1;
          if (j < cur) NS_LOAD(Kb, PW, Vb, PW, j + 1);
          if (tq_lo - 64 * j - 63 < 512) {
              lds_cptr bp = (lds_cptr)(lds + bi * TB_SIZE); f32x16 p0, p1;
#pragma unroll
              for (int r = 0; r < 16; ++r) { p0[r] = 0.f; p1[r] = 0.f; }
              qk64<4>(bp, qf, r32, hi, p0, p1);
              add_table(p0, p1, tabh + (NSA_DMAX - tq + 64 * j + 4 * hi));
              if (!(tq_lo - 64 * j - 63 >= 0 && tq_lo + 31 - 64 * j < 512)) {
                  const int d0 = tq - 64 * j - 4 * hi;
#pragma unroll
                  for (int r = 0; r < 16; ++r) { const int d = d0 - ((r & 3) + 8 * (r >> 2)); if (d < 0 || d >= 512) p0[r] = NEG_INF; if (d - 32 < 0 || d - 32 >= 512) p1[r] = NEG_INF; }
              }
              softmax_pv64(p0, p1, st, bp + TB_V + vpo, hi);
          }
          if (j < cur) NS_WRITE(bi ^ 1);
          __syncthreads();
      } }
    { const float sc = g2 / st.l;
#pragma unroll
      for (int r = 0; r < 16; ++r) { oa0[r] += sc * st.o0[r]; oa1[r] += sc * st.o1[r]; } }
    { int tq_ = tq; asm volatile("" : "+v"(tq_)); store_o_bf16(WSP(bf16_t, WS_OCAT) + (rowbase + tq_) * OCW + h * 64, oa0, oa1, 1.0f, hi); }
#undef NS_LOAD
#undef NS_FRESH
#undef NS_WRITE
}
__device__ __forceinline__ void dil_unit(Frame& F, int b, int hh, int span) {
    int lane_o = F.lane; asm volatile("" : "+v"(lane_o));
    const int wid = F.wave, lane = lane_o, r32 = lane & 31, hi = lane >> 5, tid = wid * 64 + lane;
    const int T0 = span * 512;
    const size_t rowbase = (size_t)b * SEQ;
    const bf16_t* P = WSP(const bf16_t, WS_P) + rowbase * PW;
    lds_ptr lds = (lds_ptr)F.lds;
    LAS float* dtab = (LAS float*)(lds + 32768);
    for (int i = tid; i < 3 * 192; i += 512) dtab[i] = WSP(const float, WS_DILTAB)[((i / 192) * 2 + hh) * 192 + (i % 192)];
    __syncthreads();
    lds_ptr vst = lds + wid * 4096;
    const int vpo = ((lane >> 4) & 1) * 32 + (lane & 3) * 8 + (4 * hi + ((lane & 15) >> 2)) * 64;
    bf16_t* DOG = WSP(bf16_t, WS_DOG); float* DLSE = WSP(float, WS_DLSE);
    for (int g = 0; g < 3; ++g) {
        const int sh = 2 * g, head = 2 * g + hh;
        for (int rep = 0; rep < 2; ++rep) {
            const int wt = wid + 8 * rep;
            const int res = (g == 0) ? 0 : (g == 1 ? (wt & 3) : wt);
            const int i0 = (g == 0) ? 32 * wt : (g == 1 ? 32 * (wt >> 2) : 0);
            const int n0 = (T0 >> sh) + i0;
            const int tokq = res + ((n0 + r32) << sh);
            bf16x8 qf[4];
            { const bf16_t* Qrow = P + (size_t)tokq * PW + PC_BQ + head * 64;
#pragma unroll
              for (int ks = 0; ks < 4; ++ks) qf[ks] = *(const bf16x8*)(Qrow + ks * 16 + hi * 8); }
            f32x16 o0, o1; float m = NEG_INF, l = 0.f;
#pragma unroll
            for (int r = 0; r < 16; ++r) { o0[r] = 0.f; o1[r] = 0.f; }
            for (int c = 0; c < 5; ++c) {
                const int nk0 = n0 - 128 + 32 * c;
                if (nk0 + 31 < 0) continue;
                { int nk = nk0 + r32; nk = nk < 0 ? 0 : nk; const bf16_t* Krow = P + (size_t)(res + (nk << sh)) * PW + PC_BK + head * 64;
                  bf16x8 kf[4];
#pragma unroll
                  for (int ks = 0; ks < 4; ++ks) kf[ks] = *(const bf16x8*)(Krow + ks * 16 + hi * 8);
                  u32x4 vr[4];
#pragma unroll
                  for (int i = 0; i < 4; ++i) { const int pc = lane + 64 * i, vrow = pc >> 3, c16 = pc & 7; int nv = nk0 + vrow; nv = nv < 0 ? 0 : nv;
                      vr[i] = *(const u32x4*)(P + (size_t)(res + (nv << sh)) * PW + PC_BV + head * 64 + c16 * 8); }
#pragma unroll
                  for (int i = 0; i < 4; ++i) { const int pc = lane + 64 * i, vrow = pc >> 3, c16 = pc & 7;
                      *(LAS u32x4*)(vst + (c16 >> 2) * 2048 + vrow * 64 + (c16 & 3) * 16) = vr[i]; }
                  asm volatile("s_waitcnt lgkmcnt(0)" ::: "memory");
                  f32x16 p;
#pragma unroll
                  for (int r = 0; r < 16; ++r) p[r] = 0.f;
#pragma unroll
                  for (int ks = 0; ks < 4; ++ks) p = MFMA32(kf[ks], qf[ks], p);
                  const LAS float* tb = dtab + g * 192 + (32 - r32 + 4 * hi + 32 * c);
                  float mx = NEG_INF;
#pragma unroll
                  for (int r = 0; r < 16; ++r) { const int o = (r & 3) + 8 * (r >> 2), kk = o + 4 * hi, j = 128 + r32 - 32 * c - kk;
                      const bool ok = (j >= 0) && (j <= 128) && (nk0 + kk >= 0);
                      p[r] = ok ? p[r] + tb[o] : NEG_INF; mx = fmaxf(mx, p[r]); }
                  mx = fmaxf(mx, other_half(mx, hi));
                  const float mn = fmaxf(m, mx), ms = (mn == NEG_INF) ? 0.f : mn, alpha = fast_exp2(m - ms);
                  float rs = 0.f;
#pragma unroll
                  for (int r = 0; r < 16; ++r) { p[r] = fast_exp2(p[r] - ms); rs += p[r]; }
                  rs += other_half(rs, hi);
                  l = l * alpha + rs; m = mn;
#pragma unroll
                  for (int r = 0; r < 16; ++r) { o0[r] *= alpha; o1[r] *= alpha; }
                  u32x4 w0, w1;
                  w0.x = cvtpk(p[0], p[1]); w0.y = cvtpk(p[2], p[3]); w0.z = cvtpk(p[4], p[5]); w0.w = cvtpk(p[6], p[7]);
                  w1.x = cvtpk(p[8], p[9]); w1.y = cvtpk(p[10], p[11]); w1.z = cvtpk(p[12], p[13]); w1.w = cvtpk(p[14], p[15]);
                  const bf16x8 pf0 = __builtin_bit_cast(bf16x8, w0), pf1 = __builtin_bit_cast(bf16x8, w1);
                  lds_cptr vp = (lds_cptr)(vst + vpo);
#pragma unroll
                  for (int ks = 0; ks < 2; ++ks) {
                      const s16x4 l0 = vtr(vp + ks * 1024), h0 = vtr(vp + ks * 1024 + 512), l1 = vtr(vp + 2048 + ks * 1024), h1 = vtr(vp + 2048 + ks * 1024 + 512);
                      const bf16x8 v0 = (bf16x8){l0[0], l0[1], l0[2], l0[3], h0[0], h0[1], h0[2], h0[3]}, v1 = (bf16x8){l1[0], l1[1], l1[2], l1[3], h1[0], h1[1], h1[2], h1[3]};
                      o0 = MFMA32(v0, ks == 0 ? pf0 : pf1, o0); o1 = MFMA32(v1, ks == 0 ? pf0 : pf1, o1);
                  }
                  asm volatile("s_waitcnt lgkmcnt(0)" ::: "memory"); }
            }
            const size_t orow = rowbase + tokq;
            store_o_bf16(DOG + ((size_t)g * M + orow) * 128 + hh * 64, o0, o1, 1.0f / l, hi);
            if (hi == 0) DLSE[((size_t)g * M + orow) * 2 + hh] = m + log2f(l);
        }
    }
    VM_WAIT();
    __syncthreads();
    bf16_t* OC = WSP(bf16_t, WS_OCAT);
    for (int it = 0; it < 8; ++it) {
        const int item = tid + 512 * it, tl = item >> 3, pc = item & 7; const size_t orow = rowbase + T0 + tl;
        const float l0 = DLSE[((size_t)0 * M + orow) * 2 + hh], l1 = DLSE[((size_t)1 * M + orow) * 2 + hh], l2 = DLSE[((size_t)2 * M + orow) * 2 + hh];
        const float mx = fmaxf(l0, fmaxf(l1, l2)); float w0 = fast_exp2(l0 - mx), w1 = fast_exp2(l1 - mx), w2 = fast_exp2(l2 - mx);
        const float inv = 1.0f / (w0 + w1 + w2); w0 *= inv; w1 *= inv; w2 *= inv;
        const u32x4 a = *(const u32x4*)(DOG + ((size_t)0 * M + orow) * 128 + hh * 64 + pc * 8), bb = *(const u32x4*)(DOG + ((size_t)1 * M + orow) * 128 + hh * 64 + pc * 8),
                    cc = *(const u32x4*)(DOG + ((size_t)2 * M + orow) * 128 + hh * 64 + pc * 8);
        u32x4 w;
#pragma unroll
        for (int e = 0; e < 4; ++e) {
            const float lo = w0 * __uint_as_float(a[e] << 16) + w1 * __uint_as_float(bb[e] << 16) + w2 * __uint_as_float(cc[e] << 16);
            const float hv = w0 * __uint_as_float(a[e] & 0xffff0000u) + w1 * __uint_as_float(bb[e] & 0xffff0000u) + w2 * __uint_as_float(cc[e] & 0xffff0000u);
            w[e] = cvtpk(lo, hv); }
        *(u32x4*)(OC + orow * OCW + 256 + hh * 64 + pc * 8) = w;
    }
    __syncthreads();
}
__device__ __forceinline__ float wave_sum(float v) {
    v += xor_lane_lt32<1>(v); v += xor_lane_lt32<2>(v); v += xor_lane_lt32<4>(v); v += xor_lane_lt32<8>(v); v += xor_lane_lt32<16>(v);
    return sum_halves(v);
}
__device__ __forceinline__ int rel_bucket(int dist) {
    if (dist < 0) dist = 0;
    if (dist < 16) return dist;
    const int thr[15] = {22, 30, 40, 54, 73, 99, 134, 182, 246, 332, 450, 609, 825, 1117, 1513};
    int bkt = 16;
#pragma unroll
    for (int i = 0; i < 15; ++i) bkt += (dist >= thr[i]) ? 1 : 0;
    return bkt;
}
__device__ __forceinline__ int inproj_src(int c, float& sc) {
    sc = 1.f;
    if (c < 256) { sc = C2A; return c; }
    if (c < 652) return c;
    if (c < 656) return 2572 + (c - 652);
    if (c < 672) return -1;
    if (c < 704) { const int p = c - 672; return 2960 + (p >> 1) + 16 * (p & 1); }
    if (c < 768) return -1;
    if (c < 1920) { const int r = c - 768; if (r < 384) sc = C2A; return 652 + r; }
    if (c < 2048) return 2832 + (c - 1920);
    if (c < 2816) { const int r = c - 2048; if (r < 256) sc = C2A; return 1804 + r; }
    return 2576 + (c - 2816);
}
__device__ __forceinline__ int quq_src(int r, float& sc) {
    sc = C2D;
    if (r >= 384) return -1;
    const int hd = r / 96, w = r % 96;
    if (w < 64) return hd * 96 + w;
    const int p = w - 64; return hd * 96 + 64 + (p >> 1) + 16 * (p & 1);
}
__device__ __forceinline__ void wconv_item(const float* W, int Nsrc, bf16_t* WT, int ldt, const float* kgain, int kind, LAS float* scr, int item, int nblk, int lane) {
    const int kb = item / nblk, nb = item % nblk, k0 = 64 * kb, n0 = 32 * nb;
    const int n = n0 + (lane & 31); float sc = 1.f; int src = n;
    if (kind == 1) src = inproj_src(n, sc); else if (kind == 2) src = quq_src(n, sc);
#pragma unroll 8
    for (int i = 0; i < 32; ++i) { const int kk = 2 * i + (lane >> 5); float v = (src >= 0) ? W[(size_t)(k0 + kk) * Nsrc + src] * sc : 0.f; if (kgain) v *= kgain[k0 + kk]; scr[kk * 33 + (lane & 31)] = v; }
    LDS_WAIT(); asm volatile("" ::: "memory");
    const int c = lane & 7;
#pragma unroll
    for (int j = 0; j < 4; ++j) { const int nn = (lane >> 3) + 8 * j; const LAS float* s = scr + (8 * c) * 33 + nn;
        u32x4 o; o.x = pk2(s[0 * 33], s[1 * 33]); o.y = pk2(s[2 * 33], s[3 * 33]); o.z = pk2(s[4 * 33], s[5 * 33]); o.w = pk2(s[6 * 33], s[7 * 33]);
        *(u32x4*)(WT + (size_t)(n0 + nn) * ldt + k0 + 8 * c) = o; }
    LDS_WAIT(); asm volatile("" ::: "memory");
}
__device__ __forceinline__ void p0_prologue(Frame& F) {
    LAS float* scr = (LAS float*)(F.lds + F.wave * 16384);
    const int gw = blockIdx.x * 8 + F.wave, NGW = F.G * 8, lane = F.lane;
    constexpr int I_IN = 16 * 96, I_G = 16 * 32, I_BA = 4 * 32, I_BB = 2 * 32, I_O = 16 * 32, I_UP = 16 * 176, I_DN = 44 * 32, I_UQ = 4 * 16, I_UKV = 2 * 16, I_PHI = 32 * 4;
    constexpr int I_L = I_IN + 4 * I_G + 3 * I_BA + I_BB + I_O + I_UP + I_DN + I_UQ + I_UKV + 2 * I_PHI;
    for (int it = gw; it < DEPTH * I_L; it += NGW) {
        const int l = it / I_L; int r = it % I_L;
        unsigned char* wl = F.ws + WS_WT + (size_t)l * LW;
        if (r < I_IN) { wconv_item(F.in[6] + (size_t)l * DM * DIN, DIN, (bf16_t*)(wl + LW_IN), DM, nullptr, 1, scr, r, 96, lane); continue; } r -= I_IN;
        if (r < 4 * I_G) { const int i = r / I_G; wconv_item(F.in[21] + ((size_t)l * 4 + i) * DM * DM, DM, (bf16_t*)(wl + LW_G) + (size_t)i * DM * DM, DM, nullptr, 0, scr, r % I_G, 32, lane); continue; } r -= 4 * I_G;
        if (r < I_BA) { wconv_item(F.in[17] + (size_t)l * 256 * DM, DM, (bf16_t*)(wl + LW_BR + BR_A), 256, nullptr, 0, scr, r, 32, lane); continue; } r -= I_BA;
        if (r < I_BB) { wconv_item(F.in[18] + (size_t)l * 128 * DM, DM, (bf16_t*)(wl + LW_BR + BR_B), 128, nullptr, 0, scr, r, 32, lane); continue; } r -= I_BB;
        if (r < I_BA) { wconv_item(F.in[19] + (size_t)l * 256 * DM, DM, (bf16_t*)(wl + LW_BR + BR_C), 256, nullptr, 0, scr, r, 32, lane); continue; } r -= I_BA;
        if (r < I_BA) { wconv_item(F.in[20] + (size_t)l * 256 * DM, DM, (bf16_t*)(wl + LW_BR + BR_D), 256, nullptr, 0, scr, r, 32, lane); continue; } r -= I_BA;
        if (r < I_O) { wconv_item(F.in[22] + (size_t)l * DM * DM, DM, (bf16_t*)(wl + LW_O), DM, nullptr, 0, scr, r, 32, lane); continue; } r -= I_O;
        if (r < I_UP) { wconv_item(F.in[23] + (size_t)l * DM * DFF2, DFF2, (bf16_t*)(wl + LW_UP), DM, nullptr, 0, scr, r, 176, lane); continue; } r -= I_UP;
        if (r < I_DN) { wconv_item(F.in[26] + (size_t)l * DFF * DM, DM, (bf16_t*)(wl + LW_DN), DFF, nullptr, 0, scr, r, 32, lane); continue; } r -= I_DN;
        if (r < I_UQ) { wconv_item(F.in[15] + (size_t)l * 256 * 384, 384, (bf16_t*)(wl + LW_UQ), 256, F.in[13] + l * 256, 2, scr, r, 16, lane); continue; } r -= I_UQ;
        if (r < I_UKV) { wconv_item(F.in[16] + (size_t)l * 128 * 512, 512, (bf16_t*)(wl + LW_UKV), 128, F.in[14] + l * 128, 0, scr, r, 16, lane); continue; } r -= I_UKV;
        if (r < I_PHI) { wconv_item(F.in[8] + (size_t)l * 2048 * 128, 128, (bf16_t*)(wl + LW_PHI), 2048, nullptr, 0, scr, r, 4, lane); continue; } r -= I_PHI;
        wconv_item(F.in[10] + (size_t)l * 2048 * 128, 128, (bf16_t*)(wl + LW_PHI) + (size_t)128 * 2048, 2048, nullptr, 0, scr, r, 4, lane);
    }
    const int gt = blockIdx.x * 512 + F.tid, NGT = F.G * 512;
    const float* rel = F.in[1];
    float* rope = WSP(float, WS_ROPE);
    for (int i = gt; i < SEQ * 16; i += NGT) { const int t = i >> 4, k = i & 15; const float inv = powf(10000.0f, -(float)(2 * k) / 32.0f); const float ang = (float)t * inv;
        float sn, cs; sincosf(ang, &sn, &cs); rope[2 * i] = cs; rope[2 * i + 1] = sn; }
    float* ntab = WSP(float, WS_NSATAB);
    for (int i = gt; i < 4 * NSA_TL; i += NGT) { const int hd = i / NSA_TL, k = i % NSA_TL, dist = NSA_DMAX - k; ntab[i] = dist >= 0 ? rel[rel_bucket(dist) * 10 + hd] * LOG2E : 0.f; }
    float* dtab = WSP(float, WS_DILTAB);
    for (int i = gt; i < 6 * 192; i += NGT) { const int gh = i / 192, k = i % 192, g = gh >> 1, hh = gh & 1, j = 160 - k; dtab[i] = (j >= 0 && j <= 128) ? rel[rel_bucket(j << (2 * g)) * 10 + 4 + 2 * g + hh] * LOG2E : 0.f; }
    if (gt < 4) WSP(float, WS_FARB)[gt] = rel[31 * 10 + gt] * LOG2E;
    for (int i = gt; i < DEPTH * 256; i += NGT) { const int l = i >> 8, n = i & 255; const float* w1 = (n < 128 ? F.in[8] : F.in[10]) + (size_t)l * 2048 * 128 + (n & 127); const float* cp = F.in[7] + (size_t)l * 2048;
        float a = 0.f; for (int p = 0; p < 2048; ++p) a += cp[p] * w1[(size_t)p * 128]; WSP(float, WS_CMPB)[i] = a; }
}

template <int MODE> __device__ __forceinline__ void rowpass(Frame& F, const float* x, const float* y, size_t yrow0, float* xout, bf16_t* hout, const float* g1, const float* g2, int row_lo, int row_hi) {
    const int gw = blockIdx.x * 8 + F.wave, NGW = F.G * 8, lane = F.lane;
    f32x4 ga[4], gb[4];
#pragma unroll
    for (int j = 0; j < 4; ++j) { ga[j] = *(const f32x4*)(g1 + 4 * lane + 256 * j); if (MODE == 1) gb[j] = *(const f32x4*)(g2 + 4 * lane + 256 * j); }
    for (int m = row_lo + gw; m < row_hi; m += NGW) {
        f32x4 v[4];
        const f32x4* xr = (const f32x4*)(x + (size_t)m * DM) + lane;
#pragma unroll
        for (int j = 0; j < 4; ++j) v[j] = xr[64 * j];
        if (MODE != 0) {
            const f32x4* yr = (const f32x4*)(y + ((size_t)m - yrow0) * DM) + lane; f32x4 w[4]; float s = 0.f;
#pragma unroll
            for (int j = 0; j < 4; ++j) { w[j] = yr[64 * j]; s += (w[j][0] * w[j][0] + w[j][1] * w[j][1]) + (w[j][2] * w[j][2] + w[j][3] * w[j][3]); }
            const float rstd = 1.0f / sqrtf(wave_sum(s) * (1.0f / DM) + RMS_EPS);
            f32x4* xo = (f32x4*)(xout + (size_t)m * DM) + lane;
#pragma unroll
            for (int j = 0; j < 4; ++j) { v[j] = v[j] + w[j] * rstd * ga[j]; xo[64 * j] = v[j]; }
        }
        if (MODE != 2) {
            float s = 0.f;
#pragma unroll
            for (int j = 0; j < 4; ++j) s += (v[j][0] * v[j][0] + v[j][1] * v[j][1]) + (v[j][2] * v[j][2] + v[j][3] * v[j][3]);
            const float rstd = 1.0f / sqrtf(wave_sum(s) * (1.0f / DM) + RMS_EPS);
            u32x2* ho = (u32x2*)(hout + (size_t)m * DM) + lane;
#pragma unroll
            for (int j = 0; j < 4; ++j) { const f32x4 gg = (MODE == 1) ? gb[j] : ga[j]; const f32x4 o = v[j] * rstd * gg; u32x2 w; w.x = cvtpk(o[0], o[1]); w.y = cvtpk(o[2], o[3]); ho[64 * j] = w; }
        }
    }
}

__device__ __forceinline__ void conv_pass(Frame& F, const bf16_t* U, bf16_t* ACT, const float* cw  , const float* cb  ) {
    constexpr int NCG = DFF / 8, STRIP = 32, NSTRIP = (M / 2) / STRIP;
    const int gt = blockIdx.x * 512 + F.tid, NGT = F.G * 512;
    for (int item = gt; item < NCG * NSTRIP; item += NGT) {
        const int cg = item % NCG, strip = item / NCG, c0 = cg * 8, r0 = strip * STRIP;
        float wg[3][8], wv[3][8], bg[8], bv[8];
#pragma unroll
        for (int e = 0; e < 8; ++e) { bg[e] = cb[c0 + e]; bv[e] = cb[DFF + c0 + e];
#pragma unroll
            for (int j = 0; j < 3; ++j) { wg[j][e] = cw[j * DFF2 + c0 + e]; wv[j][e] = cw[j * DFF2 + DFF + c0 + e]; } }
        float g2[8], g1[8], v2[8], v1[8];
        const bool first = ((r0 & (SEQ - 1)) == 0);
#pragma unroll
        for (int e = 0; e < 8; ++e) { g2[e] = 0.f; g1[e] = 0.f; v2[e] = 0.f; v1[e] = 0.f; }
        if (!first) {
            const u32x4 a2 = *(const u32x4*)(U + (size_t)(r0 - 2) * DFF2 + c0), a1 = *(const u32x4*)(U + (size_t)(r0 - 1) * DFF2 + c0);
            const u32x4 b2 = *(const u32x4*)(U + (size_t)(r0 - 2) * DFF2 + DFF + c0), b1 = *(const u32x4*)(U + (size_t)(r0 - 1) * DFF2 + DFF + c0);
#pragma unroll
            for (int e = 0; e < 4; ++e) { g2[2 * e] = __uint_as_float(a2[e] << 16); g2[2 * e + 1] = __uint_as_float(a2[e] & 0xffff0000u);
                g1[2 * e] = __uint_as_float(a1[e] << 16); g1[2 * e + 1] = __uint_as_float(a1[e] & 0xffff0000u);
                v2[2 * e] = __uint_as_float(b2[e] << 16); v2[2 * e + 1] = __uint_as_float(b2[e] & 0xffff0000u);
                v1[2 * e] = __uint_as_float(b1[e] << 16); v1[2 * e + 1] = __uint_as_float(b1[e] & 0xffff0000u); }
        }
        for (int r = 0; r < STRIP; ++r) {
            const u32x4 a0 = *(const u32x4*)(U + (size_t)(r0 + r) * DFF2 + c0), b0 = *(const u32x4*)(U + (size_t)(r0 + r) * DFF2 + DFF + c0);
            float g0[8], v0[8]; u32x4 w;
#pragma unroll
            for (int e = 0; e < 4; ++e) { g0[2 * e] = __uint_as_float(a0[e] << 16); g0[2 * e + 1] = __uint_as_float(a0[e] & 0xffff0000u);
                v0[2 * e] = __uint_as_float(b0[e] << 16); v0[2 * e + 1] = __uint_as_float(b0[e] & 0xffff0000u); }
            float o[8];
#pragma unroll
            for (int e = 0; e < 8; ++e) { const float gt_ = bg[e] + wg[0][e] * g2[e] + wg[1][e] * g1[e] + wg[2][e] * g0[e], vl = bv[e] + wv[0][e] * v2[e] + wv[1][e] * v1[e] + wv[2][e] * v0[e];
                o[e] = gt_ * sigmoid_f(gt_) * vl; g2[e] = g1[e]; g1[e] = g0[e]; v2[e] = v1[e]; v1[e] = v0[e]; }
#pragma unroll
            for (int e = 0; e < 4; ++e) w[e] = cvtpk(o[2 * e], o[2 * e + 1]);
            *(u32x4*)(ACT + (size_t)(r0 + r) * DFF + c0) = w;
        }
    }
}
#ifdef SELFCHECK
constexpr int CW_CHK = 20480;
__device__ __forceinline__ unsigned chk_hash(unsigned x) { x ^= x >> 16; x *= 0x7feb352du; x ^= x >> 15; x *= 0x846ca68bu; x ^= x >> 16; return x; }
__device__ __forceinline__ int chk_t(int i) {
    int r = 0;
    switch (i & 31) { case 0: r = 0; break; case 1: r = 1; break; case 2: r = 15; break; case 3: r = 16; break; case 4: r = 30; break; case 5: r = 31; break; case 6: r = 32; break; case 7: r = 47; break;
        case 8: r = 63; break; case 9: r = 64; break; case 10: r = 65; break; case 11: r = 127; break; case 12: r = 128; break; case 13: r = 129; break; case 14: r = 255; break; case 15: r = 256; break;
        case 16: r = 257; break; case 17: r = 511; break; case 18: r = 512; break; case 19: r = 513; break; case 20: r = 575; break; case 21: r = 1023; break; case 22: r = 1024; break; case 23: r = 1599; break;
        case 24: r = 1600; break; case 25: r = 2047; break; case 26: r = 2048; break; case 27: r = 2111; break; case 28: r = 3000; break; case 29: r = 4031; break; case 30: r = 4032; break; default: r = 4095; break; }
    return (i < 64) ? r : (int)(chk_hash(i * 7919u + 13u) & 4095u);
}
__device__ __forceinline__ bool chk_bad(float got, float ref, float scale) { const float d = fabsf(got - ref); return !(d <= 0.02f * fabsf(ref) + 0.02f * scale); }
__device__ __forceinline__ float bfr(float x) { return bf2f((unsigned short)f2bf(x)); }
__device__ __forceinline__ void chk_flag(Frame& F, int bit, bool bad, int allow) {
    LAS unsigned* cnt = (LAS unsigned*)(F.lds + 65536);
    __syncthreads(); if (threadIdx.x == 0) *cnt = 0u; __syncthreads();
    if (bad) atomicAdd((unsigned*)cnt, 1u);
    __syncthreads();
    if (threadIdx.x == 0 && *cnt > (unsigned)allow) atomicOr((unsigned*)(F.ctl + CW_CHK), 1u << bit);
    __syncthreads();
}
__device__ __forceinline__ int chk_bucket_ref(int dist) {
    if (dist < 0) dist = 0; if (dist < 16) return dist;
    const float d = (float)dist; int large = 16 + (int)(logf(d / 16.0f) / 4.852030263919617f * 16.0f); return large < 31 ? large : 31;
}
__device__ __forceinline__ bool chk_fox(Frame& F, int b, int h, int t) {
    const bf16_t* P = WSP(const bf16_t, WS_P);
    { const size_t row = (size_t)b * SEQ + t; const bf16_t* q = P + row * PW + PC_CQ + h * 64; const float* kb = WSP(const float, WS_KB) + ((size_t)b * 4 + h) * SEQ;
      float m = -INFINITY; for (int j = 0; j <= t; ++j) { const bf16_t* k = P + ((size_t)b * SEQ + j) * PW + PC_CK + h * 64; float s = 0.f; for (int d = 0; d < 64; ++d) s += bf2f(q[d]) * bf2f(k[d]); s += kb[j]; m = fmaxf(m, s); }
      float lsum = 0.f, dummy0_ = 0.f; f32x4 o = {0.f, 0.f, 0.f, 0.f};
      for (int j = 0; j <= t; ++j) { const bf16_t* k = P + ((size_t)b * SEQ + j) * PW + PC_CK + h * 64; const bf16_t* v = P + ((size_t)b * SEQ + j) * PW + PC_CV + h * 64; float s = 0.f; for (int d = 0; d < 64; ++d) s += bf2f(q[d]) * bf2f(k[d]); s += kb[j];
          const float p = exp2f(s - m); lsum += p; _Pragma("unroll") for (int e = 0; e < 4; ++e) o[e] += p * bf2f(v[21 * e]); }
      bool bad = false; _Pragma("unroll") for (int e = 0; e < 4; ++e) bad |= chk_bad(bf2f(WSP(const bf16_t, WS_OCAT)[row * OCW + 384 + h * 64 + 21 * e]), o[e] / lsum, 0.5f);
      return bad; }
}
__device__ __forceinline__ bool chk_dil(Frame& F, int b, int hh, int t) {
    const bf16_t* P = WSP(const bf16_t, WS_P); const float* rel = F.in[1];
    { const size_t row = (size_t)b * SEQ + t;
      float m = -INFINITY;
      for (int g = 0; g < 3; ++g) { const int dil = 1 << (2 * g), head = 2 * g + hh; const bf16_t* q = P + row * PW + PC_BQ + head * 64;
          for (int j = 0; j <= 128; ++j) { const int idx = t - dil * j; if (idx < 0) break; const bf16_t* k = P + ((size_t)b * SEQ + idx) * PW + PC_BK + head * 64; float s = 0.f; for (int d = 0; d < 64; ++d) s += bf2f(q[d]) * bf2f(k[d]);
              s += rel[chk_bucket_ref(dil * j) * 10 + 4 + head] * LOG2E; m = fmaxf(m, s); } }
      float lsum = 0.f, dummy0_ = 0.f; f32x4 o = {0.f, 0.f, 0.f, 0.f};
      for (int g = 0; g < 3; ++g) { const int dil = 1 << (2 * g), head = 2 * g + hh; const bf16_t* q = P + row * PW + PC_BQ + head * 64;
          for (int j = 0; j <= 128; ++j) { const int idx = t - dil * j; if (idx < 0) break; const bf16_t* k = P + ((size_t)b * SEQ + idx) * PW + PC_BK + head * 64; const bf16_t* v = P + ((size_t)b * SEQ + idx) * PW + PC_BV + head * 64; float s = 0.f; for (int d = 0; d < 64; ++d) s += bf2f(q[d]) * bf2f(k[d]);
              s += rel[chk_bucket_ref(dil * j) * 10 + 4 + head] * LOG2E; const float p = exp2f(s - m); lsum += p; _Pragma("unroll") for (int e = 0; e < 4; ++e) o[e] += p * bf2f(v[21 * e]); } }
      bool bad = false; _Pragma("unroll") for (int e = 0; e < 4; ++e) bad |= chk_bad(bf2f(WSP(const bf16_t, WS_OCAT)[row * OCW + 256 + hh * 64 + 21 * e]), o[e] / lsum, 0.5f);
      return bad; }
}
__device__ __forceinline__ bool chk_nsa(Frame& F, int b, int h, int t, int i) {
    const bf16_t* P = WSP(const bf16_t, WS_P); const float* rel = F.in[1];
    { bool bad = false;
      { const size_t row = (size_t)b * SEQ + t; const size_t rb = (size_t)b * SEQ;
      const bf16_t* KC = WSP(const bf16_t, WS_KC) + (size_t)b * 256 * 64; const bf16_t* VC = WSP(const bf16_t, WS_VC) + (size_t)b * 256 * 64;
      const int cmax = (t >= 31) ? (t - 31) / 16 : -1, cur = t >> 6;
      LAS float* imp = (LAS float*)(F.lds + 70000) + i * 65; for (int j = 0; j < 64; ++j) imp[j] = 0.f;
      f32x4 oc = {0.f, 0.f, 0.f, 0.f};
      for (int hh = 0; hh < 4; ++hh) { const bf16_t* q = P + row * PW + PC_AQ + hh * 64; float m = -INFINITY;
          for (int c = 0; c <= cmax; ++c) { float s = 0.f; for (int d = 0; d < 64; ++d) s += bf2f(q[d]) * bf2f(KC[c * 64 + d]); m = fmaxf(m, s); }
          float ls = 0.f; for (int c = 0; c <= cmax; ++c) { float s = 0.f; for (int d = 0; d < 64; ++d) s += bf2f(q[d]) * bf2f(KC[c * 64 + d]); ls += exp2f(s - m); }
          for (int c = 0; c <= cmax; ++c) { float s = 0.f; for (int d = 0; d < 64; ++d) s += bf2f(q[d]) * bf2f(KC[c * 64 + d]); const float p = exp2f(s - m) / ls;
              for (int j = 0; j < 64; ++j) if (16 * c <= 64 * j + 63 && 16 * c + 31 >= 64 * j) imp[j] += p;
              if (hh == h) _Pragma("unroll") for (int e = 0; e < 4; ++e) oc[e] += p * bf2f(VC[c * 64 + 21 * e]); } }
      for (int j = 0; j < 64; ++j) imp[j] = (j == 0 || j == cur || j == cur - 1) ? 1e9f : (j > cur ? -1e9f : imp[j]);
      unsigned long long selm = 0ull;
      for (int j = 0; j < 64; ++j) { int rank = 0; for (int k = 0; k < 64; ++k) rank += (imp[k] > imp[j] || (imp[k] == imp[j] && k < j)) ? 1 : 0; if (rank < 16) selm |= 1ull << j; }
      const bf16_t* q = P + row * PW + PC_AQ + h * 64;
      f32x4 os = {0.f, 0.f, 0.f, 0.f}, ow = {0.f, 0.f, 0.f, 0.f};
      { float m = -INFINITY; for (int pos = 0; pos <= t; ++pos) { if (!((selm >> (pos >> 6)) & 1ull)) continue; const bf16_t* k = P + (rb + pos) * PW + PC_KSLC; float s = 0.f; for (int d = 0; d < 64; ++d) s += bf2f(q[d]) * bf2f(k[d]); s += rel[chk_bucket_ref(t - pos) * 10 + h] * LOG2E; m = fmaxf(m, s); }
        float ls = 0.f; for (int pos = 0; pos <= t; ++pos) { if (!((selm >> (pos >> 6)) & 1ull)) continue; const bf16_t* k = P + (rb + pos) * PW + PC_KSLC; const bf16_t* v = P + (rb + pos) * PW + PC_VSLC; float s = 0.f; for (int d = 0; d < 64; ++d) s += bf2f(q[d]) * bf2f(k[d]); s += rel[chk_bucket_ref(t - pos) * 10 + h] * LOG2E;
            const float p = exp2f(s - m); ls += p; _Pragma("unroll") for (int e = 0; e < 4; ++e) os[e] += p * bf2f(v[21 * e]); }
        _Pragma("unroll") for (int e = 0; e < 4; ++e) os[e] /= ls; }
      { const int lo = t - 511 > 0 ? t - 511 : 0; float m = -INFINITY; for (int pos = lo; pos <= t; ++pos) { const bf16_t* k = P + (rb + pos) * PW + PC_KWIN; float s = 0.f; for (int d = 0; d < 64; ++d) s += bf2f(q[d]) * bf2f(k[d]); s += rel[chk_bucket_ref(t - pos) * 10 + h] * LOG2E; m = fmaxf(m, s); }
        float ls = 0.f; for (int pos = lo; pos <= t; ++pos) { const bf16_t* k = P + (rb + pos) * PW + PC_KWIN; const bf16_t* v = P + (rb + pos) * PW + PC_VWIN; float s = 0.f; for (int d = 0; d < 64; ++d) s += bf2f(q[d]) * bf2f(k[d]); s += rel[chk_bucket_ref(t - pos) * 10 + h] * LOG2E;
            const float p = exp2f(s - m); ls += p; _Pragma("unroll") for (int e = 0; e < 4; ++e) ow[e] += p * bf2f(v[21 * e]); }
        _Pragma("unroll") for (int e = 0; e < 4; ++e) ow[e] /= ls; }
      const float* sd = WSP(const float, WS_SIDE) + row * 16 + h * 3; const float g0 = 1.f / (1.f + expf(-sd[0])), g1 = 1.f / (1.f + expf(-sd[1])), g2 = 1.f / (1.f + expf(-sd[2]));
      _Pragma("unroll") for (int e = 0; e < 4; ++e) bad |= chk_bad(bf2f(WSP(const bf16_t, WS_OCAT)[row * OCW + h * 64 + 21 * e]), g0 * oc[e] + g1 * os[e] + g2 * ow[e], 0.3f); }
      return bad; }
}
__device__ __forceinline__ void selfcheck_a(Frame& F, int l) {
    const int i = threadIdx.x;
    const float* x = F.in[0];
    const bf16_t* H = WSP(const bf16_t, WS_H); const bf16_t* P = WSP(const bf16_t, WS_P);
    const float* rel = F.in[1];
    { const int row = (int)(chk_hash(i) % M), col = (int)(chk_hash(i + 999) & 1023); float s = 0.f; for (int k = 0; k < DM; ++k) { const float v = x[(size_t)row * DM + k]; s += v * v; }
      const float ref = x[(size_t)row * DM + col] * (1.0f / sqrtf(s / DM + RMS_EPS)) * F.in[2][l * DM + col];
      chk_flag(F, 0, chk_bad(bf2f(H[(size_t)row * DM + col]), ref, 1.0f), 0); }
    { const int row = (int)(chk_hash(i + 5) % M); int c = (i * 37 + 5) % PW; if (i < 32) c = 640 + (i & 15); else if (i < 96) c = 672 + (i & 31); else if (i < 160) c = 256 + ((i * 3) & 127);
      const float* W = F.in[6] + (size_t)l * DM * DIN; bool bad = false;
#define DOTC(dst, cc) do { float sc_; const int src_ = inproj_src((cc), sc_); float a_ = 0.f; if (src_ >= 0) for (int k = 0; k < DM; ++k) a_ += bf2f(H[(size_t)row * DM + k]) * bfr(W[(size_t)k * DIN + src_] * sc_); dst = a_; } while (0)
      float ref; DOTC(ref, c);
      if (c >= 672 && c < 704) { const int p = c - 672, ip = p >> 1; float oth; DOTC(oth, c ^ 1); const float x1 = (p & 1) ? oth : ref, x2 = (p & 1) ? ref : oth;
          const float inv = powf(10000.0f, -(float)(2 * ip) / 32.0f), ang = (float)(row & (SEQ - 1)) * inv, cs = cosf(ang), sn = sinf(ang);
          ref = (p & 1) ? (x2 * cs + x1 * sn) : (x1 * cs - x2 * sn);
          bad |= chk_bad(bf2f(WSP(const bf16_t, WS_KROT)[(size_t)row * 32 + p]), ref, 1.0f); }
      bad |= chk_bad(bf2f(P[(size_t)row * PW + c]), ref, 1.0f);
      if (c >= 640 && c < 656) bad |= chk_bad(WSP(const float, WS_SIDE)[(size_t)row * 16 + (c - 640)], ref, 1.0f);
      if (c >= 256 && c < 320) bad |= chk_bad(bf2f(WSP(const bf16_t, WS_KCMP)[(size_t)row * 64 + (c - 256)]), ref, 1.0f);
      if (c >= 320 && c < 384) bad |= chk_bad(bf2f(WSP(const bf16_t, WS_VCMP)[(size_t)row * 64 + (c - 320)]), ref, 1.0f);
      if (i >= 160 && i < 192) { float sq = 0.f, skv = 0.f; for (int k = 0; k < 256; ++k) { const float v = bf2f(P[(size_t)row * PW + PC_DQL + k]); sq += v * v; } for (int k = 0; k < 128; ++k) { const float v = bf2f(P[(size_t)row * PW + PC_DKV + k]); skv += v * v; }
          const float* a = WSP(const float, WS_SSQQ) + (size_t)row * 4; const float* b = WSP(const float, WS_SSQKV) + (size_t)row * 4;
          bad |= chk_bad(a[0] + a[1] + a[2] + a[3], sq, 10.f) || chk_bad(b[0] + b[1] + b[2] + b[3], skv, 5.f); }
      chk_flag(F, 1, bad, 0); }
    { const int b = i & 15, h = (i >> 4) & 3, t = chk_t(i >> 6); float a = 0.f; for (int j = 0; j <= t; ++j) { const float xx = WSP(const float, WS_SIDE)[((size_t)b * SEQ + j) * 16 + 12 + h] + F.in[12][l * 4 + h]; a += (xx >= 0.f) ? -log1pf(expf(-xx)) : (xx - log1pf(expf(xx))); }
      chk_flag(F, 2, chk_bad(WSP(const float, WS_KB)[((size_t)b * 4 + h) * SEQ + t], -a * LOG2E, 1.0f + fabsf(a) * 0.05f), 0); }
    chk_flag(F, 3, chk_fox(F, (i * 5) & 15, i & 3, chk_t(i >> 2)), 0);
    { const int row = (int)(chk_hash(i + 77) % M); bool bad = false;
      float sq = 0.f, skv = 0.f; for (int k = 0; k < 256; ++k) { const float v = bf2f(P[(size_t)row * PW + PC_DQL + k]); sq += v * v; } for (int k = 0; k < 128; ++k) { const float v = bf2f(P[(size_t)row * PW + PC_DKV + k]); skv += v * v; }
      const float rq = 1.0f / sqrtf(sq / 256.0f + RMS_EPS), rkv = 1.0f / sqrtf(skv / 128.0f + RMS_EPS);
      const float* wq = F.in[15] + (size_t)l * 256 * 384; const float* gq = F.in[13] + l * 256; const float* wkv = F.in[16] + (size_t)l * 128 * 512; const float* gkv = F.in[14] + l * 128;
#define QDOT(dst, src) do { float a_ = 0.f; for (int k = 0; k < 256; ++k) a_ += bf2f(P[(size_t)row * PW + PC_DQL + k]) * bfr(wq[(size_t)k * 384 + (src)] * C2D * gq[k]); dst = a_ * rq; } while (0)
      const int r = (i * 11) % 384, hd = r / 96, w = r % 96; float ref;
      if (w < 64) QDOT(ref, hd * 96 + w);
      else { const int p = w - 64, ip = p >> 1; float x1, x2; QDOT(x1, hd * 96 + 64 + ip); QDOT(x2, hd * 96 + 64 + 16 + ip); const float inv = powf(10000.0f, -(float)(2 * ip) / 32.0f), ang = (float)(row & (SEQ - 1)) * inv, cs = cosf(ang), sn = sinf(ang);
          ref = (p & 1) ? (x2 * cs + x1 * sn) : (x1 * cs - x2 * sn); }
      bad |= chk_bad(bf2f(WSP(const bf16_t, WS_QM)[(size_t)row * 512 + r]), ref, 1.5f);
      { const int c = (i * 13) & 511; float a = 0.f; for (int k = 0; k < 128; ++k) a += bf2f(P[(size_t)row * PW + PC_DKV + k]) * bfr(wkv[(size_t)k * 512 + c] * gkv[k]); bad |= chk_bad(bf2f(WSP(const bf16_t, WS_KVM)[(size_t)row * 512 + c]), a * rkv, 1.0f); }
      chk_flag(F, 4, bad, 0); }
    { const int b = (i * 3) & 15, h = i & 3, t = chk_t(i >> 2); const size_t row = (size_t)b * SEQ + t; const bf16_t* q = WSP(const bf16_t, WS_QM) + row * 512 + h * 96; const bf16_t* KV = WSP(const bf16_t, WS_KVM); const bf16_t* KR = WSP(const bf16_t, WS_KROT);
      float m = -INFINITY; for (int j = 0; j <= t; ++j) { const size_t rj = (size_t)b * SEQ + j; float s = 0.f; for (int d = 0; d < 64; ++d) s += bf2f(q[d]) * bf2f(KV[rj * 512 + h * 128 + d]); for (int d = 0; d < 32; ++d) s += bf2f(q[64 + d]) * bf2f(KR[rj * 32 + d]); m = fmaxf(m, s); }
      float lsum = 0.f, dummy0_ = 0.f; f32x4 o = {0.f, 0.f, 0.f, 0.f};
      for (int j = 0; j <= t; ++j) { const size_t rj = (size_t)b * SEQ + j; float s = 0.f; for (int d = 0; d < 64; ++d) s += bf2f(q[d]) * bf2f(KV[rj * 512 + h * 128 + d]); for (int d = 0; d < 32; ++d) s += bf2f(q[64 + d]) * bf2f(KR[rj * 32 + d]);
          const float p = exp2f(s - m); lsum += p; _Pragma("unroll") for (int e = 0; e < 4; ++e) o[e] += p * bf2f(KV[rj * 512 + h * 128 + 64 + 21 * e]); }
      bool bad = false; _Pragma("unroll") for (int e = 0; e < 4; ++e) bad |= chk_bad(bf2f(WSP(const bf16_t, WS_OCAT)[row * OCW + 640 + h * 64 + 21 * e]), o[e] / lsum, 0.5f);
      chk_flag(F, 5, bad, 0); }
    chk_flag(F, 6, chk_dil(F, (i * 7) & 15, i & 1, chk_t(i >> 1)), 0);
    { const int b = i & 15, which = (i >> 4) & 1, c = (int)(chk_hash(i + 31) % 255), d = (i * 5) & 63; const bf16_t* src = (which ? WSP(const bf16_t, WS_VCMP) : WSP(const bf16_t, WS_KCMP)) + ((size_t)b * SEQ + 16 * c) * 64;
      const float *pk1 = F.in[8], *pv1 = F.in[10], *pk2 = F.in[9], *pv2 = F.in[11]; asm volatile("" : "+s"(pk1), "+s"(pv1), "+s"(pk2), "+s"(pv2));
      const float* w1 = (which ? pv1 : pk1) + (size_t)l * 2048 * 128; const float* w2 = (which ? pv2 : pk2) + (size_t)l * 128 * 64; const float* cp = F.in[7] + (size_t)l * 2048;
      float out = 0.f;
      for (int n = 0; n < 128; ++n) { float a = 0.f, bsum = 0.f; for (int p = 0; p < 2048; ++p) { a += bf2f(src[p]) * bfr(w1[(size_t)p * 128 + n]); bsum += cp[p] * w1[(size_t)p * 128 + n]; }
          const float xx = a + bsum, g = 0.5f * xx * (1.0f + tanhf(0.7978845608028654f * (xx + 0.044715f * xx * xx * xx))); out += bfr(g) * w2[n * 64 + d]; }
      chk_flag(F, 7, chk_bad(bf2f((which ? WSP(const bf16_t, WS_VC) : WSP(const bf16_t, WS_KC))[((size_t)b * 256 + c) * 64 + d]), out, 0.5f), 0); }
    { bool bad = false; if (i < 128) bad = chk_nsa(F, (i * 9) & 15, i & 3, chk_t(i >> 2), i); chk_flag(F, 8, bad, 4); }
}
__device__ __forceinline__ void selfcheck_b(Frame& F, int l) {
    const int i = threadIdx.x; const int row = (int)(chk_hash(i + 3) % M), n = (i * 29 + 7) & 1023;
    const bf16_t* H = WSP(const bf16_t, WS_H); const bf16_t* OC = WSP(const bf16_t, WS_OCAT);
    float acc = 0.f;
    for (int br = 0; br < 4; ++br) { const float* wg = F.in[21] + ((size_t)l * 4 + br) * DM * DM; float g = 0.f; for (int k = 0; k < DM; ++k) g += bf2f(H[(size_t)row * DM + k]) * bfr(wg[(size_t)k * DM + n]);
        const int kk = (br == 1) ? 128 : 256, co = (br == 0) ? 0 : (br == 1 ? 256 : (br == 2 ? 384 : 640)); const float *pb0 = F.in[17], *pb1 = F.in[18], *pb2 = F.in[19], *pb3 = F.in[20]; asm volatile("" : "+s"(pb0), "+s"(pb1), "+s"(pb2), "+s"(pb3)); const float* wb = (br == 0 ? pb0 : (br == 1 ? pb1 : (br == 2 ? pb2 : pb3))) + (size_t)l * kk * DM; float t = 0.f; for (int k = 0; k < kk; ++k) t += bf2f(OC[(size_t)row * OCW + co + k]) * bfr(wb[(size_t)k * DM + n]);
        acc += (1.f / (1.f + expf(-g))) * bfr(t); }
    chk_flag(F, 9, chk_bad(bf2f(WSP(const bf16_t, WS_MERGED)[(size_t)row * DM + n]), acc, 0.5f), 0);
}
__device__ __forceinline__ void selfcheck_c(Frame& F, int l, const float* xin) {
    const int i = threadIdx.x; const int row = (int)(chk_hash(i + 11) % M), n = (i * 29 + 7) & 1023;
    const bf16_t* MG = WSP(const bf16_t, WS_MERGED); const float* wo = F.in[22] + (size_t)l * DM * DM; const float* Y = WSP(const float, WS_Y);
    float a = 0.f; for (int k = 0; k < DM; ++k) a += bf2f(MG[(size_t)row * DM + k]) * bfr(wo[(size_t)k * DM + n]);
    chk_flag(F, 0, chk_bad(Y[(size_t)row * DM + n], a, 1.0f), 0);
    float s = 0.f; for (int k = 0; k < DM; ++k) { const float v = Y[(size_t)row * DM + k]; s += v * v; }
    const float rstd = 1.0f / sqrtf(s / DM + RMS_EPS); float s2 = 0.f;
    for (int k = 0; k < DM; ++k) { const float v = xin[(size_t)row * DM + k] + Y[(size_t)row * DM + k] * rstd * F.in[3][l * DM + k]; s2 += v * v; }
    const float x1 = xin[(size_t)row * DM + n] + Y[(size_t)row * DM + n] * rstd * F.in[3][l * DM + n];
    const float h2 = x1 * (1.0f / sqrtf(s2 / DM + RMS_EPS)) * F.in[4][l * DM + n];
    chk_flag(F, 1, chk_bad(F.out[(size_t)row * DM + n], x1, 1.0f) || chk_bad(bf2f(WSP(const bf16_t, WS_H2)[(size_t)row * DM + n]), h2, 1.0f), 0);
}
__device__ __forceinline__ void selfcheck_d(Frame& F, int l) {
    const int i = threadIdx.x; const int row = (int)(chk_hash(i + 17) % (M / 2)); const bf16_t* H2 = WSP(const bf16_t, WS_H2); const bf16_t* U = WSP(const bf16_t, WS_U); const bf16_t* A = WSP(const bf16_t, WS_ACT);
    { const int c = (i * 41 + 3) % DFF2; const float* wu = F.in[23] + (size_t)l * DM * DFF2; float a = 0.f; for (int k = 0; k < DM; ++k) a += bf2f(H2[(size_t)row * DM + k]) * bfr(wu[(size_t)k * DFF2 + c]);
      chk_flag(F, 2, chk_bad(bf2f(U[(size_t)row * DFF2 + c]), a, 1.0f), 0); }
    { const int c = (i * 23 + 1) % DFF; const int t = row & (SEQ - 1); const float* cw = F.in[24] + (size_t)l * 3 * DFF2; const float* cb = F.in[25] + (size_t)l * DFF2; float g = cb[c], v = cb[DFF + c];
      for (int j = 0; j < 3; ++j) { const int tt = t - 2 + j; if (tt < 0) continue; g += cw[j * DFF2 + c] * bf2f(U[(size_t)(row - 2 + j) * DFF2 + c]); v += cw[j * DFF2 + DFF + c] * bf2f(U[(size_t)(row - 2 + j) * DFF2 + DFF + c]); }
      chk_flag(F, 3, chk_bad(bf2f(A[(size_t)row * DFF + c]), g / (1.f + expf(-g)) * v, 0.3f), 0); }
    { const int n = (i * 29 + 7) & 1023; const float* wd = F.in[26] + (size_t)l * DFF * DM; float a = 0.f; for (int k = 0; k < DFF; ++k) a += bf2f(A[(size_t)row * DFF + k]) * bfr(wd[(size_t)k * DM + n]);
      chk_flag(F, 4, chk_bad(WSP(const float, WS_Y2)[(size_t)row * DM + n], a, 1.0f), 0); }
}

__device__ __forceinline__ void selfcheck_e(Frame& F, int l) {
    const int i = threadIdx.x; const bf16_t* H = WSP(const bf16_t, WS_H); const bf16_t* P = WSP(const bf16_t, WS_P);
    const float* W = F.in[6] + (size_t)l * DM * DIN; const int row = (int)(chk_hash(i + 5) % M);
#define DOTC(dst, cc) do { float sc_; const int src_ = inproj_src((cc), sc_); float a_ = 0.f; if (src_ >= 0) for (int k = 0; k < DM; ++k) a_ += bf2f(H[(size_t)row * DM + k]) * bfr(W[(size_t)k * DIN + src_] * sc_); dst = a_; } while (0)
    { int c = (i * 37 + 5) % PW; if ((c >= 640 && c < 768)) c = 100; float ref; DOTC(ref, c); chk_flag(F, 0, chk_bad(bf2f(P[(size_t)row * PW + c]), ref, 1.0f), 0); }
    { const int c = 672 + (i & 31), p = c - 672, ip = p >> 1; float ref, oth; DOTC(ref, c); DOTC(oth, c ^ 1); const float x1 = (p & 1) ? oth : ref, x2 = (p & 1) ? ref : oth;
      const float inv = powf(10000.0f, -(float)(2 * ip) / 32.0f), ang = (float)(row & (SEQ - 1)) * inv, cs = cosf(ang), sn = sinf(ang); const float r = (p & 1) ? (x2 * cs + x1 * sn) : (x1 * cs - x2 * sn);
      chk_flag(F, 1, chk_bad(bf2f(WSP(const bf16_t, WS_KROT)[(size_t)row * 32 + p]), r, 1.0f), 0); }
    { const int c = 640 + (i & 15); float ref; DOTC(ref, c); chk_flag(F, 2, chk_bad(WSP(const float, WS_SIDE)[(size_t)row * 16 + (c - 640)], ref, 1.0f), 0); }
    { const int c = 256 + (i & 127); float ref; DOTC(ref, c); const float got = (c < 320) ? bf2f(WSP(const bf16_t, WS_KCMP)[(size_t)row * 64 + (c - 256)]) : bf2f(WSP(const bf16_t, WS_VCMP)[(size_t)row * 64 + (c - 320)]); chk_flag(F, 3, chk_bad(got, ref, 1.0f), 0); }
    float sq = 0.f, skv = 0.f; for (int k = 0; k < 256; ++k) { const float v = bf2f(P[(size_t)row * PW + PC_DQL + k]); sq += v * v; } for (int k = 0; k < 128; ++k) { const float v = bf2f(P[(size_t)row * PW + PC_DKV + k]); skv += v * v; }
    { const float* a = WSP(const float, WS_SSQQ) + (size_t)row * 4; const float* b = WSP(const float, WS_SSQKV) + (size_t)row * 4; chk_flag(F, 4, chk_bad(a[0] + a[1] + a[2] + a[3], sq, 10.f) || chk_bad(b[0] + b[1] + b[2] + b[3], skv, 5.f), 0); }
    const float rq = 1.0f / sqrtf(sq / 256.0f + RMS_EPS), rkv = 1.0f / sqrtf(skv / 128.0f + RMS_EPS);
    const float* wq = F.in[15] + (size_t)l * 256 * 384; const float* gq = F.in[13] + l * 256; const float* wkv = F.in[16] + (size_t)l * 128 * 512; const float* gkv = F.in[14] + l * 128;
#define QDOT(dst, src) do { float a_ = 0.f; for (int k = 0; k < 256; ++k) a_ += bf2f(P[(size_t)row * PW + PC_DQL + k]) * bfr(wq[(size_t)k * 384 + (src)] * C2D * gq[k]); dst = a_ * rq; } while (0)
    { const int hd = i & 3, w = (i >> 2) & 63; float ref; QDOT(ref, hd * 96 + w); chk_flag(F, 5, chk_bad(bf2f(WSP(const bf16_t, WS_QM)[(size_t)row * 512 + hd * 96 + w]), ref, 1.5f), 0); }
    { const int hd = i & 3, p = (i >> 2) & 31, ip = p >> 1; float x1, x2; QDOT(x1, hd * 96 + 64 + ip); QDOT(x2, hd * 96 + 64 + 16 + ip); const float inv = powf(10000.0f, -(float)(2 * ip) / 32.0f), ang = (float)(row & (SEQ - 1)) * inv, cs = cosf(ang), sn = sinf(ang);
      const float r = (p & 1) ? (x2 * cs + x1 * sn) : (x1 * cs - x2 * sn); chk_flag(F, 6, chk_bad(bf2f(WSP(const bf16_t, WS_QM)[(size_t)row * 512 + hd * 96 + 64 + p]), r, 1.5f), 0); }
    { const int c = (i * 13) & 511; float a = 0.f; for (int k = 0; k < 128; ++k) a += bf2f(P[(size_t)row * PW + PC_DKV + k]) * bfr(wkv[(size_t)k * 512 + c] * gkv[k]); chk_flag(F, 7, chk_bad(bf2f(WSP(const bf16_t, WS_KVM)[(size_t)row * 512 + c]), a * rkv, 1.0f), 0); }
    { const int b = i & 15, which = (i >> 4) & 1, c = (int)(chk_hash(i + 31) % 255), n = (i * 5) & 127; const bf16_t* src = (which ? WSP(const bf16_t, WS_VCMP) : WSP(const bf16_t, WS_KCMP)) + ((size_t)b * SEQ + 16 * c) * 64;
      const float *pk1 = F.in[8], *pv1 = F.in[10], *pk2 = F.in[9], *pv2 = F.in[11]; asm volatile("" : "+s"(pk1), "+s"(pv1), "+s"(pk2), "+s"(pv2));
      const float* w1 = (which ? pv1 : pk1) + (size_t)l * 2048 * 128; const float* w2 = (which ? pv2 : pk2) + (size_t)l * 128 * 64; const float* cp = F.in[7] + (size_t)l * 2048;
      float a = 0.f, bsum = 0.f; for (int p = 0; p < 2048; ++p) { a += bf2f(src[p]) * bfr(w1[(size_t)p * 128 + n]); bsum += cp[p] * w1[(size_t)p * 128 + n]; }
      const float xx = a + bsum, g = 0.5f * xx * (1.0f + tanhf(0.7978845608028654f * (xx + 0.044715f * xx * xx * xx)));
      const bf16_t* hid = WSP(const bf16_t, WS_HID) + (size_t)(which * 4096 + b * 256 + c) * 256 + which * 128;
      chk_flag(F, 8, chk_bad(bf2f(hid[n]), g, 0.5f), 0);
      const int d = (i * 5) & 63; float o2 = 0.f; for (int nn = 0; nn < 128; ++nn) o2 += bf2f(hid[nn]) * w2[nn * 64 + d];
      chk_flag(F, 9, chk_bad(bf2f((which ? WSP(const bf16_t, WS_VC) : WSP(const bf16_t, WS_KC))[((size_t)b * 256 + c) * 64 + d]), o2, 0.5f), 0); }
#undef DOTC
#undef QDOT
}

constexpr int CW_CNT = 20544;
__device__ __forceinline__ void selfcheck_g(Frame& F, int l) {
    const int gi = blockIdx.x * 512 + threadIdx.x; const bf16_t* H = WSP(const bf16_t, WS_H); const bf16_t* P = WSP(const bf16_t, WS_P); const float* W = F.in[6] + (size_t)l * DM * DIN;
    const int row = gi & (M - 1); unsigned nbad = 0u;
    for (int k4 = 0; k4 < 4; ++k4) { int c = (int)(chk_hash(gi * 4 + k4 + 12345u) % PW); if (c >= 640 && c < 768) c -= 200;
        float sc_; const int src_ = inproj_src(c, sc_); float a_ = 0.f; for (int k = 0; k < DM; ++k) a_ += bf2f(H[(size_t)row * DM + k]) * bfr(W[(size_t)k * DIN + src_] * sc_);
        if (chk_bad(bf2f(P[(size_t)row * PW + c]), a_, 1.0f)) ++nbad; }
    if (nbad) atomicAdd((unsigned*)(F.ctl + CW_CNT), nbad);
}
__device__ __forceinline__ void selfcheck_g_fin(Frame& F) {
    if (blockIdx.x == 0 && threadIdx.x == 0) { const unsigned cnt = __hip_atomic_load(F.ctl + CW_CNT, __ATOMIC_RELAXED, __HIP_MEMORY_SCOPE_AGENT); unsigned lg = 0; while ((1u << lg) <= cnt && lg < 15) ++lg;
        atomicOr((unsigned*)(F.ctl + CW_CHK), (cnt > 63u ? 63u : cnt) | (lg << 6)); }
}

__device__ __forceinline__ void selfcheck_f(Frame& F, int l) {
    const int i = threadIdx.x; const unsigned hsh = chk_hash(i + 4242u);
    chk_flag(F, 0, chk_fox(F, i & 15, (i >> 4) & 3, (i >> 6) * 8 + (hsh & 7)), 0);
    chk_flag(F, 1, chk_fox(F, i & 15, (i >> 4) & 3, 64 + (int)(hsh % 192u)), 0);
    chk_flag(F, 2, chk_fox(F, i & 15, (i >> 4) & 3, 256 + (int)(hsh % 3840u)), 0);
    chk_flag(F, 3, chk_dil(F, i & 15, (i >> 4) & 1, (int)(hsh & 127u)), 0);
    chk_flag(F, 4, chk_dil(F, i & 15, (i >> 4) & 1, 128 + (int)(hsh % 3968u)), 0);
    { bool bad = false; if (i < 128) bad = chk_nsa(F, i & 15, (i >> 4) & 3, (int)(hsh % 31u), i); chk_flag(F, 5, bad, 0); }
    { bool bad = false; if (i < 128) bad = chk_nsa(F, i & 15, (i >> 4) & 3, 31 + (int)(hsh % 33u), i); chk_flag(F, 6, bad, 0); }
    { bool bad = false; if (i < 128) bad = chk_nsa(F, i & 15, (i >> 4) & 3, 64 + (int)(hsh % 960u), i); chk_flag(F, 7, bad, 0); }
    { bool bad = false; if (i < 128) bad = chk_nsa(F, i & 15, (i >> 4) & 3, 1024 + (int)(hsh % 3072u), i); chk_flag(F, 8, bad, 4); }
}
__device__ __forceinline__ void selfcheck_report(Frame& F) {
    const unsigned mask = __hip_atomic_load(F.ctl + CW_CHK, __ATOMIC_RELAXED, __HIP_MEMORY_SCOPE_AGENT);
    float V = (float)(10u + (mask & 63u)); const unsigned e = 2u + ((mask >> 6) & 15u); for (unsigned k = 0; k < e; ++k) V *= 10.0f;
    for (size_t idx = (size_t)blockIdx.x * 512 + threadIdx.x; idx < (size_t)M * DM; idx += (size_t)F.G * 512) F.out[idx] = V;
}
#endif
struct SchedSimple {
    pg8::TileOrder T; const char* A; const char* B; int lda, ldb, nt;
    __device__ bool next(int i, GUnit& u) const { int pm, pn; if (!T.tile(i, pm, pn)) return false;
        u.A = A + (size_t)pm * 256 * lda; u.B = B + (size_t)pn * 256 * ldb; u.lda = lda; u.ldb = ldb; u.nt = nt; u.pm = pm; u.pn = pn; u.id = 0; return true; }
};
struct SchedCmp1 {
    int c; const char* kc; const char* vc; const char* B;
    __device__ bool next(int i, GUnit& u) const { if (i > 0 || c >= 32) return false;
        u.A = (c < 16 ? kc : vc) + (size_t)(c & 15) * 256 * 2048; u.B = B; u.lda = 2048; u.ldb = 4096; u.nt = 32; u.pm = c; u.pn = 0; u.id = 0; return true; }
};
struct SchedMerge {
    pg8::TileOrder T; const char* ocat; const char* h; const char* wbr; const char* wg;
    __device__ bool next(int i, GUnit& u) const { int pm, pn; if (!T.tile(i >> 3, pm, pn)) return false;
        const int sub = i & 7, br = sub >> 1; u.pm = pm; u.pn = pn; u.id = sub;
        if (sub & 1) { u.A = h + (size_t)pm * 256 * 2048; u.lda = 2048; u.B = wg + (size_t)br * DM * DM * 2 + (size_t)pn * 256 * 2048; u.ldb = 2048; u.nt = 16; }
        else { const int kk = (br == 1) ? 128 : 256; const size_t co = (br == 0) ? 0 : (br == 1 ? 256 : (br == 2 ? 384 : 640)), wo = (br == 0) ? BR_A : (br == 1 ? BR_B : (br == 2 ? BR_C : BR_D));
            u.A = ocat + (size_t)pm * 256 * (OCW * 2) + co * 2; u.lda = OCW * 2; u.B = wbr + wo + (size_t)pn * 256 * kk * 2; u.ldb = kk * 2; u.nt = kk / 64; }
        return true; }
};

#ifdef ONLY_PHASE
#define PH(k) ((k) == ONLY_PHASE)
#else
#define PH(k) true
#endif
struct Args { const float* in[27]; float* out; unsigned char* ws; };
__global__ void __launch_bounds__(512, 2) hybrid_fwd(Args args) {
    extern __shared__ __attribute__((aligned(16))) unsigned char lds_raw[];
    Frame F;
    F.lds = (LAS unsigned char*)lds_raw; F.MISC = (volatile LAS unsigned*)(F.lds + MISC_OFF);
    F.tid = threadIdx.x; F.lane = F.tid & 63; F.wave = __builtin_amdgcn_readfirstlane(F.tid >> 6); F.G = gridDim.x;
#pragma unroll
    for (int i = 0; i < 27; ++i) F.in[i] = args.in[i];
    F.out = args.out; F.ws = args.ws; F.ctl = (gu32*)(args.ws + WS_CTL);
    for (int u = F.tid; u < (LDS_BYTES - LDSCTL_OFF) / 4; u += 512) ((LAS unsigned*)(F.lds + LDSCTL_OFF))[u] = 0u;
    __syncthreads();
    XcdBarrier bar = xcd_barrier_post((unsigned*)(F.ctl + CW_BAR), F.MISC + 8);
    const int c = (int)blockIdx.x;

    if (PH(0)) p0_prologue(F);
    xcd_barrier(bar);

#define PHASE_FRESH() do { int t_ = threadIdx.x; asm volatile("" : "+v"(t_)); F.tid = t_; F.lane = t_ & 63; } while (0)
    for (int l = 0; l < DEPTH; ++l) {
        unsigned char* wl = F.ws + WS_WT + (size_t)l * LW;
        const float* xin = (l == 0) ? F.in[0] : F.out;
        PHASE_FRESH();
        if (PH(1)) rowpass<0>(F, xin, nullptr, 0, nullptr, WSP(bf16_t, WS_H), F.in[2] + l * DM, nullptr, 0, M);
        xcd_barrier(bar);
        if (PH(2)) { SchedSimple S; S.T.init(256, 12, F.G, c); S.A = (const char*)(F.ws + WS_H); S.B = (const char*)(wl + LW_IN); S.lda = 2048; S.ldb = 2048; S.nt = 16;
          pg8::EpiInProj E{WSP(bf16_t, WS_P), WSP(bf16_t, WS_KCMP), WSP(bf16_t, WS_VCMP), WSP(float, WS_SIDE), WSP(bf16_t, WS_KROT), WSP(const float, WS_ROPE), WSP(float, WS_SSQQ), WSP(float, WS_SSQKV)};
          pg8::gemm_phase<pg8::EpiInProj, SchedSimple, true>(F.lds, S, E); }
        xcd_barrier(bar);
        if (PH(3)) { SchedCmp1 S{c, (const char*)(F.ws + WS_KCMP), (const char*)(F.ws + WS_VCMP), (const char*)(wl + LW_PHI)};
          pg8::EpiCmp1 E{WSP(bf16_t, WS_HID), WSP(const float, WS_CMPB) + l * 256};
          pg8::gemm_phase<pg8::EpiCmp1, SchedCmp1, false>(F.lds, S, E); }
        if (PH(4)) { const bool split = F.G > 64; const int g2 = split ? F.G - 32 : F.G, c2 = split ? c - 32 : c;
          { SchedSimple S; S.T.init(256, 2, g2, c2 < 0 ? (1 << 28) : c2); S.A = (const char*)(F.ws + WS_P) + PC_DQL * 2; S.B = (const char*)(wl + LW_UQ); S.lda = PW * 2; S.ldb = 512; S.nt = 4;
            pg8::EpiQup E{WSP(bf16_t, WS_QM), WSP(const float, WS_SSQQ), WSP(const float, WS_ROPE)};
            pg8::gemm_phase<pg8::EpiQup, SchedSimple, true>(F.lds, S, E); }
          { SchedSimple S; S.T.init(256, 2, g2, c2 < 0 ? (1 << 28) : c2); S.A = (const char*)(F.ws + WS_P) + PC_DKV * 2; S.B = (const char*)(wl + LW_UKV); S.lda = PW * 2; S.ldb = 256; S.nt = 2;
            pg8::EpiKVup E{WSP(bf16_t, WS_KVM), WSP(const float, WS_SSQKV)};
            pg8::gemm_phase<pg8::EpiKVup, SchedSimple, true>(F.lds, S, E); } }
        PHASE_FRESH();
        if (PH(5)) {
          const int gw = c * 8 + F.wave;
          if (gw < BATCH) { const int b = gw; const float* sd = WSP(const float, WS_SIDE) + (size_t)b * SEQ * 16 + 12; const f32x4 fb = *(const f32x4*)(F.in[12] + l * 4);
              f32x4 tot = {0.f, 0.f, 0.f, 0.f};
              for (int i = 0; i < 64; ++i) { const f32x4 f = *(const f32x4*)(sd + (size_t)(F.lane * 64 + i) * 16);
#pragma unroll
                  for (int e = 0; e < 4; ++e) { const float x = f[e] + fb[e]; tot[e] += (x >= 0.f) ? -log1pf(expf(-x)) : (x - log1pf(expf(x))); } }
              LAS float* sc = (LAS float*)(F.lds + F.wave * 1024);
              *(LAS f32x4*)(sc + 4 * F.lane) = tot; LDS_WAIT(); asm volatile("" ::: "memory");
              f32x4 pre = {0.f, 0.f, 0.f, 0.f};
              for (int j = 0; j < 64; ++j) { const f32x4 o = *(const LAS f32x4*)(sc + 4 * j); if (j < F.lane) pre = pre + o; }
              pre = pre + tot;
              f32x4 run = pre - tot;
              float* kb = WSP(float, WS_KB) + (size_t)b * 4 * SEQ;
              for (int i = 0; i < 64; ++i) { const int t = F.lane * 64 + i; const f32x4 f = *(const f32x4*)(sd + (size_t)t * 16);
#pragma unroll
                  for (int e = 0; e < 4; ++e) { const float x = f[e] + fb[e]; run[e] += (x >= 0.f) ? -log1pf(expf(-x)) : (x - log1pf(expf(x))); kb[(size_t)e * SEQ + t] = -run[e] * LOG2E; } }
          } }
        xcd_barrier(bar);
        PHASE_FRESH();
        if (PH(6)) { const int gt = c * 512 + F.tid, NGT = F.G * 512; const bf16_t* hid = WSP(const bf16_t, WS_HID);
          for (int i = gt; i < 2 * BATCH * 256 * 64; i += NGT) { const int d = i & 63, rc = (i >> 6) & 4095, which = i >> 18;
              const bf16_t* hr = hid + (size_t)(which * 4096 + rc) * 256 + which * 128; const float* w2 = (which ? F.in[11] : F.in[9]) + (size_t)l * 128 * 64 + d;
              float a = 0.f;
#pragma unroll 8
              for (int n = 0; n < 128; ++n) a += bf2f(hr[n]) * w2[n * 64];
              (which ? WSP(bf16_t, WS_VC) : WSP(bf16_t, WS_KC))[(size_t)rc * 64 + d] = (bf16_t)f2bf(a); } }
        xcd_barrier(bar);
        PHASE_FRESH();
        { gu32* ctr = F.ctl + CW_Q + 64 * l;
          for (;;) { const int it = queue_grab(F, ctr);
              if (it < 2048 && PH(7)) { const int qb = 15 - (it >> 7), mla = (it >> 6) & 1, bh = it & 63; if (mla) causal_unit<false>(F, bh >> 2, bh & 3, qb); else causal_unit<true>(F, bh >> 2, bh & 3, qb); }
              else if (it < 3072 && PH(8)) { const int r = it - 2048; nsa_unit(F, r & 15, 63 - (r >> 4)); }
              else if (it < 3328 && PH(9)) { const int r = it - 3072; dil_unit(F, r & 15, (r >> 4) & 1, r >> 5); }
              else break; } }
        xcd_barrier(bar);
#if defined(SELFCHECK) && SELFCHECK == 1
        if (c == 0) selfcheck_a(F, l);
#endif
#if defined(SELFCHECK) && SELFCHECK == 3
        if (c == 0) selfcheck_e(F, l);
        xcd_barrier(bar); selfcheck_report(F); return;
#endif
#if defined(SELFCHECK) && SELFCHECK == 5
        selfcheck_g(F, l); xcd_barrier(bar); selfcheck_g_fin(F);
        xcd_barrier(bar); selfcheck_report(F); return;
#endif
#if defined(SELFCHECK) && SELFCHECK == 4
        if (c == 0) selfcheck_f(F, l);
        xcd_barrier(bar); selfcheck_report(F); return;
#endif
        if (PH(10)) { SchedMerge S; S.T.init(256, 4, F.G, c); S.ocat = (const char*)(F.ws + WS_OCAT); S.h = (const char*)(F.ws + WS_H); S.wbr = (const char*)(wl + LW_BR); S.wg = (const char*)(wl + LW_G);
          unsigned char* scr = F.ws + WS_MSCR + (size_t)c * MSCR_PER_WG;
          pg8::EpiMerge E{WSP(bf16_t, WS_MERGED), scr};
          pg8::gemm_phase<pg8::EpiMerge, SchedMerge, true>(F.lds, S, E); }
        xcd_barrier(bar);
#if defined(SELFCHECK) && SELFCHECK == 1
        if (c == 0) selfcheck_b(F, l);
        xcd_barrier(bar); selfcheck_report(F); return;
#endif
        if (PH(11)) { SchedSimple S; S.T.init(256, 4, F.G, c); S.A = (const char*)(F.ws + WS_MERGED); S.B = (const char*)(wl + LW_O); S.lda = 2048; S.ldb = 2048; S.nt = 16;
          pg8::EpiF32 E{WSP(float, WS_Y), DM};
          pg8::gemm_phase<pg8::EpiF32, SchedSimple, true>(F.lds, S, E); }
        xcd_barrier(bar);
        PHASE_FRESH();
        if (PH(12)) rowpass<1>(F, xin, WSP(const float, WS_Y), 0, F.out, WSP(bf16_t, WS_H2), F.in[3] + l * DM, F.in[4] + l * DM, 0, M);
        xcd_barrier(bar);
#if defined(SELFCHECK) && SELFCHECK == 2
        if (c == 0) selfcheck_c(F, l, xin);
#endif
        for (int hf = 0; hf < 2; ++hf) {
            if (PH(13)) { SchedSimple S; S.T.init(128, 22, F.G, c); S.A = (const char*)(F.ws + WS_H2) + (size_t)hf * (M / 2) * 2048; S.B = (const char*)(wl + LW_UP); S.lda = 2048; S.ldb = 2048; S.nt = 16;
              pg8::EpiBf16 E{WSP(bf16_t, WS_U), DFF2};
              pg8::gemm_phase<pg8::EpiBf16, SchedSimple, true>(F.lds, S, E); }
            xcd_barrier(bar);
            PHASE_FRESH();
            if (PH(14)) conv_pass(F, WSP(const bf16_t, WS_U), WSP(bf16_t, WS_ACT), F.in[24] + (size_t)l * 3 * DFF2, F.in[25] + (size_t)l * DFF2);
            xcd_barrier(bar);
            if (PH(15)) { SchedSimple S; S.T.init(128, 4, F.G, c); S.A = (const char*)(F.ws + WS_ACT); S.B = (const char*)(wl + LW_DN); S.lda = DFF * 2; S.ldb = DFF * 2; S.nt = DFF / 64;
              pg8::EpiF32 E{WSP(float, WS_Y2), DM};
              pg8::gemm_phase<pg8::EpiF32, SchedSimple, true>(F.lds, S, E); }
            xcd_barrier(bar);
#if defined(SELFCHECK) && SELFCHECK == 2
            if (c == 0) selfcheck_d(F, l);
            xcd_barrier(bar); selfcheck_report(F); return;
#endif
            PHASE_FRESH();
            if (PH(16)) rowpass<2>(F, F.out, WSP(const float, WS_Y2), (size_t)hf * (M / 2), F.out, nullptr, F.in[5] + l * DM, nullptr, hf * (M / 2), (hf + 1) * (M / 2));
            xcd_barrier(bar);
        }
    }
}

extern "C" void kernel_launch(void* const* d_in, const int* in_sizes, int n_in, void* d_out, int out_size, void* d_ws, size_t ws_size, hipStream_t stream) {
    static int grid = 0;
    if (grid == 0) {
        if (n_in != 27 || in_sizes[0] != M * DM || out_size != M * DM || ws_size < WS_END) { fprintf(stderr, "kernel_launch: unexpected shapes (n_in %d, in0 %d, out %d, ws %zu)\n", n_in, n_in > 0 ? in_sizes[0] : -1, out_size, ws_size); grid = -1; return; }
        int dev = 0, cus = 0, per_cu = 0;
        if (hipGetDevice(&dev) != hipSuccess || hipDeviceGetAttribute(&cus, hipDeviceAttributeMultiprocessorCount, dev) != hipSuccess) { grid = -1; return; }
        if (hipFuncSetAttribute((const void*)hybrid_fwd, hipFuncAttributeMaxDynamicSharedMemorySize, LDS_BYTES) != hipSuccess) { fprintf(stderr, "kernel_launch: hipFuncSetAttribute failed\n"); grid = -1; return; }
        if (hipOccupancyMaxActiveBlocksPerMultiprocessor(&per_cu, (const void*)hybrid_fwd, 512, LDS_BYTES) != hipSuccess || per_cu < 1) fprintf(stderr, "kernel_launch: occupancy query says %d\n", per_cu);
        (void)hipGetLastError();
        grid = cus;
    }
    if (grid < 0) return;
    if (hipMemsetAsync((char*)d_ws + WS_CTL, 0, CTL_ZERO_BYTES, stream) != hipSuccess) return;
    Args a{};
    for (int i = 0; i < 27; ++i) a.in[i] = (const float*)d_in[i];
    a.out = (float*)d_out; a.ws = (unsigned char*)d_ws;
    hipLaunchKernelGGL(hybrid_fwd, dim3(grid), dim3(512), LDS_BYTES, stream, a);
}
```

```cpp
#include <hip/hip_runtime.h>
#include <hip/hip_bf16.h>
#include <cstdio>
#include <cstdint>
#include <cmath>

#define GAS __attribute__((address_space(1)))
#define LAS __attribute__((address_space(3)))
typedef unsigned short bf16_t;
typedef short bf16x8 __attribute__((ext_vector_type(8)));
typedef short s16x4 __attribute__((ext_vector_type(4)));
typedef float f32x4 __attribute__((ext_vector_type(4)));
typedef float f32x2 __attribute__((ext_vector_type(2)));
typedef float f32x16 __attribute__((ext_vector_type(16)));
typedef unsigned u32x4 __attribute__((ext_vector_type(4)));
typedef unsigned u32x2 __attribute__((ext_vector_type(2)));
typedef GAS unsigned gu32;

constexpr int BATCH = 16, SEQ = 4096, DM = 1024, M = BATCH * SEQ, DEPTH = 2;
constexpr int DIN = 2992, PW = 3072;
constexpr int DFF = 2816, DFF2 = 5632;
constexpr float LOG2E = 1.4426950408889634f;
constexpr float C2A = 0.125f * LOG2E;
constexpr float C2D = 0.10206207261596575f * LOG2E;
constexpr float RMS_EPS = 1e-6f;
constexpr int PC_AQ = 0, PC_KCMP = 256, PC_VCMP = 320, PC_KSLC = 384, PC_VSLC = 448, PC_KWIN = 512, PC_VWIN = 576,
              PC_MISC = 640, PC_KROPE = 672, PC_BQ = 768, PC_BK = 1152, PC_BV = 1536, PC_DKV = 1920,
              PC_CQ = 2048, PC_CK = 2304, PC_CV = 2560, PC_DQL = 2816;
constexpr int OCW = 896;
constexpr int NSA_DFAR = 1536, NSA_DMAX = 1664, NSA_TL = 1728;

__device__ __forceinline__ unsigned f2bf(float f) { unsigned u = __float_as_uint(f); return (u + 0x7fffu + ((u >> 16) & 1u)) >> 16; }
__device__ __forceinline__ unsigned pk2(float lo, float hi) { return f2bf(lo) | (f2bf(hi) << 16); }
__device__ __forceinline__ float bf2f(unsigned short b) { return __uint_as_float((unsigned)b << 16); }
typedef __bf16 bf16x2_t __attribute__((ext_vector_type(2)));
__device__ __forceinline__ unsigned cvtpk(float lo, float hi) { f32x2 v = {lo, hi}; bf16x2_t b = __builtin_convertvector(v, bf16x2_t); return __builtin_bit_cast(unsigned, b); }
__device__ __forceinline__ float fast_exp2(float x) { return __builtin_amdgcn_exp2f(x); }
__device__ __forceinline__ float fast_rcp(float x) { return __builtin_amdgcn_rcpf(x); }
template <int MASK> __device__ __forceinline__ float xor_lane_lt32(float v) { return __uint_as_float(__builtin_amdgcn_ds_swizzle((int)__float_as_uint(v), (MASK << 10) | 0x1f)); }
__device__ __forceinline__ float sum_halves(float v) { auto rr = __builtin_amdgcn_permlane32_swap(__float_as_uint(v), __float_as_uint(v), false, false); return __uint_as_float(rr[0]) + __uint_as_float(rr[1]); }
__device__ __forceinline__ float sigmoid_f(float x) { return fast_rcp(1.0f + fast_exp2(-x * LOG2E)); }

namespace pg8 {
constexpr int BM = 256, BK = 64, HALF = 128, HTB = HALF * BK * 2  , STAGE_BYTES = 8 * HTB, NXCD = 8, WGM = 8;
__host__ __device__ __forceinline__ int lds_byte(int r, int c) { const int st = (r >> 4) * 2 + (c >> 5), rr = r & 15, cc = c & 31, ob = rr * 64 + cc * 2; return st * 1024 + (ob ^ (((ob >> 9) & 1) << 5)); }
__host__ __device__ __forceinline__ void stage_rc(int b, int& R, int& C) { const int st = b / 1024, sb = b % 1024, swz = sb ^ (((sb >> 9) & 1) << 5); R = (st >> 1) * 16 + swz / 64; C = (st & 1) * 32 + (swz % 64) / 2; }
__host__ __device__ __forceinline__ int perm32(int rho) { const int n = rho >> 4, i = rho & 15; return 8 * (i >> 2) + 4 * n + (i & 3); }

struct GUnit { const char* A; const char* B; int lda, ldb, nt, pm, pn, id; };

struct TileOrder {
    int nM, nN, nwg, G, c;
    __device__ void init(int nM_, int nN_, int G_, int c_) { nM = nM_; nN = nN_; nwg = nM * nN; G = G_; c = c_; }
    __device__ bool tile(int i, int& pm, int& pn) const {
        const long L = (long)i * G + c; if (L >= nwg) return false;
        int wgid = (int)L; { const int q = nwg / NXCD, r = nwg % NXCD, xcd = wgid % NXCD, off = wgid / NXCD; wgid = (xcd < r ? xcd * (q + 1) : r * (q + 1) + (xcd - r) * q) + off; }
        const int nig = WGM * nN, gid = wgid / nig, fm = gid * WGM, gsz = (nM - fm) < WGM ? (nM - fm) : WGM;
        pm = fm + ((wgid % nig) % gsz); pn = (wgid % nig) / gsz; return true;
    }
};

template <class Epi, class Sched, bool ALIGN_EPI>
__device__ __forceinline__ void gemm_phase(LAS unsigned char* lds, const Sched& S, const Epi& E) {
    int tid_o = threadIdx.x; asm volatile("" : "+v"(tid_o));
    const int tid = tid_o, wid = __builtin_amdgcn_readfirstlane(tid >> 6), lane = tid & 63, wr = wid >> 2, wc = wid & 3; int fr = lane & 15, fq = lane >> 4;
    int sR[2], sC[2], sRb[2];
#pragma unroll
    for (int i = 0; i < 2; ++i) { stage_rc(tid * 16 + i * 8192, sR[i], sC[i]); sRb[i] = Epi::PERM ? ((sR[i] & ~31) + perm32(sR[i] & 31)) : sR[i]; sC[i] *= 2; }
    const size_t kstep = (size_t)(BK * 2);
    const unsigned ldsw = (unsigned)wid * 1024u;
    const int aoff = lds_byte(wr * 64 + fr, fq * 8), boff = lds_byte(wc * 32 + fr, fq * 8);
#define PG8_SA(b, h) (((b) * 2 + (h)) * HTB)
#define PG8_SB(b, h) ((4 + (b) * 2 + (h)) * HTB)
#define PG8_STAGE(bufoff, gbase, rows, ld) do { _Pragma("unroll") for (int _i = 0; _i < 2; ++_i) \
        __builtin_amdgcn_global_load_lds((const unsigned*)((const char*)(gbase) + (unsigned)((rows)[_i] * (ld) + sC[_i])), (LAS unsigned*)(lds + (bufoff) + ldsw + _i * 8192), 16, 0, 0); } while (0)
#define PG8_LDA(dst, b, h) do { _Pragma("unroll") for (int m = 0; m < 4; ++m) _Pragma("unroll") for (int k = 0; k < 2; ++k) dst[m][k] = *(const LAS bf16x8*)(lds + PG8_SA(b, h) + aoff + m * 2048 + k * 1024); } while (0)
#define PG8_LDB(dst, b, h) do { _Pragma("unroll") for (int n = 0; n < 2; ++n) _Pragma("unroll") for (int k = 0; k < 2; ++k) dst[n][k] = *(const LAS bf16x8*)(lds + PG8_SB(b, h) + boff + n * 2048 + k * 1024); } while (0)
#define PG8_MMA(ai, bj, At, Bt) do { __builtin_amdgcn_s_setprio(1); _Pragma("unroll") for (int m = 0; m < 4; ++m) _Pragma("unroll") for (int n = 0; n < 2; ++n) _Pragma("unroll") for (int k = 0; k < 2; ++k) \
        acc[ai][bj][m][n] = __builtin_amdgcn_mfma_f32_16x16x32_bf16(Bt[n][k], At[m][k], acc[ai][bj][m][n], 0, 0, 0); __builtin_amdgcn_s_setprio(0); } while (0)
#define PG8_WAIT_V(n) asm volatile("s_waitcnt vmcnt(" #n ")" ::: "memory")
#define PG8_WAIT_L(n) asm volatile("s_waitcnt lgkmcnt(" #n ")" ::: "memory")
#define PG8_BAR __builtin_amdgcn_s_barrier()
#define PG8_SCHED __builtin_amdgcn_sched_barrier(0)
    GUnit cur, nxt; int ui = 0;
    if (!S.next(0, cur)) return;
    f32x4 acc[2][2][4][2];
#pragma unroll
    for (int a = 0; a < 2; ++a)
#pragma unroll
        for (int b = 0; b < 2; ++b)
#pragma unroll
            for (int m = 0; m < 4; ++m)
#pragma unroll
                for (int n = 0; n < 2; ++n) acc[a][b][m][n] = (f32x4){0.f, 0.f, 0.f, 0.f};
    bf16x8 At[4][2], B0[2][2], B1[2][2];
    int ldAc = cur.lda, ldBc = cur.ldb; size_t hAc = (size_t)HALF * ldAc, hBc = (size_t)HALF * ldBc;
    const char* cA = cur.A; const char* cB = cur.B;
    PG8_STAGE(PG8_SB(0, 0), cB, sRb, ldBc); PG8_STAGE(PG8_SB(0, 1), cB + hBc, sRb, ldBc); PG8_STAGE(PG8_SA(0, 0), cA, sR, ldAc); PG8_STAGE(PG8_SA(0, 1), cA + hAc, sR, ldAc);
    if (wr == 1) PG8_BAR;
    PG8_WAIT_V(2); PG8_BAR;
    PG8_STAGE(PG8_SB(1, 0), cB + kstep, sRb, ldBc); PG8_STAGE(PG8_SA(1, 0), cA + kstep, sR, ldAc); PG8_STAGE(PG8_SB(1, 1), cB + hBc + kstep, sRb, ldBc);
    PG8_WAIT_V(6); PG8_BAR;
    for (;;) {
        const bool has_next = S.next(ui + 1, nxt);
        int ldAn, ldBn; const char* nA; const char* nB;
        if (has_next) { ldAn = nxt.lda; ldBn = nxt.ldb; nA = nxt.A; nB = nxt.B; } else { ldAn = ldAc; ldBn = ldBc; nA = cA; nB = cB; }
        const size_t hAn = (size_t)HALF * ldAn, hBn = (size_t)HALF * ldBn;
        int nt = cur.nt; asm volatile("" : "+s"(nt));
        for (int t = 0; t < nt; t += 2) {
            const bool last = (t == nt - 2);
            const char* a1 = cA + (size_t)(t + 1) * kstep;
            const char* a2 = last ? nA : cA + (size_t)(t + 2) * kstep; const char* b2 = last ? nB : cB + (size_t)(t + 2) * kstep;
            const char* a3 = a2 + kstep; const char* b3 = b2 + kstep;
            const int ldA2 = last ? ldAn : ldAc, ldB2 = last ? ldBn : ldBc;
            const size_t hA2 = last ? hAn : hAc, hB2 = last ? hBn : hBc;
            PG8_LDB(B0, 0, 0); PG8_LDB(B1, 0, 1); PG8_SCHED; PG8_LDA(At, 0, 0); PG8_STAGE(PG8_SA(1, 1), a1 + hAc, sR, ldAc);
            PG8_WAIT_V(8); PG8_WAIT_L(0); PG8_BAR; PG8_MMA(0, 0, At, B0); PG8_MMA(0, 1, At, B1); PG8_BAR; PG8_SCHED;
            PG8_LDA(At, 0, 1); PG8_STAGE(PG8_SB(0, 0), b2, sRb, ldB2); PG8_STAGE(PG8_SB(0, 1), b2 + hB2, sRb, ldB2); PG8_STAGE(PG8_SA(0, 0), a2, sR, ldA2);
            PG8_WAIT_V(8); PG8_WAIT_L(0); PG8_BAR; PG8_MMA(1, 0, At, B0); PG8_MMA(1, 1, At, B1); PG8_BAR; PG8_SCHED;
            PG8_LDB(B0, 1, 0); PG8_LDB(B1, 1, 1); PG8_SCHED; PG8_LDA(At, 1, 0); PG8_STAGE(PG8_SA(0, 1), a2 + hA2, sR, ldA2);
            PG8_WAIT_V(8); PG8_WAIT_L(0); PG8_BAR; PG8_MMA(0, 0, At, B0); PG8_MMA(0, 1, At, B1); PG8_BAR; PG8_SCHED;
            PG8_LDA(At, 1, 1); PG8_STAGE(PG8_SB(1, 0), b3, sRb, ldB2); PG8_STAGE(PG8_SB(1, 1), b3 + hB2, sRb, ldB2); PG8_STAGE(PG8_SA(1, 0), a3, sR, ldA2);
            PG8_WAIT_V(8); PG8_WAIT_L(0); PG8_BAR; PG8_MMA(1, 0, At, B0); PG8_MMA(1, 1, At, B1); PG8_BAR; PG8_SCHED;
        }
        if constexpr (ALIGN_EPI) { if (wr == 0) PG8_BAR; }
        E(acc, cur, wr, wc, fr, fq);
        if (!has_next) break;
#pragma unroll
        for (int a = 0; a < 2; ++a)
#pragma unroll
            for (int b = 0; b < 2; ++b)
#pragma unroll
                for (int m = 0; m < 4; ++m)
#pragma unroll
                    for (int n = 0; n < 2; ++n) acc[a][b][m][n] = (f32x4){0.f, 0.f, 0.f, 0.f};
        cur = nxt; cA = nA; cB = nB; ++ui;
        ldAc = ldAn; ldBc = ldBn; hAc = hAn; hBc = hBn;
        if constexpr (ALIGN_EPI) { if (wr == 1) PG8_BAR; }
    }
    PG8_WAIT_V(0);
    if constexpr (!ALIGN_EPI) { if (wr == 0) PG8_BAR; }
    PG8_BAR;
#undef PG8_SA
#undef PG8_SB
#undef PG8_STAGE
#undef PG8_LDA
#undef PG8_LDB
#undef PG8_MMA
#undef PG8_WAIT_V
#undef PG8_WAIT_L
#undef PG8_BAR
#undef PG8_SCHED
}
}
using pg8::GUnit;
namespace pg8 {
#define EPI_OPAQUE() asm volatile("" : "+v"(fr), "+v"(fq))
struct EpiBf16 {
    static constexpr bool PERM = true;
    bf16_t* O; int ldc;
    __device__ __forceinline__ void operator()(const f32x4 (&acc)[2][2][4][2], const GUnit& u, int wr, int wc, int fr, int fq) const {
        EPI_OPAQUE();
        const int row0 = u.pm * BM + wr * 64 + fr, col0 = u.pn * BM + wc * 32 + 8 * fq;
#pragma unroll
        for (int ai = 0; ai < 2; ++ai)
#pragma unroll
            for (int m = 0; m < 4; ++m) { bf16_t* rowp = O + (size_t)(row0 + ai * HALF + m * 16) * ldc + col0;
#pragma unroll
                for (int bj = 0; bj < 2; ++bj) { const f32x4 v0 = acc[ai][bj][m][0], v1 = acc[ai][bj][m][1];
                    u32x4 w; w.x = cvtpk(v0[0], v0[1]); w.y = cvtpk(v0[2], v0[3]); w.z = cvtpk(v1[0], v1[1]); w.w = cvtpk(v1[2], v1[3]);
                    *(u32x4*)(rowp + bj * HALF) = w; } }
    }
};
struct EpiF32 {
    static constexpr bool PERM = false;
    float* O; int ldc;
    __device__ __forceinline__ void operator()(const f32x4 (&acc)[2][2][4][2], const GUnit& u, int wr, int wc, int fr, int fq) const {
        EPI_OPAQUE();
        const int row0 = u.pm * BM + wr * 64 + fr, col0 = u.pn * BM + wc * 32 + 4 * fq;
#pragma unroll
        for (int ai = 0; ai < 2; ++ai)
#pragma unroll
            for (int m = 0; m < 4; ++m) { float* rowp = O + (size_t)(row0 + ai * HALF + m * 16) * ldc + col0;
#pragma unroll
                for (int bj = 0; bj < 2; ++bj)
#pragma unroll
                    for (int n = 0; n < 2; ++n) *(f32x4*)(rowp + bj * HALF + n * 16) = acc[ai][bj][m][n]; }
    }
};
__device__ __forceinline__ void rope8(f32x4& v0, f32x4& v1, const float* cs  ) {
    const f32x4 a = *(const f32x4*)cs, b = *(const f32x4*)(cs + 4);
    f32x4 r0, r1;
    r0[0] = v0[0] * a[0] - v0[1] * a[1]; r0[1] = v0[1] * a[0] + v0[0] * a[1];
    r0[2] = v0[2] * a[2] - v0[3] * a[3]; r0[3] = v0[3] * a[2] + v0[2] * a[3];
    r1[0] = v1[0] * b[0] - v1[1] * b[1]; r1[1] = v1[1] * b[0] + v1[0] * b[1];
    r1[2] = v1[2] * b[2] - v1[3] * b[3]; r1[3] = v1[3] * b[2] + v1[2] * b[3];
    v0 = r0; v1 = r1;
}
struct EpiInProj {
    static constexpr bool PERM = true;
    bf16_t* P; bf16_t* kcmp; bf16_t* vcmp; float* side; bf16_t* krot; const float* rope; float* ssq_q; float* ssq_kv;
    __device__ __forceinline__ void operator()(const f32x4 (&acc)[2][2][4][2], const GUnit& u, int wr, int wc, int fr, int fq) const {
        EPI_OPAQUE();
        const int row0 = u.pm * BM + wr * 64 + fr, col0 = u.pn * BM + wc * 32 + 8 * fq;
#pragma unroll
        for (int ai = 0; ai < 2; ++ai)
#pragma unroll
            for (int m = 0; m < 4; ++m) { const int row = row0 + ai * HALF + m * 16; bf16_t* rowp = P + (size_t)row * PW + col0;
                float ssq = 0.f;
#pragma unroll
                for (int bj = 0; bj < 2; ++bj) { f32x4 v0 = acc[ai][bj][m][0], v1 = acc[ai][bj][m][1];
                    if (u.pn == 2 && bj == 1) {
                        if (wc == 0 && fq < 2) { float* sp = side + (size_t)row * 16 + 8 * fq; *(f32x4*)sp = v0; *(f32x4*)(sp + 4) = v1; }
                        if (wc == 1) { rope8(v0, v1, rope + (size_t)(row & (SEQ - 1)) * 32 + 8 * fq);
                            u32x4 w; w.x = cvtpk(v0[0], v0[1]); w.y = cvtpk(v0[2], v0[3]); w.z = cvtpk(v1[0], v1[1]); w.w = cvtpk(v1[2], v1[3]);
                            *(u32x4*)(krot + (size_t)row * 32 + 8 * fq) = w; }
                    }
                    u32x4 w; w.x = cvtpk(v0[0], v0[1]); w.y = cvtpk(v0[2], v0[3]); w.z = cvtpk(v1[0], v1[1]); w.w = cvtpk(v1[2], v1[3]);
                    *(u32x4*)(rowp + bj * HALF) = w;
                    if (u.pn == 1 && bj == 0) { bf16_t* cp = (wc < 2 ? kcmp : vcmp) + (size_t)row * 64 + (wc & 1) * 32 + 8 * fq; *(u32x4*)cp = w; }
                    if (u.pn == 11 || (u.pn == 7 && bj == 1)) ssq += (v0[0] * v0[0] + v0[1] * v0[1]) + (v0[2] * v0[2] + v0[3] * v0[3]) + (v1[0] * v1[0] + v1[1] * v1[1]) + (v1[2] * v1[2] + v1[3] * v1[3]);
                }
                if (u.pn == 11 || u.pn == 7) { ssq += xor_lane_lt32<16>(ssq); ssq = sum_halves(ssq);
                    if (fq == 0) (u.pn == 11 ? ssq_q : ssq_kv)[(size_t)row * 4 + wc] = ssq; }
                asm volatile("" ::: "memory");
            }
    }
};
struct EpiQup {
    static constexpr bool PERM = true;
    bf16_t* O; const float* ssq_q; const float* rope;
    __device__ __forceinline__ void operator()(const f32x4 (&acc)[2][2][4][2], const GUnit& u, int wr, int wc, int fr, int fq) const {
        EPI_OPAQUE();
        const int row0 = u.pm * BM + wr * 64 + fr, col0 = u.pn * BM + wc * 32 + 8 * fq;
#pragma unroll
        for (int ai = 0; ai < 2; ++ai)
#pragma unroll
            for (int m = 0; m < 4; ++m) { const int row = row0 + ai * HALF + m * 16; bf16_t* rowp = O + (size_t)row * 512 + col0;
                const f32x4 pq = *(const f32x4*)(ssq_q + (size_t)row * 4);
                const float rstd = 1.0f / sqrtf(((pq[0] + pq[1]) + (pq[2] + pq[3])) * (1.0f / 256.0f) + RMS_EPS);
#pragma unroll
                for (int bj = 0; bj < 2; ++bj) { f32x4 v0 = acc[ai][bj][m][0] * rstd, v1 = acc[ai][bj][m][1] * rstd;
                    const int c8 = col0 + bj * HALF, within = c8 % 96;
                    if (c8 < 384 && within >= 64) rope8(v0, v1, rope + (size_t)(row & (SEQ - 1)) * 32 + (within - 64));
                    u32x4 w; w.x = cvtpk(v0[0], v0[1]); w.y = cvtpk(v0[2], v0[3]); w.z = cvtpk(v1[0], v1[1]); w.w = cvtpk(v1[2], v1[3]);
                    *(u32x4*)(rowp + bj * HALF) = w; }
                asm volatile("" ::: "memory"); }
    }
};
struct EpiKVup {
    static constexpr bool PERM = true;
    bf16_t* O; const float* ssq_kv;
    __device__ __forceinline__ void operator()(const f32x4 (&acc)[2][2][4][2], const GUnit& u, int wr, int wc, int fr, int fq) const {
        EPI_OPAQUE();
        const int row0 = u.pm * BM + wr * 64 + fr, col0 = u.pn * BM + wc * 32 + 8 * fq;
#pragma unroll
        for (int ai = 0; ai < 2; ++ai)
#pragma unroll
            for (int m = 0; m < 4; ++m) { const int row = row0 + ai * HALF + m * 16; bf16_t* rowp = O + (size_t)row * 512 + col0;
                const f32x4 pq = *(const f32x4*)(ssq_kv + (size_t)row * 4);
                const float rstd = 1.0f / sqrtf(((pq[0] + pq[1]) + (pq[2] + pq[3])) * (1.0f / 128.0f) + RMS_EPS);
#pragma unroll
                for (int bj = 0; bj < 2; ++bj) { const f32x4 v0 = acc[ai][bj][m][0] * rstd, v1 = acc[ai][bj][m][1] * rstd;
                    u32x4 w; w.x = cvtpk(v0[0], v0[1]); w.y = cvtpk(v0[2], v0[3]); w.z = cvtpk(v1[0], v1[1]); w.w = cvtpk(v1[2], v1[3]);
                    *(u32x4*)(rowp + bj * HALF) = w; }
                asm volatile("" ::: "memory"); }
    }
};
__device__ __forceinline__ float gelu_tanh(float x) { const float u2 = 2.0f * 0.7978845608028654f * (x + 0.044715f * x * x * x); return x * fast_rcp(1.0f + fast_exp2(-u2 * LOG2E)); }
struct EpiCmp1 {
    static constexpr bool PERM = true;
    bf16_t* O; const float* bias1;
    __device__ __forceinline__ void operator()(const f32x4 (&acc)[2][2][4][2], const GUnit& u, int wr, int wc, int fr, int fq) const {
        EPI_OPAQUE();
        const int row0 = u.pm * BM + wr * 64 + fr, col0 = wc * 32 + 8 * fq;
        f32x4 bv[2][2];
#pragma unroll
        for (int bj = 0; bj < 2; ++bj)
#pragma unroll
            for (int n = 0; n < 2; ++n) bv[bj][n] = *(const f32x4*)(bias1 + col0 + bj * HALF + 4 * n);
#pragma unroll
        for (int ai = 0; ai < 2; ++ai)
#pragma unroll
            for (int m = 0; m < 4; ++m) { bf16_t* rowp = O + (size_t)(row0 + ai * HALF + m * 16) * 256 + col0;
#pragma unroll
                for (int bj = 0; bj < 2; ++bj) { f32x4 v0 = acc[ai][bj][m][0] + bv[bj][0], v1 = acc[ai][bj][m][1] + bv[bj][1];
#pragma unroll
                    for (int e = 0; e < 4; ++e) { v0[e] = gelu_tanh(v0[e]); v1[e] = gelu_tanh(v1[e]); }
                    u32x4 w; w.x = cvtpk(v0[0], v0[1]); w.y = cvtpk(v0[2], v0[3]); w.z = cvtpk(v1[0], v1[1]); w.w = cvtpk(v1[2], v1[3]);
                    *(u32x4*)(rowp + bj * HALF) = w; } }
    }
};
typedef __amdgpu_buffer_rsrc_t rsrc_t;
struct EpiMerge {
    static constexpr bool PERM = true;
    bf16_t* O;
    unsigned char* scr;
    __device__ __forceinline__ void operator()(const f32x4 (&acc)[2][2][4][2], const GUnit& u, int wr, int wc, int fr, int fq) const {
        EPI_OPAQUE();
        const int tid = (wr * 4 + wc) * 64 + fq * 16 + fr;
        const int sub = u.id;
        const rsrc_t rs = __builtin_amdgcn_make_buffer_rsrc(scr, 0, 524288, 0x00020000);
        if (sub < 4) {
#pragma unroll
            for (int ai = 0; ai < 2; ++ai)
#pragma unroll
                for (int bj = 0; bj < 2; ++bj)
#pragma unroll
                    for (int m = 0; m < 4; ++m)
#pragma unroll
                        for (int n = 0; n < 2; ++n) { const int q = ((ai * 2 + bj) * 4 + m) * 2 + n; const f32x4 v = acc[ai][bj][m][n];
                            u32x2 w; w.x = cvtpk(v[0], v[1]); w.y = cvtpk(v[2], v[3]);
                            __builtin_amdgcn_raw_buffer_store_b64(w, rs, tid * 8, (sub * 32 + q) * 4096, 0); }
            return;
        }
        const int j = sub - 4;
        const int row0 = u.pm * BM + wr * 64 + fr, col0 = u.pn * BM + 64 * j + wc * 16 + 4 * fq;
#pragma unroll
        for (int ai = 0; ai < 2; ++ai)
#pragma unroll
            for (int m = 0; m < 4; ++m) { bf16_t* rowp = O + (size_t)(row0 + ai * HALF + m * 16) * DM + col0;
                f32x4 t = {0.f, 0.f, 0.f, 0.f};
#pragma unroll
                for (int g = 0; g < 4; ++g) { const f32x4 gt = acc[ai][g >> 1][m][g & 1];
                    const int qb = (ai * 16 + m * 2);
                    const u32x2 s = (j == 0) ? __builtin_amdgcn_raw_buffer_load_b64(rs, tid * 8, (g * 32 + qb) * 4096, 0)
                                  : (j == 1) ? __builtin_amdgcn_raw_buffer_load_b64(rs, tid * 8, (g * 32 + qb + 1) * 4096, 0)
                                  : (j == 2) ? __builtin_amdgcn_raw_buffer_load_b64(rs, tid * 8, (g * 32 + qb + 8) * 4096, 0)
                                             : __builtin_amdgcn_raw_buffer_load_b64(rs, tid * 8, (g * 32 + qb + 9) * 4096, 0);
                    t[0] += sigmoid_f(gt[0]) * __uint_as_float(s.x << 16); t[1] += sigmoid_f(gt[1]) * __uint_as_float(s.x & 0xffff0000u);
                    t[2] += sigmoid_f(gt[2]) * __uint_as_float(s.y << 16); t[3] += sigmoid_f(gt[3]) * __uint_as_float(s.y & 0xffff0000u); }
                u32x2 w; w.x = cvtpk(t[0], t[1]); w.y = cvtpk(t[2], t[3]);
                *(u32x2*)rowp = w;
                asm volatile("" ::: "memory"); }
    }
};
}
#define XB_TMO      128
#define XB_XCNT(j)  (256  + 64 * (j))
#define XB_XSUB(j)  (1280 + 64 * (j))
#define XB_XGEN(j)  (2304 + 64 * (j))
#define XB_TOP      3328
#define XB_TOPGEN   3392
#define XCD_BAR_WORDS 3456
#define XB_SPIN_CAP (1u << 22)
__device__ __forceinline__ unsigned xb_ld(unsigned* p)              { return __hip_atomic_load(p, __ATOMIC_RELAXED, __HIP_MEMORY_SCOPE_AGENT); }
__device__ __forceinline__ unsigned xb_add(unsigned* p, unsigned v) { return __hip_atomic_fetch_add(p, v, __ATOMIC_RELAXED, __HIP_MEMORY_SCOPE_AGENT); }
__device__ __forceinline__ unsigned xb_xcc_id() { return (unsigned)__builtin_amdgcn_s_getreg((3 << 11) | 20) & 0xFu; }
#define XB_SPIN(cond, bar) do { unsigned _sp = 0; while (cond) { __builtin_amdgcn_s_sleep(1); \
    if ((++_sp & 255u) == 0u) { if (xb_ld(&(bar)[XB_TMO])) break; if (_sp > XB_SPIN_CAP) { atomicAdd(&(bar)[XB_TMO], 1u); break; } } } } while (0)
struct XcdBarrier { unsigned* bar; unsigned x; volatile LAS unsigned* st; };
__device__ __forceinline__ XcdBarrier xcd_barrier_post(unsigned* bar, volatile LAS unsigned* st) {
    XcdBarrier b; b.bar = bar; b.x = xb_xcc_id(); b.st = st;
    if (threadIdx.x == 0) (void)xb_add(&bar[XB_XCNT(b.x)], 1u);
    return b;
}
__device__ __forceinline__ void xcd_barrier_complete(unsigned* bar, unsigned x, unsigned& nloc, unsigned& nx) {
    const unsigned G = gridDim.x * gridDim.y * gridDim.z;
    unsigned sum, cnt, mine, sp = 0u;
    for (;;) {
        sum = 0u; cnt = 0u; mine = 0u;
#pragma unroll
        for (unsigned j = 0; j < 16; ++j) { const unsigned c = xb_ld(&bar[XB_XCNT(j)]); sum += c; cnt += (c > 0u) ? 1u : 0u; mine = (j == x) ? c : mine; }
        if (sum == G) break;
        __builtin_amdgcn_s_sleep(1);
        if ((++sp & 255u) == 0u) { if (xb_ld(&bar[XB_TMO])) break; if (sp > XB_SPIN_CAP) { atomicAdd(&bar[XB_TMO], 1u); break; } }
    }
    nloc = mine > 0u ? mine : 1u; nx = cnt > 0u ? cnt : 1u;
}
__device__ __forceinline__ void xcd_barrier(const XcdBarrier& b) {
    asm volatile("s_waitcnt vmcnt(0)" ::: "memory");
    __syncthreads();
    if (threadIdx.x == 0) {
        unsigned* bar = b.bar; unsigned bx = b.x;
        asm volatile("" : "+s"(bx));
        __builtin_amdgcn_s_waitcnt(0);
        unsigned nloc = b.st[0], nx = b.st[1];
        if (nloc == 0u) { xcd_barrier_complete(bar, bx, nloc, nx); b.st[0] = nloc; b.st[1] = nx; }
        const unsigned old = xb_add(&bar[XB_XSUB(bx)], 1u);
        const unsigned gen = old / nloc;
        if (old + 1u == (gen + 1u) * nloc) {
            __builtin_amdgcn_fence(__ATOMIC_RELEASE, "agent");
            asm volatile("s_waitcnt vmcnt(0)" ::: "memory");
            const unsigned og = xb_add(&bar[XB_TOP], 1u);
            const unsigned tg = og / nx;
            if (og + 1u == (tg + 1u) * nx) xb_add(&bar[XB_TOPGEN], 1u);
            else XB_SPIN(xb_ld(&bar[XB_TOPGEN]) == tg, bar);
            __builtin_amdgcn_fence(__ATOMIC_ACQUIRE, "agent");
            xb_add(&bar[XB_XGEN(bx)], 1u);
            asm volatile("s_waitcnt vmcnt(0)" ::: "memory");
        } else {
            XB_SPIN(xb_ld(&bar[XB_XGEN(bx)]) == gen, bar);
            __builtin_amdgcn_fence(__ATOMIC_ACQUIRE, "agent");
            asm volatile("s_waitcnt vmcnt(0)" ::: "memory");
        }
    }
    __syncthreads();
}

#define MFMA32(a, b, c) __builtin_amdgcn_mfma_f32_32x32x16_bf16(a, b, c, 0, 0, 0)
typedef short v4i16_t __attribute__((ext_vector_type(4)));
typedef LAS const char* lds_cptr;
typedef LAS char* lds_ptr;
__device__ __forceinline__ int crow(int r, int hi) { return (r & 3) + 8 * (r >> 2) + 4 * hi; }
__device__ __forceinline__ s16x4 vtr(lds_cptr p) { return __builtin_bit_cast(s16x4, __builtin_amdgcn_ds_read_tr16_b64_v4i16((LAS v4i16_t*)p)); }
__device__ __forceinline__ float other_half(float x, int hi) { auto rr = __builtin_amdgcn_permlane32_swap(__float_as_uint(x), __float_as_uint(x), false, false); return __uint_as_float(hi ? rr[0] : rr[1]); }
constexpr float NEG_INF = -INFINITY;

constexpr int TB_V = 12288, TB_KB = 20480, TB_SIZE = 20992;
struct Stg { u32x4 k, k2, v; float kb; };

template <int NKS> __device__ __forceinline__ void qk64(lds_cptr kbuf, const bf16x8* qf, int r32, int hi, f32x16& p0, f32x16& p1) {
    lds_cptr kp = kbuf + hi * 1024 + r32 * 16;
#pragma unroll
    for (int ks = 0; ks < NKS; ++ks) {
        const bf16x8 a0 = *(const LAS bf16x8*)(kp + ks * 2048), a1 = *(const LAS bf16x8*)(kp + ks * 2048 + 512);
        p0 = MFMA32(a0, qf[ks], p0); p1 = MFMA32(a1, qf[ks], p1);
    }
}
struct AState { f32x16 o0, o1; float m, l; };
__device__ __forceinline__ void astate_init(AState& s) {
#pragma unroll
    for (int r = 0; r < 16; ++r) { s.o0[r] = 0.f; s.o1[r] = 0.f; }
    s.m = NEG_INF; s.l = 0.f;
}
__device__ __forceinline__ void pv64(f32x16& o0, f32x16& o1, lds_cptr vp, const bf16x8 (&pf)[4]) {
#pragma unroll
    for (int ks = 0; ks < 4; ++ks) {
        const s16x4 l0 = vtr(vp + ks * 1024), h0 = vtr(vp + ks * 1024 + 512), l1 = vtr(vp + 4096 + ks * 1024), h1 = vtr(vp + 4096 + ks * 1024 + 512);
        const bf16x8 v0 = (bf16x8){l0[0], l0[1], l0[2], l0[3], h0[0], h0[1], h0[2], h0[3]}, v1 = (bf16x8){l1[0], l1[1], l1[2], l1[3], h1[0], h1[1], h1[2], h1[3]};
        o0 = MFMA32(v0, pf[ks], o0); o1 = MFMA32(v1, pf[ks], o1);
    }
}
__device__ __forceinline__ void pack_p(const f32x16& p0, const f32x16& p1, bf16x8 (&pf)[4]) {
    u32x4 w0, w1, w2, w3;
    w0.x = cvtpk(p0[0], p0[1]); w0.y = cvtpk(p0[2], p0[3]); w0.z = cvtpk(p0[4], p0[5]); w0.w = cvtpk(p0[6], p0[7]);
    w1.x = cvtpk(p0[8], p0[9]); w1.y = cvtpk(p0[10], p0[11]); w1.z = cvtpk(p0[12], p0[13]); w1.w = cvtpk(p0[14], p0[15]);
    w2.x = cvtpk(p1[0], p1[1]); w2.y = cvtpk(p1[2], p1[3]); w2.z = cvtpk(p1[4], p1[5]); w2.w = cvtpk(p1[6], p1[7]);
    w3.x = cvtpk(p1[8], p1[9]); w3.y = cvtpk(p1[10], p1[11]); w3.z = cvtpk(p1[12], p1[13]); w3.w = cvtpk(p1[14], p1[15]);
    pf[0] = __builtin_bit_cast(bf16x8, w0); pf[1] = __builtin_bit_cast(bf16x8, w1); pf[2] = __builtin_bit_cast(bf16x8, w2); pf[3] = __builtin_bit_cast(bf16x8, w3);
}
__device__ __forceinline__ void softmax_pv64(f32x16& p0, f32x16& p1, AState& s, lds_cptr vp, int hi) {
    float mx = fmaxf(p0[0], p1[0]);
#pragma unroll
    for (int r = 1; r < 16; ++r) mx = fmaxf(mx, fmaxf(p0[r], p1[r]));
    mx = fmaxf(mx, other_half(mx, hi));
    const float mn = fmaxf(s.m, mx), ms = (mn == NEG_INF) ? 0.f : mn;
    const float alpha = fast_exp2(s.m - ms);
    float rs = 0.f;
#pragma unroll
    for (int r = 0; r < 16; ++r) { p0[r] = fast_exp2(p0[r] - ms); p1[r] = fast_exp2(p1[r] - ms); rs += p0[r] + p1[r]; }
    rs += other_half(rs, hi);
    s.l = s.l * alpha + rs; s.m = mn;
#pragma unroll
    for (int r = 0; r < 16; ++r) { s.o0[r] *= alpha; s.o1[r] *= alpha; }
    bf16x8 pf[4]; pack_p(p0, p1, pf);
    pv64(s.o0, s.o1, vp, pf);
}
__device__ __forceinline__ void mask_causal(f32x16& p0, f32x16& p1, int kpos0, int tq, int hi) {
#pragma unroll
    for (int r = 0; r < 16; ++r) { const int kp = kpos0 + crow(r, hi); if (kp > tq) p0[r] = NEG_INF; if (kp + 32 > tq) p1[r] = NEG_INF; }
}
__device__ __forceinline__ void add_table(f32x16& p0, f32x16& p1, const LAS float* tb) {
#pragma unroll
    for (int r = 0; r < 16; ++r) { const int o = (r & 3) + 8 * (r >> 2); p0[r] += tb[o]; p1[r] += tb[o + 32]; }
}
__device__ __forceinline__ void store_o_bf16(bf16_t* orow, const f32x16& o0, const f32x16& o1, float sc, int hi) {
#pragma unroll
    for (int g = 0; g < 4; ++g) {
        u32x2 w0, w1; w0.x = cvtpk(o0[4 * g] * sc, o0[4 * g + 1] * sc); w0.y = cvtpk(o0[4 * g + 2] * sc, o0[4 * g + 3] * sc);
        w1.x = cvtpk(o1[4 * g] * sc, o1[4 * g + 1] * sc); w1.y = cvtpk(o1[4 * g + 2] * sc, o1[4 * g + 3] * sc);
        *(u32x2*)(orow + 8 * g + 4 * hi) = w0; *(u32x2*)(orow + 32 + 8 * g + 4 * hi) = w1;
    }
}
constexpr size_t MiB = 1u << 20, KiB = 1u << 10;
constexpr size_t WS_CTL = 0, CTL_ZERO_BYTES = 1 * MiB;
constexpr size_t WS_ROPE = 1 * MiB, WS_NSATAB = WS_ROPE + 512 * KiB, WS_DILTAB = WS_NSATAB + 32 * KiB, WS_CMPB = WS_DILTAB + 8 * KiB, WS_FARB = WS_CMPB + 4 * KiB;
constexpr size_t WS_WT = 4 * MiB, LW = 38 * MiB;
constexpr size_t LW_IN = 0, LW_G = 6 * MiB, LW_BR = 14 * MiB, LW_O = 16 * MiB, LW_UP = 18 * MiB, LW_DN = 29 * MiB, LW_UQ = 35 * MiB, LW_UKV = 35 * MiB + 256 * KiB, LW_PHI = 36 * MiB;
constexpr size_t BR_A = 0, BR_B = 512 * KiB, BR_C = 768 * KiB, BR_D = 1280 * KiB;
constexpr size_t WS_SIDE = 80 * MiB, WS_SSQQ = 84 * MiB, WS_SSQKV = 85 * MiB, WS_KB = 86 * MiB, WS_KROT = 87 * MiB, WS_KCMP = 91 * MiB, WS_VCMP = 100 * MiB,
                 WS_HID = 109 * MiB, WS_KC = 113 * MiB, WS_VC = 113 * MiB + 512 * KiB, WS_DLSE = 114 * MiB, WS_DOG = 116 * MiB;
constexpr size_t WS_H = 164 * MiB, WS_OCAT = 292 * MiB, WS_QM = 404 * MiB, WS_KVM = 468 * MiB, WS_P = 532 * MiB;
constexpr size_t WS_MERGED = 532 * MiB, WS_MSCR = 660 * MiB, WS_Y = 164 * MiB, WS_H2 = 756 * MiB, WS_U = 164 * MiB, WS_ACT = 532 * MiB, WS_Y2 = 884 * MiB, WS_END = 1024 * MiB;
constexpr size_t MSCR_PER_WG = 512 * KiB;
static_assert(WS_WT + 2 * LW <= WS_SIDE && WS_DOG + 48 * MiB <= WS_H && WS_P + 384 * MiB <= WS_END && WS_MSCR + 256 * MSCR_PER_WG <= WS_P + 384 * MiB && WS_H2 + 128 * MiB <= WS_Y2 && WS_Y2 + 128 * MiB <= WS_END, "ws map");
static_assert(WS_U + 352 * MiB <= WS_ACT && WS_ACT + 176 * MiB <= WS_H2 && WS_Y + 256 * MiB <= WS_MERGED, "ws overlays");
constexpr int CW_BAR = 4096;
constexpr int CW_Q = 16384;

constexpr int RING_BYTES = 131072, LDSCTL_OFF = RING_BYTES, MISC_OFF = LDSCTL_OFF + 320, LDS_BYTES = 147456;
constexpr int NSA_SLAB = 49152, NSA_SLAB_BYTES = 4 * 64 * 65 * 4, NSA_SEL = NSA_SLAB + NSA_SLAB_BYTES;
static_assert(NSA_SEL + 512 <= RING_BYTES && 4 * NSA_TL * 4 <= NSA_SLAB_BYTES && 2 * TB_SIZE <= NSA_SLAB, "NSA LDS map");

struct Frame {
    LAS unsigned char* lds; volatile LAS unsigned* MISC; gu32* ctl;
    int tid, lane, wave, G;
    const float* in[27]; float* out; unsigned char* ws;
};
#define WSP(T, off) ((T*)(F.ws + (off)))
#define VM_WAIT() asm volatile("s_waitcnt vmcnt(0)" ::: "memory")
#define LDS_WAIT() asm volatile("s_waitcnt lgkmcnt(0)" ::: "memory")

__device__ __forceinline__ int queue_grab(Frame& F, gu32* ctr) {
    if (F.tid == 0) F.MISC[0] = __hip_atomic_fetch_add(ctr, 1u, __ATOMIC_RELAXED, __HIP_MEMORY_SCOPE_AGENT);
    __syncthreads();
    const int v = (int)F.MISC[0];
    __syncthreads();
    return v;
}

template <bool FOX> __device__ __forceinline__ void causal_unit(Frame& F, int b, int h, int qb) {
    constexpr int NKS = FOX ? 4 : 6;
    int lane_o = F.lane; asm volatile("" : "+v"(lane_o));
    const int wid = F.wave, lane = lane_o, r32 = lane & 31, hi = lane >> 5;
    const size_t rowbase = (size_t)b * SEQ;
    const int q0 = qb * 256, tq = q0 + wid * 32 + r32, NT = qb * 4 + 4;
    const bf16_t* P = WSP(const bf16_t, WS_P);
    const bf16_t *Kb, *Vb, *Qrow; int kpitch, vpitch;
    const bf16_t* Kr = WSP(const bf16_t, WS_KROT) + rowbase * 32;
    const float* kbsrc = WSP(const float, WS_KB) + (size_t)(b * 4 + h) * SEQ;
    if (FOX) { Kb = P + rowbase * PW + PC_CK + h * 64; Vb = P + rowbase * PW + PC_CV + h * 64; kpitch = PW; vpitch = PW; Qrow = P + (rowbase + tq) * PW + PC_CQ + h * 64; }
    else { const bf16_t* KV = WSP(const bf16_t, WS_KVM) + rowbase * 512 + h * 128; Kb = KV; Vb = KV + 64; kpitch = 512; vpitch = 512; Qrow = WSP(const bf16_t, WS_QM) + (rowbase + tq) * 512 + h * 96; }
    bf16x8 qf[NKS];
#pragma unroll
    for (int ks = 0; ks < NKS; ++ks) qf[ks] = *(const bf16x8*)(Qrow + ks * 16 + hi * 8);
    AState st; astate_init(st);
    lds_ptr lds = (lds_ptr)F.lds;
    const int vpo = ((lane >> 4) & 1) * 32 + (lane & 3) * 8 + (4 * hi + ((lane & 15) >> 2)) * 64;
    Stg s;
#define CU_LOAD(t) do { s.k = *(const u32x4*)(Kb + (size_t)((t) * 64 + lane) * kpitch + wid * 8); \
        if (!FOX) { if (wid < 4) s.k2 = *(const u32x4*)(Kr + (size_t)((t) * 64 + lane) * 32 + wid * 8); } \
        s.v = *(const u32x4*)(Vb + (size_t)((t) * 64 + 16 * (wid & 3) + (lane >> 2)) * vpitch + (wid >> 2) * 32 + (lane & 3) * 8); \
        if (FOX) { if (wid == 0) s.kb = kbsrc[(t) * 64 + lane]; } } while (0)
#define CU_WRITE(bi) do { lds_ptr bp = lds + (bi) * TB_SIZE; *(LAS u32x4*)(bp + wid * 1024 + lane * 16) = s.k; \
        if (!FOX) { if (wid < 4) *(LAS u32x4*)(bp + (8 + wid) * 1024 + lane * 16) = s.k2; } \
        *(LAS u32x4*)(bp + TB_V + wid * 1024 + lane * 16) = s.v; \
        if (FOX) { if (wid == 0) *(LAS float*)(bp + TB_KB + lane * 4) = s.kb; } } while (0)
    CU_LOAD(0); CU_WRITE(0);
    __syncthreads();
    const int tq_lo = q0 + wid * 32;
    for (int t = 0; t < NT; ++t) {
        const int bi = t & 1;
        if (t + 1 < NT) CU_LOAD(t + 1);
        if (64 * t <= tq_lo + 31) {
            lds_cptr bp = (lds_cptr)(lds + bi * TB_SIZE);
            f32x16 p0, p1;
#pragma unroll
            for (int r = 0; r < 16; ++r) { p0[r] = 0.f; p1[r] = 0.f; }
            qk64<NKS>(bp, qf, r32, hi, p0, p1);
            if (FOX) {
                const LAS float* kbt = (const LAS float*)(bp + TB_KB) + 4 * hi;
#pragma unroll
                for (int g = 0; g < 4; ++g) { const f32x4 a = *(const LAS f32x4*)(kbt + 8 * g), c = *(const LAS f32x4*)(kbt + 32 + 8 * g);
#pragma unroll
                    for (int e = 0; e < 4; ++e) { p0[4 * g + e] += a[e]; p1[4 * g + e] += c[e]; } }
            }
            if (64 * t + 63 > tq_lo) mask_causal(p0, p1, 64 * t, tq, hi);
            softmax_pv64(p0, p1, st, bp + TB_V + vpo, hi);
        }
        if (t + 1 < NT) CU_WRITE(bi ^ 1);
        __syncthreads();
    }
#undef CU_LOAD
#undef CU_WRITE
    bf16_t* orow = WSP(bf16_t, WS_OCAT) + (rowbase + tq) * OCW + (FOX ? 384 : 640) + h * 64;
    store_o_bf16(orow, st.o0, st.o1, 1.0f / st.l, hi);
}
__device__ __forceinline__ void nsa_unit(Frame& F, int b, int qblk) {
    int lane_o = F.lane; asm volatile("" : "+v"(lane_o));
    const int wid = F.wave, lane = lane_o, r32 = lane & 31, hi = lane >> 5, tid = wid * 64 + lane;
    const int h = wid & 3, qs = wid >> 2;
    const int q0 = qblk * 64, cur = qblk, tq = q0 + 32 * qs + r32, tq_lo = q0 + 32 * qs;
    const size_t rowbase = (size_t)b * SEQ, row = rowbase + tq;
    const bf16_t* P = WSP(const bf16_t, WS_P);
    lds_ptr lds = (lds_ptr)F.lds;
    const int vpo = ((lane >> 4) & 1) * 32 + (lane & 3) * 8 + (4 * hi + ((lane & 15) >> 2)) * 64;
    bf16x8 qf[4];
    { const bf16_t* Qrow = P + row * PW + PC_AQ + h * 64;
#pragma unroll
      for (int ks = 0; ks < 4; ++ks) qf[ks] = *(const bf16x8*)(Qrow + ks * 16 + hi * 8); }
    Stg s; int ln;
#define NS_LOAD(Kb, kp, Vb, vp_, t) do { s.k = *(const u32x4*)((Kb) + (size_t)((t) * 64 + ln) * (kp) + wid * 8); \
        s.v = *(const u32x4*)((Vb) + (size_t)((t) * 64 + 16 * (wid & 3) + (ln >> 2)) * (vp_) + (wid >> 2) * 32 + (ln & 3) * 8); } while (0)
#define NS_FRESH() do { ln = lane; asm volatile("" : "+v"(ln)); } while (0)
#define NS_WRITE(bi) do { lds_ptr bp_ = lds + (bi) * TB_SIZE; *(LAS u32x4*)(bp_ + wid * 1024 + lane * 16) = s.k; *(LAS u32x4*)(bp_ + TB_V + wid * 1024 + lane * 16) = s.v; } while (0)
    const bf16_t* KC = WSP(const bf16_t, WS_KC) + (size_t)b * 256 * 64; const bf16_t* VC = WSP(const bf16_t, WS_VC) + (size_t)b * 256 * 64;
    const int cmax_u = (q0 + 63 - 31) >> 4, NTc = (cmax_u >> 6) + 1;
    const int cmax = (tq - 31) >> 4;
    float cm = NEG_INF, cl = 0.f;
    NS_FRESH(); NS_LOAD(KC, 64, VC, 64, 0); NS_WRITE(0);
    __syncthreads();
    for (int t = 0; t < NTc; ++t) {
        const int bi = t & 1;
        if (t + 1 < NTc) NS_LOAD(KC, 64, VC, 64, t + 1);
        { lds_cptr bp = (lds_cptr)(lds + bi * TB_SIZE); f32x16 p0, p1;
#pragma unroll
          for (int r = 0; r < 16; ++r) { p0[r] = 0.f; p1[r] = 0.f; }
          qk64<4>(bp, qf, r32, hi, p0, p1);
          float mx = NEG_INF;
#pragma unroll
          for (int r = 0; r < 16; ++r) { const int c = 64 * t + crow(r, hi); if (c > cmax) p0[r] = NEG_INF; if (c + 32 > cmax) p1[r] = NEG_INF; mx = fmaxf(mx, fmaxf(p0[r], p1[r])); }
          mx = fmaxf(mx, other_half(mx, hi));
          const float mn = fmaxf(cm, mx), ms = (mn == NEG_INF) ? 0.f : mn; float rs = 0.f;
#pragma unroll
          for (int r = 0; r < 16; ++r) rs += fast_exp2(p0[r] - ms) + fast_exp2(p1[r] - ms);
          rs += other_half(rs, hi);
          cl = cl * fast_exp2(cm - ms) + rs; cm = mn; }
        if (t + 1 < NTc) NS_WRITE(bi ^ 1);
        __syncthreads();
    }
    const float cms = (cm == NEG_INF) ? 0.f : cm, cinv = 1.0f / fmaxf(cl, 1e-30f);
    f32x16 oc0, oc1;
#pragma unroll
    for (int r = 0; r < 16; ++r) { oc0[r] = 0.f; oc1[r] = 0.f; }
    float G[32]; float carry = 0.f;
#pragma unroll
    for (int i = 0; i < 32; ++i) G[i] = 0.f;
    NS_FRESH(); NS_LOAD(KC, 64, VC, 64, 0); NS_WRITE(0);
    __syncthreads();
#pragma unroll
    for (int t = 0; t < 4; ++t) {
        if (t < NTc) {
            const int bi = t & 1;
            if (t + 1 < NTc) NS_LOAD(KC, 64, VC, 64, t + 1);
            { lds_cptr bp = (lds_cptr)(lds + bi * TB_SIZE); f32x16 p0, p1;
#pragma unroll
              for (int r = 0; r < 16; ++r) { p0[r] = 0.f; p1[r] = 0.f; }
              qk64<4>(bp, qf, r32, hi, p0, p1);
#pragma unroll
              for (int r = 0; r < 16; ++r) { const int c = 64 * t + crow(r, hi);
                  p0[r] = (c > cmax) ? 0.f : fast_exp2(p0[r] - cms) * cinv; p1[r] = (c + 32 > cmax) ? 0.f : fast_exp2(p1[r] - cms) * cinv; }
#pragma unroll
              for (int g = 0; g < 4; ++g) { const float oth = other_half(p0[4 * g + 3], hi);
                  G[t * 8 + g] = ((p0[4 * g] + p0[4 * g + 1]) + (p0[4 * g + 2] + p0[4 * g + 3])) + (hi ? oth : carry); carry = oth; }
#pragma unroll
              for (int g = 0; g < 4; ++g) { const float oth = other_half(p1[4 * g + 3], hi);
                  G[t * 8 + 4 + g] = ((p1[4 * g] + p1[4 * g + 1]) + (p1[4 * g + 2] + p1[4 * g + 3])) + (hi ? oth : carry); carry = oth; }
              bf16x8 pf[4]; pack_p(p0, p1, pf);
              pv64(oc0, oc1, bp + TB_V + vpo, pf); }
            if (t + 1 < NTc) NS_WRITE(bi ^ 1);
            __syncthreads();
        }
    }
    { LAS float* slab = (LAS float*)(lds + NSA_SLAB) + (size_t)(h * 64 + 32 * qs + r32) * 65;
#pragma unroll
      for (int i = 0; i < 32; ++i) slab[2 * i + hi] = G[i]; }
    __syncthreads();
    { const int q = tid >> 3, jg = tid & 7;
      const LAS float* s0 = (const LAS float*)(lds + NSA_SLAB) + (size_t)q * 65;
      float v[64];
#pragma unroll
      for (int k = 0; k < 64; ++k) { const float x = (s0[k] + s0[64 * 65 + k]) + (s0[2 * 64 * 65 + k] + s0[3 * 64 * 65 + k]);
          v[k] = (k == 0 || k == cur || k == cur - 1) ? 1e9f : ((k > cur) ? -1e9f : x); if ((k & 7) == 7) asm volatile("" ::: "memory"); }
      unsigned bits = 0u;
#pragma unroll
      for (int e = 0; e < 8; ++e) { const int j = 8 * jg + e;
          const float xj = (s0[j] + s0[64 * 65 + j]) + (s0[2 * 64 * 65 + j] + s0[3 * 64 * 65 + j]);
          const float vj = (j == 0 || j == cur || j == cur - 1) ? 1e9f : ((j > cur) ? -1e9f : xj);
          int rank = 0;
#pragma unroll
          for (int k = 0; k < 64; ++k) rank += (v[k] > vj || (v[k] == vj && k < j)) ? 1 : 0;
          bits |= (rank < 16 ? 1u : 0u) << e; }
      *((LAS unsigned char*)(lds + NSA_SEL) + q * 8 + jg) = (unsigned char)bits; }
    __syncthreads();
    const unsigned mlo = *(const LAS unsigned*)(lds + NSA_SEL + (32 * qs + r32) * 8), mhi = *(const LAS unsigned*)(lds + NSA_SEL + (32 * qs + r32) * 8 + 4);
    { const u32x4* src = WSP(const u32x4, WS_NSATAB); LAS u32x4* dst = (LAS u32x4*)(lds + NSA_SLAB);
      for (int i = tid; i < 4 * NSA_TL / 4; i += 512) dst[i] = src[i]; }
    const LAS float* tabh = (const LAS float*)(lds + NSA_SLAB) + h * NSA_TL;
    const float farb = WSP(const float, WS_FARB)[h];
    float g0, g1, g2;
    { int tq_ = tq; asm volatile("" : "+v"(tq_)); const float* sd = WSP(const float, WS_SIDE) + (rowbase + tq_) * 16 + h * 3; g0 = sigmoid_f(sd[0]); g1 = sigmoid_f(sd[1]); g2 = sigmoid_f(sd[2]); }
    AState st; astate_init(st);
    { const bf16_t* Kb = P + rowbase * PW + PC_KSLC; const bf16_t* Vb = P + rowbase * PW + PC_VSLC;
      NS_FRESH(); NS_LOAD(Kb, PW, Vb, PW, 0); NS_WRITE(0);
      __syncthreads();
      for (int j = 0; j <= cur; ++j) {
          const int bi = j & 1;
          if (j < cur) NS_LOAD(Kb, PW, Vb, PW, j + 1);
          const bool mine = ((j < 32) ? (mlo >> j) : (mhi >> (j - 32))) & 1u;
          if (__any(mine)) {
              lds_cptr bp = (lds_cptr)(lds + bi * TB_SIZE); f32x16 p0, p1;
#pragma unroll
              for (int r = 0; r < 16; ++r) { p0[r] = 0.f; p1[r] = 0.f; }
              qk64<4>(bp, qf, r32, hi, p0, p1);
              if (q0 - 64 * j - 63 >= NSA_DFAR) {
#pragma unroll
                  for (int r = 0; r < 16; ++r) { p0[r] += farb; p1[r] += farb; }
              } else add_table(p0, p1, tabh + (NSA_DMAX - tq + 64 * j + 4 * hi));
              if (j == cur) mask_causal(p0, p1, 64 * j, tq, hi);
              if (!mine) {
#pragma unroll
                  for (int r = 0; r < 16; ++r) { p0[r] = NEG_INF; p1[r] = NEG_INF; } }
              softmax_pv64(p0, p1, st, bp + TB_V + vpo, hi);
          }
          if (j < cur) NS_WRITE(bi ^ 1);
          __syncthreads();
      } }
    f32x16 oa0, oa1;
    { const float sc = g1 / st.l;
#pragma unroll
      for (int r = 0; r < 16; ++r) { oa0[r] = g0 * oc0[r] + sc * st.o0[r]; oa1[r] = g0 * oc1[r] + sc * st.o1[r]; } }
    astate_init(st);
    { const bf16_t* Kb = P + rowbase * PW + PC_KWIN; const bf16_t* Vb = P + rowbase * PW + PC_VWIN;
      const int jlo = cur >= 8 ? cur - 8 : 0;
      NS_FRESH(); NS_LOAD(Kb, PW, Vb, PW, jlo); NS_WRITE(0);
      __syncthreads();
      for (int j = jlo; j <= cur; ++j) {
          const int bi = (j - jlo) & 1;
          if (j < cur) NS_LOAD(Kb, PW, Vb, PW, j + 1);
          if (tq_lo - 64 * j - 63 < 512) {
              lds_cptr bp = (lds_cptr)(lds + bi * TB_SIZE); f32x16 p0, p1;
#pragma unroll
              for (int r = 0; r < 16; ++r) { p0[r] = 0.f; p1[r] = 0.f; }
              qk64<4>(bp, qf, r32, hi, p0, p1);
              add_table(p0, p1, tabh + (NSA_DMAX - tq + 64 * j + 4 * hi));
              if (!(tq_lo - 64 * j - 63 >= 0 && tq_lo + 31 - 64 * j < 512)) {
                  const int d0 = tq - 64 * j - 4 * hi;
#pragma unroll
                  for (int r = 0; r < 16; ++r) { const int d = d0 - ((r & 3) + 8 * (r >> 2)); if (d < 0 || d >= 512) p0[r] = NEG_INF; if (d - 32 < 0 || d - 32 >= 512) p1[r] = NEG_INF; }
              }
              softmax_pv64(p0, p1, st, bp + TB_V + vpo, hi);
          }
          if (j < cur) NS_WRITE(bi ^ 1);
          __syncthreads();
      } }
    { const float sc = g2 / st.l;
#pragma unroll
      for (int r = 0; r < 16; ++r) { oa0[r] += sc * st.o0[r]; oa1[r] += sc * st.o1[r]; } }
    { int tq_ = tq; asm volatile("" : "+v"(tq_)); store_o_bf16(WSP(bf16_t, WS_OCAT) + (rowbase + tq_) * OCW + h * 64, oa0, oa1, 1.0f, hi); }
#undef NS_LOAD
#undef NS_FRESH
#undef NS_WRITE
}
__device__ __forceinline__ void dil_unit(Frame& F, int b, int hh, int span) {
    int lane_o = F.lane; asm volatile("" : "+v"(lane_o));
    const int wid = F.wave, lane = lane_o, r32 = lane & 31, hi = lane >> 5, tid = wid * 64 + lane;
    const int T0 = span * 512;
    const size_t rowbase = (size_t)b * SEQ;
    const bf16_t* P = WSP(const bf16_t, WS_P) + rowbase * PW;
    lds_ptr lds = (lds_ptr)F.lds;
    LAS float* dtab = (LAS float*)(lds + 32768);
    for (int i = tid; i < 3 * 192; i += 512) dtab[i] = WSP(const float, WS_DILTAB)[((i / 192) * 2 + hh) * 192 + (i % 192)];
    __syncthreads();
    lds_ptr vst = lds + wid * 4096;
    const int vpo = ((lane >> 4) & 1) * 32 + (lane & 3) * 8 + (4 * hi + ((lane & 15) >> 2)) * 64;
    bf16_t* DOG = WSP(bf16_t, WS_DOG); float* DLSE = WSP(float, WS_DLSE);
    for (int g = 0; g < 3; ++g) {
        const int sh = 2 * g, head = 2 * g + hh;
        for (int rep = 0; rep < 2; ++rep) {
            const int wt = wid + 8 * rep;
            const int res = (g == 0) ? 0 : (g == 1 ? (wt & 3) : wt);
            const int i0 = (g == 0) ? 32 * wt : (g == 1 ? 32 * (wt >> 2) : 0);
            const int n0 = (T0 >> sh) + i0;
            const int tokq = res + ((n0 + r32) << sh);
            bf16x8 qf[4];
            { const bf16_t* Qrow = P + (size_t)tokq * PW + PC_BQ + head * 64;
#pragma unroll
              for (int ks = 0; ks < 4; ++ks) qf[ks] = *(const bf16x8*)(Qrow + ks * 16 + hi * 8); }
            f32x16 o0, o1; float m = NEG_INF, l = 0.f;
#pragma unroll
            for (int r = 0; r < 16; ++r) { o0[r] = 0.f; o1[r] = 0.f; }
            for (int c = 0; c < 5; ++c) {
                const int nk0 = n0 - 128 + 32 * c;
                if (nk0 + 31 < 0) continue;
                { int nk = nk0 + r32; nk = nk < 0 ? 0 : nk; const bf16_t* Krow = P + (size_t)(res + (nk << sh)) * PW + PC_BK + head * 64;
                  bf16x8 kf[4];
#pragma unroll
                  for (int ks = 0; ks < 4; ++ks) kf[ks] = *(const bf16x8*)(Krow + ks * 16 + hi * 8);
                  u32x4 vr[4];
#pragma unroll
                  for (int i = 0; i < 4; ++i) { const int pc = lane + 64 * i, vrow = pc >> 3, c16 = pc & 7; int nv = nk0 + vrow; nv = nv < 0 ? 0 : nv;
                      vr[i] = *(const u32x4*)(P + (size_t)(res + (nv << sh)) * PW + PC_BV + head * 64 + c16 * 8); }
#pragma unroll
                  for (int i = 0; i < 4; ++i) { const int pc = lane + 64 * i, vrow = pc >> 3, c16 = pc & 7;
                      *(LAS u32x4*)(vst + (c16 >> 2) * 2048 + vrow * 64 + (c16 & 3) * 16) = vr[i]; }
                  asm volatile("s_waitcnt lgkmcnt(0)" ::: "memory");
                  f32x16 p;
#pragma unroll
                  for (int r = 0; r < 16; ++r) p[r] = 0.f;
#pragma unroll
                  for (int ks = 0; ks < 4; ++ks) p = MFMA32(kf[ks], qf[ks], p);
                  const LAS float* tb = dtab + g * 192 + (32 - r32 + 4 * hi + 32 * c);
                  float mx = NEG_INF;
#pragma unroll
                  for (int r = 0; r < 16; ++r) { const int o = (r & 3) + 8 * (r >> 2), kk = o + 4 * hi, j = 128 + r32 - 32 * c - kk;
                      const bool ok = (j >= 0) && (j <= 128) && (nk0 + kk >= 0);
                      p[r] = ok ? p[r] + tb[o] : NEG_INF; mx = fmaxf(mx, p[r]); }
                  mx = fmaxf(mx, other_half(mx, hi));
                  const float mn = fmaxf(m, mx), ms = (mn == NEG_INF) ? 0.f : mn, alpha = fast_exp2(m - ms);
                  float rs = 0.f;
#pragma unroll
                  for (int r = 0; r < 16; ++r) { p[r] = fast_exp2(p[r] - ms); rs += p[r]; }
                  rs += other_half(rs, hi);
                  l = l * alpha + rs; m = mn;
#pragma unroll
                  for (int r = 0; r < 16; ++r) { o0[r] *= alpha; o1[r] *= alpha; }
                  u32x4 w0, w1;
                  w0.x = cvtpk(p[0], p[1]); w0.y = cvtpk(p[2], p[3]); w0.z = cvtpk(p[4], p[5]); w0.w = cvtpk(p[6], p[7]);
                  w1.x = cvtpk(p[8], p[9]); w1.y = cvtpk(p[10], p[11]); w1.z = cvtpk(p[12], p[13]); w1.w = cvtpk(p[14], p[15]);
                  const bf16x8 pf0 = __builtin_bit_cast(bf16x8, w0), pf1 = __builtin_bit_cast(bf16x8, w1);
                  lds_cptr vp = (lds_cptr)(vst + vpo);
#pragma unroll
                  for (int ks = 0; ks < 2; ++ks) {
                      const s16x4 l0 = vtr(vp + ks * 1024), h0 = vtr(vp + ks * 1024 + 512), l1 = vtr(vp + 2048 + ks * 1024), h1 = vtr(vp + 2048 + ks * 1024 + 512);
                      const bf16x8 v0 = (bf16x8){l0[0], l0[1], l0[2], l0[3], h0[0], h0[1], h0[2], h0[3]}, v1 = (bf16x8){l1[0], l1[1], l1[2], l1[3], h1[0], h1[1], h1[2], h1[3]};
                      o0 = MFMA32(v0, ks == 0 ? pf0 : pf1, o0); o1 = MFMA32(v1, ks == 0 ? pf0 : pf1, o1);
                  }
                  asm volatile("s_waitcnt lgkmcnt(0)" ::: "memory"); }
            }
            const size_t orow = rowbase + tokq;
            store_o_bf16(DOG + ((size_t)g * M + orow) * 128 + hh * 64, o0, o1, 1.0f / l, hi);
            if (hi == 0) DLSE[((size_t)g * M + orow) * 2 + hh] = m + log2f(l);
        }
    }
    VM_WAIT();
    __syncthreads();
    bf16_t* OC = WSP(bf16_t, WS_OCAT);
    for (int it = 0; it < 8; ++it) {
        const int item = tid + 512 * it, tl = item >> 3, pc = item & 7; const size_t orow = rowbase + T0 + tl;
        const float l0 = DLSE[((size_t)0 * M + orow) * 2 + hh], l1 = DLSE[((size_t)1 * M + orow) * 2 + hh], l2 = DLSE[((size_t)2 * M + orow) * 2 + hh];
        const float mx = fmaxf(l0, fmaxf(l1, l2)); float w0 = fast_exp2(l0 - mx), w1 = fast_exp2(l1 - mx), w2 = fast_exp2(l2 - mx);
        const float inv = 1.0f / (w0 + w1 + w2); w0 *= inv; w1 *= inv; w2 *= inv;
        const u32x4 a = *(const u32x4*)(DOG + ((size_t)0 * M + orow) * 128 + hh * 64 + pc * 8), bb = *(const u32x4*)(DOG + ((size_t)1 * M + orow) * 128 + hh * 64 + pc * 8),
                    cc = *(const u32x4*)(DOG + ((size_t)2 * M + orow) * 128 + hh * 64 + pc * 8);
        u32x4 w;
#pragma unroll
        for (int e = 0; e < 4; ++e) {
            const float lo = w0 * __uint_as_float(a[e] << 16) + w1 * __uint_as_float(bb[e] << 16) + w2 * __uint_as_float(cc[e] << 16);
            const float hv = w0 * __uint_as_float(a[e] & 0xffff0000u) + w1 * __uint_as_float(bb[e] & 0xffff0000u) + w2 * __uint_as_float(cc[e] & 0xffff0000u);
            w[e] = cvtpk(lo, hv); }
        *(u32x4*)(OC + orow * OCW + 256 + hh * 64 + pc * 8) = w;
    }
    __syncthreads();
}
__device__ __forceinline__ float wave_sum(float v) {
    v += xor_lane_lt32<1>(v); v += xor_lane_lt32<2>(v); v += xor_lane_lt32<4>(v); v += xor_lane_lt32<8>(v); v += xor_lane_lt32<16>(v);
    return sum_halves(v);
}
__device__ __forceinline__ int rel_bucket(int dist) {
    if (dist < 0) dist = 0;
    if (dist < 16) return dist;
    const int thr[15] = {22, 30, 40, 54, 73, 99, 134, 182, 246, 332, 450, 609, 825, 1117, 1513};
    int bkt = 16;
#pragma unroll
    for (int i = 0; i < 15; ++i) bkt += (dist >= thr[i]) ? 1 : 0;
    return bkt;
}
__device__ __forceinline__ int inproj_src(int c, float& sc) {
    sc = 1.f;
    if (c < 256) { sc = C2A; return c; }
    if (c < 652) return c;
    if (c < 656) return 2572 + (c - 652);
    if (c < 672) return -1;
    if (c < 704) { const int p = c - 672; return 2960 + (p >> 1) + 16 * (p & 1); }
    if (c < 768) return -1;
    if (c < 1920) { const int r = c - 768; if (r < 384) sc = C2A; return 652 + r; }
    if (c < 2048) return 2832 + (c - 1920);
    if (c < 2816) { const int r = c - 2048; if (r < 256) sc = C2A; return 1804 + r; }
    return 2576 + (c - 2816);
}
__device__ __forceinline__ int quq_src(int r, float& sc) {
    sc = C2D;
    if (r >= 384) return -1;
    const int hd = r / 96, w = r % 96;
    if (w < 64) return hd * 96 + w;
    const int p = w - 64; return hd * 96 + 64 + (p >> 1) + 16 * (p & 1);
}
__device__ __forceinline__ int gateperm_src(int r) {
    const int T = r >> 8, c = r & 255, pn = T >> 2, j = T & 3, bj = c >> 7, wc = (c >> 5) & 3, fq = (c >> 3) & 3, n = (c >> 2) & 1, e = c & 3;
    return (2 * bj + n) * DM * DM + 256 * pn + 64 * j + 16 * wc + 4 * fq + e;
}
__device__ __forceinline__ int branchperm_src(int r) {
    const int pn = r >> 8, c = r & 255, bj = c >> 7, wc = (c >> 5) & 3, fq = (c >> 3) & 3, n = (c >> 2) & 1, e = c & 3;
    return 256 * pn + 64 * (2 * bj + n) + 16 * wc + 4 * fq + e;
}
__device__ __forceinline__ void wconv_item(const float* W, int Nsrc, bf16_t* WT, int ldt, const float* kgain, int kind, LAS float* scr, int item, int nblk, int lane) {
    const int kb = item / nblk, nb = item % nblk, k0 = 64 * kb, n0 = 32 * nb;
    const int n = n0 + (lane & 31); float sc = 1.f; int src = n;
    if (kind == 1) src = inproj_src(n, sc); else if (kind == 2) src = quq_src(n, sc); else if (kind == 3) src = gateperm_src(n); else if (kind == 4) src = branchperm_src(n);
#pragma unroll 8
    for (int i = 0; i < 32; ++i) { const int kk = 2 * i + (lane >> 5); float v = (src >= 0) ? W[(size_t)(k0 + kk) * Nsrc + src] * sc : 0.f; if (kgain) v *= kgain[k0 + kk]; scr[kk * 33 + (lane & 31)] = v; }
    LDS_WAIT(); asm volatile("" ::: "memory");
    const int c = lane & 7;
#pragma unroll
    for (int j = 0; j < 4; ++j) { const int nn = (lane >> 3) + 8 * j; const LAS float* s = scr + (8 * c) * 33 + nn;
        u32x4 o; o.x = pk2(s[0 * 33], s[1 * 33]); o.y = pk2(s[2 * 33], s[3 * 33]); o.z = pk2(s[4 * 33], s[5 * 33]); o.w = pk2(s[6 * 33], s[7 * 33]);
        *(u32x4*)(WT + (size_t)(n0 + nn) * ldt + k0 + 8 * c) = o; }
    LDS_WAIT(); asm volatile("" ::: "memory");
}
__device__ __forceinline__ void p0_prologue(Frame& F) {
    LAS float* scr = (LAS float*)(F.lds + F.wave * 16384);
    const int gw = blockIdx.x * 8 + F.wave, NGW = F.G * 8, lane = F.lane;
    constexpr int I_IN = 16 * 96, I_G = 16 * 32, I_BA = 4 * 32, I_BB = 2 * 32, I_O = 16 * 32, I_UP = 16 * 176, I_DN = 44 * 32, I_UQ = 4 * 16, I_UKV = 2 * 16, I_PHI = 32 * 4;
    constexpr int I_L = I_IN + 4 * I_G + 3 * I_BA + I_BB + I_O + I_UP + I_DN + I_UQ + I_UKV + 2 * I_PHI;
    for (int it = gw; it < DEPTH * I_L; it += NGW) {
        const int l = it / I_L; int r = it % I_L;
        unsigned char* wl = F.ws + WS_WT + (size_t)l * LW;
        if (r < I_IN) { wconv_item(F.in[6] + (size_t)l * DM * DIN, DIN, (bf16_t*)(wl + LW_IN), DM, nullptr, 1, scr, r, 96, lane); continue; } r -= I_IN;
        if (r < 4 * I_G) { wconv_item(F.in[21] + (size_t)l * 4 * DM * DM, DM, (bf16_t*)(wl + LW_G), DM, nullptr, 3, scr, r, 128, lane); continue; } r -= 4 * I_G;
        if (r < I_BA) { wconv_item(F.in[17] + (size_t)l * 256 * DM, DM, (bf16_t*)(wl + LW_BR + BR_A), 256, nullptr, 4, scr, r, 32, lane); continue; } r -= I_BA;
        if (r < I_BB) { wconv_item(F.in[18] + (size_t)l * 128 * DM, DM, (bf16_t*)(wl + LW_BR + BR_B), 128, nullptr, 4, scr, r, 32, lane); continue; } r -= I_BB;
        if (r < I_BA) { wconv_item(F.in[19] + (size_t)l * 256 * DM, DM, (bf16_t*)(wl + LW_BR + BR_C), 256, nullptr, 4, scr, r, 32, lane); continue; } r -= I_BA;
        if (r < I_BA) { wconv_item(F.in[20] + (size_t)l * 256 * DM, DM, (bf16_t*)(wl + LW_BR + BR_D), 256, nullptr, 4, scr, r, 32, lane); continue; } r -= I_BA;
        if (r < I_O) { wconv_item(F.in[22] + (size_t)l * DM * DM, DM, (bf16_t*)(wl + LW_O), DM, nullptr, 0, scr, r, 32, lane); continue; } r -= I_O;
        if (r < I_UP) { wconv_item(F.in[23] + (size_t)l * DM * DFF2, DFF2, (bf16_t*)(wl + LW_UP), DM, nullptr, 0, scr, r, 176, lane); continue; } r -= I_UP;
        if (r < I_DN) { wconv_item(F.in[26] + (size_t)l * DFF * DM, DM, (bf16_t*)(wl + LW_DN), DFF, nullptr, 0, scr, r, 32, lane); continue; } r -= I_DN;
        if (r < I_UQ) { wconv_item(F.in[15] + (size_t)l * 256 * 384, 384, (bf16_t*)(wl + LW_UQ), 256, F.in[13] + l * 256, 2, scr, r, 16, lane); continue; } r -= I_UQ;
        if (r < I_UKV) { wconv_item(F.in[16] + (size_t)l * 128 * 512, 512, (bf16_t*)(wl + LW_UKV), 128, F.in[14] + l * 128, 0, scr, r, 16, lane); continue; } r -= I_UKV;
        if (r < I_PHI) { wconv_item(F.in[8] + (size_t)l * 2048 * 128, 128, (bf16_t*)(wl + LW_PHI), 2048, nullptr, 0, scr, r, 4, lane); continue; } r -= I_PHI;
        wconv_item(F.in[10] + (size_t)l * 2048 * 128, 128, (bf16_t*)(wl + LW_PHI) + (size_t)128 * 2048, 2048, nullptr, 0, scr, r, 4, lane);
    }
    const int gt = blockIdx.x * 512 + F.tid, NGT = F.G * 512;
    const float* rel = F.in[1];
    float* rope = WSP(float, WS_ROPE);
    for (int i = gt; i < SEQ * 16; i += NGT) { const int t = i >> 4, k = i & 15; const float inv = powf(10000.0f, -(float)(2 * k) / 32.0f); const float ang = (float)t * inv;
        float sn, cs; sincosf(ang, &sn, &cs); rope[2 * i] = cs; rope[2 * i + 1] = sn; }
    float* ntab = WSP(float, WS_NSATAB);
    for (int i = gt; i < 4 * NSA_TL; i += NGT) { const int hd = i / NSA_TL, k = i % NSA_TL, dist = NSA_DMAX - k; ntab[i] = dist >= 0 ? rel[rel_bucket(dist) * 10 + hd] * LOG2E : 0.f; }
    float* dtab = WSP(float, WS_DILTAB);
    for (int i = gt; i < 6 * 192; i += NGT) { const int gh = i / 192, k = i % 192, g = gh >> 1, hh = gh & 1, j = 160 - k; dtab[i] = (j >= 0 && j <= 128) ? rel[rel_bucket(j << (2 * g)) * 10 + 4 + 2 * g + hh] * LOG2E : 0.f; }
    if (gt < 4) WSP(float, WS_FARB)[gt] = rel[31 * 10 + gt] * LOG2E;
    for (int i = gt; i < DEPTH * 256; i += NGT) { const int l = i >> 8, n = i & 255; const float* w1 = (n < 128 ? F.in[8] : F.in[10]) + (size_t)l * 2048 * 128 + (n & 127); const float* cp = F.in[7] + (size_t)l * 2048;
        float a = 0.f; for (int p = 0; p < 2048; ++p) a += cp[p] * w1[(size_t)p * 128]; WSP(float, WS_CMPB)[i] = a; }
}

template <int MODE> __device__ __forceinline__ void rowpass(Frame& F, const float* x, const float* y, size_t yrow0, float* xout, bf16_t* hout, const float* g1, const float* g2, int row_lo, int row_hi) {
    const int gw = blockIdx.x * 8 + F.wave, NGW = F.G * 8, lane = F.lane;
    f32x4 ga[4], gb[4];
#pragma unroll
    for (int j = 0; j < 4; ++j) { ga[j] = *(const f32x4*)(g1 + 4 * lane + 256 * j); if (MODE == 1) gb[j] = *(const f32x4*)(g2 + 4 * lane + 256 * j); }
    for (int m = row_lo + gw; m < row_hi; m += NGW) {
        f32x4 v[4];
        const f32x4* xr = (const f32x4*)(x + (size_t)m * DM) + lane;
#pragma unroll
        for (int j = 0; j < 4; ++j) v[j] = xr[64 * j];
        if (MODE != 0) {
            const f32x4* yr = (const f32x4*)(y + ((size_t)m - yrow0) * DM) + lane; f32x4 w[4]; float s = 0.f;
#pragma unroll
            for (int j = 0; j < 4; ++j) { w[j] = yr[64 * j]; s += (w[j][0] * w[j][0] + w[j][1] * w[j][1]) + (w[j][2] * w[j][2] + w[j][3] * w[j][3]); }
            const float rstd = 1.0f / sqrtf(wave_sum(s) * (1.0f / DM) + RMS_EPS);
            f32x4* xo = (f32x4*)(xout + (size_t)m * DM) + lane;
#pragma unroll
            for (int j = 0; j < 4; ++j) { v[j] = v[j] + w[j] * rstd * ga[j]; xo[64 * j] = v[j]; }
        }
        if (MODE != 2) {
            float s = 0.f;
#pragma unroll
            for (int j = 0; j < 4; ++j) s += (v[j][0] * v[j][0] + v[j][1] * v[j][1]) + (v[j][2] * v[j][2] + v[j][3] * v[j][3]);
            const float rstd = 1.0f / sqrtf(wave_sum(s) * (1.0f / DM) + RMS_EPS);
            u32x2* ho = (u32x2*)(hout + (size_t)m * DM) + lane;
#pragma unroll
            for (int j = 0; j < 4; ++j) { const f32x4 gg = (MODE == 1) ? gb[j] : ga[j]; const f32x4 o = v[j] * rstd * gg; u32x2 w; w.x = cvtpk(o[0], o[1]); w.y = cvtpk(o[2], o[3]); ho[64 * j] = w; }
        }
    }
}

__device__ __forceinline__ void conv_pass(Frame& F, const bf16_t* U, bf16_t* ACT, const float* cw  , const float* cb  ) {
    constexpr int NCG = DFF / 8, STRIP = 32, NSTRIP = (M / 2) / STRIP;
    const int gt = blockIdx.x * 512 + F.tid, NGT = F.G * 512;
    for (int item = gt; item < NCG * NSTRIP; item += NGT) {
        const int cg = item % NCG, strip = item / NCG, c0 = cg * 8, r0 = strip * STRIP;
        float wg[3][8], wv[3][8], bg[8], bv[8];
#pragma unroll
        for (int e = 0; e < 8; ++e) { bg[e] = cb[c0 + e]; bv[e] = cb[DFF + c0 + e];
#pragma unroll
            for (int j = 0; j < 3; ++j) { wg[j][e] = cw[j * DFF2 + c0 + e]; wv[j][e] = cw[j * DFF2 + DFF + c0 + e]; } }
        float g2[8], g1[8], v2[8], v1[8];
        const bool first = ((r0 & (SEQ - 1)) == 0);
#pragma unroll
        for (int e = 0; e < 8; ++e) { g2[e] = 0.f; g1[e] = 0.f; v2[e] = 0.f; v1[e] = 0.f; }
        if (!first) {
            const u32x4 a2 = *(const u32x4*)(U + (size_t)(r0 - 2) * DFF2 + c0), a1 = *(const u32x4*)(U + (size_t)(r0 - 1) * DFF2 + c0);
            const u32x4 b2 = *(const u32x4*)(U + (size_t)(r0 - 2) * DFF2 + DFF + c0), b1 = *(const u32x4*)(U + (size_t)(r0 - 1) * DFF2 + DFF + c0);
#pragma unroll
            for (int e = 0; e < 4; ++e) { g2[2 * e] = __uint_as_float(a2[e] << 16); g2[2 * e + 1] = __uint_as_float(a2[e] & 0xffff0000u);
                g1[2 * e] = __uint_as_float(a1[e] << 16); g1[2 * e + 1] = __uint_as_float(a1[e] & 0xffff0000u);
                v2[2 * e] = __uint_as_float(b2[e] << 16); v2[2 * e + 1] = __uint_as_float(b2[e] & 0xffff0000u);
                v1[2 * e] = __uint_as_float(b1[e] << 16); v1[2 * e + 1] = __uint_as_float(b1[e] & 0xffff0000u); }
        }
        for (int r = 0; r < STRIP; ++r) {
            const u32x4 a0 = *(const u32x4*)(U + (size_t)(r0 + r) * DFF2 + c0), b0 = *(const u32x4*)(U + (size_t)(r0 + r) * DFF2 + DFF + c0);
            float g0[8], v0[8]; u32x4 w;
#pragma unroll
            for (int e = 0; e < 4; ++e) { g0[2 * e] = __uint_as_float(a0[e] << 16); g0[2 * e + 1] = __uint_as_float(a0[e] & 0xffff0000u);
                v0[2 * e] = __uint_as_float(b0[e] << 16); v0[2 * e + 1] = __uint_as_float(b0[e] & 0xffff0000u); }
            float o[8];
#pragma unroll
            for (int e = 0; e < 8; ++e) { const float gt_ = bg[e] + wg[0][e] * g2[e] + wg[1][e] * g1[e] + wg[2][e] * g0[e], vl = bv[e] + wv[0][e] * v2[e] + wv[1][e] * v1[e] + wv[2][e] * v0[e];
                o[e] = gt_ * sigmoid_f(gt_) * vl; g2[e] = g1[e]; g1[e] = g0[e]; v2[e] = v1[e]; v1[e] = v0[e]; }
#pragma unroll
            for (int e = 0; e < 4; ++e) w[e] = cvtpk(o[2 * e], o[2 * e + 1]);
            *(u32x4*)(ACT + (size_t)(r0 + r) * DFF + c0) = w;
        }
    }
}
#ifdef SELFCHECK
constexpr int CW_CHK = 20480;
__device__ __forceinline__ unsigned chk_hash(unsigned x) { x ^= x >> 16; x *= 0x7feb352du; x ^= x >> 15; x *= 0x846ca68bu; x ^= x >> 16; return x; }
__device__ __forceinline__ int chk_t(int i) {
    int r = 0;
    switch (i & 31) { case 0: r = 0; break; case 1: r = 1; break; case 2: r = 15; break; case 3: r = 16; break; case 4: r = 30; break; case 5: r = 31; break; case 6: r = 32; break; case 7: r = 47; break;
        case 8: r = 63; break; case 9: r = 64; break; case 10: r = 65; break; case 11: r = 127; break; case 12: r = 128; break; case 13: r = 129; break; case 14: r = 255; break; case 15: r = 256; break;
        case 16: r = 257; break; case 17: r = 511; break; case 18: r = 512; break; case 19: r = 513; break; case 20: r = 575; break; case 21: r = 1023; break; case 22: r = 1024; break; case 23: r = 1599; break;
        case 24: r = 1600; break; case 25: r = 2047; break; case 26: r = 2048; break; case 27: r = 2111; break; case 28: r = 3000; break; case 29: r = 4031; break; case 30: r = 4032; break; default: r = 4095; break; }
    return (i < 64) ? r : (int)(chk_hash(i * 7919u + 13u) & 4095u);
}
__device__ __forceinline__ bool chk_bad(float got, float ref, float scale) { const float d = fabsf(got - ref); return !(d <= 0.02f * fabsf(ref) + 0.02f * scale); }
__device__ __forceinline__ float bfr(float x) { return bf2f((unsigned short)f2bf(x)); }
__device__ __forceinline__ void chk_flag(Frame& F, int bit, bool bad, int allow) {
    LAS unsigned* cnt = (LAS unsigned*)(F.lds + 65536);
    __syncthreads(); if (threadIdx.x == 0) *cnt = 0u; __syncthreads();
    if (bad) atomicAdd((unsigned*)cnt, 1u);
    __syncthreads();
    if (threadIdx.x == 0 && *cnt > (unsigned)allow) atomicOr((unsigned*)(F.ctl + CW_CHK), 1u << bit);
    __syncthreads();
}
__device__ __forceinline__ int chk_bucket_ref(int dist) {
    if (dist < 0) dist = 0; if (dist < 16) return dist;
    const float d = (float)dist; int large = 16 + (int)(logf(d / 16.0f) / 4.852030263919617f * 16.0f); return large < 31 ? large : 31;
}
__device__ __forceinline__ bool chk_fox(Frame& F, int b, int h, int t) {
    const bf16_t* P = WSP(const bf16_t, WS_P);
    { const size_t row = (size_t)b * SEQ + t; const bf16_t* q = P + row * PW + PC_CQ + h * 64; const float* kb = WSP(const float, WS_KB) + ((size_t)b * 4 + h) * SEQ;
      float m = -INFINITY; for (int j = 0; j <= t; ++j) { const bf16_t* k = P + ((size_t)b * SEQ + j) * PW + PC_CK + h * 64; float s = 0.f; for (int d = 0; d < 64; ++d) s += bf2f(q[d]) * bf2f(k[d]); s += kb[j]; m = fmaxf(m, s); }
      float lsum = 0.f, dummy0_ = 0.f; f32x4 o = {0.f, 0.f, 0.f, 0.f};
      for (int j = 0; j <= t; ++j) { const bf16_t* k = P + ((size_t)b * SEQ + j) * PW + PC_CK + h * 64; const bf16_t* v = P + ((size_t)b * SEQ + j) * PW + PC_CV + h * 64; float s = 0.f; for (int d = 0; d < 64; ++d) s += bf2f(q[d]) * bf2f(k[d]); s += kb[j];
          const float p = exp2f(s - m); lsum += p; _Pragma("unroll") for (int e = 0; e < 4; ++e) o[e] += p * bf2f(v[21 * e]); }
      bool bad = false; _Pragma("unroll") for (int e = 0; e < 4; ++e) bad |= chk_bad(bf2f(WSP(const bf16_t, WS_OCAT)[row * OCW + 384 + h * 64 + 21 * e]), o[e] / lsum, 0.5f);
      return bad; }
}
__device__ __forceinline__ bool chk_dil(Frame& F, int b, int hh, int t) {
    const bf16_t* P = WSP(const bf16_t, WS_P); const float* rel = F.in[1];
    { const size_t row = (size_t)b * SEQ + t;
      float m = -INFINITY;
      for (int g = 0; g < 3; ++g) { const int dil = 1 << (2 * g), head = 2 * g + hh; const bf16_t* q = P + row * PW + PC_BQ + head * 64;
          for (int j = 0; j <= 128; ++j) { const int idx = t - dil * j; if (idx < 0) break; const bf16_t* k = P + ((size_t)b * SEQ + idx) * PW + PC_BK + head * 64; float s = 0.f; for (int d = 0; d < 64; ++d) s += bf2f(q[d]) * bf2f(k[d]);
              s += rel[chk_bucket_ref(dil * j) * 10 + 4 + head] * LOG2E; m = fmaxf(m, s); } }
      float lsum = 0.f, dummy0_ = 0.f; f32x4 o = {0.f, 0.f, 0.f, 0.f};
      for (int g = 0; g < 3; ++g) { const int dil = 1 << (2 * g), head = 2 * g + hh; const bf16_t* q = P + row * PW + PC_BQ + head * 64;
          for (int j = 0; j <= 128; ++j) { const int idx = t - dil * j; if (idx < 0) break; const bf16_t* k = P + ((size_t)b * SEQ + idx) * PW + PC_BK + head * 64; const bf16_t* v = P + ((size_t)b * SEQ + idx) * PW + PC_BV + head * 64; float s = 0.f; for (int d = 0; d < 64; ++d) s += bf2f(q[d]) * bf2f(k[d]);
              s += rel[chk_bucket_ref(dil * j) * 10 + 4 + head] * LOG2E; const float p = exp2f(s - m); lsum += p; _Pragma("unroll") for (int e = 0; e < 4; ++e) o[e] += p * bf2f(v[21 * e]); } }
      bool bad = false; _Pragma("unroll") for (int e = 0; e < 4; ++e) bad |= chk_bad(bf2f(WSP(const bf16_t, WS_OCAT)[row * OCW + 256 + hh * 64 + 21 * e]), o[e] / lsum, 0.5f);
      return bad; }
}
__device__ __forceinline__ bool chk_nsa(Frame& F, int b, int h, int t, int i) {
    const bf16_t* P = WSP(const bf16_t, WS_P); const float* rel = F.in[1];
    { bool bad = false;
      { const size_t row = (size_t)b * SEQ + t; const size_t rb = (size_t)b * SEQ;
      const bf16_t* KC = WSP(const bf16_t, WS_KC) + (size_t)b * 256 * 64; const bf16_t* VC = WSP(const bf16_t, WS_VC) + (size_t)b * 256 * 64;
      const int cmax = (t >= 31) ? (t - 31) / 16 : -1, cur = t >> 6;
      LAS float* imp = (LAS float*)(F.lds + 70000) + i * 65; for (int j = 0; j < 64; ++j) imp[j] = 0.f;
      f32x4 oc = {0.f, 0.f, 0.f, 0.f};
      for (int hh = 0; hh < 4; ++hh) { const bf16_t* q = P + row * PW + PC_AQ + hh * 64; float m = -INFINITY;
          for (int c = 0; c <= cmax; ++c) { float s = 0.f; for (int d = 0; d < 64; ++d) s += bf2f(q[d]) * bf2f(KC[c * 64 + d]); m = fmaxf(m, s); }
          float ls = 0.f; for (int c = 0; c <= cmax; ++c) { float s = 0.f; for (int d = 0; d < 64; ++d) s += bf2f(q[d]) * bf2f(KC[c * 64 + d]); ls += exp2f(s - m); }
          for (int c = 0; c <= cmax; ++c) { float s = 0.f; for (int d = 0; d < 64; ++d) s += bf2f(q[d]) * bf2f(KC[c * 64 + d]); const float p = exp2f(s - m) / ls;
              for (int j = 0; j < 64; ++j) if (16 * c <= 64 * j + 63 && 16 * c + 31 >= 64 * j) imp[j] += p;
              if (hh == h) _Pragma("unroll") for (int e = 0; e < 4; ++e) oc[e] += p * bf2f(VC[c * 64 + 21 * e]); } }
      for (int j = 0; j < 64; ++j) imp[j] = (j == 0 || j == cur || j == cur - 1) ? 1e9f : (j > cur ? -1e9f : imp[j]);
      unsigned long long selm = 0ull;
      for (int j = 0; j < 64; ++j) { int rank = 0; for (int k = 0; k < 64; ++k) rank += (imp[k] > imp[j] || (imp[k] == imp[j] && k < j)) ? 1 : 0; if (rank < 16) selm |= 1ull << j; }
      const bf16_t* q = P + row * PW + PC_AQ + h * 64;
      f32x4 os = {0.f, 0.f, 0.f, 0.f}, ow = {0.f, 0.f, 0.f, 0.f};
      { float m = -INFINITY; for (int pos = 0; pos <= t; ++pos) { if (!((selm >> (pos >> 6)) & 1ull)) continue; const bf16_t* k = P + (rb + pos) * PW + PC_KSLC; float s = 0.f; for (int d = 0; d < 64; ++d) s += bf2f(q[d]) * bf2f(k[d]); s += rel[chk_bucket_ref(t - pos) * 10 + h] * LOG2E; m = fmaxf(m, s); }
        float ls = 0.f; for (int pos = 0; pos <= t; ++pos) { if (!((selm >> (pos >> 6)) & 1ull)) continue; const bf16_t* k = P + (rb + pos) * PW + PC_KSLC; const bf16_t* v = P + (rb + pos) * PW + PC_VSLC; float s = 0.f; for (int d = 0; d < 64; ++d) s += bf2f(q[d]) * bf2f(k[d]); s += rel[chk_bucket_ref(t - pos) * 10 + h] * LOG2E;
            const float p = exp2f(s - m); ls += p; _Pragma("unroll") for (int e = 0; e < 4; ++e) os[e] += p * bf2f(v[21 * e]); }
        _Pragma("unroll") for (int e = 0; e < 4; ++e) os[e] /= ls; }
      { const int lo = t - 511 > 0 ? t - 511 : 0; float m = -INFINITY; for (int pos = lo; pos <= t; ++pos) { const bf16_t* k = P + (rb + pos) * PW + PC_KWIN; float s = 0.f; for (int d = 0; d < 64; ++d) s += bf2f(q[d]) * bf2f(k[d]); s += rel[chk_bucket_ref(t - pos) * 10 + h] * LOG2E; m = fmaxf(m, s); }
        float ls = 0.f; for (int pos = lo; pos <= t; ++pos) { const bf16_t* k = P + (rb + pos) * PW + PC_KWIN; const bf16_t* v = P + (rb + pos) * PW + PC_VWIN; float s = 0.f; for (int d = 0; d < 64; ++d) s += bf2f(q[d]) * bf2f(k[d]); s += rel[chk_bucket_ref(t - pos) * 10 + h] * LOG2E;
            const float p = exp2f(s - m); ls += p; _Pragma("unroll") for (int e = 0; e < 4; ++e) ow[e] += p * bf2f(v[21 * e]); }
        _Pragma("unroll") for (int e = 0; e < 4; ++e) ow[e] /= ls; }
      const float* sd = WSP(const float, WS_SIDE) + row * 16 + h * 3; const float g0 = 1.f / (1.f + expf(-sd[0])), g1 = 1.f / (1.f + expf(-sd[1])), g2 = 1.f / (1.f + expf(-sd[2]));
      _Pragma("unroll") for (int e = 0; e < 4; ++e) bad |= chk_bad(bf2f(WSP(const bf16_t, WS_OCAT)[row * OCW + h * 64 + 21 * e]), g0 * oc[e] + g1 * os[e] + g2 * ow[e], 0.3f); }
      return bad; }
}
__device__ __forceinline__ void selfcheck_a(Frame& F, int l) {
    const int i = threadIdx.x;
    const float* x = F.in[0];
    const bf16_t* H = WSP(const bf16_t, WS_H); const bf16_t* P = WSP(const bf16_t, WS_P);
    const float* rel = F.in[1];
    { const int row = (int)(chk_hash(i) % M), col = (int)(chk_hash(i + 999) & 1023); float s = 0.f; for (int k = 0; k < DM; ++k) { const float v = x[(size_t)row * DM + k]; s += v * v; }
      const float ref = x[(size_t)row * DM + col] * (1.0f / sqrtf(s / DM + RMS_EPS)) * F.in[2][l * DM + col];
      chk_flag(F, 0, chk_bad(bf2f(H[(size_t)row * DM + col]), ref, 1.0f), 0); }
    { const int row = (int)(chk_hash(i + 5) % M); int c = (i * 37 + 5) % PW; if (i < 32) c = 640 + (i & 15); else if (i < 96) c = 672 + (i & 31); else if (i < 160) c = 256 + ((i * 3) & 127);
      const float* W = F.in[6] + (size_t)l * DM * DIN; bool bad = false;
#define DOTC(dst, cc) do { float sc_; const int src_ = inproj_src((cc), sc_); float a_ = 0.f; if (src_ >= 0) for (int k = 0; k < DM; ++k) a_ += bf2f(H[(size_t)row * DM + k]) * bfr(W[(size_t)k * DIN + src_] * sc_); dst = a_; } while (0)
      float ref; DOTC(ref, c);
      if (c >= 672 && c < 704) { const int p = c - 672, ip = p >> 1; float oth; DOTC(oth, c ^ 1); const float x1 = (p & 1) ? oth : ref, x2 = (p & 1) ? ref : oth;
          const float inv = powf(10000.0f, -(float)(2 * ip) / 32.0f), ang = (float)(row & (SEQ - 1)) * inv, cs = cosf(ang), sn = sinf(ang);
          ref = (p & 1) ? (x2 * cs + x1 * sn) : (x1 * cs - x2 * sn);
          bad |= chk_bad(bf2f(WSP(const bf16_t, WS_KROT)[(size_t)row * 32 + p]), ref, 1.0f); }
      bad |= chk_bad(bf2f(P[(size_t)row * PW + c]), ref, 1.0f);
      if (c >= 640 && c < 656) bad |= chk_bad(WSP(const float, WS_SIDE)[(size_t)row * 16 + (c - 640)], ref, 1.0f);
      if (c >= 256 && c < 320) bad |= chk_bad(bf2f(WSP(const bf16_t, WS_KCMP)[(size_t)row * 64 + (c - 256)]), ref, 1.0f);
      if (c >= 320 && c < 384) bad |= chk_bad(bf2f(WSP(const bf16_t, WS_VCMP)[(size_t)row * 64 + (c - 320)]), ref, 1.0f);
      if (i >= 160 && i < 192) { float sq = 0.f, skv = 0.f; for (int k = 0; k < 256; ++k) { const float v = bf2f(P[(size_t)row * PW + PC_DQL + k]); sq += v * v; } for (int k = 0; k < 128; ++k) { const float v = bf2f(P[(size_t)row * PW + PC_DKV + k]); skv += v * v; }
          const float* a = WSP(const float, WS_SSQQ) + (size_t)row * 4; const float* b = WSP(const float, WS_SSQKV) + (size_t)row * 4;
          bad |= chk_bad(a[0] + a[1] + a[2] + a[3], sq, 10.f) || chk_bad(b[0] + b[1] + b[2] + b[3], skv, 5.f); }
      chk_flag(F, 1, bad, 0); }
    { const int b = i & 15, h = (i >> 4) & 3, t = chk_t(i >> 6); float a = 0.f; for (int j = 0; j <= t; ++j) { const float xx = WSP(const float, WS_SIDE)[((size_t)b * SEQ + j) * 16 + 12 + h] + F.in[12][l * 4 + h]; a += (xx >= 0.f) ? -log1pf(expf(-xx)) : (xx - log1pf(expf(xx))); }
      chk_flag(F, 2, chk_bad(WSP(const float, WS_KB)[((size_t)b * 4 + h) * SEQ + t], -a * LOG2E, 1.0f + fabsf(a) * 0.05f), 0); }
    chk_flag(F, 3, chk_fox(F, (i * 5) & 15, i & 3, chk_t(i >> 2)), 0);
    { const int row = (int)(chk_hash(i + 77) % M); bool bad = false;
      float sq = 0.f, skv = 0.f; for (int k = 0; k < 256; ++k) { const float v = bf2f(P[(size_t)row * PW + PC_DQL + k]); sq += v * v; } for (int k = 0; k < 128; ++k) { const float v = bf2f(P[(size_t)row * PW + PC_DKV + k]); skv += v * v; }
      const float rq = 1.0f / sqrtf(sq / 256.0f + RMS_EPS), rkv = 1.0f / sqrtf(skv / 128.0f + RMS_EPS);
      const float* wq = F.in[15] + (size_t)l * 256 * 384; const float* gq = F.in[13] + l * 256; const float* wkv = F.in[16] + (size_t)l * 128 * 512; const float* gkv = F.in[14] + l * 128;
#define QDOT(dst, src) do { float a_ = 0.f; for (int k = 0; k < 256; ++k) a_ += bf2f(P[(size_t)row * PW + PC_DQL + k]) * bfr(wq[(size_t)k * 384 + (src)] * C2D * gq[k]); dst = a_ * rq; } while (0)
      const int r = (i * 11) % 384, hd = r / 96, w = r % 96; float ref;
      if (w < 64) QDOT(ref, hd * 96 + w);
      else { const int p = w - 64, ip = p >> 1; float x1, x2; QDOT(x1, hd * 96 + 64 + ip); QDOT(x2, hd * 96 + 64 + 16 + ip); const float inv = powf(10000.0f, -(float)(2 * ip) / 32.0f), ang = (float)(row & (SEQ - 1)) * inv, cs = cosf(ang), sn = sinf(ang);
          ref = (p & 1) ? (x2 * cs + x1 * sn) : (x1 * cs - x2 * sn); }
      bad |= chk_bad(bf2f(WSP(const bf16_t, WS_QM)[(size_t)row * 512 + r]), ref, 1.5f);
      { const int c = (i * 13) & 511; float a = 0.f; for (int k = 0; k < 128; ++k) a += bf2f(P[(size_t)row * PW + PC_DKV + k]) * bfr(wkv[(size_t)k * 512 + c] * gkv[k]); bad |= chk_bad(bf2f(WSP(const bf16_t, WS_KVM)[(size_t)row * 512 + c]), a * rkv, 1.0f); }
      chk_flag(F, 4, bad, 0); }
    { const int b = (i * 3) & 15, h = i & 3, t = chk_t(i >> 2); const size_t row = (size_t)b * SEQ + t; const bf16_t* q = WSP(const bf16_t, WS_QM) + row * 512 + h * 96; const bf16_t* KV = WSP(const bf16_t, WS_KVM); const bf16_t* KR = WSP(const bf16_t, WS_KROT);
      float m = -INFINITY; for (int j = 0; j <= t; ++j) { const size_t rj = (size_t)b * SEQ + j; float s = 0.f; for (int d = 0; d < 64; ++d) s += bf2f(q[d]) * bf2f(KV[rj * 512 + h * 128 + d]); for (int d = 0; d < 32; ++d) s += bf2f(q[64 + d]) * bf2f(KR[rj * 32 + d]); m = fmaxf(m, s); }
      float lsum = 0.f, dummy0_ = 0.f; f32x4 o = {0.f, 0.f, 0.f, 0.f};
      for (int j = 0; j <= t; ++j) { const size_t rj = (size_t)b * SEQ + j; float s = 0.f; for (int d = 0; d < 64; ++d) s += bf2f(q[d]) * bf2f(KV[rj * 512 + h * 128 + d]); for (int d = 0; d < 32; ++d) s += bf2f(q[64 + d]) * bf2f(KR[rj * 32 + d]);
          const float p = exp2f(s - m); lsum += p; _Pragma("unroll") for (int e = 0; e < 4; ++e) o[e] += p * bf2f(KV[rj * 512 + h * 128 + 64 + 21 * e]); }
      bool bad = false; _Pragma("unroll") for (int e = 0; e < 4; ++e) bad |= chk_bad(bf2f(WSP(const bf16_t, WS_OCAT)[row * OCW + 640 + h * 64 + 21 * e]), o[e] / lsum, 0.5f);
      chk_flag(F, 5, bad, 0); }
    chk_flag(F, 6, chk_dil(F, (i * 7) & 15, i & 1, chk_t(i >> 1)), 0);
    { const int b = i & 15, which = (i >> 4) & 1, c = (int)(chk_hash(i + 31) % 255), d = (i * 5) & 63; const bf16_t* src = (which ? WSP(const bf16_t, WS_VCMP) : WSP(const bf16_t, WS_KCMP)) + ((size_t)b * SEQ + 16 * c) * 64;
      const float *pk1 = F.in[8], *pv1 = F.in[10], *pk2 = F.in[9], *pv2 = F.in[11]; asm volatile("" : "+s"(pk1), "+s"(pv1), "+s"(pk2), "+s"(pv2));
      const float* w1 = (which ? pv1 : pk1) + (size_t)l * 2048 * 128; const float* w2 = (which ? pv2 : pk2) + (size_t)l * 128 * 64; const float* cp = F.in[7] + (size_t)l * 2048;
      float out = 0.f;
      for (int n = 0; n < 128; ++n) { float a = 0.f, bsum = 0.f; for (int p = 0; p < 2048; ++p) { a += bf2f(src[p]) * bfr(w1[(size_t)p * 128 + n]); bsum += cp[p] * w1[(size_t)p * 128 + n]; }
          const float xx = a + bsum, g = 0.5f * xx * (1.0f + tanhf(0.7978845608028654f * (xx + 0.044715f * xx * xx * xx))); out += bfr(g) * w2[n * 64 + d]; }
      chk_flag(F, 7, chk_bad(bf2f((which ? WSP(const bf16_t, WS_VC) : WSP(const bf16_t, WS_KC))[((size_t)b * 256 + c) * 64 + d]), out, 0.5f), 0); }
    { bool bad = false; if (i < 128) bad = chk_nsa(F, (i * 9) & 15, i & 3, chk_t(i >> 2), i); chk_flag(F, 8, bad, 4); }
}
__device__ __forceinline__ void selfcheck_b(Frame& F, int l) {
    const int i = threadIdx.x; const int row = (int)(chk_hash(i + 3) % M), n = (i * 29 + 7) & 1023;
    const bf16_t* H = WSP(const bf16_t, WS_H); const bf16_t* OC = WSP(const bf16_t, WS_OCAT);
    float acc = 0.f;
    for (int br = 0; br < 4; ++br) { const float* wg = F.in[21] + ((size_t)l * 4 + br) * DM * DM; float g = 0.f; for (int k = 0; k < DM; ++k) g += bf2f(H[(size_t)row * DM + k]) * bfr(wg[(size_t)k * DM + n]);
        const int kk = (br == 1) ? 128 : 256, co = (br == 0) ? 0 : (br == 1 ? 256 : (br == 2 ? 384 : 640)); const float *pb0 = F.in[17], *pb1 = F.in[18], *pb2 = F.in[19], *pb3 = F.in[20]; asm volatile("" : "+s"(pb0), "+s"(pb1), "+s"(pb2), "+s"(pb3)); const float* wb = (br == 0 ? pb0 : (br == 1 ? pb1 : (br == 2 ? pb2 : pb3))) + (size_t)l * kk * DM; float t = 0.f; for (int k = 0; k < kk; ++k) t += bf2f(OC[(size_t)row * OCW + co + k]) * bfr(wb[(size_t)k * DM + n]);
        acc += (1.f / (1.f + expf(-g))) * bfr(t); }
    chk_flag(F, 9, chk_bad(bf2f(WSP(const bf16_t, WS_MERGED)[(size_t)row * DM + n]), acc, 0.5f), 0);
}
__device__ __forceinline__ void selfcheck_c(Frame& F, int l, const float* xin) {
    const int i = threadIdx.x; const int row = (int)(chk_hash(i + 11) % M), n = (i * 29 + 7) & 1023;
    const bf16_t* MG = WSP(const bf16_t, WS_MERGED); const float* wo = F.in[22] + (size_t)l * DM * DM; const float* Y = WSP(const float, WS_Y);
    float a = 0.f; for (int k = 0; k < DM; ++k) a += bf2f(MG[(size_t)row * DM + k]) * bfr(wo[(size_t)k * DM + n]);
    chk_flag(F, 0, chk_bad(Y[(size_t)row * DM + n], a, 1.0f), 0);
    float s = 0.f; for (int k = 0; k < DM; ++k) { const float v = Y[(size_t)row * DM + k]; s += v * v; }
    const float rstd = 1.0f / sqrtf(s / DM + RMS_EPS); float s2 = 0.f;
    for (int k = 0; k < DM; ++k) { const float v = xin[(size_t)row * DM + k] + Y[(size_t)row * DM + k] * rstd * F.in[3][l * DM + k]; s2 += v * v; }
    const float x1 = xin[(size_t)row * DM + n] + Y[(size_t)row * DM + n] * rstd * F.in[3][l * DM + n];
    const float h2 = x1 * (1.0f / sqrtf(s2 / DM + RMS_EPS)) * F.in[4][l * DM + n];
    chk_flag(F, 1, chk_bad(F.out[(size_t)row * DM + n], x1, 1.0f) || chk_bad(bf2f(WSP(const bf16_t, WS_H2)[(size_t)row * DM + n]), h2, 1.0f), 0);
}
__device__ __forceinline__ void selfcheck_d(Frame& F, int l) {
    const int i = threadIdx.x; const int row = (int)(chk_hash(i + 17) % (M / 2)); const bf16_t* H2 = WSP(const bf16_t, WS_H2); const bf16_t* U = WSP(const bf16_t, WS_U); const bf16_t* A = WSP(const bf16_t, WS_ACT);
    { const int c = (i * 41 + 3) % DFF2; const float* wu = F.in[23] + (size_t)l * DM * DFF2; float a = 0.f; for (int k = 0; k < DM; ++k) a += bf2f(H2[(size_t)row * DM + k]) * bfr(wu[(size_t)k * DFF2 + c]);
      chk_flag(F, 2, chk_bad(bf2f(U[(size_t)row * DFF2 + c]), a, 1.0f), 0); }
    { const int c = (i * 23 + 1) % DFF; const int t = row & (SEQ - 1); const float* cw = F.in[24] + (size_t)l * 3 * DFF2; const float* cb = F.in[25] + (size_t)l * DFF2; float g = cb[c], v = cb[DFF + c];
      for (int j = 0; j < 3; ++j) { const int tt = t - 2 + j; if (tt < 0) continue; g += cw[j * DFF2 + c] * bf2f(U[(size_t)(row - 2 + j) * DFF2 + c]); v += cw[j * DFF2 + DFF + c] * bf2f(U[(size_t)(row - 2 + j) * DFF2 + DFF + c]); }
      chk_flag(F, 3, chk_bad(bf2f(A[(size_t)row * DFF + c]), g / (1.f + expf(-g)) * v, 0.3f), 0); }
    { const int n = (i * 29 + 7) & 1023; const float* wd = F.in[26] + (size_t)l * DFF * DM; float a = 0.f; for (int k = 0; k < DFF; ++k) a += bf2f(A[(size_t)row * DFF + k]) * bfr(wd[(size_t)k * DM + n]);
      chk_flag(F, 4, chk_bad(WSP(const float, WS_Y2)[(size_t)row * DM + n], a, 1.0f), 0); }
}

__device__ __forceinline__ void selfcheck_e(Frame& F, int l) {
    const int i = threadIdx.x; const bf16_t* H = WSP(const bf16_t, WS_H); const bf16_t* P = WSP(const bf16_t, WS_P);
    const float* W = F.in[6] + (size_t)l * DM * DIN; const int row = (int)(chk_hash(i + 5) % M);
#define DOTC(dst, cc) do { float sc_; const int src_ = inproj_src((cc), sc_); float a_ = 0.f; if (src_ >= 0) for (int k = 0; k < DM; ++k) a_ += bf2f(H[(size_t)row * DM + k]) * bfr(W[(size_t)k * DIN + src_] * sc_); dst = a_; } while (0)
    { int c = (i * 37 + 5) % PW; if ((c >= 640 && c < 768)) c = 100; float ref; DOTC(ref, c); chk_flag(F, 0, chk_bad(bf2f(P[(size_t)row * PW + c]), ref, 1.0f), 0); }
    { const int c = 672 + (i & 31), p = c - 672, ip = p >> 1; float ref, oth; DOTC(ref, c); DOTC(oth, c ^ 1); const float x1 = (p & 1) ? oth : ref, x2 = (p & 1) ? ref : oth;
      const float inv = powf(10000.0f, -(float)(2 * ip) / 32.0f), ang = (float)(row & (SEQ - 1)) * inv, cs = cosf(ang), sn = sinf(ang); const float r = (p & 1) ? (x2 * cs + x1 * sn) : (x1 * cs - x2 * sn);
      chk_flag(F, 1, chk_bad(bf2f(WSP(const bf16_t, WS_KROT)[(size_t)row * 32 + p]), r, 1.0f), 0); }
    { const int c = 640 + (i & 15); float ref; DOTC(ref, c); chk_flag(F, 2, chk_bad(WSP(const float, WS_SIDE)[(size_t)row * 16 + (c - 640)], ref, 1.0f), 0); }
    { const int c = 256 + (i & 127); float ref; DOTC(ref, c); const float got = (c < 320) ? bf2f(WSP(const bf16_t, WS_KCMP)[(size_t)row * 64 + (c - 256)]) : bf2f(WSP(const bf16_t, WS_VCMP)[(size_t)row * 64 + (c - 320)]); chk_flag(F, 3, chk_bad(got, ref, 1.0f), 0); }
    float sq = 0.f, skv = 0.f; for (int k = 0; k < 256; ++k) { const float v = bf2f(P[(size_t)row * PW + PC_DQL + k]); sq += v * v; } for (int k = 0; k < 128; ++k) { const float v = bf2f(P[(size_t)row * PW + PC_DKV + k]); skv += v * v; }
    { const float* a = WSP(const float, WS_SSQQ) + (size_t)row * 4; const float* b = WSP(const float, WS_SSQKV) + (size_t)row * 4; chk_flag(F, 4, chk_bad(a[0] + a[1] + a[2] + a[3], sq, 10.f) || chk_bad(b[0] + b[1] + b[2] + b[3], skv, 5.f), 0); }
    const float rq = 1.0f / sqrtf(sq / 256.0f + RMS_EPS), rkv = 1.0f / sqrtf(skv / 128.0f + RMS_EPS);
    const float* wq = F.in[15] + (size_t)l * 256 * 384; const float* gq = F.in[13] + l * 256; const float* wkv = F.in[16] + (size_t)l * 128 * 512; const float* gkv = F.in[14] + l * 128;
#define QDOT(dst, src) do { float a_ = 0.f; for (int k = 0; k < 256; ++k) a_ += bf2f(P[(size_t)row * PW + PC_DQL + k]) * bfr(wq[(size_t)k * 384 + (src)] * C2D * gq[k]); dst = a_ * rq; } while (0)
    { const int hd = i & 3, w = (i >> 2) & 63; float ref; QDOT(ref, hd * 96 + w); chk_flag(F, 5, chk_bad(bf2f(WSP(const bf16_t, WS_QM)[(size_t)row * 512 + hd * 96 + w]), ref, 1.5f), 0); }
    { const int hd = i & 3, p = (i >> 2) & 31, ip = p >> 1; float x1, x2; QDOT(x1, hd * 96 + 64 + ip); QDOT(x2, hd * 96 + 64 + 16 + ip); const float inv = powf(10000.0f, -(float)(2 * ip) / 32.0f), ang = (float)(row & (SEQ - 1)) * inv, cs = cosf(ang), sn = sinf(ang);
      const float r = (p & 1) ? (x2 * cs + x1 * sn) : (x1 * cs - x2 * sn); chk_flag(F, 6, chk_bad(bf2f(WSP(const bf16_t, WS_QM)[(size_t)row * 512 + hd * 96 + 64 + p]), r, 1.5f), 0); }
    { const int c = (i * 13) & 511; float a = 0.f; for (int k = 0; k < 128; ++k) a += bf2f(P[(size_t)row * PW + PC_DKV + k]) * bfr(wkv[(size_t)k * 512 + c] * gkv[k]); chk_flag(F, 7, chk_bad(bf2f(WSP(const bf16_t, WS_KVM)[(size_t)row * 512 + c]), a * rkv, 1.0f), 0); }
    { const int b = i & 15, which = (i >> 4) & 1, c = (int)(chk_hash(i + 31) % 255), n = (i * 5) & 127; const bf16_t* src = (which ? WSP(const bf16_t, WS_VCMP) : WSP(const bf16_t, WS_KCMP)) + ((size_t)b * SEQ + 16 * c) * 64;
      const float *pk1 = F.in[8], *pv1 = F.in[10], *pk2 = F.in[9], *pv2 = F.in[11]; asm volatile("" : "+s"(pk1), "+s"(pv1), "+s"(pk2), "+s"(pv2));
      const float* w1 = (which ? pv1 : pk1) + (size_t)l * 2048 * 128; const float* w2 = (which ? pv2 : pk2) + (size_t)l * 128 * 64; const float* cp = F.in[7] + (size_t)l * 2048;
      float a = 0.f, bsum = 0.f; for (int p = 0; p < 2048; ++p) { a += bf2f(src[p]) * bfr(w1[(size_t)p * 128 + n]); bsum += cp[p] * w1[(size_t)p * 128 + n]; }
      const float xx = a + bsum, g = 0.5f * xx * (1.0f + tanhf(0.7978845608028654f * (xx + 0.044715f * xx * xx * xx)));
      const bf16_t* hid = WSP(const bf16_t, WS_HID) + (size_t)(which * 4096 + b * 256 + c) * 256 + which * 128;
      chk_flag(F, 8, chk_bad(bf2f(hid[n]), g, 0.5f), 0);
      const int d = (i * 5) & 63; float o2 = 0.f; for (int nn = 0; nn < 128; ++nn) o2 += bf2f(hid[nn]) * w2[nn * 64 + d];
      chk_flag(F, 9, chk_bad(bf2f((which ? WSP(const bf16_t, WS_VC) : WSP(const bf16_t, WS_KC))[((size_t)b * 256 + c) * 64 + d]), o2, 0.5f), 0); }
#undef DOTC
#undef QDOT
}

constexpr int CW_CNT = 20544;
__device__ __forceinline__ void selfcheck_g(Frame& F, int l) {
    const int gi = blockIdx.x * 512 + threadIdx.x; const bf16_t* H = WSP(const bf16_t, WS_H); const bf16_t* P = WSP(const bf16_t, WS_P); const float* W = F.in[6] + (size_t)l * DM * DIN;
    const int row = gi & (M - 1); unsigned nbad = 0u;
    for (int k4 = 0; k4 < 4; ++k4) { int c = (int)(chk_hash(gi * 4 + k4 + 12345u) % PW); if (c >= 640 && c < 768) c -= 200;
        float sc_; const int src_ = inproj_src(c, sc_); float a_ = 0.f; for (int k = 0; k < DM; ++k) a_ += bf2f(H[(size_t)row * DM + k]) * bfr(W[(size_t)k * DIN + src_] * sc_);
        if (chk_bad(bf2f(P[(size_t)row * PW + c]), a_, 1.0f)) ++nbad; }
    if (nbad) atomicAdd((unsigned*)(F.ctl + CW_CNT), nbad);
}
__device__ __forceinline__ void selfcheck_g_fin(Frame& F) {
    if (blockIdx.x == 0 && threadIdx.x == 0) { const unsigned cnt = __hip_atomic_load(F.ctl + CW_CNT, __ATOMIC_RELAXED, __HIP_MEMORY_SCOPE_AGENT); unsigned lg = 0; while ((1u << lg) <= cnt && lg < 15) ++lg;
        atomicOr((unsigned*)(F.ctl + CW_CHK), (cnt > 63u ? 63u : cnt) | (lg << 6)); }
}

__device__ __forceinline__ void selfcheck_f(Frame& F, int l) {
    const int i = threadIdx.x; const unsigned hsh = chk_hash(i + 4242u);
    chk_flag(F, 0, chk_fox(F, i & 15, (i >> 4) & 3, (i >> 6) * 8 + (hsh & 7)), 0);
    chk_flag(F, 1, chk_fox(F, i & 15, (i >> 4) & 3, 64 + (int)(hsh % 192u)), 0);
    chk_flag(F, 2, chk_fox(F, i & 15, (i >> 4) & 3, 256 + (int)(hsh % 3840u)), 0);
    chk_flag(F, 3, chk_dil(F, i & 15, (i >> 4) & 1, (int)(hsh & 127u)), 0);
    chk_flag(F, 4, chk_dil(F, i & 15, (i >> 4) & 1, 128 + (int)(hsh % 3968u)), 0);
    { bool bad = false; if (i < 128) bad = chk_nsa(F, i & 15, (i >> 4) & 3, (int)(hsh % 31u), i); chk_flag(F, 5, bad, 0); }
    { bool bad = false; if (i < 128) bad = chk_nsa(F, i & 15, (i >> 4) & 3, 31 + (int)(hsh % 33u), i); chk_flag(F, 6, bad, 0); }
    { bool bad = false; if (i < 128) bad = chk_nsa(F, i & 15, (i >> 4) & 3, 64 + (int)(hsh % 960u), i); chk_flag(F, 7, bad, 0); }
    { bool bad = false; if (i < 128) bad = chk_nsa(F, i & 15, (i >> 4) & 3, 1024 + (int)(hsh % 3072u), i); chk_flag(F, 8, bad, 4); }
}
__device__ __forceinline__ void selfcheck_report(Frame& F) {
    const unsigned mask = __hip_atomic_load(F.ctl + CW_CHK, __ATOMIC_RELAXED, __HIP_MEMORY_SCOPE_AGENT);
    float V = (float)(10u + (mask & 63u)); const unsigned e = 2u + ((mask >> 6) & 15u); for (unsigned k = 0; k < e; ++k) V *= 10.0f;
    for (size_t idx = (size_t)blockIdx.x * 512 + threadIdx.x; idx < (size_t)M * DM; idx += (size_t)F.G * 512) F.out[idx] = V;
}
#endif
struct SchedSimple {
    pg8::TileOrder T; const char* A; const char* B; int lda, ldb, nt;
    __device__ bool next(int i, GUnit& u) const { int pm, pn; if (!T.tile(i, pm, pn)) return false;
        u.A = A + (size_t)pm * 256 * lda; u.B = B + (size_t)pn * 256 * ldb; u.lda = lda; u.ldb = ldb; u.nt = nt; u.pm = pm; u.pn = pn; u.id = 0; return true; }
};
struct SchedCmp1 {
    int c; const char* kc; const char* vc; const char* B;
    __device__ bool next(int i, GUnit& u) const { if (i > 0 || c >= 32) return false;
        u.A = (c < 16 ? kc : vc) + (size_t)(c & 15) * 256 * 2048; u.B = B; u.lda = 2048; u.ldb = 4096; u.nt = 32; u.pm = c; u.pn = 0; u.id = 0; return true; }
};
struct SchedMerge {
    pg8::TileOrder T; const char* ocat; const char* h; const char* wbr; const char* wg;
    __device__ bool next(int i, GUnit& u) const { int pm, pn; if (!T.tile(i >> 3, pm, pn)) return false;
        const int sub = i & 7; u.pm = pm; u.pn = pn; u.id = sub;
        if (sub >= 4) { u.A = h + (size_t)pm * 256 * 2048; u.lda = 2048; u.B = wg + (size_t)((pn * 4 + (sub - 4)) * 256) * 2048; u.ldb = 2048; u.nt = 16; }
        else { const int br = sub; const int kk = (br == 1) ? 128 : 256; const size_t co = (br == 0) ? 0 : (br == 1 ? 256 : (br == 2 ? 384 : 640)), wo = (br == 0) ? BR_A : (br == 1 ? BR_B : (br == 2 ? BR_C : BR_D));
            u.A = ocat + (size_t)pm * 256 * (OCW * 2) + co * 2; u.lda = OCW * 2; u.B = wbr + wo + (size_t)pn * 256 * kk * 2; u.ldb = kk * 2; u.nt = kk / 64; }
        return true; }
};

#ifndef DUP_ATTN
#define DUP_ATTN 1
#endif
#ifndef DUP_GEMM
#define DUP_GEMM 1
#endif
#ifndef DUP_MERGE
#define DUP_MERGE 1
#endif
#ifndef DUP_FFN
#define DUP_FFN 1
#endif
#ifdef ONLY_PHASE
#define PH(k) ((k) == ONLY_PHASE)
#else
#define PH(k) true
#endif
struct Args { const float* in[27]; float* out; unsigned char* ws; };
__global__ void __launch_bounds__(512, 2) hybrid_fwd(Args args) {
    extern __shared__ __attribute__((aligned(16))) unsigned char lds_raw[];
    Frame F;
    F.lds = (LAS unsigned char*)lds_raw; F.MISC = (volatile LAS unsigned*)(F.lds + MISC_OFF);
    F.tid = threadIdx.x; F.lane = F.tid & 63; F.wave = __builtin_amdgcn_readfirstlane(F.tid >> 6); F.G = gridDim.x;
#pragma unroll
    for (int i = 0; i < 27; ++i) F.in[i] = args.in[i];
    F.out = args.out; F.ws = args.ws; F.ctl = (gu32*)(args.ws + WS_CTL);
    for (int u = F.tid; u < (LDS_BYTES - LDSCTL_OFF) / 4; u += 512) ((LAS unsigned*)(F.lds + LDSCTL_OFF))[u] = 0u;
    __syncthreads();
    XcdBarrier bar = xcd_barrier_post((unsigned*)(F.ctl + CW_BAR), F.MISC + 8);
    const int c = (int)blockIdx.x;
#if defined(TIMEPROBE)
    if (threadIdx.x == 0) *(volatile LAS unsigned long long*)(F.lds + MISC_OFF + 64) = __builtin_amdgcn_s_memrealtime();
#define TSTAMP(id) do { if (blockIdx.x == 0 && threadIdx.x == 0) { volatile LAS unsigned long long* tp_ = (volatile LAS unsigned long long*)(F.lds + MISC_OFF + 64); const unsigned long long now_ = __builtin_amdgcn_s_memrealtime(); unsigned long long* a_ = (unsigned long long*)(F.ws + 90000) + (id); *a_ = *a_ + (now_ - *tp_); *tp_ = now_; } } while (0)
#else
#define TSTAMP(id) do { } while (0)
#endif

#ifndef DUP_P0
#define DUP_P0 1
#endif
    for (int rep = 0; rep < DUP_P0; ++rep) { if (rep) xcd_barrier(bar); if (PH(0)) p0_prologue(F); }
    xcd_barrier(bar); TSTAMP(0);

#define PHASE_FRESH() do { int t_ = threadIdx.x; asm volatile("" : "+v"(t_)); F.tid = t_; F.lane = t_ & 63; } while (0)
    for (int l = 0; l < DEPTH; ++l) {
        unsigned char* wl = F.ws + WS_WT + (size_t)l * LW;
        const float* xin = (l == 0) ? F.in[0] : F.out;
        PHASE_FRESH();
        if (PH(1)) rowpass<0>(F, xin, nullptr, 0, nullptr, WSP(bf16_t, WS_H), F.in[2] + l * DM, nullptr, 0, M);
        xcd_barrier(bar); TSTAMP(1);
        for (int rep = 0; rep < DUP_GEMM; ++rep) if (PH(2)) { if (rep) xcd_barrier(bar); SchedSimple S; S.T.init(256, 12, F.G, c); S.A = (const char*)(F.ws + WS_H); S.B = (const char*)(wl + LW_IN); S.lda = 2048; S.ldb = 2048; S.nt = 16;
          pg8::EpiInProj E{WSP(bf16_t, WS_P), WSP(bf16_t, WS_KCMP), WSP(bf16_t, WS_VCMP), WSP(float, WS_SIDE), WSP(bf16_t, WS_KROT), WSP(const float, WS_ROPE), WSP(float, WS_SSQQ), WSP(float, WS_SSQKV)};
          pg8::gemm_phase<pg8::EpiInProj, SchedSimple, true>(F.lds, S, E); }
        xcd_barrier(bar); TSTAMP(2);
        if (PH(3)) { SchedCmp1 S{c, (const char*)(F.ws + WS_KCMP), (const char*)(F.ws + WS_VCMP), (const char*)(wl + LW_PHI)};
          pg8::EpiCmp1 E{WSP(bf16_t, WS_HID), WSP(const float, WS_CMPB) + l * 256};
          pg8::gemm_phase<pg8::EpiCmp1, SchedCmp1, false>(F.lds, S, E); }
        if (PH(4)) { const bool split = F.G > 64; const int g2 = split ? F.G - 32 : F.G, c2 = split ? c - 32 : c;
          { SchedSimple S; S.T.init(256, 2, g2, c2 < 0 ? (1 << 28) : c2); S.A = (const char*)(F.ws + WS_P) + PC_DQL * 2; S.B = (const char*)(wl + LW_UQ); S.lda = PW * 2; S.ldb = 512; S.nt = 4;
            pg8::EpiQup E{WSP(bf16_t, WS_QM), WSP(const float, WS_SSQQ), WSP(const float, WS_ROPE)};
            pg8::gemm_phase<pg8::EpiQup, SchedSimple, true>(F.lds, S, E); }
          { SchedSimple S; S.T.init(256, 2, g2, c2 < 0 ? (1 << 28) : c2); S.A = (const char*)(F.ws + WS_P) + PC_DKV * 2; S.B = (const char*)(wl + LW_UKV); S.lda = PW * 2; S.ldb = 256; S.nt = 2;
            pg8::EpiKVup E{WSP(bf16_t, WS_KVM), WSP(const float, WS_SSQKV)};
            pg8::gemm_phase<pg8::EpiKVup, SchedSimple, true>(F.lds, S, E); } }
        PHASE_FRESH();
        if (PH(5)) {
          const int gw = c * 8 + F.wave;
          if (gw < BATCH) { const int b = gw; const float* sd = WSP(const float, WS_SIDE) + (size_t)b * SEQ * 16 + 12; const f32x4 fb = *(const f32x4*)(F.in[12] + l * 4);
              f32x4 tot = {0.f, 0.f, 0.f, 0.f};
              for (int i = 0; i < 64; ++i) { const f32x4 f = *(const f32x4*)(sd + (size_t)(F.lane * 64 + i) * 16);
#pragma unroll
                  for (int e = 0; e < 4; ++e) { const float x = f[e] + fb[e]; tot[e] += (x >= 0.f) ? -log1pf(expf(-x)) : (x - log1pf(expf(x))); } }
              LAS float* sc = (LAS float*)(F.lds + F.wave * 1024);
              *(LAS f32x4*)(sc + 4 * F.lane) = tot; LDS_WAIT(); asm volatile("" ::: "memory");
              f32x4 pre = {0.f, 0.f, 0.f, 0.f};
              for (int j = 0; j < 64; ++j) { const f32x4 o = *(const LAS f32x4*)(sc + 4 * j); if (j < F.lane) pre = pre + o; }
              pre = pre + tot;
              f32x4 run = pre - tot;
              float* kb = WSP(float, WS_KB) + (size_t)b * 4 * SEQ;
              for (int i = 0; i < 64; ++i) { const int t = F.lane * 64 + i; const f32x4 f = *(const f32x4*)(sd + (size_t)t * 16);
#pragma unroll
                  for (int e = 0; e < 4; ++e) { const float x = f[e] + fb[e]; run[e] += (x >= 0.f) ? -log1pf(expf(-x)) : (x - log1pf(expf(x))); kb[(size_t)e * SEQ + t] = -run[e] * LOG2E; } }
          } }
        xcd_barrier(bar); TSTAMP(3);
        PHASE_FRESH();
        if (PH(6)) { const int gt = c * 512 + F.tid, NGT = F.G * 512; const bf16_t* hid = WSP(const bf16_t, WS_HID);
          for (int i = gt; i < 2 * BATCH * 256 * 64; i += NGT) { const int d = i & 63, rc = (i >> 6) & 4095, which = i >> 18;
              const bf16_t* hr = hid + (size_t)(which * 4096 + rc) * 256 + which * 128; const float* w2 = (which ? F.in[11] : F.in[9]) + (size_t)l * 128 * 64 + d;
              float a = 0.f;
#pragma unroll 8
              for (int n = 0; n < 128; ++n) a += bf2f(hr[n]) * w2[n * 64];
              (which ? WSP(bf16_t, WS_VC) : WSP(bf16_t, WS_KC))[(size_t)rc * 64 + d] = (bf16_t)f2bf(a); } }
        xcd_barrier(bar); TSTAMP(4);
        PHASE_FRESH();
        for (int rep = 0; rep < DUP_ATTN; ++rep) { gu32* ctr = F.ctl + CW_Q + 64 * l + 16 * rep;
          if (rep) xcd_barrier(bar);
          for (;;) { const int it = queue_grab(F, ctr);
              if (it < 2048 && PH(7)) { const int qb = 15 - (it >> 7), mla = (it >> 6) & 1, bh = it & 63; if (mla) causal_unit<false>(F, bh >> 2, bh & 3, qb); else causal_unit<true>(F, bh >> 2, bh & 3, qb); }
              else if (it < 3072 && PH(8)) { const int r = it - 2048; nsa_unit(F, r & 15, 63 - (r >> 4)); }
              else if (it < 3328 && PH(9)) { const int r = it - 3072; dil_unit(F, r & 15, (r >> 4) & 1, r >> 5); }
              else break; } }
        xcd_barrier(bar); TSTAMP(5);
#if defined(SELFCHECK) && SELFCHECK == 1
        if (c == 0) selfcheck_a(F, l);
#endif
#if defined(SELFCHECK) && SELFCHECK == 3
        if (c == 0) selfcheck_e(F, l);
        xcd_barrier(bar); selfcheck_report(F); return;
#endif
#if defined(SELFCHECK) && SELFCHECK == 5
        selfcheck_g(F, l); xcd_barrier(bar); selfcheck_g_fin(F);
        xcd_barrier(bar); selfcheck_report(F); return;
#endif
#if defined(SELFCHECK) && SELFCHECK == 4
        if (c == 0) selfcheck_f(F, l);
        xcd_barrier(bar); selfcheck_report(F); return;
#endif
        for (int rep = 0; rep < DUP_MERGE; ++rep) if (PH(10)) { if (rep) xcd_barrier(bar); SchedMerge S; S.T.init(256, 4, F.G, c); S.ocat = (const char*)(F.ws + WS_OCAT); S.h = (const char*)(F.ws + WS_H); S.wbr = (const char*)(wl + LW_BR); S.wg = (const char*)(wl + LW_G);
          unsigned char* scr = F.ws + WS_MSCR + (size_t)c * MSCR_PER_WG;
          pg8::EpiMerge E{WSP(bf16_t, WS_MERGED), scr};
          pg8::gemm_phase<pg8::EpiMerge, SchedMerge, true>(F.lds, S, E); }
        xcd_barrier(bar); TSTAMP(6);
#if defined(SELFCHECK) && SELFCHECK == 1
        if (c == 0) selfcheck_b(F, l);
        xcd_barrier(bar); selfcheck_report(F); return;
#endif
        for (int rep = 0; rep < DUP_GEMM; ++rep) if (PH(11)) { if (rep) xcd_barrier(bar); SchedSimple S; S.T.init(256, 4, F.G, c); S.A = (const char*)(F.ws + WS_MERGED); S.B = (const char*)(wl + LW_O); S.lda = 2048; S.ldb = 2048; S.nt = 16;
          pg8::EpiF32 E{WSP(float, WS_Y), DM};
          pg8::gemm_phase<pg8::EpiF32, SchedSimple, true>(F.lds, S, E); }
        xcd_barrier(bar); TSTAMP(7);
        PHASE_FRESH();
        if (PH(12)) rowpass<1>(F, xin, WSP(const float, WS_Y), 0, F.out, WSP(bf16_t, WS_H2), F.in[3] + l * DM, F.in[4] + l * DM, 0, M);
        xcd_barrier(bar); TSTAMP(8);
#if defined(SELFCHECK) && SELFCHECK == 2
        if (c == 0) selfcheck_c(F, l, xin);
#endif
        for (int hf = 0; hf < 2; ++hf) {
            for (int rep = 0; rep < DUP_FFN; ++rep) if (PH(13)) { if (rep) xcd_barrier(bar); SchedSimple S; S.T.init(128, 22, F.G, c); S.A = (const char*)(F.ws + WS_H2) + (size_t)hf * (M / 2) * 2048; S.B = (const char*)(wl + LW_UP); S.lda = 2048; S.ldb = 2048; S.nt = 16;
              pg8::EpiBf16 E{WSP(bf16_t, WS_U), DFF2};
              pg8::gemm_phase<pg8::EpiBf16, SchedSimple, true>(F.lds, S, E); }
            xcd_barrier(bar); TSTAMP(9);
            PHASE_FRESH();
            for (int rep = 0; rep < DUP_FFN; ++rep) if (PH(14)) { if (rep) xcd_barrier(bar); conv_pass(F, WSP(const bf16_t, WS_U), WSP(bf16_t, WS_ACT), F.in[24] + (size_t)l * 3 * DFF2, F.in[25] + (size_t)l * DFF2); }
            xcd_barrier(bar); TSTAMP(10);
            for (int rep = 0; rep < DUP_FFN; ++rep) if (PH(15)) { if (rep) xcd_barrier(bar); SchedSimple S; S.T.init(128, 4, F.G, c); S.A = (const char*)(F.ws + WS_ACT); S.B = (const char*)(wl + LW_DN); S.lda = DFF * 2; S.ldb = DFF * 2; S.nt = DFF / 64;
              pg8::EpiF32 E{WSP(float, WS_Y2), DM};
              pg8::gemm_phase<pg8::EpiF32, SchedSimple, true>(F.lds, S, E); }
            xcd_barrier(bar); TSTAMP(11);
#if defined(SELFCHECK) && SELFCHECK == 2
            if (c == 0) selfcheck_d(F, l);
            xcd_barrier(bar); selfcheck_report(F); return;
#endif
            PHASE_FRESH();
            if (PH(16)) rowpass<2>(F, F.out, WSP(const float, WS_Y2), (size_t)hf * (M / 2), F.out, nullptr, F.in[5] + l * DM, nullptr, hf * (M / 2), (hf + 1) * (M / 2));
            xcd_barrier(bar); TSTAMP(12);
        }
    }
#if defined(TIMEPROBE)
    { xcd_barrier(bar); const unsigned long long* a_ = (const unsigned long long*)(F.ws + 90000); const float V1 = (float)a_[TIMEPROBE_A] * 0.01f, V2 = (float)a_[TIMEPROBE_B] * 0.01f * 1000.0f;
      for (size_t idx = (size_t)blockIdx.x * 512 + threadIdx.x; idx < (size_t)M * DM; idx += (size_t)F.G * 512) F.out[idx] = (idx == 12345) ? V2 : V1; }
#endif
}

extern "C" void kernel_launch(void* const* d_in, const int* in_sizes, int n_in, void* d_out, int out_size, void* d_ws, size_t ws_size, hipStream_t stream) {
    static int grid = 0;
    if (grid == 0) {
        if (n_in != 27 || in_sizes[0] != M * DM || out_size != M * DM || ws_size < WS_END) { fprintf(stderr, "kernel_launch: unexpected shapes (n_in %d, in0 %d, out %d, ws %zu)\n", n_in, n_in > 0 ? in_sizes[0] : -1, out_size, ws_size); grid = -1; return; }
        int dev = 0, cus = 0, per_cu = 0;
        if (hipGetDevice(&dev) != hipSuccess || hipDeviceGetAttribute(&cus, hipDeviceAttributeMultiprocessorCount, dev) != hipSuccess) { grid = -1; return; }
        if (hipFuncSetAttribute((const void*)hybrid_fwd, hipFuncAttributeMaxDynamicSharedMemorySize, LDS_BYTES) != hipSuccess) { fprintf(stderr, "kernel_launch: hipFuncSetAttribute failed\n"); grid = -1; return; }
        if (hipOccupancyMaxActiveBlocksPerMultiprocessor(&per_cu, (const void*)hybrid_fwd, 512, LDS_BYTES) != hipSuccess || per_cu < 1) fprintf(stderr, "kernel_launch: occupancy query says %d\n", per_cu);
        (void)hipGetLastError();
        grid = cus;
    }
    if (grid < 0) return;
    if (hipMemsetAsync((char*)d_ws + WS_CTL, 0, CTL_ZERO_BYTES, stream) != hipSuccess) return;
    Args a{};
    for (int i = 0; i < 27; ++i) a.in[i] = (const float*)d_in[i];
    a.out = (float*)d_out; a.ws = (unsigned char*)d_ws;
    hipLaunchKernelGGL(hybrid_fwd, dim3(grid), dim3(512), LDS_BYTES, stream, a);
}
```

```cpp
#include <hip/hip_runtime.h>
#include <hip/hip_bf16.h>
#include <cstdio>
#include <cstdint>
#include <cmath>

#define GAS __attribute__((address_space(1)))
#define LAS __attribute__((address_space(3)))
typedef unsigned short bf16_t;
typedef short bf16x8 __attribute__((ext_vector_type(8)));
typedef short s16x4 __attribute__((ext_vector_type(4)));
typedef float f32x4 __attribute__((ext_vector_type(4)));
typedef float f32x2 __attribute__((ext_vector_type(2)));
typedef float f32x16 __attribute__((ext_vector_type(16)));
typedef unsigned u32x4 __attribute__((ext_vector_type(4)));
typedef unsigned u32x2 __attribute__((ext_vector_type(2)));
typedef GAS unsigned gu32;

constexpr int BATCH = 16, SEQ = 4096, DM = 1024, M = BATCH * SEQ, DEPTH = 2;
constexpr int DIN = 2992, PW = 3072;
constexpr int DFF = 2816, DFF2 = 5632;
constexpr float LOG2E = 1.4426950408889634f;
constexpr float C2A = 0.125f * LOG2E;
constexpr float C2D = 0.10206207261596575f * LOG2E;
constexpr float RMS_EPS = 1e-6f;
constexpr int PC_AQ = 0, PC_KCMP = 256, PC_VCMP = 320, PC_KSLC = 384, PC_VSLC = 448, PC_KWIN = 512, PC_VWIN = 576,
              PC_MISC = 640, PC_KROPE = 672, PC_BQ = 768, PC_BK = 1152, PC_BV = 1536, PC_DKV = 1920,
              PC_CQ = 2048, PC_CK = 2304, PC_CV = 2560, PC_DQL = 2816;
constexpr int OCW = 896;
constexpr int NSA_DFAR = 1536, NSA_DMAX = 1664, NSA_TL = 1728;

__device__ __forceinline__ unsigned f2bf(float f) { unsigned u = __float_as_uint(f); return (u + 0x7fffu + ((u >> 16) & 1u)) >> 16; }
__device__ __forceinline__ unsigned pk2(float lo, float hi) { return f2bf(lo) | (f2bf(hi) << 16); }
__device__ __forceinline__ float bf2f(unsigned short b) { return __uint_as_float((unsigned)b << 16); }
typedef __bf16 bf16x2_t __attribute__((ext_vector_type(2)));
__device__ __forceinline__ unsigned cvtpk(float lo, float hi) { f32x2 v = {lo, hi}; bf16x2_t b = __builtin_convertvector(v, bf16x2_t); return __builtin_bit_cast(unsigned, b); }
__device__ __forceinline__ float fast_exp2(float x) { return __builtin_amdgcn_exp2f(x); }
__device__ __forceinline__ float fast_rcp(float x) { return __builtin_amdgcn_rcpf(x); }
template <int MASK> __device__ __forceinline__ float xor_lane_lt32(float v) { return __uint_as_float(__builtin_amdgcn_ds_swizzle((int)__float_as_uint(v), (MASK << 10) | 0x1f)); }
__device__ __forceinline__ float sum_halves(float v) { auto rr = __builtin_amdgcn_permlane32_swap(__float_as_uint(v), __float_as_uint(v), false, false); return __uint_as_float(rr[0]) + __uint_as_float(rr[1]); }
__device__ __forceinline__ float sigmoid_f(float x) { return fast_rcp(1.0f + fast_exp2(-x * LOG2E)); }

namespace pg8 {
constexpr int BM = 256, BK = 64, HALF = 128, HTB = HALF * BK * 2  , STAGE_BYTES = 8 * HTB, NXCD = 8, WGM = 8;
__host__ __device__ __forceinline__ int lds_byte(int r, int c) { const int st = (r >> 4) * 2 + (c >> 5), rr = r & 15, cc = c & 31, ob = rr * 64 + cc * 2; return st * 1024 + (ob ^ (((ob >> 9) & 1) << 5)); }
__host__ __device__ __forceinline__ void stage_rc(int b, int& R, int& C) { const int st = b / 1024, sb = b % 1024, swz = sb ^ (((sb >> 9) & 1) << 5); R = (st >> 1) * 16 + swz / 64; C = (st & 1) * 32 + (swz % 64) / 2; }
__host__ __device__ __forceinline__ int perm32(int rho) { const int n = rho >> 4, i = rho & 15; return 8 * (i >> 2) + 4 * n + (i & 3); }

struct GUnit { const char* A; const char* B; int lda, ldb, nt, pm, pn, id; };

struct TileOrder {
    int nM, nN, nwg, G, c;
    __device__ __forceinline__ void init(int nM_, int nN_, int G_, int c_) { nM = nM_; nN = nN_; nwg = nM * nN; G = G_; c = c_; }
    __device__ __forceinline__ bool tile(int i, int& pm, int& pn) const {
        const long L = (long)i * G + c; if (L >= nwg) return false;
        int wgid = (int)L; { const int q = nwg / NXCD, r = nwg % NXCD, xcd = wgid % NXCD, off = wgid / NXCD; wgid = (xcd < r ? xcd * (q + 1) : r * (q + 1) + (xcd - r) * q) + off; }
        const int nig = WGM * nN, gid = wgid / nig, fm = gid * WGM, gsz = (nM - fm) < WGM ? (nM - fm) : WGM;
        pm = fm + ((wgid % nig) % gsz); pn = (wgid % nig) / gsz; return true;
    }
};

template <class Epi, class Sched, bool ALIGN_EPI>
__device__ __forceinline__ void gemm_phase(LAS unsigned char* lds, const Sched& S, const Epi& E) {
    int tid_o = threadIdx.x; asm volatile("" : "+v"(tid_o));
    const int tid = tid_o, wid = __builtin_amdgcn_readfirstlane(tid >> 6), lane = tid & 63, wr = wid >> 2, wc = wid & 3; int fr = lane & 15, fq = lane >> 4;
    int sR[2], sC[2], sRb[2];
#pragma unroll
    for (int i = 0; i < 2; ++i) { stage_rc(tid * 16 + i * 8192, sR[i], sC[i]); sRb[i] = Epi::PERM ? ((sR[i] & ~31) + perm32(sR[i] & 31)) : sR[i]; sC[i] *= 2; }
    const size_t kstep = (size_t)(BK * 2);
    const unsigned ldsw = (unsigned)wid * 1024u;
    const int aoff = lds_byte(wr * 64 + fr, fq * 8), boff = lds_byte(wc * 32 + fr, fq * 8);
#define PG8_SA(b, h) (((b) * 2 + (h)) * HTB)
#define PG8_SB(b, h) ((4 + (b) * 2 + (h)) * HTB)
#define PG8_STAGE(bufoff, gbase, rows, ld) do { _Pragma("unroll") for (int _i = 0; _i < 2; ++_i) \
        __builtin_amdgcn_global_load_lds((const unsigned*)((const char*)(gbase) + (unsigned)((rows)[_i] * (ld) + sC[_i])), (LAS unsigned*)(lds + (bufoff) + ldsw + _i * 8192), 16, 0, 0); } while (0)
#define PG8_LDA(dst, b, h) do { _Pragma("unroll") for (int m = 0; m < 4; ++m) _Pragma("unroll") for (int k = 0; k < 2; ++k) dst[m][k] = *(const LAS bf16x8*)(lds + PG8_SA(b, h) + aoff + m * 2048 + k * 1024); } while (0)
#define PG8_LDB(dst, b, h) do { _Pragma("unroll") for (int n = 0; n < 2; ++n) _Pragma("unroll") for (int k = 0; k < 2; ++k) dst[n][k] = *(const LAS bf16x8*)(lds + PG8_SB(b, h) + boff + n * 2048 + k * 1024); } while (0)
#define PG8_MMA(ai, bj, At, Bt) do { __builtin_amdgcn_s_setprio(1); _Pragma("unroll") for (int m = 0; m < 4; ++m) _Pragma("unroll") for (int n = 0; n < 2; ++n) _Pragma("unroll") for (int k = 0; k < 2; ++k) \
        acc[ai][bj][m][n] = __builtin_amdgcn_mfma_f32_16x16x32_bf16(Bt[n][k], At[m][k], acc[ai][bj][m][n], 0, 0, 0); __builtin_amdgcn_s_setprio(0); } while (0)
#define PG8_WAIT_V(n) asm volatile("s_waitcnt vmcnt(" #n ")" ::: "memory")
#define PG8_WAIT_L(n) asm volatile("s_waitcnt lgkmcnt(" #n ")" ::: "memory")
#define PG8_BAR __builtin_amdgcn_s_barrier()
#define PG8_SCHED __builtin_amdgcn_sched_barrier(0)
    GUnit cur, nxt; int ui = 0;
    if (!S.next(0, cur)) return;
    f32x4 acc[2][2][4][2];
#pragma unroll
    for (int a = 0; a < 2; ++a)
#pragma unroll
        for (int b = 0; b < 2; ++b)
#pragma unroll
            for (int m = 0; m < 4; ++m)
#pragma unroll
                for (int n = 0; n < 2; ++n) acc[a][b][m][n] = (f32x4){0.f, 0.f, 0.f, 0.f};
    bf16x8 At[4][2], B0[2][2], B1[2][2];
    int ldAc = cur.lda, ldBc = cur.ldb; size_t hAc = (size_t)HALF * ldAc, hBc = (size_t)HALF * ldBc;
    const char* cA = cur.A; const char* cB = cur.B;
    PG8_STAGE(PG8_SB(0, 0), cB, sRb, ldBc); PG8_STAGE(PG8_SB(0, 1), cB + hBc, sRb, ldBc); PG8_STAGE(PG8_SA(0, 0), cA, sR, ldAc); PG8_STAGE(PG8_SA(0, 1), cA + hAc, sR, ldAc);
    if (wr == 1) PG8_BAR;
    PG8_WAIT_V(2); PG8_BAR;
    PG8_STAGE(PG8_SB(1, 0), cB + kstep, sRb, ldBc); PG8_STAGE(PG8_SA(1, 0), cA + kstep, sR, ldAc); PG8_STAGE(PG8_SB(1, 1), cB + hBc + kstep, sRb, ldBc);
    PG8_WAIT_V(6); PG8_BAR;
    for (;;) {
        const bool has_next = S.next(ui + 1, nxt);
        int ldAn, ldBn; const char* nA; const char* nB;
        if (has_next) { ldAn = nxt.lda; ldBn = nxt.ldb; nA = nxt.A; nB = nxt.B; } else { ldAn = ldAc; ldBn = ldBc; nA = cA; nB = cB; }
        const size_t hAn = (size_t)HALF * ldAn, hBn = (size_t)HALF * ldBn;
        int nt = cur.nt; asm volatile("" : "+s"(nt));
        for (int t = 0; t < nt; t += 2) {
            const bool last = (t == nt - 2);
            const char* a1 = cA + (size_t)(t + 1) * kstep;
            const char* a2 = last ? nA : cA + (size_t)(t + 2) * kstep; const char* b2 = last ? nB : cB + (size_t)(t + 2) * kstep;
            const char* a3 = a2 + kstep; const char* b3 = b2 + kstep;
            const int ldA2 = last ? ldAn : ldAc, ldB2 = last ? ldBn : ldBc;
            const size_t hA2 = last ? hAn : hAc, hB2 = last ? hBn : hBc;
            PG8_LDB(B0, 0, 0); PG8_LDB(B1, 0, 1); PG8_SCHED; PG8_LDA(At, 0, 0); PG8_STAGE(PG8_SA(1, 1), a1 + hAc, sR, ldAc);
            PG8_WAIT_V(8); PG8_WAIT_L(0); PG8_BAR; PG8_MMA(0, 0, At, B0); PG8_MMA(0, 1, At, B1); PG8_BAR; PG8_SCHED;
            PG8_LDA(At, 0, 1); PG8_STAGE(PG8_SB(0, 0), b2, sRb, ldB2); PG8_STAGE(PG8_SB(0, 1), b2 + hB2, sRb, ldB2); PG8_STAGE(PG8_SA(0, 0), a2, sR, ldA2);
            PG8_WAIT_V(8); PG8_WAIT_L(0); PG8_BAR; PG8_MMA(1, 0, At, B0); PG8_MMA(1, 1, At, B1); PG8_BAR; PG8_SCHED;
            PG8_LDB(B0, 1, 0); PG8_LDB(B1, 1, 1); PG8_SCHED; PG8_LDA(At, 1, 0); PG8_STAGE(PG8_SA(0, 1), a2 + hA2, sR, ldA2);
            PG8_WAIT_V(8); PG8_WAIT_L(0); PG8_BAR; PG8_MMA(0, 0, At, B0); PG8_MMA(0, 1, At, B1); PG8_BAR; PG8_SCHED;
            PG8_LDA(At, 1, 1); PG8_STAGE(PG8_SB(1, 0), b3, sRb, ldB2); PG8_STAGE(PG8_SB(1, 1), b3 + hB2, sRb, ldB2); PG8_STAGE(PG8_SA(1, 0), a3, sR, ldA2);
            PG8_WAIT_V(8); PG8_WAIT_L(0); PG8_BAR; PG8_MMA(1, 0, At, B0); PG8_MMA(1, 1, At, B1); PG8_BAR; PG8_SCHED;
        }
        if constexpr (ALIGN_EPI) { if (wr == 0) PG8_BAR; }
        E(acc, cur, wr, wc, fr, fq);
        if (!has_next) break;
#pragma unroll
        for (int a = 0; a < 2; ++a)
#pragma unroll
            for (int b = 0; b < 2; ++b)
#pragma unroll
                for (int m = 0; m < 4; ++m)
#pragma unroll
                    for (int n = 0; n < 2; ++n) acc[a][b][m][n] = (f32x4){0.f, 0.f, 0.f, 0.f};
        cur = nxt; cA = nA; cB = nB; ++ui;
        ldAc = ldAn; ldBc = ldBn; hAc = hAn; hBc = hBn;
        if constexpr (ALIGN_EPI) { if (wr == 1) PG8_BAR; }
    }
    PG8_WAIT_V(0);
    if constexpr (!ALIGN_EPI) { if (wr == 0) PG8_BAR; }
    PG8_BAR;
#undef PG8_SA
#undef PG8_SB
#undef PG8_STAGE
#undef PG8_LDA
#undef PG8_LDB
#undef PG8_MMA
#undef PG8_WAIT_V
#undef PG8_WAIT_L
#undef PG8_BAR
#undef PG8_SCHED
}
}
using pg8::GUnit;
namespace pg8 {
#define EPI_OPAQUE() asm volatile("" : "+v"(fr), "+v"(fq))
struct EpiBf16 {
    static constexpr bool PERM = true;
    bf16_t* O; int ldc;
    __device__ __forceinline__ void operator()(const f32x4 (&acc)[2][2][4][2], const GUnit& u, int wr, int wc, int fr, int fq) const {
        EPI_OPAQUE();
        const int row0 = u.pm * BM + wr * 64 + fr, col0 = u.pn * BM + wc * 32 + 8 * fq;
#pragma unroll
        for (int ai = 0; ai < 2; ++ai)
#pragma unroll
            for (int m = 0; m < 4; ++m) { bf16_t* rowp = O + (size_t)(row0 + ai * HALF + m * 16) * ldc + col0;
#pragma unroll
                for (int bj = 0; bj < 2; ++bj) { const f32x4 v0 = acc[ai][bj][m][0], v1 = acc[ai][bj][m][1];
                    u32x4 w; w.x = cvtpk(v0[0], v0[1]); w.y = cvtpk(v0[2], v0[3]); w.z = cvtpk(v1[0], v1[1]); w.w = cvtpk(v1[2], v1[3]);
                    *(u32x4*)(rowp + bj * HALF) = w; } }
    }
};
struct EpiF32 {
    static constexpr bool PERM = false;
    float* O; int ldc;
    __device__ __forceinline__ void operator()(const f32x4 (&acc)[2][2][4][2], const GUnit& u, int wr, int wc, int fr, int fq) const {
        EPI_OPAQUE();
        const int row0 = u.pm * BM + wr * 64 + fr, col0 = u.pn * BM + wc * 32 + 4 * fq;
#pragma unroll
        for (int ai = 0; ai < 2; ++ai)
#pragma unroll
            for (int m = 0; m < 4; ++m) { float* rowp = O + (size_t)(row0 + ai * HALF + m * 16) * ldc + col0;
#pragma unroll
                for (int bj = 0; bj < 2; ++bj)
#pragma unroll
                    for (int n = 0; n < 2; ++n) *(f32x4*)(rowp + bj * HALF + n * 16) = acc[ai][bj][m][n]; }
    }
};
__device__ __forceinline__ void rope8(f32x4& v0, f32x4& v1, const float* cs  ) {
    const f32x4 a = *(const f32x4*)cs, b = *(const f32x4*)(cs + 4);
    f32x4 r0, r1;
    r0[0] = v0[0] * a[0] - v0[1] * a[1]; r0[1] = v0[1] * a[0] + v0[0] * a[1];
    r0[2] = v0[2] * a[2] - v0[3] * a[3]; r0[3] = v0[3] * a[2] + v0[2] * a[3];
    r1[0] = v1[0] * b[0] - v1[1] * b[1]; r1[1] = v1[1] * b[0] + v1[0] * b[1];
    r1[2] = v1[2] * b[2] - v1[3] * b[3]; r1[3] = v1[3] * b[2] + v1[2] * b[3];
    v0 = r0; v1 = r1;
}
struct EpiInProj {
    static constexpr bool PERM = true;
    bf16_t* P; bf16_t* kcmp; bf16_t* vcmp; float* side; bf16_t* krot; const float* rope; float* ssq_q; float* ssq_kv;
    __device__ __forceinline__ void operator()(const f32x4 (&acc)[2][2][4][2], const GUnit& u, int wr, int wc, int fr, int fq) const {
        EPI_OPAQUE();
        const int row0 = u.pm * BM + wr * 64 + fr, col0 = u.pn * BM + wc * 32 + 8 * fq;
#pragma unroll
        for (int ai = 0; ai < 2; ++ai)
#pragma unroll
            for (int m = 0; m < 4; ++m) { const int row = row0 + ai * HALF + m * 16; bf16_t* rowp = P + (size_t)row * PW + col0;
                float ssq = 0.f;
#pragma unroll
                for (int bj = 0; bj < 2; ++bj) { f32x4 v0 = acc[ai][bj][m][0], v1 = acc[ai][bj][m][1];
                    if (u.pn == 2 && bj == 1) {
                        if (wc == 0 && fq < 2) { float* sp = side + (size_t)row * 16 + 8 * fq; *(f32x4*)sp = v0; *(f32x4*)(sp + 4) = v1; }
                        if (wc == 1) { rope8(v0, v1, rope + (size_t)(row & (SEQ - 1)) * 32 + 8 * fq);
                            u32x4 w; w.x = cvtpk(v0[0], v0[1]); w.y = cvtpk(v0[2], v0[3]); w.z = cvtpk(v1[0], v1[1]); w.w = cvtpk(v1[2], v1[3]);
                            *(u32x4*)(krot + (size_t)row * 32 + 8 * fq) = w; }
                    }
                    u32x4 w; w.x = cvtpk(v0[0], v0[1]); w.y = cvtpk(v0[2], v0[3]); w.z = cvtpk(v1[0], v1[1]); w.w = cvtpk(v1[2], v1[3]);
                    *(u32x4*)(rowp + bj * HALF) = w;
                    if (u.pn == 1 && bj == 0) { bf16_t* cp = (wc < 2 ? kcmp : vcmp) + (size_t)row * 64 + (wc & 1) * 32 + 8 * fq; *(u32x4*)cp = w; }
                    if (u.pn == 11 || (u.pn == 7 && bj == 1)) ssq += (v0[0] * v0[0] + v0[1] * v0[1]) + (v0[2] * v0[2] + v0[3] * v0[3]) + (v1[0] * v1[0] + v1[1] * v1[1]) + (v1[2] * v1[2] + v1[3] * v1[3]);
                }
                if (u.pn == 11 || u.pn == 7) { ssq += xor_lane_lt32<16>(ssq); ssq = sum_halves(ssq);
                    if (fq == 0) (u.pn == 11 ? ssq_q : ssq_kv)[(size_t)row * 4 + wc] = ssq; }
                asm volatile("" ::: "memory");
            }
    }
};
struct EpiQup {
    static constexpr bool PERM = true;
    bf16_t* O; const float* ssq_q; const float* rope;
    __device__ __forceinline__ void operator()(const f32x4 (&acc)[2][2][4][2], const GUnit& u, int wr, int wc, int fr, int fq) const {
        EPI_OPAQUE();
        const int row0 = u.pm * BM + wr * 64 + fr, col0 = u.pn * BM + wc * 32 + 8 * fq;
#pragma unroll
        for (int ai = 0; ai < 2; ++ai)
#pragma unroll
            for (int m = 0; m < 4; ++m) { const int row = row0 + ai * HALF + m * 16; bf16_t* rowp = O + (size_t)row * 512 + col0;
                const f32x4 pq = *(const f32x4*)(ssq_q + (size_t)row * 4);
                const float rstd = 1.0f / sqrtf(((pq[0] + pq[1]) + (pq[2] + pq[3])) * (1.0f / 256.0f) + RMS_EPS);
#pragma unroll
                for (int bj = 0; bj < 2; ++bj) { f32x4 v0 = acc[ai][bj][m][0] * rstd, v1 = acc[ai][bj][m][1] * rstd;
                    const int c8 = col0 + bj * HALF, within = c8 % 96;
                    if (c8 < 384 && within >= 64) rope8(v0, v1, rope + (size_t)(row & (SEQ - 1)) * 32 + (within - 64));
                    u32x4 w; w.x = cvtpk(v0[0], v0[1]); w.y = cvtpk(v0[2], v0[3]); w.z = cvtpk(v1[0], v1[1]); w.w = cvtpk(v1[2], v1[3]);
                    *(u32x4*)(rowp + bj * HALF) = w; }
                asm volatile("" ::: "memory"); }
    }
};
struct EpiKVup {
    static constexpr bool PERM = true;
    bf16_t* O; const float* ssq_kv;
    __device__ __forceinline__ void operator()(const f32x4 (&acc)[2][2][4][2], const GUnit& u, int wr, int wc, int fr, int fq) const {
        EPI_OPAQUE();
        const int row0 = u.pm * BM + wr * 64 + fr, col0 = u.pn * BM + wc * 32 + 8 * fq;
#pragma unroll
        for (int ai = 0; ai < 2; ++ai)
#pragma unroll
            for (int m = 0; m < 4; ++m) { const int row = row0 + ai * HALF + m * 16; bf16_t* rowp = O + (size_t)row * 512 + col0;
                const f32x4 pq = *(const f32x4*)(ssq_kv + (size_t)row * 4);
                const float rstd = 1.0f / sqrtf(((pq[0] + pq[1]) + (pq[2] + pq[3])) * (1.0f / 128.0f) + RMS_EPS);
#pragma unroll
                for (int bj = 0; bj < 2; ++bj) { const f32x4 v0 = acc[ai][bj][m][0] * rstd, v1 = acc[ai][bj][m][1] * rstd;
                    u32x4 w; w.x = cvtpk(v0[0], v0[1]); w.y = cvtpk(v0[2], v0[3]); w.z = cvtpk(v1[0], v1[1]); w.w = cvtpk(v1[2], v1[3]);
                    *(u32x4*)(rowp + bj * HALF) = w; }
                asm volatile("" ::: "memory"); }
    }
};
__device__ __forceinline__ float gelu_tanh(float x) { const float u2 = 2.0f * 0.7978845608028654f * (x + 0.044715f * x * x * x); return x * fast_rcp(1.0f + fast_exp2(-u2 * LOG2E)); }
struct EpiCmp1 {
    static constexpr bool PERM = true;
    bf16_t* O; const float* bias1;
    __device__ __forceinline__ void operator()(const f32x4 (&acc)[2][2][4][2], const GUnit& u, int wr, int wc, int fr, int fq) const {
        EPI_OPAQUE();
        const int row0 = u.pm * BM + wr * 64 + fr, col0 = wc * 32 + 8 * fq;
        f32x4 bv[2][2];
#pragma unroll
        for (int bj = 0; bj < 2; ++bj)
#pragma unroll
            for (int n = 0; n < 2; ++n) bv[bj][n] = *(const f32x4*)(bias1 + col0 + bj * HALF + 4 * n);
#pragma unroll
        for (int ai = 0; ai < 2; ++ai)
#pragma unroll
            for (int m = 0; m < 4; ++m) { bf16_t* rowp = O + (size_t)(row0 + ai * HALF + m * 16) * 256 + col0;
#pragma unroll
                for (int bj = 0; bj < 2; ++bj) { f32x4 v0 = acc[ai][bj][m][0] + bv[bj][0], v1 = acc[ai][bj][m][1] + bv[bj][1];
#pragma unroll
                    for (int e = 0; e < 4; ++e) { v0[e] = gelu_tanh(v0[e]); v1[e] = gelu_tanh(v1[e]); }
                    u32x4 w; w.x = cvtpk(v0[0], v0[1]); w.y = cvtpk(v0[2], v0[3]); w.z = cvtpk(v1[0], v1[1]); w.w = cvtpk(v1[2], v1[3]);
                    *(u32x4*)(rowp + bj * HALF) = w; } }
    }
};
typedef __amdgpu_buffer_rsrc_t rsrc_t;
struct EpiMerge {
    static constexpr bool PERM = true;
    bf16_t* O;
    unsigned char* scr;
    __device__ __forceinline__ void operator()(const f32x4 (&acc)[2][2][4][2], const GUnit& u, int wr, int wc, int fr, int fq) const {
        EPI_OPAQUE();
        const int tid = (wr * 4 + wc) * 64 + fq * 16 + fr;
        const int sub = u.id;
        const rsrc_t rs = __builtin_amdgcn_make_buffer_rsrc(scr, 0, 524288, 0x00020000);
        if (sub < 4) {
#pragma unroll
            for (int ai = 0; ai < 2; ++ai)
#pragma unroll
                for (int bj = 0; bj < 2; ++bj)
#pragma unroll
                    for (int m = 0; m < 4; ++m)
#pragma unroll
                        for (int n = 0; n < 2; ++n) { const int q = ((ai * 2 + bj) * 4 + m) * 2 + n; const f32x4 v = acc[ai][bj][m][n];
                            u32x2 w; w.x = cvtpk(v[0], v[1]); w.y = cvtpk(v[2], v[3]);
                            __builtin_amdgcn_raw_buffer_store_b64(w, rs, tid * 8, (sub * 32 + q) * 4096, 0); }
            return;
        }
        const int j = sub - 4;
        const int row0 = u.pm * BM + wr * 64 + fr, col0 = u.pn * BM + 64 * j + wc * 16 + 4 * fq;
#pragma unroll
        for (int ai = 0; ai < 2; ++ai)
#pragma unroll
            for (int m = 0; m < 4; ++m) { bf16_t* rowp = O + (size_t)(row0 + ai * HALF + m * 16) * DM + col0;
                f32x4 t = {0.f, 0.f, 0.f, 0.f};
#pragma unroll
                for (int g = 0; g < 4; ++g) { const f32x4 gt = acc[ai][g >> 1][m][g & 1];
                    const int qb = (ai * 16 + m * 2);
                    const u32x2 s = (j == 0) ? __builtin_amdgcn_raw_buffer_load_b64(rs, tid * 8, (g * 32 + qb) * 4096, 0)
                                  : (j == 1) ? __builtin_amdgcn_raw_buffer_load_b64(rs, tid * 8, (g * 32 + qb + 1) * 4096, 0)
                                  : (j == 2) ? __builtin_amdgcn_raw_buffer_load_b64(rs, tid * 8, (g * 32 + qb + 8) * 4096, 0)
                                             : __builtin_amdgcn_raw_buffer_load_b64(rs, tid * 8, (g * 32 + qb + 9) * 4096, 0);
                    t[0] += sigmoid_f(gt[0]) * __uint_as_float(s.x << 16); t[1] += sigmoid_f(gt[1]) * __uint_as_float(s.x & 0xffff0000u);
                    t[2] += sigmoid_f(gt[2]) * __uint_as_float(s.y << 16); t[3] += sigmoid_f(gt[3]) * __uint_as_float(s.y & 0xffff0000u); }
                u32x2 w; w.x = cvtpk(t[0], t[1]); w.y = cvtpk(t[2], t[3]);
                *(u32x2*)rowp = w;
                asm volatile("" ::: "memory"); }
    }
};
__device__ __forceinline__ float dpp_ror1(float v) { return __uint_as_float((unsigned)__builtin_amdgcn_update_dpp(0, (int)__float_as_uint(v), 0x121, 0xf, 0xf, false)); }
__device__ __forceinline__ float dpp_ror2(float v) { return __uint_as_float((unsigned)__builtin_amdgcn_update_dpp(0, (int)__float_as_uint(v), 0x122, 0xf, 0xf, false)); }
struct EpiUpConv {
    static constexpr bool PERM = true;
    bf16_t* ACT; float* HB; const float* cw; const float* cb;
    __device__ __forceinline__ void operator()(const f32x4 (&acc)[2][2][4][2], const GUnit& u, int wr, int wc, int fr, int fq) const {
        EPI_OPAQUE();
        const int colL = wc * 32 + 8 * fq;
#pragma unroll
        for (int ai = 0; ai < 2; ++ai) {
            const int rowg = u.pm * BM + ai * HALF + wr * 64, g = rowg >> 6;
#pragma unroll
            for (int n = 0; n < 2; ++n) {
                const int cl = colL + 4 * n, c0 = u.pn * 128 + cl;
                f32x4 t1g, t2g, t1v, t2v;
#pragma unroll
                for (int e = 0; e < 4; ++e) { t1g[e] = 0.f; t2g[e] = 0.f; t1v[e] = 0.f; t2v[e] = 0.f; }
#pragma unroll
                for (int m = 0; m < 4; ++m) {
                    const f32x4 bg = *(const f32x4*)(cb + c0), w0g = *(const f32x4*)(cw + c0), w1g = *(const f32x4*)(cw + DFF2 + c0), w2g = *(const f32x4*)(cw + 2 * DFF2 + c0);
                    const f32x4 bv = *(const f32x4*)(cb + DFF + c0), w0v = *(const f32x4*)(cw + DFF + c0), w1v = *(const f32x4*)(cw + DFF2 + DFF + c0), w2v = *(const f32x4*)(cw + 2 * DFF2 + DFF + c0);
                    const f32x4 cg = acc[ai][0][m][n], cv = acc[ai][1][m][n];
                    f32x4 r1g, r2g, r1v, r2v, o;
#pragma unroll
                    for (int e = 0; e < 4; ++e) { r1g[e] = dpp_ror1(cg[e]); r2g[e] = dpp_ror2(cg[e]); r1v[e] = dpp_ror1(cv[e]); r2v[e] = dpp_ror2(cv[e]); }
#pragma unroll
                    for (int e = 0; e < 4; ++e) { const float p1g = (fr == 0) ? t1g[e] : r1g[e], p2g = (fr < 2) ? t2g[e] : r2g[e], p1v = (fr == 0) ? t1v[e] : r1v[e], p2v = (fr < 2) ? t2v[e] : r2v[e];
                        const float gt = bg[e] + w0g[e] * p2g + w1g[e] * p1g + w2g[e] * cg[e], vl = bv[e] + w0v[e] * p2v + w1v[e] * p1v + w2v[e] * cv[e];
                        o[e] = gt * sigmoid_f(gt) * vl; }
                    const int row = rowg + m * 16 + fr;
                    if (!(m == 0 && fr < 2)) { u32x2 w; w.x = cvtpk(o[0], o[1]); w.y = cvtpk(o[2], o[3]); *(u32x2*)(ACT + (size_t)row * DFF + c0) = w; }
                    if (m == 0 && fr < 2) { float* hp = HB + ((size_t)((g * 4 + fr) * 22 + u.pn) * 256 + cl); *(f32x4*)hp = cg; *(f32x4*)(hp + 128) = cv; }
                    if (m == 3 && fr >= 14) { float* hp = HB + ((size_t)((g * 4 + fr - 12) * 22 + u.pn) * 256 + cl); *(f32x4*)hp = cg; *(f32x4*)(hp + 128) = cv; }
                    t1g = r1g; t2g = r2g; t1v = r1v; t2v = r2v;
                    asm volatile("" ::: "memory");
                }
            }
        }
    }
};
}
#define XB_TMO      128
#define XB_XCNT(j)  (256  + 64 * (j))
#define XB_XSUB(j)  (1280 + 64 * (j))
#define XB_XGEN(j)  (2304 + 64 * (j))
#define XB_TOP      3328
#define XB_TOPGEN   3392
#define XCD_BAR_WORDS 3456
#define XB_SPIN_CAP (1u << 22)
__device__ __forceinline__ unsigned xb_ld(unsigned* p)              { return __hip_atomic_load(p, __ATOMIC_RELAXED, __HIP_MEMORY_SCOPE_AGENT); }
__device__ __forceinline__ unsigned xb_add(unsigned* p, unsigned v) { return __hip_atomic_fetch_add(p, v, __ATOMIC_RELAXED, __HIP_MEMORY_SCOPE_AGENT); }
__device__ __forceinline__ unsigned xb_xcc_id() { return (unsigned)__builtin_amdgcn_s_getreg((3 << 11) | 20) & 0xFu; }
#define XB_SPIN(cond, bar) do { unsigned _sp = 0; while (cond) { __builtin_amdgcn_s_sleep(1); \
    if ((++_sp & 255u) == 0u) { if (xb_ld(&(bar)[XB_TMO])) break; if (_sp > XB_SPIN_CAP) { atomicAdd(&(bar)[XB_TMO], 1u); break; } } } } while (0)
struct XcdBarrier { unsigned* bar; unsigned x; volatile LAS unsigned* st; };
__device__ __forceinline__ XcdBarrier xcd_barrier_post(unsigned* bar, volatile LAS unsigned* st) {
    XcdBarrier b; b.bar = bar; b.x = xb_xcc_id(); b.st = st;
    if (threadIdx.x == 0) (void)xb_add(&bar[XB_XCNT(b.x)], 1u);
    return b;
}
__device__ __forceinline__ void xcd_barrier_complete(unsigned* bar, unsigned x, unsigned& nloc, unsigned& nx) {
    const unsigned G = gridDim.x * gridDim.y * gridDim.z;
    unsigned sum, cnt, mine, sp = 0u;
    for (;;) {
        sum = 0u; cnt = 0u; mine = 0u;
#pragma unroll
        for (unsigned j = 0; j < 16; ++j) { const unsigned c = xb_ld(&bar[XB_XCNT(j)]); sum += c; cnt += (c > 0u) ? 1u : 0u; mine = (j == x) ? c : mine; }
        if (sum == G) break;
        __builtin_amdgcn_s_sleep(1);
        if ((++sp & 255u) == 0u) { if (xb_ld(&bar[XB_TMO])) break; if (sp > XB_SPIN_CAP) { atomicAdd(&bar[XB_TMO], 1u); break; } }
    }
    nloc = mine > 0u ? mine : 1u; nx = cnt > 0u ? cnt : 1u;
}
__device__ __forceinline__ void xcd_barrier(const XcdBarrier& b) {
    asm volatile("s_waitcnt vmcnt(0)" ::: "memory");
    __syncthreads();
    if (threadIdx.x == 0) {
        unsigned* bar = b.bar; unsigned bx = b.x;
        asm volatile("" : "+s"(bx));
        __builtin_amdgcn_s_waitcnt(0);
        unsigned nloc = b.st[0], nx = b.st[1];
        if (nloc == 0u) { xcd_barrier_complete(bar, bx, nloc, nx); b.st[0] = nloc; b.st[1] = nx; }
        const unsigned old = xb_add(&bar[XB_XSUB(bx)], 1u);
        const unsigned gen = old / nloc;
        if (old + 1u == (gen + 1u) * nloc) {
            __builtin_amdgcn_fence(__ATOMIC_RELEASE, "agent");
            asm volatile("s_waitcnt vmcnt(0)" ::: "memory");
            const unsigned og = xb_add(&bar[XB_TOP], 1u);
            const unsigned tg = og / nx;
            if (og + 1u == (tg + 1u) * nx) xb_add(&bar[XB_TOPGEN], 1u);
            else XB_SPIN(xb_ld(&bar[XB_TOPGEN]) == tg, bar);
            __builtin_amdgcn_fence(__ATOMIC_ACQUIRE, "agent");
            xb_add(&bar[XB_XGEN(bx)], 1u);
            asm volatile("s_waitcnt vmcnt(0)" ::: "memory");
        } else {
            XB_SPIN(xb_ld(&bar[XB_XGEN(bx)]) == gen, bar);
            __builtin_amdgcn_fence(__ATOMIC_ACQUIRE, "agent");
            asm volatile("s_waitcnt vmcnt(0)" ::: "memory");
        }
    }
    __syncthreads();
}

#define MFMA32(a, b, c) __builtin_amdgcn_mfma_f32_32x32x16_bf16(a, b, c, 0, 0, 0)
typedef short v4i16_t __attribute__((ext_vector_type(4)));
typedef LAS const char* lds_cptr;
typedef LAS char* lds_ptr;
__device__ __forceinline__ int crow(int r, int hi) { return (r & 3) + 8 * (r >> 2) + 4 * hi; }
__device__ __forceinline__ s16x4 vtr(lds_cptr p) { return __builtin_bit_cast(s16x4, __builtin_amdgcn_ds_read_tr16_b64_v4i16((LAS v4i16_t*)p)); }
__device__ __forceinline__ float other_half(float x, int hi) { auto rr = __builtin_amdgcn_permlane32_swap(__float_as_uint(x), __float_as_uint(x), false, false); return __uint_as_float(hi ? rr[0] : rr[1]); }
constexpr float NEG_INF = -INFINITY;

constexpr int TB_V = 12288, TB_KB = 20480, TB_SIZE = 20992;
struct Stg { u32x4 k, k2, v; float kb; };

template <int NKS> __device__ __forceinline__ void qk64(lds_cptr kbuf, const bf16x8* qf, int r32, int hi, f32x16& p0, f32x16& p1) {
    lds_cptr kp = kbuf + hi * 1024 + r32 * 16;
#pragma unroll
    for (int ks = 0; ks < NKS; ++ks) {
        const bf16x8 a0 = *(const LAS bf16x8*)(kp + ks * 2048), a1 = *(const LAS bf16x8*)(kp + ks * 2048 + 512);
        p0 = MFMA32(a0, qf[ks], p0); p1 = MFMA32(a1, qf[ks], p1);
    }
}
struct AState { f32x16 o0, o1; float m, l; };
__device__ __forceinline__ void astate_init(AState& s) {
#pragma unroll
    for (int r = 0; r < 16; ++r) { s.o0[r] = 0.f; s.o1[r] = 0.f; }
    s.m = NEG_INF; s.l = 0.f;
}
__device__ __forceinline__ void pv64(f32x16& o0, f32x16& o1, lds_cptr vp, const bf16x8 (&pf)[4]) {
#pragma unroll
    for (int ks = 0; ks < 4; ++ks) {
        const s16x4 l0 = vtr(vp + ks * 1024), h0 = vtr(vp + ks * 1024 + 512), l1 = vtr(vp + 4096 + ks * 1024), h1 = vtr(vp + 4096 + ks * 1024 + 512);
        const bf16x8 v0 = (bf16x8){l0[0], l0[1], l0[2], l0[3], h0[0], h0[1], h0[2], h0[3]}, v1 = (bf16x8){l1[0], l1[1], l1[2], l1[3], h1[0], h1[1], h1[2], h1[3]};
        o0 = MFMA32(v0, pf[ks], o0); o1 = MFMA32(v1, pf[ks], o1);
    }
}
__device__ __forceinline__ void pack_p(const f32x16& p0, const f32x16& p1, bf16x8 (&pf)[4]) {
    u32x4 w0, w1, w2, w3;
    w0.x = cvtpk(p0[0], p0[1]); w0.y = cvtpk(p0[2], p0[3]); w0.z = cvtpk(p0[4], p0[5]); w0.w = cvtpk(p0[6], p0[7]);
    w1.x = cvtpk(p0[8], p0[9]); w1.y = cvtpk(p0[10], p0[11]); w1.z = cvtpk(p0[12], p0[13]); w1.w = cvtpk(p0[14], p0[15]);
    w2.x = cvtpk(p1[0], p1[1]); w2.y = cvtpk(p1[2], p1[3]); w2.z = cvtpk(p1[4], p1[5]); w2.w = cvtpk(p1[6], p1[7]);
    w3.x = cvtpk(p1[8], p1[9]); w3.y = cvtpk(p1[10], p1[11]); w3.z = cvtpk(p1[12], p1[13]); w3.w = cvtpk(p1[14], p1[15]);
    pf[0] = __builtin_bit_cast(bf16x8, w0); pf[1] = __builtin_bit_cast(bf16x8, w1); pf[2] = __builtin_bit_cast(bf16x8, w2); pf[3] = __builtin_bit_cast(bf16x8, w3);
}
__device__ __forceinline__ void softmax_pv64(f32x16& p0, f32x16& p1, AState& s, lds_cptr vp, int hi) {
    float mx = fmaxf(p0[0], p1[0]);
#pragma unroll
    for (int r = 1; r < 16; ++r) mx = fmaxf(mx, fmaxf(p0[r], p1[r]));
    mx = fmaxf(mx, other_half(mx, hi));
    const float mn = fmaxf(s.m, mx), ms = (mn == NEG_INF) ? 0.f : mn;
    const float alpha = fast_exp2(s.m - ms);
    float rs = 0.f;
#pragma unroll
    for (int r = 0; r < 16; ++r) { p0[r] = fast_exp2(p0[r] - ms); p1[r] = fast_exp2(p1[r] - ms); rs += p0[r] + p1[r]; }
    rs += other_half(rs, hi);
    s.l = s.l * alpha + rs; s.m = mn;
#pragma unroll
    for (int r = 0; r < 16; ++r) { s.o0[r] *= alpha; s.o1[r] *= alpha; }
    bf16x8 pf[4]; pack_p(p0, p1, pf);
    pv64(s.o0, s.o1, vp, pf);
}
__device__ __forceinline__ void mask_causal(f32x16& p0, f32x16& p1, int kpos0, int tq, int hi) {
#pragma unroll
    for (int r = 0; r < 16; ++r) { const int kp = kpos0 + crow(r, hi); if (kp > tq) p0[r] = NEG_INF; if (kp + 32 > tq) p1[r] = NEG_INF; }
}
__device__ __forceinline__ void add_table(f32x16& p0, f32x16& p1, const LAS float* tb) {
#pragma unroll
    for (int r = 0; r < 16; ++r) { const int o = (r & 3) + 8 * (r >> 2); p0[r] += tb[o]; p1[r] += tb[o + 32]; }
}
__device__ __forceinline__ void store_o_bf16(bf16_t* orow, const f32x16& o0, const f32x16& o1, float sc, int hi) {
#pragma unroll
    for (int g = 0; g < 4; ++g) {
        u32x2 w0, w1; w0.x = cvtpk(o0[4 * g] * sc, o0[4 * g + 1] * sc); w0.y = cvtpk(o0[4 * g + 2] * sc, o0[4 * g + 3] * sc);
        w1.x = cvtpk(o1[4 * g] * sc, o1[4 * g + 1] * sc); w1.y = cvtpk(o1[4 * g + 2] * sc, o1[4 * g + 3] * sc);
        *(u32x2*)(orow + 8 * g + 4 * hi) = w0; *(u32x2*)(orow + 32 + 8 * g + 4 * hi) = w1;
    }
}
constexpr size_t MiB = 1u << 20, KiB = 1u << 10;
constexpr size_t WS_CTL = 0, CTL_ZERO_BYTES = 1 * MiB;
constexpr size_t WS_ROPE = 1 * MiB, WS_NSATAB = WS_ROPE + 512 * KiB, WS_DILTAB = WS_NSATAB + 32 * KiB, WS_CMPB = WS_DILTAB + 8 * KiB, WS_FARB = WS_CMPB + 4 * KiB;
constexpr size_t WS_WT = 4 * MiB, LW = 38 * MiB;
constexpr size_t LW_IN = 0, LW_G = 6 * MiB, LW_BR = 14 * MiB, LW_O = 16 * MiB, LW_UP = 18 * MiB, LW_DN = 29 * MiB, LW_UQ = 35 * MiB, LW_UKV = 35 * MiB + 256 * KiB, LW_PHI = 36 * MiB;
constexpr size_t BR_A = 0, BR_B = 512 * KiB, BR_C = 768 * KiB, BR_D = 1280 * KiB;
constexpr size_t WS_SIDE = 80 * MiB, WS_SSQQ = 84 * MiB, WS_SSQKV = 85 * MiB, WS_KB = 86 * MiB, WS_KROT = 87 * MiB, WS_KCMP = 91 * MiB, WS_VCMP = 100 * MiB,
                 WS_HID = 109 * MiB, WS_KC = 113 * MiB, WS_VC = 113 * MiB + 512 * KiB, WS_DLSE = 114 * MiB, WS_DOG = 116 * MiB;
constexpr size_t WS_H = 164 * MiB, WS_OCAT = 292 * MiB, WS_QM = 404 * MiB, WS_KVM = 468 * MiB, WS_P = 532 * MiB;
constexpr size_t WS_MERGED = 532 * MiB, WS_MSCR = 660 * MiB, WS_Y = 164 * MiB  , WS_H2 = 756 * MiB, WS_ACT = 164 * MiB  , WS_HB = 532 * MiB  , WS_Y2 = 884 * MiB  , WS_END = 1024 * MiB;
constexpr size_t MSCR_PER_WG = 512 * KiB;
static_assert(WS_WT + 2 * LW <= WS_SIDE && WS_DOG + 48 * MiB <= WS_H && WS_P + 384 * MiB <= WS_END && WS_MSCR + 256 * MSCR_PER_WG <= WS_P + 384 * MiB && WS_H2 + 128 * MiB <= WS_Y2 && WS_Y2 + 128 * MiB <= WS_END, "ws map");
static_assert(WS_ACT + 352 * MiB <= WS_HB && WS_HB + 96 * MiB <= WS_H2 && WS_Y + 128 * MiB <= WS_OCAT, "ws overlays");
constexpr int CW_BAR = 4096;
constexpr int CW_Q = 16384;

constexpr int RING_BYTES = 131072, LDSCTL_OFF = RING_BYTES, MISC_OFF = LDSCTL_OFF + 320, LDS_BYTES = 147456;
constexpr int NSA_SLAB = 49152, NSA_SLAB_BYTES = 4 * 64 * 65 * 4, NSA_SEL = NSA_SLAB + NSA_SLAB_BYTES;
static_assert(NSA_SEL + 512 <= RING_BYTES && 4 * NSA_TL * 4 <= NSA_SLAB_BYTES && 2 * TB_SIZE <= NSA_SLAB, "NSA LDS map");

struct Frame {
    LAS unsigned char* lds; volatile LAS unsigned* MISC; gu32* ctl;
    int tid, lane, wave, G;
    const float* in[27]; float* out; unsigned char* ws;
};
#define WSP(T, off) ((T*)(F.ws + (off)))
#define VM_WAIT() asm volatile("s_waitcnt vmcnt(0)" ::: "memory")
#define LDS_WAIT() asm volatile("s_waitcnt lgkmcnt(0)" ::: "memory")

__device__ __forceinline__ int queue_grab(Frame& F, gu32* ctr) {
    if (F.tid == 0) F.MISC[0] = __hip_atomic_fetch_add(ctr, 1u, __ATOMIC_RELAXED, __HIP_MEMORY_SCOPE_AGENT);
    __syncthreads();
    const int v = (int)F.MISC[0];
    __syncthreads();
    return v;
}

template <bool FOX> __device__ __forceinline__ void causal_unit(Frame& F, int b, int h, int qb) {
    constexpr int NKS = FOX ? 4 : 6;
    int lane_o = F.lane; asm volatile("" : "+v"(lane_o));
    const int wid = F.wave, lane = lane_o, r32 = lane & 31, hi = lane >> 5;
    const size_t rowbase = (size_t)b * SEQ;
    const int q0 = qb * 256, tq = q0 + wid * 32 + r32, NT = qb * 4 + 4;
    const bf16_t* P = WSP(const bf16_t, WS_P);
    const bf16_t *Kb, *Vb, *Qrow; int kpitch, vpitch;
    const bf16_t* Kr = WSP(const bf16_t, WS_KROT) + rowbase * 32;
    const float* kbsrc = WSP(const float, WS_KB) + (size_t)(b * 4 + h) * SEQ;
    if (FOX) { Kb = P + rowbase * PW + PC_CK + h * 64; Vb = P + rowbase * PW + PC_CV + h * 64; kpitch = PW; vpitch = PW; Qrow = P + (rowbase + tq) * PW + PC_CQ + h * 64; }
    else { const bf16_t* KV = WSP(const bf16_t, WS_KVM) + rowbase * 512 + h * 128; Kb = KV; Vb = KV + 64; kpitch = 512; vpitch = 512; Qrow = WSP(const bf16_t, WS_QM) + (rowbase + tq) * 512 + h * 96; }
    bf16x8 qf[NKS];
#pragma unroll
    for (int ks = 0; ks < NKS; ++ks) qf[ks] = *(const bf16x8*)(Qrow + ks * 16 + hi * 8);
    AState st; astate_init(st);
    lds_ptr lds = (lds_ptr)F.lds;
    const int vpo = ((lane >> 4) & 1) * 32 + (lane & 3) * 8 + (4 * hi + ((lane & 15) >> 2)) * 64;
    Stg s;
#define CU_LOAD(t) do { s.k = *(const u32x4*)(Kb + (size_t)((t) * 64 + lane) * kpitch + wid * 8); \
        if (!FOX) { if (wid < 4) s.k2 = *(const u32x4*)(Kr + (size_t)((t) * 64 + lane) * 32 + wid * 8); } \
        s.v = *(const u32x4*)(Vb + (size_t)((t) * 64 + 16 * (wid & 3) + (lane >> 2)) * vpitch + (wid >> 2) * 32 + (lane & 3) * 8); \
        if (FOX) { if (wid == 0) s.kb = kbsrc[(t) * 64 + lane]; } } while (0)
#define CU_WRITE(bi) do { lds_ptr bp = lds + (bi) * TB_SIZE; *(LAS u32x4*)(bp + wid * 1024 + lane * 16) = s.k; \
        if (!FOX) { if (wid < 4) *(LAS u32x4*)(bp + (8 + wid) * 1024 + lane * 16) = s.k2; } \
        *(LAS u32x4*)(bp + TB_V + wid * 1024 + lane * 16) = s.v; \
        if (FOX) { if (wid == 0) *(LAS float*)(bp + TB_KB + lane * 4) = s.kb; } } while (0)
    CU_LOAD(0); CU_WRITE(0);
    __syncthreads();
    const int tq_lo = q0 + wid * 32;
    for (int t = 0; t < NT; ++t) {
        const int bi = t & 1;
        if (t + 1 < NT) CU_LOAD(t + 1);
        if (64 * t <= tq_lo + 31) {
            lds_cptr bp = (lds_cptr)(lds + bi * TB_SIZE);
            f32x16 p0, p1;
#pragma unroll
            for (int r = 0; r < 16; ++r) { p0[r] = 0.f; p1[r] = 0.f; }
            qk64<NKS>(bp, qf, r32, hi, p0, p1);
            if (FOX) {
                const LAS float* kbt = (const LAS float*)(bp + TB_KB) + 4 * hi;
#pragma unroll
                for (int g = 0; g < 4; ++g) { const f32x4 a = *(const LAS f32x4*)(kbt + 8 * g), c = *(const LAS f32x4*)(kbt + 32 + 8 * g);
#pragma unroll
                    for (int e = 0; e < 4; ++e) { p0[4 * g + e] += a[e]; p1[4 * g + e] += c[e]; } }
            }
            if (64 * t + 63 > tq_lo) mask_causal(p0, p1, 64 * t, tq, hi);
            softmax_pv64(p0, p1, st, bp + TB_V + vpo, hi);
        }
        if (t + 1 < NT) CU_WRITE(bi ^ 1);
        __syncthreads();
    }
#undef CU_LOAD
#undef CU_WRITE
    bf16_t* orow = WSP(bf16_t, WS_OCAT) + (rowbase + tq) * OCW + (FOX ? 384 : 640) + h * 64;
    store_o_bf16(orow, st.o0, st.o1, 1.0f / st.l, hi);
}
__device__ __forceinline__ void nsa_unit(Frame& F, int b, int qblk) {
    int lane_o = F.lane; asm volatile("" : "+v"(lane_o));
    const int wid = F.wave, lane = lane_o, r32 = lane & 31, hi = lane >> 5, tid = wid * 64 + lane;
    const int h = wid & 3, qs = wid >> 2;
    const int q0 = qblk * 64, cur = qblk, tq = q0 + 32 * qs + r32, tq_lo = q0 + 32 * qs;
    const size_t rowbase = (size_t)b * SEQ, row = rowbase + tq;
    const bf16_t* P = WSP(const bf16_t, WS_P);
    lds_ptr lds = (lds_ptr)F.lds;
    const int vpo = ((lane >> 4) & 1) * 32 + (lane & 3) * 8 + (4 * hi + ((lane & 15) >> 2)) * 64;
    bf16x8 qf[4];
    { const bf16_t* Qrow = P + row * PW + PC_AQ + h * 64;
#pragma unroll
      for (int ks = 0; ks < 4; ++ks) qf[ks] = *(const bf16x8*)(Qrow + ks * 16 + hi * 8); }
    Stg s; int ln;
#define NS_LOAD(Kb, kp, Vb, vp_, t) do { s.k = *(const u32x4*)((Kb) + (size_t)((t) * 64 + ln) * (kp) + wid * 8); \
        s.v = *(const u32x4*)((Vb) + (size_t)((t) * 64 + 16 * (wid & 3) + (ln >> 2)) * (vp_) + (wid >> 2) * 32 + (ln & 3) * 8); } while (0)
#define NS_FRESH() do { ln = lane; asm volatile("" : "+v"(ln)); } while (0)
#define NS_WRITE(bi) do { lds_ptr bp_ = lds + (bi) * TB_SIZE; *(LAS u32x4*)(bp_ + wid * 1024 + lane * 16) = s.k; *(LAS u32x4*)(bp_ + TB_V + wid * 1024 + lane * 16) = s.v; } while (0)
    const bf16_t* KC = WSP(const bf16_t, WS_KC) + (size_t)b * 256 * 64; const bf16_t* VC = WSP(const bf16_t, WS_VC) + (size_t)b * 256 * 64;
    const int cmax_u = (q0 + 63 - 31) >> 4, NTc = (cmax_u >> 6) + 1;
    const int cmax = (tq - 31) >> 4;
    float cm = NEG_INF, cl = 0.f;
    NS_FRESH(); NS_LOAD(KC, 64, VC, 64, 0); NS_WRITE(0);
    __syncthreads();
    for (int t = 0; t < NTc; ++t) {
        const int bi = t & 1;
        if (t + 1 < NTc) NS_LOAD(KC, 64, VC, 64, t + 1);
        { lds_cptr bp = (lds_cptr)(lds + bi * TB_SIZE); f32x16 p0, p1;
#pragma unroll
          for (int r = 0; r < 16; ++r) { p0[r] = 0.f; p1[r] = 0.f; }
          qk64<4>(bp, qf, r32, hi, p0, p1);
          float mx = NEG_INF;
#pragma unroll
          for (int r = 0; r < 16; ++r) { const int c = 64 * t + crow(r, hi); if (c > cmax) p0[r] = NEG_INF; if (c + 32 > cmax) p1[r] = NEG_INF; mx = fmaxf(mx, fmaxf(p0[r], p1[r])); }
          mx = fmaxf(mx, other_half(mx, hi));
          const float mn = fmaxf(cm, mx), ms = (mn == NEG_INF) ? 0.f : mn; float rs = 0.f;
#pragma unroll
          for (int r = 0; r < 16; ++r) rs += fast_exp2(p0[r] - ms) + fast_exp2(p1[r] - ms);
          rs += other_half(rs, hi);
          cl = cl * fast_exp2(cm - ms) + rs; cm = mn; }
        if (t + 1 < NTc) NS_WRITE(bi ^ 1);
        __syncthreads();
    }
    const float cms = (cm == NEG_INF) ? 0.f : cm, cinv = 1.0f / fmaxf(cl, 1e-30f);
    f32x16 oc0, oc1;
#pragma unroll
    for (int r = 0; r < 16; ++r) { oc0[r] = 0.f; oc1[r] = 0.f; }
    float G[32]; float carry = 0.f;
#pragma unroll
    for (int i = 0; i < 32; ++i) G[i] = 0.f;
    NS_FRESH(); NS_LOAD(KC, 64, VC, 64, 0); NS_WRITE(0);
    __syncthreads();
#pragma unroll
    for (int t = 0; t < 4; ++t) {
        if (t < NTc) {
            const int bi = t & 1;
            if (t + 1 < NTc) NS_LOAD(KC, 64, VC, 64, t + 1);
            { lds_cptr bp = (lds_cptr)(lds + bi * TB_SIZE); f32x16 p0, p1;
#pragma unroll
              for (int r = 0; r < 16; ++r) { p0[r] = 0.f; p1[r] = 0.f; }
              qk64<4>(bp, qf, r32, hi, p0, p1);
#pragma unroll
              for (int r = 0; r < 16; ++r) { const int c = 64 * t + crow(r, hi);
                  p0[r] = (c > cmax) ? 0.f : fast_exp2(p0[r] - cms) * cinv; p1[r] = (c + 32 > cmax) ? 0.f : fast_exp2(p1[r] - cms) * cinv; }
#pragma unroll
              for (int g = 0; g < 4; ++g) { const float oth = other_half(p0[4 * g + 3], hi);
                  G[t * 8 + g] = ((p0[4 * g] + p0[4 * g + 1]) + (p0[4 * g + 2] + p0[4 * g + 3])) + (hi ? oth : carry); carry = oth; }
#pragma unroll
              for (int g = 0; g < 4; ++g) { const float oth = other_half(p1[4 * g + 3], hi);
                  G[t * 8 + 4 + g] = ((p1[4 * g] + p1[4 * g + 1]) + (p1[4 * g + 2] + p1[4 * g + 3])) + (hi ? oth : carry); carry = oth; }
              bf16x8 pf[4]; pack_p(p0, p1, pf);
              pv64(oc0, oc1, bp + TB_V + vpo, pf); }
            if (t + 1 < NTc) NS_WRITE(bi ^ 1);
            __syncthreads();
        }
    }
    { LAS float* slab = (LAS float*)(lds + NSA_SLAB) + (size_t)(h * 64 + 32 * qs + r32) * 65;
#pragma unroll
      for (int i = 0; i < 32; ++i) slab[2 * i + hi] = G[i]; }
    __syncthreads();
    { const int q = tid >> 3, jg = tid & 7;
      const LAS float* s0 = (const LAS float*)(lds + NSA_SLAB) + (size_t)q * 65;
      float v[64];
#pragma unroll
      for (int k = 0; k < 64; ++k) { const float x = (s0[k] + s0[64 * 65 + k]) + (s0[2 * 64 * 65 + k] + s0[3 * 64 * 65 + k]);
          v[k] = (k == 0 || k == cur || k == cur - 1) ? 1e9f : ((k > cur) ? -1e9f : x); if ((k & 7) == 7) asm volatile("" ::: "memory"); }
      unsigned bits = 0u;
#pragma unroll
      for (int e = 0; e < 8; ++e) { const int j = 8 * jg + e;
          const float xj = (s0[j] + s0[64 * 65 + j]) + (s0[2 * 64 * 65 + j] + s0[3 * 64 * 65 + j]);
          const float vj = (j == 0 || j == cur || j == cur - 1) ? 1e9f : ((j > cur) ? -1e9f : xj);
          int rank = 0;
#pragma unroll
          for (int k = 0; k < 64; ++k) rank += (v[k] > vj || (v[k] == vj && k < j)) ? 1 : 0;
          bits |= (rank < 16 ? 1u : 0u) << e; }
      *((LAS unsigned char*)(lds + NSA_SEL) + q * 8 + jg) = (unsigned char)bits; }
    __syncthreads();
    const unsigned mlo = *(const LAS unsigned*)(lds + NSA_SEL + (32 * qs + r32) * 8), mhi = *(const LAS unsigned*)(lds + NSA_SEL + (32 * qs + r32) * 8 + 4);
    { const u32x4* src = WSP(const u32x4, WS_NSATAB); LAS u32x4* dst = (LAS u32x4*)(lds + NSA_SLAB);
      for (int i = tid; i < 4 * NSA_TL / 4; i += 512) dst[i] = src[i]; }
    const LAS float* tabh = (const LAS float*)(lds + NSA_SLAB) + h * NSA_TL;
    const float farb = WSP(const float, WS_FARB)[h];
    float g0, g1, g2;
    { int tq_ = tq; asm volatile("" : "+v"(tq_)); const float* sd = WSP(const float, WS_SIDE) + (rowbase + tq_) * 16 + h * 3; g0 = sigmoid_f(sd[0]); g1 = sigmoid_f(sd[1]); g2 = sigmoid_f(sd[2]); }
    AState st; astate_init(st);
    { const bf16_t* Kb = P + rowbase * PW + PC_KSLC; const bf16_t* Vb = P + rowbase * PW + PC_VSLC;
      NS_FRESH(); NS_LOAD(Kb, PW, Vb, PW, 0); NS_WRITE(0);
      __syncthreads();
      for (int j = 0; j <= cur; ++j) {
          const int bi = j & 1;
          if (j < cur) NS_LOAD(Kb, PW, Vb, PW, j + 1);
          const bool mine = ((j < 32) ? (mlo >> j) : (mhi >> (j - 32))) & 1u;
          if (__any(mine)) {
              lds_cptr bp = (lds_cptr)(lds + bi * TB_SIZE); f32x16 p0, p1;
#pragma unroll
              for (int r = 0; r < 16; ++r) { p0[r] = 0.f; p1[r] = 0.f; }
              qk64<4>(bp, qf, r32, hi, p0, p1);
              if (q0 - 64 * j - 63 >= NSA_DFAR) {
#pragma unroll
                  for (int r = 0; r < 16; ++r) { p0[r] += farb; p1[r] += farb; }
              } else add_table(p0, p1, tabh + (NSA_DMAX - tq + 64 * j + 4 * hi));
              if (j == cur) mask_causal(p0, p1, 64 * j, tq, hi);
              if (!mine) {
#pragma unroll
                  for (int r = 0; r < 16; ++r) { p0[r] = NEG_INF; p1[r] = NEG_INF; } }
              softmax_pv64(p0, p1, st, bp + TB_V + vpo, hi);
          }
          if (j < cur) NS_WRITE(bi ^ 1);
          __syncthreads();
      } }
    f32x16 oa0, oa1;
    { const float sc = g1 / st.l;
#pragma unroll
      for (int r = 0; r < 16; ++r) { oa0[r] = g0 * oc0[r] + sc * st.o0[r]; oa1[r] = g0 * oc1[r] + sc * st.o1[r]; } }
    astate_init(st);
    { const bf16_t* Kb = P + rowbase * PW + PC_KWIN; const bf16_t* Vb = P + rowbase * PW + PC_VWIN;
      const int jlo = cur >= 8 ? cur - 8 : 0;
      NS_FRESH(); NS_LOAD(Kb, PW, Vb, PW, jlo); NS_WRITE(0);
      __syncthreads();
      for (int j = jlo; j <= cur; ++j) {
          const int bi = (j - jlo) & 1;
          if (j < cur) NS_LOAD(Kb, PW, Vb, PW, j + 1);
          if (tq_lo - 64 * j - 63 < 512) {
              lds_cptr bp = (lds_cptr)(lds + bi * TB_SIZE); f32x16 p0, p1;
#pragma unroll
              for (int r = 0; r < 16; ++r) { p0[r] = 0.f; p1[r] = 0.f; }
              qk64<4>(bp, qf, r32, hi, p0, p1);
              add_table(p0, p1, tabh + (NSA_DMAX - tq + 64 * j + 4 * hi));
              if (!(tq_lo - 64 * j - 63 >= 0 && tq_lo + 31 - 64 * j < 512)) {
                  const int d0 = tq - 64 * j - 4 * hi;
#pragma unroll
                  for (int r = 0; r < 16; ++r) { const int d = d0 - ((r & 3) + 8 * (r >> 2)); if (d < 0 || d >= 512) p0[r] = NEG_INF; if (d - 32 < 0 || d - 32 >= 512) p1[r] = NEG_INF; }
              }
              softmax_pv64(p0, p1, st, bp + TB_V + vpo, hi);
          }
          if (j < cur) NS_WRITE(bi ^ 1);
          __syncthreads();
      } }
    { const float sc = g2 / st.l;
#pragma unroll
      for (int r = 0; r < 16; ++r) { oa0[r] += sc * st.o0[r]; oa1[r] += sc * st.o1[r]; } }
    { int tq_ = tq; asm volatile("" : "+v"(tq_)); store_o_bf16(WSP(bf16_t, WS_OCAT) + (rowbase + tq_) * OCW + h * 64, oa0, oa1, 1.0f, hi); }
#undef NS_LOAD
#undef NS_FRESH
#undef NS_WRITE
}
__device__ __forceinline__ void dil_unit(Frame& F, int b, int hh, int span) {
    int lane_o = F.lane; asm volatile("" : "+v"(lane_o));
    const int wid = F.wave, lane = lane_o, r32 = lane & 31, hi = lane >> 5, tid = wid * 64 + lane;
    const int T0 = span * 512;
    const size_t rowbase = (size_t)b * SEQ;
    const bf16_t* P = WSP(const bf16_t, WS_P) + rowbase * PW;
    lds_ptr lds = (lds_ptr)F.lds;
    LAS float* dtab = (LAS float*)(lds + 32768);
    for (int i = tid; i < 3 * 192; i += 512) dtab[i] = WSP(const float, WS_DILTAB)[((i / 192) * 2 + hh) * 192 + (i % 192)];
    __syncthreads();
    lds_ptr vst = lds + wid * 4096;
    const int vpo = ((lane >> 4) & 1) * 32 + (lane & 3) * 8 + (4 * hi + ((lane & 15) >> 2)) * 64;
    bf16_t* DOG = WSP(bf16_t, WS_DOG); float* DLSE = WSP(float, WS_DLSE);
    for (int g = 0; g < 3; ++g) {
        const int sh = 2 * g, head = 2 * g + hh;
        for (int rep = 0; rep < 2; ++rep) {
            const int wt = wid + 8 * rep;
            const int res = (g == 0) ? 0 : (g == 1 ? (wt & 3) : wt);
            const int i0 = (g == 0) ? 32 * wt : (g == 1 ? 32 * (wt >> 2) : 0);
            const int n0 = (T0 >> sh) + i0;
            const int tokq = res + ((n0 + r32) << sh);
            bf16x8 qf[4];
            { const bf16_t* Qrow = P + (size_t)tokq * PW + PC_BQ + head * 64;
#pragma unroll
              for (int ks = 0; ks < 4; ++ks) qf[ks] = *(const bf16x8*)(Qrow + ks * 16 + hi * 8); }
            f32x16 o0, o1; float m = NEG_INF, l = 0.f;
#pragma unroll
            for (int r = 0; r < 16; ++r) { o0[r] = 0.f; o1[r] = 0.f; }
            for (int c = 0; c < 5; ++c) {
                const int nk0 = n0 - 128 + 32 * c;
                if (nk0 + 31 < 0) continue;
                { int nk = nk0 + r32; nk = nk < 0 ? 0 : nk; const bf16_t* Krow = P + (size_t)(res + (nk << sh)) * PW + PC_BK + head * 64;
                  bf16x8 kf[4];
#pragma unroll
                  for (int ks = 0; ks < 4; ++ks) kf[ks] = *(const bf16x8*)(Krow + ks * 16 + hi * 8);
                  u32x4 vr[4];
#pragma unroll
                  for (int i = 0; i < 4; ++i) { const int pc = lane + 64 * i, vrow = pc >> 3, c16 = pc & 7; int nv = nk0 + vrow; nv = nv < 0 ? 0 : nv;
                      vr[i] = *(const u32x4*)(P + (size_t)(res + (nv << sh)) * PW + PC_BV + head * 64 + c16 * 8); }
#pragma unroll
                  for (int i = 0; i < 4; ++i) { const int pc = lane + 64 * i, vrow = pc >> 3, c16 = pc & 7;
                      *(LAS u32x4*)(vst + (c16 >> 2) * 2048 + vrow * 64 + (c16 & 3) * 16) = vr[i]; }
                  asm volatile("s_waitcnt lgkmcnt(0)" ::: "memory");
                  f32x16 p;
#pragma unroll
                  for (int r = 0; r < 16; ++r) p[r] = 0.f;
#pragma unroll
                  for (int ks = 0; ks < 4; ++ks) p = MFMA32(kf[ks], qf[ks], p);
                  const LAS float* tb = dtab + g * 192 + (32 - r32 + 4 * hi + 32 * c);
                  float mx = NEG_INF;
#pragma unroll
                  for (int r = 0; r < 16; ++r) { const int o = (r & 3) + 8 * (r >> 2), kk = o + 4 * hi, j = 128 + r32 - 32 * c - kk;
                      const bool ok = (j >= 0) && (j <= 128) && (nk0 + kk >= 0);
                      p[r] = ok ? p[r] + tb[o] : NEG_INF; mx = fmaxf(mx, p[r]); }
                  mx = fmaxf(mx, other_half(mx, hi));
                  const float mn = fmaxf(m, mx), ms = (mn == NEG_INF) ? 0.f : mn, alpha = fast_exp2(m - ms);
                  float rs = 0.f;
#pragma unroll
                  for (int r = 0; r < 16; ++r) { p[r] = fast_exp2(p[r] - ms); rs += p[r]; }
                  rs += other_half(rs, hi);
                  l = l * alpha + rs; m = mn;
#pragma unroll
                  for (int r = 0; r < 16; ++r) { o0[r] *= alpha; o1[r] *= alpha; }
                  u32x4 w0, w1;
                  w0.x = cvtpk(p[0], p[1]); w0.y = cvtpk(p[2], p[3]); w0.z = cvtpk(p[4], p[5]); w0.w = cvtpk(p[6], p[7]);
                  w1.x = cvtpk(p[8], p[9]); w1.y = cvtpk(p[10], p[11]); w1.z = cvtpk(p[12], p[13]); w1.w = cvtpk(p[14], p[15]);
                  const bf16x8 pf0 = __builtin_bit_cast(bf16x8, w0), pf1 = __builtin_bit_cast(bf16x8, w1);
                  lds_cptr vp = (lds_cptr)(vst + vpo);
#pragma unroll
                  for (int ks = 0; ks < 2; ++ks) {
                      const s16x4 l0 = vtr(vp + ks * 1024), h0 = vtr(vp + ks * 1024 + 512), l1 = vtr(vp + 2048 + ks * 1024), h1 = vtr(vp + 2048 + ks * 1024 + 512);
                      const bf16x8 v0 = (bf16x8){l0[0], l0[1], l0[2], l0[3], h0[0], h0[1], h0[2], h0[3]}, v1 = (bf16x8){l1[0], l1[1], l1[2], l1[3], h1[0], h1[1], h1[2], h1[3]};
                      o0 = MFMA32(v0, ks == 0 ? pf0 : pf1, o0); o1 = MFMA32(v1, ks == 0 ? pf0 : pf1, o1);
                  }
                  asm volatile("s_waitcnt lgkmcnt(0)" ::: "memory"); }
            }
            const size_t orow = rowbase + tokq;
            store_o_bf16(DOG + ((size_t)g * M + orow) * 128 + hh * 64, o0, o1, 1.0f / l, hi);
            if (hi == 0) DLSE[((size_t)g * M + orow) * 2 + hh] = m + log2f(l);
        }
    }
    VM_WAIT();
    __syncthreads();
    bf16_t* OC = WSP(bf16_t, WS_OCAT);
    for (int it = 0; it < 8; ++it) {
        const int item = tid + 512 * it, tl = item >> 3, pc = item & 7; const size_t orow = rowbase + T0 + tl;
        const float l0 = DLSE[((size_t)0 * M + orow) * 2 + hh], l1 = DLSE[((size_t)1 * M + orow) * 2 + hh], l2 = DLSE[((size_t)2 * M + orow) * 2 + hh];
        const float mx = fmaxf(l0, fmaxf(l1, l2)); float w0 = fast_exp2(l0 - mx), w1 = fast_exp2(l1 - mx), w2 = fast_exp2(l2 - mx);
        const float inv = 1.0f / (w0 + w1 + w2); w0 *= inv; w1 *= inv; w2 *= inv;
        const u32x4 a = *(const u32x4*)(DOG + ((size_t)0 * M + orow) * 128 + hh * 64 + pc * 8), bb = *(const u32x4*)(DOG + ((size_t)1 * M + orow) * 128 + hh * 64 + pc * 8),
                    cc = *(const u32x4*)(DOG + ((size_t)2 * M + orow) * 128 + hh * 64 + pc * 8);
        u32x4 w;
#pragma unroll
        for (int e = 0; e < 4; ++e) {
            const float lo = w0 * __uint_as_float(a[e] << 16) + w1 * __uint_as_float(bb[e] << 16) + w2 * __uint_as_float(cc[e] << 16);
            const float hv = w0 * __uint_as_float(a[e] & 0xffff0000u) + w1 * __uint_as_float(bb[e] & 0xffff0000u) + w2 * __uint_as_float(cc[e] & 0xffff0000u);
            w[e] = cvtpk(lo, hv); }
        *(u32x4*)(OC + orow * OCW + 256 + hh * 64 + pc * 8) = w;
    }
    __syncthreads();
}
__device__ __forceinline__ float wave_sum(float v) {
    v += xor_lane_lt32<1>(v); v += xor_lane_lt32<2>(v); v += xor_lane_lt32<4>(v); v += xor_lane_lt32<8>(v); v += xor_lane_lt32<16>(v);
    return sum_halves(v);
}
__device__ __forceinline__ int rel_bucket(int dist) {
    if (dist < 0) dist = 0;
    if (dist < 16) return dist;
    const int thr[15] = {22, 30, 40, 54, 73, 99, 134, 182, 246, 332, 450, 609, 825, 1117, 1513};
    int bkt = 16;
#pragma unroll
    for (int i = 0; i < 15; ++i) bkt += (dist >= thr[i]) ? 1 : 0;
    return bkt;
}
__device__ __forceinline__ int inproj_src(int c, float& sc) {
    sc = 1.f;
    if (c < 256) { sc = C2A; return c; }
    if (c < 652) return c;
    if (c < 656) return 2572 + (c - 652);
    if (c < 672) return -1;
    if (c < 704) { const int p = c - 672; return 2960 + (p >> 1) + 16 * (p & 1); }
    if (c < 768) return -1;
    if (c < 1920) { const int r = c - 768; if (r < 384) sc = C2A; return 652 + r; }
    if (c < 2048) return 2832 + (c - 1920);
    if (c < 2816) { const int r = c - 2048; if (r < 256) sc = C2A; return 1804 + r; }
    return 2576 + (c - 2816);
}
__device__ __forceinline__ int quq_src(int r, float& sc) {
    sc = C2D;
    if (r >= 384) return -1;
    const int hd = r / 96, w = r % 96;
    if (w < 64) return hd * 96 + w;
    const int p = w - 64; return hd * 96 + 64 + (p >> 1) + 16 * (p & 1);
}
__device__ __forceinline__ int gateperm_src(int r) {
    const int T = r >> 8, c = r & 255, pn = T >> 2, j = T & 3, bj = c >> 7, wc = (c >> 5) & 3, fq = (c >> 3) & 3, n = (c >> 2) & 1, e = c & 3;
    return (2 * bj + n) * DM * DM + 256 * pn + 64 * j + 16 * wc + 4 * fq + e;
}
__device__ __forceinline__ int branchperm_src(int r) {
    const int pn = r >> 8, c = r & 255, bj = c >> 7, wc = (c >> 5) & 3, fq = (c >> 3) & 3, n = (c >> 2) & 1, e = c & 3;
    return 256 * pn + 64 * (2 * bj + n) + 16 * wc + 4 * fq + e;
}
__device__ __forceinline__ int upperm_src(int r) { const int pn = r >> 8, c = r & 255; return (c & 128) ? DFF + 128 * pn + (c & 127) : 128 * pn + c; }
__device__ __forceinline__ void wconv_item(const float* W, int Nsrc, bf16_t* WT, int ldt, const float* kgain, int kind, LAS float* scr, int item, int nblk, int lane) {
    const int kb = item / nblk, nb = item % nblk, k0 = 64 * kb, n0 = 32 * nb;
    const int n = n0 + (lane & 31); float sc = 1.f; int src = n;
    if (kind == 1) src = inproj_src(n, sc); else if (kind == 2) src = quq_src(n, sc); else if (kind == 3) src = gateperm_src(n); else if (kind == 4) src = branchperm_src(n); else if (kind == 5) src = upperm_src(n);
#pragma unroll 8
    for (int i = 0; i < 32; ++i) { const int kk = 2 * i + (lane >> 5); float v = (src >= 0) ? W[(size_t)(k0 + kk) * Nsrc + src] * sc : 0.f; if (kgain) v *= kgain[k0 + kk]; scr[kk * 33 + (lane & 31)] = v; }
    LDS_WAIT(); asm volatile("" ::: "memory");
    const int c = lane & 7;
#pragma unroll
    for (int j = 0; j < 4; ++j) { const int nn = (lane >> 3) + 8 * j; const LAS float* s = scr + (8 * c) * 33 + nn;
        u32x4 o; o.x = pk2(s[0 * 33], s[1 * 33]); o.y = pk2(s[2 * 33], s[3 * 33]); o.z = pk2(s[4 * 33], s[5 * 33]); o.w = pk2(s[6 * 33], s[7 * 33]);
        *(u32x4*)(WT + (size_t)(n0 + nn) * ldt + k0 + 8 * c) = o; }
    LDS_WAIT(); asm volatile("" ::: "memory");
}
__device__ __forceinline__ void p0_prologue(Frame& F) {
    LAS float* scr = (LAS float*)(F.lds + F.wave * 16384);
    const int gw = blockIdx.x * 8 + F.wave, NGW = F.G * 8, lane = F.lane;
    constexpr int I_IN = 16 * 96, I_G = 16 * 32, I_BA = 4 * 32, I_BB = 2 * 32, I_O = 16 * 32, I_UP = 16 * 176, I_DN = 44 * 32, I_UQ = 4 * 16, I_UKV = 2 * 16, I_PHI = 32 * 4;
    constexpr int I_L = I_IN + 4 * I_G + 3 * I_BA + I_BB + I_O + I_UP + I_DN + I_UQ + I_UKV + 2 * I_PHI;
    for (int it = gw; it < DEPTH * I_L; it += NGW) {
        const int l = it / I_L; int r = it % I_L;
        unsigned char* wl = F.ws + WS_WT + (size_t)l * LW;
        if (r < I_IN) { wconv_item(F.in[6] + (size_t)l * DM * DIN, DIN, (bf16_t*)(wl + LW_IN), DM, nullptr, 1, scr, r, 96, lane); continue; } r -= I_IN;
        if (r < 4 * I_G) { wconv_item(F.in[21] + (size_t)l * 4 * DM * DM, DM, (bf16_t*)(wl + LW_G), DM, nullptr, 3, scr, r, 128, lane); continue; } r -= 4 * I_G;
        if (r < I_BA) { wconv_item(F.in[17] + (size_t)l * 256 * DM, DM, (bf16_t*)(wl + LW_BR + BR_A), 256, nullptr, 4, scr, r, 32, lane); continue; } r -= I_BA;
        if (r < I_BB) { wconv_item(F.in[18] + (size_t)l * 128 * DM, DM, (bf16_t*)(wl + LW_BR + BR_B), 128, nullptr, 4, scr, r, 32, lane); continue; } r -= I_BB;
        if (r < I_BA) { wconv_item(F.in[19] + (size_t)l * 256 * DM, DM, (bf16_t*)(wl + LW_BR + BR_C), 256, nullptr, 4, scr, r, 32, lane); continue; } r -= I_BA;
        if (r < I_BA) { wconv_item(F.in[20] + (size_t)l * 256 * DM, DM, (bf16_t*)(wl + LW_BR + BR_D), 256, nullptr, 4, scr, r, 32, lane); continue; } r -= I_BA;
        if (r < I_O) { wconv_item(F.in[22] + (size_t)l * DM * DM, DM, (bf16_t*)(wl + LW_O), DM, nullptr, 0, scr, r, 32, lane); continue; } r -= I_O;
        if (r < I_UP) { wconv_item(F.in[23] + (size_t)l * DM * DFF2, DFF2, (bf16_t*)(wl + LW_UP), DM, nullptr, 5, scr, r, 176, lane); continue; } r -= I_UP;
        if (r < I_DN) { wconv_item(F.in[26] + (size_t)l * DFF * DM, DM, (bf16_t*)(wl + LW_DN), DFF, nullptr, 0, scr, r, 32, lane); continue; } r -= I_DN;
        if (r < I_UQ) { wconv_item(F.in[15] + (size_t)l * 256 * 384, 384, (bf16_t*)(wl + LW_UQ), 256, F.in[13] + l * 256, 2, scr, r, 16, lane); continue; } r -= I_UQ;
        if (r < I_UKV) { wconv_item(F.in[16] + (size_t)l * 128 * 512, 512, (bf16_t*)(wl + LW_UKV), 128, F.in[14] + l * 128, 0, scr, r, 16, lane); continue; } r -= I_UKV;
        if (r < I_PHI) { wconv_item(F.in[8] + (size_t)l * 2048 * 128, 128, (bf16_t*)(wl + LW_PHI), 2048, nullptr, 0, scr, r, 4, lane); continue; } r -= I_PHI;
        wconv_item(F.in[10] + (size_t)l * 2048 * 128, 128, (bf16_t*)(wl + LW_PHI) + (size_t)128 * 2048, 2048, nullptr, 0, scr, r, 4, lane);
    }
    const int gt = blockIdx.x * 512 + F.tid, NGT = F.G * 512;
    const float* rel = F.in[1];
    float* rope = WSP(float, WS_ROPE);
    for (int i = gt; i < SEQ * 16; i += NGT) { const int t = i >> 4, k = i & 15; const float inv = powf(10000.0f, -(float)(2 * k) / 32.0f); const float ang = (float)t * inv;
        float sn, cs; sincosf(ang, &sn, &cs); rope[2 * i] = cs; rope[2 * i + 1] = sn; }
    float* ntab = WSP(float, WS_NSATAB);
    for (int i = gt; i < 4 * NSA_TL; i += NGT) { const int hd = i / NSA_TL, k = i % NSA_TL, dist = NSA_DMAX - k; ntab[i] = dist >= 0 ? rel[rel_bucket(dist) * 10 + hd] * LOG2E : 0.f; }
    float* dtab = WSP(float, WS_DILTAB);
    for (int i = gt; i < 6 * 192; i += NGT) { const int gh = i / 192, k = i % 192, g = gh >> 1, hh = gh & 1, j = 160 - k; dtab[i] = (j >= 0 && j <= 128) ? rel[rel_bucket(j << (2 * g)) * 10 + 4 + 2 * g + hh] * LOG2E : 0.f; }
    if (gt < 4) WSP(float, WS_FARB)[gt] = rel[31 * 10 + gt] * LOG2E;
    for (int i = gt; i < DEPTH * 256; i += NGT) { const int l = i >> 8, n = i & 255; const float* w1 = (n < 128 ? F.in[8] : F.in[10]) + (size_t)l * 2048 * 128 + (n & 127); const float* cp = F.in[7] + (size_t)l * 2048;
        float a = 0.f; for (int p = 0; p < 2048; ++p) a += cp[p] * w1[(size_t)p * 128]; WSP(float, WS_CMPB)[i] = a; }
}

template <int MODE> __device__ __forceinline__ void rowpass(Frame& F, const float* x, const bf16_t* y, size_t yrow0, float* xout, bf16_t* hout, const float* g1, const float* g2, int row_lo, int row_hi) {
    const int gw = blockIdx.x * 8 + F.wave, NGW = F.G * 8, lane = F.lane;
    f32x4 ga[4], gb[4];
#pragma unroll
    for (int j = 0; j < 4; ++j) { ga[j] = *(const f32x4*)(g1 + 4 * lane + 256 * j); if (MODE == 1) gb[j] = *(const f32x4*)(g2 + 4 * lane + 256 * j); }
    for (int m = row_lo + gw; m < row_hi; m += NGW) {
        f32x4 v[4];
        const f32x4* xr = (const f32x4*)(x + (size_t)m * DM) + lane;
#pragma unroll
        for (int j = 0; j < 4; ++j) v[j] = xr[64 * j];
        if (MODE != 0) {
            const u32x2* yr = (const u32x2*)(y + ((size_t)m - yrow0) * DM) + lane; f32x4 w[4]; float s = 0.f;
#pragma unroll
            for (int j = 0; j < 4; ++j) { const u32x2 yy = yr[64 * j]; w[j][0] = __uint_as_float(yy.x << 16); w[j][1] = __uint_as_float(yy.x & 0xffff0000u); w[j][2] = __uint_as_float(yy.y << 16); w[j][3] = __uint_as_float(yy.y & 0xffff0000u);
                s += (w[j][0] * w[j][0] + w[j][1] * w[j][1]) + (w[j][2] * w[j][2] + w[j][3] * w[j][3]); }
            const float rstd = 1.0f / sqrtf(wave_sum(s) * (1.0f / DM) + RMS_EPS);
            f32x4* xo = (f32x4*)(xout + (size_t)m * DM) + lane;
#pragma unroll
            for (int j = 0; j < 4; ++j) { v[j] = v[j] + w[j] * rstd * ga[j]; xo[64 * j] = v[j]; }
        }
        if (MODE != 2) {
            float s = 0.f;
#pragma unroll
            for (int j = 0; j < 4; ++j) s += (v[j][0] * v[j][0] + v[j][1] * v[j][1]) + (v[j][2] * v[j][2] + v[j][3] * v[j][3]);
            const float rstd = 1.0f / sqrtf(wave_sum(s) * (1.0f / DM) + RMS_EPS);
            u32x2* ho = (u32x2*)(hout + (size_t)m * DM) + lane;
#pragma unroll
            for (int j = 0; j < 4; ++j) { const f32x4 gg = (MODE == 1) ? gb[j] : ga[j]; const f32x4 o = v[j] * rstd * gg; u32x2 w; w.x = cvtpk(o[0], o[1]); w.y = cvtpk(o[2], o[3]); ho[64 * j] = w; }
        }
    }
}

__device__ __forceinline__ void ffn_fix_panel(Frame& F, int pm, const float* HB, bf16_t* ACT, const float* cw, const float* cb) {
    for (int it = F.tid; it < 4 * 2 * (DFF / 4); it += 512) {
        const int c4 = it % (DFF / 4), rr = (it / (DFF / 4)) & 1, g = pm * 4 + it / (2 * (DFF / 4)), c = c4 * 4, pn = c >> 7, cl = c & 127;
        const bool first = ((g * 64) & (SEQ - 1)) == 0;
#define HBV(gg, s, bj) (*(const f32x4*)(HB + ((size_t)(((gg) * 4 + (s)) * 22 + pn) * 256 + (bj) * 128 + cl)))
        const f32x4 z = {0.f, 0.f, 0.f, 0.f};
        const f32x4 u0g = HBV(g, 0, 0), u0v = HBV(g, 0, 1);
        f32x4 ag, bg_, cg, av, bv_, cv;
        if (rr == 0) { ag = first ? z : HBV(g - 1, 2, 0); bg_ = first ? z : HBV(g - 1, 3, 0); cg = u0g; av = first ? z : HBV(g - 1, 2, 1); bv_ = first ? z : HBV(g - 1, 3, 1); cv = u0v; }
        else { ag = first ? z : HBV(g - 1, 3, 0); bg_ = u0g; cg = HBV(g, 1, 0); av = first ? z : HBV(g - 1, 3, 1); bv_ = u0v; cv = HBV(g, 1, 1); }
#undef HBV
        const f32x4 kb = *(const f32x4*)(cb + c), k0 = *(const f32x4*)(cw + c), k1 = *(const f32x4*)(cw + DFF2 + c), k2 = *(const f32x4*)(cw + 2 * DFF2 + c);
        const f32x4 vb = *(const f32x4*)(cb + DFF + c), v0 = *(const f32x4*)(cw + DFF + c), v1 = *(const f32x4*)(cw + DFF2 + DFF + c), v2 = *(const f32x4*)(cw + 2 * DFF2 + DFF + c);
        float o[4];
#pragma unroll
        for (int e = 0; e < 4; ++e) { const float gt = kb[e] + k0[e] * ag[e] + k1[e] * bg_[e] + k2[e] * cg[e], vl = vb[e] + v0[e] * av[e] + v1[e] * bv_[e] + v2[e] * cv[e]; o[e] = gt * sigmoid_f(gt) * vl; }
        u32x2 w; w.x = cvtpk(o[0], o[1]); w.y = cvtpk(o[2], o[3]);
        *(u32x2*)(ACT + (size_t)(g * 64 + rr) * DFF + c) = w;
    }
}
#ifdef SELFCHECK
constexpr int CW_CHK = 20480;
__device__ __forceinline__ unsigned chk_hash(unsigned x) { x ^= x >> 16; x *= 0x7feb352du; x ^= x >> 15; x *= 0x846ca68bu; x ^= x >> 16; return x; }
__device__ __forceinline__ int chk_t(int i) {
    int r = 0;
    switch (i & 31) { case 0: r = 0; break; case 1: r = 1; break; case 2: r = 15; break; case 3: r = 16; break; case 4: r = 30; break; case 5: r = 31; break; case 6: r = 32; break; case 7: r = 47; break;
        case 8: r = 63; break; case 9: r = 64; break; case 10: r = 65; break; case 11: r = 127; break; case 12: r = 128; break; case 13: r = 129; break; case 14: r = 255; break; case 15: r = 256; break;
        case 16: r = 257; break; case 17: r = 511; break; case 18: r = 512; break; case 19: r = 513; break; case 20: r = 575; break; case 21: r = 1023; break; case 22: r = 1024; break; case 23: r = 1599; break;
        case 24: r = 1600; break; case 25: r = 2047; break; case 26: r = 2048; break; case 27: r = 2111; break; case 28: r = 3000; break; case 29: r = 4031; break; case 30: r = 4032; break; default: r = 4095; break; }
    return (i < 64) ? r : (int)(chk_hash(i * 7919u + 13u) & 4095u);
}
__device__ __forceinline__ bool chk_bad(float got, float ref, float scale) { const float d = fabsf(got - ref); return !(d <= 0.02f * fabsf(ref) + 0.02f * scale); }
__device__ __forceinline__ float bfr(float x) { return bf2f((unsigned short)f2bf(x)); }
__device__ __forceinline__ void chk_flag(Frame& F, int bit, bool bad, int allow) {
    LAS unsigned* cnt = (LAS unsigned*)(F.lds + 65536);
    __syncthreads(); if (threadIdx.x == 0) *cnt = 0u; __syncthreads();
    if (bad) atomicAdd((unsigned*)cnt, 1u);
    __syncthreads();
    if (threadIdx.x == 0 && *cnt > (unsigned)allow) atomicOr((unsigned*)(F.ctl + CW_CHK), 1u << bit);
    __syncthreads();
}
__device__ __forceinline__ int chk_bucket_ref(int dist) {
    if (dist < 0) dist = 0; if (dist < 16) return dist;
    const float d = (float)dist; int large = 16 + (int)(logf(d / 16.0f) / 4.852030263919617f * 16.0f); return large < 31 ? large : 31;
}
__device__ __forceinline__ bool chk_fox(Frame& F, int b, int h, int t) {
    const bf16_t* P = WSP(const bf16_t, WS_P);
    { const size_t row = (size_t)b * SEQ + t; const bf16_t* q = P + row * PW + PC_CQ + h * 64; const float* kb = WSP(const float, WS_KB) + ((size_t)b * 4 + h) * SEQ;
      float m = -INFINITY; for (int j = 0; j <= t; ++j) { const bf16_t* k = P + ((size_t)b * SEQ + j) * PW + PC_CK + h * 64; float s = 0.f; for (int d = 0; d < 64; ++d) s += bf2f(q[d]) * bf2f(k[d]); s += kb[j]; m = fmaxf(m, s); }
      float lsum = 0.f, dummy0_ = 0.f; f32x4 o = {0.f, 0.f, 0.f, 0.f};
      for (int j = 0; j <= t; ++j) { const bf16_t* k = P + ((size_t)b * SEQ + j) * PW + PC_CK + h * 64; const bf16_t* v = P + ((size_t)b * SEQ + j) * PW + PC_CV + h * 64; float s = 0.f; for (int d = 0; d < 64; ++d) s += bf2f(q[d]) * bf2f(k[d]); s += kb[j];
          const float p = exp2f(s - m); lsum += p; _Pragma("unroll") for (int e = 0; e < 4; ++e) o[e] += p * bf2f(v[21 * e]); }
      bool bad = false; _Pragma("unroll") for (int e = 0; e < 4; ++e) bad |= chk_bad(bf2f(WSP(const bf16_t, WS_OCAT)[row * OCW + 384 + h * 64 + 21 * e]), o[e] / lsum, 0.5f);
      return bad; }
}
__device__ __forceinline__ bool chk_dil(Frame& F, int b, int hh, int t) {
    const bf16_t* P = WSP(const bf16_t, WS_P); const float* rel = F.in[1];
    { const size_t row = (size_t)b * SEQ + t;
      float m = -INFINITY;
      for (int g = 0; g < 3; ++g) { const int dil = 1 << (2 * g), head = 2 * g + hh; const bf16_t* q = P + row * PW + PC_BQ + head * 64;
          for (int j = 0; j <= 128; ++j) { const int idx = t - dil * j; if (idx < 0) break; const bf16_t* k = P + ((size_t)b * SEQ + idx) * PW + PC_BK + head * 64; float s = 0.f; for (int d = 0; d < 64; ++d) s += bf2f(q[d]) * bf2f(k[d]);
              s += rel[chk_bucket_ref(dil * j) * 10 + 4 + head] * LOG2E; m = fmaxf(m, s); } }
      float lsum = 0.f, dummy0_ = 0.f; f32x4 o = {0.f, 0.f, 0.f, 0.f};
      for (int g = 0; g < 3; ++g) { const int dil = 1 << (2 * g), head = 2 * g + hh; const bf16_t* q = P + row * PW + PC_BQ + head * 64;
          for (int j = 0; j <= 128; ++j) { const int idx = t - dil * j; if (idx < 0) break; const bf16_t* k = P + ((size_t)b * SEQ + idx) * PW + PC_BK + head * 64; const bf16_t* v = P + ((size_t)b * SEQ + idx) * PW + PC_BV + head * 64; float s = 0.f; for (int d = 0; d < 64; ++d) s += bf2f(q[d]) * bf2f(k[d]);
              s += rel[chk_bucket_ref(dil * j) * 10 + 4 + head] * LOG2E; const float p = exp2f(s - m); lsum += p; _Pragma("unroll") for (int e = 0; e < 4; ++e) o[e] += p * bf2f(v[21 * e]); } }
      bool bad = false; _Pragma("unroll") for (int e = 0; e < 4; ++e) bad |= chk_bad(bf2f(WSP(const bf16_t, WS_OCAT)[row * OCW + 256 + hh * 64 + 21 * e]), o[e] / lsum, 0.5f);
      return bad; }
}
__device__ __forceinline__ bool chk_nsa(Frame& F, int b, int h, int t, int i) {
    const bf16_t* P = WSP(const bf16_t, WS_P); const float* rel = F.in[1];
    { bool bad = false;
      { const size_t row = (size_t)b * SEQ + t; const size_t rb = (size_t)b * SEQ;
      const bf16_t* KC = WSP(const bf16_t, WS_KC) + (size_t)b * 256 * 64; const bf16_t* VC = WSP(const bf16_t, WS_VC) + (size_t)b * 256 * 64;
      const int cmax = (t >= 31) ? (t - 31) / 16 : -1, cur = t >> 6;
      LAS float* imp = (LAS float*)(F.lds + 70000) + i * 65; for (int j = 0; j < 64; ++j) imp[j] = 0.f;
      f32x4 oc = {0.f, 0.f, 0.f, 0.f};
      for (int hh = 0; hh < 4; ++hh) { const bf16_t* q = P + row * PW + PC_AQ + hh * 64; float m = -INFINITY;
          for (int c = 0; c <= cmax; ++c) { float s = 0.f; for (int d = 0; d < 64; ++d) s += bf2f(q[d]) * bf2f(KC[c * 64 + d]); m = fmaxf(m, s); }
          float ls = 0.f; for (int c = 0; c <= cmax; ++c) { float s = 0.f; for (int d = 0; d < 64; ++d) s += bf2f(q[d]) * bf2f(KC[c * 64 + d]); ls += exp2f(s - m); }
          for (int c = 0; c <= cmax; ++c) { float s = 0.f; for (int d = 0; d < 64; ++d) s += bf2f(q[d]) * bf2f(KC[c * 64 + d]); const float p = exp2f(s - m) / ls;
              for (int j = 0; j < 64; ++j) if (16 * c <= 64 * j + 63 && 16 * c + 31 >= 64 * j) imp[j] += p;
              if (hh == h) _Pragma("unroll") for (int e = 0; e < 4; ++e) oc[e] += p * bf2f(VC[c * 64 + 21 * e]); } }
      for (int j = 0; j < 64; ++j) imp[j] = (j == 0 || j == cur || j == cur - 1) ? 1e9f : (j > cur ? -1e9f : imp[j]);
      unsigned long long selm = 0ull;
      for (int j = 0; j < 64; ++j) { int rank = 0; for (int k = 0; k < 64; ++k) rank += (imp[k] > imp[j] || (imp[k] == imp[j] && k < j)) ? 1 : 0; if (rank < 16) selm |= 1ull << j; }
      const bf16_t* q = P + row * PW + PC_AQ + h * 64;
      f32x4 os = {0.f, 0.f, 0.f, 0.f}, ow = {0.f, 0.f, 0.f, 0.f};
      { float m = -INFINITY; for (int pos = 0; pos <= t; ++pos) { if (!((selm >> (pos >> 6)) & 1ull)) continue; const bf16_t* k = P + (rb + pos) * PW + PC_KSLC; float s = 0.f; for (int d = 0; d < 64; ++d) s += bf2f(q[d]) * bf2f(k[d]); s += rel[chk_bucket_ref(t - pos) * 10 + h] * LOG2E; m = fmaxf(m, s); }
        float ls = 0.f; for (int pos = 0; pos <= t; ++pos) { if (!((selm >> (pos >> 6)) & 1ull)) continue; const bf16_t* k = P + (rb + pos) * PW + PC_KSLC; const bf16_t* v = P + (rb + pos) * PW + PC_VSLC; float s = 0.f; for (int d = 0; d < 64; ++d) s += bf2f(q[d]) * bf2f(k[d]); s += rel[chk_bucket_ref(t - pos) * 10 + h] * LOG2E;
            const float p = exp2f(s - m); ls += p; _Pragma("unroll") for (int e = 0; e < 4; ++e) os[e] += p * bf2f(v[21 * e]); }
        _Pragma("unroll") for (int e = 0; e < 4; ++e) os[e] /= ls; }
      { const int lo = t - 511 > 0 ? t - 511 : 0; float m = -INFINITY; for (int pos = lo; pos <= t; ++pos) { const bf16_t* k = P + (rb + pos) * PW + PC_KWIN; float s = 0.f; for (int d = 0; d < 64; ++d) s += bf2f(q[d]) * bf2f(k[d]); s += rel[chk_bucket_ref(t - pos) * 10 + h] * LOG2E; m = fmaxf(m, s); }
        float ls = 0.f; for (int pos = lo; pos <= t; ++pos) { const bf16_t* k = P + (rb + pos) * PW + PC_KWIN; const bf16_t* v = P + (rb + pos) * PW + PC_VWIN; float s = 0.f; for (int d = 0; d < 64; ++d) s += bf2f(q[d]) * bf2f(k[d]); s += rel[chk_bucket_ref(t - pos) * 10 + h] * LOG2E;
            const float p = exp2f(s - m); ls += p; _Pragma("unroll") for (int e = 0; e < 4; ++e) ow[e] += p * bf2f(v[21 * e]); }
        _Pragma("unroll") for (int e = 0; e < 4; ++e) ow[e] /= ls; }
      const float* sd = WSP(const float, WS_SIDE) + row * 16 + h * 3; const float g0 = 1.f / (1.f + expf(-sd[0])), g1 = 1.f / (1.f + expf(-sd[1])), g2 = 1.f / (1.f + expf(-sd[2]));
      _Pragma("unroll") for (int e = 0; e < 4; ++e) bad |= chk_bad(bf2f(WSP(const bf16_t, WS_OCAT)[row * OCW + h * 64 + 21 * e]), g0 * oc[e] + g1 * os[e] + g2 * ow[e], 0.3f); }
      return bad; }
}
__device__ __forceinline__ void selfcheck_a(Frame& F, int l) {
    const int i = threadIdx.x;
    const float* x = F.in[0];
    const bf16_t* H = WSP(const bf16_t, WS_H); const bf16_t* P = WSP(const bf16_t, WS_P);
    const float* rel = F.in[1];
    { const int row = (int)(chk_hash(i) % M), col = (int)(chk_hash(i + 999) & 1023); float s = 0.f; for (int k = 0; k < DM; ++k) { const float v = x[(size_t)row * DM + k]; s += v * v; }
      const float ref = x[(size_t)row * DM + col] * (1.0f / sqrtf(s / DM + RMS_EPS)) * F.in[2][l * DM + col];
      chk_flag(F, 0, chk_bad(bf2f(H[(size_t)row * DM + col]), ref, 1.0f), 0); }
    { const int row = (int)(chk_hash(i + 5) % M); int c = (i * 37 + 5) % PW; if (i < 32) c = 640 + (i & 15); else if (i < 96) c = 672 + (i & 31); else if (i < 160) c = 256 + ((i * 3) & 127);
      const float* W = F.in[6] + (size_t)l * DM * DIN; bool bad = false;
#define DOTC(dst, cc) do { float sc_; const int src_ = inproj_src((cc), sc_); float a_ = 0.f; if (src_ >= 0) for (int k = 0; k < DM; ++k) a_ += bf2f(H[(size_t)row * DM + k]) * bfr(W[(size_t)k * DIN + src_] * sc_); dst = a_; } while (0)
      float ref; DOTC(ref, c);
      if (c >= 672 && c < 704) { const int p = c - 672, ip = p >> 1; float oth; DOTC(oth, c ^ 1); const float x1 = (p & 1) ? oth : ref, x2 = (p & 1) ? ref : oth;
          const float inv = powf(10000.0f, -(float)(2 * ip) / 32.0f), ang = (float)(row & (SEQ - 1)) * inv, cs = cosf(ang), sn = sinf(ang);
          ref = (p & 1) ? (x2 * cs + x1 * sn) : (x1 * cs - x2 * sn);
          bad |= chk_bad(bf2f(WSP(const bf16_t, WS_KROT)[(size_t)row * 32 + p]), ref, 1.0f); }
      bad |= chk_bad(bf2f(P[(size_t)row * PW + c]), ref, 1.0f);
      if (c >= 640 && c < 656) bad |= chk_bad(WSP(const float, WS_SIDE)[(size_t)row * 16 + (c - 640)], ref, 1.0f);
      if (c >= 256 && c < 320) bad |= chk_bad(bf2f(WSP(const bf16_t, WS_KCMP)[(size_t)row * 64 + (c - 256)]), ref, 1.0f);
      if (c >= 320 && c < 384) bad |= chk_bad(bf2f(WSP(const bf16_t, WS_VCMP)[(size_t)row * 64 + (c - 320)]), ref, 1.0f);
      if (i >= 160 && i < 192) { float sq = 0.f, skv = 0.f; for (int k = 0; k < 256; ++k) { const float v = bf2f(P[(size_t)row * PW + PC_DQL + k]); sq += v * v; } for (int k = 0; k < 128; ++k) { const float v = bf2f(P[(size_t)row * PW + PC_DKV + k]); skv += v * v; }
          const float* a = WSP(const float, WS_SSQQ) + (size_t)row * 4; const float* b = WSP(const float, WS_SSQKV) + (size_t)row * 4;
          bad |= chk_bad(a[0] + a[1] + a[2] + a[3], sq, 10.f) || chk_bad(b[0] + b[1] + b[2] + b[3], skv, 5.f); }
      chk_flag(F, 1, bad, 0); }
    { const int b = i & 15, h = (i >> 4) & 3, t = chk_t(i >> 6); float a = 0.f; for (int j = 0; j <= t; ++j) { const float xx = WSP(const float, WS_SIDE)[((size_t)b * SEQ + j) * 16 + 12 + h] + F.in[12][l * 4 + h]; a += (xx >= 0.f) ? -log1pf(expf(-xx)) : (xx - log1pf(expf(xx))); }
      chk_flag(F, 2, chk_bad(WSP(const float, WS_KB)[((size_t)b * 4 + h) * SEQ + t], -a * LOG2E, 1.0f + fabsf(a) * 0.05f), 0); }
    chk_flag(F, 3, chk_fox(F, (i * 5) & 15, i & 3, chk_t(i >> 2)), 0);
    { const int row = (int)(chk_hash(i + 77) % M); bool bad = false;
      float sq = 0.f, skv = 0.f; for (int k = 0; k < 256; ++k) { const float v = bf2f(P[(size_t)row * PW + PC_DQL + k]); sq += v * v; } for (int k = 0; k < 128; ++k) { const float v = bf2f(P[(size_t)row * PW + PC_DKV + k]); skv += v * v; }
      const float rq = 1.0f / sqrtf(sq / 256.0f + RMS_EPS), rkv = 1.0f / sqrtf(skv / 128.0f + RMS_EPS);
      const float* wq = F.in[15] + (size_t)l * 256 * 384; const float* gq = F.in[13] + l * 256; const float* wkv = F.in[16] + (size_t)l * 128 * 512; const float* gkv = F.in[14] + l * 128;
#define QDOT(dst, src) do { float a_ = 0.f; for (int k = 0; k < 256; ++k) a_ += bf2f(P[(size_t)row * PW + PC_DQL + k]) * bfr(wq[(size_t)k * 384 + (src)] * C2D * gq[k]); dst = a_ * rq; } while (0)
      const int r = (i * 11) % 384, hd = r / 96, w = r % 96; float ref;
      if (w < 64) QDOT(ref, hd * 96 + w);
      else { const int p = w - 64, ip = p >> 1; float x1, x2; QDOT(x1, hd * 96 + 64 + ip); QDOT(x2, hd * 96 + 64 + 16 + ip); const float inv = powf(10000.0f, -(float)(2 * ip) / 32.0f), ang = (float)(row & (SEQ - 1)) * inv, cs = cosf(ang), sn = sinf(ang);
          ref = (p & 1) ? (x2 * cs + x1 * sn) : (x1 * cs - x2 * sn); }
      bad |= chk_bad(bf2f(WSP(const bf16_t, WS_QM)[(size_t)row * 512 + r]), ref, 1.5f);
      { const int c = (i * 13) & 511; float a = 0.f; for (int k = 0; k < 128; ++k) a += bf2f(P[(size_t)row * PW + PC_DKV + k]) * bfr(wkv[(size_t)k * 512 + c] * gkv[k]); bad |= chk_bad(bf2f(WSP(const bf16_t, WS_KVM)[(size_t)row * 512 + c]), a * rkv, 1.0f); }
      chk_flag(F, 4, bad, 0); }
    { const int b = (i * 3) & 15, h = i & 3, t = chk_t(i >> 2); const size_t row = (size_t)b * SEQ + t; const bf16_t* q = WSP(const bf16_t, WS_QM) + row * 512 + h * 96; const bf16_t* KV = WSP(const bf16_t, WS_KVM); const bf16_t* KR = WSP(const bf16_t, WS_KROT);
      float m = -INFINITY; for (int j = 0; j <= t; ++j) { const size_t rj = (size_t)b * SEQ + j; float s = 0.f; for (int d = 0; d < 64; ++d) s += bf2f(q[d]) * bf2f(KV[rj * 512 + h * 128 + d]); for (int d = 0; d < 32; ++d) s += bf2f(q[64 + d]) * bf2f(KR[rj * 32 + d]); m = fmaxf(m, s); }
      float lsum = 0.f, dummy0_ = 0.f; f32x4 o = {0.f, 0.f, 0.f, 0.f};
      for (int j = 0; j <= t; ++j) { const size_t rj = (size_t)b * SEQ + j; float s = 0.f; for (int d = 0; d < 64; ++d) s += bf2f(q[d]) * bf2f(KV[rj * 512 + h * 128 + d]); for (int d = 0; d < 32; ++d) s += bf2f(q[64 + d]) * bf2f(KR[rj * 32 + d]);
          const float p = exp2f(s - m); lsum += p; _Pragma("unroll") for (int e = 0; e < 4; ++e) o[e] += p * bf2f(KV[rj * 512 + h * 128 + 64 + 21 * e]); }
      bool bad = false; _Pragma("unroll") for (int e = 0; e < 4; ++e) bad |= chk_bad(bf2f(WSP(const bf16_t, WS_OCAT)[row * OCW + 640 + h * 64 + 21 * e]), o[e] / lsum, 0.5f);
      chk_flag(F, 5, bad, 0); }
    chk_flag(F, 6, chk_dil(F, (i * 7) & 15, i & 1, chk_t(i >> 1)), 0);
    { const int b = i & 15, which = (i >> 4) & 1, c = (int)(chk_hash(i + 31) % 255), d = (i * 5) & 63; const bf16_t* src = (which ? WSP(const bf16_t, WS_VCMP) : WSP(const bf16_t, WS_KCMP)) + ((size_t)b * SEQ + 16 * c) * 64;
      const float *pk1 = F.in[8], *pv1 = F.in[10], *pk2 = F.in[9], *pv2 = F.in[11]; asm volatile("" : "+s"(pk1), "+s"(pv1), "+s"(pk2), "+s"(pv2));
      const float* w1 = (which ? pv1 : pk1) + (size_t)l * 2048 * 128; const float* w2 = (which ? pv2 : pk2) + (size_t)l * 128 * 64; const float* cp = F.in[7] + (size_t)l * 2048;
      float out = 0.f;
      for (int n = 0; n < 128; ++n) { float a = 0.f, bsum = 0.f; for (int p = 0; p < 2048; ++p) { a += bf2f(src[p]) * bfr(w1[(size_t)p * 128 + n]); bsum += cp[p] * w1[(size_t)p * 128 + n]; }
          const float xx = a + bsum, g = 0.5f * xx * (1.0f + tanhf(0.7978845608028654f * (xx + 0.044715f * xx * xx * xx))); out += bfr(g) * w2[n * 64 + d]; }
      chk_flag(F, 7, chk_bad(bf2f((which ? WSP(const bf16_t, WS_VC) : WSP(const bf16_t, WS_KC))[((size_t)b * 256 + c) * 64 + d]), out, 0.5f), 0); }
    { bool bad = false; if (i < 128) bad = chk_nsa(F, (i * 9) & 15, i & 3, chk_t(i >> 2), i); chk_flag(F, 8, bad, 4); }
}
__device__ __forceinline__ void selfcheck_b(Frame& F, int l) {
    const int i = threadIdx.x; const int row = (int)(chk_hash(i + 3) % M), n = (i * 29 + 7) & 1023;
    const bf16_t* H = WSP(const bf16_t, WS_H); const bf16_t* OC = WSP(const bf16_t, WS_OCAT);
    float acc = 0.f;
    for (int br = 0; br < 4; ++br) { const float* wg = F.in[21] + ((size_t)l * 4 + br) * DM * DM; float g = 0.f; for (int k = 0; k < DM; ++k) g += bf2f(H[(size_t)row * DM + k]) * bfr(wg[(size_t)k * DM + n]);
        const int kk = (br == 1) ? 128 : 256, co = (br == 0) ? 0 : (br == 1 ? 256 : (br == 2 ? 384 : 640)); const float *pb0 = F.in[17], *pb1 = F.in[18], *pb2 = F.in[19], *pb3 = F.in[20]; asm volatile("" : "+s"(pb0), "+s"(pb1), "+s"(pb2), "+s"(pb3)); const float* wb = (br == 0 ? pb0 : (br == 1 ? pb1 : (br == 2 ? pb2 : pb3))) + (size_t)l * kk * DM; float t = 0.f; for (int k = 0; k < kk; ++k) t += bf2f(OC[(size_t)row * OCW + co + k]) * bfr(wb[(size_t)k * DM + n]);
        acc += (1.f / (1.f + expf(-g))) * bfr(t); }
    chk_flag(F, 9, chk_bad(bf2f(WSP(const bf16_t, WS_MERGED)[(size_t)row * DM + n]), acc, 0.5f), 0);
}
__device__ __forceinline__ void selfcheck_c(Frame& F, int l, const float* xin) {
    const int i = threadIdx.x; const int row = (int)(chk_hash(i + 11) % M), n = (i * 29 + 7) & 1023;
    const bf16_t* MG = WSP(const bf16_t, WS_MERGED); const float* wo = F.in[22] + (size_t)l * DM * DM; const float* Y = WSP(const float, WS_Y);
    float a = 0.f; for (int k = 0; k < DM; ++k) a += bf2f(MG[(size_t)row * DM + k]) * bfr(wo[(size_t)k * DM + n]);
    chk_flag(F, 0, chk_bad(Y[(size_t)row * DM + n], a, 1.0f), 0);
    float s = 0.f; for (int k = 0; k < DM; ++k) { const float v = Y[(size_t)row * DM + k]; s += v * v; }
    const float rstd = 1.0f / sqrtf(s / DM + RMS_EPS); float s2 = 0.f;
    for (int k = 0; k < DM; ++k) { const float v = xin[(size_t)row * DM + k] + Y[(size_t)row * DM + k] * rstd * F.in[3][l * DM + k]; s2 += v * v; }
    const float x1 = xin[(size_t)row * DM + n] + Y[(size_t)row * DM + n] * rstd * F.in[3][l * DM + n];
    const float h2 = x1 * (1.0f / sqrtf(s2 / DM + RMS_EPS)) * F.in[4][l * DM + n];
    chk_flag(F, 1, chk_bad(F.out[(size_t)row * DM + n], x1, 1.0f) || chk_bad(bf2f(WSP(const bf16_t, WS_H2)[(size_t)row * DM + n]), h2, 1.0f), 0);
}
__device__ __forceinline__ void selfcheck_d(Frame& F, int l) {
    const int i = threadIdx.x; const int row = (int)(chk_hash(i + 17) % (M / 2)); const bf16_t* H2 = WSP(const bf16_t, WS_H2); const bf16_t* U = WSP(const bf16_t, WS_U); const bf16_t* A = WSP(const bf16_t, WS_ACT);
    { const int c = (i * 41 + 3) % DFF2; const float* wu = F.in[23] + (size_t)l * DM * DFF2; float a = 0.f; for (int k = 0; k < DM; ++k) a += bf2f(H2[(size_t)row * DM + k]) * bfr(wu[(size_t)k * DFF2 + c]);
      chk_flag(F, 2, chk_bad(bf2f(U[(size_t)row * DFF2 + c]), a, 1.0f), 0); }
    { const int c = (i * 23 + 1) % DFF; const int t = row & (SEQ - 1); const float* cw = F.in[24] + (size_t)l * 3 * DFF2; const float* cb = F.in[25] + (size_t)l * DFF2; float g = cb[c], v = cb[DFF + c];
      for (int j = 0; j < 3; ++j) { const int tt = t - 2 + j; if (tt < 0) continue; g += cw[j * DFF2 + c] * bf2f(U[(size_t)(row - 2 + j) * DFF2 + c]); v += cw[j * DFF2 + DFF + c] * bf2f(U[(size_t)(row - 2 + j) * DFF2 + DFF + c]); }
      chk_flag(F, 3, chk_bad(bf2f(A[(size_t)row * DFF + c]), g / (1.f + expf(-g)) * v, 0.3f), 0); }
    { const int n = (i * 29 + 7) & 1023; const float* wd = F.in[26] + (size_t)l * DFF * DM; float a = 0.f; for (int k = 0; k < DFF; ++k) a += bf2f(A[(size_t)row * DFF + k]) * bfr(wd[(size_t)k * DM + n]);
      chk_flag(F, 4, chk_bad(WSP(const float, WS_Y2)[(size_t)row * DM + n], a, 1.0f), 0); }
}

__device__ __forceinline__ void selfcheck_e(Frame& F, int l) {
    const int i = threadIdx.x; const bf16_t* H = WSP(const bf16_t, WS_H); const bf16_t* P = WSP(const bf16_t, WS_P);
    const float* W = F.in[6] + (size_t)l * DM * DIN; const int row = (int)(chk_hash(i + 5) % M);
#define DOTC(dst, cc) do { float sc_; const int src_ = inproj_src((cc), sc_); float a_ = 0.f; if (src_ >= 0) for (int k = 0; k < DM; ++k) a_ += bf2f(H[(size_t)row * DM + k]) * bfr(W[(size_t)k * DIN + src_] * sc_); dst = a_; } while (0)
    { int c = (i * 37 + 5) % PW; if ((c >= 640 && c < 768)) c = 100; float ref; DOTC(ref, c); chk_flag(F, 0, chk_bad(bf2f(P[(size_t)row * PW + c]), ref, 1.0f), 0); }
    { const int c = 672 + (i & 31), p = c - 672, ip = p >> 1; float ref, oth; DOTC(ref, c); DOTC(oth, c ^ 1); const float x1 = (p & 1) ? oth : ref, x2 = (p & 1) ? ref : oth;
      const float inv = powf(10000.0f, -(float)(2 * ip) / 32.0f), ang = (float)(row & (SEQ - 1)) * inv, cs = cosf(ang), sn = sinf(ang); const float r = (p & 1) ? (x2 * cs + x1 * sn) : (x1 * cs - x2 * sn);
      chk_flag(F, 1, chk_bad(bf2f(WSP(const bf16_t, WS_KROT)[(size_t)row * 32 + p]), r, 1.0f), 0); }
    { const int c = 640 + (i & 15); float ref; DOTC(ref, c); chk_flag(F, 2, chk_bad(WSP(const float, WS_SIDE)[(size_t)row * 16 + (c - 640)], ref, 1.0f), 0); }
    { const int c = 256 + (i & 127); float ref; DOTC(ref, c); const float got = (c < 320) ? bf2f(WSP(const bf16_t, WS_KCMP)[(size_t)row * 64 + (c - 256)]) : bf2f(WSP(const bf16_t, WS_VCMP)[(size_t)row * 64 + (c - 320)]); chk_flag(F, 3, chk_bad(got, ref, 1.0f), 0); }
    float sq = 0.f, skv = 0.f; for (int k = 0; k < 256; ++k) { const float v = bf2f(P[(size_t)row * PW + PC_DQL + k]); sq += v * v; } for (int k = 0; k < 128; ++k) { const float v = bf2f(P[(size_t)row * PW + PC_DKV + k]); skv += v * v; }
    { const float* a = WSP(const float, WS_SSQQ) + (size_t)row * 4; const float* b = WSP(const float, WS_SSQKV) + (size_t)row * 4; chk_flag(F, 4, chk_bad(a[0] + a[1] + a[2] + a[3], sq, 10.f) || chk_bad(b[0] + b[1] + b[2] + b[3], skv, 5.f), 0); }
    const float rq = 1.0f / sqrtf(sq / 256.0f + RMS_EPS), rkv = 1.0f / sqrtf(skv / 128.0f + RMS_EPS);
    const float* wq = F.in[15] + (size_t)l * 256 * 384; const float* gq = F.in[13] + l * 256; const float* wkv = F.in[16] + (size_t)l * 128 * 512; const float* gkv = F.in[14] + l * 128;
#define QDOT(dst, src) do { float a_ = 0.f; for (int k = 0; k < 256; ++k) a_ += bf2f(P[(size_t)row * PW + PC_DQL + k]) * bfr(wq[(size_t)k * 384 + (src)] * C2D * gq[k]); dst = a_ * rq; } while (0)
    { const int hd = i & 3, w = (i >> 2) & 63; float ref; QDOT(ref, hd * 96 + w); chk_flag(F, 5, chk_bad(bf2f(WSP(const bf16_t, WS_QM)[(size_t)row * 512 + hd * 96 + w]), ref, 1.5f), 0); }
    { const int hd = i & 3, p = (i >> 2) & 31, ip = p >> 1; float x1, x2; QDOT(x1, hd * 96 + 64 + ip); QDOT(x2, hd * 96 + 64 + 16 + ip); const float inv = powf(10000.0f, -(float)(2 * ip) / 32.0f), ang = (float)(row & (SEQ - 1)) * inv, cs = cosf(ang), sn = sinf(ang);
      const float r = (p & 1) ? (x2 * cs + x1 * sn) : (x1 * cs - x2 * sn); chk_flag(F, 6, chk_bad(bf2f(WSP(const bf16_t, WS_QM)[(size_t)row * 512 + hd * 96 + 64 + p]), r, 1.5f), 0); }
    { const int c = (i * 13) & 511; float a = 0.f; for (int k = 0; k < 128; ++k) a += bf2f(P[(size_t)row * PW + PC_DKV + k]) * bfr(wkv[(size_t)k * 512 + c] * gkv[k]); chk_flag(F, 7, chk_bad(bf2f(WSP(const bf16_t, WS_KVM)[(size_t)row * 512 + c]), a * rkv, 1.0f), 0); }
    { const int b = i & 15, which = (i >> 4) & 1, c = (int)(chk_hash(i + 31) % 255), n = (i * 5) & 127; const bf16_t* src = (which ? WSP(const bf16_t, WS_VCMP) : WSP(const bf16_t, WS_KCMP)) + ((size_t)b * SEQ + 16 * c) * 64;
      const float *pk1 = F.in[8], *pv1 = F.in[10], *pk2 = F.in[9], *pv2 = F.in[11]; asm volatile("" : "+s"(pk1), "+s"(pv1), "+s"(pk2), "+s"(pv2));
      const float* w1 = (which ? pv1 : pk1) + (size_t)l * 2048 * 128; const float* w2 = (which ? pv2 : pk2) + (size_t)l * 128 * 64; const float* cp = F.in[7] + (size_t)l * 2048;
      float a = 0.f, bsum = 0.f; for (int p = 0; p < 2048; ++p) { a += bf2f(src[p]) * bfr(w1[(size_t)p * 128 + n]); bsum += cp[p] * w1[(size_t)p * 128 + n]; }
      const float xx = a + bsum, g = 0.5f * xx * (1.0f + tanhf(0.7978845608028654f * (xx + 0.044715f * xx * xx * xx)));
      const bf16_t* hid = WSP(const bf16_t, WS_HID) + (size_t)(which * 4096 + b * 256 + c) * 256 + which * 128;
      chk_flag(F, 8, chk_bad(bf2f(hid[n]), g, 0.5f), 0);
      const int d = (i * 5) & 63; float o2 = 0.f; for (int nn = 0; nn < 128; ++nn) o2 += bf2f(hid[nn]) * w2[nn * 64 + d];
      chk_flag(F, 9, chk_bad(bf2f((which ? WSP(const bf16_t, WS_VC) : WSP(const bf16_t, WS_KC))[((size_t)b * 256 + c) * 64 + d]), o2, 0.5f), 0); }
#undef DOTC
#undef QDOT
}

constexpr int CW_CNT = 20544;
__device__ __forceinline__ void selfcheck_g(Frame& F, int l) {
    const int gi = blockIdx.x * 512 + threadIdx.x; const bf16_t* H = WSP(const bf16_t, WS_H); const bf16_t* P = WSP(const bf16_t, WS_P); const float* W = F.in[6] + (size_t)l * DM * DIN;
    const int row = gi & (M - 1); unsigned nbad = 0u;
    for (int k4 = 0; k4 < 4; ++k4) { int c = (int)(chk_hash(gi * 4 + k4 + 12345u) % PW); if (c >= 640 && c < 768) c -= 200;
        float sc_; const int src_ = inproj_src(c, sc_); float a_ = 0.f; for (int k = 0; k < DM; ++k) a_ += bf2f(H[(size_t)row * DM + k]) * bfr(W[(size_t)k * DIN + src_] * sc_);
        if (chk_bad(bf2f(P[(size_t)row * PW + c]), a_, 1.0f)) ++nbad; }
    if (nbad) atomicAdd((unsigned*)(F.ctl + CW_CNT), nbad);
}
__device__ __forceinline__ void selfcheck_g_fin(Frame& F) {
    if (blockIdx.x == 0 && threadIdx.x == 0) { const unsigned cnt = __hip_atomic_load(F.ctl + CW_CNT, __ATOMIC_RELAXED, __HIP_MEMORY_SCOPE_AGENT); unsigned lg = 0; while ((1u << lg) <= cnt && lg < 15) ++lg;
        atomicOr((unsigned*)(F.ctl + CW_CHK), (cnt > 63u ? 63u : cnt) | (lg << 6)); }
}

__device__ __forceinline__ void selfcheck_f(Frame& F, int l) {
    const int i = threadIdx.x; const unsigned hsh = chk_hash(i + 4242u);
    chk_flag(F, 0, chk_fox(F, i & 15, (i >> 4) & 3, (i >> 6) * 8 + (hsh & 7)), 0);
    chk_flag(F, 1, chk_fox(F, i & 15, (i >> 4) & 3, 64 + (int)(hsh % 192u)), 0);
    chk_flag(F, 2, chk_fox(F, i & 15, (i >> 4) & 3, 256 + (int)(hsh % 3840u)), 0);
    chk_flag(F, 3, chk_dil(F, i & 15, (i >> 4) & 1, (int)(hsh & 127u)), 0);
    chk_flag(F, 4, chk_dil(F, i & 15, (i >> 4) & 1, 128 + (int)(hsh % 3968u)), 0);
    { bool bad = false; if (i < 128) bad = chk_nsa(F, i & 15, (i >> 4) & 3, (int)(hsh % 31u), i); chk_flag(F, 5, bad, 0); }
    { bool bad = false; if (i < 128) bad = chk_nsa(F, i & 15, (i >> 4) & 3, 31 + (int)(hsh % 33u), i); chk_flag(F, 6, bad, 0); }
    { bool bad = false; if (i < 128) bad = chk_nsa(F, i & 15, (i >> 4) & 3, 64 + (int)(hsh % 960u), i); chk_flag(F, 7, bad, 0); }
    { bool bad = false; if (i < 128) bad = chk_nsa(F, i & 15, (i >> 4) & 3, 1024 + (int)(hsh % 3072u), i); chk_flag(F, 8, bad, 4); }
}
__device__ __forceinline__ void selfcheck_report(Frame& F) {
    const unsigned mask = __hip_atomic_load(F.ctl + CW_CHK, __ATOMIC_RELAXED, __HIP_MEMORY_SCOPE_AGENT);
    float V = (float)(10u + (mask & 63u)); const unsigned e = 2u + ((mask >> 6) & 15u); for (unsigned k = 0; k < e; ++k) V *= 10.0f;
    for (size_t idx = (size_t)blockIdx.x * 512 + threadIdx.x; idx < (size_t)M * DM; idx += (size_t)F.G * 512) F.out[idx] = V;
}
#endif
struct SchedSimple {
    pg8::TileOrder T; const char* A; const char* B; int lda, ldb, nt; int dup = 0;
    __device__ __forceinline__ bool next(int i, GUnit& u) const { int pm, pn; if (!T.tile(i >> dup, pm, pn)) return false;
        u.A = A + (size_t)pm * 256 * lda; u.B = B + (size_t)pn * 256 * ldb; u.lda = lda; u.ldb = ldb; u.nt = nt; u.pm = pm; u.pn = pn; u.id = 0; return true; }
};
struct SchedCmp1 {
    int c; const char* kc; const char* vc; const char* B;
    __device__ __forceinline__ bool next(int i, GUnit& u) const { if (i > 0 || c >= 32) return false;
        u.A = (c < 16 ? kc : vc) + (size_t)(c & 15) * 256 * 2048; u.B = B; u.lda = 2048; u.ldb = 4096; u.nt = 32; u.pm = c; u.pn = 0; u.id = 0; return true; }
};
struct SchedMerge {
    pg8::TileOrder T; const char* ocat; const char* h; const char* wbr; const char* wg; int dup = 0;
    __device__ __forceinline__ bool next(int i0, GUnit& u) const { const int i = i0 >> dup; int pm, pn; if (!T.tile(i >> 3, pm, pn)) return false;
        const int sub = i & 7; u.pm = pm; u.pn = pn; u.id = sub;
        if (sub >= 4) { u.A = h + (size_t)pm * 256 * 2048; u.lda = 2048; u.B = wg + (size_t)((pn * 4 + (sub - 4)) * 256) * 2048; u.ldb = 2048; u.nt = 16; }
        else { const int br = sub; const int kk = (br == 1) ? 128 : 256; const size_t co = (br == 0) ? 0 : (br == 1 ? 256 : (br == 2 ? 384 : 640)), wo = (br == 0) ? BR_A : (br == 1 ? BR_B : (br == 2 ? BR_C : BR_D));
            u.A = ocat + (size_t)pm * 256 * (OCW * 2) + co * 2; u.lda = OCW * 2; u.B = wbr + wo + (size_t)pn * 256 * kk * 2; u.ldb = kk * 2; u.nt = kk / 64; }
        return true; }
};

#ifndef SDUP_INPROJ
#define SDUP_INPROJ 0
#endif
#ifndef SDUP_MERGE
#define SDUP_MERGE 0
#endif
#ifndef SDUP_WO
#define SDUP_WO 0
#endif
#ifndef SDUP_UP
#define SDUP_UP 0
#endif
#ifndef SDUP_DN
#define SDUP_DN 0
#endif
#ifndef DUP_ATTN
#define DUP_ATTN 1
#endif
#ifndef DUP_GEMM
#define DUP_GEMM 1
#endif
#ifndef DUP_MERGE
#define DUP_MERGE 1
#endif
#ifndef DUP_FFN
#define DUP_FFN 1
#endif
#ifdef ONLY_PHASE
#define PH(k) ((k) == ONLY_PHASE)
#else
#define PH(k) true
#endif
struct Args { const float* in[27]; float* out; unsigned char* ws; };
__global__ void __launch_bounds__(512, 2) hybrid_fwd(Args args) {
    extern __shared__ __attribute__((aligned(16))) unsigned char lds_raw[];
    Frame F;
    F.lds = (LAS unsigned char*)lds_raw; F.MISC = (volatile LAS unsigned*)(F.lds + MISC_OFF);
    F.tid = threadIdx.x; F.lane = F.tid & 63; F.wave = __builtin_amdgcn_readfirstlane(F.tid >> 6); F.G = gridDim.x;
#pragma unroll
    for (int i = 0; i < 27; ++i) F.in[i] = args.in[i];
    F.out = args.out; F.ws = args.ws; F.ctl = (gu32*)(args.ws + WS_CTL);
    for (int u = F.tid; u < (LDS_BYTES - LDSCTL_OFF) / 4; u += 512) ((LAS unsigned*)(F.lds + LDSCTL_OFF))[u] = 0u;
    __syncthreads();
    XcdBarrier bar = xcd_barrier_post((unsigned*)(F.ctl + CW_BAR), F.MISC + 8);
    const int c = (int)blockIdx.x;
#if defined(TIMEPROBE)
    if (threadIdx.x == 0) *(volatile LAS unsigned long long*)(F.lds + MISC_OFF + 64) = __builtin_amdgcn_s_memrealtime();
#define TSTAMP(id) do { if (blockIdx.x == 0 && threadIdx.x == 0) { volatile LAS unsigned long long* tp_ = (volatile LAS unsigned long long*)(F.lds + MISC_OFF + 64); const unsigned long long now_ = __builtin_amdgcn_s_memrealtime(); unsigned long long* a_ = (unsigned long long*)(F.ws + 90000) + (id); *a_ = *a_ + (now_ - *tp_); *tp_ = now_; } } while (0)
#else
#define TSTAMP(id) do { } while (0)
#endif

#ifndef DUP_P0
#define DUP_P0 1
#endif
    for (int rep = 0; rep < DUP_P0; ++rep) { if (rep) xcd_barrier(bar); if (PH(0)) p0_prologue(F); }
    xcd_barrier(bar); TSTAMP(0);

#define PHASE_FRESH() do { int t_ = threadIdx.x; asm volatile("" : "+v"(t_)); F.tid = t_; F.lane = t_ & 63; } while (0)
    for (int l = 0; l < DEPTH; ++l) {
        unsigned char* wl = F.ws + WS_WT + (size_t)l * LW;
        const float* xin = (l == 0) ? F.in[0] : F.out;
        PHASE_FRESH();
        if (l == 0) { if (PH(1)) rowpass<0>(F, xin, nullptr, 0, nullptr, WSP(bf16_t, WS_H), F.in[2] + l * DM, nullptr, 0, M);
          xcd_barrier(bar); TSTAMP(1); }
        for (int rep = 0; rep < DUP_GEMM; ++rep) if (PH(2)) { if (rep) xcd_barrier(bar); SchedSimple S; S.T.init(256, 12, F.G, c); S.A = (const char*)(F.ws + WS_H); S.B = (const char*)(wl + LW_IN); S.lda = 2048; S.ldb = 2048; S.nt = 16; S.dup = SDUP_INPROJ;
          pg8::EpiInProj E{WSP(bf16_t, WS_P), WSP(bf16_t, WS_KCMP), WSP(bf16_t, WS_VCMP), WSP(float, WS_SIDE), WSP(bf16_t, WS_KROT), WSP(const float, WS_ROPE), WSP(float, WS_SSQQ), WSP(float, WS_SSQKV)};
          pg8::gemm_phase<pg8::EpiInProj, SchedSimple, true>(F.lds, S, E); }
        xcd_barrier(bar); TSTAMP(2);
        if (PH(3)) { SchedCmp1 S{c, (const char*)(F.ws + WS_KCMP), (const char*)(F.ws + WS_VCMP), (const char*)(wl + LW_PHI)};
          pg8::EpiCmp1 E{WSP(bf16_t, WS_HID), WSP(const float, WS_CMPB) + l * 256};
          pg8::gemm_phase<pg8::EpiCmp1, SchedCmp1, false>(F.lds, S, E); }
        if (PH(4)) { const bool split = F.G > 64; const int g2 = split ? F.G - 32 : F.G, c2 = split ? c - 32 : c;
          { SchedSimple S; S.T.init(256, 2, g2, c2 < 0 ? (1 << 28) : c2); S.A = (const char*)(F.ws + WS_P) + PC_DQL * 2; S.B = (const char*)(wl + LW_UQ); S.lda = PW * 2; S.ldb = 512; S.nt = 4;
            pg8::EpiQup E{WSP(bf16_t, WS_QM), WSP(const float, WS_SSQQ), WSP(const float, WS_ROPE)};
            pg8::gemm_phase<pg8::EpiQup, SchedSimple, true>(F.lds, S, E); }
          { SchedSimple S; S.T.init(256, 2, g2, c2 < 0 ? (1 << 28) : c2); S.A = (const char*)(F.ws + WS_P) + PC_DKV * 2; S.B = (const char*)(wl + LW_UKV); S.lda = PW * 2; S.ldb = 256; S.nt = 2;
            pg8::EpiKVup E{WSP(bf16_t, WS_KVM), WSP(const float, WS_SSQKV)};
            pg8::gemm_phase<pg8::EpiKVup, SchedSimple, true>(F.lds, S, E); } }
        PHASE_FRESH();
        if (PH(5)) {
          const int gw = c * 8 + F.wave;
          if (gw < BATCH) { const int b = gw; const float* sd = WSP(const float, WS_SIDE) + (size_t)b * SEQ * 16 + 12; const f32x4 fb = *(const f32x4*)(F.in[12] + l * 4);
              f32x4 tot = {0.f, 0.f, 0.f, 0.f};
              for (int i = 0; i < 64; ++i) { const f32x4 f = *(const f32x4*)(sd + (size_t)(F.lane * 64 + i) * 16);
#pragma unroll
                  for (int e = 0; e < 4; ++e) { const float x = f[e] + fb[e]; tot[e] += (x >= 0.f) ? -log1pf(expf(-x)) : (x - log1pf(expf(x))); } }
              LAS float* sc = (LAS float*)(F.lds + F.wave * 1024);
              *(LAS f32x4*)(sc + 4 * F.lane) = tot; LDS_WAIT(); asm volatile("" ::: "memory");
              f32x4 pre = {0.f, 0.f, 0.f, 0.f};
              for (int j = 0; j < 64; ++j) { const f32x4 o = *(const LAS f32x4*)(sc + 4 * j); if (j < F.lane) pre = pre + o; }
              pre = pre + tot;
              f32x4 run = pre - tot;
              float* kb = WSP(float, WS_KB) + (size_t)b * 4 * SEQ;
              for (int i = 0; i < 64; ++i) { const int t = F.lane * 64 + i; const f32x4 f = *(const f32x4*)(sd + (size_t)t * 16);
#pragma unroll
                  for (int e = 0; e < 4; ++e) { const float x = f[e] + fb[e]; run[e] += (x >= 0.f) ? -log1pf(expf(-x)) : (x - log1pf(expf(x))); kb[(size_t)e * SEQ + t] = -run[e] * LOG2E; } }
          } }
        xcd_barrier(bar); TSTAMP(3);
        PHASE_FRESH();
        if (PH(6)) { const int gt = c * 512 + F.tid, NGT = F.G * 512; const bf16_t* hid = WSP(const bf16_t, WS_HID);
          for (int i = gt; i < 2 * BATCH * 256 * 64; i += NGT) { const int d = i & 63, rc = (i >> 6) & 4095, which = i >> 18;
              const bf16_t* hr = hid + (size_t)(which * 4096 + rc) * 256 + which * 128; const float* w2 = (which ? F.in[11] : F.in[9]) + (size_t)l * 128 * 64 + d;
              float a = 0.f;
#pragma unroll 8
              for (int n = 0; n < 128; ++n) a += bf2f(hr[n]) * w2[n * 64];
              (which ? WSP(bf16_t, WS_VC) : WSP(bf16_t, WS_KC))[(size_t)rc * 64 + d] = (bf16_t)f2bf(a); } }
        xcd_barrier(bar); TSTAMP(4);
        PHASE_FRESH();
        for (int rep = 0; rep < DUP_ATTN; ++rep) { gu32* ctr = F.ctl + CW_Q + 64 * l + 16 * rep;
          if (rep) xcd_barrier(bar);
          for (;;) { const int it = queue_grab(F, ctr);
              if (it < 2048 && PH(7)) { const int qb = 15 - (it >> 7), mla = (it >> 6) & 1, bh = it & 63; if (mla) causal_unit<false>(F, bh >> 2, bh & 3, qb); else causal_unit<true>(F, bh >> 2, bh & 3, qb); }
              else if (it < 3072 && PH(8)) { const int r = it - 2048; nsa_unit(F, r & 15, 63 - (r >> 4)); }
              else if (it < 3328 && PH(9)) { const int r = it - 3072; dil_unit(F, r & 15, (r >> 4) & 1, r >> 5); }
              else break; } }
        xcd_barrier(bar); TSTAMP(5);
#if defined(SELFCHECK) && SELFCHECK == 1
        if (c == 0) selfcheck_a(F, l);
#endif
#if defined(SELFCHECK) && SELFCHECK == 3
        if (c == 0) selfcheck_e(F, l);
        xcd_barrier(bar); selfcheck_report(F); return;
#endif
#if defined(SELFCHECK) && SELFCHECK == 5
        selfcheck_g(F, l); xcd_barrier(bar); selfcheck_g_fin(F);
        xcd_barrier(bar); selfcheck_report(F); return;
#endif
#if defined(SELFCHECK) && SELFCHECK == 4
        if (c == 0) selfcheck_f(F, l);
        xcd_barrier(bar); selfcheck_report(F); return;
#endif
        for (int rep = 0; rep < DUP_MERGE; ++rep) if (PH(10)) { if (rep) xcd_barrier(bar); SchedMerge S; S.T.init(256, 4, F.G, c); S.ocat = (const char*)(F.ws + WS_OCAT); S.h = (const char*)(F.ws + WS_H); S.wbr = (const char*)(wl + LW_BR); S.wg = (const char*)(wl + LW_G); S.dup = SDUP_MERGE;
          unsigned char* scr = F.ws + WS_MSCR + (size_t)c * MSCR_PER_WG;
          pg8::EpiMerge E{WSP(bf16_t, WS_MERGED), scr};
          pg8::gemm_phase<pg8::EpiMerge, SchedMerge, true>(F.lds, S, E); }
        xcd_barrier(bar); TSTAMP(6);
#if defined(SELFCHECK) && SELFCHECK == 1
        if (c == 0) selfcheck_b(F, l);
        xcd_barrier(bar); selfcheck_report(F); return;
#endif
        if (PH(11)) { SchedSimple S; S.T.init(256, 4, F.G, c); S.A = (const char*)(F.ws + WS_MERGED); S.B = (const char*)(wl + LW_O); S.lda = 2048; S.ldb = 2048; S.nt = 16; S.dup = SDUP_WO;
          pg8::EpiBf16 E{WSP(bf16_t, WS_Y), DM};
          pg8::gemm_phase<pg8::EpiBf16, SchedSimple, true>(F.lds, S, E); }
        xcd_barrier(bar); TSTAMP(7);
        PHASE_FRESH();
        if (PH(12)) rowpass<1>(F, xin, WSP(const bf16_t, WS_Y), 0, F.out, WSP(bf16_t, WS_H2), F.in[3] + l * DM, F.in[4] + l * DM, 0, M);
        xcd_barrier(bar); TSTAMP(8);
        if (PH(13)) { SchedSimple S; S.T.init(256, 22, F.G, c); S.A = (const char*)(F.ws + WS_H2); S.B = (const char*)(wl + LW_UP); S.lda = 2048; S.ldb = 2048; S.nt = 16; S.dup = SDUP_UP;
          pg8::EpiUpConv E{WSP(bf16_t, WS_ACT), WSP(float, WS_HB), F.in[24] + (size_t)l * 3 * DFF2, F.in[25] + (size_t)l * DFF2};
          pg8::gemm_phase<pg8::EpiUpConv, SchedSimple, true>(F.lds, S, E); }
        xcd_barrier(bar); TSTAMP(9);
        PHASE_FRESH();
        if (PH(15)) { SchedSimple S; S.T.init(256, 4, F.G, c); S.A = (const char*)(F.ws + WS_ACT); S.B = (const char*)(wl + LW_DN); S.lda = DFF * 2; S.ldb = DFF * 2; S.nt = DFF / 64; S.dup = SDUP_DN;
          { int pm, pn; for (int i = 0; S.T.tile(i, pm, pn); ++i) ffn_fix_panel(F, pm, WSP(const float, WS_HB), WSP(bf16_t, WS_ACT), F.in[24] + (size_t)l * 3 * DFF2, F.in[25] + (size_t)l * DFF2); }
          VM_WAIT(); __syncthreads();
          pg8::EpiBf16 E{WSP(bf16_t, WS_Y2), DM};
          pg8::gemm_phase<pg8::EpiBf16, SchedSimple, true>(F.lds, S, E); }
        xcd_barrier(bar); TSTAMP(11);
        PHASE_FRESH();
        if (PH(16)) { if (l + 1 < DEPTH) rowpass<1>(F, F.out, WSP(const bf16_t, WS_Y2), 0, F.out, WSP(bf16_t, WS_H), F.in[5] + l * DM, F.in[2] + (l + 1) * DM, 0, M);
                      else rowpass<2>(F, F.out, WSP(const bf16_t, WS_Y2), 0, F.out, nullptr, F.in[5] + l * DM, nullptr, 0, M); }
        xcd_barrier(bar); TSTAMP(12);
    }
#if defined(TIMEPROBE)
    { xcd_barrier(bar); const unsigned long long* a_ = (const unsigned long long*)(F.ws + 90000); const float V1 = (float)a_[TIMEPROBE_A] * 0.01f, V2 = (float)a_[TIMEPROBE_B] * 0.01f * 1000.0f;
      for (size_t idx = (size_t)blockIdx.x * 512 + threadIdx.x; idx < (size_t)M * DM; idx += (size_t)F.G * 512) F.out[idx] = (idx == 12345) ? V2 : V1; }
#endif
}

extern "C" void kernel_launch(void* const* d_in, const int* in_sizes, int n_in, void* d_out, int out_size, void* d_ws, size_t ws_size, hipStream_t stream) {
    static int grid = 0;
    if (grid == 0) {
        if (n_in != 27 || in_sizes[0] != M * DM || out_size != M * DM || ws_size < WS_END) { fprintf(stderr, "kernel_launch: unexpected shapes (n_in %d, in0 %d, out %d, ws %zu)\n", n_in, n_in > 0 ? in_sizes[0] : -1, out_size, ws_size); grid = -1; return; }
        int dev = 0, cus = 0, per_cu = 0;
        if (hipGetDevice(&dev) != hipSuccess || hipDeviceGetAttribute(&cus, hipDeviceAttributeMultiprocessorCount, dev) != hipSuccess) { grid = -1; return; }
        if (hipFuncSetAttribute((const void*)hybrid_fwd, hipFuncAttributeMaxDynamicSharedMemorySize, LDS_BYTES) != hipSuccess) { fprintf(stderr, "kernel_launch: hipFuncSetAttribute failed\n"); grid = -1; return; }
        if (hipOccupancyMaxActiveBlocksPerMultiprocessor(&per_cu, (const void*)hybrid_fwd, 512, LDS_BYTES) != hipSuccess || per_cu < 1) fprintf(stderr, "kernel_launch: occupancy query says %d\n", per_cu);
        (void)hipGetLastError();
        grid = cus;
    }
    if (grid < 0) return;
    if (hipMemsetAsync((char*)d_ws + WS_CTL, 0, CTL_ZERO_BYTES, stream) != hipSuccess) return;
    Args a{};
    for (int i = 0; i < 27; ++i) a.in[i] = (const float*)d_in[i];
    a.out = (float*)d_out; a.ws = (unsigned char*)d_ws;
    hipLaunchKernelGGL(hybrid_fwd, dim3(grid), dim3(512), LDS_BYTES, stream, a);
}
```

```cpp
#include <hip/hip_runtime.h>
#include <hip/hip_bf16.h>
#include <cstdio>
#include <cstdint>
#include <cmath>

#define GAS __attribute__((address_space(1)))
#define LAS __attribute__((address_space(3)))
typedef unsigned short bf16_t;
typedef short bf16x8 __attribute__((ext_vector_type(8)));
typedef short s16x4 __attribute__((ext_vector_type(4)));
typedef float f32x4 __attribute__((ext_vector_type(4)));
typedef float f32x2 __attribute__((ext_vector_type(2)));
typedef float f32x16 __attribute__((ext_vector_type(16)));
typedef unsigned u32x4 __attribute__((ext_vector_type(4)));
typedef unsigned u32x2 __attribute__((ext_vector_type(2)));
typedef GAS unsigned gu32;

constexpr int BATCH = 16, SEQ = 4096, DM = 1024, M = BATCH * SEQ, DEPTH = 2;
constexpr int DIN = 2992, PW = 3072;
constexpr int DFF = 2816, DFF2 = 5632;
constexpr float LOG2E = 1.4426950408889634f;
constexpr float C2A = 0.125f * LOG2E;
constexpr float C2D = 0.10206207261596575f * LOG2E;
constexpr float RMS_EPS = 1e-6f;
constexpr int PC_AQ = 0, PC_KCMP = 256, PC_VCMP = 320, PC_KSLC = 384, PC_VSLC = 448, PC_KWIN = 512, PC_VWIN = 576,
              PC_MISC = 640, PC_KROPE = 672, PC_BQ = 768, PC_BK = 1152, PC_BV = 1536, PC_DKV = 1920,
              PC_CQ = 2048, PC_CK = 2304, PC_CV = 2560, PC_DQL = 2816;
constexpr int OCW = 896;
constexpr int NSA_DFAR = 1536, NSA_DMAX = 1664, NSA_TL = 1728;

__device__ __forceinline__ unsigned f2bf(float f) { unsigned u = __float_as_uint(f); return (u + 0x7fffu + ((u >> 16) & 1u)) >> 16; }
__device__ __forceinline__ unsigned pk2(float lo, float hi) { return f2bf(lo) | (f2bf(hi) << 16); }
__device__ __forceinline__ float bf2f(unsigned short b) { return __uint_as_float((unsigned)b << 16); }
typedef __bf16 bf16x2_t __attribute__((ext_vector_type(2)));
__device__ __forceinline__ unsigned cvtpk(float lo, float hi) { f32x2 v = {lo, hi}; bf16x2_t b = __builtin_convertvector(v, bf16x2_t); return __builtin_bit_cast(unsigned, b); }
__device__ __forceinline__ float fast_exp2(float x) { return __builtin_amdgcn_exp2f(x); }
__device__ __forceinline__ float fast_rcp(float x) { return __builtin_amdgcn_rcpf(x); }
template <int MASK> __device__ __forceinline__ float xor_lane_lt32(float v) { return __uint_as_float(__builtin_amdgcn_ds_swizzle((int)__float_as_uint(v), (MASK << 10) | 0x1f)); }
__device__ __forceinline__ float sum_halves(float v) { auto rr = __builtin_amdgcn_permlane32_swap(__float_as_uint(v), __float_as_uint(v), false, false); return __uint_as_float(rr[0]) + __uint_as_float(rr[1]); }
__device__ __forceinline__ float sigmoid_f(float x) { return fast_rcp(1.0f + fast_exp2(-x * LOG2E)); }

namespace pg8 {
constexpr int BM = 256, BK = 64, HALF = 128, HTB = HALF * BK * 2  , STAGE_BYTES = 8 * HTB, NXCD = 8, WGM = 8;
__host__ __device__ __forceinline__ int lds_byte(int r, int c) { const int st = (r >> 4) * 2 + (c >> 5), rr = r & 15, cc = c & 31, ob = rr * 64 + cc * 2; return st * 1024 + (ob ^ (((ob >> 9) & 1) << 5)); }
__host__ __device__ __forceinline__ void stage_rc(int b, int& R, int& C) { const int st = b / 1024, sb = b % 1024, swz = sb ^ (((sb >> 9) & 1) << 5); R = (st >> 1) * 16 + swz / 64; C = (st & 1) * 32 + (swz % 64) / 2; }
__host__ __device__ __forceinline__ int perm32(int rho) { const int n = rho >> 4, i = rho & 15; return 8 * (i >> 2) + 4 * n + (i & 3); }

struct GUnit { const char* A; const char* B; int lda, ldb, nt, pm, pn, id; };

struct TileOrder {
    int nM, nN, nwg, G, c;
    __device__ __forceinline__ void init(int nM_, int nN_, int G_, int c_) { nM = nM_; nN = nN_; nwg = nM * nN; G = G_; c = c_; }
    __device__ __forceinline__ bool tile(int i, int& pm, int& pn) const {
        const long L = (long)i * G + c; if (L >= nwg) return false;
        int wgid = (int)L; { const int q = nwg / NXCD, r = nwg % NXCD, xcd = wgid % NXCD, off = wgid / NXCD; wgid = (xcd < r ? xcd * (q + 1) : r * (q + 1) + (xcd - r) * q) + off; }
        const int nig = WGM * nN, gid = wgid / nig, fm = gid * WGM, gsz = (nM - fm) < WGM ? (nM - fm) : WGM;
        pm = fm + ((wgid % nig) % gsz); pn = (wgid % nig) / gsz; return true;
    }
};

template <class Epi, class Sched, bool ALIGN_EPI>
__device__ __forceinline__ void gemm_phase(LAS unsigned char* lds, const Sched& S, const Epi& E) {
    int tid_o = threadIdx.x; asm volatile("" : "+v"(tid_o));
    const int tid = tid_o, wid = __builtin_amdgcn_readfirstlane(tid >> 6), lane = tid & 63, wr = wid >> 2, wc = wid & 3; int fr = lane & 15, fq = lane >> 4;
    int sR[2], sC[2], sRb[2];
#pragma unroll
    for (int i = 0; i < 2; ++i) { stage_rc(tid * 16 + i * 8192, sR[i], sC[i]); sRb[i] = Epi::PERM ? ((sR[i] & ~31) + perm32(sR[i] & 31)) : sR[i]; sC[i] *= 2; }
    const size_t kstep = (size_t)(BK * 2);
    const unsigned ldsw = (unsigned)wid * 1024u;
    const int aoff = lds_byte(wr * 64 + fr, fq * 8), boff = lds_byte(wc * 32 + fr, fq * 8);
#define PG8_SA(b, h) (((b) * 2 + (h)) * HTB)
#define PG8_SB(b, h) ((4 + (b) * 2 + (h)) * HTB)
#define PG8_STAGE(bufoff, gbase, rows, ld) do { _Pragma("unroll") for (int _i = 0; _i < 2; ++_i) \
        __builtin_amdgcn_global_load_lds((const unsigned*)((const char*)(gbase) + (unsigned)((rows)[_i] * (ld) + sC[_i])), (LAS unsigned*)(lds + (bufoff) + ldsw + _i * 8192), 16, 0, 0); } while (0)
#define PG8_LDA(dst, b, h) do { _Pragma("unroll") for (int m = 0; m < 4; ++m) _Pragma("unroll") for (int k = 0; k < 2; ++k) dst[m][k] = *(const LAS bf16x8*)(lds + PG8_SA(b, h) + aoff + m * 2048 + k * 1024); } while (0)
#define PG8_LDB(dst, b, h) do { _Pragma("unroll") for (int n = 0; n < 2; ++n) _Pragma("unroll") for (int k = 0; k < 2; ++k) dst[n][k] = *(const LAS bf16x8*)(lds + PG8_SB(b, h) + boff + n * 2048 + k * 1024); } while (0)
#define PG8_MMA(ai, bj, At, Bt) do { __builtin_amdgcn_s_setprio(1); _Pragma("unroll") for (int m = 0; m < 4; ++m) _Pragma("unroll") for (int n = 0; n < 2; ++n) _Pragma("unroll") for (int k = 0; k < 2; ++k) \
        acc[ai][bj][m][n] = __builtin_amdgcn_mfma_f32_16x16x32_bf16(Bt[n][k], At[m][k], acc[ai][bj][m][n], 0, 0, 0); __builtin_amdgcn_s_setprio(0); } while (0)
#define PG8_WAIT_V(n) asm volatile("s_waitcnt vmcnt(" #n ")" ::: "memory")
#define PG8_WAIT_L(n) asm volatile("s_waitcnt lgkmcnt(" #n ")" ::: "memory")
#define PG8_BAR __builtin_amdgcn_s_barrier()
#define PG8_SCHED __builtin_amdgcn_sched_barrier(0)
    GUnit cur, nxt; int ui = 0;
    if (!S.next(0, cur)) return;
    f32x4 acc[2][2][4][2];
#pragma unroll
    for (int a = 0; a < 2; ++a)
#pragma unroll
        for (int b = 0; b < 2; ++b)
#pragma unroll
            for (int m = 0; m < 4; ++m)
#pragma unroll
                for (int n = 0; n < 2; ++n) acc[a][b][m][n] = (f32x4){0.f, 0.f, 0.f, 0.f};
    bf16x8 At[4][2], B0[2][2], B1[2][2];
    int ldAc = cur.lda, ldBc = cur.ldb; size_t hAc = (size_t)HALF * ldAc, hBc = (size_t)HALF * ldBc;
    const char* cA = cur.A; const char* cB = cur.B;
    PG8_STAGE(PG8_SB(0, 0), cB, sRb, ldBc); PG8_STAGE(PG8_SB(0, 1), cB + hBc, sRb, ldBc); PG8_STAGE(PG8_SA(0, 0), cA, sR, ldAc); PG8_STAGE(PG8_SA(0, 1), cA + hAc, sR, ldAc);
    if (wr == 1) PG8_BAR;
    PG8_WAIT_V(2); PG8_BAR;
    PG8_STAGE(PG8_SB(1, 0), cB + kstep, sRb, ldBc); PG8_STAGE(PG8_SA(1, 0), cA + kstep, sR, ldAc); PG8_STAGE(PG8_SB(1, 1), cB + hBc + kstep, sRb, ldBc);
    PG8_WAIT_V(6); PG8_BAR;
    for (;;) {
        const bool has_next = S.next(ui + 1, nxt);
        int ldAn, ldBn; const char* nA; const char* nB;
        if (has_next) { ldAn = nxt.lda; ldBn = nxt.ldb; nA = nxt.A; nB = nxt.B; } else { ldAn = ldAc; ldBn = ldBc; nA = cA; nB = cB; }
        const size_t hAn = (size_t)HALF * ldAn, hBn = (size_t)HALF * ldBn;
        int nt = cur.nt; asm volatile("" : "+s"(nt));
        for (int t = 0; t < nt; t += 2) {
            const bool last = (t == nt - 2);
            const char* a1 = cA + (size_t)(t + 1) * kstep;
            const char* a2 = last ? nA : cA + (size_t)(t + 2) * kstep; const char* b2 = last ? nB : cB + (size_t)(t + 2) * kstep;
            const char* a3 = a2 + kstep; const char* b3 = b2 + kstep;
            const int ldA2 = last ? ldAn : ldAc, ldB2 = last ? ldBn : ldBc;
            const size_t hA2 = last ? hAn : hAc, hB2 = last ? hBn : hBc;
            PG8_LDB(B0, 0, 0); PG8_LDB(B1, 0, 1); PG8_SCHED; PG8_LDA(At, 0, 0); PG8_STAGE(PG8_SA(1, 1), a1 + hAc, sR, ldAc);
            PG8_WAIT_V(8); PG8_WAIT_L(0); PG8_BAR; PG8_MMA(0, 0, At, B0); PG8_MMA(0, 1, At, B1); PG8_BAR; PG8_SCHED;
            PG8_LDA(At, 0, 1); PG8_STAGE(PG8_SB(0, 0), b2, sRb, ldB2); PG8_STAGE(PG8_SB(0, 1), b2 + hB2, sRb, ldB2); PG8_STAGE(PG8_SA(0, 0), a2, sR, ldA2);
            PG8_WAIT_V(8); PG8_WAIT_L(0); PG8_BAR; PG8_MMA(1, 0, At, B0); PG8_MMA(1, 1, At, B1); PG8_BAR; PG8_SCHED;
            PG8_LDB(B0, 1, 0); PG8_LDB(B1, 1, 1); PG8_SCHED; PG8_LDA(At, 1, 0); PG8_STAGE(PG8_SA(0, 1), a2 + hA2, sR, ldA2);
            PG8_WAIT_V(8); PG8_WAIT_L(0); PG8_BAR; PG8_MMA(0, 0, At, B0); PG8_MMA(0, 1, At, B1); PG8_BAR; PG8_SCHED;
            PG8_LDA(At, 1, 1); PG8_STAGE(PG8_SB(1, 0), b3, sRb, ldB2); PG8_STAGE(PG8_SB(1, 1), b3 + hB2, sRb, ldB2); PG8_STAGE(PG8_SA(1, 0), a3, sR, ldA2);
            PG8_WAIT_V(8); PG8_WAIT_L(0); PG8_BAR; PG8_MMA(1, 0, At, B0); PG8_MMA(1, 1, At, B1); PG8_BAR; PG8_SCHED;
        }
        if constexpr (ALIGN_EPI) { if (wr == 0) PG8_BAR; }
        E(acc, cur, wr, wc, fr, fq);
        if (!has_next) break;
#pragma unroll
        for (int a = 0; a < 2; ++a)
#pragma unroll
            for (int b = 0; b < 2; ++b)
#pragma unroll
                for (int m = 0; m < 4; ++m)
#pragma unroll
                    for (int n = 0; n < 2; ++n) acc[a][b][m][n] = (f32x4){0.f, 0.f, 0.f, 0.f};
        cur = nxt; cA = nA; cB = nB; ++ui;
        ldAc = ldAn; ldBc = ldBn; hAc = hAn; hBc = hBn;
        if constexpr (ALIGN_EPI) { if (wr == 1) PG8_BAR; }
    }
    PG8_WAIT_V(0);
    if constexpr (!ALIGN_EPI) { if (wr == 0) PG8_BAR; }
    PG8_BAR;
#undef PG8_SA
#undef PG8_SB
#undef PG8_STAGE
#undef PG8_LDA
#undef PG8_LDB
#undef PG8_MMA
#undef PG8_WAIT_V
#undef PG8_WAIT_L
#undef PG8_BAR
#undef PG8_SCHED
}
}
using pg8::GUnit;
namespace pg8 {
#define EPI_OPAQUE() asm volatile("" : "+v"(fr), "+v"(fq))
struct EpiBf16 {
    static constexpr bool PERM = true;
    bf16_t* O; int ldc;
    __device__ __forceinline__ void operator()(const f32x4 (&acc)[2][2][4][2], const GUnit& u, int wr, int wc, int fr, int fq) const {
        EPI_OPAQUE();
        const int row0 = u.pm * BM + wr * 64 + fr, col0 = u.pn * BM + wc * 32 + 8 * fq;
#pragma unroll
        for (int ai = 0; ai < 2; ++ai)
#pragma unroll
            for (int m = 0; m < 4; ++m) { bf16_t* rowp = O + (size_t)(row0 + ai * HALF + m * 16) * ldc + col0;
#pragma unroll
                for (int bj = 0; bj < 2; ++bj) { const f32x4 v0 = acc[ai][bj][m][0], v1 = acc[ai][bj][m][1];
                    u32x4 w; w.x = cvtpk(v0[0], v0[1]); w.y = cvtpk(v0[2], v0[3]); w.z = cvtpk(v1[0], v1[1]); w.w = cvtpk(v1[2], v1[3]);
                    *(u32x4*)(rowp + bj * HALF) = w; } }
    }
};
struct EpiF32 {
    static constexpr bool PERM = false;
    float* O; int ldc;
    __device__ __forceinline__ void operator()(const f32x4 (&acc)[2][2][4][2], const GUnit& u, int wr, int wc, int fr, int fq) const {
        EPI_OPAQUE();
        const int row0 = u.pm * BM + wr * 64 + fr, col0 = u.pn * BM + wc * 32 + 4 * fq;
#pragma unroll
        for (int ai = 0; ai < 2; ++ai)
#pragma unroll
            for (int m = 0; m < 4; ++m) { float* rowp = O + (size_t)(row0 + ai * HALF + m * 16) * ldc + col0;
#pragma unroll
                for (int bj = 0; bj < 2; ++bj)
#pragma unroll
                    for (int n = 0; n < 2; ++n) *(f32x4*)(rowp + bj * HALF + n * 16) = acc[ai][bj][m][n]; }
    }
};
__device__ __forceinline__ void rope8(f32x4& v0, f32x4& v1, const float* cs  ) {
    const f32x4 a = *(const f32x4*)cs, b = *(const f32x4*)(cs + 4);
    f32x4 r0, r1;
    r0[0] = v0[0] * a[0] - v0[1] * a[1]; r0[1] = v0[1] * a[0] + v0[0] * a[1];
    r0[2] = v0[2] * a[2] - v0[3] * a[3]; r0[3] = v0[3] * a[2] + v0[2] * a[3];
    r1[0] = v1[0] * b[0] - v1[1] * b[1]; r1[1] = v1[1] * b[0] + v1[0] * b[1];
    r1[2] = v1[2] * b[2] - v1[3] * b[3]; r1[3] = v1[3] * b[2] + v1[2] * b[3];
    v0 = r0; v1 = r1;
}
struct EpiInProj {
    static constexpr bool PERM = true;
    bf16_t* P; bf16_t* kcmp; bf16_t* vcmp; float* side; bf16_t* krot; const float* rope; float* ssq_q; float* ssq_kv; const float* fbias; float* lf;
    __device__ __forceinline__ void operator()(const f32x4 (&acc)[2][2][4][2], const GUnit& u, int wr, int wc, int fr, int fq) const {
        EPI_OPAQUE();
        const int row0 = u.pm * BM + wr * 64 + fr, col0 = u.pn * BM + wc * 32 + 8 * fq;
#pragma unroll
        for (int ai = 0; ai < 2; ++ai)
#pragma unroll
            for (int m = 0; m < 4; ++m) { const int row = row0 + ai * HALF + m * 16; bf16_t* rowp = P + (size_t)row * PW + col0;
                float ssq = 0.f;
#pragma unroll
                for (int bj = 0; bj < 2; ++bj) { f32x4 v0 = acc[ai][bj][m][0], v1 = acc[ai][bj][m][1];
                    if (u.pn == 2 && bj == 1) {
                        if (wc == 0 && fq < 2) { float* sp = side + (size_t)row * 16 + 8 * fq; *(f32x4*)sp = v0; *(f32x4*)(sp + 4) = v1;
                            if (fq == 1) { const f32x4 fb = *(const f32x4*)fbias; f32x4 s1;
#pragma unroll
                                for (int e = 0; e < 4; ++e) { const float x = v1[e] + fb[e]; s1[e] = (x >= 0.f) ? -log1pf(expf(-x)) : (x - log1pf(expf(x))); }
                                *(f32x4*)(lf + (size_t)row * 4) = s1; } }
                        if (wc == 1) { rope8(v0, v1, rope + (size_t)(row & (SEQ - 1)) * 32 + 8 * fq);
                            u32x4 w; w.x = cvtpk(v0[0], v0[1]); w.y = cvtpk(v0[2], v0[3]); w.z = cvtpk(v1[0], v1[1]); w.w = cvtpk(v1[2], v1[3]);
                            *(u32x4*)(krot + (size_t)row * 32 + 8 * fq) = w; }
                    }
                    u32x4 w; w.x = cvtpk(v0[0], v0[1]); w.y = cvtpk(v0[2], v0[3]); w.z = cvtpk(v1[0], v1[1]); w.w = cvtpk(v1[2], v1[3]);
                    *(u32x4*)(rowp + bj * HALF) = w;
                    if (u.pn == 1 && bj == 0) { bf16_t* cp = (wc < 2 ? kcmp : vcmp) + (size_t)row * 64 + (wc & 1) * 32 + 8 * fq; *(u32x4*)cp = w; }
                    if (u.pn == 11 || (u.pn == 7 && bj == 1)) ssq += (v0[0] * v0[0] + v0[1] * v0[1]) + (v0[2] * v0[2] + v0[3] * v0[3]) + (v1[0] * v1[0] + v1[1] * v1[1]) + (v1[2] * v1[2] + v1[3] * v1[3]);
                }
                if (u.pn == 11 || u.pn == 7) { ssq += xor_lane_lt32<16>(ssq); ssq = sum_halves(ssq);
                    if (fq == 0) (u.pn == 11 ? ssq_q : ssq_kv)[(size_t)row * 4 + wc] = ssq; }
                asm volatile("" ::: "memory");
            }
    }
};
struct EpiQup {
    static constexpr bool PERM = true;
    bf16_t* O; const float* ssq_q; const float* rope;
    __device__ __forceinline__ void operator()(const f32x4 (&acc)[2][2][4][2], const GUnit& u, int wr, int wc, int fr, int fq) const {
        EPI_OPAQUE();
        const int row0 = u.pm * BM + wr * 64 + fr, col0 = u.pn * BM + wc * 32 + 8 * fq;
#pragma unroll
        for (int ai = 0; ai < 2; ++ai)
#pragma unroll
            for (int m = 0; m < 4; ++m) { const int row = row0 + ai * HALF + m * 16; bf16_t* rowp = O + (size_t)row * 512 + col0;
                const f32x4 pq = *(const f32x4*)(ssq_q + (size_t)row * 4);
                const float rstd = 1.0f / sqrtf(((pq[0] + pq[1]) + (pq[2] + pq[3])) * (1.0f / 256.0f) + RMS_EPS);
#pragma unroll
                for (int bj = 0; bj < 2; ++bj) { f32x4 v0 = acc[ai][bj][m][0] * rstd, v1 = acc[ai][bj][m][1] * rstd;
                    const int c8 = col0 + bj * HALF, within = c8 % 96;
                    if (c8 < 384 && within >= 64) rope8(v0, v1, rope + (size_t)(row & (SEQ - 1)) * 32 + (within - 64));
                    u32x4 w; w.x = cvtpk(v0[0], v0[1]); w.y = cvtpk(v0[2], v0[3]); w.z = cvtpk(v1[0], v1[1]); w.w = cvtpk(v1[2], v1[3]);
                    *(u32x4*)(rowp + bj * HALF) = w; }
                asm volatile("" ::: "memory"); }
    }
};
struct EpiKVup {
    static constexpr bool PERM = true;
    bf16_t* O; const float* ssq_kv;
    __device__ __forceinline__ void operator()(const f32x4 (&acc)[2][2][4][2], const GUnit& u, int wr, int wc, int fr, int fq) const {
        EPI_OPAQUE();
        const int row0 = u.pm * BM + wr * 64 + fr, col0 = u.pn * BM + wc * 32 + 8 * fq;
#pragma unroll
        for (int ai = 0; ai < 2; ++ai)
#pragma unroll
            for (int m = 0; m < 4; ++m) { const int row = row0 + ai * HALF + m * 16; bf16_t* rowp = O + (size_t)row * 512 + col0;
                const f32x4 pq = *(const f32x4*)(ssq_kv + (size_t)row * 4);
                const float rstd = 1.0f / sqrtf(((pq[0] + pq[1]) + (pq[2] + pq[3])) * (1.0f / 128.0f) + RMS_EPS);
#pragma unroll
                for (int bj = 0; bj < 2; ++bj) { const f32x4 v0 = acc[ai][bj][m][0] * rstd, v1 = acc[ai][bj][m][1] * rstd;
                    u32x4 w; w.x = cvtpk(v0[0], v0[1]); w.y = cvtpk(v0[2], v0[3]); w.z = cvtpk(v1[0], v1[1]); w.w = cvtpk(v1[2], v1[3]);
                    *(u32x4*)(rowp + bj * HALF) = w; }
                asm volatile("" ::: "memory"); }
    }
};
__device__ __forceinline__ float gelu_tanh(float x) { const float u2 = 2.0f * 0.7978845608028654f * (x + 0.044715f * x * x * x); return x * fast_rcp(1.0f + fast_exp2(-u2 * LOG2E)); }
struct EpiCmp1 {
    static constexpr bool PERM = true;
    bf16_t* O; const float* bias1;
    __device__ __forceinline__ void operator()(const f32x4 (&acc)[2][2][4][2], const GUnit& u, int wr, int wc, int fr, int fq) const {
        EPI_OPAQUE();
        const int row0 = u.pm * BM + wr * 64 + fr, col0 = wc * 32 + 8 * fq;
        f32x4 bv[2][2];
#pragma unroll
        for (int bj = 0; bj < 2; ++bj)
#pragma unroll
            for (int n = 0; n < 2; ++n) bv[bj][n] = *(const f32x4*)(bias1 + col0 + bj * HALF + 4 * n);
#pragma unroll
        for (int ai = 0; ai < 2; ++ai)
#pragma unroll
            for (int m = 0; m < 4; ++m) { bf16_t* rowp = O + (size_t)(row0 + ai * HALF + m * 16) * 256 + col0;
#pragma unroll
                for (int bj = 0; bj < 2; ++bj) { f32x4 v0 = acc[ai][bj][m][0] + bv[bj][0], v1 = acc[ai][bj][m][1] + bv[bj][1];
#pragma unroll
                    for (int e = 0; e < 4; ++e) { v0[e] = gelu_tanh(v0[e]); v1[e] = gelu_tanh(v1[e]); }
                    u32x4 w; w.x = cvtpk(v0[0], v0[1]); w.y = cvtpk(v0[2], v0[3]); w.z = cvtpk(v1[0], v1[1]); w.w = cvtpk(v1[2], v1[3]);
                    *(u32x4*)(rowp + bj * HALF) = w; } }
    }
};
typedef __amdgpu_buffer_rsrc_t rsrc_t;
struct EpiMerge {
    static constexpr bool PERM = true;
    bf16_t* O;
    unsigned char* scr;
    __device__ __forceinline__ void operator()(const f32x4 (&acc)[2][2][4][2], const GUnit& u, int wr, int wc, int fr, int fq) const {
        EPI_OPAQUE();
        const int tid = (wr * 4 + wc) * 64 + fq * 16 + fr;
        const int sub = u.id;
        const rsrc_t rs = __builtin_amdgcn_make_buffer_rsrc(scr, 0, 524288, 0x00020000);
        if (sub < 4) {
#pragma unroll
            for (int ai = 0; ai < 2; ++ai)
#pragma unroll
                for (int bj = 0; bj < 2; ++bj)
#pragma unroll
                    for (int m = 0; m < 4; ++m)
#pragma unroll
                        for (int n = 0; n < 2; ++n) { const int q = ((ai * 2 + bj) * 4 + m) * 2 + n; const f32x4 v = acc[ai][bj][m][n];
                            u32x2 w; w.x = cvtpk(v[0], v[1]); w.y = cvtpk(v[2], v[3]);
                            __builtin_amdgcn_raw_buffer_store_b64(w, rs, tid * 8, (sub * 32 + q) * 4096, 0); }
            return;
        }
        const int j = sub - 4;
        const int row0 = u.pm * BM + wr * 64 + fr, col0 = u.pn * BM + 64 * j + wc * 16 + 4 * fq;
#pragma unroll
        for (int ai = 0; ai < 2; ++ai)
#pragma unroll
            for (int m = 0; m < 4; ++m) { bf16_t* rowp = O + (size_t)(row0 + ai * HALF + m * 16) * DM + col0;
                f32x4 t = {0.f, 0.f, 0.f, 0.f};
#pragma unroll
                for (int g = 0; g < 4; ++g) { const f32x4 gt = acc[ai][g >> 1][m][g & 1];
                    const int qb = (ai * 16 + m * 2);
                    const u32x2 s = (j == 0) ? __builtin_amdgcn_raw_buffer_load_b64(rs, tid * 8, (g * 32 + qb) * 4096, 0)
                                  : (j == 1) ? __builtin_amdgcn_raw_buffer_load_b64(rs, tid * 8, (g * 32 + qb + 1) * 4096, 0)
                                  : (j == 2) ? __builtin_amdgcn_raw_buffer_load_b64(rs, tid * 8, (g * 32 + qb + 8) * 4096, 0)
                                             : __builtin_amdgcn_raw_buffer_load_b64(rs, tid * 8, (g * 32 + qb + 9) * 4096, 0);
                    t[0] += sigmoid_f(gt[0]) * __uint_as_float(s.x << 16); t[1] += sigmoid_f(gt[1]) * __uint_as_float(s.x & 0xffff0000u);
                    t[2] += sigmoid_f(gt[2]) * __uint_as_float(s.y << 16); t[3] += sigmoid_f(gt[3]) * __uint_as_float(s.y & 0xffff0000u); }
                u32x2 w; w.x = cvtpk(t[0], t[1]); w.y = cvtpk(t[2], t[3]);
                *(u32x2*)rowp = w;
                asm volatile("" ::: "memory"); }
    }
};
__device__ __forceinline__ float dpp_ror1(float v) { return __uint_as_float((unsigned)__builtin_amdgcn_update_dpp(0, (int)__float_as_uint(v), 0x121, 0xf, 0xf, false)); }
__device__ __forceinline__ float dpp_ror2(float v) { return __uint_as_float((unsigned)__builtin_amdgcn_update_dpp(0, (int)__float_as_uint(v), 0x122, 0xf, 0xf, false)); }
struct EpiUpConv {
    static constexpr bool PERM = true;
    bf16_t* ACT; float* HB; const float* cw; const float* cb;
    __device__ __forceinline__ void operator()(const f32x4 (&acc)[2][2][4][2], const GUnit& u, int wr, int wc, int fr, int fq) const {
        EPI_OPAQUE();
        const int colL = wc * 32 + 8 * fq;
#pragma unroll
        for (int ai = 0; ai < 2; ++ai) {
            const int rowg = u.pm * BM + ai * HALF + wr * 64, g = rowg >> 6;
#pragma unroll
            for (int n = 0; n < 2; ++n) {
                const int cl = colL + 4 * n, c0 = u.pn * 128 + cl;
                f32x4 t1g, t2g, t1v, t2v;
#pragma unroll
                for (int e = 0; e < 4; ++e) { t1g[e] = 0.f; t2g[e] = 0.f; t1v[e] = 0.f; t2v[e] = 0.f; }
#pragma unroll
                for (int m = 0; m < 4; ++m) {
                    const f32x4 bg = *(const f32x4*)(cb + c0), w0g = *(const f32x4*)(cw + c0), w1g = *(const f32x4*)(cw + DFF2 + c0), w2g = *(const f32x4*)(cw + 2 * DFF2 + c0);
                    const f32x4 bv = *(const f32x4*)(cb + DFF + c0), w0v = *(const f32x4*)(cw + DFF + c0), w1v = *(const f32x4*)(cw + DFF2 + DFF + c0), w2v = *(const f32x4*)(cw + 2 * DFF2 + DFF + c0);
                    const f32x4 cg = acc[ai][0][m][n], cv = acc[ai][1][m][n];
                    f32x4 r1g, r2g, r1v, r2v, o;
#pragma unroll
                    for (int e = 0; e < 4; ++e) { r1g[e] = dpp_ror1(cg[e]); r2g[e] = dpp_ror2(cg[e]); r1v[e] = dpp_ror1(cv[e]); r2v[e] = dpp_ror2(cv[e]); }
#pragma unroll
                    for (int e = 0; e < 4; ++e) { const float p1g = (fr == 0) ? t1g[e] : r1g[e], p2g = (fr < 2) ? t2g[e] : r2g[e], p1v = (fr == 0) ? t1v[e] : r1v[e], p2v = (fr < 2) ? t2v[e] : r2v[e];
                        const float gt = bg[e] + w0g[e] * p2g + w1g[e] * p1g + w2g[e] * cg[e], vl = bv[e] + w0v[e] * p2v + w1v[e] * p1v + w2v[e] * cv[e];
                        o[e] = gt * sigmoid_f(gt) * vl; }
                    const int row = rowg + m * 16 + fr;
                    if (!(m == 0 && fr < 2)) { u32x2 w; w.x = cvtpk(o[0], o[1]); w.y = cvtpk(o[2], o[3]); *(u32x2*)(ACT + (size_t)row * DFF + c0) = w; }
                    if (m == 0 && fr < 2) { float* hp = HB + ((size_t)((g * 4 + fr) * 22 + u.pn) * 256 + cl); *(f32x4*)hp = cg; *(f32x4*)(hp + 128) = cv; }
                    if (m == 3 && fr >= 14) { float* hp = HB + ((size_t)((g * 4 + fr - 12) * 22 + u.pn) * 256 + cl); *(f32x4*)hp = cg; *(f32x4*)(hp + 128) = cv; }
                    t1g = r1g; t2g = r2g; t1v = r1v; t2v = r2v;
                    asm volatile("" ::: "memory");
                }
            }
        }
    }
};
}
#define XB_TMO      128
#define XB_XCNT(j)  (256  + 64 * (j))
#define XB_XSUB(j)  (1280 + 64 * (j))
#define XB_XGEN(j)  (2304 + 64 * (j))
#define XB_TOP      3328
#define XB_TOPGEN   3392
#define XCD_BAR_WORDS 3456
#define XB_SPIN_CAP (1u << 22)
__device__ __forceinline__ unsigned xb_ld(unsigned* p)              { return __hip_atomic_load(p, __ATOMIC_RELAXED, __HIP_MEMORY_SCOPE_AGENT); }
__device__ __forceinline__ unsigned xb_add(unsigned* p, unsigned v) { return __hip_atomic_fetch_add(p, v, __ATOMIC_RELAXED, __HIP_MEMORY_SCOPE_AGENT); }
__device__ __forceinline__ unsigned xb_xcc_id() { return (unsigned)__builtin_amdgcn_s_getreg((3 << 11) | 20) & 0xFu; }
#define XB_SPIN(cond, bar) do { unsigned _sp = 0; while (cond) { __builtin_amdgcn_s_sleep(1); \
    if ((++_sp & 255u) == 0u) { if (xb_ld(&(bar)[XB_TMO])) break; if (_sp > XB_SPIN_CAP) { atomicAdd(&(bar)[XB_TMO], 1u); break; } } } } while (0)
struct XcdBarrier { unsigned* bar; unsigned x; volatile LAS unsigned* st; };
__device__ __forceinline__ XcdBarrier xcd_barrier_post(unsigned* bar, volatile LAS unsigned* st) {
    XcdBarrier b; b.bar = bar; b.x = xb_xcc_id(); b.st = st;
    if (threadIdx.x == 0) (void)xb_add(&bar[XB_XCNT(b.x)], 1u);
    return b;
}
__device__ __forceinline__ void xcd_barrier_complete(unsigned* bar, unsigned x, unsigned& nloc, unsigned& nx) {
    const unsigned G = gridDim.x * gridDim.y * gridDim.z;
    unsigned sum, cnt, mine, sp = 0u;
    for (;;) {
        sum = 0u; cnt = 0u; mine = 0u;
#pragma unroll
        for (unsigned j = 0; j < 16; ++j) { const unsigned c = xb_ld(&bar[XB_XCNT(j)]); sum += c; cnt += (c > 0u) ? 1u : 0u; mine = (j == x) ? c : mine; }
        if (sum == G) break;
        __builtin_amdgcn_s_sleep(1);
        if ((++sp & 255u) == 0u) { if (xb_ld(&bar[XB_TMO])) break; if (sp > XB_SPIN_CAP) { atomicAdd(&bar[XB_TMO], 1u); break; } }
    }
    nloc = mine > 0u ? mine : 1u; nx = cnt > 0u ? cnt : 1u;
}
__device__ __forceinline__ void xcd_barrier(const XcdBarrier& b) {
    asm volatile("s_waitcnt vmcnt(0)" ::: "memory");
    __syncthreads();
    if (threadIdx.x == 0) {
        unsigned* bar = b.bar; unsigned bx = b.x;
        asm volatile("" : "+s"(bx));
        __builtin_amdgcn_s_waitcnt(0);
        unsigned nloc = b.st[0], nx = b.st[1];
        if (nloc == 0u) { xcd_barrier_complete(bar, bx, nloc, nx); b.st[0] = nloc; b.st[1] = nx; }
        const unsigned old = xb_add(&bar[XB_XSUB(bx)], 1u);
        const unsigned gen = old / nloc;
        if (old + 1u == (gen + 1u) * nloc) {
            __builtin_amdgcn_fence(__ATOMIC_RELEASE, "agent");
            asm volatile("s_waitcnt vmcnt(0)" ::: "memory");
            const unsigned og = xb_add(&bar[XB_TOP], 1u);
            const unsigned tg = og / nx;
            if (og + 1u == (tg + 1u) * nx) xb_add(&bar[XB_TOPGEN], 1u);
            else XB_SPIN(xb_ld(&bar[XB_TOPGEN]) == tg, bar);
            __builtin_amdgcn_fence(__ATOMIC_ACQUIRE, "agent");
            xb_add(&bar[XB_XGEN(bx)], 1u);
            asm volatile("s_waitcnt vmcnt(0)" ::: "memory");
        } else {
            XB_SPIN(xb_ld(&bar[XB_XGEN(bx)]) == gen, bar);
            __builtin_amdgcn_fence(__ATOMIC_ACQUIRE, "agent");
            asm volatile("s_waitcnt vmcnt(0)" ::: "memory");
        }
    }
    __syncthreads();
}

#define MFMA32(a, b, c) __builtin_amdgcn_mfma_f32_32x32x16_bf16(a, b, c, 0, 0, 0)
typedef short v4i16_t __attribute__((ext_vector_type(4)));
typedef LAS const char* lds_cptr;
typedef LAS char* lds_ptr;
__device__ __forceinline__ int crow(int r, int hi) { return (r & 3) + 8 * (r >> 2) + 4 * hi; }
__device__ __forceinline__ s16x4 vtr(lds_cptr p) { return __builtin_bit_cast(s16x4, __builtin_amdgcn_ds_read_tr16_b64_v4i16((LAS v4i16_t*)p)); }
__device__ __forceinline__ float other_half(float x, int hi) { auto rr = __builtin_amdgcn_permlane32_swap(__float_as_uint(x), __float_as_uint(x), false, false); return __uint_as_float(hi ? rr[0] : rr[1]); }
constexpr float NEG_INF = -INFINITY;

constexpr int TB_V = 12288, TB_KB = 20480, TB_SIZE = 20992;
struct Stg { u32x4 k, k2, v; float kb; };

template <int NKS> __device__ __forceinline__ void qk64(lds_cptr kbuf, const bf16x8* qf, int r32, int hi, f32x16& p0, f32x16& p1) {
    lds_cptr kp = kbuf + hi * 1024 + r32 * 16;
#pragma unroll
    for (int ks = 0; ks < NKS; ++ks) {
        const bf16x8 a0 = *(const LAS bf16x8*)(kp + ks * 2048), a1 = *(const LAS bf16x8*)(kp + ks * 2048 + 512);
        p0 = MFMA32(a0, qf[ks], p0); p1 = MFMA32(a1, qf[ks], p1);
    }
}
struct AState { f32x16 o0, o1; float m, l; };
__device__ __forceinline__ void astate_init(AState& s) {
#pragma unroll
    for (int r = 0; r < 16; ++r) { s.o0[r] = 0.f; s.o1[r] = 0.f; }
    s.m = NEG_INF; s.l = 0.f;
}
__device__ __forceinline__ void pv64(f32x16& o0, f32x16& o1, lds_cptr vp, const bf16x8 (&pf)[4]) {
#pragma unroll
    for (int ks = 0; ks < 4; ++ks) {
        const s16x4 l0 = vtr(vp + ks * 1024), h0 = vtr(vp + ks * 1024 + 512), l1 = vtr(vp + 4096 + ks * 1024), h1 = vtr(vp + 4096 + ks * 1024 + 512);
        const bf16x8 v0 = (bf16x8){l0[0], l0[1], l0[2], l0[3], h0[0], h0[1], h0[2], h0[3]}, v1 = (bf16x8){l1[0], l1[1], l1[2], l1[3], h1[0], h1[1], h1[2], h1[3]};
        o0 = MFMA32(v0, pf[ks], o0); o1 = MFMA32(v1, pf[ks], o1);
    }
}
__device__ __forceinline__ void pack_p(const f32x16& p0, const f32x16& p1, bf16x8 (&pf)[4]) {
    u32x4 w0, w1, w2, w3;
    w0.x = cvtpk(p0[0], p0[1]); w0.y = cvtpk(p0[2], p0[3]); w0.z = cvtpk(p0[4], p0[5]); w0.w = cvtpk(p0[6], p0[7]);
    w1.x = cvtpk(p0[8], p0[9]); w1.y = cvtpk(p0[10], p0[11]); w1.z = cvtpk(p0[12], p0[13]); w1.w = cvtpk(p0[14], p0[15]);
    w2.x = cvtpk(p1[0], p1[1]); w2.y = cvtpk(p1[2], p1[3]); w2.z = cvtpk(p1[4], p1[5]); w2.w = cvtpk(p1[6], p1[7]);
    w3.x = cvtpk(p1[8], p1[9]); w3.y = cvtpk(p1[10], p1[11]); w3.z = cvtpk(p1[12], p1[13]); w3.w = cvtpk(p1[14], p1[15]);
    pf[0] = __builtin_bit_cast(bf16x8, w0); pf[1] = __builtin_bit_cast(bf16x8, w1); pf[2] = __builtin_bit_cast(bf16x8, w2); pf[3] = __builtin_bit_cast(bf16x8, w3);
}
__device__ __forceinline__ void softmax_pv64(f32x16& p0, f32x16& p1, AState& s, lds_cptr vp, int hi) {
    float mx = fmaxf(p0[0], p1[0]);
#pragma unroll
    for (int r = 1; r < 16; ++r) mx = fmaxf(mx, fmaxf(p0[r], p1[r]));
    mx = fmaxf(mx, other_half(mx, hi));
    const float mn = fmaxf(s.m, mx), ms = (mn == NEG_INF) ? 0.f : mn;
    const float alpha = fast_exp2(s.m - ms);
    float rs = 0.f;
#pragma unroll
    for (int r = 0; r < 16; ++r) { p0[r] = fast_exp2(p0[r] - ms); p1[r] = fast_exp2(p1[r] - ms); rs += p0[r] + p1[r]; }
    rs += other_half(rs, hi);
    s.l = s.l * alpha + rs; s.m = mn;
#pragma unroll
    for (int r = 0; r < 16; ++r) { s.o0[r] *= alpha; s.o1[r] *= alpha; }
    bf16x8 pf[4]; pack_p(p0, p1, pf);
    pv64(s.o0, s.o1, vp, pf);
}
__device__ __forceinline__ void mask_causal(f32x16& p0, f32x16& p1, int kpos0, int tq, int hi) {
#pragma unroll
    for (int r = 0; r < 16; ++r) { const int kp = kpos0 + crow(r, hi); if (kp > tq) p0[r] = NEG_INF; if (kp + 32 > tq) p1[r] = NEG_INF; }
}
__device__ __forceinline__ void add_table(f32x16& p0, f32x16& p1, const LAS float* tb) {
#pragma unroll
    for (int r = 0; r < 16; ++r) { const int o = (r & 3) + 8 * (r >> 2); p0[r] += tb[o]; p1[r] += tb[o + 32]; }
}
__device__ __forceinline__ void store_o_bf16(bf16_t* orow, const f32x16& o0, const f32x16& o1, float sc, int hi) {
#pragma unroll
    for (int g = 0; g < 4; ++g) {
        u32x2 w0, w1; w0.x = cvtpk(o0[4 * g] * sc, o0[4 * g + 1] * sc); w0.y = cvtpk(o0[4 * g + 2] * sc, o0[4 * g + 3] * sc);
        w1.x = cvtpk(o1[4 * g] * sc, o1[4 * g + 1] * sc); w1.y = cvtpk(o1[4 * g + 2] * sc, o1[4 * g + 3] * sc);
        *(u32x2*)(orow + 8 * g + 4 * hi) = w0; *(u32x2*)(orow + 32 + 8 * g + 4 * hi) = w1;
    }
}
constexpr size_t MiB = 1u << 20, KiB = 1u << 10;
constexpr size_t WS_CTL = 0, CTL_ZERO_BYTES = 1 * MiB;
constexpr size_t WS_ROPE = 1 * MiB, WS_NSATAB = WS_ROPE + 512 * KiB, WS_DILTAB = WS_NSATAB + 32 * KiB, WS_CMPB = WS_DILTAB + 8 * KiB, WS_FARB = WS_CMPB + 4 * KiB;
constexpr size_t WS_WT = 4 * MiB, LW = 38 * MiB;
constexpr size_t LW_IN = 0, LW_G = 6 * MiB, LW_BR = 14 * MiB, LW_O = 16 * MiB, LW_UP = 18 * MiB, LW_DN = 29 * MiB, LW_UQ = 35 * MiB, LW_UKV = 35 * MiB + 256 * KiB, LW_PHI = 36 * MiB;
constexpr size_t BR_A = 0, BR_B = 512 * KiB, BR_C = 768 * KiB, BR_D = 1280 * KiB;
constexpr size_t WS_SIDE = 80 * MiB, WS_SSQQ = 84 * MiB, WS_SSQKV = 85 * MiB, WS_KB = 86 * MiB, WS_KROT = 87 * MiB, WS_KCMP = 91 * MiB, WS_VCMP = 100 * MiB,
                 WS_HID = 109 * MiB, WS_LF = 2 * MiB  , WS_KC = 113 * MiB, WS_VC = 113 * MiB + 512 * KiB, WS_DLSE = 114 * MiB, WS_DOG = 116 * MiB;
constexpr size_t WS_H = 164 * MiB, WS_OCAT = 292 * MiB, WS_QM = 404 * MiB, WS_KVM = 468 * MiB, WS_P = 532 * MiB;
constexpr size_t WS_MERGED = 532 * MiB, WS_MSCR = 660 * MiB, WS_Y = 164 * MiB  , WS_H2 = 756 * MiB, WS_ACT = 164 * MiB  , WS_HB = 532 * MiB  , WS_Y2 = 884 * MiB  , WS_END = 1024 * MiB;
constexpr size_t MSCR_PER_WG = 512 * KiB;
static_assert(WS_WT + 2 * LW <= WS_SIDE && WS_DOG + 48 * MiB <= WS_H && WS_P + 384 * MiB <= WS_END && WS_MSCR + 256 * MSCR_PER_WG <= WS_P + 384 * MiB && WS_H2 + 128 * MiB <= WS_Y2 && WS_Y2 + 128 * MiB <= WS_END, "ws map");
static_assert(WS_ACT + 352 * MiB <= WS_HB && WS_HB + 96 * MiB <= WS_H2 && WS_Y + 128 * MiB <= WS_OCAT, "ws overlays");
constexpr int CW_BAR = 4096;
constexpr int CW_Q = 16384;

constexpr int RING_BYTES = 131072, LDSCTL_OFF = RING_BYTES, MISC_OFF = LDSCTL_OFF + 320, LDS_BYTES = 147456;
constexpr int NSA_SLAB = 49152, NSA_SLAB_BYTES = 4 * 64 * 65 * 4, NSA_SEL = NSA_SLAB + NSA_SLAB_BYTES;
static_assert(NSA_SEL + 512 <= RING_BYTES && 4 * NSA_TL * 4 <= NSA_SLAB_BYTES && 2 * TB_SIZE <= NSA_SLAB, "NSA LDS map");

struct Frame {
    LAS unsigned char* lds; volatile LAS unsigned* MISC; gu32* ctl;
    int tid, lane, wave, G;
    const float* in[27]; float* out; unsigned char* ws;
};
#define WSP(T, off) ((T*)(F.ws + (off)))
#define VM_WAIT() asm volatile("s_waitcnt vmcnt(0)" ::: "memory")
#define LDS_WAIT() asm volatile("s_waitcnt lgkmcnt(0)" ::: "memory")

__device__ __forceinline__ int queue_grab(Frame& F, gu32* ctr) {
    if (F.tid == 0) F.MISC[0] = __hip_atomic_fetch_add(ctr, 1u, __ATOMIC_RELAXED, __HIP_MEMORY_SCOPE_AGENT);
    __syncthreads();
    const int v = (int)F.MISC[0];
    __syncthreads();
    return v;
}

template <bool FOX> __device__ __forceinline__ void causal_unit(Frame& F, int b, int h, int qb) {
    constexpr int NKS = FOX ? 4 : 6;
    int lane_o = F.lane; asm volatile("" : "+v"(lane_o));
    const int wid = F.wave, lane = lane_o, r32 = lane & 31, hi = lane >> 5;
    const size_t rowbase = (size_t)b * SEQ;
    const int q0 = qb * 256, tq = q0 + wid * 32 + r32, NT = qb * 4 + 4;
    const bf16_t* P = WSP(const bf16_t, WS_P);
    const bf16_t *Kb, *Vb, *Qrow; int kpitch, vpitch;
    const bf16_t* Kr = WSP(const bf16_t, WS_KROT) + rowbase * 32;
    const float* kbsrc = WSP(const float, WS_KB) + (size_t)(b * 4 + h) * SEQ;
    if (FOX) { Kb = P + rowbase * PW + PC_CK + h * 64; Vb = P + rowbase * PW + PC_CV + h * 64; kpitch = PW; vpitch = PW; Qrow = P + (rowbase + tq) * PW + PC_CQ + h * 64; }
    else { const bf16_t* KV = WSP(const bf16_t, WS_KVM) + rowbase * 512 + h * 128; Kb = KV; Vb = KV + 64; kpitch = 512; vpitch = 512; Qrow = WSP(const bf16_t, WS_QM) + (rowbase + tq) * 512 + h * 96; }
    bf16x8 qf[NKS];
#pragma unroll
    for (int ks = 0; ks < NKS; ++ks) qf[ks] = *(const bf16x8*)(Qrow + ks * 16 + hi * 8);
    AState st; astate_init(st);
    lds_ptr lds = (lds_ptr)F.lds;
    const int vpo = ((lane >> 4) & 1) * 32 + (lane & 3) * 8 + (4 * hi + ((lane & 15) >> 2)) * 64;
    Stg s;
#define CU_LOAD(t) do { s.k = *(const u32x4*)(Kb + (size_t)((t) * 64 + lane) * kpitch + wid * 8); \
        if (!FOX) { if (wid < 4) s.k2 = *(const u32x4*)(Kr + (size_t)((t) * 64 + lane) * 32 + wid * 8); } \
        s.v = *(const u32x4*)(Vb + (size_t)((t) * 64 + 16 * (wid & 3) + (lane >> 2)) * vpitch + (wid >> 2) * 32 + (lane & 3) * 8); \
        if (FOX) { if (wid == 0) s.kb = kbsrc[(t) * 64 + lane]; } } while (0)
#define CU_WRITE(bi) do { lds_ptr bp = lds + (bi) * TB_SIZE; *(LAS u32x4*)(bp + wid * 1024 + lane * 16) = s.k; \
        if (!FOX) { if (wid < 4) *(LAS u32x4*)(bp + (8 + wid) * 1024 + lane * 16) = s.k2; } \
        *(LAS u32x4*)(bp + TB_V + wid * 1024 + lane * 16) = s.v; \
        if (FOX) { if (wid == 0) *(LAS float*)(bp + TB_KB + lane * 4) = s.kb; } } while (0)
    CU_LOAD(0); CU_WRITE(0);
    __syncthreads();
    const int tq_lo = q0 + wid * 32;
    for (int t = 0; t < NT; ++t) {
        const int bi = t & 1;
        if (t + 1 < NT) CU_LOAD(t + 1);
        if (64 * t <= tq_lo + 31) {
            lds_cptr bp = (lds_cptr)(lds + bi * TB_SIZE);
            f32x16 p0, p1;
#pragma unroll
            for (int r = 0; r < 16; ++r) { p0[r] = 0.f; p1[r] = 0.f; }
            qk64<NKS>(bp, qf, r32, hi, p0, p1);
            if (FOX) {
                const LAS float* kbt = (const LAS float*)(bp + TB_KB) + 4 * hi;
#pragma unroll
                for (int g = 0; g < 4; ++g) { const f32x4 a = *(const LAS f32x4*)(kbt + 8 * g), c = *(const LAS f32x4*)(kbt + 32 + 8 * g);
#pragma unroll
                    for (int e = 0; e < 4; ++e) { p0[4 * g + e] += a[e]; p1[4 * g + e] += c[e]; } }
            }
            if (64 * t + 63 > tq_lo) mask_causal(p0, p1, 64 * t, tq, hi);
            softmax_pv64(p0, p1, st, bp + TB_V + vpo, hi);
        }
        if (t + 1 < NT) CU_WRITE(bi ^ 1);
        __syncthreads();
    }
#undef CU_LOAD
#undef CU_WRITE
    bf16_t* orow = WSP(bf16_t, WS_OCAT) + (rowbase + tq) * OCW + (FOX ? 384 : 640) + h * 64;
    store_o_bf16(orow, st.o0, st.o1, 1.0f / st.l, hi);
}
__device__ __forceinline__ void nsa_unit(Frame& F, int b, int qblk) {
    int lane_o = F.lane; asm volatile("" : "+v"(lane_o));
    const int wid = F.wave, lane = lane_o, r32 = lane & 31, hi = lane >> 5, tid = wid * 64 + lane;
    const int h = wid & 3, qs = wid >> 2;
    const int q0 = qblk * 64, cur = qblk, tq = q0 + 32 * qs + r32, tq_lo = q0 + 32 * qs;
    const size_t rowbase = (size_t)b * SEQ, row = rowbase + tq;
    const bf16_t* P = WSP(const bf16_t, WS_P);
    lds_ptr lds = (lds_ptr)F.lds;
    const int vpo = ((lane >> 4) & 1) * 32 + (lane & 3) * 8 + (4 * hi + ((lane & 15) >> 2)) * 64;
    bf16x8 qf[4];
    { const bf16_t* Qrow = P + row * PW + PC_AQ + h * 64;
#pragma unroll
      for (int ks = 0; ks < 4; ++ks) qf[ks] = *(const bf16x8*)(Qrow + ks * 16 + hi * 8); }
    Stg s; int ln;
#define NS_LOAD(Kb, kp, Vb, vp_, t) do { s.k = *(const u32x4*)((Kb) + (size_t)((t) * 64 + ln) * (kp) + wid * 8); \
        s.v = *(const u32x4*)((Vb) + (size_t)((t) * 64 + 16 * (wid & 3) + (ln >> 2)) * (vp_) + (wid >> 2) * 32 + (ln & 3) * 8); } while (0)
#define NS_FRESH() do { ln = lane; asm volatile("" : "+v"(ln)); } while (0)
#define NS_WRITE(bi) do { lds_ptr bp_ = lds + (bi) * TB_SIZE; *(LAS u32x4*)(bp_ + wid * 1024 + lane * 16) = s.k; *(LAS u32x4*)(bp_ + TB_V + wid * 1024 + lane * 16) = s.v; } while (0)
    const bf16_t* KC = WSP(const bf16_t, WS_KC) + (size_t)b * 256 * 64; const bf16_t* VC = WSP(const bf16_t, WS_VC) + (size_t)b * 256 * 64;
    const int cmax_u = (q0 + 63 - 31) >> 4, NTc = (cmax_u >> 6) + 1;
    const int cmax = (tq - 31) >> 4;
    float cm = NEG_INF, cl = 0.f;
    NS_FRESH(); NS_LOAD(KC, 64, VC, 64, 0); NS_WRITE(0);
    __syncthreads();
    for (int t = 0; t < NTc; ++t) {
        const int bi = t & 1;
        if (t + 1 < NTc) NS_LOAD(KC, 64, VC, 64, t + 1);
        { lds_cptr bp = (lds_cptr)(lds + bi * TB_SIZE); f32x16 p0, p1;
#pragma unroll
          for (int r = 0; r < 16; ++r) { p0[r] = 0.f; p1[r] = 0.f; }
          qk64<4>(bp, qf, r32, hi, p0, p1);
          float mx = NEG_INF;
#pragma unroll
          for (int r = 0; r < 16; ++r) { const int c = 64 * t + crow(r, hi); if (c > cmax) p0[r] = NEG_INF; if (c + 32 > cmax) p1[r] = NEG_INF; mx = fmaxf(mx, fmaxf(p0[r], p1[r])); }
          mx = fmaxf(mx, other_half(mx, hi));
          const float mn = fmaxf(cm, mx), ms = (mn == NEG_INF) ? 0.f : mn; float rs = 0.f;
#pragma unroll
          for (int r = 0; r < 16; ++r) rs += fast_exp2(p0[r] - ms) + fast_exp2(p1[r] - ms);
          rs += other_half(rs, hi);
          cl = cl * fast_exp2(cm - ms) + rs; cm = mn; }
        if (t + 1 < NTc) NS_WRITE(bi ^ 1);
        __syncthreads();
    }
    const float cms = (cm == NEG_INF) ? 0.f : cm, cinv = 1.0f / fmaxf(cl, 1e-30f);
    f32x16 oc0, oc1;
#pragma unroll
    for (int r = 0; r < 16; ++r) { oc0[r] = 0.f; oc1[r] = 0.f; }
    float G[32]; float carry = 0.f;
#pragma unroll
    for (int i = 0; i < 32; ++i) G[i] = 0.f;
    NS_FRESH(); NS_LOAD(KC, 64, VC, 64, 0); NS_WRITE(0);
    __syncthreads();
#pragma unroll
    for (int t = 0; t < 4; ++t) {
        if (t < NTc) {
            const int bi = t & 1;
            if (t + 1 < NTc) NS_LOAD(KC, 64, VC, 64, t + 1);
            { lds_cptr bp = (lds_cptr)(lds + bi * TB_SIZE); f32x16 p0, p1;
#pragma unroll
              for (int r = 0; r < 16; ++r) { p0[r] = 0.f; p1[r] = 0.f; }
              qk64<4>(bp, qf, r32, hi, p0, p1);
#pragma unroll
              for (int r = 0; r < 16; ++r) { const int c = 64 * t + crow(r, hi);
                  p0[r] = (c > cmax) ? 0.f : fast_exp2(p0[r] - cms) * cinv; p1[r] = (c + 32 > cmax) ? 0.f : fast_exp2(p1[r] - cms) * cinv; }
#pragma unroll
              for (int g = 0; g < 4; ++g) { const float oth = other_half(p0[4 * g + 3], hi);
                  G[t * 8 + g] = ((p0[4 * g] + p0[4 * g + 1]) + (p0[4 * g + 2] + p0[4 * g + 3])) + (hi ? oth : carry); carry = oth; }
#pragma unroll
              for (int g = 0; g < 4; ++g) { const float oth = other_half(p1[4 * g + 3], hi);
                  G[t * 8 + 4 + g] = ((p1[4 * g] + p1[4 * g + 1]) + (p1[4 * g + 2] + p1[4 * g + 3])) + (hi ? oth : carry); carry = oth; }
              bf16x8 pf[4]; pack_p(p0, p1, pf);
              pv64(oc0, oc1, bp + TB_V + vpo, pf); }
            if (t + 1 < NTc) NS_WRITE(bi ^ 1);
            __syncthreads();
        }
    }
    { LAS float* slab = (LAS float*)(lds + NSA_SLAB) + (size_t)(h * 64 + 32 * qs + r32) * 65;
#pragma unroll
      for (int i = 0; i < 32; ++i) slab[2 * i + hi] = G[i]; }
    __syncthreads();
    { const int q = tid >> 3, jg = tid & 7;
      const LAS float* s0 = (const LAS float*)(lds + NSA_SLAB) + (size_t)q * 65;
      float v[64];
#pragma unroll
      for (int k = 0; k < 64; ++k) { const float x = (s0[k] + s0[64 * 65 + k]) + (s0[2 * 64 * 65 + k] + s0[3 * 64 * 65 + k]);
          v[k] = (k == 0 || k == cur || k == cur - 1) ? 1e9f : ((k > cur) ? -1e9f : x); if ((k & 7) == 7) asm volatile("" ::: "memory"); }
      unsigned bits = 0u;
#pragma unroll
      for (int e = 0; e < 8; ++e) { const int j = 8 * jg + e;
          const float xj = (s0[j] + s0[64 * 65 + j]) + (s0[2 * 64 * 65 + j] + s0[3 * 64 * 65 + j]);
          const float vj = (j == 0 || j == cur || j == cur - 1) ? 1e9f : ((j > cur) ? -1e9f : xj);
          int rank = 0;
#pragma unroll
          for (int k = 0; k < 64; ++k) rank += (v[k] > vj || (v[k] == vj && k < j)) ? 1 : 0;
          bits |= (rank < 16 ? 1u : 0u) << e; }
      *((LAS unsigned char*)(lds + NSA_SEL) + q * 8 + jg) = (unsigned char)bits; }
    __syncthreads();
    const unsigned mlo = *(const LAS unsigned*)(lds + NSA_SEL + (32 * qs + r32) * 8), mhi = *(const LAS unsigned*)(lds + NSA_SEL + (32 * qs + r32) * 8 + 4);
    { const u32x4* src = WSP(const u32x4, WS_NSATAB); LAS u32x4* dst = (LAS u32x4*)(lds + NSA_SLAB);
      for (int i = tid; i < 4 * NSA_TL / 4; i += 512) dst[i] = src[i]; }
    const LAS float* tabh = (const LAS float*)(lds + NSA_SLAB) + h * NSA_TL;
    const float farb = WSP(const float, WS_FARB)[h];
    float g0, g1, g2;
    { int tq_ = tq; asm volatile("" : "+v"(tq_)); const float* sd = WSP(const float, WS_SIDE) + (rowbase + tq_) * 16 + h * 3; g0 = sigmoid_f(sd[0]); g1 = sigmoid_f(sd[1]); g2 = sigmoid_f(sd[2]); }
    AState st; astate_init(st);
    { const bf16_t* Kb = P + rowbase * PW + PC_KSLC; const bf16_t* Vb = P + rowbase * PW + PC_VSLC;
      NS_FRESH(); NS_LOAD(Kb, PW, Vb, PW, 0); NS_WRITE(0);
      __syncthreads();
      for (int j = 0; j <= cur; ++j) {
          const int bi = j & 1;
          if (j < cur) NS_LOAD(Kb, PW, Vb, PW, j + 1);
          const bool mine = ((j < 32) ? (mlo >> j) : (mhi >> (j - 32))) & 1u;
          if (__any(mine)) {
              lds_cptr bp = (lds_cptr)(lds + bi * TB_SIZE); f32x16 p0, p1;
#pragma unroll
              for (int r = 0; r < 16; ++r) { p0[r] = 0.f; p1[r] = 0.f; }
              qk64<4>(bp, qf, r32, hi, p0, p1);
              if (q0 - 64 * j - 63 >= NSA_DFAR) {
#pragma unroll
                  for (int r = 0; r < 16; ++r) { p0[r] += farb; p1[r] += farb; }
              } else add_table(p0, p1, tabh + (NSA_DMAX - tq + 64 * j + 4 * hi));
              if (j == cur) mask_causal(p0, p1, 64 * j, tq, hi);
              if (!mine) {
#pragma unroll
                  for (int r = 0; r < 16; ++r) { p0[r] = NEG_INF; p1[r] = NEG_INF; } }
              softmax_pv64(p0, p1, st, bp + TB_V + vpo, hi);
          }
          if (j < cur) NS_WRITE(bi ^ 1);
          __syncthreads();
      } }
    f32x16 oa0, oa1;
    { const float sc = g1 / st.l;
#pragma unroll
      for (int r = 0; r < 16; ++r) { oa0[r] = g0 * oc0[r] + sc * st.o0[r]; oa1[r] = g0 * oc1[r] + sc * st.o1[r]; } }
    astate_init(st);
    { const bf16_t* Kb = P + rowbase * PW + PC_KWIN; const bf16_t* Vb = P + rowbase * PW + PC_VWIN;
      const int jlo = cur >= 8 ? cur - 8 : 0;
      NS_FRESH(); NS_LOAD(Kb, PW, Vb, PW, jlo); NS_WRITE(0);
      __syncthreads();
      for (int j = jlo; j <= cur; ++j) {
          const int bi = (j - jlo) & 1;
          if (j < cur) NS_LOAD(Kb, PW, Vb, PW, j + 1);
          if (tq_lo - 64 * j - 63 < 512) {
              lds_cptr bp = (lds_cptr)(lds + bi * TB_SIZE); f32x16 p0, p1;
#pragma unroll
              for (int r = 0; r < 16; ++r) { p0[r] = 0.f; p1[r] = 0.f; }
              qk64<4>(bp, qf, r32, hi, p0, p1);
              add_table(p0, p1, tabh + (NSA_DMAX - tq + 64 * j + 4 * hi));
              if (!(tq_lo - 64 * j - 63 >= 0 && tq_lo + 31 - 64 * j < 512)) {
                  const int d0 = tq - 64 * j - 4 * hi;
#pragma unroll
                  for (int r = 0; r < 16; ++r) { const int d = d0 - ((r & 3) + 8 * (r >> 2)); if (d < 0 || d >= 512) p0[r] = NEG_INF; if (d - 32 < 0 || d - 32 >= 512) p1[r] = NEG_INF; }
              }
              softmax_pv64(p0, p1, st, bp + TB_V + vpo, hi);
          }
          if (j < cur) NS_WRITE(bi ^ 1);
          __syncthreads();
      } }
    { const float sc = g2 / st.l;
#pragma unroll
      for (int r = 0; r < 16; ++r) { oa0[r] += sc * st.o0[r]; oa1[r] += sc * st.o1[r]; } }
    { int tq_ = tq; asm volatile("" : "+v"(tq_)); store_o_bf16(WSP(bf16_t, WS_OCAT) + (rowbase + tq_) * OCW + h * 64, oa0, oa1, 1.0f, hi); }
#undef NS_LOAD
#undef NS_FRESH
#undef NS_WRITE
}
__device__ __forceinline__ void dil_unit(Frame& F, int b, int hh, int span) {
    int lane_o = F.lane; asm volatile("" : "+v"(lane_o));
    const int wid = F.wave, lane = lane_o, r32 = lane & 31, hi = lane >> 5, tid = wid * 64 + lane;
    const int T0 = span * 512;
    const size_t rowbase = (size_t)b * SEQ;
    const bf16_t* P = WSP(const bf16_t, WS_P) + rowbase * PW;
    lds_ptr lds = (lds_ptr)F.lds;
    LAS float* dtab = (LAS float*)(lds + 32768);
    for (int i = tid; i < 3 * 192; i += 512) dtab[i] = WSP(const float, WS_DILTAB)[((i / 192) * 2 + hh) * 192 + (i % 192)];
    __syncthreads();
    lds_ptr vst = lds + wid * 4096;
    const int vpo = ((lane >> 4) & 1) * 32 + (lane & 3) * 8 + (4 * hi + ((lane & 15) >> 2)) * 64;
    bf16_t* DOG = WSP(bf16_t, WS_DOG); float* DLSE = WSP(float, WS_DLSE);
    for (int g = 0; g < 3; ++g) {
        const int sh = 2 * g, head = 2 * g + hh;
        for (int rep = 0; rep < 2; ++rep) {
            const int wt = wid + 8 * rep;
            const int res = (g == 0) ? 0 : (g == 1 ? (wt & 3) : wt);
            const int i0 = (g == 0) ? 32 * wt : (g == 1 ? 32 * (wt >> 2) : 0);
            const int n0 = (T0 >> sh) + i0;
            const int tokq = res + ((n0 + r32) << sh);
            bf16x8 qf[4];
            { const bf16_t* Qrow = P + (size_t)tokq * PW + PC_BQ + head * 64;
#pragma unroll
              for (int ks = 0; ks < 4; ++ks) qf[ks] = *(const bf16x8*)(Qrow + ks * 16 + hi * 8); }
            f32x16 o0, o1; float m = NEG_INF, l = 0.f;
#pragma unroll
            for (int r = 0; r < 16; ++r) { o0[r] = 0.f; o1[r] = 0.f; }
            for (int c = 0; c < 5; ++c) {
                const int nk0 = n0 - 128 + 32 * c;
                if (nk0 + 31 < 0) continue;
                { int nk = nk0 + r32; nk = nk < 0 ? 0 : nk; const bf16_t* Krow = P + (size_t)(res + (nk << sh)) * PW + PC_BK + head * 64;
                  bf16x8 kf[4];
#pragma unroll
                  for (int ks = 0; ks < 4; ++ks) kf[ks] = *(const bf16x8*)(Krow + ks * 16 + hi * 8);
                  u32x4 vr[4];
#pragma unroll
                  for (int i = 0; i < 4; ++i) { const int pc = lane + 64 * i, vrow = pc >> 3, c16 = pc & 7; int nv = nk0 + vrow; nv = nv < 0 ? 0 : nv;
                      vr[i] = *(const u32x4*)(P + (size_t)(res + (nv << sh)) * PW + PC_BV + head * 64 + c16 * 8); }
#pragma unroll
                  for (int i = 0; i < 4; ++i) { const int pc = lane + 64 * i, vrow = pc >> 3, c16 = pc & 7;
                      *(LAS u32x4*)(vst + (c16 >> 2) * 2048 + vrow * 64 + (c16 & 3) * 16) = vr[i]; }
                  asm volatile("s_waitcnt lgkmcnt(0)" ::: "memory");
                  f32x16 p;
#pragma unroll
                  for (int r = 0; r < 16; ++r) p[r] = 0.f;
#pragma unroll
                  for (int ks = 0; ks < 4; ++ks) p = MFMA32(kf[ks], qf[ks], p);
                  const LAS float* tb = dtab + g * 192 + (32 - r32 + 4 * hi + 32 * c);
                  float mx = NEG_INF;
#pragma unroll
                  for (int r = 0; r < 16; ++r) { const int o = (r & 3) + 8 * (r >> 2), kk = o + 4 * hi, j = 128 + r32 - 32 * c - kk;
                      const bool ok = (j >= 0) && (j <= 128) && (nk0 + kk >= 0);
                      p[r] = ok ? p[r] + tb[o] : NEG_INF; mx = fmaxf(mx, p[r]); }
                  mx = fmaxf(mx, other_half(mx, hi));
                  const float mn = fmaxf(m, mx), ms = (mn == NEG_INF) ? 0.f : mn, alpha = fast_exp2(m - ms);
                  float rs = 0.f;
#pragma unroll
                  for (int r = 0; r < 16; ++r) { p[r] = fast_exp2(p[r] - ms); rs += p[r]; }
                  rs += other_half(rs, hi);
                  l = l * alpha + rs; m = mn;
#pragma unroll
                  for (int r = 0; r < 16; ++r) { o0[r] *= alpha; o1[r] *= alpha; }
                  u32x4 w0, w1;
                  w0.x = cvtpk(p[0], p[1]); w0.y = cvtpk(p[2], p[3]); w0.z = cvtpk(p[4], p[5]); w0.w = cvtpk(p[6], p[7]);
                  w1.x = cvtpk(p[8], p[9]); w1.y = cvtpk(p[10], p[11]); w1.z = cvtpk(p[12], p[13]); w1.w = cvtpk(p[14], p[15]);
                  const bf16x8 pf0 = __builtin_bit_cast(bf16x8, w0), pf1 = __builtin_bit_cast(bf16x8, w1);
                  lds_cptr vp = (lds_cptr)(vst + vpo);
#pragma unroll
                  for (int ks = 0; ks < 2; ++ks) {
                      const s16x4 l0 = vtr(vp + ks * 1024), h0 = vtr(vp + ks * 1024 + 512), l1 = vtr(vp + 2048 + ks * 1024), h1 = vtr(vp + 2048 + ks * 1024 + 512);
                      const bf16x8 v0 = (bf16x8){l0[0], l0[1], l0[2], l0[3], h0[0], h0[1], h0[2], h0[3]}, v1 = (bf16x8){l1[0], l1[1], l1[2], l1[3], h1[0], h1[1], h1[2], h1[3]};
                      o0 = MFMA32(v0, ks == 0 ? pf0 : pf1, o0); o1 = MFMA32(v1, ks == 0 ? pf0 : pf1, o1);
                  }
                  asm volatile("s_waitcnt lgkmcnt(0)" ::: "memory"); }
            }
            const size_t orow = rowbase + tokq;
            store_o_bf16(DOG + ((size_t)g * M + orow) * 128 + hh * 64, o0, o1, 1.0f / l, hi);
            if (hi == 0) DLSE[((size_t)g * M + orow) * 2 + hh] = m + log2f(l);
        }
    }
    VM_WAIT();
    __syncthreads();
    bf16_t* OC = WSP(bf16_t, WS_OCAT);
    for (int it = 0; it < 8; ++it) {
        const int item = tid + 512 * it, tl = item >> 3, pc = item & 7; const size_t orow = rowbase + T0 + tl;
        const float l0 = DLSE[((size_t)0 * M + orow) * 2 + hh], l1 = DLSE[((size_t)1 * M + orow) * 2 + hh], l2 = DLSE[((size_t)2 * M + orow) * 2 + hh];
        const float mx = fmaxf(l0, fmaxf(l1, l2)); float w0 = fast_exp2(l0 - mx), w1 = fast_exp2(l1 - mx), w2 = fast_exp2(l2 - mx);
        const float inv = 1.0f / (w0 + w1 + w2); w0 *= inv; w1 *= inv; w2 *= inv;
        const u32x4 a = *(const u32x4*)(DOG + ((size_t)0 * M + orow) * 128 + hh * 64 + pc * 8), bb = *(const u32x4*)(DOG + ((size_t)1 * M + orow) * 128 + hh * 64 + pc * 8),
                    cc = *(const u32x4*)(DOG + ((size_t)2 * M + orow) * 128 + hh * 64 + pc * 8);
        u32x4 w;
#pragma unroll
        for (int e = 0; e < 4; ++e) {
            const float lo = w0 * __uint_as_float(a[e] << 16) + w1 * __uint_as_float(bb[e] << 16) + w2 * __uint_as_float(cc[e] << 16);
            const float hv = w0 * __uint_as_float(a[e] & 0xffff0000u) + w1 * __uint_as_float(bb[e] & 0xffff0000u) + w2 * __uint_as_float(cc[e] & 0xffff0000u);
            w[e] = cvtpk(lo, hv); }
        *(u32x4*)(OC + orow * OCW + 256 + hh * 64 + pc * 8) = w;
    }
    __syncthreads();
}
__device__ __forceinline__ float wave_sum(float v) {
    v += xor_lane_lt32<1>(v); v += xor_lane_lt32<2>(v); v += xor_lane_lt32<4>(v); v += xor_lane_lt32<8>(v); v += xor_lane_lt32<16>(v);
    return sum_halves(v);
}
__device__ __forceinline__ int rel_bucket(int dist) {
    if (dist < 0) dist = 0;
    if (dist < 16) return dist;
    const int thr[15] = {22, 30, 40, 54, 73, 99, 134, 182, 246, 332, 450, 609, 825, 1117, 1513};
    int bkt = 16;
#pragma unroll
    for (int i = 0; i < 15; ++i) bkt += (dist >= thr[i]) ? 1 : 0;
    return bkt;
}
__device__ __forceinline__ int inproj_src(int c, float& sc) {
    sc = 1.f;
    if (c < 256) { sc = C2A; return c; }
    if (c < 652) return c;
    if (c < 656) return 2572 + (c - 652);
    if (c < 672) return -1;
    if (c < 704) { const int p = c - 672; return 2960 + (p >> 1) + 16 * (p & 1); }
    if (c < 768) return -1;
    if (c < 1920) { const int r = c - 768; if (r < 384) sc = C2A; return 652 + r; }
    if (c < 2048) return 2832 + (c - 1920);
    if (c < 2816) { const int r = c - 2048; if (r < 256) sc = C2A; return 1804 + r; }
    return 2576 + (c - 2816);
}
__device__ __forceinline__ int quq_src(int r, float& sc) {
    sc = C2D;
    if (r >= 384) return -1;
    const int hd = r / 96, w = r % 96;
    if (w < 64) return hd * 96 + w;
    const int p = w - 64; return hd * 96 + 64 + (p >> 1) + 16 * (p & 1);
}
__device__ __forceinline__ int gateperm_src(int r) {
    const int T = r >> 8, c = r & 255, pn = T >> 2, j = T & 3, bj = c >> 7, wc = (c >> 5) & 3, fq = (c >> 3) & 3, n = (c >> 2) & 1, e = c & 3;
    return (2 * bj + n) * DM * DM + 256 * pn + 64 * j + 16 * wc + 4 * fq + e;
}
__device__ __forceinline__ int branchperm_src(int r) {
    const int pn = r >> 8, c = r & 255, bj = c >> 7, wc = (c >> 5) & 3, fq = (c >> 3) & 3, n = (c >> 2) & 1, e = c & 3;
    return 256 * pn + 64 * (2 * bj + n) + 16 * wc + 4 * fq + e;
}
__device__ __forceinline__ int upperm_src(int r) { const int pn = r >> 8, c = r & 255; return (c & 128) ? DFF + 128 * pn + (c & 127) : 128 * pn + c; }
__device__ __forceinline__ void wconv_item(const float* W, int Nsrc, bf16_t* WT, int ldt, const float* kgain, int kind, LAS float* scr, int item, int nblk, int lane) {
    const int kb = item / nblk, nb = item % nblk, k0 = 64 * kb, n0 = 32 * nb;
    const int n = n0 + (lane & 31); float sc = 1.f; int src = n;
    if (kind == 1) src = inproj_src(n, sc); else if (kind == 2) src = quq_src(n, sc); else if (kind == 3) src = gateperm_src(n); else if (kind == 4) src = branchperm_src(n); else if (kind == 5) src = upperm_src(n);
#pragma unroll 8
    for (int i = 0; i < 32; ++i) { const int kk = 2 * i + (lane >> 5); float v = (src >= 0) ? W[(size_t)(k0 + kk) * Nsrc + src] * sc : 0.f; if (kgain) v *= kgain[k0 + kk]; scr[kk * 33 + (lane & 31)] = v; }
    LDS_WAIT(); asm volatile("" ::: "memory");
    const int c = lane & 7;
#pragma unroll
    for (int j = 0; j < 4; ++j) { const int nn = (lane >> 3) + 8 * j; const LAS float* s = scr + (8 * c) * 33 + nn;
        u32x4 o; o.x = pk2(s[0 * 33], s[1 * 33]); o.y = pk2(s[2 * 33], s[3 * 33]); o.z = pk2(s[4 * 33], s[5 * 33]); o.w = pk2(s[6 * 33], s[7 * 33]);
        *(u32x4*)(WT + (size_t)(n0 + nn) * ldt + k0 + 8 * c) = o; }
    LDS_WAIT(); asm volatile("" ::: "memory");
}
__device__ __forceinline__ void p0_prologue(Frame& F) {
    LAS float* scr = (LAS float*)(F.lds + F.wave * 16384);
    const int gw = blockIdx.x * 8 + F.wave, NGW = F.G * 8, lane = F.lane;
    constexpr int I_IN = 16 * 96, I_G = 16 * 32, I_BA = 4 * 32, I_BB = 2 * 32, I_O = 16 * 32, I_UP = 16 * 176, I_DN = 44 * 32, I_UQ = 4 * 16, I_UKV = 2 * 16, I_PHI = 32 * 4;
    constexpr int I_L = I_IN + 4 * I_G + 3 * I_BA + I_BB + I_O + I_UP + I_DN + I_UQ + I_UKV + 2 * I_PHI;
    for (int it = gw; it < DEPTH * I_L; it += NGW) {
        const int l = it / I_L; int r = it % I_L;
        unsigned char* wl = F.ws + WS_WT + (size_t)l * LW;
        if (r < I_IN) { wconv_item(F.in[6] + (size_t)l * DM * DIN, DIN, (bf16_t*)(wl + LW_IN), DM, nullptr, 1, scr, r, 96, lane); continue; } r -= I_IN;
        if (r < 4 * I_G) { wconv_item(F.in[21] + (size_t)l * 4 * DM * DM, DM, (bf16_t*)(wl + LW_G), DM, nullptr, 3, scr, r, 128, lane); continue; } r -= 4 * I_G;
        if (r < I_BA) { wconv_item(F.in[17] + (size_t)l * 256 * DM, DM, (bf16_t*)(wl + LW_BR + BR_A), 256, nullptr, 4, scr, r, 32, lane); continue; } r -= I_BA;
        if (r < I_BB) { wconv_item(F.in[18] + (size_t)l * 128 * DM, DM, (bf16_t*)(wl + LW_BR + BR_B), 128, nullptr, 4, scr, r, 32, lane); continue; } r -= I_BB;
        if (r < I_BA) { wconv_item(F.in[19] + (size_t)l * 256 * DM, DM, (bf16_t*)(wl + LW_BR + BR_C), 256, nullptr, 4, scr, r, 32, lane); continue; } r -= I_BA;
        if (r < I_BA) { wconv_item(F.in[20] + (size_t)l * 256 * DM, DM, (bf16_t*)(wl + LW_BR + BR_D), 256, nullptr, 4, scr, r, 32, lane); continue; } r -= I_BA;
        if (r < I_O) { wconv_item(F.in[22] + (size_t)l * DM * DM, DM, (bf16_t*)(wl + LW_O), DM, nullptr, 0, scr, r, 32, lane); continue; } r -= I_O;
        if (r < I_UP) { wconv_item(F.in[23] + (size_t)l * DM * DFF2, DFF2, (bf16_t*)(wl + LW_UP), DM, nullptr, 5, scr, r, 176, lane); continue; } r -= I_UP;
        if (r < I_DN) { wconv_item(F.in[26] + (size_t)l * DFF * DM, DM, (bf16_t*)(wl + LW_DN), DFF, nullptr, 0, scr, r, 32, lane); continue; } r -= I_DN;
        if (r < I_UQ) { wconv_item(F.in[15] + (size_t)l * 256 * 384, 384, (bf16_t*)(wl + LW_UQ), 256, F.in[13] + l * 256, 2, scr, r, 16, lane); continue; } r -= I_UQ;
        if (r < I_UKV) { wconv_item(F.in[16] + (size_t)l * 128 * 512, 512, (bf16_t*)(wl + LW_UKV), 128, F.in[14] + l * 128, 0, scr, r, 16, lane); continue; } r -= I_UKV;
        if (r < I_PHI) { wconv_item(F.in[8] + (size_t)l * 2048 * 128, 128, (bf16_t*)(wl + LW_PHI), 2048, nullptr, 0, scr, r, 4, lane); continue; } r -= I_PHI;
        wconv_item(F.in[10] + (size_t)l * 2048 * 128, 128, (bf16_t*)(wl + LW_PHI) + (size_t)128 * 2048, 2048, nullptr, 0, scr, r, 4, lane);
    }
    const int gt = blockIdx.x * 512 + F.tid, NGT = F.G * 512;
    const float* rel = F.in[1];
    float* rope = WSP(float, WS_ROPE);
    for (int i = gt; i < SEQ * 16; i += NGT) { const int t = i >> 4, k = i & 15; const float inv = powf(10000.0f, -(float)(2 * k) / 32.0f); const float ang = (float)t * inv;
        float sn, cs; sincosf(ang, &sn, &cs); rope[2 * i] = cs; rope[2 * i + 1] = sn; }
    float* ntab = WSP(float, WS_NSATAB);
    for (int i = gt; i < 4 * NSA_TL; i += NGT) { const int hd = i / NSA_TL, k = i % NSA_TL, dist = NSA_DMAX - k; ntab[i] = dist >= 0 ? rel[rel_bucket(dist) * 10 + hd] * LOG2E : 0.f; }
    float* dtab = WSP(float, WS_DILTAB);
    for (int i = gt; i < 6 * 192; i += NGT) { const int gh = i / 192, k = i % 192, g = gh >> 1, hh = gh & 1, j = 160 - k; dtab[i] = (j >= 0 && j <= 128) ? rel[rel_bucket(j << (2 * g)) * 10 + 4 + 2 * g + hh] * LOG2E : 0.f; }
    if (gt < 4) WSP(float, WS_FARB)[gt] = rel[31 * 10 + gt] * LOG2E;
    for (int i = gt; i < DEPTH * 256; i += NGT) { const int l = i >> 8, n = i & 255; const float* w1 = (n < 128 ? F.in[8] : F.in[10]) + (size_t)l * 2048 * 128 + (n & 127); const float* cp = F.in[7] + (size_t)l * 2048;
        float a = 0.f; for (int p = 0; p < 2048; ++p) a += cp[p] * w1[(size_t)p * 128]; WSP(float, WS_CMPB)[i] = a; }
}

template <int MODE> __device__ __forceinline__ void rowpass(Frame& F, const float* x, const bf16_t* y, size_t yrow0, float* xout, bf16_t* hout, const float* g1, const float* g2, int row_lo, int row_hi) {
    int gw = blockIdx.x * 8 + F.wave; asm volatile("" : "+s"(gw));
    const int NGW = F.G * 8, lane = F.lane;
    f32x4 ga[4], gb[4];
#pragma unroll
    for (int j = 0; j < 4; ++j) { ga[j] = *(const f32x4*)(g1 + 4 * lane + 256 * j); if (MODE == 1) gb[j] = *(const f32x4*)(g2 + 4 * lane + 256 * j); }
    for (int m = row_lo + gw; m < row_hi; m += NGW) {
        f32x4 v[4];
        const f32x4* xr = (const f32x4*)(x + (size_t)m * DM) + lane;
#pragma unroll
        for (int j = 0; j < 4; ++j) v[j] = xr[64 * j];
        if (MODE != 0) {
            const u32x2* yr = (const u32x2*)(y + ((size_t)m - yrow0) * DM) + lane; f32x4 w[4]; float s = 0.f;
#pragma unroll
            for (int j = 0; j < 4; ++j) { const u32x2 yy = yr[64 * j]; w[j][0] = __uint_as_float(yy.x << 16); w[j][1] = __uint_as_float(yy.x & 0xffff0000u); w[j][2] = __uint_as_float(yy.y << 16); w[j][3] = __uint_as_float(yy.y & 0xffff0000u);
                s += (w[j][0] * w[j][0] + w[j][1] * w[j][1]) + (w[j][2] * w[j][2] + w[j][3] * w[j][3]); }
            const float rstd = 1.0f / sqrtf(wave_sum(s) * (1.0f / DM) + RMS_EPS);
            f32x4* xo = (f32x4*)(xout + (size_t)m * DM) + lane;
#pragma unroll
            for (int j = 0; j < 4; ++j) { v[j] = v[j] + w[j] * rstd * ga[j]; xo[64 * j] = v[j]; }
        }
        if (MODE != 2) {
            float s = 0.f;
#pragma unroll
            for (int j = 0; j < 4; ++j) s += (v[j][0] * v[j][0] + v[j][1] * v[j][1]) + (v[j][2] * v[j][2] + v[j][3] * v[j][3]);
            const float rstd = 1.0f / sqrtf(wave_sum(s) * (1.0f / DM) + RMS_EPS);
            u32x2* ho = (u32x2*)(hout + (size_t)m * DM) + lane;
#pragma unroll
            for (int j = 0; j < 4; ++j) { const f32x4 gg = (MODE == 1) ? gb[j] : ga[j]; const f32x4 o = v[j] * rstd * gg; u32x2 w; w.x = cvtpk(o[0], o[1]); w.y = cvtpk(o[2], o[3]); ho[64 * j] = w; }
        }
    }
}

__device__ __forceinline__ void ffn_fix_panel(Frame& F, int pm, const float* HB, bf16_t* ACT, const float* cw, const float* cb) {
    for (int it = F.tid; it < 4 * 2 * (DFF / 4); it += 512) {
        const int c4 = it % (DFF / 4), rr = (it / (DFF / 4)) & 1, g = pm * 4 + it / (2 * (DFF / 4)), c = c4 * 4, pn = c >> 7, cl = c & 127;
        const bool first = ((g * 64) & (SEQ - 1)) == 0;
#define HBV(gg, s, bj) (*(const f32x4*)(HB + ((size_t)(((gg) * 4 + (s)) * 22 + pn) * 256 + (bj) * 128 + cl)))
        const f32x4 z = {0.f, 0.f, 0.f, 0.f};
        const f32x4 u0g = HBV(g, 0, 0), u0v = HBV(g, 0, 1);
        f32x4 ag, bg_, cg, av, bv_, cv;
        if (rr == 0) { ag = first ? z : HBV(g - 1, 2, 0); bg_ = first ? z : HBV(g - 1, 3, 0); cg = u0g; av = first ? z : HBV(g - 1, 2, 1); bv_ = first ? z : HBV(g - 1, 3, 1); cv = u0v; }
        else { ag = first ? z : HBV(g - 1, 3, 0); bg_ = u0g; cg = HBV(g, 1, 0); av = first ? z : HBV(g - 1, 3, 1); bv_ = u0v; cv = HBV(g, 1, 1); }
#undef HBV
        const f32x4 kb = *(const f32x4*)(cb + c), k0 = *(const f32x4*)(cw + c), k1 = *(const f32x4*)(cw + DFF2 + c), k2 = *(const f32x4*)(cw + 2 * DFF2 + c);
        const f32x4 vb = *(const f32x4*)(cb + DFF + c), v0 = *(const f32x4*)(cw + DFF + c), v1 = *(const f32x4*)(cw + DFF2 + DFF + c), v2 = *(const f32x4*)(cw + 2 * DFF2 + DFF + c);
        float o[4];
#pragma unroll
        for (int e = 0; e < 4; ++e) { const float gt = kb[e] + k0[e] * ag[e] + k1[e] * bg_[e] + k2[e] * cg[e], vl = vb[e] + v0[e] * av[e] + v1[e] * bv_[e] + v2[e] * cv[e]; o[e] = gt * sigmoid_f(gt) * vl; }
        u32x2 w; w.x = cvtpk(o[0], o[1]); w.y = cvtpk(o[2], o[3]);
        *(u32x2*)(ACT + (size_t)(g * 64 + rr) * DFF + c) = w;
    }
}
#ifdef SELFCHECK
constexpr int CW_CHK = 20480;
__device__ __forceinline__ unsigned chk_hash(unsigned x) { x ^= x >> 16; x *= 0x7feb352du; x ^= x >> 15; x *= 0x846ca68bu; x ^= x >> 16; return x; }
__device__ __forceinline__ int chk_t(int i) {
    int r = 0;
    switch (i & 31) { case 0: r = 0; break; case 1: r = 1; break; case 2: r = 15; break; case 3: r = 16; break; case 4: r = 30; break; case 5: r = 31; break; case 6: r = 32; break; case 7: r = 47; break;
        case 8: r = 63; break; case 9: r = 64; break; case 10: r = 65; break; case 11: r = 127; break; case 12: r = 128; break; case 13: r = 129; break; case 14: r = 255; break; case 15: r = 256; break;
        case 16: r = 257; break; case 17: r = 511; break; case 18: r = 512; break; case 19: r = 513; break; case 20: r = 575; break; case 21: r = 1023; break; case 22: r = 1024; break; case 23: r = 1599; break;
        case 24: r = 1600; break; case 25: r = 2047; break; case 26: r = 2048; break; case 27: r = 2111; break; case 28: r = 3000; break; case 29: r = 4031; break; case 30: r = 4032; break; default: r = 4095; break; }
    return (i < 64) ? r : (int)(chk_hash(i * 7919u + 13u) & 4095u);
}
__device__ __forceinline__ bool chk_bad(float got, float ref, float scale) { const float d = fabsf(got - ref); return !(d <= 0.02f * fabsf(ref) + 0.02f * scale); }
__device__ __forceinline__ float bfr(float x) { return bf2f((unsigned short)f2bf(x)); }
__device__ __forceinline__ void chk_flag(Frame& F, int bit, bool bad, int allow) {
    LAS unsigned* cnt = (LAS unsigned*)(F.lds + 65536);
    __syncthreads(); if (threadIdx.x == 0) *cnt = 0u; __syncthreads();
    if (bad) atomicAdd((unsigned*)cnt, 1u);
    __syncthreads();
    if (threadIdx.x == 0 && *cnt > (unsigned)allow) atomicOr((unsigned*)(F.ctl + CW_CHK), 1u << bit);
    __syncthreads();
}
__device__ __forceinline__ int chk_bucket_ref(int dist) {
    if (dist < 0) dist = 0; if (dist < 16) return dist;
    const float d = (float)dist; int large = 16 + (int)(logf(d / 16.0f) / 4.852030263919617f * 16.0f); return large < 31 ? large : 31;
}
__device__ __forceinline__ bool chk_fox(Frame& F, int b, int h, int t) {
    const bf16_t* P = WSP(const bf16_t, WS_P);
    { const size_t row = (size_t)b * SEQ + t; const bf16_t* q = P + row * PW + PC_CQ + h * 64; const float* kb = WSP(const float, WS_KB) + ((size_t)b * 4 + h) * SEQ;
      float m = -INFINITY; for (int j = 0; j <= t; ++j) { const bf16_t* k = P + ((size_t)b * SEQ + j) * PW + PC_CK + h * 64; float s = 0.f; for (int d = 0; d < 64; ++d) s += bf2f(q[d]) * bf2f(k[d]); s += kb[j]; m = fmaxf(m, s); }
      float lsum = 0.f, dummy0_ = 0.f; f32x4 o = {0.f, 0.f, 0.f, 0.f};
      for (int j = 0; j <= t; ++j) { const bf16_t* k = P + ((size_t)b * SEQ + j) * PW + PC_CK + h * 64; const bf16_t* v = P + ((size_t)b * SEQ + j) * PW + PC_CV + h * 64; float s = 0.f; for (int d = 0; d < 64; ++d) s += bf2f(q[d]) * bf2f(k[d]); s += kb[j];
          const float p = exp2f(s - m); lsum += p; _Pragma("unroll") for (int e = 0; e < 4; ++e) o[e] += p * bf2f(v[21 * e]); }
      bool bad = false; _Pragma("unroll") for (int e = 0; e < 4; ++e) bad |= chk_bad(bf2f(WSP(const bf16_t, WS_OCAT)[row * OCW + 384 + h * 64 + 21 * e]), o[e] / lsum, 0.5f);
      return bad; }
}
__device__ __forceinline__ bool chk_dil(Frame& F, int b, int hh, int t) {
    const bf16_t* P = WSP(const bf16_t, WS_P); const float* rel = F.in[1];
    { const size_t row = (size_t)b * SEQ + t;
      float m = -INFINITY;
      for (int g = 0; g < 3; ++g) { const int dil = 1 << (2 * g), head = 2 * g + hh; const bf16_t* q = P + row * PW + PC_BQ + head * 64;
          for (int j = 0; j <= 128; ++j) { const int idx = t - dil * j; if (idx < 0) break; const bf16_t* k = P + ((size_t)b * SEQ + idx) * PW + PC_BK + head * 64; float s = 0.f; for (int d = 0; d < 64; ++d) s += bf2f(q[d]) * bf2f(k[d]);
              s += rel[chk_bucket_ref(dil * j) * 10 + 4 + head] * LOG2E; m = fmaxf(m, s); } }
      float lsum = 0.f, dummy0_ = 0.f; f32x4 o = {0.f, 0.f, 0.f, 0.f};
      for (int g = 0; g < 3; ++g) { const int dil = 1 << (2 * g), head = 2 * g + hh; const bf16_t* q = P + row * PW + PC_BQ + head * 64;
          for (int j = 0; j <= 128; ++j) { const int idx = t - dil * j; if (idx < 0) break; const bf16_t* k = P + ((size_t)b * SEQ + idx) * PW + PC_BK + head * 64; const bf16_t* v = P + ((size_t)b * SEQ + idx) * PW + PC_BV + head * 64; float s = 0.f; for (int d = 0; d < 64; ++d) s += bf2f(q[d]) * bf2f(k[d]);
              s += rel[chk_bucket_ref(dil * j) * 10 + 4 + head] * LOG2E; const float p = exp2f(s - m); lsum += p; _Pragma("unroll") for (int e = 0; e < 4; ++e) o[e] += p * bf2f(v[21 * e]); } }
      bool bad = false; _Pragma("unroll") for (int e = 0; e < 4; ++e) bad |= chk_bad(bf2f(WSP(const bf16_t, WS_OCAT)[row * OCW + 256 + hh * 64 + 21 * e]), o[e] / lsum, 0.5f);
      return bad; }
}
__device__ __forceinline__ bool chk_nsa(Frame& F, int b, int h, int t, int i) {
    const bf16_t* P = WSP(const bf16_t, WS_P); const float* rel = F.in[1];
    { bool bad = false;
      { const size_t row = (size_t)b * SEQ + t; const size_t rb = (size_t)b * SEQ;
      const bf16_t* KC = WSP(const bf16_t, WS_KC) + (size_t)b * 256 * 64; const bf16_t* VC = WSP(const bf16_t, WS_VC) + (size_t)b * 256 * 64;
      const int cmax = (t >= 31) ? (t - 31) / 16 : -1, cur = t >> 6;
      LAS float* imp = (LAS float*)(F.lds + 70000) + i * 65; for (int j = 0; j < 64; ++j) imp[j] = 0.f;
      f32x4 oc = {0.f, 0.f, 0.f, 0.f};
      for (int hh = 0; hh < 4; ++hh) { const bf16_t* q = P + row * PW + PC_AQ + hh * 64; float m = -INFINITY;
          for (int c = 0; c <= cmax; ++c) { float s = 0.f; for (int d = 0; d < 64; ++d) s += bf2f(q[d]) * bf2f(KC[c * 64 + d]); m = fmaxf(m, s); }
          float ls = 0.f; for (int c = 0; c <= cmax; ++c) { float s = 0.f; for (int d = 0; d < 64; ++d) s += bf2f(q[d]) * bf2f(KC[c * 64 + d]); ls += exp2f(s - m); }
          for (int c = 0; c <= cmax; ++c) { float s = 0.f; for (int d = 0; d < 64; ++d) s += bf2f(q[d]) * bf2f(KC[c * 64 + d]); const float p = exp2f(s - m) / ls;
              for (int j = 0; j < 64; ++j) if (16 * c <= 64 * j + 63 && 16 * c + 31 >= 64 * j) imp[j] += p;
              if (hh == h) _Pragma("unroll") for (int e = 0; e < 4; ++e) oc[e] += p * bf2f(VC[c * 64 + 21 * e]); } }
      for (int j = 0; j < 64; ++j) imp[j] = (j == 0 || j == cur || j == cur - 1) ? 1e9f : (j > cur ? -1e9f : imp[j]);
      unsigned long long selm = 0ull;
      for (int j = 0; j < 64; ++j) { int rank = 0; for (int k = 0; k < 64; ++k) rank += (imp[k] > imp[j] || (imp[k] == imp[j] && k < j)) ? 1 : 0; if (rank < 16) selm |= 1ull << j; }
      const bf16_t* q = P + row * PW + PC_AQ + h * 64;
      f32x4 os = {0.f, 0.f, 0.f, 0.f}, ow = {0.f, 0.f, 0.f, 0.f};
      { float m = -INFINITY; for (int pos = 0; pos <= t; ++pos) { if (!((selm >> (pos >> 6)) & 1ull)) continue; const bf16_t* k = P + (rb + pos) * PW + PC_KSLC; float s = 0.f; for (int d = 0; d < 64; ++d) s += bf2f(q[d]) * bf2f(k[d]); s += rel[chk_bucket_ref(t - pos) * 10 + h] * LOG2E; m = fmaxf(m, s); }
        float ls = 0.f; for (int pos = 0; pos <= t; ++pos) { if (!((selm >> (pos >> 6)) & 1ull)) continue; const bf16_t* k = P + (rb + pos) * PW + PC_KSLC; const bf16_t* v = P + (rb + pos) * PW + PC_VSLC; float s = 0.f; for (int d = 0; d < 64; ++d) s += bf2f(q[d]) * bf2f(k[d]); s += rel[chk_bucket_ref(t - pos) * 10 + h] * LOG2E;
            const float p = exp2f(s - m); ls += p; _Pragma("unroll") for (int e = 0; e < 4; ++e) os[e] += p * bf2f(v[21 * e]); }
        _Pragma("unroll") for (int e = 0; e < 4; ++e) os[e] /= ls; }
      { const int lo = t - 511 > 0 ? t - 511 : 0; float m = -INFINITY; for (int pos = lo; pos <= t; ++pos) { const bf16_t* k = P + (rb + pos) * PW + PC_KWIN; float s = 0.f; for (int d = 0; d < 64; ++d) s += bf2f(q[d]) * bf2f(k[d]); s += rel[chk_bucket_ref(t - pos) * 10 + h] * LOG2E; m = fmaxf(m, s); }
        float ls = 0.f; for (int pos = lo; pos <= t; ++pos) { const bf16_t* k = P + (rb + pos) * PW + PC_KWIN; const bf16_t* v = P + (rb + pos) * PW + PC_VWIN; float s = 0.f; for (int d = 0; d < 64; ++d) s += bf2f(q[d]) * bf2f(k[d]); s += rel[chk_bucket_ref(t - pos) * 10 + h] * LOG2E;
            const float p = exp2f(s - m); ls += p; _Pragma("unroll") for (int e = 0; e < 4; ++e) ow[e] += p * bf2f(v[21 * e]); }
        _Pragma("unroll") for (int e = 0; e < 4; ++e) ow[e] /= ls; }
      const float* sd = WSP(const float, WS_SIDE) + row * 16 + h * 3; const float g0 = 1.f / (1.f + expf(-sd[0])), g1 = 1.f / (1.f + expf(-sd[1])), g2 = 1.f / (1.f + expf(-sd[2]));
      _Pragma("unroll") for (int e = 0; e < 4; ++e) bad |= chk_bad(bf2f(WSP(const bf16_t, WS_OCAT)[row * OCW + h * 64 + 21 * e]), g0 * oc[e] + g1 * os[e] + g2 * ow[e], 0.3f); }
      return bad; }
}
__device__ __forceinline__ void selfcheck_a(Frame& F, int l) {
    const int i = threadIdx.x;
    const float* x = F.in[0];
    const bf16_t* H = WSP(const bf16_t, WS_H); const bf16_t* P = WSP(const bf16_t, WS_P);
    const float* rel = F.in[1];
    { const int row = (int)(chk_hash(i) % M), col = (int)(chk_hash(i + 999) & 1023); float s = 0.f; for (int k = 0; k < DM; ++k) { const float v = x[(size_t)row * DM + k]; s += v * v; }
      const float ref = x[(size_t)row * DM + col] * (1.0f / sqrtf(s / DM + RMS_EPS)) * F.in[2][l * DM + col];
      chk_flag(F, 0, chk_bad(bf2f(H[(size_t)row * DM + col]), ref, 1.0f), 0); }
    { const int row = (int)(chk_hash(i + 5) % M); int c = (i * 37 + 5) % PW; if (i < 32) c = 640 + (i & 15); else if (i < 96) c = 672 + (i & 31); else if (i < 160) c = 256 + ((i * 3) & 127);
      const float* W = F.in[6] + (size_t)l * DM * DIN; bool bad = false;
#define DOTC(dst, cc) do { float sc_; const int src_ = inproj_src((cc), sc_); float a_ = 0.f; if (src_ >= 0) for (int k = 0; k < DM; ++k) a_ += bf2f(H[(size_t)row * DM + k]) * bfr(W[(size_t)k * DIN + src_] * sc_); dst = a_; } while (0)
      float ref; DOTC(ref, c);
      if (c >= 672 && c < 704) { const int p = c - 672, ip = p >> 1; float oth; DOTC(oth, c ^ 1); const float x1 = (p & 1) ? oth : ref, x2 = (p & 1) ? ref : oth;
          const float inv = powf(10000.0f, -(float)(2 * ip) / 32.0f), ang = (float)(row & (SEQ - 1)) * inv, cs = cosf(ang), sn = sinf(ang);
          ref = (p & 1) ? (x2 * cs + x1 * sn) : (x1 * cs - x2 * sn);
          bad |= chk_bad(bf2f(WSP(const bf16_t, WS_KROT)[(size_t)row * 32 + p]), ref, 1.0f); }
      bad |= chk_bad(bf2f(P[(size_t)row * PW + c]), ref, 1.0f);
      if (c >= 640 && c < 656) bad |= chk_bad(WSP(const float, WS_SIDE)[(size_t)row * 16 + (c - 640)], ref, 1.0f);
      if (c >= 256 && c < 320) bad |= chk_bad(bf2f(WSP(const bf16_t, WS_KCMP)[(size_t)row * 64 + (c - 256)]), ref, 1.0f);
      if (c >= 320 && c < 384) bad |= chk_bad(bf2f(WSP(const bf16_t, WS_VCMP)[(size_t)row * 64 + (c - 320)]), ref, 1.0f);
      if (i >= 160 && i < 192) { float sq = 0.f, skv = 0.f; for (int k = 0; k < 256; ++k) { const float v = bf2f(P[(size_t)row * PW + PC_DQL + k]); sq += v * v; } for (int k = 0; k < 128; ++k) { const float v = bf2f(P[(size_t)row * PW + PC_DKV + k]); skv += v * v; }
          const float* a = WSP(const float, WS_SSQQ) + (size_t)row * 4; const float* b = WSP(const float, WS_SSQKV) + (size_t)row * 4;
          bad |= chk_bad(a[0] + a[1] + a[2] + a[3], sq, 10.f) || chk_bad(b[0] + b[1] + b[2] + b[3], skv, 5.f); }
      chk_flag(F, 1, bad, 0); }
    { const int b = i & 15, h = (i >> 4) & 3, t = chk_t(i >> 6); float a = 0.f; for (int j = 0; j <= t; ++j) { const float xx = WSP(const float, WS_SIDE)[((size_t)b * SEQ + j) * 16 + 12 + h] + F.in[12][l * 4 + h]; a += (xx >= 0.f) ? -log1pf(expf(-xx)) : (xx - log1pf(expf(xx))); }
      chk_flag(F, 2, chk_bad(WSP(const float, WS_KB)[((size_t)b * 4 + h) * SEQ + t], -a * LOG2E, 1.0f + fabsf(a) * 0.05f), 0); }
    chk_flag(F, 3, chk_fox(F, (i * 5) & 15, i & 3, chk_t(i >> 2)), 0);
    { const int row = (int)(chk_hash(i + 77) % M); bool bad = false;
      float sq = 0.f, skv = 0.f; for (int k = 0; k < 256; ++k) { const float v = bf2f(P[(size_t)row * PW + PC_DQL + k]); sq += v * v; } for (int k = 0; k < 128; ++k) { const float v = bf2f(P[(size_t)row * PW + PC_DKV + k]); skv += v * v; }
      const float rq = 1.0f / sqrtf(sq / 256.0f + RMS_EPS), rkv = 1.0f / sqrtf(skv / 128.0f + RMS_EPS);
      const float* wq = F.in[15] + (size_t)l * 256 * 384; const float* gq = F.in[13] + l * 256; const float* wkv = F.in[16] + (size_t)l * 128 * 512; const float* gkv = F.in[14] + l * 128;
#define QDOT(dst, src) do { float a_ = 0.f; for (int k = 0; k < 256; ++k) a_ += bf2f(P[(size_t)row * PW + PC_DQL + k]) * bfr(wq[(size_t)k * 384 + (src)] * C2D * gq[k]); dst = a_ * rq; } while (0)
      const int r = (i * 11) % 384, hd = r / 96, w = r % 96; float ref;
      if (w < 64) QDOT(ref, hd * 96 + w);
      else { const int p = w - 64, ip = p >> 1; float x1, x2; QDOT(x1, hd * 96 + 64 + ip); QDOT(x2, hd * 96 + 64 + 16 + ip); const float inv = powf(10000.0f, -(float)(2 * ip) / 32.0f), ang = (float)(row & (SEQ - 1)) * inv, cs = cosf(ang), sn = sinf(ang);
          ref = (p & 1) ? (x2 * cs + x1 * sn) : (x1 * cs - x2 * sn); }
      bad |= chk_bad(bf2f(WSP(const bf16_t, WS_QM)[(size_t)row * 512 + r]), ref, 1.5f);
      { const int c = (i * 13) & 511; float a = 0.f; for (int k = 0; k < 128; ++k) a += bf2f(P[(size_t)row * PW + PC_DKV + k]) * bfr(wkv[(size_t)k * 512 + c] * gkv[k]); bad |= chk_bad(bf2f(WSP(const bf16_t, WS_KVM)[(size_t)row * 512 + c]), a * rkv, 1.0f); }
      chk_flag(F, 4, bad, 0); }
    { const int b = (i * 3) & 15, h = i & 3, t = chk_t(i >> 2); const size_t row = (size_t)b * SEQ + t; const bf16_t* q = WSP(const bf16_t, WS_QM) + row * 512 + h * 96; const bf16_t* KV = WSP(const bf16_t, WS_KVM); const bf16_t* KR = WSP(const bf16_t, WS_KROT);
      float m = -INFINITY; for (int j = 0; j <= t; ++j) { const size_t rj = (size_t)b * SEQ + j; float s = 0.f; for (int d = 0; d < 64; ++d) s += bf2f(q[d]) * bf2f(KV[rj * 512 + h * 128 + d]); for (int d = 0; d < 32; ++d) s += bf2f(q[64 + d]) * bf2f(KR[rj * 32 + d]); m = fmaxf(m, s); }
      float lsum = 0.f, dummy0_ = 0.f; f32x4 o = {0.f, 0.f, 0.f, 0.f};
      for (int j = 0; j <= t; ++j) { const size_t rj = (size_t)b * SEQ + j; float s = 0.f; for (int d = 0; d < 64; ++d) s += bf2f(q[d]) * bf2f(KV[rj * 512 + h * 128 + d]); for (int d = 0; d < 32; ++d) s += bf2f(q[64 + d]) * bf2f(KR[rj * 32 + d]);
          const float p = exp2f(s - m); lsum += p; _Pragma("unroll") for (int e = 0; e < 4; ++e) o[e] += p * bf2f(KV[rj * 512 + h * 128 + 64 + 21 * e]); }
      bool bad = false; _Pragma("unroll") for (int e = 0; e < 4; ++e) bad |= chk_bad(bf2f(WSP(const bf16_t, WS_OCAT)[row * OCW + 640 + h * 64 + 21 * e]), o[e] / lsum, 0.5f);
      chk_flag(F, 5, bad, 0); }
    chk_flag(F, 6, chk_dil(F, (i * 7) & 15, i & 1, chk_t(i >> 1)), 0);
    { const int b = i & 15, which = (i >> 4) & 1, c = (int)(chk_hash(i + 31) % 255), d = (i * 5) & 63; const bf16_t* src = (which ? WSP(const bf16_t, WS_VCMP) : WSP(const bf16_t, WS_KCMP)) + ((size_t)b * SEQ + 16 * c) * 64;
      const float *pk1 = F.in[8], *pv1 = F.in[10], *pk2 = F.in[9], *pv2 = F.in[11]; asm volatile("" : "+s"(pk1), "+s"(pv1), "+s"(pk2), "+s"(pv2));
      const float* w1 = (which ? pv1 : pk1) + (size_t)l * 2048 * 128; const float* w2 = (which ? pv2 : pk2) + (size_t)l * 128 * 64; const float* cp = F.in[7] + (size_t)l * 2048;
      float out = 0.f;
      for (int n = 0; n < 128; ++n) { float a = 0.f, bsum = 0.f; for (int p = 0; p < 2048; ++p) { a += bf2f(src[p]) * bfr(w1[(size_t)p * 128 + n]); bsum += cp[p] * w1[(size_t)p * 128 + n]; }
          const float xx = a + bsum, g = 0.5f * xx * (1.0f + tanhf(0.7978845608028654f * (xx + 0.044715f * xx * xx * xx))); out += bfr(g) * w2[n * 64 + d]; }
      chk_flag(F, 7, chk_bad(bf2f((which ? WSP(const bf16_t, WS_VC) : WSP(const bf16_t, WS_KC))[((size_t)b * 256 + c) * 64 + d]), out, 0.5f), 0); }
    { bool bad = false; if (i < 128) bad = chk_nsa(F, (i * 9) & 15, i & 3, chk_t(i >> 2), i); chk_flag(F, 8, bad, 4); }
}
__device__ __forceinline__ void selfcheck_b(Frame& F, int l) {
    const int i = threadIdx.x; const int row = (int)(chk_hash(i + 3) % M), n = (i * 29 + 7) & 1023;
    const bf16_t* H = WSP(const bf16_t, WS_H); const bf16_t* OC = WSP(const bf16_t, WS_OCAT);
    float acc = 0.f;
    for (int br = 0; br < 4; ++br) { const float* wg = F.in[21] + ((size_t)l * 4 + br) * DM * DM; float g = 0.f; for (int k = 0; k < DM; ++k) g += bf2f(H[(size_t)row * DM + k]) * bfr(wg[(size_t)k * DM + n]);
        const int kk = (br == 1) ? 128 : 256, co = (br == 0) ? 0 : (br == 1 ? 256 : (br == 2 ? 384 : 640)); const float *pb0 = F.in[17], *pb1 = F.in[18], *pb2 = F.in[19], *pb3 = F.in[20]; asm volatile("" : "+s"(pb0), "+s"(pb1), "+s"(pb2), "+s"(pb3)); const float* wb = (br == 0 ? pb0 : (br == 1 ? pb1 : (br == 2 ? pb2 : pb3))) + (size_t)l * kk * DM; float t = 0.f; for (int k = 0; k < kk; ++k) t += bf2f(OC[(size_t)row * OCW + co + k]) * bfr(wb[(size_t)k * DM + n]);
        acc += (1.f / (1.f + expf(-g))) * bfr(t); }
    chk_flag(F, 9, chk_bad(bf2f(WSP(const bf16_t, WS_MERGED)[(size_t)row * DM + n]), acc, 0.5f), 0);
}
__device__ __forceinline__ void selfcheck_c(Frame& F, int l, const float* xin) {
    const int i = threadIdx.x; const int row = (int)(chk_hash(i + 11) % M), n = (i * 29 + 7) & 1023;
    const bf16_t* MG = WSP(const bf16_t, WS_MERGED); const float* wo = F.in[22] + (size_t)l * DM * DM; const float* Y = WSP(const float, WS_Y);
    float a = 0.f; for (int k = 0; k < DM; ++k) a += bf2f(MG[(size_t)row * DM + k]) * bfr(wo[(size_t)k * DM + n]);
    chk_flag(F, 0, chk_bad(Y[(size_t)row * DM + n], a, 1.0f), 0);
    float s = 0.f; for (int k = 0; k < DM; ++k) { const float v = Y[(size_t)row * DM + k]; s += v * v; }
    const float rstd = 1.0f / sqrtf(s / DM + RMS_EPS); float s2 = 0.f;
    for (int k = 0; k < DM; ++k) { const float v = xin[(size_t)row * DM + k] + Y[(size_t)row * DM + k] * rstd * F.in[3][l * DM + k]; s2 += v * v; }
    const float x1 = xin[(size_t)row * DM + n] + Y[(size_t)row * DM + n] * rstd * F.in[3][l * DM + n];
    const float h2 = x1 * (1.0f / sqrtf(s2 / DM + RMS_EPS)) * F.in[4][l * DM + n];
    chk_flag(F, 1, chk_bad(F.out[(size_t)row * DM + n], x1, 1.0f) || chk_bad(bf2f(WSP(const bf16_t, WS_H2)[(size_t)row * DM + n]), h2, 1.0f), 0);
}
__device__ __forceinline__ void selfcheck_d(Frame& F, int l) {
    const int i = threadIdx.x; const int row = (int)(chk_hash(i + 17) % (M / 2)); const bf16_t* H2 = WSP(const bf16_t, WS_H2); const bf16_t* U = WSP(const bf16_t, WS_U); const bf16_t* A = WSP(const bf16_t, WS_ACT);
    { const int c = (i * 41 + 3) % DFF2; const float* wu = F.in[23] + (size_t)l * DM * DFF2; float a = 0.f; for (int k = 0; k < DM; ++k) a += bf2f(H2[(size_t)row * DM + k]) * bfr(wu[(size_t)k * DFF2 + c]);
      chk_flag(F, 2, chk_bad(bf2f(U[(size_t)row * DFF2 + c]), a, 1.0f), 0); }
    { const int c = (i * 23 + 1) % DFF; const int t = row & (SEQ - 1); const float* cw = F.in[24] + (size_t)l * 3 * DFF2; const float* cb = F.in[25] + (size_t)l * DFF2; float g = cb[c], v = cb[DFF + c];
      for (int j = 0; j < 3; ++j) { const int tt = t - 2 + j; if (tt < 0) continue; g += cw[j * DFF2 + c] * bf2f(U[(size_t)(row - 2 + j) * DFF2 + c]); v += cw[j * DFF2 + DFF + c] * bf2f(U[(size_t)(row - 2 + j) * DFF2 + DFF + c]); }
      chk_flag(F, 3, chk_bad(bf2f(A[(size_t)row * DFF + c]), g / (1.f + expf(-g)) * v, 0.3f), 0); }
    { const int n = (i * 29 + 7) & 1023; const float* wd = F.in[26] + (size_t)l * DFF * DM; float a = 0.f; for (int k = 0; k < DFF; ++k) a += bf2f(A[(size_t)row * DFF + k]) * bfr(wd[(size_t)k * DM + n]);
      chk_flag(F, 4, chk_bad(WSP(const float, WS_Y2)[(size_t)row * DM + n], a, 1.0f), 0); }
}

__device__ __forceinline__ void selfcheck_e(Frame& F, int l) {
    const int i = threadIdx.x; const bf16_t* H = WSP(const bf16_t, WS_H); const bf16_t* P = WSP(const bf16_t, WS_P);
    const float* W = F.in[6] + (size_t)l * DM * DIN; const int row = (int)(chk_hash(i + 5) % M);
#define DOTC(dst, cc) do { float sc_; const int src_ = inproj_src((cc), sc_); float a_ = 0.f; if (src_ >= 0) for (int k = 0; k < DM; ++k) a_ += bf2f(H[(size_t)row * DM + k]) * bfr(W[(size_t)k * DIN + src_] * sc_); dst = a_; } while (0)
    { int c = (i * 37 + 5) % PW; if ((c >= 640 && c < 768)) c = 100; float ref; DOTC(ref, c); chk_flag(F, 0, chk_bad(bf2f(P[(size_t)row * PW + c]), ref, 1.0f), 0); }
    { const int c = 672 + (i & 31), p = c - 672, ip = p >> 1; float ref, oth; DOTC(ref, c); DOTC(oth, c ^ 1); const float x1 = (p & 1) ? oth : ref, x2 = (p & 1) ? ref : oth;
      const float inv = powf(10000.0f, -(float)(2 * ip) / 32.0f), ang = (float)(row & (SEQ - 1)) * inv, cs = cosf(ang), sn = sinf(ang); const float r = (p & 1) ? (x2 * cs + x1 * sn) : (x1 * cs - x2 * sn);
      chk_flag(F, 1, chk_bad(bf2f(WSP(const bf16_t, WS_KROT)[(size_t)row * 32 + p]), r, 1.0f), 0); }
    { const int c = 640 + (i & 15); float ref; DOTC(ref, c); chk_flag(F, 2, chk_bad(WSP(const float, WS_SIDE)[(size_t)row * 16 + (c - 640)], ref, 1.0f), 0); }
    { const int c = 256 + (i & 127); float ref; DOTC(ref, c); const float got = (c < 320) ? bf2f(WSP(const bf16_t, WS_KCMP)[(size_t)row * 64 + (c - 256)]) : bf2f(WSP(const bf16_t, WS_VCMP)[(size_t)row * 64 + (c - 320)]); chk_flag(F, 3, chk_bad(got, ref, 1.0f), 0); }
    float sq = 0.f, skv = 0.f; for (int k = 0; k < 256; ++k) { const float v = bf2f(P[(size_t)row * PW + PC_DQL + k]); sq += v * v; } for (int k = 0; k < 128; ++k) { const float v = bf2f(P[(size_t)row * PW + PC_DKV + k]); skv += v * v; }
    { const float* a = WSP(const float, WS_SSQQ) + (size_t)row * 4; const float* b = WSP(const float, WS_SSQKV) + (size_t)row * 4; chk_flag(F, 4, chk_bad(a[0] + a[1] + a[2] + a[3], sq, 10.f) || chk_bad(b[0] + b[1] + b[2] + b[3], skv, 5.f), 0); }
    const float rq = 1.0f / sqrtf(sq / 256.0f + RMS_EPS), rkv = 1.0f / sqrtf(skv / 128.0f + RMS_EPS);
    const float* wq = F.in[15] + (size_t)l * 256 * 384; const float* gq = F.in[13] + l * 256; const float* wkv = F.in[16] + (size_t)l * 128 * 512; const float* gkv = F.in[14] + l * 128;
#define QDOT(dst, src) do { float a_ = 0.f; for (int k = 0; k < 256; ++k) a_ += bf2f(P[(size_t)row * PW + PC_DQL + k]) * bfr(wq[(size_t)k * 384 + (src)] * C2D * gq[k]); dst = a_ * rq; } while (0)
    { const int hd = i & 3, w = (i >> 2) & 63; float ref; QDOT(ref, hd * 96 + w); chk_flag(F, 5, chk_bad(bf2f(WSP(const bf16_t, WS_QM)[(size_t)row * 512 + hd * 96 + w]), ref, 1.5f), 0); }
    { const int hd = i & 3, p = (i >> 2) & 31, ip = p >> 1; float x1, x2; QDOT(x1, hd * 96 + 64 + ip); QDOT(x2, hd * 96 + 64 + 16 + ip); const float inv = powf(10000.0f, -(float)(2 * ip) / 32.0f), ang = (float)(row & (SEQ - 1)) * inv, cs = cosf(ang), sn = sinf(ang);
      const float r = (p & 1) ? (x2 * cs + x1 * sn) : (x1 * cs - x2 * sn); chk_flag(F, 6, chk_bad(bf2f(WSP(const bf16_t, WS_QM)[(size_t)row * 512 + hd * 96 + 64 + p]), r, 1.5f), 0); }
    { const int c = (i * 13) & 511; float a = 0.f; for (int k = 0; k < 128; ++k) a += bf2f(P[(size_t)row * PW + PC_DKV + k]) * bfr(wkv[(size_t)k * 512 + c] * gkv[k]); chk_flag(F, 7, chk_bad(bf2f(WSP(const bf16_t, WS_KVM)[(size_t)row * 512 + c]), a * rkv, 1.0f), 0); }
    { const int b = i & 15, which = (i >> 4) & 1, c = (int)(chk_hash(i + 31) % 255), n = (i * 5) & 127; const bf16_t* src = (which ? WSP(const bf16_t, WS_VCMP) : WSP(const bf16_t, WS_KCMP)) + ((size_t)b * SEQ + 16 * c) * 64;
      const float *pk1 = F.in[8], *pv1 = F.in[10], *pk2 = F.in[9], *pv2 = F.in[11]; asm volatile("" : "+s"(pk1), "+s"(pv1), "+s"(pk2), "+s"(pv2));
      const float* w1 = (which ? pv1 : pk1) + (size_t)l * 2048 * 128; const float* w2 = (which ? pv2 : pk2) + (size_t)l * 128 * 64; const float* cp = F.in[7] + (size_t)l * 2048;
      float a = 0.f, bsum = 0.f; for (int p = 0; p < 2048; ++p) { a += bf2f(src[p]) * bfr(w1[(size_t)p * 128 + n]); bsum += cp[p] * w1[(size_t)p * 128 + n]; }
      const float xx = a + bsum, g = 0.5f * xx * (1.0f + tanhf(0.7978845608028654f * (xx + 0.044715f * xx * xx * xx)));
      const bf16_t* hid = WSP(const bf16_t, WS_HID) + (size_t)(which * 4096 + b * 256 + c) * 256 + which * 128;
      chk_flag(F, 8, chk_bad(bf2f(hid[n]), g, 0.5f), 0);
      const int d = (i * 5) & 63; float o2 = 0.f; for (int nn = 0; nn < 128; ++nn) o2 += bf2f(hid[nn]) * w2[nn * 64 + d];
      chk_flag(F, 9, chk_bad(bf2f((which ? WSP(const bf16_t, WS_VC) : WSP(const bf16_t, WS_KC))[((size_t)b * 256 + c) * 64 + d]), o2, 0.5f), 0); }
#undef DOTC
#undef QDOT
}

constexpr int CW_CNT = 20544;
__device__ __forceinline__ void selfcheck_g(Frame& F, int l) {
    const int gi = blockIdx.x * 512 + threadIdx.x; const bf16_t* H = WSP(const bf16_t, WS_H); const bf16_t* P = WSP(const bf16_t, WS_P); const float* W = F.in[6] + (size_t)l * DM * DIN;
    const int row = gi & (M - 1); unsigned nbad = 0u;
    for (int k4 = 0; k4 < 4; ++k4) { int c = (int)(chk_hash(gi * 4 + k4 + 12345u) % PW); if (c >= 640 && c < 768) c -= 200;
        float sc_; const int src_ = inproj_src(c, sc_); float a_ = 0.f; for (int k = 0; k < DM; ++k) a_ += bf2f(H[(size_t)row * DM + k]) * bfr(W[(size_t)k * DIN + src_] * sc_);
        if (chk_bad(bf2f(P[(size_t)row * PW + c]), a_, 1.0f)) ++nbad; }
    if (nbad) atomicAdd((unsigned*)(F.ctl + CW_CNT), nbad);
}
__device__ __forceinline__ void selfcheck_g_fin(Frame& F) {
    if (blockIdx.x == 0 && threadIdx.x == 0) { const unsigned cnt = __hip_atomic_load(F.ctl + CW_CNT, __ATOMIC_RELAXED, __HIP_MEMORY_SCOPE_AGENT); unsigned lg = 0; while ((1u << lg) <= cnt && lg < 15) ++lg;
        atomicOr((unsigned*)(F.ctl + CW_CHK), (cnt > 63u ? 63u : cnt) | (lg << 6)); }
}

__device__ __forceinline__ void selfcheck_f(Frame& F, int l) {
    const int i = threadIdx.x; const unsigned hsh = chk_hash(i + 4242u);
    chk_flag(F, 0, chk_fox(F, i & 15, (i >> 4) & 3, (i >> 6) * 8 + (hsh & 7)), 0);
    chk_flag(F, 1, chk_fox(F, i & 15, (i >> 4) & 3, 64 + (int)(hsh % 192u)), 0);
    chk_flag(F, 2, chk_fox(F, i & 15, (i >> 4) & 3, 256 + (int)(hsh % 3840u)), 0);
    chk_flag(F, 3, chk_dil(F, i & 15, (i >> 4) & 1, (int)(hsh & 127u)), 0);
    chk_flag(F, 4, chk_dil(F, i & 15, (i >> 4) & 1, 128 + (int)(hsh % 3968u)), 0);
    { bool bad = false; if (i < 128) bad = chk_nsa(F, i & 15, (i >> 4) & 3, (int)(hsh % 31u), i); chk_flag(F, 5, bad, 0); }
    { bool bad = false; if (i < 128) bad = chk_nsa(F, i & 15, (i >> 4) & 3, 31 + (int)(hsh % 33u), i); chk_flag(F, 6, bad, 0); }
    { bool bad = false; if (i < 128) bad = chk_nsa(F, i & 15, (i >> 4) & 3, 64 + (int)(hsh % 960u), i); chk_flag(F, 7, bad, 0); }
    { bool bad = false; if (i < 128) bad = chk_nsa(F, i & 15, (i >> 4) & 3, 1024 + (int)(hsh % 3072u), i); chk_flag(F, 8, bad, 4); }
}
__device__ __forceinline__ void selfcheck_report(Frame& F) {
    const unsigned mask = __hip_atomic_load(F.ctl + CW_CHK, __ATOMIC_RELAXED, __HIP_MEMORY_SCOPE_AGENT);
    float V = (float)(10u + (mask & 63u)); const unsigned e = 2u + ((mask >> 6) & 15u); for (unsigned k = 0; k < e; ++k) V *= 10.0f;
    for (size_t idx = (size_t)blockIdx.x * 512 + threadIdx.x; idx < (size_t)M * DM; idx += (size_t)F.G * 512) F.out[idx] = V;
}
#endif
struct SchedSimple {
    pg8::TileOrder T; const char* A; const char* B; int lda, ldb, nt; int dup = 0;
    __device__ __forceinline__ bool next(int i, GUnit& u) const { int pm, pn; if (!T.tile(i >> dup, pm, pn)) return false;
        u.A = A + (size_t)pm * 256 * lda; u.B = B + (size_t)pn * 256 * ldb; u.lda = lda; u.ldb = ldb; u.nt = nt; u.pm = pm; u.pn = pn; u.id = 0; return true; }
};
struct SchedCmp1 {
    int c; const char* kc; const char* vc; const char* B;
    __device__ __forceinline__ bool next(int i, GUnit& u) const { if (i > 0 || c >= 32) return false;
        u.A = (c < 16 ? kc : vc) + (size_t)(c & 15) * 256 * 2048; u.B = B; u.lda = 2048; u.ldb = 4096; u.nt = 32; u.pm = c; u.pn = 0; u.id = 0; return true; }
};
struct SchedMerge {
    pg8::TileOrder T; const char* ocat; const char* h; const char* wbr; const char* wg; int dup = 0;
    __device__ __forceinline__ bool next(int i0, GUnit& u) const { const int i = i0 >> dup; int pm, pn; if (!T.tile(i >> 3, pm, pn)) return false;
        const int sub = i & 7; u.pm = pm; u.pn = pn; u.id = sub;
        if (sub >= 4) { u.A = h + (size_t)pm * 256 * 2048; u.lda = 2048; u.B = wg + (size_t)((pn * 4 + (sub - 4)) * 256) * 2048; u.ldb = 2048; u.nt = 16; }
        else { const int br = sub; const int kk = (br == 1) ? 128 : 256; const size_t co = (br == 0) ? 0 : (br == 1 ? 256 : (br == 2 ? 384 : 640)), wo = (br == 0) ? BR_A : (br == 1 ? BR_B : (br == 2 ? BR_C : BR_D));
            u.A = ocat + (size_t)pm * 256 * (OCW * 2) + co * 2; u.lda = OCW * 2; u.B = wbr + wo + (size_t)pn * 256 * kk * 2; u.ldb = kk * 2; u.nt = kk / 64; }
        return true; }
};

#ifndef SDUP_INPROJ
#define SDUP_INPROJ 0
#endif
#ifndef SDUP_MERGE
#define SDUP_MERGE 0
#endif
#ifndef SDUP_WO
#define SDUP_WO 0
#endif
#ifndef SDUP_UP
#define SDUP_UP 0
#endif
#ifndef SDUP_DN
#define SDUP_DN 0
#endif
#ifndef DUP_ATTN
#define DUP_ATTN 1
#endif
#ifndef DUP_GEMM
#define DUP_GEMM 1
#endif
#ifndef DUP_MERGE
#define DUP_MERGE 1
#endif
#ifndef DUP_FFN
#define DUP_FFN 1
#endif
#ifdef ONLY_PHASE
#define PH(k) ((k) == ONLY_PHASE)
#else
#define PH(k) true
#endif
struct Args { const float* in[27]; float* out; unsigned char* ws; };
__global__ void __launch_bounds__(512, 2) hybrid_fwd(Args args) {
    extern __shared__ __attribute__((aligned(16))) unsigned char lds_raw[];
    Frame F;
    F.lds = (LAS unsigned char*)lds_raw; F.MISC = (volatile LAS unsigned*)(F.lds + MISC_OFF);
    F.tid = threadIdx.x; F.lane = F.tid & 63; F.wave = __builtin_amdgcn_readfirstlane(F.tid >> 6); F.G = gridDim.x;
#pragma unroll
    for (int i = 0; i < 27; ++i) F.in[i] = args.in[i];
    F.out = args.out; F.ws = args.ws; F.ctl = (gu32*)(args.ws + WS_CTL);
    for (int u = F.tid; u < (LDS_BYTES - LDSCTL_OFF) / 4; u += 512) ((LAS unsigned*)(F.lds + LDSCTL_OFF))[u] = 0u;
    __syncthreads();
    XcdBarrier bar = xcd_barrier_post((unsigned*)(F.ctl + CW_BAR), F.MISC + 8);
    const int c = (int)blockIdx.x;
#if defined(TIMEPROBE)
    if (threadIdx.x == 0) *(volatile LAS unsigned long long*)(F.lds + MISC_OFF + 64) = __builtin_amdgcn_s_memrealtime();
#define TSTAMP(id) do { if (blockIdx.x == 0 && threadIdx.x == 0) { volatile LAS unsigned long long* tp_ = (volatile LAS unsigned long long*)(F.lds + MISC_OFF + 64); const unsigned long long now_ = __builtin_amdgcn_s_memrealtime(); unsigned long long* a_ = (unsigned long long*)(F.ws + 90000) + (id); *a_ = *a_ + (now_ - *tp_); *tp_ = now_; } } while (0)
#else
#define TSTAMP(id) do { } while (0)
#endif

#ifndef DUP_P0
#define DUP_P0 1
#endif
    for (int rep = 0; rep < DUP_P0; ++rep) { if (rep) xcd_barrier(bar); if (PH(0)) p0_prologue(F); }
    xcd_barrier(bar); TSTAMP(0);

#ifndef XTRA_BAR
#define XTRA_BAR 0
#endif
    _Pragma("unroll") for (int xb = 0; xb < XTRA_BAR; ++xb) xcd_barrier(bar);
#define PHASE_FRESH() do { int t_ = threadIdx.x; asm volatile("" : "+v"(t_)); F.tid = t_; F.lane = t_ & 63; } while (0)
    for (int l = 0; l < DEPTH; ++l) {
        unsigned char* wl = F.ws + WS_WT + (size_t)l * LW;
        const float* xin = (l == 0) ? F.in[0] : F.out;
        PHASE_FRESH();
#ifndef DUP_RP0
#define DUP_RP0 1
#endif
        if (l == 0) { _Pragma("unroll") for (int rep = 0; rep < DUP_RP0; ++rep) { if (rep) xcd_barrier(bar); if (PH(1)) rowpass<0>(F, xin, nullptr, 0, nullptr, WSP(bf16_t, WS_H), F.in[2] + l * DM, nullptr, 0, M); }
          xcd_barrier(bar); TSTAMP(1); }
        for (int rep = 0; rep < DUP_GEMM; ++rep) if (PH(2)) { if (rep) xcd_barrier(bar); SchedSimple S; S.T.init(256, 12, F.G, c); S.A = (const char*)(F.ws + WS_H); S.B = (const char*)(wl + LW_IN); S.lda = 2048; S.ldb = 2048; S.nt = 16; S.dup = SDUP_INPROJ;
          pg8::EpiInProj E{WSP(bf16_t, WS_P), WSP(bf16_t, WS_KCMP), WSP(bf16_t, WS_VCMP), WSP(float, WS_SIDE), WSP(bf16_t, WS_KROT), WSP(const float, WS_ROPE), WSP(float, WS_SSQQ), WSP(float, WS_SSQKV), F.in[12] + l * 4, WSP(float, WS_LF)};
          pg8::gemm_phase<pg8::EpiInProj, SchedSimple, true>(F.lds, S, E); }
        xcd_barrier(bar); TSTAMP(2);
        if (PH(3)) { SchedCmp1 S{c, (const char*)(F.ws + WS_KCMP), (const char*)(F.ws + WS_VCMP), (const char*)(wl + LW_PHI)};
          pg8::EpiCmp1 E{WSP(bf16_t, WS_HID), WSP(const float, WS_CMPB) + l * 256};
          pg8::gemm_phase<pg8::EpiCmp1, SchedCmp1, false>(F.lds, S, E);
          if (c < 32) {
              __syncthreads(); const int which = c >> 4, b = c & 15;
              int ln_ = threadIdx.x & 63; asm volatile("" : "+v"(ln_)); const int r32 = ln_ & 31, hi = ln_ >> 5;
              const bf16_t* hrow = WSP(const bf16_t, WS_HID) + ((size_t)c * 256 + F.wave * 32 + r32) * 256 + which * 128;
              const float *pk2 = F.in[9], *pv2 = F.in[11]; asm volatile("" : "+s"(pk2), "+s"(pv2)); const float* w2 = (which ? pv2 : pk2) + (size_t)l * 128 * 64;
              f32x16 o0, o1;
#pragma unroll
              for (int r = 0; r < 16; ++r) { o0[r] = 0.f; o1[r] = 0.f; }
#pragma unroll
              for (int ks = 0; ks < 8; ++ks) { const bf16x8 a = *(const bf16x8*)(hrow + ks * 16 + hi * 8);
                  const float* wp = w2 + (size_t)(ks * 16 + hi * 8) * 64 + r32; u32x4 b0, b1;
#pragma unroll
                  for (int jj = 0; jj < 4; ++jj) { b0[jj] = cvtpk(wp[(2 * jj) * 64], wp[(2 * jj + 1) * 64]); b1[jj] = cvtpk(wp[(2 * jj) * 64 + 32], wp[(2 * jj + 1) * 64 + 32]); }
                  o0 = MFMA32(a, __builtin_bit_cast(bf16x8, b0), o0); o1 = MFMA32(a, __builtin_bit_cast(bf16x8, b1), o1); }
              bf16_t* dst = (which ? WSP(bf16_t, WS_VC) : WSP(bf16_t, WS_KC)) + ((size_t)b * 256 + F.wave * 32) * 64 + r32;
#pragma unroll
              for (int r = 0; r < 16; ++r) { const int rw = crow(r, hi); dst[(size_t)rw * 64] = (bf16_t)f2bf(o0[r]); dst[(size_t)rw * 64 + 32] = (bf16_t)f2bf(o1[r]); } } }
        if (PH(4)) { int G2_ = F.G; asm volatile("" : "+s"(G2_)); const bool split = G2_ > 64; const int g2 = split ? F.G - 32 : F.G, c2 = split ? c - 32 : c;
          { SchedSimple S; S.T.init(256, 2, g2, c2 < 0 ? (1 << 28) : c2); S.A = (const char*)(F.ws + WS_P) + PC_DQL * 2; S.B = (const char*)(wl + LW_UQ); S.lda = PW * 2; S.ldb = 512; S.nt = 4;
            pg8::EpiQup E{WSP(bf16_t, WS_QM), WSP(const float, WS_SSQQ), WSP(const float, WS_ROPE)};
            pg8::gemm_phase<pg8::EpiQup, SchedSimple, true>(F.lds, S, E); }
          { SchedSimple S; S.T.init(256, 2, g2, c2 < 0 ? (1 << 28) : c2); S.A = (const char*)(F.ws + WS_P) + PC_DKV * 2; S.B = (const char*)(wl + LW_UKV); S.lda = PW * 2; S.ldb = 256; S.nt = 2;
            pg8::EpiKVup E{WSP(bf16_t, WS_KVM), WSP(const float, WS_SSQKV)};
            pg8::gemm_phase<pg8::EpiKVup, SchedSimple, true>(F.lds, S, E); } }
        PHASE_FRESH();
        if (PH(5)) {
          int G_ = F.G; asm volatile("" : "+s"(G_)); const int cb = (G_ >= 48) ? c - 32 : c;
          if (cb >= 0 && cb < BATCH) { const int b = cb, tid = F.tid; const float* lf = WSP(const float, WS_LF) + ((size_t)b * SEQ + 8 * tid) * 4;
              f32x4 v[8];
#pragma unroll
              for (int i = 0; i < 8; ++i) v[i] = *(const f32x4*)(lf + 4 * i);
#pragma unroll
              for (int i = 1; i < 8; ++i) v[i] = v[i] + v[i - 1];
              LAS f32x4* sc = (LAS f32x4*)F.lds; f32x4 run = v[7];
              sc[tid] = run; __syncthreads();
              for (int off = 1, cur = 0; off < 512; off <<= 1, cur ^= 1) { f32x4 t = sc[cur * 512 + tid]; if (tid >= off) t = t + sc[cur * 512 + tid - off]; sc[(cur ^ 1) * 512 + tid] = t; __syncthreads(); run = t; }
              const f32x4 ex = run - v[7];
              float* kb = WSP(float, WS_KB) + (size_t)b * 4 * SEQ + 8 * tid;
#pragma unroll
              for (int e = 0; e < 4; ++e) { f32x4 lo, hi4;
#pragma unroll
                  for (int i = 0; i < 4; ++i) { lo[i] = -(ex[e] + v[i][e]) * LOG2E; hi4[i] = -(ex[e] + v[4 + i][e]) * LOG2E; }
                  *(f32x4*)(kb + (size_t)e * SEQ) = lo; *(f32x4*)(kb + (size_t)e * SEQ + 4) = hi4; }
              __syncthreads();
          } }
        xcd_barrier(bar); TSTAMP(3);
        PHASE_FRESH();
        for (int rep = 0; rep < DUP_ATTN; ++rep) { gu32* ctr = F.ctl + CW_Q + 64 * l + 16 * rep;
          if (rep) xcd_barrier(bar);
          for (;;) { const int it = queue_grab(F, ctr);
              if (it < 2048 && PH(7)) { const int qb = 15 - (it >> 7), mla = (it >> 6) & 1, bh = it & 63; if (mla) causal_unit<false>(F, bh >> 2, bh & 3, qb); else causal_unit<true>(F, bh >> 2, bh & 3, qb); }
              else if (it < 3072 && PH(8)) { const int r = it - 2048; nsa_unit(F, r & 15, 63 - (r >> 4)); }
              else if (it < 3328 && PH(9)) { const int r = it - 3072; dil_unit(F, r & 15, (r >> 4) & 1, r >> 5); }
              else break; } }
        xcd_barrier(bar); TSTAMP(5);
#if defined(SELFCHECK) && SELFCHECK == 1
        if (c == 0) selfcheck_a(F, l);
#endif
#if defined(SELFCHECK) && SELFCHECK == 3
        if (c == 0) selfcheck_e(F, l);
        xcd_barrier(bar); selfcheck_report(F); return;
#endif
#if defined(SELFCHECK) && SELFCHECK == 5
        selfcheck_g(F, l); xcd_barrier(bar); selfcheck_g_fin(F);
        xcd_barrier(bar); selfcheck_report(F); return;
#endif
#if defined(SELFCHECK) && SELFCHECK == 4
        if (c == 0) selfcheck_f(F, l);
        xcd_barrier(bar); selfcheck_report(F); return;
#endif
        for (int rep = 0; rep < DUP_MERGE; ++rep) if (PH(10)) { if (rep) xcd_barrier(bar); SchedMerge S; S.T.init(256, 4, F.G, c); S.ocat = (const char*)(F.ws + WS_OCAT); S.h = (const char*)(F.ws + WS_H); S.wbr = (const char*)(wl + LW_BR); S.wg = (const char*)(wl + LW_G); S.dup = SDUP_MERGE;
          unsigned char* scr = F.ws + WS_MSCR + (size_t)c * MSCR_PER_WG;
          pg8::EpiMerge E{WSP(bf16_t, WS_MERGED), scr};
          pg8::gemm_phase<pg8::EpiMerge, SchedMerge, true>(F.lds, S, E); }
        xcd_barrier(bar); TSTAMP(6);
#if defined(SELFCHECK) && SELFCHECK == 1
        if (c == 0) selfcheck_b(F, l);
        xcd_barrier(bar); selfcheck_report(F); return;
#endif
        if (PH(11)) { SchedSimple S; S.T.init(256, 4, F.G, c); S.A = (const char*)(F.ws + WS_MERGED); S.B = (const char*)(wl + LW_O); S.lda = 2048; S.ldb = 2048; S.nt = 16; S.dup = SDUP_WO;
          pg8::EpiBf16 E{WSP(bf16_t, WS_Y), DM};
          pg8::gemm_phase<pg8::EpiBf16, SchedSimple, true>(F.lds, S, E); }
        xcd_barrier(bar); TSTAMP(7);
        PHASE_FRESH();
        if (PH(12)) rowpass<1>(F, xin, WSP(const bf16_t, WS_Y), 0, F.out, WSP(bf16_t, WS_H2), F.in[3] + l * DM, F.in[4] + l * DM, 0, M);
        xcd_barrier(bar); TSTAMP(8);
        if (PH(13)) { SchedSimple S; S.T.init(256, 22, F.G, c); S.A = (const char*)(F.ws + WS_H2); S.B = (const char*)(wl + LW_UP); S.lda = 2048; S.ldb = 2048; S.nt = 16; S.dup = SDUP_UP;
          pg8::EpiUpConv E{WSP(bf16_t, WS_ACT), WSP(float, WS_HB), F.in[24] + (size_t)l * 3 * DFF2, F.in[25] + (size_t)l * DFF2};
          pg8::gemm_phase<pg8::EpiUpConv, SchedSimple, true>(F.lds, S, E); }
        xcd_barrier(bar); TSTAMP(9);
        PHASE_FRESH();
        if (PH(15)) { SchedSimple S; S.T.init(256, 4, F.G, c); S.A = (const char*)(F.ws + WS_ACT); S.B = (const char*)(wl + LW_DN); S.lda = DFF * 2; S.ldb = DFF * 2; S.nt = DFF / 64; S.dup = SDUP_DN;
          { int pm, pn; for (int i = 0; S.T.tile(i, pm, pn); ++i) ffn_fix_panel(F, pm, WSP(const float, WS_HB), WSP(bf16_t, WS_ACT), F.in[24] + (size_t)l * 3 * DFF2, F.in[25] + (size_t)l * DFF2); }
          VM_WAIT(); __syncthreads();
          pg8::EpiBf16 E{WSP(bf16_t, WS_Y2), DM};
          pg8::gemm_phase<pg8::EpiBf16, SchedSimple, true>(F.lds, S, E); }
        xcd_barrier(bar); TSTAMP(11);
        PHASE_FRESH();
        if (PH(16)) { if (l + 1 < DEPTH) rowpass<1>(F, F.out, WSP(const bf16_t, WS_Y2), 0, F.out, WSP(bf16_t, WS_H), F.in[5] + l * DM, F.in[2] + (l + 1) * DM, 0, M);
                      else rowpass<2>(F, F.out, WSP(const bf16_t, WS_Y2), 0, F.out, nullptr, F.in[5] + l * DM, nullptr, 0, M); }
        xcd_barrier(bar); TSTAMP(12);
    }
#if defined(TIMEPROBE)
    { xcd_barrier(bar); const unsigned long long* a_ = (const unsigned long long*)(F.ws + 90000); const float V1 = (float)a_[TIMEPROBE_A] * 0.01f, V2 = (float)a_[TIMEPROBE_B] * 0.01f * 1000.0f;
      for (size_t idx = (size_t)blockIdx.x * 512 + threadIdx.x; idx < (size_t)M * DM; idx += (size_t)F.G * 512) F.out[idx] = (idx == 12345) ? V2 : V1; }
#endif
}

extern "C" void kernel_launch(void* const* d_in, const int* in_sizes, int n_in, void* d_out, int out_size, void* d_ws, size_t ws_size, hipStream_t stream) {
    static int grid = 0;
    if (grid == 0) {
        if (n_in != 27 || in_sizes[0] != M * DM || out_size != M * DM || ws_size < WS_END) { fprintf(stderr, "kernel_launch: unexpected shapes (n_in %d, in0 %d, out %d, ws %zu)\n", n_in, n_in > 0 ? in_sizes[0] : -1, out_size, ws_size); grid = -1; return; }
        int dev = 0, cus = 0, per_cu = 0;
        if (hipGetDevice(&dev) != hipSuccess || hipDeviceGetAttribute(&cus, hipDeviceAttributeMultiprocessorCount, dev) != hipSuccess) { grid = -1; return; }
        if (hipFuncSetAttribute((const void*)hybrid_fwd, hipFuncAttributeMaxDynamicSharedMemorySize, LDS_BYTES) != hipSuccess) { fprintf(stderr, "kernel_launch: hipFuncSetAttribute failed\n"); grid = -1; return; }
        if (hipOccupancyMaxActiveBlocksPerMultiprocessor(&per_cu, (const void*)hybrid_fwd, 512, LDS_BYTES) != hipSuccess || per_cu < 1) fprintf(stderr, "kernel_launch: occupancy query says %d\n", per_cu);
        (void)hipGetLastError();
        grid = cus;
    }
    if (grid < 0) return;
    if (hipMemsetAsync((char*)d_ws + WS_CTL, 0, CTL_ZERO_BYTES, stream) != hipSuccess) return;
    Args a{};
    for (int i = 0; i < 27; ++i) a.in[i] = (const float*)d_in[i];
    a.out = (float*)d_out; a.ws = (unsigned char*)d_ws;
    hipLaunchKernelGGL(hybrid_fwd, dim3(grid), dim3(512), LDS_BYTES, stream, a);
}
```

```cpp
#include <hip/hip_runtime.h>
#include <hip/hip_bf16.h>
#include <cstdio>
#include <cstdint>
#include <cmath>

#define GAS __attribute__((address_space(1)))
#define LAS __attribute__((address_space(3)))
typedef unsigned short bf16_t;
typedef short bf16x8 __attribute__((ext_vector_type(8)));
typedef short s16x4 __attribute__((ext_vector_type(4)));
typedef float f32x4 __attribute__((ext_vector_type(4)));
typedef float f32x2 __attribute__((ext_vector_type(2)));
typedef float f32x16 __attribute__((ext_vector_type(16)));
typedef unsigned u32x4 __attribute__((ext_vector_type(4)));
typedef unsigned u32x2 __attribute__((ext_vector_type(2)));
typedef GAS unsigned gu32;

constexpr int BATCH = 16, SEQ = 4096, DM = 1024, M = BATCH * SEQ, DEPTH = 2;
constexpr int DIN = 2992, PW = 3072;
constexpr int DFF = 2816, DFF2 = 5632;
constexpr float LOG2E = 1.4426950408889634f;
constexpr float C2A = 0.125f * LOG2E;
constexpr float C2D = 0.10206207261596575f * LOG2E;
constexpr float RMS_EPS = 1e-6f;
constexpr int PC_AQ = 0, PC_KCMP = 256, PC_VCMP = 320, PC_KSLC = 384, PC_VSLC = 448, PC_KWIN = 512, PC_VWIN = 576,
              PC_MISC = 640, PC_KROPE = 672, PC_BQ = 768, PC_BK = 1152, PC_BV = 1536, PC_DKV = 1920,
              PC_CQ = 2048, PC_CK = 2304, PC_CV = 2560, PC_DQL = 2816;
constexpr int OCW = 896;
constexpr int NSA_DFAR = 1536, NSA_DMAX = 1664, NSA_TL = 1728;

__device__ __forceinline__ unsigned f2bf(float f) { unsigned u = __float_as_uint(f); return (u + 0x7fffu + ((u >> 16) & 1u)) >> 16; }
__device__ __forceinline__ unsigned pk2(float lo, float hi) { return f2bf(lo) | (f2bf(hi) << 16); }
__device__ __forceinline__ float bf2f(unsigned short b) { return __uint_as_float((unsigned)b << 16); }
typedef __bf16 bf16x2_t __attribute__((ext_vector_type(2)));
__device__ __forceinline__ unsigned cvtpk(float lo, float hi) { f32x2 v = {lo, hi}; bf16x2_t b = __builtin_convertvector(v, bf16x2_t); return __builtin_bit_cast(unsigned, b); }
__device__ __forceinline__ float fast_exp2(float x) { return __builtin_amdgcn_exp2f(x); }
__device__ __forceinline__ float fast_rcp(float x) { return __builtin_amdgcn_rcpf(x); }
template <int MASK> __device__ __forceinline__ float xor_lane_lt32(float v) { return __uint_as_float(__builtin_amdgcn_ds_swizzle((int)__float_as_uint(v), (MASK << 10) | 0x1f)); }
__device__ __forceinline__ float sum_halves(float v) { auto rr = __builtin_amdgcn_permlane32_swap(__float_as_uint(v), __float_as_uint(v), false, false); return __uint_as_float(rr[0]) + __uint_as_float(rr[1]); }
__device__ __forceinline__ float sigmoid_f(float x) { return fast_rcp(1.0f + fast_exp2(-x * LOG2E)); }

namespace pg8 {
constexpr int BM = 256, BK = 64, HALF = 128, HTB = HALF * BK * 2  , STAGE_BYTES = 8 * HTB, NXCD = 8, WGM = 8;
__host__ __device__ __forceinline__ int lds_byte(int r, int c) { const int st = (r >> 4) * 2 + (c >> 5), rr = r & 15, cc = c & 31, ob = rr * 64 + cc * 2; return st * 1024 + (ob ^ (((ob >> 9) & 1) << 5)); }
__host__ __device__ __forceinline__ void stage_rc(int b, int& R, int& C) { const int st = b / 1024, sb = b % 1024, swz = sb ^ (((sb >> 9) & 1) << 5); R = (st >> 1) * 16 + swz / 64; C = (st & 1) * 32 + (swz % 64) / 2; }
__host__ __device__ __forceinline__ int perm32(int rho) { const int n = rho >> 4, i = rho & 15; return 8 * (i >> 2) + 4 * n + (i & 3); }

struct GUnit { const char* A; const char* B; int lda, ldb, nt, pm, pn, id; };

struct TileOrder {
    int nM, nN, nwg, G, c;
    __device__ __forceinline__ void init(int nM_, int nN_, int G_, int c_) { nM = nM_; nN = nN_; nwg = nM * nN; G = G_; c = c_; }
    __device__ __forceinline__ bool tile(int i, int& pm, int& pn) const {
        const long L = (long)i * G + c; if (L >= nwg) return false;
        int wgid = (int)L; { const int q = nwg / NXCD, r = nwg % NXCD, xcd = wgid % NXCD, off = wgid / NXCD; wgid = (xcd < r ? xcd * (q + 1) : r * (q + 1) + (xcd - r) * q) + off; }
        const int nig = WGM * nN, gid = wgid / nig, fm = gid * WGM, gsz = (nM - fm) < WGM ? (nM - fm) : WGM;
        pm = fm + ((wgid % nig) % gsz); pn = (wgid % nig) / gsz; return true;
    }
};

template <class Epi, class Sched, bool ALIGN_EPI>
__device__ __forceinline__ void gemm_phase(LAS unsigned char* lds, const Sched& S, const Epi& E) {
    int tid_o = threadIdx.x; asm volatile("" : "+v"(tid_o));
    const int tid = tid_o, wid = __builtin_amdgcn_readfirstlane(tid >> 6), lane = tid & 63, wr = wid >> 2, wc = wid & 3; int fr = lane & 15, fq = lane >> 4;
    int sR[2], sC[2], sRb[2];
#pragma unroll
    for (int i = 0; i < 2; ++i) { stage_rc(tid * 16 + i * 8192, sR[i], sC[i]); sRb[i] = Epi::PERM ? ((sR[i] & ~31) + perm32(sR[i] & 31)) : sR[i]; sC[i] *= 2; }
    const size_t kstep = (size_t)(BK * 2);
    const unsigned ldsw = (unsigned)wid * 1024u;
    const int aoff = lds_byte(wr * 64 + fr, fq * 8), boff = lds_byte(wc * 32 + fr, fq * 8);
#define PG8_SA(b, h) (((b) * 2 + (h)) * HTB)
#define PG8_SB(b, h) ((4 + (b) * 2 + (h)) * HTB)
#define PG8_STAGE(bufoff, gbase, rows, ld) do { _Pragma("unroll") for (int _i = 0; _i < 2; ++_i) \
        __builtin_amdgcn_global_load_lds((const unsigned*)((const char*)(gbase) + (unsigned)((rows)[_i] * (ld) + sC[_i])), (LAS unsigned*)(lds + (bufoff) + ldsw + _i * 8192), 16, 0, 0); } while (0)
#define PG8_LDA(dst, b, h) do { _Pragma("unroll") for (int m = 0; m < 4; ++m) _Pragma("unroll") for (int k = 0; k < 2; ++k) dst[m][k] = *(const LAS bf16x8*)(lds + PG8_SA(b, h) + aoff + m * 2048 + k * 1024); } while (0)
#define PG8_LDB(dst, b, h) do { _Pragma("unroll") for (int n = 0; n < 2; ++n) _Pragma("unroll") for (int k = 0; k < 2; ++k) dst[n][k] = *(const LAS bf16x8*)(lds + PG8_SB(b, h) + boff + n * 2048 + k * 1024); } while (0)
#define PG8_MMA(ai, bj, At, Bt) do { __builtin_amdgcn_s_setprio(1); _Pragma("unroll") for (int m = 0; m < 4; ++m) _Pragma("unroll") for (int n = 0; n < 2; ++n) _Pragma("unroll") for (int k = 0; k < 2; ++k) \
        acc[ai][bj][m][n] = __builtin_amdgcn_mfma_f32_16x16x32_bf16(Bt[n][k], At[m][k], acc[ai][bj][m][n], 0, 0, 0); __builtin_amdgcn_s_setprio(0); } while (0)
#define PG8_WAIT_V(n) asm volatile("s_waitcnt vmcnt(" #n ")" ::: "memory")
#define PG8_WAIT_L(n) asm volatile("s_waitcnt lgkmcnt(" #n ")" ::: "memory")
#define PG8_BAR __builtin_amdgcn_s_barrier()
#define PG8_SCHED __builtin_amdgcn_sched_barrier(0)
    GUnit cur, nxt; int ui = 0;
    if (!S.next(0, cur)) return;
    f32x4 acc[2][2][4][2];
#pragma unroll
    for (int a = 0; a < 2; ++a)
#pragma unroll
        for (int b = 0; b < 2; ++b)
#pragma unroll
            for (int m = 0; m < 4; ++m)
#pragma unroll
                for (int n = 0; n < 2; ++n) acc[a][b][m][n] = (f32x4){0.f, 0.f, 0.f, 0.f};
    bf16x8 At[4][2], B0[2][2], B1[2][2];
    int ldAc = cur.lda, ldBc = cur.ldb; size_t hAc = (size_t)HALF * ldAc, hBc = (size_t)HALF * ldBc;
    const char* cA = cur.A; const char* cB = cur.B;
    PG8_STAGE(PG8_SB(0, 0), cB, sRb, ldBc); PG8_STAGE(PG8_SB(0, 1), cB + hBc, sRb, ldBc); PG8_STAGE(PG8_SA(0, 0), cA, sR, ldAc); PG8_STAGE(PG8_SA(0, 1), cA + hAc, sR, ldAc);
    if (wr == 1) PG8_BAR;
    PG8_WAIT_V(2); PG8_BAR;
    PG8_STAGE(PG8_SB(1, 0), cB + kstep, sRb, ldBc); PG8_STAGE(PG8_SA(1, 0), cA + kstep, sR, ldAc); PG8_STAGE(PG8_SB(1, 1), cB + hBc + kstep, sRb, ldBc);
    PG8_WAIT_V(6); PG8_BAR;
    for (;;) {
        const bool has_next = S.next(ui + 1, nxt);
        int ldAn, ldBn; const char* nA; const char* nB;
        if (has_next) { ldAn = nxt.lda; ldBn = nxt.ldb; nA = nxt.A; nB = nxt.B; } else { ldAn = ldAc; ldBn = ldBc; nA = cA; nB = cB; }
        const size_t hAn = (size_t)HALF * ldAn, hBn = (size_t)HALF * ldBn;
        int nt = cur.nt; asm volatile("" : "+s"(nt));
        for (int t = 0; t < nt; t += 2) {
            const bool last = (t == nt - 2);
            const char* a1 = cA + (size_t)(t + 1) * kstep;
            const char* a2 = last ? nA : cA + (size_t)(t + 2) * kstep; const char* b2 = last ? nB : cB + (size_t)(t + 2) * kstep;
            const char* a3 = a2 + kstep; const char* b3 = b2 + kstep;
            const int ldA2 = last ? ldAn : ldAc, ldB2 = last ? ldBn : ldBc;
            const size_t hA2 = last ? hAn : hAc, hB2 = last ? hBn : hBc;
            PG8_LDB(B0, 0, 0); PG8_LDB(B1, 0, 1); PG8_SCHED; PG8_LDA(At, 0, 0); PG8_STAGE(PG8_SA(1, 1), a1 + hAc, sR, ldAc);
            PG8_WAIT_V(8); PG8_WAIT_L(0); PG8_BAR; PG8_MMA(0, 0, At, B0); PG8_MMA(0, 1, At, B1); PG8_BAR; PG8_SCHED;
            PG8_LDA(At, 0, 1); PG8_STAGE(PG8_SB(0, 0), b2, sRb, ldB2); PG8_STAGE(PG8_SB(0, 1), b2 + hB2, sRb, ldB2); PG8_STAGE(PG8_SA(0, 0), a2, sR, ldA2);
            PG8_WAIT_V(8); PG8_WAIT_L(0); PG8_BAR; PG8_MMA(1, 0, At, B0); PG8_MMA(1, 1, At, B1); PG8_BAR; PG8_SCHED;
            PG8_LDB(B0, 1, 0); PG8_LDB(B1, 1, 1); PG8_SCHED; PG8_LDA(At, 1, 0); PG8_STAGE(PG8_SA(0, 1), a2 + hA2, sR, ldA2);
            PG8_WAIT_V(8); PG8_WAIT_L(0); PG8_BAR; PG8_MMA(0, 0, At, B0); PG8_MMA(0, 1, At, B1); PG8_BAR; PG8_SCHED;
            PG8_LDA(At, 1, 1); PG8_STAGE(PG8_SB(1, 0), b3, sRb, ldB2); PG8_STAGE(PG8_SB(1, 1), b3 + hB2, sRb, ldB2); PG8_STAGE(PG8_SA(1, 0), a3, sR, ldA2);
            PG8_WAIT_V(8); PG8_WAIT_L(0); PG8_BAR; PG8_MMA(1, 0, At, B0); PG8_MMA(1, 1, At, B1); PG8_BAR; PG8_SCHED;
        }
        if constexpr (ALIGN_EPI) { if (wr == 0) PG8_BAR; }
        E(acc, cur, wr, wc, fr, fq);
        if (!has_next) break;
#pragma unroll
        for (int a = 0; a < 2; ++a)
#pragma unroll
            for (int b = 0; b < 2; ++b)
#pragma unroll
                for (int m = 0; m < 4; ++m)
#pragma unroll
                    for (int n = 0; n < 2; ++n) acc[a][b][m][n] = (f32x4){0.f, 0.f, 0.f, 0.f};
        cur = nxt; cA = nA; cB = nB; ++ui;
        ldAc = ldAn; ldBc = ldBn; hAc = hAn; hBc = hBn;
        if constexpr (ALIGN_EPI) { if (wr == 1) PG8_BAR; }
    }
    PG8_WAIT_V(0);
    if constexpr (!ALIGN_EPI) { if (wr == 0) PG8_BAR; }
    PG8_BAR;
#undef PG8_SA
#undef PG8_SB
#undef PG8_STAGE
#undef PG8_LDA
#undef PG8_LDB
#undef PG8_MMA
#undef PG8_WAIT_V
#undef PG8_WAIT_L
#undef PG8_BAR
#undef PG8_SCHED
}
}
using pg8::GUnit;
namespace pg8 {
#define EPI_OPAQUE() asm volatile("" : "+v"(fr), "+v"(fq))
struct EpiBf16 {
    static constexpr bool PERM = true;
    bf16_t* O; int ldc;
    __device__ __forceinline__ void operator()(const f32x4 (&acc)[2][2][4][2], const GUnit& u, int wr, int wc, int fr, int fq) const {
        EPI_OPAQUE();
        const int row0 = u.pm * BM + wr * 64 + fr, col0 = u.pn * BM + wc * 32 + 8 * fq;
#pragma unroll
        for (int ai = 0; ai < 2; ++ai)
#pragma unroll
            for (int m = 0; m < 4; ++m) { bf16_t* rowp = O + (size_t)(row0 + ai * HALF + m * 16) * ldc + col0;
#pragma unroll
                for (int bj = 0; bj < 2; ++bj) { const f32x4 v0 = acc[ai][bj][m][0], v1 = acc[ai][bj][m][1];
                    u32x4 w; w.x = cvtpk(v0[0], v0[1]); w.y = cvtpk(v0[2], v0[3]); w.z = cvtpk(v1[0], v1[1]); w.w = cvtpk(v1[2], v1[3]);
                    *(u32x4*)(rowp + bj * HALF) = w; } }
    }
};
struct EpiF32 {
    static constexpr bool PERM = false;
    float* O; int ldc;
    __device__ __forceinline__ void operator()(const f32x4 (&acc)[2][2][4][2], const GUnit& u, int wr, int wc, int fr, int fq) const {
        EPI_OPAQUE();
        const int row0 = u.pm * BM + wr * 64 + fr, col0 = u.pn * BM + wc * 32 + 4 * fq;
#pragma unroll
        for (int ai = 0; ai < 2; ++ai)
#pragma unroll
            for (int m = 0; m < 4; ++m) { float* rowp = O + (size_t)(row0 + ai * HALF + m * 16) * ldc + col0;
#pragma unroll
                for (int bj = 0; bj < 2; ++bj)
#pragma unroll
                    for (int n = 0; n < 2; ++n) *(f32x4*)(rowp + bj * HALF + n * 16) = acc[ai][bj][m][n]; }
    }
};
__device__ __forceinline__ void rope8(f32x4& v0, f32x4& v1, const float* cs  ) {
    const f32x4 a = *(const f32x4*)cs, b = *(const f32x4*)(cs + 4);
    f32x4 r0, r1;
    r0[0] = v0[0] * a[0] - v0[1] * a[1]; r0[1] = v0[1] * a[0] + v0[0] * a[1];
    r0[2] = v0[2] * a[2] - v0[3] * a[3]; r0[3] = v0[3] * a[2] + v0[2] * a[3];
    r1[0] = v1[0] * b[0] - v1[1] * b[1]; r1[1] = v1[1] * b[0] + v1[0] * b[1];
    r1[2] = v1[2] * b[2] - v1[3] * b[3]; r1[3] = v1[3] * b[2] + v1[2] * b[3];
    v0 = r0; v1 = r1;
}
struct EpiInProj {
    static constexpr bool PERM = true;
    bf16_t* P; bf16_t* kcmp; bf16_t* vcmp; float* side; bf16_t* krot; const float* rope; float* ssq_q; float* ssq_kv; const float* fbias; float* lf;
    __device__ __forceinline__ void operator()(const f32x4 (&acc)[2][2][4][2], const GUnit& u, int wr, int wc, int fr, int fq) const {
        EPI_OPAQUE();
        const int row0 = u.pm * BM + wr * 64 + fr, col0 = u.pn * BM + wc * 32 + 8 * fq;
#pragma unroll
        for (int ai = 0; ai < 2; ++ai)
#pragma unroll
            for (int m = 0; m < 4; ++m) { const int row = row0 + ai * HALF + m * 16; bf16_t* rowp = P + (size_t)row * PW + col0;
                float ssq = 0.f;
#pragma unroll
                for (int bj = 0; bj < 2; ++bj) { f32x4 v0 = acc[ai][bj][m][0], v1 = acc[ai][bj][m][1];
                    if (u.pn == 2 && bj == 1) {
                        if (wc == 0 && fq < 2) { float* sp = side + (size_t)row * 16 + 8 * fq; *(f32x4*)sp = v0; *(f32x4*)(sp + 4) = v1;
                            if (fq == 1) { const f32x4 fb = *(const f32x4*)fbias; f32x4 s1;
#pragma unroll
                                for (int e = 0; e < 4; ++e) { const float x = v1[e] + fb[e]; s1[e] = (x >= 0.f) ? -log1pf(expf(-x)) : (x - log1pf(expf(x))); }
                                *(f32x4*)(lf + (size_t)row * 4) = s1; } }
                        if (wc == 1) { rope8(v0, v1, rope + (size_t)(row & (SEQ - 1)) * 32 + 8 * fq);
                            u32x4 w; w.x = cvtpk(v0[0], v0[1]); w.y = cvtpk(v0[2], v0[3]); w.z = cvtpk(v1[0], v1[1]); w.w = cvtpk(v1[2], v1[3]);
                            *(u32x4*)(krot + (size_t)row * 32 + 8 * fq) = w; }
                    }
                    u32x4 w; w.x = cvtpk(v0[0], v0[1]); w.y = cvtpk(v0[2], v0[3]); w.z = cvtpk(v1[0], v1[1]); w.w = cvtpk(v1[2], v1[3]);
                    *(u32x4*)(rowp + bj * HALF) = w;
                    if (u.pn == 1 && bj == 0) { bf16_t* cp = (wc < 2 ? kcmp : vcmp) + (size_t)row * 64 + (wc & 1) * 32 + 8 * fq; *(u32x4*)cp = w; }
                    if (u.pn == 11 || (u.pn == 7 && bj == 1)) ssq += (v0[0] * v0[0] + v0[1] * v0[1]) + (v0[2] * v0[2] + v0[3] * v0[3]) + (v1[0] * v1[0] + v1[1] * v1[1]) + (v1[2] * v1[2] + v1[3] * v1[3]);
                }
                if (u.pn == 11 || u.pn == 7) { ssq += xor_lane_lt32<16>(ssq); ssq = sum_halves(ssq);
                    if (fq == 0) (u.pn == 11 ? ssq_q : ssq_kv)[(size_t)row * 4 + wc] = ssq; }
                asm volatile("" ::: "memory");
            }
    }
};
struct EpiQup {
    static constexpr bool PERM = true;
    bf16_t* O; const float* ssq_q; const float* rope;
    __device__ __forceinline__ void operator()(const f32x4 (&acc)[2][2][4][2], const GUnit& u, int wr, int wc, int fr, int fq) const {
        EPI_OPAQUE();
        const int row0 = u.pm * BM + wr * 64 + fr, col0 = u.pn * BM + wc * 32 + 8 * fq;
#pragma unroll
        for (int ai = 0; ai < 2; ++ai)
#pragma unroll
            for (int m = 0; m < 4; ++m) { const int row = row0 + ai * HALF + m * 16; bf16_t* rowp = O + (size_t)row * 512 + col0;
                const f32x4 pq = *(const f32x4*)(ssq_q + (size_t)row * 4);
                const float rstd = 1.0f / sqrtf(((pq[0] + pq[1]) + (pq[2] + pq[3])) * (1.0f / 256.0f) + RMS_EPS);
#pragma unroll
                for (int bj = 0; bj < 2; ++bj) { f32x4 v0 = acc[ai][bj][m][0] * rstd, v1 = acc[ai][bj][m][1] * rstd;
                    const int c8 = col0 + bj * HALF, within = c8 % 96;
                    if (c8 < 384 && within >= 64) rope8(v0, v1, rope + (size_t)(row & (SEQ - 1)) * 32 + (within - 64));
                    u32x4 w; w.x = cvtpk(v0[0], v0[1]); w.y = cvtpk(v0[2], v0[3]); w.z = cvtpk(v1[0], v1[1]); w.w = cvtpk(v1[2], v1[3]);
                    *(u32x4*)(rowp + bj * HALF) = w; }
                asm volatile("" ::: "memory"); }
    }
};
struct EpiKVup {
    static constexpr bool PERM = true;
    bf16_t* O; const float* ssq_kv;
    __device__ __forceinline__ void operator()(const f32x4 (&acc)[2][2][4][2], const GUnit& u, int wr, int wc, int fr, int fq) const {
        EPI_OPAQUE();
        const int row0 = u.pm * BM + wr * 64 + fr, col0 = u.pn * BM + wc * 32 + 8 * fq;
#pragma unroll
        for (int ai = 0; ai < 2; ++ai)
#pragma unroll
            for (int m = 0; m < 4; ++m) { const int row = row0 + ai * HALF + m * 16; bf16_t* rowp = O + (size_t)row * 512 + col0;
                const f32x4 pq = *(const f32x4*)(ssq_kv + (size_t)row * 4);
                const float rstd = 1.0f / sqrtf(((pq[0] + pq[1]) + (pq[2] + pq[3])) * (1.0f / 128.0f) + RMS_EPS);
#pragma unroll
                for (int bj = 0; bj < 2; ++bj) { const f32x4 v0 = acc[ai][bj][m][0] * rstd, v1 = acc[ai][bj][m][1] * rstd;
                    u32x4 w; w.x = cvtpk(v0[0], v0[1]); w.y = cvtpk(v0[2], v0[3]); w.z = cvtpk(v1[0], v1[1]); w.w = cvtpk(v1[2], v1[3]);
                    *(u32x4*)(rowp + bj * HALF) = w; }
                asm volatile("" ::: "memory"); }
    }
};
__device__ __forceinline__ float gelu_tanh(float x) { const float u2 = 2.0f * 0.7978845608028654f * (x + 0.044715f * x * x * x); return x * fast_rcp(1.0f + fast_exp2(-u2 * LOG2E)); }
struct EpiCmp1 {
    static constexpr bool PERM = true;
    bf16_t* O; const float* bias1;
    __device__ __forceinline__ void operator()(const f32x4 (&acc)[2][2][4][2], const GUnit& u, int wr, int wc, int fr, int fq) const {
        EPI_OPAQUE();
        const int row0 = u.pm * BM + wr * 64 + fr, col0 = wc * 32 + 8 * fq;
        f32x4 bv[2][2];
#pragma unroll
        for (int bj = 0; bj < 2; ++bj)
#pragma unroll
            for (int n = 0; n < 2; ++n) bv[bj][n] = *(const f32x4*)(bias1 + col0 + bj * HALF + 4 * n);
#pragma unroll
        for (int ai = 0; ai < 2; ++ai)
#pragma unroll
            for (int m = 0; m < 4; ++m) { bf16_t* rowp = O + (size_t)(row0 + ai * HALF + m * 16) * 256 + col0;
#pragma unroll
                for (int bj = 0; bj < 2; ++bj) { f32x4 v0 = acc[ai][bj][m][0] + bv[bj][0], v1 = acc[ai][bj][m][1] + bv[bj][1];
#pragma unroll
                    for (int e = 0; e < 4; ++e) { v0[e] = gelu_tanh(v0[e]); v1[e] = gelu_tanh(v1[e]); }
                    u32x4 w; w.x = cvtpk(v0[0], v0[1]); w.y = cvtpk(v0[2], v0[3]); w.z = cvtpk(v1[0], v1[1]); w.w = cvtpk(v1[2], v1[3]);
                    *(u32x4*)(rowp + bj * HALF) = w; } }
    }
};
typedef __amdgpu_buffer_rsrc_t rsrc_t;
struct EpiMerge {
    static constexpr bool PERM = true;
    bf16_t* O;
    unsigned char* scr;
    __device__ __forceinline__ void operator()(const f32x4 (&acc)[2][2][4][2], const GUnit& u, int wr, int wc, int fr, int fq) const {
        EPI_OPAQUE();
        const int tid = (wr * 4 + wc) * 64 + fq * 16 + fr;
        const int sub = u.id;
        const rsrc_t rs = __builtin_amdgcn_make_buffer_rsrc(scr, 0, 524288, 0x00020000);
        if (sub < 4) {
#pragma unroll
            for (int ai = 0; ai < 2; ++ai)
#pragma unroll
                for (int bj = 0; bj < 2; ++bj)
#pragma unroll
                    for (int m = 0; m < 4; ++m)
#pragma unroll
                        for (int n = 0; n < 2; ++n) { const int q = ((ai * 2 + bj) * 4 + m) * 2 + n; const f32x4 v = acc[ai][bj][m][n];
                            u32x2 w; w.x = cvtpk(v[0], v[1]); w.y = cvtpk(v[2], v[3]);
                            __builtin_amdgcn_raw_buffer_store_b64(w, rs, tid * 8, (sub * 32 + q) * 4096, 0); }
            return;
        }
        const int j = sub - 4;
        const int row0 = u.pm * BM + wr * 64 + fr, col0 = u.pn * BM + 64 * j + wc * 16 + 4 * fq;
#pragma unroll
        for (int ai = 0; ai < 2; ++ai)
#pragma unroll
            for (int m = 0; m < 4; ++m) { bf16_t* rowp = O + (size_t)(row0 + ai * HALF + m * 16) * DM + col0;
                f32x4 t = {0.f, 0.f, 0.f, 0.f};
#pragma unroll
                for (int g = 0; g < 4; ++g) { const f32x4 gt = acc[ai][g >> 1][m][g & 1];
                    const int qb = (ai * 16 + m * 2);
                    const u32x2 s = (j == 0) ? __builtin_amdgcn_raw_buffer_load_b64(rs, tid * 8, (g * 32 + qb) * 4096, 0)
                                  : (j == 1) ? __builtin_amdgcn_raw_buffer_load_b64(rs, tid * 8, (g * 32 + qb + 1) * 4096, 0)
                                  : (j == 2) ? __builtin_amdgcn_raw_buffer_load_b64(rs, tid * 8, (g * 32 + qb + 8) * 4096, 0)
                                             : __builtin_amdgcn_raw_buffer_load_b64(rs, tid * 8, (g * 32 + qb + 9) * 4096, 0);
                    t[0] += sigmoid_f(gt[0]) * __uint_as_float(s.x << 16); t[1] += sigmoid_f(gt[1]) * __uint_as_float(s.x & 0xffff0000u);
                    t[2] += sigmoid_f(gt[2]) * __uint_as_float(s.y << 16); t[3] += sigmoid_f(gt[3]) * __uint_as_float(s.y & 0xffff0000u); }
                u32x2 w; w.x = cvtpk(t[0], t[1]); w.y = cvtpk(t[2], t[3]);
                *(u32x2*)rowp = w;
                asm volatile("" ::: "memory"); }
    }
};
__device__ __forceinline__ float dpp_ror1(float v) { return __uint_as_float((unsigned)__builtin_amdgcn_update_dpp(0, (int)__float_as_uint(v), 0x121, 0xf, 0xf, false)); }
__device__ __forceinline__ float dpp_ror2(float v) { return __uint_as_float((unsigned)__builtin_amdgcn_update_dpp(0, (int)__float_as_uint(v), 0x122, 0xf, 0xf, false)); }
struct EpiUpConv {
    static constexpr bool PERM = true;
    bf16_t* ACT; float* HB; const float* cw; const float* cb;
    __device__ __forceinline__ void operator()(const f32x4 (&acc)[2][2][4][2], const GUnit& u, int wr, int wc, int fr, int fq) const {
        EPI_OPAQUE();
        const int colL = wc * 32 + 8 * fq;
#pragma unroll
        for (int ai = 0; ai < 2; ++ai) {
            const int rowg = u.pm * BM + ai * HALF + wr * 64, g = rowg >> 6;
#pragma unroll
            for (int n = 0; n < 2; ++n) {
                const int cl = colL + 4 * n, c0 = u.pn * 128 + cl;
                f32x4 t1g, t2g, t1v, t2v;
#pragma unroll
                for (int e = 0; e < 4; ++e) { t1g[e] = 0.f; t2g[e] = 0.f; t1v[e] = 0.f; t2v[e] = 0.f; }
#pragma unroll
                for (int m = 0; m < 4; ++m) {
                    const f32x4 bg = *(const f32x4*)(cb + c0), w0g = *(const f32x4*)(cw + c0), w1g = *(const f32x4*)(cw + DFF2 + c0), w2g = *(const f32x4*)(cw + 2 * DFF2 + c0);
                    const f32x4 bv = *(const f32x4*)(cb + DFF + c0), w0v = *(const f32x4*)(cw + DFF + c0), w1v = *(const f32x4*)(cw + DFF2 + DFF + c0), w2v = *(const f32x4*)(cw + 2 * DFF2 + DFF + c0);
                    const f32x4 cg = acc[ai][0][m][n], cv = acc[ai][1][m][n];
                    f32x4 r1g, r2g, r1v, r2v, o;
#pragma unroll
                    for (int e = 0; e < 4; ++e) { r1g[e] = dpp_ror1(cg[e]); r2g[e] = dpp_ror2(cg[e]); r1v[e] = dpp_ror1(cv[e]); r2v[e] = dpp_ror2(cv[e]); }
#pragma unroll
                    for (int e = 0; e < 4; ++e) { const float p1g = (fr == 0) ? t1g[e] : r1g[e], p2g = (fr < 2) ? t2g[e] : r2g[e], p1v = (fr == 0) ? t1v[e] : r1v[e], p2v = (fr < 2) ? t2v[e] : r2v[e];
                        const float gt = bg[e] + w0g[e] * p2g + w1g[e] * p1g + w2g[e] * cg[e], vl = bv[e] + w0v[e] * p2v + w1v[e] * p1v + w2v[e] * cv[e];
                        o[e] = gt * sigmoid_f(gt) * vl; }
                    const int row = rowg + m * 16 + fr;
                    if (!(m == 0 && fr < 2)) { u32x2 w; w.x = cvtpk(o[0], o[1]); w.y = cvtpk(o[2], o[3]); *(u32x2*)(ACT + (size_t)row * DFF + c0) = w; }
                    if (m == 0 && fr < 2) { float* hp = HB + ((size_t)((g * 4 + fr) * 22 + u.pn) * 256 + cl); *(f32x4*)hp = cg; *(f32x4*)(hp + 128) = cv; }
                    if (m == 3 && fr >= 14) { float* hp = HB + ((size_t)((g * 4 + fr - 12) * 22 + u.pn) * 256 + cl); *(f32x4*)hp = cg; *(f32x4*)(hp + 128) = cv; }
                    t1g = r1g; t2g = r2g; t1v = r1v; t2v = r2v;
                    asm volatile("" ::: "memory");
                }
            }
        }
    }
};
}
#define XB_TMO      128
#define XB_XCNT(j)  (256  + 64 * (j))
#define XB_XSUB(j)  (1280 + 64 * (j))
#define XB_XGEN(j)  (2304 + 64 * (j))
#define XB_TOP      3328
#define XB_TOPGEN   3392
#define XCD_BAR_WORDS 3456
#define XB_SPIN_CAP (1u << 22)
__device__ __forceinline__ unsigned xb_ld(unsigned* p)              { return __hip_atomic_load(p, __ATOMIC_RELAXED, __HIP_MEMORY_SCOPE_AGENT); }
__device__ __forceinline__ unsigned xb_add(unsigned* p, unsigned v) { return __hip_atomic_fetch_add(p, v, __ATOMIC_RELAXED, __HIP_MEMORY_SCOPE_AGENT); }
__device__ __forceinline__ unsigned xb_xcc_id() { return (unsigned)__builtin_amdgcn_s_getreg((3 << 11) | 20) & 0xFu; }
#define XB_SPIN(cond, bar) do { unsigned _sp = 0; while (cond) { __builtin_amdgcn_s_sleep(1); \
    if ((++_sp & 255u) == 0u) { if (xb_ld(&(bar)[XB_TMO])) break; if (_sp > XB_SPIN_CAP) { atomicAdd(&(bar)[XB_TMO], 1u); break; } } } } while (0)
struct XcdBarrier { unsigned* bar; unsigned x; volatile LAS unsigned* st; };
__device__ __forceinline__ XcdBarrier xcd_barrier_post(unsigned* bar, volatile LAS unsigned* st) {
    XcdBarrier b; b.bar = bar; b.x = xb_xcc_id(); b.st = st;
    if (threadIdx.x == 0) (void)xb_add(&bar[XB_XCNT(b.x)], 1u);
    return b;
}
__device__ __forceinline__ void xcd_barrier_complete(unsigned* bar, unsigned x, unsigned& nloc, unsigned& nx) {
    const unsigned G = gridDim.x * gridDim.y * gridDim.z;
    unsigned sum, cnt, mine, sp = 0u;
    for (;;) {
        sum = 0u; cnt = 0u; mine = 0u;
#pragma unroll
        for (unsigned j = 0; j < 16; ++j) { const unsigned c = xb_ld(&bar[XB_XCNT(j)]); sum += c; cnt += (c > 0u) ? 1u : 0u; mine = (j == x) ? c : mine; }
        if (sum == G) break;
        __builtin_amdgcn_s_sleep(1);
        if ((++sp & 255u) == 0u) { if (xb_ld(&bar[XB_TMO])) break; if (sp > XB_SPIN_CAP) { atomicAdd(&bar[XB_TMO], 1u); break; } }
    }
    nloc = mine > 0u ? mine : 1u; nx = cnt > 0u ? cnt : 1u;
}
__device__ __forceinline__ void xcd_barrier(const XcdBarrier& b) {
    asm volatile("s_waitcnt vmcnt(0)" ::: "memory");
    __syncthreads();
    if (threadIdx.x == 0) {
        unsigned* bar = b.bar; unsigned bx = b.x;
        asm volatile("" : "+s"(bx));
        __builtin_amdgcn_s_waitcnt(0);
        unsigned nloc = b.st[0], nx = b.st[1];
        if (nloc == 0u) { xcd_barrier_complete(bar, bx, nloc, nx); b.st[0] = nloc; b.st[1] = nx; }
        const unsigned old = xb_add(&bar[XB_XSUB(bx)], 1u);
        const unsigned gen = old / nloc;
        if (old + 1u == (gen + 1u) * nloc) {
            __builtin_amdgcn_fence(__ATOMIC_RELEASE, "agent");
            asm volatile("s_waitcnt vmcnt(0)" ::: "memory");
            const unsigned og = xb_add(&bar[XB_TOP], 1u);
            const unsigned tg = og / nx;
            if (og + 1u == (tg + 1u) * nx) xb_add(&bar[XB_TOPGEN], 1u);
            else XB_SPIN(xb_ld(&bar[XB_TOPGEN]) == tg, bar);
            __builtin_amdgcn_fence(__ATOMIC_ACQUIRE, "agent");
            xb_add(&bar[XB_XGEN(bx)], 1u);
            asm volatile("s_waitcnt vmcnt(0)" ::: "memory");
        } else {
            XB_SPIN(xb_ld(&bar[XB_XGEN(bx)]) == gen, bar);
            __builtin_amdgcn_fence(__ATOMIC_ACQUIRE, "agent");
            asm volatile("s_waitcnt vmcnt(0)" ::: "memory");
        }
    }
    __syncthreads();
}

#define MFMA32(a, b, c) __builtin_amdgcn_mfma_f32_32x32x16_bf16(a, b, c, 0, 0, 0)
typedef short v4i16_t __attribute__((ext_vector_type(4)));
typedef LAS const char* lds_cptr;
typedef LAS char* lds_ptr;
__device__ __forceinline__ int crow(int r, int hi) { return (r & 3) + 8 * (r >> 2) + 4 * hi; }
__device__ __forceinline__ s16x4 vtr(lds_cptr p) { return __builtin_bit_cast(s16x4, __builtin_amdgcn_ds_read_tr16_b64_v4i16((LAS v4i16_t*)p)); }
__device__ __forceinline__ float other_half(float x, int hi) { auto rr = __builtin_amdgcn_permlane32_swap(__float_as_uint(x), __float_as_uint(x), false, false); return __uint_as_float(hi ? rr[0] : rr[1]); }
constexpr float NEG_INF = -INFINITY;

constexpr int TB_V = 12288, TB_KB = 20480, TB_SIZE = 20992;
struct Stg { u32x4 k, k2, v; float kb; };

template <int NKS> __device__ __forceinline__ void qk64(lds_cptr kbuf, const bf16x8* qf, int r32, int hi, f32x16& p0, f32x16& p1) {
    lds_cptr kp = kbuf + hi * 1024 + r32 * 16;
#pragma unroll
    for (int ks = 0; ks < NKS; ++ks) {
        const bf16x8 a0 = *(const LAS bf16x8*)(kp + ks * 2048), a1 = *(const LAS bf16x8*)(kp + ks * 2048 + 512);
        p0 = MFMA32(a0, qf[ks], p0); p1 = MFMA32(a1, qf[ks], p1);
    }
}
struct AState { f32x16 o0, o1; float m, l; };
__device__ __forceinline__ void astate_init(AState& s) {
#pragma unroll
    for (int r = 0; r < 16; ++r) { s.o0[r] = 0.f; s.o1[r] = 0.f; }
    s.m = NEG_INF; s.l = 0.f;
}
__device__ __forceinline__ void pv64(f32x16& o0, f32x16& o1, lds_cptr vp, const bf16x8 (&pf)[4]) {
#pragma unroll
    for (int ks = 0; ks < 4; ++ks) {
        const s16x4 l0 = vtr(vp + ks * 1024), h0 = vtr(vp + ks * 1024 + 512), l1 = vtr(vp + 4096 + ks * 1024), h1 = vtr(vp + 4096 + ks * 1024 + 512);
        const bf16x8 v0 = (bf16x8){l0[0], l0[1], l0[2], l0[3], h0[0], h0[1], h0[2], h0[3]}, v1 = (bf16x8){l1[0], l1[1], l1[2], l1[3], h1[0], h1[1], h1[2], h1[3]};
        o0 = MFMA32(v0, pf[ks], o0); o1 = MFMA32(v1, pf[ks], o1);
    }
}
__device__ __forceinline__ void pack_p(const f32x16& p0, const f32x16& p1, bf16x8 (&pf)[4]) {
    u32x4 w0, w1, w2, w3;
    w0.x = cvtpk(p0[0], p0[1]); w0.y = cvtpk(p0[2], p0[3]); w0.z = cvtpk(p0[4], p0[5]); w0.w = cvtpk(p0[6], p0[7]);
    w1.x = cvtpk(p0[8], p0[9]); w1.y = cvtpk(p0[10], p0[11]); w1.z = cvtpk(p0[12], p0[13]); w1.w = cvtpk(p0[14], p0[15]);
    w2.x = cvtpk(p1[0], p1[1]); w2.y = cvtpk(p1[2], p1[3]); w2.z = cvtpk(p1[4], p1[5]); w2.w = cvtpk(p1[6], p1[7]);
    w3.x = cvtpk(p1[8], p1[9]); w3.y = cvtpk(p1[10], p1[11]); w3.z = cvtpk(p1[12], p1[13]); w3.w = cvtpk(p1[14], p1[15]);
    pf[0] = __builtin_bit_cast(bf16x8, w0); pf[1] = __builtin_bit_cast(bf16x8, w1); pf[2] = __builtin_bit_cast(bf16x8, w2); pf[3] = __builtin_bit_cast(bf16x8, w3);
}
__device__ __forceinline__ void softmax_pv64(f32x16& p0, f32x16& p1, AState& s, lds_cptr vp, int hi) {
    float mx = fmaxf(p0[0], p1[0]);
#pragma unroll
    for (int r = 1; r < 16; ++r) mx = fmaxf(mx, fmaxf(p0[r], p1[r]));
    mx = fmaxf(mx, other_half(mx, hi));
    const float mn = fmaxf(s.m, mx), ms = (mn == NEG_INF) ? 0.f : mn;
    const float alpha = fast_exp2(s.m - ms);
    float rs = 0.f;
#pragma unroll
    for (int r = 0; r < 16; ++r) { p0[r] = fast_exp2(p0[r] - ms); p1[r] = fast_exp2(p1[r] - ms); rs += p0[r] + p1[r]; }
    rs += other_half(rs, hi);
    s.l = s.l * alpha + rs; s.m = mn;
#pragma unroll
    for (int r = 0; r < 16; ++r) { s.o0[r] *= alpha; s.o1[r] *= alpha; }
    bf16x8 pf[4]; pack_p(p0, p1, pf);
    pv64(s.o0, s.o1, vp, pf);
}
__device__ __forceinline__ void mask_causal(f32x16& p0, f32x16& p1, int kpos0, int tq, int hi) {
#pragma unroll
    for (int r = 0; r < 16; ++r) { const int kp = kpos0 + crow(r, hi); if (kp > tq) p0[r] = NEG_INF; if (kp + 32 > tq) p1[r] = NEG_INF; }
}
__device__ __forceinline__ void add_table(f32x16& p0, f32x16& p1, const LAS float* tb) {
#pragma unroll
    for (int r = 0; r < 16; ++r) { const int o = (r & 3) + 8 * (r >> 2); p0[r] += tb[o]; p1[r] += tb[o + 32]; }
}
__device__ __forceinline__ void store_o_bf16(bf16_t* orow, const f32x16& o0, const f32x16& o1, float sc, int hi) {
#pragma unroll
    for (int g = 0; g < 4; ++g) {
        u32x2 w0, w1; w0.x = cvtpk(o0[4 * g] * sc, o0[4 * g + 1] * sc); w0.y = cvtpk(o0[4 * g + 2] * sc, o0[4 * g + 3] * sc);
        w1.x = cvtpk(o1[4 * g] * sc, o1[4 * g + 1] * sc); w1.y = cvtpk(o1[4 * g + 2] * sc, o1[4 * g + 3] * sc);
        *(u32x2*)(orow + 8 * g + 4 * hi) = w0; *(u32x2*)(orow + 32 + 8 * g + 4 * hi) = w1;
    }
}
constexpr size_t MiB = 1u << 20, KiB = 1u << 10;
constexpr size_t WS_CTL = 0, CTL_ZERO_BYTES = 1 * MiB;
constexpr size_t WS_ROPE = 1 * MiB, WS_NSATAB = WS_ROPE + 512 * KiB, WS_DILTAB = WS_NSATAB + 32 * KiB, WS_CMPB = WS_DILTAB + 8 * KiB, WS_FARB = WS_CMPB + 4 * KiB;
constexpr size_t WS_WT = 4 * MiB, LW = 38 * MiB;
constexpr size_t LW_IN = 0, LW_G = 6 * MiB, LW_BR = 14 * MiB, LW_O = 16 * MiB, LW_UP = 18 * MiB, LW_DN = 29 * MiB, LW_UQ = 35 * MiB, LW_UKV = 35 * MiB + 256 * KiB, LW_PHI = 36 * MiB;
constexpr size_t BR_A = 0, BR_B = 512 * KiB, BR_C = 768 * KiB, BR_D = 1280 * KiB;
constexpr size_t WS_SIDE = 80 * MiB, WS_SSQQ = 84 * MiB, WS_SSQKV = 85 * MiB, WS_KB = 86 * MiB, WS_KROT = 87 * MiB, WS_KCMP = 91 * MiB, WS_VCMP = 100 * MiB,
                 WS_HID = 109 * MiB, WS_LF = 2 * MiB  , WS_CMPP = 3 * MiB  , WS_ORDER = 3 * MiB + 64 * KiB  , WS_KC = 113 * MiB, WS_VC = 113 * MiB + 512 * KiB, WS_DLSE = 114 * MiB, WS_DOG = 116 * MiB;
constexpr size_t WS_H = 164 * MiB, WS_OCAT = 292 * MiB, WS_QM = 404 * MiB, WS_KVM = 468 * MiB, WS_P = 532 * MiB;
constexpr size_t WS_MERGED = 532 * MiB, WS_MSCR = 660 * MiB, WS_Y = 164 * MiB  , WS_H2 = 756 * MiB, WS_ACT = 164 * MiB  , WS_HB = 532 * MiB  , WS_Y2 = 884 * MiB  , WS_END = 1024 * MiB;
constexpr size_t MSCR_PER_WG = 512 * KiB;
static_assert(WS_WT + 2 * LW <= WS_SIDE && WS_DOG + 48 * MiB <= WS_H && WS_P + 384 * MiB <= WS_END && WS_MSCR + 256 * MSCR_PER_WG <= WS_P + 384 * MiB && WS_H2 + 128 * MiB <= WS_Y2 && WS_Y2 + 128 * MiB <= WS_END, "ws map");
static_assert(WS_ACT + 352 * MiB <= WS_HB && WS_HB + 96 * MiB <= WS_H2 && WS_Y + 128 * MiB <= WS_OCAT, "ws overlays");
constexpr int CW_BAR = 4096;
constexpr int CW_Q = 16384;

constexpr int RING_BYTES = 131072, LDSCTL_OFF = RING_BYTES, MISC_OFF = LDSCTL_OFF + 320, LDS_BYTES = 147456;
constexpr int NSA_SLAB = 49152, NSA_SLAB_BYTES = 4 * 64 * 65 * 4, NSA_SEL = NSA_SLAB + NSA_SLAB_BYTES;
static_assert(NSA_SEL + 512 <= RING_BYTES && 4 * NSA_TL * 4 <= NSA_SLAB_BYTES && 2 * TB_SIZE <= NSA_SLAB, "NSA LDS map");

struct Frame {
    LAS unsigned char* lds; volatile LAS unsigned* MISC; gu32* ctl;
    int tid, lane, wave, G;
    const float* in[27]; float* out; unsigned char* ws;
};
#define WSP(T, off) ((T*)(F.ws + (off)))
#define VM_WAIT() asm volatile("s_waitcnt vmcnt(0)" ::: "memory")
#define LDS_WAIT() asm volatile("s_waitcnt lgkmcnt(0)" ::: "memory")

__device__ __forceinline__ int queue_grab(Frame& F, gu32* ctr) {
    if (F.tid == 0) F.MISC[0] = __hip_atomic_fetch_add(ctr, 1u, __ATOMIC_RELAXED, __HIP_MEMORY_SCOPE_AGENT);
    __syncthreads();
    const int v = (int)F.MISC[0];
    __syncthreads();
    return v;
}

template <bool FOX> __device__ __forceinline__ void causal_unit(Frame& F, int b, int h, int qb) {
    constexpr int NKS = FOX ? 4 : 6;
    int lane_o = F.lane; asm volatile("" : "+v"(lane_o));
    const int wid = F.wave, lane = lane_o, r32 = lane & 31, hi = lane >> 5;
    const size_t rowbase = (size_t)b * SEQ;
    const int q0 = qb * 256, tq = q0 + wid * 32 + r32, NT = qb * 4 + 4;
    const bf16_t* P = WSP(const bf16_t, WS_P);
    const bf16_t *Kb, *Vb, *Qrow; int kpitch, vpitch;
    const bf16_t* Kr = WSP(const bf16_t, WS_KROT) + rowbase * 32;
    const float* kbsrc = WSP(const float, WS_KB) + (size_t)(b * 4 + h) * SEQ;
    if (FOX) { Kb = P + rowbase * PW + PC_CK + h * 64; Vb = P + rowbase * PW + PC_CV + h * 64; kpitch = PW; vpitch = PW; Qrow = P + (rowbase + tq) * PW + PC_CQ + h * 64; }
    else { const bf16_t* KV = WSP(const bf16_t, WS_KVM) + rowbase * 512 + h * 128; Kb = KV; Vb = KV + 64; kpitch = 512; vpitch = 512; Qrow = WSP(const bf16_t, WS_QM) + (rowbase + tq) * 512 + h * 96; }
    bf16x8 qf[NKS];
#pragma unroll
    for (int ks = 0; ks < NKS; ++ks) qf[ks] = *(const bf16x8*)(Qrow + ks * 16 + hi * 8);
    AState st; astate_init(st);
    lds_ptr lds = (lds_ptr)F.lds;
    const int vpo = ((lane >> 4) & 1) * 32 + (lane & 3) * 8 + (4 * hi + ((lane & 15) >> 2)) * 64;
    Stg s;
#define CU_LOAD(t) do { s.k = *(const u32x4*)(Kb + (size_t)((t) * 64 + lane) * kpitch + wid * 8); \
        if (!FOX) { if (wid < 4) s.k2 = *(const u32x4*)(Kr + (size_t)((t) * 64 + lane) * 32 + wid * 8); } \
        s.v = *(const u32x4*)(Vb + (size_t)((t) * 64 + 16 * (wid & 3) + (lane >> 2)) * vpitch + (wid >> 2) * 32 + (lane & 3) * 8); \
        if (FOX) { if (wid == 0) s.kb = kbsrc[(t) * 64 + lane]; } } while (0)
#define CU_WRITE(bi) do { lds_ptr bp = lds + (bi) * TB_SIZE; *(LAS u32x4*)(bp + wid * 1024 + lane * 16) = s.k; \
        if (!FOX) { if (wid < 4) *(LAS u32x4*)(bp + (8 + wid) * 1024 + lane * 16) = s.k2; } \
        *(LAS u32x4*)(bp + TB_V + wid * 1024 + lane * 16) = s.v; \
        if (FOX) { if (wid == 0) *(LAS float*)(bp + TB_KB + lane * 4) = s.kb; } } while (0)
    CU_LOAD(0); CU_WRITE(0);
    __syncthreads();
    const int tq_lo = q0 + wid * 32;
    for (int t = 0; t < NT; ++t) {
        const int bi = t & 1;
        if (t + 1 < NT) CU_LOAD(t + 1);
        if (64 * t <= tq_lo + 31) {
            lds_cptr bp = (lds_cptr)(lds + bi * TB_SIZE);
            f32x16 p0, p1;
#pragma unroll
            for (int r = 0; r < 16; ++r) { p0[r] = 0.f; p1[r] = 0.f; }
            qk64<NKS>(bp, qf, r32, hi, p0, p1);
            if (FOX) {
                const LAS float* kbt = (const LAS float*)(bp + TB_KB) + 4 * hi;
#pragma unroll
                for (int g = 0; g < 4; ++g) { const f32x4 a = *(const LAS f32x4*)(kbt + 8 * g), c = *(const LAS f32x4*)(kbt + 32 + 8 * g);
#pragma unroll
                    for (int e = 0; e < 4; ++e) { p0[4 * g + e] += a[e]; p1[4 * g + e] += c[e]; } }
            }
            if (64 * t + 63 > tq_lo) mask_causal(p0, p1, 64 * t, tq, hi);
            softmax_pv64(p0, p1, st, bp + TB_V + vpo, hi);
        }
        if (t + 1 < NT) CU_WRITE(bi ^ 1);
        __syncthreads();
    }
#undef CU_LOAD
#undef CU_WRITE
    bf16_t* orow = WSP(bf16_t, WS_OCAT) + (rowbase + tq) * OCW + (FOX ? 384 : 640) + h * 64;
    store_o_bf16(orow, st.o0, st.o1, 1.0f / st.l, hi);
}
__device__ __forceinline__ void nsa_unit(Frame& F, int b, int qblk) {
    int lane_o = F.lane; asm volatile("" : "+v"(lane_o));
    const int wid = F.wave, lane = lane_o, r32 = lane & 31, hi = lane >> 5, tid = wid * 64 + lane;
    const int h = wid & 3, qs = wid >> 2;
    const int q0 = qblk * 64, cur = qblk, tq = q0 + 32 * qs + r32, tq_lo = q0 + 32 * qs;
    const size_t rowbase = (size_t)b * SEQ, row = rowbase + tq;
    const bf16_t* P = WSP(const bf16_t, WS_P);
    lds_ptr lds = (lds_ptr)F.lds;
    const int vpo = ((lane >> 4) & 1) * 32 + (lane & 3) * 8 + (4 * hi + ((lane & 15) >> 2)) * 64;
    bf16x8 qf[4];
    { const bf16_t* Qrow = P + row * PW + PC_AQ + h * 64;
#pragma unroll
      for (int ks = 0; ks < 4; ++ks) qf[ks] = *(const bf16x8*)(Qrow + ks * 16 + hi * 8); }
    Stg s; int ln;
#define NS_LOAD(Kb, kp, Vb, vp_, t) do { s.k = *(const u32x4*)((Kb) + (size_t)((t) * 64 + ln) * (kp) + wid * 8); \
        s.v = *(const u32x4*)((Vb) + (size_t)((t) * 64 + 16 * (wid & 3) + (ln >> 2)) * (vp_) + (wid >> 2) * 32 + (ln & 3) * 8); } while (0)
#define NS_FRESH() do { ln = lane; asm volatile("" : "+v"(ln)); } while (0)
#define NS_WRITE(bi) do { lds_ptr bp_ = lds + (bi) * TB_SIZE; *(LAS u32x4*)(bp_ + wid * 1024 + lane * 16) = s.k; *(LAS u32x4*)(bp_ + TB_V + wid * 1024 + lane * 16) = s.v; } while (0)
    const bf16_t* KC = WSP(const bf16_t, WS_KC) + (size_t)b * 256 * 64; const bf16_t* VC = WSP(const bf16_t, WS_VC) + (size_t)b * 256 * 64;
    const int cmax_u = (q0 + 63 - 31) >> 4, NTc = (cmax_u >> 6) + 1;
    const int cmax = (tq - 31) >> 4;
    float cm = NEG_INF, cl = 0.f;
    NS_FRESH(); NS_LOAD(KC, 64, VC, 64, 0); NS_WRITE(0);
    __syncthreads();
    for (int t = 0; t < NTc; ++t) {
        const int bi = t & 1;
        if (t + 1 < NTc) NS_LOAD(KC, 64, VC, 64, t + 1);
        { lds_cptr bp = (lds_cptr)(lds + bi * TB_SIZE); f32x16 p0, p1;
#pragma unroll
          for (int r = 0; r < 16; ++r) { p0[r] = 0.f; p1[r] = 0.f; }
          qk64<4>(bp, qf, r32, hi, p0, p1);
          float mx = NEG_INF;
#pragma unroll
          for (int r = 0; r < 16; ++r) { const int c = 64 * t + crow(r, hi); if (c > cmax) p0[r] = NEG_INF; if (c + 32 > cmax) p1[r] = NEG_INF; mx = fmaxf(mx, fmaxf(p0[r], p1[r])); }
          mx = fmaxf(mx, other_half(mx, hi));
          const float mn = fmaxf(cm, mx), ms = (mn == NEG_INF) ? 0.f : mn; float rs = 0.f;
#pragma unroll
          for (int r = 0; r < 16; ++r) rs += fast_exp2(p0[r] - ms) + fast_exp2(p1[r] - ms);
          rs += other_half(rs, hi);
          cl = cl * fast_exp2(cm - ms) + rs; cm = mn; }
        if (t + 1 < NTc) NS_WRITE(bi ^ 1);
        __syncthreads();
    }
    const float cms = (cm == NEG_INF) ? 0.f : cm, cinv = 1.0f / fmaxf(cl, 1e-30f);
    f32x16 oc0, oc1;
#pragma unroll
    for (int r = 0; r < 16; ++r) { oc0[r] = 0.f; oc1[r] = 0.f; }
    float G[32]; float carry = 0.f;
#pragma unroll
    for (int i = 0; i < 32; ++i) G[i] = 0.f;
    NS_FRESH(); NS_LOAD(KC, 64, VC, 64, 0); NS_WRITE(0);
    __syncthreads();
#pragma unroll
    for (int t = 0; t < 4; ++t) {
        if (t < NTc) {
            const int bi = t & 1;
            if (t + 1 < NTc) NS_LOAD(KC, 64, VC, 64, t + 1);
            { lds_cptr bp = (lds_cptr)(lds + bi * TB_SIZE); f32x16 p0, p1;
#pragma unroll
              for (int r = 0; r < 16; ++r) { p0[r] = 0.f; p1[r] = 0.f; }
              qk64<4>(bp, qf, r32, hi, p0, p1);
#pragma unroll
              for (int r = 0; r < 16; ++r) { const int c = 64 * t + crow(r, hi);
                  p0[r] = (c > cmax) ? 0.f : fast_exp2(p0[r] - cms) * cinv; p1[r] = (c + 32 > cmax) ? 0.f : fast_exp2(p1[r] - cms) * cinv; }
#pragma unroll
              for (int g = 0; g < 4; ++g) { const float oth = other_half(p0[4 * g + 3], hi);
                  G[t * 8 + g] = ((p0[4 * g] + p0[4 * g + 1]) + (p0[4 * g + 2] + p0[4 * g + 3])) + (hi ? oth : carry); carry = oth; }
#pragma unroll
              for (int g = 0; g < 4; ++g) { const float oth = other_half(p1[4 * g + 3], hi);
                  G[t * 8 + 4 + g] = ((p1[4 * g] + p1[4 * g + 1]) + (p1[4 * g + 2] + p1[4 * g + 3])) + (hi ? oth : carry); carry = oth; }
              bf16x8 pf[4]; pack_p(p0, p1, pf);
              pv64(oc0, oc1, bp + TB_V + vpo, pf); }
            if (t + 1 < NTc) NS_WRITE(bi ^ 1);
            __syncthreads();
        }
    }
    { LAS float* slab = (LAS float*)(lds + NSA_SLAB) + (size_t)(h * 64 + 32 * qs + r32) * 65;
#pragma unroll
      for (int i = 0; i < 32; ++i) slab[2 * i + hi] = G[i]; }
    __syncthreads();
    { const int q = tid >> 3, jg = tid & 7;
      const LAS float* s0 = (const LAS float*)(lds + NSA_SLAB) + (size_t)q * 65;
      float v[64];
#pragma unroll
      for (int k = 0; k < 64; ++k) { const float x = (s0[k] + s0[64 * 65 + k]) + (s0[2 * 64 * 65 + k] + s0[3 * 64 * 65 + k]);
          v[k] = (k == 0 || k == cur || k == cur - 1) ? 1e9f : ((k > cur) ? -1e9f : x); if ((k & 7) == 7) asm volatile("" ::: "memory"); }
      unsigned bits = 0u;
#pragma unroll
      for (int e = 0; e < 8; ++e) { const int j = 8 * jg + e;
          const float xj = (s0[j] + s0[64 * 65 + j]) + (s0[2 * 64 * 65 + j] + s0[3 * 64 * 65 + j]);
          const float vj = (j == 0 || j == cur || j == cur - 1) ? 1e9f : ((j > cur) ? -1e9f : xj);
          int rank = 0;
#pragma unroll
          for (int k = 0; k < 64; ++k) rank += (v[k] > vj || (v[k] == vj && k < j)) ? 1 : 0;
          bits |= (rank < 16 ? 1u : 0u) << e; }
      *((LAS unsigned char*)(lds + NSA_SEL) + q * 8 + jg) = (unsigned char)bits; }
    __syncthreads();
    const unsigned mlo = *(const LAS unsigned*)(lds + NSA_SEL + (32 * qs + r32) * 8), mhi = *(const LAS unsigned*)(lds + NSA_SEL + (32 * qs + r32) * 8 + 4);
    { const u32x4* src = WSP(const u32x4, WS_NSATAB); LAS u32x4* dst = (LAS u32x4*)(lds + NSA_SLAB);
      for (int i = tid; i < 4 * NSA_TL / 4; i += 512) dst[i] = src[i]; }
    const LAS float* tabh = (const LAS float*)(lds + NSA_SLAB) + h * NSA_TL;
    const float farb = WSP(const float, WS_FARB)[h];
    float g0, g1, g2;
    { int tq_ = tq; asm volatile("" : "+v"(tq_)); const float* sd = WSP(const float, WS_SIDE) + (rowbase + tq_) * 16 + h * 3; g0 = sigmoid_f(sd[0]); g1 = sigmoid_f(sd[1]); g2 = sigmoid_f(sd[2]); }
    AState st; astate_init(st);
    { const bf16_t* Kb = P + rowbase * PW + PC_KSLC; const bf16_t* Vb = P + rowbase * PW + PC_VSLC;
      NS_FRESH(); NS_LOAD(Kb, PW, Vb, PW, 0); NS_WRITE(0);
      __syncthreads();
      for (int j = 0; j <= cur; ++j) {
          const int bi = j & 1;
          if (j < cur) NS_LOAD(Kb, PW, Vb, PW, j + 1);
          const bool mine = ((j < 32) ? (mlo >> j) : (mhi >> (j - 32))) & 1u;
          if (__any(mine)) {
              lds_cptr bp = (lds_cptr)(lds + bi * TB_SIZE); f32x16 p0, p1;
#pragma unroll
              for (int r = 0; r < 16; ++r) { p0[r] = 0.f; p1[r] = 0.f; }
              qk64<4>(bp, qf, r32, hi, p0, p1);
              if (q0 - 64 * j - 63 >= NSA_DFAR) {
#pragma unroll
                  for (int r = 0; r < 16; ++r) { p0[r] += farb; p1[r] += farb; }
              } else add_table(p0, p1, tabh + (NSA_DMAX - tq + 64 * j + 4 * hi));
              if (j == cur) mask_causal(p0, p1, 64 * j, tq, hi);
              if (!mine) {
#pragma unroll
                  for (int r = 0; r < 16; ++r) { p0[r] = NEG_INF; p1[r] = NEG_INF; } }
              softmax_pv64(p0, p1, st, bp + TB_V + vpo, hi);
          }
          if (j < cur) NS_WRITE(bi ^ 1);
          __syncthreads();
      } }
    f32x16 oa0, oa1;
    { const float sc = g1 / st.l;
#pragma unroll
      for (int r = 0; r < 16; ++r) { oa0[r] = g0 * oc0[r] + sc * st.o0[r]; oa1[r] = g0 * oc1[r] + sc * st.o1[r]; } }
    astate_init(st);
    { const bf16_t* Kb = P + rowbase * PW + PC_KWIN; const bf16_t* Vb = P + rowbase * PW + PC_VWIN;
      const int jlo = cur >= 8 ? cur - 8 : 0;
      NS_FRESH(); NS_LOAD(Kb, PW, Vb, PW, jlo); NS_WRITE(0);
      __syncthreads();
      for (int j = jlo; j <= cur; ++j) {
          const int bi = (j - jlo) & 1;
          if (j < cur) NS_LOAD(Kb, PW, Vb, PW, j + 1);
          if (tq_lo - 64 * j - 63 < 512) {
              lds_cptr bp = (lds_cptr)(lds + bi * TB_SIZE); f32x16 p0, p1;
#pragma unroll
              for (int r = 0; r < 16; ++r) { p0[r] = 0.f; p1[r] = 0.f; }
              qk64<4>(bp, qf, r32, hi, p0, p1);
              add_table(p0, p1, tabh + (NSA_DMAX - tq + 64 * j + 4 * hi));
              if (!(tq_lo - 64 * j - 63 >= 0 && tq_lo + 31 - 64 * j < 512)) {
                  const int d0 = tq - 64 * j - 4 * hi;
#pragma unroll
                  for (int r = 0; r < 16; ++r) { const int d = d0 - ((r & 3) + 8 * (r >> 2)); if (d < 0 || d >= 512) p0[r] = NEG_INF; if (d - 32 < 0 || d - 32 >= 512) p1[r] = NEG_INF; }
              }
              softmax_pv64(p0, p1, st, bp + TB_V + vpo, hi);
          }
          if (j < cur) NS_WRITE(bi ^ 1);
          __syncthreads();
      } }
    { const float sc = g2 / st.l;
#pragma unroll
      for (int r = 0; r < 16; ++r) { oa0[r] += sc * st.o0[r]; oa1[r] += sc * st.o1[r]; } }
    { int tq_ = tq; asm volatile("" : "+v"(tq_)); store_o_bf16(WSP(bf16_t, WS_OCAT) + (rowbase + tq_) * OCW + h * 64, oa0, oa1, 1.0f, hi); }
#undef NS_LOAD
#undef NS_FRESH
#undef NS_WRITE
}
__device__ __forceinline__ void dil_unit(Frame& F, int b, int hh, int span) {
    int lane_o = F.lane; asm volatile("" : "+v"(lane_o));
    const int wid = F.wave, lane = lane_o, r32 = lane & 31, hi = lane >> 5, tid = wid * 64 + lane;
    const int T0 = span * 512;
    const size_t rowbase = (size_t)b * SEQ;
    const bf16_t* P = WSP(const bf16_t, WS_P) + rowbase * PW;
    lds_ptr lds = (lds_ptr)F.lds;
    LAS float* dtab = (LAS float*)(lds + 32768);
    for (int i = tid; i < 3 * 192; i += 512) dtab[i] = WSP(const float, WS_DILTAB)[((i / 192) * 2 + hh) * 192 + (i % 192)];
    __syncthreads();
    lds_ptr vst = lds + wid * 4096;
    const int vpo = ((lane >> 4) & 1) * 32 + (lane & 3) * 8 + (4 * hi + ((lane & 15) >> 2)) * 64;
    bf16_t* DOG = WSP(bf16_t, WS_DOG); float* DLSE = WSP(float, WS_DLSE);
    for (int g = 0; g < 3; ++g) {
        const int sh = 2 * g, head = 2 * g + hh;
        for (int rep = 0; rep < 2; ++rep) {
            const int wt = wid + 8 * rep;
            const int res = (g == 0) ? 0 : (g == 1 ? (wt & 3) : wt);
            const int i0 = (g == 0) ? 32 * wt : (g == 1 ? 32 * (wt >> 2) : 0);
            const int n0 = (T0 >> sh) + i0;
            const int tokq = res + ((n0 + r32) << sh);
            bf16x8 qf[4];
            { const bf16_t* Qrow = P + (size_t)tokq * PW + PC_BQ + head * 64;
#pragma unroll
              for (int ks = 0; ks < 4; ++ks) qf[ks] = *(const bf16x8*)(Qrow + ks * 16 + hi * 8); }
            f32x16 o0, o1; float m = NEG_INF, l = 0.f;
#pragma unroll
            for (int r = 0; r < 16; ++r) { o0[r] = 0.f; o1[r] = 0.f; }
            for (int c = 0; c < 5; ++c) {
                const int nk0 = n0 - 128 + 32 * c;
                if (nk0 + 31 < 0) continue;
                { int nk = nk0 + r32; nk = nk < 0 ? 0 : nk; const bf16_t* Krow = P + (size_t)(res + (nk << sh)) * PW + PC_BK + head * 64;
                  bf16x8 kf[4];
#pragma unroll
                  for (int ks = 0; ks < 4; ++ks) kf[ks] = *(const bf16x8*)(Krow + ks * 16 + hi * 8);
                  u32x4 vr[4];
#pragma unroll
                  for (int i = 0; i < 4; ++i) { const int pc = lane + 64 * i, vrow = pc >> 3, c16 = pc & 7; int nv = nk0 + vrow; nv = nv < 0 ? 0 : nv;
                      vr[i] = *(const u32x4*)(P + (size_t)(res + (nv << sh)) * PW + PC_BV + head * 64 + c16 * 8); }
#pragma unroll
                  for (int i = 0; i < 4; ++i) { const int pc = lane + 64 * i, vrow = pc >> 3, c16 = pc & 7;
                      *(LAS u32x4*)(vst + (c16 >> 2) * 2048 + vrow * 64 + (c16 & 3) * 16) = vr[i]; }
                  asm volatile("s_waitcnt lgkmcnt(0)" ::: "memory");
                  f32x16 p;
#pragma unroll
                  for (int r = 0; r < 16; ++r) p[r] = 0.f;
#pragma unroll
                  for (int ks = 0; ks < 4; ++ks) p = MFMA32(kf[ks], qf[ks], p);
                  const LAS float* tb = dtab + g * 192 + (32 - r32 + 4 * hi + 32 * c);
                  float mx = NEG_INF;
#pragma unroll
                  for (int r = 0; r < 16; ++r) { const int o = (r & 3) + 8 * (r >> 2), kk = o + 4 * hi, j = 128 + r32 - 32 * c - kk;
                      const bool ok = (j >= 0) && (j <= 128) && (nk0 + kk >= 0);
                      p[r] = ok ? p[r] + tb[o] : NEG_INF; mx = fmaxf(mx, p[r]); }
                  mx = fmaxf(mx, other_half(mx, hi));
                  const float mn = fmaxf(m, mx), ms = (mn == NEG_INF) ? 0.f : mn, alpha = fast_exp2(m - ms);
                  float rs = 0.f;
#pragma unroll
                  for (int r = 0; r < 16; ++r) { p[r] = fast_exp2(p[r] - ms); rs += p[r]; }
                  rs += other_half(rs, hi);
                  l = l * alpha + rs; m = mn;
#pragma unroll
                  for (int r = 0; r < 16; ++r) { o0[r] *= alpha; o1[r] *= alpha; }
                  u32x4 w0, w1;
                  w0.x = cvtpk(p[0], p[1]); w0.y = cvtpk(p[2], p[3]); w0.z = cvtpk(p[4], p[5]); w0.w = cvtpk(p[6], p[7]);
                  w1.x = cvtpk(p[8], p[9]); w1.y = cvtpk(p[10], p[11]); w1.z = cvtpk(p[12], p[13]); w1.w = cvtpk(p[14], p[15]);
                  const bf16x8 pf0 = __builtin_bit_cast(bf16x8, w0), pf1 = __builtin_bit_cast(bf16x8, w1);
                  lds_cptr vp = (lds_cptr)(vst + vpo);
#pragma unroll
                  for (int ks = 0; ks < 2; ++ks) {
                      const s16x4 l0 = vtr(vp + ks * 1024), h0 = vtr(vp + ks * 1024 + 512), l1 = vtr(vp + 2048 + ks * 1024), h1 = vtr(vp + 2048 + ks * 1024 + 512);
                      const bf16x8 v0 = (bf16x8){l0[0], l0[1], l0[2], l0[3], h0[0], h0[1], h0[2], h0[3]}, v1 = (bf16x8){l1[0], l1[1], l1[2], l1[3], h1[0], h1[1], h1[2], h1[3]};
                      o0 = MFMA32(v0, ks == 0 ? pf0 : pf1, o0); o1 = MFMA32(v1, ks == 0 ? pf0 : pf1, o1);
                  }
                  asm volatile("s_waitcnt lgkmcnt(0)" ::: "memory"); }
            }
            const size_t orow = rowbase + tokq;
            store_o_bf16(DOG + ((size_t)g * M + orow) * 128 + hh * 64, o0, o1, 1.0f / l, hi);
            if (hi == 0) DLSE[((size_t)g * M + orow) * 2 + hh] = m + log2f(l);
        }
    }
    VM_WAIT();
    __syncthreads();
    bf16_t* OC = WSP(bf16_t, WS_OCAT);
    for (int it = 0; it < 8; ++it) {
        const int item = tid + 512 * it, tl = item >> 3, pc = item & 7; const size_t orow = rowbase + T0 + tl;
        const float l0 = DLSE[((size_t)0 * M + orow) * 2 + hh], l1 = DLSE[((size_t)1 * M + orow) * 2 + hh], l2 = DLSE[((size_t)2 * M + orow) * 2 + hh];
        const float mx = fmaxf(l0, fmaxf(l1, l2)); float w0 = fast_exp2(l0 - mx), w1 = fast_exp2(l1 - mx), w2 = fast_exp2(l2 - mx);
        const float inv = 1.0f / (w0 + w1 + w2); w0 *= inv; w1 *= inv; w2 *= inv;
        const u32x4 a = *(const u32x4*)(DOG + ((size_t)0 * M + orow) * 128 + hh * 64 + pc * 8), bb = *(const u32x4*)(DOG + ((size_t)1 * M + orow) * 128 + hh * 64 + pc * 8),
                    cc = *(const u32x4*)(DOG + ((size_t)2 * M + orow) * 128 + hh * 64 + pc * 8);
        u32x4 w;
#pragma unroll
        for (int e = 0; e < 4; ++e) {
            const float lo = w0 * __uint_as_float(a[e] << 16) + w1 * __uint_as_float(bb[e] << 16) + w2 * __uint_as_float(cc[e] << 16);
            const float hv = w0 * __uint_as_float(a[e] & 0xffff0000u) + w1 * __uint_as_float(bb[e] & 0xffff0000u) + w2 * __uint_as_float(cc[e] & 0xffff0000u);
            w[e] = cvtpk(lo, hv); }
        *(u32x4*)(OC + orow * OCW + 256 + hh * 64 + pc * 8) = w;
    }
    __syncthreads();
}
__device__ __forceinline__ float wave_sum(float v) {
    v += xor_lane_lt32<1>(v); v += xor_lane_lt32<2>(v); v += xor_lane_lt32<4>(v); v += xor_lane_lt32<8>(v); v += xor_lane_lt32<16>(v);
    return sum_halves(v);
}
__device__ __forceinline__ int rel_bucket(int dist) {
    if (dist < 0) dist = 0;
    if (dist < 16) return dist;
    const int thr[15] = {22, 30, 40, 54, 73, 99, 134, 182, 246, 332, 450, 609, 825, 1117, 1513};
    int bkt = 16;
#pragma unroll
    for (int i = 0; i < 15; ++i) bkt += (dist >= thr[i]) ? 1 : 0;
    return bkt;
}
__device__ __forceinline__ int inproj_src(int c, float& sc) {
    sc = 1.f;
    if (c < 256) { sc = C2A; return c; }
    if (c < 652) return c;
    if (c < 656) return 2572 + (c - 652);
    if (c < 672) return -1;
    if (c < 704) { const int p = c - 672; return 2960 + (p >> 1) + 16 * (p & 1); }
    if (c < 768) return -1;
    if (c < 1920) { const int r = c - 768; if (r < 384) sc = C2A; return 652 + r; }
    if (c < 2048) return 2832 + (c - 1920);
    if (c < 2816) { const int r = c - 2048; if (r < 256) sc = C2A; return 1804 + r; }
    return 2576 + (c - 2816);
}
__device__ __forceinline__ int quq_src(int r, float& sc) {
    sc = C2D;
    if (r >= 384) return -1;
    const int hd = r / 96, w = r % 96;
    if (w < 64) return hd * 96 + w;
    const int p = w - 64; return hd * 96 + 64 + (p >> 1) + 16 * (p & 1);
}
__device__ __forceinline__ int gateperm_src(int r) {
    const int T = r >> 8, c = r & 255, pn = T >> 2, j = T & 3, bj = c >> 7, wc = (c >> 5) & 3, fq = (c >> 3) & 3, n = (c >> 2) & 1, e = c & 3;
    return (2 * bj + n) * DM * DM + 256 * pn + 64 * j + 16 * wc + 4 * fq + e;
}
__device__ __forceinline__ int branchperm_src(int r) {
    const int pn = r >> 8, c = r & 255, bj = c >> 7, wc = (c >> 5) & 3, fq = (c >> 3) & 3, n = (c >> 2) & 1, e = c & 3;
    return 256 * pn + 64 * (2 * bj + n) + 16 * wc + 4 * fq + e;
}
__device__ __forceinline__ int upperm_src(int r) { const int pn = r >> 8, c = r & 255; return (c & 128) ? DFF + 128 * pn + (c & 127) : 128 * pn + c; }
__device__ __forceinline__ void wconv_item(const float* W, int Nsrc, bf16_t* WT, int ldt, const float* kgain, int kind, LAS float* scr, int item, int nblk, int lane) {
    const int kb = item / nblk, nb = item % nblk, k0 = 64 * kb, n0 = 32 * nb;
    const int n = n0 + (lane & 31); float sc = 1.f; int src = n;
    if (kind == 1) src = inproj_src(n, sc); else if (kind == 2) src = quq_src(n, sc); else if (kind == 3) src = gateperm_src(n); else if (kind == 4) src = branchperm_src(n); else if (kind == 5) src = upperm_src(n);
#pragma unroll 8
    for (int i = 0; i < 32; ++i) { const int kk = 2 * i + (lane >> 5); float v = (src >= 0) ? W[(size_t)(k0 + kk) * Nsrc + src] * sc : 0.f; if (kgain) v *= kgain[k0 + kk]; scr[kk * 33 + (lane & 31)] = v; }
    LDS_WAIT(); asm volatile("" ::: "memory");
    const int c = lane & 7;
#pragma unroll
    for (int j = 0; j < 4; ++j) { const int nn = (lane >> 3) + 8 * j; const LAS float* s = scr + (8 * c) * 33 + nn;
        u32x4 o; o.x = pk2(s[0 * 33], s[1 * 33]); o.y = pk2(s[2 * 33], s[3 * 33]); o.z = pk2(s[4 * 33], s[5 * 33]); o.w = pk2(s[6 * 33], s[7 * 33]);
        *(u32x4*)(WT + (size_t)(n0 + nn) * ldt + k0 + 8 * c) = o; }
    LDS_WAIT(); asm volatile("" ::: "memory");
}
constexpr int ATT_UNITS = 3328;
__device__ __forceinline__ int att_cost(int id) {
    if (id < 2048) { const int qb = 15 - (id >> 7), mla = (id >> 6) & 1; return (mla ? 5 : 4) * (qb + 1); }
    if (id < 3072) return (63 - ((id - 2048) >> 4)) + 20;
    return 30;
}
__device__ __forceinline__ int clampi(int x, int lo, int hi) { return x < lo ? lo : (x > hi ? hi : x); }
__device__ __forceinline__ int att_rank(int i) {
    const int c = att_cost(i);
    int r = clampi(16 - c / 4, 0, 16) * 64 + clampi(16 - c / 5, 0, 16) * 64 + clampi(83 - c, 0, 64) * 16 + (c < 30 ? 256 : 0);
    if (c % 4 == 0 && c / 4 >= 1 && c / 4 <= 16) r += clampi(i - (16 - c / 4) * 128, 0, 64);
    if (c % 5 == 0 && c / 5 >= 1 && c / 5 <= 16) r += clampi(i - ((16 - c / 5) * 128 + 64), 0, 64);
    if (c >= 20 && c <= 83) r += clampi(i - (2048 + (63 - (c - 20)) * 16), 0, 16);
    if (c == 30) r += clampi(i - 3072, 0, 256);
    return r;
}
__device__ __forceinline__ void p0_prologue(Frame& F) {
    LAS float* scr = (LAS float*)(F.lds + F.wave * 16384);
    const int gw = blockIdx.x * 8 + F.wave, NGW = F.G * 8, lane = F.lane;
    constexpr int I_IN = 16 * 96, I_G = 16 * 32, I_BA = 4 * 32, I_BB = 2 * 32, I_O = 16 * 32, I_UP = 16 * 176, I_DN = 44 * 32, I_UQ = 4 * 16, I_UKV = 2 * 16, I_PHI = 32 * 4;
    constexpr int I_L = I_IN + 4 * I_G + 3 * I_BA + I_BB + I_O + I_UP + I_DN + I_UQ + I_UKV + 2 * I_PHI;
    for (int it = gw; it < DEPTH * I_L; it += NGW) {
        const int l = it / I_L; int r = it % I_L;
        unsigned char* wl = F.ws + WS_WT + (size_t)l * LW;
        if (r < I_IN) { wconv_item(F.in[6] + (size_t)l * DM * DIN, DIN, (bf16_t*)(wl + LW_IN), DM, nullptr, 1, scr, r, 96, lane); continue; } r -= I_IN;
        if (r < 4 * I_G) { wconv_item(F.in[21] + (size_t)l * 4 * DM * DM, DM, (bf16_t*)(wl + LW_G), DM, nullptr, 3, scr, r, 128, lane); continue; } r -= 4 * I_G;
        if (r < I_BA) { wconv_item(F.in[17] + (size_t)l * 256 * DM, DM, (bf16_t*)(wl + LW_BR + BR_A), 256, nullptr, 4, scr, r, 32, lane); continue; } r -= I_BA;
        if (r < I_BB) { wconv_item(F.in[18] + (size_t)l * 128 * DM, DM, (bf16_t*)(wl + LW_BR + BR_B), 128, nullptr, 4, scr, r, 32, lane); continue; } r -= I_BB;
        if (r < I_BA) { wconv_item(F.in[19] + (size_t)l * 256 * DM, DM, (bf16_t*)(wl + LW_BR + BR_C), 256, nullptr, 4, scr, r, 32, lane); continue; } r -= I_BA;
        if (r < I_BA) { wconv_item(F.in[20] + (size_t)l * 256 * DM, DM, (bf16_t*)(wl + LW_BR + BR_D), 256, nullptr, 4, scr, r, 32, lane); continue; } r -= I_BA;
        if (r < I_O) { wconv_item(F.in[22] + (size_t)l * DM * DM, DM, (bf16_t*)(wl + LW_O), DM, nullptr, 0, scr, r, 32, lane); continue; } r -= I_O;
        if (r < I_UP) { wconv_item(F.in[23] + (size_t)l * DM * DFF2, DFF2, (bf16_t*)(wl + LW_UP), DM, nullptr, 5, scr, r, 176, lane); continue; } r -= I_UP;
        if (r < I_DN) { wconv_item(F.in[26] + (size_t)l * DFF * DM, DM, (bf16_t*)(wl + LW_DN), DFF, nullptr, 0, scr, r, 32, lane); continue; } r -= I_DN;
        if (r < I_UQ) { wconv_item(F.in[15] + (size_t)l * 256 * 384, 384, (bf16_t*)(wl + LW_UQ), 256, F.in[13] + l * 256, 2, scr, r, 16, lane); continue; } r -= I_UQ;
        if (r < I_UKV) { wconv_item(F.in[16] + (size_t)l * 128 * 512, 512, (bf16_t*)(wl + LW_UKV), 128, F.in[14] + l * 128, 0, scr, r, 16, lane); continue; } r -= I_UKV;
        if (r < I_PHI) { wconv_item(F.in[8] + (size_t)l * 2048 * 128, 128, (bf16_t*)(wl + LW_PHI), 2048, nullptr, 0, scr, r, 4, lane); continue; } r -= I_PHI;
        wconv_item(F.in[10] + (size_t)l * 2048 * 128, 128, (bf16_t*)(wl + LW_PHI) + (size_t)128 * 2048, 2048, nullptr, 0, scr, r, 4, lane);
    }
    const int gt = blockIdx.x * 512 + F.tid, NGT = F.G * 512;
    const float* rel = F.in[1];
    float* rope = WSP(float, WS_ROPE);
    for (int i = gt; i < SEQ * 16; i += NGT) { const int t = i >> 4, k = i & 15; const float inv = powf(10000.0f, -(float)(2 * k) / 32.0f); const float ang = (float)t * inv;
        float sn, cs; sincosf(ang, &sn, &cs); rope[2 * i] = cs; rope[2 * i + 1] = sn; }
    float* ntab = WSP(float, WS_NSATAB);
    for (int i = gt; i < 4 * NSA_TL; i += NGT) { const int hd = i / NSA_TL, k = i % NSA_TL, dist = NSA_DMAX - k; ntab[i] = dist >= 0 ? rel[rel_bucket(dist) * 10 + hd] * LOG2E : 0.f; }
    float* dtab = WSP(float, WS_DILTAB);
    for (int i = gt; i < 6 * 192; i += NGT) { const int gh = i / 192, k = i % 192, g = gh >> 1, hh = gh & 1, j = 160 - k; dtab[i] = (j >= 0 && j <= 128) ? rel[rel_bucket(j << (2 * g)) * 10 + 4 + 2 * g + hh] * LOG2E : 0.f; }
    if (gt < 4) WSP(float, WS_FARB)[gt] = rel[31 * 10 + gt] * LOG2E;
    if (gw < 128) { const int mi = gw >> 5, pc = gw & 31, l = mi >> 1; const float *pk1 = F.in[8], *pv1 = F.in[10]; asm volatile("" : "+s"(pk1), "+s"(pv1));
        const float* w1 = ((mi & 1) ? pv1 : pk1) + (size_t)l * 2048 * 128 + (size_t)(64 * pc) * 128 + 2 * lane; const float* cp = F.in[7] + (size_t)l * 2048 + 64 * pc;
        f32x2 a = {0.f, 0.f};
#pragma unroll 8
        for (int p = 0; p < 64; ++p) { const f32x2 w = *(const f32x2*)(w1 + (size_t)p * 128); const float cpp = cp[p]; a[0] += cpp * w[0]; a[1] += cpp * w[1]; }
        *(f32x2*)(WSP(float, WS_CMPP) + ((size_t)mi * 32 + pc) * 128 + 2 * lane) = a; }
    if (gt < ATT_UNITS) WSP(int, WS_ORDER)[att_rank(gt)] = gt;
}
__device__ __forceinline__ void cmpb_reduce(Frame& F) {
    const int i = F.tid; if (i < DEPTH * 256) { const int l = i >> 8, n = i & 255, mi = l * 2 + (n >> 7); const float* pp = WSP(const float, WS_CMPP) + (size_t)mi * 32 * 128 + (n & 127); float a = 0.f;
        for (int pc = 0; pc < 32; ++pc) a += pp[pc * 128]; WSP(float, WS_CMPB)[i] = a; }
}

template <int MODE> __device__ __forceinline__ void rowpass(Frame& F, const float* x, const bf16_t* y, size_t yrow0, float* xout, bf16_t* hout, const float* g1, const float* g2, int row_lo, int row_hi) {
    int gw = blockIdx.x * 8 + F.wave; asm volatile("" : "+s"(gw));
    const int NGW = F.G * 8, lane = F.lane;
    f32x4 ga[4], gb[4];
#pragma unroll
    for (int j = 0; j < 4; ++j) { ga[j] = *(const f32x4*)(g1 + 4 * lane + 256 * j); if (MODE == 1) gb[j] = *(const f32x4*)(g2 + 4 * lane + 256 * j); }
    for (int m = row_lo + gw; m < row_hi; m += NGW) {
        f32x4 v[4];
        const f32x4* xr = (const f32x4*)(x + (size_t)m * DM) + lane;
#pragma unroll
        for (int j = 0; j < 4; ++j) v[j] = xr[64 * j];
        if (MODE != 0) {
            const u32x2* yr = (const u32x2*)(y + ((size_t)m - yrow0) * DM) + lane; f32x4 w[4]; float s = 0.f;
#pragma unroll
            for (int j = 0; j < 4; ++j) { const u32x2 yy = yr[64 * j]; w[j][0] = __uint_as_float(yy.x << 16); w[j][1] = __uint_as_float(yy.x & 0xffff0000u); w[j][2] = __uint_as_float(yy.y << 16); w[j][3] = __uint_as_float(yy.y & 0xffff0000u);
                s += (w[j][0] * w[j][0] + w[j][1] * w[j][1]) + (w[j][2] * w[j][2] + w[j][3] * w[j][3]); }
            const float rstd = 1.0f / sqrtf(wave_sum(s) * (1.0f / DM) + RMS_EPS);
            f32x4* xo = (f32x4*)(xout + (size_t)m * DM) + lane;
#pragma unroll
            for (int j = 0; j < 4; ++j) { v[j] = v[j] + w[j] * rstd * ga[j]; xo[64 * j] = v[j]; }
        }
        if (MODE != 2) {
            float s = 0.f;
#pragma unroll
            for (int j = 0; j < 4; ++j) s += (v[j][0] * v[j][0] + v[j][1] * v[j][1]) + (v[j][2] * v[j][2] + v[j][3] * v[j][3]);
            const float rstd = 1.0f / sqrtf(wave_sum(s) * (1.0f / DM) + RMS_EPS);
            u32x2* ho = (u32x2*)(hout + (size_t)m * DM) + lane;
#pragma unroll
            for (int j = 0; j < 4; ++j) { const f32x4 gg = (MODE == 1) ? gb[j] : ga[j]; const f32x4 o = v[j] * rstd * gg; u32x2 w; w.x = cvtpk(o[0], o[1]); w.y = cvtpk(o[2], o[3]); ho[64 * j] = w; }
        }
    }
}

__device__ __forceinline__ void ffn_fix_panel(Frame& F, int pm, const float* HB, bf16_t* ACT, const float* cw, const float* cb) {
    for (int it = F.tid; it < 4 * 2 * (DFF / 4); it += 512) {
        const int c4 = it % (DFF / 4), rr = (it / (DFF / 4)) & 1, g = pm * 4 + it / (2 * (DFF / 4)), c = c4 * 4, pn = c >> 7, cl = c & 127;
        const bool first = ((g * 64) & (SEQ - 1)) == 0;
#define HBV(gg, s, bj) (*(const f32x4*)(HB + ((size_t)(((gg) * 4 + (s)) * 22 + pn) * 256 + (bj) * 128 + cl)))
        const f32x4 z = {0.f, 0.f, 0.f, 0.f};
        const f32x4 u0g = HBV(g, 0, 0), u0v = HBV(g, 0, 1);
        f32x4 ag, bg_, cg, av, bv_, cv;
        if (rr == 0) { ag = first ? z : HBV(g - 1, 2, 0); bg_ = first ? z : HBV(g - 1, 3, 0); cg = u0g; av = first ? z : HBV(g - 1, 2, 1); bv_ = first ? z : HBV(g - 1, 3, 1); cv = u0v; }
        else { ag = first ? z : HBV(g - 1, 3, 0); bg_ = u0g; cg = HBV(g, 1, 0); av = first ? z : HBV(g - 1, 3, 1); bv_ = u0v; cv = HBV(g, 1, 1); }
#undef HBV
        const f32x4 kb = *(const f32x4*)(cb + c), k0 = *(const f32x4*)(cw + c), k1 = *(const f32x4*)(cw + DFF2 + c), k2 = *(const f32x4*)(cw + 2 * DFF2 + c);
        const f32x4 vb = *(const f32x4*)(cb + DFF + c), v0 = *(const f32x4*)(cw + DFF + c), v1 = *(const f32x4*)(cw + DFF2 + DFF + c), v2 = *(const f32x4*)(cw + 2 * DFF2 + DFF + c);
        float o[4];
#pragma unroll
        for (int e = 0; e < 4; ++e) { const float gt = kb[e] + k0[e] * ag[e] + k1[e] * bg_[e] + k2[e] * cg[e], vl = vb[e] + v0[e] * av[e] + v1[e] * bv_[e] + v2[e] * cv[e]; o[e] = gt * sigmoid_f(gt) * vl; }
        u32x2 w; w.x = cvtpk(o[0], o[1]); w.y = cvtpk(o[2], o[3]);
        *(u32x2*)(ACT + (size_t)(g * 64 + rr) * DFF + c) = w;
    }
}
#ifdef SELFCHECK
constexpr int CW_CHK = 20480;
__device__ __forceinline__ unsigned chk_hash(unsigned x) { x ^= x >> 16; x *= 0x7feb352du; x ^= x >> 15; x *= 0x846ca68bu; x ^= x >> 16; return x; }
__device__ __forceinline__ int chk_t(int i) {
    int r = 0;
    switch (i & 31) { case 0: r = 0; break; case 1: r = 1; break; case 2: r = 15; break; case 3: r = 16; break; case 4: r = 30; break; case 5: r = 31; break; case 6: r = 32; break; case 7: r = 47; break;
        case 8: r = 63; break; case 9: r = 64; break; case 10: r = 65; break; case 11: r = 127; break; case 12: r = 128; break; case 13: r = 129; break; case 14: r = 255; break; case 15: r = 256; break;
        case 16: r = 257; break; case 17: r = 511; break; case 18: r = 512; break; case 19: r = 513; break; case 20: r = 575; break; case 21: r = 1023; break; case 22: r = 1024; break; case 23: r = 1599; break;
        case 24: r = 1600; break; case 25: r = 2047; break; case 26: r = 2048; break; case 27: r = 2111; break; case 28: r = 3000; break; case 29: r = 4031; break; case 30: r = 4032; break; default: r = 4095; break; }
    return (i < 64) ? r : (int)(chk_hash(i * 7919u + 13u) & 4095u);
}
__device__ __forceinline__ bool chk_bad(float got, float ref, float scale) { const float d = fabsf(got - ref); return !(d <= 0.02f * fabsf(ref) + 0.02f * scale); }
__device__ __forceinline__ float bfr(float x) { return bf2f((unsigned short)f2bf(x)); }
__device__ __forceinline__ void chk_flag(Frame& F, int bit, bool bad, int allow) {
    LAS unsigned* cnt = (LAS unsigned*)(F.lds + 65536);
    __syncthreads(); if (threadIdx.x == 0) *cnt = 0u; __syncthreads();
    if (bad) atomicAdd((unsigned*)cnt, 1u);
    __syncthreads();
    if (threadIdx.x == 0 && *cnt > (unsigned)allow) atomicOr((unsigned*)(F.ctl + CW_CHK), 1u << bit);
    __syncthreads();
}
__device__ __forceinline__ int chk_bucket_ref(int dist) {
    if (dist < 0) dist = 0; if (dist < 16) return dist;
    const float d = (float)dist; int large = 16 + (int)(logf(d / 16.0f) / 4.852030263919617f * 16.0f); return large < 31 ? large : 31;
}
__device__ __forceinline__ bool chk_fox(Frame& F, int b, int h, int t) {
    const bf16_t* P = WSP(const bf16_t, WS_P);
    { const size_t row = (size_t)b * SEQ + t; const bf16_t* q = P + row * PW + PC_CQ + h * 64; const float* kb = WSP(const float, WS_KB) + ((size_t)b * 4 + h) * SEQ;
      float m = -INFINITY; for (int j = 0; j <= t; ++j) { const bf16_t* k = P + ((size_t)b * SEQ + j) * PW + PC_CK + h * 64; float s = 0.f; for (int d = 0; d < 64; ++d) s += bf2f(q[d]) * bf2f(k[d]); s += kb[j]; m = fmaxf(m, s); }
      float lsum = 0.f, dummy0_ = 0.f; f32x4 o = {0.f, 0.f, 0.f, 0.f};
      for (int j = 0; j <= t; ++j) { const bf16_t* k = P + ((size_t)b * SEQ + j) * PW + PC_CK + h * 64; const bf16_t* v = P + ((size_t)b * SEQ + j) * PW + PC_CV + h * 64; float s = 0.f; for (int d = 0; d < 64; ++d) s += bf2f(q[d]) * bf2f(k[d]); s += kb[j];
          const float p = exp2f(s - m); lsum += p; _Pragma("unroll") for (int e = 0; e < 4; ++e) o[e] += p * bf2f(v[21 * e]); }
      bool bad = false; _Pragma("unroll") for (int e = 0; e < 4; ++e) bad |= chk_bad(bf2f(WSP(const bf16_t, WS_OCAT)[row * OCW + 384 + h * 64 + 21 * e]), o[e] / lsum, 0.5f);
      return bad; }
}
__device__ __forceinline__ bool chk_dil(Frame& F, int b, int hh, int t) {
    const bf16_t* P = WSP(const bf16_t, WS_P); const float* rel = F.in[1];
    { const size_t row = (size_t)b * SEQ + t;
      float m = -INFINITY;
      for (int g = 0; g < 3; ++g) { const int dil = 1 << (2 * g), head = 2 * g + hh; const bf16_t* q = P + row * PW + PC_BQ + head * 64;
          for (int j = 0; j <= 128; ++j) { const int idx = t - dil * j; if (idx < 0) break; const bf16_t* k = P + ((size_t)b * SEQ + idx) * PW + PC_BK + head * 64; float s = 0.f; for (int d = 0; d < 64; ++d) s += bf2f(q[d]) * bf2f(k[d]);
              s += rel[chk_bucket_ref(dil * j) * 10 + 4 + head] * LOG2E; m = fmaxf(m, s); } }
      float lsum = 0.f, dummy0_ = 0.f; f32x4 o = {0.f, 0.f, 0.f, 0.f};
      for (int g = 0; g < 3; ++g) { const int dil = 1 << (2 * g), head = 2 * g + hh; const bf16_t* q = P + row * PW + PC_BQ + head * 64;
          for (int j = 0; j <= 128; ++j) { const int idx = t - dil * j; if (idx < 0) break; const bf16_t* k = P + ((size_t)b * SEQ + idx) * PW + PC_BK + head * 64; const bf16_t* v = P + ((size_t)b * SEQ + idx) * PW + PC_BV + head * 64; float s = 0.f; for (int d = 0; d < 64; ++d) s += bf2f(q[d]) * bf2f(k[d]);
              s += rel[chk_bucket_ref(dil * j) * 10 + 4 + head] * LOG2E; const float p = exp2f(s - m); lsum += p; _Pragma("unroll") for (int e = 0; e < 4; ++e) o[e] += p * bf2f(v[21 * e]); } }
      bool bad = false; _Pragma("unroll") for (int e = 0; e < 4; ++e) bad |= chk_bad(bf2f(WSP(const bf16_t, WS_OCAT)[row * OCW + 256 + hh * 64 + 21 * e]), o[e] / lsum, 0.5f);
      return bad; }
}
__device__ __forceinline__ bool chk_nsa(Frame& F, int b, int h, int t, int i) {
    const bf16_t* P = WSP(const bf16_t, WS_P); const float* rel = F.in[1];
    { bool bad = false;
      { const size_t row = (size_t)b * SEQ + t; const size_t rb = (size_t)b * SEQ;
      const bf16_t* KC = WSP(const bf16_t, WS_KC) + (size_t)b * 256 * 64; const bf16_t* VC = WSP(const bf16_t, WS_VC) + (size_t)b * 256 * 64;
      const int cmax = (t >= 31) ? (t - 31) / 16 : -1, cur = t >> 6;
      LAS float* imp = (LAS float*)(F.lds + 70000) + i * 65; for (int j = 0; j < 64; ++j) imp[j] = 0.f;
      f32x4 oc = {0.f, 0.f, 0.f, 0.f};
      for (int hh = 0; hh < 4; ++hh) { const bf16_t* q = P + row * PW + PC_AQ + hh * 64; float m = -INFINITY;
          for (int c = 0; c <= cmax; ++c) { float s = 0.f; for (int d = 0; d < 64; ++d) s += bf2f(q[d]) * bf2f(KC[c * 64 + d]); m = fmaxf(m, s); }
          float ls = 0.f; for (int c = 0; c <= cmax; ++c) { float s = 0.f; for (int d = 0; d < 64; ++d) s += bf2f(q[d]) * bf2f(KC[c * 64 + d]); ls += exp2f(s - m); }
          for (int c = 0; c <= cmax; ++c) { float s = 0.f; for (int d = 0; d < 64; ++d) s += bf2f(q[d]) * bf2f(KC[c * 64 + d]); const float p = exp2f(s - m) / ls;
              for (int j = 0; j < 64; ++j) if (16 * c <= 64 * j + 63 && 16 * c + 31 >= 64 * j) imp[j] += p;
              if (hh == h) _Pragma("unroll") for (int e = 0; e < 4; ++e) oc[e] += p * bf2f(VC[c * 64 + 21 * e]); } }
      for (int j = 0; j < 64; ++j) imp[j] = (j == 0 || j == cur || j == cur - 1) ? 1e9f : (j > cur ? -1e9f : imp[j]);
      unsigned long long selm = 0ull;
      for (int j = 0; j < 64; ++j) { int rank = 0; for (int k = 0; k < 64; ++k) rank += (imp[k] > imp[j] || (imp[k] == imp[j] && k < j)) ? 1 : 0; if (rank < 16) selm |= 1ull << j; }
      const bf16_t* q = P + row * PW + PC_AQ + h * 64;
      f32x4 os = {0.f, 0.f, 0.f, 0.f}, ow = {0.f, 0.f, 0.f, 0.f};
      { float m = -INFINITY; for (int pos = 0; pos <= t; ++pos) { if (!((selm >> (pos >> 6)) & 1ull)) continue; const bf16_t* k = P + (rb + pos) * PW + PC_KSLC; float s = 0.f; for (int d = 0; d < 64; ++d) s += bf2f(q[d]) * bf2f(k[d]); s += rel[chk_bucket_ref(t - pos) * 10 + h] * LOG2E; m = fmaxf(m, s); }
        float ls = 0.f; for (int pos = 0; pos <= t; ++pos) { if (!((selm >> (pos >> 6)) & 1ull)) continue; const bf16_t* k = P + (rb + pos) * PW + PC_KSLC; const bf16_t* v = P + (rb + pos) * PW + PC_VSLC; float s = 0.f; for (int d = 0; d < 64; ++d) s += bf2f(q[d]) * bf2f(k[d]); s += rel[chk_bucket_ref(t - pos) * 10 + h] * LOG2E;
            const float p = exp2f(s - m); ls += p; _Pragma("unroll") for (int e = 0; e < 4; ++e) os[e] += p * bf2f(v[21 * e]); }
        _Pragma("unroll") for (int e = 0; e < 4; ++e) os[e] /= ls; }
      { const int lo = t - 511 > 0 ? t - 511 : 0; float m = -INFINITY; for (int pos = lo; pos <= t; ++pos) { const bf16_t* k = P + (rb + pos) * PW + PC_KWIN; float s = 0.f; for (int d = 0; d < 64; ++d) s += bf2f(q[d]) * bf2f(k[d]); s += rel[chk_bucket_ref(t - pos) * 10 + h] * LOG2E; m = fmaxf(m, s); }
        float ls = 0.f; for (int pos = lo; pos <= t; ++pos) { const bf16_t* k = P + (rb + pos) * PW + PC_KWIN; const bf16_t* v = P + (rb + pos) * PW + PC_VWIN; float s = 0.f; for (int d = 0; d < 64; ++d) s += bf2f(q[d]) * bf2f(k[d]); s += rel[chk_bucket_ref(t - pos) * 10 + h] * LOG2E;
            const float p = exp2f(s - m); ls += p; _Pragma("unroll") for (int e = 0; e < 4; ++e) ow[e] += p * bf2f(v[21 * e]); }
        _Pragma("unroll") for (int e = 0; e < 4; ++e) ow[e] /= ls; }
      const float* sd = WSP(const float, WS_SIDE) + row * 16 + h * 3; const float g0 = 1.f / (1.f + expf(-sd[0])), g1 = 1.f / (1.f + expf(-sd[1])), g2 = 1.f / (1.f + expf(-sd[2]));
      _Pragma("unroll") for (int e = 0; e < 4; ++e) bad |= chk_bad(bf2f(WSP(const bf16_t, WS_OCAT)[row * OCW + h * 64 + 21 * e]), g0 * oc[e] + g1 * os[e] + g2 * ow[e], 0.3f); }
      return bad; }
}
__device__ __forceinline__ void selfcheck_a(Frame& F, int l) {
    const int i = threadIdx.x;
    const float* x = F.in[0];
    const bf16_t* H = WSP(const bf16_t, WS_H); const bf16_t* P = WSP(const bf16_t, WS_P);
    const float* rel = F.in[1];
    { const int row = (int)(chk_hash(i) % M), col = (int)(chk_hash(i + 999) & 1023); float s = 0.f; for (int k = 0; k < DM; ++k) { const float v = x[(size_t)row * DM + k]; s += v * v; }
      const float ref = x[(size_t)row * DM + col] * (1.0f / sqrtf(s / DM + RMS_EPS)) * F.in[2][l * DM + col];
      chk_flag(F, 0, chk_bad(bf2f(H[(size_t)row * DM + col]), ref, 1.0f), 0); }
    { const int row = (int)(chk_hash(i + 5) % M); int c = (i * 37 + 5) % PW; if (i < 32) c = 640 + (i & 15); else if (i < 96) c = 672 + (i & 31); else if (i < 160) c = 256 + ((i * 3) & 127);
      const float* W = F.in[6] + (size_t)l * DM * DIN; bool bad = false;
#define DOTC(dst, cc) do { float sc_; const int src_ = inproj_src((cc), sc_); float a_ = 0.f; if (src_ >= 0) for (int k = 0; k < DM; ++k) a_ += bf2f(H[(size_t)row * DM + k]) * bfr(W[(size_t)k * DIN + src_] * sc_); dst = a_; } while (0)
      float ref; DOTC(ref, c);
      if (c >= 672 && c < 704) { const int p = c - 672, ip = p >> 1; float oth; DOTC(oth, c ^ 1); const float x1 = (p & 1) ? oth : ref, x2 = (p & 1) ? ref : oth;
          const float inv = powf(10000.0f, -(float)(2 * ip) / 32.0f), ang = (float)(row & (SEQ - 1)) * inv, cs = cosf(ang), sn = sinf(ang);
          ref = (p & 1) ? (x2 * cs + x1 * sn) : (x1 * cs - x2 * sn);
          bad |= chk_bad(bf2f(WSP(const bf16_t, WS_KROT)[(size_t)row * 32 + p]), ref, 1.0f); }
      bad |= chk_bad(bf2f(P[(size_t)row * PW + c]), ref, 1.0f);
      if (c >= 640 && c < 656) bad |= chk_bad(WSP(const float, WS_SIDE)[(size_t)row * 16 + (c - 640)], ref, 1.0f);
      if (c >= 256 && c < 320) bad |= chk_bad(bf2f(WSP(const bf16_t, WS_KCMP)[(size_t)row * 64 + (c - 256)]), ref, 1.0f);
      if (c >= 320 && c < 384) bad |= chk_bad(bf2f(WSP(const bf16_t, WS_VCMP)[(size_t)row * 64 + (c - 320)]), ref, 1.0f);
      if (i >= 160 && i < 192) { float sq = 0.f, skv = 0.f; for (int k = 0; k < 256; ++k) { const float v = bf2f(P[(size_t)row * PW + PC_DQL + k]); sq += v * v; } for (int k = 0; k < 128; ++k) { const float v = bf2f(P[(size_t)row * PW + PC_DKV + k]); skv += v * v; }
          const float* a = WSP(const float, WS_SSQQ) + (size_t)row * 4; const float* b = WSP(const float, WS_SSQKV) + (size_t)row * 4;
          bad |= chk_bad(a[0] + a[1] + a[2] + a[3], sq, 10.f) || chk_bad(b[0] + b[1] + b[2] + b[3], skv, 5.f); }
      chk_flag(F, 1, bad, 0); }
    { const int b = i & 15, h = (i >> 4) & 3, t = chk_t(i >> 6); float a = 0.f; for (int j = 0; j <= t; ++j) { const float xx = WSP(const float, WS_SIDE)[((size_t)b * SEQ + j) * 16 + 12 + h] + F.in[12][l * 4 + h]; a += (xx >= 0.f) ? -log1pf(expf(-xx)) : (xx - log1pf(expf(xx))); }
      chk_flag(F, 2, chk_bad(WSP(const float, WS_KB)[((size_t)b * 4 + h) * SEQ + t], -a * LOG2E, 1.0f + fabsf(a) * 0.05f), 0); }
    chk_flag(F, 3, chk_fox(F, (i * 5) & 15, i & 3, chk_t(i >> 2)), 0);
    { const int row = (int)(chk_hash(i + 77) % M); bool bad = false;
      float sq = 0.f, skv = 0.f; for (int k = 0; k < 256; ++k) { const float v = bf2f(P[(size_t)row * PW + PC_DQL + k]); sq += v * v; } for (int k = 0; k < 128; ++k) { const float v = bf2f(P[(size_t)row * PW + PC_DKV + k]); skv += v * v; }
      const float rq = 1.0f / sqrtf(sq / 256.0f + RMS_EPS), rkv = 1.0f / sqrtf(skv / 128.0f + RMS_EPS);
      const float* wq = F.in[15] + (size_t)l * 256 * 384; const float* gq = F.in[13] + l * 256; const float* wkv = F.in[16] + (size_t)l * 128 * 512; const float* gkv = F.in[14] + l * 128;
#define QDOT(dst, src) do { float a_ = 0.f; for (int k = 0; k < 256; ++k) a_ += bf2f(P[(size_t)row * PW + PC_DQL + k]) * bfr(wq[(size_t)k * 384 + (src)] * C2D * gq[k]); dst = a_ * rq; } while (0)
      const int r = (i * 11) % 384, hd = r / 96, w = r % 96; float ref;
      if (w < 64) QDOT(ref, hd * 96 + w);
      else { const int p = w - 64, ip = p >> 1; float x1, x2; QDOT(x1, hd * 96 + 64 + ip); QDOT(x2, hd * 96 + 64 + 16 + ip); const float inv = powf(10000.0f, -(float)(2 * ip) / 32.0f), ang = (float)(row & (SEQ - 1)) * inv, cs = cosf(ang), sn = sinf(ang);
          ref = (p & 1) ? (x2 * cs + x1 * sn) : (x1 * cs - x2 * sn); }
      bad |= chk_bad(bf2f(WSP(const bf16_t, WS_QM)[(size_t)row * 512 + r]), ref, 1.5f);
      { const int c = (i * 13) & 511; float a = 0.f; for (int k = 0; k < 128; ++k) a += bf2f(P[(size_t)row * PW + PC_DKV + k]) * bfr(wkv[(size_t)k * 512 + c] * gkv[k]); bad |= chk_bad(bf2f(WSP(const bf16_t, WS_KVM)[(size_t)row * 512 + c]), a * rkv, 1.0f); }
      chk_flag(F, 4, bad, 0); }
    { const int b = (i * 3) & 15, h = i & 3, t = chk_t(i >> 2); const size_t row = (size_t)b * SEQ + t; const bf16_t* q = WSP(const bf16_t, WS_QM) + row * 512 + h * 96; const bf16_t* KV = WSP(const bf16_t, WS_KVM); const bf16_t* KR = WSP(const bf16_t, WS_KROT);
      float m = -INFINITY; for (int j = 0; j <= t; ++j) { const size_t rj = (size_t)b * SEQ + j; float s = 0.f; for (int d = 0; d < 64; ++d) s += bf2f(q[d]) * bf2f(KV[rj * 512 + h * 128 + d]); for (int d = 0; d < 32; ++d) s += bf2f(q[64 + d]) * bf2f(KR[rj * 32 + d]); m = fmaxf(m, s); }
      float lsum = 0.f, dummy0_ = 0.f; f32x4 o = {0.f, 0.f, 0.f, 0.f};
      for (int j = 0; j <= t; ++j) { const size_t rj = (size_t)b * SEQ + j; float s = 0.f; for (int d = 0; d < 64; ++d) s += bf2f(q[d]) * bf2f(KV[rj * 512 + h * 128 + d]); for (int d = 0; d < 32; ++d) s += bf2f(q[64 + d]) * bf2f(KR[rj * 32 + d]);
          const float p = exp2f(s - m); lsum += p; _Pragma("unroll") for (int e = 0; e < 4; ++e) o[e] += p * bf2f(KV[rj * 512 + h * 128 + 64 + 21 * e]); }
      bool bad = false; _Pragma("unroll") for (int e = 0; e < 4; ++e) bad |= chk_bad(bf2f(WSP(const bf16_t, WS_OCAT)[row * OCW + 640 + h * 64 + 21 * e]), o[e] / lsum, 0.5f);
      chk_flag(F, 5, bad, 0); }
    chk_flag(F, 6, chk_dil(F, (i * 7) & 15, i & 1, chk_t(i >> 1)), 0);
    { const int b = i & 15, which = (i >> 4) & 1, c = (int)(chk_hash(i + 31) % 255), d = (i * 5) & 63; const bf16_t* src = (which ? WSP(const bf16_t, WS_VCMP) : WSP(const bf16_t, WS_KCMP)) + ((size_t)b * SEQ + 16 * c) * 64;
      const float *pk1 = F.in[8], *pv1 = F.in[10], *pk2 = F.in[9], *pv2 = F.in[11]; asm volatile("" : "+s"(pk1), "+s"(pv1), "+s"(pk2), "+s"(pv2));
      const float* w1 = (which ? pv1 : pk1) + (size_t)l * 2048 * 128; const float* w2 = (which ? pv2 : pk2) + (size_t)l * 128 * 64; const float* cp = F.in[7] + (size_t)l * 2048;
      float out = 0.f;
      for (int n = 0; n < 128; ++n) { float a = 0.f, bsum = 0.f; for (int p = 0; p < 2048; ++p) { a += bf2f(src[p]) * bfr(w1[(size_t)p * 128 + n]); bsum += cp[p] * w1[(size_t)p * 128 + n]; }
          const float xx = a + bsum, g = 0.5f * xx * (1.0f + tanhf(0.7978845608028654f * (xx + 0.044715f * xx * xx * xx))); out += bfr(g) * w2[n * 64 + d]; }
      chk_flag(F, 7, chk_bad(bf2f((which ? WSP(const bf16_t, WS_VC) : WSP(const bf16_t, WS_KC))[((size_t)b * 256 + c) * 64 + d]), out, 0.5f), 0); }
    { bool bad = false; if (i < 128) bad = chk_nsa(F, (i * 9) & 15, i & 3, chk_t(i >> 2), i); chk_flag(F, 8, bad, 4); }
}
__device__ __forceinline__ void selfcheck_b(Frame& F, int l) {
    const int i = threadIdx.x; const int row = (int)(chk_hash(i + 3) % M), n = (i * 29 + 7) & 1023;
    const bf16_t* H = WSP(const bf16_t, WS_H); const bf16_t* OC = WSP(const bf16_t, WS_OCAT);
    float acc = 0.f;
    for (int br = 0; br < 4; ++br) { const float* wg = F.in[21] + ((size_t)l * 4 + br) * DM * DM; float g = 0.f; for (int k = 0; k < DM; ++k) g += bf2f(H[(size_t)row * DM + k]) * bfr(wg[(size_t)k * DM + n]);
        const int kk = (br == 1) ? 128 : 256, co = (br == 0) ? 0 : (br == 1 ? 256 : (br == 2 ? 384 : 640)); const float *pb0 = F.in[17], *pb1 = F.in[18], *pb2 = F.in[19], *pb3 = F.in[20]; asm volatile("" : "+s"(pb0), "+s"(pb1), "+s"(pb2), "+s"(pb3)); const float* wb = (br == 0 ? pb0 : (br == 1 ? pb1 : (br == 2 ? pb2 : pb3))) + (size_t)l * kk * DM; float t = 0.f; for (int k = 0; k < kk; ++k) t += bf2f(OC[(size_t)row * OCW + co + k]) * bfr(wb[(size_t)k * DM + n]);
        acc += (1.f / (1.f + expf(-g))) * bfr(t); }
    chk_flag(F, 9, chk_bad(bf2f(WSP(const bf16_t, WS_MERGED)[(size_t)row * DM + n]), acc, 0.5f), 0);
}
__device__ __forceinline__ void selfcheck_c(Frame& F, int l, const float* xin) {
    const int i = threadIdx.x; const int row = (int)(chk_hash(i + 11) % M), n = (i * 29 + 7) & 1023;
    const bf16_t* MG = WSP(const bf16_t, WS_MERGED); const float* wo = F.in[22] + (size_t)l * DM * DM; const float* Y = WSP(const float, WS_Y);
    float a = 0.f; for (int k = 0; k < DM; ++k) a += bf2f(MG[(size_t)row * DM + k]) * bfr(wo[(size_t)k * DM + n]);
    chk_flag(F, 0, chk_bad(Y[(size_t)row * DM + n], a, 1.0f), 0);
    float s = 0.f; for (int k = 0; k < DM; ++k) { const float v = Y[(size_t)row * DM + k]; s += v * v; }
    const float rstd = 1.0f / sqrtf(s / DM + RMS_EPS); float s2 = 0.f;
    for (int k = 0; k < DM; ++k) { const float v = xin[(size_t)row * DM + k] + Y[(size_t)row * DM + k] * rstd * F.in[3][l * DM + k]; s2 += v * v; }
    const float x1 = xin[(size_t)row * DM + n] + Y[(size_t)row * DM + n] * rstd * F.in[3][l * DM + n];
    const float h2 = x1 * (1.0f / sqrtf(s2 / DM + RMS_EPS)) * F.in[4][l * DM + n];
    chk_flag(F, 1, chk_bad(F.out[(size_t)row * DM + n], x1, 1.0f) || chk_bad(bf2f(WSP(const bf16_t, WS_H2)[(size_t)row * DM + n]), h2, 1.0f), 0);
}
__device__ __forceinline__ void selfcheck_d(Frame& F, int l) {
    const int i = threadIdx.x; const int row = (int)(chk_hash(i + 17) % (M / 2)); const bf16_t* H2 = WSP(const bf16_t, WS_H2); const bf16_t* U = WSP(const bf16_t, WS_U); const bf16_t* A = WSP(const bf16_t, WS_ACT);
    { const int c = (i * 41 + 3) % DFF2; const float* wu = F.in[23] + (size_t)l * DM * DFF2; float a = 0.f; for (int k = 0; k < DM; ++k) a += bf2f(H2[(size_t)row * DM + k]) * bfr(wu[(size_t)k * DFF2 + c]);
      chk_flag(F, 2, chk_bad(bf2f(U[(size_t)row * DFF2 + c]), a, 1.0f), 0); }
    { const int c = (i * 23 + 1) % DFF; const int t = row & (SEQ - 1); const float* cw = F.in[24] + (size_t)l * 3 * DFF2; const float* cb = F.in[25] + (size_t)l * DFF2; float g = cb[c], v = cb[DFF + c];
      for (int j = 0; j < 3; ++j) { const int tt = t - 2 + j; if (tt < 0) continue; g += cw[j * DFF2 + c] * bf2f(U[(size_t)(row - 2 + j) * DFF2 + c]); v += cw[j * DFF2 + DFF + c] * bf2f(U[(size_t)(row - 2 + j) * DFF2 + DFF + c]); }
      chk_flag(F, 3, chk_bad(bf2f(A[(size_t)row * DFF + c]), g / (1.f + expf(-g)) * v, 0.3f), 0); }
    { const int n = (i * 29 + 7) & 1023; const float* wd = F.in[26] + (size_t)l * DFF * DM; float a = 0.f; for (int k = 0; k < DFF; ++k) a += bf2f(A[(size_t)row * DFF + k]) * bfr(wd[(size_t)k * DM + n]);
      chk_flag(F, 4, chk_bad(WSP(const float, WS_Y2)[(size_t)row * DM + n], a, 1.0f), 0); }
}

__device__ __forceinline__ void selfcheck_e(Frame& F, int l) {
    const int i = threadIdx.x; const bf16_t* H = WSP(const bf16_t, WS_H); const bf16_t* P = WSP(const bf16_t, WS_P);
    const float* W = F.in[6] + (size_t)l * DM * DIN; const int row = (int)(chk_hash(i + 5) % M);
#define DOTC(dst, cc) do { float sc_; const int src_ = inproj_src((cc), sc_); float a_ = 0.f; if (src_ >= 0) for (int k = 0; k < DM; ++k) a_ += bf2f(H[(size_t)row * DM + k]) * bfr(W[(size_t)k * DIN + src_] * sc_); dst = a_; } while (0)
    { int c = (i * 37 + 5) % PW; if ((c >= 640 && c < 768)) c = 100; float ref; DOTC(ref, c); chk_flag(F, 0, chk_bad(bf2f(P[(size_t)row * PW + c]), ref, 1.0f), 0); }
    { const int c = 672 + (i & 31), p = c - 672, ip = p >> 1; float ref, oth; DOTC(ref, c); DOTC(oth, c ^ 1); const float x1 = (p & 1) ? oth : ref, x2 = (p & 1) ? ref : oth;
      const float inv = powf(10000.0f, -(float)(2 * ip) / 32.0f), ang = (float)(row & (SEQ - 1)) * inv, cs = cosf(ang), sn = sinf(ang); const float r = (p & 1) ? (x2 * cs + x1 * sn) : (x1 * cs - x2 * sn);
      chk_flag(F, 1, chk_bad(bf2f(WSP(const bf16_t, WS_KROT)[(size_t)row * 32 + p]), r, 1.0f), 0); }
    { const int c = 640 + (i & 15); float ref; DOTC(ref, c); chk_flag(F, 2, chk_bad(WSP(const float, WS_SIDE)[(size_t)row * 16 + (c - 640)], ref, 1.0f), 0); }
    { const int c = 256 + (i & 127); float ref; DOTC(ref, c); const float got = (c < 320) ? bf2f(WSP(const bf16_t, WS_KCMP)[(size_t)row * 64 + (c - 256)]) : bf2f(WSP(const bf16_t, WS_VCMP)[(size_t)row * 64 + (c - 320)]); chk_flag(F, 3, chk_bad(got, ref, 1.0f), 0); }
    float sq = 0.f, skv = 0.f; for (int k = 0; k < 256; ++k) { const float v = bf2f(P[(size_t)row * PW + PC_DQL + k]); sq += v * v; } for (int k = 0; k < 128; ++k) { const float v = bf2f(P[(size_t)row * PW + PC_DKV + k]); skv += v * v; }
    { const float* a = WSP(const float, WS_SSQQ) + (size_t)row * 4; const float* b = WSP(const float, WS_SSQKV) + (size_t)row * 4; chk_flag(F, 4, chk_bad(a[0] + a[1] + a[2] + a[3], sq, 10.f) || chk_bad(b[0] + b[1] + b[2] + b[3], skv, 5.f), 0); }
    const float rq = 1.0f / sqrtf(sq / 256.0f + RMS_EPS), rkv = 1.0f / sqrtf(skv / 128.0f + RMS_EPS);
    const float* wq = F.in[15] + (size_t)l * 256 * 384; const float* gq = F.in[13] + l * 256; const float* wkv = F.in[16] + (size_t)l * 128 * 512; const float* gkv = F.in[14] + l * 128;
#define QDOT(dst, src) do { float a_ = 0.f; for (int k = 0; k < 256; ++k) a_ += bf2f(P[(size_t)row * PW + PC_DQL + k]) * bfr(wq[(size_t)k * 384 + (src)] * C2D * gq[k]); dst = a_ * rq; } while (0)
    { const int hd = i & 3, w = (i >> 2) & 63; float ref; QDOT(ref, hd * 96 + w); chk_flag(F, 5, chk_bad(bf2f(WSP(const bf16_t, WS_QM)[(size_t)row * 512 + hd * 96 + w]), ref, 1.5f), 0); }
    { const int hd = i & 3, p = (i >> 2) & 31, ip = p >> 1; float x1, x2; QDOT(x1, hd * 96 + 64 + ip); QDOT(x2, hd * 96 + 64 + 16 + ip); const float inv = powf(10000.0f, -(float)(2 * ip) / 32.0f), ang = (float)(row & (SEQ - 1)) * inv, cs = cosf(ang), sn = sinf(ang);
      const float r = (p & 1) ? (x2 * cs + x1 * sn) : (x1 * cs - x2 * sn); chk_flag(F, 6, chk_bad(bf2f(WSP(const bf16_t, WS_QM)[(size_t)row * 512 + hd * 96 + 64 + p]), r, 1.5f), 0); }
    { const int c = (i * 13) & 511; float a = 0.f; for (int k = 0; k < 128; ++k) a += bf2f(P[(size_t)row * PW + PC_DKV + k]) * bfr(wkv[(size_t)k * 512 + c] * gkv[k]); chk_flag(F, 7, chk_bad(bf2f(WSP(const bf16_t, WS_KVM)[(size_t)row * 512 + c]), a * rkv, 1.0f), 0); }
    { const int b = i & 15, which = (i >> 4) & 1, c = (int)(chk_hash(i + 31) % 255), n = (i * 5) & 127; const bf16_t* src = (which ? WSP(const bf16_t, WS_VCMP) : WSP(const bf16_t, WS_KCMP)) + ((size_t)b * SEQ + 16 * c) * 64;
      const float *pk1 = F.in[8], *pv1 = F.in[10], *pk2 = F.in[9], *pv2 = F.in[11]; asm volatile("" : "+s"(pk1), "+s"(pv1), "+s"(pk2), "+s"(pv2));
      const float* w1 = (which ? pv1 : pk1) + (size_t)l * 2048 * 128; const float* w2 = (which ? pv2 : pk2) + (size_t)l * 128 * 64; const float* cp = F.in[7] + (size_t)l * 2048;
      float a = 0.f, bsum = 0.f; for (int p = 0; p < 2048; ++p) { a += bf2f(src[p]) * bfr(w1[(size_t)p * 128 + n]); bsum += cp[p] * w1[(size_t)p * 128 + n]; }
      const float xx = a + bsum, g = 0.5f * xx * (1.0f + tanhf(0.7978845608028654f * (xx + 0.044715f * xx * xx * xx)));
      const bf16_t* hid = WSP(const bf16_t, WS_HID) + (size_t)(which * 4096 + b * 256 + c) * 256 + which * 128;
      chk_flag(F, 8, chk_bad(bf2f(hid[n]), g, 0.5f), 0);
      const int d = (i * 5) & 63; float o2 = 0.f; for (int nn = 0; nn < 128; ++nn) o2 += bf2f(hid[nn]) * w2[nn * 64 + d];
      chk_flag(F, 9, chk_bad(bf2f((which ? WSP(const bf16_t, WS_VC) : WSP(const bf16_t, WS_KC))[((size_t)b * 256 + c) * 64 + d]), o2, 0.5f), 0); }
#undef DOTC
#undef QDOT
}

constexpr int CW_CNT = 20544;
__device__ __forceinline__ void selfcheck_g(Frame& F, int l) {
    const int gi = blockIdx.x * 512 + threadIdx.x; const bf16_t* H = WSP(const bf16_t, WS_H); const bf16_t* P = WSP(const bf16_t, WS_P); const float* W = F.in[6] + (size_t)l * DM * DIN;
    const int row = gi & (M - 1); unsigned nbad = 0u;
    for (int k4 = 0; k4 < 4; ++k4) { int c = (int)(chk_hash(gi * 4 + k4 + 12345u) % PW); if (c >= 640 && c < 768) c -= 200;
        float sc_; const int src_ = inproj_src(c, sc_); float a_ = 0.f; for (int k = 0; k < DM; ++k) a_ += bf2f(H[(size_t)row * DM + k]) * bfr(W[(size_t)k * DIN + src_] * sc_);
        if (chk_bad(bf2f(P[(size_t)row * PW + c]), a_, 1.0f)) ++nbad; }
    if (nbad) atomicAdd((unsigned*)(F.ctl + CW_CNT), nbad);
}
__device__ __forceinline__ void selfcheck_g_fin(Frame& F) {
    if (blockIdx.x == 0 && threadIdx.x == 0) { const unsigned cnt = __hip_atomic_load(F.ctl + CW_CNT, __ATOMIC_RELAXED, __HIP_MEMORY_SCOPE_AGENT); unsigned lg = 0; while ((1u << lg) <= cnt && lg < 15) ++lg;
        atomicOr((unsigned*)(F.ctl + CW_CHK), (cnt > 63u ? 63u : cnt) | (lg << 6)); }
}

__device__ __forceinline__ void selfcheck_f(Frame& F, int l) {
    const int i = threadIdx.x; const unsigned hsh = chk_hash(i + 4242u);
    chk_flag(F, 0, chk_fox(F, i & 15, (i >> 4) & 3, (i >> 6) * 8 + (hsh & 7)), 0);
    chk_flag(F, 1, chk_fox(F, i & 15, (i >> 4) & 3, 64 + (int)(hsh % 192u)), 0);
    chk_flag(F, 2, chk_fox(F, i & 15, (i >> 4) & 3, 256 + (int)(hsh % 3840u)), 0);
    chk_flag(F, 3, chk_dil(F, i & 15, (i >> 4) & 1, (int)(hsh & 127u)), 0);
    chk_flag(F, 4, chk_dil(F, i & 15, (i >> 4) & 1, 128 + (int)(hsh % 3968u)), 0);
    { bool bad = false; if (i < 128) bad = chk_nsa(F, i & 15, (i >> 4) & 3, (int)(hsh % 31u), i); chk_flag(F, 5, bad, 0); }
    { bool bad = false; if (i < 128) bad = chk_nsa(F, i & 15, (i >> 4) & 3, 31 + (int)(hsh % 33u), i); chk_flag(F, 6, bad, 0); }
    { bool bad = false; if (i < 128) bad = chk_nsa(F, i & 15, (i >> 4) & 3, 64 + (int)(hsh % 960u), i); chk_flag(F, 7, bad, 0); }
    { bool bad = false; if (i < 128) bad = chk_nsa(F, i & 15, (i >> 4) & 3, 1024 + (int)(hsh % 3072u), i); chk_flag(F, 8, bad, 4); }
}
__device__ __forceinline__ void selfcheck_report(Frame& F) {
    const unsigned mask = __hip_atomic_load(F.ctl + CW_CHK, __ATOMIC_RELAXED, __HIP_MEMORY_SCOPE_AGENT);
    float V = (float)(10u + (mask & 63u)); const unsigned e = 2u + ((mask >> 6) & 15u); for (unsigned k = 0; k < e; ++k) V *= 10.0f;
    for (size_t idx = (size_t)blockIdx.x * 512 + threadIdx.x; idx < (size_t)M * DM; idx += (size_t)F.G * 512) F.out[idx] = V;
}
#endif
struct SchedSimple {
    pg8::TileOrder T; const char* A; const char* B; int lda, ldb, nt; int dup = 0;
    __device__ __forceinline__ bool next(int i, GUnit& u) const { int pm, pn; if (!T.tile(i >> dup, pm, pn)) return false;
        u.A = A + (size_t)pm * 256 * lda; u.B = B + (size_t)pn * 256 * ldb; u.lda = lda; u.ldb = ldb; u.nt = nt; u.pm = pm; u.pn = pn; u.id = 0; return true; }
};
struct SchedCmp1 {
    int c; const char* kc; const char* vc; const char* B;
    __device__ __forceinline__ bool next(int i, GUnit& u) const { if (i > 0 || c >= 32) return false;
        u.A = (c < 16 ? kc : vc) + (size_t)(c & 15) * 256 * 2048; u.B = B; u.lda = 2048; u.ldb = 4096; u.nt = 32; u.pm = c; u.pn = 0; u.id = 0; return true; }
};
struct SchedMerge {
    pg8::TileOrder T; const char* ocat; const char* h; const char* wbr; const char* wg; int dup = 0;
    __device__ __forceinline__ bool next(int i0, GUnit& u) const { const int i = i0 >> dup; int pm, pn; if (!T.tile(i >> 3, pm, pn)) return false;
        const int sub = i & 7; u.pm = pm; u.pn = pn; u.id = sub;
        if (sub >= 4) { u.A = h + (size_t)pm * 256 * 2048; u.lda = 2048; u.B = wg + (size_t)((pn * 4 + (sub - 4)) * 256) * 2048; u.ldb = 2048; u.nt = 16; }
        else { const int br = sub; const int kk = (br == 1) ? 128 : 256; const size_t co = (br == 0) ? 0 : (br == 1 ? 256 : (br == 2 ? 384 : 640)), wo = (br == 0) ? BR_A : (br == 1 ? BR_B : (br == 2 ? BR_C : BR_D));
            u.A = ocat + (size_t)pm * 256 * (OCW * 2) + co * 2; u.lda = OCW * 2; u.B = wbr + wo + (size_t)pn * 256 * kk * 2; u.ldb = kk * 2; u.nt = kk / 64; }
        return true; }
};

#ifndef SDUP_INPROJ
#define SDUP_INPROJ 0
#endif
#ifndef SDUP_MERGE
#define SDUP_MERGE 0
#endif
#ifndef SDUP_WO
#define SDUP_WO 0
#endif
#ifndef SDUP_UP
#define SDUP_UP 0
#endif
#ifndef SDUP_DN
#define SDUP_DN 0
#endif
#ifndef DUP_ATTN
#define DUP_ATTN 1
#endif
#ifndef DUP_GEMM
#define DUP_GEMM 1
#endif
#ifndef DUP_MERGE
#define DUP_MERGE 1
#endif
#ifndef DUP_FFN
#define DUP_FFN 1
#endif
#ifdef ONLY_PHASE
#define PH(k) ((k) == ONLY_PHASE)
#else
#define PH(k) true
#endif
struct Args { const float* in[27]; float* out; unsigned char* ws; };
__global__ void __launch_bounds__(512, 2) hybrid_fwd(Args args) {
    extern __shared__ __attribute__((aligned(16))) unsigned char lds_raw[];
    Frame F;
    F.lds = (LAS unsigned char*)lds_raw; F.MISC = (volatile LAS unsigned*)(F.lds + MISC_OFF);
    F.tid = threadIdx.x; F.lane = F.tid & 63; F.wave = __builtin_amdgcn_readfirstlane(F.tid >> 6); F.G = gridDim.x;
#pragma unroll
    for (int i = 0; i < 27; ++i) F.in[i] = args.in[i];
    F.out = args.out; F.ws = args.ws; F.ctl = (gu32*)(args.ws + WS_CTL);
    for (int u = F.tid; u < (LDS_BYTES - LDSCTL_OFF) / 4; u += 512) ((LAS unsigned*)(F.lds + LDSCTL_OFF))[u] = 0u;
    __syncthreads();
    XcdBarrier bar = xcd_barrier_post((unsigned*)(F.ctl + CW_BAR), F.MISC + 8);
    const int c = (int)blockIdx.x;
#if defined(TIMEPROBE)
    if (threadIdx.x == 0) *(volatile LAS unsigned long long*)(F.lds + MISC_OFF + 64) = __builtin_amdgcn_s_memrealtime();
#define TSTAMP(id) do { if (blockIdx.x == 0 && threadIdx.x == 0) { volatile LAS unsigned long long* tp_ = (volatile LAS unsigned long long*)(F.lds + MISC_OFF + 64); const unsigned long long now_ = __builtin_amdgcn_s_memrealtime(); unsigned long long* a_ = (unsigned long long*)(F.ws + 90000) + (id); *a_ = *a_ + (now_ - *tp_); *tp_ = now_; } } while (0)
#else
#define TSTAMP(id) do { } while (0)
#endif

#ifndef DUP_P0
#define DUP_P0 1
#endif
    for (int rep = 0; rep < DUP_P0; ++rep) { if (rep) xcd_barrier(bar); if (PH(0)) p0_prologue(F); }
    xcd_barrier(bar); TSTAMP(0);

#ifndef XTRA_BAR
#define XTRA_BAR 0
#endif
    _Pragma("unroll") for (int xb = 0; xb < XTRA_BAR; ++xb) xcd_barrier(bar);
#define PHASE_FRESH() do { int t_ = threadIdx.x; asm volatile("" : "+v"(t_)); F.tid = t_; F.lane = t_ & 63; } while (0)
    for (int l = 0; l < DEPTH; ++l) {
        unsigned char* wl = F.ws + WS_WT + (size_t)l * LW;
        const float* xin = (l == 0) ? F.in[0] : F.out;
        PHASE_FRESH();
#ifndef DUP_RP0
#define DUP_RP0 1
#endif
        if (l == 0) { if (c == 0) cmpb_reduce(F);
          _Pragma("unroll") for (int rep = 0; rep < DUP_RP0; ++rep) { if (rep) xcd_barrier(bar); if (PH(1)) rowpass<0>(F, xin, nullptr, 0, nullptr, WSP(bf16_t, WS_H), F.in[2] + l * DM, nullptr, 0, M); }
          xcd_barrier(bar); TSTAMP(1); }
        for (int rep = 0; rep < DUP_GEMM; ++rep) if (PH(2)) { if (rep) xcd_barrier(bar); SchedSimple S; S.T.init(256, 12, F.G, c); S.A = (const char*)(F.ws + WS_H); S.B = (const char*)(wl + LW_IN); S.lda = 2048; S.ldb = 2048; S.nt = 16; S.dup = SDUP_INPROJ;
          pg8::EpiInProj E{WSP(bf16_t, WS_P), WSP(bf16_t, WS_KCMP), WSP(bf16_t, WS_VCMP), WSP(float, WS_SIDE), WSP(bf16_t, WS_KROT), WSP(const float, WS_ROPE), WSP(float, WS_SSQQ), WSP(float, WS_SSQKV), F.in[12] + l * 4, WSP(float, WS_LF)};
          pg8::gemm_phase<pg8::EpiInProj, SchedSimple, true>(F.lds, S, E); }
        xcd_barrier(bar); TSTAMP(2);
        if (PH(3)) { SchedCmp1 S{c, (const char*)(F.ws + WS_KCMP), (const char*)(F.ws + WS_VCMP), (const char*)(wl + LW_PHI)};
          pg8::EpiCmp1 E{WSP(bf16_t, WS_HID), WSP(const float, WS_CMPB) + l * 256};
          pg8::gemm_phase<pg8::EpiCmp1, SchedCmp1, false>(F.lds, S, E);
          if (c < 32) {
              __syncthreads(); const int which = c >> 4, b = c & 15;
              int ln_ = threadIdx.x & 63; asm volatile("" : "+v"(ln_)); const int r32 = ln_ & 31, hi = ln_ >> 5;
              const bf16_t* hrow = WSP(const bf16_t, WS_HID) + ((size_t)c * 256 + F.wave * 32 + r32) * 256 + which * 128;
              const float *pk2 = F.in[9], *pv2 = F.in[11]; asm volatile("" : "+s"(pk2), "+s"(pv2)); const float* w2 = (which ? pv2 : pk2) + (size_t)l * 128 * 64;
              f32x16 o0, o1;
#pragma unroll
              for (int r = 0; r < 16; ++r) { o0[r] = 0.f; o1[r] = 0.f; }
#pragma unroll
              for (int ks = 0; ks < 8; ++ks) { const bf16x8 a = *(const bf16x8*)(hrow + ks * 16 + hi * 8);
                  const float* wp = w2 + (size_t)(ks * 16 + hi * 8) * 64 + r32; u32x4 b0, b1;
#pragma unroll
                  for (int jj = 0; jj < 4; ++jj) { b0[jj] = cvtpk(wp[(2 * jj) * 64], wp[(2 * jj + 1) * 64]); b1[jj] = cvtpk(wp[(2 * jj) * 64 + 32], wp[(2 * jj + 1) * 64 + 32]); }
                  o0 = MFMA32(a, __builtin_bit_cast(bf16x8, b0), o0); o1 = MFMA32(a, __builtin_bit_cast(bf16x8, b1), o1); }
              bf16_t* dst = (which ? WSP(bf16_t, WS_VC) : WSP(bf16_t, WS_KC)) + ((size_t)b * 256 + F.wave * 32) * 64 + r32;
#pragma unroll
              for (int r = 0; r < 16; ++r) { const int rw = crow(r, hi); dst[(size_t)rw * 64] = (bf16_t)f2bf(o0[r]); dst[(size_t)rw * 64 + 32] = (bf16_t)f2bf(o1[r]); } } }
        if (PH(4)) { int G2_ = F.G; asm volatile("" : "+s"(G2_)); const bool split = G2_ > 64; const int g2 = split ? F.G - 32 : F.G, c2 = split ? c - 32 : c;
          { SchedSimple S; S.T.init(256, 2, g2, c2 < 0 ? (1 << 28) : c2); S.A = (const char*)(F.ws + WS_P) + PC_DQL * 2; S.B = (const char*)(wl + LW_UQ); S.lda = PW * 2; S.ldb = 512; S.nt = 4;
            pg8::EpiQup E{WSP(bf16_t, WS_QM), WSP(const float, WS_SSQQ), WSP(const float, WS_ROPE)};
            pg8::gemm_phase<pg8::EpiQup, SchedSimple, true>(F.lds, S, E); }
          { SchedSimple S; S.T.init(256, 2, g2, c2 < 0 ? (1 << 28) : c2); S.A = (const char*)(F.ws + WS_P) + PC_DKV * 2; S.B = (const char*)(wl + LW_UKV); S.lda = PW * 2; S.ldb = 256; S.nt = 2;
            pg8::EpiKVup E{WSP(bf16_t, WS_KVM), WSP(const float, WS_SSQKV)};
            pg8::gemm_phase<pg8::EpiKVup, SchedSimple, true>(F.lds, S, E); } }
        PHASE_FRESH();
        if (PH(5)) {
          int G_ = F.G; asm volatile("" : "+s"(G_)); const int cb = (G_ >= 48) ? c - 32 : c;
          if (cb >= 0 && cb < BATCH) { const int b = cb, tid = F.tid; const float* lf = WSP(const float, WS_LF) + ((size_t)b * SEQ + 8 * tid) * 4;
              f32x4 v[8];
#pragma unroll
              for (int i = 0; i < 8; ++i) v[i] = *(const f32x4*)(lf + 4 * i);
#pragma unroll
              for (int i = 1; i < 8; ++i) v[i] = v[i] + v[i - 1];
              LAS f32x4* sc = (LAS f32x4*)F.lds; f32x4 run = v[7];
              sc[tid] = run; __syncthreads();
              for (int off = 1, cur = 0; off < 512; off <<= 1, cur ^= 1) { f32x4 t = sc[cur * 512 + tid]; if (tid >= off) t = t + sc[cur * 512 + tid - off]; sc[(cur ^ 1) * 512 + tid] = t; __syncthreads(); run = t; }
              const f32x4 ex = run - v[7];
              float* kb = WSP(float, WS_KB) + (size_t)b * 4 * SEQ + 8 * tid;
#pragma unroll
              for (int e = 0; e < 4; ++e) { f32x4 lo, hi4;
#pragma unroll
                  for (int i = 0; i < 4; ++i) { lo[i] = -(ex[e] + v[i][e]) * LOG2E; hi4[i] = -(ex[e] + v[4 + i][e]) * LOG2E; }
                  *(f32x4*)(kb + (size_t)e * SEQ) = lo; *(f32x4*)(kb + (size_t)e * SEQ + 4) = hi4; }
              __syncthreads();
          } }
        xcd_barrier(bar); TSTAMP(3);
        PHASE_FRESH();
        for (int rep = 0; rep < DUP_ATTN; ++rep) { gu32* ctr = F.ctl + CW_Q + 64 * l + 16 * rep;
          if (rep) xcd_barrier(bar);
          for (;;) { const int iq = queue_grab(F, ctr); if (iq >= ATT_UNITS) break;
              const int it = __builtin_amdgcn_readfirstlane(WSP(const int, WS_ORDER)[iq]);
              if (it < 2048 && PH(7)) { const int qb = 15 - (it >> 7), mla = (it >> 6) & 1, bh = it & 63; if (mla) causal_unit<false>(F, bh >> 2, bh & 3, qb); else causal_unit<true>(F, bh >> 2, bh & 3, qb); }
              else if (it < 3072 && PH(8)) { const int r = it - 2048; nsa_unit(F, r & 15, 63 - (r >> 4)); }
              else if (it < 3328 && PH(9)) { const int r = it - 3072; dil_unit(F, r & 15, (r >> 4) & 1, r >> 5); }
              else break; } }
        xcd_barrier(bar); TSTAMP(5);
#if defined(SELFCHECK) && SELFCHECK == 1
        if (c == 0) selfcheck_a(F, l);
#endif
#if defined(SELFCHECK) && SELFCHECK == 3
        if (c == 0) selfcheck_e(F, l);
        xcd_barrier(bar); selfcheck_report(F); return;
#endif
#if defined(SELFCHECK) && SELFCHECK == 5
        selfcheck_g(F, l); xcd_barrier(bar); selfcheck_g_fin(F);
        xcd_barrier(bar); selfcheck_report(F); return;
#endif
#if defined(SELFCHECK) && SELFCHECK == 4
        if (c == 0) selfcheck_f(F, l);
        xcd_barrier(bar); selfcheck_report(F); return;
#endif
        for (int rep = 0; rep < DUP_MERGE; ++rep) if (PH(10)) { if (rep) xcd_barrier(bar); SchedMerge S; S.T.init(256, 4, F.G, c); S.ocat = (const char*)(F.ws + WS_OCAT); S.h = (const char*)(F.ws + WS_H); S.wbr = (const char*)(wl + LW_BR); S.wg = (const char*)(wl + LW_G); S.dup = SDUP_MERGE;
          unsigned char* scr = F.ws + WS_MSCR + (size_t)c * MSCR_PER_WG;
          pg8::EpiMerge E{WSP(bf16_t, WS_MERGED), scr};
          pg8::gemm_phase<pg8::EpiMerge, SchedMerge, true>(F.lds, S, E); }
        xcd_barrier(bar); TSTAMP(6);
#if defined(SELFCHECK) && SELFCHECK == 1
        if (c == 0) selfcheck_b(F, l);
        xcd_barrier(bar); selfcheck_report(F); return;
#endif
        if (PH(11)) { SchedSimple S; S.T.init(256, 4, F.G, c); S.A = (const char*)(F.ws + WS_MERGED); S.B = (const char*)(wl + LW_O); S.lda = 2048; S.ldb = 2048; S.nt = 16; S.dup = SDUP_WO;
          pg8::EpiBf16 E{WSP(bf16_t, WS_Y), DM};
          pg8::gemm_phase<pg8::EpiBf16, SchedSimple, true>(F.lds, S, E); }
        xcd_barrier(bar); TSTAMP(7);
        PHASE_FRESH();
        if (PH(12)) rowpass<1>(F, xin, WSP(const bf16_t, WS_Y), 0, F.out, WSP(bf16_t, WS_H2), F.in[3] + l * DM, F.in[4] + l * DM, 0, M);
        xcd_barrier(bar); TSTAMP(8);
        if (PH(13)) { SchedSimple S; S.T.init(256, 22, F.G, c); S.A = (const char*)(F.ws + WS_H2); S.B = (const char*)(wl + LW_UP); S.lda = 2048; S.ldb = 2048; S.nt = 16; S.dup = SDUP_UP;
          pg8::EpiUpConv E{WSP(bf16_t, WS_ACT), WSP(float, WS_HB), F.in[24] + (size_t)l * 3 * DFF2, F.in[25] + (size_t)l * DFF2};
          pg8::gemm_phase<pg8::EpiUpConv, SchedSimple, true>(F.lds, S, E); }
        xcd_barrier(bar); TSTAMP(9);
        PHASE_FRESH();
        if (PH(15)) { SchedSimple S; S.T.init(256, 4, F.G, c); S.A = (const char*)(F.ws + WS_ACT); S.B = (const char*)(wl + LW_DN); S.lda = DFF * 2; S.ldb = DFF * 2; S.nt = DFF / 64; S.dup = SDUP_DN;
          { int pm, pn; for (int i = 0; S.T.tile(i, pm, pn); ++i) ffn_fix_panel(F, pm, WSP(const float, WS_HB), WSP(bf16_t, WS_ACT), F.in[24] + (size_t)l * 3 * DFF2, F.in[25] + (size_t)l * DFF2); }
          VM_WAIT(); __syncthreads();
          pg8::EpiBf16 E{WSP(bf16_t, WS_Y2), DM};
          pg8::gemm_phase<pg8::EpiBf16, SchedSimple, true>(F.lds, S, E); }
        xcd_barrier(bar); TSTAMP(11);
        PHASE_FRESH();
        if (PH(16)) { if (l + 1 < DEPTH) rowpass<1>(F, F.out, WSP(const bf16_t, WS_Y2), 0, F.out, WSP(bf16_t, WS_H), F.in[5] + l * DM, F.in[2] + (l + 1) * DM, 0, M);
                      else rowpass<2>(F, F.out, WSP(const bf16_t, WS_Y2), 0, F.out, nullptr, F.in[5] + l * DM, nullptr, 0, M); }
        xcd_barrier(bar); TSTAMP(12);
    }
#if defined(TIMEPROBE)
    { xcd_barrier(bar); const unsigned long long* a_ = (const unsigned long long*)(F.ws + 90000); const float V1 = (float)a_[TIMEPROBE_A] * 0.01f, V2 = (float)a_[TIMEPROBE_B] * 0.01f * 1000.0f;
      for (size_t idx = (size_t)blockIdx.x * 512 + threadIdx.x; idx < (size_t)M * DM; idx += (size_t)F.G * 512) F.out[idx] = (idx == 12345) ? V2 : V1; }
#endif
}

extern "C" void kernel_launch(void* const* d_in, const int* in_sizes, int n_in, void* d_out, int out_size, void* d_ws, size_t ws_size, hipStream_t stream) {
    static int grid = 0;
    if (grid == 0) {
        if (n_in != 27 || in_sizes[0] != M * DM || out_size != M * DM || ws_size < WS_END) { fprintf(stderr, "kernel_launch: unexpected shapes (n_in %d, in0 %d, out %d, ws %zu)\n", n_in, n_in > 0 ? in_sizes[0] : -1, out_size, ws_size); grid = -1; return; }
        int dev = 0, cus = 0, per_cu = 0;
        if (hipGetDevice(&dev) != hipSuccess || hipDeviceGetAttribute(&cus, hipDeviceAttributeMultiprocessorCount, dev) != hipSuccess) { grid = -1; return; }
        if (hipFuncSetAttribute((const void*)hybrid_fwd, hipFuncAttributeMaxDynamicSharedMemorySize, LDS_BYTES) != hipSuccess) { fprintf(stderr, "kernel_launch: hipFuncSetAttribute failed\n"); grid = -1; return; }
        if (hipOccupancyMaxActiveBlocksPerMultiprocessor(&per_cu, (const void*)hybrid_fwd, 512, LDS_BYTES) != hipSuccess || per_cu < 1) fprintf(stderr, "kernel_launch: occupancy query says %d\n", per_cu);
        (void)hipGetLastError();
        grid = cus;
    }
    if (grid < 0) return;
    if (hipMemsetAsync((char*)d_ws + WS_CTL, 0, CTL_ZERO_BYTES, stream) != hipSuccess) return;
    Args a{};
    for (int i = 0; i < 27; ++i) a.in[i] = (const float*)d_in[i];
    a.out = (float*)d_out; a.ws = (unsigned char*)d_ws;
    hipLaunchKernelGGL(hybrid_fwd, dim3(grid), dim3(512), LDS_BYTES, stream, a);
}
```

```cpp
#include <hip/hip_runtime.h>
#include <hip/hip_bf16.h>
#include <cstdio>
#include <cstdint>
#include <cmath>

#define GAS __attribute__((address_space(1)))
#define LAS __attribute__((address_space(3)))
typedef unsigned short bf16_t;
typedef short bf16x8 __attribute__((ext_vector_type(8)));
typedef short s16x4 __attribute__((ext_vector_type(4)));
typedef float f32x4 __attribute__((ext_vector_type(4)));
typedef float f32x2 __attribute__((ext_vector_type(2)));
typedef float f32x16 __attribute__((ext_vector_type(16)));
typedef unsigned u32x4 __attribute__((ext_vector_type(4)));
typedef unsigned u32x2 __attribute__((ext_vector_type(2)));
typedef GAS unsigned gu32;

constexpr int BATCH = 16, SEQ = 4096, DM = 1024, M = BATCH * SEQ, DEPTH = 2;
constexpr int DIN = 2992, PW = 3072;
constexpr int DFF = 2816, DFF2 = 5632;
constexpr float LOG2E = 1.4426950408889634f;
constexpr float C2A = 0.125f * LOG2E;
constexpr float C2D = 0.10206207261596575f * LOG2E;
constexpr float RMS_EPS = 1e-6f;
constexpr int PC_AQ = 0, PC_KCMP = 256, PC_VCMP = 320, PC_KSLC = 384, PC_VSLC = 448, PC_KWIN = 512, PC_VWIN = 576,
              PC_MISC = 640, PC_KROPE = 672, PC_BQ = 768, PC_BK = 1152, PC_BV = 1536, PC_DKV = 1920,
              PC_CQ = 2048, PC_CK = 2304, PC_CV = 2560, PC_DQL = 2816;
constexpr int OCW = 896;
constexpr int NSA_DFAR = 1536, NSA_DMAX = 1664, NSA_TL = 1728;

__device__ __forceinline__ unsigned f2bf(float f) { unsigned u = __float_as_uint(f); return (u + 0x7fffu + ((u >> 16) & 1u)) >> 16; }
__device__ __forceinline__ unsigned pk2(float lo, float hi) { return f2bf(lo) | (f2bf(hi) << 16); }
__device__ __forceinline__ float bf2f(unsigned short b) { return __uint_as_float((unsigned)b << 16); }
typedef __bf16 bf16x2_t __attribute__((ext_vector_type(2)));
__device__ __forceinline__ unsigned cvtpk(float lo, float hi) { f32x2 v = {lo, hi}; bf16x2_t b = __builtin_convertvector(v, bf16x2_t); return __builtin_bit_cast(unsigned, b); }
__device__ __forceinline__ float fast_exp2(float x) { return __builtin_amdgcn_exp2f(x); }
__device__ __forceinline__ float fast_rcp(float x) { return __builtin_amdgcn_rcpf(x); }
template <int MASK> __device__ __forceinline__ float xor_lane_lt32(float v) { return __uint_as_float(__builtin_amdgcn_ds_swizzle((int)__float_as_uint(v), (MASK << 10) | 0x1f)); }
__device__ __forceinline__ float sum_halves(float v) { auto rr = __builtin_amdgcn_permlane32_swap(__float_as_uint(v), __float_as_uint(v), false, false); return __uint_as_float(rr[0]) + __uint_as_float(rr[1]); }
__device__ __forceinline__ float sigmoid_f(float x) { return fast_rcp(1.0f + fast_exp2(-x * LOG2E)); }

namespace pg8 {
constexpr int BM = 256, BK = 64, HALF = 128, HTB = HALF * BK * 2  , STAGE_BYTES = 8 * HTB, NXCD = 8, WGM = 8;
__host__ __device__ __forceinline__ int lds_byte(int r, int c) { const int st = (r >> 4) * 2 + (c >> 5), rr = r & 15, cc = c & 31, ob = rr * 64 + cc * 2; return st * 1024 + (ob ^ (((ob >> 9) & 1) << 5)); }
__host__ __device__ __forceinline__ void stage_rc(int b, int& R, int& C) { const int st = b / 1024, sb = b % 1024, swz = sb ^ (((sb >> 9) & 1) << 5); R = (st >> 1) * 16 + swz / 64; C = (st & 1) * 32 + (swz % 64) / 2; }
__host__ __device__ __forceinline__ int perm32(int rho) { const int n = rho >> 4, i = rho & 15; return 8 * (i >> 2) + 4 * n + (i & 3); }

struct GUnit { const char* A; const char* B; int lda, ldb, nt, pm, pn, id; };

struct TileOrder {
    int nM, nN, nwg, G, c;
    __device__ __forceinline__ void init(int nM_, int nN_, int G_, int c_) { nM = nM_; nN = nN_; nwg = nM * nN; G = G_; c = c_; }
    __device__ __forceinline__ bool tile(int i, int& pm, int& pn) const {
        const long L = (long)i * G + c; if (L >= nwg) return false;
        int wgid = (int)L; { const int q = nwg / NXCD, r = nwg % NXCD, xcd = wgid % NXCD, off = wgid / NXCD; wgid = (xcd < r ? xcd * (q + 1) : r * (q + 1) + (xcd - r) * q) + off; }
        const int nig = WGM * nN, gid = wgid / nig, fm = gid * WGM, gsz = (nM - fm) < WGM ? (nM - fm) : WGM;
        pm = fm + ((wgid % nig) % gsz); pn = (wgid % nig) / gsz; return true;
    }
};

template <class Epi, class Sched, bool ALIGN_EPI>
__device__ __forceinline__ void gemm_phase(LAS unsigned char* lds, const Sched& S, const Epi& E) {
    int tid_o = threadIdx.x; asm volatile("" : "+v"(tid_o));
    const int tid = tid_o, wid = __builtin_amdgcn_readfirstlane(tid >> 6), lane = tid & 63, wr = wid >> 2, wc = wid & 3; int fr = lane & 15, fq = lane >> 4;
    int sR[2], sC[2], sRb[2];
#pragma unroll
    for (int i = 0; i < 2; ++i) { stage_rc(tid * 16 + i * 8192, sR[i], sC[i]); sRb[i] = Epi::PERM ? ((sR[i] & ~31) + perm32(sR[i] & 31)) : sR[i]; sC[i] *= 2; }
    const size_t kstep = (size_t)(BK * 2);
    const unsigned ldsw = (unsigned)wid * 1024u;
    const int aoff = lds_byte(wr * 64 + fr, fq * 8), boff = lds_byte(wc * 32 + fr, fq * 8);
#define PG8_SA(b, h) (((b) * 2 + (h)) * HTB)
#define PG8_SB(b, h) ((4 + (b) * 2 + (h)) * HTB)
#define PG8_STAGE(bufoff, gbase, rows, ld) do { _Pragma("unroll") for (int _i = 0; _i < 2; ++_i) \
        __builtin_amdgcn_global_load_lds((const unsigned*)((const char*)(gbase) + (unsigned)((rows)[_i] * (ld) + sC[_i])), (LAS unsigned*)(lds + (bufoff) + ldsw + _i * 8192), 16, 0, 0); } while (0)
#define PG8_LDA(dst, b, h) do { _Pragma("unroll") for (int m = 0; m < 4; ++m) _Pragma("unroll") for (int k = 0; k < 2; ++k) dst[m][k] = *(const LAS bf16x8*)(lds + PG8_SA(b, h) + aoff + m * 2048 + k * 1024); } while (0)
#define PG8_LDB(dst, b, h) do { _Pragma("unroll") for (int n = 0; n < 2; ++n) _Pragma("unroll") for (int k = 0; k < 2; ++k) dst[n][k] = *(const LAS bf16x8*)(lds + PG8_SB(b, h) + boff + n * 2048 + k * 1024); } while (0)
#define PG8_MMA(ai, bj, At, Bt) do { __builtin_amdgcn_s_setprio(1); _Pragma("unroll") for (int m = 0; m < 4; ++m) _Pragma("unroll") for (int n = 0; n < 2; ++n) _Pragma("unroll") for (int k = 0; k < 2; ++k) \
        acc[ai][bj][m][n] = __builtin_amdgcn_mfma_f32_16x16x32_bf16(Bt[n][k], At[m][k], acc[ai][bj][m][n], 0, 0, 0); __builtin_amdgcn_s_setprio(0); } while (0)
#define PG8_WAIT_V(n) asm volatile("s_waitcnt vmcnt(" #n ")" ::: "memory")
#define PG8_WAIT_L(n) asm volatile("s_waitcnt lgkmcnt(" #n ")" ::: "memory")
#define PG8_BAR __builtin_amdgcn_s_barrier()
#define PG8_SCHED __builtin_amdgcn_sched_barrier(0)
    GUnit cur, nxt; int ui = 0;
    if (!S.next(0, cur)) return;
    f32x4 acc[2][2][4][2];
#pragma unroll
    for (int a = 0; a < 2; ++a)
#pragma unroll
        for (int b = 0; b < 2; ++b)
#pragma unroll
            for (int m = 0; m < 4; ++m)
#pragma unroll
                for (int n = 0; n < 2; ++n) acc[a][b][m][n] = (f32x4){0.f, 0.f, 0.f, 0.f};
    bf16x8 At[4][2], B0[2][2], B1[2][2];
    int ldAc = cur.lda, ldBc = cur.ldb; size_t hAc = (size_t)HALF * ldAc, hBc = (size_t)HALF * ldBc;
    const char* cA = cur.A; const char* cB = cur.B;
    PG8_STAGE(PG8_SB(0, 0), cB, sRb, ldBc); PG8_STAGE(PG8_SB(0, 1), cB + hBc, sRb, ldBc); PG8_STAGE(PG8_SA(0, 0), cA, sR, ldAc); PG8_STAGE(PG8_SA(0, 1), cA + hAc, sR, ldAc);
    if (wr == 1) PG8_BAR;
    PG8_WAIT_V(2); PG8_BAR;
    PG8_STAGE(PG8_SB(1, 0), cB + kstep, sRb, ldBc); PG8_STAGE(PG8_SA(1, 0), cA + kstep, sR, ldAc); PG8_STAGE(PG8_SB(1, 1), cB + hBc + kstep, sRb, ldBc);
    PG8_WAIT_V(6); PG8_BAR;
    for (;;) {
        const bool has_next = S.next(ui + 1, nxt);
        int ldAn, ldBn; const char* nA; const char* nB;
        if (has_next) { ldAn = nxt.lda; ldBn = nxt.ldb; nA = nxt.A; nB = nxt.B; } else { ldAn = ldAc; ldBn = ldBc; nA = cA; nB = cB; }
        const size_t hAn = (size_t)HALF * ldAn, hBn = (size_t)HALF * ldBn;
        int nt = cur.nt; asm volatile("" : "+s"(nt));
        for (int t = 0; t < nt; t += 2) {
            const bool last = (t == nt - 2);
            const char* a1 = cA + (size_t)(t + 1) * kstep;
            const char* a2 = last ? nA : cA + (size_t)(t + 2) * kstep; const char* b2 = last ? nB : cB + (size_t)(t + 2) * kstep;
            const char* a3 = a2 + kstep; const char* b3 = b2 + kstep;
            const int ldA2 = last ? ldAn : ldAc, ldB2 = last ? ldBn : ldBc;
            const size_t hA2 = last ? hAn : hAc, hB2 = last ? hBn : hBc;
            PG8_LDB(B0, 0, 0); PG8_LDB(B1, 0, 1); PG8_SCHED; PG8_LDA(At, 0, 0); PG8_STAGE(PG8_SA(1, 1), a1 + hAc, sR, ldAc);
            PG8_WAIT_V(8); PG8_WAIT_L(0); PG8_BAR; PG8_MMA(0, 0, At, B0); PG8_MMA(0, 1, At, B1); PG8_BAR; PG8_SCHED;
            PG8_LDA(At, 0, 1); PG8_STAGE(PG8_SB(0, 0), b2, sRb, ldB2); PG8_STAGE(PG8_SB(0, 1), b2 + hB2, sRb, ldB2); PG8_STAGE(PG8_SA(0, 0), a2, sR, ldA2);
            PG8_WAIT_V(8); PG8_WAIT_L(0); PG8_BAR; PG8_MMA(1, 0, At, B0); PG8_MMA(1, 1, At, B1); PG8_BAR; PG8_SCHED;
            PG8_LDB(B0, 1, 0); PG8_LDB(B1, 1, 1); PG8_SCHED; PG8_LDA(At, 1, 0); PG8_STAGE(PG8_SA(0, 1), a2 + hA2, sR, ldA2);
            PG8_WAIT_V(8); PG8_WAIT_L(0); PG8_BAR; PG8_MMA(0, 0, At, B0); PG8_MMA(0, 1, At, B1); PG8_BAR; PG8_SCHED;
            PG8_LDA(At, 1, 1); PG8_STAGE(PG8_SB(1, 0), b3, sRb, ldB2); PG8_STAGE(PG8_SB(1, 1), b3 + hB2, sRb, ldB2); PG8_STAGE(PG8_SA(1, 0), a3, sR, ldA2);
            PG8_WAIT_V(8); PG8_WAIT_L(0); PG8_BAR; PG8_MMA(1, 0, At, B0); PG8_MMA(1, 1, At, B1); PG8_BAR; PG8_SCHED;
        }
        if constexpr (ALIGN_EPI) { if (wr == 0) PG8_BAR; }
        E(acc, cur, wr, wc, fr, fq);
        if (!has_next) break;
#pragma unroll
        for (int a = 0; a < 2; ++a)
#pragma unroll
            for (int b = 0; b < 2; ++b)
#pragma unroll
                for (int m = 0; m < 4; ++m)
#pragma unroll
                    for (int n = 0; n < 2; ++n) acc[a][b][m][n] = (f32x4){0.f, 0.f, 0.f, 0.f};
        cur = nxt; cA = nA; cB = nB; ++ui;
        ldAc = ldAn; ldBc = ldBn; hAc = hAn; hBc = hBn;
        if constexpr (ALIGN_EPI) { if (wr == 1) PG8_BAR; }
    }
    PG8_WAIT_V(0);
    if constexpr (!ALIGN_EPI) { if (wr == 0) PG8_BAR; }
    PG8_BAR;
#undef PG8_SA
#undef PG8_SB
#undef PG8_STAGE
#undef PG8_LDA
#undef PG8_LDB
#undef PG8_MMA
#undef PG8_WAIT_V
#undef PG8_WAIT_L
#undef PG8_BAR
#undef PG8_SCHED
}
}
using pg8::GUnit;
namespace pg8 {
#define EPI_OPAQUE() asm volatile("" : "+v"(fr), "+v"(fq))
struct EpiBf16 {
    static constexpr bool PERM = true;
    bf16_t* O; int ldc;
    __device__ __forceinline__ void operator()(const f32x4 (&acc)[2][2][4][2], const GUnit& u, int wr, int wc, int fr, int fq) const {
        EPI_OPAQUE();
        const int row0 = u.pm * BM + wr * 64 + fr, col0 = u.pn * BM + wc * 32 + 8 * fq;
#pragma unroll
        for (int ai = 0; ai < 2; ++ai)
#pragma unroll
            for (int m = 0; m < 4; ++m) { bf16_t* rowp = O + (size_t)(row0 + ai * HALF + m * 16) * ldc + col0;
#pragma unroll
                for (int bj = 0; bj < 2; ++bj) { const f32x4 v0 = acc[ai][bj][m][0], v1 = acc[ai][bj][m][1];
                    u32x4 w; w.x = cvtpk(v0[0], v0[1]); w.y = cvtpk(v0[2], v0[3]); w.z = cvtpk(v1[0], v1[1]); w.w = cvtpk(v1[2], v1[3]);
                    *(u32x4*)(rowp + bj * HALF) = w; } }
    }
};
struct EpiF32 {
    static constexpr bool PERM = false;
    float* O; int ldc;
    __device__ __forceinline__ void operator()(const f32x4 (&acc)[2][2][4][2], const GUnit& u, int wr, int wc, int fr, int fq) const {
        EPI_OPAQUE();
        const int row0 = u.pm * BM + wr * 64 + fr, col0 = u.pn * BM + wc * 32 + 4 * fq;
#pragma unroll
        for (int ai = 0; ai < 2; ++ai)
#pragma unroll
            for (int m = 0; m < 4; ++m) { float* rowp = O + (size_t)(row0 + ai * HALF + m * 16) * ldc + col0;
#pragma unroll
                for (int bj = 0; bj < 2; ++bj)
#pragma unroll
                    for (int n = 0; n < 2; ++n) *(f32x4*)(rowp + bj * HALF + n * 16) = acc[ai][bj][m][n]; }
    }
};
__device__ __forceinline__ void rope8(f32x4& v0, f32x4& v1, const float* cs  ) {
    const f32x4 a = *(const f32x4*)cs, b = *(const f32x4*)(cs + 4);
    f32x4 r0, r1;
    r0[0] = v0[0] * a[0] - v0[1] * a[1]; r0[1] = v0[1] * a[0] + v0[0] * a[1];
    r0[2] = v0[2] * a[2] - v0[3] * a[3]; r0[3] = v0[3] * a[2] + v0[2] * a[3];
    r1[0] = v1[0] * b[0] - v1[1] * b[1]; r1[1] = v1[1] * b[0] + v1[0] * b[1];
    r1[2] = v1[2] * b[2] - v1[3] * b[3]; r1[3] = v1[3] * b[2] + v1[2] * b[3];
    v0 = r0; v1 = r1;
}
struct EpiInProj {
    static constexpr bool PERM = true;
    bf16_t* P; bf16_t* kcmp; bf16_t* vcmp; float* side; bf16_t* krot; const float* rope; float* ssq_q; float* ssq_kv; const float* fbias; float* lf;
    __device__ __forceinline__ void operator()(const f32x4 (&acc)[2][2][4][2], const GUnit& u, int wr, int wc, int fr, int fq) const {
        EPI_OPAQUE();
        const int row0 = u.pm * BM + wr * 64 + fr, col0 = u.pn * BM + wc * 32 + 8 * fq;
#pragma unroll
        for (int ai = 0; ai < 2; ++ai)
#pragma unroll
            for (int m = 0; m < 4; ++m) { const int row = row0 + ai * HALF + m * 16; bf16_t* rowp = P + (size_t)row * PW + col0;
                float ssq = 0.f;
#pragma unroll
                for (int bj = 0; bj < 2; ++bj) { f32x4 v0 = acc[ai][bj][m][0], v1 = acc[ai][bj][m][1];
                    if (u.pn == 2 && bj == 1) {
                        if (wc == 0 && fq < 2) { float* sp = side + (size_t)row * 16 + 8 * fq; *(f32x4*)sp = v0; *(f32x4*)(sp + 4) = v1;
                            if (fq == 1) { const f32x4 fb = *(const f32x4*)fbias; f32x4 s1;
#pragma unroll
                                for (int e = 0; e < 4; ++e) { const float x = v1[e] + fb[e]; s1[e] = (x >= 0.f) ? -log1pf(expf(-x)) : (x - log1pf(expf(x))); }
                                *(f32x4*)(lf + (size_t)row * 4) = s1; } }
                        if (wc == 1) { rope8(v0, v1, rope + (size_t)(row & (SEQ - 1)) * 32 + 8 * fq);
                            u32x4 w; w.x = cvtpk(v0[0], v0[1]); w.y = cvtpk(v0[2], v0[3]); w.z = cvtpk(v1[0], v1[1]); w.w = cvtpk(v1[2], v1[3]);
                            *(u32x4*)(krot + (size_t)row * 32 + 8 * fq) = w; }
                    }
                    u32x4 w; w.x = cvtpk(v0[0], v0[1]); w.y = cvtpk(v0[2], v0[3]); w.z = cvtpk(v1[0], v1[1]); w.w = cvtpk(v1[2], v1[3]);
                    *(u32x4*)(rowp + bj * HALF) = w;
                    if (u.pn == 1 && bj == 0) { bf16_t* cp = (wc < 2 ? kcmp : vcmp) + (size_t)row * 64 + (wc & 1) * 32 + 8 * fq; *(u32x4*)cp = w; }
                    if (u.pn == 11 || (u.pn == 7 && bj == 1)) ssq += (v0[0] * v0[0] + v0[1] * v0[1]) + (v0[2] * v0[2] + v0[3] * v0[3]) + (v1[0] * v1[0] + v1[1] * v1[1]) + (v1[2] * v1[2] + v1[3] * v1[3]);
                }
                if (u.pn == 11 || u.pn == 7) { ssq += xor_lane_lt32<16>(ssq); ssq = sum_halves(ssq);
                    if (fq == 0) (u.pn == 11 ? ssq_q : ssq_kv)[(size_t)row * 4 + wc] = ssq; }
                asm volatile("" ::: "memory");
            }
    }
};
struct EpiQup {
    static constexpr bool PERM = true;
    bf16_t* O; const float* ssq_q; const float* rope;
    __device__ __forceinline__ void operator()(const f32x4 (&acc)[2][2][4][2], const GUnit& u, int wr, int wc, int fr, int fq) const {
        EPI_OPAQUE();
        const int row0 = u.pm * BM + wr * 64 + fr, col0 = u.pn * BM + wc * 32 + 8 * fq;
#pragma unroll
        for (int ai = 0; ai < 2; ++ai)
#pragma unroll
            for (int m = 0; m < 4; ++m) { const int row = row0 + ai * HALF + m * 16; bf16_t* rowp = O + (size_t)row * 512 + col0;
                const f32x4 pq = *(const f32x4*)(ssq_q + (size_t)row * 4);
                const float rstd = 1.0f / sqrtf(((pq[0] + pq[1]) + (pq[2] + pq[3])) * (1.0f / 256.0f) + RMS_EPS);
#pragma unroll
                for (int bj = 0; bj < 2; ++bj) { f32x4 v0 = acc[ai][bj][m][0] * rstd, v1 = acc[ai][bj][m][1] * rstd;
                    const int c8 = col0 + bj * HALF, within = c8 % 96;
                    if (c8 < 384 && within >= 64) rope8(v0, v1, rope + (size_t)(row & (SEQ - 1)) * 32 + (within - 64));
                    u32x4 w; w.x = cvtpk(v0[0], v0[1]); w.y = cvtpk(v0[2], v0[3]); w.z = cvtpk(v1[0], v1[1]); w.w = cvtpk(v1[2], v1[3]);
                    *(u32x4*)(rowp + bj * HALF) = w; }
                asm volatile("" ::: "memory"); }
    }
};
struct EpiKVup {
    static constexpr bool PERM = true;
    bf16_t* O; const float* ssq_kv;
    __device__ __forceinline__ void operator()(const f32x4 (&acc)[2][2][4][2], const GUnit& u, int wr, int wc, int fr, int fq) const {
        EPI_OPAQUE();
        const int row0 = u.pm * BM + wr * 64 + fr, col0 = u.pn * BM + wc * 32 + 8 * fq;
#pragma unroll
        for (int ai = 0; ai < 2; ++ai)
#pragma unroll
            for (int m = 0; m < 4; ++m) { const int row = row0 + ai * HALF + m * 16; bf16_t* rowp = O + (size_t)row * 512 + col0;
                const f32x4 pq = *(const f32x4*)(ssq_kv + (size_t)row * 4);
                const float rstd = 1.0f / sqrtf(((pq[0] + pq[1]) + (pq[2] + pq[3])) * (1.0f / 128.0f) + RMS_EPS);
#pragma unroll
                for (int bj = 0; bj < 2; ++bj) { const f32x4 v0 = acc[ai][bj][m][0] * rstd, v1 = acc[ai][bj][m][1] * rstd;
                    u32x4 w; w.x = cvtpk(v0[0], v0[1]); w.y = cvtpk(v0[2], v0[3]); w.z = cvtpk(v1[0], v1[1]); w.w = cvtpk(v1[2], v1[3]);
                    *(u32x4*)(rowp + bj * HALF) = w; }
                asm volatile("" ::: "memory"); }
    }
};
__device__ __forceinline__ float gelu_tanh(float x) { const float u2 = 2.0f * 0.7978845608028654f * (x + 0.044715f * x * x * x); return x * fast_rcp(1.0f + fast_exp2(-u2 * LOG2E)); }
struct EpiCmp1 {
    static constexpr bool PERM = true;
    bf16_t* O; const float* bias1;
    __device__ __forceinline__ void operator()(const f32x4 (&acc)[2][2][4][2], const GUnit& u, int wr, int wc, int fr, int fq) const {
        EPI_OPAQUE();
        const int row0 = u.pm * BM + wr * 64 + fr, col0 = wc * 32 + 8 * fq;
        f32x4 bv[2][2];
#pragma unroll
        for (int bj = 0; bj < 2; ++bj)
#pragma unroll
            for (int n = 0; n < 2; ++n) bv[bj][n] = *(const f32x4*)(bias1 + col0 + bj * HALF + 4 * n);
#pragma unroll
        for (int ai = 0; ai < 2; ++ai)
#pragma unroll
            for (int m = 0; m < 4; ++m) { bf16_t* rowp = O + (size_t)(row0 + ai * HALF + m * 16) * 256 + col0;
#pragma unroll
                for (int bj = 0; bj < 2; ++bj) { f32x4 v0 = acc[ai][bj][m][0] + bv[bj][0], v1 = acc[ai][bj][m][1] + bv[bj][1];
#pragma unroll
                    for (int e = 0; e < 4; ++e) { v0[e] = gelu_tanh(v0[e]); v1[e] = gelu_tanh(v1[e]); }
                    u32x4 w; w.x = cvtpk(v0[0], v0[1]); w.y = cvtpk(v0[2], v0[3]); w.z = cvtpk(v1[0], v1[1]); w.w = cvtpk(v1[2], v1[3]);
                    *(u32x4*)(rowp + bj * HALF) = w; } }
    }
};
typedef __amdgpu_buffer_rsrc_t rsrc_t;
struct EpiMerge {
    static constexpr bool PERM = true;
    bf16_t* O;
    unsigned char* scr;
    __device__ __forceinline__ void operator()(const f32x4 (&acc)[2][2][4][2], const GUnit& u, int wr, int wc, int fr, int fq) const {
        EPI_OPAQUE();
        const int tid = (wr * 4 + wc) * 64 + fq * 16 + fr;
        const int sub = u.id;
        const rsrc_t rs = __builtin_amdgcn_make_buffer_rsrc(scr, 0, 524288, 0x00020000);
        if (sub < 4) {
#pragma unroll
            for (int ai = 0; ai < 2; ++ai)
#pragma unroll
                for (int bj = 0; bj < 2; ++bj)
#pragma unroll
                    for (int m = 0; m < 4; ++m)
#pragma unroll
                        for (int n = 0; n < 2; ++n) { const int q = ((ai * 2 + bj) * 4 + m) * 2 + n; const f32x4 v = acc[ai][bj][m][n];
                            u32x2 w; w.x = cvtpk(v[0], v[1]); w.y = cvtpk(v[2], v[3]);
                            __builtin_amdgcn_raw_buffer_store_b64(w, rs, tid * 8, (sub * 32 + q) * 4096, 0); }
            return;
        }
        const int j = sub - 4;
        const int row0 = u.pm * BM + wr * 64 + fr, col0 = u.pn * BM + 64 * j + wc * 16 + 4 * fq;
#pragma unroll
        for (int ai = 0; ai < 2; ++ai)
#pragma unroll
            for (int m = 0; m < 4; ++m) { bf16_t* rowp = O + (size_t)(row0 + ai * HALF + m * 16) * DM + col0;
                f32x4 t = {0.f, 0.f, 0.f, 0.f};
#pragma unroll
                for (int g = 0; g < 4; ++g) { const f32x4 gt = acc[ai][g >> 1][m][g & 1];
                    const int qb = (ai * 16 + m * 2);
                    const u32x2 s = (j == 0) ? __builtin_amdgcn_raw_buffer_load_b64(rs, tid * 8, (g * 32 + qb) * 4096, 0)
                                  : (j == 1) ? __builtin_amdgcn_raw_buffer_load_b64(rs, tid * 8, (g * 32 + qb + 1) * 4096, 0)
                                  : (j == 2) ? __builtin_amdgcn_raw_buffer_load_b64(rs, tid * 8, (g * 32 + qb + 8) * 4096, 0)
                                             : __builtin_amdgcn_raw_buffer_load_b64(rs, tid * 8, (g * 32 + qb + 9) * 4096, 0);
                    t[0] += sigmoid_f(gt[0]) * __uint_as_float(s.x << 16); t[1] += sigmoid_f(gt[1]) * __uint_as_float(s.x & 0xffff0000u);
                    t[2] += sigmoid_f(gt[2]) * __uint_as_float(s.y << 16); t[3] += sigmoid_f(gt[3]) * __uint_as_float(s.y & 0xffff0000u); }
                u32x2 w; w.x = cvtpk(t[0], t[1]); w.y = cvtpk(t[2], t[3]);
                *(u32x2*)rowp = w;
                asm volatile("" ::: "memory"); }
    }
};
__device__ __forceinline__ float dpp_ror1(float v) { return __uint_as_float((unsigned)__builtin_amdgcn_update_dpp(0, (int)__float_as_uint(v), 0x121, 0xf, 0xf, false)); }
__device__ __forceinline__ float dpp_ror2(float v) { return __uint_as_float((unsigned)__builtin_amdgcn_update_dpp(0, (int)__float_as_uint(v), 0x122, 0xf, 0xf, false)); }
struct EpiUpConv {
    static constexpr bool PERM = true;
    bf16_t* ACT; float* HB; const float* cw; const float* cb;
    __device__ __forceinline__ void operator()(const f32x4 (&acc)[2][2][4][2], const GUnit& u, int wr, int wc, int fr, int fq) const {
        EPI_OPAQUE();
        const int colL = wc * 32 + 8 * fq;
#pragma unroll
        for (int ai = 0; ai < 2; ++ai) {
            const int rowg = u.pm * BM + ai * HALF + wr * 64, g = rowg >> 6;
#pragma unroll
            for (int n = 0; n < 2; ++n) {
                const int cl = colL + 4 * n, c0 = u.pn * 128 + cl;
                f32x4 t1g, t2g, t1v, t2v;
#pragma unroll
                for (int e = 0; e < 4; ++e) { t1g[e] = 0.f; t2g[e] = 0.f; t1v[e] = 0.f; t2v[e] = 0.f; }
#pragma unroll
                for (int m = 0; m < 4; ++m) {
                    const f32x4 bg = *(const f32x4*)(cb + c0), w0g = *(const f32x4*)(cw + c0), w1g = *(const f32x4*)(cw + DFF2 + c0), w2g = *(const f32x4*)(cw + 2 * DFF2 + c0);
                    const f32x4 bv = *(const f32x4*)(cb + DFF + c0), w0v = *(const f32x4*)(cw + DFF + c0), w1v = *(const f32x4*)(cw + DFF2 + DFF + c0), w2v = *(const f32x4*)(cw + 2 * DFF2 + DFF + c0);
                    const f32x4 cg = acc[ai][0][m][n], cv = acc[ai][1][m][n];
                    f32x4 r1g, r2g, r1v, r2v, o;
#pragma unroll
                    for (int e = 0; e < 4; ++e) { r1g[e] = dpp_ror1(cg[e]); r2g[e] = dpp_ror2(cg[e]); r1v[e] = dpp_ror1(cv[e]); r2v[e] = dpp_ror2(cv[e]); }
#pragma unroll
                    for (int e = 0; e < 4; ++e) { const float p1g = (fr == 0) ? t1g[e] : r1g[e], p2g = (fr < 2) ? t2g[e] : r2g[e], p1v = (fr == 0) ? t1v[e] : r1v[e], p2v = (fr < 2) ? t2v[e] : r2v[e];
                        const float gt = bg[e] + w0g[e] * p2g + w1g[e] * p1g + w2g[e] * cg[e], vl = bv[e] + w0v[e] * p2v + w1v[e] * p1v + w2v[e] * cv[e];
                        o[e] = gt * sigmoid_f(gt) * vl; }
                    const int row = rowg + m * 16 + fr;
                    if (!(m == 0 && fr < 2)) { u32x2 w; w.x = cvtpk(o[0], o[1]); w.y = cvtpk(o[2], o[3]); *(u32x2*)(ACT + (size_t)row * DFF + c0) = w; }
                    if (m == 0 && fr < 2) { float* hp = HB + ((size_t)((g * 4 + fr) * 22 + u.pn) * 256 + cl); *(f32x4*)hp = cg; *(f32x4*)(hp + 128) = cv; }
                    if (m == 3 && fr >= 14) { float* hp = HB + ((size_t)((g * 4 + fr - 12) * 22 + u.pn) * 256 + cl); *(f32x4*)hp = cg; *(f32x4*)(hp + 128) = cv; }
                    t1g = r1g; t2g = r2g; t1v = r1v; t2v = r2v;
                    asm volatile("" ::: "memory");
                }
            }
        }
    }
};
}
#define XB_TMO      128
#define XB_XCNT(j)  (256  + 64 * (j))
#define XB_XSUB(j)  (1280 + 64 * (j))
#define XB_XGEN(j)  (2304 + 64 * (j))
#define XB_TOP      3328
#define XB_TOPGEN   3392
#define XCD_BAR_WORDS 3456
#define XB_SPIN_CAP (1u << 22)
__device__ __forceinline__ unsigned xb_ld(unsigned* p)              { return __hip_atomic_load(p, __ATOMIC_RELAXED, __HIP_MEMORY_SCOPE_AGENT); }
__device__ __forceinline__ unsigned xb_add(unsigned* p, unsigned v) { return __hip_atomic_fetch_add(p, v, __ATOMIC_RELAXED, __HIP_MEMORY_SCOPE_AGENT); }
__device__ __forceinline__ unsigned xb_xcc_id() { return (unsigned)__builtin_amdgcn_s_getreg((3 << 11) | 20) & 0xFu; }
#define XB_SPIN(cond, bar) do { unsigned _sp = 0; while (cond) { __builtin_amdgcn_s_sleep(1); \
    if ((++_sp & 255u) == 0u) { if (xb_ld(&(bar)[XB_TMO])) break; if (_sp > XB_SPIN_CAP) { atomicAdd(&(bar)[XB_TMO], 1u); break; } } } } while (0)
struct XcdBarrier { unsigned* bar; unsigned x; volatile LAS unsigned* st; };
__device__ __forceinline__ XcdBarrier xcd_barrier_post(unsigned* bar, volatile LAS unsigned* st) {
    XcdBarrier b; b.bar = bar; b.x = xb_xcc_id(); b.st = st;
    if (threadIdx.x == 0) (void)xb_add(&bar[XB_XCNT(b.x)], 1u);
    return b;
}
__device__ __forceinline__ void xcd_barrier_complete(unsigned* bar, unsigned x, unsigned& nloc, unsigned& nx) {
    const unsigned G = gridDim.x * gridDim.y * gridDim.z;
    unsigned sum, cnt, mine, sp = 0u;
    for (;;) {
        sum = 0u; cnt = 0u; mine = 0u;
#pragma unroll
        for (unsigned j = 0; j < 16; ++j) { const unsigned c = xb_ld(&bar[XB_XCNT(j)]); sum += c; cnt += (c > 0u) ? 1u : 0u; mine = (j == x) ? c : mine; }
        if (sum == G) break;
        __builtin_amdgcn_s_sleep(1);
        if ((++sp & 255u) == 0u) { if (xb_ld(&bar[XB_TMO])) break; if (sp > XB_SPIN_CAP) { atomicAdd(&bar[XB_TMO], 1u); break; } }
    }
    nloc = mine > 0u ? mine : 1u; nx = cnt > 0u ? cnt : 1u;
}
__device__ __forceinline__ void xcd_barrier(const XcdBarrier& b) {
    asm volatile("s_waitcnt vmcnt(0)" ::: "memory");
    __syncthreads();
    if (threadIdx.x == 0) {
        unsigned* bar = b.bar; unsigned bx = b.x;
        asm volatile("" : "+s"(bx));
        __builtin_amdgcn_s_waitcnt(0);
        unsigned nloc = b.st[0], nx = b.st[1];
        if (nloc == 0u) { xcd_barrier_complete(bar, bx, nloc, nx); b.st[0] = nloc; b.st[1] = nx; }
        const unsigned old = xb_add(&bar[XB_XSUB(bx)], 1u);
        const unsigned gen = old / nloc;
        if (old + 1u == (gen + 1u) * nloc) {
            __builtin_amdgcn_fence(__ATOMIC_RELEASE, "agent");
            asm volatile("s_waitcnt vmcnt(0)" ::: "memory");
            const unsigned og = xb_add(&bar[XB_TOP], 1u);
            const unsigned tg = og / nx;
            if (og + 1u == (tg + 1u) * nx) xb_add(&bar[XB_TOPGEN], 1u);
            else XB_SPIN(xb_ld(&bar[XB_TOPGEN]) == tg, bar);
            __builtin_amdgcn_fence(__ATOMIC_ACQUIRE, "agent");
            xb_add(&bar[XB_XGEN(bx)], 1u);
            asm volatile("s_waitcnt vmcnt(0)" ::: "memory");
        } else {
            XB_SPIN(xb_ld(&bar[XB_XGEN(bx)]) == gen, bar);
            __builtin_amdgcn_fence(__ATOMIC_ACQUIRE, "agent");
            asm volatile("s_waitcnt vmcnt(0)" ::: "memory");
        }
    }
    __syncthreads();
}

#define MFMA32(a, b, c) __builtin_amdgcn_mfma_f32_32x32x16_bf16(a, b, c, 0, 0, 0)
typedef short v4i16_t __attribute__((ext_vector_type(4)));
typedef LAS const char* lds_cptr;
typedef LAS char* lds_ptr;
__device__ __forceinline__ int crow(int r, int hi) { return (r & 3) + 8 * (r >> 2) + 4 * hi; }
__device__ __forceinline__ s16x4 vtr(lds_cptr p) { return __builtin_bit_cast(s16x4, __builtin_amdgcn_ds_read_tr16_b64_v4i16((LAS v4i16_t*)p)); }
__device__ __forceinline__ float other_half(float x, int hi) { auto rr = __builtin_amdgcn_permlane32_swap(__float_as_uint(x), __float_as_uint(x), false, false); return __uint_as_float(hi ? rr[0] : rr[1]); }
constexpr float NEG_INF = -INFINITY;

constexpr int TB_V = 12288, TB_KB = 20480, TB_SIZE = 20992;
struct Stg { u32x4 k, k2, v; float kb; };

template <int NKS> __device__ __forceinline__ void qk64(lds_cptr kbuf, const bf16x8* qf, int r32, int hi, f32x16& p0, f32x16& p1) {
    lds_cptr kp = kbuf + hi * 1024 + r32 * 16;
#pragma unroll
    for (int ks = 0; ks < NKS; ++ks) {
        const bf16x8 a0 = *(const LAS bf16x8*)(kp + ks * 2048), a1 = *(const LAS bf16x8*)(kp + ks * 2048 + 512);
        p0 = MFMA32(a0, qf[ks], p0); p1 = MFMA32(a1, qf[ks], p1);
    }
}
struct AState { f32x16 o0, o1; float m, l; };
__device__ __forceinline__ void astate_init(AState& s) {
#pragma unroll
    for (int r = 0; r < 16; ++r) { s.o0[r] = 0.f; s.o1[r] = 0.f; }
    s.m = NEG_INF; s.l = 0.f;
}
__device__ __forceinline__ void pv64(f32x16& o0, f32x16& o1, lds_cptr vp, const bf16x8 (&pf)[4]) {
#pragma unroll
    for (int ks = 0; ks < 4; ++ks) {
        const s16x4 l0 = vtr(vp + ks * 1024), h0 = vtr(vp + ks * 1024 + 512), l1 = vtr(vp + 4096 + ks * 1024), h1 = vtr(vp + 4096 + ks * 1024 + 512);
        const bf16x8 v0 = (bf16x8){l0[0], l0[1], l0[2], l0[3], h0[0], h0[1], h0[2], h0[3]}, v1 = (bf16x8){l1[0], l1[1], l1[2], l1[3], h1[0], h1[1], h1[2], h1[3]};
        o0 = MFMA32(v0, pf[ks], o0); o1 = MFMA32(v1, pf[ks], o1);
    }
}
__device__ __forceinline__ void pack_p(const f32x16& p0, const f32x16& p1, bf16x8 (&pf)[4]) {
    u32x4 w0, w1, w2, w3;
    w0.x = cvtpk(p0[0], p0[1]); w0.y = cvtpk(p0[2], p0[3]); w0.z = cvtpk(p0[4], p0[5]); w0.w = cvtpk(p0[6], p0[7]);
    w1.x = cvtpk(p0[8], p0[9]); w1.y = cvtpk(p0[10], p0[11]); w1.z = cvtpk(p0[12], p0[13]); w1.w = cvtpk(p0[14], p0[15]);
    w2.x = cvtpk(p1[0], p1[1]); w2.y = cvtpk(p1[2], p1[3]); w2.z = cvtpk(p1[4], p1[5]); w2.w = cvtpk(p1[6], p1[7]);
    w3.x = cvtpk(p1[8], p1[9]); w3.y = cvtpk(p1[10], p1[11]); w3.z = cvtpk(p1[12], p1[13]); w3.w = cvtpk(p1[14], p1[15]);
    pf[0] = __builtin_bit_cast(bf16x8, w0); pf[1] = __builtin_bit_cast(bf16x8, w1); pf[2] = __builtin_bit_cast(bf16x8, w2); pf[3] = __builtin_bit_cast(bf16x8, w3);
}
__device__ __forceinline__ void softmax_pv64(f32x16& p0, f32x16& p1, AState& s, lds_cptr vp, int hi) {
    float mx = fmaxf(p0[0], p1[0]);
#pragma unroll
    for (int r = 1; r < 16; ++r) mx = fmaxf(mx, fmaxf(p0[r], p1[r]));
    mx = fmaxf(mx, other_half(mx, hi));
    const float mn = fmaxf(s.m, mx), ms = (mn == NEG_INF) ? 0.f : mn;
    const float alpha = fast_exp2(s.m - ms);
    float rs = 0.f;
#pragma unroll
    for (int r = 0; r < 16; ++r) { p0[r] = fast_exp2(p0[r] - ms); p1[r] = fast_exp2(p1[r] - ms); rs += p0[r] + p1[r]; }
    rs += other_half(rs, hi);
    s.l = s.l * alpha + rs; s.m = mn;
#pragma unroll
    for (int r = 0; r < 16; ++r) { s.o0[r] *= alpha; s.o1[r] *= alpha; }
    bf16x8 pf[4]; pack_p(p0, p1, pf);
    pv64(s.o0, s.o1, vp, pf);
}
__device__ __forceinline__ void mask_causal(f32x16& p0, f32x16& p1, int kpos0, int tq, int hi) {
#pragma unroll
    for (int r = 0; r < 16; ++r) { const int kp = kpos0 + crow(r, hi); if (kp > tq) p0[r] = NEG_INF; if (kp + 32 > tq) p1[r] = NEG_INF; }
}
__device__ __forceinline__ void add_table(f32x16& p0, f32x16& p1, const LAS float* tb) {
#pragma unroll
    for (int r = 0; r < 16; ++r) { const int o = (r & 3) + 8 * (r >> 2); p0[r] += tb[o]; p1[r] += tb[o + 32]; }
}
__device__ __forceinline__ void store_o_bf16(bf16_t* orow, const f32x16& o0, const f32x16& o1, float sc, int hi) {
#pragma unroll
    for (int g = 0; g < 4; ++g) {
        u32x2 w0, w1; w0.x = cvtpk(o0[4 * g] * sc, o0[4 * g + 1] * sc); w0.y = cvtpk(o0[4 * g + 2] * sc, o0[4 * g + 3] * sc);
        w1.x = cvtpk(o1[4 * g] * sc, o1[4 * g + 1] * sc); w1.y = cvtpk(o1[4 * g + 2] * sc, o1[4 * g + 3] * sc);
        *(u32x2*)(orow + 8 * g + 4 * hi) = w0; *(u32x2*)(orow + 32 + 8 * g + 4 * hi) = w1;
    }
}
constexpr size_t MiB = 1u << 20, KiB = 1u << 10;
constexpr size_t WS_CTL = 0, CTL_ZERO_BYTES = 1 * MiB;
constexpr size_t WS_ROPE = 1 * MiB, WS_NSATAB = WS_ROPE + 512 * KiB, WS_DILTAB = WS_NSATAB + 32 * KiB, WS_CMPB = WS_DILTAB + 8 * KiB, WS_FARB = WS_CMPB + 4 * KiB;
constexpr size_t WS_WT = 4 * MiB, LW = 38 * MiB;
constexpr size_t LW_IN = 0, LW_G = 6 * MiB, LW_BR = 14 * MiB, LW_O = 16 * MiB, LW_UP = 18 * MiB, LW_DN = 29 * MiB, LW_UQ = 35 * MiB, LW_UKV = 35 * MiB + 256 * KiB, LW_PHI = 36 * MiB;
constexpr size_t BR_A = 0, BR_B = 512 * KiB, BR_C = 768 * KiB, BR_D = 1280 * KiB;
constexpr size_t WS_SIDE = 80 * MiB, WS_SSQQ = 84 * MiB, WS_SSQKV = 85 * MiB, WS_KB = 86 * MiB, WS_KROT = 87 * MiB, WS_KCMP = 91 * MiB, WS_VCMP = 100 * MiB,
                 WS_HID = 109 * MiB, WS_KMAX = 3 * MiB + 128 * KiB  , WS_LF = 2 * MiB  , WS_CMPP = 3 * MiB  , WS_ORDER = 3 * MiB + 64 * KiB  , WS_KC = 113 * MiB, WS_VC = 113 * MiB + 512 * KiB, WS_DLSE = 114 * MiB, WS_DOG = 116 * MiB;
constexpr size_t WS_H = 164 * MiB, WS_OCAT = 292 * MiB, WS_QM = 404 * MiB, WS_KVM = 468 * MiB, WS_P = 532 * MiB;
constexpr size_t WS_MERGED = 532 * MiB, WS_MSCR = 660 * MiB, WS_Y = 164 * MiB  , WS_H2 = 756 * MiB, WS_ACT = 164 * MiB  , WS_HB = 532 * MiB  , WS_Y2 = 884 * MiB  , WS_END = 1024 * MiB;
constexpr size_t MSCR_PER_WG = 512 * KiB;
static_assert(WS_WT + 2 * LW <= WS_SIDE && WS_DOG + 48 * MiB <= WS_H && WS_P + 384 * MiB <= WS_END && WS_MSCR + 256 * MSCR_PER_WG <= WS_P + 384 * MiB && WS_H2 + 128 * MiB <= WS_Y2 && WS_Y2 + 128 * MiB <= WS_END, "ws map");
static_assert(WS_ACT + 352 * MiB <= WS_HB && WS_HB + 96 * MiB <= WS_H2 && WS_Y + 128 * MiB <= WS_OCAT, "ws overlays");
constexpr int CW_BAR = 4096;
constexpr int CW_Q = 16384;

constexpr int RING_BYTES = 131072, LDSCTL_OFF = RING_BYTES, MISC_OFF = LDSCTL_OFF + 320, LDS_BYTES = 147456;
constexpr int NSA_SLAB = 49152, NSA_SLAB_BYTES = 4 * 64 * 65 * 4, NSA_SEL = NSA_SLAB + NSA_SLAB_BYTES;
static_assert(NSA_SEL + 512 <= RING_BYTES && 4 * NSA_TL * 4 <= NSA_SLAB_BYTES && 2 * TB_SIZE <= NSA_SLAB, "NSA LDS map");

struct Frame {
    LAS unsigned char* lds; volatile LAS unsigned* MISC; gu32* ctl;
    int tid, lane, wave, G;
    const float* in[27]; float* out; unsigned char* ws;
};
#define WSP(T, off) ((T*)(F.ws + (off)))
#define VM_WAIT() asm volatile("s_waitcnt vmcnt(0)" ::: "memory")
#define LDS_WAIT() asm volatile("s_waitcnt lgkmcnt(0)" ::: "memory")

__device__ __forceinline__ int queue_grab(Frame& F, gu32* ctr) {
    if (F.tid == 0) F.MISC[0] = __hip_atomic_fetch_add(ctr, 1u, __ATOMIC_RELAXED, __HIP_MEMORY_SCOPE_AGENT);
    __syncthreads();
    const int v = (int)F.MISC[0];
    __syncthreads();
    return v;
}

template <bool FOX> __device__ __forceinline__ void causal_unit(Frame& F, int b, int h, int qb) {
    constexpr int NKS = FOX ? 4 : 6;
    int lane_o = F.lane; asm volatile("" : "+v"(lane_o));
    const int wid = F.wave, lane = lane_o, r32 = lane & 31, hi = lane >> 5;
    const size_t rowbase = (size_t)b * SEQ;
    const int q0 = qb * 256, tq = q0 + wid * 32 + r32, NT = qb * 4 + 4;
    const bf16_t* P = WSP(const bf16_t, WS_P);
    const bf16_t *Kb, *Vb, *Qrow; int kpitch, vpitch;
    const bf16_t* Kr = WSP(const bf16_t, WS_KROT) + rowbase * 32;
    const float* kbsrc = WSP(const float, WS_KB) + (size_t)(b * 4 + h) * SEQ;
    if (FOX) { Kb = P + rowbase * PW + PC_CK + h * 64; Vb = P + rowbase * PW + PC_CV + h * 64; kpitch = PW; vpitch = PW; Qrow = P + (rowbase + tq) * PW + PC_CQ + h * 64; }
    else { const bf16_t* KV = WSP(const bf16_t, WS_KVM) + rowbase * 512 + h * 128; Kb = KV; Vb = KV + 64; kpitch = 512; vpitch = 512; Qrow = WSP(const bf16_t, WS_QM) + (rowbase + tq) * 512 + h * 96; }
    bf16x8 qf[NKS];
#pragma unroll
    for (int ks = 0; ks < NKS; ++ks) qf[ks] = *(const bf16x8*)(Qrow + ks * 16 + hi * 8);
    AState st; astate_init(st);
    lds_ptr lds = (lds_ptr)F.lds;
    const int vpo = ((lane >> 4) & 1) * 32 + (lane & 3) * 8 + (4 * hi + ((lane & 15) >> 2)) * 64;
    Stg s;
#define CU_LOAD(t) do { s.k = *(const u32x4*)(Kb + (size_t)((t) * 64 + lane) * kpitch + wid * 8); \
        if (!FOX) { if (wid < 4) s.k2 = *(const u32x4*)(Kr + (size_t)((t) * 64 + lane) * 32 + wid * 8); } \
        s.v = *(const u32x4*)(Vb + (size_t)((t) * 64 + 16 * (wid & 3) + (lane >> 2)) * vpitch + (wid >> 2) * 32 + (lane & 3) * 8); \
        if (FOX) { if (wid == 0) s.kb = kbsrc[(t) * 64 + lane]; } } while (0)
#define CU_WRITE(bi) do { lds_ptr bp = lds + (bi) * TB_SIZE; *(LAS u32x4*)(bp + wid * 1024 + lane * 16) = s.k; \
        if (!FOX) { if (wid < 4) *(LAS u32x4*)(bp + (8 + wid) * 1024 + lane * 16) = s.k2; } \
        *(LAS u32x4*)(bp + TB_V + wid * 1024 + lane * 16) = s.v; \
        if (FOX) { if (wid == 0) *(LAS float*)(bp + TB_KB + lane * 4) = s.kb; } } while (0)
    const int tq_lo = q0 + wid * 32;
    float qn = 0.f, kmax = 0.f;
    if (FOX) {
#pragma unroll
        for (int ks = 0; ks < NKS; ++ks)
#pragma unroll
            for (int e = 0; e < 8; ++e) { const float x = bf2f((unsigned short)qf[ks][e]); qn += x * x; }
        qn += other_half(qn, hi); qn = sqrtf(qn); kmax = WSP(const float, WS_KMAX)[b * 4 + h];
    }
    LAS volatile unsigned* dflag = (LAS volatile unsigned*)(lds + 2 * TB_SIZE + 64);
    const int t_first = FOX ? NT - 1 : 0, t_step = FOX ? -1 : 1;
    CU_LOAD(t_first); CU_WRITE(0);
    __syncthreads();
    for (int tt = 0; tt < NT; ++tt) {
        const int bi = tt & 1, t = t_first + tt * t_step;
        if (tt + 1 < NT) CU_LOAD(t + t_step);
        if (64 * t <= tq_lo + 31) {
            lds_cptr bp = (lds_cptr)(lds + bi * TB_SIZE);
            f32x16 p0, p1;
#pragma unroll
            for (int r = 0; r < 16; ++r) { p0[r] = 0.f; p1[r] = 0.f; }
            qk64<NKS>(bp, qf, r32, hi, p0, p1);
            if (FOX) {
                const LAS float* kbt = (const LAS float*)(bp + TB_KB) + 4 * hi;
#pragma unroll
                for (int g = 0; g < 4; ++g) { const f32x4 a = *(const LAS f32x4*)(kbt + 8 * g), c = *(const LAS f32x4*)(kbt + 32 + 8 * g);
#pragma unroll
                    for (int e = 0; e < 4; ++e) { p0[4 * g + e] += a[e]; p1[4 * g + e] += c[e]; } }
            }
            if (64 * t + 63 > tq_lo) mask_causal(p0, p1, 64 * t, tq, hi);
            softmax_pv64(p0, p1, st, bp + TB_V + vpo, hi);
        }
        if (FOX) { if (t > 0) { const float kb_last = kbsrc[64 * t - 1]; const bool done = (qn * kmax + kb_last - st.m) < -130.0f; const unsigned alld = __all(done) ? 1u : 0u; if (lane == 0) dflag[bi * 8 + wid] = alld; } }
        if (tt + 1 < NT) CU_WRITE(bi ^ 1);
        __syncthreads();
        if (FOX) { if (t > 0) { unsigned all = 1u;
#pragma unroll
                for (int w = 0; w < 8; ++w) all &= dflag[bi * 8 + w];
                if (all) break; } }
    }
#undef CU_LOAD
#undef CU_WRITE
    bf16_t* orow = WSP(bf16_t, WS_OCAT) + (rowbase + tq) * OCW + (FOX ? 384 : 640) + h * 64;
    store_o_bf16(orow, st.o0, st.o1, 1.0f / st.l, hi);
}
__device__ __forceinline__ void nsa_unit(Frame& F, int b, int qblk) {
    int lane_o = F.lane; asm volatile("" : "+v"(lane_o));
    const int wid = F.wave, lane = lane_o, r32 = lane & 31, hi = lane >> 5, tid = wid * 64 + lane;
    const int h = wid & 3, qs = wid >> 2;
    const int q0 = qblk * 64, cur = qblk, tq = q0 + 32 * qs + r32, tq_lo = q0 + 32 * qs;
    const size_t rowbase = (size_t)b * SEQ, row = rowbase + tq;
    const bf16_t* P = WSP(const bf16_t, WS_P);
    lds_ptr lds = (lds_ptr)F.lds;
    const int vpo = ((lane >> 4) & 1) * 32 + (lane & 3) * 8 + (4 * hi + ((lane & 15) >> 2)) * 64;
    bf16x8 qf[4];
    { const bf16_t* Qrow = P + row * PW + PC_AQ + h * 64;
#pragma unroll
      for (int ks = 0; ks < 4; ++ks) qf[ks] = *(const bf16x8*)(Qrow + ks * 16 + hi * 8); }
    Stg s; int ln;
#define NS_LOAD(Kb, kp, Vb, vp_, t) do { s.k = *(const u32x4*)((Kb) + (size_t)((t) * 64 + ln) * (kp) + wid * 8); \
        s.v = *(const u32x4*)((Vb) + (size_t)((t) * 64 + 16 * (wid & 3) + (ln >> 2)) * (vp_) + (wid >> 2) * 32 + (ln & 3) * 8); } while (0)
#define NS_FRESH() do { ln = lane; asm volatile("" : "+v"(ln)); } while (0)
#define NS_WRITE(bi) do { lds_ptr bp_ = lds + (bi) * TB_SIZE; *(LAS u32x4*)(bp_ + wid * 1024 + lane * 16) = s.k; *(LAS u32x4*)(bp_ + TB_V + wid * 1024 + lane * 16) = s.v; } while (0)
    const bf16_t* KC = WSP(const bf16_t, WS_KC) + (size_t)b * 256 * 64; const bf16_t* VC = WSP(const bf16_t, WS_VC) + (size_t)b * 256 * 64;
    const int cmax_u = (q0 + 63 - 31) >> 4, NTc = (cmax_u >> 6) + 1;
    const int cmax = (tq - 31) >> 4;
    float cm = NEG_INF, cl = 0.f;
    NS_FRESH(); NS_LOAD(KC, 64, VC, 64, 0); NS_WRITE(0);
    __syncthreads();
    for (int t = 0; t < NTc; ++t) {
        const int bi = t & 1;
        if (t + 1 < NTc) NS_LOAD(KC, 64, VC, 64, t + 1);
        { lds_cptr bp = (lds_cptr)(lds + bi * TB_SIZE); f32x16 p0, p1;
#pragma unroll
          for (int r = 0; r < 16; ++r) { p0[r] = 0.f; p1[r] = 0.f; }
          qk64<4>(bp, qf, r32, hi, p0, p1);
          float mx = NEG_INF;
#pragma unroll
          for (int r = 0; r < 16; ++r) { const int c = 64 * t + crow(r, hi); if (c > cmax) p0[r] = NEG_INF; if (c + 32 > cmax) p1[r] = NEG_INF; mx = fmaxf(mx, fmaxf(p0[r], p1[r])); }
          mx = fmaxf(mx, other_half(mx, hi));
          const float mn = fmaxf(cm, mx), ms = (mn == NEG_INF) ? 0.f : mn; float rs = 0.f;
#pragma unroll
          for (int r = 0; r < 16; ++r) rs += fast_exp2(p0[r] - ms) + fast_exp2(p1[r] - ms);
          rs += other_half(rs, hi);
          cl = cl * fast_exp2(cm - ms) + rs; cm = mn; }
        if (t + 1 < NTc) NS_WRITE(bi ^ 1);
        __syncthreads();
    }
    const float cms = (cm == NEG_INF) ? 0.f : cm, cinv = 1.0f / fmaxf(cl, 1e-30f);
    f32x16 oc0, oc1;
#pragma unroll
    for (int r = 0; r < 16; ++r) { oc0[r] = 0.f; oc1[r] = 0.f; }
    float G[32]; float carry = 0.f;
#pragma unroll
    for (int i = 0; i < 32; ++i) G[i] = 0.f;
    NS_FRESH(); NS_LOAD(KC, 64, VC, 64, 0); NS_WRITE(0);
    __syncthreads();
#pragma unroll
    for (int t = 0; t < 4; ++t) {
        if (t < NTc) {
            const int bi = t & 1;
            if (t + 1 < NTc) NS_LOAD(KC, 64, VC, 64, t + 1);
            { lds_cptr bp = (lds_cptr)(lds + bi * TB_SIZE); f32x16 p0, p1;
#pragma unroll
              for (int r = 0; r < 16; ++r) { p0[r] = 0.f; p1[r] = 0.f; }
              qk64<4>(bp, qf, r32, hi, p0, p1);
#pragma unroll
              for (int r = 0; r < 16; ++r) { const int c = 64 * t + crow(r, hi);
                  p0[r] = (c > cmax) ? 0.f : fast_exp2(p0[r] - cms) * cinv; p1[r] = (c + 32 > cmax) ? 0.f : fast_exp2(p1[r] - cms) * cinv; }
#pragma unroll
              for (int g = 0; g < 4; ++g) { const float oth = other_half(p0[4 * g + 3], hi);
                  G[t * 8 + g] = ((p0[4 * g] + p0[4 * g + 1]) + (p0[4 * g + 2] + p0[4 * g + 3])) + (hi ? oth : carry); carry = oth; }
#pragma unroll
              for (int g = 0; g < 4; ++g) { const float oth = other_half(p1[4 * g + 3], hi);
                  G[t * 8 + 4 + g] = ((p1[4 * g] + p1[4 * g + 1]) + (p1[4 * g + 2] + p1[4 * g + 3])) + (hi ? oth : carry); carry = oth; }
              bf16x8 pf[4]; pack_p(p0, p1, pf);
              pv64(oc0, oc1, bp + TB_V + vpo, pf); }
            if (t + 1 < NTc) NS_WRITE(bi ^ 1);
            __syncthreads();
        }
    }
    { LAS float* slab = (LAS float*)(lds + NSA_SLAB) + (size_t)(h * 64 + 32 * qs + r32) * 65;
#pragma unroll
      for (int i = 0; i < 32; ++i) slab[2 * i + hi] = G[i]; }
    __syncthreads();
    { const int q = tid >> 3, jg = tid & 7;
      const LAS float* s0 = (const LAS float*)(lds + NSA_SLAB) + (size_t)q * 65;
      float v[64];
#pragma unroll
      for (int k = 0; k < 64; ++k) { const float x = (s0[k] + s0[64 * 65 + k]) + (s0[2 * 64 * 65 + k] + s0[3 * 64 * 65 + k]);
          v[k] = (k == 0 || k == cur || k == cur - 1) ? 1e9f : ((k > cur) ? -1e9f : x); if ((k & 7) == 7) asm volatile("" ::: "memory"); }
      unsigned bits = 0u;
#pragma unroll
      for (int e = 0; e < 8; ++e) { const int j = 8 * jg + e;
          const float xj = (s0[j] + s0[64 * 65 + j]) + (s0[2 * 64 * 65 + j] + s0[3 * 64 * 65 + j]);
          const float vj = (j == 0 || j == cur || j == cur - 1) ? 1e9f : ((j > cur) ? -1e9f : xj);
          int rank = 0;
#pragma unroll
          for (int k = 0; k < 64; ++k) rank += (v[k] > vj || (v[k] == vj && k < j)) ? 1 : 0;
          bits |= (rank < 16 ? 1u : 0u) << e; }
      *((LAS unsigned char*)(lds + NSA_SEL) + q * 8 + jg) = (unsigned char)bits; }
    __syncthreads();
    const unsigned mlo = *(const LAS unsigned*)(lds + NSA_SEL + (32 * qs + r32) * 8), mhi = *(const LAS unsigned*)(lds + NSA_SEL + (32 * qs + r32) * 8 + 4);
    { const u32x4* src = WSP(const u32x4, WS_NSATAB); LAS u32x4* dst = (LAS u32x4*)(lds + NSA_SLAB);
      for (int i = tid; i < 4 * NSA_TL / 4; i += 512) dst[i] = src[i]; }
    const LAS float* tabh = (const LAS float*)(lds + NSA_SLAB) + h * NSA_TL;
    const float farb = WSP(const float, WS_FARB)[h];
    float g0, g1, g2;
    { int tq_ = tq; asm volatile("" : "+v"(tq_)); const float* sd = WSP(const float, WS_SIDE) + (rowbase + tq_) * 16 + h * 3; g0 = sigmoid_f(sd[0]); g1 = sigmoid_f(sd[1]); g2 = sigmoid_f(sd[2]); }
    AState st; astate_init(st);
    { const bf16_t* Kb = P + rowbase * PW + PC_KSLC; const bf16_t* Vb = P + rowbase * PW + PC_VSLC;
      NS_FRESH(); NS_LOAD(Kb, PW, Vb, PW, 0); NS_WRITE(0);
      __syncthreads();
      for (int j = 0; j <= cur; ++j) {
          const int bi = j & 1;
          if (j < cur) NS_LOAD(Kb, PW, Vb, PW, j + 1);
          const bool mine = ((j < 32) ? (mlo >> j) : (mhi >> (j - 32))) & 1u;
          if (__any(mine)) {
              lds_cptr bp = (lds_cptr)(lds + bi * TB_SIZE); f32x16 p0, p1;
#pragma unroll
              for (int r = 0; r < 16; ++r) { p0[r] = 0.f; p1[r] = 0.f; }
              qk64<4>(bp, qf, r32, hi, p0, p1);
              if (q0 - 64 * j - 63 >= NSA_DFAR) {
#pragma unroll
                  for (int r = 0; r < 16; ++r) { p0[r] += farb; p1[r] += farb; }
              } else add_table(p0, p1, tabh + (NSA_DMAX - tq + 64 * j + 4 * hi));
              if (j == cur) mask_causal(p0, p1, 64 * j, tq, hi);
              if (!mine) {
#pragma unroll
                  for (int r = 0; r < 16; ++r) { p0[r] = NEG_INF; p1[r] = NEG_INF; } }
              softmax_pv64(p0, p1, st, bp + TB_V + vpo, hi);
          }
          if (j < cur) NS_WRITE(bi ^ 1);
          __syncthreads();
      } }
    f32x16 oa0, oa1;
    { const float sc = g1 / st.l;
#pragma unroll
      for (int r = 0; r < 16; ++r) { oa0[r] = g0 * oc0[r] + sc * st.o0[r]; oa1[r] = g0 * oc1[r] + sc * st.o1[r]; } }
    astate_init(st);
    { const bf16_t* Kb = P + rowbase * PW + PC_KWIN; const bf16_t* Vb = P + rowbase * PW + PC_VWIN;
      const int jlo = cur >= 8 ? cur - 8 : 0;
      NS_FRESH(); NS_LOAD(Kb, PW, Vb, PW, jlo); NS_WRITE(0);
      __syncthreads();
      for (int j = jlo; j <= cur; ++j) {
          const int bi = (j - jlo) & 1;
          if (j < cur) NS_LOAD(Kb, PW, Vb, PW, j + 1);
          if (tq_lo - 64 * j - 63 < 512) {
              lds_cptr bp = (lds_cptr)(lds + bi * TB_SIZE); f32x16 p0, p1;
#pragma unroll
              for (int r = 0; r < 16; ++r) { p0[r] = 0.f; p1[r] = 0.f; }
              qk64<4>(bp, qf, r32, hi, p0, p1);
              add_table(p0, p1, tabh + (NSA_DMAX - tq + 64 * j + 4 * hi));
              if (!(tq_lo - 64 * j - 63 >= 0 && tq_lo + 31 - 64 * j < 512)) {
                  const int d0 = tq - 64 * j - 4 * hi;
#pragma unroll
                  for (int r = 0; r < 16; ++r) { const int d = d0 - ((r & 3) + 8 * (r >> 2)); if (d < 0 || d >= 512) p0[r] = NEG_INF; if (d - 32 < 0 || d - 32 >= 512) p1[r] = NEG_INF; }
              }
              softmax_pv64(p0, p1, st, bp + TB_V + vpo, hi);
          }
          if (j < cur) NS_WRITE(bi ^ 1);
          __syncthreads();
      } }
    { const float sc = g2 / st.l;
#pragma unroll
      for (int r = 0; r < 16; ++r) { oa0[r] += sc * st.o0[r]; oa1[r] += sc * st.o1[r]; } }
    { int tq_ = tq; asm volatile("" : "+v"(tq_)); store_o_bf16(WSP(bf16_t, WS_OCAT) + (rowbase + tq_) * OCW + h * 64, oa0, oa1, 1.0f, hi); }
#undef NS_LOAD
#undef NS_FRESH
#undef NS_WRITE
}
__device__ __forceinline__ void dil_unit(Frame& F, int b, int hh, int span) {
    int lane_o = F.lane; asm volatile("" : "+v"(lane_o));
    const int wid = F.wave, lane = lane_o, r32 = lane & 31, hi = lane >> 5, tid = wid * 64 + lane;
    const int T0 = span * 512;
    const size_t rowbase = (size_t)b * SEQ;
    const bf16_t* P = WSP(const bf16_t, WS_P) + rowbase * PW;
    lds_ptr lds = (lds_ptr)F.lds;
    LAS float* dtab = (LAS float*)(lds + 32768);
    for (int i = tid; i < 3 * 192; i += 512) dtab[i] = WSP(const float, WS_DILTAB)[((i / 192) * 2 + hh) * 192 + (i % 192)];
    __syncthreads();
    lds_ptr vst = lds + wid * 4096;
    const int vpo = ((lane >> 4) & 1) * 32 + (lane & 3) * 8 + (4 * hi + ((lane & 15) >> 2)) * 64;
    bf16_t* DOG = WSP(bf16_t, WS_DOG); float* DLSE = WSP(float, WS_DLSE);
    for (int g = 0; g < 3; ++g) {
        const int sh = 2 * g, head = 2 * g + hh;
        for (int rep = 0; rep < 2; ++rep) {
            const int wt = wid + 8 * rep;
            const int res = (g == 0) ? 0 : (g == 1 ? (wt & 3) : wt);
            const int i0 = (g == 0) ? 32 * wt : (g == 1 ? 32 * (wt >> 2) : 0);
            const int n0 = (T0 >> sh) + i0;
            const int tokq = res + ((n0 + r32) << sh);
            bf16x8 qf[4];
            { const bf16_t* Qrow = P + (size_t)tokq * PW + PC_BQ + head * 64;
#pragma unroll
              for (int ks = 0; ks < 4; ++ks) qf[ks] = *(const bf16x8*)(Qrow + ks * 16 + hi * 8); }
            f32x16 o0, o1; float m = NEG_INF, l = 0.f;
#pragma unroll
            for (int r = 0; r < 16; ++r) { o0[r] = 0.f; o1[r] = 0.f; }
            for (int c = 0; c < 5; ++c) {
                const int nk0 = n0 - 128 + 32 * c;
                if (nk0 + 31 < 0) continue;
                { int nk = nk0 + r32; nk = nk < 0 ? 0 : nk; const bf16_t* Krow = P + (size_t)(res + (nk << sh)) * PW + PC_BK + head * 64;
                  bf16x8 kf[4];
#pragma unroll
                  for (int ks = 0; ks < 4; ++ks) kf[ks] = *(const bf16x8*)(Krow + ks * 16 + hi * 8);
                  u32x4 vr[4];
#pragma unroll
                  for (int i = 0; i < 4; ++i) { const int pc = lane + 64 * i, vrow = pc >> 3, c16 = pc & 7; int nv = nk0 + vrow; nv = nv < 0 ? 0 : nv;
                      vr[i] = *(const u32x4*)(P + (size_t)(res + (nv << sh)) * PW + PC_BV + head * 64 + c16 * 8); }
#pragma unroll
                  for (int i = 0; i < 4; ++i) { const int pc = lane + 64 * i, vrow = pc >> 3, c16 = pc & 7;
                      *(LAS u32x4*)(vst + (c16 >> 2) * 2048 + vrow * 64 + (c16 & 3) * 16) = vr[i]; }
                  asm volatile("s_waitcnt lgkmcnt(0)" ::: "memory");
                  f32x16 p;
#pragma unroll
                  for (int r = 0; r < 16; ++r) p[r] = 0.f;
#pragma unroll
                  for (int ks = 0; ks < 4; ++ks) p = MFMA32(kf[ks], qf[ks], p);
                  const LAS float* tb = dtab + g * 192 + (32 - r32 + 4 * hi + 32 * c);
                  float mx = NEG_INF;
#pragma unroll
                  for (int r = 0; r < 16; ++r) { const int o = (r & 3) + 8 * (r >> 2), kk = o + 4 * hi, j = 128 + r32 - 32 * c - kk;
                      const bool ok = (j >= 0) && (j <= 128) && (nk0 + kk >= 0);
                      p[r] = ok ? p[r] + tb[o] : NEG_INF; mx = fmaxf(mx, p[r]); }
                  mx = fmaxf(mx, other_half(mx, hi));
                  const float mn = fmaxf(m, mx), ms = (mn == NEG_INF) ? 0.f : mn, alpha = fast_exp2(m - ms);
                  float rs = 0.f;
#pragma unroll
                  for (int r = 0; r < 16; ++r) { p[r] = fast_exp2(p[r] - ms); rs += p[r]; }
                  rs += other_half(rs, hi);
                  l = l * alpha + rs; m = mn;
#pragma unroll
                  for (int r = 0; r < 16; ++r) { o0[r] *= alpha; o1[r] *= alpha; }
                  u32x4 w0, w1;
                  w0.x = cvtpk(p[0], p[1]); w0.y = cvtpk(p[2], p[3]); w0.z = cvtpk(p[4], p[5]); w0.w = cvtpk(p[6], p[7]);
                  w1.x = cvtpk(p[8], p[9]); w1.y = cvtpk(p[10], p[11]); w1.z = cvtpk(p[12], p[13]); w1.w = cvtpk(p[14], p[15]);
                  const bf16x8 pf0 = __builtin_bit_cast(bf16x8, w0), pf1 = __builtin_bit_cast(bf16x8, w1);
                  lds_cptr vp = (lds_cptr)(vst + vpo);
#pragma unroll
                  for (int ks = 0; ks < 2; ++ks) {
                      const s16x4 l0 = vtr(vp + ks * 1024), h0 = vtr(vp + ks * 1024 + 512), l1 = vtr(vp + 2048 + ks * 1024), h1 = vtr(vp + 2048 + ks * 1024 + 512);
                      const bf16x8 v0 = (bf16x8){l0[0], l0[1], l0[2], l0[3], h0[0], h0[1], h0[2], h0[3]}, v1 = (bf16x8){l1[0], l1[1], l1[2], l1[3], h1[0], h1[1], h1[2], h1[3]};
                      o0 = MFMA32(v0, ks == 0 ? pf0 : pf1, o0); o1 = MFMA32(v1, ks == 0 ? pf0 : pf1, o1);
                  }
                  asm volatile("s_waitcnt lgkmcnt(0)" ::: "memory"); }
            }
            const size_t orow = rowbase + tokq;
            store_o_bf16(DOG + ((size_t)g * M + orow) * 128 + hh * 64, o0, o1, 1.0f / l, hi);
            if (hi == 0) DLSE[((size_t)g * M + orow) * 2 + hh] = m + log2f(l);
        }
    }
    VM_WAIT();
    __syncthreads();
    bf16_t* OC = WSP(bf16_t, WS_OCAT);
    for (int it = 0; it < 8; ++it) {
        const int item = tid + 512 * it, tl = item >> 3, pc = item & 7; const size_t orow = rowbase + T0 + tl;
        const float l0 = DLSE[((size_t)0 * M + orow) * 2 + hh], l1 = DLSE[((size_t)1 * M + orow) * 2 + hh], l2 = DLSE[((size_t)2 * M + orow) * 2 + hh];
        const float mx = fmaxf(l0, fmaxf(l1, l2)); float w0 = fast_exp2(l0 - mx), w1 = fast_exp2(l1 - mx), w2 = fast_exp2(l2 - mx);
        const float inv = 1.0f / (w0 + w1 + w2); w0 *= inv; w1 *= inv; w2 *= inv;
        const u32x4 a = *(const u32x4*)(DOG + ((size_t)0 * M + orow) * 128 + hh * 64 + pc * 8), bb = *(const u32x4*)(DOG + ((size_t)1 * M + orow) * 128 + hh * 64 + pc * 8),
                    cc = *(const u32x4*)(DOG + ((size_t)2 * M + orow) * 128 + hh * 64 + pc * 8);
        u32x4 w;
#pragma unroll
        for (int e = 0; e < 4; ++e) {
            const float lo = w0 * __uint_as_float(a[e] << 16) + w1 * __uint_as_float(bb[e] << 16) + w2 * __uint_as_float(cc[e] << 16);
            const float hv = w0 * __uint_as_float(a[e] & 0xffff0000u) + w1 * __uint_as_float(bb[e] & 0xffff0000u) + w2 * __uint_as_float(cc[e] & 0xffff0000u);
            w[e] = cvtpk(lo, hv); }
        *(u32x4*)(OC + orow * OCW + 256 + hh * 64 + pc * 8) = w;
    }
    __syncthreads();
}
__device__ __forceinline__ float wave_sum(float v) {
    v += xor_lane_lt32<1>(v); v += xor_lane_lt32<2>(v); v += xor_lane_lt32<4>(v); v += xor_lane_lt32<8>(v); v += xor_lane_lt32<16>(v);
    return sum_halves(v);
}
__device__ __forceinline__ int rel_bucket(int dist) {
    if (dist < 0) dist = 0;
    if (dist < 16) return dist;
    const int thr[15] = {22, 30, 40, 54, 73, 99, 134, 182, 246, 332, 450, 609, 825, 1117, 1513};
    int bkt = 16;
#pragma unroll
    for (int i = 0; i < 15; ++i) bkt += (dist >= thr[i]) ? 1 : 0;
    return bkt;
}
__device__ __forceinline__ int inproj_src(int c, float& sc) {
    sc = 1.f;
    if (c < 256) { sc = C2A; return c; }
    if (c < 652) return c;
    if (c < 656) return 2572 + (c - 652);
    if (c < 672) return -1;
    if (c < 704) { const int p = c - 672; return 2960 + (p >> 1) + 16 * (p & 1); }
    if (c < 768) return -1;
    if (c < 1920) { const int r = c - 768; if (r < 384) sc = C2A; return 652 + r; }
    if (c < 2048) return 2832 + (c - 1920);
    if (c < 2816) { const int r = c - 2048; if (r < 256) sc = C2A; return 1804 + r; }
    return 2576 + (c - 2816);
}
__device__ __forceinline__ int quq_src(int r, float& sc) {
    sc = C2D;
    if (r >= 384) return -1;
    const int hd = r / 96, w = r % 96;
    if (w < 64) return hd * 96 + w;
    const int p = w - 64; return hd * 96 + 64 + (p >> 1) + 16 * (p & 1);
}
__device__ __forceinline__ int gateperm_src(int r) {
    const int T = r >> 8, c = r & 255, pn = T >> 2, j = T & 3, bj = c >> 7, wc = (c >> 5) & 3, fq = (c >> 3) & 3, n = (c >> 2) & 1, e = c & 3;
    return (2 * bj + n) * DM * DM + 256 * pn + 64 * j + 16 * wc + 4 * fq + e;
}
__device__ __forceinline__ int branchperm_src(int r) {
    const int pn = r >> 8, c = r & 255, bj = c >> 7, wc = (c >> 5) & 3, fq = (c >> 3) & 3, n = (c >> 2) & 1, e = c & 3;
    return 256 * pn + 64 * (2 * bj + n) + 16 * wc + 4 * fq + e;
}
__device__ __forceinline__ int upperm_src(int r) { const int pn = r >> 8, c = r & 255; return (c & 128) ? DFF + 128 * pn + (c & 127) : 128 * pn + c; }
__device__ __forceinline__ void wconv_item(const float* W, int Nsrc, bf16_t* WT, int ldt, const float* kgain, int kind, LAS float* scr, int item, int nblk, int lane) {
    const int kb = item / nblk, nb = item % nblk, k0 = 64 * kb, n0 = 32 * nb;
    const int n = n0 + (lane & 31); float sc = 1.f; int src = n;
    if (kind == 1) src = inproj_src(n, sc); else if (kind == 2) src = quq_src(n, sc); else if (kind == 3) src = gateperm_src(n); else if (kind == 4) src = branchperm_src(n); else if (kind == 5) src = upperm_src(n);
#pragma unroll 8
    for (int i = 0; i < 32; ++i) { const int kk = 2 * i + (lane >> 5); float v = (src >= 0) ? W[(size_t)(k0 + kk) * Nsrc + src] * sc : 0.f; if (kgain) v *= kgain[k0 + kk]; scr[kk * 33 + (lane & 31)] = v; }
    LDS_WAIT(); asm volatile("" ::: "memory");
    const int c = lane & 7;
#pragma unroll
    for (int j = 0; j < 4; ++j) { const int nn = (lane >> 3) + 8 * j; const LAS float* s = scr + (8 * c) * 33 + nn;
        u32x4 o; o.x = pk2(s[0 * 33], s[1 * 33]); o.y = pk2(s[2 * 33], s[3 * 33]); o.z = pk2(s[4 * 33], s[5 * 33]); o.w = pk2(s[6 * 33], s[7 * 33]);
        *(u32x4*)(WT + (size_t)(n0 + nn) * ldt + k0 + 8 * c) = o; }
    LDS_WAIT(); asm volatile("" ::: "memory");
}
constexpr int ATT_UNITS = 3328;
__device__ __forceinline__ int att_cost(int id) {
    if (id < 2048) { const int qb = 15 - (id >> 7), mla = (id >> 6) & 1; return (mla ? 5 : 4) * (qb + 1); }
    if (id < 3072) return (63 - ((id - 2048) >> 4)) + 20;
    return 30;
}
__device__ __forceinline__ int clampi(int x, int lo, int hi) { return x < lo ? lo : (x > hi ? hi : x); }
__device__ __forceinline__ int att_rank(int i) {
    const int c = att_cost(i);
    int r = clampi(16 - c / 4, 0, 16) * 64 + clampi(16 - c / 5, 0, 16) * 64 + clampi(83 - c, 0, 64) * 16 + (c < 30 ? 256 : 0);
    if (c % 4 == 0 && c / 4 >= 1 && c / 4 <= 16) r += clampi(i - (16 - c / 4) * 128, 0, 64);
    if (c % 5 == 0 && c / 5 >= 1 && c / 5 <= 16) r += clampi(i - ((16 - c / 5) * 128 + 64), 0, 64);
    if (c >= 20 && c <= 83) r += clampi(i - (2048 + (63 - (c - 20)) * 16), 0, 16);
    if (c == 30) r += clampi(i - 3072, 0, 256);
    return r;
}
__device__ __forceinline__ void p0_prologue(Frame& F) {
    LAS float* scr = (LAS float*)(F.lds + F.wave * 16384);
    const int gw = blockIdx.x * 8 + F.wave, NGW = F.G * 8, lane = F.lane;
    constexpr int I_IN = 16 * 96, I_G = 16 * 32, I_BA = 4 * 32, I_BB = 2 * 32, I_O = 16 * 32, I_UP = 16 * 176, I_DN = 44 * 32, I_UQ = 4 * 16, I_UKV = 2 * 16, I_PHI = 32 * 4;
    constexpr int I_L = I_IN + 4 * I_G + 3 * I_BA + I_BB + I_O + I_UP + I_DN + I_UQ + I_UKV + 2 * I_PHI;
    for (int it = gw; it < DEPTH * I_L; it += NGW) {
        const int l = it / I_L; int r = it % I_L;
        unsigned char* wl = F.ws + WS_WT + (size_t)l * LW;
        if (r < I_IN) { wconv_item(F.in[6] + (size_t)l * DM * DIN, DIN, (bf16_t*)(wl + LW_IN), DM, nullptr, 1, scr, r, 96, lane); continue; } r -= I_IN;
        if (r < 4 * I_G) { wconv_item(F.in[21] + (size_t)l * 4 * DM * DM, DM, (bf16_t*)(wl + LW_G), DM, nullptr, 3, scr, r, 128, lane); continue; } r -= 4 * I_G;
        if (r < I_BA) { wconv_item(F.in[17] + (size_t)l * 256 * DM, DM, (bf16_t*)(wl + LW_BR + BR_A), 256, nullptr, 4, scr, r, 32, lane); continue; } r -= I_BA;
        if (r < I_BB) { wconv_item(F.in[18] + (size_t)l * 128 * DM, DM, (bf16_t*)(wl + LW_BR + BR_B), 128, nullptr, 4, scr, r, 32, lane); continue; } r -= I_BB;
        if (r < I_BA) { wconv_item(F.in[19] + (size_t)l * 256 * DM, DM, (bf16_t*)(wl + LW_BR + BR_C), 256, nullptr, 4, scr, r, 32, lane); continue; } r -= I_BA;
        if (r < I_BA) { wconv_item(F.in[20] + (size_t)l * 256 * DM, DM, (bf16_t*)(wl + LW_BR + BR_D), 256, nullptr, 4, scr, r, 32, lane); continue; } r -= I_BA;
        if (r < I_O) { wconv_item(F.in[22] + (size_t)l * DM * DM, DM, (bf16_t*)(wl + LW_O), DM, nullptr, 0, scr, r, 32, lane); continue; } r -= I_O;
        if (r < I_UP) { wconv_item(F.in[23] + (size_t)l * DM * DFF2, DFF2, (bf16_t*)(wl + LW_UP), DM, nullptr, 5, scr, r, 176, lane); continue; } r -= I_UP;
        if (r < I_DN) { wconv_item(F.in[26] + (size_t)l * DFF * DM, DM, (bf16_t*)(wl + LW_DN), DFF, nullptr, 0, scr, r, 32, lane); continue; } r -= I_DN;
        if (r < I_UQ) { wconv_item(F.in[15] + (size_t)l * 256 * 384, 384, (bf16_t*)(wl + LW_UQ), 256, F.in[13] + l * 256, 2, scr, r, 16, lane); continue; } r -= I_UQ;
        if (r < I_UKV) { wconv_item(F.in[16] + (size_t)l * 128 * 512, 512, (bf16_t*)(wl + LW_UKV), 128, F.in[14] + l * 128, 0, scr, r, 16, lane); continue; } r -= I_UKV;
        if (r < I_PHI) { wconv_item(F.in[8] + (size_t)l * 2048 * 128, 128, (bf16_t*)(wl + LW_PHI), 2048, nullptr, 0, scr, r, 4, lane); continue; } r -= I_PHI;
        wconv_item(F.in[10] + (size_t)l * 2048 * 128, 128, (bf16_t*)(wl + LW_PHI) + (size_t)128 * 2048, 2048, nullptr, 0, scr, r, 4, lane);
    }
    const int gt = blockIdx.x * 512 + F.tid, NGT = F.G * 512;
    const float* rel = F.in[1];
    float* rope = WSP(float, WS_ROPE);
    for (int i = gt; i < SEQ * 16; i += NGT) { const int t = i >> 4, k = i & 15; const float inv = powf(10000.0f, -(float)(2 * k) / 32.0f); const float ang = (float)t * inv;
        float sn, cs; sincosf(ang, &sn, &cs); rope[2 * i] = cs; rope[2 * i + 1] = sn; }
    float* ntab = WSP(float, WS_NSATAB);
    for (int i = gt; i < 4 * NSA_TL; i += NGT) { const int hd = i / NSA_TL, k = i % NSA_TL, dist = NSA_DMAX - k; ntab[i] = dist >= 0 ? rel[rel_bucket(dist) * 10 + hd] * LOG2E : 0.f; }
    float* dtab = WSP(float, WS_DILTAB);
    for (int i = gt; i < 6 * 192; i += NGT) { const int gh = i / 192, k = i % 192, g = gh >> 1, hh = gh & 1, j = 160 - k; dtab[i] = (j >= 0 && j <= 128) ? rel[rel_bucket(j << (2 * g)) * 10 + 4 + 2 * g + hh] * LOG2E : 0.f; }
    if (gt < 4) WSP(float, WS_FARB)[gt] = rel[31 * 10 + gt] * LOG2E;
    if (gw < 128) { const int mi = gw >> 5, pc = gw & 31, l = mi >> 1; const float *pk1 = F.in[8], *pv1 = F.in[10]; asm volatile("" : "+s"(pk1), "+s"(pv1));
        const float* w1 = ((mi & 1) ? pv1 : pk1) + (size_t)l * 2048 * 128 + (size_t)(64 * pc) * 128 + 2 * lane; const float* cp = F.in[7] + (size_t)l * 2048 + 64 * pc;
        f32x2 a = {0.f, 0.f};
#pragma unroll 8
        for (int p = 0; p < 64; ++p) { const f32x2 w = *(const f32x2*)(w1 + (size_t)p * 128); const float cpp = cp[p]; a[0] += cpp * w[0]; a[1] += cpp * w[1]; }
        *(f32x2*)(WSP(float, WS_CMPP) + ((size_t)mi * 32 + pc) * 128 + 2 * lane) = a; }
    if (gt < ATT_UNITS) WSP(int, WS_ORDER)[att_rank(gt)] = gt;
}
__device__ __forceinline__ void cmpb_reduce(Frame& F) {
    const int i = F.tid; if (i < DEPTH * 256) { const int l = i >> 8, n = i & 255, mi = l * 2 + (n >> 7); const float* pp = WSP(const float, WS_CMPP) + (size_t)mi * 32 * 128 + (n & 127); float a = 0.f;
        for (int pc = 0; pc < 32; ++pc) a += pp[pc * 128]; WSP(float, WS_CMPB)[i] = a; }
}

template <int MODE> __device__ __forceinline__ void rowpass(Frame& F, const float* x, const bf16_t* y, size_t yrow0, float* xout, bf16_t* hout, const float* g1, const float* g2, int row_lo, int row_hi) {
    int gw = blockIdx.x * 8 + F.wave; asm volatile("" : "+s"(gw));
    const int NGW = F.G * 8, lane = F.lane;
    f32x4 ga[4], gb[4];
#pragma unroll
    for (int j = 0; j < 4; ++j) { ga[j] = *(const f32x4*)(g1 + 4 * lane + 256 * j); if (MODE == 1) gb[j] = *(const f32x4*)(g2 + 4 * lane + 256 * j); }
    for (int m = row_lo + gw; m < row_hi; m += NGW) {
        f32x4 v[4];
        const f32x4* xr = (const f32x4*)(x + (size_t)m * DM) + lane;
#pragma unroll
        for (int j = 0; j < 4; ++j) v[j] = xr[64 * j];
        if (MODE != 0) {
            const u32x2* yr = (const u32x2*)(y + ((size_t)m - yrow0) * DM) + lane; f32x4 w[4]; float s = 0.f;
#pragma unroll
            for (int j = 0; j < 4; ++j) { const u32x2 yy = yr[64 * j]; w[j][0] = __uint_as_float(yy.x << 16); w[j][1] = __uint_as_float(yy.x & 0xffff0000u); w[j][2] = __uint_as_float(yy.y << 16); w[j][3] = __uint_as_float(yy.y & 0xffff0000u);
                s += (w[j][0] * w[j][0] + w[j][1] * w[j][1]) + (w[j][2] * w[j][2] + w[j][3] * w[j][3]); }
            const float rstd = 1.0f / sqrtf(wave_sum(s) * (1.0f / DM) + RMS_EPS);
            f32x4* xo = (f32x4*)(xout + (size_t)m * DM) + lane;
#pragma unroll
            for (int j = 0; j < 4; ++j) { v[j] = v[j] + w[j] * rstd * ga[j]; xo[64 * j] = v[j]; }
        }
        if (MODE != 2) {
            float s = 0.f;
#pragma unroll
            for (int j = 0; j < 4; ++j) s += (v[j][0] * v[j][0] + v[j][1] * v[j][1]) + (v[j][2] * v[j][2] + v[j][3] * v[j][3]);
            const float rstd = 1.0f / sqrtf(wave_sum(s) * (1.0f / DM) + RMS_EPS);
            u32x2* ho = (u32x2*)(hout + (size_t)m * DM) + lane;
#pragma unroll
            for (int j = 0; j < 4; ++j) { const f32x4 gg = (MODE == 1) ? gb[j] : ga[j]; const f32x4 o = v[j] * rstd * gg; u32x2 w; w.x = cvtpk(o[0], o[1]); w.y = cvtpk(o[2], o[3]); ho[64 * j] = w; }
        }
    }
}

__device__ __forceinline__ void ffn_fix_panel(Frame& F, int pm, const float* HB, bf16_t* ACT, const float* cw, const float* cb) {
    for (int it = F.tid; it < 4 * 2 * (DFF / 4); it += 512) {
        const int c4 = it % (DFF / 4), rr = (it / (DFF / 4)) & 1, g = pm * 4 + it / (2 * (DFF / 4)), c = c4 * 4, pn = c >> 7, cl = c & 127;
        const bool first = ((g * 64) & (SEQ - 1)) == 0;
#define HBV(gg, s, bj) (*(const f32x4*)(HB + ((size_t)(((gg) * 4 + (s)) * 22 + pn) * 256 + (bj) * 128 + cl)))
        const f32x4 z = {0.f, 0.f, 0.f, 0.f};
        const f32x4 u0g = HBV(g, 0, 0), u0v = HBV(g, 0, 1);
        f32x4 ag, bg_, cg, av, bv_, cv;
        if (rr == 0) { ag = first ? z : HBV(g - 1, 2, 0); bg_ = first ? z : HBV(g - 1, 3, 0); cg = u0g; av = first ? z : HBV(g - 1, 2, 1); bv_ = first ? z : HBV(g - 1, 3, 1); cv = u0v; }
        else { ag = first ? z : HBV(g - 1, 3, 0); bg_ = u0g; cg = HBV(g, 1, 0); av = first ? z : HBV(g - 1, 3, 1); bv_ = u0v; cv = HBV(g, 1, 1); }
#undef HBV
        const f32x4 kb = *(const f32x4*)(cb + c), k0 = *(const f32x4*)(cw + c), k1 = *(const f32x4*)(cw + DFF2 + c), k2 = *(const f32x4*)(cw + 2 * DFF2 + c);
        const f32x4 vb = *(const f32x4*)(cb + DFF + c), v0 = *(const f32x4*)(cw + DFF + c), v1 = *(const f32x4*)(cw + DFF2 + DFF + c), v2 = *(const f32x4*)(cw + 2 * DFF2 + DFF + c);
        float o[4];
#pragma unroll
        for (int e = 0; e < 4; ++e) { const float gt = kb[e] + k0[e] * ag[e] + k1[e] * bg_[e] + k2[e] * cg[e], vl = vb[e] + v0[e] * av[e] + v1[e] * bv_[e] + v2[e] * cv[e]; o[e] = gt * sigmoid_f(gt) * vl; }
        u32x2 w; w.x = cvtpk(o[0], o[1]); w.y = cvtpk(o[2], o[3]);
        *(u32x2*)(ACT + (size_t)(g * 64 + rr) * DFF + c) = w;
    }
}
#ifdef SELFCHECK
constexpr int CW_CHK = 20480;
__device__ __forceinline__ unsigned chk_hash(unsigned x) { x ^= x >> 16; x *= 0x7feb352du; x ^= x >> 15; x *= 0x846ca68bu; x ^= x >> 16; return x; }
__device__ __forceinline__ int chk_t(int i) {
    int r = 0;
    switch (i & 31) { case 0: r = 0; break; case 1: r = 1; break; case 2: r = 15; break; case 3: r = 16; break; case 4: r = 30; break; case 5: r = 31; break; case 6: r = 32; break; case 7: r = 47; break;
        case 8: r = 63; break; case 9: r = 64; break; case 10: r = 65; break; case 11: r = 127; break; case 12: r = 128; break; case 13: r = 129; break; case 14: r = 255; break; case 15: r = 256; break;
        case 16: r = 257; break; case 17: r = 511; break; case 18: r = 512; break; case 19: r = 513; break; case 20: r = 575; break; case 21: r = 1023; break; case 22: r = 1024; break; case 23: r = 1599; break;
        case 24: r = 1600; break; case 25: r = 2047; break; case 26: r = 2048; break; case 27: r = 2111; break; case 28: r = 3000; break; case 29: r = 4031; break; case 30: r = 4032; break; default: r = 4095; break; }
    return (i < 64) ? r : (int)(chk_hash(i * 7919u + 13u) & 4095u);
}
__device__ __forceinline__ bool chk_bad(float got, float ref, float scale) { const float d = fabsf(got - ref); return !(d <= 0.02f * fabsf(ref) + 0.02f * scale); }
__device__ __forceinline__ float bfr(float x) { return bf2f((unsigned short)f2bf(x)); }
__device__ __forceinline__ void chk_flag(Frame& F, int bit, bool bad, int allow) {
    LAS unsigned* cnt = (LAS unsigned*)(F.lds + 65536);
    __syncthreads(); if (threadIdx.x == 0) *cnt = 0u; __syncthreads();
    if (bad) atomicAdd((unsigned*)cnt, 1u);
    __syncthreads();
    if (threadIdx.x == 0 && *cnt > (unsigned)allow) atomicOr((unsigned*)(F.ctl + CW_CHK), 1u << bit);
    __syncthreads();
}
__device__ __forceinline__ int chk_bucket_ref(int dist) {
    if (dist < 0) dist = 0; if (dist < 16) return dist;
    const float d = (float)dist; int large = 16 + (int)(logf(d / 16.0f) / 4.852030263919617f * 16.0f); return large < 31 ? large : 31;
}
__device__ __forceinline__ bool chk_fox(Frame& F, int b, int h, int t) {
    const bf16_t* P = WSP(const bf16_t, WS_P);
    { const size_t row = (size_t)b * SEQ + t; const bf16_t* q = P + row * PW + PC_CQ + h * 64; const float* kb = WSP(const float, WS_KB) + ((size_t)b * 4 + h) * SEQ;
      float m = -INFINITY; for (int j = 0; j <= t; ++j) { const bf16_t* k = P + ((size_t)b * SEQ + j) * PW + PC_CK + h * 64; float s = 0.f; for (int d = 0; d < 64; ++d) s += bf2f(q[d]) * bf2f(k[d]); s += kb[j]; m = fmaxf(m, s); }
      float lsum = 0.f, dummy0_ = 0.f; f32x4 o = {0.f, 0.f, 0.f, 0.f};
      for (int j = 0; j <= t; ++j) { const bf16_t* k = P + ((size_t)b * SEQ + j) * PW + PC_CK + h * 64; const bf16_t* v = P + ((size_t)b * SEQ + j) * PW + PC_CV + h * 64; float s = 0.f; for (int d = 0; d < 64; ++d) s += bf2f(q[d]) * bf2f(k[d]); s += kb[j];
          const float p = exp2f(s - m); lsum += p; _Pragma("unroll") for (int e = 0; e < 4; ++e) o[e] += p * bf2f(v[21 * e]); }
      bool bad = false; _Pragma("unroll") for (int e = 0; e < 4; ++e) bad |= chk_bad(bf2f(WSP(const bf16_t, WS_OCAT)[row * OCW + 384 + h * 64 + 21 * e]), o[e] / lsum, 0.5f);
      return bad; }
}
__device__ __forceinline__ bool chk_dil(Frame& F, int b, int hh, int t) {
    const bf16_t* P = WSP(const bf16_t, WS_P); const float* rel = F.in[1];
    { const size_t row = (size_t)b * SEQ + t;
      float m = -INFINITY;
      for (int g = 0; g < 3; ++g) { const int dil = 1 << (2 * g), head = 2 * g + hh; const bf16_t* q = P + row * PW + PC_BQ + head * 64;
          for (int j = 0; j <= 128; ++j) { const int idx = t - dil * j; if (idx < 0) break; const bf16_t* k = P + ((size_t)b * SEQ + idx) * PW + PC_BK + head * 64; float s = 0.f; for (int d = 0; d < 64; ++d) s += bf2f(q[d]) * bf2f(k[d]);
              s += rel[chk_bucket_ref(dil * j) * 10 + 4 + head] * LOG2E; m = fmaxf(m, s); } }
      float lsum = 0.f, dummy0_ = 0.f; f32x4 o = {0.f, 0.f, 0.f, 0.f};
      for (int g = 0; g < 3; ++g) { const int dil = 1 << (2 * g), head = 2 * g + hh; const bf16_t* q = P + row * PW + PC_BQ + head * 64;
          for (int j = 0; j <= 128; ++j) { const int idx = t - dil * j; if (idx < 0) break; const bf16_t* k = P + ((size_t)b * SEQ + idx) * PW + PC_BK + head * 64; const bf16_t* v = P + ((size_t)b * SEQ + idx) * PW + PC_BV + head * 64; float s = 0.f; for (int d = 0; d < 64; ++d) s += bf2f(q[d]) * bf2f(k[d]);
              s += rel[chk_bucket_ref(dil * j) * 10 + 4 + head] * LOG2E; const float p = exp2f(s - m); lsum += p; _Pragma("unroll") for (int e = 0; e < 4; ++e) o[e] += p * bf2f(v[21 * e]); } }
      bool bad = false; _Pragma("unroll") for (int e = 0; e < 4; ++e) bad |= chk_bad(bf2f(WSP(const bf16_t, WS_OCAT)[row * OCW + 256 + hh * 64 + 21 * e]), o[e] / lsum, 0.5f);
      return bad; }
}
__device__ __forceinline__ bool chk_nsa(Frame& F, int b, int h, int t, int i) {
    const bf16_t* P = WSP(const bf16_t, WS_P); const float* rel = F.in[1];
    { bool bad = false;
      { const size_t row = (size_t)b * SEQ + t; const size_t rb = (size_t)b * SEQ;
      const bf16_t* KC = WSP(const bf16_t, WS_KC) + (size_t)b * 256 * 64; const bf16_t* VC = WSP(const bf16_t, WS_VC) + (size_t)b * 256 * 64;
      const int cmax = (t >= 31) ? (t - 31) / 16 : -1, cur = t >> 6;
      LAS float* imp = (LAS float*)(F.lds + 70000) + i * 65; for (int j = 0; j < 64; ++j) imp[j] = 0.f;
      f32x4 oc = {0.f, 0.f, 0.f, 0.f};
      for (int hh = 0; hh < 4; ++hh) { const bf16_t* q = P + row * PW + PC_AQ + hh * 64; float m = -INFINITY;
          for (int c = 0; c <= cmax; ++c) { float s = 0.f; for (int d = 0; d < 64; ++d) s += bf2f(q[d]) * bf2f(KC[c * 64 + d]); m = fmaxf(m, s); }
          float ls = 0.f; for (int c = 0; c <= cmax; ++c) { float s = 0.f; for (int d = 0; d < 64; ++d) s += bf2f(q[d]) * bf2f(KC[c * 64 + d]); ls += exp2f(s - m); }
          for (int c = 0; c <= cmax; ++c) { float s = 0.f; for (int d = 0; d < 64; ++d) s += bf2f(q[d]) * bf2f(KC[c * 64 + d]); const float p = exp2f(s - m) / ls;
              for (int j = 0; j < 64; ++j) if (16 * c <= 64 * j + 63 && 16 * c + 31 >= 64 * j) imp[j] += p;
              if (hh == h) _Pragma("unroll") for (int e = 0; e < 4; ++e) oc[e] += p * bf2f(VC[c * 64 + 21 * e]); } }
      for (int j = 0; j < 64; ++j) imp[j] = (j == 0 || j == cur || j == cur - 1) ? 1e9f : (j > cur ? -1e9f : imp[j]);
      unsigned long long selm = 0ull;
      for (int j = 0; j < 64; ++j) { int rank = 0; for (int k = 0; k < 64; ++k) rank += (imp[k] > imp[j] || (imp[k] == imp[j] && k < j)) ? 1 : 0; if (rank < 16) selm |= 1ull << j; }
      const bf16_t* q = P + row * PW + PC_AQ + h * 64;
      f32x4 os = {0.f, 0.f, 0.f, 0.f}, ow = {0.f, 0.f, 0.f, 0.f};
      { float m = -INFINITY; for (int pos = 0; pos <= t; ++pos) { if (!((selm >> (pos >> 6)) & 1ull)) continue; const bf16_t* k = P + (rb + pos) * PW + PC_KSLC; float s = 0.f; for (int d = 0; d < 64; ++d) s += bf2f(q[d]) * bf2f(k[d]); s += rel[chk_bucket_ref(t - pos) * 10 + h] * LOG2E; m = fmaxf(m, s); }
        float ls = 0.f; for (int pos = 0; pos <= t; ++pos) { if (!((selm >> (pos >> 6)) & 1ull)) continue; const bf16_t* k = P + (rb + pos) * PW + PC_KSLC; const bf16_t* v = P + (rb + pos) * PW + PC_VSLC; float s = 0.f; for (int d = 0; d < 64; ++d) s += bf2f(q[d]) * bf2f(k[d]); s += rel[chk_bucket_ref(t - pos) * 10 + h] * LOG2E;
            const float p = exp2f(s - m); ls += p; _Pragma("unroll") for (int e = 0; e < 4; ++e) os[e] += p * bf2f(v[21 * e]); }
        _Pragma("unroll") for (int e = 0; e < 4; ++e) os[e] /= ls; }
      { const int lo = t - 511 > 0 ? t - 511 : 0; float m = -INFINITY; for (int pos = lo; pos <= t; ++pos) { const bf16_t* k = P + (rb + pos) * PW + PC_KWIN; float s = 0.f; for (int d = 0; d < 64; ++d) s += bf2f(q[d]) * bf2f(k[d]); s += rel[chk_bucket_ref(t - pos) * 10 + h] * LOG2E; m = fmaxf(m, s); }
        float ls = 0.f; for (int pos = lo; pos <= t; ++pos) { const bf16_t* k = P + (rb + pos) * PW + PC_KWIN; const bf16_t* v = P + (rb + pos) * PW + PC_VWIN; float s = 0.f; for (int d = 0; d < 64; ++d) s += bf2f(q[d]) * bf2f(k[d]); s += rel[chk_bucket_ref(t - pos) * 10 + h] * LOG2E;
            const float p = exp2f(s - m); ls += p; _Pragma("unroll") for (int e = 0; e < 4; ++e) ow[e] += p * bf2f(v[21 * e]); }
        _Pragma("unroll") for (int e = 0; e < 4; ++e) ow[e] /= ls; }
      const float* sd = WSP(const float, WS_SIDE) + row * 16 + h * 3; const float g0 = 1.f / (1.f + expf(-sd[0])), g1 = 1.f / (1.f + expf(-sd[1])), g2 = 1.f / (1.f + expf(-sd[2]));
      _Pragma("unroll") for (int e = 0; e < 4; ++e) bad |= chk_bad(bf2f(WSP(const bf16_t, WS_OCAT)[row * OCW + h * 64 + 21 * e]), g0 * oc[e] + g1 * os[e] + g2 * ow[e], 0.3f); }
      return bad; }
}
__device__ __forceinline__ void selfcheck_a(Frame& F, int l) {
    const int i = threadIdx.x;
    const float* x = F.in[0];
    const bf16_t* H = WSP(const bf16_t, WS_H); const bf16_t* P = WSP(const bf16_t, WS_P);
    const float* rel = F.in[1];
    { const int row = (int)(chk_hash(i) % M), col = (int)(chk_hash(i + 999) & 1023); float s = 0.f; for (int k = 0; k < DM; ++k) { const float v = x[(size_t)row * DM + k]; s += v * v; }
      const float ref = x[(size_t)row * DM + col] * (1.0f / sqrtf(s / DM + RMS_EPS)) * F.in[2][l * DM + col];
      chk_flag(F, 0, chk_bad(bf2f(H[(size_t)row * DM + col]), ref, 1.0f), 0); }
    { const int row = (int)(chk_hash(i + 5) % M); int c = (i * 37 + 5) % PW; if (i < 32) c = 640 + (i & 15); else if (i < 96) c = 672 + (i & 31); else if (i < 160) c = 256 + ((i * 3) & 127);
      const float* W = F.in[6] + (size_t)l * DM * DIN; bool bad = false;
#define DOTC(dst, cc) do { float sc_; const int src_ = inproj_src((cc), sc_); float a_ = 0.f; if (src_ >= 0) for (int k = 0; k < DM; ++k) a_ += bf2f(H[(size_t)row * DM + k]) * bfr(W[(size_t)k * DIN + src_] * sc_); dst = a_; } while (0)
      float ref; DOTC(ref, c);
      if (c >= 672 && c < 704) { const int p = c - 672, ip = p >> 1; float oth; DOTC(oth, c ^ 1); const float x1 = (p & 1) ? oth : ref, x2 = (p & 1) ? ref : oth;
          const float inv = powf(10000.0f, -(float)(2 * ip) / 32.0f), ang = (float)(row & (SEQ - 1)) * inv, cs = cosf(ang), sn = sinf(ang);
          ref = (p & 1) ? (x2 * cs + x1 * sn) : (x1 * cs - x2 * sn);
          bad |= chk_bad(bf2f(WSP(const bf16_t, WS_KROT)[(size_t)row * 32 + p]), ref, 1.0f); }
      bad |= chk_bad(bf2f(P[(size_t)row * PW + c]), ref, 1.0f);
      if (c >= 640 && c < 656) bad |= chk_bad(WSP(const float, WS_SIDE)[(size_t)row * 16 + (c - 640)], ref, 1.0f);
      if (c >= 256 && c < 320) bad |= chk_bad(bf2f(WSP(const bf16_t, WS_KCMP)[(size_t)row * 64 + (c - 256)]), ref, 1.0f);
      if (c >= 320 && c < 384) bad |= chk_bad(bf2f(WSP(const bf16_t, WS_VCMP)[(size_t)row * 64 + (c - 320)]), ref, 1.0f);
      if (i >= 160 && i < 192) { float sq = 0.f, skv = 0.f; for (int k = 0; k < 256; ++k) { const float v = bf2f(P[(size_t)row * PW + PC_DQL + k]); sq += v * v; } for (int k = 0; k < 128; ++k) { const float v = bf2f(P[(size_t)row * PW + PC_DKV + k]); skv += v * v; }
          const float* a = WSP(const float, WS_SSQQ) + (size_t)row * 4; const float* b = WSP(const float, WS_SSQKV) + (size_t)row * 4;
          bad |= chk_bad(a[0] + a[1] + a[2] + a[3], sq, 10.f) || chk_bad(b[0] + b[1] + b[2] + b[3], skv, 5.f); }
      chk_flag(F, 1, bad, 0); }
    { const int b = i & 15, h = (i >> 4) & 3, t = chk_t(i >> 6); float a = 0.f; for (int j = 0; j <= t; ++j) { const float xx = WSP(const float, WS_SIDE)[((size_t)b * SEQ + j) * 16 + 12 + h] + F.in[12][l * 4 + h]; a += (xx >= 0.f) ? -log1pf(expf(-xx)) : (xx - log1pf(expf(xx))); }
      chk_flag(F, 2, chk_bad(WSP(const float, WS_KB)[((size_t)b * 4 + h) * SEQ + t], -a * LOG2E, 1.0f + fabsf(a) * 0.05f), 0); }
    chk_flag(F, 3, chk_fox(F, (i * 5) & 15, i & 3, chk_t(i >> 2)), 0);
    { const int row = (int)(chk_hash(i + 77) % M); bool bad = false;
      float sq = 0.f, skv = 0.f; for (int k = 0; k < 256; ++k) { const float v = bf2f(P[(size_t)row * PW + PC_DQL + k]); sq += v * v; } for (int k = 0; k < 128; ++k) { const float v = bf2f(P[(size_t)row * PW + PC_DKV + k]); skv += v * v; }
      const float rq = 1.0f / sqrtf(sq / 256.0f + RMS_EPS), rkv = 1.0f / sqrtf(skv / 128.0f + RMS_EPS);
      const float* wq = F.in[15] + (size_t)l * 256 * 384; const float* gq = F.in[13] + l * 256; const float* wkv = F.in[16] + (size_t)l * 128 * 512; const float* gkv = F.in[14] + l * 128;
#define QDOT(dst, src) do { float a_ = 0.f; for (int k = 0; k < 256; ++k) a_ += bf2f(P[(size_t)row * PW + PC_DQL + k]) * bfr(wq[(size_t)k * 384 + (src)] * C2D * gq[k]); dst = a_ * rq; } while (0)
      const int r = (i * 11) % 384, hd = r / 96, w = r % 96; float ref;
      if (w < 64) QDOT(ref, hd * 96 + w);
      else { const int p = w - 64, ip = p >> 1; float x1, x2; QDOT(x1, hd * 96 + 64 + ip); QDOT(x2, hd * 96 + 64 + 16 + ip); const float inv = powf(10000.0f, -(float)(2 * ip) / 32.0f), ang = (float)(row & (SEQ - 1)) * inv, cs = cosf(ang), sn = sinf(ang);
          ref = (p & 1) ? (x2 * cs + x1 * sn) : (x1 * cs - x2 * sn); }
      bad |= chk_bad(bf2f(WSP(const bf16_t, WS_QM)[(size_t)row * 512 + r]), ref, 1.5f);
      { const int c = (i * 13) & 511; float a = 0.f; for (int k = 0; k < 128; ++k) a += bf2f(P[(size_t)row * PW + PC_DKV + k]) * bfr(wkv[(size_t)k * 512 + c] * gkv[k]); bad |= chk_bad(bf2f(WSP(const bf16_t, WS_KVM)[(size_t)row * 512 + c]), a * rkv, 1.0f); }
      chk_flag(F, 4, bad, 0); }
    { const int b = (i * 3) & 15, h = i & 3, t = chk_t(i >> 2); const size_t row = (size_t)b * SEQ + t; const bf16_t* q = WSP(const bf16_t, WS_QM) + row * 512 + h * 96; const bf16_t* KV = WSP(const bf16_t, WS_KVM); const bf16_t* KR = WSP(const bf16_t, WS_KROT);
      float m = -INFINITY; for (int j = 0; j <= t; ++j) { const size_t rj = (size_t)b * SEQ + j; float s = 0.f; for (int d = 0; d < 64; ++d) s += bf2f(q[d]) * bf2f(KV[rj * 512 + h * 128 + d]); for (int d = 0; d < 32; ++d) s += bf2f(q[64 + d]) * bf2f(KR[rj * 32 + d]); m = fmaxf(m, s); }
      float lsum = 0.f, dummy0_ = 0.f; f32x4 o = {0.f, 0.f, 0.f, 0.f};
      for (int j = 0; j <= t; ++j) { const size_t rj = (size_t)b * SEQ + j; float s = 0.f; for (int d = 0; d < 64; ++d) s += bf2f(q[d]) * bf2f(KV[rj * 512 + h * 128 + d]); for (int d = 0; d < 32; ++d) s += bf2f(q[64 + d]) * bf2f(KR[rj * 32 + d]);
          const float p = exp2f(s - m); lsum += p; _Pragma("unroll") for (int e = 0; e < 4; ++e) o[e] += p * bf2f(KV[rj * 512 + h * 128 + 64 + 21 * e]); }
      bool bad = false; _Pragma("unroll") for (int e = 0; e < 4; ++e) bad |= chk_bad(bf2f(WSP(const bf16_t, WS_OCAT)[row * OCW + 640 + h * 64 + 21 * e]), o[e] / lsum, 0.5f);
      chk_flag(F, 5, bad, 0); }
    chk_flag(F, 6, chk_dil(F, (i * 7) & 15, i & 1, chk_t(i >> 1)), 0);
    { const int b = i & 15, which = (i >> 4) & 1, c = (int)(chk_hash(i + 31) % 255), d = (i * 5) & 63; const bf16_t* src = (which ? WSP(const bf16_t, WS_VCMP) : WSP(const bf16_t, WS_KCMP)) + ((size_t)b * SEQ + 16 * c) * 64;
      const float *pk1 = F.in[8], *pv1 = F.in[10], *pk2 = F.in[9], *pv2 = F.in[11]; asm volatile("" : "+s"(pk1), "+s"(pv1), "+s"(pk2), "+s"(pv2));
      const float* w1 = (which ? pv1 : pk1) + (size_t)l * 2048 * 128; const float* w2 = (which ? pv2 : pk2) + (size_t)l * 128 * 64; const float* cp = F.in[7] + (size_t)l * 2048;
      float out = 0.f;
      for (int n = 0; n < 128; ++n) { float a = 0.f, bsum = 0.f; for (int p = 0; p < 2048; ++p) { a += bf2f(src[p]) * bfr(w1[(size_t)p * 128 + n]); bsum += cp[p] * w1[(size_t)p * 128 + n]; }
          const float xx = a + bsum, g = 0.5f * xx * (1.0f + tanhf(0.7978845608028654f * (xx + 0.044715f * xx * xx * xx))); out += bfr(g) * w2[n * 64 + d]; }
      chk_flag(F, 7, chk_bad(bf2f((which ? WSP(const bf16_t, WS_VC) : WSP(const bf16_t, WS_KC))[((size_t)b * 256 + c) * 64 + d]), out, 0.5f), 0); }
    { bool bad = false; if (i < 128) bad = chk_nsa(F, (i * 9) & 15, i & 3, chk_t(i >> 2), i); chk_flag(F, 8, bad, 4); }
}
__device__ __forceinline__ void selfcheck_b(Frame& F, int l) {
    const int i = threadIdx.x; const int row = (int)(chk_hash(i + 3) % M), n = (i * 29 + 7) & 1023;
    const bf16_t* H = WSP(const bf16_t, WS_H); const bf16_t* OC = WSP(const bf16_t, WS_OCAT);
    float acc = 0.f;
    for (int br = 0; br < 4; ++br) { const float* wg = F.in[21] + ((size_t)l * 4 + br) * DM * DM; float g = 0.f; for (int k = 0; k < DM; ++k) g += bf2f(H[(size_t)row * DM + k]) * bfr(wg[(size_t)k * DM + n]);
        const int kk = (br == 1) ? 128 : 256, co = (br == 0) ? 0 : (br == 1 ? 256 : (br == 2 ? 384 : 640)); const float *pb0 = F.in[17], *pb1 = F.in[18], *pb2 = F.in[19], *pb3 = F.in[20]; asm volatile("" : "+s"(pb0), "+s"(pb1), "+s"(pb2), "+s"(pb3)); const float* wb = (br == 0 ? pb0 : (br == 1 ? pb1 : (br == 2 ? pb2 : pb3))) + (size_t)l * kk * DM; float t = 0.f; for (int k = 0; k < kk; ++k) t += bf2f(OC[(size_t)row * OCW + co + k]) * bfr(wb[(size_t)k * DM + n]);
        acc += (1.f / (1.f + expf(-g))) * bfr(t); }
    chk_flag(F, 9, chk_bad(bf2f(WSP(const bf16_t, WS_MERGED)[(size_t)row * DM + n]), acc, 0.5f), 0);
}
__device__ __forceinline__ void selfcheck_c(Frame& F, int l, const float* xin) {
    const int i = threadIdx.x; const int row = (int)(chk_hash(i + 11) % M), n = (i * 29 + 7) & 1023;
    const bf16_t* MG = WSP(const bf16_t, WS_MERGED); const float* wo = F.in[22] + (size_t)l * DM * DM; const float* Y = WSP(const float, WS_Y);
    float a = 0.f; for (int k = 0; k < DM; ++k) a += bf2f(MG[(size_t)row * DM + k]) * bfr(wo[(size_t)k * DM + n]);
    chk_flag(F, 0, chk_bad(Y[(size_t)row * DM + n], a, 1.0f), 0);
    float s = 0.f; for (int k = 0; k < DM; ++k) { const float v = Y[(size_t)row * DM + k]; s += v * v; }
    const float rstd = 1.0f / sqrtf(s / DM + RMS_EPS); float s2 = 0.f;
    for (int k = 0; k < DM; ++k) { const float v = xin[(size_t)row * DM + k] + Y[(size_t)row * DM + k] * rstd * F.in[3][l * DM + k]; s2 += v * v; }
    const float x1 = xin[(size_t)row * DM + n] + Y[(size_t)row * DM + n] * rstd * F.in[3][l * DM + n];
    const float h2 = x1 * (1.0f / sqrtf(s2 / DM + RMS_EPS)) * F.in[4][l * DM + n];
    chk_flag(F, 1, chk_bad(F.out[(size_t)row * DM + n], x1, 1.0f) || chk_bad(bf2f(WSP(const bf16_t, WS_H2)[(size_t)row * DM + n]), h2, 1.0f), 0);
}
__device__ __forceinline__ void selfcheck_d(Frame& F, int l) {
    const int i = threadIdx.x; const int row = (int)(chk_hash(i + 17) % (M / 2)); const bf16_t* H2 = WSP(const bf16_t, WS_H2); const bf16_t* U = WSP(const bf16_t, WS_U); const bf16_t* A = WSP(const bf16_t, WS_ACT);
    { const int c = (i * 41 + 3) % DFF2; const float* wu = F.in[23] + (size_t)l * DM * DFF2; float a = 0.f; for (int k = 0; k < DM; ++k) a += bf2f(H2[(size_t)row * DM + k]) * bfr(wu[(size_t)k * DFF2 + c]);
      chk_flag(F, 2, chk_bad(bf2f(U[(size_t)row * DFF2 + c]), a, 1.0f), 0); }
    { const int c = (i * 23 + 1) % DFF; const int t = row & (SEQ - 1); const float* cw = F.in[24] + (size_t)l * 3 * DFF2; const float* cb = F.in[25] + (size_t)l * DFF2; float g = cb[c], v = cb[DFF + c];
      for (int j = 0; j < 3; ++j) { const int tt = t - 2 + j; if (tt < 0) continue; g += cw[j * DFF2 + c] * bf2f(U[(size_t)(row - 2 + j) * DFF2 + c]); v += cw[j * DFF2 + DFF + c] * bf2f(U[(size_t)(row - 2 + j) * DFF2 + DFF + c]); }
      chk_flag(F, 3, chk_bad(bf2f(A[(size_t)row * DFF + c]), g / (1.f + expf(-g)) * v, 0.3f), 0); }
    { const int n = (i * 29 + 7) & 1023; const float* wd = F.in[26] + (size_t)l * DFF * DM; float a = 0.f; for (int k = 0; k < DFF; ++k) a += bf2f(A[(size_t)row * DFF + k]) * bfr(wd[(size_t)k * DM + n]);
      chk_flag(F, 4, chk_bad(WSP(const float, WS_Y2)[(size_t)row * DM + n], a, 1.0f), 0); }
}

__device__ __forceinline__ void selfcheck_e(Frame& F, int l) {
    const int i = threadIdx.x; const bf16_t* H = WSP(const bf16_t, WS_H); const bf16_t* P = WSP(const bf16_t, WS_P);
    const float* W = F.in[6] + (size_t)l * DM * DIN; const int row = (int)(chk_hash(i + 5) % M);
#define DOTC(dst, cc) do { float sc_; const int src_ = inproj_src((cc), sc_); float a_ = 0.f; if (src_ >= 0) for (int k = 0; k < DM; ++k) a_ += bf2f(H[(size_t)row * DM + k]) * bfr(W[(size_t)k * DIN + src_] * sc_); dst = a_; } while (0)
    { int c = (i * 37 + 5) % PW; if ((c >= 640 && c < 768)) c = 100; float ref; DOTC(ref, c); chk_flag(F, 0, chk_bad(bf2f(P[(size_t)row * PW + c]), ref, 1.0f), 0); }
    { const int c = 672 + (i & 31), p = c - 672, ip = p >> 1; float ref, oth; DOTC(ref, c); DOTC(oth, c ^ 1); const float x1 = (p & 1) ? oth : ref, x2 = (p & 1) ? ref : oth;
      const float inv = powf(10000.0f, -(float)(2 * ip) / 32.0f), ang = (float)(row & (SEQ - 1)) * inv, cs = cosf(ang), sn = sinf(ang); const float r = (p & 1) ? (x2 * cs + x1 * sn) : (x1 * cs - x2 * sn);
      chk_flag(F, 1, chk_bad(bf2f(WSP(const bf16_t, WS_KROT)[(size_t)row * 32 + p]), r, 1.0f), 0); }
    { const int c = 640 + (i & 15); float ref; DOTC(ref, c); chk_flag(F, 2, chk_bad(WSP(const float, WS_SIDE)[(size_t)row * 16 + (c - 640)], ref, 1.0f), 0); }
    { const int c = 256 + (i & 127); float ref; DOTC(ref, c); const float got = (c < 320) ? bf2f(WSP(const bf16_t, WS_KCMP)[(size_t)row * 64 + (c - 256)]) : bf2f(WSP(const bf16_t, WS_VCMP)[(size_t)row * 64 + (c - 320)]); chk_flag(F, 3, chk_bad(got, ref, 1.0f), 0); }
    float sq = 0.f, skv = 0.f; for (int k = 0; k < 256; ++k) { const float v = bf2f(P[(size_t)row * PW + PC_DQL + k]); sq += v * v; } for (int k = 0; k < 128; ++k) { const float v = bf2f(P[(size_t)row * PW + PC_DKV + k]); skv += v * v; }
    { const float* a = WSP(const float, WS_SSQQ) + (size_t)row * 4; const float* b = WSP(const float, WS_SSQKV) + (size_t)row * 4; chk_flag(F, 4, chk_bad(a[0] + a[1] + a[2] + a[3], sq, 10.f) || chk_bad(b[0] + b[1] + b[2] + b[3], skv, 5.f), 0); }
    const float rq = 1.0f / sqrtf(sq / 256.0f + RMS_EPS), rkv = 1.0f / sqrtf(skv / 128.0f + RMS_EPS);
    const float* wq = F.in[15] + (size_t)l * 256 * 384; const float* gq = F.in[13] + l * 256; const float* wkv = F.in[16] + (size_t)l * 128 * 512; const float* gkv = F.in[14] + l * 128;
#define QDOT(dst, src) do { float a_ = 0.f; for (int k = 0; k < 256; ++k) a_ += bf2f(P[(size_t)row * PW + PC_DQL + k]) * bfr(wq[(size_t)k * 384 + (src)] * C2D * gq[k]); dst = a_ * rq; } while (0)
    { const int hd = i & 3, w = (i >> 2) & 63; float ref; QDOT(ref, hd * 96 + w); chk_flag(F, 5, chk_bad(bf2f(WSP(const bf16_t, WS_QM)[(size_t)row * 512 + hd * 96 + w]), ref, 1.5f), 0); }
    { const int hd = i & 3, p = (i >> 2) & 31, ip = p >> 1; float x1, x2; QDOT(x1, hd * 96 + 64 + ip); QDOT(x2, hd * 96 + 64 + 16 + ip); const float inv = powf(10000.0f, -(float)(2 * ip) / 32.0f), ang = (float)(row & (SEQ - 1)) * inv, cs = cosf(ang), sn = sinf(ang);
      const float r = (p & 1) ? (x2 * cs + x1 * sn) : (x1 * cs - x2 * sn); chk_flag(F, 6, chk_bad(bf2f(WSP(const bf16_t, WS_QM)[(size_t)row * 512 + hd * 96 + 64 + p]), r, 1.5f), 0); }
    { const int c = (i * 13) & 511; float a = 0.f; for (int k = 0; k < 128; ++k) a += bf2f(P[(size_t)row * PW + PC_DKV + k]) * bfr(wkv[(size_t)k * 512 + c] * gkv[k]); chk_flag(F, 7, chk_bad(bf2f(WSP(const bf16_t, WS_KVM)[(size_t)row * 512 + c]), a * rkv, 1.0f), 0); }
    { const int b = i & 15, which = (i >> 4) & 1, c = (int)(chk_hash(i + 31) % 255), n = (i * 5) & 127; const bf16_t* src = (which ? WSP(const bf16_t, WS_VCMP) : WSP(const bf16_t, WS_KCMP)) + ((size_t)b * SEQ + 16 * c) * 64;
      const float *pk1 = F.in[8], *pv1 = F.in[10], *pk2 = F.in[9], *pv2 = F.in[11]; asm volatile("" : "+s"(pk1), "+s"(pv1), "+s"(pk2), "+s"(pv2));
      const float* w1 = (which ? pv1 : pk1) + (size_t)l * 2048 * 128; const float* w2 = (which ? pv2 : pk2) + (size_t)l * 128 * 64; const float* cp = F.in[7] + (size_t)l * 2048;
      float a = 0.f, bsum = 0.f; for (int p = 0; p < 2048; ++p) { a += bf2f(src[p]) * bfr(w1[(size_t)p * 128 + n]); bsum += cp[p] * w1[(size_t)p * 128 + n]; }
      const float xx = a + bsum, g = 0.5f * xx * (1.0f + tanhf(0.7978845608028654f * (xx + 0.044715f * xx * xx * xx)));
      const bf16_t* hid = WSP(const bf16_t, WS_HID) + (size_t)(which * 4096 + b * 256 + c) * 256 + which * 128;
      chk_flag(F, 8, chk_bad(bf2f(hid[n]), g, 0.5f), 0);
      const int d = (i * 5) & 63; float o2 = 0.f; for (int nn = 0; nn < 128; ++nn) o2 += bf2f(hid[nn]) * w2[nn * 64 + d];
      chk_flag(F, 9, chk_bad(bf2f((which ? WSP(const bf16_t, WS_VC) : WSP(const bf16_t, WS_KC))[((size_t)b * 256 + c) * 64 + d]), o2, 0.5f), 0); }
#undef DOTC
#undef QDOT
}

constexpr int CW_CNT = 20544;
__device__ __forceinline__ void selfcheck_g(Frame& F, int l) {
    const int gi = blockIdx.x * 512 + threadIdx.x; const bf16_t* H = WSP(const bf16_t, WS_H); const bf16_t* P = WSP(const bf16_t, WS_P); const float* W = F.in[6] + (size_t)l * DM * DIN;
    const int row = gi & (M - 1); unsigned nbad = 0u;
    for (int k4 = 0; k4 < 4; ++k4) { int c = (int)(chk_hash(gi * 4 + k4 + 12345u) % PW); if (c >= 640 && c < 768) c -= 200;
        float sc_; const int src_ = inproj_src(c, sc_); float a_ = 0.f; for (int k = 0; k < DM; ++k) a_ += bf2f(H[(size_t)row * DM + k]) * bfr(W[(size_t)k * DIN + src_] * sc_);
        if (chk_bad(bf2f(P[(size_t)row * PW + c]), a_, 1.0f)) ++nbad; }
    if (nbad) atomicAdd((unsigned*)(F.ctl + CW_CNT), nbad);
}
__device__ __forceinline__ void selfcheck_g_fin(Frame& F) {
    if (blockIdx.x == 0 && threadIdx.x == 0) { const unsigned cnt = __hip_atomic_load(F.ctl + CW_CNT, __ATOMIC_RELAXED, __HIP_MEMORY_SCOPE_AGENT); unsigned lg = 0; while ((1u << lg) <= cnt && lg < 15) ++lg;
        atomicOr((unsigned*)(F.ctl + CW_CHK), (cnt > 63u ? 63u : cnt) | (lg << 6)); }
}

__device__ __forceinline__ void selfcheck_f(Frame& F, int l) {
    const int i = threadIdx.x; const unsigned hsh = chk_hash(i + 4242u);
    chk_flag(F, 0, chk_fox(F, i & 15, (i >> 4) & 3, (i >> 6) * 8 + (hsh & 7)), 0);
    chk_flag(F, 1, chk_fox(F, i & 15, (i >> 4) & 3, 64 + (int)(hsh % 192u)), 0);
    chk_flag(F, 2, chk_fox(F, i & 15, (i >> 4) & 3, 256 + (int)(hsh % 3840u)), 0);
    chk_flag(F, 3, chk_dil(F, i & 15, (i >> 4) & 1, (int)(hsh & 127u)), 0);
    chk_flag(F, 4, chk_dil(F, i & 15, (i >> 4) & 1, 128 + (int)(hsh % 3968u)), 0);
    { bool bad = false; if (i < 128) bad = chk_nsa(F, i & 15, (i >> 4) & 3, (int)(hsh % 31u), i); chk_flag(F, 5, bad, 0); }
    { bool bad = false; if (i < 128) bad = chk_nsa(F, i & 15, (i >> 4) & 3, 31 + (int)(hsh % 33u), i); chk_flag(F, 6, bad, 0); }
    { bool bad = false; if (i < 128) bad = chk_nsa(F, i & 15, (i >> 4) & 3, 64 + (int)(hsh % 960u), i); chk_flag(F, 7, bad, 0); }
    { bool bad = false; if (i < 128) bad = chk_nsa(F, i & 15, (i >> 4) & 3, 1024 + (int)(hsh % 3072u), i); chk_flag(F, 8, bad, 4); }
}
__device__ __forceinline__ void selfcheck_report(Frame& F) {
    const unsigned mask = __hip_atomic_load(F.ctl + CW_CHK, __ATOMIC_RELAXED, __HIP_MEMORY_SCOPE_AGENT);
    float V = (float)(10u + (mask & 63u)); const unsigned e = 2u + ((mask >> 6) & 15u); for (unsigned k = 0; k < e; ++k) V *= 10.0f;
    for (size_t idx = (size_t)blockIdx.x * 512 + threadIdx.x; idx < (size_t)M * DM; idx += (size_t)F.G * 512) F.out[idx] = V;
}
#endif
struct SchedSimple {
    pg8::TileOrder T; const char* A; const char* B; int lda, ldb, nt; int dup = 0;
    __device__ __forceinline__ bool next(int i, GUnit& u) const { int pm, pn; if (!T.tile(i >> dup, pm, pn)) return false;
        u.A = A + (size_t)pm * 256 * lda; u.B = B + (size_t)pn * 256 * ldb; u.lda = lda; u.ldb = ldb; u.nt = nt; u.pm = pm; u.pn = pn; u.id = 0; return true; }
};
struct SchedCmp1 {
    int c; const char* kc; const char* vc; const char* B;
    __device__ __forceinline__ bool next(int i, GUnit& u) const { if (i > 0 || c >= 32) return false;
        u.A = (c < 16 ? kc : vc) + (size_t)(c & 15) * 256 * 2048; u.B = B; u.lda = 2048; u.ldb = 4096; u.nt = 32; u.pm = c; u.pn = 0; u.id = 0; return true; }
};
struct SchedMerge {
    pg8::TileOrder T; const char* ocat; const char* h; const char* wbr; const char* wg; int dup = 0;
    __device__ __forceinline__ bool next(int i0, GUnit& u) const { const int i = i0 >> dup; int pm, pn; if (!T.tile(i >> 3, pm, pn)) return false;
        const int sub = i & 7; u.pm = pm; u.pn = pn; u.id = sub;
        if (sub >= 4) { u.A = h + (size_t)pm * 256 * 2048; u.lda = 2048; u.B = wg + (size_t)((pn * 4 + (sub - 4)) * 256) * 2048; u.ldb = 2048; u.nt = 16; }
        else { const int br = sub; const int kk = (br == 1) ? 128 : 256; const size_t co = (br == 0) ? 0 : (br == 1 ? 256 : (br == 2 ? 384 : 640)), wo = (br == 0) ? BR_A : (br == 1 ? BR_B : (br == 2 ? BR_C : BR_D));
            u.A = ocat + (size_t)pm * 256 * (OCW * 2) + co * 2; u.lda = OCW * 2; u.B = wbr + wo + (size_t)pn * 256 * kk * 2; u.ldb = kk * 2; u.nt = kk / 64; }
        return true; }
};

#ifndef SDUP_INPROJ
#define SDUP_INPROJ 0
#endif
#ifndef SDUP_MERGE
#define SDUP_MERGE 0
#endif
#ifndef SDUP_WO
#define SDUP_WO 0
#endif
#ifndef SDUP_UP
#define SDUP_UP 0
#endif
#ifndef SDUP_DN
#define SDUP_DN 0
#endif
#ifndef DUP_ATTN
#define DUP_ATTN 1
#endif
#ifndef DUP_GEMM
#define DUP_GEMM 1
#endif
#ifndef DUP_MERGE
#define DUP_MERGE 1
#endif
#ifndef DUP_FFN
#define DUP_FFN 1
#endif
#ifdef ONLY_PHASE
#define PH(k) ((k) == ONLY_PHASE)
#else
#define PH(k) true
#endif
struct Args { const float* in[27]; float* out; unsigned char* ws; };
__global__ void __launch_bounds__(512, 2) hybrid_fwd(Args args) {
    extern __shared__ __attribute__((aligned(16))) unsigned char lds_raw[];
    Frame F;
    F.lds = (LAS unsigned char*)lds_raw; F.MISC = (volatile LAS unsigned*)(F.lds + MISC_OFF);
    F.tid = threadIdx.x; F.lane = F.tid & 63; F.wave = __builtin_amdgcn_readfirstlane(F.tid >> 6); F.G = gridDim.x;
#pragma unroll
    for (int i = 0; i < 27; ++i) F.in[i] = args.in[i];
    F.out = args.out; F.ws = args.ws; F.ctl = (gu32*)(args.ws + WS_CTL);
    for (int u = F.tid; u < (LDS_BYTES - LDSCTL_OFF) / 4; u += 512) ((LAS unsigned*)(F.lds + LDSCTL_OFF))[u] = 0u;
    __syncthreads();
    XcdBarrier bar = xcd_barrier_post((unsigned*)(F.ctl + CW_BAR), F.MISC + 8);
    const int c = (int)blockIdx.x;
#if defined(TIMEPROBE)
    if (threadIdx.x == 0) *(volatile LAS unsigned long long*)(F.lds + MISC_OFF + 64) = __builtin_amdgcn_s_memrealtime();
#define TSTAMP(id) do { if (blockIdx.x == 0 && threadIdx.x == 0) { volatile LAS unsigned long long* tp_ = (volatile LAS unsigned long long*)(F.lds + MISC_OFF + 64); const unsigned long long now_ = __builtin_amdgcn_s_memrealtime(); unsigned long long* a_ = (unsigned long long*)(F.ws + 90000) + (id); *a_ = *a_ + (now_ - *tp_); *tp_ = now_; } } while (0)
#else
#define TSTAMP(id) do { } while (0)
#endif

#ifndef DUP_P0
#define DUP_P0 1
#endif
    for (int rep = 0; rep < DUP_P0; ++rep) { if (rep) xcd_barrier(bar); if (PH(0)) p0_prologue(F); }
    xcd_barrier(bar); TSTAMP(0);

#ifndef XTRA_BAR
#define XTRA_BAR 0
#endif
    _Pragma("unroll") for (int xb = 0; xb < XTRA_BAR; ++xb) xcd_barrier(bar);
#define PHASE_FRESH() do { int t_ = threadIdx.x; asm volatile("" : "+v"(t_)); F.tid = t_; F.lane = t_ & 63; } while (0)
    for (int l = 0; l < DEPTH; ++l) {
        unsigned char* wl = F.ws + WS_WT + (size_t)l * LW;
        const float* xin = (l == 0) ? F.in[0] : F.out;
        PHASE_FRESH();
#ifndef DUP_RP0
#define DUP_RP0 1
#endif
        if (l == 0) { if (c == 0) cmpb_reduce(F);
          _Pragma("unroll") for (int rep = 0; rep < DUP_RP0; ++rep) { if (rep) xcd_barrier(bar); if (PH(1)) rowpass<0>(F, xin, nullptr, 0, nullptr, WSP(bf16_t, WS_H), F.in[2] + l * DM, nullptr, 0, M); }
          xcd_barrier(bar); TSTAMP(1); }
        for (int rep = 0; rep < DUP_GEMM; ++rep) if (PH(2)) { if (rep) xcd_barrier(bar); SchedSimple S; S.T.init(256, 12, F.G, c); S.A = (const char*)(F.ws + WS_H); S.B = (const char*)(wl + LW_IN); S.lda = 2048; S.ldb = 2048; S.nt = 16; S.dup = SDUP_INPROJ;
          pg8::EpiInProj E{WSP(bf16_t, WS_P), WSP(bf16_t, WS_KCMP), WSP(bf16_t, WS_VCMP), WSP(float, WS_SIDE), WSP(bf16_t, WS_KROT), WSP(const float, WS_ROPE), WSP(float, WS_SSQQ), WSP(float, WS_SSQKV), F.in[12] + l * 4, WSP(float, WS_LF)};
          pg8::gemm_phase<pg8::EpiInProj, SchedSimple, true>(F.lds, S, E); }
        xcd_barrier(bar); TSTAMP(2);
#ifndef DUP_L2A
#define DUP_L2A 1
#endif
        _Pragma("unroll") for (int rep2 = 0; rep2 < DUP_L2A; ++rep2) { if (rep2) xcd_barrier(bar);
        if (PH(3)) { SchedCmp1 S{c, (const char*)(F.ws + WS_KCMP), (const char*)(F.ws + WS_VCMP), (const char*)(wl + LW_PHI)};
          pg8::EpiCmp1 E{WSP(bf16_t, WS_HID), WSP(const float, WS_CMPB) + l * 256};
          pg8::gemm_phase<pg8::EpiCmp1, SchedCmp1, false>(F.lds, S, E);
          if (c < 32) {
              __syncthreads(); const int which = c >> 4, b = c & 15;
              int ln_ = threadIdx.x & 63; asm volatile("" : "+v"(ln_)); const int r32 = ln_ & 31, hi = ln_ >> 5;
              const bf16_t* hrow = WSP(const bf16_t, WS_HID) + ((size_t)c * 256 + F.wave * 32 + r32) * 256 + which * 128;
              const float *pk2 = F.in[9], *pv2 = F.in[11]; asm volatile("" : "+s"(pk2), "+s"(pv2)); const float* w2 = (which ? pv2 : pk2) + (size_t)l * 128 * 64;
              f32x16 o0, o1;
#pragma unroll
              for (int r = 0; r < 16; ++r) { o0[r] = 0.f; o1[r] = 0.f; }
#pragma unroll
              for (int ks = 0; ks < 8; ++ks) { const bf16x8 a = *(const bf16x8*)(hrow + ks * 16 + hi * 8);
                  const float* wp = w2 + (size_t)(ks * 16 + hi * 8) * 64 + r32; u32x4 b0, b1;
#pragma unroll
                  for (int jj = 0; jj < 4; ++jj) { b0[jj] = cvtpk(wp[(2 * jj) * 64], wp[(2 * jj + 1) * 64]); b1[jj] = cvtpk(wp[(2 * jj) * 64 + 32], wp[(2 * jj + 1) * 64 + 32]); }
                  o0 = MFMA32(a, __builtin_bit_cast(bf16x8, b0), o0); o1 = MFMA32(a, __builtin_bit_cast(bf16x8, b1), o1); }
              bf16_t* dst = (which ? WSP(bf16_t, WS_VC) : WSP(bf16_t, WS_KC)) + ((size_t)b * 256 + F.wave * 32) * 64 + r32;
#pragma unroll
              for (int r = 0; r < 16; ++r) { const int rw = crow(r, hi); dst[(size_t)rw * 64] = (bf16_t)f2bf(o0[r]); dst[(size_t)rw * 64 + 32] = (bf16_t)f2bf(o1[r]); } } }
        if (PH(4)) { int G2_ = F.G; asm volatile("" : "+s"(G2_)); const bool split = G2_ > 64; const int g2 = split ? F.G - 32 : F.G, c2 = split ? c - 32 : c;
          { SchedSimple S; S.T.init(256, 2, g2, c2 < 0 ? (1 << 28) : c2); S.A = (const char*)(F.ws + WS_P) + PC_DQL * 2; S.B = (const char*)(wl + LW_UQ); S.lda = PW * 2; S.ldb = 512; S.nt = 4;
            pg8::EpiQup E{WSP(bf16_t, WS_QM), WSP(const float, WS_SSQQ), WSP(const float, WS_ROPE)};
            pg8::gemm_phase<pg8::EpiQup, SchedSimple, true>(F.lds, S, E); }
          { SchedSimple S; S.T.init(256, 2, g2, c2 < 0 ? (1 << 28) : c2); S.A = (const char*)(F.ws + WS_P) + PC_DKV * 2; S.B = (const char*)(wl + LW_UKV); S.lda = PW * 2; S.ldb = 256; S.nt = 2;
            pg8::EpiKVup E{WSP(bf16_t, WS_KVM), WSP(const float, WS_SSQKV)};
            pg8::gemm_phase<pg8::EpiKVup, SchedSimple, true>(F.lds, S, E); } }
        PHASE_FRESH();
        if (PH(5)) {
          int G_ = F.G; asm volatile("" : "+s"(G_)); const int cb = (G_ >= 48) ? c - 32 : c;
          if (cb >= 0 && cb < BATCH) { const int b = cb, tid = F.tid; const float* lf = WSP(const float, WS_LF) + ((size_t)b * SEQ + 8 * tid) * 4;
              f32x4 v[8];
#pragma unroll
              for (int i = 0; i < 8; ++i) v[i] = *(const f32x4*)(lf + 4 * i);
#pragma unroll
              for (int i = 1; i < 8; ++i) v[i] = v[i] + v[i - 1];
              LAS f32x4* sc = (LAS f32x4*)F.lds; f32x4 run = v[7];
              sc[tid] = run; __syncthreads();
              for (int off = 1, cur = 0; off < 512; off <<= 1, cur ^= 1) { f32x4 t = sc[cur * 512 + tid]; if (tid >= off) t = t + sc[cur * 512 + tid - off]; sc[(cur ^ 1) * 512 + tid] = t; __syncthreads(); run = t; }
              const f32x4 ex = run - v[7];
              float* kb = WSP(float, WS_KB) + (size_t)b * 4 * SEQ + 8 * tid;
#pragma unroll
              for (int e = 0; e < 4; ++e) { f32x4 lo, hi4;
#pragma unroll
                  for (int i = 0; i < 4; ++i) { lo[i] = -(ex[e] + v[i][e]) * LOG2E; hi4[i] = -(ex[e] + v[4 + i][e]) * LOG2E; }
                  *(f32x4*)(kb + (size_t)e * SEQ) = lo; *(f32x4*)(kb + (size_t)e * SEQ + 4) = hi4; }
              __syncthreads();
              { const bf16_t* Kp = WSP(const bf16_t, WS_P) + ((size_t)b * SEQ + 8 * tid) * PW + PC_CK; f32x4 mx2 = {0.f, 0.f, 0.f, 0.f};
                for (int i = 0; i < 8; ++i)
#pragma unroll
                    for (int hh = 0; hh < 4; ++hh) { float ss = 0.f;
#pragma unroll
                        for (int q8 = 0; q8 < 8; ++q8) { const bf16x8 kv = *(const bf16x8*)(Kp + (size_t)i * PW + hh * 64 + q8 * 8);
#pragma unroll
                            for (int e = 0; e < 8; ++e) { const float x = bf2f((unsigned short)kv[e]); ss += x * x; } }
                        mx2[hh] = fmaxf(mx2[hh], ss); }
                LAS f32x4* sm = (LAS f32x4*)F.lds; sm[tid] = mx2; __syncthreads();
                for (int off = 256; off > 0; off >>= 1) { if (tid < off) { const f32x4 o = sm[tid + off]; f32x4 t = sm[tid]; t[0] = fmaxf(t[0], o[0]); t[1] = fmaxf(t[1], o[1]); t[2] = fmaxf(t[2], o[2]); t[3] = fmaxf(t[3], o[3]); sm[tid] = t; } __syncthreads(); }
                if (tid < 4) WSP(float, WS_KMAX)[b * 4 + tid] = sqrtf(sm[0][tid]); __syncthreads(); }
          } }
        }
        xcd_barrier(bar); TSTAMP(3);
        PHASE_FRESH();
        for (int rep = 0; rep < DUP_ATTN; ++rep) { gu32* ctr = F.ctl + CW_Q + 64 * l + 16 * rep;
          if (rep) xcd_barrier(bar);
          for (;;) { const int iq = queue_grab(F, ctr); if (iq >= ATT_UNITS) break;
              const int it = __builtin_amdgcn_readfirstlane(WSP(const int, WS_ORDER)[iq]);
              if (it < 2048 && PH(7)) { const int qb = 15 - (it >> 7), mla = (it >> 6) & 1, bh = it & 63; if (mla) causal_unit<false>(F, bh >> 2, bh & 3, qb); else causal_unit<true>(F, bh >> 2, bh & 3, qb); }
              else if (it < 3072 && PH(8)) { const int r = it - 2048; nsa_unit(F, r & 15, 63 - (r >> 4)); }
              else if (it < 3328 && PH(9)) { const int r = it - 3072; dil_unit(F, r & 15, (r >> 4) & 1, r >> 5); }
              else break; } }
        xcd_barrier(bar); TSTAMP(5);
#if defined(SELFCHECK) && SELFCHECK == 1
        if (c == 0) selfcheck_a(F, l);
#endif
#if defined(SELFCHECK) && SELFCHECK == 3
        if (c == 0) selfcheck_e(F, l);
        xcd_barrier(bar); selfcheck_report(F); return;
#endif
#if defined(SELFCHECK) && SELFCHECK == 5
        selfcheck_g(F, l); xcd_barrier(bar); selfcheck_g_fin(F);
        xcd_barrier(bar); selfcheck_report(F); return;
#endif
#if defined(SELFCHECK) && SELFCHECK == 4
        if (c == 0) selfcheck_f(F, l);
        xcd_barrier(bar); selfcheck_report(F); return;
#endif
        for (int rep = 0; rep < DUP_MERGE; ++rep) if (PH(10)) { if (rep) xcd_barrier(bar); SchedMerge S; S.T.init(256, 4, F.G, c); S.ocat = (const char*)(F.ws + WS_OCAT); S.h = (const char*)(F.ws + WS_H); S.wbr = (const char*)(wl + LW_BR); S.wg = (const char*)(wl + LW_G); S.dup = SDUP_MERGE;
          unsigned char* scr = F.ws + WS_MSCR + (size_t)c * MSCR_PER_WG;
          pg8::EpiMerge E{WSP(bf16_t, WS_MERGED), scr};
          pg8::gemm_phase<pg8::EpiMerge, SchedMerge, true>(F.lds, S, E); }
        xcd_barrier(bar); TSTAMP(6);
#if defined(SELFCHECK) && SELFCHECK == 1
        if (c == 0) selfcheck_b(F, l);
        xcd_barrier(bar); selfcheck_report(F); return;
#endif
        if (PH(11)) { SchedSimple S; S.T.init(256, 4, F.G, c); S.A = (const char*)(F.ws + WS_MERGED); S.B = (const char*)(wl + LW_O); S.lda = 2048; S.ldb = 2048; S.nt = 16; S.dup = SDUP_WO;
          pg8::EpiBf16 E{WSP(bf16_t, WS_Y), DM};
          pg8::gemm_phase<pg8::EpiBf16, SchedSimple, true>(F.lds, S, E); }
        xcd_barrier(bar); TSTAMP(7);
        PHASE_FRESH();
        if (PH(12)) rowpass<1>(F, xin, WSP(const bf16_t, WS_Y), 0, F.out, WSP(bf16_t, WS_H2), F.in[3] + l * DM, F.in[4] + l * DM, 0, M);
        xcd_barrier(bar); TSTAMP(8);
#ifdef DUP_RP1
        if (l == 0) { _Pragma("unroll") for (int rep = 0; rep < DUP_RP1; ++rep) { rowpass<1>(F, xin, WSP(const bf16_t, WS_Y), 0, F.out, WSP(bf16_t, WS_H2), F.in[3] + l * DM, F.in[4] + l * DM, 0, M); xcd_barrier(bar); } }
#endif
#ifndef DUP_UP
#define DUP_UP 1
#endif
        _Pragma("unroll") for (int rep = 0; rep < DUP_UP; ++rep) if (PH(13)) { if (rep) xcd_barrier(bar); SchedSimple S; S.T.init(256, 22, F.G, c); S.A = (const char*)(F.ws + WS_H2); S.B = (const char*)(wl + LW_UP); S.lda = 2048; S.ldb = 2048; S.nt = 16; S.dup = SDUP_UP;
          pg8::EpiUpConv E{WSP(bf16_t, WS_ACT), WSP(float, WS_HB), F.in[24] + (size_t)l * 3 * DFF2, F.in[25] + (size_t)l * DFF2};
          pg8::gemm_phase<pg8::EpiUpConv, SchedSimple, true>(F.lds, S, E); }
        xcd_barrier(bar); TSTAMP(9);
        PHASE_FRESH();
        if (PH(15)) { SchedSimple S; S.T.init(256, 4, F.G, c); S.A = (const char*)(F.ws + WS_ACT); S.B = (const char*)(wl + LW_DN); S.lda = DFF * 2; S.ldb = DFF * 2; S.nt = DFF / 64; S.dup = SDUP_DN;
          { int pm, pn; for (int i = 0; S.T.tile(i, pm, pn); ++i) ffn_fix_panel(F, pm, WSP(const float, WS_HB), WSP(bf16_t, WS_ACT), F.in[24] + (size_t)l * 3 * DFF2, F.in[25] + (size_t)l * DFF2); }
          VM_WAIT(); __syncthreads();
          pg8::EpiBf16 E{WSP(bf16_t, WS_Y2), DM};
          pg8::gemm_phase<pg8::EpiBf16, SchedSimple, true>(F.lds, S, E); }
        xcd_barrier(bar); TSTAMP(11);
        PHASE_FRESH();
        if (PH(16)) { if (l + 1 < DEPTH) rowpass<1>(F, F.out, WSP(const bf16_t, WS_Y2), 0, F.out, WSP(bf16_t, WS_H), F.in[5] + l * DM, F.in[2] + (l + 1) * DM, 0, M);
                      else rowpass<2>(F, F.out, WSP(const bf16_t, WS_Y2), 0, F.out, nullptr, F.in[5] + l * DM, nullptr, 0, M); }
        xcd_barrier(bar); TSTAMP(12);
    }
#if defined(TIMEPROBE)
    { xcd_barrier(bar); const unsigned long long* a_ = (const unsigned long long*)(F.ws + 90000); const float V1 = (float)a_[TIMEPROBE_A] * 0.01f, V2 = (float)a_[TIMEPROBE_B] * 0.01f * 1000.0f;
      for (size_t idx = (size_t)blockIdx.x * 512 + threadIdx.x; idx < (size_t)M * DM; idx += (size_t)F.G * 512) F.out[idx] = (idx == 12345) ? V2 : V1; }
#endif
}

extern "C" void kernel_launch(void* const* d_in, const int* in_sizes, int n_in, void* d_out, int out_size, void* d_ws, size_t ws_size, hipStream_t stream) {
    static int grid = 0;
    if (grid == 0) {
        if (n_in != 27 || in_sizes[0] != M * DM || out_size != M * DM || ws_size < WS_END) { fprintf(stderr, "kernel_launch: unexpected shapes (n_in %d, in0 %d, out %d, ws %zu)\n", n_in, n_in > 0 ? in_sizes[0] : -1, out_size, ws_size); grid = -1; return; }
        int dev = 0, cus = 0, per_cu = 0;
        if (hipGetDevice(&dev) != hipSuccess || hipDeviceGetAttribute(&cus, hipDeviceAttributeMultiprocessorCount, dev) != hipSuccess) { grid = -1; return; }
        if (hipFuncSetAttribute((const void*)hybrid_fwd, hipFuncAttributeMaxDynamicSharedMemorySize, LDS_BYTES) != hipSuccess) { fprintf(stderr, "kernel_launch: hipFuncSetAttribute failed\n"); grid = -1; return; }
        if (hipOccupancyMaxActiveBlocksPerMultiprocessor(&per_cu, (const void*)hybrid_fwd, 512, LDS_BYTES) != hipSuccess || per_cu < 1) fprintf(stderr, "kernel_launch: occupancy query says %d\n", per_cu);
        (void)hipGetLastError();
        grid = cus;
    }
    if (grid < 0) return;
    if (hipMemsetAsync((char*)d_ws + WS_CTL, 0, CTL_ZERO_BYTES, stream) != hipSuccess) return;
    Args a{};
    for (int i = 0; i < 27; ++i) a.in[i] = (const float*)d_in[i];
    a.out = (float*)d_out; a.ws = (unsigned char*)d_ws;
    hipLaunchKernelGGL(hybrid_fwd, dim3(grid), dim3(512), LDS_BYTES, stream, a);
}
```

```cpp
#include <hip/hip_runtime.h>
#include <hip/hip_bf16.h>
#include <cstdio>
#include <cstdint>
#include <cmath>

#define GAS __attribute__((address_space(1)))
#define LAS __attribute__((address_space(3)))
typedef unsigned short bf16_t;
typedef short bf16x8 __attribute__((ext_vector_type(8)));
typedef short s16x4 __attribute__((ext_vector_type(4)));
typedef float f32x4 __attribute__((ext_vector_type(4)));
typedef float f32x2 __attribute__((ext_vector_type(2)));
typedef float f32x16 __attribute__((ext_vector_type(16)));
typedef unsigned u32x4 __attribute__((ext_vector_type(4)));
typedef unsigned u32x2 __attribute__((ext_vector_type(2)));
typedef GAS unsigned gu32;

constexpr int BATCH = 16, SEQ = 4096, DM = 1024, M = BATCH * SEQ, DEPTH = 2;
constexpr int DIN = 2992, PW = 3072;
constexpr int DFF = 2816, DFF2 = 5632;
constexpr float LOG2E = 1.4426950408889634f;
constexpr float C2A = 0.125f * LOG2E;
constexpr float C2D = 0.10206207261596575f * LOG2E;
constexpr float RMS_EPS = 1e-6f;
constexpr int PC_AQ = 0, PC_KCMP = 256, PC_VCMP = 320, PC_KSLC = 384, PC_VSLC = 448, PC_KWIN = 512, PC_VWIN = 576,
              PC_MISC = 640, PC_KROPE = 672, PC_BQ = 768, PC_BK = 1152, PC_BV = 1536, PC_DKV = 1920,
              PC_CQ = 2048, PC_CK = 2304, PC_CV = 2560, PC_DQL = 2816;
constexpr int OCW = 896;
constexpr int NSA_DFAR = 1536, NSA_DMAX = 1664, NSA_TL = 1728;

__device__ __forceinline__ unsigned f2bf(float f) { unsigned u = __float_as_uint(f); return (u + 0x7fffu + ((u >> 16) & 1u)) >> 16; }
__device__ __forceinline__ unsigned pk2(float lo, float hi) { return f2bf(lo) | (f2bf(hi) << 16); }
__device__ __forceinline__ float bf2f(unsigned short b) { return __uint_as_float((unsigned)b << 16); }
typedef __bf16 bf16x2_t __attribute__((ext_vector_type(2)));
__device__ __forceinline__ unsigned cvtpk(float lo, float hi) { f32x2 v = {lo, hi}; bf16x2_t b = __builtin_convertvector(v, bf16x2_t); return __builtin_bit_cast(unsigned, b); }
__device__ __forceinline__ float fast_exp2(float x) { return __builtin_amdgcn_exp2f(x); }
__device__ __forceinline__ float fast_rcp(float x) { return __builtin_amdgcn_rcpf(x); }
template <int MASK> __device__ __forceinline__ float xor_lane_lt32(float v) { return __uint_as_float(__builtin_amdgcn_ds_swizzle((int)__float_as_uint(v), (MASK << 10) | 0x1f)); }
__device__ __forceinline__ float sum_halves(float v) { auto rr = __builtin_amdgcn_permlane32_swap(__float_as_uint(v), __float_as_uint(v), false, false); return __uint_as_float(rr[0]) + __uint_as_float(rr[1]); }
__device__ __forceinline__ float sigmoid_f(float x) { return fast_rcp(1.0f + fast_exp2(-x * LOG2E)); }

namespace pg8 {
constexpr int BM = 256, BK = 64, HALF = 128, HTB = HALF * BK * 2  , STAGE_BYTES = 8 * HTB, NXCD = 8, WGM = 8;
__host__ __device__ __forceinline__ int lds_byte(int r, int c) { const int st = (r >> 4) * 2 + (c >> 5), rr = r & 15, cc = c & 31, ob = rr * 64 + cc * 2; return st * 1024 + (ob ^ (((ob >> 9) & 1) << 5)); }
__host__ __device__ __forceinline__ void stage_rc(int b, int& R, int& C) { const int st = b / 1024, sb = b % 1024, swz = sb ^ (((sb >> 9) & 1) << 5); R = (st >> 1) * 16 + swz / 64; C = (st & 1) * 32 + (swz % 64) / 2; }
__host__ __device__ __forceinline__ int perm32(int rho) { const int n = rho >> 4, i = rho & 15; return 8 * (i >> 2) + 4 * n + (i & 3); }

struct GUnit { const char* A; const char* B; int lda, ldb, nt, pm, pn, id; };

struct TileOrder {
    int nM, nN, nwg, G, c;
    __device__ __forceinline__ void init(int nM_, int nN_, int G_, int c_) { nM = nM_; nN = nN_; nwg = nM * nN; G = G_; c = c_; }
    __device__ __forceinline__ bool tile(int i, int& pm, int& pn) const {
        const long L = (long)i * G + c; if (L >= nwg) return false;
        int wgid = (int)L; { const int q = nwg / NXCD, r = nwg % NXCD, xcd = wgid % NXCD, off = wgid / NXCD; wgid = (xcd < r ? xcd * (q + 1) : r * (q + 1) + (xcd - r) * q) + off; }
        const int nig = WGM * nN, gid = wgid / nig, fm = gid * WGM, gsz = (nM - fm) < WGM ? (nM - fm) : WGM;
        pm = fm + ((wgid % nig) % gsz); pn = (wgid % nig) / gsz; return true;
    }
};

template <class Epi, class Sched, bool ALIGN_EPI>
__device__ __forceinline__ void gemm_phase(LAS unsigned char* lds, const Sched& S, const Epi& E) {
    int tid_o = threadIdx.x; asm volatile("" : "+v"(tid_o));
    const int tid = tid_o, wid = __builtin_amdgcn_readfirstlane(tid >> 6), lane = tid & 63, wr = wid >> 2, wc = wid & 3; int fr = lane & 15, fq = lane >> 4;
    int sR[2], sC[2], sRb[2];
#pragma unroll
    for (int i = 0; i < 2; ++i) { stage_rc(tid * 16 + i * 8192, sR[i], sC[i]); sRb[i] = Epi::PERM ? ((sR[i] & ~31) + perm32(sR[i] & 31)) : sR[i]; sC[i] *= 2; }
    const size_t kstep = (size_t)(BK * 2);
    const unsigned ldsw = (unsigned)wid * 1024u;
    const int aoff = lds_byte(wr * 64 + fr, fq * 8), boff = lds_byte(wc * 32 + fr, fq * 8);
#define PG8_SA(b, h) (((b) * 2 + (h)) * HTB)
#define PG8_SB(b, h) ((4 + (b) * 2 + (h)) * HTB)
#define PG8_STAGE(bufoff, gbase, rows, ld) do { _Pragma("unroll") for (int _i = 0; _i < 2; ++_i) \
        __builtin_amdgcn_global_load_lds((const unsigned*)((const char*)(gbase) + (unsigned)((rows)[_i] * (ld) + sC[_i])), (LAS unsigned*)(lds + (bufoff) + ldsw + _i * 8192), 16, 0, 0); } while (0)
#define PG8_LDA(dst, b, h) do { _Pragma("unroll") for (int m = 0; m < 4; ++m) _Pragma("unroll") for (int k = 0; k < 2; ++k) dst[m][k] = *(const LAS bf16x8*)(lds + PG8_SA(b, h) + aoff + m * 2048 + k * 1024); } while (0)
#define PG8_LDB(dst, b, h) do { _Pragma("unroll") for (int n = 0; n < 2; ++n) _Pragma("unroll") for (int k = 0; k < 2; ++k) dst[n][k] = *(const LAS bf16x8*)(lds + PG8_SB(b, h) + boff + n * 2048 + k * 1024); } while (0)
#define PG8_MMA(ai, bj, At, Bt) do { __builtin_amdgcn_s_setprio(1); _Pragma("unroll") for (int m = 0; m < 4; ++m) _Pragma("unroll") for (int n = 0; n < 2; ++n) _Pragma("unroll") for (int k = 0; k < 2; ++k) \
        acc[ai][bj][m][n] = __builtin_amdgcn_mfma_f32_16x16x32_bf16(Bt[n][k], At[m][k], acc[ai][bj][m][n], 0, 0, 0); __builtin_amdgcn_s_setprio(0); } while (0)
#define PG8_WAIT_V(n) asm volatile("s_waitcnt vmcnt(" #n ")" ::: "memory")
#define PG8_WAIT_L(n) asm volatile("s_waitcnt lgkmcnt(" #n ")" ::: "memory")
#define PG8_BAR __builtin_amdgcn_s_barrier()
#define PG8_SCHED __builtin_amdgcn_sched_barrier(0)
    GUnit cur, nxt; int ui = 0;
    if (!S.next(0, cur)) return;
    f32x4 acc[2][2][4][2];
#pragma unroll
    for (int a = 0; a < 2; ++a)
#pragma unroll
        for (int b = 0; b < 2; ++b)
#pragma unroll
            for (int m = 0; m < 4; ++m)
#pragma unroll
                for (int n = 0; n < 2; ++n) acc[a][b][m][n] = (f32x4){0.f, 0.f, 0.f, 0.f};
    bf16x8 At[4][2], B0[2][2], B1[2][2];
    int ldAc = cur.lda, ldBc = cur.ldb; size_t hAc = (size_t)HALF * ldAc, hBc = (size_t)HALF * ldBc;
    const char* cA = cur.A; const char* cB = cur.B;
    PG8_STAGE(PG8_SB(0, 0), cB, sRb, ldBc); PG8_STAGE(PG8_SB(0, 1), cB + hBc, sRb, ldBc); PG8_STAGE(PG8_SA(0, 0), cA, sR, ldAc); PG8_STAGE(PG8_SA(0, 1), cA + hAc, sR, ldAc);
    if (wr == 1) PG8_BAR;
    PG8_WAIT_V(2); PG8_BAR;
    PG8_STAGE(PG8_SB(1, 0), cB + kstep, sRb, ldBc); PG8_STAGE(PG8_SA(1, 0), cA + kstep, sR, ldAc); PG8_STAGE(PG8_SB(1, 1), cB + hBc + kstep, sRb, ldBc);
    PG8_WAIT_V(6); PG8_BAR;
    for (;;) {
        const bool has_next = S.next(ui + 1, nxt);
        int ldAn, ldBn; const char* nA; const char* nB;
        if (has_next) { ldAn = nxt.lda; ldBn = nxt.ldb; nA = nxt.A; nB = nxt.B; } else { ldAn = ldAc; ldBn = ldBc; nA = cA; nB = cB; }
        const size_t hAn = (size_t)HALF * ldAn, hBn = (size_t)HALF * ldBn;
        int nt = cur.nt; asm volatile("" : "+s"(nt));
        for (int t = 0; t < nt; t += 2) {
            const bool last = (t == nt - 2);
            const char* a1 = cA + (size_t)(t + 1) * kstep;
            const char* a2 = last ? nA : cA + (size_t)(t + 2) * kstep; const char* b2 = last ? nB : cB + (size_t)(t + 2) * kstep;
            const char* a3 = a2 + kstep; const char* b3 = b2 + kstep;
            const int ldA2 = last ? ldAn : ldAc, ldB2 = last ? ldBn : ldBc;
            const size_t hA2 = last ? hAn : hAc, hB2 = last ? hBn : hBc;
            PG8_LDB(B0, 0, 0); PG8_LDB(B1, 0, 1); PG8_SCHED; PG8_LDA(At, 0, 0); PG8_STAGE(PG8_SA(1, 1), a1 + hAc, sR, ldAc);
            PG8_WAIT_V(8); PG8_WAIT_L(0); PG8_BAR; PG8_MMA(0, 0, At, B0); PG8_MMA(0, 1, At, B1); PG8_BAR; PG8_SCHED;
            PG8_LDA(At, 0, 1); PG8_STAGE(PG8_SB(0, 0), b2, sRb, ldB2); PG8_STAGE(PG8_SB(0, 1), b2 + hB2, sRb, ldB2); PG8_STAGE(PG8_SA(0, 0), a2, sR, ldA2);
            PG8_WAIT_V(8); PG8_WAIT_L(0); PG8_BAR; PG8_MMA(1, 0, At, B0); PG8_MMA(1, 1, At, B1); PG8_BAR; PG8_SCHED;
            PG8_LDB(B0, 1, 0); PG8_LDB(B1, 1, 1); PG8_SCHED; PG8_LDA(At, 1, 0); PG8_STAGE(PG8_SA(0, 1), a2 + hA2, sR, ldA2);
            PG8_WAIT_V(8); PG8_WAIT_L(0); PG8_BAR; PG8_MMA(0, 0, At, B0); PG8_MMA(0, 1, At, B1); PG8_BAR; PG8_SCHED;
            PG8_LDA(At, 1, 1); PG8_STAGE(PG8_SB(1, 0), b3, sRb, ldB2); PG8_STAGE(PG8_SB(1, 1), b3 + hB2, sRb, ldB2); PG8_STAGE(PG8_SA(1, 0), a3, sR, ldA2);
            PG8_WAIT_V(8); PG8_WAIT_L(0); PG8_BAR; PG8_MMA(1, 0, At, B0); PG8_MMA(1, 1, At, B1); PG8_BAR; PG8_SCHED;
        }
        if constexpr (ALIGN_EPI) { if (wr == 0) PG8_BAR; }
        E(acc, cur, wr, wc, fr, fq);
        if (!has_next) break;
#pragma unroll
        for (int a = 0; a < 2; ++a)
#pragma unroll
            for (int b = 0; b < 2; ++b)
#pragma unroll
                for (int m = 0; m < 4; ++m)
#pragma unroll
                    for (int n = 0; n < 2; ++n) acc[a][b][m][n] = (f32x4){0.f, 0.f, 0.f, 0.f};
        cur = nxt; cA = nA; cB = nB; ++ui;
        ldAc = ldAn; ldBc = ldBn; hAc = hAn; hBc = hBn;
        if constexpr (ALIGN_EPI) { if (wr == 1) PG8_BAR; }
    }
    PG8_WAIT_V(0);
    if constexpr (!ALIGN_EPI) { if (wr == 0) PG8_BAR; }
    PG8_BAR;
#undef PG8_SA
#undef PG8_SB
#undef PG8_STAGE
#undef PG8_LDA
#undef PG8_LDB
#undef PG8_MMA
#undef PG8_WAIT_V
#undef PG8_WAIT_L
#undef PG8_BAR
#undef PG8_SCHED
}
}
using pg8::GUnit;
namespace pg8 {
#define EPI_OPAQUE() asm volatile("" : "+v"(fr), "+v"(fq))
struct EpiBf16 {
    static constexpr bool PERM = true;
    bf16_t* O; int ldc;
    __device__ __forceinline__ void operator()(const f32x4 (&acc)[2][2][4][2], const GUnit& u, int wr, int wc, int fr, int fq) const {
        EPI_OPAQUE();
        const int row0 = u.pm * BM + wr * 64 + fr, col0 = u.pn * BM + wc * 32 + 8 * fq;
#pragma unroll
        for (int ai = 0; ai < 2; ++ai)
#pragma unroll
            for (int m = 0; m < 4; ++m) { bf16_t* rowp = O + (size_t)(row0 + ai * HALF + m * 16) * ldc + col0;
#pragma unroll
                for (int bj = 0; bj < 2; ++bj) { const f32x4 v0 = acc[ai][bj][m][0], v1 = acc[ai][bj][m][1];
                    u32x4 w; w.x = cvtpk(v0[0], v0[1]); w.y = cvtpk(v0[2], v0[3]); w.z = cvtpk(v1[0], v1[1]); w.w = cvtpk(v1[2], v1[3]);
                    *(u32x4*)(rowp + bj * HALF) = w; } }
    }
};
struct EpiF32 {
    static constexpr bool PERM = false;
    float* O; int ldc;
    __device__ __forceinline__ void operator()(const f32x4 (&acc)[2][2][4][2], const GUnit& u, int wr, int wc, int fr, int fq) const {
        EPI_OPAQUE();
        const int row0 = u.pm * BM + wr * 64 + fr, col0 = u.pn * BM + wc * 32 + 4 * fq;
#pragma unroll
        for (int ai = 0; ai < 2; ++ai)
#pragma unroll
            for (int m = 0; m < 4; ++m) { float* rowp = O + (size_t)(row0 + ai * HALF + m * 16) * ldc + col0;
#pragma unroll
                for (int bj = 0; bj < 2; ++bj)
#pragma unroll
                    for (int n = 0; n < 2; ++n) *(f32x4*)(rowp + bj * HALF + n * 16) = acc[ai][bj][m][n]; }
    }
};
__device__ __forceinline__ void rope8(f32x4& v0, f32x4& v1, const float* cs  ) {
    const f32x4 a = *(const f32x4*)cs, b = *(const f32x4*)(cs + 4);
    f32x4 r0, r1;
    r0[0] = v0[0] * a[0] - v0[1] * a[1]; r0[1] = v0[1] * a[0] + v0[0] * a[1];
    r0[2] = v0[2] * a[2] - v0[3] * a[3]; r0[3] = v0[3] * a[2] + v0[2] * a[3];
    r1[0] = v1[0] * b[0] - v1[1] * b[1]; r1[1] = v1[1] * b[0] + v1[0] * b[1];
    r1[2] = v1[2] * b[2] - v1[3] * b[3]; r1[3] = v1[3] * b[2] + v1[2] * b[3];
    v0 = r0; v1 = r1;
}
struct EpiInProj {
    static constexpr bool PERM = true;
    bf16_t* P; bf16_t* kcmp; bf16_t* vcmp; float* side; bf16_t* krot; const float* rope; float* ssq_q; float* ssq_kv; const float* fbias; float* lf;
    __device__ __forceinline__ void operator()(const f32x4 (&acc)[2][2][4][2], const GUnit& u, int wr, int wc, int fr, int fq) const {
        EPI_OPAQUE();
        const int row0 = u.pm * BM + wr * 64 + fr, col0 = u.pn * BM + wc * 32 + 8 * fq;
#pragma unroll
        for (int ai = 0; ai < 2; ++ai)
#pragma unroll
            for (int m = 0; m < 4; ++m) { const int row = row0 + ai * HALF + m * 16; bf16_t* rowp = P + (size_t)row * PW + col0;
                float ssq = 0.f;
#pragma unroll
                for (int bj = 0; bj < 2; ++bj) { f32x4 v0 = acc[ai][bj][m][0], v1 = acc[ai][bj][m][1];
                    if (u.pn == 2 && bj == 1) {
                        if (wc == 0 && fq < 2) { float* sp = side + (size_t)row * 16 + 8 * fq; *(f32x4*)sp = v0; *(f32x4*)(sp + 4) = v1;
                            if (fq == 1) { const f32x4 fb = *(const f32x4*)fbias; f32x4 s1;
#pragma unroll
                                for (int e = 0; e < 4; ++e) { const float x = v1[e] + fb[e]; s1[e] = (x >= 0.f) ? -log1pf(expf(-x)) : (x - log1pf(expf(x))); }
                                *(f32x4*)(lf + (size_t)row * 4) = s1; } }
                        if (wc == 1) { rope8(v0, v1, rope + (size_t)(row & (SEQ - 1)) * 32 + 8 * fq);
                            u32x4 w; w.x = cvtpk(v0[0], v0[1]); w.y = cvtpk(v0[2], v0[3]); w.z = cvtpk(v1[0], v1[1]); w.w = cvtpk(v1[2], v1[3]);
                            *(u32x4*)(krot + (size_t)row * 32 + 8 * fq) = w; }
                    }
                    u32x4 w; w.x = cvtpk(v0[0], v0[1]); w.y = cvtpk(v0[2], v0[3]); w.z = cvtpk(v1[0], v1[1]); w.w = cvtpk(v1[2], v1[3]);
                    *(u32x4*)(rowp + bj * HALF) = w;
                    if (u.pn == 1 && bj == 0) { bf16_t* cp = (wc < 2 ? kcmp : vcmp) + (size_t)row * 64 + (wc & 1) * 32 + 8 * fq; *(u32x4*)cp = w; }
                    if (u.pn == 11 || (u.pn == 7 && bj == 1)) ssq += (v0[0] * v0[0] + v0[1] * v0[1]) + (v0[2] * v0[2] + v0[3] * v0[3]) + (v1[0] * v1[0] + v1[1] * v1[1]) + (v1[2] * v1[2] + v1[3] * v1[3]);
                }
                if (u.pn == 11 || u.pn == 7) { ssq += xor_lane_lt32<16>(ssq); ssq = sum_halves(ssq);
                    if (fq == 0) (u.pn == 11 ? ssq_q : ssq_kv)[(size_t)row * 4 + wc] = ssq; }
                asm volatile("" ::: "memory");
            }
    }
};
struct EpiQup {
    static constexpr bool PERM = true;
    bf16_t* O; const float* ssq_q; const float* rope;
    __device__ __forceinline__ void operator()(const f32x4 (&acc)[2][2][4][2], const GUnit& u, int wr, int wc, int fr, int fq) const {
        EPI_OPAQUE();
        const int row0 = u.pm * BM + wr * 64 + fr, col0 = u.pn * BM + wc * 32 + 8 * fq;
#pragma unroll
        for (int ai = 0; ai < 2; ++ai)
#pragma unroll
            for (int m = 0; m < 4; ++m) { const int row = row0 + ai * HALF + m * 16; bf16_t* rowp = O + (size_t)row * 512 + col0;
                const f32x4 pq = *(const f32x4*)(ssq_q + (size_t)row * 4);
                const float rstd = 1.0f / sqrtf(((pq[0] + pq[1]) + (pq[2] + pq[3])) * (1.0f / 256.0f) + RMS_EPS);
#pragma unroll
                for (int bj = 0; bj < 2; ++bj) { f32x4 v0 = acc[ai][bj][m][0] * rstd, v1 = acc[ai][bj][m][1] * rstd;
                    const int c8 = col0 + bj * HALF, within = c8 % 96;
                    if (c8 < 384 && within >= 64) rope8(v0, v1, rope + (size_t)(row & (SEQ - 1)) * 32 + (within - 64));
                    u32x4 w; w.x = cvtpk(v0[0], v0[1]); w.y = cvtpk(v0[2], v0[3]); w.z = cvtpk(v1[0], v1[1]); w.w = cvtpk(v1[2], v1[3]);
                    *(u32x4*)(rowp + bj * HALF) = w; }
                asm volatile("" ::: "memory"); }
    }
};
struct EpiKVup {
    static constexpr bool PERM = true;
    bf16_t* O; const float* ssq_kv;
    __device__ __forceinline__ void operator()(const f32x4 (&acc)[2][2][4][2], const GUnit& u, int wr, int wc, int fr, int fq) const {
        EPI_OPAQUE();
        const int row0 = u.pm * BM + wr * 64 + fr, col0 = u.pn * BM + wc * 32 + 8 * fq;
#pragma unroll
        for (int ai = 0; ai < 2; ++ai)
#pragma unroll
            for (int m = 0; m < 4; ++m) { const int row = row0 + ai * HALF + m * 16; bf16_t* rowp = O + (size_t)row * 512 + col0;
                const f32x4 pq = *(const f32x4*)(ssq_kv + (size_t)row * 4);
                const float rstd = 1.0f / sqrtf(((pq[0] + pq[1]) + (pq[2] + pq[3])) * (1.0f / 128.0f) + RMS_EPS);
#pragma unroll
                for (int bj = 0; bj < 2; ++bj) { const f32x4 v0 = acc[ai][bj][m][0] * rstd, v1 = acc[ai][bj][m][1] * rstd;
                    u32x4 w; w.x = cvtpk(v0[0], v0[1]); w.y = cvtpk(v0[2], v0[3]); w.z = cvtpk(v1[0], v1[1]); w.w = cvtpk(v1[2], v1[3]);
                    *(u32x4*)(rowp + bj * HALF) = w; }
                asm volatile("" ::: "memory"); }
    }
};
__device__ __forceinline__ float gelu_tanh(float x) { const float u2 = 2.0f * 0.7978845608028654f * (x + 0.044715f * x * x * x); return x * fast_rcp(1.0f + fast_exp2(-u2 * LOG2E)); }
struct EpiCmp1 {
    static constexpr bool PERM = true;
    bf16_t* O; const float* bias1;
    __device__ __forceinline__ void operator()(const f32x4 (&acc)[2][2][4][2], const GUnit& u, int wr, int wc, int fr, int fq) const {
        EPI_OPAQUE();
        const int row0 = u.pm * BM + wr * 64 + fr, col0 = wc * 32 + 8 * fq;
        f32x4 bv[2][2];
#pragma unroll
        for (int bj = 0; bj < 2; ++bj)
#pragma unroll
            for (int n = 0; n < 2; ++n) bv[bj][n] = *(const f32x4*)(bias1 + col0 + bj * HALF + 4 * n);
#pragma unroll
        for (int ai = 0; ai < 2; ++ai)
#pragma unroll
            for (int m = 0; m < 4; ++m) { bf16_t* rowp = O + (size_t)(row0 + ai * HALF + m * 16) * 256 + col0;
#pragma unroll
                for (int bj = 0; bj < 2; ++bj) { f32x4 v0 = acc[ai][bj][m][0] + bv[bj][0], v1 = acc[ai][bj][m][1] + bv[bj][1];
#pragma unroll
                    for (int e = 0; e < 4; ++e) { v0[e] = gelu_tanh(v0[e]); v1[e] = gelu_tanh(v1[e]); }
                    u32x4 w; w.x = cvtpk(v0[0], v0[1]); w.y = cvtpk(v0[2], v0[3]); w.z = cvtpk(v1[0], v1[1]); w.w = cvtpk(v1[2], v1[3]);
                    *(u32x4*)(rowp + bj * HALF) = w; } }
    }
};
typedef __amdgpu_buffer_rsrc_t rsrc_t;
struct EpiMerge {
    static constexpr bool PERM = true;
    bf16_t* O;
    unsigned char* scr;
    __device__ __forceinline__ void operator()(const f32x4 (&acc)[2][2][4][2], const GUnit& u, int wr, int wc, int fr, int fq) const {
        EPI_OPAQUE();
        const int tid = (wr * 4 + wc) * 64 + fq * 16 + fr;
        const int sub = u.id;
        const rsrc_t rs = __builtin_amdgcn_make_buffer_rsrc(scr, 0, 524288, 0x00020000);
        if (sub < 4) {
#pragma unroll
            for (int ai = 0; ai < 2; ++ai)
#pragma unroll
                for (int bj = 0; bj < 2; ++bj)
#pragma unroll
                    for (int m = 0; m < 4; ++m)
#pragma unroll
                        for (int n = 0; n < 2; ++n) { const int q = ((ai * 2 + bj) * 4 + m) * 2 + n; const f32x4 v = acc[ai][bj][m][n];
                            u32x2 w; w.x = cvtpk(v[0], v[1]); w.y = cvtpk(v[2], v[3]);
                            __builtin_amdgcn_raw_buffer_store_b64(w, rs, tid * 8, (sub * 32 + q) * 4096, 0); }
            return;
        }
        const int j = sub - 4;
        const int row0 = u.pm * BM + wr * 64 + fr, col0 = u.pn * BM + 64 * j + wc * 16 + 4 * fq;
#pragma unroll
        for (int ai = 0; ai < 2; ++ai) {
            u32x2 sv[4][4];
#pragma unroll
            for (int m = 0; m < 4; ++m)
#pragma unroll
                for (int g = 0; g < 4; ++g) { const int qb = (ai * 16 + m * 2);
                    sv[m][g] = (j == 0) ? __builtin_amdgcn_raw_buffer_load_b64(rs, tid * 8, (g * 32 + qb) * 4096, 0)
                             : (j == 1) ? __builtin_amdgcn_raw_buffer_load_b64(rs, tid * 8, (g * 32 + qb + 1) * 4096, 0)
                             : (j == 2) ? __builtin_amdgcn_raw_buffer_load_b64(rs, tid * 8, (g * 32 + qb + 8) * 4096, 0)
                                        : __builtin_amdgcn_raw_buffer_load_b64(rs, tid * 8, (g * 32 + qb + 9) * 4096, 0); }
#pragma unroll
            for (int m = 0; m < 4; ++m) { bf16_t* rowp = O + (size_t)(row0 + ai * HALF + m * 16) * DM + col0;
                f32x4 t = {0.f, 0.f, 0.f, 0.f};
#pragma unroll
                for (int g = 0; g < 4; ++g) { const f32x4 gt = acc[ai][g >> 1][m][g & 1]; const u32x2 s = sv[m][g];
                    t[0] += sigmoid_f(gt[0]) * __uint_as_float(s.x << 16); t[1] += sigmoid_f(gt[1]) * __uint_as_float(s.x & 0xffff0000u);
                    t[2] += sigmoid_f(gt[2]) * __uint_as_float(s.y << 16); t[3] += sigmoid_f(gt[3]) * __uint_as_float(s.y & 0xffff0000u); }
                u32x2 w; w.x = cvtpk(t[0], t[1]); w.y = cvtpk(t[2], t[3]);
                *(u32x2*)rowp = w; }
            asm volatile("" ::: "memory"); }
    }
};
__device__ __forceinline__ float dpp_ror1(float v) { return __uint_as_float((unsigned)__builtin_amdgcn_update_dpp(0, (int)__float_as_uint(v), 0x121, 0xf, 0xf, false)); }
__device__ __forceinline__ float dpp_ror2(float v) { return __uint_as_float((unsigned)__builtin_amdgcn_update_dpp(0, (int)__float_as_uint(v), 0x122, 0xf, 0xf, false)); }
struct EpiUpConv {
    static constexpr bool PERM = true;
    bf16_t* ACT; float* HB; const float* cw; const float* cb;
    __device__ __forceinline__ void operator()(const f32x4 (&acc)[2][2][4][2], const GUnit& u, int wr, int wc, int fr, int fq) const {
        EPI_OPAQUE();
        const int colL = wc * 32 + 8 * fq;
#pragma unroll
        for (int n = 0; n < 2; ++n) {
            const int cl = colL + 4 * n, c0 = u.pn * 128 + cl;
            const f32x4 bg = *(const f32x4*)(cb + c0), w0g = *(const f32x4*)(cw + c0), w1g = *(const f32x4*)(cw + DFF2 + c0), w2g = *(const f32x4*)(cw + 2 * DFF2 + c0);
            const f32x4 bv = *(const f32x4*)(cb + DFF + c0), w0v = *(const f32x4*)(cw + DFF + c0), w1v = *(const f32x4*)(cw + DFF2 + DFF + c0), w2v = *(const f32x4*)(cw + 2 * DFF2 + DFF + c0);
#pragma unroll
            for (int ai = 0; ai < 2; ++ai) {
                const int rowg = u.pm * BM + ai * HALF + wr * 64, g = rowg >> 6;
                f32x4 t1g, t2g, t1v, t2v;
#pragma unroll
                for (int e = 0; e < 4; ++e) { t1g[e] = 0.f; t2g[e] = 0.f; t1v[e] = 0.f; t2v[e] = 0.f; }
#pragma unroll
                for (int m = 0; m < 4; ++m) {
                    const f32x4 cg = acc[ai][0][m][n], cv = acc[ai][1][m][n];
                    f32x4 r1g, r2g, r1v, r2v, o;
#pragma unroll
                    for (int e = 0; e < 4; ++e) { r1g[e] = dpp_ror1(cg[e]); r2g[e] = dpp_ror2(cg[e]); r1v[e] = dpp_ror1(cv[e]); r2v[e] = dpp_ror2(cv[e]); }
#pragma unroll
                    for (int e = 0; e < 4; ++e) { const float p1g = (fr == 0) ? t1g[e] : r1g[e], p2g = (fr < 2) ? t2g[e] : r2g[e], p1v = (fr == 0) ? t1v[e] : r1v[e], p2v = (fr < 2) ? t2v[e] : r2v[e];
                        const float gt = bg[e] + w0g[e] * p2g + w1g[e] * p1g + w2g[e] * cg[e], vl = bv[e] + w0v[e] * p2v + w1v[e] * p1v + w2v[e] * cv[e];
                        o[e] = gt * sigmoid_f(gt) * vl; }
                    const int row = rowg + m * 16 + fr;
                    if (!(m == 0 && fr < 2)) { u32x2 w; w.x = cvtpk(o[0], o[1]); w.y = cvtpk(o[2], o[3]); *(u32x2*)(ACT + (size_t)row * DFF + c0) = w; }
                    if (m == 0 && fr < 2) { float* hp = HB + ((size_t)((g * 4 + fr) * 22 + u.pn) * 256 + cl); *(f32x4*)hp = cg; *(f32x4*)(hp + 128) = cv; }
                    if (m == 3 && fr >= 14) { float* hp = HB + ((size_t)((g * 4 + fr - 12) * 22 + u.pn) * 256 + cl); *(f32x4*)hp = cg; *(f32x4*)(hp + 128) = cv; }
                    t1g = r1g; t2g = r2g; t1v = r1v; t2v = r2v;
                }
            }
            asm volatile("" ::: "memory");
        }
    }
};
}
#define XB_TMO      128
#define XB_XCNT(j)  (256  + 64 * (j))
#define XB_XSUB(j)  (1280 + 64 * (j))
#define XB_XGEN(j)  (2304 + 64 * (j))
#define XB_TOP      3328
#define XB_TOPGEN   3392
#define XCD_BAR_WORDS 3456
#define XB_SPIN_CAP (1u << 22)
__device__ __forceinline__ unsigned xb_ld(unsigned* p)              { return __hip_atomic_load(p, __ATOMIC_RELAXED, __HIP_MEMORY_SCOPE_AGENT); }
__device__ __forceinline__ unsigned xb_add(unsigned* p, unsigned v) { return __hip_atomic_fetch_add(p, v, __ATOMIC_RELAXED, __HIP_MEMORY_SCOPE_AGENT); }
__device__ __forceinline__ unsigned xb_xcc_id() { return (unsigned)__builtin_amdgcn_s_getreg((3 << 11) | 20) & 0xFu; }
#define XB_SPIN(cond, bar) do { unsigned _sp = 0; while (cond) { __builtin_amdgcn_s_sleep(1); \
    if ((++_sp & 255u) == 0u) { if (xb_ld(&(bar)[XB_TMO])) break; if (_sp > XB_SPIN_CAP) { atomicAdd(&(bar)[XB_TMO], 1u); break; } } } } while (0)
struct XcdBarrier { unsigned* bar; unsigned x; volatile LAS unsigned* st; };
__device__ __forceinline__ XcdBarrier xcd_barrier_post(unsigned* bar, volatile LAS unsigned* st) {
    XcdBarrier b; b.bar = bar; b.x = xb_xcc_id(); b.st = st;
    if (threadIdx.x == 0) (void)xb_add(&bar[XB_XCNT(b.x)], 1u);
    return b;
}
__device__ __forceinline__ void xcd_barrier_complete(unsigned* bar, unsigned x, unsigned& nloc, unsigned& nx) {
    const unsigned G = gridDim.x * gridDim.y * gridDim.z;
    unsigned sum, cnt, mine, sp = 0u;
    for (;;) {
        sum = 0u; cnt = 0u; mine = 0u;
#pragma unroll
        for (unsigned j = 0; j < 16; ++j) { const unsigned c = xb_ld(&bar[XB_XCNT(j)]); sum += c; cnt += (c > 0u) ? 1u : 0u; mine = (j == x) ? c : mine; }
        if (sum == G) break;
        __builtin_amdgcn_s_sleep(1);
        if ((++sp & 255u) == 0u) { if (xb_ld(&bar[XB_TMO])) break; if (sp > XB_SPIN_CAP) { atomicAdd(&bar[XB_TMO], 1u); break; } }
    }
    nloc = mine > 0u ? mine : 1u; nx = cnt > 0u ? cnt : 1u;
}
__device__ __forceinline__ void xcd_barrier(const XcdBarrier& b) {
    asm volatile("s_waitcnt vmcnt(0)" ::: "memory");
    __syncthreads();
    if (threadIdx.x == 0) {
        unsigned* bar = b.bar; unsigned bx = b.x;
        asm volatile("" : "+s"(bx));
        __builtin_amdgcn_s_waitcnt(0);
        unsigned nloc = b.st[0], nx = b.st[1];
        if (nloc == 0u) { xcd_barrier_complete(bar, bx, nloc, nx); b.st[0] = nloc; b.st[1] = nx; }
        const unsigned old = xb_add(&bar[XB_XSUB(bx)], 1u);
        const unsigned gen = old / nloc;
        if (old + 1u == (gen + 1u) * nloc) {
            __builtin_amdgcn_fence(__ATOMIC_RELEASE, "agent");
            asm volatile("s_waitcnt vmcnt(0)" ::: "memory");
            const unsigned og = xb_add(&bar[XB_TOP], 1u);
            const unsigned tg = og / nx;
            if (og + 1u == (tg + 1u) * nx) xb_add(&bar[XB_TOPGEN], 1u);
            else XB_SPIN(xb_ld(&bar[XB_TOPGEN]) == tg, bar);
            __builtin_amdgcn_fence(__ATOMIC_ACQUIRE, "agent");
            xb_add(&bar[XB_XGEN(bx)], 1u);
            asm volatile("s_waitcnt vmcnt(0)" ::: "memory");
        } else {
            XB_SPIN(xb_ld(&bar[XB_XGEN(bx)]) == gen, bar);
            __builtin_amdgcn_fence(__ATOMIC_ACQUIRE, "agent");
            asm volatile("s_waitcnt vmcnt(0)" ::: "memory");
        }
    }
    __syncthreads();
}

#define MFMA32(a, b, c) __builtin_amdgcn_mfma_f32_32x32x16_bf16(a, b, c, 0, 0, 0)
typedef short v4i16_t __attribute__((ext_vector_type(4)));
typedef LAS const char* lds_cptr;
typedef LAS char* lds_ptr;
__device__ __forceinline__ int crow(int r, int hi) { return (r & 3) + 8 * (r >> 2) + 4 * hi; }
__device__ __forceinline__ s16x4 vtr(lds_cptr p) { return __builtin_bit_cast(s16x4, __builtin_amdgcn_ds_read_tr16_b64_v4i16((LAS v4i16_t*)p)); }
__device__ __forceinline__ float other_half(float x, int hi) { auto rr = __builtin_amdgcn_permlane32_swap(__float_as_uint(x), __float_as_uint(x), false, false); return __uint_as_float(hi ? rr[0] : rr[1]); }
constexpr float NEG_INF = -INFINITY;

constexpr int TB_V = 12288, TB_KB = 20480, TB_SIZE = 20992;
struct Stg { u32x4 k, k2, v; float kb; };

template <int NKS> __device__ __forceinline__ void qk64(lds_cptr kbuf, const bf16x8* qf, int r32, int hi, f32x16& p0, f32x16& p1) {
    lds_cptr kp = kbuf + hi * 1024 + r32 * 16;
#pragma unroll
    for (int ks = 0; ks < NKS; ++ks) {
        const bf16x8 a0 = *(const LAS bf16x8*)(kp + ks * 2048), a1 = *(const LAS bf16x8*)(kp + ks * 2048 + 512);
        p0 = MFMA32(a0, qf[ks], p0); p1 = MFMA32(a1, qf[ks], p1);
    }
}
struct AState { f32x16 o0, o1; float m, l; };
__device__ __forceinline__ void astate_init(AState& s) {
#pragma unroll
    for (int r = 0; r < 16; ++r) { s.o0[r] = 0.f; s.o1[r] = 0.f; }
    s.m = NEG_INF; s.l = 0.f;
}
__device__ __forceinline__ void pv64(f32x16& o0, f32x16& o1, lds_cptr vp, const bf16x8 (&pf)[4]) {
#pragma unroll
    for (int ks = 0; ks < 4; ++ks) {
        const s16x4 l0 = vtr(vp + ks * 1024), h0 = vtr(vp + ks * 1024 + 512), l1 = vtr(vp + 4096 + ks * 1024), h1 = vtr(vp + 4096 + ks * 1024 + 512);
        const bf16x8 v0 = (bf16x8){l0[0], l0[1], l0[2], l0[3], h0[0], h0[1], h0[2], h0[3]}, v1 = (bf16x8){l1[0], l1[1], l1[2], l1[3], h1[0], h1[1], h1[2], h1[3]};
        o0 = MFMA32(v0, pf[ks], o0); o1 = MFMA32(v1, pf[ks], o1);
    }
}
__device__ __forceinline__ void pack_p(const f32x16& p0, const f32x16& p1, bf16x8 (&pf)[4]) {
    u32x4 w0, w1, w2, w3;
    w0.x = cvtpk(p0[0], p0[1]); w0.y = cvtpk(p0[2], p0[3]); w0.z = cvtpk(p0[4], p0[5]); w0.w = cvtpk(p0[6], p0[7]);
    w1.x = cvtpk(p0[8], p0[9]); w1.y = cvtpk(p0[10], p0[11]); w1.z = cvtpk(p0[12], p0[13]); w1.w = cvtpk(p0[14], p0[15]);
    w2.x = cvtpk(p1[0], p1[1]); w2.y = cvtpk(p1[2], p1[3]); w2.z = cvtpk(p1[4], p1[5]); w2.w = cvtpk(p1[6], p1[7]);
    w3.x = cvtpk(p1[8], p1[9]); w3.y = cvtpk(p1[10], p1[11]); w3.z = cvtpk(p1[12], p1[13]); w3.w = cvtpk(p1[14], p1[15]);
    pf[0] = __builtin_bit_cast(bf16x8, w0); pf[1] = __builtin_bit_cast(bf16x8, w1); pf[2] = __builtin_bit_cast(bf16x8, w2); pf[3] = __builtin_bit_cast(bf16x8, w3);
}
__device__ __forceinline__ void softmax_pv64(f32x16& p0, f32x16& p1, AState& s, lds_cptr vp, int hi) {
    float mx = fmaxf(p0[0], p1[0]);
#pragma unroll
    for (int r = 1; r < 16; ++r) mx = fmaxf(mx, fmaxf(p0[r], p1[r]));
    mx = fmaxf(mx, other_half(mx, hi));
    const float mn = fmaxf(s.m, mx), ms = (mn == NEG_INF) ? 0.f : mn;
    const float alpha = fast_exp2(s.m - ms);
    float rs = 0.f;
#pragma unroll
    for (int r = 0; r < 16; ++r) { p0[r] = fast_exp2(p0[r] - ms); p1[r] = fast_exp2(p1[r] - ms); rs += p0[r] + p1[r]; }
    rs += other_half(rs, hi);
    s.l = s.l * alpha + rs; s.m = mn;
#pragma unroll
    for (int r = 0; r < 16; ++r) { s.o0[r] *= alpha; s.o1[r] *= alpha; }
    bf16x8 pf[4]; pack_p(p0, p1, pf);
    pv64(s.o0, s.o1, vp, pf);
}
__device__ __forceinline__ void mask_causal(f32x16& p0, f32x16& p1, int kpos0, int tq, int hi) {
#pragma unroll
    for (int r = 0; r < 16; ++r) { const int kp = kpos0 + crow(r, hi); if (kp > tq) p0[r] = NEG_INF; if (kp + 32 > tq) p1[r] = NEG_INF; }
}
__device__ __forceinline__ void add_table(f32x16& p0, f32x16& p1, const LAS float* tb) {
#pragma unroll
    for (int r = 0; r < 16; ++r) { const int o = (r & 3) + 8 * (r >> 2); p0[r] += tb[o]; p1[r] += tb[o + 32]; }
}
__device__ __forceinline__ void store_o_bf16(bf16_t* orow, const f32x16& o0, const f32x16& o1, float sc, int hi) {
#pragma unroll
    for (int g = 0; g < 4; ++g) {
        u32x2 w0, w1; w0.x = cvtpk(o0[4 * g] * sc, o0[4 * g + 1] * sc); w0.y = cvtpk(o0[4 * g + 2] * sc, o0[4 * g + 3] * sc);
        w1.x = cvtpk(o1[4 * g] * sc, o1[4 * g + 1] * sc); w1.y = cvtpk(o1[4 * g + 2] * sc, o1[4 * g + 3] * sc);
        *(u32x2*)(orow + 8 * g + 4 * hi) = w0; *(u32x2*)(orow + 32 + 8 * g + 4 * hi) = w1;
    }
}
constexpr size_t MiB = 1u << 20, KiB = 1u << 10;
constexpr size_t WS_CTL = 0, CTL_ZERO_BYTES = 1 * MiB;
constexpr size_t WS_ROPE = 1 * MiB, WS_NSATAB = WS_ROPE + 512 * KiB, WS_DILTAB = WS_NSATAB + 32 * KiB, WS_CMPB = WS_DILTAB + 8 * KiB, WS_FARB = WS_CMPB + 4 * KiB;
constexpr size_t WS_WT = 4 * MiB, LW = 38 * MiB;
constexpr size_t LW_IN = 0, LW_G = 6 * MiB, LW_BR = 14 * MiB, LW_O = 16 * MiB, LW_UP = 18 * MiB, LW_DN = 29 * MiB, LW_UQ = 35 * MiB, LW_UKV = 35 * MiB + 256 * KiB, LW_PHI = 36 * MiB;
constexpr size_t BR_A = 0, BR_B = 512 * KiB, BR_C = 768 * KiB, BR_D = 1280 * KiB;
constexpr size_t WS_SIDE = 80 * MiB, WS_SSQQ = 84 * MiB, WS_SSQKV = 85 * MiB, WS_KB = 86 * MiB, WS_KROT = 87 * MiB, WS_KCMP = 91 * MiB, WS_VCMP = 100 * MiB,
                 WS_HID = 109 * MiB, WS_KMAX = 3 * MiB + 128 * KiB  , WS_LF = 2 * MiB  , WS_CMPP = 3 * MiB  , WS_ORDER = 3 * MiB + 64 * KiB  , WS_KC = 113 * MiB, WS_VC = 113 * MiB + 512 * KiB, WS_DLSE = 114 * MiB, WS_DOG = 116 * MiB;
constexpr size_t WS_H = 164 * MiB, WS_OCAT = 292 * MiB, WS_QM = 404 * MiB, WS_KVM = 468 * MiB, WS_P = 532 * MiB;
constexpr size_t WS_MERGED = 532 * MiB, WS_MSCR = 660 * MiB, WS_Y = 164 * MiB  , WS_H2 = 756 * MiB, WS_ACT = 164 * MiB  , WS_HB = 532 * MiB  , WS_Y2 = 884 * MiB  , WS_END = 1024 * MiB;
constexpr size_t MSCR_PER_WG = 512 * KiB;
static_assert(WS_WT + 2 * LW <= WS_SIDE && WS_DOG + 48 * MiB <= WS_H && WS_P + 384 * MiB <= WS_END && WS_MSCR + 256 * MSCR_PER_WG <= WS_P + 384 * MiB && WS_H2 + 128 * MiB <= WS_Y2 && WS_Y2 + 128 * MiB <= WS_END, "ws map");
static_assert(WS_ACT + 352 * MiB <= WS_HB && WS_HB + 96 * MiB <= WS_H2 && WS_Y + 128 * MiB <= WS_OCAT, "ws overlays");
constexpr int CW_BAR = 4096;
constexpr int CW_Q = 16384;

constexpr int RING_BYTES = 131072, LDSCTL_OFF = RING_BYTES, MISC_OFF = LDSCTL_OFF + 320, LDS_BYTES = 147456;
constexpr int NSA_SLAB = 49152, NSA_SLAB_BYTES = 4 * 64 * 65 * 4, NSA_SEL = NSA_SLAB + NSA_SLAB_BYTES;
static_assert(NSA_SEL + 512 <= RING_BYTES && 4 * NSA_TL * 4 <= NSA_SLAB_BYTES && 2 * TB_SIZE <= NSA_SLAB, "NSA LDS map");

struct Frame {
    LAS unsigned char* lds; volatile LAS unsigned* MISC; gu32* ctl;
    int tid, lane, wave, G;
    const float* in[27]; float* out; unsigned char* ws;
};
#define WSP(T, off) ((T*)(F.ws + (off)))
#define VM_WAIT() asm volatile("s_waitcnt vmcnt(0)" ::: "memory")
#define LDS_WAIT() asm volatile("s_waitcnt lgkmcnt(0)" ::: "memory")

__device__ __forceinline__ int queue_grab(Frame& F, gu32* ctr) {
    if (F.tid == 0) F.MISC[0] = __hip_atomic_fetch_add(ctr, 1u, __ATOMIC_RELAXED, __HIP_MEMORY_SCOPE_AGENT);
    __syncthreads();
    const int v = (int)F.MISC[0];
    __syncthreads();
    return v;
}

template <bool FOX> __device__ __forceinline__ void causal_unit(Frame& F, int b, int h, int qb) {
    constexpr int NKS = FOX ? 4 : 6;
    int lane_o = F.lane; asm volatile("" : "+v"(lane_o));
    const int wid = F.wave, lane = lane_o, r32 = lane & 31, hi = lane >> 5;
    const size_t rowbase = (size_t)b * SEQ;
    const int q0 = qb * 256, tq = q0 + wid * 32 + r32, NT = qb * 4 + 4;
    const bf16_t* P = WSP(const bf16_t, WS_P);
    const bf16_t *Kb, *Vb, *Qrow; int kpitch, vpitch;
    const bf16_t* Kr = WSP(const bf16_t, WS_KROT) + rowbase * 32;
    const float* kbsrc = WSP(const float, WS_KB) + (size_t)(b * 4 + h) * SEQ;
    if (FOX) { Kb = P + rowbase * PW + PC_CK + h * 64; Vb = P + rowbase * PW + PC_CV + h * 64; kpitch = PW; vpitch = PW; Qrow = P + (rowbase + tq) * PW + PC_CQ + h * 64; }
    else { const bf16_t* KV = WSP(const bf16_t, WS_KVM) + rowbase * 512 + h * 128; Kb = KV; Vb = KV + 64; kpitch = 512; vpitch = 512; Qrow = WSP(const bf16_t, WS_QM) + (rowbase + tq) * 512 + h * 96; }
    bf16x8 qf[NKS];
#pragma unroll
    for (int ks = 0; ks < NKS; ++ks) qf[ks] = *(const bf16x8*)(Qrow + ks * 16 + hi * 8);
    AState st; astate_init(st);
    lds_ptr lds = (lds_ptr)F.lds;
    const int vpo = ((lane >> 4) & 1) * 32 + (lane & 3) * 8 + (4 * hi + ((lane & 15) >> 2)) * 64;
    Stg s;
#define CU_LOAD(t) do { s.k = *(const u32x4*)(Kb + (size_t)((t) * 64 + lane) * kpitch + wid * 8); \
        if (!FOX) { if (wid < 4) s.k2 = *(const u32x4*)(Kr + (size_t)((t) * 64 + lane) * 32 + wid * 8); } \
        s.v = *(const u32x4*)(Vb + (size_t)((t) * 64 + 16 * (wid & 3) + (lane >> 2)) * vpitch + (wid >> 2) * 32 + (lane & 3) * 8); \
        if (FOX) { if (wid == 0) s.kb = kbsrc[(t) * 64 + lane]; } } while (0)
#define CU_WRITE(bi) do { lds_ptr bp = lds + (bi) * TB_SIZE; *(LAS u32x4*)(bp + wid * 1024 + lane * 16) = s.k; \
        if (!FOX) { if (wid < 4) *(LAS u32x4*)(bp + (8 + wid) * 1024 + lane * 16) = s.k2; } \
        *(LAS u32x4*)(bp + TB_V + wid * 1024 + lane * 16) = s.v; \
        if (FOX) { if (wid == 0) *(LAS float*)(bp + TB_KB + lane * 4) = s.kb; } } while (0)
    const int tq_lo = q0 + wid * 32;
    float qn = 0.f, kmax = 0.f;
    if (FOX) {
#pragma unroll
        for (int ks = 0; ks < NKS; ++ks)
#pragma unroll
            for (int e = 0; e < 8; ++e) { const float x = bf2f((unsigned short)qf[ks][e]); qn += x * x; }
        qn += other_half(qn, hi); qn = sqrtf(qn); kmax = WSP(const float, WS_KMAX)[b * 4 + h];
    }
    LAS volatile unsigned* dflag = (LAS volatile unsigned*)(lds + 2 * TB_SIZE + 64);
    const int t_first = FOX ? NT - 1 : 0, t_step = FOX ? -1 : 1;
    CU_LOAD(t_first); CU_WRITE(0);
    __syncthreads();
    for (int tt = 0; tt < NT; ++tt) {
        const int bi = tt & 1, t = t_first + tt * t_step;
        if (tt + 1 < NT) CU_LOAD(t + t_step);
        if (64 * t <= tq_lo + 31) {
            lds_cptr bp = (lds_cptr)(lds + bi * TB_SIZE);
            f32x16 p0, p1;
#pragma unroll
            for (int r = 0; r < 16; ++r) { p0[r] = 0.f; p1[r] = 0.f; }
            qk64<NKS>(bp, qf, r32, hi, p0, p1);
            if (FOX) {
                const LAS float* kbt = (const LAS float*)(bp + TB_KB) + 4 * hi;
#pragma unroll
                for (int g = 0; g < 4; ++g) { const f32x4 a = *(const LAS f32x4*)(kbt + 8 * g), c = *(const LAS f32x4*)(kbt + 32 + 8 * g);
#pragma unroll
                    for (int e = 0; e < 4; ++e) { p0[4 * g + e] += a[e]; p1[4 * g + e] += c[e]; } }
            }
            if (64 * t + 63 > tq_lo) mask_causal(p0, p1, 64 * t, tq, hi);
            softmax_pv64(p0, p1, st, bp + TB_V + vpo, hi);
        }
        if (FOX) { if (t > 0) { const float kb_last = kbsrc[64 * t - 1]; const bool done = (qn * kmax + kb_last - st.m) < -130.0f; const unsigned alld = __all(done) ? 1u : 0u; if (lane == 0) dflag[bi * 8 + wid] = alld; } }
        if (tt + 1 < NT) CU_WRITE(bi ^ 1);
        __syncthreads();
        if (FOX) { if (t > 0) { unsigned all = 1u;
#pragma unroll
                for (int w = 0; w < 8; ++w) all &= dflag[bi * 8 + w];
                if (all) break; } }
    }
#undef CU_LOAD
#undef CU_WRITE
    bf16_t* orow = WSP(bf16_t, WS_OCAT) + (rowbase + tq) * OCW + (FOX ? 384 : 640) + h * 64;
    store_o_bf16(orow, st.o0, st.o1, 1.0f / st.l, hi);
}
__device__ __forceinline__ void nsa_unit(Frame& F, int b, int qblk) {
    int lane_o = F.lane; asm volatile("" : "+v"(lane_o));
    const int wid = F.wave, lane = lane_o, r32 = lane & 31, hi = lane >> 5, tid = wid * 64 + lane;
    const int h = wid & 3, qs = wid >> 2;
    const int q0 = qblk * 64, cur = qblk, tq = q0 + 32 * qs + r32, tq_lo = q0 + 32 * qs;
    const size_t rowbase = (size_t)b * SEQ, row = rowbase + tq;
    const bf16_t* P = WSP(const bf16_t, WS_P);
    lds_ptr lds = (lds_ptr)F.lds;
    const int vpo = ((lane >> 4) & 1) * 32 + (lane & 3) * 8 + (4 * hi + ((lane & 15) >> 2)) * 64;
    bf16x8 qf[4];
    { const bf16_t* Qrow = P + row * PW + PC_AQ + h * 64;
#pragma unroll
      for (int ks = 0; ks < 4; ++ks) qf[ks] = *(const bf16x8*)(Qrow + ks * 16 + hi * 8); }
    Stg s; int ln;
#define NS_LOAD(Kb, kp, Vb, vp_, t) do { s.k = *(const u32x4*)((Kb) + (size_t)((t) * 64 + ln) * (kp) + wid * 8); \
        s.v = *(const u32x4*)((Vb) + (size_t)((t) * 64 + 16 * (wid & 3) + (ln >> 2)) * (vp_) + (wid >> 2) * 32 + (ln & 3) * 8); } while (0)
#define NS_FRESH() do { ln = lane; asm volatile("" : "+v"(ln)); } while (0)
#define NS_WRITE(bi) do { lds_ptr bp_ = lds + (bi) * TB_SIZE; *(LAS u32x4*)(bp_ + wid * 1024 + lane * 16) = s.k; *(LAS u32x4*)(bp_ + TB_V + wid * 1024 + lane * 16) = s.v; } while (0)
    const bf16_t* KC = WSP(const bf16_t, WS_KC) + (size_t)b * 256 * 64; const bf16_t* VC = WSP(const bf16_t, WS_VC) + (size_t)b * 256 * 64;
    const int cmax_u = (q0 + 63 - 31) >> 4, NTc = (cmax_u >> 6) + 1;
    const int cmax = (tq - 31) >> 4;
    float cm = NEG_INF, cl = 0.f;
    NS_FRESH(); NS_LOAD(KC, 64, VC, 64, 0); NS_WRITE(0);
    __syncthreads();
    for (int t = 0; t < NTc; ++t) {
        const int bi = t & 1;
        if (t + 1 < NTc) NS_LOAD(KC, 64, VC, 64, t + 1);
        { lds_cptr bp = (lds_cptr)(lds + bi * TB_SIZE); f32x16 p0, p1;
#pragma unroll
          for (int r = 0; r < 16; ++r) { p0[r] = 0.f; p1[r] = 0.f; }
          qk64<4>(bp, qf, r32, hi, p0, p1);
          float mx = NEG_INF;
#pragma unroll
          for (int r = 0; r < 16; ++r) { const int c = 64 * t + crow(r, hi); if (c > cmax) p0[r] = NEG_INF; if (c + 32 > cmax) p1[r] = NEG_INF; mx = fmaxf(mx, fmaxf(p0[r], p1[r])); }
          mx = fmaxf(mx, other_half(mx, hi));
          const float mn = fmaxf(cm, mx), ms = (mn == NEG_INF) ? 0.f : mn; float rs = 0.f;
#pragma unroll
          for (int r = 0; r < 16; ++r) rs += fast_exp2(p0[r] - ms) + fast_exp2(p1[r] - ms);
          rs += other_half(rs, hi);
          cl = cl * fast_exp2(cm - ms) + rs; cm = mn; }
        if (t + 1 < NTc) NS_WRITE(bi ^ 1);
        __syncthreads();
    }
    const float cms = (cm == NEG_INF) ? 0.f : cm, cinv = 1.0f / fmaxf(cl, 1e-30f);
    f32x16 oc0, oc1;
#pragma unroll
    for (int r = 0; r < 16; ++r) { oc0[r] = 0.f; oc1[r] = 0.f; }
    float G[32]; float carry = 0.f;
#pragma unroll
    for (int i = 0; i < 32; ++i) G[i] = 0.f;
    NS_FRESH(); NS_LOAD(KC, 64, VC, 64, 0); NS_WRITE(0);
    __syncthreads();
#pragma unroll
    for (int t = 0; t < 4; ++t) {
        if (t < NTc) {
            const int bi = t & 1;
            if (t + 1 < NTc) NS_LOAD(KC, 64, VC, 64, t + 1);
            { lds_cptr bp = (lds_cptr)(lds + bi * TB_SIZE); f32x16 p0, p1;
#pragma unroll
              for (int r = 0; r < 16; ++r) { p0[r] = 0.f; p1[r] = 0.f; }
              qk64<4>(bp, qf, r32, hi, p0, p1);
#pragma unroll
              for (int r = 0; r < 16; ++r) { const int c = 64 * t + crow(r, hi);
                  p0[r] = (c > cmax) ? 0.f : fast_exp2(p0[r] - cms) * cinv; p1[r] = (c + 32 > cmax) ? 0.f : fast_exp2(p1[r] - cms) * cinv; }
#pragma unroll
              for (int g = 0; g < 4; ++g) { const float oth = other_half(p0[4 * g + 3], hi);
                  G[t * 8 + g] = ((p0[4 * g] + p0[4 * g + 1]) + (p0[4 * g + 2] + p0[4 * g + 3])) + (hi ? oth : carry); carry = oth; }
#pragma unroll
              for (int g = 0; g < 4; ++g) { const float oth = other_half(p1[4 * g + 3], hi);
                  G[t * 8 + 4 + g] = ((p1[4 * g] + p1[4 * g + 1]) + (p1[4 * g + 2] + p1[4 * g + 3])) + (hi ? oth : carry); carry = oth; }
              bf16x8 pf[4]; pack_p(p0, p1, pf);
              pv64(oc0, oc1, bp + TB_V + vpo, pf); }
            if (t + 1 < NTc) NS_WRITE(bi ^ 1);
            __syncthreads();
        }
    }
    { LAS float* slab = (LAS float*)(lds + NSA_SLAB) + (size_t)(h * 64 + 32 * qs + r32) * 65;
#pragma unroll
      for (int i = 0; i < 32; ++i) slab[2 * i + hi] = G[i]; }
    __syncthreads();
    { const int q = tid >> 3, jg = tid & 7;
      const LAS float* s0 = (const LAS float*)(lds + NSA_SLAB) + (size_t)q * 65;
      float v[64];
#pragma unroll
      for (int k = 0; k < 64; ++k) { const float x = (s0[k] + s0[64 * 65 + k]) + (s0[2 * 64 * 65 + k] + s0[3 * 64 * 65 + k]);
          v[k] = (k == 0 || k == cur || k == cur - 1) ? 1e9f : ((k > cur) ? -1e9f : x); if ((k & 7) == 7) asm volatile("" ::: "memory"); }
      unsigned bits = 0u;
#pragma unroll
      for (int e = 0; e < 8; ++e) { const int j = 8 * jg + e;
          const float xj = (s0[j] + s0[64 * 65 + j]) + (s0[2 * 64 * 65 + j] + s0[3 * 64 * 65 + j]);
          const float vj = (j == 0 || j == cur || j == cur - 1) ? 1e9f : ((j > cur) ? -1e9f : xj);
          int rank = 0;
#pragma unroll
          for (int k = 0; k < 64; ++k) rank += (v[k] > vj || (v[k] == vj && k < j)) ? 1 : 0;
          bits |= (rank < 16 ? 1u : 0u) << e; }
      *((LAS unsigned char*)(lds + NSA_SEL) + q * 8 + jg) = (unsigned char)bits; }
    __syncthreads();
    const unsigned mlo = *(const LAS unsigned*)(lds + NSA_SEL + (32 * qs + r32) * 8), mhi = *(const LAS unsigned*)(lds + NSA_SEL + (32 * qs + r32) * 8 + 4);
    { const u32x4* src = WSP(const u32x4, WS_NSATAB); LAS u32x4* dst = (LAS u32x4*)(lds + NSA_SLAB);
      for (int i = tid; i < 4 * NSA_TL / 4; i += 512) dst[i] = src[i]; }
    const LAS float* tabh = (const LAS float*)(lds + NSA_SLAB) + h * NSA_TL;
    const float farb = WSP(const float, WS_FARB)[h];
    float g0, g1, g2;
    { int tq_ = tq; asm volatile("" : "+v"(tq_)); const float* sd = WSP(const float, WS_SIDE) + (rowbase + tq_) * 16 + h * 3; g0 = sigmoid_f(sd[0]); g1 = sigmoid_f(sd[1]); g2 = sigmoid_f(sd[2]); }
    AState st; astate_init(st);
    { const bf16_t* Kb = P + rowbase * PW + PC_KSLC; const bf16_t* Vb = P + rowbase * PW + PC_VSLC;
      NS_FRESH(); NS_LOAD(Kb, PW, Vb, PW, 0); NS_WRITE(0);
      __syncthreads();
      for (int j = 0; j <= cur; ++j) {
          const int bi = j & 1;
          if (j < cur) NS_LOAD(Kb, PW, Vb, PW, j + 1);
          const bool mine = ((j < 32) ? (mlo >> j) : (mhi >> (j - 32))) & 1u;
          if (__any(mine)) {
              lds_cptr bp = (lds_cptr)(lds + bi * TB_SIZE); f32x16 p0, p1;
#pragma unroll
              for (int r = 0; r < 16; ++r) { p0[r] = 0.f; p1[r] = 0.f; }
              qk64<4>(bp, qf, r32, hi, p0, p1);
              if (q0 - 64 * j - 63 >= NSA_DFAR) {
#pragma unroll
                  for (int r = 0; r < 16; ++r) { p0[r] += farb; p1[r] += farb; }
              } else add_table(p0, p1, tabh + (NSA_DMAX - tq + 64 * j + 4 * hi));
              if (j == cur) mask_causal(p0, p1, 64 * j, tq, hi);
              if (!mine) {
#pragma unroll
                  for (int r = 0; r < 16; ++r) { p0[r] = NEG_INF; p1[r] = NEG_INF; } }
              softmax_pv64(p0, p1, st, bp + TB_V + vpo, hi);
          }
          if (j < cur) NS_WRITE(bi ^ 1);
          __syncthreads();
      } }
    f32x16 oa0, oa1;
    { const float sc = g1 / st.l;
#pragma unroll
      for (int r = 0; r < 16; ++r) { oa0[r] = g0 * oc0[r] + sc * st.o0[r]; oa1[r] = g0 * oc1[r] + sc * st.o1[r]; } }
    astate_init(st);
    { const bf16_t* Kb = P + rowbase * PW + PC_KWIN; const bf16_t* Vb = P + rowbase * PW + PC_VWIN;
      const int jlo = cur >= 8 ? cur - 8 : 0;
      NS_FRESH(); NS_LOAD(Kb, PW, Vb, PW, jlo); NS_WRITE(0);
      __syncthreads();
      for (int j = jlo; j <= cur; ++j) {
          const int bi = (j - jlo) & 1;
          if (j < cur) NS_LOAD(Kb, PW, Vb, PW, j + 1);
          if (tq_lo - 64 * j - 63 < 512) {
              lds_cptr bp = (lds_cptr)(lds + bi * TB_SIZE); f32x16 p0, p1;
#pragma unroll
              for (int r = 0; r < 16; ++r) { p0[r] = 0.f; p1[r] = 0.f; }
              qk64<4>(bp, qf, r32, hi, p0, p1);
              add_table(p0, p1, tabh + (NSA_DMAX - tq + 64 * j + 4 * hi));
              if (!(tq_lo - 64 * j - 63 >= 0 && tq_lo + 31 - 64 * j < 512)) {
                  const int d0 = tq - 64 * j - 4 * hi;
#pragma unroll
                  for (int r = 0; r < 16; ++r) { const int d = d0 - ((r & 3) + 8 * (r >> 2)); if (d < 0 || d >= 512) p0[r] = NEG_INF; if (d - 32 < 0 || d - 32 >= 512) p1[r] = NEG_INF; }
              }
              softmax_pv64(p0, p1, st, bp + TB_V + vpo, hi);
          }
          if (j < cur) NS_WRITE(bi ^ 1);
          __syncthreads();
      } }
    { const float sc = g2 / st.l;
#pragma unroll
      for (int r = 0; r < 16; ++r) { oa0[r] += sc * st.o0[r]; oa1[r] += sc * st.o1[r]; } }
    { int tq_ = tq; asm volatile("" : "+v"(tq_)); store_o_bf16(WSP(bf16_t, WS_OCAT) + (rowbase + tq_) * OCW + h * 64, oa0, oa1, 1.0f, hi); }
#undef NS_LOAD
#undef NS_FRESH
#undef NS_WRITE
}
__device__ __forceinline__ void dil_unit(Frame& F, int b, int hh, int span) {
    int lane_o = F.lane; asm volatile("" : "+v"(lane_o));
    const int wid = F.wave, lane = lane_o, r32 = lane & 31, hi = lane >> 5, tid = wid * 64 + lane;
    const int T0 = span * 512;
    const size_t rowbase = (size_t)b * SEQ;
    const bf16_t* P = WSP(const bf16_t, WS_P) + rowbase * PW;
    lds_ptr lds = (lds_ptr)F.lds;
    LAS float* dtab = (LAS float*)(lds + 32768);
    for (int i = tid; i < 3 * 192; i += 512) dtab[i] = WSP(const float, WS_DILTAB)[((i / 192) * 2 + hh) * 192 + (i % 192)];
    __syncthreads();
    lds_ptr vst = lds + wid * 4096;
    const int vpo = ((lane >> 4) & 1) * 32 + (lane & 3) * 8 + (4 * hi + ((lane & 15) >> 2)) * 64;
    bf16_t* DOG = WSP(bf16_t, WS_DOG); float* DLSE = WSP(float, WS_DLSE);
    for (int g = 0; g < 3; ++g) {
        const int sh = 2 * g, head = 2 * g + hh;
        for (int rep = 0; rep < 2; ++rep) {
            const int wt = wid + 8 * rep;
            const int res = (g == 0) ? 0 : (g == 1 ? (wt & 3) : wt);
            const int i0 = (g == 0) ? 32 * wt : (g == 1 ? 32 * (wt >> 2) : 0);
            const int n0 = (T0 >> sh) + i0;
            const int tokq = res + ((n0 + r32) << sh);
            bf16x8 qf[4];
            { const bf16_t* Qrow = P + (size_t)tokq * PW + PC_BQ + head * 64;
#pragma unroll
              for (int ks = 0; ks < 4; ++ks) qf[ks] = *(const bf16x8*)(Qrow + ks * 16 + hi * 8); }
            f32x16 o0, o1; float m = NEG_INF, l = 0.f;
#pragma unroll
            for (int r = 0; r < 16; ++r) { o0[r] = 0.f; o1[r] = 0.f; }
            for (int c = 0; c < 5; ++c) {
                const int nk0 = n0 - 128 + 32 * c;
                if (nk0 + 31 < 0) continue;
                { int nk = nk0 + r32; nk = nk < 0 ? 0 : nk; const bf16_t* Krow = P + (size_t)(res + (nk << sh)) * PW + PC_BK + head * 64;
                  bf16x8 kf[4];
#pragma unroll
                  for (int ks = 0; ks < 4; ++ks) kf[ks] = *(const bf16x8*)(Krow + ks * 16 + hi * 8);
                  u32x4 vr[4];
#pragma unroll
                  for (int i = 0; i < 4; ++i) { const int pc = lane + 64 * i, vrow = pc >> 3, c16 = pc & 7; int nv = nk0 + vrow; nv = nv < 0 ? 0 : nv;
                      vr[i] = *(const u32x4*)(P + (size_t)(res + (nv << sh)) * PW + PC_BV + head * 64 + c16 * 8); }
#pragma unroll
                  for (int i = 0; i < 4; ++i) { const int pc = lane + 64 * i, vrow = pc >> 3, c16 = pc & 7;
                      *(LAS u32x4*)(vst + (c16 >> 2) * 2048 + vrow * 64 + (c16 & 3) * 16) = vr[i]; }
                  asm volatile("s_waitcnt lgkmcnt(0)" ::: "memory");
                  f32x16 p;
#pragma unroll
                  for (int r = 0; r < 16; ++r) p[r] = 0.f;
#pragma unroll
                  for (int ks = 0; ks < 4; ++ks) p = MFMA32(kf[ks], qf[ks], p);
                  const LAS float* tb = dtab + g * 192 + (32 - r32 + 4 * hi + 32 * c);
                  float mx = NEG_INF;
#pragma unroll
                  for (int r = 0; r < 16; ++r) { const int o = (r & 3) + 8 * (r >> 2), kk = o + 4 * hi, j = 128 + r32 - 32 * c - kk;
                      const bool ok = (j >= 0) && (j <= 128) && (nk0 + kk >= 0);
                      p[r] = ok ? p[r] + tb[o] : NEG_INF; mx = fmaxf(mx, p[r]); }
                  mx = fmaxf(mx, other_half(mx, hi));
                  const float mn = fmaxf(m, mx), ms = (mn == NEG_INF) ? 0.f : mn, alpha = fast_exp2(m - ms);
                  float rs = 0.f;
#pragma unroll
                  for (int r = 0; r < 16; ++r) { p[r] = fast_exp2(p[r] - ms); rs += p[r]; }
                  rs += other_half(rs, hi);
                  l = l * alpha + rs; m = mn;
#pragma unroll
                  for (int r = 0; r < 16; ++r) { o0[r] *= alpha; o1[r] *= alpha; }
                  u32x4 w0, w1;
                  w0.x = cvtpk(p[0], p[1]); w0.y = cvtpk(p[2], p[3]); w0.z = cvtpk(p[4], p[5]); w0.w = cvtpk(p[6], p[7]);
                  w1.x = cvtpk(p[8], p[9]); w1.y = cvtpk(p[10], p[11]); w1.z = cvtpk(p[12], p[13]); w1.w = cvtpk(p[14], p[15]);
                  const bf16x8 pf0 = __builtin_bit_cast(bf16x8, w0), pf1 = __builtin_bit_cast(bf16x8, w1);
                  lds_cptr vp = (lds_cptr)(vst + vpo);
#pragma unroll
                  for (int ks = 0; ks < 2; ++ks) {
                      const s16x4 l0 = vtr(vp + ks * 1024), h0 = vtr(vp + ks * 1024 + 512), l1 = vtr(vp + 2048 + ks * 1024), h1 = vtr(vp + 2048 + ks * 1024 + 512);
                      const bf16x8 v0 = (bf16x8){l0[0], l0[1], l0[2], l0[3], h0[0], h0[1], h0[2], h0[3]}, v1 = (bf16x8){l1[0], l1[1], l1[2], l1[3], h1[0], h1[1], h1[2], h1[3]};
                      o0 = MFMA32(v0, ks == 0 ? pf0 : pf1, o0); o1 = MFMA32(v1, ks == 0 ? pf0 : pf1, o1);
                  }
                  asm volatile("s_waitcnt lgkmcnt(0)" ::: "memory"); }
            }
            const size_t orow = rowbase + tokq;
            store_o_bf16(DOG + ((size_t)g * M + orow) * 128 + hh * 64, o0, o1, 1.0f / l, hi);
            if (hi == 0) DLSE[((size_t)g * M + orow) * 2 + hh] = m + log2f(l);
        }
    }
    VM_WAIT();
    __syncthreads();
    bf16_t* OC = WSP(bf16_t, WS_OCAT);
    for (int it = 0; it < 8; ++it) {
        const int item = tid + 512 * it, tl = item >> 3, pc = item & 7; const size_t orow = rowbase + T0 + tl;
        const float l0 = DLSE[((size_t)0 * M + orow) * 2 + hh], l1 = DLSE[((size_t)1 * M + orow) * 2 + hh], l2 = DLSE[((size_t)2 * M + orow) * 2 + hh];
        const float mx = fmaxf(l0, fmaxf(l1, l2)); float w0 = fast_exp2(l0 - mx), w1 = fast_exp2(l1 - mx), w2 = fast_exp2(l2 - mx);
        const float inv = 1.0f / (w0 + w1 + w2); w0 *= inv; w1 *= inv; w2 *= inv;
        const u32x4 a = *(const u32x4*)(DOG + ((size_t)0 * M + orow) * 128 + hh * 64 + pc * 8), bb = *(const u32x4*)(DOG + ((size_t)1 * M + orow) * 128 + hh * 64 + pc * 8),
                    cc = *(const u32x4*)(DOG + ((size_t)2 * M + orow) * 128 + hh * 64 + pc * 8);
        u32x4 w;
#pragma unroll
        for (int e = 0; e < 4; ++e) {
            const float lo = w0 * __uint_as_float(a[e] << 16) + w1 * __uint_as_float(bb[e] << 16) + w2 * __uint_as_float(cc[e] << 16);
            const float hv = w0 * __uint_as_float(a[e] & 0xffff0000u) + w1 * __uint_as_float(bb[e] & 0xffff0000u) + w2 * __uint_as_float(cc[e] & 0xffff0000u);
            w[e] = cvtpk(lo, hv); }
        *(u32x4*)(OC + orow * OCW + 256 + hh * 64 + pc * 8) = w;
    }
    __syncthreads();
}
__device__ __forceinline__ float wave_sum(float v) {
    v += xor_lane_lt32<1>(v); v += xor_lane_lt32<2>(v); v += xor_lane_lt32<4>(v); v += xor_lane_lt32<8>(v); v += xor_lane_lt32<16>(v);
    return sum_halves(v);
}
__device__ __forceinline__ int rel_bucket(int dist) {
    if (dist < 0) dist = 0;
    if (dist < 16) return dist;
    const int thr[15] = {22, 30, 40, 54, 73, 99, 134, 182, 246, 332, 450, 609, 825, 1117, 1513};
    int bkt = 16;
#pragma unroll
    for (int i = 0; i < 15; ++i) bkt += (dist >= thr[i]) ? 1 : 0;
    return bkt;
}
__device__ __forceinline__ int inproj_src(int c, float& sc) {
    sc = 1.f;
    if (c < 256) { sc = C2A; return c; }
    if (c < 652) return c;
    if (c < 656) return 2572 + (c - 652);
    if (c < 672) return -1;
    if (c < 704) { const int p = c - 672; return 2960 + (p >> 1) + 16 * (p & 1); }
    if (c < 768) return -1;
    if (c < 1920) { const int r = c - 768; if (r < 384) sc = C2A; return 652 + r; }
    if (c < 2048) return 2832 + (c - 1920);
    if (c < 2816) { const int r = c - 2048; if (r < 256) sc = C2A; return 1804 + r; }
    return 2576 + (c - 2816);
}
__device__ __forceinline__ int quq_src(int r, float& sc) {
    sc = C2D;
    if (r >= 384) return -1;
    const int hd = r / 96, w = r % 96;
    if (w < 64) return hd * 96 + w;
    const int p = w - 64; return hd * 96 + 64 + (p >> 1) + 16 * (p & 1);
}
__device__ __forceinline__ int gateperm_src(int r) {
    const int T = r >> 8, c = r & 255, pn = T >> 2, j = T & 3, bj = c >> 7, wc = (c >> 5) & 3, fq = (c >> 3) & 3, n = (c >> 2) & 1, e = c & 3;
    return (2 * bj + n) * DM * DM + 256 * pn + 64 * j + 16 * wc + 4 * fq + e;
}
__device__ __forceinline__ int branchperm_src(int r) {
    const int pn = r >> 8, c = r & 255, bj = c >> 7, wc = (c >> 5) & 3, fq = (c >> 3) & 3, n = (c >> 2) & 1, e = c & 3;
    return 256 * pn + 64 * (2 * bj + n) + 16 * wc + 4 * fq + e;
}
__device__ __forceinline__ int upperm_src(int r) { const int pn = r >> 8, c = r & 255; return (c & 128) ? DFF + 128 * pn + (c & 127) : 128 * pn + c; }
__device__ __forceinline__ void wconv_item(const float* W, int Nsrc, bf16_t* WT, int ldt, const float* kgain, int kind, LAS float* scr, int item, int nblk, int lane) {
    const int kb = item / nblk, nb = item % nblk, k0 = 64 * kb, n0 = 32 * nb;
    const int n = n0 + (lane & 31); float sc = 1.f; int src = n;
    if (kind == 1) src = inproj_src(n, sc); else if (kind == 2) src = quq_src(n, sc); else if (kind == 3) src = gateperm_src(n); else if (kind == 4) src = branchperm_src(n); else if (kind == 5) src = upperm_src(n);
    float wv[32];
#pragma unroll
    for (int i = 0; i < 32; ++i) { const int kk = 2 * i + (lane >> 5); wv[i] = (src >= 0) ? W[(size_t)(k0 + kk) * Nsrc + src] : 0.f; }
#pragma unroll
    for (int i = 0; i < 32; ++i) { const int kk = 2 * i + (lane >> 5); float v = wv[i] * sc; if (kgain) v *= kgain[k0 + kk]; scr[kk * 33 + (lane & 31)] = v; }
    LDS_WAIT(); asm volatile("" ::: "memory");
    const int c = lane & 7;
#pragma unroll
    for (int j = 0; j < 4; ++j) { const int nn = (lane >> 3) + 8 * j; const LAS float* s = scr + (8 * c) * 33 + nn;
        u32x4 o; o.x = pk2(s[0 * 33], s[1 * 33]); o.y = pk2(s[2 * 33], s[3 * 33]); o.z = pk2(s[4 * 33], s[5 * 33]); o.w = pk2(s[6 * 33], s[7 * 33]);
        *(u32x4*)(WT + (size_t)(n0 + nn) * ldt + k0 + 8 * c) = o; }
    LDS_WAIT(); asm volatile("" ::: "memory");
}
constexpr int ATT_UNITS = 3328;
__device__ __forceinline__ int att_cost(int id) {
    if (id < 2048) { const int qb = 15 - (id >> 7), mla = (id >> 6) & 1; return (mla ? 5 : 4) * (qb + 1); }
    if (id < 3072) return (63 - ((id - 2048) >> 4)) + 20;
    return 30;
}
__device__ __forceinline__ int clampi(int x, int lo, int hi) { return x < lo ? lo : (x > hi ? hi : x); }
__device__ __forceinline__ int att_rank(int i) {
    const int c = att_cost(i);
    int r = clampi(16 - c / 4, 0, 16) * 64 + clampi(16 - c / 5, 0, 16) * 64 + clampi(83 - c, 0, 64) * 16 + (c < 30 ? 256 : 0);
    if (c % 4 == 0 && c / 4 >= 1 && c / 4 <= 16) r += clampi(i - (16 - c / 4) * 128, 0, 64);
    if (c % 5 == 0 && c / 5 >= 1 && c / 5 <= 16) r += clampi(i - ((16 - c / 5) * 128 + 64), 0, 64);
    if (c >= 20 && c <= 83) r += clampi(i - (2048 + (63 - (c - 20)) * 16), 0, 16);
    if (c == 30) r += clampi(i - 3072, 0, 256);
    return r;
}
__device__ __forceinline__ void p0_prologue(Frame& F) {
    LAS float* scr = (LAS float*)(F.lds + F.wave * 16384);
    const int gw = blockIdx.x * 8 + F.wave, NGW = F.G * 8, lane = F.lane;
    constexpr int I_IN = 16 * 96, I_G = 16 * 32, I_BA = 4 * 32, I_BB = 2 * 32, I_O = 16 * 32, I_UP = 16 * 176, I_DN = 44 * 32, I_UQ = 4 * 16, I_UKV = 2 * 16, I_PHI = 32 * 4;
    constexpr int I_L = I_IN + 4 * I_G + 3 * I_BA + I_BB + I_O + I_UP + I_DN + I_UQ + I_UKV + 2 * I_PHI;
    for (int it = gw; it < DEPTH * I_L; it += NGW) {
        const int l = it / I_L; int r = it % I_L;
        unsigned char* wl = F.ws + WS_WT + (size_t)l * LW;
        if (r < I_IN) { wconv_item(F.in[6] + (size_t)l * DM * DIN, DIN, (bf16_t*)(wl + LW_IN), DM, nullptr, 1, scr, r, 96, lane); continue; } r -= I_IN;
        if (r < 4 * I_G) { wconv_item(F.in[21] + (size_t)l * 4 * DM * DM, DM, (bf16_t*)(wl + LW_G), DM, nullptr, 3, scr, r, 128, lane); continue; } r -= 4 * I_G;
        if (r < I_BA) { wconv_item(F.in[17] + (size_t)l * 256 * DM, DM, (bf16_t*)(wl + LW_BR + BR_A), 256, nullptr, 4, scr, r, 32, lane); continue; } r -= I_BA;
        if (r < I_BB) { wconv_item(F.in[18] + (size_t)l * 128 * DM, DM, (bf16_t*)(wl + LW_BR + BR_B), 128, nullptr, 4, scr, r, 32, lane); continue; } r -= I_BB;
        if (r < I_BA) { wconv_item(F.in[19] + (size_t)l * 256 * DM, DM, (bf16_t*)(wl + LW_BR + BR_C), 256, nullptr, 4, scr, r, 32, lane); continue; } r -= I_BA;
        if (r < I_BA) { wconv_item(F.in[20] + (size_t)l * 256 * DM, DM, (bf16_t*)(wl + LW_BR + BR_D), 256, nullptr, 4, scr, r, 32, lane); continue; } r -= I_BA;
        if (r < I_O) { wconv_item(F.in[22] + (size_t)l * DM * DM, DM, (bf16_t*)(wl + LW_O), DM, nullptr, 0, scr, r, 32, lane); continue; } r -= I_O;
        if (r < I_UP) { wconv_item(F.in[23] + (size_t)l * DM * DFF2, DFF2, (bf16_t*)(wl + LW_UP), DM, nullptr, 5, scr, r, 176, lane); continue; } r -= I_UP;
        if (r < I_DN) { wconv_item(F.in[26] + (size_t)l * DFF * DM, DM, (bf16_t*)(wl + LW_DN), DFF, nullptr, 0, scr, r, 32, lane); continue; } r -= I_DN;
        if (r < I_UQ) { wconv_item(F.in[15] + (size_t)l * 256 * 384, 384, (bf16_t*)(wl + LW_UQ), 256, F.in[13] + l * 256, 2, scr, r, 16, lane); continue; } r -= I_UQ;
        if (r < I_UKV) { wconv_item(F.in[16] + (size_t)l * 128 * 512, 512, (bf16_t*)(wl + LW_UKV), 128, F.in[14] + l * 128, 0, scr, r, 16, lane); continue; } r -= I_UKV;
        if (r < I_PHI) { wconv_item(F.in[8] + (size_t)l * 2048 * 128, 128, (bf16_t*)(wl + LW_PHI), 2048, nullptr, 0, scr, r, 4, lane); continue; } r -= I_PHI;
        wconv_item(F.in[10] + (size_t)l * 2048 * 128, 128, (bf16_t*)(wl + LW_PHI) + (size_t)128 * 2048, 2048, nullptr, 0, scr, r, 4, lane);
    }
    const int gt = blockIdx.x * 512 + F.tid, NGT = F.G * 512;
    const float* rel = F.in[1];
    float* rope = WSP(float, WS_ROPE);
    for (int i = gt; i < SEQ * 16; i += NGT) { const int t = i >> 4, k = i & 15; const float inv = powf(10000.0f, -(float)(2 * k) / 32.0f); const float ang = (float)t * inv;
        float sn, cs; sincosf(ang, &sn, &cs); rope[2 * i] = cs; rope[2 * i + 1] = sn; }
    float* ntab = WSP(float, WS_NSATAB);
    for (int i = gt; i < 4 * NSA_TL; i += NGT) { const int hd = i / NSA_TL, k = i % NSA_TL, dist = NSA_DMAX - k; ntab[i] = dist >= 0 ? rel[rel_bucket(dist) * 10 + hd] * LOG2E : 0.f; }
    float* dtab = WSP(float, WS_DILTAB);
    for (int i = gt; i < 6 * 192; i += NGT) { const int gh = i / 192, k = i % 192, g = gh >> 1, hh = gh & 1, j = 160 - k; dtab[i] = (j >= 0 && j <= 128) ? rel[rel_bucket(j << (2 * g)) * 10 + 4 + 2 * g + hh] * LOG2E : 0.f; }
    if (gt < 4) WSP(float, WS_FARB)[gt] = rel[31 * 10 + gt] * LOG2E;
    if (gw < 128) { const int mi = gw >> 5, pc = gw & 31, l = mi >> 1; const float *pk1 = F.in[8], *pv1 = F.in[10]; asm volatile("" : "+s"(pk1), "+s"(pv1));
        const float* w1 = ((mi & 1) ? pv1 : pk1) + (size_t)l * 2048 * 128 + (size_t)(64 * pc) * 128 + 2 * lane; const float* cp = F.in[7] + (size_t)l * 2048 + 64 * pc;
        f32x2 a = {0.f, 0.f};
#pragma unroll 8
        for (int p = 0; p < 64; ++p) { const f32x2 w = *(const f32x2*)(w1 + (size_t)p * 128); const float cpp = cp[p]; a[0] += cpp * w[0]; a[1] += cpp * w[1]; }
        *(f32x2*)(WSP(float, WS_CMPP) + ((size_t)mi * 32 + pc) * 128 + 2 * lane) = a; }
    if (gt < ATT_UNITS) WSP(int, WS_ORDER)[att_rank(gt)] = gt;
}
__device__ __forceinline__ void cmpb_reduce(Frame& F) {
    const int i = F.tid; if (i < DEPTH * 256) { const int l = i >> 8, n = i & 255, mi = l * 2 + (n >> 7); const float* pp = WSP(const float, WS_CMPP) + (size_t)mi * 32 * 128 + (n & 127); float a = 0.f;
        for (int pc = 0; pc < 32; ++pc) a += pp[pc * 128]; WSP(float, WS_CMPB)[i] = a; }
}

template <int MODE> __device__ __forceinline__ void rowpass(Frame& F, const float* x, const bf16_t* y, size_t yrow0, float* xout, bf16_t* hout, const float* g1, const float* g2, int row_lo, int row_hi) {
    int gw = blockIdx.x * 8 + F.wave; asm volatile("" : "+s"(gw));
    const int NGW = F.G * 8, lane = F.lane;
    f32x4 ga[4], gb[4];
#pragma unroll
    for (int j = 0; j < 4; ++j) { ga[j] = *(const f32x4*)(g1 + 4 * lane + 256 * j); if (MODE == 1) gb[j] = *(const f32x4*)(g2 + 4 * lane + 256 * j); }
    for (int m = row_lo + gw; m < row_hi; m += NGW) {
        f32x4 v[4];
        const f32x4* xr = (const f32x4*)(x + (size_t)m * DM) + lane;
#pragma unroll
        for (int j = 0; j < 4; ++j) v[j] = xr[64 * j];
        if (MODE != 0) {
            const u32x2* yr = (const u32x2*)(y + ((size_t)m - yrow0) * DM) + lane; f32x4 w[4]; float s = 0.f;
#pragma unroll
            for (int j = 0; j < 4; ++j) { const u32x2 yy = yr[64 * j]; w[j][0] = __uint_as_float(yy.x << 16); w[j][1] = __uint_as_float(yy.x & 0xffff0000u); w[j][2] = __uint_as_float(yy.y << 16); w[j][3] = __uint_as_float(yy.y & 0xffff0000u);
                s += (w[j][0] * w[j][0] + w[j][1] * w[j][1]) + (w[j][2] * w[j][2] + w[j][3] * w[j][3]); }
            const float rstd = 1.0f / sqrtf(wave_sum(s) * (1.0f / DM) + RMS_EPS);
            f32x4* xo = (f32x4*)(xout + (size_t)m * DM) + lane;
#pragma unroll
            for (int j = 0; j < 4; ++j) { v[j] = v[j] + w[j] * rstd * ga[j]; xo[64 * j] = v[j]; }
        }
        if (MODE != 2) {
            float s = 0.f;
#pragma unroll
            for (int j = 0; j < 4; ++j) s += (v[j][0] * v[j][0] + v[j][1] * v[j][1]) + (v[j][2] * v[j][2] + v[j][3] * v[j][3]);
            const float rstd = 1.0f / sqrtf(wave_sum(s) * (1.0f / DM) + RMS_EPS);
            u32x2* ho = (u32x2*)(hout + (size_t)m * DM) + lane;
#pragma unroll
            for (int j = 0; j < 4; ++j) { const f32x4 gg = (MODE == 1) ? gb[j] : ga[j]; const f32x4 o = v[j] * rstd * gg; u32x2 w; w.x = cvtpk(o[0], o[1]); w.y = cvtpk(o[2], o[3]); ho[64 * j] = w; }
        }
    }
}

__device__ __forceinline__ void ffn_fix_panel(Frame& F, int pm, const float* HB, bf16_t* ACT, const float* cw, const float* cb) {
    for (int it = F.tid; it < 4 * 2 * (DFF / 4); it += 512) {
        const int c4 = it % (DFF / 4), rr = (it / (DFF / 4)) & 1, g = pm * 4 + it / (2 * (DFF / 4)), c = c4 * 4, pn = c >> 7, cl = c & 127;
        const bool first = ((g * 64) & (SEQ - 1)) == 0;
#define HBV(gg, s, bj) (*(const f32x4*)(HB + ((size_t)(((gg) * 4 + (s)) * 22 + pn) * 256 + (bj) * 128 + cl)))
        const f32x4 z = {0.f, 0.f, 0.f, 0.f};
        const f32x4 u0g = HBV(g, 0, 0), u0v = HBV(g, 0, 1);
        f32x4 ag, bg_, cg, av, bv_, cv;
        if (rr == 0) { ag = first ? z : HBV(g - 1, 2, 0); bg_ = first ? z : HBV(g - 1, 3, 0); cg = u0g; av = first ? z : HBV(g - 1, 2, 1); bv_ = first ? z : HBV(g - 1, 3, 1); cv = u0v; }
        else { ag = first ? z : HBV(g - 1, 3, 0); bg_ = u0g; cg = HBV(g, 1, 0); av = first ? z : HBV(g - 1, 3, 1); bv_ = u0v; cv = HBV(g, 1, 1); }
#undef HBV
        const f32x4 kb = *(const f32x4*)(cb + c), k0 = *(const f32x4*)(cw + c), k1 = *(const f32x4*)(cw + DFF2 + c), k2 = *(const f32x4*)(cw + 2 * DFF2 + c);
        const f32x4 vb = *(const f32x4*)(cb + DFF + c), v0 = *(const f32x4*)(cw + DFF + c), v1 = *(const f32x4*)(cw + DFF2 + DFF + c), v2 = *(const f32x4*)(cw + 2 * DFF2 + DFF + c);
        float o[4];
#pragma unroll
        for (int e = 0; e < 4; ++e) { const float gt = kb[e] + k0[e] * ag[e] + k1[e] * bg_[e] + k2[e] * cg[e], vl = vb[e] + v0[e] * av[e] + v1[e] * bv_[e] + v2[e] * cv[e]; o[e] = gt * sigmoid_f(gt) * vl; }
        u32x2 w; w.x = cvtpk(o[0], o[1]); w.y = cvtpk(o[2], o[3]);
        *(u32x2*)(ACT + (size_t)(g * 64 + rr) * DFF + c) = w;
    }
}
#ifdef SELFCHECK
constexpr int CW_CHK = 20480;
__device__ __forceinline__ unsigned chk_hash(unsigned x) { x ^= x >> 16; x *= 0x7feb352du; x ^= x >> 15; x *= 0x846ca68bu; x ^= x >> 16; return x; }
__device__ __forceinline__ int chk_t(int i) {
    int r = 0;
    switch (i & 31) { case 0: r = 0; break; case 1: r = 1; break; case 2: r = 15; break; case 3: r = 16; break; case 4: r = 30; break; case 5: r = 31; break; case 6: r = 32; break; case 7: r = 47; break;
        case 8: r = 63; break; case 9: r = 64; break; case 10: r = 65; break; case 11: r = 127; break; case 12: r = 128; break; case 13: r = 129; break; case 14: r = 255; break; case 15: r = 256; break;
        case 16: r = 257; break; case 17: r = 511; break; case 18: r = 512; break; case 19: r = 513; break; case 20: r = 575; break; case 21: r = 1023; break; case 22: r = 1024; break; case 23: r = 1599; break;
        case 24: r = 1600; break; case 25: r = 2047; break; case 26: r = 2048; break; case 27: r = 2111; break; case 28: r = 3000; break; case 29: r = 4031; break; case 30: r = 4032; break; default: r = 4095; break; }
    return (i < 64) ? r : (int)(chk_hash(i * 7919u + 13u) & 4095u);
}
__device__ __forceinline__ bool chk_bad(float got, float ref, float scale) { const float d = fabsf(got - ref); return !(d <= 0.02f * fabsf(ref) + 0.02f * scale); }
__device__ __forceinline__ float bfr(float x) { return bf2f((unsigned short)f2bf(x)); }
__device__ __forceinline__ void chk_flag(Frame& F, int bit, bool bad, int allow) {
    LAS unsigned* cnt = (LAS unsigned*)(F.lds + 65536);
    __syncthreads(); if (threadIdx.x == 0) *cnt = 0u; __syncthreads();
    if (bad) atomicAdd((unsigned*)cnt, 1u);
    __syncthreads();
    if (threadIdx.x == 0 && *cnt > (unsigned)allow) atomicOr((unsigned*)(F.ctl + CW_CHK), 1u << bit);
    __syncthreads();
}
__device__ __forceinline__ int chk_bucket_ref(int dist) {
    if (dist < 0) dist = 0; if (dist < 16) return dist;
    const float d = (float)dist; int large = 16 + (int)(logf(d / 16.0f) / 4.852030263919617f * 16.0f); return large < 31 ? large : 31;
}
__device__ __forceinline__ bool chk_fox(Frame& F, int b, int h, int t) {
    const bf16_t* P = WSP(const bf16_t, WS_P);
    { const size_t row = (size_t)b * SEQ + t; const bf16_t* q = P + row * PW + PC_CQ + h * 64; const float* kb = WSP(const float, WS_KB) + ((size_t)b * 4 + h) * SEQ;
      float m = -INFINITY; for (int j = 0; j <= t; ++j) { const bf16_t* k = P + ((size_t)b * SEQ + j) * PW + PC_CK + h * 64; float s = 0.f; for (int d = 0; d < 64; ++d) s += bf2f(q[d]) * bf2f(k[d]); s += kb[j]; m = fmaxf(m, s); }
      float lsum = 0.f, dummy0_ = 0.f; f32x4 o = {0.f, 0.f, 0.f, 0.f};
      for (int j = 0; j <= t; ++j) { const bf16_t* k = P + ((size_t)b * SEQ + j) * PW + PC_CK + h * 64; const bf16_t* v = P + ((size_t)b * SEQ + j) * PW + PC_CV + h * 64; float s = 0.f; for (int d = 0; d < 64; ++d) s += bf2f(q[d]) * bf2f(k[d]); s += kb[j];
          const float p = exp2f(s - m); lsum += p; _Pragma("unroll") for (int e = 0; e < 4; ++e) o[e] += p * bf2f(v[21 * e]); }
      bool bad = false; _Pragma("unroll") for (int e = 0; e < 4; ++e) bad |= chk_bad(bf2f(WSP(const bf16_t, WS_OCAT)[row * OCW + 384 + h * 64 + 21 * e]), o[e] / lsum, 0.5f);
      return bad; }
}
__device__ __forceinline__ bool chk_dil(Frame& F, int b, int hh, int t) {
    const bf16_t* P = WSP(const bf16_t, WS_P); const float* rel = F.in[1];
    { const size_t row = (size_t)b * SEQ + t;
      float m = -INFINITY;
      for (int g = 0; g < 3; ++g) { const int dil = 1 << (2 * g), head = 2 * g + hh; const bf16_t* q = P + row * PW + PC_BQ + head * 64;
          for (int j = 0; j <= 128; ++j) { const int idx = t - dil * j; if (idx < 0) break; const bf16_t* k = P + ((size_t)b * SEQ + idx) * PW + PC_BK + head * 64; float s = 0.f; for (int d = 0; d < 64; ++d) s += bf2f(q[d]) * bf2f(k[d]);
              s += rel[chk_bucket_ref(dil * j) * 10 + 4 + head] * LOG2E; m = fmaxf(m, s); } }
      float lsum = 0.f, dummy0_ = 0.f; f32x4 o = {0.f, 0.f, 0.f, 0.f};
      for (int g = 0; g < 3; ++g) { const int dil = 1 << (2 * g), head = 2 * g + hh; const bf16_t* q = P + row * PW + PC_BQ + head * 64;
          for (int j = 0; j <= 128; ++j) { const int idx = t - dil * j; if (idx < 0) break; const bf16_t* k = P + ((size_t)b * SEQ + idx) * PW + PC_BK + head * 64; const bf16_t* v = P + ((size_t)b * SEQ + idx) * PW + PC_BV + head * 64; float s = 0.f; for (int d = 0; d < 64; ++d) s += bf2f(q[d]) * bf2f(k[d]);
              s += rel[chk_bucket_ref(dil * j) * 10 + 4 + head] * LOG2E; const float p = exp2f(s - m); lsum += p; _Pragma("unroll") for (int e = 0; e < 4; ++e) o[e] += p * bf2f(v[21 * e]); } }
      bool bad = false; _Pragma("unroll") for (int e = 0; e < 4; ++e) bad |= chk_bad(bf2f(WSP(const bf16_t, WS_OCAT)[row * OCW + 256 + hh * 64 + 21 * e]), o[e] / lsum, 0.5f);
      return bad; }
}
__device__ __forceinline__ bool chk_nsa(Frame& F, int b, int h, int t, int i) {
    const bf16_t* P = WSP(const bf16_t, WS_P); const float* rel = F.in[1];
    { bool bad = false;
      { const size_t row = (size_t)b * SEQ + t; const size_t rb = (size_t)b * SEQ;
      const bf16_t* KC = WSP(const bf16_t, WS_KC) + (size_t)b * 256 * 64; const bf16_t* VC = WSP(const bf16_t, WS_VC) + (size_t)b * 256 * 64;
      const int cmax = (t >= 31) ? (t - 31) / 16 : -1, cur = t >> 6;
      LAS float* imp = (LAS float*)(F.lds + 70000) + i * 65; for (int j = 0; j < 64; ++j) imp[j] = 0.f;
      f32x4 oc = {0.f, 0.f, 0.f, 0.f};
      for (int hh = 0; hh < 4; ++hh) { const bf16_t* q = P + row * PW + PC_AQ + hh * 64; float m = -INFINITY;
          for (int c = 0; c <= cmax; ++c) { float s = 0.f; for (int d = 0; d < 64; ++d) s += bf2f(q[d]) * bf2f(KC[c * 64 + d]); m = fmaxf(m, s); }
          float ls = 0.f; for (int c = 0; c <= cmax; ++c) { float s = 0.f; for (int d = 0; d < 64; ++d) s += bf2f(q[d]) * bf2f(KC[c * 64 + d]); ls += exp2f(s - m); }
          for (int c = 0; c <= cmax; ++c) { float s = 0.f; for (int d = 0; d < 64; ++d) s += bf2f(q[d]) * bf2f(KC[c * 64 + d]); const float p = exp2f(s - m) / ls;
              for (int j = 0; j < 64; ++j) if (16 * c <= 64 * j + 63 && 16 * c + 31 >= 64 * j) imp[j] += p;
              if (hh == h) _Pragma("unroll") for (int e = 0; e < 4; ++e) oc[e] += p * bf2f(VC[c * 64 + 21 * e]); } }
      for (int j = 0; j < 64; ++j) imp[j] = (j == 0 || j == cur || j == cur - 1) ? 1e9f : (j > cur ? -1e9f : imp[j]);
      unsigned long long selm = 0ull;
      for (int j = 0; j < 64; ++j) { int rank = 0; for (int k = 0; k < 64; ++k) rank += (imp[k] > imp[j] || (imp[k] == imp[j] && k < j)) ? 1 : 0; if (rank < 16) selm |= 1ull << j; }
      const bf16_t* q = P + row * PW + PC_AQ + h * 64;
      f32x4 os = {0.f, 0.f, 0.f, 0.f}, ow = {0.f, 0.f, 0.f, 0.f};
      { float m = -INFINITY; for (int pos = 0; pos <= t; ++pos) { if (!((selm >> (pos >> 6)) & 1ull)) continue; const bf16_t* k = P + (rb + pos) * PW + PC_KSLC; float s = 0.f; for (int d = 0; d < 64; ++d) s += bf2f(q[d]) * bf2f(k[d]); s += rel[chk_bucket_ref(t - pos) * 10 + h] * LOG2E; m = fmaxf(m, s); }
        float ls = 0.f; for (int pos = 0; pos <= t; ++pos) { if (!((selm >> (pos >> 6)) & 1ull)) continue; const bf16_t* k = P + (rb + pos) * PW + PC_KSLC; const bf16_t* v = P + (rb + pos) * PW + PC_VSLC; float s = 0.f; for (int d = 0; d < 64; ++d) s += bf2f(q[d]) * bf2f(k[d]); s += rel[chk_bucket_ref(t - pos) * 10 + h] * LOG2E;
            const float p = exp2f(s - m); ls += p; _Pragma("unroll") for (int e = 0; e < 4; ++e) os[e] += p * bf2f(v[21 * e]); }
        _Pragma("unroll") for (int e = 0; e < 4; ++e) os[e] /= ls; }
      { const int lo = t - 511 > 0 ? t - 511 : 0; float m = -INFINITY; for (int pos = lo; pos <= t; ++pos) { const bf16_t* k = P + (rb + pos) * PW + PC_KWIN; float s = 0.f; for (int d = 0; d < 64; ++d) s += bf2f(q[d]) * bf2f(k[d]); s += rel[chk_bucket_ref(t - pos) * 10 + h] * LOG2E; m = fmaxf(m, s); }
        float ls = 0.f; for (int pos = lo; pos <= t; ++pos) { const bf16_t* k = P + (rb + pos) * PW + PC_KWIN; const bf16_t* v = P + (rb + pos) * PW + PC_VWIN; float s = 0.f; for (int d = 0; d < 64; ++d) s += bf2f(q[d]) * bf2f(k[d]); s += rel[chk_bucket_ref(t - pos) * 10 + h] * LOG2E;
            const float p = exp2f(s - m); ls += p; _Pragma("unroll") for (int e = 0; e < 4; ++e) ow[e] += p * bf2f(v[21 * e]); }
        _Pragma("unroll") for (int e = 0; e < 4; ++e) ow[e] /= ls; }
      const float* sd = WSP(const float, WS_SIDE) + row * 16 + h * 3; const float g0 = 1.f / (1.f + expf(-sd[0])), g1 = 1.f / (1.f + expf(-sd[1])), g2 = 1.f / (1.f + expf(-sd[2]));
      _Pragma("unroll") for (int e = 0; e < 4; ++e) bad |= chk_bad(bf2f(WSP(const bf16_t, WS_OCAT)[row * OCW + h * 64 + 21 * e]), g0 * oc[e] + g1 * os[e] + g2 * ow[e], 0.3f); }
      return bad; }
}
__device__ __forceinline__ void selfcheck_a(Frame& F, int l) {
    const int i = threadIdx.x;
    const float* x = F.in[0];
    const bf16_t* H = WSP(const bf16_t, WS_H); const bf16_t* P = WSP(const bf16_t, WS_P);
    const float* rel = F.in[1];
    { const int row = (int)(chk_hash(i) % M), col = (int)(chk_hash(i + 999) & 1023); float s = 0.f; for (int k = 0; k < DM; ++k) { const float v = x[(size_t)row * DM + k]; s += v * v; }
      const float ref = x[(size_t)row * DM + col] * (1.0f / sqrtf(s / DM + RMS_EPS)) * F.in[2][l * DM + col];
      chk_flag(F, 0, chk_bad(bf2f(H[(size_t)row * DM + col]), ref, 1.0f), 0); }
    { const int row = (int)(chk_hash(i + 5) % M); int c = (i * 37 + 5) % PW; if (i < 32) c = 640 + (i & 15); else if (i < 96) c = 672 + (i & 31); else if (i < 160) c = 256 + ((i * 3) & 127);
      const float* W = F.in[6] + (size_t)l * DM * DIN; bool bad = false;
#define DOTC(dst, cc) do { float sc_; const int src_ = inproj_src((cc), sc_); float a_ = 0.f; if (src_ >= 0) for (int k = 0; k < DM; ++k) a_ += bf2f(H[(size_t)row * DM + k]) * bfr(W[(size_t)k * DIN + src_] * sc_); dst = a_; } while (0)
      float ref; DOTC(ref, c);
      if (c >= 672 && c < 704) { const int p = c - 672, ip = p >> 1; float oth; DOTC(oth, c ^ 1); const float x1 = (p & 1) ? oth : ref, x2 = (p & 1) ? ref : oth;
          const float inv = powf(10000.0f, -(float)(2 * ip) / 32.0f), ang = (float)(row & (SEQ - 1)) * inv, cs = cosf(ang), sn = sinf(ang);
          ref = (p & 1) ? (x2 * cs + x1 * sn) : (x1 * cs - x2 * sn);
          bad |= chk_bad(bf2f(WSP(const bf16_t, WS_KROT)[(size_t)row * 32 + p]), ref, 1.0f); }
      bad |= chk_bad(bf2f(P[(size_t)row * PW + c]), ref, 1.0f);
      if (c >= 640 && c < 656) bad |= chk_bad(WSP(const float, WS_SIDE)[(size_t)row * 16 + (c - 640)], ref, 1.0f);
      if (c >= 256 && c < 320) bad |= chk_bad(bf2f(WSP(const bf16_t, WS_KCMP)[(size_t)row * 64 + (c - 256)]), ref, 1.0f);
      if (c >= 320 && c < 384) bad |= chk_bad(bf2f(WSP(const bf16_t, WS_VCMP)[(size_t)row * 64 + (c - 320)]), ref, 1.0f);
      if (i >= 160 && i < 192) { float sq = 0.f, skv = 0.f; for (int k = 0; k < 256; ++k) { const float v = bf2f(P[(size_t)row * PW + PC_DQL + k]); sq += v * v; } for (int k = 0; k < 128; ++k) { const float v = bf2f(P[(size_t)row * PW + PC_DKV + k]); skv += v * v; }
          const float* a = WSP(const float, WS_SSQQ) + (size_t)row * 4; const float* b = WSP(const float, WS_SSQKV) + (size_t)row * 4;
          bad |= chk_bad(a[0] + a[1] + a[2] + a[3], sq, 10.f) || chk_bad(b[0] + b[1] + b[2] + b[3], skv, 5.f); }
      chk_flag(F, 1, bad, 0); }
    { const int b = i & 15, h = (i >> 4) & 3, t = chk_t(i >> 6); float a = 0.f; for (int j = 0; j <= t; ++j) { const float xx = WSP(const float, WS_SIDE)[((size_t)b * SEQ + j) * 16 + 12 + h] + F.in[12][l * 4 + h]; a += (xx >= 0.f) ? -log1pf(expf(-xx)) : (xx - log1pf(expf(xx))); }
      chk_flag(F, 2, chk_bad(WSP(const float, WS_KB)[((size_t)b * 4 + h) * SEQ + t], -a * LOG2E, 1.0f + fabsf(a) * 0.05f), 0); }
    chk_flag(F, 3, chk_fox(F, (i * 5) & 15, i & 3, chk_t(i >> 2)), 0);
    { const int row = (int)(chk_hash(i + 77) % M); bool bad = false;
      float sq = 0.f, skv = 0.f; for (int k = 0; k < 256; ++k) { const float v = bf2f(P[(size_t)row * PW + PC_DQL + k]); sq += v * v; } for (int k = 0; k < 128; ++k) { const float v = bf2f(P[(size_t)row * PW + PC_DKV + k]); skv += v * v; }
      const float rq = 1.0f / sqrtf(sq / 256.0f + RMS_EPS), rkv = 1.0f / sqrtf(skv / 128.0f + RMS_EPS);
      const float* wq = F.in[15] + (size_t)l * 256 * 384; const float* gq = F.in[13] + l * 256; const float* wkv = F.in[16] + (size_t)l * 128 * 512; const float* gkv = F.in[14] + l * 128;
#define QDOT(dst, src) do { float a_ = 0.f; for (int k = 0; k < 256; ++k) a_ += bf2f(P[(size_t)row * PW + PC_DQL + k]) * bfr(wq[(size_t)k * 384 + (src)] * C2D * gq[k]); dst = a_ * rq; } while (0)
      const int r = (i * 11) % 384, hd = r / 96, w = r % 96; float ref;
      if (w < 64) QDOT(ref, hd * 96 + w);
      else { const int p = w - 64, ip = p >> 1; float x1, x2; QDOT(x1, hd * 96 + 64 + ip); QDOT(x2, hd * 96 + 64 + 16 + ip); const float inv = powf(10000.0f, -(float)(2 * ip) / 32.0f), ang = (float)(row & (SEQ - 1)) * inv, cs = cosf(ang), sn = sinf(ang);
          ref = (p & 1) ? (x2 * cs + x1 * sn) : (x1 * cs - x2 * sn); }
      bad |= chk_bad(bf2f(WSP(const bf16_t, WS_QM)[(size_t)row * 512 + r]), ref, 1.5f);
      { const int c = (i * 13) & 511; float a = 0.f; for (int k = 0; k < 128; ++k) a += bf2f(P[(size_t)row * PW + PC_DKV + k]) * bfr(wkv[(size_t)k * 512 + c] * gkv[k]); bad |= chk_bad(bf2f(WSP(const bf16_t, WS_KVM)[(size_t)row * 512 + c]), a * rkv, 1.0f); }
      chk_flag(F, 4, bad, 0); }
    { const int b = (i * 3) & 15, h = i & 3, t = chk_t(i >> 2); const size_t row = (size_t)b * SEQ + t; const bf16_t* q = WSP(const bf16_t, WS_QM) + row * 512 + h * 96; const bf16_t* KV = WSP(const bf16_t, WS_KVM); const bf16_t* KR = WSP(const bf16_t, WS_KROT);
      float m = -INFINITY; for (int j = 0; j <= t; ++j) { const size_t rj = (size_t)b * SEQ + j; float s = 0.f; for (int d = 0; d < 64; ++d) s += bf2f(q[d]) * bf2f(KV[rj * 512 + h * 128 + d]); for (int d = 0; d < 32; ++d) s += bf2f(q[64 + d]) * bf2f(KR[rj * 32 + d]); m = fmaxf(m, s); }
      float lsum = 0.f, dummy0_ = 0.f; f32x4 o = {0.f, 0.f, 0.f, 0.f};
      for (int j = 0; j <= t; ++j) { const size_t rj = (size_t)b * SEQ + j; float s = 0.f; for (int d = 0; d < 64; ++d) s += bf2f(q[d]) * bf2f(KV[rj * 512 + h * 128 + d]); for (int d = 0; d < 32; ++d) s += bf2f(q[64 + d]) * bf2f(KR[rj * 32 + d]);
          const float p = exp2f(s - m); lsum += p; _Pragma("unroll") for (int e = 0; e < 4; ++e) o[e] += p * bf2f(KV[rj * 512 + h * 128 + 64 + 21 * e]); }
      bool bad = false; _Pragma("unroll") for (int e = 0; e < 4; ++e) bad |= chk_bad(bf2f(WSP(const bf16_t, WS_OCAT)[row * OCW + 640 + h * 64 + 21 * e]), o[e] / lsum, 0.5f);
      chk_flag(F, 5, bad, 0); }
    chk_flag(F, 6, chk_dil(F, (i * 7) & 15, i & 1, chk_t(i >> 1)), 0);
    { const int b = i & 15, which = (i >> 4) & 1, c = (int)(chk_hash(i + 31) % 255), d = (i * 5) & 63; const bf16_t* src = (which ? WSP(const bf16_t, WS_VCMP) : WSP(const bf16_t, WS_KCMP)) + ((size_t)b * SEQ + 16 * c) * 64;
      const float *pk1 = F.in[8], *pv1 = F.in[10], *pk2 = F.in[9], *pv2 = F.in[11]; asm volatile("" : "+s"(pk1), "+s"(pv1), "+s"(pk2), "+s"(pv2));
      const float* w1 = (which ? pv1 : pk1) + (size_t)l * 2048 * 128; const float* w2 = (which ? pv2 : pk2) + (size_t)l * 128 * 64; const float* cp = F.in[7] + (size_t)l * 2048;
      float out = 0.f;
      for (int n = 0; n < 128; ++n) { float a = 0.f, bsum = 0.f; for (int p = 0; p < 2048; ++p) { a += bf2f(src[p]) * bfr(w1[(size_t)p * 128 + n]); bsum += cp[p] * w1[(size_t)p * 128 + n]; }
          const float xx = a + bsum, g = 0.5f * xx * (1.0f + tanhf(0.7978845608028654f * (xx + 0.044715f * xx * xx * xx))); out += bfr(g) * w2[n * 64 + d]; }
      chk_flag(F, 7, chk_bad(bf2f((which ? WSP(const bf16_t, WS_VC) : WSP(const bf16_t, WS_KC))[((size_t)b * 256 + c) * 64 + d]), out, 0.5f), 0); }
    { bool bad = false; if (i < 128) bad = chk_nsa(F, (i * 9) & 15, i & 3, chk_t(i >> 2), i); chk_flag(F, 8, bad, 4); }
}
__device__ __forceinline__ void selfcheck_b(Frame& F, int l) {
    const int i = threadIdx.x; const int row = (int)(chk_hash(i + 3) % M), n = (i * 29 + 7) & 1023;
    const bf16_t* H = WSP(const bf16_t, WS_H); const bf16_t* OC = WSP(const bf16_t, WS_OCAT);
    float acc = 0.f;
    for (int br = 0; br < 4; ++br) { const float* wg = F.in[21] + ((size_t)l * 4 + br) * DM * DM; float g = 0.f; for (int k = 0; k < DM; ++k) g += bf2f(H[(size_t)row * DM + k]) * bfr(wg[(size_t)k * DM + n]);
        const int kk = (br == 1) ? 128 : 256, co = (br == 0) ? 0 : (br == 1 ? 256 : (br == 2 ? 384 : 640)); const float *pb0 = F.in[17], *pb1 = F.in[18], *pb2 = F.in[19], *pb3 = F.in[20]; asm volatile("" : "+s"(pb0), "+s"(pb1), "+s"(pb2), "+s"(pb3)); const float* wb = (br == 0 ? pb0 : (br == 1 ? pb1 : (br == 2 ? pb2 : pb3))) + (size_t)l * kk * DM; float t = 0.f; for (int k = 0; k < kk; ++k) t += bf2f(OC[(size_t)row * OCW + co + k]) * bfr(wb[(size_t)k * DM + n]);
        acc += (1.f / (1.f + expf(-g))) * bfr(t); }
    chk_flag(F, 9, chk_bad(bf2f(WSP(const bf16_t, WS_MERGED)[(size_t)row * DM + n]), acc, 0.5f), 0);
}
__device__ __forceinline__ void selfcheck_c(Frame& F, int l, const float* xin) {
    const int i = threadIdx.x; const int row = (int)(chk_hash(i + 11) % M), n = (i * 29 + 7) & 1023;
    const bf16_t* MG = WSP(const bf16_t, WS_MERGED); const float* wo = F.in[22] + (size_t)l * DM * DM; const float* Y = WSP(const float, WS_Y);
    float a = 0.f; for (int k = 0; k < DM; ++k) a += bf2f(MG[(size_t)row * DM + k]) * bfr(wo[(size_t)k * DM + n]);
    chk_flag(F, 0, chk_bad(Y[(size_t)row * DM + n], a, 1.0f), 0);
    float s = 0.f; for (int k = 0; k < DM; ++k) { const float v = Y[(size_t)row * DM + k]; s += v * v; }
    const float rstd = 1.0f / sqrtf(s / DM + RMS_EPS); float s2 = 0.f;
    for (int k = 0; k < DM; ++k) { const float v = xin[(size_t)row * DM + k] + Y[(size_t)row * DM + k] * rstd * F.in[3][l * DM + k]; s2 += v * v; }
    const float x1 = xin[(size_t)row * DM + n] + Y[(size_t)row * DM + n] * rstd * F.in[3][l * DM + n];
    const float h2 = x1 * (1.0f / sqrtf(s2 / DM + RMS_EPS)) * F.in[4][l * DM + n];
    chk_flag(F, 1, chk_bad(F.out[(size_t)row * DM + n], x1, 1.0f) || chk_bad(bf2f(WSP(const bf16_t, WS_H2)[(size_t)row * DM + n]), h2, 1.0f), 0);
}
__device__ __forceinline__ void selfcheck_d(Frame& F, int l) {
    const int i = threadIdx.x; const int row = (int)(chk_hash(i + 17) % (M / 2)); const bf16_t* H2 = WSP(const bf16_t, WS_H2); const bf16_t* U = WSP(const bf16_t, WS_U); const bf16_t* A = WSP(const bf16_t, WS_ACT);
    { const int c = (i * 41 + 3) % DFF2; const float* wu = F.in[23] + (size_t)l * DM * DFF2; float a = 0.f; for (int k = 0; k < DM; ++k) a += bf2f(H2[(size_t)row * DM + k]) * bfr(wu[(size_t)k * DFF2 + c]);
      chk_flag(F, 2, chk_bad(bf2f(U[(size_t)row * DFF2 + c]), a, 1.0f), 0); }
    { const int c = (i * 23 + 1) % DFF; const int t = row & (SEQ - 1); const float* cw = F.in[24] + (size_t)l * 3 * DFF2; const float* cb = F.in[25] + (size_t)l * DFF2; float g = cb[c], v = cb[DFF + c];
      for (int j = 0; j < 3; ++j) { const int tt = t - 2 + j; if (tt < 0) continue; g += cw[j * DFF2 + c] * bf2f(U[(size_t)(row - 2 + j) * DFF2 + c]); v += cw[j * DFF2 + DFF + c] * bf2f(U[(size_t)(row - 2 + j) * DFF2 + DFF + c]); }
      chk_flag(F, 3, chk_bad(bf2f(A[(size_t)row * DFF + c]), g / (1.f + expf(-g)) * v, 0.3f), 0); }
    { const int n = (i * 29 + 7) & 1023; const float* wd = F.in[26] + (size_t)l * DFF * DM; float a = 0.f; for (int k = 0; k < DFF; ++k) a += bf2f(A[(size_t)row * DFF + k]) * bfr(wd[(size_t)k * DM + n]);
      chk_flag(F, 4, chk_bad(WSP(const float, WS_Y2)[(size_t)row * DM + n], a, 1.0f), 0); }
}

__device__ __forceinline__ void selfcheck_e(Frame& F, int l) {
    const int i = threadIdx.x; const bf16_t* H = WSP(const bf16_t, WS_H); const bf16_t* P = WSP(const bf16_t, WS_P);
    const float* W = F.in[6] + (size_t)l * DM * DIN; const int row = (int)(chk_hash(i + 5) % M);
#define DOTC(dst, cc) do { float sc_; const int src_ = inproj_src((cc), sc_); float a_ = 0.f; if (src_ >= 0) for (int k = 0; k < DM; ++k) a_ += bf2f(H[(size_t)row * DM + k]) * bfr(W[(size_t)k * DIN + src_] * sc_); dst = a_; } while (0)
    { int c = (i * 37 + 5) % PW; if ((c >= 640 && c < 768)) c = 100; float ref; DOTC(ref, c); chk_flag(F, 0, chk_bad(bf2f(P[(size_t)row * PW + c]), ref, 1.0f), 0); }
    { const int c = 672 + (i & 31), p = c - 672, ip = p >> 1; float ref, oth; DOTC(ref, c); DOTC(oth, c ^ 1); const float x1 = (p & 1) ? oth : ref, x2 = (p & 1) ? ref : oth;
      const float inv = powf(10000.0f, -(float)(2 * ip) / 32.0f), ang = (float)(row & (SEQ - 1)) * inv, cs = cosf(ang), sn = sinf(ang); const float r = (p & 1) ? (x2 * cs + x1 * sn) : (x1 * cs - x2 * sn);
      chk_flag(F, 1, chk_bad(bf2f(WSP(const bf16_t, WS_KROT)[(size_t)row * 32 + p]), r, 1.0f), 0); }
    { const int c = 640 + (i & 15); float ref; DOTC(ref, c); chk_flag(F, 2, chk_bad(WSP(const float, WS_SIDE)[(size_t)row * 16 + (c - 640)], ref, 1.0f), 0); }
    { const int c = 256 + (i & 127); float ref; DOTC(ref, c); const float got = (c < 320) ? bf2f(WSP(const bf16_t, WS_KCMP)[(size_t)row * 64 + (c - 256)]) : bf2f(WSP(const bf16_t, WS_VCMP)[(size_t)row * 64 + (c - 320)]); chk_flag(F, 3, chk_bad(got, ref, 1.0f), 0); }
    float sq = 0.f, skv = 0.f; for (int k = 0; k < 256; ++k) { const float v = bf2f(P[(size_t)row * PW + PC_DQL + k]); sq += v * v; } for (int k = 0; k < 128; ++k) { const float v = bf2f(P[(size_t)row * PW + PC_DKV + k]); skv += v * v; }
    { const float* a = WSP(const float, WS_SSQQ) + (size_t)row * 4; const float* b = WSP(const float, WS_SSQKV) + (size_t)row * 4; chk_flag(F, 4, chk_bad(a[0] + a[1] + a[2] + a[3], sq, 10.f) || chk_bad(b[0] + b[1] + b[2] + b[3], skv, 5.f), 0); }
    const float rq = 1.0f / sqrtf(sq / 256.0f + RMS_EPS), rkv = 1.0f / sqrtf(skv / 128.0f + RMS_EPS);
    const float* wq = F.in[15] + (size_t)l * 256 * 384; const float* gq = F.in[13] + l * 256; const float* wkv = F.in[16] + (size_t)l * 128 * 512; const float* gkv = F.in[14] + l * 128;
#define QDOT(dst, src) do { float a_ = 0.f; for (int k = 0; k < 256; ++k) a_ += bf2f(P[(size_t)row * PW + PC_DQL + k]) * bfr(wq[(size_t)k * 384 + (src)] * C2D * gq[k]); dst = a_ * rq; } while (0)
    { const int hd = i & 3, w = (i >> 2) & 63; float ref; QDOT(ref, hd * 96 + w); chk_flag(F, 5, chk_bad(bf2f(WSP(const bf16_t, WS_QM)[(size_t)row * 512 + hd * 96 + w]), ref, 1.5f), 0); }
    { const int hd = i & 3, p = (i >> 2) & 31, ip = p >> 1; float x1, x2; QDOT(x1, hd * 96 + 64 + ip); QDOT(x2, hd * 96 + 64 + 16 + ip); const float inv = powf(10000.0f, -(float)(2 * ip) / 32.0f), ang = (float)(row & (SEQ - 1)) * inv, cs = cosf(ang), sn = sinf(ang);
      const float r = (p & 1) ? (x2 * cs + x1 * sn) : (x1 * cs - x2 * sn); chk_flag(F, 6, chk_bad(bf2f(WSP(const bf16_t, WS_QM)[(size_t)row * 512 + hd * 96 + 64 + p]), r, 1.5f), 0); }
    { const int c = (i * 13) & 511; float a = 0.f; for (int k = 0; k < 128; ++k) a += bf2f(P[(size_t)row * PW + PC_DKV + k]) * bfr(wkv[(size_t)k * 512 + c] * gkv[k]); chk_flag(F, 7, chk_bad(bf2f(WSP(const bf16_t, WS_KVM)[(size_t)row * 512 + c]), a * rkv, 1.0f), 0); }
    { const int b = i & 15, which = (i >> 4) & 1, c = (int)(chk_hash(i + 31) % 255), n = (i * 5) & 127; const bf16_t* src = (which ? WSP(const bf16_t, WS_VCMP) : WSP(const bf16_t, WS_KCMP)) + ((size_t)b * SEQ + 16 * c) * 64;
      const float *pk1 = F.in[8], *pv1 = F.in[10], *pk2 = F.in[9], *pv2 = F.in[11]; asm volatile("" : "+s"(pk1), "+s"(pv1), "+s"(pk2), "+s"(pv2));
      const float* w1 = (which ? pv1 : pk1) + (size_t)l * 2048 * 128; const float* w2 = (which ? pv2 : pk2) + (size_t)l * 128 * 64; const float* cp = F.in[7] + (size_t)l * 2048;
      float a = 0.f, bsum = 0.f; for (int p = 0; p < 2048; ++p) { a += bf2f(src[p]) * bfr(w1[(size_t)p * 128 + n]); bsum += cp[p] * w1[(size_t)p * 128 + n]; }
      const float xx = a + bsum, g = 0.5f * xx * (1.0f + tanhf(0.7978845608028654f * (xx + 0.044715f * xx * xx * xx)));
      const bf16_t* hid = WSP(const bf16_t, WS_HID) + (size_t)(which * 4096 + b * 256 + c) * 256 + which * 128;
      chk_flag(F, 8, chk_bad(bf2f(hid[n]), g, 0.5f), 0);
      const int d = (i * 5) & 63; float o2 = 0.f; for (int nn = 0; nn < 128; ++nn) o2 += bf2f(hid[nn]) * w2[nn * 64 + d];
      chk_flag(F, 9, chk_bad(bf2f((which ? WSP(const bf16_t, WS_VC) : WSP(const bf16_t, WS_KC))[((size_t)b * 256 + c) * 64 + d]), o2, 0.5f), 0); }
#undef DOTC
#undef QDOT
}

constexpr int CW_CNT = 20544;
__device__ __forceinline__ void selfcheck_g(Frame& F, int l) {
    const int gi = blockIdx.x * 512 + threadIdx.x; const bf16_t* H = WSP(const bf16_t, WS_H); const bf16_t* P = WSP(const bf16_t, WS_P); const float* W = F.in[6] + (size_t)l * DM * DIN;
    const int row = gi & (M - 1); unsigned nbad = 0u;
    for (int k4 = 0; k4 < 4; ++k4) { int c = (int)(chk_hash(gi * 4 + k4 + 12345u) % PW); if (c >= 640 && c < 768) c -= 200;
        float sc_; const int src_ = inproj_src(c, sc_); float a_ = 0.f; for (int k = 0; k < DM; ++k) a_ += bf2f(H[(size_t)row * DM + k]) * bfr(W[(size_t)k * DIN + src_] * sc_);
        if (chk_bad(bf2f(P[(size_t)row * PW + c]), a_, 1.0f)) ++nbad; }
    if (nbad) atomicAdd((unsigned*)(F.ctl + CW_CNT), nbad);
}
__device__ __forceinline__ void selfcheck_g_fin(Frame& F) {
    if (blockIdx.x == 0 && threadIdx.x == 0) { const unsigned cnt = __hip_atomic_load(F.ctl + CW_CNT, __ATOMIC_RELAXED, __HIP_MEMORY_SCOPE_AGENT); unsigned lg = 0; while ((1u << lg) <= cnt && lg < 15) ++lg;
        atomicOr((unsigned*)(F.ctl + CW_CHK), (cnt > 63u ? 63u : cnt) | (lg << 6)); }
}

__device__ __forceinline__ void selfcheck_f(Frame& F, int l) {
    const int i = threadIdx.x; const unsigned hsh = chk_hash(i + 4242u);
    chk_flag(F, 0, chk_fox(F, i & 15, (i >> 4) & 3, (i >> 6) * 8 + (hsh & 7)), 0);
    chk_flag(F, 1, chk_fox(F, i & 15, (i >> 4) & 3, 64 + (int)(hsh % 192u)), 0);
    chk_flag(F, 2, chk_fox(F, i & 15, (i >> 4) & 3, 256 + (int)(hsh % 3840u)), 0);
    chk_flag(F, 3, chk_dil(F, i & 15, (i >> 4) & 1, (int)(hsh & 127u)), 0);
    chk_flag(F, 4, chk_dil(F, i & 15, (i >> 4) & 1, 128 + (int)(hsh % 3968u)), 0);
    { bool bad = false; if (i < 128) bad = chk_nsa(F, i & 15, (i >> 4) & 3, (int)(hsh % 31u), i); chk_flag(F, 5, bad, 0); }
    { bool bad = false; if (i < 128) bad = chk_nsa(F, i & 15, (i >> 4) & 3, 31 + (int)(hsh % 33u), i); chk_flag(F, 6, bad, 0); }
    { bool bad = false; if (i < 128) bad = chk_nsa(F, i & 15, (i >> 4) & 3, 64 + (int)(hsh % 960u), i); chk_flag(F, 7, bad, 0); }
    { bool bad = false; if (i < 128) bad = chk_nsa(F, i & 15, (i >> 4) & 3, 1024 + (int)(hsh % 3072u), i); chk_flag(F, 8, bad, 4); }
}
__device__ __forceinline__ void selfcheck_report(Frame& F) {
    const unsigned mask = __hip_atomic_load(F.ctl + CW_CHK, __ATOMIC_RELAXED, __HIP_MEMORY_SCOPE_AGENT);
    float V = (float)(10u + (mask & 63u)); const unsigned e = 2u + ((mask >> 6) & 15u); for (unsigned k = 0; k < e; ++k) V *= 10.0f;
    for (size_t idx = (size_t)blockIdx.x * 512 + threadIdx.x; idx < (size_t)M * DM; idx += (size_t)F.G * 512) F.out[idx] = V;
}
#endif
struct SchedSimple {
    pg8::TileOrder T; const char* A; const char* B; int lda, ldb, nt; int dup = 0;
    __device__ __forceinline__ bool next(int i, GUnit& u) const { int pm, pn; if (!T.tile(i >> dup, pm, pn)) return false;
        u.A = A + (size_t)pm * 256 * lda; u.B = B + (size_t)pn * 256 * ldb; u.lda = lda; u.ldb = ldb; u.nt = nt; u.pm = pm; u.pn = pn; u.id = 0; return true; }
};
struct SchedCmp1 {
    int c; const char* kc; const char* vc; const char* B;
    __device__ __forceinline__ bool next(int i, GUnit& u) const { if (i > 0 || c >= 32) return false;
        u.A = (c < 16 ? kc : vc) + (size_t)(c & 15) * 256 * 2048; u.B = B; u.lda = 2048; u.ldb = 4096; u.nt = 32; u.pm = c; u.pn = 0; u.id = 0; return true; }
};
struct SchedMerge {
    pg8::TileOrder T; const char* ocat; const char* h; const char* wbr; const char* wg; int dup = 0;
    __device__ __forceinline__ bool next(int i0, GUnit& u) const { const int i = i0 >> dup; int pm, pn; if (!T.tile(i >> 3, pm, pn)) return false;
        const int sub = i & 7; u.pm = pm; u.pn = pn; u.id = sub;
        if (sub >= 4) { u.A = h + (size_t)pm * 256 * 2048; u.lda = 2048; u.B = wg + (size_t)((pn * 4 + (sub - 4)) * 256) * 2048; u.ldb = 2048; u.nt = 16; }
        else { const int br = sub; const int kk = (br == 1) ? 128 : 256; const size_t co = (br == 0) ? 0 : (br == 1 ? 256 : (br == 2 ? 384 : 640)), wo = (br == 0) ? BR_A : (br == 1 ? BR_B : (br == 2 ? BR_C : BR_D));
            u.A = ocat + (size_t)pm * 256 * (OCW * 2) + co * 2; u.lda = OCW * 2; u.B = wbr + wo + (size_t)pn * 256 * kk * 2; u.ldb = kk * 2; u.nt = kk / 64; }
        return true; }
};

#ifndef SDUP_INPROJ
#define SDUP_INPROJ 0
#endif
#ifndef SDUP_MERGE
#define SDUP_MERGE 0
#endif
#ifndef SDUP_WO
#define SDUP_WO 0
#endif
#ifndef SDUP_UP
#define SDUP_UP 0
#endif
#ifndef SDUP_DN
#define SDUP_DN 0
#endif
#ifndef DUP_ATTN
#define DUP_ATTN 1
#endif
#ifndef DUP_GEMM
#define DUP_GEMM 1
#endif
#ifndef DUP_MERGE
#define DUP_MERGE 1
#endif
#ifndef DUP_FFN
#define DUP_FFN 1
#endif
#ifdef ONLY_PHASE
#define PH(k) ((k) == ONLY_PHASE)
#else
#define PH(k) true
#endif
struct Args { const float* in[27]; float* out; unsigned char* ws; };
__global__ void __launch_bounds__(512, 2) hybrid_fwd(Args args) {
    extern __shared__ __attribute__((aligned(16))) unsigned char lds_raw[];
    Frame F;
    F.lds = (LAS unsigned char*)lds_raw; F.MISC = (volatile LAS unsigned*)(F.lds + MISC_OFF);
    F.tid = threadIdx.x; F.lane = F.tid & 63; F.wave = __builtin_amdgcn_readfirstlane(F.tid >> 6); F.G = gridDim.x;
#pragma unroll
    for (int i = 0; i < 27; ++i) F.in[i] = args.in[i];
    F.out = args.out; F.ws = args.ws; F.ctl = (gu32*)(args.ws + WS_CTL);
    for (int u = F.tid; u < (LDS_BYTES - LDSCTL_OFF) / 4; u += 512) ((LAS unsigned*)(F.lds + LDSCTL_OFF))[u] = 0u;
    __syncthreads();
    XcdBarrier bar = xcd_barrier_post((unsigned*)(F.ctl + CW_BAR), F.MISC + 8);
    const int c = (int)blockIdx.x;
#if defined(TIMEPROBE)
    if (threadIdx.x == 0) *(volatile LAS unsigned long long*)(F.lds + MISC_OFF + 64) = __builtin_amdgcn_s_memrealtime();
#define TSTAMP(id) do { if (blockIdx.x == 0 && threadIdx.x == 0) { volatile LAS unsigned long long* tp_ = (volatile LAS unsigned long long*)(F.lds + MISC_OFF + 64); const unsigned long long now_ = __builtin_amdgcn_s_memrealtime(); unsigned long long* a_ = (unsigned long long*)(F.ws + 90000) + (id); *a_ = *a_ + (now_ - *tp_); *tp_ = now_; } } while (0)
#else
#define TSTAMP(id) do { } while (0)
#endif

#ifndef DUP_P0
#define DUP_P0 1
#endif
    for (int rep = 0; rep < DUP_P0; ++rep) { if (rep) xcd_barrier(bar); if (PH(0)) p0_prologue(F); }
    xcd_barrier(bar); TSTAMP(0);

#ifndef XTRA_BAR
#define XTRA_BAR 0
#endif
    _Pragma("unroll") for (int xb = 0; xb < XTRA_BAR; ++xb) xcd_barrier(bar);
#define PHASE_FRESH() do { int t_ = threadIdx.x; asm volatile("" : "+v"(t_)); F.tid = t_; F.lane = t_ & 63; } while (0)
    for (int l = 0; l < DEPTH; ++l) {
        unsigned char* wl = F.ws + WS_WT + (size_t)l * LW;
        const float* xin = (l == 0) ? F.in[0] : F.out;
        PHASE_FRESH();
#ifndef DUP_RP0
#define DUP_RP0 1
#endif
        if (l == 0) { if (c == 0) cmpb_reduce(F);
          _Pragma("unroll") for (int rep = 0; rep < DUP_RP0; ++rep) { if (rep) xcd_barrier(bar); if (PH(1)) rowpass<0>(F, xin, nullptr, 0, nullptr, WSP(bf16_t, WS_H), F.in[2] + l * DM, nullptr, 0, M); }
          xcd_barrier(bar); TSTAMP(1); }
        for (int rep = 0; rep < DUP_GEMM; ++rep) if (PH(2)) { if (rep) xcd_barrier(bar); SchedSimple S; S.T.init(256, 12, F.G, c); S.A = (const char*)(F.ws + WS_H); S.B = (const char*)(wl + LW_IN); S.lda = 2048; S.ldb = 2048; S.nt = 16; S.dup = SDUP_INPROJ;
          pg8::EpiInProj E{WSP(bf16_t, WS_P), WSP(bf16_t, WS_KCMP), WSP(bf16_t, WS_VCMP), WSP(float, WS_SIDE), WSP(bf16_t, WS_KROT), WSP(const float, WS_ROPE), WSP(float, WS_SSQQ), WSP(float, WS_SSQKV), F.in[12] + l * 4, WSP(float, WS_LF)};
          pg8::gemm_phase<pg8::EpiInProj, SchedSimple, true>(F.lds, S, E); }
        xcd_barrier(bar); TSTAMP(2);
#ifndef DUP_L2A
#define DUP_L2A 1
#endif
        _Pragma("unroll") for (int rep2 = 0; rep2 < DUP_L2A; ++rep2) { if (rep2) xcd_barrier(bar);
        if (PH(3)) { SchedCmp1 S{c, (const char*)(F.ws + WS_KCMP), (const char*)(F.ws + WS_VCMP), (const char*)(wl + LW_PHI)};
          pg8::EpiCmp1 E{WSP(bf16_t, WS_HID), WSP(const float, WS_CMPB) + l * 256};
          pg8::gemm_phase<pg8::EpiCmp1, SchedCmp1, false>(F.lds, S, E);
          if (c < 32) {
              __syncthreads(); const int which = c >> 4, b = c & 15;
              int ln_ = threadIdx.x & 63; asm volatile("" : "+v"(ln_)); const int r32 = ln_ & 31, hi = ln_ >> 5;
              const bf16_t* hrow = WSP(const bf16_t, WS_HID) + ((size_t)c * 256 + F.wave * 32 + r32) * 256 + which * 128;
              const float *pk2 = F.in[9], *pv2 = F.in[11]; asm volatile("" : "+s"(pk2), "+s"(pv2)); const float* w2 = (which ? pv2 : pk2) + (size_t)l * 128 * 64;
              f32x16 o0, o1;
#pragma unroll
              for (int r = 0; r < 16; ++r) { o0[r] = 0.f; o1[r] = 0.f; }
#pragma unroll
              for (int ks = 0; ks < 8; ++ks) { const bf16x8 a = *(const bf16x8*)(hrow + ks * 16 + hi * 8);
                  const float* wp = w2 + (size_t)(ks * 16 + hi * 8) * 64 + r32; u32x4 b0, b1;
#pragma unroll
                  for (int jj = 0; jj < 4; ++jj) { b0[jj] = cvtpk(wp[(2 * jj) * 64], wp[(2 * jj + 1) * 64]); b1[jj] = cvtpk(wp[(2 * jj) * 64 + 32], wp[(2 * jj + 1) * 64 + 32]); }
                  o0 = MFMA32(a, __builtin_bit_cast(bf16x8, b0), o0); o1 = MFMA32(a, __builtin_bit_cast(bf16x8, b1), o1); }
              bf16_t* dst = (which ? WSP(bf16_t, WS_VC) : WSP(bf16_t, WS_KC)) + ((size_t)b * 256 + F.wave * 32) * 64 + r32;
#pragma unroll
              for (int r = 0; r < 16; ++r) { const int rw = crow(r, hi); dst[(size_t)rw * 64] = (bf16_t)f2bf(o0[r]); dst[(size_t)rw * 64 + 32] = (bf16_t)f2bf(o1[r]); } } }
        if (PH(4)) { int G2_ = F.G; asm volatile("" : "+s"(G2_)); const bool split = G2_ > 64; const int g2 = split ? F.G - 32 : F.G, c2 = split ? c - 32 : c;
          { SchedSimple S; S.T.init(256, 2, g2, c2 < 0 ? (1 << 28) : c2); S.A = (const char*)(F.ws + WS_P) + PC_DQL * 2; S.B = (const char*)(wl + LW_UQ); S.lda = PW * 2; S.ldb = 512; S.nt = 4;
            pg8::EpiQup E{WSP(bf16_t, WS_QM), WSP(const float, WS_SSQQ), WSP(const float, WS_ROPE)};
            pg8::gemm_phase<pg8::EpiQup, SchedSimple, true>(F.lds, S, E); }
          { SchedSimple S; S.T.init(256, 2, g2, c2 < 0 ? (1 << 28) : c2); S.A = (const char*)(F.ws + WS_P) + PC_DKV * 2; S.B = (const char*)(wl + LW_UKV); S.lda = PW * 2; S.ldb = 256; S.nt = 2;
            pg8::EpiKVup E{WSP(bf16_t, WS_KVM), WSP(const float, WS_SSQKV)};
            pg8::gemm_phase<pg8::EpiKVup, SchedSimple, true>(F.lds, S, E); } }
        PHASE_FRESH();
        if (PH(5)) {
          int G_ = F.G; asm volatile("" : "+s"(G_)); const int cb = (G_ >= 48) ? c - 32 : c;
          if (cb >= 0 && cb < BATCH) { const int b = cb, tid = F.tid; const float* lf = WSP(const float, WS_LF) + ((size_t)b * SEQ + 8 * tid) * 4;
              f32x4 v[8];
#pragma unroll
              for (int i = 0; i < 8; ++i) v[i] = *(const f32x4*)(lf + 4 * i);
#pragma unroll
              for (int i = 1; i < 8; ++i) v[i] = v[i] + v[i - 1];
              LAS f32x4* sc = (LAS f32x4*)F.lds; f32x4 run = v[7];
              sc[tid] = run; __syncthreads();
              for (int off = 1, cur = 0; off < 512; off <<= 1, cur ^= 1) { f32x4 t = sc[cur * 512 + tid]; if (tid >= off) t = t + sc[cur * 512 + tid - off]; sc[(cur ^ 1) * 512 + tid] = t; __syncthreads(); run = t; }
              const f32x4 ex = run - v[7];
              float* kb = WSP(float, WS_KB) + (size_t)b * 4 * SEQ + 8 * tid;
#pragma unroll
              for (int e = 0; e < 4; ++e) { f32x4 lo, hi4;
#pragma unroll
                  for (int i = 0; i < 4; ++i) { lo[i] = -(ex[e] + v[i][e]) * LOG2E; hi4[i] = -(ex[e] + v[4 + i][e]) * LOG2E; }
                  *(f32x4*)(kb + (size_t)e * SEQ) = lo; *(f32x4*)(kb + (size_t)e * SEQ + 4) = hi4; }
              __syncthreads();
              { const bf16_t* Kp = WSP(const bf16_t, WS_P) + ((size_t)b * SEQ + 8 * tid) * PW + PC_CK; f32x4 mx2 = {0.f, 0.f, 0.f, 0.f};
                for (int i = 0; i < 8; ++i)
#pragma unroll
                    for (int hh = 0; hh < 4; ++hh) { float ss = 0.f;
#pragma unroll
                        for (int q8 = 0; q8 < 8; ++q8) { const bf16x8 kv = *(const bf16x8*)(Kp + (size_t)i * PW + hh * 64 + q8 * 8);
#pragma unroll
                            for (int e = 0; e < 8; ++e) { const float x = bf2f((unsigned short)kv[e]); ss += x * x; } }
                        mx2[hh] = fmaxf(mx2[hh], ss); }
                LAS f32x4* sm = (LAS f32x4*)F.lds; sm[tid] = mx2; __syncthreads();
                for (int off = 256; off > 0; off >>= 1) { if (tid < off) { const f32x4 o = sm[tid + off]; f32x4 t = sm[tid]; t[0] = fmaxf(t[0], o[0]); t[1] = fmaxf(t[1], o[1]); t[2] = fmaxf(t[2], o[2]); t[3] = fmaxf(t[3], o[3]); sm[tid] = t; } __syncthreads(); }
                if (tid < 4) WSP(float, WS_KMAX)[b * 4 + tid] = sqrtf(sm[0][tid]); __syncthreads(); }
          } }
        }
        xcd_barrier(bar); TSTAMP(3);
        PHASE_FRESH();
        for (int rep = 0; rep < DUP_ATTN; ++rep) { gu32* ctr = F.ctl + CW_Q + 64 * l + 16 * rep;
          if (rep) xcd_barrier(bar);
          unsigned nxtq = 0u; if (F.tid == 0) nxtq = __hip_atomic_fetch_add(ctr, 1u, __ATOMIC_RELAXED, __HIP_MEMORY_SCOPE_AGENT);
          for (;;) { if (F.tid == 0) F.MISC[0] = nxtq; __syncthreads(); const int iq = (int)F.MISC[0]; __syncthreads(); if (iq >= ATT_UNITS) break;
              if (F.tid == 0) nxtq = __hip_atomic_fetch_add(ctr, 1u, __ATOMIC_RELAXED, __HIP_MEMORY_SCOPE_AGENT);
              const int it = __builtin_amdgcn_readfirstlane(WSP(const int, WS_ORDER)[iq]);
              if (it < 2048 && PH(7)) { const int qb = 15 - (it >> 7), mla = (it >> 6) & 1, bh = it & 63; if (mla) causal_unit<false>(F, bh >> 2, bh & 3, qb); else causal_unit<true>(F, bh >> 2, bh & 3, qb); }
              else if (it < 3072 && PH(8)) { const int r = it - 2048; nsa_unit(F, r & 15, 63 - (r >> 4)); }
              else if (it < 3328 && PH(9)) { const int r = it - 3072; dil_unit(F, r & 15, (r >> 4) & 1, r >> 5); } } }
        xcd_barrier(bar); TSTAMP(5);
#if defined(SELFCHECK) && SELFCHECK == 1
        if (c == 0) selfcheck_a(F, l);
#endif
#if defined(SELFCHECK) && SELFCHECK == 3
        if (c == 0) selfcheck_e(F, l);
        xcd_barrier(bar); selfcheck_report(F); return;
#endif
#if defined(SELFCHECK) && SELFCHECK == 5
        selfcheck_g(F, l); xcd_barrier(bar); selfcheck_g_fin(F);
        xcd_barrier(bar); selfcheck_report(F); return;
#endif
#if defined(SELFCHECK) && SELFCHECK == 4
        if (c == 0) selfcheck_f(F, l);
        xcd_barrier(bar); selfcheck_report(F); return;
#endif
        for (int rep = 0; rep < DUP_MERGE; ++rep) if (PH(10)) { if (rep) xcd_barrier(bar); SchedMerge S; S.T.init(256, 4, F.G, c); S.ocat = (const char*)(F.ws + WS_OCAT); S.h = (const char*)(F.ws + WS_H); S.wbr = (const char*)(wl + LW_BR); S.wg = (const char*)(wl + LW_G); S.dup = SDUP_MERGE;
          unsigned char* scr = F.ws + WS_MSCR + (size_t)c * MSCR_PER_WG;
          pg8::EpiMerge E{WSP(bf16_t, WS_MERGED), scr};
          pg8::gemm_phase<pg8::EpiMerge, SchedMerge, true>(F.lds, S, E); }
        xcd_barrier(bar); TSTAMP(6);
#if defined(SELFCHECK) && SELFCHECK == 1
        if (c == 0) selfcheck_b(F, l);
        xcd_barrier(bar); selfcheck_report(F); return;
#endif
        if (PH(11)) { SchedSimple S; S.T.init(256, 4, F.G, c); S.A = (const char*)(F.ws + WS_MERGED); S.B = (const char*)(wl + LW_O); S.lda = 2048; S.ldb = 2048; S.nt = 16; S.dup = SDUP_WO;
          pg8::EpiBf16 E{WSP(bf16_t, WS_Y), DM};
          pg8::gemm_phase<pg8::EpiBf16, SchedSimple, true>(F.lds, S, E); }
        xcd_barrier(bar); TSTAMP(7);
        PHASE_FRESH();
        if (PH(12)) rowpass<1>(F, xin, WSP(const bf16_t, WS_Y), 0, F.out, WSP(bf16_t, WS_H2), F.in[3] + l * DM, F.in[4] + l * DM, 0, M);
        xcd_barrier(bar); TSTAMP(8);
#ifdef DUP_RP1
        if (l == 0) { _Pragma("unroll") for (int rep = 0; rep < DUP_RP1; ++rep) { rowpass<1>(F, xin, WSP(const bf16_t, WS_Y), 0, F.out, WSP(bf16_t, WS_H2), F.in[3] + l * DM, F.in[4] + l * DM, 0, M); xcd_barrier(bar); } }
#endif
#ifndef DUP_UP
#define DUP_UP 1
#endif
        _Pragma("unroll") for (int rep = 0; rep < DUP_UP; ++rep) if (PH(13)) { if (rep) xcd_barrier(bar); SchedSimple S; S.T.init(256, 22, F.G, c); S.A = (const char*)(F.ws + WS_H2); S.B = (const char*)(wl + LW_UP); S.lda = 2048; S.ldb = 2048; S.nt = 16; S.dup = SDUP_UP;
          pg8::EpiUpConv E{WSP(bf16_t, WS_ACT), WSP(float, WS_HB), F.in[24] + (size_t)l * 3 * DFF2, F.in[25] + (size_t)l * DFF2};
          pg8::gemm_phase<pg8::EpiUpConv, SchedSimple, true>(F.lds, S, E); }
        xcd_barrier(bar); TSTAMP(9);
        PHASE_FRESH();
        if (PH(15)) { SchedSimple S; S.T.init(256, 4, F.G, c); S.A = (const char*)(F.ws + WS_ACT); S.B = (const char*)(wl + LW_DN); S.lda = DFF * 2; S.ldb = DFF * 2; S.nt = DFF / 64; S.dup = SDUP_DN;
          { int pm, pn; for (int i = 0; S.T.tile(i, pm, pn); ++i) ffn_fix_panel(F, pm, WSP(const float, WS_HB), WSP(bf16_t, WS_ACT), F.in[24] + (size_t)l * 3 * DFF2, F.in[25] + (size_t)l * DFF2); }
          VM_WAIT(); __syncthreads();
          pg8::EpiBf16 E{WSP(bf16_t, WS_Y2), DM};
          pg8::gemm_phase<pg8::EpiBf16, SchedSimple, true>(F.lds, S, E); }
        xcd_barrier(bar); TSTAMP(11);
        PHASE_FRESH();
        if (PH(16)) { if (l + 1 < DEPTH) rowpass<1>(F, F.out, WSP(const bf16_t, WS_Y2), 0, F.out, WSP(bf16_t, WS_H), F.in[5] + l * DM, F.in[2] + (l + 1) * DM, 0, M);
                      else rowpass<2>(F, F.out, WSP(const bf16_t, WS_Y2), 0, F.out, nullptr, F.in[5] + l * DM, nullptr, 0, M); }
        xcd_barrier(bar); TSTAMP(12);
    }
#if defined(TIMEPROBE)
    { xcd_barrier(bar); const unsigned long long* a_ = (const unsigned long long*)(F.ws + 90000); const float V1 = (float)a_[TIMEPROBE_A] * 0.01f, V2 = (float)a_[TIMEPROBE_B] * 0.01f * 1000.0f;
      for (size_t idx = (size_t)blockIdx.x * 512 + threadIdx.x; idx < (size_t)M * DM; idx += (size_t)F.G * 512) F.out[idx] = (idx == 12345) ? V2 : V1; }
#endif
}

extern "C" void kernel_launch(void* const* d_in, const int* in_sizes, int n_in, void* d_out, int out_size, void* d_ws, size_t ws_size, hipStream_t stream) {
    static int grid = 0;
    if (grid == 0) {
        if (n_in != 27 || in_sizes[0] != M * DM || out_size != M * DM || ws_size < WS_END) { fprintf(stderr, "kernel_launch: unexpected shapes (n_in %d, in0 %d, out %d, ws %zu)\n", n_in, n_in > 0 ? in_sizes[0] : -1, out_size, ws_size); grid = -1; return; }
        int dev = 0, cus = 0, per_cu = 0;
        if (hipGetDevice(&dev) != hipSuccess || hipDeviceGetAttribute(&cus, hipDeviceAttributeMultiprocessorCount, dev) != hipSuccess) { grid = -1; return; }
        if (hipFuncSetAttribute((const void*)hybrid_fwd, hipFuncAttributeMaxDynamicSharedMemorySize, LDS_BYTES) != hipSuccess) { fprintf(stderr, "kernel_launch: hipFuncSetAttribute failed\n"); grid = -1; return; }
        if (hipOccupancyMaxActiveBlocksPerMultiprocessor(&per_cu, (const void*)hybrid_fwd, 512, LDS_BYTES) != hipSuccess || per_cu < 1) fprintf(stderr, "kernel_launch: occupancy query says %d\n", per_cu);
        (void)hipGetLastError();
        grid = cus;
    }
    if (grid < 0) return;
    if (hipMemsetAsync((char*)d_ws + WS_CTL, 0, CTL_ZERO_BYTES, stream) != hipSuccess) return;
    Args a{};
    for (int i = 0; i < 27; ++i) a.in[i] = (const float*)d_in[i];
    a.out = (float*)d_out; a.ws = (unsigned char*)d_ws;
    hipLaunchKernelGGL(hybrid_fwd, dim3(grid), dim3(512), LDS_BYTES, stream, a);
}
```

```cpp
#include <hip/hip_runtime.h>
#include <hip/hip_bf16.h>
#include <cstdio>
#include <cstdint>
#include <cmath>

#define GAS __attribute__((address_space(1)))
#define LAS __attribute__((address_space(3)))
typedef unsigned short bf16_t;
typedef short bf16x8 __attribute__((ext_vector_type(8)));
typedef short s16x4 __attribute__((ext_vector_type(4)));
typedef float f32x4 __attribute__((ext_vector_type(4)));
typedef float f32x2 __attribute__((ext_vector_type(2)));
typedef float f32x16 __attribute__((ext_vector_type(16)));
typedef unsigned u32x4 __attribute__((ext_vector_type(4)));
typedef unsigned u32x2 __attribute__((ext_vector_type(2)));
typedef GAS unsigned gu32;

constexpr int BATCH = 16, SEQ = 4096, DM = 1024, M = BATCH * SEQ, DEPTH = 2;
constexpr int DIN = 2992, PW = 3072;
constexpr int DFF = 2816, DFF2 = 5632;
constexpr float LOG2E = 1.4426950408889634f;
constexpr float C2A = 0.125f * LOG2E;
constexpr float C2D = 0.10206207261596575f * LOG2E;
constexpr float RMS_EPS = 1e-6f;
constexpr int PC_AQ = 0, PC_KCMP = 256, PC_VCMP = 320, PC_KSLC = 384, PC_VSLC = 448, PC_KWIN = 512, PC_VWIN = 576,
              PC_MISC = 640, PC_KROPE = 672, PC_BQ = 768, PC_BK = 1152, PC_BV = 1536, PC_DKV = 1920,
              PC_CQ = 2048, PC_CK = 2304, PC_CV = 2560, PC_DQL = 2816;
constexpr int OCW = 896;
constexpr int NSA_DFAR = 1536, NSA_DMAX = 1664, NSA_TL = 1728;

__device__ __forceinline__ unsigned f2bf(float f) { unsigned u = __float_as_uint(f); return (u + 0x7fffu + ((u >> 16) & 1u)) >> 16; }
__device__ __forceinline__ unsigned pk2(float lo, float hi) { return f2bf(lo) | (f2bf(hi) << 16); }
__device__ __forceinline__ float bf2f(unsigned short b) { return __uint_as_float((unsigned)b << 16); }
typedef __bf16 bf16x2_t __attribute__((ext_vector_type(2)));
__device__ __forceinline__ unsigned cvtpk(float lo, float hi) { f32x2 v = {lo, hi}; bf16x2_t b = __builtin_convertvector(v, bf16x2_t); return __builtin_bit_cast(unsigned, b); }
__device__ __forceinline__ float fast_exp2(float x) { return __builtin_amdgcn_exp2f(x); }
__device__ __forceinline__ float fast_rcp(float x) { return __builtin_amdgcn_rcpf(x); }
template <int MASK> __device__ __forceinline__ float xor_lane_lt32(float v) { return __uint_as_float(__builtin_amdgcn_ds_swizzle((int)__float_as_uint(v), (MASK << 10) | 0x1f)); }
__device__ __forceinline__ float sum_halves(float v) { auto rr = __builtin_amdgcn_permlane32_swap(__float_as_uint(v), __float_as_uint(v), false, false); return __uint_as_float(rr[0]) + __uint_as_float(rr[1]); }
__device__ __forceinline__ float sigmoid_f(float x) { return fast_rcp(1.0f + fast_exp2(-x * LOG2E)); }

namespace pg8 {
constexpr int BM = 256, BK = 64, HALF = 128, HTB = HALF * BK * 2  , STAGE_BYTES = 8 * HTB, NXCD = 8, WGM = 8;
__host__ __device__ __forceinline__ int lds_byte(int r, int c) { const int st = (r >> 4) * 2 + (c >> 5), rr = r & 15, cc = c & 31, ob = rr * 64 + cc * 2; return st * 1024 + (ob ^ (((ob >> 9) & 1) << 5)); }
__host__ __device__ __forceinline__ void stage_rc(int b, int& R, int& C) { const int st = b / 1024, sb = b % 1024, swz = sb ^ (((sb >> 9) & 1) << 5); R = (st >> 1) * 16 + swz / 64; C = (st & 1) * 32 + (swz % 64) / 2; }
__host__ __device__ __forceinline__ int perm32(int rho) { const int n = rho >> 4, i = rho & 15; return 8 * (i >> 2) + 4 * n + (i & 3); }

struct GUnit { const char* A; const char* B; int lda, ldb, nt, pm, pn, id; };

struct TileOrder {
    int nM, nN, nwg, G, c;
    __device__ __forceinline__ void init(int nM_, int nN_, int G_, int c_) { nM = nM_; nN = nN_; nwg = nM * nN; G = G_; c = c_; }
    __device__ __forceinline__ bool tile(int i, int& pm, int& pn) const {
        const long L = (long)i * G + c; if (L >= nwg) return false;
        int wgid = (int)L; { const int q = nwg / NXCD, r = nwg % NXCD, xcd = wgid % NXCD, off = wgid / NXCD; wgid = (xcd < r ? xcd * (q + 1) : r * (q + 1) + (xcd - r) * q) + off; }
        const int nig = WGM * nN, gid = wgid / nig, fm = gid * WGM, gsz = (nM - fm) < WGM ? (nM - fm) : WGM;
        pm = fm + ((wgid % nig) % gsz); pn = (wgid % nig) / gsz; return true;
    }
};

template <class Epi, class Sched, bool ALIGN_EPI>
__device__ __forceinline__ void gemm_phase(LAS unsigned char* lds, const Sched& S, const Epi& E) {
    int tid_o = threadIdx.x; asm volatile("" : "+v"(tid_o));
    const int tid = tid_o, wid = __builtin_amdgcn_readfirstlane(tid >> 6), lane = tid & 63, wr = wid >> 2, wc = wid & 3; int fr = lane & 15, fq = lane >> 4;
    int sR[2], sC[2], sRb[2];
#pragma unroll
    for (int i = 0; i < 2; ++i) { stage_rc(tid * 16 + i * 8192, sR[i], sC[i]); sRb[i] = Epi::PERM ? ((sR[i] & ~31) + perm32(sR[i] & 31)) : sR[i]; sC[i] *= 2; }
    const size_t kstep = (size_t)(BK * 2);
    const unsigned ldsw = (unsigned)wid * 1024u;
    const int aoff = lds_byte(wr * 64 + fr, fq * 8), boff = lds_byte(wc * 32 + fr, fq * 8);
#define PG8_SA(b, h) (((b) * 2 + (h)) * HTB)
#define PG8_SB(b, h) ((4 + (b) * 2 + (h)) * HTB)
#define PG8_STAGE(bufoff, gbase, rows, ld) do { _Pragma("unroll") for (int _i = 0; _i < 2; ++_i) \
        __builtin_amdgcn_global_load_lds((const unsigned*)((const char*)(gbase) + (unsigned)((rows)[_i] * (ld) + sC[_i])), (LAS unsigned*)(lds + (bufoff) + ldsw + _i * 8192), 16, 0, 0); } while (0)
#define PG8_LDA(dst, b, h) do { _Pragma("unroll") for (int m = 0; m < 4; ++m) _Pragma("unroll") for (int k = 0; k < 2; ++k) dst[m][k] = *(const LAS bf16x8*)(lds + PG8_SA(b, h) + aoff + m * 2048 + k * 1024); } while (0)
#define PG8_LDB(dst, b, h) do { _Pragma("unroll") for (int n = 0; n < 2; ++n) _Pragma("unroll") for (int k = 0; k < 2; ++k) dst[n][k] = *(const LAS bf16x8*)(lds + PG8_SB(b, h) + boff + n * 2048 + k * 1024); } while (0)
#define PG8_MMA(ai, bj, At, Bt) do { __builtin_amdgcn_s_setprio(1); _Pragma("unroll") for (int m = 0; m < 4; ++m) _Pragma("unroll") for (int n = 0; n < 2; ++n) _Pragma("unroll") for (int k = 0; k < 2; ++k) \
        acc[ai][bj][m][n] = __builtin_amdgcn_mfma_f32_16x16x32_bf16(Bt[n][k], At[m][k], acc[ai][bj][m][n], 0, 0, 0); __builtin_amdgcn_s_setprio(0); } while (0)
#define PG8_WAIT_V(n) asm volatile("s_waitcnt vmcnt(" #n ")" ::: "memory")
#define PG8_WAIT_L(n) asm volatile("s_waitcnt lgkmcnt(" #n ")" ::: "memory")
#define PG8_BAR __builtin_amdgcn_s_barrier()
#define PG8_SCHED __builtin_amdgcn_sched_barrier(0)
    GUnit cur, nxt; int ui = 0;
    if (!S.next(0, cur)) return;
    f32x4 acc[2][2][4][2];
#pragma unroll
    for (int a = 0; a < 2; ++a)
#pragma unroll
        for (int b = 0; b < 2; ++b)
#pragma unroll
            for (int m = 0; m < 4; ++m)
#pragma unroll
                for (int n = 0; n < 2; ++n) acc[a][b][m][n] = (f32x4){0.f, 0.f, 0.f, 0.f};
    bf16x8 At[4][2], B0[2][2], B1[2][2];
    int ldAc = cur.lda, ldBc = cur.ldb; size_t hAc = (size_t)HALF * ldAc, hBc = (size_t)HALF * ldBc;
    const char* cA = cur.A; const char* cB = cur.B;
    PG8_STAGE(PG8_SB(0, 0), cB, sRb, ldBc); PG8_STAGE(PG8_SB(0, 1), cB + hBc, sRb, ldBc); PG8_STAGE(PG8_SA(0, 0), cA, sR, ldAc); PG8_STAGE(PG8_SA(0, 1), cA + hAc, sR, ldAc);
    if (wr == 1) PG8_BAR;
    PG8_WAIT_V(2); PG8_BAR;
    PG8_STAGE(PG8_SB(1, 0), cB + kstep, sRb, ldBc); PG8_STAGE(PG8_SA(1, 0), cA + kstep, sR, ldAc); PG8_STAGE(PG8_SB(1, 1), cB + hBc + kstep, sRb, ldBc);
    PG8_WAIT_V(6); PG8_BAR;
    for (;;) {
        const bool has_next = S.next(ui + 1, nxt);
        int ldAn, ldBn; const char* nA; const char* nB;
        if (has_next) { ldAn = nxt.lda; ldBn = nxt.ldb; nA = nxt.A; nB = nxt.B; } else { ldAn = ldAc; ldBn = ldBc; nA = cA; nB = cB; }
        const size_t hAn = (size_t)HALF * ldAn, hBn = (size_t)HALF * ldBn;
        int nt = cur.nt; asm volatile("" : "+s"(nt));
        for (int t = 0; t < nt; t += 2) {
            const bool last = (t == nt - 2);
            const char* a1 = cA + (size_t)(t + 1) * kstep;
            const char* a2 = last ? nA : cA + (size_t)(t + 2) * kstep; const char* b2 = last ? nB : cB + (size_t)(t + 2) * kstep;
            const char* a3 = a2 + kstep; const char* b3 = b2 + kstep;
            const int ldA2 = last ? ldAn : ldAc, ldB2 = last ? ldBn : ldBc;
            const size_t hA2 = last ? hAn : hAc, hB2 = last ? hBn : hBc;
            PG8_LDB(B0, 0, 0); PG8_LDB(B1, 0, 1); PG8_SCHED; PG8_LDA(At, 0, 0); PG8_STAGE(PG8_SA(1, 1), a1 + hAc, sR, ldAc);
            PG8_WAIT_V(8); PG8_WAIT_L(0); PG8_BAR; PG8_MMA(0, 0, At, B0); PG8_MMA(0, 1, At, B1); PG8_BAR; PG8_SCHED;
            PG8_LDA(At, 0, 1); PG8_STAGE(PG8_SB(0, 0), b2, sRb, ldB2); PG8_STAGE(PG8_SB(0, 1), b2 + hB2, sRb, ldB2); PG8_STAGE(PG8_SA(0, 0), a2, sR, ldA2);
            PG8_WAIT_V(8); PG8_WAIT_L(0); PG8_BAR; PG8_MMA(1, 0, At, B0); PG8_MMA(1, 1, At, B1); PG8_BAR; PG8_SCHED;
            PG8_LDB(B0, 1, 0); PG8_LDB(B1, 1, 1); PG8_SCHED; PG8_LDA(At, 1, 0); PG8_STAGE(PG8_SA(0, 1), a2 + hA2, sR, ldA2);
            PG8_WAIT_V(8); PG8_WAIT_L(0); PG8_BAR; PG8_MMA(0, 0, At, B0); PG8_MMA(0, 1, At, B1); PG8_BAR; PG8_SCHED;
            PG8_LDA(At, 1, 1); PG8_STAGE(PG8_SB(1, 0), b3, sRb, ldB2); PG8_STAGE(PG8_SB(1, 1), b3 + hB2, sRb, ldB2); PG8_STAGE(PG8_SA(1, 0), a3, sR, ldA2);
            PG8_WAIT_V(8); PG8_WAIT_L(0); PG8_BAR; PG8_MMA(1, 0, At, B0); PG8_MMA(1, 1, At, B1); PG8_BAR; PG8_SCHED;
        }
        if constexpr (ALIGN_EPI) { if (wr == 0) PG8_BAR; }
        E(acc, cur, wr, wc, fr, fq);
        if (!has_next) break;
#pragma unroll
        for (int a = 0; a < 2; ++a)
#pragma unroll
            for (int b = 0; b < 2; ++b)
#pragma unroll
                for (int m = 0; m < 4; ++m)
#pragma unroll
                    for (int n = 0; n < 2; ++n) acc[a][b][m][n] = (f32x4){0.f, 0.f, 0.f, 0.f};
        cur = nxt; cA = nA; cB = nB; ++ui;
        ldAc = ldAn; ldBc = ldBn; hAc = hAn; hBc = hBn;
        if constexpr (ALIGN_EPI) { if (wr == 1) PG8_BAR; }
    }
    PG8_WAIT_V(0);
    if constexpr (!ALIGN_EPI) { if (wr == 0) PG8_BAR; }
    PG8_BAR;
#undef PG8_SA
#undef PG8_SB
#undef PG8_STAGE
#undef PG8_LDA
#undef PG8_LDB
#undef PG8_MMA
#undef PG8_WAIT_V
#undef PG8_WAIT_L
#undef PG8_BAR
#undef PG8_SCHED
}
}
using pg8::GUnit;
namespace pg8 {
#define EPI_OPAQUE() asm volatile("" : "+v"(fr), "+v"(fq))
struct EpiBf16 {
    static constexpr bool PERM = true;
    bf16_t* O; int ldc;
    __device__ __forceinline__ void operator()(const f32x4 (&acc)[2][2][4][2], const GUnit& u, int wr, int wc, int fr, int fq) const {
        EPI_OPAQUE();
        const int row0 = u.pm * BM + wr * 64 + fr, col0 = u.pn * BM + wc * 32 + 8 * fq;
#pragma unroll
        for (int ai = 0; ai < 2; ++ai)
#pragma unroll
            for (int m = 0; m < 4; ++m) { bf16_t* rowp = O + (size_t)(row0 + ai * HALF + m * 16) * ldc + col0;
#pragma unroll
                for (int bj = 0; bj < 2; ++bj) { const f32x4 v0 = acc[ai][bj][m][0], v1 = acc[ai][bj][m][1];
                    u32x4 w; w.x = cvtpk(v0[0], v0[1]); w.y = cvtpk(v0[2], v0[3]); w.z = cvtpk(v1[0], v1[1]); w.w = cvtpk(v1[2], v1[3]);
                    *(u32x4*)(rowp + bj * HALF) = w; } }
    }
};
struct EpiF32 {
    static constexpr bool PERM = false;
    float* O; int ldc;
    __device__ __forceinline__ void operator()(const f32x4 (&acc)[2][2][4][2], const GUnit& u, int wr, int wc, int fr, int fq) const {
        EPI_OPAQUE();
        const int row0 = u.pm * BM + wr * 64 + fr, col0 = u.pn * BM + wc * 32 + 4 * fq;
#pragma unroll
        for (int ai = 0; ai < 2; ++ai)
#pragma unroll
            for (int m = 0; m < 4; ++m) { float* rowp = O + (size_t)(row0 + ai * HALF + m * 16) * ldc + col0;
#pragma unroll
                for (int bj = 0; bj < 2; ++bj)
#pragma unroll
                    for (int n = 0; n < 2; ++n) *(f32x4*)(rowp + bj * HALF + n * 16) = acc[ai][bj][m][n]; }
    }
};
__device__ __forceinline__ void rope8(f32x4& v0, f32x4& v1, const float* cs  ) {
    const f32x4 a = *(const f32x4*)cs, b = *(const f32x4*)(cs + 4);
    f32x4 r0, r1;
    r0[0] = v0[0] * a[0] - v0[1] * a[1]; r0[1] = v0[1] * a[0] + v0[0] * a[1];
    r0[2] = v0[2] * a[2] - v0[3] * a[3]; r0[3] = v0[3] * a[2] + v0[2] * a[3];
    r1[0] = v1[0] * b[0] - v1[1] * b[1]; r1[1] = v1[1] * b[0] + v1[0] * b[1];
    r1[2] = v1[2] * b[2] - v1[3] * b[3]; r1[3] = v1[3] * b[2] + v1[2] * b[3];
    v0 = r0; v1 = r1;
}
struct EpiInProj {
    static constexpr bool PERM = true;
    bf16_t* P; bf16_t* kcmp; bf16_t* vcmp; float* side; bf16_t* krot; const float* rope; float* ssq_q; float* ssq_kv; const float* fbias; float* lf;
    __device__ __forceinline__ void operator()(const f32x4 (&acc)[2][2][4][2], const GUnit& u, int wr, int wc, int fr, int fq) const {
        EPI_OPAQUE();
        const int row0 = u.pm * BM + wr * 64 + fr, col0 = u.pn * BM + wc * 32 + 8 * fq;
#pragma unroll
        for (int ai = 0; ai < 2; ++ai)
#pragma unroll
            for (int m = 0; m < 4; ++m) { const int row = row0 + ai * HALF + m * 16; bf16_t* rowp = P + (size_t)row * PW + col0;
                float ssq = 0.f;
#pragma unroll
                for (int bj = 0; bj < 2; ++bj) { f32x4 v0 = acc[ai][bj][m][0], v1 = acc[ai][bj][m][1];
                    if (u.pn == 2 && bj == 1) {
                        if (wc == 0 && fq < 2) { float* sp = side + (size_t)row * 16 + 8 * fq; *(f32x4*)sp = v0; *(f32x4*)(sp + 4) = v1;
                            if (fq == 1) { const f32x4 fb = *(const f32x4*)fbias; f32x4 s1;
#pragma unroll
                                for (int e = 0; e < 4; ++e) { const float x = v1[e] + fb[e]; s1[e] = (x >= 0.f) ? -log1pf(expf(-x)) : (x - log1pf(expf(x))); }
                                *(f32x4*)(lf + (size_t)row * 4) = s1; } }
                        if (wc == 1) { rope8(v0, v1, rope + (size_t)(row & (SEQ - 1)) * 32 + 8 * fq);
                            u32x4 w; w.x = cvtpk(v0[0], v0[1]); w.y = cvtpk(v0[2], v0[3]); w.z = cvtpk(v1[0], v1[1]); w.w = cvtpk(v1[2], v1[3]);
                            *(u32x4*)(krot + (size_t)row * 32 + 8 * fq) = w; }
                    }
                    u32x4 w; w.x = cvtpk(v0[0], v0[1]); w.y = cvtpk(v0[2], v0[3]); w.z = cvtpk(v1[0], v1[1]); w.w = cvtpk(v1[2], v1[3]);
                    *(u32x4*)(rowp + bj * HALF) = w;
                    if (u.pn == 1 && bj == 0) { bf16_t* cp = (wc < 2 ? kcmp : vcmp) + (size_t)row * 64 + (wc & 1) * 32 + 8 * fq; *(u32x4*)cp = w; }
                    if (u.pn == 11 || (u.pn == 7 && bj == 1)) ssq += (v0[0] * v0[0] + v0[1] * v0[1]) + (v0[2] * v0[2] + v0[3] * v0[3]) + (v1[0] * v1[0] + v1[1] * v1[1]) + (v1[2] * v1[2] + v1[3] * v1[3]);
                }
                if (u.pn == 11 || u.pn == 7) { ssq += xor_lane_lt32<16>(ssq); ssq = sum_halves(ssq);
                    if (fq == 0) (u.pn == 11 ? ssq_q : ssq_kv)[(size_t)row * 4 + wc] = ssq; }
                asm volatile("" ::: "memory");
            }
    }
};
struct EpiQup {
    static constexpr bool PERM = true;
    bf16_t* O; const float* ssq_q; const float* rope;
    __device__ __forceinline__ void operator()(const f32x4 (&acc)[2][2][4][2], const GUnit& u, int wr, int wc, int fr, int fq) const {
        EPI_OPAQUE();
        const int row0 = u.pm * BM + wr * 64 + fr, col0 = u.pn * BM + wc * 32 + 8 * fq;
#pragma unroll
        for (int ai = 0; ai < 2; ++ai)
#pragma unroll
            for (int m = 0; m < 4; ++m) { const int row = row0 + ai * HALF + m * 16; bf16_t* rowp = O + (size_t)row * 512 + col0;
                const f32x4 pq = *(const f32x4*)(ssq_q + (size_t)row * 4);
                const float rstd = 1.0f / sqrtf(((pq[0] + pq[1]) + (pq[2] + pq[3])) * (1.0f / 256.0f) + RMS_EPS);
#pragma unroll
                for (int bj = 0; bj < 2; ++bj) { f32x4 v0 = acc[ai][bj][m][0] * rstd, v1 = acc[ai][bj][m][1] * rstd;
                    const int c8 = col0 + bj * HALF, within = c8 % 96;
                    if (c8 < 384 && within >= 64) rope8(v0, v1, rope + (size_t)(row & (SEQ - 1)) * 32 + (within - 64));
                    u32x4 w; w.x = cvtpk(v0[0], v0[1]); w.y = cvtpk(v0[2], v0[3]); w.z = cvtpk(v1[0], v1[1]); w.w = cvtpk(v1[2], v1[3]);
                    *(u32x4*)(rowp + bj * HALF) = w; }
                asm volatile("" ::: "memory"); }
    }
};
struct EpiKVup {
    static constexpr bool PERM = true;
    bf16_t* O; const float* ssq_kv;
    __device__ __forceinline__ void operator()(const f32x4 (&acc)[2][2][4][2], const GUnit& u, int wr, int wc, int fr, int fq) const {
        EPI_OPAQUE();
        const int row0 = u.pm * BM + wr * 64 + fr, col0 = u.pn * BM + wc * 32 + 8 * fq;
#pragma unroll
        for (int ai = 0; ai < 2; ++ai)
#pragma unroll
            for (int m = 0; m < 4; ++m) { const int row = row0 + ai * HALF + m * 16; bf16_t* rowp = O + (size_t)row * 512 + col0;
                const f32x4 pq = *(const f32x4*)(ssq_kv + (size_t)row * 4);
                const float rstd = 1.0f / sqrtf(((pq[0] + pq[1]) + (pq[2] + pq[3])) * (1.0f / 128.0f) + RMS_EPS);
#pragma unroll
                for (int bj = 0; bj < 2; ++bj) { const f32x4 v0 = acc[ai][bj][m][0] * rstd, v1 = acc[ai][bj][m][1] * rstd;
                    u32x4 w; w.x = cvtpk(v0[0], v0[1]); w.y = cvtpk(v0[2], v0[3]); w.z = cvtpk(v1[0], v1[1]); w.w = cvtpk(v1[2], v1[3]);
                    *(u32x4*)(rowp + bj * HALF) = w; }
                asm volatile("" ::: "memory"); }
    }
};
__device__ __forceinline__ float gelu_tanh(float x) { const float u2 = 2.0f * 0.7978845608028654f * (x + 0.044715f * x * x * x); return x * fast_rcp(1.0f + fast_exp2(-u2 * LOG2E)); }
struct EpiCmp1 {
    static constexpr bool PERM = true;
    bf16_t* O; const float* bias1;
    __device__ __forceinline__ void operator()(const f32x4 (&acc)[2][2][4][2], const GUnit& u, int wr, int wc, int fr, int fq) const {
        EPI_OPAQUE();
        const int row0 = u.pm * BM + wr * 64 + fr, col0 = wc * 32 + 8 * fq;
        f32x4 bv[2][2];
#pragma unroll
        for (int bj = 0; bj < 2; ++bj)
#pragma unroll
            for (int n = 0; n < 2; ++n) bv[bj][n] = *(const f32x4*)(bias1 + col0 + bj * HALF + 4 * n);
#pragma unroll
        for (int ai = 0; ai < 2; ++ai)
#pragma unroll
            for (int m = 0; m < 4; ++m) { bf16_t* rowp = O + (size_t)(row0 + ai * HALF + m * 16) * 256 + col0;
#pragma unroll
                for (int bj = 0; bj < 2; ++bj) { f32x4 v0 = acc[ai][bj][m][0] + bv[bj][0], v1 = acc[ai][bj][m][1] + bv[bj][1];
#pragma unroll
                    for (int e = 0; e < 4; ++e) { v0[e] = gelu_tanh(v0[e]); v1[e] = gelu_tanh(v1[e]); }
                    u32x4 w; w.x = cvtpk(v0[0], v0[1]); w.y = cvtpk(v0[2], v0[3]); w.z = cvtpk(v1[0], v1[1]); w.w = cvtpk(v1[2], v1[3]);
                    *(u32x4*)(rowp + bj * HALF) = w; } }
    }
};
typedef __amdgpu_buffer_rsrc_t rsrc_t;
struct EpiMerge {
    static constexpr bool PERM = true;
    bf16_t* O;
    unsigned char* scr;
    __device__ __forceinline__ void operator()(const f32x4 (&acc)[2][2][4][2], const GUnit& u, int wr, int wc, int fr, int fq) const {
        EPI_OPAQUE();
        const int tid = (wr * 4 + wc) * 64 + fq * 16 + fr;
        const int sub = u.id;
        const rsrc_t rs = __builtin_amdgcn_make_buffer_rsrc(scr, 0, 524288, 0x00020000);
        if (sub < 4) {
#pragma unroll
            for (int ai = 0; ai < 2; ++ai)
#pragma unroll
                for (int bj = 0; bj < 2; ++bj)
#pragma unroll
                    for (int m = 0; m < 4; ++m)
#pragma unroll
                        for (int n = 0; n < 2; ++n) { const int q = ((ai * 2 + bj) * 4 + m) * 2 + n; const f32x4 v = acc[ai][bj][m][n];
                            u32x2 w; w.x = cvtpk(v[0], v[1]); w.y = cvtpk(v[2], v[3]);
                            __builtin_amdgcn_raw_buffer_store_b64(w, rs, tid * 8, (sub * 32 + q) * 4096, 0); }
            return;
        }
        const int j = sub - 4;
        const int row0 = u.pm * BM + wr * 64 + fr, col0 = u.pn * BM + 64 * j + wc * 16 + 4 * fq;
#pragma unroll
        for (int ai = 0; ai < 2; ++ai) {
            u32x2 sv[4][4];
#pragma unroll
            for (int m = 0; m < 4; ++m)
#pragma unroll
                for (int g = 0; g < 4; ++g) { const int qb = (ai * 16 + m * 2);
                    sv[m][g] = (j == 0) ? __builtin_amdgcn_raw_buffer_load_b64(rs, tid * 8, (g * 32 + qb) * 4096, 0)
                             : (j == 1) ? __builtin_amdgcn_raw_buffer_load_b64(rs, tid * 8, (g * 32 + qb + 1) * 4096, 0)
                             : (j == 2) ? __builtin_amdgcn_raw_buffer_load_b64(rs, tid * 8, (g * 32 + qb + 8) * 4096, 0)
                                        : __builtin_amdgcn_raw_buffer_load_b64(rs, tid * 8, (g * 32 + qb + 9) * 4096, 0); }
#pragma unroll
            for (int m = 0; m < 4; ++m) { bf16_t* rowp = O + (size_t)(row0 + ai * HALF + m * 16) * DM + col0;
                f32x4 t = {0.f, 0.f, 0.f, 0.f};
#pragma unroll
                for (int g = 0; g < 4; ++g) { const f32x4 gt = acc[ai][g >> 1][m][g & 1]; const u32x2 s = sv[m][g];
                    t[0] += sigmoid_f(gt[0]) * __uint_as_float(s.x << 16); t[1] += sigmoid_f(gt[1]) * __uint_as_float(s.x & 0xffff0000u);
                    t[2] += sigmoid_f(gt[2]) * __uint_as_float(s.y << 16); t[3] += sigmoid_f(gt[3]) * __uint_as_float(s.y & 0xffff0000u); }
                u32x2 w; w.x = cvtpk(t[0], t[1]); w.y = cvtpk(t[2], t[3]);
                *(u32x2*)rowp = w; }
            asm volatile("" ::: "memory"); }
    }
};
__device__ __forceinline__ float dpp_ror1(float v) { return __uint_as_float((unsigned)__builtin_amdgcn_update_dpp(0, (int)__float_as_uint(v), 0x121, 0xf, 0xf, false)); }
__device__ __forceinline__ float dpp_ror2(float v) { return __uint_as_float((unsigned)__builtin_amdgcn_update_dpp(0, (int)__float_as_uint(v), 0x122, 0xf, 0xf, false)); }
struct EpiUpConv {
    static constexpr bool PERM = true;
    bf16_t* ACT; float* HB; const float* cw; const float* cb;
    __device__ __forceinline__ void operator()(const f32x4 (&acc)[2][2][4][2], const GUnit& u, int wr, int wc, int fr, int fq) const {
        EPI_OPAQUE();
        const int colL = wc * 32 + 8 * fq;
#pragma unroll
        for (int n = 0; n < 2; ++n) {
            const int cl = colL + 4 * n, c0 = u.pn * 128 + cl;
            const f32x4 bg = *(const f32x4*)(cb + c0), w0g = *(const f32x4*)(cw + c0), w1g = *(const f32x4*)(cw + DFF2 + c0), w2g = *(const f32x4*)(cw + 2 * DFF2 + c0);
            const f32x4 bv = *(const f32x4*)(cb + DFF + c0), w0v = *(const f32x4*)(cw + DFF + c0), w1v = *(const f32x4*)(cw + DFF2 + DFF + c0), w2v = *(const f32x4*)(cw + 2 * DFF2 + DFF + c0);
#pragma unroll
            for (int ai = 0; ai < 2; ++ai) {
                const int rowg = u.pm * BM + ai * HALF + wr * 64, g = rowg >> 6;
                f32x4 t1g, t2g, t1v, t2v;
#pragma unroll
                for (int e = 0; e < 4; ++e) { t1g[e] = 0.f; t2g[e] = 0.f; t1v[e] = 0.f; t2v[e] = 0.f; }
#pragma unroll
                for (int m = 0; m < 4; ++m) {
                    const f32x4 cg = acc[ai][0][m][n], cv = acc[ai][1][m][n];
                    f32x4 r1g, r2g, r1v, r2v, o;
#pragma unroll
                    for (int e = 0; e < 4; ++e) { r1g[e] = dpp_ror1(cg[e]); r2g[e] = dpp_ror2(cg[e]); r1v[e] = dpp_ror1(cv[e]); r2v[e] = dpp_ror2(cv[e]); }
#pragma unroll
                    for (int e = 0; e < 4; ++e) { const float p1g = (fr == 0) ? t1g[e] : r1g[e], p2g = (fr < 2) ? t2g[e] : r2g[e], p1v = (fr == 0) ? t1v[e] : r1v[e], p2v = (fr < 2) ? t2v[e] : r2v[e];
                        const float gt = bg[e] + w0g[e] * p2g + w1g[e] * p1g + w2g[e] * cg[e], vl = bv[e] + w0v[e] * p2v + w1v[e] * p1v + w2v[e] * cv[e];
                        o[e] = gt * sigmoid_f(gt) * vl; }
                    const int row = rowg + m * 16 + fr;
                    if (!(m == 0 && fr < 2)) { u32x2 w; w.x = cvtpk(o[0], o[1]); w.y = cvtpk(o[2], o[3]); *(u32x2*)(ACT + (size_t)row * DFF + c0) = w; }
                    if (m == 0 && fr < 2) { float* hp = HB + ((size_t)((g * 4 + fr) * 22 + u.pn) * 256 + cl); *(f32x4*)hp = cg; *(f32x4*)(hp + 128) = cv; }
                    if (m == 3 && fr >= 14) { float* hp = HB + ((size_t)((g * 4 + fr - 12) * 22 + u.pn) * 256 + cl); *(f32x4*)hp = cg; *(f32x4*)(hp + 128) = cv; }
                    t1g = r1g; t2g = r2g; t1v = r1v; t2v = r2v;
                }
            }
            asm volatile("" ::: "memory");
        }
    }
};
}
#define XB_TMO      128
#define XB_XCNT(j)  (256  + 64 * (j))
#define XB_XSUB(j)  (1280 + 64 * (j))
#define XB_XGEN(j)  (2304 + 64 * (j))
#define XB_TOP      3328
#define XB_TOPGEN   3392
#define XCD_BAR_WORDS 3456
#define XB_SPIN_CAP (1u << 22)
__device__ __forceinline__ unsigned xb_ld(unsigned* p)              { return __hip_atomic_load(p, __ATOMIC_RELAXED, __HIP_MEMORY_SCOPE_AGENT); }
__device__ __forceinline__ unsigned xb_add(unsigned* p, unsigned v) { return __hip_atomic_fetch_add(p, v, __ATOMIC_RELAXED, __HIP_MEMORY_SCOPE_AGENT); }
__device__ __forceinline__ unsigned xb_xcc_id() { return (unsigned)__builtin_amdgcn_s_getreg((3 << 11) | 20) & 0xFu; }
#define XB_SPIN(cond, bar) do { unsigned _sp = 0; while (cond) { __builtin_amdgcn_s_sleep(1); \
    if ((++_sp & 255u) == 0u) { if (xb_ld(&(bar)[XB_TMO])) break; if (_sp > XB_SPIN_CAP) { atomicAdd(&(bar)[XB_TMO], 1u); break; } } } } while (0)
struct XcdBarrier { unsigned* bar; unsigned x; volatile LAS unsigned* st; };
__device__ __forceinline__ XcdBarrier xcd_barrier_post(unsigned* bar, volatile LAS unsigned* st) {
    XcdBarrier b; b.bar = bar; b.x = xb_xcc_id(); b.st = st;
    if (threadIdx.x == 0) (void)xb_add(&bar[XB_XCNT(b.x)], 1u);
    return b;
}
__device__ __forceinline__ void xcd_barrier_complete(unsigned* bar, unsigned x, unsigned& nloc, unsigned& nx) {
    const unsigned G = gridDim.x * gridDim.y * gridDim.z;
    unsigned sum, cnt, mine, sp = 0u;
    for (;;) {
        sum = 0u; cnt = 0u; mine = 0u;
#pragma unroll
        for (unsigned j = 0; j < 16; ++j) { const unsigned c = xb_ld(&bar[XB_XCNT(j)]); sum += c; cnt += (c > 0u) ? 1u : 0u; mine = (j == x) ? c : mine; }
        if (sum == G) break;
        __builtin_amdgcn_s_sleep(1);
        if ((++sp & 255u) == 0u) { if (xb_ld(&bar[XB_TMO])) break; if (sp > XB_SPIN_CAP) { atomicAdd(&bar[XB_TMO], 1u); break; } }
    }
    nloc = mine > 0u ? mine : 1u; nx = cnt > 0u ? cnt : 1u;
}
__device__ __forceinline__ void xcd_barrier(const XcdBarrier& b) {
    asm volatile("s_waitcnt vmcnt(0)" ::: "memory");
    __syncthreads();
    if (threadIdx.x == 0) {
        unsigned* bar = b.bar; unsigned bx = b.x;
        asm volatile("" : "+s"(bx));
        __builtin_amdgcn_s_waitcnt(0);
        unsigned nloc = b.st[0], nx = b.st[1];
        if (nloc == 0u) { xcd_barrier_complete(bar, bx, nloc, nx); b.st[0] = nloc; b.st[1] = nx; }
        const unsigned old = xb_add(&bar[XB_XSUB(bx)], 1u);
        const unsigned gen = old / nloc;
        if (old + 1u == (gen + 1u) * nloc) {
            __builtin_amdgcn_fence(__ATOMIC_RELEASE, "agent");
            asm volatile("s_waitcnt vmcnt(0)" ::: "memory");
            const unsigned og = xb_add(&bar[XB_TOP], 1u);
            const unsigned tg = og / nx;
            if (og + 1u == (tg + 1u) * nx) xb_add(&bar[XB_TOPGEN], 1u);
            else XB_SPIN(xb_ld(&bar[XB_TOPGEN]) == tg, bar);
            __builtin_amdgcn_fence(__ATOMIC_ACQUIRE, "agent");
            xb_add(&bar[XB_XGEN(bx)], 1u);
            asm volatile("s_waitcnt vmcnt(0)" ::: "memory");
        } else {
            XB_SPIN(xb_ld(&bar[XB_XGEN(bx)]) == gen, bar);
            __builtin_amdgcn_fence(__ATOMIC_ACQUIRE, "agent");
            asm volatile("s_waitcnt vmcnt(0)" ::: "memory");
        }
    }
    __syncthreads();
}

#define MFMA32(a, b, c) __builtin_amdgcn_mfma_f32_32x32x16_bf16(a, b, c, 0, 0, 0)
typedef short v4i16_t __attribute__((ext_vector_type(4)));
typedef LAS const char* lds_cptr;
typedef LAS char* lds_ptr;
__device__ __forceinline__ int crow(int r, int hi) { return (r & 3) + 8 * (r >> 2) + 4 * hi; }
__device__ __forceinline__ s16x4 vtr(lds_cptr p) { return __builtin_bit_cast(s16x4, __builtin_amdgcn_ds_read_tr16_b64_v4i16((LAS v4i16_t*)p)); }
__device__ __forceinline__ float other_half(float x, int hi) { auto rr = __builtin_amdgcn_permlane32_swap(__float_as_uint(x), __float_as_uint(x), false, false); return __uint_as_float(hi ? rr[0] : rr[1]); }
constexpr float NEG_INF = -INFINITY;

constexpr int TB_V = 12288, TB_KB = 20480, TB_SIZE = 20992;
struct Stg { u32x4 k, k2, v; float kb; };

template <int NKS> __device__ __forceinline__ void qk64(lds_cptr kbuf, const bf16x8* qf, int r32, int hi, f32x16& p0, f32x16& p1) {
    lds_cptr kp = kbuf + hi * 1024 + r32 * 16;
#pragma unroll
    for (int ks = 0; ks < NKS; ++ks) {
        const bf16x8 a0 = *(const LAS bf16x8*)(kp + ks * 2048), a1 = *(const LAS bf16x8*)(kp + ks * 2048 + 512);
        p0 = MFMA32(a0, qf[ks], p0); p1 = MFMA32(a1, qf[ks], p1);
    }
}
struct AState { f32x16 o0, o1; float m, l; };
__device__ __forceinline__ void astate_init(AState& s) {
#pragma unroll
    for (int r = 0; r < 16; ++r) { s.o0[r] = 0.f; s.o1[r] = 0.f; }
    s.m = NEG_INF; s.l = 0.f;
}
__device__ __forceinline__ void pv64(f32x16& o0, f32x16& o1, lds_cptr vp, const bf16x8 (&pf)[4]) {
#pragma unroll
    for (int ks = 0; ks < 4; ++ks) {
        const s16x4 l0 = vtr(vp + ks * 1024), h0 = vtr(vp + ks * 1024 + 512), l1 = vtr(vp + 4096 + ks * 1024), h1 = vtr(vp + 4096 + ks * 1024 + 512);
        const bf16x8 v0 = (bf16x8){l0[0], l0[1], l0[2], l0[3], h0[0], h0[1], h0[2], h0[3]}, v1 = (bf16x8){l1[0], l1[1], l1[2], l1[3], h1[0], h1[1], h1[2], h1[3]};
        o0 = MFMA32(v0, pf[ks], o0); o1 = MFMA32(v1, pf[ks], o1);
    }
}
__device__ __forceinline__ void pack_p(const f32x16& p0, const f32x16& p1, bf16x8 (&pf)[4]) {
    u32x4 w0, w1, w2, w3;
    w0.x = cvtpk(p0[0], p0[1]); w0.y = cvtpk(p0[2], p0[3]); w0.z = cvtpk(p0[4], p0[5]); w0.w = cvtpk(p0[6], p0[7]);
    w1.x = cvtpk(p0[8], p0[9]); w1.y = cvtpk(p0[10], p0[11]); w1.z = cvtpk(p0[12], p0[13]); w1.w = cvtpk(p0[14], p0[15]);
    w2.x = cvtpk(p1[0], p1[1]); w2.y = cvtpk(p1[2], p1[3]); w2.z = cvtpk(p1[4], p1[5]); w2.w = cvtpk(p1[6], p1[7]);
    w3.x = cvtpk(p1[8], p1[9]); w3.y = cvtpk(p1[10], p1[11]); w3.z = cvtpk(p1[12], p1[13]); w3.w = cvtpk(p1[14], p1[15]);
    pf[0] = __builtin_bit_cast(bf16x8, w0); pf[1] = __builtin_bit_cast(bf16x8, w1); pf[2] = __builtin_bit_cast(bf16x8, w2); pf[3] = __builtin_bit_cast(bf16x8, w3);
}
__device__ __forceinline__ void softmax_pv64(f32x16& p0, f32x16& p1, AState& s, lds_cptr vp, int hi) {
    float mx = fmaxf(p0[0], p1[0]);
#pragma unroll
    for (int r = 1; r < 16; ++r) mx = fmaxf(mx, fmaxf(p0[r], p1[r]));
    mx = fmaxf(mx, other_half(mx, hi));
    const float mn = fmaxf(s.m, mx), ms = (mn == NEG_INF) ? 0.f : mn;
    const float alpha = fast_exp2(s.m - ms);
    float rs = 0.f;
#pragma unroll
    for (int r = 0; r < 16; ++r) { p0[r] = fast_exp2(p0[r] - ms); p1[r] = fast_exp2(p1[r] - ms); rs += p0[r] + p1[r]; }
    rs += other_half(rs, hi);
    s.l = s.l * alpha + rs; s.m = mn;
#pragma unroll
    for (int r = 0; r < 16; ++r) { s.o0[r] *= alpha; s.o1[r] *= alpha; }
    bf16x8 pf[4]; pack_p(p0, p1, pf);
    pv64(s.o0, s.o1, vp, pf);
}
__device__ __forceinline__ void mask_causal(f32x16& p0, f32x16& p1, int kpos0, int tq, int hi) {
#pragma unroll
    for (int r = 0; r < 16; ++r) { const int kp = kpos0 + crow(r, hi); if (kp > tq) p0[r] = NEG_INF; if (kp + 32 > tq) p1[r] = NEG_INF; }
}
__device__ __forceinline__ void add_table(f32x16& p0, f32x16& p1, const LAS float* tb) {
#pragma unroll
    for (int r = 0; r < 16; ++r) { const int o = (r & 3) + 8 * (r >> 2); p0[r] += tb[o]; p1[r] += tb[o + 32]; }
}
__device__ __forceinline__ void store_o_bf16(bf16_t* orow, const f32x16& o0, const f32x16& o1, float sc, int hi) {
#pragma unroll
    for (int g = 0; g < 4; ++g) {
        u32x2 w0, w1; w0.x = cvtpk(o0[4 * g] * sc, o0[4 * g + 1] * sc); w0.y = cvtpk(o0[4 * g + 2] * sc, o0[4 * g + 3] * sc);
        w1.x = cvtpk(o1[4 * g] * sc, o1[4 * g + 1] * sc); w1.y = cvtpk(o1[4 * g + 2] * sc, o1[4 * g + 3] * sc);
        *(u32x2*)(orow + 8 * g + 4 * hi) = w0; *(u32x2*)(orow + 32 + 8 * g + 4 * hi) = w1;
    }
}
constexpr size_t MiB = 1u << 20, KiB = 1u << 10;
constexpr size_t WS_CTL = 0, CTL_ZERO_BYTES = 1 * MiB;
constexpr size_t WS_ROPE = 1 * MiB, WS_NSATAB = WS_ROPE + 512 * KiB, WS_DILTAB = WS_NSATAB + 32 * KiB, WS_CMPB = WS_DILTAB + 8 * KiB, WS_FARB = WS_CMPB + 4 * KiB;
constexpr size_t WS_WT = 4 * MiB, LW = 38 * MiB;
constexpr size_t LW_IN = 0, LW_G = 6 * MiB, LW_BR = 14 * MiB, LW_O = 16 * MiB, LW_UP = 18 * MiB, LW_DN = 29 * MiB, LW_UQ = 35 * MiB, LW_UKV = 35 * MiB + 256 * KiB, LW_PHI = 36 * MiB;
constexpr size_t BR_A = 0, BR_B = 512 * KiB, BR_C = 768 * KiB, BR_D = 1280 * KiB;
constexpr size_t WS_SIDE = 80 * MiB, WS_SSQQ = 84 * MiB, WS_SSQKV = 85 * MiB, WS_KB = 86 * MiB, WS_KROT = 87 * MiB, WS_KCMP = 91 * MiB, WS_VCMP = 100 * MiB,
                 WS_HID = 109 * MiB, WS_KMAX = 3 * MiB + 128 * KiB  , WS_LF = 2 * MiB  , WS_CMPP = 3 * MiB  , WS_ORDER = 3 * MiB + 64 * KiB  , WS_KC = 113 * MiB, WS_VC = 113 * MiB + 512 * KiB, WS_DLSE = 114 * MiB, WS_DOG = 116 * MiB;
constexpr size_t WS_H = 164 * MiB, WS_OCAT = 292 * MiB, WS_QM = 404 * MiB, WS_KVM = 468 * MiB, WS_P = 532 * MiB;
constexpr size_t WS_MERGED = 532 * MiB, WS_MSCR = 660 * MiB, WS_Y = 164 * MiB  , WS_H2 = 756 * MiB, WS_ACT = 164 * MiB  , WS_HB = 532 * MiB  , WS_Y2 = 884 * MiB  , WS_END = 1024 * MiB;
constexpr size_t MSCR_PER_WG = 512 * KiB;
static_assert(WS_WT + 2 * LW <= WS_SIDE && WS_DOG + 48 * MiB <= WS_H && WS_P + 384 * MiB <= WS_END && WS_MSCR + 256 * MSCR_PER_WG <= WS_P + 384 * MiB && WS_H2 + 128 * MiB <= WS_Y2 && WS_Y2 + 128 * MiB <= WS_END, "ws map");
static_assert(WS_ACT + 352 * MiB <= WS_HB && WS_HB + 96 * MiB <= WS_H2 && WS_Y + 128 * MiB <= WS_OCAT, "ws overlays");
constexpr int CW_BAR = 4096;
constexpr int CW_KMAX = 24576;
constexpr int CW_Q = 16384;

constexpr int RING_BYTES = 131072, LDSCTL_OFF = RING_BYTES, MISC_OFF = LDSCTL_OFF + 320, LDS_BYTES = 147456;
constexpr int NSA_SLAB = 49152, NSA_SLAB_BYTES = 4 * 64 * 65 * 4, NSA_SEL = NSA_SLAB + NSA_SLAB_BYTES;
static_assert(NSA_SEL + 512 <= RING_BYTES && 4 * NSA_TL * 4 <= NSA_SLAB_BYTES && 2 * TB_SIZE <= NSA_SLAB, "NSA LDS map");

struct Frame {
    LAS unsigned char* lds; volatile LAS unsigned* MISC; gu32* ctl;
    int tid, lane, wave, G;
    const float* in[27]; float* out; unsigned char* ws;
};
#define WSP(T, off) ((T*)(F.ws + (off)))
#define VM_WAIT() asm volatile("s_waitcnt vmcnt(0)" ::: "memory")
#define LDS_WAIT() asm volatile("s_waitcnt lgkmcnt(0)" ::: "memory")

__device__ __forceinline__ int queue_grab(Frame& F, gu32* ctr) {
    if (F.tid == 0) F.MISC[0] = __hip_atomic_fetch_add(ctr, 1u, __ATOMIC_RELAXED, __HIP_MEMORY_SCOPE_AGENT);
    __syncthreads();
    const int v = (int)F.MISC[0];
    __syncthreads();
    return v;
}

template <bool FOX> __device__ __forceinline__ void causal_unit(Frame& F, int b, int h, int qb, float kmax_in) {
    constexpr int NKS = FOX ? 4 : 6;
    int lane_o = F.lane; asm volatile("" : "+v"(lane_o));
    const int wid = F.wave, lane = lane_o, r32 = lane & 31, hi = lane >> 5;
    const size_t rowbase = (size_t)b * SEQ;
    const int q0 = qb * 256, tq = q0 + wid * 32 + r32, NT = qb * 4 + 4;
    const bf16_t* P = WSP(const bf16_t, WS_P);
    const bf16_t *Kb, *Vb, *Qrow; int kpitch, vpitch;
    const bf16_t* Kr = WSP(const bf16_t, WS_KROT) + rowbase * 32;
    const float* kbsrc = WSP(const float, WS_KB) + (size_t)(b * 4 + h) * SEQ;
    if (FOX) { Kb = P + rowbase * PW + PC_CK + h * 64; Vb = P + rowbase * PW + PC_CV + h * 64; kpitch = PW; vpitch = PW; Qrow = P + (rowbase + tq) * PW + PC_CQ + h * 64; }
    else { const bf16_t* KV = WSP(const bf16_t, WS_KVM) + rowbase * 512 + h * 128; Kb = KV; Vb = KV + 64; kpitch = 512; vpitch = 512; Qrow = WSP(const bf16_t, WS_QM) + (rowbase + tq) * 512 + h * 96; }
    bf16x8 qf[NKS];
#pragma unroll
    for (int ks = 0; ks < NKS; ++ks) qf[ks] = *(const bf16x8*)(Qrow + ks * 16 + hi * 8);
    AState st; astate_init(st);
    lds_ptr lds = (lds_ptr)F.lds;
    const int vpo = ((lane >> 4) & 1) * 32 + (lane & 3) * 8 + (4 * hi + ((lane & 15) >> 2)) * 64;
    Stg s;
#define CU_LOAD(t) do { s.k = *(const u32x4*)(Kb + (size_t)((t) * 64 + lane) * kpitch + wid * 8); \
        if (!FOX) { if (wid < 4) s.k2 = *(const u32x4*)(Kr + (size_t)((t) * 64 + lane) * 32 + wid * 8); } \
        s.v = *(const u32x4*)(Vb + (size_t)((t) * 64 + 16 * (wid & 3) + (lane >> 2)) * vpitch + (wid >> 2) * 32 + (lane & 3) * 8); \
        if (FOX) { if (wid == 0) s.kb = kbsrc[(t) * 64 + lane]; } } while (0)
#define CU_WRITE(bi) do { lds_ptr bp = lds + (bi) * TB_SIZE; *(LAS u32x4*)(bp + wid * 1024 + lane * 16) = s.k; \
        if (!FOX) { if (wid < 4) *(LAS u32x4*)(bp + (8 + wid) * 1024 + lane * 16) = s.k2; } \
        *(LAS u32x4*)(bp + TB_V + wid * 1024 + lane * 16) = s.v; \
        if (FOX) { if (wid == 0) *(LAS float*)(bp + TB_KB + lane * 4) = s.kb; } } while (0)
    const int tq_lo = q0 + wid * 32;
    float qn = 0.f, kmax = 0.f;
    if (FOX) {
#pragma unroll
        for (int ks = 0; ks < NKS; ++ks)
#pragma unroll
            for (int e = 0; e < 8; ++e) { const float x = bf2f((unsigned short)qf[ks][e]); qn += x * x; }
        qn += other_half(qn, hi); qn = sqrtf(qn); kmax = kmax_in;
    }
    LAS volatile unsigned* dflag = (LAS volatile unsigned*)(lds + 2 * TB_SIZE + 64);
    const int t_first = FOX ? NT - 1 : 0, t_step = FOX ? -1 : 1;
    CU_LOAD(t_first); CU_WRITE(0);
    __syncthreads();
    for (int tt = 0; tt < NT; ++tt) {
        const int bi = tt & 1, t = t_first + tt * t_step;
        if (tt + 1 < NT) CU_LOAD(t + t_step);
        if (64 * t <= tq_lo + 31) {
            lds_cptr bp = (lds_cptr)(lds + bi * TB_SIZE);
            f32x16 p0, p1;
#pragma unroll
            for (int r = 0; r < 16; ++r) { p0[r] = 0.f; p1[r] = 0.f; }
            qk64<NKS>(bp, qf, r32, hi, p0, p1);
            if (FOX) {
                const LAS float* kbt = (const LAS float*)(bp + TB_KB) + 4 * hi;
#pragma unroll
                for (int g = 0; g < 4; ++g) { const f32x4 a = *(const LAS f32x4*)(kbt + 8 * g), c = *(const LAS f32x4*)(kbt + 32 + 8 * g);
#pragma unroll
                    for (int e = 0; e < 4; ++e) { p0[4 * g + e] += a[e]; p1[4 * g + e] += c[e]; } }
            }
            if (64 * t + 63 > tq_lo) mask_causal(p0, p1, 64 * t, tq, hi);
            softmax_pv64(p0, p1, st, bp + TB_V + vpo, hi);
        }
        if (FOX) { if (t > 0) { const float kb_last = kbsrc[64 * t - 1]; const bool done = (qn * kmax + kb_last - st.m) < -130.0f; const unsigned alld = __all(done) ? 1u : 0u; if (lane == 0) dflag[bi * 8 + wid] = alld; } }
        if (tt + 1 < NT) CU_WRITE(bi ^ 1);
        __syncthreads();
        if (FOX) { if (t > 0) { unsigned all = 1u;
#pragma unroll
                for (int w = 0; w < 8; ++w) all &= dflag[bi * 8 + w];
                if (all) break; } }
    }
#undef CU_LOAD
#undef CU_WRITE
    bf16_t* orow = WSP(bf16_t, WS_OCAT) + (rowbase + tq) * OCW + (FOX ? 384 : 640) + h * 64;
    store_o_bf16(orow, st.o0, st.o1, 1.0f / st.l, hi);
}
__device__ __forceinline__ void nsa_unit(Frame& F, int b, int qblk) {
    int lane_o = F.lane; asm volatile("" : "+v"(lane_o));
    const int wid = F.wave, lane = lane_o, r32 = lane & 31, hi = lane >> 5, tid = wid * 64 + lane;
    const int h = wid & 3, qs = wid >> 2;
    const int q0 = qblk * 64, cur = qblk, tq = q0 + 32 * qs + r32, tq_lo = q0 + 32 * qs;
    const size_t rowbase = (size_t)b * SEQ, row = rowbase + tq;
    const bf16_t* P = WSP(const bf16_t, WS_P);
    lds_ptr lds = (lds_ptr)F.lds;
    const int vpo = ((lane >> 4) & 1) * 32 + (lane & 3) * 8 + (4 * hi + ((lane & 15) >> 2)) * 64;
    bf16x8 qf[4];
    { const bf16_t* Qrow = P + row * PW + PC_AQ + h * 64;
#pragma unroll
      for (int ks = 0; ks < 4; ++ks) qf[ks] = *(const bf16x8*)(Qrow + ks * 16 + hi * 8); }
    Stg s; int ln;
#define NS_LOAD(Kb, kp, Vb, vp_, t) do { s.k = *(const u32x4*)((Kb) + (size_t)((t) * 64 + ln) * (kp) + wid * 8); \
        s.v = *(const u32x4*)((Vb) + (size_t)((t) * 64 + 16 * (wid & 3) + (ln >> 2)) * (vp_) + (wid >> 2) * 32 + (ln & 3) * 8); } while (0)
#define NS_FRESH() do { ln = lane; asm volatile("" : "+v"(ln)); } while (0)
#define NS_WRITE(bi) do { lds_ptr bp_ = lds + (bi) * TB_SIZE; *(LAS u32x4*)(bp_ + wid * 1024 + lane * 16) = s.k; *(LAS u32x4*)(bp_ + TB_V + wid * 1024 + lane * 16) = s.v; } while (0)
    const bf16_t* KC = WSP(const bf16_t, WS_KC) + (size_t)b * 256 * 64; const bf16_t* VC = WSP(const bf16_t, WS_VC) + (size_t)b * 256 * 64;
    const int cmax_u = (q0 + 63 - 31) >> 4, NTc = (cmax_u >> 6) + 1;
    const int cmax = (tq - 31) >> 4;
    float cm = NEG_INF, cl = 0.f;
    NS_FRESH(); NS_LOAD(KC, 64, VC, 64, 0); NS_WRITE(0);
    __syncthreads();
    for (int t = 0; t < NTc; ++t) {
        const int bi = t & 1;
        if (t + 1 < NTc) NS_LOAD(KC, 64, VC, 64, t + 1);
        { lds_cptr bp = (lds_cptr)(lds + bi * TB_SIZE); f32x16 p0, p1;
#pragma unroll
          for (int r = 0; r < 16; ++r) { p0[r] = 0.f; p1[r] = 0.f; }
          qk64<4>(bp, qf, r32, hi, p0, p1);
          float mx = NEG_INF;
#pragma unroll
          for (int r = 0; r < 16; ++r) { const int c = 64 * t + crow(r, hi); if (c > cmax) p0[r] = NEG_INF; if (c + 32 > cmax) p1[r] = NEG_INF; mx = fmaxf(mx, fmaxf(p0[r], p1[r])); }
          mx = fmaxf(mx, other_half(mx, hi));
          const float mn = fmaxf(cm, mx), ms = (mn == NEG_INF) ? 0.f : mn; float rs = 0.f;
#pragma unroll
          for (int r = 0; r < 16; ++r) rs += fast_exp2(p0[r] - ms) + fast_exp2(p1[r] - ms);
          rs += other_half(rs, hi);
          cl = cl * fast_exp2(cm - ms) + rs; cm = mn; }
        if (t + 1 < NTc) NS_WRITE(bi ^ 1);
        __syncthreads();
    }
    const float cms = (cm == NEG_INF) ? 0.f : cm, cinv = 1.0f / fmaxf(cl, 1e-30f);
    f32x16 oc0, oc1;
#pragma unroll
    for (int r = 0; r < 16; ++r) { oc0[r] = 0.f; oc1[r] = 0.f; }
    float G[32]; float carry = 0.f;
#pragma unroll
    for (int i = 0; i < 32; ++i) G[i] = 0.f;
    NS_FRESH(); NS_LOAD(KC, 64, VC, 64, 0); NS_WRITE(0);
    __syncthreads();
#pragma unroll
    for (int t = 0; t < 4; ++t) {
        if (t < NTc) {
            const int bi = t & 1;
            if (t + 1 < NTc) NS_LOAD(KC, 64, VC, 64, t + 1);
            { lds_cptr bp = (lds_cptr)(lds + bi * TB_SIZE); f32x16 p0, p1;
#pragma unroll
              for (int r = 0; r < 16; ++r) { p0[r] = 0.f; p1[r] = 0.f; }
              qk64<4>(bp, qf, r32, hi, p0, p1);
#pragma unroll
              for (int r = 0; r < 16; ++r) { const int c = 64 * t + crow(r, hi);
                  p0[r] = (c > cmax) ? 0.f : fast_exp2(p0[r] - cms) * cinv; p1[r] = (c + 32 > cmax) ? 0.f : fast_exp2(p1[r] - cms) * cinv; }
#pragma unroll
              for (int g = 0; g < 4; ++g) { const float oth = other_half(p0[4 * g + 3], hi);
                  G[t * 8 + g] = ((p0[4 * g] + p0[4 * g + 1]) + (p0[4 * g + 2] + p0[4 * g + 3])) + (hi ? oth : carry); carry = oth; }
#pragma unroll
              for (int g = 0; g < 4; ++g) { const float oth = other_half(p1[4 * g + 3], hi);
                  G[t * 8 + 4 + g] = ((p1[4 * g] + p1[4 * g + 1]) + (p1[4 * g + 2] + p1[4 * g + 3])) + (hi ? oth : carry); carry = oth; }
              bf16x8 pf[4]; pack_p(p0, p1, pf);
              pv64(oc0, oc1, bp + TB_V + vpo, pf); }
            if (t + 1 < NTc) NS_WRITE(bi ^ 1);
            __syncthreads();
        }
    }
    { LAS float* slab = (LAS float*)(lds + NSA_SLAB) + (size_t)(h * 64 + 32 * qs + r32) * 65;
#pragma unroll
      for (int i = 0; i < 32; ++i) slab[2 * i + hi] = G[i]; }
    __syncthreads();
    u32x4 tbr[4]; { const u32x4* src = WSP(const u32x4, WS_NSATAB);
#pragma unroll
      for (int i = 0; i < 4; ++i) { const int idx = tid + 512 * i; tbr[i] = (idx < 4 * NSA_TL / 4) ? src[idx] : (u32x4){0u, 0u, 0u, 0u}; } }
    float gl0, gl1, gl2; { const float* sd = WSP(const float, WS_SIDE) + row * 16 + h * 3; gl0 = sd[0]; gl1 = sd[1]; gl2 = sd[2]; }
    { const int q = tid >> 3, jg = tid & 7;
      const LAS float* s0 = (const LAS float*)(lds + NSA_SLAB) + (size_t)q * 65;
      float v[64];
#pragma unroll
      for (int k = 0; k < 64; ++k) { const float x = (s0[k] + s0[64 * 65 + k]) + (s0[2 * 64 * 65 + k] + s0[3 * 64 * 65 + k]);
          v[k] = (k == 0 || k == cur || k == cur - 1) ? 1e9f : ((k > cur) ? -1e9f : x); if ((k & 7) == 7) asm volatile("" ::: "memory"); }
      unsigned bits = 0u;
#pragma unroll
      for (int e = 0; e < 8; ++e) { const int j = 8 * jg + e;
          const float xj = (s0[j] + s0[64 * 65 + j]) + (s0[2 * 64 * 65 + j] + s0[3 * 64 * 65 + j]);
          const float vj = (j == 0 || j == cur || j == cur - 1) ? 1e9f : ((j > cur) ? -1e9f : xj);
          int rank = 0;
#pragma unroll
          for (int k = 0; k < 64; ++k) rank += (v[k] > vj || (v[k] == vj && k < j)) ? 1 : 0;
          bits |= (rank < 16 ? 1u : 0u) << e; }
      *((LAS unsigned char*)(lds + NSA_SEL) + q * 8 + jg) = (unsigned char)bits; }
    __syncthreads();
    const unsigned mlo = *(const LAS unsigned*)(lds + NSA_SEL + (32 * qs + r32) * 8), mhi = *(const LAS unsigned*)(lds + NSA_SEL + (32 * qs + r32) * 8 + 4);
    { LAS u32x4* dst = (LAS u32x4*)(lds + NSA_SLAB);
#pragma unroll
      for (int i = 0; i < 4; ++i) { const int idx = tid + 512 * i; if (idx < 4 * NSA_TL / 4) dst[idx] = tbr[i]; } }
    const LAS float* tabh = (const LAS float*)(lds + NSA_SLAB) + h * NSA_TL;
    const float farb = WSP(const float, WS_FARB)[h];
    const float g0 = sigmoid_f(gl0), g1 = sigmoid_f(gl1), g2 = sigmoid_f(gl2);
    AState st; astate_init(st);
    { const bf16_t* Kb = P + rowbase * PW + PC_KSLC; const bf16_t* Vb = P + rowbase * PW + PC_VSLC;
      NS_FRESH(); NS_LOAD(Kb, PW, Vb, PW, 0); NS_WRITE(0);
      __syncthreads();
      for (int j = 0; j <= cur; ++j) {
          const int bi = j & 1;
          if (j < cur) NS_LOAD(Kb, PW, Vb, PW, j + 1);
          const bool mine = ((j < 32) ? (mlo >> j) : (mhi >> (j - 32))) & 1u;
          if (__any(mine)) {
              lds_cptr bp = (lds_cptr)(lds + bi * TB_SIZE); f32x16 p0, p1;
#pragma unroll
              for (int r = 0; r < 16; ++r) { p0[r] = 0.f; p1[r] = 0.f; }
              qk64<4>(bp, qf, r32, hi, p0, p1);
              if (q0 - 64 * j - 63 >= NSA_DFAR) {
#pragma unroll
                  for (int r = 0; r < 16; ++r) { p0[r] += farb; p1[r] += farb; }
              } else add_table(p0, p1, tabh + (NSA_DMAX - tq + 64 * j + 4 * hi));
              if (j == cur) mask_causal(p0, p1, 64 * j, tq, hi);
              if (!mine) {
#pragma unroll
                  for (int r = 0; r < 16; ++r) { p0[r] = NEG_INF; p1[r] = NEG_INF; } }
              softmax_pv64(p0, p1, st, bp + TB_V + vpo, hi);
          }
          if (j < cur) NS_WRITE(bi ^ 1);
          __syncthreads();
      } }
    f32x16 oa0, oa1;
    { const float sc = g1 / st.l;
#pragma unroll
      for (int r = 0; r < 16; ++r) { oa0[r] = g0 * oc0[r] + sc * st.o0[r]; oa1[r] = g0 * oc1[r] + sc * st.o1[r]; } }
    astate_init(st);
    { const bf16_t* Kb = P + rowbase * PW + PC_KWIN; const bf16_t* Vb = P + rowbase * PW + PC_VWIN;
      const int jlo = cur >= 8 ? cur - 8 : 0;
      NS_FRESH(); NS_LOAD(Kb, PW, Vb, PW, jlo); NS_WRITE(0);
      __syncthreads();
      for (int j = jlo; j <= cur; ++j) {
          const int bi = (j - jlo) & 1;
          if (j < cur) NS_LOAD(Kb, PW, Vb, PW, j + 1);
          if (tq_lo - 64 * j - 63 < 512) {
              lds_cptr bp = (lds_cptr)(lds + bi * TB_SIZE); f32x16 p0, p1;
#pragma unroll
              for (int r = 0; r < 16; ++r) { p0[r] = 0.f; p1[r] = 0.f; }
              qk64<4>(bp, qf, r32, hi, p0, p1);
              add_table(p0, p1, tabh + (NSA_DMAX - tq + 64 * j + 4 * hi));
              if (!(tq_lo - 64 * j - 63 >= 0 && tq_lo + 31 - 64 * j < 512)) {
                  const int d0 = tq - 64 * j - 4 * hi;
#pragma unroll
                  for (int r = 0; r < 16; ++r) { const int d = d0 - ((r & 3) + 8 * (r >> 2)); if (d < 0 || d >= 512) p0[r] = NEG_INF; if (d - 32 < 0 || d - 32 >= 512) p1[r] = NEG_INF; }
              }
              softmax_pv64(p0, p1, st, bp + TB_V + vpo, hi);
          }
          if (j < cur) NS_WRITE(bi ^ 1);
          __syncthreads();
      } }
    { const float sc = g2 / st.l;
#pragma unroll
      for (int r = 0; r < 16; ++r) { oa0[r] += sc * st.o0[r]; oa1[r] += sc * st.o1[r]; } }
    { int tq_ = tq; asm volatile("" : "+v"(tq_)); store_o_bf16(WSP(bf16_t, WS_OCAT) + (rowbase + tq_) * OCW + h * 64, oa0, oa1, 1.0f, hi); }
#undef NS_LOAD
#undef NS_FRESH
#undef NS_WRITE
}
__device__ __forceinline__ void dil_unit(Frame& F, int b, int hh, int span) {
    int lane_o = F.lane; asm volatile("" : "+v"(lane_o));
    const int wid = F.wave, lane = lane_o, r32 = lane & 31, hi = lane >> 5, tid = wid * 64 + lane;
    const int T0 = span * 512;
    const size_t rowbase = (size_t)b * SEQ;
    const bf16_t* P = WSP(const bf16_t, WS_P) + rowbase * PW;
    lds_ptr lds = (lds_ptr)F.lds;
    LAS float* dtab = (LAS float*)(lds + 32768);
    for (int i = tid; i < 3 * 192; i += 512) dtab[i] = WSP(const float, WS_DILTAB)[((i / 192) * 2 + hh) * 192 + (i % 192)];
    __syncthreads();
    lds_ptr vst = lds + wid * 4096;
    const int vpo = ((lane >> 4) & 1) * 32 + (lane & 3) * 8 + (4 * hi + ((lane & 15) >> 2)) * 64;
    bf16_t* DOG = WSP(bf16_t, WS_DOG); float* DLSE = WSP(float, WS_DLSE);
    for (int g = 0; g < 3; ++g) {
        const int sh = 2 * g, head = 2 * g + hh;
        for (int rep = 0; rep < 2; ++rep) {
            const int wt = wid + 8 * rep;
            const int res = (g == 0) ? 0 : (g == 1 ? (wt & 3) : wt);
            const int i0 = (g == 0) ? 32 * wt : (g == 1 ? 32 * (wt >> 2) : 0);
            const int n0 = (T0 >> sh) + i0;
            const int tokq = res + ((n0 + r32) << sh);
            bf16x8 qf[4];
            { const bf16_t* Qrow = P + (size_t)tokq * PW + PC_BQ + head * 64;
#pragma unroll
              for (int ks = 0; ks < 4; ++ks) qf[ks] = *(const bf16x8*)(Qrow + ks * 16 + hi * 8); }
            f32x16 o0, o1; float m = NEG_INF, l = 0.f;
#pragma unroll
            for (int r = 0; r < 16; ++r) { o0[r] = 0.f; o1[r] = 0.f; }
#define DIL_LOAD(cc, KF, VR) do { const int nk0_ = n0 - 128 + 32 * (cc); int nk_ = nk0_ + r32; nk_ = nk_ < 0 ? 0 : nk_; const bf16_t* Krow_ = P + (size_t)(res + (nk_ << sh)) * PW + PC_BK + head * 64; \
        _Pragma("unroll") for (int ks = 0; ks < 4; ++ks) KF[ks] = *(const bf16x8*)(Krow_ + ks * 16 + hi * 8); \
        _Pragma("unroll") for (int i = 0; i < 4; ++i) { const int pc_ = lane + 64 * i, vrow_ = pc_ >> 3, c16_ = pc_ & 7; int nv_ = nk0_ + vrow_; nv_ = nv_ < 0 ? 0 : nv_; \
            VR[i] = *(const u32x4*)(P + (size_t)(res + (nv_ << sh)) * PW + PC_BV + head * 64 + c16_ * 8); } } while (0)
            int cfirst = 0; while (cfirst < 4 && n0 - 128 + 32 * cfirst + 31 < 0) ++cfirst;
            bf16x8 kfn[4]; u32x4 vrn[4];
            DIL_LOAD(cfirst, kfn, vrn);
            for (int c = cfirst; c < 5; ++c) {
                const int nk0 = n0 - 128 + 32 * c;
                { bf16x8 kf[4]; u32x4 vr[4];
#pragma unroll
                  for (int i = 0; i < 4; ++i) { kf[i] = kfn[i]; vr[i] = vrn[i]; }
                  if (c < 4) DIL_LOAD(c + 1, kfn, vrn);
#pragma unroll
                  for (int i = 0; i < 4; ++i) { const int pc = lane + 64 * i, vrow = pc >> 3, c16 = pc & 7;
                      *(LAS u32x4*)(vst + (c16 >> 2) * 2048 + vrow * 64 + (c16 & 3) * 16) = vr[i]; }
                  asm volatile("s_waitcnt lgkmcnt(0)" ::: "memory");
                  f32x16 p;
#pragma unroll
                  for (int r = 0; r < 16; ++r) p[r] = 0.f;
#pragma unroll
                  for (int ks = 0; ks < 4; ++ks) p = MFMA32(kf[ks], qf[ks], p);
                  const LAS float* tb = dtab + g * 192 + (32 - r32 + 4 * hi + 32 * c);
                  float mx = NEG_INF;
#pragma unroll
                  for (int r = 0; r < 16; ++r) { const int o = (r & 3) + 8 * (r >> 2), kk = o + 4 * hi, j = 128 + r32 - 32 * c - kk;
                      const bool ok = (j >= 0) && (j <= 128) && (nk0 + kk >= 0);
                      p[r] = ok ? p[r] + tb[o] : NEG_INF; mx = fmaxf(mx, p[r]); }
                  mx = fmaxf(mx, other_half(mx, hi));
                  const float mn = fmaxf(m, mx), ms = (mn == NEG_INF) ? 0.f : mn, alpha = fast_exp2(m - ms);
                  float rs = 0.f;
#pragma unroll
                  for (int r = 0; r < 16; ++r) { p[r] = fast_exp2(p[r] - ms); rs += p[r]; }
                  rs += other_half(rs, hi);
                  l = l * alpha + rs; m = mn;
#pragma unroll
                  for (int r = 0; r < 16; ++r) { o0[r] *= alpha; o1[r] *= alpha; }
                  u32x4 w0, w1;
                  w0.x = cvtpk(p[0], p[1]); w0.y = cvtpk(p[2], p[3]); w0.z = cvtpk(p[4], p[5]); w0.w = cvtpk(p[6], p[7]);
                  w1.x = cvtpk(p[8], p[9]); w1.y = cvtpk(p[10], p[11]); w1.z = cvtpk(p[12], p[13]); w1.w = cvtpk(p[14], p[15]);
                  const bf16x8 pf0 = __builtin_bit_cast(bf16x8, w0), pf1 = __builtin_bit_cast(bf16x8, w1);
                  lds_cptr vp = (lds_cptr)(vst + vpo);
#pragma unroll
                  for (int ks = 0; ks < 2; ++ks) {
                      const s16x4 l0 = vtr(vp + ks * 1024), h0 = vtr(vp + ks * 1024 + 512), l1 = vtr(vp + 2048 + ks * 1024), h1 = vtr(vp + 2048 + ks * 1024 + 512);
                      const bf16x8 v0 = (bf16x8){l0[0], l0[1], l0[2], l0[3], h0[0], h0[1], h0[2], h0[3]}, v1 = (bf16x8){l1[0], l1[1], l1[2], l1[3], h1[0], h1[1], h1[2], h1[3]};
                      o0 = MFMA32(v0, ks == 0 ? pf0 : pf1, o0); o1 = MFMA32(v1, ks == 0 ? pf0 : pf1, o1);
                  }
                  asm volatile("s_waitcnt lgkmcnt(0)" ::: "memory"); }
            }
#undef DIL_LOAD
            const size_t orow = rowbase + tokq;
            store_o_bf16(DOG + ((size_t)g * M + orow) * 128 + hh * 64, o0, o1, 1.0f / l, hi);
            if (hi == 0) DLSE[((size_t)g * M + orow) * 2 + hh] = m + log2f(l);
        }
    }
    VM_WAIT();
    __syncthreads();
    bf16_t* OC = WSP(bf16_t, WS_OCAT);
    for (int it = 0; it < 8; ++it) {
        const int item = tid + 512 * it, tl = item >> 3, pc = item & 7; const size_t orow = rowbase + T0 + tl;
        const float l0 = DLSE[((size_t)0 * M + orow) * 2 + hh], l1 = DLSE[((size_t)1 * M + orow) * 2 + hh], l2 = DLSE[((size_t)2 * M + orow) * 2 + hh];
        const float mx = fmaxf(l0, fmaxf(l1, l2)); float w0 = fast_exp2(l0 - mx), w1 = fast_exp2(l1 - mx), w2 = fast_exp2(l2 - mx);
        const float inv = 1.0f / (w0 + w1 + w2); w0 *= inv; w1 *= inv; w2 *= inv;
        const u32x4 a = *(const u32x4*)(DOG + ((size_t)0 * M + orow) * 128 + hh * 64 + pc * 8), bb = *(const u32x4*)(DOG + ((size_t)1 * M + orow) * 128 + hh * 64 + pc * 8),
                    cc = *(const u32x4*)(DOG + ((size_t)2 * M + orow) * 128 + hh * 64 + pc * 8);
        u32x4 w;
#pragma unroll
        for (int e = 0; e < 4; ++e) {
            const float lo = w0 * __uint_as_float(a[e] << 16) + w1 * __uint_as_float(bb[e] << 16) + w2 * __uint_as_float(cc[e] << 16);
            const float hv = w0 * __uint_as_float(a[e] & 0xffff0000u) + w1 * __uint_as_float(bb[e] & 0xffff0000u) + w2 * __uint_as_float(cc[e] & 0xffff0000u);
            w[e] = cvtpk(lo, hv); }
        *(u32x4*)(OC + orow * OCW + 256 + hh * 64 + pc * 8) = w;
    }
    __syncthreads();
}
__device__ __forceinline__ float wave_sum(float v) {
    v += xor_lane_lt32<1>(v); v += xor_lane_lt32<2>(v); v += xor_lane_lt32<4>(v); v += xor_lane_lt32<8>(v); v += xor_lane_lt32<16>(v);
    return sum_halves(v);
}
__device__ __forceinline__ int rel_bucket(int dist) {
    if (dist < 0) dist = 0;
    if (dist < 16) return dist;
    const int thr[15] = {22, 30, 40, 54, 73, 99, 134, 182, 246, 332, 450, 609, 825, 1117, 1513};
    int bkt = 16;
#pragma unroll
    for (int i = 0; i < 15; ++i) bkt += (dist >= thr[i]) ? 1 : 0;
    return bkt;
}
__device__ __forceinline__ int inproj_src(int c, float& sc) {
    sc = 1.f;
    if (c < 256) { sc = C2A; return c; }
    if (c < 652) return c;
    if (c < 656) return 2572 + (c - 652);
    if (c < 672) return -1;
    if (c < 704) { const int p = c - 672; return 2960 + (p >> 1) + 16 * (p & 1); }
    if (c < 768) return -1;
    if (c < 1920) { const int r = c - 768; if (r < 384) sc = C2A; return 652 + r; }
    if (c < 2048) return 2832 + (c - 1920);
    if (c < 2816) { const int r = c - 2048; if (r < 256) sc = C2A; return 1804 + r; }
    return 2576 + (c - 2816);
}
__device__ __forceinline__ int quq_src(int r, float& sc) {
    sc = C2D;
    if (r >= 384) return -1;
    const int hd = r / 96, w = r % 96;
    if (w < 64) return hd * 96 + w;
    const int p = w - 64; return hd * 96 + 64 + (p >> 1) + 16 * (p & 1);
}
__device__ __forceinline__ int gateperm_src(int r) {
    const int T = r >> 8, c = r & 255, pn = T >> 2, j = T & 3, bj = c >> 7, wc = (c >> 5) & 3, fq = (c >> 3) & 3, n = (c >> 2) & 1, e = c & 3;
    return (2 * bj + n) * DM * DM + 256 * pn + 64 * j + 16 * wc + 4 * fq + e;
}
__device__ __forceinline__ int branchperm_src(int r) {
    const int pn = r >> 8, c = r & 255, bj = c >> 7, wc = (c >> 5) & 3, fq = (c >> 3) & 3, n = (c >> 2) & 1, e = c & 3;
    return 256 * pn + 64 * (2 * bj + n) + 16 * wc + 4 * fq + e;
}
__device__ __forceinline__ int upperm_src(int r) { const int pn = r >> 8, c = r & 255; return (c & 128) ? DFF + 128 * pn + (c & 127) : 128 * pn + c; }
__device__ __forceinline__ void wconv_item(const float* W, int Nsrc, bf16_t* WT, int ldt, const float* kgain, int kind, LAS float* scr, int item, int nblk, int lane) {
    const int kb = item / nblk, nb = item % nblk, k0 = 64 * kb, n0 = 32 * nb;
    const int n = n0 + (lane & 31); float sc = 1.f; int src = n;
    if (kind == 1) src = inproj_src(n, sc); else if (kind == 2) src = quq_src(n, sc); else if (kind == 3) src = gateperm_src(n); else if (kind == 4) src = branchperm_src(n); else if (kind == 5) src = upperm_src(n);
    float wv[32];
#pragma unroll
    for (int i = 0; i < 32; ++i) { const int kk = 2 * i + (lane >> 5); wv[i] = (src >= 0) ? W[(size_t)(k0 + kk) * Nsrc + src] : 0.f; }
#pragma unroll
    for (int i = 0; i < 32; ++i) { const int kk = 2 * i + (lane >> 5); float v = wv[i] * sc; if (kgain) v *= kgain[k0 + kk]; scr[kk * 33 + (lane & 31)] = v; }
    LDS_WAIT(); asm volatile("" ::: "memory");
    const int c = lane & 7;
#pragma unroll
    for (int j = 0; j < 4; ++j) { const int nn = (lane >> 3) + 8 * j; const LAS float* s = scr + (8 * c) * 33 + nn;
        u32x4 o; o.x = pk2(s[0 * 33], s[1 * 33]); o.y = pk2(s[2 * 33], s[3 * 33]); o.z = pk2(s[4 * 33], s[5 * 33]); o.w = pk2(s[6 * 33], s[7 * 33]);
        *(u32x4*)(WT + (size_t)(n0 + nn) * ldt + k0 + 8 * c) = o; }
    LDS_WAIT(); asm volatile("" ::: "memory");
}
constexpr int ATT_UNITS = 3328;
__device__ __forceinline__ int att_cost(int id) {
    if (id < 2048) { const int qb = 15 - (id >> 7), mla = (id >> 6) & 1; return (mla ? 5 : 4) * (qb + 1); }
    if (id < 3072) return (63 - ((id - 2048) >> 4)) + 20;
    return 30;
}
__device__ __forceinline__ int clampi(int x, int lo, int hi) { return x < lo ? lo : (x > hi ? hi : x); }
__device__ __forceinline__ int att_rank(int i) {
    const int c = att_cost(i);
    int r = clampi(16 - c / 4, 0, 16) * 64 + clampi(16 - c / 5, 0, 16) * 64 + clampi(83 - c, 0, 64) * 16 + (c < 30 ? 256 : 0);
    if (c % 4 == 0 && c / 4 >= 1 && c / 4 <= 16) r += clampi(i - (16 - c / 4) * 128, 0, 64);
    if (c % 5 == 0 && c / 5 >= 1 && c / 5 <= 16) r += clampi(i - ((16 - c / 5) * 128 + 64), 0, 64);
    if (c >= 20 && c <= 83) r += clampi(i - (2048 + (63 - (c - 20)) * 16), 0, 16);
    if (c == 30) r += clampi(i - 3072, 0, 256);
    return r;
}
__device__ __forceinline__ void p0_prologue(Frame& F) {
    LAS float* scr = (LAS float*)(F.lds + F.wave * 16384);
    const int gw = blockIdx.x * 8 + F.wave, NGW = F.G * 8, lane = F.lane;
    constexpr int I_IN = 16 * 96, I_G = 16 * 32, I_BA = 4 * 32, I_BB = 2 * 32, I_O = 16 * 32, I_UP = 16 * 176, I_DN = 44 * 32, I_UQ = 4 * 16, I_UKV = 2 * 16, I_PHI = 32 * 4;
    constexpr int I_L = I_IN + 4 * I_G + 3 * I_BA + I_BB + I_O + I_UP + I_DN + I_UQ + I_UKV + 2 * I_PHI;
    for (int it = gw; it < DEPTH * I_L; it += NGW) {
        const int l = it / I_L; int r = it % I_L;
        unsigned char* wl = F.ws + WS_WT + (size_t)l * LW;
        if (r < I_IN) { wconv_item(F.in[6] + (size_t)l * DM * DIN, DIN, (bf16_t*)(wl + LW_IN), DM, nullptr, 1, scr, r, 96, lane); continue; } r -= I_IN;
        if (r < 4 * I_G) { wconv_item(F.in[21] + (size_t)l * 4 * DM * DM, DM, (bf16_t*)(wl + LW_G), DM, nullptr, 3, scr, r, 128, lane); continue; } r -= 4 * I_G;
        if (r < I_BA) { wconv_item(F.in[17] + (size_t)l * 256 * DM, DM, (bf16_t*)(wl + LW_BR + BR_A), 256, nullptr, 4, scr, r, 32, lane); continue; } r -= I_BA;
        if (r < I_BB) { wconv_item(F.in[18] + (size_t)l * 128 * DM, DM, (bf16_t*)(wl + LW_BR + BR_B), 128, nullptr, 4, scr, r, 32, lane); continue; } r -= I_BB;
        if (r < I_BA) { wconv_item(F.in[19] + (size_t)l * 256 * DM, DM, (bf16_t*)(wl + LW_BR + BR_C), 256, nullptr, 4, scr, r, 32, lane); continue; } r -= I_BA;
        if (r < I_BA) { wconv_item(F.in[20] + (size_t)l * 256 * DM, DM, (bf16_t*)(wl + LW_BR + BR_D), 256, nullptr, 4, scr, r, 32, lane); continue; } r -= I_BA;
        if (r < I_O) { wconv_item(F.in[22] + (size_t)l * DM * DM, DM, (bf16_t*)(wl + LW_O), DM, nullptr, 0, scr, r, 32, lane); continue; } r -= I_O;
        if (r < I_UP) { wconv_item(F.in[23] + (size_t)l * DM * DFF2, DFF2, (bf16_t*)(wl + LW_UP), DM, nullptr, 5, scr, r, 176, lane); continue; } r -= I_UP;
        if (r < I_DN) { wconv_item(F.in[26] + (size_t)l * DFF * DM, DM, (bf16_t*)(wl + LW_DN), DFF, nullptr, 0, scr, r, 32, lane); continue; } r -= I_DN;
        if (r < I_UQ) { wconv_item(F.in[15] + (size_t)l * 256 * 384, 384, (bf16_t*)(wl + LW_UQ), 256, F.in[13] + l * 256, 2, scr, r, 16, lane); continue; } r -= I_UQ;
        if (r < I_UKV) { wconv_item(F.in[16] + (size_t)l * 128 * 512, 512, (bf16_t*)(wl + LW_UKV), 128, F.in[14] + l * 128, 0, scr, r, 16, lane); continue; } r -= I_UKV;
        if (r < I_PHI) { wconv_item(F.in[8] + (size_t)l * 2048 * 128, 128, (bf16_t*)(wl + LW_PHI), 2048, nullptr, 0, scr, r, 4, lane); continue; } r -= I_PHI;
        wconv_item(F.in[10] + (size_t)l * 2048 * 128, 128, (bf16_t*)(wl + LW_PHI) + (size_t)128 * 2048, 2048, nullptr, 0, scr, r, 4, lane);
    }
    const int gt = blockIdx.x * 512 + F.tid, NGT = F.G * 512;
    const float* rel = F.in[1];
    float* rope = WSP(float, WS_ROPE);
    for (int i = gt; i < SEQ * 16; i += NGT) { const int t = i >> 4, k = i & 15; const float inv = powf(10000.0f, -(float)(2 * k) / 32.0f); const float ang = (float)t * inv;
        float sn, cs; sincosf(ang, &sn, &cs); rope[2 * i] = cs; rope[2 * i + 1] = sn; }
    float* ntab = WSP(float, WS_NSATAB);
    for (int i = gt; i < 4 * NSA_TL; i += NGT) { const int hd = i / NSA_TL, k = i % NSA_TL, dist = NSA_DMAX - k; ntab[i] = dist >= 0 ? rel[rel_bucket(dist) * 10 + hd] * LOG2E : 0.f; }
    float* dtab = WSP(float, WS_DILTAB);
    for (int i = gt; i < 6 * 192; i += NGT) { const int gh = i / 192, k = i % 192, g = gh >> 1, hh = gh & 1, j = 160 - k; dtab[i] = (j >= 0 && j <= 128) ? rel[rel_bucket(j << (2 * g)) * 10 + 4 + 2 * g + hh] * LOG2E : 0.f; }
    if (gt < 4) WSP(float, WS_FARB)[gt] = rel[31 * 10 + gt] * LOG2E;
    if (gw < 128) { const int mi = gw >> 5, pc = gw & 31, l = mi >> 1; const float *pk1 = F.in[8], *pv1 = F.in[10]; asm volatile("" : "+s"(pk1), "+s"(pv1));
        const float* w1 = ((mi & 1) ? pv1 : pk1) + (size_t)l * 2048 * 128 + (size_t)(64 * pc) * 128 + 2 * lane; const float* cp = F.in[7] + (size_t)l * 2048 + 64 * pc;
        f32x2 a = {0.f, 0.f};
#pragma unroll 8
        for (int p = 0; p < 64; ++p) { const f32x2 w = *(const f32x2*)(w1 + (size_t)p * 128); const float cpp = cp[p]; a[0] += cpp * w[0]; a[1] += cpp * w[1]; }
        *(f32x2*)(WSP(float, WS_CMPP) + ((size_t)mi * 32 + pc) * 128 + 2 * lane) = a; }
    if (gt < ATT_UNITS) WSP(int, WS_ORDER)[att_rank(gt)] = gt;
}
__device__ __forceinline__ void cmpb_reduce(Frame& F) {
    const int i = F.tid; if (i < DEPTH * 256) { const int l = i >> 8, n = i & 255, mi = l * 2 + (n >> 7); const float* pp = WSP(const float, WS_CMPP) + (size_t)mi * 32 * 128 + (n & 127); float a = 0.f;
        for (int pc = 0; pc < 32; ++pc) a += pp[pc * 128]; WSP(float, WS_CMPB)[i] = a; }
}

template <int MODE> __device__ __forceinline__ void rowpass(Frame& F, const float* x, const bf16_t* y, size_t yrow0, float* xout, bf16_t* hout, const float* g1, const float* g2, int row_lo, int row_hi) {
    int gw = blockIdx.x * 8 + F.wave; asm volatile("" : "+s"(gw));
    const int NGW = F.G * 8, lane = F.lane;
    f32x4 ga[4], gb[4];
#pragma unroll
    for (int j = 0; j < 4; ++j) { ga[j] = *(const f32x4*)(g1 + 4 * lane + 256 * j); if (MODE == 1) gb[j] = *(const f32x4*)(g2 + 4 * lane + 256 * j); }
    for (int m = row_lo + gw; m < row_hi; m += NGW) {
        f32x4 v[4];
        const f32x4* xr = (const f32x4*)(x + (size_t)m * DM) + lane;
#pragma unroll
        for (int j = 0; j < 4; ++j) v[j] = xr[64 * j];
        if (MODE != 0) {
            const u32x2* yr = (const u32x2*)(y + ((size_t)m - yrow0) * DM) + lane; f32x4 w[4]; float s = 0.f;
#pragma unroll
            for (int j = 0; j < 4; ++j) { const u32x2 yy = yr[64 * j]; w[j][0] = __uint_as_float(yy.x << 16); w[j][1] = __uint_as_float(yy.x & 0xffff0000u); w[j][2] = __uint_as_float(yy.y << 16); w[j][3] = __uint_as_float(yy.y & 0xffff0000u);
                s += (w[j][0] * w[j][0] + w[j][1] * w[j][1]) + (w[j][2] * w[j][2] + w[j][3] * w[j][3]); }
            const float rstd = 1.0f / sqrtf(wave_sum(s) * (1.0f / DM) + RMS_EPS);
            f32x4* xo = (f32x4*)(xout + (size_t)m * DM) + lane;
#pragma unroll
            for (int j = 0; j < 4; ++j) { v[j] = v[j] + w[j] * rstd * ga[j]; xo[64 * j] = v[j]; }
        }
        if (MODE != 2) {
            float s = 0.f;
#pragma unroll
            for (int j = 0; j < 4; ++j) s += (v[j][0] * v[j][0] + v[j][1] * v[j][1]) + (v[j][2] * v[j][2] + v[j][3] * v[j][3]);
            const float rstd = 1.0f / sqrtf(wave_sum(s) * (1.0f / DM) + RMS_EPS);
            u32x2* ho = (u32x2*)(hout + (size_t)m * DM) + lane;
#pragma unroll
            for (int j = 0; j < 4; ++j) { const f32x4 gg = (MODE == 1) ? gb[j] : ga[j]; const f32x4 o = v[j] * rstd * gg; u32x2 w; w.x = cvtpk(o[0], o[1]); w.y = cvtpk(o[2], o[3]); ho[64 * j] = w; }
        }
    }
}

__device__ __forceinline__ void ffn_fix_panel(Frame& F, int pm, const float* HB, bf16_t* ACT, const float* cw, const float* cb) {
#pragma unroll 2
    for (int it = F.tid; it < 4 * 2 * (DFF / 4); it += 512) {
        const int c4 = it % (DFF / 4), rr = (it / (DFF / 4)) & 1, g = pm * 4 + it / (2 * (DFF / 4)), c = c4 * 4, pn = c >> 7, cl = c & 127;
        const bool first = ((g * 64) & (SEQ - 1)) == 0;
#define HBV(gg, s, bj) (*(const f32x4*)(HB + ((size_t)(((gg) * 4 + (s)) * 22 + pn) * 256 + (bj) * 128 + cl)))
        const f32x4 z = {0.f, 0.f, 0.f, 0.f};
        const f32x4 u0g = HBV(g, 0, 0), u0v = HBV(g, 0, 1);
        f32x4 ag, bg_, cg, av, bv_, cv;
        if (rr == 0) { ag = first ? z : HBV(g - 1, 2, 0); bg_ = first ? z : HBV(g - 1, 3, 0); cg = u0g; av = first ? z : HBV(g - 1, 2, 1); bv_ = first ? z : HBV(g - 1, 3, 1); cv = u0v; }
        else { ag = first ? z : HBV(g - 1, 3, 0); bg_ = u0g; cg = HBV(g, 1, 0); av = first ? z : HBV(g - 1, 3, 1); bv_ = u0v; cv = HBV(g, 1, 1); }
#undef HBV
        const f32x4 kb = *(const f32x4*)(cb + c), k0 = *(const f32x4*)(cw + c), k1 = *(const f32x4*)(cw + DFF2 + c), k2 = *(const f32x4*)(cw + 2 * DFF2 + c);
        const f32x4 vb = *(const f32x4*)(cb + DFF + c), v0 = *(const f32x4*)(cw + DFF + c), v1 = *(const f32x4*)(cw + DFF2 + DFF + c), v2 = *(const f32x4*)(cw + 2 * DFF2 + DFF + c);
        float o[4];
#pragma unroll
        for (int e = 0; e < 4; ++e) { const float gt = kb[e] + k0[e] * ag[e] + k1[e] * bg_[e] + k2[e] * cg[e], vl = vb[e] + v0[e] * av[e] + v1[e] * bv_[e] + v2[e] * cv[e]; o[e] = gt * sigmoid_f(gt) * vl; }
        u32x2 w; w.x = cvtpk(o[0], o[1]); w.y = cvtpk(o[2], o[3]);
        *(u32x2*)(ACT + (size_t)(g * 64 + rr) * DFF + c) = w;
    }
}
#ifdef SELFCHECK
constexpr int CW_CHK = 20480;
__device__ __forceinline__ unsigned chk_hash(unsigned x) { x ^= x >> 16; x *= 0x7feb352du; x ^= x >> 15; x *= 0x846ca68bu; x ^= x >> 16; return x; }
__device__ __forceinline__ int chk_t(int i) {
    int r = 0;
    switch (i & 31) { case 0: r = 0; break; case 1: r = 1; break; case 2: r = 15; break; case 3: r = 16; break; case 4: r = 30; break; case 5: r = 31; break; case 6: r = 32; break; case 7: r = 47; break;
        case 8: r = 63; break; case 9: r = 64; break; case 10: r = 65; break; case 11: r = 127; break; case 12: r = 128; break; case 13: r = 129; break; case 14: r = 255; break; case 15: r = 256; break;
        case 16: r = 257; break; case 17: r = 511; break; case 18: r = 512; break; case 19: r = 513; break; case 20: r = 575; break; case 21: r = 1023; break; case 22: r = 1024; break; case 23: r = 1599; break;
        case 24: r = 1600; break; case 25: r = 2047; break; case 26: r = 2048; break; case 27: r = 2111; break; case 28: r = 3000; break; case 29: r = 4031; break; case 30: r = 4032; break; default: r = 4095; break; }
    return (i < 64) ? r : (int)(chk_hash(i * 7919u + 13u) & 4095u);
}
__device__ __forceinline__ bool chk_bad(float got, float ref, float scale) { const float d = fabsf(got - ref); return !(d <= 0.02f * fabsf(ref) + 0.02f * scale); }
__device__ __forceinline__ float bfr(float x) { return bf2f((unsigned short)f2bf(x)); }
__device__ __forceinline__ void chk_flag(Frame& F, int bit, bool bad, int allow) {
    LAS unsigned* cnt = (LAS unsigned*)(F.lds + 65536);
    __syncthreads(); if (threadIdx.x == 0) *cnt = 0u; __syncthreads();
    if (bad) atomicAdd((unsigned*)cnt, 1u);
    __syncthreads();
    if (threadIdx.x == 0 && *cnt > (unsigned)allow) atomicOr((unsigned*)(F.ctl + CW_CHK), 1u << bit);
    __syncthreads();
}
__device__ __forceinline__ int chk_bucket_ref(int dist) {
    if (dist < 0) dist = 0; if (dist < 16) return dist;
    const float d = (float)dist; int large = 16 + (int)(logf(d / 16.0f) / 4.852030263919617f * 16.0f); return large < 31 ? large : 31;
}
__device__ __forceinline__ bool chk_fox(Frame& F, int b, int h, int t) {
    const bf16_t* P = WSP(const bf16_t, WS_P);
    { const size_t row = (size_t)b * SEQ + t; const bf16_t* q = P + row * PW + PC_CQ + h * 64; const float* kb = WSP(const float, WS_KB) + ((size_t)b * 4 + h) * SEQ;
      float m = -INFINITY; for (int j = 0; j <= t; ++j) { const bf16_t* k = P + ((size_t)b * SEQ + j) * PW + PC_CK + h * 64; float s = 0.f; for (int d = 0; d < 64; ++d) s += bf2f(q[d]) * bf2f(k[d]); s += kb[j]; m = fmaxf(m, s); }
      float lsum = 0.f, dummy0_ = 0.f; f32x4 o = {0.f, 0.f, 0.f, 0.f};
      for (int j = 0; j <= t; ++j) { const bf16_t* k = P + ((size_t)b * SEQ + j) * PW + PC_CK + h * 64; const bf16_t* v = P + ((size_t)b * SEQ + j) * PW + PC_CV + h * 64; float s = 0.f; for (int d = 0; d < 64; ++d) s += bf2f(q[d]) * bf2f(k[d]); s += kb[j];
          const float p = exp2f(s - m); lsum += p; _Pragma("unroll") for (int e = 0; e < 4; ++e) o[e] += p * bf2f(v[21 * e]); }
      bool bad = false; _Pragma("unroll") for (int e = 0; e < 4; ++e) bad |= chk_bad(bf2f(WSP(const bf16_t, WS_OCAT)[row * OCW + 384 + h * 64 + 21 * e]), o[e] / lsum, 0.5f);
      return bad; }
}
__device__ __forceinline__ bool chk_dil(Frame& F, int b, int hh, int t) {
    const bf16_t* P = WSP(const bf16_t, WS_P); const float* rel = F.in[1];
    { const size_t row = (size_t)b * SEQ + t;
      float m = -INFINITY;
      for (int g = 0; g < 3; ++g) { const int dil = 1 << (2 * g), head = 2 * g + hh; const bf16_t* q = P + row * PW + PC_BQ + head * 64;
          for (int j = 0; j <= 128; ++j) { const int idx = t - dil * j; if (idx < 0) break; const bf16_t* k = P + ((size_t)b * SEQ + idx) * PW + PC_BK + head * 64; float s = 0.f; for (int d = 0; d < 64; ++d) s += bf2f(q[d]) * bf2f(k[d]);
              s += rel[chk_bucket_ref(dil * j) * 10 + 4 + head] * LOG2E; m = fmaxf(m, s); } }
      float lsum = 0.f, dummy0_ = 0.f; f32x4 o = {0.f, 0.f, 0.f, 0.f};
      for (int g = 0; g < 3; ++g) { const int dil = 1 << (2 * g), head = 2 * g + hh; const bf16_t* q = P + row * PW + PC_BQ + head * 64;
          for (int j = 0; j <= 128; ++j) { const int idx = t - dil * j; if (idx < 0) break; const bf16_t* k = P + ((size_t)b * SEQ + idx) * PW + PC_BK + head * 64; const bf16_t* v = P + ((size_t)b * SEQ + idx) * PW + PC_BV + head * 64; float s = 0.f; for (int d = 0; d < 64; ++d) s += bf2f(q[d]) * bf2f(k[d]);
              s += rel[chk_bucket_ref(dil * j) * 10 + 4 + head] * LOG2E; const float p = exp2f(s - m); lsum += p; _Pragma("unroll") for (int e = 0; e < 4; ++e) o[e] += p * bf2f(v[21 * e]); } }
      bool bad = false; _Pragma("unroll") for (int e = 0; e < 4; ++e) bad |= chk_bad(bf2f(WSP(const bf16_t, WS_OCAT)[row * OCW + 256 + hh * 64 + 21 * e]), o[e] / lsum, 0.5f);
      return bad; }
}
__device__ __forceinline__ bool chk_nsa(Frame& F, int b, int h, int t, int i) {
    const bf16_t* P = WSP(const bf16_t, WS_P); const float* rel = F.in[1];
    { bool bad = false;
      { const size_t row = (size_t)b * SEQ + t; const size_t rb = (size_t)b * SEQ;
      const bf16_t* KC = WSP(const bf16_t, WS_KC) + (size_t)b * 256 * 64; const bf16_t* VC = WSP(const bf16_t, WS_VC) + (size_t)b * 256 * 64;
      const int cmax = (t >= 31) ? (t - 31) / 16 : -1, cur = t >> 6;
      LAS float* imp = (LAS float*)(F.lds + 70000) + i * 65; for (int j = 0; j < 64; ++j) imp[j] = 0.f;
      f32x4 oc = {0.f, 0.f, 0.f, 0.f};
      for (int hh = 0; hh < 4; ++hh) { const bf16_t* q = P + row * PW + PC_AQ + hh * 64; float m = -INFINITY;
          for (int c = 0; c <= cmax; ++c) { float s = 0.f; for (int d = 0; d < 64; ++d) s += bf2f(q[d]) * bf2f(KC[c * 64 + d]); m = fmaxf(m, s); }
          float ls = 0.f; for (int c = 0; c <= cmax; ++c) { float s = 0.f; for (int d = 0; d < 64; ++d) s += bf2f(q[d]) * bf2f(KC[c * 64 + d]); ls += exp2f(s - m); }
          for (int c = 0; c <= cmax; ++c) { float s = 0.f; for (int d = 0; d < 64; ++d) s += bf2f(q[d]) * bf2f(KC[c * 64 + d]); const float p = exp2f(s - m) / ls;
              for (int j = 0; j < 64; ++j) if (16 * c <= 64 * j + 63 && 16 * c + 31 >= 64 * j) imp[j] += p;
              if (hh == h) _Pragma("unroll") for (int e = 0; e < 4; ++e) oc[e] += p * bf2f(VC[c * 64 + 21 * e]); } }
      for (int j = 0; j < 64; ++j) imp[j] = (j == 0 || j == cur || j == cur - 1) ? 1e9f : (j > cur ? -1e9f : imp[j]);
      unsigned long long selm = 0ull;
      for (int j = 0; j < 64; ++j) { int rank = 0; for (int k = 0; k < 64; ++k) rank += (imp[k] > imp[j] || (imp[k] == imp[j] && k < j)) ? 1 : 0; if (rank < 16) selm |= 1ull << j; }
      const bf16_t* q = P + row * PW + PC_AQ + h * 64;
      f32x4 os = {0.f, 0.f, 0.f, 0.f}, ow = {0.f, 0.f, 0.f, 0.f};
      { float m = -INFINITY; for (int pos = 0; pos <= t; ++pos) { if (!((selm >> (pos >> 6)) & 1ull)) continue; const bf16_t* k = P + (rb + pos) * PW + PC_KSLC; float s = 0.f; for (int d = 0; d < 64; ++d) s += bf2f(q[d]) * bf2f(k[d]); s += rel[chk_bucket_ref(t - pos) * 10 + h] * LOG2E; m = fmaxf(m, s); }
        float ls = 0.f; for (int pos = 0; pos <= t; ++pos) { if (!((selm >> (pos >> 6)) & 1ull)) continue; const bf16_t* k = P + (rb + pos) * PW + PC_KSLC; const bf16_t* v = P + (rb + pos) * PW + PC_VSLC; float s = 0.f; for (int d = 0; d < 64; ++d) s += bf2f(q[d]) * bf2f(k[d]); s += rel[chk_bucket_ref(t - pos) * 10 + h] * LOG2E;
            const float p = exp2f(s - m); ls += p; _Pragma("unroll") for (int e = 0; e < 4; ++e) os[e] += p * bf2f(v[21 * e]); }
        _Pragma("unroll") for (int e = 0; e < 4; ++e) os[e] /= ls; }
      { const int lo = t - 511 > 0 ? t - 511 : 0; float m = -INFINITY; for (int pos = lo; pos <= t; ++pos) { const bf16_t* k = P + (rb + pos) * PW + PC_KWIN; float s = 0.f; for (int d = 0; d < 64; ++d) s += bf2f(q[d]) * bf2f(k[d]); s += rel[chk_bucket_ref(t - pos) * 10 + h] * LOG2E; m = fmaxf(m, s); }
        float ls = 0.f; for (int pos = lo; pos <= t; ++pos) { const bf16_t* k = P + (rb + pos) * PW + PC_KWIN; const bf16_t* v = P + (rb + pos) * PW + PC_VWIN; float s = 0.f; for (int d = 0; d < 64; ++d) s += bf2f(q[d]) * bf2f(k[d]); s += rel[chk_bucket_ref(t - pos) * 10 + h] * LOG2E;
            const float p = exp2f(s - m); ls += p; _Pragma("unroll") for (int e = 0; e < 4; ++e) ow[e] += p * bf2f(v[21 * e]); }
        _Pragma("unroll") for (int e = 0; e < 4; ++e) ow[e] /= ls; }
      const float* sd = WSP(const float, WS_SIDE) + row * 16 + h * 3; const float g0 = 1.f / (1.f + expf(-sd[0])), g1 = 1.f / (1.f + expf(-sd[1])), g2 = 1.f / (1.f + expf(-sd[2]));
      _Pragma("unroll") for (int e = 0; e < 4; ++e) bad |= chk_bad(bf2f(WSP(const bf16_t, WS_OCAT)[row * OCW + h * 64 + 21 * e]), g0 * oc[e] + g1 * os[e] + g2 * ow[e], 0.3f); }
      return bad; }
}
__device__ __forceinline__ void selfcheck_a(Frame& F, int l) {
    const int i = threadIdx.x;
    const float* x = F.in[0];
    const bf16_t* H = WSP(const bf16_t, WS_H); const bf16_t* P = WSP(const bf16_t, WS_P);
    const float* rel = F.in[1];
    { const int row = (int)(chk_hash(i) % M), col = (int)(chk_hash(i + 999) & 1023); float s = 0.f; for (int k = 0; k < DM; ++k) { const float v = x[(size_t)row * DM + k]; s += v * v; }
      const float ref = x[(size_t)row * DM + col] * (1.0f / sqrtf(s / DM + RMS_EPS)) * F.in[2][l * DM + col];
      chk_flag(F, 0, chk_bad(bf2f(H[(size_t)row * DM + col]), ref, 1.0f), 0); }
    { const int row = (int)(chk_hash(i + 5) % M); int c = (i * 37 + 5) % PW; if (i < 32) c = 640 + (i & 15); else if (i < 96) c = 672 + (i & 31); else if (i < 160) c = 256 + ((i * 3) & 127);
      const float* W = F.in[6] + (size_t)l * DM * DIN; bool bad = false;
#define DOTC(dst, cc) do { float sc_; const int src_ = inproj_src((cc), sc_); float a_ = 0.f; if (src_ >= 0) for (int k = 0; k < DM; ++k) a_ += bf2f(H[(size_t)row * DM + k]) * bfr(W[(size_t)k * DIN + src_] * sc_); dst = a_; } while (0)
      float ref; DOTC(ref, c);
      if (c >= 672 && c < 704) { const int p = c - 672, ip = p >> 1; float oth; DOTC(oth, c ^ 1); const float x1 = (p & 1) ? oth : ref, x2 = (p & 1) ? ref : oth;
          const float inv = powf(10000.0f, -(float)(2 * ip) / 32.0f), ang = (float)(row & (SEQ - 1)) * inv, cs = cosf(ang), sn = sinf(ang);
          ref = (p & 1) ? (x2 * cs + x1 * sn) : (x1 * cs - x2 * sn);
          bad |= chk_bad(bf2f(WSP(const bf16_t, WS_KROT)[(size_t)row * 32 + p]), ref, 1.0f); }
      bad |= chk_bad(bf2f(P[(size_t)row * PW + c]), ref, 1.0f);
      if (c >= 640 && c < 656) bad |= chk_bad(WSP(const float, WS_SIDE)[(size_t)row * 16 + (c - 640)], ref, 1.0f);
      if (c >= 256 && c < 320) bad |= chk_bad(bf2f(WSP(const bf16_t, WS_KCMP)[(size_t)row * 64 + (c - 256)]), ref, 1.0f);
      if (c >= 320 && c < 384) bad |= chk_bad(bf2f(WSP(const bf16_t, WS_VCMP)[(size_t)row * 64 + (c - 320)]), ref, 1.0f);
      if (i >= 160 && i < 192) { float sq = 0.f, skv = 0.f; for (int k = 0; k < 256; ++k) { const float v = bf2f(P[(size_t)row * PW + PC_DQL + k]); sq += v * v; } for (int k = 0; k < 128; ++k) { const float v = bf2f(P[(size_t)row * PW + PC_DKV + k]); skv += v * v; }
          const float* a = WSP(const float, WS_SSQQ) + (size_t)row * 4; const float* b = WSP(const float, WS_SSQKV) + (size_t)row * 4;
          bad |= chk_bad(a[0] + a[1] + a[2] + a[3], sq, 10.f) || chk_bad(b[0] + b[1] + b[2] + b[3], skv, 5.f); }
      chk_flag(F, 1, bad, 0); }
    { const int b = i & 15, h = (i >> 4) & 3, t = chk_t(i >> 6); float a = 0.f; for (int j = 0; j <= t; ++j) { const float xx = WSP(const float, WS_SIDE)[((size_t)b * SEQ + j) * 16 + 12 + h] + F.in[12][l * 4 + h]; a += (xx >= 0.f) ? -log1pf(expf(-xx)) : (xx - log1pf(expf(xx))); }
      chk_flag(F, 2, chk_bad(WSP(const float, WS_KB)[((size_t)b * 4 + h) * SEQ + t], -a * LOG2E, 1.0f + fabsf(a) * 0.05f), 0); }
    chk_flag(F, 3, chk_fox(F, (i * 5) & 15, i & 3, chk_t(i >> 2)), 0);
    { const int row = (int)(chk_hash(i + 77) % M); bool bad = false;
      float sq = 0.f, skv = 0.f; for (int k = 0; k < 256; ++k) { const float v = bf2f(P[(size_t)row * PW + PC_DQL + k]); sq += v * v; } for (int k = 0; k < 128; ++k) { const float v = bf2f(P[(size_t)row * PW + PC_DKV + k]); skv += v * v; }
      const float rq = 1.0f / sqrtf(sq / 256.0f + RMS_EPS), rkv = 1.0f / sqrtf(skv / 128.0f + RMS_EPS);
      const float* wq = F.in[15] + (size_t)l * 256 * 384; const float* gq = F.in[13] + l * 256; const float* wkv = F.in[16] + (size_t)l * 128 * 512; const float* gkv = F.in[14] + l * 128;
#define QDOT(dst, src) do { float a_ = 0.f; for (int k = 0; k < 256; ++k) a_ += bf2f(P[(size_t)row * PW + PC_DQL + k]) * bfr(wq[(size_t)k * 384 + (src)] * C2D * gq[k]); dst = a_ * rq; } while (0)
      const int r = (i * 11) % 384, hd = r / 96, w = r % 96; float ref;
      if (w < 64) QDOT(ref, hd * 96 + w);
      else { const int p = w - 64, ip = p >> 1; float x1, x2; QDOT(x1, hd * 96 + 64 + ip); QDOT(x2, hd * 96 + 64 + 16 + ip); const float inv = powf(10000.0f, -(float)(2 * ip) / 32.0f), ang = (float)(row & (SEQ - 1)) * inv, cs = cosf(ang), sn = sinf(ang);
          ref = (p & 1) ? (x2 * cs + x1 * sn) : (x1 * cs - x2 * sn); }
      bad |= chk_bad(bf2f(WSP(const bf16_t, WS_QM)[(size_t)row * 512 + r]), ref, 1.5f);
      { const int c = (i * 13) & 511; float a = 0.f; for (int k = 0; k < 128; ++k) a += bf2f(P[(size_t)row * PW + PC_DKV + k]) * bfr(wkv[(size_t)k * 512 + c] * gkv[k]); bad |= chk_bad(bf2f(WSP(const bf16_t, WS_KVM)[(size_t)row * 512 + c]), a * rkv, 1.0f); }
      chk_flag(F, 4, bad, 0); }
    { const int b = (i * 3) & 15, h = i & 3, t = chk_t(i >> 2); const size_t row = (size_t)b * SEQ + t; const bf16_t* q = WSP(const bf16_t, WS_QM) + row * 512 + h * 96; const bf16_t* KV = WSP(const bf16_t, WS_KVM); const bf16_t* KR = WSP(const bf16_t, WS_KROT);
      float m = -INFINITY; for (int j = 0; j <= t; ++j) { const size_t rj = (size_t)b * SEQ + j; float s = 0.f; for (int d = 0; d < 64; ++d) s += bf2f(q[d]) * bf2f(KV[rj * 512 + h * 128 + d]); for (int d = 0; d < 32; ++d) s += bf2f(q[64 + d]) * bf2f(KR[rj * 32 + d]); m = fmaxf(m, s); }
      float lsum = 0.f, dummy0_ = 0.f; f32x4 o = {0.f, 0.f, 0.f, 0.f};
      for (int j = 0; j <= t; ++j) { const size_t rj = (size_t)b * SEQ + j; float s = 0.f; for (int d = 0; d < 64; ++d) s += bf2f(q[d]) * bf2f(KV[rj * 512 + h * 128 + d]); for (int d = 0; d < 32; ++d) s += bf2f(q[64 + d]) * bf2f(KR[rj * 32 + d]);
          const float p = exp2f(s - m); lsum += p; _Pragma("unroll") for (int e = 0; e < 4; ++e) o[e] += p * bf2f(KV[rj * 512 + h * 128 + 64 + 21 * e]); }
      bool bad = false; _Pragma("unroll") for (int e = 0; e < 4; ++e) bad |= chk_bad(bf2f(WSP(const bf16_t, WS_OCAT)[row * OCW + 640 + h * 64 + 21 * e]), o[e] / lsum, 0.5f);
      chk_flag(F, 5, bad, 0); }
    chk_flag(F, 6, chk_dil(F, (i * 7) & 15, i & 1, chk_t(i >> 1)), 0);
    { const int b = i & 15, which = (i >> 4) & 1, c = (int)(chk_hash(i + 31) % 255), d = (i * 5) & 63; const bf16_t* src = (which ? WSP(const bf16_t, WS_VCMP) : WSP(const bf16_t, WS_KCMP)) + ((size_t)b * SEQ + 16 * c) * 64;
      const float *pk1 = F.in[8], *pv1 = F.in[10], *pk2 = F.in[9], *pv2 = F.in[11]; asm volatile("" : "+s"(pk1), "+s"(pv1), "+s"(pk2), "+s"(pv2));
      const float* w1 = (which ? pv1 : pk1) + (size_t)l * 2048 * 128; const float* w2 = (which ? pv2 : pk2) + (size_t)l * 128 * 64; const float* cp = F.in[7] + (size_t)l * 2048;
      float out = 0.f;
      for (int n = 0; n < 128; ++n) { float a = 0.f, bsum = 0.f; for (int p = 0; p < 2048; ++p) { a += bf2f(src[p]) * bfr(w1[(size_t)p * 128 + n]); bsum += cp[p] * w1[(size_t)p * 128 + n]; }
          const float xx = a + bsum, g = 0.5f * xx * (1.0f + tanhf(0.7978845608028654f * (xx + 0.044715f * xx * xx * xx))); out += bfr(g) * w2[n * 64 + d]; }
      chk_flag(F, 7, chk_bad(bf2f((which ? WSP(const bf16_t, WS_VC) : WSP(const bf16_t, WS_KC))[((size_t)b * 256 + c) * 64 + d]), out, 0.5f), 0); }
    { bool bad = false; if (i < 128) bad = chk_nsa(F, (i * 9) & 15, i & 3, chk_t(i >> 2), i); chk_flag(F, 8, bad, 4); }
}
__device__ __forceinline__ void selfcheck_b(Frame& F, int l) {
    const int i = threadIdx.x; const int row = (int)(chk_hash(i + 3) % M), n = (i * 29 + 7) & 1023;
    const bf16_t* H = WSP(const bf16_t, WS_H); const bf16_t* OC = WSP(const bf16_t, WS_OCAT);
    float acc = 0.f;
    for (int br = 0; br < 4; ++br) { const float* wg = F.in[21] + ((size_t)l * 4 + br) * DM * DM; float g = 0.f; for (int k = 0; k < DM; ++k) g += bf2f(H[(size_t)row * DM + k]) * bfr(wg[(size_t)k * DM + n]);
        const int kk = (br == 1) ? 128 : 256, co = (br == 0) ? 0 : (br == 1 ? 256 : (br == 2 ? 384 : 640)); const float *pb0 = F.in[17], *pb1 = F.in[18], *pb2 = F.in[19], *pb3 = F.in[20]; asm volatile("" : "+s"(pb0), "+s"(pb1), "+s"(pb2), "+s"(pb3)); const float* wb = (br == 0 ? pb0 : (br == 1 ? pb1 : (br == 2 ? pb2 : pb3))) + (size_t)l * kk * DM; float t = 0.f; for (int k = 0; k < kk; ++k) t += bf2f(OC[(size_t)row * OCW + co + k]) * bfr(wb[(size_t)k * DM + n]);
        acc += (1.f / (1.f + expf(-g))) * bfr(t); }
    chk_flag(F, 9, chk_bad(bf2f(WSP(const bf16_t, WS_MERGED)[(size_t)row * DM + n]), acc, 0.5f), 0);
}
__device__ __forceinline__ void selfcheck_c(Frame& F, int l, const float* xin) {
    const int i = threadIdx.x; const int row = (int)(chk_hash(i + 11) % M), n = (i * 29 + 7) & 1023;
    const bf16_t* MG = WSP(const bf16_t, WS_MERGED); const float* wo = F.in[22] + (size_t)l * DM * DM; const float* Y = WSP(const float, WS_Y);
    float a = 0.f; for (int k = 0; k < DM; ++k) a += bf2f(MG[(size_t)row * DM + k]) * bfr(wo[(size_t)k * DM + n]);
    chk_flag(F, 0, chk_bad(Y[(size_t)row * DM + n], a, 1.0f), 0);
    float s = 0.f; for (int k = 0; k < DM; ++k) { const float v = Y[(size_t)row * DM + k]; s += v * v; }
    const float rstd = 1.0f / sqrtf(s / DM + RMS_EPS); float s2 = 0.f;
    for (int k = 0; k < DM; ++k) { const float v = xin[(size_t)row * DM + k] + Y[(size_t)row * DM + k] * rstd * F.in[3][l * DM + k]; s2 += v * v; }
    const float x1 = xin[(size_t)row * DM + n] + Y[(size_t)row * DM + n] * rstd * F.in[3][l * DM + n];
    const float h2 = x1 * (1.0f / sqrtf(s2 / DM + RMS_EPS)) * F.in[4][l * DM + n];
    chk_flag(F, 1, chk_bad(F.out[(size_t)row * DM + n], x1, 1.0f) || chk_bad(bf2f(WSP(const bf16_t, WS_H2)[(size_t)row * DM + n]), h2, 1.0f), 0);
}
__device__ __forceinline__ void selfcheck_d(Frame& F, int l) {
    const int i = threadIdx.x; const int row = (int)(chk_hash(i + 17) % (M / 2)); const bf16_t* H2 = WSP(const bf16_t, WS_H2); const bf16_t* U = WSP(const bf16_t, WS_U); const bf16_t* A = WSP(const bf16_t, WS_ACT);
    { const int c = (i * 41 + 3) % DFF2; const float* wu = F.in[23] + (size_t)l * DM * DFF2; float a = 0.f; for (int k = 0; k < DM; ++k) a += bf2f(H2[(size_t)row * DM + k]) * bfr(wu[(size_t)k * DFF2 + c]);
      chk_flag(F, 2, chk_bad(bf2f(U[(size_t)row * DFF2 + c]), a, 1.0f), 0); }
    { const int c = (i * 23 + 1) % DFF; const int t = row & (SEQ - 1); const float* cw = F.in[24] + (size_t)l * 3 * DFF2; const float* cb = F.in[25] + (size_t)l * DFF2; float g = cb[c], v = cb[DFF + c];
      for (int j = 0; j < 3; ++j) { const int tt = t - 2 + j; if (tt < 0) continue; g += cw[j * DFF2 + c] * bf2f(U[(size_t)(row - 2 + j) * DFF2 + c]); v += cw[j * DFF2 + DFF + c] * bf2f(U[(size_t)(row - 2 + j) * DFF2 + DFF + c]); }
      chk_flag(F, 3, chk_bad(bf2f(A[(size_t)row * DFF + c]), g / (1.f + expf(-g)) * v, 0.3f), 0); }
    { const int n = (i * 29 + 7) & 1023; const float* wd = F.in[26] + (size_t)l * DFF * DM; float a = 0.f; for (int k = 0; k < DFF; ++k) a += bf2f(A[(size_t)row * DFF + k]) * bfr(wd[(size_t)k * DM + n]);
      chk_flag(F, 4, chk_bad(WSP(const float, WS_Y2)[(size_t)row * DM + n], a, 1.0f), 0); }
}

__device__ __forceinline__ void selfcheck_e(Frame& F, int l) {
    const int i = threadIdx.x; const bf16_t* H = WSP(const bf16_t, WS_H); const bf16_t* P = WSP(const bf16_t, WS_P);
    const float* W = F.in[6] + (size_t)l * DM * DIN; const int row = (int)(chk_hash(i + 5) % M);
#define DOTC(dst, cc) do { float sc_; const int src_ = inproj_src((cc), sc_); float a_ = 0.f; if (src_ >= 0) for (int k = 0; k < DM; ++k) a_ += bf2f(H[(size_t)row * DM + k]) * bfr(W[(size_t)k * DIN + src_] * sc_); dst = a_; } while (0)
    { int c = (i * 37 + 5) % PW; if ((c >= 640 && c < 768)) c = 100; float ref; DOTC(ref, c); chk_flag(F, 0, chk_bad(bf2f(P[(size_t)row * PW + c]), ref, 1.0f), 0); }
    { const int c = 672 + (i & 31), p = c - 672, ip = p >> 1; float ref, oth; DOTC(ref, c); DOTC(oth, c ^ 1); const float x1 = (p & 1) ? oth : ref, x2 = (p & 1) ? ref : oth;
      const float inv = powf(10000.0f, -(float)(2 * ip) / 32.0f), ang = (float)(row & (SEQ - 1)) * inv, cs = cosf(ang), sn = sinf(ang); const float r = (p & 1) ? (x2 * cs + x1 * sn) : (x1 * cs - x2 * sn);
      chk_flag(F, 1, chk_bad(bf2f(WSP(const bf16_t, WS_KROT)[(size_t)row * 32 + p]), r, 1.0f), 0); }
    { const int c = 640 + (i & 15); float ref; DOTC(ref, c); chk_flag(F, 2, chk_bad(WSP(const float, WS_SIDE)[(size_t)row * 16 + (c - 640)], ref, 1.0f), 0); }
    { const int c = 256 + (i & 127); float ref; DOTC(ref, c); const float got = (c < 320) ? bf2f(WSP(const bf16_t, WS_KCMP)[(size_t)row * 64 + (c - 256)]) : bf2f(WSP(const bf16_t, WS_VCMP)[(size_t)row * 64 + (c - 320)]); chk_flag(F, 3, chk_bad(got, ref, 1.0f), 0); }
    float sq = 0.f, skv = 0.f; for (int k = 0; k < 256; ++k) { const float v = bf2f(P[(size_t)row * PW + PC_DQL + k]); sq += v * v; } for (int k = 0; k < 128; ++k) { const float v = bf2f(P[(size_t)row * PW + PC_DKV + k]); skv += v * v; }
    { const float* a = WSP(const float, WS_SSQQ) + (size_t)row * 4; const float* b = WSP(const float, WS_SSQKV) + (size_t)row * 4; chk_flag(F, 4, chk_bad(a[0] + a[1] + a[2] + a[3], sq, 10.f) || chk_bad(b[0] + b[1] + b[2] + b[3], skv, 5.f), 0); }
    const float rq = 1.0f / sqrtf(sq / 256.0f + RMS_EPS), rkv = 1.0f / sqrtf(skv / 128.0f + RMS_EPS);
    const float* wq = F.in[15] + (size_t)l * 256 * 384; const float* gq = F.in[13] + l * 256; const float* wkv = F.in[16] + (size_t)l * 128 * 512; const float* gkv = F.in[14] + l * 128;
#define QDOT(dst, src) do { float a_ = 0.f; for (int k = 0; k < 256; ++k) a_ += bf2f(P[(size_t)row * PW + PC_DQL + k]) * bfr(wq[(size_t)k * 384 + (src)] * C2D * gq[k]); dst = a_ * rq; } while (0)
    { const int hd = i & 3, w = (i >> 2) & 63; float ref; QDOT(ref, hd * 96 + w); chk_flag(F, 5, chk_bad(bf2f(WSP(const bf16_t, WS_QM)[(size_t)row * 512 + hd * 96 + w]), ref, 1.5f), 0); }
    { const int hd = i & 3, p = (i >> 2) & 31, ip = p >> 1; float x1, x2; QDOT(x1, hd * 96 + 64 + ip); QDOT(x2, hd * 96 + 64 + 16 + ip); const float inv = powf(10000.0f, -(float)(2 * ip) / 32.0f), ang = (float)(row & (SEQ - 1)) * inv, cs = cosf(ang), sn = sinf(ang);
      const float r = (p & 1) ? (x2 * cs + x1 * sn) : (x1 * cs - x2 * sn); chk_flag(F, 6, chk_bad(bf2f(WSP(const bf16_t, WS_QM)[(size_t)row * 512 + hd * 96 + 64 + p]), r, 1.5f), 0); }
    { const int c = (i * 13) & 511; float a = 0.f; for (int k = 0; k < 128; ++k) a += bf2f(P[(size_t)row * PW + PC_DKV + k]) * bfr(wkv[(size_t)k * 512 + c] * gkv[k]); chk_flag(F, 7, chk_bad(bf2f(WSP(const bf16_t, WS_KVM)[(size_t)row * 512 + c]), a * rkv, 1.0f), 0); }
    { const int b = i & 15, which = (i >> 4) & 1, c = (int)(chk_hash(i + 31) % 255), n = (i * 5) & 127; const bf16_t* src = (which ? WSP(const bf16_t, WS_VCMP) : WSP(const bf16_t, WS_KCMP)) + ((size_t)b * SEQ + 16 * c) * 64;
      const float *pk1 = F.in[8], *pv1 = F.in[10], *pk2 = F.in[9], *pv2 = F.in[11]; asm volatile("" : "+s"(pk1), "+s"(pv1), "+s"(pk2), "+s"(pv2));
      const float* w1 = (which ? pv1 : pk1) + (size_t)l * 2048 * 128; const float* w2 = (which ? pv2 : pk2) + (size_t)l * 128 * 64; const float* cp = F.in[7] + (size_t)l * 2048;
      float a = 0.f, bsum = 0.f; for (int p = 0; p < 2048; ++p) { a += bf2f(src[p]) * bfr(w1[(size_t)p * 128 + n]); bsum += cp[p] * w1[(size_t)p * 128 + n]; }
      const float xx = a + bsum, g = 0.5f * xx * (1.0f + tanhf(0.7978845608028654f * (xx + 0.044715f * xx * xx * xx)));
      const bf16_t* hid = WSP(const bf16_t, WS_HID) + (size_t)(which * 4096 + b * 256 + c) * 256 + which * 128;
      chk_flag(F, 8, chk_bad(bf2f(hid[n]), g, 0.5f), 0);
      const int d = (i * 5) & 63; float o2 = 0.f; for (int nn = 0; nn < 128; ++nn) o2 += bf2f(hid[nn]) * w2[nn * 64 + d];
      chk_flag(F, 9, chk_bad(bf2f((which ? WSP(const bf16_t, WS_VC) : WSP(const bf16_t, WS_KC))[((size_t)b * 256 + c) * 64 + d]), o2, 0.5f), 0); }
#undef DOTC
#undef QDOT
}

constexpr int CW_CNT = 20544;
__device__ __forceinline__ void selfcheck_g(Frame& F, int l) {
    const int gi = blockIdx.x * 512 + threadIdx.x; const bf16_t* H = WSP(const bf16_t, WS_H); const bf16_t* P = WSP(const bf16_t, WS_P); const float* W = F.in[6] + (size_t)l * DM * DIN;
    const int row = gi & (M - 1); unsigned nbad = 0u;
    for (int k4 = 0; k4 < 4; ++k4) { int c = (int)(chk_hash(gi * 4 + k4 + 12345u) % PW); if (c >= 640 && c < 768) c -= 200;
        float sc_; const int src_ = inproj_src(c, sc_); float a_ = 0.f; for (int k = 0; k < DM; ++k) a_ += bf2f(H[(size_t)row * DM + k]) * bfr(W[(size_t)k * DIN + src_] * sc_);
        if (chk_bad(bf2f(P[(size_t)row * PW + c]), a_, 1.0f)) ++nbad; }
    if (nbad) atomicAdd((unsigned*)(F.ctl + CW_CNT), nbad);
}
__device__ __forceinline__ void selfcheck_g_fin(Frame& F) {
    if (blockIdx.x == 0 && threadIdx.x == 0) { const unsigned cnt = __hip_atomic_load(F.ctl + CW_CNT, __ATOMIC_RELAXED, __HIP_MEMORY_SCOPE_AGENT); unsigned lg = 0; while ((1u << lg) <= cnt && lg < 15) ++lg;
        atomicOr((unsigned*)(F.ctl + CW_CHK), (cnt > 63u ? 63u : cnt) | (lg << 6)); }
}

__device__ __forceinline__ void selfcheck_f(Frame& F, int l) {
    const int i = threadIdx.x; const unsigned hsh = chk_hash(i + 4242u);
    chk_flag(F, 0, chk_fox(F, i & 15, (i >> 4) & 3, (i >> 6) * 8 + (hsh & 7)), 0);
    chk_flag(F, 1, chk_fox(F, i & 15, (i >> 4) & 3, 64 + (int)(hsh % 192u)), 0);
    chk_flag(F, 2, chk_fox(F, i & 15, (i >> 4) & 3, 256 + (int)(hsh % 3840u)), 0);
    chk_flag(F, 3, chk_dil(F, i & 15, (i >> 4) & 1, (int)(hsh & 127u)), 0);
    chk_flag(F, 4, chk_dil(F, i & 15, (i >> 4) & 1, 128 + (int)(hsh % 3968u)), 0);
    { bool bad = false; if (i < 128) bad = chk_nsa(F, i & 15, (i >> 4) & 3, (int)(hsh % 31u), i); chk_flag(F, 5, bad, 0); }
    { bool bad = false; if (i < 128) bad = chk_nsa(F, i & 15, (i >> 4) & 3, 31 + (int)(hsh % 33u), i); chk_flag(F, 6, bad, 0); }
    { bool bad = false; if (i < 128) bad = chk_nsa(F, i & 15, (i >> 4) & 3, 64 + (int)(hsh % 960u), i); chk_flag(F, 7, bad, 0); }
    { bool bad = false; if (i < 128) bad = chk_nsa(F, i & 15, (i >> 4) & 3, 1024 + (int)(hsh % 3072u), i); chk_flag(F, 8, bad, 4); }
}
__device__ __forceinline__ void selfcheck_report(Frame& F) {
    const unsigned mask = __hip_atomic_load(F.ctl + CW_CHK, __ATOMIC_RELAXED, __HIP_MEMORY_SCOPE_AGENT);
    float V = (float)(10u + (mask & 63u)); const unsigned e = 2u + ((mask >> 6) & 15u); for (unsigned k = 0; k < e; ++k) V *= 10.0f;
    for (size_t idx = (size_t)blockIdx.x * 512 + threadIdx.x; idx < (size_t)M * DM; idx += (size_t)F.G * 512) F.out[idx] = V;
}
#endif
struct SchedSimple {
    pg8::TileOrder T; const char* A; const char* B; int lda, ldb, nt; int dup = 0;
    __device__ __forceinline__ bool next(int i, GUnit& u) const { int pm, pn; if (!T.tile(i >> dup, pm, pn)) return false;
        u.A = A + (size_t)pm * 256 * lda; u.B = B + (size_t)pn * 256 * ldb; u.lda = lda; u.ldb = ldb; u.nt = nt; u.pm = pm; u.pn = pn; u.id = 0; return true; }
};
struct SchedCmp1 {
    int c; const char* kc; const char* vc; const char* B;
    __device__ __forceinline__ bool next(int i, GUnit& u) const { if (i > 0 || c >= 32) return false;
        u.A = (c < 16 ? kc : vc) + (size_t)(c & 15) * 256 * 2048; u.B = B; u.lda = 2048; u.ldb = 4096; u.nt = 32; u.pm = c; u.pn = 0; u.id = 0; return true; }
};
struct SchedMerge {
    pg8::TileOrder T; const char* ocat; const char* h; const char* wbr; const char* wg; int dup = 0;
    __device__ __forceinline__ bool next(int i0, GUnit& u) const { const int i = i0 >> dup; int pm, pn; if (!T.tile(i >> 3, pm, pn)) return false;
        const int sub = i & 7; u.pm = pm; u.pn = pn; u.id = sub;
        if (sub >= 4) { u.A = h + (size_t)pm * 256 * 2048; u.lda = 2048; u.B = wg + (size_t)((pn * 4 + (sub - 4)) * 256) * 2048; u.ldb = 2048; u.nt = 16; }
        else { const int br = sub; const int kk = (br == 1) ? 128 : 256; const size_t co = (br == 0) ? 0 : (br == 1 ? 256 : (br == 2 ? 384 : 640)), wo = (br == 0) ? BR_A : (br == 1 ? BR_B : (br == 2 ? BR_C : BR_D));
            u.A = ocat + (size_t)pm * 256 * (OCW * 2) + co * 2; u.lda = OCW * 2; u.B = wbr + wo + (size_t)pn * 256 * kk * 2; u.ldb = kk * 2; u.nt = kk / 64; }
        return true; }
};

#ifndef SDUP_INPROJ
#define SDUP_INPROJ 0
#endif
#ifndef SDUP_MERGE
#define SDUP_MERGE 0
#endif
#ifndef SDUP_WO
#define SDUP_WO 0
#endif
#ifndef SDUP_UP
#define SDUP_UP 0
#endif
#ifndef SDUP_DN
#define SDUP_DN 0
#endif
#ifndef DUP_ATTN
#define DUP_ATTN 1
#endif
#ifndef DUP_GEMM
#define DUP_GEMM 1
#endif
#ifndef DUP_MERGE
#define DUP_MERGE 1
#endif
#ifndef DUP_FFN
#define DUP_FFN 1
#endif
#ifdef ONLY_PHASE
#define PH(k) ((k) == ONLY_PHASE)
#else
#define PH(k) true
#endif
struct Args { const float* in[27]; float* out; unsigned char* ws; };
__global__ void __launch_bounds__(512, 2) hybrid_fwd(Args args) {
    extern __shared__ __attribute__((aligned(16))) unsigned char lds_raw[];
    Frame F;
    F.lds = (LAS unsigned char*)lds_raw; F.MISC = (volatile LAS unsigned*)(F.lds + MISC_OFF);
    F.tid = threadIdx.x; F.lane = F.tid & 63; F.wave = __builtin_amdgcn_readfirstlane(F.tid >> 6); F.G = gridDim.x;
#pragma unroll
    for (int i = 0; i < 27; ++i) F.in[i] = args.in[i];
    F.out = args.out; F.ws = args.ws; F.ctl = (gu32*)(args.ws + WS_CTL);
    for (int u = F.tid; u < (LDS_BYTES - LDSCTL_OFF) / 4; u += 512) ((LAS unsigned*)(F.lds + LDSCTL_OFF))[u] = 0u;
    __syncthreads();
    XcdBarrier bar = xcd_barrier_post((unsigned*)(F.ctl + CW_BAR), F.MISC + 8);
    const int c = (int)blockIdx.x;
#if defined(TIMEPROBE)
    if (threadIdx.x == 0) *(volatile LAS unsigned long long*)(F.lds + MISC_OFF + 64) = __builtin_amdgcn_s_memrealtime();
#define TSTAMP(id) do { if (blockIdx.x == 0 && threadIdx.x == 0) { volatile LAS unsigned long long* tp_ = (volatile LAS unsigned long long*)(F.lds + MISC_OFF + 64); const unsigned long long now_ = __builtin_amdgcn_s_memrealtime(); unsigned long long* a_ = (unsigned long long*)(F.ws + 90000) + (id); *a_ = *a_ + (now_ - *tp_); *tp_ = now_; } } while (0)
#else
#define TSTAMP(id) do { } while (0)
#endif

#ifndef DUP_P0
#define DUP_P0 1
#endif
    for (int rep = 0; rep < DUP_P0; ++rep) { if (rep) xcd_barrier(bar); if (PH(0)) p0_prologue(F); }
    xcd_barrier(bar); TSTAMP(0);

#ifndef XTRA_BAR
#define XTRA_BAR 0
#endif
    _Pragma("unroll") for (int xb = 0; xb < XTRA_BAR; ++xb) xcd_barrier(bar);
#define PHASE_FRESH() do { int t_ = threadIdx.x; asm volatile("" : "+v"(t_)); F.tid = t_; F.lane = t_ & 63; } while (0)
    for (int l = 0; l < DEPTH; ++l) {
        unsigned char* wl = F.ws + WS_WT + (size_t)l * LW;
        const float* xin = (l == 0) ? F.in[0] : F.out;
        PHASE_FRESH();
#ifndef DUP_RP0
#define DUP_RP0 1
#endif
        if (l == 0) { if (c == 0) cmpb_reduce(F);
          _Pragma("unroll") for (int rep = 0; rep < DUP_RP0; ++rep) { if (rep) xcd_barrier(bar); if (PH(1)) rowpass<0>(F, xin, nullptr, 0, nullptr, WSP(bf16_t, WS_H), F.in[2] + l * DM, nullptr, 0, M); }
          xcd_barrier(bar); TSTAMP(1); }
        for (int rep = 0; rep < DUP_GEMM; ++rep) if (PH(2)) { if (rep) xcd_barrier(bar); SchedSimple S; S.T.init(256, 12, F.G, c); S.A = (const char*)(F.ws + WS_H); S.B = (const char*)(wl + LW_IN); S.lda = 2048; S.ldb = 2048; S.nt = 16; S.dup = SDUP_INPROJ;
          pg8::EpiInProj E{WSP(bf16_t, WS_P), WSP(bf16_t, WS_KCMP), WSP(bf16_t, WS_VCMP), WSP(float, WS_SIDE), WSP(bf16_t, WS_KROT), WSP(const float, WS_ROPE), WSP(float, WS_SSQQ), WSP(float, WS_SSQKV), F.in[12] + l * 4, WSP(float, WS_LF)};
          pg8::gemm_phase<pg8::EpiInProj, SchedSimple, true>(F.lds, S, E); }
        xcd_barrier(bar); TSTAMP(2);
#ifndef DUP_L2A
#define DUP_L2A 1
#endif
        _Pragma("unroll") for (int rep2 = 0; rep2 < DUP_L2A; ++rep2) { if (rep2) xcd_barrier(bar);
        if (PH(3)) { SchedCmp1 S{c, (const char*)(F.ws + WS_KCMP), (const char*)(F.ws + WS_VCMP), (const char*)(wl + LW_PHI)};
          pg8::EpiCmp1 E{WSP(bf16_t, WS_HID), WSP(const float, WS_CMPB) + l * 256};
          pg8::gemm_phase<pg8::EpiCmp1, SchedCmp1, false>(F.lds, S, E);
          if (c < 32) {
              __syncthreads(); const int which = c >> 4, b = c & 15;
              int ln_ = threadIdx.x & 63; asm volatile("" : "+v"(ln_)); const int r32 = ln_ & 31, hi = ln_ >> 5;
              const bf16_t* hrow = WSP(const bf16_t, WS_HID) + ((size_t)c * 256 + F.wave * 32 + r32) * 256 + which * 128;
              const float *pk2 = F.in[9], *pv2 = F.in[11]; asm volatile("" : "+s"(pk2), "+s"(pv2)); const float* w2 = (which ? pv2 : pk2) + (size_t)l * 128 * 64;
              f32x16 o0, o1;
#pragma unroll
              for (int r = 0; r < 16; ++r) { o0[r] = 0.f; o1[r] = 0.f; }
#pragma unroll
              for (int ks = 0; ks < 8; ++ks) { const bf16x8 a = *(const bf16x8*)(hrow + ks * 16 + hi * 8);
                  const float* wp = w2 + (size_t)(ks * 16 + hi * 8) * 64 + r32; u32x4 b0, b1;
#pragma unroll
                  for (int jj = 0; jj < 4; ++jj) { b0[jj] = cvtpk(wp[(2 * jj) * 64], wp[(2 * jj + 1) * 64]); b1[jj] = cvtpk(wp[(2 * jj) * 64 + 32], wp[(2 * jj + 1) * 64 + 32]); }
                  o0 = MFMA32(a, __builtin_bit_cast(bf16x8, b0), o0); o1 = MFMA32(a, __builtin_bit_cast(bf16x8, b1), o1); }
              bf16_t* dst = (which ? WSP(bf16_t, WS_VC) : WSP(bf16_t, WS_KC)) + ((size_t)b * 256 + F.wave * 32) * 64 + r32;
#pragma unroll
              for (int r = 0; r < 16; ++r) { const int rw = crow(r, hi); dst[(size_t)rw * 64] = (bf16_t)f2bf(o0[r]); dst[(size_t)rw * 64 + 32] = (bf16_t)f2bf(o1[r]); } } }
        if (PH(4)) { int G2_ = F.G; asm volatile("" : "+s"(G2_)); const bool split = G2_ > 64; const int g2 = split ? F.G - 32 : F.G, c2 = split ? c - 32 : c;
          { SchedSimple S; S.T.init(256, 2, g2, c2 < 0 ? (1 << 28) : c2); S.A = (const char*)(F.ws + WS_P) + PC_DQL * 2; S.B = (const char*)(wl + LW_UQ); S.lda = PW * 2; S.ldb = 512; S.nt = 4;
            pg8::EpiQup E{WSP(bf16_t, WS_QM), WSP(const float, WS_SSQQ), WSP(const float, WS_ROPE)};
            pg8::gemm_phase<pg8::EpiQup, SchedSimple, true>(F.lds, S, E); }
          { SchedSimple S; S.T.init(256, 2, g2, c2 < 0 ? (1 << 28) : c2); S.A = (const char*)(F.ws + WS_P) + PC_DKV * 2; S.B = (const char*)(wl + LW_UKV); S.lda = PW * 2; S.ldb = 256; S.nt = 2;
            pg8::EpiKVup E{WSP(bf16_t, WS_KVM), WSP(const float, WS_SSQKV)};
            pg8::gemm_phase<pg8::EpiKVup, SchedSimple, true>(F.lds, S, E); } }
        PHASE_FRESH();
        if (PH(5)) {
          int G_ = F.G; asm volatile("" : "+s"(G_)); const int cb = (G_ >= 48) ? c - 32 : c;
          if (cb >= 0 && cb < BATCH) { const int b = cb, tid = F.tid; const float* lf = WSP(const float, WS_LF) + ((size_t)b * SEQ + 8 * tid) * 4;
              f32x4 v[8];
#pragma unroll
              for (int i = 0; i < 8; ++i) v[i] = *(const f32x4*)(lf + 4 * i);
#pragma unroll
              for (int i = 1; i < 8; ++i) v[i] = v[i] + v[i - 1];
              LAS f32x4* sc = (LAS f32x4*)F.lds; f32x4 run = v[7];
              sc[tid] = run; __syncthreads();
              for (int off = 1, cur = 0; off < 512; off <<= 1, cur ^= 1) { f32x4 t = sc[cur * 512 + tid]; if (tid >= off) t = t + sc[cur * 512 + tid - off]; sc[(cur ^ 1) * 512 + tid] = t; __syncthreads(); run = t; }
              const f32x4 ex = run - v[7];
              float* kb = WSP(float, WS_KB) + (size_t)b * 4 * SEQ + 8 * tid;
#pragma unroll
              for (int e = 0; e < 4; ++e) { f32x4 lo, hi4;
#pragma unroll
                  for (int i = 0; i < 4; ++i) { lo[i] = -(ex[e] + v[i][e]) * LOG2E; hi4[i] = -(ex[e] + v[4 + i][e]) * LOG2E; }
                  *(f32x4*)(kb + (size_t)e * SEQ) = lo; *(f32x4*)(kb + (size_t)e * SEQ + 4) = hi4; }
              __syncthreads();
          } }
        }
        if (PH(5)) {
          const int gt2 = c * 512 + F.tid, hp = gt2 & 1;
          for (int t2 = gt2 >> 1; t2 < M; t2 += F.G * 256) { const bf16_t* Kp = WSP(const bf16_t, WS_P) + (size_t)t2 * PW + PC_CK + hp * 128; float s0 = 0.f, s1 = 0.f;
#pragma unroll
              for (int q8 = 0; q8 < 8; ++q8) { const bf16x8 ka = *(const bf16x8*)(Kp + q8 * 8), kb2 = *(const bf16x8*)(Kp + 64 + q8 * 8);
#pragma unroll
                  for (int e = 0; e < 8; ++e) { const float xa = bf2f((unsigned short)ka[e]), xb = bf2f((unsigned short)kb2[e]); s0 += xa * xa; s1 += xb * xb; } }
              s0 = fmaxf(s0, xor_lane_lt32<2>(s0)); s0 = fmaxf(s0, xor_lane_lt32<4>(s0)); s0 = fmaxf(s0, xor_lane_lt32<8>(s0)); s0 = fmaxf(s0, xor_lane_lt32<16>(s0));
              s1 = fmaxf(s1, xor_lane_lt32<2>(s1)); s1 = fmaxf(s1, xor_lane_lt32<4>(s1)); s1 = fmaxf(s1, xor_lane_lt32<8>(s1)); s1 = fmaxf(s1, xor_lane_lt32<16>(s1));
              { auto r0 = __builtin_amdgcn_permlane32_swap(__float_as_uint(s0), __float_as_uint(s0), false, false); s0 = fmaxf(__uint_as_float(r0[0]), __uint_as_float(r0[1]));
                auto r1 = __builtin_amdgcn_permlane32_swap(__float_as_uint(s1), __float_as_uint(s1), false, false); s1 = fmaxf(__uint_as_float(r1[0]), __uint_as_float(r1[1])); }
              if (F.lane < 2) { unsigned* kw = (unsigned*)(F.ctl + CW_KMAX + 64 * l) + (t2 >> 12) * 4 + 2 * hp; atomicMax(kw, __float_as_uint(s0)); atomicMax(kw + 1, __float_as_uint(s1)); } } }
        xcd_barrier(bar); TSTAMP(3);
        PHASE_FRESH();
        for (int rep = 0; rep < DUP_ATTN; ++rep) { gu32* ctr = F.ctl + CW_Q + 64 * l + 16 * rep;
          if (rep) xcd_barrier(bar);
          unsigned nxtq = 0u; if (F.tid == 0) nxtq = __hip_atomic_fetch_add(ctr, 1u, __ATOMIC_RELAXED, __HIP_MEMORY_SCOPE_AGENT);
          for (;;) { if (F.tid == 0) F.MISC[0] = nxtq; __syncthreads(); const int iq = (int)F.MISC[0]; __syncthreads(); if (iq >= ATT_UNITS) break;
              if (F.tid == 0) nxtq = __hip_atomic_fetch_add(ctr, 1u, __ATOMIC_RELAXED, __HIP_MEMORY_SCOPE_AGENT);
              const int it = __builtin_amdgcn_readfirstlane(WSP(const int, WS_ORDER)[iq]);
              if (it < 2048 && PH(7)) { const int qb = 15 - (it >> 7), mla = (it >> 6) & 1, bh = it & 63; if (mla) causal_unit<false>(F, bh >> 2, bh & 3, qb, 0.f); else causal_unit<true>(F, bh >> 2, bh & 3, qb, sqrtf(__uint_as_float(__hip_atomic_load(F.ctl + CW_KMAX + 64 * l + bh, __ATOMIC_RELAXED, __HIP_MEMORY_SCOPE_AGENT)))); }
              else if (it < 3072 && PH(8)) { const int r = it - 2048; nsa_unit(F, r & 15, 63 - (r >> 4)); }
              else if (it < 3328 && PH(9)) { const int r = it - 3072; dil_unit(F, r & 15, (r >> 4) & 1, r >> 5); } } }
        xcd_barrier(bar); TSTAMP(5);
#if defined(SELFCHECK) && SELFCHECK == 1
        if (c == 0) selfcheck_a(F, l);
#endif
#if defined(SELFCHECK) && SELFCHECK == 3
        if (c == 0) selfcheck_e(F, l);
        xcd_barrier(bar); selfcheck_report(F); return;
#endif
#if defined(SELFCHECK) && SELFCHECK == 5
        selfcheck_g(F, l); xcd_barrier(bar); selfcheck_g_fin(F);
        xcd_barrier(bar); selfcheck_report(F); return;
#endif
#if defined(SELFCHECK) && SELFCHECK == 4
        if (c == 0) selfcheck_f(F, l);
        xcd_barrier(bar); selfcheck_report(F); return;
#endif
        for (int rep = 0; rep < DUP_MERGE; ++rep) if (PH(10)) { if (rep) xcd_barrier(bar); SchedMerge S; S.T.init(256, 4, F.G, c); S.ocat = (const char*)(F.ws + WS_OCAT); S.h = (const char*)(F.ws + WS_H); S.wbr = (const char*)(wl + LW_BR); S.wg = (const char*)(wl + LW_G); S.dup = SDUP_MERGE;
          unsigned char* scr = F.ws + WS_MSCR + (size_t)c * MSCR_PER_WG;
          pg8::EpiMerge E{WSP(bf16_t, WS_MERGED), scr};
          pg8::gemm_phase<pg8::EpiMerge, SchedMerge, true>(F.lds, S, E); }
        xcd_barrier(bar); TSTAMP(6);
#if defined(SELFCHECK) && SELFCHECK == 1
        if (c == 0) selfcheck_b(F, l);
        xcd_barrier(bar); selfcheck_report(F); return;
#endif
        if (PH(11)) { SchedSimple S; S.T.init(256, 4, F.G, c); S.A = (const char*)(F.ws + WS_MERGED); S.B = (const char*)(wl + LW_O); S.lda = 2048; S.ldb = 2048; S.nt = 16; S.dup = SDUP_WO;
          pg8::EpiBf16 E{WSP(bf16_t, WS_Y), DM};
          pg8::gemm_phase<pg8::EpiBf16, SchedSimple, true>(F.lds, S, E); }
        xcd_barrier(bar); TSTAMP(7);
        PHASE_FRESH();
        if (PH(12)) rowpass<1>(F, xin, WSP(const bf16_t, WS_Y), 0, F.out, WSP(bf16_t, WS_H2), F.in[3] + l * DM, F.in[4] + l * DM, 0, M);
        xcd_barrier(bar); TSTAMP(8);
#ifdef DUP_RP1
        if (l == 0) { _Pragma("unroll") for (int rep = 0; rep < DUP_RP1; ++rep) { rowpass<1>(F, xin, WSP(const bf16_t, WS_Y), 0, F.out, WSP(bf16_t, WS_H2), F.in[3] + l * DM, F.in[4] + l * DM, 0, M); xcd_barrier(bar); } }
#endif
#ifndef DUP_UP
#define DUP_UP 1
#endif
        _Pragma("unroll") for (int rep = 0; rep < DUP_UP; ++rep) if (PH(13)) { if (rep) xcd_barrier(bar); SchedSimple S; S.T.init(256, 22, F.G, c); S.A = (const char*)(F.ws + WS_H2); S.B = (const char*)(wl + LW_UP); S.lda = 2048; S.ldb = 2048; S.nt = 16; S.dup = SDUP_UP;
          pg8::EpiUpConv E{WSP(bf16_t, WS_ACT), WSP(float, WS_HB), F.in[24] + (size_t)l * 3 * DFF2, F.in[25] + (size_t)l * DFF2};
          pg8::gemm_phase<pg8::EpiUpConv, SchedSimple, true>(F.lds, S, E); }
        xcd_barrier(bar); TSTAMP(9);
        PHASE_FRESH();
        if (PH(15)) { SchedSimple S; S.T.init(256, 4, F.G, c); S.A = (const char*)(F.ws + WS_ACT); S.B = (const char*)(wl + LW_DN); S.lda = DFF * 2; S.ldb = DFF * 2; S.nt = DFF / 64; S.dup = SDUP_DN;
          { int pm, pn; for (int i = 0; S.T.tile(i, pm, pn); ++i) ffn_fix_panel(F, pm, WSP(const float, WS_HB), WSP(bf16_t, WS_ACT), F.in[24] + (size_t)l * 3 * DFF2, F.in[25] + (size_t)l * DFF2); }
          VM_WAIT(); __syncthreads();
          pg8::EpiBf16 E{WSP(bf16_t, WS_Y2), DM};
          pg8::gemm_phase<pg8::EpiBf16, SchedSimple, true>(F.lds, S, E); }
        xcd_barrier(bar); TSTAMP(11);
        PHASE_FRESH();
        if (PH(16)) { if (l + 1 < DEPTH) rowpass<1>(F, F.out, WSP(const bf16_t, WS_Y2), 0, F.out, WSP(bf16_t, WS_H), F.in[5] + l * DM, F.in[2] + (l + 1) * DM, 0, M);
                      else rowpass<2>(F, F.out, WSP(const bf16_t, WS_Y2), 0, F.out, nullptr, F.in[5] + l * DM, nullptr, 0, M); }
        xcd_barrier(bar); TSTAMP(12);
    }
#if defined(TIMEPROBE)
    { xcd_barrier(bar); const unsigned long long* a_ = (const unsigned long long*)(F.ws + 90000); const float V1 = (float)a_[TIMEPROBE_A] * 0.01f, V2 = (float)a_[TIMEPROBE_B] * 0.01f * 1000.0f;
      for (size_t idx = (size_t)blockIdx.x * 512 + threadIdx.x; idx < (size_t)M * DM; idx += (size_t)F.G * 512) F.out[idx] = (idx == 12345) ? V2 : V1; }
#endif
}

extern "C" void kernel_launch(void* const* d_in, const int* in_sizes, int n_in, void* d_out, int out_size, void* d_ws, size_t ws_size, hipStream_t stream) {
    static int grid = 0;
    if (grid == 0) {
        if (n_in != 27 || in_sizes[0] != M * DM || out_size != M * DM || ws_size < WS_END) { fprintf(stderr, "kernel_launch: unexpected shapes (n_in %d, in0 %d, out %d, ws %zu)\n", n_in, n_in > 0 ? in_sizes[0] : -1, out_size, ws_size); grid = -1; return; }
        int dev = 0, cus = 0, per_cu = 0;
        if (hipGetDevice(&dev) != hipSuccess || hipDeviceGetAttribute(&cus, hipDeviceAttributeMultiprocessorCount, dev) != hipSuccess) { grid = -1; return; }
        if (hipFuncSetAttribute((const void*)hybrid_fwd, hipFuncAttributeMaxDynamicSharedMemorySize, LDS_BYTES) != hipSuccess) { fprintf(stderr, "kernel_launch: hipFuncSetAttribute failed\n"); grid = -1; return; }
        if (hipOccupancyMaxActiveBlocksPerMultiprocessor(&per_cu, (const void*)hybrid_fwd, 512, LDS_BYTES) != hipSuccess || per_cu < 1) fprintf(stderr, "kernel_launch: occupancy query says %d\n", per_cu);
        (void)hipGetLastError();
        grid = cus;
    }
    if (grid < 0) return;
    if (hipMemsetAsync((char*)d_ws + WS_CTL, 0, CTL_ZERO_BYTES, stream) != hipSuccess) return;
    Args a{};
    for (int i = 0; i < 27; ++i) a.in[i] = (const float*)d_in[i];
    a.out = (float*)d_out; a.ws = (unsigned char*)d_ws;
    hipLaunchKernelGGL(hybrid_fwd, dim3(grid), dim3(512), LDS_BYTES, stream, a);
}
```

```cpp
#include <hip/hip_runtime.h>
#include <hip/hip_bf16.h>
#include <cstdio>
#include <cstdint>
#include <cmath>

#define GAS __attribute__((address_space(1)))
#define LAS __attribute__((address_space(3)))
typedef unsigned short bf16_t;
typedef short bf16x8 __attribute__((ext_vector_type(8)));
typedef short s16x4 __attribute__((ext_vector_type(4)));
typedef float f32x4 __attribute__((ext_vector_type(4)));
typedef float f32x2 __attribute__((ext_vector_type(2)));
typedef float f32x16 __attribute__((ext_vector_type(16)));
typedef unsigned u32x4 __attribute__((ext_vector_type(4)));
typedef unsigned u32x2 __attribute__((ext_vector_type(2)));
typedef GAS unsigned gu32;

constexpr int BATCH = 16, SEQ = 4096, DM = 1024, M = BATCH * SEQ, DEPTH = 2;
constexpr int DIN = 2992, PW = 3072;
constexpr int DFF = 2816, DFF2 = 5632;
constexpr float LOG2E = 1.4426950408889634f;
constexpr float C2A = 0.125f * LOG2E;
constexpr float C2D = 0.10206207261596575f * LOG2E;
constexpr float RMS_EPS = 1e-6f;
constexpr float H8_SCALE = 8.0f, WG8_SCALE = 64.0f, GATE_UNSCALE = 1.0f / (H8_SCALE * WG8_SCALE);
constexpr int PC_AQ = 0, PC_KCMP = 256, PC_VCMP = 320, PC_KSLC = 384, PC_VSLC = 448, PC_KWIN = 512, PC_VWIN = 576,
              PC_MISC = 640, PC_KROPE = 672, PC_BQ = 768, PC_BK = 1152, PC_BV = 1536, PC_DKV = 1920,
              PC_CQ = 2048, PC_CK = 2304, PC_CV = 2560, PC_DQL = 2816;
constexpr int OCW = 896;
constexpr int NSA_DFAR = 1536, NSA_DMAX = 1664, NSA_TL = 1728;

__device__ __forceinline__ unsigned f2bf(float f) { unsigned u = __float_as_uint(f); return (u + 0x7fffu + ((u >> 16) & 1u)) >> 16; }
__device__ __forceinline__ unsigned pk2(float lo, float hi) { return f2bf(lo) | (f2bf(hi) << 16); }
__device__ __forceinline__ float bf2f(unsigned short b) { return __uint_as_float((unsigned)b << 16); }
typedef __bf16 bf16x2_t __attribute__((ext_vector_type(2)));
__device__ __forceinline__ unsigned cvtpk(float lo, float hi) { f32x2 v = {lo, hi}; bf16x2_t b = __builtin_convertvector(v, bf16x2_t); return __builtin_bit_cast(unsigned, b); }
__device__ __forceinline__ unsigned pk4_fp8(float a, float b, float c, float d) { int w = 0; w = __builtin_amdgcn_cvt_pk_fp8_f32(a, b, w, false); w = __builtin_amdgcn_cvt_pk_fp8_f32(c, d, w, true); return (unsigned)w; }
__device__ __forceinline__ float fast_exp2(float x) { return __builtin_amdgcn_exp2f(x); }
__device__ __forceinline__ float fast_rcp(float x) { return __builtin_amdgcn_rcpf(x); }
template <int MASK> __device__ __forceinline__ float xor_lane_lt32(float v) { return __uint_as_float(__builtin_amdgcn_ds_swizzle((int)__float_as_uint(v), (MASK << 10) | 0x1f)); }
__device__ __forceinline__ float sum_halves(float v) { auto rr = __builtin_amdgcn_permlane32_swap(__float_as_uint(v), __float_as_uint(v), false, false); return __uint_as_float(rr[0]) + __uint_as_float(rr[1]); }
__device__ __forceinline__ float sigmoid_f(float x) { return fast_rcp(1.0f + fast_exp2(-x * LOG2E)); }

namespace pg8 {
constexpr int BM = 256, BK = 64, HALF = 128, HTB = HALF * BK * 2  , STAGE_BYTES = 8 * HTB, NXCD = 8, WGM = 8;
__host__ __device__ __forceinline__ int lds_byte(int r, int c) { const int st = (r >> 4) * 2 + (c >> 5), rr = r & 15, cc = c & 31, ob = rr * 64 + cc * 2; return st * 1024 + (ob ^ (((ob >> 9) & 1) << 5)); }
__host__ __device__ __forceinline__ void stage_rc(int b, int& R, int& C) { const int st = b / 1024, sb = b % 1024, swz = sb ^ (((sb >> 9) & 1) << 5); R = (st >> 1) * 16 + swz / 64; C = (st & 1) * 32 + (swz % 64) / 2; }
__host__ __device__ __forceinline__ int perm32(int rho) { const int n = rho >> 4, i = rho & 15; return 8 * (i >> 2) + 4 * n + (i & 3); }

typedef int v8i_t __attribute__((ext_vector_type(8)));
typedef int v4i_t __attribute__((ext_vector_type(4)));
__device__ __forceinline__ v8i_t cat8(const bf16x8 lo, const bf16x8 hi) { const v4i_t a = __builtin_bit_cast(v4i_t, lo), b = __builtin_bit_cast(v4i_t, hi); return __builtin_shufflevector(a, b, 0, 1, 2, 3, 4, 5, 6, 7); }
struct GUnit { const char* A; const char* B; int lda, ldb, nt, pm, pn, id; };

struct TileOrder {
    int nM, nN, nwg, G, c;
    __device__ __forceinline__ void init(int nM_, int nN_, int G_, int c_) { nM = nM_; nN = nN_; nwg = nM * nN; G = G_; c = c_; }
    __device__ __forceinline__ bool tile(int i, int& pm, int& pn) const {
        const long L = (long)i * G + c; if (L >= nwg) return false;
        int wgid = (int)L; { const int q = nwg / NXCD, r = nwg % NXCD, xcd = wgid % NXCD, off = wgid / NXCD; wgid = (xcd < r ? xcd * (q + 1) : r * (q + 1) + (xcd - r) * q) + off; }
        const int nig = WGM * nN, gid = wgid / nig, fm = gid * WGM, gsz = (nM - fm) < WGM ? (nM - fm) : WGM;
        pm = fm + ((wgid % nig) % gsz); pn = (wgid % nig) / gsz; return true;
    }
};

template <class Epi, class Sched, bool ALIGN_EPI, bool F8 = false>
__device__ __forceinline__ void gemm_phase(LAS unsigned char* lds, const Sched& S, const Epi& E) {
    int tid_o = threadIdx.x; asm volatile("" : "+v"(tid_o));
    const int tid = tid_o, wid = __builtin_amdgcn_readfirstlane(tid >> 6), lane = tid & 63, wr = wid >> 2, wc = wid & 3; int fr = lane & 15, fq = lane >> 4;
    int sR[2], sC[2], sRb[2];
#pragma unroll
    for (int i = 0; i < 2; ++i) { stage_rc(tid * 16 + i * 8192, sR[i], sC[i]); sRb[i] = Epi::PERM ? ((sR[i] & ~31) + perm32(sR[i] & 31)) : sR[i]; sC[i] *= 2; }
    const size_t kstep = (size_t)(BK * 2);
    const unsigned ldsw = (unsigned)wid * 1024u;
    const int aoff = lds_byte(wr * 64 + fr, fq * 8), boff = lds_byte(wc * 32 + fr, fq * 8);
#define PG8_SA(b, h) (((b) * 2 + (h)) * HTB)
#define PG8_SB(b, h) ((4 + (b) * 2 + (h)) * HTB)
#define PG8_STAGE(bufoff, gbase, rows, ld) do { _Pragma("unroll") for (int _i = 0; _i < 2; ++_i) \
        __builtin_amdgcn_global_load_lds((const unsigned*)((const char*)(gbase) + (unsigned)((rows)[_i] * (ld) + sC[_i])), (LAS unsigned*)(lds + (bufoff) + ldsw + _i * 8192), 16, 0, 0); } while (0)
#define PG8_LDA(dst, b, h) do { _Pragma("unroll") for (int m = 0; m < 4; ++m) _Pragma("unroll") for (int k = 0; k < 2; ++k) dst[m][k] = *(const LAS bf16x8*)(lds + PG8_SA(b, h) + aoff + m * 2048 + k * 1024); } while (0)
#define PG8_LDB(dst, b, h) do { _Pragma("unroll") for (int n = 0; n < 2; ++n) _Pragma("unroll") for (int k = 0; k < 2; ++k) dst[n][k] = *(const LAS bf16x8*)(lds + PG8_SB(b, h) + boff + n * 2048 + k * 1024); } while (0)
#define PG8_MMA(ai, bj, At, Bt) do { __builtin_amdgcn_s_setprio(1); _Pragma("unroll") for (int m = 0; m < 4; ++m) _Pragma("unroll") for (int n = 0; n < 2; ++n) _Pragma("unroll") for (int k = 0; k < 2; ++k) \
        acc[ai][bj][m][n] = __builtin_amdgcn_mfma_f32_16x16x32_bf16(Bt[n][k], At[m][k], acc[ai][bj][m][n], 0, 0, 0); __builtin_amdgcn_s_setprio(0); } while (0)
#define PG8_LDA8(dst, b, h) do { _Pragma("unroll") for (int m = 0; m < 4; ++m) { dst[m].lo = *(const LAS v4i_t*)(lds + PG8_SA(b, h) + aoff + m * 2048); dst[m].hi = *(const LAS v4i_t*)(lds + PG8_SA(b, h) + aoff + m * 2048 + 1024); } } while (0)
#define PG8_LDB8(dst, b, h) do { _Pragma("unroll") for (int n = 0; n < 2; ++n) { dst[n].lo = *(const LAS v4i_t*)(lds + PG8_SB(b, h) + boff + n * 2048); dst[n].hi = *(const LAS v4i_t*)(lds + PG8_SB(b, h) + boff + n * 2048 + 1024); } } while (0)
#define PG8_MMA8(ai, bj, At, Bt) do { __builtin_amdgcn_s_setprio(1); _Pragma("unroll") for (int m = 0; m < 4; ++m) _Pragma("unroll") for (int n = 0; n < 2; ++n) \
        asm volatile("v_mfma_f32_16x16x128_f8f6f4 %0, %1, %2, %0" : "+v"(acc[ai][bj][m][n]) : "v"(Bt[n]), "v"(At[m])); __builtin_amdgcn_s_setprio(0); } while (0)
#define PG8_WAIT_V(n) asm volatile("s_waitcnt vmcnt(" #n ")" ::: "memory")
#define PG8_WAIT_L(n) asm volatile("s_waitcnt lgkmcnt(" #n ")" ::: "memory")
#define PG8_BAR __builtin_amdgcn_s_barrier()
#define PG8_SCHED __builtin_amdgcn_sched_barrier(0)
#define PG8_KLOOP(MM, LDA_, LDB_, At, B0, B1) for (int t = 0; t < nt; t += 2) { \
            const bool last = (t == nt - 2); \
            const char* a1 = cA + (size_t)(t + 1) * kstep; \
            const char* a2 = last ? nA : cA + (size_t)(t + 2) * kstep; const char* b2 = last ? nB : cB + (size_t)(t + 2) * kstep; \
            const char* a3 = a2 + kstep; const char* b3 = b2 + kstep; \
            const int ldA2 = last ? ldAn : ldAc, ldB2 = last ? ldBn : ldBc; \
            const size_t hA2 = last ? hAn : hAc, hB2 = last ? hBn : hBc; \
              \
            LDB_(B0, 0, 0); LDB_(B1, 0, 1); PG8_SCHED; LDA_(At, 0, 0); PG8_STAGE(PG8_SA(1, 1), a1 + hAc, sR, ldAc); \
            PG8_WAIT_V(8); PG8_WAIT_L(0); PG8_BAR; MM(0, 0, At, B0); MM(0, 1, At, B1); PG8_BAR; PG8_SCHED; \
              \
            LDA_(At, 0, 1); PG8_STAGE(PG8_SB(0, 0), b2, sRb, ldB2); PG8_STAGE(PG8_SB(0, 1), b2 + hB2, sRb, ldB2); PG8_STAGE(PG8_SA(0, 0), a2, sR, ldA2); \
            PG8_WAIT_V(8); PG8_WAIT_L(0); PG8_BAR; MM(1, 0, At, B0); MM(1, 1, At, B1); PG8_BAR; PG8_SCHED; \
              \
            LDB_(B0, 1, 0); LDB_(B1, 1, 1); PG8_SCHED; LDA_(At, 1, 0); PG8_STAGE(PG8_SA(0, 1), a2 + hA2, sR, ldA2); \
            PG8_WAIT_V(8); PG8_WAIT_L(0); PG8_BAR; MM(0, 0, At, B0); MM(0, 1, At, B1); PG8_BAR; PG8_SCHED; \
              \
            LDA_(At, 1, 1); PG8_STAGE(PG8_SB(1, 0), b3, sRb, ldB2); PG8_STAGE(PG8_SB(1, 1), b3 + hB2, sRb, ldB2); PG8_STAGE(PG8_SA(1, 0), a3, sR, ldA2); \
            PG8_WAIT_V(8); PG8_WAIT_L(0); PG8_BAR; MM(1, 0, At, B0); MM(1, 1, At, B1); PG8_BAR; PG8_SCHED; \
        }
    GUnit cur, nxt; int ui = 0;
    if (!S.next(0, cur)) return;
    f32x4 acc[2][2][4][2];
#pragma unroll
    for (int a = 0; a < 2; ++a)
#pragma unroll
        for (int b = 0; b < 2; ++b)
#pragma unroll
            for (int m = 0; m < 4; ++m)
#pragma unroll
                for (int n = 0; n < 2; ++n) acc[a][b][m][n] = (f32x4){0.f, 0.f, 0.f, 0.f};
    bf16x8 At[4][2], B0[2][2], B1[2][2]; v8i_t At8[4], B08[2], B18[2];
    int ldAc = cur.lda, ldBc = cur.ldb; size_t hAc = (size_t)HALF * ldAc, hBc = (size_t)HALF * ldBc;
    const char* cA = cur.A; const char* cB = cur.B;
    PG8_STAGE(PG8_SB(0, 0), cB, sRb, ldBc); PG8_STAGE(PG8_SB(0, 1), cB + hBc, sRb, ldBc); PG8_STAGE(PG8_SA(0, 0), cA, sR, ldAc); PG8_STAGE(PG8_SA(0, 1), cA + hAc, sR, ldAc);
    if (wr == 1) PG8_BAR;
    PG8_WAIT_V(2); PG8_BAR;
    PG8_STAGE(PG8_SB(1, 0), cB + kstep, sRb, ldBc); PG8_STAGE(PG8_SA(1, 0), cA + kstep, sR, ldAc); PG8_STAGE(PG8_SB(1, 1), cB + hBc + kstep, sRb, ldBc);
    PG8_WAIT_V(6); PG8_BAR;
    for (;;) {
        const bool has_next = S.next(ui + 1, nxt);
        int ldAn, ldBn; const char* nA; const char* nB;
        if (has_next) { ldAn = nxt.lda; ldBn = nxt.ldb; nA = nxt.A; nB = nxt.B; } else { ldAn = ldAc; ldBn = ldBc; nA = cA; nB = cB; }
        const size_t hAn = (size_t)HALF * ldAn, hBn = (size_t)HALF * ldBn;
        int nt = cur.nt; asm volatile("" : "+s"(nt));
        if constexpr (F8) { PG8_KLOOP(PG8_MMA8, PG8_LDA8, PG8_LDB8, At8, B08, B18) asm volatile("s_nop 15\n\ts_nop 15" ::: "memory"); }
        else { PG8_KLOOP(PG8_MMA, PG8_LDA, PG8_LDB, At, B0, B1) }
        if constexpr (ALIGN_EPI) { if (wr == 0) PG8_BAR; }
        E(acc, cur, wr, wc, fr, fq);
        if (!has_next) break;
#pragma unroll
        for (int a = 0; a < 2; ++a)
#pragma unroll
            for (int b = 0; b < 2; ++b)
#pragma unroll
                for (int m = 0; m < 4; ++m)
#pragma unroll
                    for (int n = 0; n < 2; ++n) acc[a][b][m][n] = (f32x4){0.f, 0.f, 0.f, 0.f};
        cur = nxt; cA = nA; cB = nB; ++ui;
        ldAc = ldAn; ldBc = ldBn; hAc = hAn; hBc = hBn;
        if constexpr (ALIGN_EPI) { if (wr == 1) PG8_BAR; }
    }
    PG8_WAIT_V(0);
    if constexpr (!ALIGN_EPI) { if (wr == 0) PG8_BAR; }
    PG8_BAR;
#undef PG8_SA
#undef PG8_SB
#undef PG8_STAGE
#undef PG8_LDA
#undef PG8_LDB
#undef PG8_MMA
#undef PG8_MMA8
#undef PG8_LDA8
#undef PG8_LDB8
#undef PG8_KLOOP
#undef PG8_WAIT_V
#undef PG8_WAIT_L
#undef PG8_BAR
#undef PG8_SCHED
}
}
using pg8::GUnit;
namespace pg8 {
#define EPI_OPAQUE() asm volatile("" : "+v"(fr), "+v"(fq))
struct EpiBf16 {
    static constexpr bool PERM = true;
    bf16_t* O; int ldc;
    __device__ __forceinline__ void operator()(const f32x4 (&acc)[2][2][4][2], const GUnit& u, int wr, int wc, int fr, int fq) const {
        EPI_OPAQUE();
        const int row0 = u.pm * BM + wr * 64 + fr, col0 = u.pn * BM + wc * 32 + 8 * fq;
#pragma unroll
        for (int ai = 0; ai < 2; ++ai)
#pragma unroll
            for (int m = 0; m < 4; ++m) { bf16_t* rowp = O + (size_t)(row0 + ai * HALF + m * 16) * ldc + col0;
#pragma unroll
                for (int bj = 0; bj < 2; ++bj) { const f32x4 v0 = acc[ai][bj][m][0], v1 = acc[ai][bj][m][1];
                    u32x4 w; w.x = cvtpk(v0[0], v0[1]); w.y = cvtpk(v0[2], v0[3]); w.z = cvtpk(v1[0], v1[1]); w.w = cvtpk(v1[2], v1[3]);
                    *(u32x4*)(rowp + bj * HALF) = w; } }
    }
};
struct EpiF32 {
    static constexpr bool PERM = false;
    float* O; int ldc;
    __device__ __forceinline__ void operator()(const f32x4 (&acc)[2][2][4][2], const GUnit& u, int wr, int wc, int fr, int fq) const {
        EPI_OPAQUE();
        const int row0 = u.pm * BM + wr * 64 + fr, col0 = u.pn * BM + wc * 32 + 4 * fq;
#pragma unroll
        for (int ai = 0; ai < 2; ++ai)
#pragma unroll
            for (int m = 0; m < 4; ++m) { float* rowp = O + (size_t)(row0 + ai * HALF + m * 16) * ldc + col0;
#pragma unroll
                for (int bj = 0; bj < 2; ++bj)
#pragma unroll
                    for (int n = 0; n < 2; ++n) *(f32x4*)(rowp + bj * HALF + n * 16) = acc[ai][bj][m][n]; }
    }
};
__device__ __forceinline__ void rope8(f32x4& v0, f32x4& v1, const float* cs  ) {
    const f32x4 a = *(const f32x4*)cs, b = *(const f32x4*)(cs + 4);
    f32x4 r0, r1;
    r0[0] = v0[0] * a[0] - v0[1] * a[1]; r0[1] = v0[1] * a[0] + v0[0] * a[1];
    r0[2] = v0[2] * a[2] - v0[3] * a[3]; r0[3] = v0[3] * a[2] + v0[2] * a[3];
    r1[0] = v1[0] * b[0] - v1[1] * b[1]; r1[1] = v1[1] * b[0] + v1[0] * b[1];
    r1[2] = v1[2] * b[2] - v1[3] * b[3]; r1[3] = v1[3] * b[2] + v1[2] * b[3];
    v0 = r0; v1 = r1;
}
struct EpiInProj {
    static constexpr bool PERM = true;
    bf16_t* P; bf16_t* kcmp; bf16_t* vcmp; float* side; bf16_t* krot; const float* rope; float* ssq_q; float* ssq_kv; const float* fbias; float* lf;
    __device__ __forceinline__ void operator()(const f32x4 (&acc)[2][2][4][2], const GUnit& u, int wr, int wc, int fr, int fq) const {
        EPI_OPAQUE();
        const int row0 = u.pm * BM + wr * 64 + fr, col0 = u.pn * BM + wc * 32 + 8 * fq;
#pragma unroll
        for (int ai = 0; ai < 2; ++ai)
#pragma unroll
            for (int m = 0; m < 4; ++m) { const int row = row0 + ai * HALF + m * 16; bf16_t* rowp = P + (size_t)row * PW + col0;
                float ssq = 0.f;
#pragma unroll
                for (int bj = 0; bj < 2; ++bj) { f32x4 v0 = acc[ai][bj][m][0], v1 = acc[ai][bj][m][1];
                    if (u.pn == 2 && bj == 1) {
                        if (wc == 0 && fq < 2) { float* sp = side + (size_t)row * 16 + 8 * fq; *(f32x4*)sp = v0; *(f32x4*)(sp + 4) = v1;
                            if (fq == 1) { const f32x4 fb = *(const f32x4*)fbias; f32x4 s1;
#pragma unroll
                                for (int e = 0; e < 4; ++e) { const float x = v1[e] + fb[e]; s1[e] = (x >= 0.f) ? -log1pf(expf(-x)) : (x - log1pf(expf(x))); }
                                *(f32x4*)(lf + (size_t)row * 4) = s1; } }
                        if (wc == 1) { rope8(v0, v1, rope + (size_t)(row & (SEQ - 1)) * 32 + 8 * fq);
                            u32x4 w; w.x = cvtpk(v0[0], v0[1]); w.y = cvtpk(v0[2], v0[3]); w.z = cvtpk(v1[0], v1[1]); w.w = cvtpk(v1[2], v1[3]);
                            *(u32x4*)(krot + (size_t)row * 32 + 8 * fq) = w; }
                    }
                    u32x4 w; w.x = cvtpk(v0[0], v0[1]); w.y = cvtpk(v0[2], v0[3]); w.z = cvtpk(v1[0], v1[1]); w.w = cvtpk(v1[2], v1[3]);
                    *(u32x4*)(rowp + bj * HALF) = w;
                    if (u.pn == 1 && bj == 0) { bf16_t* cp = (wc < 2 ? kcmp : vcmp) + (size_t)row * 64 + (wc & 1) * 32 + 8 * fq; *(u32x4*)cp = w; }
                    if (u.pn == 11 || (u.pn == 7 && bj == 1)) ssq += (v0[0] * v0[0] + v0[1] * v0[1]) + (v0[2] * v0[2] + v0[3] * v0[3]) + (v1[0] * v1[0] + v1[1] * v1[1]) + (v1[2] * v1[2] + v1[3] * v1[3]);
                }
                if (u.pn == 11 || u.pn == 7) { ssq += xor_lane_lt32<16>(ssq); ssq = sum_halves(ssq);
                    if (fq == 0) (u.pn == 11 ? ssq_q : ssq_kv)[(size_t)row * 4 + wc] = ssq; }
                asm volatile("" ::: "memory");
            }
    }
};
struct EpiQup {
    static constexpr bool PERM = true;
    bf16_t* O; const float* ssq_q; const float* rope;
    __device__ __forceinline__ void operator()(const f32x4 (&acc)[2][2][4][2], const GUnit& u, int wr, int wc, int fr, int fq) const {
        EPI_OPAQUE();
        const int row0 = u.pm * BM + wr * 64 + fr, col0 = u.pn * BM + wc * 32 + 8 * fq;
#pragma unroll
        for (int ai = 0; ai < 2; ++ai)
#pragma unroll
            for (int m = 0; m < 4; ++m) { const int row = row0 + ai * HALF + m * 16; bf16_t* rowp = O + (size_t)row * 512 + col0;
                const f32x4 pq = *(const f32x4*)(ssq_q + (size_t)row * 4);
                const float rstd = 1.0f / sqrtf(((pq[0] + pq[1]) + (pq[2] + pq[3])) * (1.0f / 256.0f) + RMS_EPS);
#pragma unroll
                for (int bj = 0; bj < 2; ++bj) { f32x4 v0 = acc[ai][bj][m][0] * rstd, v1 = acc[ai][bj][m][1] * rstd;
                    const int c8 = col0 + bj * HALF, within = c8 % 96;
                    if (c8 < 384 && within >= 64) rope8(v0, v1, rope + (size_t)(row & (SEQ - 1)) * 32 + (within - 64));
                    u32x4 w; w.x = cvtpk(v0[0], v0[1]); w.y = cvtpk(v0[2], v0[3]); w.z = cvtpk(v1[0], v1[1]); w.w = cvtpk(v1[2], v1[3]);
                    *(u32x4*)(rowp + bj * HALF) = w; }
                asm volatile("" ::: "memory"); }
    }
};
struct EpiKVup {
    static constexpr bool PERM = true;
    bf16_t* O; const float* ssq_kv; unsigned* kmx;
    __device__ __forceinline__ void operator()(const f32x4 (&acc)[2][2][4][2], const GUnit& u, int wr, int wc, int fr, int fq) const {
        EPI_OPAQUE();
        const int row0 = u.pm * BM + wr * 64 + fr, col0 = u.pn * BM + wc * 32 + 8 * fq;
        float mk0 = 0.f, mk1 = 0.f;
#pragma unroll
        for (int ai = 0; ai < 2; ++ai)
#pragma unroll
            for (int m = 0; m < 4; ++m) { const int row = row0 + ai * HALF + m * 16; bf16_t* rowp = O + (size_t)row * 512 + col0;
                const f32x4 pq = *(const f32x4*)(ssq_kv + (size_t)row * 4);
                const float rstd = 1.0f / sqrtf(((pq[0] + pq[1]) + (pq[2] + pq[3])) * (1.0f / 128.0f) + RMS_EPS);
#pragma unroll
                for (int bj = 0; bj < 2; ++bj) { const f32x4 v0 = acc[ai][bj][m][0] * rstd, v1 = acc[ai][bj][m][1] * rstd;
                    u32x4 w; w.x = cvtpk(v0[0], v0[1]); w.y = cvtpk(v0[2], v0[3]); w.z = cvtpk(v1[0], v1[1]); w.w = cvtpk(v1[2], v1[3]);
                    *(u32x4*)(rowp + bj * HALF) = w;
                    if (wc < 2) { float ss = ((v0[0] * v0[0] + v0[1] * v0[1]) + (v0[2] * v0[2] + v0[3] * v0[3])) + ((v1[0] * v1[0] + v1[1] * v1[1]) + (v1[2] * v1[2] + v1[3] * v1[3]));
                        ss += xor_lane_lt32<16>(ss); ss = sum_halves(ss); if (bj == 0) mk0 = fmaxf(mk0, ss); else mk1 = fmaxf(mk1, ss); } }
                asm volatile("" ::: "memory"); }
        if (wc < 2) {
            mk0 = fmaxf(mk0, xor_lane_lt32<1>(mk0)); mk0 = fmaxf(mk0, xor_lane_lt32<2>(mk0)); mk0 = fmaxf(mk0, xor_lane_lt32<4>(mk0)); mk0 = fmaxf(mk0, xor_lane_lt32<8>(mk0));
            mk1 = fmaxf(mk1, xor_lane_lt32<1>(mk1)); mk1 = fmaxf(mk1, xor_lane_lt32<2>(mk1)); mk1 = fmaxf(mk1, xor_lane_lt32<4>(mk1)); mk1 = fmaxf(mk1, xor_lane_lt32<8>(mk1));
            if (fr == 0 && fq == 0) { unsigned* kw = kmx + ((u.pm >> 4) * 4 + 2 * u.pn) * 4 + wc; atomicMax(kw, __float_as_uint(mk0)); atomicMax(kw + 4, __float_as_uint(mk1)); }
        }
    }
};
__device__ __forceinline__ float gelu_tanh(float x) { const float u2 = 2.0f * 0.7978845608028654f * (x + 0.044715f * x * x * x); return x * fast_rcp(1.0f + fast_exp2(-u2 * LOG2E)); }
struct EpiCmp1 {
    static constexpr bool PERM = true;
    bf16_t* O; const float* bias1;
    __device__ __forceinline__ void operator()(const f32x4 (&acc)[2][2][4][2], const GUnit& u, int wr, int wc, int fr, int fq) const {
        EPI_OPAQUE();
        const int row0 = u.pm * BM + wr * 64 + fr, col0 = wc * 32 + 8 * fq;
        f32x4 bv[2][2];
#pragma unroll
        for (int bj = 0; bj < 2; ++bj)
#pragma unroll
            for (int n = 0; n < 2; ++n) bv[bj][n] = *(const f32x4*)(bias1 + col0 + bj * HALF + 4 * n);
#pragma unroll
        for (int ai = 0; ai < 2; ++ai)
#pragma unroll
            for (int m = 0; m < 4; ++m) { bf16_t* rowp = O + (size_t)(row0 + ai * HALF + m * 16) * 256 + col0;
#pragma unroll
                for (int bj = 0; bj < 2; ++bj) { f32x4 v0 = acc[ai][bj][m][0] + bv[bj][0], v1 = acc[ai][bj][m][1] + bv[bj][1];
#pragma unroll
                    for (int e = 0; e < 4; ++e) { v0[e] = gelu_tanh(v0[e]); v1[e] = gelu_tanh(v1[e]); }
                    u32x4 w; w.x = cvtpk(v0[0], v0[1]); w.y = cvtpk(v0[2], v0[3]); w.z = cvtpk(v1[0], v1[1]); w.w = cvtpk(v1[2], v1[3]);
                    *(u32x4*)(rowp + bj * HALF) = w; } }
    }
};
typedef __amdgpu_buffer_rsrc_t rsrc_t;
struct EpiMerge {
    static constexpr bool PERM = true;
    bf16_t* O;
    unsigned char* scr;
    __device__ __forceinline__ void operator()(const f32x4 (&acc)[2][2][4][2], const GUnit& u, int wr, int wc, int fr, int fq) const {
        EPI_OPAQUE();
        const int tid = (wr * 4 + wc) * 64 + fq * 16 + fr;
        const int sub = u.id;
        const rsrc_t rs = __builtin_amdgcn_make_buffer_rsrc(scr, 0, 524288, 0x00020000);
        if (sub < 4) {
#pragma unroll
            for (int ai = 0; ai < 2; ++ai)
#pragma unroll
                for (int bj = 0; bj < 2; ++bj)
#pragma unroll
                    for (int m = 0; m < 4; ++m)
#pragma unroll
                        for (int n = 0; n < 2; ++n) { const int q = ((ai * 2 + bj) * 4 + m) * 2 + n; const f32x4 v = acc[ai][bj][m][n];
                            u32x2 w; w.x = cvtpk(v[0], v[1]); w.y = cvtpk(v[2], v[3]);
                            __builtin_amdgcn_raw_buffer_store_b64(w, rs, tid * 8, (sub * 32 + q) * 4096, 0); }
            return;
        }
        const int j = sub - 4;
        const int row0 = u.pm * BM + wr * 64 + fr, col0 = u.pn * BM + 64 * j + wc * 16 + 4 * fq;
#pragma unroll
        for (int ai = 0; ai < 2; ++ai) {
            u32x2 sv[4][4];
#pragma unroll
            for (int m = 0; m < 4; ++m)
#pragma unroll
                for (int g = 0; g < 4; ++g) { const int qb = (ai * 16 + m * 2);
                    sv[m][g] = (j == 0) ? __builtin_amdgcn_raw_buffer_load_b64(rs, tid * 8, (g * 32 + qb) * 4096, 0)
                             : (j == 1) ? __builtin_amdgcn_raw_buffer_load_b64(rs, tid * 8, (g * 32 + qb + 1) * 4096, 0)
                             : (j == 2) ? __builtin_amdgcn_raw_buffer_load_b64(rs, tid * 8, (g * 32 + qb + 8) * 4096, 0)
                                        : __builtin_amdgcn_raw_buffer_load_b64(rs, tid * 8, (g * 32 + qb + 9) * 4096, 0); }
#pragma unroll
            for (int m = 0; m < 4; ++m) { bf16_t* rowp = O + (size_t)(row0 + ai * HALF + m * 16) * DM + col0;
                f32x4 t = {0.f, 0.f, 0.f, 0.f};
#pragma unroll
                for (int g = 0; g < 4; ++g) { const f32x4 gt = acc[ai][g >> 1][m][g & 1]; const u32x2 s = sv[m][g];
                    t[0] += sigmoid_f(gt[0] * GATE_UNSCALE) * __uint_as_float(s.x << 16); t[1] += sigmoid_f(gt[1] * GATE_UNSCALE) * __uint_as_float(s.x & 0xffff0000u);
                    t[2] += sigmoid_f(gt[2] * GATE_UNSCALE) * __uint_as_float(s.y << 16); t[3] += sigmoid_f(gt[3] * GATE_UNSCALE) * __uint_as_float(s.y & 0xffff0000u); }
                u32x2 w; w.x = cvtpk(t[0], t[1]); w.y = cvtpk(t[2], t[3]);
                *(u32x2*)rowp = w; }
            asm volatile("" ::: "memory"); }
    }
};
__device__ __forceinline__ float dpp_ror1(float v) { return __uint_as_float((unsigned)__builtin_amdgcn_update_dpp(0, (int)__float_as_uint(v), 0x121, 0xf, 0xf, false)); }
__device__ __forceinline__ float dpp_ror2(float v) { return __uint_as_float((unsigned)__builtin_amdgcn_update_dpp(0, (int)__float_as_uint(v), 0x122, 0xf, 0xf, false)); }
struct EpiUpConv {
    static constexpr bool PERM = true;
    bf16_t* ACT; float* HB; const float* cw; const float* cb;
    __device__ __forceinline__ void operator()(const f32x4 (&acc)[2][2][4][2], const GUnit& u, int wr, int wc, int fr, int fq) const {
        EPI_OPAQUE();
        const int colL = wc * 32 + 8 * fq;
#pragma unroll
        for (int n = 0; n < 2; ++n) {
            const int cl = colL + 4 * n, c0 = u.pn * 128 + cl;
            const f32x4 bg = *(const f32x4*)(cb + c0), w0g = *(const f32x4*)(cw + c0), w1g = *(const f32x4*)(cw + DFF2 + c0), w2g = *(const f32x4*)(cw + 2 * DFF2 + c0);
            const f32x4 bv = *(const f32x4*)(cb + DFF + c0), w0v = *(const f32x4*)(cw + DFF + c0), w1v = *(const f32x4*)(cw + DFF2 + DFF + c0), w2v = *(const f32x4*)(cw + 2 * DFF2 + DFF + c0);
#pragma unroll
            for (int ai = 0; ai < 2; ++ai) {
                const int rowg = u.pm * BM + ai * HALF + wr * 64, g = rowg >> 6;
                f32x4 t1g, t2g, t1v, t2v;
#pragma unroll
                for (int e = 0; e < 4; ++e) { t1g[e] = 0.f; t2g[e] = 0.f; t1v[e] = 0.f; t2v[e] = 0.f; }
#pragma unroll
                for (int m = 0; m < 4; ++m) {
                    const f32x4 cg = acc[ai][0][m][n], cv = acc[ai][1][m][n];
                    f32x4 r1g, r2g, r1v, r2v, o;
#pragma unroll
                    for (int e = 0; e < 4; ++e) { r1g[e] = dpp_ror1(cg[e]); r2g[e] = dpp_ror2(cg[e]); r1v[e] = dpp_ror1(cv[e]); r2v[e] = dpp_ror2(cv[e]); }
#pragma unroll
                    for (int e = 0; e < 4; ++e) { const float p1g = (fr == 0) ? t1g[e] : r1g[e], p2g = (fr < 2) ? t2g[e] : r2g[e], p1v = (fr == 0) ? t1v[e] : r1v[e], p2v = (fr < 2) ? t2v[e] : r2v[e];
                        const float gt = bg[e] + w0g[e] * p2g + w1g[e] * p1g + w2g[e] * cg[e], vl = bv[e] + w0v[e] * p2v + w1v[e] * p1v + w2v[e] * cv[e];
                        o[e] = gt * sigmoid_f(gt) * vl; }
                    const int row = rowg + m * 16 + fr;
                    if (!(m == 0 && fr < 2)) { u32x2 w; w.x = cvtpk(o[0], o[1]); w.y = cvtpk(o[2], o[3]); *(u32x2*)(ACT + (size_t)row * DFF + c0) = w; }
                    if (m == 0 && fr < 2) { float* hp = HB + ((size_t)((g * 4 + fr) * 22 + u.pn) * 256 + cl); *(f32x4*)hp = cg; *(f32x4*)(hp + 128) = cv; }
                    if (m == 3 && fr >= 14) { float* hp = HB + ((size_t)((g * 4 + fr - 12) * 22 + u.pn) * 256 + cl); *(f32x4*)hp = cg; *(f32x4*)(hp + 128) = cv; }
                    t1g = r1g; t2g = r2g; t1v = r1v; t2v = r2v;
                }
            }
            asm volatile("" ::: "memory");
        }
    }
};
}
#define XB_TMO      128
#define XB_XCNT(j)  (256  + 64 * (j))
#define XB_XSUB(j)  (1280 + 64 * (j))
#define XB_XGEN(j)  (2304 + 64 * (j))
#define XB_TOP      3328
#define XB_TOPGEN   3392
#define XCD_BAR_WORDS 3456
#define XB_SPIN_CAP (1u << 22)
__device__ __forceinline__ unsigned xb_ld(unsigned* p)              { return __hip_atomic_load(p, __ATOMIC_RELAXED, __HIP_MEMORY_SCOPE_AGENT); }
__device__ __forceinline__ unsigned xb_add(unsigned* p, unsigned v) { return __hip_atomic_fetch_add(p, v, __ATOMIC_RELAXED, __HIP_MEMORY_SCOPE_AGENT); }
__device__ __forceinline__ unsigned xb_xcc_id() { return (unsigned)__builtin_amdgcn_s_getreg((3 << 11) | 20) & 0xFu; }
#define XB_SPIN(cond, bar) do { unsigned _sp = 0; while (cond) { __builtin_amdgcn_s_sleep(1); \
    if ((++_sp & 255u) == 0u) { if (xb_ld(&(bar)[XB_TMO])) break; if (_sp > XB_SPIN_CAP) { atomicAdd(&(bar)[XB_TMO], 1u); break; } } } } while (0)
struct XcdBarrier { unsigned* bar; unsigned x; volatile LAS unsigned* st; };
__device__ __forceinline__ XcdBarrier xcd_barrier_post(unsigned* bar, volatile LAS unsigned* st) {
    XcdBarrier b; b.bar = bar; b.x = xb_xcc_id(); b.st = st;
    if (threadIdx.x == 0) (void)xb_add(&bar[XB_XCNT(b.x)], 1u);
    return b;
}
__device__ __forceinline__ void xcd_barrier_complete(unsigned* bar, unsigned x, unsigned& nloc, unsigned& nx) {
    const unsigned G = gridDim.x * gridDim.y * gridDim.z;
    unsigned sum, cnt, mine, sp = 0u;
    for (;;) {
        sum = 0u; cnt = 0u; mine = 0u;
#pragma unroll
        for (unsigned j = 0; j < 16; ++j) { const unsigned c = xb_ld(&bar[XB_XCNT(j)]); sum += c; cnt += (c > 0u) ? 1u : 0u; mine = (j == x) ? c : mine; }
        if (sum == G) break;
        __builtin_amdgcn_s_sleep(1);
        if ((++sp & 255u) == 0u) { if (xb_ld(&bar[XB_TMO])) break; if (sp > XB_SPIN_CAP) { atomicAdd(&bar[XB_TMO], 1u); break; } }
    }
    nloc = mine > 0u ? mine : 1u; nx = cnt > 0u ? cnt : 1u;
}
__device__ __forceinline__ void xcd_barrier(const XcdBarrier& b) {
    asm volatile("s_waitcnt vmcnt(0)" ::: "memory");
    __syncthreads();
    if (threadIdx.x == 0) {
        unsigned* bar = b.bar; unsigned bx = b.x;
        asm volatile("" : "+s"(bx));
        __builtin_amdgcn_s_waitcnt(0);
        unsigned nloc = b.st[0], nx = b.st[1];
        if (nloc == 0u) { xcd_barrier_complete(bar, bx, nloc, nx); b.st[0] = nloc; b.st[1] = nx; }
        const unsigned old = xb_add(&bar[XB_XSUB(bx)], 1u);
        const unsigned gen = old / nloc;
        if (old + 1u == (gen + 1u) * nloc) {
            __builtin_amdgcn_fence(__ATOMIC_RELEASE, "agent");
            asm volatile("s_waitcnt vmcnt(0)" ::: "memory");
            const unsigned og = xb_add(&bar[XB_TOP], 1u);
            const unsigned tg = og / nx;
            if (og + 1u == (tg + 1u) * nx) xb_add(&bar[XB_TOPGEN], 1u);
            else XB_SPIN(xb_ld(&bar[XB_TOPGEN]) == tg, bar);
            __builtin_amdgcn_fence(__ATOMIC_ACQUIRE, "agent");
            xb_add(&bar[XB_XGEN(bx)], 1u);
            asm volatile("s_waitcnt vmcnt(0)" ::: "memory");
        } else {
            XB_SPIN(xb_ld(&bar[XB_XGEN(bx)]) == gen, bar);
            __builtin_amdgcn_fence(__ATOMIC_ACQUIRE, "agent");
            asm volatile("s_waitcnt vmcnt(0)" ::: "memory");
        }
    }
    __syncthreads();
}

#define MFMA32(a, b, c) __builtin_amdgcn_mfma_f32_32x32x16_bf16(a, b, c, 0, 0, 0)
typedef short v4i16_t __attribute__((ext_vector_type(4)));
typedef LAS const char* lds_cptr;
typedef LAS char* lds_ptr;
__device__ __forceinline__ int crow(int r, int hi) { return (r & 3) + 8 * (r >> 2) + 4 * hi; }
__device__ __forceinline__ s16x4 vtr(lds_cptr p) { return __builtin_bit_cast(s16x4, __builtin_amdgcn_ds_read_tr16_b64_v4i16((LAS v4i16_t*)p)); }
__device__ __forceinline__ float other_half(float x, int hi) { auto rr = __builtin_amdgcn_permlane32_swap(__float_as_uint(x), __float_as_uint(x), false, false); return __uint_as_float(hi ? rr[0] : rr[1]); }
constexpr float NEG_INF = -INFINITY;

constexpr int TB_V = 12288, TB_KB = 20480, TB_SIZE = 20992;
struct Stg { u32x4 k, k2, v; float kb; };

template <int NKS> __device__ __forceinline__ void qk64(lds_cptr kbuf, const bf16x8* qf, int r32, int hi, f32x16& p0, f32x16& p1) {
    lds_cptr kp = kbuf + hi * 1024 + r32 * 16;
#pragma unroll
    for (int ks = 0; ks < NKS; ++ks) {
        const bf16x8 a0 = *(const LAS bf16x8*)(kp + ks * 2048), a1 = *(const LAS bf16x8*)(kp + ks * 2048 + 512);
        p0 = MFMA32(a0, qf[ks], p0); p1 = MFMA32(a1, qf[ks], p1);
    }
}
template <int NKS> __device__ __forceinline__ void qk64c(lds_cptr kbuf, const bf16x8* qf, int r32, int hi, const f32x16& c, f32x16& p0, f32x16& p1) {
    lds_cptr kp = kbuf + hi * 1024 + r32 * 16;
    { const bf16x8 a0 = *(const LAS bf16x8*)(kp), a1 = *(const LAS bf16x8*)(kp + 512); p0 = MFMA32(a0, qf[0], c); p1 = MFMA32(a1, qf[0], c); }
#pragma unroll
    for (int ks = 1; ks < NKS; ++ks) {
        const bf16x8 a0 = *(const LAS bf16x8*)(kp + ks * 2048), a1 = *(const LAS bf16x8*)(kp + ks * 2048 + 512);
        p0 = MFMA32(a0, qf[ks], p0); p1 = MFMA32(a1, qf[ks], p1);
    }
}
struct AState { f32x16 o0, o1; float m, l; };
__device__ __forceinline__ void astate_init(AState& s) {
#pragma unroll
    for (int r = 0; r < 16; ++r) { s.o0[r] = 0.f; s.o1[r] = 0.f; }
    s.m = NEG_INF; s.l = 0.f;
}
__device__ __forceinline__ void pv64(f32x16& o0, f32x16& o1, lds_cptr vp, const bf16x8 (&pf)[4]) {
#pragma unroll
    for (int ks = 0; ks < 4; ++ks) {
        const s16x4 l0 = vtr(vp + ks * 1024), h0 = vtr(vp + ks * 1024 + 512), l1 = vtr(vp + 4096 + ks * 1024), h1 = vtr(vp + 4096 + ks * 1024 + 512);
        const bf16x8 v0 = (bf16x8){l0[0], l0[1], l0[2], l0[3], h0[0], h0[1], h0[2], h0[3]}, v1 = (bf16x8){l1[0], l1[1], l1[2], l1[3], h1[0], h1[1], h1[2], h1[3]};
        o0 = MFMA32(v0, pf[ks], o0); o1 = MFMA32(v1, pf[ks], o1);
    }
}
struct VFrag { bf16x8 v0[4], v1[4]; };
__device__ __forceinline__ void v_load64(VFrag& f, lds_cptr vp) {
#pragma unroll
    for (int ks = 0; ks < 4; ++ks) {
        const s16x4 l0 = vtr(vp + ks * 1024), h0 = vtr(vp + ks * 1024 + 512), l1 = vtr(vp + 4096 + ks * 1024), h1 = vtr(vp + 4096 + ks * 1024 + 512);
        f.v0[ks] = (bf16x8){l0[0], l0[1], l0[2], l0[3], h0[0], h0[1], h0[2], h0[3]}; f.v1[ks] = (bf16x8){l1[0], l1[1], l1[2], l1[3], h1[0], h1[1], h1[2], h1[3]};
    }
}
__device__ __forceinline__ void pv64f(f32x16& o0, f32x16& o1, const VFrag& f, const bf16x8 (&pf)[4]) {
#pragma unroll
    for (int ks = 0; ks < 4; ++ks) { o0 = MFMA32(f.v0[ks], pf[ks], o0); o1 = MFMA32(f.v1[ks], pf[ks], o1); }
}
__device__ __forceinline__ void pack_p(const f32x16& p0, const f32x16& p1, bf16x8 (&pf)[4]) {
    u32x4 w0, w1, w2, w3;
    w0.x = cvtpk(p0[0], p0[1]); w0.y = cvtpk(p0[2], p0[3]); w0.z = cvtpk(p0[4], p0[5]); w0.w = cvtpk(p0[6], p0[7]);
    w1.x = cvtpk(p0[8], p0[9]); w1.y = cvtpk(p0[10], p0[11]); w1.z = cvtpk(p0[12], p0[13]); w1.w = cvtpk(p0[14], p0[15]);
    w2.x = cvtpk(p1[0], p1[1]); w2.y = cvtpk(p1[2], p1[3]); w2.z = cvtpk(p1[4], p1[5]); w2.w = cvtpk(p1[6], p1[7]);
    w3.x = cvtpk(p1[8], p1[9]); w3.y = cvtpk(p1[10], p1[11]); w3.z = cvtpk(p1[12], p1[13]); w3.w = cvtpk(p1[14], p1[15]);
    pf[0] = __builtin_bit_cast(bf16x8, w0); pf[1] = __builtin_bit_cast(bf16x8, w1); pf[2] = __builtin_bit_cast(bf16x8, w2); pf[3] = __builtin_bit_cast(bf16x8, w3);
}
__device__ __forceinline__ void softmax_pv64(f32x16& p0, f32x16& p1, AState& s, lds_cptr vp, int hi) {
    VFrag vf; v_load64(vf, vp); __builtin_amdgcn_sched_barrier(0);
    float mx = fmaxf(p0[0], p1[0]);
#pragma unroll
    for (int r = 1; r < 16; ++r) mx = fmaxf(mx, fmaxf(p0[r], p1[r]));
    mx = fmaxf(mx, other_half(mx, hi));
    const float mn = fmaxf(s.m, mx), ms = (mn == NEG_INF) ? 0.f : mn;
    const float alpha = fast_exp2(s.m - ms);
    float rs = 0.f;
#pragma unroll
    for (int r = 0; r < 16; ++r) { p0[r] = fast_exp2(p0[r] - ms); p1[r] = fast_exp2(p1[r] - ms); rs += p0[r] + p1[r]; }
    rs += other_half(rs, hi);
    s.l = s.l * alpha + rs; s.m = mn;
#pragma unroll
    for (int r = 0; r < 16; ++r) { s.o0[r] *= alpha; s.o1[r] *= alpha; }
    bf16x8 pf[4]; pack_p(p0, p1, pf);
    pv64f(s.o0, s.o1, vf, pf);
}
__device__ __forceinline__ void softmax_fixed_pv64(f32x16& p0, f32x16& p1, AState& s, lds_cptr vp) {
    VFrag vf; v_load64(vf, vp); __builtin_amdgcn_sched_barrier(0);
    float rs = 0.f;
#pragma unroll
    for (int r = 0; r < 16; ++r) { p0[r] = fast_exp2(p0[r]); p1[r] = fast_exp2(p1[r]); rs += p0[r] + p1[r]; }
    s.l += rs;
    bf16x8 pf[4]; pack_p(p0, p1, pf);
    pv64f(s.o0, s.o1, vf, pf);
}
__device__ __forceinline__ void mask_causal(f32x16& p0, f32x16& p1, int kpos0, int tq, int hi) {
#pragma unroll
    for (int r = 0; r < 16; ++r) { const int kp = kpos0 + crow(r, hi); if (kp > tq) p0[r] = NEG_INF; if (kp + 32 > tq) p1[r] = NEG_INF; }
}
__device__ __forceinline__ void add_table(f32x16& p0, f32x16& p1, const LAS float* tb) {
#pragma unroll
    for (int r = 0; r < 16; ++r) { const int o = (r & 3) + 8 * (r >> 2); p0[r] += tb[o]; p1[r] += tb[o + 32]; }
}
__device__ __forceinline__ void store_o_bf16(bf16_t* orow, const f32x16& o0, const f32x16& o1, float sc, int hi) {
#pragma unroll
    for (int g = 0; g < 4; ++g) {
        u32x2 w0, w1; w0.x = cvtpk(o0[4 * g] * sc, o0[4 * g + 1] * sc); w0.y = cvtpk(o0[4 * g + 2] * sc, o0[4 * g + 3] * sc);
        w1.x = cvtpk(o1[4 * g] * sc, o1[4 * g + 1] * sc); w1.y = cvtpk(o1[4 * g + 2] * sc, o1[4 * g + 3] * sc);
        *(u32x2*)(orow + 8 * g + 4 * hi) = w0; *(u32x2*)(orow + 32 + 8 * g + 4 * hi) = w1;
    }
}
constexpr size_t MiB = 1u << 20, KiB = 1u << 10;
constexpr size_t WS_CTL = 0, CTL_ZERO_BYTES = 1 * MiB;
constexpr size_t WS_ROPE = 1 * MiB, WS_NSATAB = WS_ROPE + 512 * KiB, WS_DILTAB = WS_NSATAB + 32 * KiB, WS_CMPB = WS_DILTAB + 8 * KiB, WS_FARB = WS_CMPB + 4 * KiB;
constexpr size_t WS_WT = 4 * MiB, LW = 38 * MiB;
constexpr size_t LW_IN = 0, LW_G = 6 * MiB, LW_BR = 14 * MiB, LW_O = 16 * MiB, LW_UP = 18 * MiB, LW_DN = 29 * MiB, LW_UQ = 35 * MiB, LW_UKV = 35 * MiB + 256 * KiB, LW_PHI = 36 * MiB;
constexpr size_t BR_A = 0, BR_B = 512 * KiB, BR_C = 768 * KiB, BR_D = 1280 * KiB;
constexpr size_t WS_SIDE = 80 * MiB, WS_SSQQ = 84 * MiB, WS_SSQKV = 85 * MiB, WS_KB = 86 * MiB, WS_KROT = 87 * MiB, WS_KCMP = 91 * MiB, WS_VCMP = 100 * MiB,
                 WS_HID = 109 * MiB, WS_KMAX = 3 * MiB + 128 * KiB  , WS_LF = 2 * MiB  , WS_CMPP = 3 * MiB  , WS_ORDER = 3 * MiB + 64 * KiB  , WS_KC = 113 * MiB, WS_VC = 113 * MiB + 512 * KiB, WS_DLSE = 114 * MiB, WS_DOG = 116 * MiB;
constexpr size_t WS_H = 164 * MiB, WS_OCAT = 292 * MiB, WS_QM = 404 * MiB, WS_KVM = 468 * MiB, WS_P = 532 * MiB;
constexpr size_t WS_MERGED = 532 * MiB, WS_MSCR = 660 * MiB, WS_Y = 164 * MiB  , WS_H2 = 756 * MiB, WS_ACT = 164 * MiB  , WS_HB = 532 * MiB  , WS_Y2 = 884 * MiB  , WS_X3 = 620 * MiB  , WS_END = 1024 * MiB;
constexpr size_t MSCR_PER_WG = 512 * KiB;
constexpr size_t H8_OFF = 128 * MiB;
static_assert(WS_WT + 2 * LW <= WS_SIDE && WS_DOG + 48 * MiB <= WS_H && WS_P + 384 * MiB <= WS_END && WS_MSCR + 256 * MSCR_PER_WG <= WS_P + 384 * MiB && WS_H2 + 128 * MiB <= WS_Y2 && WS_Y2 + 128 * MiB <= WS_END, "ws map");
static_assert(WS_ACT + 352 * MiB <= WS_HB && WS_HB + 88 * MiB <= WS_X3 && WS_X3 + 128 * MiB <= WS_H2 && WS_Y + 128 * MiB <= WS_OCAT, "ws overlays");
constexpr int CW_BAR = 4096;
constexpr int CW_KMAX = 24576;
constexpr int CW_KMLA = 24832;
constexpr int CW_KROT = 25344;
constexpr int CW_Q = 16384;

constexpr int RING_BYTES = 131072, LDSCTL_OFF = RING_BYTES, MISC_OFF = LDSCTL_OFF + 320, LDS_BYTES = 147456;
constexpr int NSA_SLAB = 49152, NSA_SLAB_BYTES = 4 * 64 * 65 * 4, NSA_SEL = NSA_SLAB + NSA_SLAB_BYTES;
static_assert(NSA_SEL + 512 <= RING_BYTES && 4 * NSA_TL * 4 <= NSA_SLAB_BYTES && 2 * TB_SIZE <= NSA_SLAB, "NSA LDS map");

struct Frame {
    LAS unsigned char* lds; volatile LAS unsigned* MISC; gu32* ctl;
    int tid, lane, wave, G;
    const float* in[27]; float* out; unsigned char* ws;
};
#define WSP(T, off) ((T*)(F.ws + (off)))
#define VM_WAIT() asm volatile("s_waitcnt vmcnt(0)" ::: "memory")
#define LDS_WAIT() asm volatile("s_waitcnt lgkmcnt(0)" ::: "memory")

__device__ __forceinline__ int queue_grab(Frame& F, gu32* ctr) {
    if (F.tid == 0) F.MISC[0] = __hip_atomic_fetch_add(ctr, 1u, __ATOMIC_RELAXED, __HIP_MEMORY_SCOPE_AGENT);
    __syncthreads();
    const int v = (int)F.MISC[0];
    __syncthreads();
    return v;
}

template <bool FOX> __device__ __forceinline__ void causal_unit(Frame& F, int b, int h, int qb, float kmax_in) {
    constexpr int NKS = FOX ? 4 : 6;
    int lane_o = F.lane; asm volatile("" : "+v"(lane_o));
    const int wid = F.wave, lane = lane_o, r32 = lane & 31, hi = lane >> 5;
    const size_t rowbase = (size_t)b * SEQ;
    const int q0 = qb * 256, tq = q0 + wid * 32 + r32, NT = qb * 4 + 4;
    const bf16_t* P = WSP(const bf16_t, WS_P);
    const bf16_t *Kb, *Vb, *Qrow; int kpitch, vpitch;
    const bf16_t* Kr = WSP(const bf16_t, WS_KROT) + rowbase * 32;
    const float* kbsrc = WSP(const float, WS_KB) + (size_t)(b * 4 + h) * SEQ;
    if (FOX) { Kb = P + rowbase * PW + PC_CK + h * 64; Vb = P + rowbase * PW + PC_CV + h * 64; kpitch = PW; vpitch = PW; Qrow = P + (rowbase + tq) * PW + PC_CQ + h * 64; }
    else { const bf16_t* KV = WSP(const bf16_t, WS_KVM) + rowbase * 512 + h * 128; Kb = KV; Vb = KV + 64; kpitch = 512; vpitch = 512; Qrow = WSP(const bf16_t, WS_QM) + (rowbase + tq) * 512 + h * 96; }
    bf16x8 qf[NKS];
#pragma unroll
    for (int ks = 0; ks < NKS; ++ks) qf[ks] = *(const bf16x8*)(Qrow + ks * 16 + hi * 8);
    AState st; astate_init(st);
    lds_ptr lds = (lds_ptr)F.lds;
    const int vpo = ((lane >> 4) & 1) * 32 + (lane & 3) * 8 + (4 * hi + ((lane & 15) >> 2)) * 64;
    Stg sA, sB;
#define CU_LOAD(S, t) do { S.k = *(const u32x4*)(Kb + (size_t)((t) * 64 + lane) * kpitch + wid * 8); \
        if (!FOX) { if (wid < 4) S.k2 = *(const u32x4*)(Kr + (size_t)((t) * 64 + lane) * 32 + wid * 8); } \
        S.v = *(const u32x4*)(Vb + (size_t)((t) * 64 + 16 * (wid & 3) + (lane >> 2)) * vpitch + (wid >> 2) * 32 + (lane & 3) * 8); \
        if (FOX) { if (wid == 0) S.kb = kbsrc[(t) * 64 + lane]; else if (wid == 1) S.kb = kbsrc[(t) > 0 ? (t) * 64 - 1 : 0]; } } while (0)
#define CU_WRITE(S, bi) do { lds_ptr bp = lds + (bi) * TB_SIZE; *(LAS u32x4*)(bp + wid * 1024 + lane * 16) = S.k; \
        if (!FOX) { if (wid < 4) *(LAS u32x4*)(bp + (8 + wid) * 1024 + lane * 16) = S.k2; } \
        *(LAS u32x4*)(bp + TB_V + wid * 1024 + lane * 16) = S.v; \
        if (FOX) { if (wid == 0) *(LAS float*)(bp + TB_KB + lane * 4) = S.kb; else if (wid == 1 && lane == 0) *(LAS float*)(bp + TB_KB + 256) = S.kb; } } while (0)
    const int tq_lo = q0 + wid * 32;
    float qn = 0.f; const float kmax = kmax_in;
#pragma unroll
    for (int ks = 0; ks < NKS; ++ks)
#pragma unroll
        for (int e = 0; e < 8; ++e) { const float x = bf2f((unsigned short)qf[ks][e]); qn += x * x; }
    qn += other_half(qn, hi); qn = sqrtf(qn);
    const float bnd = qn * kmax * 1.002f + 0.05f;
    const bool fast = __all(bnd <= 50.0f);
    const float kbi = FOX ? kbsrc[tq] : 0.f;
    f32x16 cinit;
    { const float c0 = -(bnd + kbi);
#pragma unroll
      for (int r = 0; r < 16; ++r) cinit[r] = c0; }
    LAS volatile unsigned* dflag = (LAS volatile unsigned*)(lds + 2 * TB_SIZE + 64);
    const int t_first = FOX ? NT - 1 : 0, t_step = FOX ? -1 : 1;
#define CU_STEP(TT, BI, SL, SW) { const int tt = (TT), t = t_first + tt * t_step; \
        if (tt + 2 < NT) CU_LOAD(SL, t + 2 * t_step); \
        lds_cptr bp = (lds_cptr)(lds + (BI) * TB_SIZE); \
        if (64 * t <= tq_lo + 31) {                                \
            f32x16 p0, p1; \
            if (fast) qk64c<NKS>(bp, qf, r32, hi, cinit, p0, p1); \
            else { _Pragma("unroll") for (int r = 0; r < 16; ++r) { p0[r] = 0.f; p1[r] = 0.f; } qk64<NKS>(bp, qf, r32, hi, p0, p1); } \
            if (FOX) { const LAS float* kbt = (const LAS float*)(bp + TB_KB) + 4 * hi; \
                _Pragma("unroll") for (int g = 0; g < 4; ++g) { const f32x4 a = *(const LAS f32x4*)(kbt + 8 * g), c = *(const LAS f32x4*)(kbt + 32 + 8 * g); \
                    _Pragma("unroll") for (int e = 0; e < 4; ++e) { p0[4 * g + e] += a[e]; p1[4 * g + e] += c[e]; } } } \
            if (64 * t + 63 > tq_lo) mask_causal(p0, p1, 64 * t, tq, hi); \
            if (fast) softmax_fixed_pv64(p0, p1, st, bp + TB_V + vpo); else softmax_pv64(p0, p1, st, bp + TB_V + vpo, hi); \
        } \
          \
        if (FOX) { if (t > 0) { const float kb_last = *(const LAS float*)(bp + TB_KB + 256); const bool done = fast ? ((kb_last - kbi) < -150.0f) : ((qn * kmax + kb_last - st.m) < -130.0f); const unsigned alld = __all(done) ? 1u : 0u; if (lane == 0) dflag[(BI) * 8 + wid] = alld; } } \
        if (tt + 1 < NT) CU_WRITE(SW, (BI) ^ 1); \
        __syncthreads(); \
        if (FOX) { if (t > 0) { unsigned all = 1u; _Pragma("unroll") for (int w = 0; w < 8; ++w) all &= dflag[(BI) * 8 + w]; if (all) break; } } }
    CU_LOAD(sA, t_first); CU_WRITE(sA, 0);
    CU_LOAD(sA, t_first + t_step);
    __syncthreads();
    for (int t2 = 0; t2 < NT; t2 += 2) {
        CU_STEP(t2, 0, sB, sA)
        CU_STEP(t2 + 1, 1, sA, sB)
    }
#undef CU_STEP
#undef CU_LOAD
#undef CU_WRITE
    bf16_t* orow = WSP(bf16_t, WS_OCAT) + (rowbase + tq) * OCW + (FOX ? 384 : 640) + h * 64;
    const float ltot = fast ? st.l + other_half(st.l, hi) : st.l;
    store_o_bf16(orow, st.o0, st.o1, 1.0f / ltot, hi);
}
__device__ __forceinline__ void nsa_unit(Frame& F, int b, int qblk) {
    int lane_o = F.lane; asm volatile("" : "+v"(lane_o));
    const int wid = F.wave, lane = lane_o, r32 = lane & 31, hi = lane >> 5, tid = wid * 64 + lane;
    const int h = wid & 3, qs = wid >> 2;
    const int q0 = qblk * 64, cur = qblk, tq = q0 + 32 * qs + r32, tq_lo = q0 + 32 * qs;
    const size_t rowbase = (size_t)b * SEQ, row = rowbase + tq;
    const bf16_t* P = WSP(const bf16_t, WS_P);
    lds_ptr lds = (lds_ptr)F.lds;
    const int vpo = ((lane >> 4) & 1) * 32 + (lane & 3) * 8 + (4 * hi + ((lane & 15) >> 2)) * 64;
    bf16x8 qf[4];
    { const bf16_t* Qrow = P + row * PW + PC_AQ + h * 64;
#pragma unroll
      for (int ks = 0; ks < 4; ++ks) qf[ks] = *(const bf16x8*)(Qrow + ks * 16 + hi * 8); }
    Stg s; int ln;
#define NS_LOAD(Kb, kp, Vb, vp_, t) do { s.k = *(const u32x4*)((Kb) + (size_t)((t) * 64 + ln) * (kp) + wid * 8); \
        s.v = *(const u32x4*)((Vb) + (size_t)((t) * 64 + 16 * (wid & 3) + (ln >> 2)) * (vp_) + (wid >> 2) * 32 + (ln & 3) * 8); } while (0)
#define NS_FRESH() do { ln = lane; asm volatile("" : "+v"(ln)); } while (0)
#define NS_WRITE(bi) do { lds_ptr bp_ = lds + (bi) * TB_SIZE; *(LAS u32x4*)(bp_ + wid * 1024 + lane * 16) = s.k; *(LAS u32x4*)(bp_ + TB_V + wid * 1024 + lane * 16) = s.v; } while (0)
    const bf16_t* KC = WSP(const bf16_t, WS_KC) + (size_t)b * 256 * 64; const bf16_t* VC = WSP(const bf16_t, WS_VC) + (size_t)b * 256 * 64;
    const int cmax_u = (q0 + 63 - 31) >> 4, NTc = (cmax_u >> 6) + 1;
    const int cmax = (tq - 31) >> 4;
    float cm = NEG_INF, cl = 0.f;
    NS_FRESH(); NS_LOAD(KC, 64, VC, 64, 0); NS_WRITE(0);
    __syncthreads();
    for (int t = 0; t < NTc; ++t) {
        const int bi = t & 1;
        if (t + 1 < NTc) NS_LOAD(KC, 64, VC, 64, t + 1);
        { lds_cptr bp = (lds_cptr)(lds + bi * TB_SIZE); f32x16 p0, p1;
#pragma unroll
          for (int r = 0; r < 16; ++r) { p0[r] = 0.f; p1[r] = 0.f; }
          qk64<4>(bp, qf, r32, hi, p0, p1);
          float mx = NEG_INF;
#pragma unroll
          for (int r = 0; r < 16; ++r) { const int c = 64 * t + crow(r, hi); if (c > cmax) p0[r] = NEG_INF; if (c + 32 > cmax) p1[r] = NEG_INF; mx = fmaxf(mx, fmaxf(p0[r], p1[r])); }
          mx = fmaxf(mx, other_half(mx, hi));
          const float mn = fmaxf(cm, mx), ms = (mn == NEG_INF) ? 0.f : mn; float rs = 0.f;
#pragma unroll
          for (int r = 0; r < 16; ++r) rs += fast_exp2(p0[r] - ms) + fast_exp2(p1[r] - ms);
          rs += other_half(rs, hi);
          cl = cl * fast_exp2(cm - ms) + rs; cm = mn; }
        if (t + 1 < NTc) NS_WRITE(bi ^ 1);
        __syncthreads();
    }
    const float cms = (cm == NEG_INF) ? 0.f : cm, cinv = 1.0f / fmaxf(cl, 1e-30f);
    f32x16 oc0, oc1;
#pragma unroll
    for (int r = 0; r < 16; ++r) { oc0[r] = 0.f; oc1[r] = 0.f; }
    float G[32]; float carry = 0.f;
#pragma unroll
    for (int i = 0; i < 32; ++i) G[i] = 0.f;
    NS_FRESH(); NS_LOAD(KC, 64, VC, 64, 0); NS_WRITE(0);
    __syncthreads();
#pragma unroll
    for (int t = 0; t < 4; ++t) {
        if (t < NTc) {
            const int bi = t & 1;
            if (t + 1 < NTc) NS_LOAD(KC, 64, VC, 64, t + 1);
            { lds_cptr bp = (lds_cptr)(lds + bi * TB_SIZE); f32x16 p0, p1;
#pragma unroll
              for (int r = 0; r < 16; ++r) { p0[r] = 0.f; p1[r] = 0.f; }
              qk64<4>(bp, qf, r32, hi, p0, p1);
#pragma unroll
              for (int r = 0; r < 16; ++r) { const int c = 64 * t + crow(r, hi);
                  p0[r] = (c > cmax) ? 0.f : fast_exp2(p0[r] - cms) * cinv; p1[r] = (c + 32 > cmax) ? 0.f : fast_exp2(p1[r] - cms) * cinv; }
#pragma unroll
              for (int g = 0; g < 4; ++g) { const float oth = other_half(p0[4 * g + 3], hi);
                  G[t * 8 + g] = ((p0[4 * g] + p0[4 * g + 1]) + (p0[4 * g + 2] + p0[4 * g + 3])) + (hi ? oth : carry); carry = oth; }
#pragma unroll
              for (int g = 0; g < 4; ++g) { const float oth = other_half(p1[4 * g + 3], hi);
                  G[t * 8 + 4 + g] = ((p1[4 * g] + p1[4 * g + 1]) + (p1[4 * g + 2] + p1[4 * g + 3])) + (hi ? oth : carry); carry = oth; }
              bf16x8 pf[4]; pack_p(p0, p1, pf);
              pv64(oc0, oc1, bp + TB_V + vpo, pf); }
            if (t + 1 < NTc) NS_WRITE(bi ^ 1);
            __syncthreads();
        }
    }
    { LAS float* slab = (LAS float*)(lds + NSA_SLAB) + (size_t)(h * 64 + 32 * qs + r32) * 65;
#pragma unroll
      for (int i = 0; i < 32; ++i) slab[2 * i + hi] = G[i]; }
    __syncthreads();
    u32x4 tbr[4]; { const u32x4* src = WSP(const u32x4, WS_NSATAB);
#pragma unroll
      for (int i = 0; i < 4; ++i) { const int idx = tid + 512 * i; tbr[i] = (idx < 4 * NSA_TL / 4) ? src[idx] : (u32x4){0u, 0u, 0u, 0u}; } }
    float gl0, gl1, gl2; { const float* sd = WSP(const float, WS_SIDE) + row * 16 + h * 3; gl0 = sd[0]; gl1 = sd[1]; gl2 = sd[2]; }
    { const int q = tid >> 3, jg = tid & 7;
      const LAS float* s0 = (const LAS float*)(lds + NSA_SLAB) + (size_t)q * 65;
      float v[64];
#pragma unroll
      for (int k = 0; k < 64; ++k) { const float x = (s0[k] + s0[64 * 65 + k]) + (s0[2 * 64 * 65 + k] + s0[3 * 64 * 65 + k]);
          v[k] = (k == 0 || k == cur || k == cur - 1) ? 1e9f : ((k > cur) ? -1e9f : x); if ((k & 7) == 7) asm volatile("" ::: "memory"); }
      unsigned bits = 0u;
#pragma unroll
      for (int e = 0; e < 8; ++e) { const int j = 8 * jg + e;
          const float xj = (s0[j] + s0[64 * 65 + j]) + (s0[2 * 64 * 65 + j] + s0[3 * 64 * 65 + j]);
          const float vj = (j == 0 || j == cur || j == cur - 1) ? 1e9f : ((j > cur) ? -1e9f : xj);
          int rank = 0;
#pragma unroll
          for (int k = 0; k < 64; ++k) rank += (v[k] > vj || (v[k] == vj && k < j)) ? 1 : 0;
          bits |= (rank < 16 ? 1u : 0u) << e; }
      *((LAS unsigned char*)(lds + NSA_SEL) + q * 8 + jg) = (unsigned char)bits; }
    __syncthreads();
    const unsigned mlo = *(const LAS unsigned*)(lds + NSA_SEL + (32 * qs + r32) * 8), mhi = *(const LAS unsigned*)(lds + NSA_SEL + (32 * qs + r32) * 8 + 4);
    { LAS u32x4* dst = (LAS u32x4*)(lds + NSA_SLAB);
#pragma unroll
      for (int i = 0; i < 4; ++i) { const int idx = tid + 512 * i; if (idx < 4 * NSA_TL / 4) dst[idx] = tbr[i]; } }
    const LAS float* tabh = (const LAS float*)(lds + NSA_SLAB) + h * NSA_TL;
    const float farb = WSP(const float, WS_FARB)[h];
    const float g0 = sigmoid_f(gl0), g1 = sigmoid_f(gl1), g2 = sigmoid_f(gl2);
    AState st; astate_init(st);
    { const bf16_t* Kb = P + rowbase * PW + PC_KSLC; const bf16_t* Vb = P + rowbase * PW + PC_VSLC;
      NS_FRESH(); NS_LOAD(Kb, PW, Vb, PW, 0); NS_WRITE(0);
      __syncthreads();
      for (int j = 0; j <= cur; ++j) {
          const int bi = j & 1;
          if (j < cur) NS_LOAD(Kb, PW, Vb, PW, j + 1);
          const bool mine = ((j < 32) ? (mlo >> j) : (mhi >> (j - 32))) & 1u;
          if (__any(mine)) {
              lds_cptr bp = (lds_cptr)(lds + bi * TB_SIZE); f32x16 p0, p1;
#pragma unroll
              for (int r = 0; r < 16; ++r) { p0[r] = 0.f; p1[r] = 0.f; }
              qk64<4>(bp, qf, r32, hi, p0, p1);
              if (q0 - 64 * j - 63 >= NSA_DFAR) {
#pragma unroll
                  for (int r = 0; r < 16; ++r) { p0[r] += farb; p1[r] += farb; }
              } else add_table(p0, p1, tabh + (NSA_DMAX - tq + 64 * j + 4 * hi));
              if (j == cur) mask_causal(p0, p1, 64 * j, tq, hi);
              if (!mine) {
#pragma unroll
                  for (int r = 0; r < 16; ++r) { p0[r] = NEG_INF; p1[r] = NEG_INF; } }
              softmax_pv64(p0, p1, st, bp + TB_V + vpo, hi);
          }
          if (j < cur) NS_WRITE(bi ^ 1);
          __syncthreads();
      } }
    f32x16 oa0, oa1;
    { const float sc = g1 / st.l;
#pragma unroll
      for (int r = 0; r < 16; ++r) { oa0[r] = g0 * oc0[r] + sc * st.o0[r]; oa1[r] = g0 * oc1[r] + sc * st.o1[r]; } }
    astate_init(st);
    { const bf16_t* Kb = P + rowbase * PW + PC_KWIN; const bf16_t* Vb = P + rowbase * PW + PC_VWIN;
      const int jlo = cur >= 8 ? cur - 8 : 0;
      NS_FRESH(); NS_LOAD(Kb, PW, Vb, PW, jlo); NS_WRITE(0);
      __syncthreads();
      for (int j = jlo; j <= cur; ++j) {
          const int bi = (j - jlo) & 1;
          if (j < cur) NS_LOAD(Kb, PW, Vb, PW, j + 1);
          if (tq_lo - 64 * j - 63 < 512) {
              lds_cptr bp = (lds_cptr)(lds + bi * TB_SIZE); f32x16 p0, p1;
#pragma unroll
              for (int r = 0; r < 16; ++r) { p0[r] = 0.f; p1[r] = 0.f; }
              qk64<4>(bp, qf, r32, hi, p0, p1);
              add_table(p0, p1, tabh + (NSA_DMAX - tq + 64 * j + 4 * hi));
              if (!(tq_lo - 64 * j - 63 >= 0 && tq_lo + 31 - 64 * j < 512)) {
                  const int d0 = tq - 64 * j - 4 * hi;
#pragma unroll
                  for (int r = 0; r < 16; ++r) { const int d = d0 - ((r & 3) + 8 * (r >> 2)); if (d < 0 || d >= 512) p0[r] = NEG_INF; if (d - 32 < 0 || d - 32 >= 512) p1[r] = NEG_INF; }
              }
              softmax_pv64(p0, p1, st, bp + TB_V + vpo, hi);
          }
          if (j < cur) NS_WRITE(bi ^ 1);
          __syncthreads();
      } }
    { const float sc = g2 / st.l;
#pragma unroll
      for (int r = 0; r < 16; ++r) { oa0[r] += sc * st.o0[r]; oa1[r] += sc * st.o1[r]; } }
    { int tq_ = tq; asm volatile("" : "+v"(tq_)); store_o_bf16(WSP(bf16_t, WS_OCAT) + (rowbase + tq_) * OCW + h * 64, oa0, oa1, 1.0f, hi); }
#undef NS_LOAD
#undef NS_FRESH
#undef NS_WRITE
}
__device__ __forceinline__ void dil_unit(Frame& F, int b, int hh, int span) {
    int lane_o = F.lane; asm volatile("" : "+v"(lane_o));
    const int wid = F.wave, lane = lane_o, r32 = lane & 31, hi = lane >> 5, tid = wid * 64 + lane;
    const int T0 = span * 512;
    const size_t rowbase = (size_t)b * SEQ;
    const bf16_t* P = WSP(const bf16_t, WS_P) + rowbase * PW;
    lds_ptr lds = (lds_ptr)F.lds;
    LAS float* dtab = (LAS float*)(lds + 32768);
    for (int i = tid; i < 3 * 192; i += 512) dtab[i] = WSP(const float, WS_DILTAB)[((i / 192) * 2 + hh) * 192 + (i % 192)];
    __syncthreads();
    lds_ptr vst = lds + wid * 4096;
    const int vpo = ((lane >> 4) & 1) * 32 + (lane & 3) * 8 + (4 * hi + ((lane & 15) >> 2)) * 64;
    bf16_t* DOG = WSP(bf16_t, WS_DOG); float* DLSE = WSP(float, WS_DLSE);
    for (int g = 0; g < 3; ++g) {
        const int sh = 2 * g, head = 2 * g + hh;
        for (int rep = 0; rep < 2; ++rep) {
            const int wt = wid + 8 * rep;
            const int res = (g == 0) ? 0 : (g == 1 ? (wt & 3) : wt);
            const int i0 = (g == 0) ? 32 * wt : (g == 1 ? 32 * (wt >> 2) : 0);
            const int n0 = (T0 >> sh) + i0;
            const int tokq = res + ((n0 + r32) << sh);
            bf16x8 qf[4];
            { const bf16_t* Qrow = P + (size_t)tokq * PW + PC_BQ + head * 64;
#pragma unroll
              for (int ks = 0; ks < 4; ++ks) qf[ks] = *(const bf16x8*)(Qrow + ks * 16 + hi * 8); }
            f32x16 o0, o1; float m = NEG_INF, l = 0.f;
#pragma unroll
            for (int r = 0; r < 16; ++r) { o0[r] = 0.f; o1[r] = 0.f; }
#define DIL_LOAD(cc, KF, VR) do { const int nk0_ = n0 - 128 + 32 * (cc); int nk_ = nk0_ + r32; nk_ = nk_ < 0 ? 0 : nk_; const bf16_t* Krow_ = P + (size_t)(res + (nk_ << sh)) * PW + PC_BK + head * 64; \
        _Pragma("unroll") for (int ks = 0; ks < 4; ++ks) KF[ks] = *(const bf16x8*)(Krow_ + ks * 16 + hi * 8); \
        _Pragma("unroll") for (int i = 0; i < 4; ++i) { const int pc_ = lane + 64 * i, vrow_ = pc_ >> 3, c16_ = pc_ & 7; int nv_ = nk0_ + vrow_; nv_ = nv_ < 0 ? 0 : nv_; \
            VR[i] = *(const u32x4*)(P + (size_t)(res + (nv_ << sh)) * PW + PC_BV + head * 64 + c16_ * 8); } } while (0)
            int cfirst = 0; while (cfirst < 4 && n0 - 128 + 32 * cfirst + 31 < 0) ++cfirst;
            bf16x8 kfn[4]; u32x4 vrn[4];
            DIL_LOAD(cfirst, kfn, vrn);
            for (int c = cfirst; c < 5; ++c) {
                const int nk0 = n0 - 128 + 32 * c;
                { bf16x8 kf[4]; u32x4 vr[4];
#pragma unroll
                  for (int i = 0; i < 4; ++i) { kf[i] = kfn[i]; vr[i] = vrn[i]; }
                  if (c < 4) DIL_LOAD(c + 1, kfn, vrn);
#pragma unroll
                  for (int i = 0; i < 4; ++i) { const int pc = lane + 64 * i, vrow = pc >> 3, c16 = pc & 7;
                      *(LAS u32x4*)(vst + (c16 >> 2) * 2048 + vrow * 64 + (c16 & 3) * 16) = vr[i]; }
                  asm volatile("s_waitcnt lgkmcnt(0)" ::: "memory");
                  f32x16 p;
#pragma unroll
                  for (int r = 0; r < 16; ++r) p[r] = 0.f;
#pragma unroll
                  for (int ks = 0; ks < 4; ++ks) p = MFMA32(kf[ks], qf[ks], p);
                  const LAS float* tb = dtab + g * 192 + (32 - r32 + 4 * hi + 32 * c);
                  float mx = NEG_INF;
#pragma unroll
                  for (int r = 0; r < 16; ++r) { const int o = (r & 3) + 8 * (r >> 2), kk = o + 4 * hi, j = 128 + r32 - 32 * c - kk;
                      const bool ok = (j >= 0) && (j <= 128) && (nk0 + kk >= 0);
                      p[r] = ok ? p[r] + tb[o] : NEG_INF; mx = fmaxf(mx, p[r]); }
                  mx = fmaxf(mx, other_half(mx, hi));
                  const float mn = fmaxf(m, mx), ms = (mn == NEG_INF) ? 0.f : mn, alpha = fast_exp2(m - ms);
                  float rs = 0.f;
#pragma unroll
                  for (int r = 0; r < 16; ++r) { p[r] = fast_exp2(p[r] - ms); rs += p[r]; }
                  rs += other_half(rs, hi);
                  l = l * alpha + rs; m = mn;
#pragma unroll
                  for (int r = 0; r < 16; ++r) { o0[r] *= alpha; o1[r] *= alpha; }
                  u32x4 w0, w1;
                  w0.x = cvtpk(p[0], p[1]); w0.y = cvtpk(p[2], p[3]); w0.z = cvtpk(p[4], p[5]); w0.w = cvtpk(p[6], p[7]);
                  w1.x = cvtpk(p[8], p[9]); w1.y = cvtpk(p[10], p[11]); w1.z = cvtpk(p[12], p[13]); w1.w = cvtpk(p[14], p[15]);
                  const bf16x8 pf0 = __builtin_bit_cast(bf16x8, w0), pf1 = __builtin_bit_cast(bf16x8, w1);
                  lds_cptr vp = (lds_cptr)(vst + vpo);
#pragma unroll
                  for (int ks = 0; ks < 2; ++ks) {
                      const s16x4 l0 = vtr(vp + ks * 1024), h0 = vtr(vp + ks * 1024 + 512), l1 = vtr(vp + 2048 + ks * 1024), h1 = vtr(vp + 2048 + ks * 1024 + 512);
                      const bf16x8 v0 = (bf16x8){l0[0], l0[1], l0[2], l0[3], h0[0], h0[1], h0[2], h0[3]}, v1 = (bf16x8){l1[0], l1[1], l1[2], l1[3], h1[0], h1[1], h1[2], h1[3]};
                      o0 = MFMA32(v0, ks == 0 ? pf0 : pf1, o0); o1 = MFMA32(v1, ks == 0 ? pf0 : pf1, o1);
                  }
                  asm volatile("s_waitcnt lgkmcnt(0)" ::: "memory"); }
            }
#undef DIL_LOAD
            const size_t orow = rowbase + tokq;
            store_o_bf16(DOG + ((size_t)g * M + orow) * 128 + hh * 64, o0, o1, 1.0f / l, hi);
            if (hi == 0) DLSE[((size_t)g * M + orow) * 2 + hh] = m + log2f(l);
        }
    }
    VM_WAIT();
    __syncthreads();
    bf16_t* OC = WSP(bf16_t, WS_OCAT);
    for (int it = 0; it < 8; ++it) {
        const int item = tid + 512 * it, tl = item >> 3, pc = item & 7; const size_t orow = rowbase + T0 + tl;
        const float l0 = DLSE[((size_t)0 * M + orow) * 2 + hh], l1 = DLSE[((size_t)1 * M + orow) * 2 + hh], l2 = DLSE[((size_t)2 * M + orow) * 2 + hh];
        const float mx = fmaxf(l0, fmaxf(l1, l2)); float w0 = fast_exp2(l0 - mx), w1 = fast_exp2(l1 - mx), w2 = fast_exp2(l2 - mx);
        const float inv = 1.0f / (w0 + w1 + w2); w0 *= inv; w1 *= inv; w2 *= inv;
        const u32x4 a = *(const u32x4*)(DOG + ((size_t)0 * M + orow) * 128 + hh * 64 + pc * 8), bb = *(const u32x4*)(DOG + ((size_t)1 * M + orow) * 128 + hh * 64 + pc * 8),
                    cc = *(const u32x4*)(DOG + ((size_t)2 * M + orow) * 128 + hh * 64 + pc * 8);
        u32x4 w;
#pragma unroll
        for (int e = 0; e < 4; ++e) {
            const float lo = w0 * __uint_as_float(a[e] << 16) + w1 * __uint_as_float(bb[e] << 16) + w2 * __uint_as_float(cc[e] << 16);
            const float hv = w0 * __uint_as_float(a[e] & 0xffff0000u) + w1 * __uint_as_float(bb[e] & 0xffff0000u) + w2 * __uint_as_float(cc[e] & 0xffff0000u);
            w[e] = cvtpk(lo, hv); }
        *(u32x4*)(OC + orow * OCW + 256 + hh * 64 + pc * 8) = w;
    }
    __syncthreads();
}
__device__ __forceinline__ float wave_sum(float v) {
    v += xor_lane_lt32<1>(v); v += xor_lane_lt32<2>(v); v += xor_lane_lt32<4>(v); v += xor_lane_lt32<8>(v); v += xor_lane_lt32<16>(v);
    return sum_halves(v);
}
__device__ __forceinline__ int rel_bucket(int dist) {
    if (dist < 0) dist = 0;
    if (dist < 16) return dist;
    const int thr[15] = {22, 30, 40, 54, 73, 99, 134, 182, 246, 332, 450, 609, 825, 1117, 1513};
    int bkt = 16;
#pragma unroll
    for (int i = 0; i < 15; ++i) bkt += (dist >= thr[i]) ? 1 : 0;
    return bkt;
}
__device__ __forceinline__ int inproj_src(int c, float& sc) {
    sc = 1.f;
    if (c < 256) { sc = C2A; return c; }
    if (c < 652) return c;
    if (c < 656) return 2572 + (c - 652);
    if (c < 672) return -1;
    if (c < 704) { const int p = c - 672; return 2960 + (p >> 1) + 16 * (p & 1); }
    if (c < 768) return -1;
    if (c < 1920) { const int r = c - 768; if (r < 384) sc = C2A; return 652 + r; }
    if (c < 2048) return 2832 + (c - 1920);
    if (c < 2816) { const int r = c - 2048; if (r < 256) sc = C2A; return 1804 + r; }
    return 2576 + (c - 2816);
}
__device__ __forceinline__ int quq_src(int r, float& sc) {
    sc = C2D;
    if (r >= 384) return -1;
    const int hd = r / 96, w = r % 96;
    if (w < 64) return hd * 96 + w;
    const int p = w - 64; return hd * 96 + 64 + (p >> 1) + 16 * (p & 1);
}
__device__ __forceinline__ int gateperm_src(int r) {
    const int T = r >> 8, c = r & 255, pn = T >> 2, j = T & 3, bj = c >> 7, wc = (c >> 5) & 3, fq = (c >> 3) & 3, n = (c >> 2) & 1, e = c & 3;
    return (2 * bj + n) * DM * DM + 256 * pn + 64 * j + 16 * wc + 4 * fq + e;
}
__device__ __forceinline__ int branchperm_src(int r) {
    const int pn = r >> 8, c = r & 255, bj = c >> 7, wc = (c >> 5) & 3, fq = (c >> 3) & 3, n = (c >> 2) & 1, e = c & 3;
    return 256 * pn + 64 * (2 * bj + n) + 16 * wc + 4 * fq + e;
}
__device__ __forceinline__ int upperm_src(int r) { const int pn = r >> 8, c = r & 255; return (c & 128) ? DFF + 128 * pn + (c & 127) : 128 * pn + c; }
__device__ __forceinline__ void wconv_item(const float* W, int Nsrc, bf16_t* WT, int ldt, const float* kgain, int kind, LAS float* scr, int item, int nblk, int lane, bool f8out = false) {
    const int kb = item / nblk, nb = item % nblk, k0 = 64 * kb, n0 = 32 * nb;
    const int n = n0 + (lane & 31); float sc = 1.f; int src = n;
    if (kind == 1) src = inproj_src(n, sc); else if (kind == 2) src = quq_src(n, sc); else if (kind == 3) src = gateperm_src(n); else if (kind == 4) src = branchperm_src(n); else if (kind == 5) src = upperm_src(n);
    float wv[32];
#pragma unroll
    for (int i = 0; i < 32; ++i) { const int kk = 2 * i + (lane >> 5); wv[i] = (src >= 0) ? W[(size_t)(k0 + kk) * Nsrc + src] : 0.f; }
#pragma unroll
    for (int i = 0; i < 32; ++i) { const int kk = 2 * i + (lane >> 5); float v = wv[i] * sc; if (kgain) v *= kgain[k0 + kk]; scr[kk * 33 + (lane & 31)] = v; }
    LDS_WAIT(); asm volatile("" ::: "memory");
    if (f8out) {
        const int nn = lane >> 1, hh = lane & 1; const LAS float* s = scr + (32 * hh) * 33 + nn; unsigned char* dst = (unsigned char*)WT + (size_t)(n0 + nn) * ldt + k0 + 32 * hh;
#pragma unroll
        for (int j = 0; j < 2; ++j) { u32x4 o;
#pragma unroll
            for (int e = 0; e < 4; ++e) { const LAS float* q = s + (16 * j + 4 * e) * 33; o[e] = pk4_fp8(q[0] * WG8_SCALE, q[33] * WG8_SCALE, q[66] * WG8_SCALE, q[99] * WG8_SCALE); }
            *(u32x4*)(dst + 16 * j) = o; }
        LDS_WAIT(); asm volatile("" ::: "memory");
        return;
    }
    const int c = lane & 7;
#pragma unroll
    for (int j = 0; j < 4; ++j) { const int nn = (lane >> 3) + 8 * j; const LAS float* s = scr + (8 * c) * 33 + nn;
        u32x4 o; o.x = pk2(s[0 * 33], s[1 * 33]); o.y = pk2(s[2 * 33], s[3 * 33]); o.z = pk2(s[4 * 33], s[5 * 33]); o.w = pk2(s[6 * 33], s[7 * 33]);
        *(u32x4*)(WT + (size_t)(n0 + nn) * ldt + k0 + 8 * c) = o; }
    LDS_WAIT(); asm volatile("" ::: "memory");
}
constexpr int ATT_UNITS = 3328;
__device__ __forceinline__ int att_cost(int id) {
    if (id < 2048) { const int qb = 15 - (id >> 7), mla = (id >> 6) & 1; return (mla ? 5 : 4) * (qb + 1); }
    if (id < 3072) return (63 - ((id - 2048) >> 4)) + 20;
    return 30;
}
__device__ __forceinline__ int clampi(int x, int lo, int hi) { return x < lo ? lo : (x > hi ? hi : x); }
__device__ __forceinline__ int att_rank(int i) {
    const int c = att_cost(i);
    int r = clampi(16 - c / 4, 0, 16) * 64 + clampi(16 - c / 5, 0, 16) * 64 + clampi(83 - c, 0, 64) * 16 + (c < 30 ? 256 : 0);
    if (c % 4 == 0 && c / 4 >= 1 && c / 4 <= 16) r += clampi(i - (16 - c / 4) * 128, 0, 64);
    if (c % 5 == 0 && c / 5 >= 1 && c / 5 <= 16) r += clampi(i - ((16 - c / 5) * 128 + 64), 0, 64);
    if (c >= 20 && c <= 83) r += clampi(i - (2048 + (63 - (c - 20)) * 16), 0, 16);
    if (c == 30) r += clampi(i - 3072, 0, 256);
    return r;
}
__device__ __forceinline__ void p0_prologue(Frame& F) {
    LAS float* scr = (LAS float*)(F.lds + F.wave * 16384);
    const int gw = blockIdx.x * 8 + F.wave, NGW = F.G * 8, lane = F.lane;
    constexpr int I_IN = 16 * 96, I_G = 16 * 32, I_BA = 4 * 32, I_BB = 2 * 32, I_O = 16 * 32, I_UP = 16 * 176, I_DN = 44 * 32, I_UQ = 4 * 16, I_UKV = 2 * 16, I_PHI = 32 * 4;
    constexpr int I_L = I_IN + 4 * I_G + 3 * I_BA + I_BB + I_O + I_UP + I_DN + I_UQ + I_UKV + 2 * I_PHI;
    for (int it = gw; it < DEPTH * I_L; it += NGW) {
        const int l = it / I_L; int r = it % I_L;
        unsigned char* wl = F.ws + WS_WT + (size_t)l * LW;
        if (r < I_IN) { wconv_item(F.in[6] + (size_t)l * DM * DIN, DIN, (bf16_t*)(wl + LW_IN), DM, nullptr, 1, scr, r, 96, lane); continue; } r -= I_IN;
        if (r < 4 * I_G) { wconv_item(F.in[21] + (size_t)l * 4 * DM * DM, DM, (bf16_t*)(wl + LW_G), DM, nullptr, 3, scr, r, 128, lane, true); continue; } r -= 4 * I_G;
        if (r < I_BA) { wconv_item(F.in[17] + (size_t)l * 256 * DM, DM, (bf16_t*)(wl + LW_BR + BR_A), 256, nullptr, 4, scr, r, 32, lane); continue; } r -= I_BA;
        if (r < I_BB) { wconv_item(F.in[18] + (size_t)l * 128 * DM, DM, (bf16_t*)(wl + LW_BR + BR_B), 128, nullptr, 4, scr, r, 32, lane); continue; } r -= I_BB;
        if (r < I_BA) { wconv_item(F.in[19] + (size_t)l * 256 * DM, DM, (bf16_t*)(wl + LW_BR + BR_C), 256, nullptr, 4, scr, r, 32, lane); continue; } r -= I_BA;
        if (r < I_BA) { wconv_item(F.in[20] + (size_t)l * 256 * DM, DM, (bf16_t*)(wl + LW_BR + BR_D), 256, nullptr, 4, scr, r, 32, lane); continue; } r -= I_BA;
        if (r < I_O) { wconv_item(F.in[22] + (size_t)l * DM * DM, DM, (bf16_t*)(wl + LW_O), DM, nullptr, 0, scr, r, 32, lane); continue; } r -= I_O;
        if (r < I_UP) { wconv_item(F.in[23] + (size_t)l * DM * DFF2, DFF2, (bf16_t*)(wl + LW_UP), DM, nullptr, 5, scr, r, 176, lane); continue; } r -= I_UP;
        if (r < I_DN) { wconv_item(F.in[26] + (size_t)l * DFF * DM, DM, (bf16_t*)(wl + LW_DN), DFF, nullptr, 0, scr, r, 32, lane); continue; } r -= I_DN;
        if (r < I_UQ) { wconv_item(F.in[15] + (size_t)l * 256 * 384, 384, (bf16_t*)(wl + LW_UQ), 256, F.in[13] + l * 256, 2, scr, r, 16, lane); continue; } r -= I_UQ;
        if (r < I_UKV) { wconv_item(F.in[16] + (size_t)l * 128 * 512, 512, (bf16_t*)(wl + LW_UKV), 128, F.in[14] + l * 128, 0, scr, r, 16, lane); continue; } r -= I_UKV;
        if (r < I_PHI) { wconv_item(F.in[8] + (size_t)l * 2048 * 128, 128, (bf16_t*)(wl + LW_PHI), 2048, nullptr, 0, scr, r, 4, lane); continue; } r -= I_PHI;
        wconv_item(F.in[10] + (size_t)l * 2048 * 128, 128, (bf16_t*)(wl + LW_PHI) + (size_t)128 * 2048, 2048, nullptr, 0, scr, r, 4, lane);
    }
    const int gt = blockIdx.x * 512 + F.tid, NGT = F.G * 512;
    const float* rel = F.in[1];
    float* rope = WSP(float, WS_ROPE);
    for (int i = gt; i < SEQ * 16; i += NGT) { const int t = i >> 4, k = i & 15; const float inv = powf(10000.0f, -(float)(2 * k) / 32.0f); const float ang = (float)t * inv;
        float sn, cs; sincosf(ang, &sn, &cs); rope[2 * i] = cs; rope[2 * i + 1] = sn; }
    float* ntab = WSP(float, WS_NSATAB);
    for (int i = gt; i < 4 * NSA_TL; i += NGT) { const int hd = i / NSA_TL, k = i % NSA_TL, dist = NSA_DMAX - k; ntab[i] = dist >= 0 ? rel[rel_bucket(dist) * 10 + hd] * LOG2E : 0.f; }
    float* dtab = WSP(float, WS_DILTAB);
    for (int i = gt; i < 6 * 192; i += NGT) { const int gh = i / 192, k = i % 192, g = gh >> 1, hh = gh & 1, j = 160 - k; dtab[i] = (j >= 0 && j <= 128) ? rel[rel_bucket(j << (2 * g)) * 10 + 4 + 2 * g + hh] * LOG2E : 0.f; }
    if (gt < 4) WSP(float, WS_FARB)[gt] = rel[31 * 10 + gt] * LOG2E;
    if (gw < 128) { const int mi = gw >> 5, pc = gw & 31, l = mi >> 1; const float *pk1 = F.in[8], *pv1 = F.in[10]; asm volatile("" : "+s"(pk1), "+s"(pv1));
        const float* w1 = ((mi & 1) ? pv1 : pk1) + (size_t)l * 2048 * 128 + (size_t)(64 * pc) * 128 + 2 * lane; const float* cp = F.in[7] + (size_t)l * 2048 + 64 * pc;
        f32x2 a = {0.f, 0.f};
#pragma unroll 8
        for (int p = 0; p < 64; ++p) { const f32x2 w = *(const f32x2*)(w1 + (size_t)p * 128); const float cpp = cp[p]; a[0] += cpp * w[0]; a[1] += cpp * w[1]; }
        *(f32x2*)(WSP(float, WS_CMPP) + ((size_t)mi * 32 + pc) * 128 + 2 * lane) = a; }
    if (gt < ATT_UNITS) WSP(int, WS_ORDER)[att_rank(gt)] = gt;
}
__device__ __forceinline__ void cmpb_reduce(Frame& F) {
    const int i = F.tid; if (i < DEPTH * 256) { const int l = i >> 8, n = i & 255, mi = l * 2 + (n >> 7); const float* pp = WSP(const float, WS_CMPP) + (size_t)mi * 32 * 128 + (n & 127); float a = 0.f;
        for (int pc = 0; pc < 32; ++pc) a += pp[pc * 128]; WSP(float, WS_CMPB)[i] = a; }
}

template <int MODE, bool XIB, bool XOB, bool H8 = false> __device__ __forceinline__ void rowpass(Frame& F, const void* x, const bf16_t* y, size_t yrow0, void* xout, bf16_t* hout, const float* g1, const float* g2, int row_lo, int row_hi, unsigned char* h8out = nullptr) {
    int gw = blockIdx.x * 8 + F.wave; asm volatile("" : "+s"(gw));
    const int NGW = F.G * 8, lane = F.lane;
    f32x4 ga[4], gb[4];
#pragma unroll
    for (int j = 0; j < 4; ++j) { ga[j] = *(const f32x4*)(g1 + 4 * lane + 256 * j); if (MODE == 1) gb[j] = *(const f32x4*)(g2 + 4 * lane + 256 * j); }
    f32x4 xf[4], xfn[4]; u32x2 xb[4], xbn[4], yb[4], ybn[4];
#define RP_LOAD(XF, XB, YB, mm) do { if (XIB) { const u32x2* xr_ = (const u32x2*)((const bf16_t*)x + (size_t)(mm) * DM) + lane; _Pragma("unroll") for (int j = 0; j < 4; ++j) XB[j] = xr_[64 * j]; } \
        else { const f32x4* xr_ = (const f32x4*)((const float*)x + (size_t)(mm) * DM) + lane; _Pragma("unroll") for (int j = 0; j < 4; ++j) XF[j] = xr_[64 * j]; } \
        if (MODE != 0) { const u32x2* yr_ = (const u32x2*)(y + ((size_t)(mm) - yrow0) * DM) + lane; _Pragma("unroll") for (int j = 0; j < 4; ++j) YB[j] = yr_[64 * j]; } } while (0)
    int m = row_lo + gw;
    if (m < row_hi) RP_LOAD(xf, xb, yb, m);
    for (; m < row_hi; m += NGW) {
        const int mn = m + NGW;
        if (mn < row_hi) RP_LOAD(xfn, xbn, ybn, mn);
        f32x4 v[4];
#pragma unroll
        for (int j = 0; j < 4; ++j) { if (XIB) { v[j][0] = __uint_as_float(xb[j].x << 16); v[j][1] = __uint_as_float(xb[j].x & 0xffff0000u); v[j][2] = __uint_as_float(xb[j].y << 16); v[j][3] = __uint_as_float(xb[j].y & 0xffff0000u); } else v[j] = xf[j]; }
        if (MODE != 0) {
            f32x4 w[4]; float s = 0.f;
#pragma unroll
            for (int j = 0; j < 4; ++j) { const u32x2 yy = yb[j]; w[j][0] = __uint_as_float(yy.x << 16); w[j][1] = __uint_as_float(yy.x & 0xffff0000u); w[j][2] = __uint_as_float(yy.y << 16); w[j][3] = __uint_as_float(yy.y & 0xffff0000u);
                s += (w[j][0] * w[j][0] + w[j][1] * w[j][1]) + (w[j][2] * w[j][2] + w[j][3] * w[j][3]); }
            const float rstd = 1.0f / sqrtf(wave_sum(s) * (1.0f / DM) + RMS_EPS);
#pragma unroll
            for (int j = 0; j < 4; ++j) v[j] = v[j] + w[j] * rstd * ga[j];
            if (XOB) { u32x2* xo = (u32x2*)((bf16_t*)xout + (size_t)m * DM) + lane;
#pragma unroll
                for (int j = 0; j < 4; ++j) { u32x2 w2; w2.x = cvtpk(v[j][0], v[j][1]); w2.y = cvtpk(v[j][2], v[j][3]); xo[64 * j] = w2; } }
            else { f32x4* xo = (f32x4*)((float*)xout + (size_t)m * DM) + lane;
#pragma unroll
                for (int j = 0; j < 4; ++j) xo[64 * j] = v[j]; }
        }
        if (MODE != 2) {
            float s = 0.f;
#pragma unroll
            for (int j = 0; j < 4; ++j) s += (v[j][0] * v[j][0] + v[j][1] * v[j][1]) + (v[j][2] * v[j][2] + v[j][3] * v[j][3]);
            const float rstd = 1.0f / sqrtf(wave_sum(s) * (1.0f / DM) + RMS_EPS);
            u32x2* ho = (u32x2*)(hout + (size_t)m * DM) + lane;
#pragma unroll
            for (int j = 0; j < 4; ++j) { const f32x4 gg = (MODE == 1) ? gb[j] : ga[j]; const f32x4 o = v[j] * rstd * gg; u32x2 w; w.x = cvtpk(o[0], o[1]); w.y = cvtpk(o[2], o[3]); ho[64 * j] = w;
                if (H8) ((unsigned*)(h8out + (size_t)m * DM))[lane + 64 * j] = pk4_fp8(o[0] * H8_SCALE, o[1] * H8_SCALE, o[2] * H8_SCALE, o[3] * H8_SCALE); }
        }
#pragma unroll
        for (int j = 0; j < 4; ++j) { if (XIB) xb[j] = xbn[j]; else xf[j] = xfn[j]; if (MODE != 0) yb[j] = ybn[j]; }
    }
#undef RP_LOAD
}

__device__ __forceinline__ void ffn_fix_panel(Frame& F, int pm, const float* HB, bf16_t* ACT, const float* cw, const float* cb) {
#pragma unroll 2
    for (int it = F.tid; it < 4 * 2 * (DFF / 4); it += 512) {
        const int c4 = it % (DFF / 4), rr = (it / (DFF / 4)) & 1, g = pm * 4 + it / (2 * (DFF / 4)), c = c4 * 4, pn = c >> 7, cl = c & 127;
        const bool first = ((g * 64) & (SEQ - 1)) == 0;
#define HBV(gg, s, bj) (*(const f32x4*)(HB + ((size_t)(((gg) * 4 + (s)) * 22 + pn) * 256 + (bj) * 128 + cl)))
        const f32x4 z = {0.f, 0.f, 0.f, 0.f};
        const f32x4 u0g = HBV(g, 0, 0), u0v = HBV(g, 0, 1);
        f32x4 ag, bg_, cg, av, bv_, cv;
        if (rr == 0) { ag = first ? z : HBV(g - 1, 2, 0); bg_ = first ? z : HBV(g - 1, 3, 0); cg = u0g; av = first ? z : HBV(g - 1, 2, 1); bv_ = first ? z : HBV(g - 1, 3, 1); cv = u0v; }
        else { ag = first ? z : HBV(g - 1, 3, 0); bg_ = u0g; cg = HBV(g, 1, 0); av = first ? z : HBV(g - 1, 3, 1); bv_ = u0v; cv = HBV(g, 1, 1); }
#undef HBV
        const f32x4 kb = *(const f32x4*)(cb + c), k0 = *(const f32x4*)(cw + c), k1 = *(const f32x4*)(cw + DFF2 + c), k2 = *(const f32x4*)(cw + 2 * DFF2 + c);
        const f32x4 vb = *(const f32x4*)(cb + DFF + c), v0 = *(const f32x4*)(cw + DFF + c), v1 = *(const f32x4*)(cw + DFF2 + DFF + c), v2 = *(const f32x4*)(cw + 2 * DFF2 + DFF + c);
        float o[4];
#pragma unroll
        for (int e = 0; e < 4; ++e) { const float gt = kb[e] + k0[e] * ag[e] + k1[e] * bg_[e] + k2[e] * cg[e], vl = vb[e] + v0[e] * av[e] + v1[e] * bv_[e] + v2[e] * cv[e]; o[e] = gt * sigmoid_f(gt) * vl; }
        u32x2 w; w.x = cvtpk(o[0], o[1]); w.y = cvtpk(o[2], o[3]);
        *(u32x2*)(ACT + (size_t)(g * 64 + rr) * DFF + c) = w;
    }
}
#ifdef SELFCHECK
constexpr int CW_CHK = 20480;
__device__ __forceinline__ unsigned chk_hash(unsigned x) { x ^= x >> 16; x *= 0x7feb352du; x ^= x >> 15; x *= 0x846ca68bu; x ^= x >> 16; return x; }
__device__ __forceinline__ int chk_t(int i) {
    int r = 0;
    switch (i & 31) { case 0: r = 0; break; case 1: r = 1; break; case 2: r = 15; break; case 3: r = 16; break; case 4: r = 30; break; case 5: r = 31; break; case 6: r = 32; break; case 7: r = 47; break;
        case 8: r = 63; break; case 9: r = 64; break; case 10: r = 65; break; case 11: r = 127; break; case 12: r = 128; break; case 13: r = 129; break; case 14: r = 255; break; case 15: r = 256; break;
        case 16: r = 257; break; case 17: r = 511; break; case 18: r = 512; break; case 19: r = 513; break; case 20: r = 575; break; case 21: r = 1023; break; case 22: r = 1024; break; case 23: r = 1599; break;
        case 24: r = 1600; break; case 25: r = 2047; break; case 26: r = 2048; break; case 27: r = 2111; break; case 28: r = 3000; break; case 29: r = 4031; break; case 30: r = 4032; break; default: r = 4095; break; }
    return (i < 64) ? r : (int)(chk_hash(i * 7919u + 13u) & 4095u);
}
__device__ __forceinline__ bool chk_bad(float got, float ref, float scale) { const float d = fabsf(got - ref); return !(d <= 0.02f * fabsf(ref) + 0.02f * scale); }
__device__ __forceinline__ float bfr(float x) { return bf2f((unsigned short)f2bf(x)); }
__device__ __forceinline__ void chk_flag(Frame& F, int bit, bool bad, int allow) {
    LAS unsigned* cnt = (LAS unsigned*)(F.lds + 65536);
    __syncthreads(); if (threadIdx.x == 0) *cnt = 0u; __syncthreads();
    if (bad) atomicAdd((unsigned*)cnt, 1u);
    __syncthreads();
    if (threadIdx.x == 0 && *cnt > (unsigned)allow) atomicOr((unsigned*)(F.ctl + CW_CHK), 1u << bit);
    __syncthreads();
}
__device__ __forceinline__ int chk_bucket_ref(int dist) {
    if (dist < 0) dist = 0; if (dist < 16) return dist;
    const float d = (float)dist; int large = 16 + (int)(logf(d / 16.0f) / 4.852030263919617f * 16.0f); return large < 31 ? large : 31;
}
__device__ __forceinline__ bool chk_fox(Frame& F, int b, int h, int t) {
    const bf16_t* P = WSP(const bf16_t, WS_P);
    { const size_t row = (size_t)b * SEQ + t; const bf16_t* q = P + row * PW + PC_CQ + h * 64; const float* kb = WSP(const float, WS_KB) + ((size_t)b * 4 + h) * SEQ;
      float m = -INFINITY; for (int j = 0; j <= t; ++j) { const bf16_t* k = P + ((size_t)b * SEQ + j) * PW + PC_CK + h * 64; float s = 0.f; for (int d = 0; d < 64; ++d) s += bf2f(q[d]) * bf2f(k[d]); s += kb[j]; m = fmaxf(m, s); }
      float lsum = 0.f, dummy0_ = 0.f; f32x4 o = {0.f, 0.f, 0.f, 0.f};
      for (int j = 0; j <= t; ++j) { const bf16_t* k = P + ((size_t)b * SEQ + j) * PW + PC_CK + h * 64; const bf16_t* v = P + ((size_t)b * SEQ + j) * PW + PC_CV + h * 64; float s = 0.f; for (int d = 0; d < 64; ++d) s += bf2f(q[d]) * bf2f(k[d]); s += kb[j];
          const float p = exp2f(s - m); lsum += p; _Pragma("unroll") for (int e = 0; e < 4; ++e) o[e] += p * bf2f(v[21 * e]); }
      bool bad = false; _Pragma("unroll") for (int e = 0; e < 4; ++e) bad |= chk_bad(bf2f(WSP(const bf16_t, WS_OCAT)[row * OCW + 384 + h * 64 + 21 * e]), o[e] / lsum, 0.5f);
      return bad; }
}
__device__ __forceinline__ bool chk_dil(Frame& F, int b, int hh, int t) {
    const bf16_t* P = WSP(const bf16_t, WS_P); const float* rel = F.in[1];
    { const size_t row = (size_t)b * SEQ + t;
      float m = -INFINITY;
      for (int g = 0; g < 3; ++g) { const int dil = 1 << (2 * g), head = 2 * g + hh; const bf16_t* q = P + row * PW + PC_BQ + head * 64;
          for (int j = 0; j <= 128; ++j) { const int idx = t - dil * j; if (idx < 0) break; const bf16_t* k = P + ((size_t)b * SEQ + idx) * PW + PC_BK + head * 64; float s = 0.f; for (int d = 0; d < 64; ++d) s += bf2f(q[d]) * bf2f(k[d]);
              s += rel[chk_bucket_ref(dil * j) * 10 + 4 + head] * LOG2E; m = fmaxf(m, s); } }
      float lsum = 0.f, dummy0_ = 0.f; f32x4 o = {0.f, 0.f, 0.f, 0.f};
      for (int g = 0; g < 3; ++g) { const int dil = 1 << (2 * g), head = 2 * g + hh; const bf16_t* q = P + row * PW + PC_BQ + head * 64;
          for (int j = 0; j <= 128; ++j) { const int idx = t - dil * j; if (idx < 0) break; const bf16_t* k = P + ((size_t)b * SEQ + idx) * PW + PC_BK + head * 64; const bf16_t* v = P + ((size_t)b * SEQ + idx) * PW + PC_BV + head * 64; float s = 0.f; for (int d = 0; d < 64; ++d) s += bf2f(q[d]) * bf2f(k[d]);
              s += rel[chk_bucket_ref(dil * j) * 10 + 4 + head] * LOG2E; const float p = exp2f(s - m); lsum += p; _Pragma("unroll") for (int e = 0; e < 4; ++e) o[e] += p * bf2f(v[21 * e]); } }
      bool bad = false; _Pragma("unroll") for (int e = 0; e < 4; ++e) bad |= chk_bad(bf2f(WSP(const bf16_t, WS_OCAT)[row * OCW + 256 + hh * 64 + 21 * e]), o[e] / lsum, 0.5f);
      return bad; }
}
__device__ __forceinline__ bool chk_nsa(Frame& F, int b, int h, int t, int i) {
    const bf16_t* P = WSP(const bf16_t, WS_P); const float* rel = F.in[1];
    { bool bad = false;
      { const size_t row = (size_t)b * SEQ + t; const size_t rb = (size_t)b * SEQ;
      const bf16_t* KC = WSP(const bf16_t, WS_KC) + (size_t)b * 256 * 64; const bf16_t* VC = WSP(const bf16_t, WS_VC) + (size_t)b * 256 * 64;
      const int cmax = (t >= 31) ? (t - 31) / 16 : -1, cur = t >> 6;
      LAS float* imp = (LAS float*)(F.lds + 70000) + i * 65; for (int j = 0; j < 64; ++j) imp[j] = 0.f;
      f32x4 oc = {0.f, 0.f, 0.f, 0.f};
      for (int hh = 0; hh < 4; ++hh) { const bf16_t* q = P + row * PW + PC_AQ + hh * 64; float m = -INFINITY;
          for (int c = 0; c <= cmax; ++c) { float s = 0.f; for (int d = 0; d < 64; ++d) s += bf2f(q[d]) * bf2f(KC[c * 64 + d]); m = fmaxf(m, s); }
          float ls = 0.f; for (int c = 0; c <= cmax; ++c) { float s = 0.f; for (int d = 0; d < 64; ++d) s += bf2f(q[d]) * bf2f(KC[c * 64 + d]); ls += exp2f(s - m); }
          for (int c = 0; c <= cmax; ++c) { float s = 0.f; for (int d = 0; d < 64; ++d) s += bf2f(q[d]) * bf2f(KC[c * 64 + d]); const float p = exp2f(s - m) / ls;
              for (int j = 0; j < 64; ++j) if (16 * c <= 64 * j + 63 && 16 * c + 31 >= 64 * j) imp[j] += p;
              if (hh == h) _Pragma("unroll") for (int e = 0; e < 4; ++e) oc[e] += p * bf2f(VC[c * 64 + 21 * e]); } }
      for (int j = 0; j < 64; ++j) imp[j] = (j == 0 || j == cur || j == cur - 1) ? 1e9f : (j > cur ? -1e9f : imp[j]);
      unsigned long long selm = 0ull;
      for (int j = 0; j < 64; ++j) { int rank = 0; for (int k = 0; k < 64; ++k) rank += (imp[k] > imp[j] || (imp[k] == imp[j] && k < j)) ? 1 : 0; if (rank < 16) selm |= 1ull << j; }
      const bf16_t* q = P + row * PW + PC_AQ + h * 64;
      f32x4 os = {0.f, 0.f, 0.f, 0.f}, ow = {0.f, 0.f, 0.f, 0.f};
      { float m = -INFINITY; for (int pos = 0; pos <= t; ++pos) { if (!((selm >> (pos >> 6)) & 1ull)) continue; const bf16_t* k = P + (rb + pos) * PW + PC_KSLC; float s = 0.f; for (int d = 0; d < 64; ++d) s += bf2f(q[d]) * bf2f(k[d]); s += rel[chk_bucket_ref(t - pos) * 10 + h] * LOG2E; m = fmaxf(m, s); }
        float ls = 0.f; for (int pos = 0; pos <= t; ++pos) { if (!((selm >> (pos >> 6)) & 1ull)) continue; const bf16_t* k = P + (rb + pos) * PW + PC_KSLC; const bf16_t* v = P + (rb + pos) * PW + PC_VSLC; float s = 0.f; for (int d = 0; d < 64; ++d) s += bf2f(q[d]) * bf2f(k[d]); s += rel[chk_bucket_ref(t - pos) * 10 + h] * LOG2E;
            const float p = exp2f(s - m); ls += p; _Pragma("unroll") for (int e = 0; e < 4; ++e) os[e] += p * bf2f(v[21 * e]); }
        _Pragma("unroll") for (int e = 0; e < 4; ++e) os[e] /= ls; }
      { const int lo = t - 511 > 0 ? t - 511 : 0; float m = -INFINITY; for (int pos = lo; pos <= t; ++pos) { const bf16_t* k = P + (rb + pos) * PW + PC_KWIN; float s = 0.f; for (int d = 0; d < 64; ++d) s += bf2f(q[d]) * bf2f(k[d]); s += rel[chk_bucket_ref(t - pos) * 10 + h] * LOG2E; m = fmaxf(m, s); }
        float ls = 0.f; for (int pos = lo; pos <= t; ++pos) { const bf16_t* k = P + (rb + pos) * PW + PC_KWIN; const bf16_t* v = P + (rb + pos) * PW + PC_VWIN; float s = 0.f; for (int d = 0; d < 64; ++d) s += bf2f(q[d]) * bf2f(k[d]); s += rel[chk_bucket_ref(t - pos) * 10 + h] * LOG2E;
            const float p = exp2f(s - m); ls += p; _Pragma("unroll") for (int e = 0; e < 4; ++e) ow[e] += p * bf2f(v[21 * e]); }
        _Pragma("unroll") for (int e = 0; e < 4; ++e) ow[e] /= ls; }
      const float* sd = WSP(const float, WS_SIDE) + row * 16 + h * 3; const float g0 = 1.f / (1.f + expf(-sd[0])), g1 = 1.f / (1.f + expf(-sd[1])), g2 = 1.f / (1.f + expf(-sd[2]));
      _Pragma("unroll") for (int e = 0; e < 4; ++e) bad |= chk_bad(bf2f(WSP(const bf16_t, WS_OCAT)[row * OCW + h * 64 + 21 * e]), g0 * oc[e] + g1 * os[e] + g2 * ow[e], 0.3f); }
      return bad; }
}
__device__ __forceinline__ void selfcheck_a(Frame& F, int l) {
    const int i = threadIdx.x;
    const float* x = F.in[0];
    const bf16_t* H = WSP(const bf16_t, WS_H); const bf16_t* P = WSP(const bf16_t, WS_P);
    const float* rel = F.in[1];
    { const int row = (int)(chk_hash(i) % M), col = (int)(chk_hash(i + 999) & 1023); float s = 0.f; for (int k = 0; k < DM; ++k) { const float v = x[(size_t)row * DM + k]; s += v * v; }
      const float ref = x[(size_t)row * DM + col] * (1.0f / sqrtf(s / DM + RMS_EPS)) * F.in[2][l * DM + col];
      chk_flag(F, 0, chk_bad(bf2f(H[(size_t)row * DM + col]), ref, 1.0f), 0); }
    { const int row = (int)(chk_hash(i + 5) % M); int c = (i * 37 + 5) % PW; if (i < 32) c = 640 + (i & 15); else if (i < 96) c = 672 + (i & 31); else if (i < 160) c = 256 + ((i * 3) & 127);
      const float* W = F.in[6] + (size_t)l * DM * DIN; bool bad = false;
#define DOTC(dst, cc) do { float sc_; const int src_ = inproj_src((cc), sc_); float a_ = 0.f; if (src_ >= 0) for (int k = 0; k < DM; ++k) a_ += bf2f(H[(size_t)row * DM + k]) * bfr(W[(size_t)k * DIN + src_] * sc_); dst = a_; } while (0)
      float ref; DOTC(ref, c);
      if (c >= 672 && c < 704) { const int p = c - 672, ip = p >> 1; float oth; DOTC(oth, c ^ 1); const float x1 = (p & 1) ? oth : ref, x2 = (p & 1) ? ref : oth;
          const float inv = powf(10000.0f, -(float)(2 * ip) / 32.0f), ang = (float)(row & (SEQ - 1)) * inv, cs = cosf(ang), sn = sinf(ang);
          ref = (p & 1) ? (x2 * cs + x1 * sn) : (x1 * cs - x2 * sn);
          bad |= chk_bad(bf2f(WSP(const bf16_t, WS_KROT)[(size_t)row * 32 + p]), ref, 1.0f); }
      bad |= chk_bad(bf2f(P[(size_t)row * PW + c]), ref, 1.0f);
      if (c >= 640 && c < 656) bad |= chk_bad(WSP(const float, WS_SIDE)[(size_t)row * 16 + (c - 640)], ref, 1.0f);
      if (c >= 256 && c < 320) bad |= chk_bad(bf2f(WSP(const bf16_t, WS_KCMP)[(size_t)row * 64 + (c - 256)]), ref, 1.0f);
      if (c >= 320 && c < 384) bad |= chk_bad(bf2f(WSP(const bf16_t, WS_VCMP)[(size_t)row * 64 + (c - 320)]), ref, 1.0f);
      if (i >= 160 && i < 192) { float sq = 0.f, skv = 0.f; for (int k = 0; k < 256; ++k) { const float v = bf2f(P[(size_t)row * PW + PC_DQL + k]); sq += v * v; } for (int k = 0; k < 128; ++k) { const float v = bf2f(P[(size_t)row * PW + PC_DKV + k]); skv += v * v; }
          const float* a = WSP(const float, WS_SSQQ) + (size_t)row * 4; const float* b = WSP(const float, WS_SSQKV) + (size_t)row * 4;
          bad |= chk_bad(a[0] + a[1] + a[2] + a[3], sq, 10.f) || chk_bad(b[0] + b[1] + b[2] + b[3], skv, 5.f); }
      chk_flag(F, 1, bad, 0); }
    { const int b = i & 15, h = (i >> 4) & 3, t = chk_t(i >> 6); float a = 0.f; for (int j = 0; j <= t; ++j) { const float xx = WSP(const float, WS_SIDE)[((size_t)b * SEQ + j) * 16 + 12 + h] + F.in[12][l * 4 + h]; a += (xx >= 0.f) ? -log1pf(expf(-xx)) : (xx - log1pf(expf(xx))); }
      chk_flag(F, 2, chk_bad(WSP(const float, WS_KB)[((size_t)b * 4 + h) * SEQ + t], -a * LOG2E, 1.0f + fabsf(a) * 0.05f), 0); }
    chk_flag(F, 3, chk_fox(F, (i * 5) & 15, i & 3, chk_t(i >> 2)), 0);
    { const int row = (int)(chk_hash(i + 77) % M); bool bad = false;
      float sq = 0.f, skv = 0.f; for (int k = 0; k < 256; ++k) { const float v = bf2f(P[(size_t)row * PW + PC_DQL + k]); sq += v * v; } for (int k = 0; k < 128; ++k) { const float v = bf2f(P[(size_t)row * PW + PC_DKV + k]); skv += v * v; }
      const float rq = 1.0f / sqrtf(sq / 256.0f + RMS_EPS), rkv = 1.0f / sqrtf(skv / 128.0f + RMS_EPS);
      const float* wq = F.in[15] + (size_t)l * 256 * 384; const float* gq = F.in[13] + l * 256; const float* wkv = F.in[16] + (size_t)l * 128 * 512; const float* gkv = F.in[14] + l * 128;
#define QDOT(dst, src) do { float a_ = 0.f; for (int k = 0; k < 256; ++k) a_ += bf2f(P[(size_t)row * PW + PC_DQL + k]) * bfr(wq[(size_t)k * 384 + (src)] * C2D * gq[k]); dst = a_ * rq; } while (0)
      const int r = (i * 11) % 384, hd = r / 96, w = r % 96; float ref;
      if (w < 64) QDOT(ref, hd * 96 + w);
      else { const int p = w - 64, ip = p >> 1; float x1, x2; QDOT(x1, hd * 96 + 64 + ip); QDOT(x2, hd * 96 + 64 + 16 + ip); const float inv = powf(10000.0f, -(float)(2 * ip) / 32.0f), ang = (float)(row & (SEQ - 1)) * inv, cs = cosf(ang), sn = sinf(ang);
          ref = (p & 1) ? (x2 * cs + x1 * sn) : (x1 * cs - x2 * sn); }
      bad |= chk_bad(bf2f(WSP(const bf16_t, WS_QM)[(size_t)row * 512 + r]), ref, 1.5f);
      { const int c = (i * 13) & 511; float a = 0.f; for (int k = 0; k < 128; ++k) a += bf2f(P[(size_t)row * PW + PC_DKV + k]) * bfr(wkv[(size_t)k * 512 + c] * gkv[k]); bad |= chk_bad(bf2f(WSP(const bf16_t, WS_KVM)[(size_t)row * 512 + c]), a * rkv, 1.0f); }
      chk_flag(F, 4, bad, 0); }
    { const int b = (i * 3) & 15, h = i & 3, t = chk_t(i >> 2); const size_t row = (size_t)b * SEQ + t; const bf16_t* q = WSP(const bf16_t, WS_QM) + row * 512 + h * 96; const bf16_t* KV = WSP(const bf16_t, WS_KVM); const bf16_t* KR = WSP(const bf16_t, WS_KROT);
      float m = -INFINITY; for (int j = 0; j <= t; ++j) { const size_t rj = (size_t)b * SEQ + j; float s = 0.f; for (int d = 0; d < 64; ++d) s += bf2f(q[d]) * bf2f(KV[rj * 512 + h * 128 + d]); for (int d = 0; d < 32; ++d) s += bf2f(q[64 + d]) * bf2f(KR[rj * 32 + d]); m = fmaxf(m, s); }
      float lsum = 0.f, dummy0_ = 0.f; f32x4 o = {0.f, 0.f, 0.f, 0.f};
      for (int j = 0; j <= t; ++j) { const size_t rj = (size_t)b * SEQ + j; float s = 0.f; for (int d = 0; d < 64; ++d) s += bf2f(q[d]) * bf2f(KV[rj * 512 + h * 128 + d]); for (int d = 0; d < 32; ++d) s += bf2f(q[64 + d]) * bf2f(KR[rj * 32 + d]);
          const float p = exp2f(s - m); lsum += p; _Pragma("unroll") for (int e = 0; e < 4; ++e) o[e] += p * bf2f(KV[rj * 512 + h * 128 + 64 + 21 * e]); }
      bool bad = false; _Pragma("unroll") for (int e = 0; e < 4; ++e) bad |= chk_bad(bf2f(WSP(const bf16_t, WS_OCAT)[row * OCW + 640 + h * 64 + 21 * e]), o[e] / lsum, 0.5f);
      chk_flag(F, 5, bad, 0); }
    chk_flag(F, 6, chk_dil(F, (i * 7) & 15, i & 1, chk_t(i >> 1)), 0);
    { const int b = i & 15, which = (i >> 4) & 1, c = (int)(chk_hash(i + 31) % 255), d = (i * 5) & 63; const bf16_t* src = (which ? WSP(const bf16_t, WS_VCMP) : WSP(const bf16_t, WS_KCMP)) + ((size_t)b * SEQ + 16 * c) * 64;
      const float *pk1 = F.in[8], *pv1 = F.in[10], *pk2 = F.in[9], *pv2 = F.in[11]; asm volatile("" : "+s"(pk1), "+s"(pv1), "+s"(pk2), "+s"(pv2));
      const float* w1 = (which ? pv1 : pk1) + (size_t)l * 2048 * 128; const float* w2 = (which ? pv2 : pk2) + (size_t)l * 128 * 64; const float* cp = F.in[7] + (size_t)l * 2048;
      float out = 0.f;
      for (int n = 0; n < 128; ++n) { float a = 0.f, bsum = 0.f; for (int p = 0; p < 2048; ++p) { a += bf2f(src[p]) * bfr(w1[(size_t)p * 128 + n]); bsum += cp[p] * w1[(size_t)p * 128 + n]; }
          const float xx = a + bsum, g = 0.5f * xx * (1.0f + tanhf(0.7978845608028654f * (xx + 0.044715f * xx * xx * xx))); out += bfr(g) * w2[n * 64 + d]; }
      chk_flag(F, 7, chk_bad(bf2f((which ? WSP(const bf16_t, WS_VC) : WSP(const bf16_t, WS_KC))[((size_t)b * 256 + c) * 64 + d]), out, 0.5f), 0); }
    { bool bad = false; if (i < 128) bad = chk_nsa(F, (i * 9) & 15, i & 3, chk_t(i >> 2), i); chk_flag(F, 8, bad, 4); }
}
__device__ __forceinline__ void selfcheck_b(Frame& F, int l) {
    const int i = threadIdx.x; const int row = (int)(chk_hash(i + 3) % M), n = (i * 29 + 7) & 1023;
    const bf16_t* H = WSP(const bf16_t, WS_H); const bf16_t* OC = WSP(const bf16_t, WS_OCAT);
    float acc = 0.f;
    for (int br = 0; br < 4; ++br) { const float* wg = F.in[21] + ((size_t)l * 4 + br) * DM * DM; float g = 0.f; for (int k = 0; k < DM; ++k) g += bf2f(H[(size_t)row * DM + k]) * bfr(wg[(size_t)k * DM + n]);
        const int kk = (br == 1) ? 128 : 256, co = (br == 0) ? 0 : (br == 1 ? 256 : (br == 2 ? 384 : 640)); const float *pb0 = F.in[17], *pb1 = F.in[18], *pb2 = F.in[19], *pb3 = F.in[20]; asm volatile("" : "+s"(pb0), "+s"(pb1), "+s"(pb2), "+s"(pb3)); const float* wb = (br == 0 ? pb0 : (br == 1 ? pb1 : (br == 2 ? pb2 : pb3))) + (size_t)l * kk * DM; float t = 0.f; for (int k = 0; k < kk; ++k) t += bf2f(OC[(size_t)row * OCW + co + k]) * bfr(wb[(size_t)k * DM + n]);
        acc += (1.f / (1.f + expf(-g))) * bfr(t); }
    chk_flag(F, 9, chk_bad(bf2f(WSP(const bf16_t, WS_MERGED)[(size_t)row * DM + n]), acc, 0.5f), 0);
}
__device__ __forceinline__ void selfcheck_c(Frame& F, int l, const float* xin) {
    const int i = threadIdx.x; const int row = (int)(chk_hash(i + 11) % M), n = (i * 29 + 7) & 1023;
    const bf16_t* MG = WSP(const bf16_t, WS_MERGED); const float* wo = F.in[22] + (size_t)l * DM * DM; const float* Y = WSP(const float, WS_Y);
    float a = 0.f; for (int k = 0; k < DM; ++k) a += bf2f(MG[(size_t)row * DM + k]) * bfr(wo[(size_t)k * DM + n]);
    chk_flag(F, 0, chk_bad(Y[(size_t)row * DM + n], a, 1.0f), 0);
    float s = 0.f; for (int k = 0; k < DM; ++k) { const float v = Y[(size_t)row * DM + k]; s += v * v; }
    const float rstd = 1.0f / sqrtf(s / DM + RMS_EPS); float s2 = 0.f;
    for (int k = 0; k < DM; ++k) { const float v = xin[(size_t)row * DM + k] + Y[(size_t)row * DM + k] * rstd * F.in[3][l * DM + k]; s2 += v * v; }
    const float x1 = xin[(size_t)row * DM + n] + Y[(size_t)row * DM + n] * rstd * F.in[3][l * DM + n];
    const float h2 = x1 * (1.0f / sqrtf(s2 / DM + RMS_EPS)) * F.in[4][l * DM + n];
    chk_flag(F, 1, chk_bad(F.out[(size_t)row * DM + n], x1, 1.0f) || chk_bad(bf2f(WSP(const bf16_t, WS_H2)[(size_t)row * DM + n]), h2, 1.0f), 0);
}
__device__ __forceinline__ void selfcheck_d(Frame& F, int l) {
    const int i = threadIdx.x; const int row = (int)(chk_hash(i + 17) % (M / 2)); const bf16_t* H2 = WSP(const bf16_t, WS_H2); const bf16_t* U = WSP(const bf16_t, WS_U); const bf16_t* A = WSP(const bf16_t, WS_ACT);
    { const int c = (i * 41 + 3) % DFF2; const float* wu = F.in[23] + (size_t)l * DM * DFF2; float a = 0.f; for (int k = 0; k < DM; ++k) a += bf2f(H2[(size_t)row * DM + k]) * bfr(wu[(size_t)k * DFF2 + c]);
      chk_flag(F, 2, chk_bad(bf2f(U[(size_t)row * DFF2 + c]), a, 1.0f), 0); }
    { const int c = (i * 23 + 1) % DFF; const int t = row & (SEQ - 1); const float* cw = F.in[24] + (size_t)l * 3 * DFF2; const float* cb = F.in[25] + (size_t)l * DFF2; float g = cb[c], v = cb[DFF + c];
      for (int j = 0; j < 3; ++j) { const int tt = t - 2 + j; if (tt < 0) continue; g += cw[j * DFF2 + c] * bf2f(U[(size_t)(row - 2 + j) * DFF2 + c]); v += cw[j * DFF2 + DFF + c] * bf2f(U[(size_t)(row - 2 + j) * DFF2 + DFF + c]); }
      chk_flag(F, 3, chk_bad(bf2f(A[(size_t)row * DFF + c]), g / (1.f + expf(-g)) * v, 0.3f), 0); }
    { const int n = (i * 29 + 7) & 1023; const float* wd = F.in[26] + (size_t)l * DFF * DM; float a = 0.f; for (int k = 0; k < DFF; ++k) a += bf2f(A[(size_t)row * DFF + k]) * bfr(wd[(size_t)k * DM + n]);
      chk_flag(F, 4, chk_bad(WSP(const float, WS_Y2)[(size_t)row * DM + n], a, 1.0f), 0); }
}

__device__ __forceinline__ void selfcheck_e(Frame& F, int l) {
    const int i = threadIdx.x; const bf16_t* H = WSP(const bf16_t, WS_H); const bf16_t* P = WSP(const bf16_t, WS_P);
    const float* W = F.in[6] + (size_t)l * DM * DIN; const int row = (int)(chk_hash(i + 5) % M);
#define DOTC(dst, cc) do { float sc_; const int src_ = inproj_src((cc), sc_); float a_ = 0.f; if (src_ >= 0) for (int k = 0; k < DM; ++k) a_ += bf2f(H[(size_t)row * DM + k]) * bfr(W[(size_t)k * DIN + src_] * sc_); dst = a_; } while (0)
    { int c = (i * 37 + 5) % PW; if ((c >= 640 && c < 768)) c = 100; float ref; DOTC(ref, c); chk_flag(F, 0, chk_bad(bf2f(P[(size_t)row * PW + c]), ref, 1.0f), 0); }
    { const int c = 672 + (i & 31), p = c - 672, ip = p >> 1; float ref, oth; DOTC(ref, c); DOTC(oth, c ^ 1); const float x1 = (p & 1) ? oth : ref, x2 = (p & 1) ? ref : oth;
      const float inv = powf(10000.0f, -(float)(2 * ip) / 32.0f), ang = (float)(row & (SEQ - 1)) * inv, cs = cosf(ang), sn = sinf(ang); const float r = (p & 1) ? (x2 * cs + x1 * sn) : (x1 * cs - x2 * sn);
      chk_flag(F, 1, chk_bad(bf2f(WSP(const bf16_t, WS_KROT)[(size_t)row * 32 + p]), r, 1.0f), 0); }
    { const int c = 640 + (i & 15); float ref; DOTC(ref, c); chk_flag(F, 2, chk_bad(WSP(const float, WS_SIDE)[(size_t)row * 16 + (c - 640)], ref, 1.0f), 0); }
    { const int c = 256 + (i & 127); float ref; DOTC(ref, c); const float got = (c < 320) ? bf2f(WSP(const bf16_t, WS_KCMP)[(size_t)row * 64 + (c - 256)]) : bf2f(WSP(const bf16_t, WS_VCMP)[(size_t)row * 64 + (c - 320)]); chk_flag(F, 3, chk_bad(got, ref, 1.0f), 0); }
    float sq = 0.f, skv = 0.f; for (int k = 0; k < 256; ++k) { const float v = bf2f(P[(size_t)row * PW + PC_DQL + k]); sq += v * v; } for (int k = 0; k < 128; ++k) { const float v = bf2f(P[(size_t)row * PW + PC_DKV + k]); skv += v * v; }
    { const float* a = WSP(const float, WS_SSQQ) + (size_t)row * 4; const float* b = WSP(const float, WS_SSQKV) + (size_t)row * 4; chk_flag(F, 4, chk_bad(a[0] + a[1] + a[2] + a[3], sq, 10.f) || chk_bad(b[0] + b[1] + b[2] + b[3], skv, 5.f), 0); }
    const float rq = 1.0f / sqrtf(sq / 256.0f + RMS_EPS), rkv = 1.0f / sqrtf(skv / 128.0f + RMS_EPS);
    const float* wq = F.in[15] + (size_t)l * 256 * 384; const float* gq = F.in[13] + l * 256; const float* wkv = F.in[16] + (size_t)l * 128 * 512; const float* gkv = F.in[14] + l * 128;
#define QDOT(dst, src) do { float a_ = 0.f; for (int k = 0; k < 256; ++k) a_ += bf2f(P[(size_t)row * PW + PC_DQL + k]) * bfr(wq[(size_t)k * 384 + (src)] * C2D * gq[k]); dst = a_ * rq; } while (0)
    { const int hd = i & 3, w = (i >> 2) & 63; float ref; QDOT(ref, hd * 96 + w); chk_flag(F, 5, chk_bad(bf2f(WSP(const bf16_t, WS_QM)[(size_t)row * 512 + hd * 96 + w]), ref, 1.5f), 0); }
    { const int hd = i & 3, p = (i >> 2) & 31, ip = p >> 1; float x1, x2; QDOT(x1, hd * 96 + 64 + ip); QDOT(x2, hd * 96 + 64 + 16 + ip); const float inv = powf(10000.0f, -(float)(2 * ip) / 32.0f), ang = (float)(row & (SEQ - 1)) * inv, cs = cosf(ang), sn = sinf(ang);
      const float r = (p & 1) ? (x2 * cs + x1 * sn) : (x1 * cs - x2 * sn); chk_flag(F, 6, chk_bad(bf2f(WSP(const bf16_t, WS_QM)[(size_t)row * 512 + hd * 96 + 64 + p]), r, 1.5f), 0); }
    { const int c = (i * 13) & 511; float a = 0.f; for (int k = 0; k < 128; ++k) a += bf2f(P[(size_t)row * PW + PC_DKV + k]) * bfr(wkv[(size_t)k * 512 + c] * gkv[k]); chk_flag(F, 7, chk_bad(bf2f(WSP(const bf16_t, WS_KVM)[(size_t)row * 512 + c]), a * rkv, 1.0f), 0); }
    { const int b = i & 15, which = (i >> 4) & 1, c = (int)(chk_hash(i + 31) % 255), n = (i * 5) & 127; const bf16_t* src = (which ? WSP(const bf16_t, WS_VCMP) : WSP(const bf16_t, WS_KCMP)) + ((size_t)b * SEQ + 16 * c) * 64;
      const float *pk1 = F.in[8], *pv1 = F.in[10], *pk2 = F.in[9], *pv2 = F.in[11]; asm volatile("" : "+s"(pk1), "+s"(pv1), "+s"(pk2), "+s"(pv2));
      const float* w1 = (which ? pv1 : pk1) + (size_t)l * 2048 * 128; const float* w2 = (which ? pv2 : pk2) + (size_t)l * 128 * 64; const float* cp = F.in[7] + (size_t)l * 2048;
      float a = 0.f, bsum = 0.f; for (int p = 0; p < 2048; ++p) { a += bf2f(src[p]) * bfr(w1[(size_t)p * 128 + n]); bsum += cp[p] * w1[(size_t)p * 128 + n]; }
      const float xx = a + bsum, g = 0.5f * xx * (1.0f + tanhf(0.7978845608028654f * (xx + 0.044715f * xx * xx * xx)));
      const bf16_t* hid = WSP(const bf16_t, WS_HID) + (size_t)(which * 4096 + b * 256 + c) * 256 + which * 128;
      chk_flag(F, 8, chk_bad(bf2f(hid[n]), g, 0.5f), 0);
      const int d = (i * 5) & 63; float o2 = 0.f; for (int nn = 0; nn < 128; ++nn) o2 += bf2f(hid[nn]) * w2[nn * 64 + d];
      chk_flag(F, 9, chk_bad(bf2f((which ? WSP(const bf16_t, WS_VC) : WSP(const bf16_t, WS_KC))[((size_t)b * 256 + c) * 64 + d]), o2, 0.5f), 0); }
#undef DOTC
#undef QDOT
}

constexpr int CW_CNT = 20544;
__device__ __forceinline__ void selfcheck_g(Frame& F, int l) {
    const int gi = blockIdx.x * 512 + threadIdx.x; const bf16_t* H = WSP(const bf16_t, WS_H); const bf16_t* P = WSP(const bf16_t, WS_P); const float* W = F.in[6] + (size_t)l * DM * DIN;
    const int row = gi & (M - 1); unsigned nbad = 0u;
    for (int k4 = 0; k4 < 4; ++k4) { int c = (int)(chk_hash(gi * 4 + k4 + 12345u) % PW); if (c >= 640 && c < 768) c -= 200;
        float sc_; const int src_ = inproj_src(c, sc_); float a_ = 0.f; for (int k = 0; k < DM; ++k) a_ += bf2f(H[(size_t)row * DM + k]) * bfr(W[(size_t)k * DIN + src_] * sc_);
        if (chk_bad(bf2f(P[(size_t)row * PW + c]), a_, 1.0f)) ++nbad; }
    if (nbad) atomicAdd((unsigned*)(F.ctl + CW_CNT), nbad);
}
__device__ __forceinline__ void selfcheck_g_fin(Frame& F) {
    if (blockIdx.x == 0 && threadIdx.x == 0) { const unsigned cnt = __hip_atomic_load(F.ctl + CW_CNT, __ATOMIC_RELAXED, __HIP_MEMORY_SCOPE_AGENT); unsigned lg = 0; while ((1u << lg) <= cnt && lg < 15) ++lg;
        atomicOr((unsigned*)(F.ctl + CW_CHK), (cnt > 63u ? 63u : cnt) | (lg << 6)); }
}

__device__ __forceinline__ void selfcheck_f(Frame& F, int l) {
    const int i = threadIdx.x; const unsigned hsh = chk_hash(i + 4242u);
    chk_flag(F, 0, chk_fox(F, i & 15, (i >> 4) & 3, (i >> 6) * 8 + (hsh & 7)), 0);
    chk_flag(F, 1, chk_fox(F, i & 15, (i >> 4) & 3, 64 + (int)(hsh % 192u)), 0);
    chk_flag(F, 2, chk_fox(F, i & 15, (i >> 4) & 3, 256 + (int)(hsh % 3840u)), 0);
    chk_flag(F, 3, chk_dil(F, i & 15, (i >> 4) & 1, (int)(hsh & 127u)), 0);
    chk_flag(F, 4, chk_dil(F, i & 15, (i >> 4) & 1, 128 + (int)(hsh % 3968u)), 0);
    { bool bad = false; if (i < 128) bad = chk_nsa(F, i & 15, (i >> 4) & 3, (int)(hsh % 31u), i); chk_flag(F, 5, bad, 0); }
    { bool bad = false; if (i < 128) bad = chk_nsa(F, i & 15, (i >> 4) & 3, 31 + (int)(hsh % 33u), i); chk_flag(F, 6, bad, 0); }
    { bool bad = false; if (i < 128) bad = chk_nsa(F, i & 15, (i >> 4) & 3, 64 + (int)(hsh % 960u), i); chk_flag(F, 7, bad, 0); }
    { bool bad = false; if (i < 128) bad = chk_nsa(F, i & 15, (i >> 4) & 3, 1024 + (int)(hsh % 3072u), i); chk_flag(F, 8, bad, 4); }
}
__device__ __forceinline__ void selfcheck_report(Frame& F) {
    const unsigned mask = __hip_atomic_load(F.ctl + CW_CHK, __ATOMIC_RELAXED, __HIP_MEMORY_SCOPE_AGENT);
    float V = (float)(10u + (mask & 63u)); const unsigned e = 2u + ((mask >> 6) & 15u); for (unsigned k = 0; k < e; ++k) V *= 10.0f;
    for (size_t idx = (size_t)blockIdx.x * 512 + threadIdx.x; idx < (size_t)M * DM; idx += (size_t)F.G * 512) F.out[idx] = V;
}
#endif
struct SchedSimple {
    pg8::TileOrder T; const char* A; const char* B; int lda, ldb, nt; int dup = 0;
    __device__ __forceinline__ bool next(int i, GUnit& u) const { int pm, pn; if (!T.tile(i >> dup, pm, pn)) return false;
        u.A = A + (size_t)pm * 256 * lda; u.B = B + (size_t)pn * 256 * ldb; u.lda = lda; u.ldb = ldb; u.nt = nt; u.pm = pm; u.pn = pn; u.id = 0; return true; }
};
struct SchedCmp1 {
    int c; const char* kc; const char* vc; const char* B;
    __device__ __forceinline__ bool next(int i, GUnit& u) const { if (i > 0 || c >= 32) return false;
        u.A = (c < 16 ? kc : vc) + (size_t)(c & 15) * 256 * 2048; u.B = B; u.lda = 2048; u.ldb = 4096; u.nt = 32; u.pm = c; u.pn = 0; u.id = 0; return true; }
};
struct SchedMerge {
    pg8::TileOrder T; const char* ocat; const char* h; const char* wbr; const char* wg; int rg, gate;
    __device__ __forceinline__ bool next(int i, GUnit& u) const { int pm, pn; if (i >= 4 || !T.tile(rg, pm, pn)) return false;
        u.pm = pm; u.pn = pn; u.id = gate * 4 + i;
        if (gate) { u.A = h + (size_t)pm * 256 * 1024; u.lda = 1024; u.B = wg + (size_t)((pn * 4 + i) * 256) * 1024; u.ldb = 1024; u.nt = 8; }
        else { const int br = i; const int kk = (br == 1) ? 128 : 256; const size_t co = (br == 0) ? 0 : (br == 1 ? 256 : (br == 2 ? 384 : 640)), wo = (br == 0) ? BR_A : (br == 1 ? BR_B : (br == 2 ? BR_C : BR_D));
            u.A = ocat + (size_t)pm * 256 * (OCW * 2) + co * 2; u.lda = OCW * 2; u.B = wbr + wo + (size_t)pn * 256 * kk * 2; u.ldb = kk * 2; u.nt = kk / 64; }
        return true; }
};

#ifndef SDUP_INPROJ
#define SDUP_INPROJ 0
#endif
#ifndef SDUP_MERGE
#define SDUP_MERGE 0
#endif
#ifndef SDUP_WO
#define SDUP_WO 0
#endif
#ifndef SDUP_UP
#define SDUP_UP 0
#endif
#ifndef SDUP_DN
#define SDUP_DN 0
#endif
#ifndef DUP_ATTN
#define DUP_ATTN 1
#endif
#ifndef DUP_GEMM
#define DUP_GEMM 1
#endif
#ifndef DUP_MERGE
#define DUP_MERGE 1
#endif
#ifndef DUP_FFN
#define DUP_FFN 1
#endif
#ifdef ONLY_PHASE
#define PH(k) ((k) == ONLY_PHASE)
#else
#define PH(k) true
#endif
struct Args { const float* in[27]; float* out; unsigned char* ws; };
__global__ void __launch_bounds__(512, 2) hybrid_fwd(Args args) {
    extern __shared__ __attribute__((aligned(16))) unsigned char lds_raw[];
    Frame F;
    F.lds = (LAS unsigned char*)lds_raw; F.MISC = (volatile LAS unsigned*)(F.lds + MISC_OFF);
    F.tid = threadIdx.x; F.lane = F.tid & 63; F.wave = __builtin_amdgcn_readfirstlane(F.tid >> 6); F.G = gridDim.x;
#pragma unroll
    for (int i = 0; i < 27; ++i) F.in[i] = args.in[i];
    F.out = args.out; F.ws = args.ws; F.ctl = (gu32*)(args.ws + WS_CTL);
    for (int u = F.tid; u < (LDS_BYTES - LDSCTL_OFF) / 4; u += 512) ((LAS unsigned*)(F.lds + LDSCTL_OFF))[u] = 0u;
    __syncthreads();
    XcdBarrier bar = xcd_barrier_post((unsigned*)(F.ctl + CW_BAR), F.MISC + 8);
    const int c = (int)blockIdx.x;
#if defined(TIMEPROBE)
    if (threadIdx.x == 0) *(volatile LAS unsigned long long*)(F.lds + MISC_OFF + 64) = __builtin_amdgcn_s_memrealtime();
#define TSTAMP(id) do { if (blockIdx.x == 0 && threadIdx.x == 0) { volatile LAS unsigned long long* tp_ = (volatile LAS unsigned long long*)(F.lds + MISC_OFF + 64); const unsigned long long now_ = __builtin_amdgcn_s_memrealtime(); unsigned long long* a_ = (unsigned long long*)(F.ws + 90000) + (id); *a_ = *a_ + (now_ - *tp_); *tp_ = now_; } } while (0)
#else
#define TSTAMP(id) do { } while (0)
#endif

#ifndef DUP_P0
#define DUP_P0 1
#endif
    for (int rep = 0; rep < DUP_P0; ++rep) { if (rep) xcd_barrier(bar); if (PH(0)) p0_prologue(F); }
    xcd_barrier(bar); TSTAMP(0);

#ifndef XTRA_BAR
#define XTRA_BAR 0
#endif
    _Pragma("unroll") for (int xb = 0; xb < XTRA_BAR; ++xb) xcd_barrier(bar);
#define PHASE_FRESH() do { int t_ = threadIdx.x; asm volatile("" : "+v"(t_)); F.tid = t_; F.lane = t_ & 63; } while (0)
    for (int l = 0; l < DEPTH; ++l) {
        unsigned char* wl = F.ws + WS_WT + (size_t)l * LW;
        const float* xin = (l == 0) ? F.in[0] : F.out;
        PHASE_FRESH();
#ifndef DUP_RP0
#define DUP_RP0 1
#endif
        if (l == 0) { if (c == 0) cmpb_reduce(F);
          _Pragma("unroll") for (int rep = 0; rep < DUP_RP0; ++rep) { if (rep) xcd_barrier(bar); if (PH(1)) rowpass<0, false, false, true>(F, F.in[0], nullptr, 0, nullptr, WSP(bf16_t, WS_H), F.in[2] + l * DM, nullptr, 0, M, (unsigned char*)F.out + H8_OFF); }
          xcd_barrier(bar); TSTAMP(1); }
        for (int rep = 0; rep < DUP_GEMM; ++rep) if (PH(2)) { if (rep) xcd_barrier(bar); SchedSimple S; S.T.init(256, 12, F.G, c); S.A = (const char*)(F.ws + WS_H); S.B = (const char*)(wl + LW_IN); S.lda = 2048; S.ldb = 2048; S.nt = 16; S.dup = SDUP_INPROJ;
          pg8::EpiInProj E{WSP(bf16_t, WS_P), WSP(bf16_t, WS_KCMP), WSP(bf16_t, WS_VCMP), WSP(float, WS_SIDE), WSP(bf16_t, WS_KROT), WSP(const float, WS_ROPE), WSP(float, WS_SSQQ), WSP(float, WS_SSQKV), F.in[12] + l * 4, WSP(float, WS_LF)};
          pg8::gemm_phase<pg8::EpiInProj, SchedSimple, true>(F.lds, S, E); }
        xcd_barrier(bar); TSTAMP(2);
#ifndef DUP_L2A
#define DUP_L2A 1
#endif
        _Pragma("unroll") for (int rep2 = 0; rep2 < DUP_L2A; ++rep2) { if (rep2) xcd_barrier(bar);
        if (PH(3)) { SchedCmp1 S{c, (const char*)(F.ws + WS_KCMP), (const char*)(F.ws + WS_VCMP), (const char*)(wl + LW_PHI)};
          pg8::EpiCmp1 E{WSP(bf16_t, WS_HID), WSP(const float, WS_CMPB) + l * 256};
          pg8::gemm_phase<pg8::EpiCmp1, SchedCmp1, false>(F.lds, S, E);
          if (c < 32) {
              __syncthreads(); const int which = c >> 4, b = c & 15;
              int ln_ = threadIdx.x & 63; asm volatile("" : "+v"(ln_)); const int r32 = ln_ & 31, hi = ln_ >> 5;
              const bf16_t* hrow = WSP(const bf16_t, WS_HID) + ((size_t)c * 256 + F.wave * 32 + r32) * 256 + which * 128;
              const float *pk2 = F.in[9], *pv2 = F.in[11]; asm volatile("" : "+s"(pk2), "+s"(pv2)); const float* w2 = (which ? pv2 : pk2) + (size_t)l * 128 * 64;
              f32x16 o0, o1;
#pragma unroll
              for (int r = 0; r < 16; ++r) { o0[r] = 0.f; o1[r] = 0.f; }
#pragma unroll
              for (int ks = 0; ks < 8; ++ks) { const bf16x8 a = *(const bf16x8*)(hrow + ks * 16 + hi * 8);
                  const float* wp = w2 + (size_t)(ks * 16 + hi * 8) * 64 + r32; u32x4 b0, b1;
#pragma unroll
                  for (int jj = 0; jj < 4; ++jj) { b0[jj] = cvtpk(wp[(2 * jj) * 64], wp[(2 * jj + 1) * 64]); b1[jj] = cvtpk(wp[(2 * jj) * 64 + 32], wp[(2 * jj + 1) * 64 + 32]); }
                  o0 = MFMA32(a, __builtin_bit_cast(bf16x8, b0), o0); o1 = MFMA32(a, __builtin_bit_cast(bf16x8, b1), o1); }
              bf16_t* dst = (which ? WSP(bf16_t, WS_VC) : WSP(bf16_t, WS_KC)) + ((size_t)b * 256 + F.wave * 32) * 64 + r32;
#pragma unroll
              for (int r = 0; r < 16; ++r) { const int rw = crow(r, hi); dst[(size_t)rw * 64] = (bf16_t)f2bf(o0[r]); dst[(size_t)rw * 64 + 32] = (bf16_t)f2bf(o1[r]); } } }
        if (PH(4)) { int G2_ = F.G; asm volatile("" : "+s"(G2_)); const bool split = G2_ > 64; const int g2 = split ? F.G - 32 : F.G, c2 = split ? c - 32 : c;
          { SchedSimple S; S.T.init(256, 2, g2, c2 < 0 ? (1 << 28) : c2); S.A = (const char*)(F.ws + WS_P) + PC_DQL * 2; S.B = (const char*)(wl + LW_UQ); S.lda = PW * 2; S.ldb = 512; S.nt = 4;
            pg8::EpiQup E{WSP(bf16_t, WS_QM), WSP(const float, WS_SSQQ), WSP(const float, WS_ROPE)};
            pg8::gemm_phase<pg8::EpiQup, SchedSimple, true>(F.lds, S, E); }
          { SchedSimple S; S.T.init(256, 2, g2, c2 < 0 ? (1 << 28) : c2); S.A = (const char*)(F.ws + WS_P) + PC_DKV * 2; S.B = (const char*)(wl + LW_UKV); S.lda = PW * 2; S.ldb = 256; S.nt = 2;
            pg8::EpiKVup E{WSP(bf16_t, WS_KVM), WSP(const float, WS_SSQKV), (unsigned*)(F.ctl + CW_KMLA + 256 * l)};
            pg8::gemm_phase<pg8::EpiKVup, SchedSimple, true>(F.lds, S, E); } }
        PHASE_FRESH();
        if (PH(5)) {
          int G_ = F.G; asm volatile("" : "+s"(G_)); const int cb = (G_ >= 48) ? c - 32 : c;
          if (cb >= 0 && cb < BATCH) { const int b = cb, tid = F.tid; const float* lf = WSP(const float, WS_LF) + ((size_t)b * SEQ + 8 * tid) * 4;
              f32x4 v[8];
#pragma unroll
              for (int i = 0; i < 8; ++i) v[i] = *(const f32x4*)(lf + 4 * i);
#pragma unroll
              for (int i = 1; i < 8; ++i) v[i] = v[i] + v[i - 1];
              LAS f32x4* sc = (LAS f32x4*)F.lds; f32x4 run = v[7];
              sc[tid] = run; __syncthreads();
              for (int off = 1, cur = 0; off < 512; off <<= 1, cur ^= 1) { f32x4 t = sc[cur * 512 + tid]; if (tid >= off) t = t + sc[cur * 512 + tid - off]; sc[(cur ^ 1) * 512 + tid] = t; __syncthreads(); run = t; }
              const f32x4 ex = run - v[7];
              float* kb = WSP(float, WS_KB) + (size_t)b * 4 * SEQ + 8 * tid;
#pragma unroll
              for (int e = 0; e < 4; ++e) { f32x4 lo, hi4;
#pragma unroll
                  for (int i = 0; i < 4; ++i) { lo[i] = -(ex[e] + v[i][e]) * LOG2E; hi4[i] = -(ex[e] + v[4 + i][e]) * LOG2E; }
                  *(f32x4*)(kb + (size_t)e * SEQ) = lo; *(f32x4*)(kb + (size_t)e * SEQ + 4) = hi4; }
              __syncthreads();
          } }
        }
        if (PH(5)) {
          const int gt2 = c * 512 + F.tid, hp = gt2 & 1;
          for (int t2 = gt2 >> 1; t2 < M; t2 += F.G * 256) { const bf16_t* Kp = WSP(const bf16_t, WS_P) + (size_t)t2 * PW + PC_CK + hp * 128; float s0 = 0.f, s1 = 0.f, s2 = 0.f;
              if (hp == 0) { const bf16_t* Rp = WSP(const bf16_t, WS_KROT) + (size_t)t2 * 32;
#pragma unroll
                  for (int q8 = 0; q8 < 4; ++q8) { const bf16x8 ra = *(const bf16x8*)(Rp + q8 * 8);
#pragma unroll
                      for (int e = 0; e < 8; ++e) { const float xa = bf2f((unsigned short)ra[e]); s2 += xa * xa; } } }
#pragma unroll
              for (int q8 = 0; q8 < 8; ++q8) { const bf16x8 ka = *(const bf16x8*)(Kp + q8 * 8), kb2 = *(const bf16x8*)(Kp + 64 + q8 * 8);
#pragma unroll
                  for (int e = 0; e < 8; ++e) { const float xa = bf2f((unsigned short)ka[e]), xb = bf2f((unsigned short)kb2[e]); s0 += xa * xa; s1 += xb * xb; } }
              s0 = fmaxf(s0, xor_lane_lt32<2>(s0)); s0 = fmaxf(s0, xor_lane_lt32<4>(s0)); s0 = fmaxf(s0, xor_lane_lt32<8>(s0)); s0 = fmaxf(s0, xor_lane_lt32<16>(s0));
              s1 = fmaxf(s1, xor_lane_lt32<2>(s1)); s1 = fmaxf(s1, xor_lane_lt32<4>(s1)); s1 = fmaxf(s1, xor_lane_lt32<8>(s1)); s1 = fmaxf(s1, xor_lane_lt32<16>(s1));
              { auto r0 = __builtin_amdgcn_permlane32_swap(__float_as_uint(s0), __float_as_uint(s0), false, false); s0 = fmaxf(__uint_as_float(r0[0]), __uint_as_float(r0[1]));
                auto r1 = __builtin_amdgcn_permlane32_swap(__float_as_uint(s1), __float_as_uint(s1), false, false); s1 = fmaxf(__uint_as_float(r1[0]), __uint_as_float(r1[1])); }
              s2 = fmaxf(s2, xor_lane_lt32<2>(s2)); s2 = fmaxf(s2, xor_lane_lt32<4>(s2)); s2 = fmaxf(s2, xor_lane_lt32<8>(s2)); s2 = fmaxf(s2, xor_lane_lt32<16>(s2));
              { auto r2 = __builtin_amdgcn_permlane32_swap(__float_as_uint(s2), __float_as_uint(s2), false, false); s2 = fmaxf(__uint_as_float(r2[0]), __uint_as_float(r2[1])); }
              if (F.lane < 2) { unsigned* kw = (unsigned*)(F.ctl + CW_KMAX + 64 * l) + (t2 >> 12) * 4 + 2 * hp; atomicMax(kw, __float_as_uint(s0)); atomicMax(kw + 1, __float_as_uint(s1));
                  if (hp == 0) atomicMax((unsigned*)(F.ctl + CW_KROT + 16 * l) + (t2 >> 12), __float_as_uint(s2)); } } }
        xcd_barrier(bar); TSTAMP(3);
        PHASE_FRESH();
        for (int rep = 0; rep < DUP_ATTN; ++rep) { gu32* ctr = F.ctl + CW_Q + 64 * l + 16 * rep;
          if (rep) xcd_barrier(bar);
          unsigned nxtq = 0u; if (F.tid == 0) nxtq = __hip_atomic_fetch_add(ctr, 1u, __ATOMIC_RELAXED, __HIP_MEMORY_SCOPE_AGENT);
          for (;;) { if (F.tid == 0) F.MISC[0] = nxtq; __syncthreads(); const int iq = (int)F.MISC[0]; __syncthreads(); if (iq >= ATT_UNITS) break;
              if (F.tid == 0) nxtq = __hip_atomic_fetch_add(ctr, 1u, __ATOMIC_RELAXED, __HIP_MEMORY_SCOPE_AGENT);
              const int it = __builtin_amdgcn_readfirstlane(WSP(const int, WS_ORDER)[iq]);
              if (it < 2048 && PH(7)) { const int qb = 15 - (it >> 7), mla = (it >> 6) & 1, bh = it & 63; if (mla) { const gu32* km = F.ctl + CW_KMLA + 256 * l + bh * 4; const float k2 = __uint_as_float(__hip_atomic_load(km, __ATOMIC_RELAXED, __HIP_MEMORY_SCOPE_AGENT)) + __uint_as_float(__hip_atomic_load(km + 1, __ATOMIC_RELAXED, __HIP_MEMORY_SCOPE_AGENT)) + __uint_as_float(__hip_atomic_load(F.ctl + CW_KROT + 16 * l + (bh >> 2), __ATOMIC_RELAXED, __HIP_MEMORY_SCOPE_AGENT)); causal_unit<false>(F, bh >> 2, bh & 3, qb, sqrtf(k2) * 1.01f); } else causal_unit<true>(F, bh >> 2, bh & 3, qb, sqrtf(__uint_as_float(__hip_atomic_load(F.ctl + CW_KMAX + 64 * l + bh, __ATOMIC_RELAXED, __HIP_MEMORY_SCOPE_AGENT)))); }
              else if (it < 3072 && PH(8)) { const int r = it - 2048; nsa_unit(F, r & 15, 63 - (r >> 4)); }
              else if (it < 3328 && PH(9)) { const int r = it - 3072; dil_unit(F, r & 15, (r >> 4) & 1, r >> 5); } } }
        xcd_barrier(bar); TSTAMP(5);
#if defined(SELFCHECK) && SELFCHECK == 1
        if (c == 0) selfcheck_a(F, l);
#endif
#if defined(SELFCHECK) && SELFCHECK == 3
        if (c == 0) selfcheck_e(F, l);
        xcd_barrier(bar); selfcheck_report(F); return;
#endif
#if defined(SELFCHECK) && SELFCHECK == 5
        selfcheck_g(F, l); xcd_barrier(bar); selfcheck_g_fin(F);
        xcd_barrier(bar); selfcheck_report(F); return;
#endif
#if defined(SELFCHECK) && SELFCHECK == 4
        if (c == 0) selfcheck_f(F, l);
        xcd_barrier(bar); selfcheck_report(F); return;
#endif
        for (int rep = 0; rep < DUP_MERGE; ++rep) if (PH(10)) { if (rep) xcd_barrier(bar); SchedMerge S; S.T.init(256, 4, F.G, c); S.ocat = (const char*)(F.ws + WS_OCAT); S.h = (const char*)F.out + H8_OFF; S.wbr = (const char*)(wl + LW_BR); S.wg = (const char*)(wl + LW_G);
          unsigned char* scr = F.ws + WS_MSCR + (size_t)c * MSCR_PER_WG;
          pg8::EpiMerge E{WSP(bf16_t, WS_MERGED), scr};
          for (int rg = 0; rg < 4; ++rg) { S.rg = rg; S.gate = 0; pg8::gemm_phase<pg8::EpiMerge, SchedMerge, true, false>(F.lds, S, E);
                                           S.gate = 1; pg8::gemm_phase<pg8::EpiMerge, SchedMerge, true, true>(F.lds, S, E); } }
        xcd_barrier(bar); TSTAMP(6);
#if defined(SELFCHECK) && SELFCHECK == 1
        if (c == 0) selfcheck_b(F, l);
        xcd_barrier(bar); selfcheck_report(F); return;
#endif
        if (PH(11)) { SchedSimple S; S.T.init(256, 4, F.G, c); S.A = (const char*)(F.ws + WS_MERGED); S.B = (const char*)(wl + LW_O); S.lda = 2048; S.ldb = 2048; S.nt = 16; S.dup = SDUP_WO;
          pg8::EpiBf16 E{WSP(bf16_t, WS_Y), DM};
          pg8::gemm_phase<pg8::EpiBf16, SchedSimple, true>(F.lds, S, E); }
        xcd_barrier(bar); TSTAMP(7);
        PHASE_FRESH();
        if (PH(12)) { if (l == 0) rowpass<1, false, true>(F, F.in[0], WSP(const bf16_t, WS_Y), 0, F.out, WSP(bf16_t, WS_H2), F.in[3] + l * DM, F.in[4] + l * DM, 0, M);
                      else rowpass<1, true, true>(F, F.out, WSP(const bf16_t, WS_Y), 0, WSP(bf16_t, WS_X3), WSP(bf16_t, WS_H2), F.in[3] + l * DM, F.in[4] + l * DM, 0, M); }
        xcd_barrier(bar); TSTAMP(8);
#ifndef DUP_UP
#define DUP_UP 1
#endif
        _Pragma("unroll") for (int rep = 0; rep < DUP_UP; ++rep) if (PH(13)) { if (rep) xcd_barrier(bar); SchedSimple S; S.T.init(256, 22, F.G, c); S.A = (const char*)(F.ws + WS_H2); S.B = (const char*)(wl + LW_UP); S.lda = 2048; S.ldb = 2048; S.nt = 16; S.dup = SDUP_UP;
          pg8::EpiUpConv E{WSP(bf16_t, WS_ACT), WSP(float, WS_HB), F.in[24] + (size_t)l * 3 * DFF2, F.in[25] + (size_t)l * DFF2};
          pg8::gemm_phase<pg8::EpiUpConv, SchedSimple, true>(F.lds, S, E); }
        xcd_barrier(bar); TSTAMP(9);
        PHASE_FRESH();
        if (PH(15)) { SchedSimple S; S.T.init(256, 4, F.G, c); S.A = (const char*)(F.ws + WS_ACT); S.B = (const char*)(wl + LW_DN); S.lda = DFF * 2; S.ldb = DFF * 2; S.nt = DFF / 64; S.dup = SDUP_DN;
          { int pm, pn; for (int i = 0; S.T.tile(i, pm, pn); ++i) ffn_fix_panel(F, pm, WSP(const float, WS_HB), WSP(bf16_t, WS_ACT), F.in[24] + (size_t)l * 3 * DFF2, F.in[25] + (size_t)l * DFF2); }
          VM_WAIT(); __syncthreads();
          pg8::EpiBf16 E{WSP(bf16_t, WS_Y2), DM};
          pg8::gemm_phase<pg8::EpiBf16, SchedSimple, true>(F.lds, S, E); }
        xcd_barrier(bar); TSTAMP(11);
        PHASE_FRESH();
        if (PH(16)) { if (l + 1 < DEPTH) rowpass<1, true, true, true>(F, F.out, WSP(const bf16_t, WS_Y2), 0, F.out, WSP(bf16_t, WS_H), F.in[5] + l * DM, F.in[2] + (l + 1) * DM, 0, M, (unsigned char*)F.out + H8_OFF);
                      else rowpass<2, true, false>(F, WSP(const bf16_t, WS_X3), WSP(const bf16_t, WS_Y2), 0, F.out, nullptr, F.in[5] + l * DM, nullptr, 0, M); }
        xcd_barrier(bar); TSTAMP(12);
    }
#if defined(TIMEPROBE)
    { xcd_barrier(bar); const unsigned long long* a_ = (const unsigned long long*)(F.ws + 90000); const float V1 = (float)a_[TIMEPROBE_A] * 0.01f, V2 = (float)a_[TIMEPROBE_B] * 0.01f * 1000.0f;
      for (size_t idx = (size_t)blockIdx.x * 512 + threadIdx.x; idx < (size_t)M * DM; idx += (size_t)F.G * 512) F.out[idx] = (idx == 12345) ? V2 : V1; }
#endif
}

extern "C" void kernel_launch(void* const* d_in, const int* in_sizes, int n_in, void* d_out, int out_size, void* d_ws, size_t ws_size, hipStream_t stream) {
    static int grid = 0;
    if (grid == 0) {
        if (n_in != 27 || in_sizes[0] != M * DM || out_size != M * DM || ws_size < WS_END) { fprintf(stderr, "kernel_launch: unexpected shapes (n_in %d, in0 %d, out %d, ws %zu)\n", n_in, n_in > 0 ? in_sizes[0] : -1, out_size, ws_size); grid = -1; return; }
        int dev = 0, cus = 0, per_cu = 0;
        if (hipGetDevice(&dev) != hipSuccess || hipDeviceGetAttribute(&cus, hipDeviceAttributeMultiprocessorCount, dev) != hipSuccess) { grid = -1; return; }
        if (hipFuncSetAttribute((const void*)hybrid_fwd, hipFuncAttributeMaxDynamicSharedMemorySize, LDS_BYTES) != hipSuccess) { fprintf(stderr, "kernel_launch: hipFuncSetAttribute failed\n"); grid = -1; return; }
        if (hipOccupancyMaxActiveBlocksPerMultiprocessor(&per_cu, (const void*)hybrid_fwd, 512, LDS_BYTES) != hipSuccess || per_cu < 1) fprintf(stderr, "kernel_launch: occupancy query says %d\n", per_cu);
        (void)hipGetLastError();
        grid = cus;
    }
    if (grid < 0) return;
    if (hipMemsetAsync((char*)d_ws + WS_CTL, 0, CTL_ZERO_BYTES, stream) != hipSuccess) return;
    Args a{};
    for (int i = 0; i < 27; ++i) a.in[i] = (const float*)d_in[i];
    a.out = (float*)d_out; a.ws = (unsigned char*)d_ws;
    hipLaunchKernelGGL(hybrid_fwd, dim3(grid), dim3(512), LDS_BYTES, stream, a);
}
```

```cpp
#include <hip/hip_runtime.h>
#include <hip/hip_bf16.h>
#include <cstdio>
#include <cstdint>
#include <cmath>

#define GAS __attribute__((address_space(1)))
#define LAS __attribute__((address_space(3)))
typedef unsigned short bf16_t;
typedef short bf16x8 __attribute__((ext_vector_type(8)));
typedef short s16x4 __attribute__((ext_vector_type(4)));
typedef float f32x4 __attribute__((ext_vector_type(4)));
typedef float f32x2 __attribute__((ext_vector_type(2)));
typedef float f32x16 __attribute__((ext_vector_type(16)));
typedef unsigned u32x4 __attribute__((ext_vector_type(4)));
typedef unsigned u32x2 __attribute__((ext_vector_type(2)));
typedef GAS unsigned gu32;

constexpr int BATCH = 16, SEQ = 4096, DM = 1024, M = BATCH * SEQ, DEPTH = 2;
constexpr int DIN = 2992, PW = 3072;
constexpr int DFF = 2816, DFF2 = 5632;
constexpr float LOG2E = 1.4426950408889634f;
constexpr float C2A = 0.125f * LOG2E;
constexpr float C2D = 0.10206207261596575f * LOG2E;
constexpr float RMS_EPS = 1e-6f;
constexpr float H8_SCALE = 8.0f, WG8_SCALE = 64.0f, GATE_UNSCALE = 1.0f / (H8_SCALE * WG8_SCALE);
constexpr int PC_AQ = 0, PC_KCMP = 256, PC_VCMP = 320, PC_KSLC = 384, PC_VSLC = 448, PC_KWIN = 512, PC_VWIN = 576,
              PC_MISC = 640, PC_KROPE = 672, PC_BQ = 768, PC_BK = 1152, PC_BV = 1536, PC_DKV = 1920,
              PC_CQ = 2048, PC_CK = 2304, PC_CV = 2560, PC_DQL = 2816;
constexpr int OCW = 896;
constexpr int NSA_DFAR = 1536, NSA_DMAX = 1664, NSA_TL = 1728;

__device__ __forceinline__ unsigned f2bf(float f) { unsigned u = __float_as_uint(f); return (u + 0x7fffu + ((u >> 16) & 1u)) >> 16; }
__device__ __forceinline__ unsigned pk2(float lo, float hi) { return f2bf(lo) | (f2bf(hi) << 16); }
__device__ __forceinline__ float bf2f(unsigned short b) { return __uint_as_float((unsigned)b << 16); }
typedef __bf16 bf16x2_t __attribute__((ext_vector_type(2)));
__device__ __forceinline__ unsigned cvtpk(float lo, float hi) { f32x2 v = {lo, hi}; bf16x2_t b = __builtin_convertvector(v, bf16x2_t); return __builtin_bit_cast(unsigned, b); }
__device__ __forceinline__ unsigned pk4_fp8(float a, float b, float c, float d) { int w = 0; w = __builtin_amdgcn_cvt_pk_fp8_f32(a, b, w, false); w = __builtin_amdgcn_cvt_pk_fp8_f32(c, d, w, true); return (unsigned)w; }
__device__ __forceinline__ float fast_exp2(float x) { return __builtin_amdgcn_exp2f(x); }
__device__ __forceinline__ float fast_rcp(float x) { return __builtin_amdgcn_rcpf(x); }
template <int MASK> __device__ __forceinline__ float xor_lane_lt32(float v) { return __uint_as_float(__builtin_amdgcn_ds_swizzle((int)__float_as_uint(v), (MASK << 10) | 0x1f)); }
__device__ __forceinline__ float sum_halves(float v) { auto rr = __builtin_amdgcn_permlane32_swap(__float_as_uint(v), __float_as_uint(v), false, false); return __uint_as_float(rr[0]) + __uint_as_float(rr[1]); }
__device__ __forceinline__ float sigmoid_f(float x) { return fast_rcp(1.0f + fast_exp2(-x * LOG2E)); }

namespace pg8 {
constexpr int BM = 256, BK = 64, HALF = 128, HTB = HALF * BK * 2  , STAGE_BYTES = 8 * HTB, NXCD = 8, WGM = 8;
__host__ __device__ __forceinline__ int lds_byte(int r, int c) { const int st = (r >> 4) * 2 + (c >> 5), rr = r & 15, cc = c & 31, ob = rr * 64 + cc * 2; return st * 1024 + (ob ^ (((ob >> 9) & 1) << 5)); }
__host__ __device__ __forceinline__ void stage_rc(int b, int& R, int& C) { const int st = b / 1024, sb = b % 1024, swz = sb ^ (((sb >> 9) & 1) << 5); R = (st >> 1) * 16 + swz / 64; C = (st & 1) * 32 + (swz % 64) / 2; }
__host__ __device__ __forceinline__ int perm32(int rho) { const int n = rho >> 4, i = rho & 15; return 8 * (i >> 2) + 4 * n + (i & 3); }

typedef int v8i_t __attribute__((ext_vector_type(8)));
typedef int v4i_t __attribute__((ext_vector_type(4)));
__device__ __forceinline__ v8i_t cat8(const bf16x8 lo, const bf16x8 hi) { const v4i_t a = __builtin_bit_cast(v4i_t, lo), b = __builtin_bit_cast(v4i_t, hi); return __builtin_shufflevector(a, b, 0, 1, 2, 3, 4, 5, 6, 7); }
struct GUnit { const char* A; const char* B; int lda, ldb, nt, pm, pn, id; };

struct TileOrder {
    int nM, nN, nwg, G, c;
    __device__ __forceinline__ void init(int nM_, int nN_, int G_, int c_) { nM = nM_; nN = nN_; nwg = nM * nN; G = G_; c = c_; }
    __device__ __forceinline__ bool tile(int i, int& pm, int& pn) const {
        const long L = (long)i * G + c; if (L >= nwg) return false;
        int wgid = (int)L; { const int q = nwg / NXCD, r = nwg % NXCD, xcd = wgid % NXCD, off = wgid / NXCD; wgid = (xcd < r ? xcd * (q + 1) : r * (q + 1) + (xcd - r) * q) + off; }
        const int nig = WGM * nN, gid = wgid / nig, fm = gid * WGM, gsz = (nM - fm) < WGM ? (nM - fm) : WGM;
        pm = fm + ((wgid % nig) % gsz); pn = (wgid % nig) / gsz; return true;
    }
};

template <class Epi, class Sched, bool ALIGN_EPI, bool F8 = false>
__device__ __forceinline__ void gemm_phase(LAS unsigned char* lds, const Sched& S, const Epi& E) {
    int tid_o = threadIdx.x; asm volatile("" : "+v"(tid_o));
    const int tid = tid_o, wid = __builtin_amdgcn_readfirstlane(tid >> 6), lane = tid & 63, wr = wid >> 2, wc = wid & 3; int fr = lane & 15, fq = lane >> 4;
    int sR[2], sC[2], sRb[2];
#pragma unroll
    for (int i = 0; i < 2; ++i) { stage_rc(tid * 16 + i * 8192, sR[i], sC[i]); sRb[i] = Epi::PERM ? ((sR[i] & ~31) + perm32(sR[i] & 31)) : sR[i]; sC[i] *= 2; }
    const size_t kstep = (size_t)(BK * 2);
    const unsigned ldsw = (unsigned)wid * 1024u;
    const int aoff = lds_byte(wr * 64 + fr, fq * 8), boff = lds_byte(wc * 32 + fr, fq * 8);
#define PG8_SA(b, h) (((b) * 2 + (h)) * HTB)
#define PG8_SB(b, h) ((4 + (b) * 2 + (h)) * HTB)
#define PG8_STAGE(bufoff, gbase, rows, ld) do { _Pragma("unroll") for (int _i = 0; _i < 2; ++_i) \
        __builtin_amdgcn_global_load_lds((const unsigned*)((const char*)(gbase) + (unsigned)((rows)[_i] * (ld) + sC[_i])), (LAS unsigned*)(lds + (bufoff) + ldsw + _i * 8192), 16, 0, 0); } while (0)
#define PG8_LDA(dst, b, h) do { _Pragma("unroll") for (int m = 0; m < 4; ++m) _Pragma("unroll") for (int k = 0; k < 2; ++k) dst[m][k] = *(const LAS bf16x8*)(lds + PG8_SA(b, h) + aoff + m * 2048 + k * 1024); } while (0)
#define PG8_LDB(dst, b, h) do { _Pragma("unroll") for (int n = 0; n < 2; ++n) _Pragma("unroll") for (int k = 0; k < 2; ++k) dst[n][k] = *(const LAS bf16x8*)(lds + PG8_SB(b, h) + boff + n * 2048 + k * 1024); } while (0)
#define PG8_MMA(ai, bj, At, Bt) do { __builtin_amdgcn_s_setprio(1); _Pragma("unroll") for (int m = 0; m < 4; ++m) _Pragma("unroll") for (int n = 0; n < 2; ++n) _Pragma("unroll") for (int k = 0; k < 2; ++k) \
        acc[ai][bj][m][n] = __builtin_amdgcn_mfma_f32_16x16x32_bf16(Bt[n][k], At[m][k], acc[ai][bj][m][n], 0, 0, 0); __builtin_amdgcn_s_setprio(0); } while (0)
#define PG8_LDA8(dst, b, h) do { _Pragma("unroll") for (int m = 0; m < 4; ++m) { dst[m].lo = *(const LAS v4i_t*)(lds + PG8_SA(b, h) + aoff + m * 2048); dst[m].hi = *(const LAS v4i_t*)(lds + PG8_SA(b, h) + aoff + m * 2048 + 1024); } } while (0)
#define PG8_LDB8(dst, b, h) do { _Pragma("unroll") for (int n = 0; n < 2; ++n) { dst[n].lo = *(const LAS v4i_t*)(lds + PG8_SB(b, h) + boff + n * 2048); dst[n].hi = *(const LAS v4i_t*)(lds + PG8_SB(b, h) + boff + n * 2048 + 1024); } } while (0)
#define PG8_MMA8(ai, bj, At, Bt) do { __builtin_amdgcn_s_setprio(1); _Pragma("unroll") for (int m = 0; m < 4; ++m) _Pragma("unroll") for (int n = 0; n < 2; ++n) \
        asm volatile("v_mfma_f32_16x16x128_f8f6f4 %0, %1, %2, %0" : "+v"(acc[ai][bj][m][n]) : "v"(Bt[n]), "v"(At[m])); __builtin_amdgcn_s_setprio(0); } while (0)
#define PG8_WAIT_V(n) asm volatile("s_waitcnt vmcnt(" #n ")" ::: "memory")
#define PG8_WAIT_L(n) asm volatile("s_waitcnt lgkmcnt(" #n ")" ::: "memory")
#define PG8_BAR __builtin_amdgcn_s_barrier()
#define PG8_SCHED __builtin_amdgcn_sched_barrier(0)
#define PG8_KLOOP(MM, LDA_, LDB_, At, B0, B1) for (int t = 0; t < nt; t += 2) { \
            const bool last = (t == nt - 2); \
            const char* a1 = cA + (size_t)(t + 1) * kstep; \
            const char* a2 = last ? nA : cA + (size_t)(t + 2) * kstep; const char* b2 = last ? nB : cB + (size_t)(t + 2) * kstep; \
            const char* a3 = a2 + kstep; const char* b3 = b2 + kstep; \
            const int ldA2 = last ? ldAn : ldAc, ldB2 = last ? ldBn : ldBc; \
            const size_t hA2 = last ? hAn : hAc, hB2 = last ? hBn : hBc; \
              \
            LDB_(B0, 0, 0); LDB_(B1, 0, 1); PG8_SCHED; LDA_(At, 0, 0); PG8_STAGE(PG8_SA(1, 1), a1 + hAc, sR, ldAc); \
            PG8_WAIT_V(8); PG8_WAIT_L(0); PG8_BAR; MM(0, 0, At, B0); MM(0, 1, At, B1); PG8_BAR; PG8_SCHED; \
              \
            LDA_(At, 0, 1); PG8_STAGE(PG8_SB(0, 0), b2, sRb, ldB2); PG8_STAGE(PG8_SB(0, 1), b2 + hB2, sRb, ldB2); PG8_STAGE(PG8_SA(0, 0), a2, sR, ldA2); \
            PG8_WAIT_V(8); PG8_WAIT_L(0); PG8_BAR; MM(1, 0, At, B0); MM(1, 1, At, B1); PG8_BAR; PG8_SCHED; \
              \
            LDB_(B0, 1, 0); LDB_(B1, 1, 1); PG8_SCHED; LDA_(At, 1, 0); PG8_STAGE(PG8_SA(0, 1), a2 + hA2, sR, ldA2); \
            PG8_WAIT_V(8); PG8_WAIT_L(0); PG8_BAR; MM(0, 0, At, B0); MM(0, 1, At, B1); PG8_BAR; PG8_SCHED; \
              \
            LDA_(At, 1, 1); PG8_STAGE(PG8_SB(1, 0), b3, sRb, ldB2); PG8_STAGE(PG8_SB(1, 1), b3 + hB2, sRb, ldB2); PG8_STAGE(PG8_SA(1, 0), a3, sR, ldA2); \
            PG8_WAIT_V(8); PG8_WAIT_L(0); PG8_BAR; MM(1, 0, At, B0); MM(1, 1, At, B1); PG8_BAR; PG8_SCHED; \
        }
    GUnit cur, nxt; int ui = 0;
    if (!S.next(0, cur)) return;
    f32x4 acc[2][2][4][2];
#pragma unroll
    for (int a = 0; a < 2; ++a)
#pragma unroll
        for (int b = 0; b < 2; ++b)
#pragma unroll
            for (int m = 0; m < 4; ++m)
#pragma unroll
                for (int n = 0; n < 2; ++n) acc[a][b][m][n] = (f32x4){0.f, 0.f, 0.f, 0.f};
    bf16x8 At[4][2], B0[2][2], B1[2][2]; v8i_t At8[4], B08[2], B18[2];
    int ldAc = cur.lda, ldBc = cur.ldb; size_t hAc = (size_t)HALF * ldAc, hBc = (size_t)HALF * ldBc;
    const char* cA = cur.A; const char* cB = cur.B;
    PG8_STAGE(PG8_SB(0, 0), cB, sRb, ldBc); PG8_STAGE(PG8_SB(0, 1), cB + hBc, sRb, ldBc); PG8_STAGE(PG8_SA(0, 0), cA, sR, ldAc); PG8_STAGE(PG8_SA(0, 1), cA + hAc, sR, ldAc);
    if (wr == 1) PG8_BAR;
    PG8_WAIT_V(2); PG8_BAR;
    PG8_STAGE(PG8_SB(1, 0), cB + kstep, sRb, ldBc); PG8_STAGE(PG8_SA(1, 0), cA + kstep, sR, ldAc); PG8_STAGE(PG8_SB(1, 1), cB + hBc + kstep, sRb, ldBc);
    PG8_WAIT_V(6); PG8_BAR;
    for (;;) {
        const bool has_next = S.next(ui + 1, nxt);
        int ldAn, ldBn; const char* nA; const char* nB;
        if (has_next) { ldAn = nxt.lda; ldBn = nxt.ldb; nA = nxt.A; nB = nxt.B; } else { ldAn = ldAc; ldBn = ldBc; nA = cA; nB = cB; }
        const size_t hAn = (size_t)HALF * ldAn, hBn = (size_t)HALF * ldBn;
        int nt = cur.nt; asm volatile("" : "+s"(nt));
        bool f8u = false; if constexpr (F8) f8u = Epi::f8(cur);
        if (F8 && f8u) { PG8_KLOOP(PG8_MMA8, PG8_LDA8, PG8_LDB8, At8, B08, B18) asm volatile("s_nop 15\n\ts_nop 15" ::: "memory"); }
        else { PG8_KLOOP(PG8_MMA, PG8_LDA, PG8_LDB, At, B0, B1) }
        if constexpr (ALIGN_EPI) { if (wr == 0) PG8_BAR; }
        E(acc, cur, wr, wc, fr, fq);
        if (!has_next) break;
#pragma unroll
        for (int a = 0; a < 2; ++a)
#pragma unroll
            for (int b = 0; b < 2; ++b)
#pragma unroll
                for (int m = 0; m < 4; ++m)
#pragma unroll
                    for (int n = 0; n < 2; ++n) acc[a][b][m][n] = (f32x4){0.f, 0.f, 0.f, 0.f};
        cur = nxt; cA = nA; cB = nB; ++ui;
        ldAc = ldAn; ldBc = ldBn; hAc = hAn; hBc = hBn;
        if constexpr (ALIGN_EPI) { if (wr == 1) PG8_BAR; }
    }
    PG8_WAIT_V(0);
    if constexpr (!ALIGN_EPI) { if (wr == 0) PG8_BAR; }
    PG8_BAR;
#undef PG8_SA
#undef PG8_SB
#undef PG8_STAGE
#undef PG8_LDA
#undef PG8_LDB
#undef PG8_MMA
#undef PG8_MMA8
#undef PG8_LDA8
#undef PG8_LDB8
#undef PG8_KLOOP
#undef PG8_WAIT_V
#undef PG8_WAIT_L
#undef PG8_BAR
#undef PG8_SCHED
}
}
using pg8::GUnit;
namespace pg8 {
#define EPI_OPAQUE() asm volatile("" : "+v"(fr), "+v"(fq))
struct EpiBf16 {
    static constexpr bool PERM = true;
    bf16_t* O; int ldc;
    __device__ __forceinline__ void operator()(const f32x4 (&acc)[2][2][4][2], const GUnit& u, int wr, int wc, int fr, int fq) const {
        EPI_OPAQUE();
        const int row0 = u.pm * BM + wr * 64 + fr, col0 = u.pn * BM + wc * 32 + 8 * fq;
#pragma unroll
        for (int ai = 0; ai < 2; ++ai)
#pragma unroll
            for (int m = 0; m < 4; ++m) { bf16_t* rowp = O + (size_t)(row0 + ai * HALF + m * 16) * ldc + col0;
#pragma unroll
                for (int bj = 0; bj < 2; ++bj) { const f32x4 v0 = acc[ai][bj][m][0], v1 = acc[ai][bj][m][1];
                    u32x4 w; w.x = cvtpk(v0[0], v0[1]); w.y = cvtpk(v0[2], v0[3]); w.z = cvtpk(v1[0], v1[1]); w.w = cvtpk(v1[2], v1[3]);
                    *(u32x4*)(rowp + bj * HALF) = w; } }
    }
};
struct EpiF32 {
    static constexpr bool PERM = false;
    float* O; int ldc;
    __device__ __forceinline__ void operator()(const f32x4 (&acc)[2][2][4][2], const GUnit& u, int wr, int wc, int fr, int fq) const {
        EPI_OPAQUE();
        const int row0 = u.pm * BM + wr * 64 + fr, col0 = u.pn * BM + wc * 32 + 4 * fq;
#pragma unroll
        for (int ai = 0; ai < 2; ++ai)
#pragma unroll
            for (int m = 0; m < 4; ++m) { float* rowp = O + (size_t)(row0 + ai * HALF + m * 16) * ldc + col0;
#pragma unroll
                for (int bj = 0; bj < 2; ++bj)
#pragma unroll
                    for (int n = 0; n < 2; ++n) *(f32x4*)(rowp + bj * HALF + n * 16) = acc[ai][bj][m][n]; }
    }
};
__device__ __forceinline__ void rope8(f32x4& v0, f32x4& v1, const float* cs  ) {
    const f32x4 a = *(const f32x4*)cs, b = *(const f32x4*)(cs + 4);
    f32x4 r0, r1;
    r0[0] = v0[0] * a[0] - v0[1] * a[1]; r0[1] = v0[1] * a[0] + v0[0] * a[1];
    r0[2] = v0[2] * a[2] - v0[3] * a[3]; r0[3] = v0[3] * a[2] + v0[2] * a[3];
    r1[0] = v1[0] * b[0] - v1[1] * b[1]; r1[1] = v1[1] * b[0] + v1[0] * b[1];
    r1[2] = v1[2] * b[2] - v1[3] * b[3]; r1[3] = v1[3] * b[2] + v1[2] * b[3];
    v0 = r0; v1 = r1;
}
struct EpiInProj {
    static constexpr bool PERM = true;
    bf16_t* P; bf16_t* kcmp; bf16_t* vcmp; float* side; bf16_t* krot; const float* rope; float* ssq_q; float* ssq_kv; const float* fbias; float* lf;
    __device__ __forceinline__ void operator()(const f32x4 (&acc)[2][2][4][2], const GUnit& u, int wr, int wc, int fr, int fq) const {
        EPI_OPAQUE();
        const int row0 = u.pm * BM + wr * 64 + fr, col0 = u.pn * BM + wc * 32 + 8 * fq;
#pragma unroll
        for (int ai = 0; ai < 2; ++ai)
#pragma unroll
            for (int m = 0; m < 4; ++m) { const int row = row0 + ai * HALF + m * 16; bf16_t* rowp = P + (size_t)row * PW + col0;
                float ssq = 0.f;
#pragma unroll
                for (int bj = 0; bj < 2; ++bj) { f32x4 v0 = acc[ai][bj][m][0], v1 = acc[ai][bj][m][1];
                    if (u.pn == 2 && bj == 1) {
                        if (wc == 0 && fq < 2) { float* sp = side + (size_t)row * 16 + 8 * fq; *(f32x4*)sp = v0; *(f32x4*)(sp + 4) = v1;
                            if (fq == 1) { const f32x4 fb = *(const f32x4*)fbias; f32x4 s1;
#pragma unroll
                                for (int e = 0; e < 4; ++e) { const float x = v1[e] + fb[e]; s1[e] = (x >= 0.f) ? -log1pf(expf(-x)) : (x - log1pf(expf(x))); }
                                *(f32x4*)(lf + (size_t)row * 4) = s1; } }
                        if (wc == 1) { rope8(v0, v1, rope + (size_t)(row & (SEQ - 1)) * 32 + 8 * fq);
                            u32x4 w; w.x = cvtpk(v0[0], v0[1]); w.y = cvtpk(v0[2], v0[3]); w.z = cvtpk(v1[0], v1[1]); w.w = cvtpk(v1[2], v1[3]);
                            *(u32x4*)(krot + (size_t)row * 32 + 8 * fq) = w; }
                    }
                    u32x4 w; w.x = cvtpk(v0[0], v0[1]); w.y = cvtpk(v0[2], v0[3]); w.z = cvtpk(v1[0], v1[1]); w.w = cvtpk(v1[2], v1[3]);
                    *(u32x4*)(rowp + bj * HALF) = w;
                    if (u.pn == 1 && bj == 0) { bf16_t* cp = (wc < 2 ? kcmp : vcmp) + (size_t)row * 64 + (wc & 1) * 32 + 8 * fq; *(u32x4*)cp = w; }
                    if (u.pn == 11 || (u.pn == 7 && bj == 1)) ssq += (v0[0] * v0[0] + v0[1] * v0[1]) + (v0[2] * v0[2] + v0[3] * v0[3]) + (v1[0] * v1[0] + v1[1] * v1[1]) + (v1[2] * v1[2] + v1[3] * v1[3]);
                }
                if (u.pn == 11 || u.pn == 7) { ssq += xor_lane_lt32<16>(ssq); ssq = sum_halves(ssq);
                    if (fq == 0) (u.pn == 11 ? ssq_q : ssq_kv)[(size_t)row * 4 + wc] = ssq; }
                asm volatile("" ::: "memory");
            }
    }
};
struct EpiQup {
    static constexpr bool PERM = true;
    bf16_t* O; const float* ssq_q; const float* rope;
    __device__ __forceinline__ void operator()(const f32x4 (&acc)[2][2][4][2], const GUnit& u, int wr, int wc, int fr, int fq) const {
        EPI_OPAQUE();
        const int row0 = u.pm * BM + wr * 64 + fr, col0 = u.pn * BM + wc * 32 + 8 * fq;
#pragma unroll
        for (int ai = 0; ai < 2; ++ai)
#pragma unroll
            for (int m = 0; m < 4; ++m) { const int row = row0 + ai * HALF + m * 16; bf16_t* rowp = O + (size_t)row * 512 + col0;
                const f32x4 pq = *(const f32x4*)(ssq_q + (size_t)row * 4);
                const float rstd = 1.0f / sqrtf(((pq[0] + pq[1]) + (pq[2] + pq[3])) * (1.0f / 256.0f) + RMS_EPS);
#pragma unroll
                for (int bj = 0; bj < 2; ++bj) { f32x4 v0 = acc[ai][bj][m][0] * rstd, v1 = acc[ai][bj][m][1] * rstd;
                    const int c8 = col0 + bj * HALF, within = c8 % 96;
                    if (c8 < 384 && within >= 64) rope8(v0, v1, rope + (size_t)(row & (SEQ - 1)) * 32 + (within - 64));
                    u32x4 w; w.x = cvtpk(v0[0], v0[1]); w.y = cvtpk(v0[2], v0[3]); w.z = cvtpk(v1[0], v1[1]); w.w = cvtpk(v1[2], v1[3]);
                    *(u32x4*)(rowp + bj * HALF) = w; }
                asm volatile("" ::: "memory"); }
    }
};
struct EpiKVup {
    static constexpr bool PERM = true;
    bf16_t* O; const float* ssq_kv; unsigned* kmx;
    __device__ __forceinline__ void operator()(const f32x4 (&acc)[2][2][4][2], const GUnit& u, int wr, int wc, int fr, int fq) const {
        EPI_OPAQUE();
        const int row0 = u.pm * BM + wr * 64 + fr, col0 = u.pn * BM + wc * 32 + 8 * fq;
        float mk0 = 0.f, mk1 = 0.f;
#pragma unroll
        for (int ai = 0; ai < 2; ++ai)
#pragma unroll
            for (int m = 0; m < 4; ++m) { const int row = row0 + ai * HALF + m * 16; bf16_t* rowp = O + (size_t)row * 512 + col0;
                const f32x4 pq = *(const f32x4*)(ssq_kv + (size_t)row * 4);
                const float rstd = 1.0f / sqrtf(((pq[0] + pq[1]) + (pq[2] + pq[3])) * (1.0f / 128.0f) + RMS_EPS);
#pragma unroll
                for (int bj = 0; bj < 2; ++bj) { const f32x4 v0 = acc[ai][bj][m][0] * rstd, v1 = acc[ai][bj][m][1] * rstd;
                    u32x4 w; w.x = cvtpk(v0[0], v0[1]); w.y = cvtpk(v0[2], v0[3]); w.z = cvtpk(v1[0], v1[1]); w.w = cvtpk(v1[2], v1[3]);
                    *(u32x4*)(rowp + bj * HALF) = w;
                    if (wc < 2) { float ss = ((v0[0] * v0[0] + v0[1] * v0[1]) + (v0[2] * v0[2] + v0[3] * v0[3])) + ((v1[0] * v1[0] + v1[1] * v1[1]) + (v1[2] * v1[2] + v1[3] * v1[3]));
                        ss += xor_lane_lt32<16>(ss); ss = sum_halves(ss); if (bj == 0) mk0 = fmaxf(mk0, ss); else mk1 = fmaxf(mk1, ss); } }
                asm volatile("" ::: "memory"); }
        if (wc < 2) {
            mk0 = fmaxf(mk0, xor_lane_lt32<1>(mk0)); mk0 = fmaxf(mk0, xor_lane_lt32<2>(mk0)); mk0 = fmaxf(mk0, xor_lane_lt32<4>(mk0)); mk0 = fmaxf(mk0, xor_lane_lt32<8>(mk0));
            mk1 = fmaxf(mk1, xor_lane_lt32<1>(mk1)); mk1 = fmaxf(mk1, xor_lane_lt32<2>(mk1)); mk1 = fmaxf(mk1, xor_lane_lt32<4>(mk1)); mk1 = fmaxf(mk1, xor_lane_lt32<8>(mk1));
            if (fr == 0 && fq == 0) { unsigned* kw = kmx + ((u.pm >> 4) * 4 + 2 * u.pn) * 4 + wc; atomicMax(kw, __float_as_uint(mk0)); atomicMax(kw + 4, __float_as_uint(mk1)); }
        }
    }
};
__device__ __forceinline__ float gelu_tanh(float x) { const float u2 = 2.0f * 0.7978845608028654f * (x + 0.044715f * x * x * x); return x * fast_rcp(1.0f + fast_exp2(-u2 * LOG2E)); }
struct EpiCmp1 {
    static constexpr bool PERM = true;
    bf16_t* O; const float* bias1;
    __device__ __forceinline__ void operator()(const f32x4 (&acc)[2][2][4][2], const GUnit& u, int wr, int wc, int fr, int fq) const {
        EPI_OPAQUE();
        const int row0 = u.pm * BM + wr * 64 + fr, col0 = wc * 32 + 8 * fq;
        f32x4 bv[2][2];
#pragma unroll
        for (int bj = 0; bj < 2; ++bj)
#pragma unroll
            for (int n = 0; n < 2; ++n) bv[bj][n] = *(const f32x4*)(bias1 + col0 + bj * HALF + 4 * n);
#pragma unroll
        for (int ai = 0; ai < 2; ++ai)
#pragma unroll
            for (int m = 0; m < 4; ++m) { bf16_t* rowp = O + (size_t)(row0 + ai * HALF + m * 16) * 256 + col0;
#pragma unroll
                for (int bj = 0; bj < 2; ++bj) { f32x4 v0 = acc[ai][bj][m][0] + bv[bj][0], v1 = acc[ai][bj][m][1] + bv[bj][1];
#pragma unroll
                    for (int e = 0; e < 4; ++e) { v0[e] = gelu_tanh(v0[e]); v1[e] = gelu_tanh(v1[e]); }
                    u32x4 w; w.x = cvtpk(v0[0], v0[1]); w.y = cvtpk(v0[2], v0[3]); w.z = cvtpk(v1[0], v1[1]); w.w = cvtpk(v1[2], v1[3]);
                    *(u32x4*)(rowp + bj * HALF) = w; } }
    }
};
typedef __amdgpu_buffer_rsrc_t rsrc_t;
struct EpiMerge {
    __device__ static __forceinline__ bool f8(const GUnit& u) { return u.id >= 4; }
    static constexpr bool PERM = true;
    bf16_t* O;
    unsigned char* scr;
    __device__ __forceinline__ void operator()(const f32x4 (&acc)[2][2][4][2], const GUnit& u, int wr, int wc, int fr, int fq) const {
        EPI_OPAQUE();
        const int tid = (wr * 4 + wc) * 64 + fq * 16 + fr;
        const int sub = u.id;
        const rsrc_t rs = __builtin_amdgcn_make_buffer_rsrc(scr, 0, 524288, 0x00020000);
        if (sub < 4) {
#pragma unroll
            for (int ai = 0; ai < 2; ++ai)
#pragma unroll
                for (int bj = 0; bj < 2; ++bj)
#pragma unroll
                    for (int m = 0; m < 4; ++m)
#pragma unroll
                        for (int n = 0; n < 2; ++n) { const int q = ((ai * 2 + bj) * 4 + m) * 2 + n; const f32x4 v = acc[ai][bj][m][n];
                            u32x2 w; w.x = cvtpk(v[0], v[1]); w.y = cvtpk(v[2], v[3]);
                            __builtin_amdgcn_raw_buffer_store_b64(w, rs, tid * 8, (sub * 32 + q) * 4096, 0); }
            return;
        }
        const int j = sub - 4;
        const int row0 = u.pm * BM + wr * 64 + fr, col0 = u.pn * BM + 64 * j + wc * 16 + 4 * fq;
#pragma unroll
        for (int ai = 0; ai < 2; ++ai) {
            u32x2 sv[4][4];
#pragma unroll
            for (int m = 0; m < 4; ++m)
#pragma unroll
                for (int g = 0; g < 4; ++g) { const int qb = (ai * 16 + m * 2);
                    sv[m][g] = (j == 0) ? __builtin_amdgcn_raw_buffer_load_b64(rs, tid * 8, (g * 32 + qb) * 4096, 0)
                             : (j == 1) ? __builtin_amdgcn_raw_buffer_load_b64(rs, tid * 8, (g * 32 + qb + 1) * 4096, 0)
                             : (j == 2) ? __builtin_amdgcn_raw_buffer_load_b64(rs, tid * 8, (g * 32 + qb + 8) * 4096, 0)
                                        : __builtin_amdgcn_raw_buffer_load_b64(rs, tid * 8, (g * 32 + qb + 9) * 4096, 0); }
#pragma unroll
            for (int m = 0; m < 4; ++m) { bf16_t* rowp = O + (size_t)(row0 + ai * HALF + m * 16) * DM + col0;
                f32x4 t = {0.f, 0.f, 0.f, 0.f};
#pragma unroll
                for (int g = 0; g < 4; ++g) { const f32x4 gt = acc[ai][g >> 1][m][g & 1]; const u32x2 s = sv[m][g];
                    t[0] += sigmoid_f(gt[0] * GATE_UNSCALE) * __uint_as_float(s.x << 16); t[1] += sigmoid_f(gt[1] * GATE_UNSCALE) * __uint_as_float(s.x & 0xffff0000u);
                    t[2] += sigmoid_f(gt[2] * GATE_UNSCALE) * __uint_as_float(s.y << 16); t[3] += sigmoid_f(gt[3] * GATE_UNSCALE) * __uint_as_float(s.y & 0xffff0000u); }
                u32x2 w; w.x = cvtpk(t[0], t[1]); w.y = cvtpk(t[2], t[3]);
                *(u32x2*)rowp = w; }
            asm volatile("" ::: "memory"); }
    }
};
__device__ __forceinline__ float dpp_ror1(float v) { return __uint_as_float((unsigned)__builtin_amdgcn_mov_dpp((int)__float_as_uint(v), 0x121, 0xf, 0xf, false)); }
__device__ __forceinline__ float dpp_ror2(float v) { return __uint_as_float((unsigned)__builtin_amdgcn_mov_dpp((int)__float_as_uint(v), 0x122, 0xf, 0xf, false)); }
struct EpiUpConv {
    static constexpr int KIND = 8;
    static constexpr bool PERM = true;
    bf16_t* ACT; float* HB; const float* cw; const float* cb;
    __device__ __forceinline__ void operator()(const f32x4 (&acc)[2][2][4][2], const GUnit& u, int wr, int wc, int fr, int fq) const {
        EPI_OPAQUE();
        const int colL = wc * 32 + 8 * fq;
        const bool l0 = (fr == 0), l01 = (fr < 2);
#pragma unroll
        for (int n = 0; n < 2; ++n) {
            const int cl = colL + 4 * n, c0 = u.pn * 128 + cl;
            const f32x4 bg = *(const f32x4*)(cb + c0), w0g = *(const f32x4*)(cw + c0), w1g = *(const f32x4*)(cw + DFF2 + c0), w2g = *(const f32x4*)(cw + 2 * DFF2 + c0);
            const f32x4 bv = *(const f32x4*)(cb + DFF + c0), w0v = *(const f32x4*)(cw + DFF + c0), w1v = *(const f32x4*)(cw + DFF2 + DFF + c0), w2v = *(const f32x4*)(cw + 2 * DFF2 + DFF + c0);
            f32x4 w1ga, w1gb, w0ga, w0gb, w1va, w1vb, w0va, w0vb;
#pragma unroll
            for (int e = 0; e < 4; ++e) { w1ga[e] = l0 ? 0.f : w1g[e]; w1gb[e] = l0 ? w1g[e] : 0.f; w0ga[e] = l01 ? 0.f : w0g[e]; w0gb[e] = l01 ? w0g[e] : 0.f;
                                          w1va[e] = l0 ? 0.f : w1v[e]; w1vb[e] = l0 ? w1v[e] : 0.f; w0va[e] = l01 ? 0.f : w0v[e]; w0vb[e] = l01 ? w0v[e] : 0.f; }
#pragma unroll
            for (int ai = 0; ai < 2; ++ai) {
                const int rowg = u.pm * BM + ai * HALF + wr * 64, g = rowg >> 6;
#pragma unroll
                for (int m = 0; m < 4; ++m) {
                    const f32x4 cg = acc[ai][0][m][n], cv = acc[ai][1][m][n];
                    f32x4 o;
#pragma unroll
                    for (int e = 0; e < 4; ++e) {
                        float gt = fmaf(w2g[e], cg[e], bg[e]), vl = fmaf(w2v[e], cv[e], bv[e]);
                        gt = fmaf(dpp_ror1(cg[e]), w1ga[e], gt); gt = fmaf(dpp_ror2(cg[e]), w0ga[e], gt);
                        vl = fmaf(dpp_ror1(cv[e]), w1va[e], vl); vl = fmaf(dpp_ror2(cv[e]), w0va[e], vl);
                        if (m > 0) { const float pg = acc[ai][0][m - 1][n][e], pv = acc[ai][1][m - 1][n][e];
                            gt = fmaf(dpp_ror1(pg), w1gb[e], gt); gt = fmaf(dpp_ror2(pg), w0gb[e], gt);
                            vl = fmaf(dpp_ror1(pv), w1vb[e], vl); vl = fmaf(dpp_ror2(pv), w0vb[e], vl); }
                        o[e] = gt * sigmoid_f(gt) * vl; }
                    const int row = rowg + m * 16 + fr;
                    if (!(m == 0 && fr < 2)) { u32x2 w; w.x = cvtpk(o[0], o[1]); w.y = cvtpk(o[2], o[3]); *(u32x2*)(ACT + (size_t)row * DFF + c0) = w; }
                    if (m == 0 && fr < 2) { float* hp = HB + ((size_t)((g * 4 + fr) * 22 + u.pn) * 256 + cl); *(f32x4*)hp = cg; *(f32x4*)(hp + 128) = cv; }
                    if (m == 3 && fr >= 14) { float* hp = HB + ((size_t)((g * 4 + fr - 12) * 22 + u.pn) * 256 + cl); *(f32x4*)hp = cg; *(f32x4*)(hp + 128) = cv; }
                }
            }
            asm volatile("" ::: "memory");
        }
    }
};
}
#define XB_TMO      128
#define XB_XCNT(j)  (256  + 64 * (j))
#define XB_XSUB(j)  (1280 + 64 * (j))
#define XB_XGEN(j)  (2304 + 64 * (j))
#define XB_TOP      3328
#define XB_TOPGEN   3392
#define XCD_BAR_WORDS 3456
#define XB_SPIN_CAP (1u << 22)
__device__ __forceinline__ unsigned xb_ld(unsigned* p)              { return __hip_atomic_load(p, __ATOMIC_RELAXED, __HIP_MEMORY_SCOPE_AGENT); }
__device__ __forceinline__ unsigned xb_add(unsigned* p, unsigned v) { return __hip_atomic_fetch_add(p, v, __ATOMIC_RELAXED, __HIP_MEMORY_SCOPE_AGENT); }
__device__ __forceinline__ unsigned xb_xcc_id() { return (unsigned)__builtin_amdgcn_s_getreg((3 << 11) | 20) & 0xFu; }
#define XB_SPIN(cond, bar) do { unsigned _sp = 0; while (cond) { __builtin_amdgcn_s_sleep(1); \
    if ((++_sp & 255u) == 0u) { if (xb_ld(&(bar)[XB_TMO])) break; if (_sp > XB_SPIN_CAP) { atomicAdd(&(bar)[XB_TMO], 1u); break; } } } } while (0)
struct XcdBarrier { unsigned* bar; unsigned x; volatile LAS unsigned* st; };
__device__ __forceinline__ XcdBarrier xcd_barrier_post(unsigned* bar, volatile LAS unsigned* st) {
    XcdBarrier b; b.bar = bar; b.x = xb_xcc_id(); b.st = st;
    if (threadIdx.x == 0) (void)xb_add(&bar[XB_XCNT(b.x)], 1u);
    return b;
}
__device__ __forceinline__ void xcd_barrier_complete(unsigned* bar, unsigned x, unsigned& nloc, unsigned& nx) {
    const unsigned G = gridDim.x * gridDim.y * gridDim.z;
    unsigned sum, cnt, mine, sp = 0u;
    for (;;) {
        sum = 0u; cnt = 0u; mine = 0u;
#pragma unroll
        for (unsigned j = 0; j < 16; ++j) { const unsigned c = xb_ld(&bar[XB_XCNT(j)]); sum += c; cnt += (c > 0u) ? 1u : 0u; mine = (j == x) ? c : mine; }
        if (sum == G) break;
        __builtin_amdgcn_s_sleep(1);
        if ((++sp & 255u) == 0u) { if (xb_ld(&bar[XB_TMO])) break; if (sp > XB_SPIN_CAP) { atomicAdd(&bar[XB_TMO], 1u); break; } }
    }
    nloc = mine > 0u ? mine : 1u; nx = cnt > 0u ? cnt : 1u;
}
__device__ __forceinline__ void xcd_barrier(const XcdBarrier& b) {
    asm volatile("s_waitcnt vmcnt(0)" ::: "memory");
    __syncthreads();
    if (threadIdx.x == 0) {
        unsigned* bar = b.bar; unsigned bx = b.x;
        asm volatile("" : "+s"(bx));
        __builtin_amdgcn_s_waitcnt(0);
        unsigned nloc = b.st[0], nx = b.st[1];
        if (nloc == 0u) { xcd_barrier_complete(bar, bx, nloc, nx); b.st[0] = nloc; b.st[1] = nx; }
        const unsigned old = xb_add(&bar[XB_XSUB(bx)], 1u);
        const unsigned gen = old / nloc;
        if (old + 1u == (gen + 1u) * nloc) {
            __builtin_amdgcn_fence(__ATOMIC_RELEASE, "agent");
            asm volatile("s_waitcnt vmcnt(0)" ::: "memory");
            const unsigned og = xb_add(&bar[XB_TOP], 1u);
            const unsigned tg = og / nx;
            if (og + 1u == (tg + 1u) * nx) xb_add(&bar[XB_TOPGEN], 1u);
            else XB_SPIN(xb_ld(&bar[XB_TOPGEN]) == tg, bar);
            __builtin_amdgcn_fence(__ATOMIC_ACQUIRE, "agent");
            xb_add(&bar[XB_XGEN(bx)], 1u);
            asm volatile("s_waitcnt vmcnt(0)" ::: "memory");
        } else {
            XB_SPIN(xb_ld(&bar[XB_XGEN(bx)]) == gen, bar);
            __builtin_amdgcn_fence(__ATOMIC_ACQUIRE, "agent");
            asm volatile("s_waitcnt vmcnt(0)" ::: "memory");
        }
    }
    __syncthreads();
}

#define MFMA32(a, b, c) __builtin_amdgcn_mfma_f32_32x32x16_bf16(a, b, c, 0, 0, 0)
typedef short v4i16_t __attribute__((ext_vector_type(4)));
typedef LAS const char* lds_cptr;
typedef LAS char* lds_ptr;
__device__ __forceinline__ int crow(int r, int hi) { return (r & 3) + 8 * (r >> 2) + 4 * hi; }
__device__ __forceinline__ s16x4 vtr(lds_cptr p) { return __builtin_bit_cast(s16x4, __builtin_amdgcn_ds_read_tr16_b64_v4i16((LAS v4i16_t*)p)); }
__device__ __forceinline__ float other_half(float x, int hi) { auto rr = __builtin_amdgcn_permlane32_swap(__float_as_uint(x), __float_as_uint(x), false, false); return __uint_as_float(hi ? rr[0] : rr[1]); }
constexpr float NEG_INF = -INFINITY;

constexpr int TB_V = 12288, TB_KB = 20480, TB_SIZE = 20992;
struct Stg { u32x4 k, k2, v; float kb; };

template <int NKS> __device__ __forceinline__ void qk64(lds_cptr kbuf, const bf16x8* qf, int r32, int hi, f32x16& p0, f32x16& p1) {
    lds_cptr kp = kbuf + hi * 1024 + r32 * 16;
#pragma unroll
    for (int ks = 0; ks < NKS; ++ks) {
        const bf16x8 a0 = *(const LAS bf16x8*)(kp + ks * 2048), a1 = *(const LAS bf16x8*)(kp + ks * 2048 + 512);
        p0 = MFMA32(a0, qf[ks], p0); p1 = MFMA32(a1, qf[ks], p1);
    }
}
template <int NKS> __device__ __forceinline__ void qk64c(lds_cptr kbuf, const bf16x8* qf, int r32, int hi, const f32x16& c, f32x16& p0, f32x16& p1) {
    lds_cptr kp = kbuf + hi * 1024 + r32 * 16;
    { const bf16x8 a0 = *(const LAS bf16x8*)(kp), a1 = *(const LAS bf16x8*)(kp + 512); p0 = MFMA32(a0, qf[0], c); p1 = MFMA32(a1, qf[0], c); }
#pragma unroll
    for (int ks = 1; ks < NKS; ++ks) {
        const bf16x8 a0 = *(const LAS bf16x8*)(kp + ks * 2048), a1 = *(const LAS bf16x8*)(kp + ks * 2048 + 512);
        p0 = MFMA32(a0, qf[ks], p0); p1 = MFMA32(a1, qf[ks], p1);
    }
}
struct AState { f32x16 o0, o1; float m, l; };
__device__ __forceinline__ void astate_init(AState& s) {
#pragma unroll
    for (int r = 0; r < 16; ++r) { s.o0[r] = 0.f; s.o1[r] = 0.f; }
    s.m = NEG_INF; s.l = 0.f;
}
__device__ __forceinline__ void pv64(f32x16& o0, f32x16& o1, lds_cptr vp, const bf16x8 (&pf)[4]) {
#pragma unroll
    for (int ks = 0; ks < 4; ++ks) {
        const s16x4 l0 = vtr(vp + ks * 1024), h0 = vtr(vp + ks * 1024 + 512), l1 = vtr(vp + 4096 + ks * 1024), h1 = vtr(vp + 4096 + ks * 1024 + 512);
        const bf16x8 v0 = (bf16x8){l0[0], l0[1], l0[2], l0[3], h0[0], h0[1], h0[2], h0[3]}, v1 = (bf16x8){l1[0], l1[1], l1[2], l1[3], h1[0], h1[1], h1[2], h1[3]};
        o0 = MFMA32(v0, pf[ks], o0); o1 = MFMA32(v1, pf[ks], o1);
    }
}
struct VFrag { bf16x8 v0[4], v1[4]; };
__device__ __forceinline__ void v_load64(VFrag& f, lds_cptr vp) {
#pragma unroll
    for (int ks = 0; ks < 4; ++ks) {
        const s16x4 l0 = vtr(vp + ks * 1024), h0 = vtr(vp + ks * 1024 + 512), l1 = vtr(vp + 4096 + ks * 1024), h1 = vtr(vp + 4096 + ks * 1024 + 512);
        f.v0[ks] = (bf16x8){l0[0], l0[1], l0[2], l0[3], h0[0], h0[1], h0[2], h0[3]}; f.v1[ks] = (bf16x8){l1[0], l1[1], l1[2], l1[3], h1[0], h1[1], h1[2], h1[3]};
    }
}
__device__ __forceinline__ void pv64f(f32x16& o0, f32x16& o1, const VFrag& f, const bf16x8 (&pf)[4]) {
#pragma unroll
    for (int ks = 0; ks < 4; ++ks) { o0 = MFMA32(f.v0[ks], pf[ks], o0); o1 = MFMA32(f.v1[ks], pf[ks], o1); }
}
__device__ __forceinline__ void pack_p(const f32x16& p0, const f32x16& p1, bf16x8 (&pf)[4]) {
    u32x4 w0, w1, w2, w3;
    w0.x = cvtpk(p0[0], p0[1]); w0.y = cvtpk(p0[2], p0[3]); w0.z = cvtpk(p0[4], p0[5]); w0.w = cvtpk(p0[6], p0[7]);
    w1.x = cvtpk(p0[8], p0[9]); w1.y = cvtpk(p0[10], p0[11]); w1.z = cvtpk(p0[12], p0[13]); w1.w = cvtpk(p0[14], p0[15]);
    w2.x = cvtpk(p1[0], p1[1]); w2.y = cvtpk(p1[2], p1[3]); w2.z = cvtpk(p1[4], p1[5]); w2.w = cvtpk(p1[6], p1[7]);
    w3.x = cvtpk(p1[8], p1[9]); w3.y = cvtpk(p1[10], p1[11]); w3.z = cvtpk(p1[12], p1[13]); w3.w = cvtpk(p1[14], p1[15]);
    pf[0] = __builtin_bit_cast(bf16x8, w0); pf[1] = __builtin_bit_cast(bf16x8, w1); pf[2] = __builtin_bit_cast(bf16x8, w2); pf[3] = __builtin_bit_cast(bf16x8, w3);
}
__device__ __forceinline__ void softmax_pv64(f32x16& p0, f32x16& p1, AState& s, lds_cptr vp, int hi) {
    VFrag vf; v_load64(vf, vp); __builtin_amdgcn_sched_barrier(0);
    float mx = fmaxf(p0[0], p1[0]);
#pragma unroll
    for (int r = 1; r < 16; ++r) mx = fmaxf(mx, fmaxf(p0[r], p1[r]));
    mx = fmaxf(mx, other_half(mx, hi));
    const float mn = fmaxf(s.m, mx), ms = (mn == NEG_INF) ? 0.f : mn;
    const float alpha = fast_exp2(s.m - ms);
    float rs = 0.f;
#pragma unroll
    for (int r = 0; r < 16; ++r) { p0[r] = fast_exp2(p0[r] - ms); p1[r] = fast_exp2(p1[r] - ms); rs += p0[r] + p1[r]; }
    rs += other_half(rs, hi);
    s.l = s.l * alpha + rs; s.m = mn;
#pragma unroll
    for (int r = 0; r < 16; ++r) { s.o0[r] *= alpha; s.o1[r] *= alpha; }
    bf16x8 pf[4]; pack_p(p0, p1, pf);
    pv64f(s.o0, s.o1, vf, pf);
}
__device__ __forceinline__ void softmax_fixed_pv64(f32x16& p0, f32x16& p1, AState& s, lds_cptr vp) {
    VFrag vf; v_load64(vf, vp); __builtin_amdgcn_sched_barrier(0);
    float rs = 0.f;
#pragma unroll
    for (int r = 0; r < 16; ++r) { p0[r] = fast_exp2(p0[r]); p1[r] = fast_exp2(p1[r]); rs += p0[r] + p1[r]; }
    s.l += rs;
    bf16x8 pf[4]; pack_p(p0, p1, pf);
    pv64f(s.o0, s.o1, vf, pf);
}
__device__ __forceinline__ void mask_causal(f32x16& p0, f32x16& p1, int kpos0, int tq, int hi) {
#pragma unroll
    for (int r = 0; r < 16; ++r) { const int kp = kpos0 + crow(r, hi); if (kp > tq) p0[r] = NEG_INF; if (kp + 32 > tq) p1[r] = NEG_INF; }
}
__device__ __forceinline__ void add_table(f32x16& p0, f32x16& p1, const LAS float* tb) {
#pragma unroll
    for (int r = 0; r < 16; ++r) { const int o = (r & 3) + 8 * (r >> 2); p0[r] += tb[o]; p1[r] += tb[o + 32]; }
}
__device__ __forceinline__ void store_o_bf16(bf16_t* orow, const f32x16& o0, const f32x16& o1, float sc, int hi) {
#pragma unroll
    for (int g = 0; g < 4; ++g) {
        u32x2 w0, w1; w0.x = cvtpk(o0[4 * g] * sc, o0[4 * g + 1] * sc); w0.y = cvtpk(o0[4 * g + 2] * sc, o0[4 * g + 3] * sc);
        w1.x = cvtpk(o1[4 * g] * sc, o1[4 * g + 1] * sc); w1.y = cvtpk(o1[4 * g + 2] * sc, o1[4 * g + 3] * sc);
        *(u32x2*)(orow + 8 * g + 4 * hi) = w0; *(u32x2*)(orow + 32 + 8 * g + 4 * hi) = w1;
    }
}
constexpr size_t MiB = 1u << 20, KiB = 1u << 10;
constexpr size_t WS_CTL = 0, CTL_ZERO_BYTES = 1 * MiB;
constexpr size_t WS_ROPE = 1 * MiB, WS_NSATAB = WS_ROPE + 512 * KiB, WS_DILTAB = WS_NSATAB + 32 * KiB, WS_CMPB = WS_DILTAB + 8 * KiB, WS_FARB = WS_CMPB + 4 * KiB;
constexpr size_t WS_WT = 4 * MiB, LW = 38 * MiB;
constexpr size_t LW_IN = 0, LW_G = 6 * MiB, LW_BR = 14 * MiB, LW_O = 16 * MiB, LW_UP = 18 * MiB, LW_DN = 29 * MiB, LW_UQ = 35 * MiB, LW_UKV = 35 * MiB + 256 * KiB, LW_PHI = 36 * MiB;
constexpr size_t BR_A = 0, BR_B = 512 * KiB, BR_C = 768 * KiB, BR_D = 1280 * KiB;
constexpr size_t WS_SIDE = 80 * MiB, WS_SSQQ = 84 * MiB, WS_SSQKV = 85 * MiB, WS_KB = 86 * MiB, WS_KROT = 87 * MiB, WS_KCMP = 91 * MiB, WS_VCMP = 100 * MiB,
                 WS_HID = 109 * MiB, WS_KMAX = 3 * MiB + 128 * KiB  , WS_LF = 2 * MiB  , WS_CMPP = 3 * MiB  , WS_ORDER = 3 * MiB + 64 * KiB  , WS_KC = 113 * MiB, WS_VC = 113 * MiB + 512 * KiB, WS_DLSE = 114 * MiB, WS_DOG = 116 * MiB;
constexpr size_t WS_H = 164 * MiB, WS_OCAT = 292 * MiB, WS_QM = 404 * MiB, WS_KVM = 468 * MiB, WS_P = 532 * MiB;
constexpr size_t WS_MERGED = 532 * MiB, WS_MSCR = 660 * MiB, WS_Y = 164 * MiB  , WS_H2 = 756 * MiB, WS_ACT = 164 * MiB  , WS_HB = 532 * MiB  , WS_Y2 = 884 * MiB  , WS_X3 = 620 * MiB  , WS_END = 1024 * MiB;
constexpr size_t MSCR_PER_WG = 512 * KiB;
constexpr size_t H8_OFF = 128 * MiB;
static_assert(WS_WT + 2 * LW <= WS_SIDE && WS_DOG + 48 * MiB <= WS_H && WS_P + 384 * MiB <= WS_END && WS_MSCR + 256 * MSCR_PER_WG <= WS_P + 384 * MiB && WS_H2 + 128 * MiB <= WS_Y2 && WS_Y2 + 128 * MiB <= WS_END, "ws map");
static_assert(WS_ACT + 352 * MiB <= WS_HB && WS_HB + 88 * MiB <= WS_X3 && WS_X3 + 128 * MiB <= WS_H2 && WS_Y + 128 * MiB <= WS_OCAT, "ws overlays");
constexpr int CW_BAR = 4096;
constexpr int CW_KMAX = 24576;
constexpr int CW_KMLA = 24832;
constexpr int CW_KROT = 25344;
constexpr int CW_Q = 16384;

constexpr int RING_BYTES = 131072, LDSCTL_OFF = RING_BYTES, MISC_OFF = LDSCTL_OFF + 320, LDS_BYTES = 147456;
constexpr int NSA_SLAB = 49152, NSA_SLAB_BYTES = 4 * 64 * 65 * 4, NSA_SEL = NSA_SLAB + NSA_SLAB_BYTES;
static_assert(NSA_SEL + 512 <= RING_BYTES && 4 * NSA_TL * 4 <= NSA_SLAB_BYTES && 2 * TB_SIZE <= NSA_SLAB, "NSA LDS map");

struct Frame {
    LAS unsigned char* lds; volatile LAS unsigned* MISC; gu32* ctl;
    int tid, lane, wave, G;
    const float* in[27]; float* out; unsigned char* ws;
};
#define WSP(T, off) ((T*)(F.ws + (off)))
#define VM_WAIT() asm volatile("s_waitcnt vmcnt(0)" ::: "memory")
#define LDS_WAIT() asm volatile("s_waitcnt lgkmcnt(0)" ::: "memory")

__device__ __forceinline__ int queue_grab(Frame& F, gu32* ctr) {
    if (F.tid == 0) F.MISC[0] = __hip_atomic_fetch_add(ctr, 1u, __ATOMIC_RELAXED, __HIP_MEMORY_SCOPE_AGENT);
    __syncthreads();
    const int v = (int)F.MISC[0];
    __syncthreads();
    return v;
}

template <bool FOX> __device__ __forceinline__ void causal_unit(Frame& F, int b, int h, int qb, float kmax_in) {
    constexpr int NKS = FOX ? 4 : 6;
    int lane_o = F.lane; asm volatile("" : "+v"(lane_o));
    const int wid = F.wave, lane = lane_o, r32 = lane & 31, hi = lane >> 5;
    const size_t rowbase = (size_t)b * SEQ;
    const int q0 = qb * 256, tq = q0 + wid * 32 + r32, NT = qb * 4 + 4;
    const bf16_t* P = WSP(const bf16_t, WS_P);
    const bf16_t *Kb, *Vb, *Qrow; int kpitch, vpitch;
    const bf16_t* Kr = WSP(const bf16_t, WS_KROT) + rowbase * 32;
    const float* kbsrc = WSP(const float, WS_KB) + (size_t)(b * 4 + h) * SEQ;
    if (FOX) { Kb = P + rowbase * PW + PC_CK + h * 64; Vb = P + rowbase * PW + PC_CV + h * 64; kpitch = PW; vpitch = PW; Qrow = P + (rowbase + tq) * PW + PC_CQ + h * 64; }
    else { const bf16_t* KV = WSP(const bf16_t, WS_KVM) + rowbase * 512 + h * 128; Kb = KV; Vb = KV + 64; kpitch = 512; vpitch = 512; Qrow = WSP(const bf16_t, WS_QM) + (rowbase + tq) * 512 + h * 96; }
    bf16x8 qf[NKS];
#pragma unroll
    for (int ks = 0; ks < NKS; ++ks) qf[ks] = *(const bf16x8*)(Qrow + ks * 16 + hi * 8);
    AState st; astate_init(st);
    lds_ptr lds = (lds_ptr)F.lds;
    const int vpo = ((lane >> 4) & 1) * 32 + (lane & 3) * 8 + (4 * hi + ((lane & 15) >> 2)) * 64;
    Stg sA, sB;
#define CU_LOAD(S, t) do { S.k = *(const u32x4*)(Kb + (size_t)((t) * 64 + lane) * kpitch + wid * 8); \
        if (!FOX) { if (wid < 4) S.k2 = *(const u32x4*)(Kr + (size_t)((t) * 64 + lane) * 32 + wid * 8); } \
        S.v = *(const u32x4*)(Vb + (size_t)((t) * 64 + 16 * (wid & 3) + (lane >> 2)) * vpitch + (wid >> 2) * 32 + (lane & 3) * 8); \
        if (FOX) { if (wid == 0) S.kb = kbsrc[(t) * 64 + lane]; else if (wid == 1) S.kb = kbsrc[(t) > 0 ? (t) * 64 - 1 : 0]; } } while (0)
#define CU_WRITE(S, bi) do { lds_ptr bp = lds + (bi) * TB_SIZE; *(LAS u32x4*)(bp + wid * 1024 + lane * 16) = S.k; \
        if (!FOX) { if (wid < 4) *(LAS u32x4*)(bp + (8 + wid) * 1024 + lane * 16) = S.k2; } \
        *(LAS u32x4*)(bp + TB_V + wid * 1024 + lane * 16) = S.v; \
        if (FOX) { if (wid == 0) *(LAS float*)(bp + TB_KB + lane * 4) = S.kb; else if (wid == 1 && lane == 0) *(LAS float*)(bp + TB_KB + 256) = S.kb; } } while (0)
    const int tq_lo = q0 + wid * 32;
    float qn = 0.f; const float kmax = kmax_in;
#pragma unroll
    for (int ks = 0; ks < NKS; ++ks)
#pragma unroll
        for (int e = 0; e < 8; ++e) { const float x = bf2f((unsigned short)qf[ks][e]); qn += x * x; }
    qn += other_half(qn, hi); qn = sqrtf(qn);
    const float bnd = qn * kmax * 1.002f + 0.05f;
    const bool fast = __all(bnd <= 50.0f);
    const float kbi = FOX ? kbsrc[tq] : 0.f;
    f32x16 cinit;
    { const float c0 = -(bnd + kbi);
#pragma unroll
      for (int r = 0; r < 16; ++r) cinit[r] = c0; }
    LAS volatile unsigned* dflag = (LAS volatile unsigned*)(lds + 2 * TB_SIZE + 64);
    const int t_first = FOX ? NT - 1 : 0, t_step = FOX ? -1 : 1;
#define CU_STEP(TT, BI, SL, SW) { const int tt = (TT), t = t_first + tt * t_step; \
        if (tt + 2 < NT) CU_LOAD(SL, t + 2 * t_step); \
        lds_cptr bp = (lds_cptr)(lds + (BI) * TB_SIZE); \
        if (64 * t <= tq_lo + 31) {                                \
            f32x16 p0, p1; \
            if (fast) qk64c<NKS>(bp, qf, r32, hi, cinit, p0, p1); \
            else { _Pragma("unroll") for (int r = 0; r < 16; ++r) { p0[r] = 0.f; p1[r] = 0.f; } qk64<NKS>(bp, qf, r32, hi, p0, p1); } \
            if (FOX) { const LAS float* kbt = (const LAS float*)(bp + TB_KB) + 4 * hi; \
                _Pragma("unroll") for (int g = 0; g < 4; ++g) { const f32x4 a = *(const LAS f32x4*)(kbt + 8 * g), c = *(const LAS f32x4*)(kbt + 32 + 8 * g); \
                    _Pragma("unroll") for (int e = 0; e < 4; ++e) { p0[4 * g + e] += a[e]; p1[4 * g + e] += c[e]; } } } \
            if (64 * t + 63 > tq_lo) mask_causal(p0, p1, 64 * t, tq, hi); \
            if (fast) softmax_fixed_pv64(p0, p1, st, bp + TB_V + vpo); else softmax_pv64(p0, p1, st, bp + TB_V + vpo, hi); \
        } \
          \
        if (FOX) { if (t > 0) { const float kb_last = *(const LAS float*)(bp + TB_KB + 256); const bool done = fast ? ((kb_last - kbi) < -150.0f) : ((qn * kmax + kb_last - st.m) < -130.0f); const unsigned alld = __all(done) ? 1u : 0u; if (lane == 0) dflag[(BI) * 8 + wid] = alld; } } \
        if (tt + 1 < NT) CU_WRITE(SW, (BI) ^ 1); \
        __syncthreads(); \
        if (FOX) { if (t > 0) { unsigned all = 1u; _Pragma("unroll") for (int w = 0; w < 8; ++w) all &= dflag[(BI) * 8 + w]; if (all) break; } } }
    CU_LOAD(sA, t_first); CU_WRITE(sA, 0);
    CU_LOAD(sA, t_first + t_step);
    __syncthreads();
    for (int t2 = 0; t2 < NT; t2 += 2) {
        CU_STEP(t2, 0, sB, sA)
        CU_STEP(t2 + 1, 1, sA, sB)
    }
#undef CU_STEP
#undef CU_LOAD
#undef CU_WRITE
    bf16_t* orow = WSP(bf16_t, WS_OCAT) + (rowbase + tq) * OCW + (FOX ? 384 : 640) + h * 64;
    const float ltot = fast ? st.l + other_half(st.l, hi) : st.l;
    store_o_bf16(orow, st.o0, st.o1, 1.0f / ltot, hi);
}
__device__ __forceinline__ void nsa_unit(Frame& F, int b, int qblk) {
    int lane_o = F.lane; asm volatile("" : "+v"(lane_o));
    const int wid = F.wave, lane = lane_o, r32 = lane & 31, hi = lane >> 5, tid = wid * 64 + lane;
    const int h = wid & 3, qs = wid >> 2;
    const int q0 = qblk * 64, cur = qblk, tq = q0 + 32 * qs + r32, tq_lo = q0 + 32 * qs;
    const size_t rowbase = (size_t)b * SEQ, row = rowbase + tq;
    const bf16_t* P = WSP(const bf16_t, WS_P);
    lds_ptr lds = (lds_ptr)F.lds;
    const int vpo = ((lane >> 4) & 1) * 32 + (lane & 3) * 8 + (4 * hi + ((lane & 15) >> 2)) * 64;
    bf16x8 qf[4];
    { const bf16_t* Qrow = P + row * PW + PC_AQ + h * 64;
#pragma unroll
      for (int ks = 0; ks < 4; ++ks) qf[ks] = *(const bf16x8*)(Qrow + ks * 16 + hi * 8); }
    Stg s; int ln;
#define NS_LOAD(Kb, kp, Vb, vp_, t) do { s.k = *(const u32x4*)((Kb) + (size_t)((t) * 64 + ln) * (kp) + wid * 8); \
        s.v = *(const u32x4*)((Vb) + (size_t)((t) * 64 + 16 * (wid & 3) + (ln >> 2)) * (vp_) + (wid >> 2) * 32 + (ln & 3) * 8); } while (0)
#define NS_FRESH() do { ln = lane; asm volatile("" : "+v"(ln)); } while (0)
#define NS_WRITE(bi) do { lds_ptr bp_ = lds + (bi) * TB_SIZE; *(LAS u32x4*)(bp_ + wid * 1024 + lane * 16) = s.k; *(LAS u32x4*)(bp_ + TB_V + wid * 1024 + lane * 16) = s.v; } while (0)
    const bf16_t* KC = WSP(const bf16_t, WS_KC) + (size_t)b * 256 * 64; const bf16_t* VC = WSP(const bf16_t, WS_VC) + (size_t)b * 256 * 64;
    const int cmax_u = (q0 + 63 - 31) >> 4, NTc = (cmax_u >> 6) + 1;
    const int cmax = (tq - 31) >> 4;
    float cm = NEG_INF, cl = 0.f;
    NS_FRESH(); NS_LOAD(KC, 64, VC, 64, 0); NS_WRITE(0);
    __syncthreads();
    for (int t = 0; t < NTc; ++t) {
        const int bi = t & 1;
        if (t + 1 < NTc) NS_LOAD(KC, 64, VC, 64, t + 1);
        { lds_cptr bp = (lds_cptr)(lds + bi * TB_SIZE); f32x16 p0, p1;
#pragma unroll
          for (int r = 0; r < 16; ++r) { p0[r] = 0.f; p1[r] = 0.f; }
          qk64<4>(bp, qf, r32, hi, p0, p1);
          float mx = NEG_INF;
#pragma unroll
          for (int r = 0; r < 16; ++r) { const int c = 64 * t + crow(r, hi); if (c > cmax) p0[r] = NEG_INF; if (c + 32 > cmax) p1[r] = NEG_INF; mx = fmaxf(mx, fmaxf(p0[r], p1[r])); }
          mx = fmaxf(mx, other_half(mx, hi));
          const float mn = fmaxf(cm, mx), ms = (mn == NEG_INF) ? 0.f : mn; float rs = 0.f;
#pragma unroll
          for (int r = 0; r < 16; ++r) rs += fast_exp2(p0[r] - ms) + fast_exp2(p1[r] - ms);
          rs += other_half(rs, hi);
          cl = cl * fast_exp2(cm - ms) + rs; cm = mn; }
        if (t + 1 < NTc) NS_WRITE(bi ^ 1);
        __syncthreads();
    }
    const float cms = (cm == NEG_INF) ? 0.f : cm, cinv = 1.0f / fmaxf(cl, 1e-30f);
    f32x16 oc0, oc1;
#pragma unroll
    for (int r = 0; r < 16; ++r) { oc0[r] = 0.f; oc1[r] = 0.f; }
    float G[32]; float carry = 0.f;
#pragma unroll
    for (int i = 0; i < 32; ++i) G[i] = 0.f;
    NS_FRESH(); NS_LOAD(KC, 64, VC, 64, 0); NS_WRITE(0);
    __syncthreads();
#pragma unroll
    for (int t = 0; t < 4; ++t) {
        if (t < NTc) {
            const int bi = t & 1;
            if (t + 1 < NTc) NS_LOAD(KC, 64, VC, 64, t + 1);
            { lds_cptr bp = (lds_cptr)(lds + bi * TB_SIZE); f32x16 p0, p1;
#pragma unroll
              for (int r = 0; r < 16; ++r) { p0[r] = 0.f; p1[r] = 0.f; }
              qk64<4>(bp, qf, r32, hi, p0, p1);
#pragma unroll
              for (int r = 0; r < 16; ++r) { const int c = 64 * t + crow(r, hi);
                  p0[r] = (c > cmax) ? 0.f : fast_exp2(p0[r] - cms) * cinv; p1[r] = (c + 32 > cmax) ? 0.f : fast_exp2(p1[r] - cms) * cinv; }
#pragma unroll
              for (int g = 0; g < 4; ++g) { const float oth = other_half(p0[4 * g + 3], hi);
                  G[t * 8 + g] = ((p0[4 * g] + p0[4 * g + 1]) + (p0[4 * g + 2] + p0[4 * g + 3])) + (hi ? oth : carry); carry = oth; }
#pragma unroll
              for (int g = 0; g < 4; ++g) { const float oth = other_half(p1[4 * g + 3], hi);
                  G[t * 8 + 4 + g] = ((p1[4 * g] + p1[4 * g + 1]) + (p1[4 * g + 2] + p1[4 * g + 3])) + (hi ? oth : carry); carry = oth; }
              bf16x8 pf[4]; pack_p(p0, p1, pf);
              pv64(oc0, oc1, bp + TB_V + vpo, pf); }
            if (t + 1 < NTc) NS_WRITE(bi ^ 1);
            __syncthreads();
        }
    }
    { LAS float* slab = (LAS float*)(lds + NSA_SLAB) + (size_t)(h * 64 + 32 * qs + r32) * 65;
#pragma unroll
      for (int i = 0; i < 32; ++i) slab[2 * i + hi] = G[i]; }
    __syncthreads();
    u32x4 tbr[4]; { const u32x4* src = WSP(const u32x4, WS_NSATAB);
#pragma unroll
      for (int i = 0; i < 4; ++i) { const int idx = tid + 512 * i; tbr[i] = (idx < 4 * NSA_TL / 4) ? src[idx] : (u32x4){0u, 0u, 0u, 0u}; } }
    float gl0, gl1, gl2; { const float* sd = WSP(const float, WS_SIDE) + row * 16 + h * 3; gl0 = sd[0]; gl1 = sd[1]; gl2 = sd[2]; }
    { const int q = tid >> 3, jg = tid & 7;
      const LAS float* s0 = (const LAS float*)(lds + NSA_SLAB) + (size_t)q * 65;
      float v[64];
#pragma unroll
      for (int k = 0; k < 64; ++k) { const float x = (s0[k] + s0[64 * 65 + k]) + (s0[2 * 64 * 65 + k] + s0[3 * 64 * 65 + k]);
          v[k] = (k == 0 || k == cur || k == cur - 1) ? 1e9f : ((k > cur) ? -1e9f : x); if ((k & 7) == 7) asm volatile("" ::: "memory"); }
      unsigned bits = 0u;
#pragma unroll
      for (int e = 0; e < 8; ++e) { const int j = 8 * jg + e;
          const float xj = (s0[j] + s0[64 * 65 + j]) + (s0[2 * 64 * 65 + j] + s0[3 * 64 * 65 + j]);
          const float vj = (j == 0 || j == cur || j == cur - 1) ? 1e9f : ((j > cur) ? -1e9f : xj);
          int rank = 0;
#pragma unroll
          for (int k = 0; k < 64; ++k) rank += (v[k] > vj || (v[k] == vj && k < j)) ? 1 : 0;
          bits |= (rank < 16 ? 1u : 0u) << e; }
      *((LAS unsigned char*)(lds + NSA_SEL) + q * 8 + jg) = (unsigned char)bits; }
    __syncthreads();
    const unsigned mlo = *(const LAS unsigned*)(lds + NSA_SEL + (32 * qs + r32) * 8), mhi = *(const LAS unsigned*)(lds + NSA_SEL + (32 * qs + r32) * 8 + 4);
    { LAS u32x4* dst = (LAS u32x4*)(lds + NSA_SLAB);
#pragma unroll
      for (int i = 0; i < 4; ++i) { const int idx = tid + 512 * i; if (idx < 4 * NSA_TL / 4) dst[idx] = tbr[i]; } }
    const LAS float* tabh = (const LAS float*)(lds + NSA_SLAB) + h * NSA_TL;
    const float farb = WSP(const float, WS_FARB)[h];
    const float g0 = sigmoid_f(gl0), g1 = sigmoid_f(gl1), g2 = sigmoid_f(gl2);
    AState st; astate_init(st);
    { const bf16_t* Kb = P + rowbase * PW + PC_KSLC; const bf16_t* Vb = P + rowbase * PW + PC_VSLC;
      NS_FRESH(); NS_LOAD(Kb, PW, Vb, PW, 0); NS_WRITE(0);
      __syncthreads();
      for (int j = 0; j <= cur; ++j) {
          const int bi = j & 1;
          if (j < cur) NS_LOAD(Kb, PW, Vb, PW, j + 1);
          const bool mine = ((j < 32) ? (mlo >> j) : (mhi >> (j - 32))) & 1u;
          if (__any(mine)) {
              lds_cptr bp = (lds_cptr)(lds + bi * TB_SIZE); f32x16 p0, p1;
#pragma unroll
              for (int r = 0; r < 16; ++r) { p0[r] = 0.f; p1[r] = 0.f; }
              qk64<4>(bp, qf, r32, hi, p0, p1);
              if (q0 - 64 * j - 63 >= NSA_DFAR) {
#pragma unroll
                  for (int r = 0; r < 16; ++r) { p0[r] += farb; p1[r] += farb; }
              } else add_table(p0, p1, tabh + (NSA_DMAX - tq + 64 * j + 4 * hi));
              if (j == cur) mask_causal(p0, p1, 64 * j, tq, hi);
              if (!mine) {
#pragma unroll
                  for (int r = 0; r < 16; ++r) { p0[r] = NEG_INF; p1[r] = NEG_INF; } }
              softmax_pv64(p0, p1, st, bp + TB_V + vpo, hi);
          }
          if (j < cur) NS_WRITE(bi ^ 1);
          __syncthreads();
      } }
    f32x16 oa0, oa1;
    { const float sc = g1 / st.l;
#pragma unroll
      for (int r = 0; r < 16; ++r) { oa0[r] = g0 * oc0[r] + sc * st.o0[r]; oa1[r] = g0 * oc1[r] + sc * st.o1[r]; } }
    astate_init(st);
    { const bf16_t* Kb = P + rowbase * PW + PC_KWIN; const bf16_t* Vb = P + rowbase * PW + PC_VWIN;
      const int jlo = cur >= 8 ? cur - 8 : 0;
      NS_FRESH(); NS_LOAD(Kb, PW, Vb, PW, jlo); NS_WRITE(0);
      __syncthreads();
      for (int j = jlo; j <= cur; ++j) {
          const int bi = (j - jlo) & 1;
          if (j < cur) NS_LOAD(Kb, PW, Vb, PW, j + 1);
          if (tq_lo - 64 * j - 63 < 512) {
              lds_cptr bp = (lds_cptr)(lds + bi * TB_SIZE); f32x16 p0, p1;
#pragma unroll
              for (int r = 0; r < 16; ++r) { p0[r] = 0.f; p1[r] = 0.f; }
              qk64<4>(bp, qf, r32, hi, p0, p1);
              add_table(p0, p1, tabh + (NSA_DMAX - tq + 64 * j + 4 * hi));
              if (!(tq_lo - 64 * j - 63 >= 0 && tq_lo + 31 - 64 * j < 512)) {
                  const int d0 = tq - 64 * j - 4 * hi;
#pragma unroll
                  for (int r = 0; r < 16; ++r) { const int d = d0 - ((r & 3) + 8 * (r >> 2)); if (d < 0 || d >= 512) p0[r] = NEG_INF; if (d - 32 < 0 || d - 32 >= 512) p1[r] = NEG_INF; }
              }
              softmax_pv64(p0, p1, st, bp + TB_V + vpo, hi);
          }
          if (j < cur) NS_WRITE(bi ^ 1);
          __syncthreads();
      } }
    { const float sc = g2 / st.l;
#pragma unroll
      for (int r = 0; r < 16; ++r) { oa0[r] += sc * st.o0[r]; oa1[r] += sc * st.o1[r]; } }
    { int tq_ = tq; asm volatile("" : "+v"(tq_)); store_o_bf16(WSP(bf16_t, WS_OCAT) + (rowbase + tq_) * OCW + h * 64, oa0, oa1, 1.0f, hi); }
#undef NS_LOAD
#undef NS_FRESH
#undef NS_WRITE
}
__device__ __forceinline__ void dil_unit(Frame& F, int b, int hh, int span) {
    int lane_o = F.lane; asm volatile("" : "+v"(lane_o));
    const int wid = F.wave, lane = lane_o, r32 = lane & 31, hi = lane >> 5, tid = wid * 64 + lane;
    const int T0 = span * 512;
    const size_t rowbase = (size_t)b * SEQ;
    const bf16_t* P = WSP(const bf16_t, WS_P) + rowbase * PW;
    lds_ptr lds = (lds_ptr)F.lds;
    LAS float* dtab = (LAS float*)(lds + 32768);
    for (int i = tid; i < 3 * 192; i += 512) dtab[i] = WSP(const float, WS_DILTAB)[((i / 192) * 2 + hh) * 192 + (i % 192)];
    __syncthreads();
    lds_ptr vst = lds + wid * 4096;
    const int vpo = ((lane >> 4) & 1) * 32 + (lane & 3) * 8 + (4 * hi + ((lane & 15) >> 2)) * 64;
    bf16_t* DOG = WSP(bf16_t, WS_DOG); float* DLSE = WSP(float, WS_DLSE);
    for (int g = 0; g < 3; ++g) {
        const int sh = 2 * g, head = 2 * g + hh;
        for (int rep = 0; rep < 2; ++rep) {
            const int wt = wid + 8 * rep;
            const int res = (g == 0) ? 0 : (g == 1 ? (wt & 3) : wt);
            const int i0 = (g == 0) ? 32 * wt : (g == 1 ? 32 * (wt >> 2) : 0);
            const int n0 = (T0 >> sh) + i0;
            const int tokq = res + ((n0 + r32) << sh);
            bf16x8 qf[4];
            { const bf16_t* Qrow = P + (size_t)tokq * PW + PC_BQ + head * 64;
#pragma unroll
              for (int ks = 0; ks < 4; ++ks) qf[ks] = *(const bf16x8*)(Qrow + ks * 16 + hi * 8); }
            f32x16 o0, o1; float m = NEG_INF, l = 0.f;
#pragma unroll
            for (int r = 0; r < 16; ++r) { o0[r] = 0.f; o1[r] = 0.f; }
#define DIL_LOAD(cc, KF, VR) do { const int nk0_ = n0 - 128 + 32 * (cc); int nk_ = nk0_ + r32; nk_ = nk_ < 0 ? 0 : nk_; const bf16_t* Krow_ = P + (size_t)(res + (nk_ << sh)) * PW + PC_BK + head * 64; \
        _Pragma("unroll") for (int ks = 0; ks < 4; ++ks) KF[ks] = *(const bf16x8*)(Krow_ + ks * 16 + hi * 8); \
        _Pragma("unroll") for (int i = 0; i < 4; ++i) { const int pc_ = lane + 64 * i, vrow_ = pc_ >> 3, c16_ = pc_ & 7; int nv_ = nk0_ + vrow_; nv_ = nv_ < 0 ? 0 : nv_; \
            VR[i] = *(const u32x4*)(P + (size_t)(res + (nv_ << sh)) * PW + PC_BV + head * 64 + c16_ * 8); } } while (0)
            int cfirst = 0; while (cfirst < 4 && n0 - 128 + 32 * cfirst + 31 < 0) ++cfirst;
            bf16x8 kfn[4]; u32x4 vrn[4];
            DIL_LOAD(cfirst, kfn, vrn);
            for (int c = cfirst; c < 5; ++c) {
                const int nk0 = n0 - 128 + 32 * c;
                { bf16x8 kf[4]; u32x4 vr[4];
#pragma unroll
                  for (int i = 0; i < 4; ++i) { kf[i] = kfn[i]; vr[i] = vrn[i]; }
                  if (c < 4) DIL_LOAD(c + 1, kfn, vrn);
#pragma unroll
                  for (int i = 0; i < 4; ++i) { const int pc = lane + 64 * i, vrow = pc >> 3, c16 = pc & 7;
                      *(LAS u32x4*)(vst + (c16 >> 2) * 2048 + vrow * 64 + (c16 & 3) * 16) = vr[i]; }
                  asm volatile("s_waitcnt lgkmcnt(0)" ::: "memory");
                  f32x16 p;
#pragma unroll
                  for (int r = 0; r < 16; ++r) p[r] = 0.f;
#pragma unroll
                  for (int ks = 0; ks < 4; ++ks) p = MFMA32(kf[ks], qf[ks], p);
                  const LAS float* tb = dtab + g * 192 + (32 - r32 + 4 * hi + 32 * c);
                  float mx = NEG_INF;
#pragma unroll
                  for (int r = 0; r < 16; ++r) { const int o = (r & 3) + 8 * (r >> 2), kk = o + 4 * hi, j = 128 + r32 - 32 * c - kk;
                      const bool ok = (j >= 0) && (j <= 128) && (nk0 + kk >= 0);
                      p[r] = ok ? p[r] + tb[o] : NEG_INF; mx = fmaxf(mx, p[r]); }
                  mx = fmaxf(mx, other_half(mx, hi));
                  const float mn = fmaxf(m, mx), ms = (mn == NEG_INF) ? 0.f : mn, alpha = fast_exp2(m - ms);
                  float rs = 0.f;
#pragma unroll
                  for (int r = 0; r < 16; ++r) { p[r] = fast_exp2(p[r] - ms); rs += p[r]; }
                  rs += other_half(rs, hi);
                  l = l * alpha + rs; m = mn;
#pragma unroll
                  for (int r = 0; r < 16; ++r) { o0[r] *= alpha; o1[r] *= alpha; }
                  u32x4 w0, w1;
                  w0.x = cvtpk(p[0], p[1]); w0.y = cvtpk(p[2], p[3]); w0.z = cvtpk(p[4], p[5]); w0.w = cvtpk(p[6], p[7]);
                  w1.x = cvtpk(p[8], p[9]); w1.y = cvtpk(p[10], p[11]); w1.z = cvtpk(p[12], p[13]); w1.w = cvtpk(p[14], p[15]);
                  const bf16x8 pf0 = __builtin_bit_cast(bf16x8, w0), pf1 = __builtin_bit_cast(bf16x8, w1);
                  lds_cptr vp = (lds_cptr)(vst + vpo);
#pragma unroll
                  for (int ks = 0; ks < 2; ++ks) {
                      const s16x4 l0 = vtr(vp + ks * 1024), h0 = vtr(vp + ks * 1024 + 512), l1 = vtr(vp + 2048 + ks * 1024), h1 = vtr(vp + 2048 + ks * 1024 + 512);
                      const bf16x8 v0 = (bf16x8){l0[0], l0[1], l0[2], l0[3], h0[0], h0[1], h0[2], h0[3]}, v1 = (bf16x8){l1[0], l1[1], l1[2], l1[3], h1[0], h1[1], h1[2], h1[3]};
                      o0 = MFMA32(v0, ks == 0 ? pf0 : pf1, o0); o1 = MFMA32(v1, ks == 0 ? pf0 : pf1, o1);
                  }
                  asm volatile("s_waitcnt lgkmcnt(0)" ::: "memory"); }
            }
#undef DIL_LOAD
            const size_t orow = rowbase + tokq;
            store_o_bf16(DOG + ((size_t)g * M + orow) * 128 + hh * 64, o0, o1, 1.0f / l, hi);
            if (hi == 0) DLSE[((size_t)g * M + orow) * 2 + hh] = m + log2f(l);
        }
    }
    VM_WAIT();
    __syncthreads();
    bf16_t* OC = WSP(bf16_t, WS_OCAT);
    for (int it = 0; it < 8; ++it) {
        const int item = tid + 512 * it, tl = item >> 3, pc = item & 7; const size_t orow = rowbase + T0 + tl;
        const float l0 = DLSE[((size_t)0 * M + orow) * 2 + hh], l1 = DLSE[((size_t)1 * M + orow) * 2 + hh], l2 = DLSE[((size_t)2 * M + orow) * 2 + hh];
        const float mx = fmaxf(l0, fmaxf(l1, l2)); float w0 = fast_exp2(l0 - mx), w1 = fast_exp2(l1 - mx), w2 = fast_exp2(l2 - mx);
        const float inv = 1.0f / (w0 + w1 + w2); w0 *= inv; w1 *= inv; w2 *= inv;
        const u32x4 a = *(const u32x4*)(DOG + ((size_t)0 * M + orow) * 128 + hh * 64 + pc * 8), bb = *(const u32x4*)(DOG + ((size_t)1 * M + orow) * 128 + hh * 64 + pc * 8),
                    cc = *(const u32x4*)(DOG + ((size_t)2 * M + orow) * 128 + hh * 64 + pc * 8);
        u32x4 w;
#pragma unroll
        for (int e = 0; e < 4; ++e) {
            const float lo = w0 * __uint_as_float(a[e] << 16) + w1 * __uint_as_float(bb[e] << 16) + w2 * __uint_as_float(cc[e] << 16);
            const float hv = w0 * __uint_as_float(a[e] & 0xffff0000u) + w1 * __uint_as_float(bb[e] & 0xffff0000u) + w2 * __uint_as_float(cc[e] & 0xffff0000u);
            w[e] = cvtpk(lo, hv); }
        *(u32x4*)(OC + orow * OCW + 256 + hh * 64 + pc * 8) = w;
    }
    __syncthreads();
}
__device__ __forceinline__ float wave_sum(float v) {
    v += xor_lane_lt32<1>(v); v += xor_lane_lt32<2>(v); v += xor_lane_lt32<4>(v); v += xor_lane_lt32<8>(v); v += xor_lane_lt32<16>(v);
    return sum_halves(v);
}
__device__ __forceinline__ int rel_bucket(int dist) {
    if (dist < 0) dist = 0;
    if (dist < 16) return dist;
    const int thr[15] = {22, 30, 40, 54, 73, 99, 134, 182, 246, 332, 450, 609, 825, 1117, 1513};
    int bkt = 16;
#pragma unroll
    for (int i = 0; i < 15; ++i) bkt += (dist >= thr[i]) ? 1 : 0;
    return bkt;
}
__device__ __forceinline__ int inproj_src(int c, float& sc) {
    sc = 1.f;
    if (c < 256) { sc = C2A; return c; }
    if (c < 652) return c;
    if (c < 656) return 2572 + (c - 652);
    if (c < 672) return -1;
    if (c < 704) { const int p = c - 672; return 2960 + (p >> 1) + 16 * (p & 1); }
    if (c < 768) return -1;
    if (c < 1920) { const int r = c - 768; if (r < 384) sc = C2A; return 652 + r; }
    if (c < 2048) return 2832 + (c - 1920);
    if (c < 2816) { const int r = c - 2048; if (r < 256) sc = C2A; return 1804 + r; }
    return 2576 + (c - 2816);
}
__device__ __forceinline__ int quq_src(int r, float& sc) {
    sc = C2D;
    if (r >= 384) return -1;
    const int hd = r / 96, w = r % 96;
    if (w < 64) return hd * 96 + w;
    const int p = w - 64; return hd * 96 + 64 + (p >> 1) + 16 * (p & 1);
}
__device__ __forceinline__ int gateperm_src(int r) {
    const int T = r >> 8, c = r & 255, pn = T >> 2, j = T & 3, bj = c >> 7, wc = (c >> 5) & 3, fq = (c >> 3) & 3, n = (c >> 2) & 1, e = c & 3;
    return (2 * bj + n) * DM * DM + 256 * pn + 64 * j + 16 * wc + 4 * fq + e;
}
__device__ __forceinline__ int branchperm_src(int r) {
    const int pn = r >> 8, c = r & 255, bj = c >> 7, wc = (c >> 5) & 3, fq = (c >> 3) & 3, n = (c >> 2) & 1, e = c & 3;
    return 256 * pn + 64 * (2 * bj + n) + 16 * wc + 4 * fq + e;
}
__device__ __forceinline__ int upperm_src(int r) { const int pn = r >> 8, c = r & 255; return (c & 128) ? DFF + 128 * pn + (c & 127) : 128 * pn + c; }
__device__ __forceinline__ void wconv_item(const float* W, int Nsrc, bf16_t* WT, int ldt, const float* kgain, int kind, LAS float* scr, int item, int nblk, int lane, bool f8out = false) {
    const int kb = item / nblk, nb = item % nblk, k0 = 64 * kb, n0 = 32 * nb;
    const int n = n0 + (lane & 31); float sc = 1.f; int src = n;
    if (kind == 1) src = inproj_src(n, sc); else if (kind == 2) src = quq_src(n, sc); else if (kind == 3) src = gateperm_src(n); else if (kind == 4) src = branchperm_src(n); else if (kind == 5) src = upperm_src(n);
    float wv[32];
#pragma unroll
    for (int i = 0; i < 32; ++i) { const int kk = 2 * i + (lane >> 5); wv[i] = (src >= 0) ? W[(size_t)(k0 + kk) * Nsrc + src] : 0.f; }
#pragma unroll
    for (int i = 0; i < 32; ++i) { const int kk = 2 * i + (lane >> 5); float v = wv[i] * sc; if (kgain) v *= kgain[k0 + kk]; scr[kk * 33 + (lane & 31)] = v; }
    LDS_WAIT(); asm volatile("" ::: "memory");
    if (f8out) {
        const int nn = lane >> 1, hh = lane & 1; const LAS float* s = scr + (32 * hh) * 33 + nn; unsigned char* dst = (unsigned char*)WT + (size_t)(n0 + nn) * ldt + k0 + 32 * hh;
#pragma unroll
        for (int j = 0; j < 2; ++j) { u32x4 o;
#pragma unroll
            for (int e = 0; e < 4; ++e) { const LAS float* q = s + (16 * j + 4 * e) * 33; o[e] = pk4_fp8(q[0] * WG8_SCALE, q[33] * WG8_SCALE, q[66] * WG8_SCALE, q[99] * WG8_SCALE); }
            *(u32x4*)(dst + 16 * j) = o; }
        LDS_WAIT(); asm volatile("" ::: "memory");
        return;
    }
    const int c = lane & 7;
#pragma unroll
    for (int j = 0; j < 4; ++j) { const int nn = (lane >> 3) + 8 * j; const LAS float* s = scr + (8 * c) * 33 + nn;
        u32x4 o; o.x = pk2(s[0 * 33], s[1 * 33]); o.y = pk2(s[2 * 33], s[3 * 33]); o.z = pk2(s[4 * 33], s[5 * 33]); o.w = pk2(s[6 * 33], s[7 * 33]);
        *(u32x4*)(WT + (size_t)(n0 + nn) * ldt + k0 + 8 * c) = o; }
    LDS_WAIT(); asm volatile("" ::: "memory");
}
constexpr int ATT_UNITS = 3328;
__device__ __forceinline__ int att_cost(int id) {
    if (id < 2048) { const int qb = 15 - (id >> 7), mla = (id >> 6) & 1; return (mla ? 5 : 4) * (qb + 1); }
    if (id < 3072) return (63 - ((id - 2048) >> 4)) + 20;
    return 30;
}
__device__ __forceinline__ int clampi(int x, int lo, int hi) { return x < lo ? lo : (x > hi ? hi : x); }
__device__ __forceinline__ int att_rank(int i) {
    const int c = att_cost(i);
    int r = clampi(16 - c / 4, 0, 16) * 64 + clampi(16 - c / 5, 0, 16) * 64 + clampi(83 - c, 0, 64) * 16 + (c < 30 ? 256 : 0);
    if (c % 4 == 0 && c / 4 >= 1 && c / 4 <= 16) r += clampi(i - (16 - c / 4) * 128, 0, 64);
    if (c % 5 == 0 && c / 5 >= 1 && c / 5 <= 16) r += clampi(i - ((16 - c / 5) * 128 + 64), 0, 64);
    if (c >= 20 && c <= 83) r += clampi(i - (2048 + (63 - (c - 20)) * 16), 0, 16);
    if (c == 30) r += clampi(i - 3072, 0, 256);
    return r;
}
__device__ __forceinline__ void p0_prologue(Frame& F) {
    LAS float* scr = (LAS float*)(F.lds + F.wave * 16384);
    const int gw = blockIdx.x * 8 + F.wave, NGW = F.G * 8, lane = F.lane;
    constexpr int I_IN = 16 * 96, I_G = 16 * 32, I_BA = 4 * 32, I_BB = 2 * 32, I_O = 16 * 32, I_UP = 16 * 176, I_DN = 44 * 32, I_UQ = 4 * 16, I_UKV = 2 * 16, I_PHI = 32 * 4;
    constexpr int I_L = I_IN + 4 * I_G + 3 * I_BA + I_BB + I_O + I_UP + I_DN + I_UQ + I_UKV + 2 * I_PHI;
    for (int it = gw; it < DEPTH * I_L; it += NGW) {
        const int l = it / I_L; int r = it % I_L;
        unsigned char* wl = F.ws + WS_WT + (size_t)l * LW;
        if (r < I_IN) { wconv_item(F.in[6] + (size_t)l * DM * DIN, DIN, (bf16_t*)(wl + LW_IN), DM, nullptr, 1, scr, r, 96, lane); continue; } r -= I_IN;
        if (r < 4 * I_G) { wconv_item(F.in[21] + (size_t)l * 4 * DM * DM, DM, (bf16_t*)(wl + LW_G), DM, nullptr, 3, scr, r, 128, lane, true); continue; } r -= 4 * I_G;
        if (r < I_BA) { wconv_item(F.in[17] + (size_t)l * 256 * DM, DM, (bf16_t*)(wl + LW_BR + BR_A), 256, nullptr, 4, scr, r, 32, lane); continue; } r -= I_BA;
        if (r < I_BB) { wconv_item(F.in[18] + (size_t)l * 128 * DM, DM, (bf16_t*)(wl + LW_BR + BR_B), 128, nullptr, 4, scr, r, 32, lane); continue; } r -= I_BB;
        if (r < I_BA) { wconv_item(F.in[19] + (size_t)l * 256 * DM, DM, (bf16_t*)(wl + LW_BR + BR_C), 256, nullptr, 4, scr, r, 32, lane); continue; } r -= I_BA;
        if (r < I_BA) { wconv_item(F.in[20] + (size_t)l * 256 * DM, DM, (bf16_t*)(wl + LW_BR + BR_D), 256, nullptr, 4, scr, r, 32, lane); continue; } r -= I_BA;
        if (r < I_O) { wconv_item(F.in[22] + (size_t)l * DM * DM, DM, (bf16_t*)(wl + LW_O), DM, nullptr, 0, scr, r, 32, lane); continue; } r -= I_O;
        if (r < I_UP) { wconv_item(F.in[23] + (size_t)l * DM * DFF2, DFF2, (bf16_t*)(wl + LW_UP), DM, nullptr, 5, scr, r, 176, lane); continue; } r -= I_UP;
        if (r < I_DN) { wconv_item(F.in[26] + (size_t)l * DFF * DM, DM, (bf16_t*)(wl + LW_DN), DFF, nullptr, 0, scr, r, 32, lane); continue; } r -= I_DN;
        if (r < I_UQ) { wconv_item(F.in[15] + (size_t)l * 256 * 384, 384, (bf16_t*)(wl + LW_UQ), 256, F.in[13] + l * 256, 2, scr, r, 16, lane); continue; } r -= I_UQ;
        if (r < I_UKV) { wconv_item(F.in[16] + (size_t)l * 128 * 512, 512, (bf16_t*)(wl + LW_UKV), 128, F.in[14] + l * 128, 0, scr, r, 16, lane); continue; } r -= I_UKV;
        if (r < I_PHI) { wconv_item(F.in[8] + (size_t)l * 2048 * 128, 128, (bf16_t*)(wl + LW_PHI), 2048, nullptr, 0, scr, r, 4, lane); continue; } r -= I_PHI;
        wconv_item(F.in[10] + (size_t)l * 2048 * 128, 128, (bf16_t*)(wl + LW_PHI) + (size_t)128 * 2048, 2048, nullptr, 0, scr, r, 4, lane);
    }
    const int gt = blockIdx.x * 512 + F.tid, NGT = F.G * 512;
    const float* rel = F.in[1];
    float* rope = WSP(float, WS_ROPE);
    for (int i = gt; i < SEQ * 16; i += NGT) { const int t = i >> 4, k = i & 15; const float inv = powf(10000.0f, -(float)(2 * k) / 32.0f); const float ang = (float)t * inv;
        float sn, cs; sincosf(ang, &sn, &cs); rope[2 * i] = cs; rope[2 * i + 1] = sn; }
    float* ntab = WSP(float, WS_NSATAB);
    for (int i = gt; i < 4 * NSA_TL; i += NGT) { const int hd = i / NSA_TL, k = i % NSA_TL, dist = NSA_DMAX - k; ntab[i] = dist >= 0 ? rel[rel_bucket(dist) * 10 + hd] * LOG2E : 0.f; }
    float* dtab = WSP(float, WS_DILTAB);
    for (int i = gt; i < 6 * 192; i += NGT) { const int gh = i / 192, k = i % 192, g = gh >> 1, hh = gh & 1, j = 160 - k; dtab[i] = (j >= 0 && j <= 128) ? rel[rel_bucket(j << (2 * g)) * 10 + 4 + 2 * g + hh] * LOG2E : 0.f; }
    if (gt < 4) WSP(float, WS_FARB)[gt] = rel[31 * 10 + gt] * LOG2E;
    if (gw < 128) { const int mi = gw >> 5, pc = gw & 31, l = mi >> 1; const float *pk1 = F.in[8], *pv1 = F.in[10]; asm volatile("" : "+s"(pk1), "+s"(pv1));
        const float* w1 = ((mi & 1) ? pv1 : pk1) + (size_t)l * 2048 * 128 + (size_t)(64 * pc) * 128 + 2 * lane; const float* cp = F.in[7] + (size_t)l * 2048 + 64 * pc;
        f32x2 a = {0.f, 0.f};
#pragma unroll 8
        for (int p = 0; p < 64; ++p) { const f32x2 w = *(const f32x2*)(w1 + (size_t)p * 128); const float cpp = cp[p]; a[0] += cpp * w[0]; a[1] += cpp * w[1]; }
        *(f32x2*)(WSP(float, WS_CMPP) + ((size_t)mi * 32 + pc) * 128 + 2 * lane) = a; }
    if (gt < ATT_UNITS) WSP(int, WS_ORDER)[att_rank(gt)] = gt;
}
__device__ __forceinline__ void cmpb_reduce(Frame& F) {
    const int i = F.tid; if (i < DEPTH * 256) { const int l = i >> 8, n = i & 255, mi = l * 2 + (n >> 7); const float* pp = WSP(const float, WS_CMPP) + (size_t)mi * 32 * 128 + (n & 127); float a = 0.f;
        for (int pc = 0; pc < 32; ++pc) a += pp[pc * 128]; WSP(float, WS_CMPB)[i] = a; }
}

template <int MODE, bool XIB, bool XOB, bool H8 = false> __device__ __forceinline__ void rowpass(Frame& F, const void* x, const bf16_t* y, size_t yrow0, void* xout, bf16_t* hout, const float* g1, const float* g2, int row_lo, int row_hi, unsigned char* h8out = nullptr) {
    int gw = blockIdx.x * 8 + F.wave; asm volatile("" : "+s"(gw));
    const int NGW = F.G * 8, lane = F.lane;
    f32x4 ga[4], gb[4];
#pragma unroll
    for (int j = 0; j < 4; ++j) { ga[j] = *(const f32x4*)(g1 + 4 * lane + 256 * j); if (MODE == 1) gb[j] = *(const f32x4*)(g2 + 4 * lane + 256 * j); }
    f32x4 xf[4], xfn[4]; u32x2 xb[4], xbn[4], yb[4], ybn[4];
#define RP_LOAD(XF, XB, YB, mm) do { if (XIB) { const u32x2* xr_ = (const u32x2*)((const bf16_t*)x + (size_t)(mm) * DM) + lane; _Pragma("unroll") for (int j = 0; j < 4; ++j) XB[j] = xr_[64 * j]; } \
        else { const f32x4* xr_ = (const f32x4*)((const float*)x + (size_t)(mm) * DM) + lane; _Pragma("unroll") for (int j = 0; j < 4; ++j) XF[j] = xr_[64 * j]; } \
        if (MODE != 0) { const u32x2* yr_ = (const u32x2*)(y + ((size_t)(mm) - yrow0) * DM) + lane; _Pragma("unroll") for (int j = 0; j < 4; ++j) YB[j] = yr_[64 * j]; } } while (0)
    int m = row_lo + gw;
    if (m < row_hi) RP_LOAD(xf, xb, yb, m);
    for (; m < row_hi; m += NGW) {
        const int mn = m + NGW;
        if (mn < row_hi) RP_LOAD(xfn, xbn, ybn, mn);
        f32x4 v[4];
#pragma unroll
        for (int j = 0; j < 4; ++j) { if (XIB) { v[j][0] = __uint_as_float(xb[j].x << 16); v[j][1] = __uint_as_float(xb[j].x & 0xffff0000u); v[j][2] = __uint_as_float(xb[j].y << 16); v[j][3] = __uint_as_float(xb[j].y & 0xffff0000u); } else v[j] = xf[j]; }
        if (MODE != 0) {
            f32x4 w[4]; float s = 0.f;
#pragma unroll
            for (int j = 0; j < 4; ++j) { const u32x2 yy = yb[j]; w[j][0] = __uint_as_float(yy.x << 16); w[j][1] = __uint_as_float(yy.x & 0xffff0000u); w[j][2] = __uint_as_float(yy.y << 16); w[j][3] = __uint_as_float(yy.y & 0xffff0000u);
                s += (w[j][0] * w[j][0] + w[j][1] * w[j][1]) + (w[j][2] * w[j][2] + w[j][3] * w[j][3]); }
            const float rstd = 1.0f / sqrtf(wave_sum(s) * (1.0f / DM) + RMS_EPS);
#pragma unroll
            for (int j = 0; j < 4; ++j) v[j] = v[j] + w[j] * rstd * ga[j];
            if (XOB) { u32x2* xo = (u32x2*)((bf16_t*)xout + (size_t)m * DM) + lane;
#pragma unroll
                for (int j = 0; j < 4; ++j) { u32x2 w2; w2.x = cvtpk(v[j][0], v[j][1]); w2.y = cvtpk(v[j][2], v[j][3]); xo[64 * j] = w2; } }
            else { f32x4* xo = (f32x4*)((float*)xout + (size_t)m * DM) + lane;
#pragma unroll
                for (int j = 0; j < 4; ++j) xo[64 * j] = v[j]; }
        }
        if (MODE != 2) {
            float s = 0.f;
#pragma unroll
            for (int j = 0; j < 4; ++j) s += (v[j][0] * v[j][0] + v[j][1] * v[j][1]) + (v[j][2] * v[j][2] + v[j][3] * v[j][3]);
            const float rstd = 1.0f / sqrtf(wave_sum(s) * (1.0f / DM) + RMS_EPS);
            u32x2* ho = (u32x2*)(hout + (size_t)m * DM) + lane;
#pragma unroll
            for (int j = 0; j < 4; ++j) { const f32x4 gg = (MODE == 1) ? gb[j] : ga[j]; const f32x4 o = v[j] * rstd * gg; u32x2 w; w.x = cvtpk(o[0], o[1]); w.y = cvtpk(o[2], o[3]); ho[64 * j] = w;
                if (H8) ((unsigned*)(h8out + (size_t)m * DM))[lane + 64 * j] = pk4_fp8(o[0] * H8_SCALE, o[1] * H8_SCALE, o[2] * H8_SCALE, o[3] * H8_SCALE); }
        }
#pragma unroll
        for (int j = 0; j < 4; ++j) { if (XIB) xb[j] = xbn[j]; else xf[j] = xfn[j]; if (MODE != 0) yb[j] = ybn[j]; }
    }
#undef RP_LOAD
}

__device__ __forceinline__ void ffn_fix_panel(Frame& F, int pm, const float* HB, bf16_t* ACT, const float* cw, const float* cb) {
#pragma unroll 2
    for (int it = F.tid; it < 4 * 2 * (DFF / 4); it += 512) {
        const int c4 = it % (DFF / 4), rr = (it / (DFF / 4)) & 1, g = pm * 4 + it / (2 * (DFF / 4)), c = c4 * 4, pn = c >> 7, cl = c & 127;
        const bool first = ((g * 64) & (SEQ - 1)) == 0;
#define HBV(gg, s, bj) (*(const f32x4*)(HB + ((size_t)(((gg) * 4 + (s)) * 22 + pn) * 256 + (bj) * 128 + cl)))
        const f32x4 z = {0.f, 0.f, 0.f, 0.f};
        const f32x4 u0g = HBV(g, 0, 0), u0v = HBV(g, 0, 1);
        f32x4 ag, bg_, cg, av, bv_, cv;
        if (rr == 0) { ag = first ? z : HBV(g - 1, 2, 0); bg_ = first ? z : HBV(g - 1, 3, 0); cg = u0g; av = first ? z : HBV(g - 1, 2, 1); bv_ = first ? z : HBV(g - 1, 3, 1); cv = u0v; }
        else { ag = first ? z : HBV(g - 1, 3, 0); bg_ = u0g; cg = HBV(g, 1, 0); av = first ? z : HBV(g - 1, 3, 1); bv_ = u0v; cv = HBV(g, 1, 1); }
#undef HBV
        const f32x4 kb = *(const f32x4*)(cb + c), k0 = *(const f32x4*)(cw + c), k1 = *(const f32x4*)(cw + DFF2 + c), k2 = *(const f32x4*)(cw + 2 * DFF2 + c);
        const f32x4 vb = *(const f32x4*)(cb + DFF + c), v0 = *(const f32x4*)(cw + DFF + c), v1 = *(const f32x4*)(cw + DFF2 + DFF + c), v2 = *(const f32x4*)(cw + 2 * DFF2 + DFF + c);
        float o[4];
#pragma unroll
        for (int e = 0; e < 4; ++e) { const float gt = kb[e] + k0[e] * ag[e] + k1[e] * bg_[e] + k2[e] * cg[e], vl = vb[e] + v0[e] * av[e] + v1[e] * bv_[e] + v2[e] * cv[e]; o[e] = gt * sigmoid_f(gt) * vl; }
        u32x2 w; w.x = cvtpk(o[0], o[1]); w.y = cvtpk(o[2], o[3]);
        *(u32x2*)(ACT + (size_t)(g * 64 + rr) * DFF + c) = w;
    }
}
#ifdef SELFCHECK
constexpr int CW_CHK = 20480;
__device__ __forceinline__ unsigned chk_hash(unsigned x) { x ^= x >> 16; x *= 0x7feb352du; x ^= x >> 15; x *= 0x846ca68bu; x ^= x >> 16; return x; }
__device__ __forceinline__ int chk_t(int i) {
    int r = 0;
    switch (i & 31) { case 0: r = 0; break; case 1: r = 1; break; case 2: r = 15; break; case 3: r = 16; break; case 4: r = 30; break; case 5: r = 31; break; case 6: r = 32; break; case 7: r = 47; break;
        case 8: r = 63; break; case 9: r = 64; break; case 10: r = 65; break; case 11: r = 127; break; case 12: r = 128; break; case 13: r = 129; break; case 14: r = 255; break; case 15: r = 256; break;
        case 16: r = 257; break; case 17: r = 511; break; case 18: r = 512; break; case 19: r = 513; break; case 20: r = 575; break; case 21: r = 1023; break; case 22: r = 1024; break; case 23: r = 1599; break;
        case 24: r = 1600; break; case 25: r = 2047; break; case 26: r = 2048; break; case 27: r = 2111; break; case 28: r = 3000; break; case 29: r = 4031; break; case 30: r = 4032; break; default: r = 4095; break; }
    return (i < 64) ? r : (int)(chk_hash(i * 7919u + 13u) & 4095u);
}
__device__ __forceinline__ bool chk_bad(float got, float ref, float scale) { const float d = fabsf(got - ref); return !(d <= 0.02f * fabsf(ref) + 0.02f * scale); }
__device__ __forceinline__ float bfr(float x) { return bf2f((unsigned short)f2bf(x)); }
__device__ __forceinline__ void chk_flag(Frame& F, int bit, bool bad, int allow) {
    LAS unsigned* cnt = (LAS unsigned*)(F.lds + 65536);
    __syncthreads(); if (threadIdx.x == 0) *cnt = 0u; __syncthreads();
    if (bad) atomicAdd((unsigned*)cnt, 1u);
    __syncthreads();
    if (threadIdx.x == 0 && *cnt > (unsigned)allow) atomicOr((unsigned*)(F.ctl + CW_CHK), 1u << bit);
    __syncthreads();
}
__device__ __forceinline__ int chk_bucket_ref(int dist) {
    if (dist < 0) dist = 0; if (dist < 16) return dist;
    const float d = (float)dist; int large = 16 + (int)(logf(d / 16.0f) / 4.852030263919617f * 16.0f); return large < 31 ? large : 31;
}
__device__ __forceinline__ bool chk_fox(Frame& F, int b, int h, int t) {
    const bf16_t* P = WSP(const bf16_t, WS_P);
    { const size_t row = (size_t)b * SEQ + t; const bf16_t* q = P + row * PW + PC_CQ + h * 64; const float* kb = WSP(const float, WS_KB) + ((size_t)b * 4 + h) * SEQ;
      float m = -INFINITY; for (int j = 0; j <= t; ++j) { const bf16_t* k = P + ((size_t)b * SEQ + j) * PW + PC_CK + h * 64; float s = 0.f; for (int d = 0; d < 64; ++d) s += bf2f(q[d]) * bf2f(k[d]); s += kb[j]; m = fmaxf(m, s); }
      float lsum = 0.f, dummy0_ = 0.f; f32x4 o = {0.f, 0.f, 0.f, 0.f};
      for (int j = 0; j <= t; ++j) { const bf16_t* k = P + ((size_t)b * SEQ + j) * PW + PC_CK + h * 64; const bf16_t* v = P + ((size_t)b * SEQ + j) * PW + PC_CV + h * 64; float s = 0.f; for (int d = 0; d < 64; ++d) s += bf2f(q[d]) * bf2f(k[d]); s += kb[j];
          const float p = exp2f(s - m); lsum += p; _Pragma("unroll") for (int e = 0; e < 4; ++e) o[e] += p * bf2f(v[21 * e]); }
      bool bad = false; _Pragma("unroll") for (int e = 0; e < 4; ++e) bad |= chk_bad(bf2f(WSP(const bf16_t, WS_OCAT)[row * OCW + 384 + h * 64 + 21 * e]), o[e] / lsum, 0.5f);
      return bad; }
}
__device__ __forceinline__ bool chk_dil(Frame& F, int b, int hh, int t) {
    const bf16_t* P = WSP(const bf16_t, WS_P); const float* rel = F.in[1];
    { const size_t row = (size_t)b * SEQ + t;
      float m = -INFINITY;
      for (int g = 0; g < 3; ++g) { const int dil = 1 << (2 * g), head = 2 * g + hh; const bf16_t* q = P + row * PW + PC_BQ + head * 64;
          for (int j = 0; j <= 128; ++j) { const int idx = t - dil * j; if (idx < 0) break; const bf16_t* k = P + ((size_t)b * SEQ + idx) * PW + PC_BK + head * 64; float s = 0.f; for (int d = 0; d < 64; ++d) s += bf2f(q[d]) * bf2f(k[d]);
              s += rel[chk_bucket_ref(dil * j) * 10 + 4 + head] * LOG2E; m = fmaxf(m, s); } }
      float lsum = 0.f, dummy0_ = 0.f; f32x4 o = {0.f, 0.f, 0.f, 0.f};
      for (int g = 0; g < 3; ++g) { const int dil = 1 << (2 * g), head = 2 * g + hh; const bf16_t* q = P + row * PW + PC_BQ + head * 64;
          for (int j = 0; j <= 128; ++j) { const int idx = t - dil * j; if (idx < 0) break; const bf16_t* k = P + ((size_t)b * SEQ + idx) * PW + PC_BK + head * 64; const bf16_t* v = P + ((size_t)b * SEQ + idx) * PW + PC_BV + head * 64; float s = 0.f; for (int d = 0; d < 64; ++d) s += bf2f(q[d]) * bf2f(k[d]);
              s += rel[chk_bucket_ref(dil * j) * 10 + 4 + head] * LOG2E; const float p = exp2f(s - m); lsum += p; _Pragma("unroll") for (int e = 0; e < 4; ++e) o[e] += p * bf2f(v[21 * e]); } }
      bool bad = false; _Pragma("unroll") for (int e = 0; e < 4; ++e) bad |= chk_bad(bf2f(WSP(const bf16_t, WS_OCAT)[row * OCW + 256 + hh * 64 + 21 * e]), o[e] / lsum, 0.5f);
      return bad; }
}
__device__ __forceinline__ bool chk_nsa(Frame& F, int b, int h, int t, int i) {
    const bf16_t* P = WSP(const bf16_t, WS_P); const float* rel = F.in[1];
    { bool bad = false;
      { const size_t row = (size_t)b * SEQ + t; const size_t rb = (size_t)b * SEQ;
      const bf16_t* KC = WSP(const bf16_t, WS_KC) + (size_t)b * 256 * 64; const bf16_t* VC = WSP(const bf16_t, WS_VC) + (size_t)b * 256 * 64;
      const int cmax = (t >= 31) ? (t - 31) / 16 : -1, cur = t >> 6;
      LAS float* imp = (LAS float*)(F.lds + 70000) + i * 65; for (int j = 0; j < 64; ++j) imp[j] = 0.f;
      f32x4 oc = {0.f, 0.f, 0.f, 0.f};
      for (int hh = 0; hh < 4; ++hh) { const bf16_t* q = P + row * PW + PC_AQ + hh * 64; float m = -INFINITY;
          for (int c = 0; c <= cmax; ++c) { float s = 0.f; for (int d = 0; d < 64; ++d) s += bf2f(q[d]) * bf2f(KC[c * 64 + d]); m = fmaxf(m, s); }
          float ls = 0.f; for (int c = 0; c <= cmax; ++c) { float s = 0.f; for (int d = 0; d < 64; ++d) s += bf2f(q[d]) * bf2f(KC[c * 64 + d]); ls += exp2f(s - m); }
          for (int c = 0; c <= cmax; ++c) { float s = 0.f; for (int d = 0; d < 64; ++d) s += bf2f(q[d]) * bf2f(KC[c * 64 + d]); const float p = exp2f(s - m) / ls;
              for (int j = 0; j < 64; ++j) if (16 * c <= 64 * j + 63 && 16 * c + 31 >= 64 * j) imp[j] += p;
              if (hh == h) _Pragma("unroll") for (int e = 0; e < 4; ++e) oc[e] += p * bf2f(VC[c * 64 + 21 * e]); } }
      for (int j = 0; j < 64; ++j) imp[j] = (j == 0 || j == cur || j == cur - 1) ? 1e9f : (j > cur ? -1e9f : imp[j]);
      unsigned long long selm = 0ull;
      for (int j = 0; j < 64; ++j) { int rank = 0; for (int k = 0; k < 64; ++k) rank += (imp[k] > imp[j] || (imp[k] == imp[j] && k < j)) ? 1 : 0; if (rank < 16) selm |= 1ull << j; }
      const bf16_t* q = P + row * PW + PC_AQ + h * 64;
      f32x4 os = {0.f, 0.f, 0.f, 0.f}, ow = {0.f, 0.f, 0.f, 0.f};
      { float m = -INFINITY; for (int pos = 0; pos <= t; ++pos) { if (!((selm >> (pos >> 6)) & 1ull)) continue; const bf16_t* k = P + (rb + pos) * PW + PC_KSLC; float s = 0.f; for (int d = 0; d < 64; ++d) s += bf2f(q[d]) * bf2f(k[d]); s += rel[chk_bucket_ref(t - pos) * 10 + h] * LOG2E; m = fmaxf(m, s); }
        float ls = 0.f; for (int pos = 0; pos <= t; ++pos) { if (!((selm >> (pos >> 6)) & 1ull)) continue; const bf16_t* k = P + (rb + pos) * PW + PC_KSLC; const bf16_t* v = P + (rb + pos) * PW + PC_VSLC; float s = 0.f; for (int d = 0; d < 64; ++d) s += bf2f(q[d]) * bf2f(k[d]); s += rel[chk_bucket_ref(t - pos) * 10 + h] * LOG2E;
            const float p = exp2f(s - m); ls += p; _Pragma("unroll") for (int e = 0; e < 4; ++e) os[e] += p * bf2f(v[21 * e]); }
        _Pragma("unroll") for (int e = 0; e < 4; ++e) os[e] /= ls; }
      { const int lo = t - 511 > 0 ? t - 511 : 0; float m = -INFINITY; for (int pos = lo; pos <= t; ++pos) { const bf16_t* k = P + (rb + pos) * PW + PC_KWIN; float s = 0.f; for (int d = 0; d < 64; ++d) s += bf2f(q[d]) * bf2f(k[d]); s += rel[chk_bucket_ref(t - pos) * 10 + h] * LOG2E; m = fmaxf(m, s); }
        float ls = 0.f; for (int pos = lo; pos <= t; ++pos) { const bf16_t* k = P + (rb + pos) * PW + PC_KWIN; const bf16_t* v = P + (rb + pos) * PW + PC_VWIN; float s = 0.f; for (int d = 0; d < 64; ++d) s += bf2f(q[d]) * bf2f(k[d]); s += rel[chk_bucket_ref(t - pos) * 10 + h] * LOG2E;
            const float p = exp2f(s - m); ls += p; _Pragma("unroll") for (int e = 0; e < 4; ++e) ow[e] += p * bf2f(v[21 * e]); }
        _Pragma("unroll") for (int e = 0; e < 4; ++e) ow[e] /= ls; }
      const float* sd = WSP(const float, WS_SIDE) + row * 16 + h * 3; const float g0 = 1.f / (1.f + expf(-sd[0])), g1 = 1.f / (1.f + expf(-sd[1])), g2 = 1.f / (1.f + expf(-sd[2]));
      _Pragma("unroll") for (int e = 0; e < 4; ++e) bad |= chk_bad(bf2f(WSP(const bf16_t, WS_OCAT)[row * OCW + h * 64 + 21 * e]), g0 * oc[e] + g1 * os[e] + g2 * ow[e], 0.3f); }
      return bad; }
}
__device__ __forceinline__ void selfcheck_a(Frame& F, int l) {
    const int i = threadIdx.x;
    const float* x = F.in[0];
    const bf16_t* H = WSP(const bf16_t, WS_H); const bf16_t* P = WSP(const bf16_t, WS_P);
    const float* rel = F.in[1];
    { const int row = (int)(chk_hash(i) % M), col = (int)(chk_hash(i + 999) & 1023); float s = 0.f; for (int k = 0; k < DM; ++k) { const float v = x[(size_t)row * DM + k]; s += v * v; }
      const float ref = x[(size_t)row * DM + col] * (1.0f / sqrtf(s / DM + RMS_EPS)) * F.in[2][l * DM + col];
      chk_flag(F, 0, chk_bad(bf2f(H[(size_t)row * DM + col]), ref, 1.0f), 0); }
    { const int row = (int)(chk_hash(i + 5) % M); int c = (i * 37 + 5) % PW; if (i < 32) c = 640 + (i & 15); else if (i < 96) c = 672 + (i & 31); else if (i < 160) c = 256 + ((i * 3) & 127);
      const float* W = F.in[6] + (size_t)l * DM * DIN; bool bad = false;
#define DOTC(dst, cc) do { float sc_; const int src_ = inproj_src((cc), sc_); float a_ = 0.f; if (src_ >= 0) for (int k = 0; k < DM; ++k) a_ += bf2f(H[(size_t)row * DM + k]) * bfr(W[(size_t)k * DIN + src_] * sc_); dst = a_; } while (0)
      float ref; DOTC(ref, c);
      if (c >= 672 && c < 704) { const int p = c - 672, ip = p >> 1; float oth; DOTC(oth, c ^ 1); const float x1 = (p & 1) ? oth : ref, x2 = (p & 1) ? ref : oth;
          const float inv = powf(10000.0f, -(float)(2 * ip) / 32.0f), ang = (float)(row & (SEQ - 1)) * inv, cs = cosf(ang), sn = sinf(ang);
          ref = (p & 1) ? (x2 * cs + x1 * sn) : (x1 * cs - x2 * sn);
          bad |= chk_bad(bf2f(WSP(const bf16_t, WS_KROT)[(size_t)row * 32 + p]), ref, 1.0f); }
      bad |= chk_bad(bf2f(P[(size_t)row * PW + c]), ref, 1.0f);
      if (c >= 640 && c < 656) bad |= chk_bad(WSP(const float, WS_SIDE)[(size_t)row * 16 + (c - 640)], ref, 1.0f);
      if (c >= 256 && c < 320) bad |= chk_bad(bf2f(WSP(const bf16_t, WS_KCMP)[(size_t)row * 64 + (c - 256)]), ref, 1.0f);
      if (c >= 320 && c < 384) bad |= chk_bad(bf2f(WSP(const bf16_t, WS_VCMP)[(size_t)row * 64 + (c - 320)]), ref, 1.0f);
      if (i >= 160 && i < 192) { float sq = 0.f, skv = 0.f; for (int k = 0; k < 256; ++k) { const float v = bf2f(P[(size_t)row * PW + PC_DQL + k]); sq += v * v; } for (int k = 0; k < 128; ++k) { const float v = bf2f(P[(size_t)row * PW + PC_DKV + k]); skv += v * v; }
          const float* a = WSP(const float, WS_SSQQ) + (size_t)row * 4; const float* b = WSP(const float, WS_SSQKV) + (size_t)row * 4;
          bad |= chk_bad(a[0] + a[1] + a[2] + a[3], sq, 10.f) || chk_bad(b[0] + b[1] + b[2] + b[3], skv, 5.f); }
      chk_flag(F, 1, bad, 0); }
    { const int b = i & 15, h = (i >> 4) & 3, t = chk_t(i >> 6); float a = 0.f; for (int j = 0; j <= t; ++j) { const float xx = WSP(const float, WS_SIDE)[((size_t)b * SEQ + j) * 16 + 12 + h] + F.in[12][l * 4 + h]; a += (xx >= 0.f) ? -log1pf(expf(-xx)) : (xx - log1pf(expf(xx))); }
      chk_flag(F, 2, chk_bad(WSP(const float, WS_KB)[((size_t)b * 4 + h) * SEQ + t], -a * LOG2E, 1.0f + fabsf(a) * 0.05f), 0); }
    chk_flag(F, 3, chk_fox(F, (i * 5) & 15, i & 3, chk_t(i >> 2)), 0);
    { const int row = (int)(chk_hash(i + 77) % M); bool bad = false;
      float sq = 0.f, skv = 0.f; for (int k = 0; k < 256; ++k) { const float v = bf2f(P[(size_t)row * PW + PC_DQL + k]); sq += v * v; } for (int k = 0; k < 128; ++k) { const float v = bf2f(P[(size_t)row * PW + PC_DKV + k]); skv += v * v; }
      const float rq = 1.0f / sqrtf(sq / 256.0f + RMS_EPS), rkv = 1.0f / sqrtf(skv / 128.0f + RMS_EPS);
      const float* wq = F.in[15] + (size_t)l * 256 * 384; const float* gq = F.in[13] + l * 256; const float* wkv = F.in[16] + (size_t)l * 128 * 512; const float* gkv = F.in[14] + l * 128;
#define QDOT(dst, src) do { float a_ = 0.f; for (int k = 0; k < 256; ++k) a_ += bf2f(P[(size_t)row * PW + PC_DQL + k]) * bfr(wq[(size_t)k * 384 + (src)] * C2D * gq[k]); dst = a_ * rq; } while (0)
      const int r = (i * 11) % 384, hd = r / 96, w = r % 96; float ref;
      if (w < 64) QDOT(ref, hd * 96 + w);
      else { const int p = w - 64, ip = p >> 1; float x1, x2; QDOT(x1, hd * 96 + 64 + ip); QDOT(x2, hd * 96 + 64 + 16 + ip); const float inv = powf(10000.0f, -(float)(2 * ip) / 32.0f), ang = (float)(row & (SEQ - 1)) * inv, cs = cosf(ang), sn = sinf(ang);
          ref = (p & 1) ? (x2 * cs + x1 * sn) : (x1 * cs - x2 * sn); }
      bad |= chk_bad(bf2f(WSP(const bf16_t, WS_QM)[(size_t)row * 512 + r]), ref, 1.5f);
      { const int c = (i * 13) & 511; float a = 0.f; for (int k = 0; k < 128; ++k) a += bf2f(P[(size_t)row * PW + PC_DKV + k]) * bfr(wkv[(size_t)k * 512 + c] * gkv[k]); bad |= chk_bad(bf2f(WSP(const bf16_t, WS_KVM)[(size_t)row * 512 + c]), a * rkv, 1.0f); }
      chk_flag(F, 4, bad, 0); }
    { const int b = (i * 3) & 15, h = i & 3, t = chk_t(i >> 2); const size_t row = (size_t)b * SEQ + t; const bf16_t* q = WSP(const bf16_t, WS_QM) + row * 512 + h * 96; const bf16_t* KV = WSP(const bf16_t, WS_KVM); const bf16_t* KR = WSP(const bf16_t, WS_KROT);
      float m = -INFINITY; for (int j = 0; j <= t; ++j) { const size_t rj = (size_t)b * SEQ + j; float s = 0.f; for (int d = 0; d < 64; ++d) s += bf2f(q[d]) * bf2f(KV[rj * 512 + h * 128 + d]); for (int d = 0; d < 32; ++d) s += bf2f(q[64 + d]) * bf2f(KR[rj * 32 + d]); m = fmaxf(m, s); }
      float lsum = 0.f, dummy0_ = 0.f; f32x4 o = {0.f, 0.f, 0.f, 0.f};
      for (int j = 0; j <= t; ++j) { const size_t rj = (size_t)b * SEQ + j; float s = 0.f; for (int d = 0; d < 64; ++d) s += bf2f(q[d]) * bf2f(KV[rj * 512 + h * 128 + d]); for (int d = 0; d < 32; ++d) s += bf2f(q[64 + d]) * bf2f(KR[rj * 32 + d]);
          const float p = exp2f(s - m); lsum += p; _Pragma("unroll") for (int e = 0; e < 4; ++e) o[e] += p * bf2f(KV[rj * 512 + h * 128 + 64 + 21 * e]); }
      bool bad = false; _Pragma("unroll") for (int e = 0; e < 4; ++e) bad |= chk_bad(bf2f(WSP(const bf16_t, WS_OCAT)[row * OCW + 640 + h * 64 + 21 * e]), o[e] / lsum, 0.5f);
      chk_flag(F, 5, bad, 0); }
    chk_flag(F, 6, chk_dil(F, (i * 7) & 15, i & 1, chk_t(i >> 1)), 0);
    { const int b = i & 15, which = (i >> 4) & 1, c = (int)(chk_hash(i + 31) % 255), d = (i * 5) & 63; const bf16_t* src = (which ? WSP(const bf16_t, WS_VCMP) : WSP(const bf16_t, WS_KCMP)) + ((size_t)b * SEQ + 16 * c) * 64;
      const float *pk1 = F.in[8], *pv1 = F.in[10], *pk2 = F.in[9], *pv2 = F.in[11]; asm volatile("" : "+s"(pk1), "+s"(pv1), "+s"(pk2), "+s"(pv2));
      const float* w1 = (which ? pv1 : pk1) + (size_t)l * 2048 * 128; const float* w2 = (which ? pv2 : pk2) + (size_t)l * 128 * 64; const float* cp = F.in[7] + (size_t)l * 2048;
      float out = 0.f;
      for (int n = 0; n < 128; ++n) { float a = 0.f, bsum = 0.f; for (int p = 0; p < 2048; ++p) { a += bf2f(src[p]) * bfr(w1[(size_t)p * 128 + n]); bsum += cp[p] * w1[(size_t)p * 128 + n]; }
          const float xx = a + bsum, g = 0.5f * xx * (1.0f + tanhf(0.7978845608028654f * (xx + 0.044715f * xx * xx * xx))); out += bfr(g) * w2[n * 64 + d]; }
      chk_flag(F, 7, chk_bad(bf2f((which ? WSP(const bf16_t, WS_VC) : WSP(const bf16_t, WS_KC))[((size_t)b * 256 + c) * 64 + d]), out, 0.5f), 0); }
    { bool bad = false; if (i < 128) bad = chk_nsa(F, (i * 9) & 15, i & 3, chk_t(i >> 2), i); chk_flag(F, 8, bad, 4); }
}
__device__ __forceinline__ void selfcheck_b(Frame& F, int l) {
    const int i = threadIdx.x; const int row = (int)(chk_hash(i + 3) % M), n = (i * 29 + 7) & 1023;
    const bf16_t* H = WSP(const bf16_t, WS_H); const bf16_t* OC = WSP(const bf16_t, WS_OCAT);
    float acc = 0.f;
    for (int br = 0; br < 4; ++br) { const float* wg = F.in[21] + ((size_t)l * 4 + br) * DM * DM; float g = 0.f; for (int k = 0; k < DM; ++k) g += bf2f(H[(size_t)row * DM + k]) * bfr(wg[(size_t)k * DM + n]);
        const int kk = (br == 1) ? 128 : 256, co = (br == 0) ? 0 : (br == 1 ? 256 : (br == 2 ? 384 : 640)); const float *pb0 = F.in[17], *pb1 = F.in[18], *pb2 = F.in[19], *pb3 = F.in[20]; asm volatile("" : "+s"(pb0), "+s"(pb1), "+s"(pb2), "+s"(pb3)); const float* wb = (br == 0 ? pb0 : (br == 1 ? pb1 : (br == 2 ? pb2 : pb3))) + (size_t)l * kk * DM; float t = 0.f; for (int k = 0; k < kk; ++k) t += bf2f(OC[(size_t)row * OCW + co + k]) * bfr(wb[(size_t)k * DM + n]);
        acc += (1.f / (1.f + expf(-g))) * bfr(t); }
    chk_flag(F, 9, chk_bad(bf2f(WSP(const bf16_t, WS_MERGED)[(size_t)row * DM + n]), acc, 0.5f), 0);
}
__device__ __forceinline__ void selfcheck_c(Frame& F, int l, const float* xin) {
    const int i = threadIdx.x; const int row = (int)(chk_hash(i + 11) % M), n = (i * 29 + 7) & 1023;
    const bf16_t* MG = WSP(const bf16_t, WS_MERGED); const float* wo = F.in[22] + (size_t)l * DM * DM; const float* Y = WSP(const float, WS_Y);
    float a = 0.f; for (int k = 0; k < DM; ++k) a += bf2f(MG[(size_t)row * DM + k]) * bfr(wo[(size_t)k * DM + n]);
    chk_flag(F, 0, chk_bad(Y[(size_t)row * DM + n], a, 1.0f), 0);
    float s = 0.f; for (int k = 0; k < DM; ++k) { const float v = Y[(size_t)row * DM + k]; s += v * v; }
    const float rstd = 1.0f / sqrtf(s / DM + RMS_EPS); float s2 = 0.f;
    for (int k = 0; k < DM; ++k) { const float v = xin[(size_t)row * DM + k] + Y[(size_t)row * DM + k] * rstd * F.in[3][l * DM + k]; s2 += v * v; }
    const float x1 = xin[(size_t)row * DM + n] + Y[(size_t)row * DM + n] * rstd * F.in[3][l * DM + n];
    const float h2 = x1 * (1.0f / sqrtf(s2 / DM + RMS_EPS)) * F.in[4][l * DM + n];
    chk_flag(F, 1, chk_bad(F.out[(size_t)row * DM + n], x1, 1.0f) || chk_bad(bf2f(WSP(const bf16_t, WS_H2)[(size_t)row * DM + n]), h2, 1.0f), 0);
}
__device__ __forceinline__ void selfcheck_d(Frame& F, int l) {
    const int i = threadIdx.x; const int row = (int)(chk_hash(i + 17) % (M / 2)); const bf16_t* H2 = WSP(const bf16_t, WS_H2); const bf16_t* U = WSP(const bf16_t, WS_U); const bf16_t* A = WSP(const bf16_t, WS_ACT);
    { const int c = (i * 41 + 3) % DFF2; const float* wu = F.in[23] + (size_t)l * DM * DFF2; float a = 0.f; for (int k = 0; k < DM; ++k) a += bf2f(H2[(size_t)row * DM + k]) * bfr(wu[(size_t)k * DFF2 + c]);
      chk_flag(F, 2, chk_bad(bf2f(U[(size_t)row * DFF2 + c]), a, 1.0f), 0); }
    { const int c = (i * 23 + 1) % DFF; const int t = row & (SEQ - 1); const float* cw = F.in[24] + (size_t)l * 3 * DFF2; const float* cb = F.in[25] + (size_t)l * DFF2; float g = cb[c], v = cb[DFF + c];
      for (int j = 0; j < 3; ++j) { const int tt = t - 2 + j; if (tt < 0) continue; g += cw[j * DFF2 + c] * bf2f(U[(size_t)(row - 2 + j) * DFF2 + c]); v += cw[j * DFF2 + DFF + c] * bf2f(U[(size_t)(row - 2 + j) * DFF2 + DFF + c]); }
      chk_flag(F, 3, chk_bad(bf2f(A[(size_t)row * DFF + c]), g / (1.f + expf(-g)) * v, 0.3f), 0); }
    { const int n = (i * 29 + 7) & 1023; const float* wd = F.in[26] + (size_t)l * DFF * DM; float a = 0.f; for (int k = 0; k < DFF; ++k) a += bf2f(A[(size_t)row * DFF + k]) * bfr(wd[(size_t)k * DM + n]);
      chk_flag(F, 4, chk_bad(WSP(const float, WS_Y2)[(size_t)row * DM + n], a, 1.0f), 0); }
}

__device__ __forceinline__ void selfcheck_e(Frame& F, int l) {
    const int i = threadIdx.x; const bf16_t* H = WSP(const bf16_t, WS_H); const bf16_t* P = WSP(const bf16_t, WS_P);
    const float* W = F.in[6] + (size_t)l * DM * DIN; const int row = (int)(chk_hash(i + 5) % M);
#define DOTC(dst, cc) do { float sc_; const int src_ = inproj_src((cc), sc_); float a_ = 0.f; if (src_ >= 0) for (int k = 0; k < DM; ++k) a_ += bf2f(H[(size_t)row * DM + k]) * bfr(W[(size_t)k * DIN + src_] * sc_); dst = a_; } while (0)
    { int c = (i * 37 + 5) % PW; if ((c >= 640 && c < 768)) c = 100; float ref; DOTC(ref, c); chk_flag(F, 0, chk_bad(bf2f(P[(size_t)row * PW + c]), ref, 1.0f), 0); }
    { const int c = 672 + (i & 31), p = c - 672, ip = p >> 1; float ref, oth; DOTC(ref, c); DOTC(oth, c ^ 1); const float x1 = (p & 1) ? oth : ref, x2 = (p & 1) ? ref : oth;
      const float inv = powf(10000.0f, -(float)(2 * ip) / 32.0f), ang = (float)(row & (SEQ - 1)) * inv, cs = cosf(ang), sn = sinf(ang); const float r = (p & 1) ? (x2 * cs + x1 * sn) : (x1 * cs - x2 * sn);
      chk_flag(F, 1, chk_bad(bf2f(WSP(const bf16_t, WS_KROT)[(size_t)row * 32 + p]), r, 1.0f), 0); }
    { const int c = 640 + (i & 15); float ref; DOTC(ref, c); chk_flag(F, 2, chk_bad(WSP(const float, WS_SIDE)[(size_t)row * 16 + (c - 640)], ref, 1.0f), 0); }
    { const int c = 256 + (i & 127); float ref; DOTC(ref, c); const float got = (c < 320) ? bf2f(WSP(const bf16_t, WS_KCMP)[(size_t)row * 64 + (c - 256)]) : bf2f(WSP(const bf16_t, WS_VCMP)[(size_t)row * 64 + (c - 320)]); chk_flag(F, 3, chk_bad(got, ref, 1.0f), 0); }
    float sq = 0.f, skv = 0.f; for (int k = 0; k < 256; ++k) { const float v = bf2f(P[(size_t)row * PW + PC_DQL + k]); sq += v * v; } for (int k = 0; k < 128; ++k) { const float v = bf2f(P[(size_t)row * PW + PC_DKV + k]); skv += v * v; }
    { const float* a = WSP(const float, WS_SSQQ) + (size_t)row * 4; const float* b = WSP(const float, WS_SSQKV) + (size_t)row * 4; chk_flag(F, 4, chk_bad(a[0] + a[1] + a[2] + a[3], sq, 10.f) || chk_bad(b[0] + b[1] + b[2] + b[3], skv, 5.f), 0); }
    const float rq = 1.0f / sqrtf(sq / 256.0f + RMS_EPS), rkv = 1.0f / sqrtf(skv / 128.0f + RMS_EPS);
    const float* wq = F.in[15] + (size_t)l * 256 * 384; const float* gq = F.in[13] + l * 256; const float* wkv = F.in[16] + (size_t)l * 128 * 512; const float* gkv = F.in[14] + l * 128;
#define QDOT(dst, src) do { float a_ = 0.f; for (int k = 0; k < 256; ++k) a_ += bf2f(P[(size_t)row * PW + PC_DQL + k]) * bfr(wq[(size_t)k * 384 + (src)] * C2D * gq[k]); dst = a_ * rq; } while (0)
    { const int hd = i & 3, w = (i >> 2) & 63; float ref; QDOT(ref, hd * 96 + w); chk_flag(F, 5, chk_bad(bf2f(WSP(const bf16_t, WS_QM)[(size_t)row * 512 + hd * 96 + w]), ref, 1.5f), 0); }
    { const int hd = i & 3, p = (i >> 2) & 31, ip = p >> 1; float x1, x2; QDOT(x1, hd * 96 + 64 + ip); QDOT(x2, hd * 96 + 64 + 16 + ip); const float inv = powf(10000.0f, -(float)(2 * ip) / 32.0f), ang = (float)(row & (SEQ - 1)) * inv, cs = cosf(ang), sn = sinf(ang);
      const float r = (p & 1) ? (x2 * cs + x1 * sn) : (x1 * cs - x2 * sn); chk_flag(F, 6, chk_bad(bf2f(WSP(const bf16_t, WS_QM)[(size_t)row * 512 + hd * 96 + 64 + p]), r, 1.5f), 0); }
    { const int c = (i * 13) & 511; float a = 0.f; for (int k = 0; k < 128; ++k) a += bf2f(P[(size_t)row * PW + PC_DKV + k]) * bfr(wkv[(size_t)k * 512 + c] * gkv[k]); chk_flag(F, 7, chk_bad(bf2f(WSP(const bf16_t, WS_KVM)[(size_t)row * 512 + c]), a * rkv, 1.0f), 0); }
    { const int b = i & 15, which = (i >> 4) & 1, c = (int)(chk_hash(i + 31) % 255), n = (i * 5) & 127; const bf16_t* src = (which ? WSP(const bf16_t, WS_VCMP) : WSP(const bf16_t, WS_KCMP)) + ((size_t)b * SEQ + 16 * c) * 64;
      const float *pk1 = F.in[8], *pv1 = F.in[10], *pk2 = F.in[9], *pv2 = F.in[11]; asm volatile("" : "+s"(pk1), "+s"(pv1), "+s"(pk2), "+s"(pv2));
      const float* w1 = (which ? pv1 : pk1) + (size_t)l * 2048 * 128; const float* w2 = (which ? pv2 : pk2) + (size_t)l * 128 * 64; const float* cp = F.in[7] + (size_t)l * 2048;
      float a = 0.f, bsum = 0.f; for (int p = 0; p < 2048; ++p) { a += bf2f(src[p]) * bfr(w1[(size_t)p * 128 + n]); bsum += cp[p] * w1[(size_t)p * 128 + n]; }
      const float xx = a + bsum, g = 0.5f * xx * (1.0f + tanhf(0.7978845608028654f * (xx + 0.044715f * xx * xx * xx)));
      const bf16_t* hid = WSP(const bf16_t, WS_HID) + (size_t)(which * 4096 + b * 256 + c) * 256 + which * 128;
      chk_flag(F, 8, chk_bad(bf2f(hid[n]), g, 0.5f), 0);
      const int d = (i * 5) & 63; float o2 = 0.f; for (int nn = 0; nn < 128; ++nn) o2 += bf2f(hid[nn]) * w2[nn * 64 + d];
      chk_flag(F, 9, chk_bad(bf2f((which ? WSP(const bf16_t, WS_VC) : WSP(const bf16_t, WS_KC))[((size_t)b * 256 + c) * 64 + d]), o2, 0.5f), 0); }
#undef DOTC
#undef QDOT
}

constexpr int CW_CNT = 20544;
__device__ __forceinline__ void selfcheck_g(Frame& F, int l) {
    const int gi = blockIdx.x * 512 + threadIdx.x; const bf16_t* H = WSP(const bf16_t, WS_H); const bf16_t* P = WSP(const bf16_t, WS_P); const float* W = F.in[6] + (size_t)l * DM * DIN;
    const int row = gi & (M - 1); unsigned nbad = 0u;
    for (int k4 = 0; k4 < 4; ++k4) { int c = (int)(chk_hash(gi * 4 + k4 + 12345u) % PW); if (c >= 640 && c < 768) c -= 200;
        float sc_; const int src_ = inproj_src(c, sc_); float a_ = 0.f; for (int k = 0; k < DM; ++k) a_ += bf2f(H[(size_t)row * DM + k]) * bfr(W[(size_t)k * DIN + src_] * sc_);
        if (chk_bad(bf2f(P[(size_t)row * PW + c]), a_, 1.0f)) ++nbad; }
    if (nbad) atomicAdd((unsigned*)(F.ctl + CW_CNT), nbad);
}
__device__ __forceinline__ void selfcheck_g_fin(Frame& F) {
    if (blockIdx.x == 0 && threadIdx.x == 0) { const unsigned cnt = __hip_atomic_load(F.ctl + CW_CNT, __ATOMIC_RELAXED, __HIP_MEMORY_SCOPE_AGENT); unsigned lg = 0; while ((1u << lg) <= cnt && lg < 15) ++lg;
        atomicOr((unsigned*)(F.ctl + CW_CHK), (cnt > 63u ? 63u : cnt) | (lg << 6)); }
}

__device__ __forceinline__ void selfcheck_f(Frame& F, int l) {
    const int i = threadIdx.x; const unsigned hsh = chk_hash(i + 4242u);
    chk_flag(F, 0, chk_fox(F, i & 15, (i >> 4) & 3, (i >> 6) * 8 + (hsh & 7)), 0);
    chk_flag(F, 1, chk_fox(F, i & 15, (i >> 4) & 3, 64 + (int)(hsh % 192u)), 0);
    chk_flag(F, 2, chk_fox(F, i & 15, (i >> 4) & 3, 256 + (int)(hsh % 3840u)), 0);
    chk_flag(F, 3, chk_dil(F, i & 15, (i >> 4) & 1, (int)(hsh & 127u)), 0);
    chk_flag(F, 4, chk_dil(F, i & 15, (i >> 4) & 1, 128 + (int)(hsh % 3968u)), 0);
    { bool bad = false; if (i < 128) bad = chk_nsa(F, i & 15, (i >> 4) & 3, (int)(hsh % 31u), i); chk_flag(F, 5, bad, 0); }
    { bool bad = false; if (i < 128) bad = chk_nsa(F, i & 15, (i >> 4) & 3, 31 + (int)(hsh % 33u), i); chk_flag(F, 6, bad, 0); }
    { bool bad = false; if (i < 128) bad = chk_nsa(F, i & 15, (i >> 4) & 3, 64 + (int)(hsh % 960u), i); chk_flag(F, 7, bad, 0); }
    { bool bad = false; if (i < 128) bad = chk_nsa(F, i & 15, (i >> 4) & 3, 1024 + (int)(hsh % 3072u), i); chk_flag(F, 8, bad, 4); }
}
__device__ __forceinline__ void selfcheck_report(Frame& F) {
    const unsigned mask = __hip_atomic_load(F.ctl + CW_CHK, __ATOMIC_RELAXED, __HIP_MEMORY_SCOPE_AGENT);
    float V = (float)(10u + (mask & 63u)); const unsigned e = 2u + ((mask >> 6) & 15u); for (unsigned k = 0; k < e; ++k) V *= 10.0f;
    for (size_t idx = (size_t)blockIdx.x * 512 + threadIdx.x; idx < (size_t)M * DM; idx += (size_t)F.G * 512) F.out[idx] = V;
}
#endif
struct SchedSimple {
    pg8::TileOrder T; const char* A; const char* B; int lda, ldb, nt; int dup = 0;
    __device__ __forceinline__ bool next(int i, GUnit& u) const { int pm, pn; if (!T.tile(i >> dup, pm, pn)) return false;
        u.A = A + (size_t)pm * 256 * lda; u.B = B + (size_t)pn * 256 * ldb; u.lda = lda; u.ldb = ldb; u.nt = nt; u.pm = pm; u.pn = pn; u.id = 0; return true; }
};
struct SchedCmp1 {
    int c; const char* kc; const char* vc; const char* B;
    __device__ __forceinline__ bool next(int i, GUnit& u) const { if (i > 0 || c >= 32) return false;
        u.A = (c < 16 ? kc : vc) + (size_t)(c & 15) * 256 * 2048; u.B = B; u.lda = 2048; u.ldb = 4096; u.nt = 32; u.pm = c; u.pn = 0; u.id = 0; return true; }
};
struct SchedMerge {
    pg8::TileOrder T; const char* ocat; const char* h; const char* wbr; const char* wg; int dup = 0;
    __device__ __forceinline__ bool next(int i0, GUnit& u) const { const int i = i0 >> dup; int pm, pn; if (!T.tile(i >> 3, pm, pn)) return false;
        const int sub = i & 7; u.pm = pm; u.pn = pn; u.id = sub;
        if (sub >= 4) { u.A = h + (size_t)pm * 256 * 1024; u.lda = 1024; u.B = wg + (size_t)((pn * 4 + (sub - 4)) * 256) * 1024; u.ldb = 1024; u.nt = 8; }
        else { const int br = sub; const int kk = (br == 1) ? 128 : 256; const size_t co = (br == 0) ? 0 : (br == 1 ? 256 : (br == 2 ? 384 : 640)), wo = (br == 0) ? BR_A : (br == 1 ? BR_B : (br == 2 ? BR_C : BR_D));
            u.A = ocat + (size_t)pm * 256 * (OCW * 2) + co * 2; u.lda = OCW * 2; u.B = wbr + wo + (size_t)pn * 256 * kk * 2; u.ldb = kk * 2; u.nt = kk / 64; }
        return true; }
};

#ifndef SDUP_INPROJ
#define SDUP_INPROJ 0
#endif
#ifndef SDUP_MERGE
#define SDUP_MERGE 0
#endif
#ifndef SDUP_WO
#define SDUP_WO 0
#endif
#ifndef SDUP_UP
#define SDUP_UP 0
#endif
#ifndef SDUP_DN
#define SDUP_DN 0
#endif
#ifndef DUP_ATTN
#define DUP_ATTN 1
#endif
#ifndef DUP_GEMM
#define DUP_GEMM 1
#endif
#ifndef DUP_MERGE
#define DUP_MERGE 1
#endif
#ifndef DUP_FFN
#define DUP_FFN 1
#endif
#ifdef ONLY_PHASE
#define PH(k) ((k) == ONLY_PHASE)
#else
#define PH(k) true
#endif
struct Args { const float* in[27]; float* out; unsigned char* ws; };
__global__ void __launch_bounds__(512, 2) hybrid_fwd(Args args) {
    extern __shared__ __attribute__((aligned(16))) unsigned char lds_raw[];
    Frame F;
    F.lds = (LAS unsigned char*)lds_raw; F.MISC = (volatile LAS unsigned*)(F.lds + MISC_OFF);
    F.tid = threadIdx.x; F.lane = F.tid & 63; F.wave = __builtin_amdgcn_readfirstlane(F.tid >> 6); F.G = gridDim.x;
#pragma unroll
    for (int i = 0; i < 27; ++i) F.in[i] = args.in[i];
    F.out = args.out; F.ws = args.ws; F.ctl = (gu32*)(args.ws + WS_CTL);
    for (int u = F.tid; u < (LDS_BYTES - LDSCTL_OFF) / 4; u += 512) ((LAS unsigned*)(F.lds + LDSCTL_OFF))[u] = 0u;
    __syncthreads();
    XcdBarrier bar = xcd_barrier_post((unsigned*)(F.ctl + CW_BAR), F.MISC + 8);
    const int c = (int)blockIdx.x;
#if defined(TIMEPROBE)
    if (threadIdx.x == 0) *(volatile LAS unsigned long long*)(F.lds + MISC_OFF + 64) = __builtin_amdgcn_s_memrealtime();
#define TSTAMP(id) do { if (blockIdx.x == 0 && threadIdx.x == 0) { volatile LAS unsigned long long* tp_ = (volatile LAS unsigned long long*)(F.lds + MISC_OFF + 64); const unsigned long long now_ = __builtin_amdgcn_s_memrealtime(); unsigned long long* a_ = (unsigned long long*)(F.ws + 90000) + (id); *a_ = *a_ + (now_ - *tp_); *tp_ = now_; } } while (0)
#else
#define TSTAMP(id) do { } while (0)
#endif

#ifndef DUP_P0
#define DUP_P0 1
#endif
    for (int rep = 0; rep < DUP_P0; ++rep) { if (rep) xcd_barrier(bar); if (PH(0)) p0_prologue(F); }
    xcd_barrier(bar); TSTAMP(0);

#ifndef XTRA_BAR
#define XTRA_BAR 0
#endif
    _Pragma("unroll") for (int xb = 0; xb < XTRA_BAR; ++xb) xcd_barrier(bar);
#define PHASE_FRESH() do { int t_ = threadIdx.x; asm volatile("" : "+v"(t_)); F.tid = t_; F.lane = t_ & 63; } while (0)
    for (int l = 0; l < DEPTH; ++l) {
        unsigned char* wl = F.ws + WS_WT + (size_t)l * LW;
        const float* xin = (l == 0) ? F.in[0] : F.out;
        PHASE_FRESH();
#ifndef DUP_RP0
#define DUP_RP0 1
#endif
        if (l == 0) { if (c == 0) cmpb_reduce(F);
          _Pragma("unroll") for (int rep = 0; rep < DUP_RP0; ++rep) { if (rep) xcd_barrier(bar); if (PH(1)) rowpass<0, false, false, true>(F, F.in[0], nullptr, 0, nullptr, WSP(bf16_t, WS_H), F.in[2] + l * DM, nullptr, 0, M, (unsigned char*)F.out + H8_OFF); }
          xcd_barrier(bar); TSTAMP(1); }
        for (int rep = 0; rep < DUP_GEMM; ++rep) if (PH(2)) { if (rep) xcd_barrier(bar); SchedSimple S; S.T.init(256, 12, F.G, c); S.A = (const char*)(F.ws + WS_H); S.B = (const char*)(wl + LW_IN); S.lda = 2048; S.ldb = 2048; S.nt = 16; S.dup = SDUP_INPROJ;
          pg8::EpiInProj E{WSP(bf16_t, WS_P), WSP(bf16_t, WS_KCMP), WSP(bf16_t, WS_VCMP), WSP(float, WS_SIDE), WSP(bf16_t, WS_KROT), WSP(const float, WS_ROPE), WSP(float, WS_SSQQ), WSP(float, WS_SSQKV), F.in[12] + l * 4, WSP(float, WS_LF)};
          pg8::gemm_phase<pg8::EpiInProj, SchedSimple, true>(F.lds, S, E); }
        xcd_barrier(bar); TSTAMP(2);
#ifndef DUP_L2A
#define DUP_L2A 1
#endif
        _Pragma("unroll") for (int rep2 = 0; rep2 < DUP_L2A; ++rep2) { if (rep2) xcd_barrier(bar);
        if (PH(3)) { SchedCmp1 S{c, (const char*)(F.ws + WS_KCMP), (const char*)(F.ws + WS_VCMP), (const char*)(wl + LW_PHI)};
          pg8::EpiCmp1 E{WSP(bf16_t, WS_HID), WSP(const float, WS_CMPB) + l * 256};
          pg8::gemm_phase<pg8::EpiCmp1, SchedCmp1, false>(F.lds, S, E);
          if (c < 32) {
              __syncthreads(); const int which = c >> 4, b = c & 15;
              int ln_ = threadIdx.x & 63; asm volatile("" : "+v"(ln_)); const int r32 = ln_ & 31, hi = ln_ >> 5;
              const bf16_t* hrow = WSP(const bf16_t, WS_HID) + ((size_t)c * 256 + F.wave * 32 + r32) * 256 + which * 128;
              const float *pk2 = F.in[9], *pv2 = F.in[11]; asm volatile("" : "+s"(pk2), "+s"(pv2)); const float* w2 = (which ? pv2 : pk2) + (size_t)l * 128 * 64;
              f32x16 o0, o1;
#pragma unroll
              for (int r = 0; r < 16; ++r) { o0[r] = 0.f; o1[r] = 0.f; }
#pragma unroll
              for (int ks = 0; ks < 8; ++ks) { const bf16x8 a = *(const bf16x8*)(hrow + ks * 16 + hi * 8);
                  const float* wp = w2 + (size_t)(ks * 16 + hi * 8) * 64 + r32; u32x4 b0, b1;
#pragma unroll
                  for (int jj = 0; jj < 4; ++jj) { b0[jj] = cvtpk(wp[(2 * jj) * 64], wp[(2 * jj + 1) * 64]); b1[jj] = cvtpk(wp[(2 * jj) * 64 + 32], wp[(2 * jj + 1) * 64 + 32]); }
                  o0 = MFMA32(a, __builtin_bit_cast(bf16x8, b0), o0); o1 = MFMA32(a, __builtin_bit_cast(bf16x8, b1), o1); }
              bf16_t* dst = (which ? WSP(bf16_t, WS_VC) : WSP(bf16_t, WS_KC)) + ((size_t)b * 256 + F.wave * 32) * 64 + r32;
#pragma unroll
              for (int r = 0; r < 16; ++r) { const int rw = crow(r, hi); dst[(size_t)rw * 64] = (bf16_t)f2bf(o0[r]); dst[(size_t)rw * 64 + 32] = (bf16_t)f2bf(o1[r]); } } }
        if (PH(4)) { int G2_ = F.G; asm volatile("" : "+s"(G2_)); const bool split = G2_ > 64; const int g2 = split ? F.G - 32 : F.G, c2 = split ? c - 32 : c;
          { SchedSimple S; S.T.init(256, 2, g2, c2 < 0 ? (1 << 28) : c2); S.A = (const char*)(F.ws + WS_P) + PC_DQL * 2; S.B = (const char*)(wl + LW_UQ); S.lda = PW * 2; S.ldb = 512; S.nt = 4;
            pg8::EpiQup E{WSP(bf16_t, WS_QM), WSP(const float, WS_SSQQ), WSP(const float, WS_ROPE)};
            pg8::gemm_phase<pg8::EpiQup, SchedSimple, true>(F.lds, S, E); }
          { SchedSimple S; S.T.init(256, 2, g2, c2 < 0 ? (1 << 28) : c2); S.A = (const char*)(F.ws + WS_P) + PC_DKV * 2; S.B = (const char*)(wl + LW_UKV); S.lda = PW * 2; S.ldb = 256; S.nt = 2;
            pg8::EpiKVup E{WSP(bf16_t, WS_KVM), WSP(const float, WS_SSQKV), (unsigned*)(F.ctl + CW_KMLA + 256 * l)};
            pg8::gemm_phase<pg8::EpiKVup, SchedSimple, true>(F.lds, S, E); } }
        PHASE_FRESH();
        if (PH(5)) {
          int G_ = F.G; asm volatile("" : "+s"(G_)); const int cb = (G_ >= 48) ? c - 32 : c;
          if (cb >= 0 && cb < BATCH) { const int b = cb, tid = F.tid; const float* lf = WSP(const float, WS_LF) + ((size_t)b * SEQ + 8 * tid) * 4;
              f32x4 v[8];
#pragma unroll
              for (int i = 0; i < 8; ++i) v[i] = *(const f32x4*)(lf + 4 * i);
#pragma unroll
              for (int i = 1; i < 8; ++i) v[i] = v[i] + v[i - 1];
              LAS f32x4* sc = (LAS f32x4*)F.lds; f32x4 run = v[7];
              sc[tid] = run; __syncthreads();
              for (int off = 1, cur = 0; off < 512; off <<= 1, cur ^= 1) { f32x4 t = sc[cur * 512 + tid]; if (tid >= off) t = t + sc[cur * 512 + tid - off]; sc[(cur ^ 1) * 512 + tid] = t; __syncthreads(); run = t; }
              const f32x4 ex = run - v[7];
              float* kb = WSP(float, WS_KB) + (size_t)b * 4 * SEQ + 8 * tid;
#pragma unroll
              for (int e = 0; e < 4; ++e) { f32x4 lo, hi4;
#pragma unroll
                  for (int i = 0; i < 4; ++i) { lo[i] = -(ex[e] + v[i][e]) * LOG2E; hi4[i] = -(ex[e] + v[4 + i][e]) * LOG2E; }
                  *(f32x4*)(kb + (size_t)e * SEQ) = lo; *(f32x4*)(kb + (size_t)e * SEQ + 4) = hi4; }
              __syncthreads();
          } }
        }
        if (PH(5)) {
          const int gt2 = c * 512 + F.tid, hp = gt2 & 1;
          for (int t2 = gt2 >> 1; t2 < M; t2 += F.G * 256) { const bf16_t* Kp = WSP(const bf16_t, WS_P) + (size_t)t2 * PW + PC_CK + hp * 128; float s0 = 0.f, s1 = 0.f, s2 = 0.f;
              if (hp == 0) { const bf16_t* Rp = WSP(const bf16_t, WS_KROT) + (size_t)t2 * 32;
#pragma unroll
                  for (int q8 = 0; q8 < 4; ++q8) { const bf16x8 ra = *(const bf16x8*)(Rp + q8 * 8);
#pragma unroll
                      for (int e = 0; e < 8; ++e) { const float xa = bf2f((unsigned short)ra[e]); s2 += xa * xa; } } }
#pragma unroll
              for (int q8 = 0; q8 < 8; ++q8) { const bf16x8 ka = *(const bf16x8*)(Kp + q8 * 8), kb2 = *(const bf16x8*)(Kp + 64 + q8 * 8);
#pragma unroll
                  for (int e = 0; e < 8; ++e) { const float xa = bf2f((unsigned short)ka[e]), xb = bf2f((unsigned short)kb2[e]); s0 += xa * xa; s1 += xb * xb; } }
              s0 = fmaxf(s0, xor_lane_lt32<2>(s0)); s0 = fmaxf(s0, xor_lane_lt32<4>(s0)); s0 = fmaxf(s0, xor_lane_lt32<8>(s0)); s0 = fmaxf(s0, xor_lane_lt32<16>(s0));
              s1 = fmaxf(s1, xor_lane_lt32<2>(s1)); s1 = fmaxf(s1, xor_lane_lt32<4>(s1)); s1 = fmaxf(s1, xor_lane_lt32<8>(s1)); s1 = fmaxf(s1, xor_lane_lt32<16>(s1));
              { auto r0 = __builtin_amdgcn_permlane32_swap(__float_as_uint(s0), __float_as_uint(s0), false, false); s0 = fmaxf(__uint_as_float(r0[0]), __uint_as_float(r0[1]));
                auto r1 = __builtin_amdgcn_permlane32_swap(__float_as_uint(s1), __float_as_uint(s1), false, false); s1 = fmaxf(__uint_as_float(r1[0]), __uint_as_float(r1[1])); }
              s2 = fmaxf(s2, xor_lane_lt32<2>(s2)); s2 = fmaxf(s2, xor_lane_lt32<4>(s2)); s2 = fmaxf(s2, xor_lane_lt32<8>(s2)); s2 = fmaxf(s2, xor_lane_lt32<16>(s2));
              { auto r2 = __builtin_amdgcn_permlane32_swap(__float_as_uint(s2), __float_as_uint(s2), false, false); s2 = fmaxf(__uint_as_float(r2[0]), __uint_as_float(r2[1])); }
              if (F.lane < 2) { unsigned* kw = (unsigned*)(F.ctl + CW_KMAX + 64 * l) + (t2 >> 12) * 4 + 2 * hp; atomicMax(kw, __float_as_uint(s0)); atomicMax(kw + 1, __float_as_uint(s1));
                  if (hp == 0) atomicMax((unsigned*)(F.ctl + CW_KROT + 16 * l) + (t2 >> 12), __float_as_uint(s2)); } } }
        xcd_barrier(bar); TSTAMP(3);
        PHASE_FRESH();
        for (int rep = 0; rep < DUP_ATTN; ++rep) { gu32* ctr = F.ctl + CW_Q + 64 * l + 16 * rep;
          if (rep) xcd_barrier(bar);
          unsigned nxtq = 0u; if (F.tid == 0) nxtq = __hip_atomic_fetch_add(ctr, 1u, __ATOMIC_RELAXED, __HIP_MEMORY_SCOPE_AGENT);
          for (;;) { if (F.tid == 0) F.MISC[0] = nxtq; __syncthreads(); const int iq = (int)F.MISC[0]; __syncthreads(); if (iq >= ATT_UNITS) break;
              if (F.tid == 0) nxtq = __hip_atomic_fetch_add(ctr, 1u, __ATOMIC_RELAXED, __HIP_MEMORY_SCOPE_AGENT);
              const int it = __builtin_amdgcn_readfirstlane(WSP(const int, WS_ORDER)[iq]);
              if (it < 2048 && PH(7)) { const int qb = 15 - (it >> 7), mla = (it >> 6) & 1, bh = it & 63; if (mla) { const gu32* km = F.ctl + CW_KMLA + 256 * l + bh * 4; const float k2 = __uint_as_float(__hip_atomic_load(km, __ATOMIC_RELAXED, __HIP_MEMORY_SCOPE_AGENT)) + __uint_as_float(__hip_atomic_load(km + 1, __ATOMIC_RELAXED, __HIP_MEMORY_SCOPE_AGENT)) + __uint_as_float(__hip_atomic_load(F.ctl + CW_KROT + 16 * l + (bh >> 2), __ATOMIC_RELAXED, __HIP_MEMORY_SCOPE_AGENT)); causal_unit<false>(F, bh >> 2, bh & 3, qb, sqrtf(k2) * 1.01f); } else causal_unit<true>(F, bh >> 2, bh & 3, qb, sqrtf(__uint_as_float(__hip_atomic_load(F.ctl + CW_KMAX + 64 * l + bh, __ATOMIC_RELAXED, __HIP_MEMORY_SCOPE_AGENT)))); }
              else if (it < 3072 && PH(8)) { const int r = it - 2048; nsa_unit(F, r & 15, 63 - (r >> 4)); }
              else if (it < 3328 && PH(9)) { const int r = it - 3072; dil_unit(F, r & 15, (r >> 4) & 1, r >> 5); } } }
        xcd_barrier(bar); TSTAMP(5);
#if defined(SELFCHECK) && SELFCHECK == 1
        if (c == 0) selfcheck_a(F, l);
#endif
#if defined(SELFCHECK) && SELFCHECK == 3
        if (c == 0) selfcheck_e(F, l);
        xcd_barrier(bar); selfcheck_report(F); return;
#endif
#if defined(SELFCHECK) && SELFCHECK == 5
        selfcheck_g(F, l); xcd_barrier(bar); selfcheck_g_fin(F);
        xcd_barrier(bar); selfcheck_report(F); return;
#endif
#if defined(SELFCHECK) && SELFCHECK == 4
        if (c == 0) selfcheck_f(F, l);
        xcd_barrier(bar); selfcheck_report(F); return;
#endif
        for (int rep = 0; rep < DUP_MERGE; ++rep) if (PH(10)) { if (rep) xcd_barrier(bar); SchedMerge S; S.T.init(256, 4, F.G, c); S.ocat = (const char*)(F.ws + WS_OCAT); S.h = (const char*)F.out + H8_OFF; S.wbr = (const char*)(wl + LW_BR); S.wg = (const char*)(wl + LW_G); S.dup = SDUP_MERGE;
          unsigned char* scr = F.ws + WS_MSCR + (size_t)c * MSCR_PER_WG;
          pg8::EpiMerge E{WSP(bf16_t, WS_MERGED), scr};
          pg8::gemm_phase<pg8::EpiMerge, SchedMerge, true, true>(F.lds, S, E); }
        xcd_barrier(bar); TSTAMP(6);
#if defined(SELFCHECK) && SELFCHECK == 1
        if (c == 0) selfcheck_b(F, l);
        xcd_barrier(bar); selfcheck_report(F); return;
#endif
        if (PH(11)) { SchedSimple S; S.T.init(256, 4, F.G, c); S.A = (const char*)(F.ws + WS_MERGED); S.B = (const char*)(wl + LW_O); S.lda = 2048; S.ldb = 2048; S.nt = 16; S.dup = SDUP_WO;
          pg8::EpiBf16 E{WSP(bf16_t, WS_Y), DM};
          pg8::gemm_phase<pg8::EpiBf16, SchedSimple, true>(F.lds, S, E); }
        xcd_barrier(bar); TSTAMP(7);
        PHASE_FRESH();
        if (PH(12)) { if (l == 0) rowpass<1, false, true>(F, F.in[0], WSP(const bf16_t, WS_Y), 0, F.out, WSP(bf16_t, WS_H2), F.in[3] + l * DM, F.in[4] + l * DM, 0, M);
                      else rowpass<1, true, true>(F, F.out, WSP(const bf16_t, WS_Y), 0, WSP(bf16_t, WS_X3), WSP(bf16_t, WS_H2), F.in[3] + l * DM, F.in[4] + l * DM, 0, M); }
        xcd_barrier(bar); TSTAMP(8);
#ifndef DUP_UP
#define DUP_UP 1
#endif
        _Pragma("unroll") for (int rep = 0; rep < DUP_UP; ++rep) if (PH(13)) { if (rep) xcd_barrier(bar); SchedSimple S; S.T.init(256, 22, F.G, c); S.A = (const char*)(F.ws + WS_H2); S.B = (const char*)(wl + LW_UP); S.lda = 2048; S.ldb = 2048; S.nt = 16; S.dup = SDUP_UP;
          pg8::EpiUpConv E{WSP(bf16_t, WS_ACT), WSP(float, WS_HB), F.in[24] + (size_t)l * 3 * DFF2, F.in[25] + (size_t)l * DFF2};
          pg8::gemm_phase<pg8::EpiUpConv, SchedSimple, true>(F.lds, S, E); }
        xcd_barrier(bar); TSTAMP(9);
        PHASE_FRESH();
        if (PH(15)) { SchedSimple S; S.T.init(256, 4, F.G, c); S.A = (const char*)(F.ws + WS_ACT); S.B = (const char*)(wl + LW_DN); S.lda = DFF * 2; S.ldb = DFF * 2; S.nt = DFF / 64; S.dup = SDUP_DN;
          { int pm, pn; for (int i = 0; S.T.tile(i, pm, pn); ++i) ffn_fix_panel(F, pm, WSP(const float, WS_HB), WSP(bf16_t, WS_ACT), F.in[24] + (size_t)l * 3 * DFF2, F.in[25] + (size_t)l * DFF2); }
          VM_WAIT(); __syncthreads();
          pg8::EpiBf16 E{WSP(bf16_t, WS_Y2), DM};
          pg8::gemm_phase<pg8::EpiBf16, SchedSimple, true>(F.lds, S, E); }
        xcd_barrier(bar); TSTAMP(11);
        PHASE_FRESH();
        if (PH(16)) { if (l + 1 < DEPTH) rowpass<1, true, true, true>(F, F.out, WSP(const bf16_t, WS_Y2), 0, F.out, WSP(bf16_t, WS_H), F.in[5] + l * DM, F.in[2] + (l + 1) * DM, 0, M, (unsigned char*)F.out + H8_OFF);
                      else rowpass<2, true, false>(F, WSP(const bf16_t, WS_X3), WSP(const bf16_t, WS_Y2), 0, F.out, nullptr, F.in[5] + l * DM, nullptr, 0, M); }
        xcd_barrier(bar); TSTAMP(12);
    }
#if defined(TIMEPROBE)
    { xcd_barrier(bar); const unsigned long long* a_ = (const unsigned long long*)(F.ws + 90000); const float V1 = (float)a_[TIMEPROBE_A] * 0.01f, V2 = (float)a_[TIMEPROBE_B] * 0.01f * 1000.0f;
      for (size_t idx = (size_t)blockIdx.x * 512 + threadIdx.x; idx < (size_t)M * DM; idx += (size_t)F.G * 512) F.out[idx] = (idx == 12345) ? V2 : V1; }
#endif
}

extern "C" void kernel_launch(void* const* d_in, const int* in_sizes, int n_in, void* d_out, int out_size, void* d_ws, size_t ws_size, hipStream_t stream) {
    static int grid = 0;
    if (grid == 0) {
        if (n_in != 27 || in_sizes[0] != M * DM || out_size != M * DM || ws_size < WS_END) { fprintf(stderr, "kernel_launch: unexpected shapes (n_in %d, in0 %d, out %d, ws %zu)\n", n_in, n_in > 0 ? in_sizes[0] : -1, out_size, ws_size); grid = -1; return; }
        int dev = 0, cus = 0, per_cu = 0;
        if (hipGetDevice(&dev) != hipSuccess || hipDeviceGetAttribute(&cus, hipDeviceAttributeMultiprocessorCount, dev) != hipSuccess) { grid = -1; return; }
        if (hipFuncSetAttribute((const void*)hybrid_fwd, hipFuncAttributeMaxDynamicSharedMemorySize, LDS_BYTES) != hipSuccess) { fprintf(stderr, "kernel_launch: hipFuncSetAttribute failed\n"); grid = -1; return; }
        if (hipOccupancyMaxActiveBlocksPerMultiprocessor(&per_cu, (const void*)hybrid_fwd, 512, LDS_BYTES) != hipSuccess || per_cu < 1) fprintf(stderr, "kernel_launch: occupancy query says %d\n", per_cu);
        (void)hipGetLastError();
        grid = cus;
    }
    if (grid < 0) return;
    if (hipMemsetAsync((char*)d_ws + WS_CTL, 0, CTL_ZERO_BYTES, stream) != hipSuccess) return;
    Args a{};
    for (int i = 0; i < 27; ++i) a.in[i] = (const float*)d_in[i];
    a.out = (float*)d_out; a.ws = (unsigned char*)d_ws;
    hipLaunchKernelGGL(hybrid_fwd, dim3(grid), dim3(512), LDS_BYTES, stream, a);
}
```

```cpp
#include <hip/hip_runtime.h>
#include <hip/hip_bf16.h>
#include <cstdio>
#include <cstdint>
#include <cmath>

#define GAS __attribute__((address_space(1)))
#define LAS __attribute__((address_space(3)))
typedef unsigned short bf16_t;
typedef short bf16x8 __attribute__((ext_vector_type(8)));
typedef short s16x4 __attribute__((ext_vector_type(4)));
typedef float f32x4 __attribute__((ext_vector_type(4)));
typedef float f32x2 __attribute__((ext_vector_type(2)));
typedef float f32x16 __attribute__((ext_vector_type(16)));
typedef unsigned u32x4 __attribute__((ext_vector_type(4)));
typedef unsigned u32x2 __attribute__((ext_vector_type(2)));
typedef GAS unsigned gu32;

constexpr int BATCH = 16, SEQ = 4096, DM = 1024, M = BATCH * SEQ, DEPTH = 2;
constexpr int DIN = 2992, PW = 3072;
constexpr int DFF = 2816, DFF2 = 5632;
constexpr float LOG2E = 1.4426950408889634f;
constexpr float C2A = 0.125f * LOG2E;
constexpr float C2D = 0.10206207261596575f * LOG2E;
constexpr float RMS_EPS = 1e-6f;
constexpr float H8_SCALE = 8.0f, WG8_SCALE = 64.0f, GATE_UNSCALE = 1.0f / (H8_SCALE * WG8_SCALE);
constexpr int PC_AQ = 0, PC_KCMP = 256, PC_VCMP = 320, PC_KSLC = 384, PC_VSLC = 448, PC_KWIN = 512, PC_VWIN = 576,
              PC_MISC = 640, PC_KROPE = 672, PC_BQ = 768, PC_BK = 1152, PC_BV = 1536, PC_DKV = 1920,
              PC_CQ = 2048, PC_CK = 2304, PC_CV = 2560, PC_DQL = 2816;
constexpr int OCW = 896;
constexpr int NSA_DFAR = 1536, NSA_DMAX = 1664, NSA_TL = 1728;

__device__ __forceinline__ unsigned f2bf(float f) { unsigned u = __float_as_uint(f); return (u + 0x7fffu + ((u >> 16) & 1u)) >> 16; }
__device__ __forceinline__ unsigned pk2(float lo, float hi) { return f2bf(lo) | (f2bf(hi) << 16); }
__device__ __forceinline__ float bf2f(unsigned short b) { return __uint_as_float((unsigned)b << 16); }
typedef __bf16 bf16x2_t __attribute__((ext_vector_type(2)));
__device__ __forceinline__ unsigned cvtpk(float lo, float hi) { f32x2 v = {lo, hi}; bf16x2_t b = __builtin_convertvector(v, bf16x2_t); return __builtin_bit_cast(unsigned, b); }
__device__ __forceinline__ unsigned pk4_fp8(float a, float b, float c, float d) { int w = 0; w = __builtin_amdgcn_cvt_pk_fp8_f32(a, b, w, false); w = __builtin_amdgcn_cvt_pk_fp8_f32(c, d, w, true); return (unsigned)w; }
__device__ __forceinline__ float fast_exp2(float x) { return __builtin_amdgcn_exp2f(x); }
__device__ __forceinline__ float fast_rcp(float x) { return __builtin_amdgcn_rcpf(x); }
template <int MASK> __device__ __forceinline__ float xor_lane_lt32(float v) { return __uint_as_float(__builtin_amdgcn_ds_swizzle((int)__float_as_uint(v), (MASK << 10) | 0x1f)); }
__device__ __forceinline__ float sum_halves(float v) { auto rr = __builtin_amdgcn_permlane32_swap(__float_as_uint(v), __float_as_uint(v), false, false); return __uint_as_float(rr[0]) + __uint_as_float(rr[1]); }
__device__ __forceinline__ float sigmoid_f(float x) { return fast_rcp(1.0f + fast_exp2(-x * LOG2E)); }

namespace pg8 {
constexpr int BM = 256, BK = 64, HALF = 128, HTB = HALF * BK * 2  , STAGE_BYTES = 8 * HTB, NXCD = 8, WGM = 8;
__host__ __device__ __forceinline__ int lds_byte(int r, int c) { const int st = (r >> 4) * 2 + (c >> 5), rr = r & 15, cc = c & 31, ob = rr * 64 + cc * 2; return st * 1024 + (ob ^ (((ob >> 9) & 1) << 5)); }
__host__ __device__ __forceinline__ void stage_rc(int b, int& R, int& C) { const int st = b / 1024, sb = b % 1024, swz = sb ^ (((sb >> 9) & 1) << 5); R = (st >> 1) * 16 + swz / 64; C = (st & 1) * 32 + (swz % 64) / 2; }
__host__ __device__ __forceinline__ int perm32(int rho) { const int n = rho >> 4, i = rho & 15; return 8 * (i >> 2) + 4 * n + (i & 3); }

typedef int v8i_t __attribute__((ext_vector_type(8)));
typedef int v4i_t __attribute__((ext_vector_type(4)));
__device__ __forceinline__ v8i_t cat8(const bf16x8 lo, const bf16x8 hi) { const v4i_t a = __builtin_bit_cast(v4i_t, lo), b = __builtin_bit_cast(v4i_t, hi); return __builtin_shufflevector(a, b, 0, 1, 2, 3, 4, 5, 6, 7); }
struct GUnit { const char* A; const char* B; int lda, ldb, nt, pm, pn, id; };

struct TileOrder {
    int nM, nN, nwg, G, c;
    __device__ __forceinline__ void init(int nM_, int nN_, int G_, int c_) { nM = nM_; nN = nN_; nwg = nM * nN; G = G_; c = c_; }
    __device__ __forceinline__ bool tile(int i, int& pm, int& pn) const {
        const long L = (long)i * G + c; if (L >= nwg) return false;
        int wgid = (int)L; { const int q = nwg / NXCD, r = nwg % NXCD, xcd = wgid % NXCD, off = wgid / NXCD; wgid = (xcd < r ? xcd * (q + 1) : r * (q + 1) + (xcd - r) * q) + off; }
        const int nig = WGM * nN, gid = wgid / nig, fm = gid * WGM, gsz = (nM - fm) < WGM ? (nM - fm) : WGM;
        pm = fm + ((wgid % nig) % gsz); pn = (wgid % nig) / gsz; return true;
    }
};

template <class Epi, class Sched, bool ALIGN_EPI, bool F8 = false>
__device__ __forceinline__ void gemm_phase(LAS unsigned char* lds, const Sched& S, const Epi& E) {
    int tid_o = threadIdx.x; asm volatile("" : "+v"(tid_o));
    const int tid = tid_o, wid = __builtin_amdgcn_readfirstlane(tid >> 6), lane = tid & 63, wr = wid >> 2, wc = wid & 3; int fr = lane & 15, fq = lane >> 4;
    int sR[2], sC[2], sRb[2];
#pragma unroll
    for (int i = 0; i < 2; ++i) { stage_rc(tid * 16 + i * 8192, sR[i], sC[i]); sRb[i] = Epi::PERM ? ((sR[i] & ~31) + perm32(sR[i] & 31)) : sR[i]; sC[i] *= 2; }
    const size_t kstep = (size_t)(BK * 2);
    const unsigned ldsw = (unsigned)wid * 1024u;
    const int aoff = lds_byte(wr * 64 + fr, fq * 8), boff = lds_byte(wc * 32 + fr, fq * 8);
#define PG8_SA(b, h) (((b) * 2 + (h)) * HTB)
#define PG8_SB(b, h) ((4 + (b) * 2 + (h)) * HTB)
#define PG8_STAGE(bufoff, gbase, rows, ld) do { _Pragma("unroll") for (int _i = 0; _i < 2; ++_i) \
        __builtin_amdgcn_global_load_lds((const unsigned*)((const char*)(gbase) + (unsigned)((rows)[_i] * (ld) + sC[_i])), (LAS unsigned*)(lds + (bufoff) + ldsw + _i * 8192), 16, 0, 0); } while (0)
#define PG8_LDA(dst, b, h) do { _Pragma("unroll") for (int m = 0; m < 4; ++m) _Pragma("unroll") for (int k = 0; k < 2; ++k) dst[m][k] = *(const LAS bf16x8*)(lds + PG8_SA(b, h) + aoff + m * 2048 + k * 1024); } while (0)
#define PG8_LDB(dst, b, h) do { _Pragma("unroll") for (int n = 0; n < 2; ++n) _Pragma("unroll") for (int k = 0; k < 2; ++k) dst[n][k] = *(const LAS bf16x8*)(lds + PG8_SB(b, h) + boff + n * 2048 + k * 1024); } while (0)
#define PG8_MMA(ai, bj, At, Bt) do { __builtin_amdgcn_s_setprio(1); _Pragma("unroll") for (int m = 0; m < 4; ++m) _Pragma("unroll") for (int n = 0; n < 2; ++n) _Pragma("unroll") for (int k = 0; k < 2; ++k) \
        acc[ai][bj][m][n] = __builtin_amdgcn_mfma_f32_16x16x32_bf16(Bt[n][k], At[m][k], acc[ai][bj][m][n], 0, 0, 0); __builtin_amdgcn_s_setprio(0); } while (0)
#define PG8_LDA8(dst, b, h) do { _Pragma("unroll") for (int m = 0; m < 4; ++m) { dst[m].lo = *(const LAS v4i_t*)(lds + PG8_SA(b, h) + aoff + m * 2048); dst[m].hi = *(const LAS v4i_t*)(lds + PG8_SA(b, h) + aoff + m * 2048 + 1024); } } while (0)
#define PG8_LDB8(dst, b, h) do { _Pragma("unroll") for (int n = 0; n < 2; ++n) { dst[n].lo = *(const LAS v4i_t*)(lds + PG8_SB(b, h) + boff + n * 2048); dst[n].hi = *(const LAS v4i_t*)(lds + PG8_SB(b, h) + boff + n * 2048 + 1024); } } while (0)
#define PG8_MMA8(ai, bj, At, Bt) do { __builtin_amdgcn_s_setprio(1); _Pragma("unroll") for (int m = 0; m < 4; ++m) _Pragma("unroll") for (int n = 0; n < 2; ++n) \
        asm volatile("v_mfma_f32_16x16x128_f8f6f4 %0, %1, %2, %0" : "+v"(acc[ai][bj][m][n]) : "v"(Bt[n]), "v"(At[m])); __builtin_amdgcn_s_setprio(0); } while (0)
#define PG8_WAIT_V(n) asm volatile("s_waitcnt vmcnt(" #n ")" ::: "memory")
#define PG8_WAIT_L(n) asm volatile("s_waitcnt lgkmcnt(" #n ")" ::: "memory")
#define PG8_BAR __builtin_amdgcn_s_barrier()
#define PG8_SCHED __builtin_amdgcn_sched_barrier(0)
#define PG8_KLOOP(MM, LDA_, LDB_, At, B0, B1) for (int t = 0; t < nt; t += 2) { \
            const bool last = (t == nt - 2); \
            const char* a1 = cA + (size_t)(t + 1) * kstep; \
            const char* a2 = last ? nA : cA + (size_t)(t + 2) * kstep; const char* b2 = last ? nB : cB + (size_t)(t + 2) * kstep; \
            const char* a3 = a2 + kstep; const char* b3 = b2 + kstep; \
            const int ldA2 = last ? ldAn : ldAc, ldB2 = last ? ldBn : ldBc; \
            const size_t hA2 = last ? hAn : hAc, hB2 = last ? hBn : hBc; \
              \
            LDB_(B0, 0, 0); LDB_(B1, 0, 1); PG8_SCHED; LDA_(At, 0, 0); PG8_STAGE(PG8_SA(1, 1), a1 + hAc, sR, ldAc); \
            PG8_WAIT_V(8); PG8_WAIT_L(0); PG8_BAR; MM(0, 0, At, B0); MM(0, 1, At, B1); PG8_BAR; PG8_SCHED; \
              \
            LDA_(At, 0, 1); PG8_STAGE(PG8_SB(0, 0), b2, sRb, ldB2); PG8_STAGE(PG8_SB(0, 1), b2 + hB2, sRb, ldB2); PG8_STAGE(PG8_SA(0, 0), a2, sR, ldA2); \
            PG8_WAIT_V(8); PG8_WAIT_L(0); PG8_BAR; MM(1, 0, At, B0); MM(1, 1, At, B1); PG8_BAR; PG8_SCHED; \
              \
            LDB_(B0, 1, 0); LDB_(B1, 1, 1); PG8_SCHED; LDA_(At, 1, 0); PG8_STAGE(PG8_SA(0, 1), a2 + hA2, sR, ldA2); \
            PG8_WAIT_V(8); PG8_WAIT_L(0); PG8_BAR; MM(0, 0, At, B0); MM(0, 1, At, B1); PG8_BAR; PG8_SCHED; \
              \
            LDA_(At, 1, 1); PG8_STAGE(PG8_SB(1, 0), b3, sRb, ldB2); PG8_STAGE(PG8_SB(1, 1), b3 + hB2, sRb, ldB2); PG8_STAGE(PG8_SA(1, 0), a3, sR, ldA2); \
            PG8_WAIT_V(8); PG8_WAIT_L(0); PG8_BAR; MM(1, 0, At, B0); MM(1, 1, At, B1); PG8_BAR; PG8_SCHED; \
        }
    GUnit cur, nxt; int ui = 0;
    if (!S.next(0, cur)) return;
    f32x4 acc[2][2][4][2];
#pragma unroll
    for (int a = 0; a < 2; ++a)
#pragma unroll
        for (int b = 0; b < 2; ++b)
#pragma unroll
            for (int m = 0; m < 4; ++m)
#pragma unroll
                for (int n = 0; n < 2; ++n) acc[a][b][m][n] = (f32x4){0.f, 0.f, 0.f, 0.f};
    bf16x8 At[4][2], B0[2][2], B1[2][2]; v8i_t At8[4], B08[2], B18[2];
    int ldAc = cur.lda, ldBc = cur.ldb; size_t hAc = (size_t)HALF * ldAc, hBc = (size_t)HALF * ldBc;
    const char* cA = cur.A; const char* cB = cur.B;
    PG8_STAGE(PG8_SB(0, 0), cB, sRb, ldBc); PG8_STAGE(PG8_SB(0, 1), cB + hBc, sRb, ldBc); PG8_STAGE(PG8_SA(0, 0), cA, sR, ldAc); PG8_STAGE(PG8_SA(0, 1), cA + hAc, sR, ldAc);
    if (wr == 1) PG8_BAR;
    PG8_WAIT_V(2); PG8_BAR;
    PG8_STAGE(PG8_SB(1, 0), cB + kstep, sRb, ldBc); PG8_STAGE(PG8_SA(1, 0), cA + kstep, sR, ldAc); PG8_STAGE(PG8_SB(1, 1), cB + hBc + kstep, sRb, ldBc);
    PG8_WAIT_V(6); PG8_BAR;
    for (;;) {
        const bool has_next = S.next(ui + 1, nxt);
        int ldAn, ldBn; const char* nA; const char* nB;
        if (has_next) { ldAn = nxt.lda; ldBn = nxt.ldb; nA = nxt.A; nB = nxt.B; } else { ldAn = ldAc; ldBn = ldBc; nA = cA; nB = cB; }
        const size_t hAn = (size_t)HALF * ldAn, hBn = (size_t)HALF * ldBn;
        int nt = cur.nt; asm volatile("" : "+s"(nt));
        bool f8u = false; if constexpr (F8) f8u = Epi::f8(cur);
        if (F8 && f8u) { PG8_KLOOP(PG8_MMA8, PG8_LDA8, PG8_LDB8, At8, B08, B18) asm volatile("s_nop 15\n\ts_nop 15" ::: "memory"); }
        else { PG8_KLOOP(PG8_MMA, PG8_LDA, PG8_LDB, At, B0, B1) }
        if constexpr (ALIGN_EPI) { if (wr == 0) PG8_BAR; }
        E(acc, cur, wr, wc, fr, fq);
        if (!has_next) break;
#pragma unroll
        for (int a = 0; a < 2; ++a)
#pragma unroll
            for (int b = 0; b < 2; ++b)
#pragma unroll
                for (int m = 0; m < 4; ++m)
#pragma unroll
                    for (int n = 0; n < 2; ++n) acc[a][b][m][n] = (f32x4){0.f, 0.f, 0.f, 0.f};
        cur = nxt; cA = nA; cB = nB; ++ui;
        ldAc = ldAn; ldBc = ldBn; hAc = hAn; hBc = hBn;
        if constexpr (ALIGN_EPI) { if (wr == 1) PG8_BAR; }
    }
    PG8_WAIT_V(0);
    if constexpr (!ALIGN_EPI) { if (wr == 0) PG8_BAR; }
    PG8_BAR;
#undef PG8_SA
#undef PG8_SB
#undef PG8_STAGE
#undef PG8_LDA
#undef PG8_LDB
#undef PG8_MMA
#undef PG8_MMA8
#undef PG8_LDA8
#undef PG8_LDB8
#undef PG8_KLOOP
#undef PG8_WAIT_V
#undef PG8_WAIT_L
#undef PG8_BAR
#undef PG8_SCHED
}
}
using pg8::GUnit;
namespace pg8 {
#define EPI_OPAQUE() asm volatile("" : "+v"(fr), "+v"(fq))
struct EpiBf16 {
    static constexpr bool PERM = true;
    bf16_t* O; int ldc;
    __device__ __forceinline__ void operator()(const f32x4 (&acc)[2][2][4][2], const GUnit& u, int wr, int wc, int fr, int fq) const {
        EPI_OPAQUE();
        const int row0 = u.pm * BM + wr * 64 + fr, col0 = u.pn * BM + wc * 32 + 8 * fq;
#pragma unroll
        for (int ai = 0; ai < 2; ++ai)
#pragma unroll
            for (int m = 0; m < 4; ++m) { bf16_t* rowp = O + (size_t)(row0 + ai * HALF + m * 16) * ldc + col0;
#pragma unroll
                for (int bj = 0; bj < 2; ++bj) { const f32x4 v0 = acc[ai][bj][m][0], v1 = acc[ai][bj][m][1];
                    u32x4 w; w.x = cvtpk(v0[0], v0[1]); w.y = cvtpk(v0[2], v0[3]); w.z = cvtpk(v1[0], v1[1]); w.w = cvtpk(v1[2], v1[3]);
                    *(u32x4*)(rowp + bj * HALF) = w; } }
    }
};
struct EpiF32 {
    static constexpr bool PERM = false;
    float* O; int ldc;
    __device__ __forceinline__ void operator()(const f32x4 (&acc)[2][2][4][2], const GUnit& u, int wr, int wc, int fr, int fq) const {
        EPI_OPAQUE();
        const int row0 = u.pm * BM + wr * 64 + fr, col0 = u.pn * BM + wc * 32 + 4 * fq;
#pragma unroll
        for (int ai = 0; ai < 2; ++ai)
#pragma unroll
            for (int m = 0; m < 4; ++m) { float* rowp = O + (size_t)(row0 + ai * HALF + m * 16) * ldc + col0;
#pragma unroll
                for (int bj = 0; bj < 2; ++bj)
#pragma unroll
                    for (int n = 0; n < 2; ++n) *(f32x4*)(rowp + bj * HALF + n * 16) = acc[ai][bj][m][n]; }
    }
};
__device__ __forceinline__ void rope8(f32x4& v0, f32x4& v1, const float* cs  ) {
    const f32x4 a = *(const f32x4*)cs, b = *(const f32x4*)(cs + 4);
    f32x4 r0, r1;
    r0[0] = v0[0] * a[0] - v0[1] * a[1]; r0[1] = v0[1] * a[0] + v0[0] * a[1];
    r0[2] = v0[2] * a[2] - v0[3] * a[3]; r0[3] = v0[3] * a[2] + v0[2] * a[3];
    r1[0] = v1[0] * b[0] - v1[1] * b[1]; r1[1] = v1[1] * b[0] + v1[0] * b[1];
    r1[2] = v1[2] * b[2] - v1[3] * b[3]; r1[3] = v1[3] * b[2] + v1[2] * b[3];
    v0 = r0; v1 = r1;
}
struct EpiInProj {
    static constexpr bool PERM = true;
    bf16_t* P; bf16_t* kcmp; bf16_t* vcmp; float* side; bf16_t* krot; const float* rope; float* ssq_q; float* ssq_kv; const float* fbias; float* lf;
    __device__ __forceinline__ void operator()(const f32x4 (&acc)[2][2][4][2], const GUnit& u, int wr, int wc, int fr, int fq) const {
        EPI_OPAQUE();
        const int row0 = u.pm * BM + wr * 64 + fr, col0 = u.pn * BM + wc * 32 + 8 * fq;
#pragma unroll
        for (int ai = 0; ai < 2; ++ai)
#pragma unroll
            for (int m = 0; m < 4; ++m) { const int row = row0 + ai * HALF + m * 16; bf16_t* rowp = P + (size_t)row * PW + col0;
                float ssq = 0.f;
#pragma unroll
                for (int bj = 0; bj < 2; ++bj) { f32x4 v0 = acc[ai][bj][m][0], v1 = acc[ai][bj][m][1];
                    if (u.pn == 2 && bj == 1) {
                        if (wc == 0 && fq < 2) { float* sp = side + (size_t)row * 16 + 8 * fq; *(f32x4*)sp = v0; *(f32x4*)(sp + 4) = v1; }
                        if (wc == 1) { rope8(v0, v1, rope + (size_t)(row & (SEQ - 1)) * 32 + 8 * fq);
                            u32x4 w; w.x = cvtpk(v0[0], v0[1]); w.y = cvtpk(v0[2], v0[3]); w.z = cvtpk(v1[0], v1[1]); w.w = cvtpk(v1[2], v1[3]);
                            *(u32x4*)(krot + (size_t)row * 32 + 8 * fq) = w; }
                    }
                    u32x4 w; w.x = cvtpk(v0[0], v0[1]); w.y = cvtpk(v0[2], v0[3]); w.z = cvtpk(v1[0], v1[1]); w.w = cvtpk(v1[2], v1[3]);
                    *(u32x4*)(rowp + bj * HALF) = w;
                    if (u.pn == 1 && bj == 0) { bf16_t* cp = (wc < 2 ? kcmp : vcmp) + (size_t)row * 64 + (wc & 1) * 32 + 8 * fq; *(u32x4*)cp = w; }
                    if (u.pn == 11 || (u.pn == 7 && bj == 1)) ssq += (v0[0] * v0[0] + v0[1] * v0[1]) + (v0[2] * v0[2] + v0[3] * v0[3]) + (v1[0] * v1[0] + v1[1] * v1[1]) + (v1[2] * v1[2] + v1[3] * v1[3]);
                }
                if (u.pn == 11 || u.pn == 7) { ssq += xor_lane_lt32<16>(ssq); ssq = sum_halves(ssq);
                    if (fq == 0) (u.pn == 11 ? ssq_q : ssq_kv)[(size_t)row * 4 + wc] = ssq; }
                asm volatile("" ::: "memory");
            }
    }
};
struct EpiQup {
    static constexpr bool PERM = true;
    bf16_t* O; const float* ssq_q; const float* rope;
    __device__ __forceinline__ void operator()(const f32x4 (&acc)[2][2][4][2], const GUnit& u, int wr, int wc, int fr, int fq) const {
        EPI_OPAQUE();
        const int row0 = u.pm * BM + wr * 64 + fr, col0 = u.pn * BM + wc * 32 + 8 * fq;
#pragma unroll
        for (int ai = 0; ai < 2; ++ai)
#pragma unroll
            for (int m = 0; m < 4; ++m) { const int row = row0 + ai * HALF + m * 16; bf16_t* rowp = O + (size_t)row * 512 + col0;
                const f32x4 pq = *(const f32x4*)(ssq_q + (size_t)row * 4);
                const float rstd = 1.0f / sqrtf(((pq[0] + pq[1]) + (pq[2] + pq[3])) * (1.0f / 256.0f) + RMS_EPS);
#pragma unroll
                for (int bj = 0; bj < 2; ++bj) { f32x4 v0 = acc[ai][bj][m][0] * rstd, v1 = acc[ai][bj][m][1] * rstd;
                    const int c8 = col0 + bj * HALF, within = c8 % 96;
                    if (c8 < 384 && within >= 64) rope8(v0, v1, rope + (size_t)(row & (SEQ - 1)) * 32 + (within - 64));
                    u32x4 w; w.x = cvtpk(v0[0], v0[1]); w.y = cvtpk(v0[2], v0[3]); w.z = cvtpk(v1[0], v1[1]); w.w = cvtpk(v1[2], v1[3]);
                    *(u32x4*)(rowp + bj * HALF) = w; }
                asm volatile("" ::: "memory"); }
    }
};
struct EpiKVup {
    static constexpr bool PERM = true;
    bf16_t* O; const float* ssq_kv; unsigned* kmx;
    __device__ __forceinline__ void operator()(const f32x4 (&acc)[2][2][4][2], const GUnit& u, int wr, int wc, int fr, int fq) const {
        EPI_OPAQUE();
        const int row0 = u.pm * BM + wr * 64 + fr, col0 = u.pn * BM + wc * 32 + 8 * fq;
        float mk0 = 0.f, mk1 = 0.f;
#pragma unroll
        for (int ai = 0; ai < 2; ++ai)
#pragma unroll
            for (int m = 0; m < 4; ++m) { const int row = row0 + ai * HALF + m * 16; bf16_t* rowp = O + (size_t)row * 512 + col0;
                const f32x4 pq = *(const f32x4*)(ssq_kv + (size_t)row * 4);
                const float rstd = 1.0f / sqrtf(((pq[0] + pq[1]) + (pq[2] + pq[3])) * (1.0f / 128.0f) + RMS_EPS);
#pragma unroll
                for (int bj = 0; bj < 2; ++bj) { const f32x4 v0 = acc[ai][bj][m][0] * rstd, v1 = acc[ai][bj][m][1] * rstd;
                    u32x4 w; w.x = cvtpk(v0[0], v0[1]); w.y = cvtpk(v0[2], v0[3]); w.z = cvtpk(v1[0], v1[1]); w.w = cvtpk(v1[2], v1[3]);
                    *(u32x4*)(rowp + bj * HALF) = w;
                    if (wc < 2) { float ss = ((v0[0] * v0[0] + v0[1] * v0[1]) + (v0[2] * v0[2] + v0[3] * v0[3])) + ((v1[0] * v1[0] + v1[1] * v1[1]) + (v1[2] * v1[2] + v1[3] * v1[3]));
                        ss += xor_lane_lt32<16>(ss); ss = sum_halves(ss); if (bj == 0) mk0 = fmaxf(mk0, ss); else mk1 = fmaxf(mk1, ss); } }
                asm volatile("" ::: "memory"); }
        if (wc < 2) {
            mk0 = fmaxf(mk0, xor_lane_lt32<1>(mk0)); mk0 = fmaxf(mk0, xor_lane_lt32<2>(mk0)); mk0 = fmaxf(mk0, xor_lane_lt32<4>(mk0)); mk0 = fmaxf(mk0, xor_lane_lt32<8>(mk0));
            mk1 = fmaxf(mk1, xor_lane_lt32<1>(mk1)); mk1 = fmaxf(mk1, xor_lane_lt32<2>(mk1)); mk1 = fmaxf(mk1, xor_lane_lt32<4>(mk1)); mk1 = fmaxf(mk1, xor_lane_lt32<8>(mk1));
            if (fr == 0 && fq == 0) { unsigned* kw = kmx + ((u.pm >> 4) * 4 + 2 * u.pn) * 4 + wc; atomicMax(kw, __float_as_uint(mk0)); atomicMax(kw + 4, __float_as_uint(mk1)); }
        }
    }
};
__device__ __forceinline__ float gelu_tanh(float x) { const float u2 = 2.0f * 0.7978845608028654f * (x + 0.044715f * x * x * x); return x * fast_rcp(1.0f + fast_exp2(-u2 * LOG2E)); }
struct EpiCmp1 {
    static constexpr bool PERM = true;
    bf16_t* O; const float* bias1;
    __device__ __forceinline__ void operator()(const f32x4 (&acc)[2][2][4][2], const GUnit& u, int wr, int wc, int fr, int fq) const {
        EPI_OPAQUE();
        const int row0 = u.pm * BM + wr * 64 + fr, col0 = wc * 32 + 8 * fq;
        f32x4 bv[2][2];
#pragma unroll
        for (int bj = 0; bj < 2; ++bj)
#pragma unroll
            for (int n = 0; n < 2; ++n) bv[bj][n] = *(const f32x4*)(bias1 + col0 + bj * HALF + 4 * n);
#pragma unroll
        for (int ai = 0; ai < 2; ++ai)
#pragma unroll
            for (int m = 0; m < 4; ++m) { bf16_t* rowp = O + (size_t)(row0 + ai * HALF + m * 16) * 256 + col0;
#pragma unroll
                for (int bj = 0; bj < 2; ++bj) { f32x4 v0 = acc[ai][bj][m][0] + bv[bj][0], v1 = acc[ai][bj][m][1] + bv[bj][1];
#pragma unroll
                    for (int e = 0; e < 4; ++e) { v0[e] = gelu_tanh(v0[e]); v1[e] = gelu_tanh(v1[e]); }
                    u32x4 w; w.x = cvtpk(v0[0], v0[1]); w.y = cvtpk(v0[2], v0[3]); w.z = cvtpk(v1[0], v1[1]); w.w = cvtpk(v1[2], v1[3]);
                    *(u32x4*)(rowp + bj * HALF) = w; } }
    }
};
typedef __amdgpu_buffer_rsrc_t rsrc_t;
struct EpiMerge {
    __device__ static __forceinline__ bool f8(const GUnit& u) { return u.id >= 4; }
    static constexpr bool PERM = true;
    bf16_t* O;
    unsigned char* scr;
    __device__ __forceinline__ void operator()(const f32x4 (&acc)[2][2][4][2], const GUnit& u, int wr, int wc, int fr, int fq) const {
        EPI_OPAQUE();
        const int tid = (wr * 4 + wc) * 64 + fq * 16 + fr;
        const int sub = u.id;
        const rsrc_t rs = __builtin_amdgcn_make_buffer_rsrc(scr, 0, 524288, 0x00020000);
        if (sub < 4) {
#pragma unroll
            for (int ai = 0; ai < 2; ++ai)
#pragma unroll
                for (int bj = 0; bj < 2; ++bj)
#pragma unroll
                    for (int m = 0; m < 4; ++m)
#pragma unroll
                        for (int n = 0; n < 2; ++n) { const int q = ((ai * 2 + bj) * 4 + m) * 2 + n; const f32x4 v = acc[ai][bj][m][n];
                            u32x2 w; w.x = cvtpk(v[0], v[1]); w.y = cvtpk(v[2], v[3]);
                            __builtin_amdgcn_raw_buffer_store_b64(w, rs, tid * 8, (sub * 32 + q) * 4096, 0); }
            return;
        }
        const int j = sub - 4;
        const int row0 = u.pm * BM + wr * 64 + fr, col0 = u.pn * BM + 64 * j + wc * 16 + 4 * fq;
#pragma unroll
        for (int ai = 0; ai < 2; ++ai) {
            u32x2 sv[4][4];
#pragma unroll
            for (int m = 0; m < 4; ++m)
#pragma unroll
                for (int g = 0; g < 4; ++g) { const int qb = (ai * 16 + m * 2);
                    sv[m][g] = (j == 0) ? __builtin_amdgcn_raw_buffer_load_b64(rs, tid * 8, (g * 32 + qb) * 4096, 0)
                             : (j == 1) ? __builtin_amdgcn_raw_buffer_load_b64(rs, tid * 8, (g * 32 + qb + 1) * 4096, 0)
                             : (j == 2) ? __builtin_amdgcn_raw_buffer_load_b64(rs, tid * 8, (g * 32 + qb + 8) * 4096, 0)
                                        : __builtin_amdgcn_raw_buffer_load_b64(rs, tid * 8, (g * 32 + qb + 9) * 4096, 0); }
#pragma unroll
            for (int m = 0; m < 4; ++m) { bf16_t* rowp = O + (size_t)(row0 + ai * HALF + m * 16) * DM + col0;
                f32x4 t = {0.f, 0.f, 0.f, 0.f};
#pragma unroll
                for (int g = 0; g < 4; ++g) { const f32x4 gt = acc[ai][g >> 1][m][g & 1]; const u32x2 s = sv[m][g];
                    t[0] += sigmoid_f(gt[0] * GATE_UNSCALE) * __uint_as_float(s.x << 16); t[1] += sigmoid_f(gt[1] * GATE_UNSCALE) * __uint_as_float(s.x & 0xffff0000u);
                    t[2] += sigmoid_f(gt[2] * GATE_UNSCALE) * __uint_as_float(s.y << 16); t[3] += sigmoid_f(gt[3] * GATE_UNSCALE) * __uint_as_float(s.y & 0xffff0000u); }
                u32x2 w; w.x = cvtpk(t[0], t[1]); w.y = cvtpk(t[2], t[3]);
                *(u32x2*)rowp = w; }
            asm volatile("" ::: "memory"); }
    }
};
__device__ __forceinline__ float dpp_ror1(float v) { return __uint_as_float((unsigned)__builtin_amdgcn_mov_dpp((int)__float_as_uint(v), 0x121, 0xf, 0xf, false)); }
__device__ __forceinline__ float dpp_ror2(float v) { return __uint_as_float((unsigned)__builtin_amdgcn_mov_dpp((int)__float_as_uint(v), 0x122, 0xf, 0xf, false)); }
struct EpiUpConv {
    static constexpr int KIND = 8;
    static constexpr bool PERM = true;
    bf16_t* ACT; float* HB; const float* cw; const float* cb;
    __device__ __forceinline__ void operator()(const f32x4 (&acc)[2][2][4][2], const GUnit& u, int wr, int wc, int fr, int fq) const {
        EPI_OPAQUE();
        const int colL = wc * 32 + 8 * fq;
        const bool l0 = (fr == 0), l01 = (fr < 2);
#pragma unroll
        for (int n = 0; n < 2; ++n) {
            const int cl = colL + 4 * n, c0 = u.pn * 128 + cl;
            const f32x4 bg = *(const f32x4*)(cb + c0), w0g = *(const f32x4*)(cw + c0), w1g = *(const f32x4*)(cw + DFF2 + c0), w2g = *(const f32x4*)(cw + 2 * DFF2 + c0);
            const f32x4 bv = *(const f32x4*)(cb + DFF + c0), w0v = *(const f32x4*)(cw + DFF + c0), w1v = *(const f32x4*)(cw + DFF2 + DFF + c0), w2v = *(const f32x4*)(cw + 2 * DFF2 + DFF + c0);
            f32x4 w1ga, w1gb, w0ga, w0gb, w1va, w1vb, w0va, w0vb;
#pragma unroll
            for (int e = 0; e < 4; ++e) { w1ga[e] = l0 ? 0.f : w1g[e]; w1gb[e] = l0 ? w1g[e] : 0.f; w0ga[e] = l01 ? 0.f : w0g[e]; w0gb[e] = l01 ? w0g[e] : 0.f;
                                          w1va[e] = l0 ? 0.f : w1v[e]; w1vb[e] = l0 ? w1v[e] : 0.f; w0va[e] = l01 ? 0.f : w0v[e]; w0vb[e] = l01 ? w0v[e] : 0.f; }
#pragma unroll
            for (int ai = 0; ai < 2; ++ai) {
                const int rowg = u.pm * BM + ai * HALF + wr * 64, g = rowg >> 6;
#pragma unroll
                for (int m = 0; m < 4; ++m) {
                    const f32x4 cg = acc[ai][0][m][n], cv = acc[ai][1][m][n];
                    f32x4 o;
#pragma unroll
                    for (int e = 0; e < 4; ++e) {
                        float gt = fmaf(w2g[e], cg[e], bg[e]), vl = fmaf(w2v[e], cv[e], bv[e]);
                        gt = fmaf(dpp_ror1(cg[e]), w1ga[e], gt); gt = fmaf(dpp_ror2(cg[e]), w0ga[e], gt);
                        vl = fmaf(dpp_ror1(cv[e]), w1va[e], vl); vl = fmaf(dpp_ror2(cv[e]), w0va[e], vl);
                        if (m > 0) { const float pg = acc[ai][0][m - 1][n][e], pv = acc[ai][1][m - 1][n][e];
                            gt = fmaf(dpp_ror1(pg), w1gb[e], gt); gt = fmaf(dpp_ror2(pg), w0gb[e], gt);
                            vl = fmaf(dpp_ror1(pv), w1vb[e], vl); vl = fmaf(dpp_ror2(pv), w0vb[e], vl); }
                        o[e] = gt * sigmoid_f(gt) * vl; }
                    const int row = rowg + m * 16 + fr;
                    if (!(m == 0 && fr < 2)) { u32x2 w; w.x = cvtpk(o[0], o[1]); w.y = cvtpk(o[2], o[3]); *(u32x2*)(ACT + (size_t)row * DFF + c0) = w; }
                    if (m == 0 && fr < 2) { float* hp = HB + ((size_t)((g * 4 + fr) * 22 + u.pn) * 256 + cl); *(f32x4*)hp = cg; *(f32x4*)(hp + 128) = cv; }
                    if (m == 3 && fr >= 14) { float* hp = HB + ((size_t)((g * 4 + fr - 12) * 22 + u.pn) * 256 + cl); *(f32x4*)hp = cg; *(f32x4*)(hp + 128) = cv; }
                }
            }
            asm volatile("" ::: "memory");
        }
    }
};
}
#define XB_TMO      128
#define XB_XCNT(j)  (256  + 64 * (j))
#define XB_XSUB(j)  (1280 + 64 * (j))
#define XB_XGEN(j)  (2304 + 64 * (j))
#define XB_TOP      3328
#define XB_TOPGEN   3392
#define XCD_BAR_WORDS 3456
#define XB_SPIN_CAP (1u << 22)
__device__ __forceinline__ unsigned xb_ld(unsigned* p)              { return __hip_atomic_load(p, __ATOMIC_RELAXED, __HIP_MEMORY_SCOPE_AGENT); }
__device__ __forceinline__ unsigned xb_add(unsigned* p, unsigned v) { return __hip_atomic_fetch_add(p, v, __ATOMIC_RELAXED, __HIP_MEMORY_SCOPE_AGENT); }
__device__ __forceinline__ unsigned xb_xcc_id() { return (unsigned)__builtin_amdgcn_s_getreg((3 << 11) | 20) & 0xFu; }
#define XB_SPIN(cond, bar) do { unsigned _sp = 0; while (cond) { __builtin_amdgcn_s_sleep(1); \
    if ((++_sp & 255u) == 0u) { if (xb_ld(&(bar)[XB_TMO])) break; if (_sp > XB_SPIN_CAP) { atomicAdd(&(bar)[XB_TMO], 1u); break; } } } } while (0)
struct XcdBarrier { unsigned* bar; unsigned x; volatile LAS unsigned* st; };
__device__ __forceinline__ XcdBarrier xcd_barrier_post(unsigned* bar, volatile LAS unsigned* st) {
    XcdBarrier b; b.bar = bar; b.x = xb_xcc_id(); b.st = st;
    if (threadIdx.x == 0) (void)xb_add(&bar[XB_XCNT(b.x)], 1u);
    return b;
}
__device__ __forceinline__ void xcd_barrier_complete(unsigned* bar, unsigned x, unsigned& nloc, unsigned& nx) {
    const unsigned G = gridDim.x * gridDim.y * gridDim.z;
    unsigned sum, cnt, mine, sp = 0u;
    for (;;) {
        sum = 0u; cnt = 0u; mine = 0u;
#pragma unroll
        for (unsigned j = 0; j < 16; ++j) { const unsigned c = xb_ld(&bar[XB_XCNT(j)]); sum += c; cnt += (c > 0u) ? 1u : 0u; mine = (j == x) ? c : mine; }
        if (sum == G) break;
        __builtin_amdgcn_s_sleep(1);
        if ((++sp & 255u) == 0u) { if (xb_ld(&bar[XB_TMO])) break; if (sp > XB_SPIN_CAP) { atomicAdd(&bar[XB_TMO], 1u); break; } }
    }
    nloc = mine > 0u ? mine : 1u; nx = cnt > 0u ? cnt : 1u;
}
__device__ __forceinline__ void xcd_barrier(const XcdBarrier& b) {
    asm volatile("s_waitcnt vmcnt(0)" ::: "memory");
    __syncthreads();
    if (threadIdx.x == 0) {
        unsigned* bar = b.bar; unsigned bx = b.x;
        asm volatile("" : "+s"(bx));
        __builtin_amdgcn_s_waitcnt(0);
        unsigned nloc = b.st[0], nx = b.st[1];
        if (nloc == 0u) { xcd_barrier_complete(bar, bx, nloc, nx); b.st[0] = nloc; b.st[1] = nx; }
        const unsigned old = xb_add(&bar[XB_XSUB(bx)], 1u);
        const unsigned gen = old / nloc;
        if (old + 1u == (gen + 1u) * nloc) {
            __builtin_amdgcn_fence(__ATOMIC_RELEASE, "agent");
            asm volatile("s_waitcnt vmcnt(0)" ::: "memory");
            const unsigned og = xb_add(&bar[XB_TOP], 1u);
            const unsigned tg = og / nx;
            if (og + 1u == (tg + 1u) * nx) xb_add(&bar[XB_TOPGEN], 1u);
            else XB_SPIN(xb_ld(&bar[XB_TOPGEN]) == tg, bar);
            __builtin_amdgcn_fence(__ATOMIC_ACQUIRE, "agent");
            xb_add(&bar[XB_XGEN(bx)], 1u);
            asm volatile("s_waitcnt vmcnt(0)" ::: "memory");
        } else {
            XB_SPIN(xb_ld(&bar[XB_XGEN(bx)]) == gen, bar);
            __builtin_amdgcn_fence(__ATOMIC_ACQUIRE, "agent");
            asm volatile("s_waitcnt vmcnt(0)" ::: "memory");
        }
    }
    __syncthreads();
}

#define MFMA32(a, b, c) __builtin_amdgcn_mfma_f32_32x32x16_bf16(a, b, c, 0, 0, 0)
typedef short v4i16_t __attribute__((ext_vector_type(4)));
typedef LAS const char* lds_cptr;
typedef LAS char* lds_ptr;
__device__ __forceinline__ int crow(int r, int hi) { return (r & 3) + 8 * (r >> 2) + 4 * hi; }
__device__ __forceinline__ s16x4 vtr(lds_cptr p) { return __builtin_bit_cast(s16x4, __builtin_amdgcn_ds_read_tr16_b64_v4i16((LAS v4i16_t*)p)); }
__device__ __forceinline__ float other_half(float x, int hi) { auto rr = __builtin_amdgcn_permlane32_swap(__float_as_uint(x), __float_as_uint(x), false, false); return __uint_as_float(hi ? rr[0] : rr[1]); }
constexpr float NEG_INF = -INFINITY;

constexpr int TB_V = 12288, TB_KB = 20480, TB_SIZE = 20992;
struct Stg { u32x4 k, k2, v; float kb; };

template <int NKS> __device__ __forceinline__ void qk64(lds_cptr kbuf, const bf16x8* qf, int r32, int hi, f32x16& p0, f32x16& p1) {
    lds_cptr kp = kbuf + hi * 1024 + r32 * 16;
#pragma unroll
    for (int ks = 0; ks < NKS; ++ks) {
        const bf16x8 a0 = *(const LAS bf16x8*)(kp + ks * 2048), a1 = *(const LAS bf16x8*)(kp + ks * 2048 + 512);
        p0 = MFMA32(a0, qf[ks], p0); p1 = MFMA32(a1, qf[ks], p1);
    }
}
template <int NKS> __device__ __forceinline__ void qk64c(lds_cptr kbuf, const bf16x8* qf, int r32, int hi, const f32x16& c, f32x16& p0, f32x16& p1) {
    lds_cptr kp = kbuf + hi * 1024 + r32 * 16;
    { const bf16x8 a0 = *(const LAS bf16x8*)(kp), a1 = *(const LAS bf16x8*)(kp + 512); p0 = MFMA32(a0, qf[0], c); p1 = MFMA32(a1, qf[0], c); }
#pragma unroll
    for (int ks = 1; ks < NKS; ++ks) {
        const bf16x8 a0 = *(const LAS bf16x8*)(kp + ks * 2048), a1 = *(const LAS bf16x8*)(kp + ks * 2048 + 512);
        p0 = MFMA32(a0, qf[ks], p0); p1 = MFMA32(a1, qf[ks], p1);
    }
}
struct AState { f32x16 o0, o1; float m, l; };
__device__ __forceinline__ void astate_init(AState& s) {
#pragma unroll
    for (int r = 0; r < 16; ++r) { s.o0[r] = 0.f; s.o1[r] = 0.f; }
    s.m = NEG_INF; s.l = 0.f;
}
__device__ __forceinline__ void pv64(f32x16& o0, f32x16& o1, lds_cptr vp, const bf16x8 (&pf)[4]) {
#pragma unroll
    for (int ks = 0; ks < 4; ++ks) {
        const s16x4 l0 = vtr(vp + ks * 1024), h0 = vtr(vp + ks * 1024 + 512), l1 = vtr(vp + 4096 + ks * 1024), h1 = vtr(vp + 4096 + ks * 1024 + 512);
        const bf16x8 v0 = (bf16x8){l0[0], l0[1], l0[2], l0[3], h0[0], h0[1], h0[2], h0[3]}, v1 = (bf16x8){l1[0], l1[1], l1[2], l1[3], h1[0], h1[1], h1[2], h1[3]};
        o0 = MFMA32(v0, pf[ks], o0); o1 = MFMA32(v1, pf[ks], o1);
    }
}
struct VFrag { bf16x8 v0[4], v1[4]; };
__device__ __forceinline__ void v_load64(VFrag& f, lds_cptr vp) {
#pragma unroll
    for (int ks = 0; ks < 4; ++ks) {
        const s16x4 l0 = vtr(vp + ks * 1024), h0 = vtr(vp + ks * 1024 + 512), l1 = vtr(vp + 4096 + ks * 1024), h1 = vtr(vp + 4096 + ks * 1024 + 512);
        f.v0[ks] = (bf16x8){l0[0], l0[1], l0[2], l0[3], h0[0], h0[1], h0[2], h0[3]}; f.v1[ks] = (bf16x8){l1[0], l1[1], l1[2], l1[3], h1[0], h1[1], h1[2], h1[3]};
    }
}
__device__ __forceinline__ void pv64f(f32x16& o0, f32x16& o1, const VFrag& f, const bf16x8 (&pf)[4]) {
#pragma unroll
    for (int ks = 0; ks < 4; ++ks) { o0 = MFMA32(f.v0[ks], pf[ks], o0); o1 = MFMA32(f.v1[ks], pf[ks], o1); }
}
__device__ __forceinline__ void pack_p(const f32x16& p0, const f32x16& p1, bf16x8 (&pf)[4]) {
    u32x4 w0, w1, w2, w3;
    w0.x = cvtpk(p0[0], p0[1]); w0.y = cvtpk(p0[2], p0[3]); w0.z = cvtpk(p0[4], p0[5]); w0.w = cvtpk(p0[6], p0[7]);
    w1.x = cvtpk(p0[8], p0[9]); w1.y = cvtpk(p0[10], p0[11]); w1.z = cvtpk(p0[12], p0[13]); w1.w = cvtpk(p0[14], p0[15]);
    w2.x = cvtpk(p1[0], p1[1]); w2.y = cvtpk(p1[2], p1[3]); w2.z = cvtpk(p1[4], p1[5]); w2.w = cvtpk(p1[6], p1[7]);
    w3.x = cvtpk(p1[8], p1[9]); w3.y = cvtpk(p1[10], p1[11]); w3.z = cvtpk(p1[12], p1[13]); w3.w = cvtpk(p1[14], p1[15]);
    pf[0] = __builtin_bit_cast(bf16x8, w0); pf[1] = __builtin_bit_cast(bf16x8, w1); pf[2] = __builtin_bit_cast(bf16x8, w2); pf[3] = __builtin_bit_cast(bf16x8, w3);
}
__device__ __forceinline__ void softmax_pv64(f32x16& p0, f32x16& p1, AState& s, lds_cptr vp, int hi) {
    VFrag vf; v_load64(vf, vp); __builtin_amdgcn_sched_barrier(0);
    float mx = fmaxf(p0[0], p1[0]);
#pragma unroll
    for (int r = 1; r < 16; ++r) mx = fmaxf(mx, fmaxf(p0[r], p1[r]));
    mx = fmaxf(mx, other_half(mx, hi));
    const float mn = fmaxf(s.m, mx), ms = (mn == NEG_INF) ? 0.f : mn;
    const float alpha = fast_exp2(s.m - ms);
    float rs = 0.f;
#pragma unroll
    for (int r = 0; r < 16; ++r) { p0[r] = fast_exp2(p0[r] - ms); p1[r] = fast_exp2(p1[r] - ms); rs += p0[r] + p1[r]; }
    rs += other_half(rs, hi);
    s.l = s.l * alpha + rs; s.m = mn;
#pragma unroll
    for (int r = 0; r < 16; ++r) { s.o0[r] *= alpha; s.o1[r] *= alpha; }
    bf16x8 pf[4]; pack_p(p0, p1, pf);
    pv64f(s.o0, s.o1, vf, pf);
}
__device__ __forceinline__ void softmax_fixed_pv64(f32x16& p0, f32x16& p1, AState& s, lds_cptr vp) {
    VFrag vf; v_load64(vf, vp); __builtin_amdgcn_sched_barrier(0);
    float rs = 0.f;
#pragma unroll
    for (int r = 0; r < 16; ++r) { p0[r] = fast_exp2(p0[r]); p1[r] = fast_exp2(p1[r]); rs += p0[r] + p1[r]; }
    s.l += rs;
    bf16x8 pf[4]; pack_p(p0, p1, pf);
    pv64f(s.o0, s.o1, vf, pf);
}
__device__ __forceinline__ void mask_causal(f32x16& p0, f32x16& p1, int kpos0, int tq, int hi) {
#pragma unroll
    for (int r = 0; r < 16; ++r) { const int kp = kpos0 + crow(r, hi); if (kp > tq) p0[r] = NEG_INF; if (kp + 32 > tq) p1[r] = NEG_INF; }
}
__device__ __forceinline__ void add_table(f32x16& p0, f32x16& p1, const LAS float* tb) {
#pragma unroll
    for (int r = 0; r < 16; ++r) { const int o = (r & 3) + 8 * (r >> 2); p0[r] += tb[o]; p1[r] += tb[o + 32]; }
}
__device__ __forceinline__ void store_o_bf16(bf16_t* orow, const f32x16& o0, const f32x16& o1, float sc, int hi) {
#pragma unroll
    for (int g = 0; g < 4; ++g) {
        u32x2 w0, w1; w0.x = cvtpk(o0[4 * g] * sc, o0[4 * g + 1] * sc); w0.y = cvtpk(o0[4 * g + 2] * sc, o0[4 * g + 3] * sc);
        w1.x = cvtpk(o1[4 * g] * sc, o1[4 * g + 1] * sc); w1.y = cvtpk(o1[4 * g + 2] * sc, o1[4 * g + 3] * sc);
        *(u32x2*)(orow + 8 * g + 4 * hi) = w0; *(u32x2*)(orow + 32 + 8 * g + 4 * hi) = w1;
    }
}
constexpr size_t MiB = 1u << 20, KiB = 1u << 10;
constexpr size_t WS_CTL = 0, CTL_ZERO_BYTES = 1 * MiB;
constexpr size_t WS_ROPE = 1 * MiB, WS_NSATAB = WS_ROPE + 512 * KiB, WS_DILTAB = WS_NSATAB + 32 * KiB, WS_CMPB = WS_DILTAB + 8 * KiB, WS_FARB = WS_CMPB + 4 * KiB;
constexpr size_t WS_WT = 4 * MiB, LW = 38 * MiB;
constexpr size_t LW_IN = 0, LW_G = 6 * MiB, LW_BR = 14 * MiB, LW_O = 16 * MiB, LW_UP = 18 * MiB, LW_DN = 29 * MiB, LW_UQ = 35 * MiB, LW_UKV = 35 * MiB + 256 * KiB, LW_PHI = 36 * MiB;
constexpr size_t BR_A = 0, BR_B = 512 * KiB, BR_C = 768 * KiB, BR_D = 1280 * KiB;
constexpr size_t WS_SIDE = 80 * MiB, WS_SSQQ = 84 * MiB, WS_SSQKV = 85 * MiB, WS_KB = 86 * MiB, WS_KROT = 87 * MiB, WS_KCMP = 91 * MiB, WS_VCMP = 100 * MiB,
                 WS_HID = 109 * MiB, WS_KMAX = 3 * MiB + 128 * KiB  , WS_LF = 2 * MiB  , WS_CMPP = 3 * MiB  , WS_ORDER = 3 * MiB + 64 * KiB  , WS_KC = 113 * MiB, WS_VC = 113 * MiB + 512 * KiB, WS_DLSE = 114 * MiB, WS_DOG = 116 * MiB;
constexpr size_t WS_H = 164 * MiB, WS_OCAT = 292 * MiB, WS_QM = 404 * MiB, WS_KVM = 468 * MiB, WS_P = 532 * MiB;
constexpr size_t WS_MERGED = 532 * MiB, WS_MSCR = 660 * MiB, WS_Y = 164 * MiB  , WS_H2 = 756 * MiB, WS_ACT = 164 * MiB  , WS_HB = 532 * MiB  , WS_Y2 = 884 * MiB  , WS_X3 = 620 * MiB  , WS_END = 1024 * MiB;
constexpr size_t MSCR_PER_WG = 512 * KiB;
constexpr size_t H8_OFF = 128 * MiB;
static_assert(WS_WT + 2 * LW <= WS_SIDE && WS_DOG + 48 * MiB <= WS_H && WS_P + 384 * MiB <= WS_END && WS_MSCR + 256 * MSCR_PER_WG <= WS_P + 384 * MiB && WS_H2 + 128 * MiB <= WS_Y2 && WS_Y2 + 128 * MiB <= WS_END, "ws map");
static_assert(WS_ACT + 352 * MiB <= WS_HB && WS_HB + 88 * MiB <= WS_X3 && WS_X3 + 128 * MiB <= WS_H2 && WS_Y + 128 * MiB <= WS_OCAT, "ws overlays");
constexpr int CW_BAR = 4096;
constexpr int CW_KMAX = 24576;
constexpr int CW_KMLA = 24832;
constexpr int CW_KROT = 25344;
constexpr int CW_Q = 16384;

constexpr int RING_BYTES = 131072, LDSCTL_OFF = RING_BYTES, MISC_OFF = LDSCTL_OFF + 320, LDS_BYTES = 147456;
constexpr int NSA_SLAB = 49152, NSA_SLAB_BYTES = 4 * 64 * 65 * 4, NSA_SEL = NSA_SLAB + NSA_SLAB_BYTES;
static_assert(NSA_SEL + 512 <= RING_BYTES && 4 * NSA_TL * 4 <= NSA_SLAB_BYTES && 2 * TB_SIZE <= NSA_SLAB, "NSA LDS map");

struct Frame {
    LAS unsigned char* lds; volatile LAS unsigned* MISC; gu32* ctl;
    int tid, lane, wave, G;
    const float* in[27]; float* out; unsigned char* ws;
};
#define WSP(T, off) ((T*)(F.ws + (off)))
#define VM_WAIT() asm volatile("s_waitcnt vmcnt(0)" ::: "memory")
#define LDS_WAIT() asm volatile("s_waitcnt lgkmcnt(0)" ::: "memory")

__device__ __forceinline__ int queue_grab(Frame& F, gu32* ctr) {
    if (F.tid == 0) F.MISC[0] = __hip_atomic_fetch_add(ctr, 1u, __ATOMIC_RELAXED, __HIP_MEMORY_SCOPE_AGENT);
    __syncthreads();
    const int v = (int)F.MISC[0];
    __syncthreads();
    return v;
}

template <bool FOX> __device__ __forceinline__ void causal_unit(Frame& F, int b, int h, int qb, float kmax_in) {
    constexpr int NKS = FOX ? 4 : 6;
    int lane_o = F.lane; asm volatile("" : "+v"(lane_o));
    const int wid = F.wave, lane = lane_o, r32 = lane & 31, hi = lane >> 5;
    const size_t rowbase = (size_t)b * SEQ;
    const int q0 = qb * 256, tq = q0 + wid * 32 + r32, NT = qb * 4 + 4;
    const bf16_t* P = WSP(const bf16_t, WS_P);
    const bf16_t *Kb, *Vb, *Qrow; int kpitch, vpitch;
    const bf16_t* Kr = WSP(const bf16_t, WS_KROT) + rowbase * 32;
    const float* kbsrc = WSP(const float, WS_KB) + (size_t)(b * 4 + h) * SEQ;
    if (FOX) { Kb = P + rowbase * PW + PC_CK + h * 64; Vb = P + rowbase * PW + PC_CV + h * 64; kpitch = PW; vpitch = PW; Qrow = P + (rowbase + tq) * PW + PC_CQ + h * 64; }
    else { const bf16_t* KV = WSP(const bf16_t, WS_KVM) + rowbase * 512 + h * 128; Kb = KV; Vb = KV + 64; kpitch = 512; vpitch = 512; Qrow = WSP(const bf16_t, WS_QM) + (rowbase + tq) * 512 + h * 96; }
    bf16x8 qf[NKS];
#pragma unroll
    for (int ks = 0; ks < NKS; ++ks) qf[ks] = *(const bf16x8*)(Qrow + ks * 16 + hi * 8);
    AState st; astate_init(st);
    lds_ptr lds = (lds_ptr)F.lds;
    const int vpo = ((lane >> 4) & 1) * 32 + (lane & 3) * 8 + (4 * hi + ((lane & 15) >> 2)) * 64;
    Stg sA, sB;
#define CU_LOAD(S, t) do { S.k = *(const u32x4*)(Kb + (size_t)((t) * 64 + lane) * kpitch + wid * 8); \
        if (!FOX) { if (wid < 4) S.k2 = *(const u32x4*)(Kr + (size_t)((t) * 64 + lane) * 32 + wid * 8); } \
        S.v = *(const u32x4*)(Vb + (size_t)((t) * 64 + 16 * (wid & 3) + (lane >> 2)) * vpitch + (wid >> 2) * 32 + (lane & 3) * 8); \
        if (FOX) { if (wid == 0) S.kb = kbsrc[(t) * 64 + lane]; else if (wid == 1) S.kb = kbsrc[(t) > 0 ? (t) * 64 - 1 : 0]; } } while (0)
#define CU_WRITE(S, bi) do { lds_ptr bp = lds + (bi) * TB_SIZE; *(LAS u32x4*)(bp + wid * 1024 + lane * 16) = S.k; \
        if (!FOX) { if (wid < 4) *(LAS u32x4*)(bp + (8 + wid) * 1024 + lane * 16) = S.k2; } \
        *(LAS u32x4*)(bp + TB_V + wid * 1024 + lane * 16) = S.v; \
        if (FOX) { if (wid == 0) *(LAS float*)(bp + TB_KB + lane * 4) = S.kb; else if (wid == 1 && lane == 0) *(LAS float*)(bp + TB_KB + 256) = S.kb; } } while (0)
    const int tq_lo = q0 + wid * 32;
    float qn = 0.f; const float kmax = kmax_in;
#pragma unroll
    for (int ks = 0; ks < NKS; ++ks)
#pragma unroll
        for (int e = 0; e < 8; ++e) { const float x = bf2f((unsigned short)qf[ks][e]); qn += x * x; }
    qn += other_half(qn, hi); qn = sqrtf(qn);
    const float bnd = qn * kmax * 1.002f + 0.05f;
    const bool fast = __all(bnd <= 50.0f);
    const float kbi = FOX ? kbsrc[tq] : 0.f;
    f32x16 cinit;
    { const float c0 = -(bnd + kbi);
#pragma unroll
      for (int r = 0; r < 16; ++r) cinit[r] = c0; }
    LAS volatile unsigned* dflag = (LAS volatile unsigned*)(lds + 2 * TB_SIZE + 64);
    const int t_first = FOX ? NT - 1 : 0, t_step = FOX ? -1 : 1;
#define CU_STEP(TT, BI, SL, SW) { const int tt = (TT), t = t_first + tt * t_step; \
        if (tt + 2 < NT) CU_LOAD(SL, t + 2 * t_step); \
        lds_cptr bp = (lds_cptr)(lds + (BI) * TB_SIZE); \
        if (64 * t <= tq_lo + 31) {                                \
            f32x16 p0, p1; \
            if (fast) qk64c<NKS>(bp, qf, r32, hi, cinit, p0, p1); \
            else { _Pragma("unroll") for (int r = 0; r < 16; ++r) { p0[r] = 0.f; p1[r] = 0.f; } qk64<NKS>(bp, qf, r32, hi, p0, p1); } \
            if (FOX) { const LAS float* kbt = (const LAS float*)(bp + TB_KB) + 4 * hi; \
                _Pragma("unroll") for (int g = 0; g < 4; ++g) { const f32x4 a = *(const LAS f32x4*)(kbt + 8 * g), c = *(const LAS f32x4*)(kbt + 32 + 8 * g); \
                    _Pragma("unroll") for (int e = 0; e < 4; ++e) { p0[4 * g + e] += a[e]; p1[4 * g + e] += c[e]; } } } \
            if (64 * t + 63 > tq_lo) mask_causal(p0, p1, 64 * t, tq, hi); \
            if (fast) softmax_fixed_pv64(p0, p1, st, bp + TB_V + vpo); else softmax_pv64(p0, p1, st, bp + TB_V + vpo, hi); \
        } \
          \
        if (FOX) { if (t > 0) { const float kb_last = *(const LAS float*)(bp + TB_KB + 256); const bool done = fast ? ((kb_last - kbi) < -150.0f) : ((qn * kmax + kb_last - st.m) < -130.0f); const unsigned alld = __all(done) ? 1u : 0u; if (lane == 0) dflag[(BI) * 8 + wid] = alld; } } \
        if (tt + 1 < NT) CU_WRITE(SW, (BI) ^ 1); \
        __syncthreads(); \
        if (FOX) { if (t > 0) { unsigned all = 1u; _Pragma("unroll") for (int w = 0; w < 8; ++w) all &= dflag[(BI) * 8 + w]; if (all) break; } } }
    CU_LOAD(sA, t_first); CU_WRITE(sA, 0);
    CU_LOAD(sA, t_first + t_step);
    __syncthreads();
    for (int t2 = 0; t2 < NT; t2 += 2) {
        CU_STEP(t2, 0, sB, sA)
        CU_STEP(t2 + 1, 1, sA, sB)
    }
#undef CU_STEP
#undef CU_LOAD
#undef CU_WRITE
    bf16_t* orow = WSP(bf16_t, WS_OCAT) + (rowbase + tq) * OCW + (FOX ? 384 : 640) + h * 64;
    const float ltot = fast ? st.l + other_half(st.l, hi) : st.l;
    store_o_bf16(orow, st.o0, st.o1, 1.0f / ltot, hi);
}
__device__ __forceinline__ void nsa_unit(Frame& F, int b, int qblk) {
    int lane_o = F.lane; asm volatile("" : "+v"(lane_o));
    const int wid = F.wave, lane = lane_o, r32 = lane & 31, hi = lane >> 5, tid = wid * 64 + lane;
    const int h = wid & 3, qs = wid >> 2;
    const int q0 = qblk * 64, cur = qblk, tq = q0 + 32 * qs + r32, tq_lo = q0 + 32 * qs;
    const size_t rowbase = (size_t)b * SEQ, row = rowbase + tq;
    const bf16_t* P = WSP(const bf16_t, WS_P);
    lds_ptr lds = (lds_ptr)F.lds;
    const int vpo = ((lane >> 4) & 1) * 32 + (lane & 3) * 8 + (4 * hi + ((lane & 15) >> 2)) * 64;
    bf16x8 qf[4];
    { const bf16_t* Qrow = P + row * PW + PC_AQ + h * 64;
#pragma unroll
      for (int ks = 0; ks < 4; ++ks) qf[ks] = *(const bf16x8*)(Qrow + ks * 16 + hi * 8); }
    Stg s; int ln;
#define NS_LOAD(Kb, kp, Vb, vp_, t) do { s.k = *(const u32x4*)((Kb) + (size_t)((t) * 64 + ln) * (kp) + wid * 8); \
        s.v = *(const u32x4*)((Vb) + (size_t)((t) * 64 + 16 * (wid & 3) + (ln >> 2)) * (vp_) + (wid >> 2) * 32 + (ln & 3) * 8); } while (0)
#define NS_FRESH() do { ln = lane; asm volatile("" : "+v"(ln)); } while (0)
#define NS_WRITE(bi) do { lds_ptr bp_ = lds + (bi) * TB_SIZE; *(LAS u32x4*)(bp_ + wid * 1024 + lane * 16) = s.k; *(LAS u32x4*)(bp_ + TB_V + wid * 1024 + lane * 16) = s.v; } while (0)
    const bf16_t* KC = WSP(const bf16_t, WS_KC) + (size_t)b * 256 * 64; const bf16_t* VC = WSP(const bf16_t, WS_VC) + (size_t)b * 256 * 64;
    const int cmax_u = (q0 + 63 - 31) >> 4, NTc = (cmax_u >> 6) + 1;
    const int cmax = (tq - 31) >> 4;
    float cm = NEG_INF, cl = 0.f;
    NS_FRESH(); NS_LOAD(KC, 64, VC, 64, 0); NS_WRITE(0);
    __syncthreads();
    for (int t = 0; t < NTc; ++t) {
        const int bi = t & 1;
        if (t + 1 < NTc) NS_LOAD(KC, 64, VC, 64, t + 1);
        { lds_cptr bp = (lds_cptr)(lds + bi * TB_SIZE); f32x16 p0, p1;
#pragma unroll
          for (int r = 0; r < 16; ++r) { p0[r] = 0.f; p1[r] = 0.f; }
          qk64<4>(bp, qf, r32, hi, p0, p1);
          float mx = NEG_INF;
#pragma unroll
          for (int r = 0; r < 16; ++r) { const int c = 64 * t + crow(r, hi); if (c > cmax) p0[r] = NEG_INF; if (c + 32 > cmax) p1[r] = NEG_INF; mx = fmaxf(mx, fmaxf(p0[r], p1[r])); }
          mx = fmaxf(mx, other_half(mx, hi));
          const float mn = fmaxf(cm, mx), ms = (mn == NEG_INF) ? 0.f : mn; float rs = 0.f;
#pragma unroll
          for (int r = 0; r < 16; ++r) rs += fast_exp2(p0[r] - ms) + fast_exp2(p1[r] - ms);
          rs += other_half(rs, hi);
          cl = cl * fast_exp2(cm - ms) + rs; cm = mn; }
        if (t + 1 < NTc) NS_WRITE(bi ^ 1);
        __syncthreads();
    }
    const float cms = (cm == NEG_INF) ? 0.f : cm, cinv = 1.0f / fmaxf(cl, 1e-30f);
    f32x16 oc0, oc1;
#pragma unroll
    for (int r = 0; r < 16; ++r) { oc0[r] = 0.f; oc1[r] = 0.f; }
    float G[32]; float carry = 0.f;
#pragma unroll
    for (int i = 0; i < 32; ++i) G[i] = 0.f;
    NS_FRESH(); NS_LOAD(KC, 64, VC, 64, 0); NS_WRITE(0);
    __syncthreads();
#pragma unroll
    for (int t = 0; t < 4; ++t) {
        if (t < NTc) {
            const int bi = t & 1;
            if (t + 1 < NTc) NS_LOAD(KC, 64, VC, 64, t + 1);
            { lds_cptr bp = (lds_cptr)(lds + bi * TB_SIZE); f32x16 p0, p1;
#pragma unroll
              for (int r = 0; r < 16; ++r) { p0[r] = 0.f; p1[r] = 0.f; }
              qk64<4>(bp, qf, r32, hi, p0, p1);
#pragma unroll
              for (int r = 0; r < 16; ++r) { const int c = 64 * t + crow(r, hi);
                  p0[r] = (c > cmax) ? 0.f : fast_exp2(p0[r] - cms) * cinv; p1[r] = (c + 32 > cmax) ? 0.f : fast_exp2(p1[r] - cms) * cinv; }
#pragma unroll
              for (int g = 0; g < 4; ++g) { const float oth = other_half(p0[4 * g + 3], hi);
                  G[t * 8 + g] = ((p0[4 * g] + p0[4 * g + 1]) + (p0[4 * g + 2] + p0[4 * g + 3])) + (hi ? oth : carry); carry = oth; }
#pragma unroll
              for (int g = 0; g < 4; ++g) { const float oth = other_half(p1[4 * g + 3], hi);
                  G[t * 8 + 4 + g] = ((p1[4 * g] + p1[4 * g + 1]) + (p1[4 * g + 2] + p1[4 * g + 3])) + (hi ? oth : carry); carry = oth; }
              bf16x8 pf[4]; pack_p(p0, p1, pf);
              pv64(oc0, oc1, bp + TB_V + vpo, pf); }
            if (t + 1 < NTc) NS_WRITE(bi ^ 1);
            __syncthreads();
        }
    }
    { LAS float* slab = (LAS float*)(lds + NSA_SLAB) + (size_t)(h * 64 + 32 * qs + r32) * 65;
#pragma unroll
      for (int i = 0; i < 32; ++i) slab[2 * i + hi] = G[i]; }
    __syncthreads();
    u32x4 tbr[4]; { const u32x4* src = WSP(const u32x4, WS_NSATAB);
#pragma unroll
      for (int i = 0; i < 4; ++i) { const int idx = tid + 512 * i; tbr[i] = (idx < 4 * NSA_TL / 4) ? src[idx] : (u32x4){0u, 0u, 0u, 0u}; } }
    float gl0, gl1, gl2; { const float* sd = WSP(const float, WS_SIDE) + row * 16 + h * 3; gl0 = sd[0]; gl1 = sd[1]; gl2 = sd[2]; }
    { const int q = tid >> 3, jg = tid & 7;
      const LAS float* s0 = (const LAS float*)(lds + NSA_SLAB) + (size_t)q * 65;
      float v[64];
#pragma unroll
      for (int k = 0; k < 64; ++k) { const float x = (s0[k] + s0[64 * 65 + k]) + (s0[2 * 64 * 65 + k] + s0[3 * 64 * 65 + k]);
          v[k] = (k == 0 || k == cur || k == cur - 1) ? 1e9f : ((k > cur) ? -1e9f : x); if ((k & 7) == 7) asm volatile("" ::: "memory"); }
      unsigned bits = 0u;
#pragma unroll
      for (int e = 0; e < 8; ++e) { const int j = 8 * jg + e;
          const float xj = (s0[j] + s0[64 * 65 + j]) + (s0[2 * 64 * 65 + j] + s0[3 * 64 * 65 + j]);
          const float vj = (j == 0 || j == cur || j == cur - 1) ? 1e9f : ((j > cur) ? -1e9f : xj);
          int rank = 0;
#pragma unroll
          for (int k = 0; k < 64; ++k) rank += (v[k] > vj || (v[k] == vj && k < j)) ? 1 : 0;
          bits |= (rank < 16 ? 1u : 0u) << e; }
      *((LAS unsigned char*)(lds + NSA_SEL) + q * 8 + jg) = (unsigned char)bits; }
    __syncthreads();
    const unsigned mlo = *(const LAS unsigned*)(lds + NSA_SEL + (32 * qs + r32) * 8), mhi = *(const LAS unsigned*)(lds + NSA_SEL + (32 * qs + r32) * 8 + 4);
    { LAS u32x4* dst = (LAS u32x4*)(lds + NSA_SLAB);
#pragma unroll
      for (int i = 0; i < 4; ++i) { const int idx = tid + 512 * i; if (idx < 4 * NSA_TL / 4) dst[idx] = tbr[i]; } }
    const LAS float* tabh = (const LAS float*)(lds + NSA_SLAB) + h * NSA_TL;
    const float farb = WSP(const float, WS_FARB)[h];
    const float g0 = sigmoid_f(gl0), g1 = sigmoid_f(gl1), g2 = sigmoid_f(gl2);
    AState st; astate_init(st);
    { const bf16_t* Kb = P + rowbase * PW + PC_KSLC; const bf16_t* Vb = P + rowbase * PW + PC_VSLC;
      NS_FRESH(); NS_LOAD(Kb, PW, Vb, PW, 0); NS_WRITE(0);
      __syncthreads();
      for (int j = 0; j <= cur; ++j) {
          const int bi = j & 1;
          if (j < cur) NS_LOAD(Kb, PW, Vb, PW, j + 1);
          const bool mine = ((j < 32) ? (mlo >> j) : (mhi >> (j - 32))) & 1u;
          if (__any(mine)) {
              lds_cptr bp = (lds_cptr)(lds + bi * TB_SIZE); f32x16 p0, p1;
#pragma unroll
              for (int r = 0; r < 16; ++r) { p0[r] = 0.f; p1[r] = 0.f; }
              qk64<4>(bp, qf, r32, hi, p0, p1);
              if (q0 - 64 * j - 63 >= NSA_DFAR) {
#pragma unroll
                  for (int r = 0; r < 16; ++r) { p0[r] += farb; p1[r] += farb; }
              } else add_table(p0, p1, tabh + (NSA_DMAX - tq + 64 * j + 4 * hi));
              if (j == cur) mask_causal(p0, p1, 64 * j, tq, hi);
              if (!mine) {
#pragma unroll
                  for (int r = 0; r < 16; ++r) { p0[r] = NEG_INF; p1[r] = NEG_INF; } }
              softmax_pv64(p0, p1, st, bp + TB_V + vpo, hi);
          }
          if (j < cur) NS_WRITE(bi ^ 1);
          __syncthreads();
      } }
    f32x16 oa0, oa1;
    { const float sc = g1 / st.l;
#pragma unroll
      for (int r = 0; r < 16; ++r) { oa0[r] = g0 * oc0[r] + sc * st.o0[r]; oa1[r] = g0 * oc1[r] + sc * st.o1[r]; } }
    astate_init(st);
    { const bf16_t* Kb = P + rowbase * PW + PC_KWIN; const bf16_t* Vb = P + rowbase * PW + PC_VWIN;
      const int jlo = cur >= 8 ? cur - 8 : 0;
      NS_FRESH(); NS_LOAD(Kb, PW, Vb, PW, jlo); NS_WRITE(0);
      __syncthreads();
      for (int j = jlo; j <= cur; ++j) {
          const int bi = (j - jlo) & 1;
          if (j < cur) NS_LOAD(Kb, PW, Vb, PW, j + 1);
          if (tq_lo - 64 * j - 63 < 512) {
              lds_cptr bp = (lds_cptr)(lds + bi * TB_SIZE); f32x16 p0, p1;
#pragma unroll
              for (int r = 0; r < 16; ++r) { p0[r] = 0.f; p1[r] = 0.f; }
              qk64<4>(bp, qf, r32, hi, p0, p1);
              add_table(p0, p1, tabh + (NSA_DMAX - tq + 64 * j + 4 * hi));
              if (!(tq_lo - 64 * j - 63 >= 0 && tq_lo + 31 - 64 * j < 512)) {
                  const int d0 = tq - 64 * j - 4 * hi;
#pragma unroll
                  for (int r = 0; r < 16; ++r) { const int d = d0 - ((r & 3) + 8 * (r >> 2)); if (d < 0 || d >= 512) p0[r] = NEG_INF; if (d - 32 < 0 || d - 32 >= 512) p1[r] = NEG_INF; }
              }
              softmax_pv64(p0, p1, st, bp + TB_V + vpo, hi);
          }
          if (j < cur) NS_WRITE(bi ^ 1);
          __syncthreads();
      } }
    { const float sc = g2 / st.l;
#pragma unroll
      for (int r = 0; r < 16; ++r) { oa0[r] += sc * st.o0[r]; oa1[r] += sc * st.o1[r]; } }
    { int tq_ = tq; asm volatile("" : "+v"(tq_)); store_o_bf16(WSP(bf16_t, WS_OCAT) + (rowbase + tq_) * OCW + h * 64, oa0, oa1, 1.0f, hi); }
#undef NS_LOAD
#undef NS_FRESH
#undef NS_WRITE
}
__device__ __forceinline__ void dil_unit(Frame& F, int b, int hh, int span) {
    int lane_o = F.lane; asm volatile("" : "+v"(lane_o));
    const int wid = F.wave, lane = lane_o, r32 = lane & 31, hi = lane >> 5, tid = wid * 64 + lane;
    const int T0 = span * 512;
    const size_t rowbase = (size_t)b * SEQ;
    const bf16_t* P = WSP(const bf16_t, WS_P) + rowbase * PW;
    lds_ptr lds = (lds_ptr)F.lds;
    LAS float* dtab = (LAS float*)(lds + 32768);
    for (int i = tid; i < 3 * 192; i += 512) dtab[i] = WSP(const float, WS_DILTAB)[((i / 192) * 2 + hh) * 192 + (i % 192)];
    __syncthreads();
    lds_ptr vst = lds + wid * 4096;
    const int vpo = ((lane >> 4) & 1) * 32 + (lane & 3) * 8 + (4 * hi + ((lane & 15) >> 2)) * 64;
    bf16_t* DOG = WSP(bf16_t, WS_DOG); float* DLSE = WSP(float, WS_DLSE);
    for (int g = 0; g < 3; ++g) {
        const int sh = 2 * g, head = 2 * g + hh;
        for (int rep = 0; rep < 2; ++rep) {
            const int wt = wid + 8 * rep;
            const int res = (g == 0) ? 0 : (g == 1 ? (wt & 3) : wt);
            const int i0 = (g == 0) ? 32 * wt : (g == 1 ? 32 * (wt >> 2) : 0);
            const int n0 = (T0 >> sh) + i0;
            const int tokq = res + ((n0 + r32) << sh);
            bf16x8 qf[4];
            { const bf16_t* Qrow = P + (size_t)tokq * PW + PC_BQ + head * 64;
#pragma unroll
              for (int ks = 0; ks < 4; ++ks) qf[ks] = *(const bf16x8*)(Qrow + ks * 16 + hi * 8); }
            f32x16 o0, o1; float m = NEG_INF, l = 0.f;
#pragma unroll
            for (int r = 0; r < 16; ++r) { o0[r] = 0.f; o1[r] = 0.f; }
#define DIL_LOAD(cc, KF, VR) do { const int nk0_ = n0 - 128 + 32 * (cc); int nk_ = nk0_ + r32; nk_ = nk_ < 0 ? 0 : nk_; const bf16_t* Krow_ = P + (size_t)(res + (nk_ << sh)) * PW + PC_BK + head * 64; \
        _Pragma("unroll") for (int ks = 0; ks < 4; ++ks) KF[ks] = *(const bf16x8*)(Krow_ + ks * 16 + hi * 8); \
        _Pragma("unroll") for (int i = 0; i < 4; ++i) { const int pc_ = lane + 64 * i, vrow_ = pc_ >> 3, c16_ = pc_ & 7; int nv_ = nk0_ + vrow_; nv_ = nv_ < 0 ? 0 : nv_; \
            VR[i] = *(const u32x4*)(P + (size_t)(res + (nv_ << sh)) * PW + PC_BV + head * 64 + c16_ * 8); } } while (0)
            int cfirst = 0; while (cfirst < 4 && n0 - 128 + 32 * cfirst + 31 < 0) ++cfirst;
            bf16x8 kfn[4]; u32x4 vrn[4];
            DIL_LOAD(cfirst, kfn, vrn);
            for (int c = cfirst; c < 5; ++c) {
                const int nk0 = n0 - 128 + 32 * c;
                { bf16x8 kf[4]; u32x4 vr[4];
#pragma unroll
                  for (int i = 0; i < 4; ++i) { kf[i] = kfn[i]; vr[i] = vrn[i]; }
                  if (c < 4) DIL_LOAD(c + 1, kfn, vrn);
#pragma unroll
                  for (int i = 0; i < 4; ++i) { const int pc = lane + 64 * i, vrow = pc >> 3, c16 = pc & 7;
                      *(LAS u32x4*)(vst + (c16 >> 2) * 2048 + vrow * 64 + (c16 & 3) * 16) = vr[i]; }
                  asm volatile("s_waitcnt lgkmcnt(0)" ::: "memory");
                  f32x16 p;
#pragma unroll
                  for (int r = 0; r < 16; ++r) p[r] = 0.f;
#pragma unroll
                  for (int ks = 0; ks < 4; ++ks) p = MFMA32(kf[ks], qf[ks], p);
                  const LAS float* tb = dtab + g * 192 + (32 - r32 + 4 * hi + 32 * c);
                  float mx = NEG_INF;
#pragma unroll
                  for (int r = 0; r < 16; ++r) { const int o = (r & 3) + 8 * (r >> 2), kk = o + 4 * hi, j = 128 + r32 - 32 * c - kk;
                      const bool ok = (j >= 0) && (j <= 128) && (nk0 + kk >= 0);
                      p[r] = ok ? p[r] + tb[o] : NEG_INF; mx = fmaxf(mx, p[r]); }
                  mx = fmaxf(mx, other_half(mx, hi));
                  const float mn = fmaxf(m, mx), ms = (mn == NEG_INF) ? 0.f : mn, alpha = fast_exp2(m - ms);
                  float rs = 0.f;
#pragma unroll
                  for (int r = 0; r < 16; ++r) { p[r] = fast_exp2(p[r] - ms); rs += p[r]; }
                  rs += other_half(rs, hi);
                  l = l * alpha + rs; m = mn;
#pragma unroll
                  for (int r = 0; r < 16; ++r) { o0[r] *= alpha; o1[r] *= alpha; }
                  u32x4 w0, w1;
                  w0.x = cvtpk(p[0], p[1]); w0.y = cvtpk(p[2], p[3]); w0.z = cvtpk(p[4], p[5]); w0.w = cvtpk(p[6], p[7]);
                  w1.x = cvtpk(p[8], p[9]); w1.y = cvtpk(p[10], p[11]); w1.z = cvtpk(p[12], p[13]); w1.w = cvtpk(p[14], p[15]);
                  const bf16x8 pf0 = __builtin_bit_cast(bf16x8, w0), pf1 = __builtin_bit_cast(bf16x8, w1);
                  lds_cptr vp = (lds_cptr)(vst + vpo);
#pragma unroll
                  for (int ks = 0; ks < 2; ++ks) {
                      const s16x4 l0 = vtr(vp + ks * 1024), h0 = vtr(vp + ks * 1024 + 512), l1 = vtr(vp + 2048 + ks * 1024), h1 = vtr(vp + 2048 + ks * 1024 + 512);
                      const bf16x8 v0 = (bf16x8){l0[0], l0[1], l0[2], l0[3], h0[0], h0[1], h0[2], h0[3]}, v1 = (bf16x8){l1[0], l1[1], l1[2], l1[3], h1[0], h1[1], h1[2], h1[3]};
                      o0 = MFMA32(v0, ks == 0 ? pf0 : pf1, o0); o1 = MFMA32(v1, ks == 0 ? pf0 : pf1, o1);
                  }
                  asm volatile("s_waitcnt lgkmcnt(0)" ::: "memory"); }
            }
#undef DIL_LOAD
            const size_t orow = rowbase + tokq;
            store_o_bf16(DOG + ((size_t)g * M + orow) * 128 + hh * 64, o0, o1, 1.0f / l, hi);
            if (hi == 0) DLSE[((size_t)g * M + orow) * 2 + hh] = m + log2f(l);
        }
    }
    VM_WAIT();
    __syncthreads();
    bf16_t* OC = WSP(bf16_t, WS_OCAT);
    for (int it = 0; it < 8; ++it) {
        const int item = tid + 512 * it, tl = item >> 3, pc = item & 7; const size_t orow = rowbase + T0 + tl;
        const float l0 = DLSE[((size_t)0 * M + orow) * 2 + hh], l1 = DLSE[((size_t)1 * M + orow) * 2 + hh], l2 = DLSE[((size_t)2 * M + orow) * 2 + hh];
        const float mx = fmaxf(l0, fmaxf(l1, l2)); float w0 = fast_exp2(l0 - mx), w1 = fast_exp2(l1 - mx), w2 = fast_exp2(l2 - mx);
        const float inv = 1.0f / (w0 + w1 + w2); w0 *= inv; w1 *= inv; w2 *= inv;
        const u32x4 a = *(const u32x4*)(DOG + ((size_t)0 * M + orow) * 128 + hh * 64 + pc * 8), bb = *(const u32x4*)(DOG + ((size_t)1 * M + orow) * 128 + hh * 64 + pc * 8),
                    cc = *(const u32x4*)(DOG + ((size_t)2 * M + orow) * 128 + hh * 64 + pc * 8);
        u32x4 w;
#pragma unroll
        for (int e = 0; e < 4; ++e) {
            const float lo = w0 * __uint_as_float(a[e] << 16) + w1 * __uint_as_float(bb[e] << 16) + w2 * __uint_as_float(cc[e] << 16);
            const float hv = w0 * __uint_as_float(a[e] & 0xffff0000u) + w1 * __uint_as_float(bb[e] & 0xffff0000u) + w2 * __uint_as_float(cc[e] & 0xffff0000u);
            w[e] = cvtpk(lo, hv); }
        *(u32x4*)(OC + orow * OCW + 256 + hh * 64 + pc * 8) = w;
    }
    __syncthreads();
}
__device__ __forceinline__ float wave_sum(float v) {
    v += xor_lane_lt32<1>(v); v += xor_lane_lt32<2>(v); v += xor_lane_lt32<4>(v); v += xor_lane_lt32<8>(v); v += xor_lane_lt32<16>(v);
    return sum_halves(v);
}
__device__ __forceinline__ int rel_bucket(int dist) {
    if (dist < 0) dist = 0;
    if (dist < 16) return dist;
    const int thr[15] = {22, 30, 40, 54, 73, 99, 134, 182, 246, 332, 450, 609, 825, 1117, 1513};
    int bkt = 16;
#pragma unroll
    for (int i = 0; i < 15; ++i) bkt += (dist >= thr[i]) ? 1 : 0;
    return bkt;
}
__device__ __forceinline__ int inproj_src(int c, float& sc) {
    sc = 1.f;
    if (c < 256) { sc = C2A; return c; }
    if (c < 652) return c;
    if (c < 656) return 2572 + (c - 652);
    if (c < 672) return -1;
    if (c < 704) { const int p = c - 672; return 2960 + (p >> 1) + 16 * (p & 1); }
    if (c < 768) return -1;
    if (c < 1920) { const int r = c - 768; if (r < 384) sc = C2A; return 652 + r; }
    if (c < 2048) return 2832 + (c - 1920);
    if (c < 2816) { const int r = c - 2048; if (r < 256) sc = C2A; return 1804 + r; }
    return 2576 + (c - 2816);
}
__device__ __forceinline__ int quq_src(int r, float& sc) {
    sc = C2D;
    if (r >= 384) return -1;
    const int hd = r / 96, w = r % 96;
    if (w < 64) return hd * 96 + w;
    const int p = w - 64; return hd * 96 + 64 + (p >> 1) + 16 * (p & 1);
}
__device__ __forceinline__ int gateperm_src(int r) {
    const int T = r >> 8, c = r & 255, pn = T >> 2, j = T & 3, bj = c >> 7, wc = (c >> 5) & 3, fq = (c >> 3) & 3, n = (c >> 2) & 1, e = c & 3;
    return (2 * bj + n) * DM * DM + 256 * pn + 64 * j + 16 * wc + 4 * fq + e;
}
__device__ __forceinline__ int branchperm_src(int r) {
    const int pn = r >> 8, c = r & 255, bj = c >> 7, wc = (c >> 5) & 3, fq = (c >> 3) & 3, n = (c >> 2) & 1, e = c & 3;
    return 256 * pn + 64 * (2 * bj + n) + 16 * wc + 4 * fq + e;
}
__device__ __forceinline__ int upperm_src(int r) { const int pn = r >> 8, c = r & 255; return (c & 128) ? DFF + 128 * pn + (c & 127) : 128 * pn + c; }
__device__ __forceinline__ void wconv_item(const float* W, int Nsrc, bf16_t* WT, int ldt, const float* kgain, int kind, LAS float* scr, int item, int nblk, int lane, bool f8out = false) {
    const int kb = item / nblk, nb = item % nblk, k0 = 64 * kb, n0 = 32 * nb;
    const int n = n0 + (lane & 31); float sc = 1.f; int src = n;
    if (kind == 1) src = inproj_src(n, sc); else if (kind == 2) src = quq_src(n, sc); else if (kind == 3) src = gateperm_src(n); else if (kind == 4) src = branchperm_src(n); else if (kind == 5) src = upperm_src(n);
    float wv[32];
#pragma unroll
    for (int i = 0; i < 32; ++i) { const int kk = 2 * i + (lane >> 5); wv[i] = (src >= 0) ? W[(size_t)(k0 + kk) * Nsrc + src] : 0.f; }
#pragma unroll
    for (int i = 0; i < 32; ++i) { const int kk = 2 * i + (lane >> 5); float v = wv[i] * sc; if (kgain) v *= kgain[k0 + kk]; scr[kk * 33 + (lane & 31)] = v; }
    LDS_WAIT(); asm volatile("" ::: "memory");
    if (f8out) {
        const int nn = lane >> 1, hh = lane & 1; const LAS float* s = scr + (32 * hh) * 33 + nn; unsigned char* dst = (unsigned char*)WT + (size_t)(n0 + nn) * ldt + k0 + 32 * hh;
#pragma unroll
        for (int j = 0; j < 2; ++j) { u32x4 o;
#pragma unroll
            for (int e = 0; e < 4; ++e) { const LAS float* q = s + (16 * j + 4 * e) * 33; o[e] = pk4_fp8(q[0] * WG8_SCALE, q[33] * WG8_SCALE, q[66] * WG8_SCALE, q[99] * WG8_SCALE); }
            *(u32x4*)(dst + 16 * j) = o; }
        LDS_WAIT(); asm volatile("" ::: "memory");
        return;
    }
    const int c = lane & 7;
#pragma unroll
    for (int j = 0; j < 4; ++j) { const int nn = (lane >> 3) + 8 * j; const LAS float* s = scr + (8 * c) * 33 + nn;
        u32x4 o; o.x = pk2(s[0 * 33], s[1 * 33]); o.y = pk2(s[2 * 33], s[3 * 33]); o.z = pk2(s[4 * 33], s[5 * 33]); o.w = pk2(s[6 * 33], s[7 * 33]);
        *(u32x4*)(WT + (size_t)(n0 + nn) * ldt + k0 + 8 * c) = o; }
    LDS_WAIT(); asm volatile("" ::: "memory");
}
constexpr int ATT_UNITS = 3328;
__device__ __forceinline__ int att_cost(int id) {
    if (id < 2048) { const int qb = 15 - (id >> 7), mla = (id >> 6) & 1; return (mla ? 5 : 4) * (qb + 1); }
    if (id < 3072) return (63 - ((id - 2048) >> 4)) + 20;
    return 30;
}
__device__ __forceinline__ int clampi(int x, int lo, int hi) { return x < lo ? lo : (x > hi ? hi : x); }
__device__ __forceinline__ int att_rank(int i) {
    const int c = att_cost(i);
    int r = clampi(16 - c / 4, 0, 16) * 64 + clampi(16 - c / 5, 0, 16) * 64 + clampi(83 - c, 0, 64) * 16 + (c < 30 ? 256 : 0);
    if (c % 4 == 0 && c / 4 >= 1 && c / 4 <= 16) r += clampi(i - (16 - c / 4) * 128, 0, 64);
    if (c % 5 == 0 && c / 5 >= 1 && c / 5 <= 16) r += clampi(i - ((16 - c / 5) * 128 + 64), 0, 64);
    if (c >= 20 && c <= 83) r += clampi(i - (2048 + (63 - (c - 20)) * 16), 0, 16);
    if (c == 30) r += clampi(i - 3072, 0, 256);
    return r;
}
__device__ __forceinline__ void p0_prologue(Frame& F) {
    LAS float* scr = (LAS float*)(F.lds + F.wave * 16384);
    const int gw = blockIdx.x * 8 + F.wave, NGW = F.G * 8, lane = F.lane;
    constexpr int I_IN = 16 * 96, I_G = 16 * 32, I_BA = 4 * 32, I_BB = 2 * 32, I_O = 16 * 32, I_UP = 16 * 176, I_DN = 44 * 32, I_UQ = 4 * 16, I_UKV = 2 * 16, I_PHI = 32 * 4;
    constexpr int I_L = I_IN + 4 * I_G + 3 * I_BA + I_BB + I_O + I_UP + I_DN + I_UQ + I_UKV + 2 * I_PHI;
    for (int it = gw; it < DEPTH * I_L; it += NGW) {
        const int l = it / I_L; int r = it % I_L;
        unsigned char* wl = F.ws + WS_WT + (size_t)l * LW;
        if (r < I_IN) { wconv_item(F.in[6] + (size_t)l * DM * DIN, DIN, (bf16_t*)(wl + LW_IN), DM, nullptr, 1, scr, r, 96, lane); continue; } r -= I_IN;
        if (r < 4 * I_G) { wconv_item(F.in[21] + (size_t)l * 4 * DM * DM, DM, (bf16_t*)(wl + LW_G), DM, nullptr, 3, scr, r, 128, lane, true); continue; } r -= 4 * I_G;
        if (r < I_BA) { wconv_item(F.in[17] + (size_t)l * 256 * DM, DM, (bf16_t*)(wl + LW_BR + BR_A), 256, nullptr, 4, scr, r, 32, lane); continue; } r -= I_BA;
        if (r < I_BB) { wconv_item(F.in[18] + (size_t)l * 128 * DM, DM, (bf16_t*)(wl + LW_BR + BR_B), 128, nullptr, 4, scr, r, 32, lane); continue; } r -= I_BB;
        if (r < I_BA) { wconv_item(F.in[19] + (size_t)l * 256 * DM, DM, (bf16_t*)(wl + LW_BR + BR_C), 256, nullptr, 4, scr, r, 32, lane); continue; } r -= I_BA;
        if (r < I_BA) { wconv_item(F.in[20] + (size_t)l * 256 * DM, DM, (bf16_t*)(wl + LW_BR + BR_D), 256, nullptr, 4, scr, r, 32, lane); continue; } r -= I_BA;
        if (r < I_O) { wconv_item(F.in[22] + (size_t)l * DM * DM, DM, (bf16_t*)(wl + LW_O), DM, nullptr, 0, scr, r, 32, lane); continue; } r -= I_O;
        if (r < I_UP) { wconv_item(F.in[23] + (size_t)l * DM * DFF2, DFF2, (bf16_t*)(wl + LW_UP), DM, nullptr, 5, scr, r, 176, lane); continue; } r -= I_UP;
        if (r < I_DN) { wconv_item(F.in[26] + (size_t)l * DFF * DM, DM, (bf16_t*)(wl + LW_DN), DFF, nullptr, 0, scr, r, 32, lane); continue; } r -= I_DN;
        if (r < I_UQ) { wconv_item(F.in[15] + (size_t)l * 256 * 384, 384, (bf16_t*)(wl + LW_UQ), 256, F.in[13] + l * 256, 2, scr, r, 16, lane); continue; } r -= I_UQ;
        if (r < I_UKV) { wconv_item(F.in[16] + (size_t)l * 128 * 512, 512, (bf16_t*)(wl + LW_UKV), 128, F.in[14] + l * 128, 0, scr, r, 16, lane); continue; } r -= I_UKV;
        if (r < I_PHI) { wconv_item(F.in[8] + (size_t)l * 2048 * 128, 128, (bf16_t*)(wl + LW_PHI), 2048, nullptr, 0, scr, r, 4, lane); continue; } r -= I_PHI;
        wconv_item(F.in[10] + (size_t)l * 2048 * 128, 128, (bf16_t*)(wl + LW_PHI) + (size_t)128 * 2048, 2048, nullptr, 0, scr, r, 4, lane);
    }
    const int gt = blockIdx.x * 512 + F.tid, NGT = F.G * 512;
    const float* rel = F.in[1];
    float* rope = WSP(float, WS_ROPE);
    for (int i = gt; i < SEQ * 16; i += NGT) { const int t = i >> 4, k = i & 15; const float inv = powf(10000.0f, -(float)(2 * k) / 32.0f); const float ang = (float)t * inv;
        float sn, cs; sincosf(ang, &sn, &cs); rope[2 * i] = cs; rope[2 * i + 1] = sn; }
    float* ntab = WSP(float, WS_NSATAB);
    for (int i = gt; i < 4 * NSA_TL; i += NGT) { const int hd = i / NSA_TL, k = i % NSA_TL, dist = NSA_DMAX - k; ntab[i] = dist >= 0 ? rel[rel_bucket(dist) * 10 + hd] * LOG2E : 0.f; }
    float* dtab = WSP(float, WS_DILTAB);
    for (int i = gt; i < 6 * 192; i += NGT) { const int gh = i / 192, k = i % 192, g = gh >> 1, hh = gh & 1, j = 160 - k; dtab[i] = (j >= 0 && j <= 128) ? rel[rel_bucket(j << (2 * g)) * 10 + 4 + 2 * g + hh] * LOG2E : 0.f; }
    if (gt < 4) WSP(float, WS_FARB)[gt] = rel[31 * 10 + gt] * LOG2E;
    if (gw < 128) { const int mi = gw >> 5, pc = gw & 31, l = mi >> 1; const float *pk1 = F.in[8], *pv1 = F.in[10]; asm volatile("" : "+s"(pk1), "+s"(pv1));
        const float* w1 = ((mi & 1) ? pv1 : pk1) + (size_t)l * 2048 * 128 + (size_t)(64 * pc) * 128 + 2 * lane; const float* cp = F.in[7] + (size_t)l * 2048 + 64 * pc;
        f32x2 a = {0.f, 0.f};
#pragma unroll 8
        for (int p = 0; p < 64; ++p) { const f32x2 w = *(const f32x2*)(w1 + (size_t)p * 128); const float cpp = cp[p]; a[0] += cpp * w[0]; a[1] += cpp * w[1]; }
        *(f32x2*)(WSP(float, WS_CMPP) + ((size_t)mi * 32 + pc) * 128 + 2 * lane) = a; }
    if (gt < ATT_UNITS) WSP(int, WS_ORDER)[att_rank(gt)] = gt;
}
__device__ __forceinline__ void cmpb_reduce(Frame& F) {
    const int i = F.tid; if (i < DEPTH * 256) { const int l = i >> 8, n = i & 255, mi = l * 2 + (n >> 7); const float* pp = WSP(const float, WS_CMPP) + (size_t)mi * 32 * 128 + (n & 127); float a = 0.f;
        for (int pc = 0; pc < 32; ++pc) a += pp[pc * 128]; WSP(float, WS_CMPB)[i] = a; }
}

template <int MODE, bool XIB, bool XOB, bool H8 = false> __device__ __forceinline__ void rowpass(Frame& F, const void* x, const bf16_t* y, size_t yrow0, void* xout, bf16_t* hout, const float* g1, const float* g2, int row_lo, int row_hi, unsigned char* h8out = nullptr) {
    int gw = blockIdx.x * 8 + F.wave; asm volatile("" : "+s"(gw));
    const int NGW = F.G * 8, lane = F.lane;
    f32x4 ga[4], gb[4];
#pragma unroll
    for (int j = 0; j < 4; ++j) { ga[j] = *(const f32x4*)(g1 + 4 * lane + 256 * j); if (MODE == 1) gb[j] = *(const f32x4*)(g2 + 4 * lane + 256 * j); }
    f32x4 xf[4], xfn[4]; u32x2 xb[4], xbn[4], yb[4], ybn[4];
#define RP_LOAD(XF, XB, YB, mm) do { if (XIB) { const u32x2* xr_ = (const u32x2*)((const bf16_t*)x + (size_t)(mm) * DM) + lane; _Pragma("unroll") for (int j = 0; j < 4; ++j) XB[j] = xr_[64 * j]; } \
        else { const f32x4* xr_ = (const f32x4*)((const float*)x + (size_t)(mm) * DM) + lane; _Pragma("unroll") for (int j = 0; j < 4; ++j) XF[j] = xr_[64 * j]; } \
        if (MODE != 0) { const u32x2* yr_ = (const u32x2*)(y + ((size_t)(mm) - yrow0) * DM) + lane; _Pragma("unroll") for (int j = 0; j < 4; ++j) YB[j] = yr_[64 * j]; } } while (0)
    int m = row_lo + gw;
    if (m < row_hi) RP_LOAD(xf, xb, yb, m);
    for (; m < row_hi; m += NGW) {
        const int mn = m + NGW;
        if (mn < row_hi) RP_LOAD(xfn, xbn, ybn, mn);
        f32x4 v[4];
#pragma unroll
        for (int j = 0; j < 4; ++j) { if (XIB) { v[j][0] = __uint_as_float(xb[j].x << 16); v[j][1] = __uint_as_float(xb[j].x & 0xffff0000u); v[j][2] = __uint_as_float(xb[j].y << 16); v[j][3] = __uint_as_float(xb[j].y & 0xffff0000u); } else v[j] = xf[j]; }
        if (MODE != 0) {
            f32x4 w[4]; float s = 0.f;
#pragma unroll
            for (int j = 0; j < 4; ++j) { const u32x2 yy = yb[j]; w[j][0] = __uint_as_float(yy.x << 16); w[j][1] = __uint_as_float(yy.x & 0xffff0000u); w[j][2] = __uint_as_float(yy.y << 16); w[j][3] = __uint_as_float(yy.y & 0xffff0000u);
                s += (w[j][0] * w[j][0] + w[j][1] * w[j][1]) + (w[j][2] * w[j][2] + w[j][3] * w[j][3]); }
            const float rstd = 1.0f / sqrtf(wave_sum(s) * (1.0f / DM) + RMS_EPS);
#pragma unroll
            for (int j = 0; j < 4; ++j) v[j] = v[j] + w[j] * rstd * ga[j];
            if (XOB) { u32x2* xo = (u32x2*)((bf16_t*)xout + (size_t)m * DM) + lane;
#pragma unroll
                for (int j = 0; j < 4; ++j) { u32x2 w2; w2.x = cvtpk(v[j][0], v[j][1]); w2.y = cvtpk(v[j][2], v[j][3]); xo[64 * j] = w2; } }
            else { f32x4* xo = (f32x4*)((float*)xout + (size_t)m * DM) + lane;
#pragma unroll
                for (int j = 0; j < 4; ++j) xo[64 * j] = v[j]; }
        }
        if (MODE != 2) {
            float s = 0.f;
#pragma unroll
            for (int j = 0; j < 4; ++j) s += (v[j][0] * v[j][0] + v[j][1] * v[j][1]) + (v[j][2] * v[j][2] + v[j][3] * v[j][3]);
            const float rstd = 1.0f / sqrtf(wave_sum(s) * (1.0f / DM) + RMS_EPS);
            u32x2* ho = (u32x2*)(hout + (size_t)m * DM) + lane;
#pragma unroll
            for (int j = 0; j < 4; ++j) { const f32x4 gg = (MODE == 1) ? gb[j] : ga[j]; const f32x4 o = v[j] * rstd * gg; u32x2 w; w.x = cvtpk(o[0], o[1]); w.y = cvtpk(o[2], o[3]); ho[64 * j] = w;
                if (H8) ((unsigned*)(h8out + (size_t)m * DM))[lane + 64 * j] = pk4_fp8(o[0] * H8_SCALE, o[1] * H8_SCALE, o[2] * H8_SCALE, o[3] * H8_SCALE); }
        }
#pragma unroll
        for (int j = 0; j < 4; ++j) { if (XIB) xb[j] = xbn[j]; else xf[j] = xfn[j]; if (MODE != 0) yb[j] = ybn[j]; }
    }
#undef RP_LOAD
}

__device__ __forceinline__ void ffn_fix_panel(Frame& F, int pm, const float* HB, bf16_t* ACT, const float* cw, const float* cb) {
#pragma unroll 2
    for (int it = F.tid; it < 4 * 2 * (DFF / 4); it += 512) {
        const int c4 = it % (DFF / 4), rr = (it / (DFF / 4)) & 1, g = pm * 4 + it / (2 * (DFF / 4)), c = c4 * 4, pn = c >> 7, cl = c & 127;
        const bool first = ((g * 64) & (SEQ - 1)) == 0;
#define HBV(gg, s, bj) (*(const f32x4*)(HB + ((size_t)(((gg) * 4 + (s)) * 22 + pn) * 256 + (bj) * 128 + cl)))
        const f32x4 z = {0.f, 0.f, 0.f, 0.f};
        const f32x4 u0g = HBV(g, 0, 0), u0v = HBV(g, 0, 1);
        f32x4 ag, bg_, cg, av, bv_, cv;
        if (rr == 0) { ag = first ? z : HBV(g - 1, 2, 0); bg_ = first ? z : HBV(g - 1, 3, 0); cg = u0g; av = first ? z : HBV(g - 1, 2, 1); bv_ = first ? z : HBV(g - 1, 3, 1); cv = u0v; }
        else { ag = first ? z : HBV(g - 1, 3, 0); bg_ = u0g; cg = HBV(g, 1, 0); av = first ? z : HBV(g - 1, 3, 1); bv_ = u0v; cv = HBV(g, 1, 1); }
#undef HBV
        const f32x4 kb = *(const f32x4*)(cb + c), k0 = *(const f32x4*)(cw + c), k1 = *(const f32x4*)(cw + DFF2 + c), k2 = *(const f32x4*)(cw + 2 * DFF2 + c);
        const f32x4 vb = *(const f32x4*)(cb + DFF + c), v0 = *(const f32x4*)(cw + DFF + c), v1 = *(const f32x4*)(cw + DFF2 + DFF + c), v2 = *(const f32x4*)(cw + 2 * DFF2 + DFF + c);
        float o[4];
#pragma unroll
        for (int e = 0; e < 4; ++e) { const float gt = kb[e] + k0[e] * ag[e] + k1[e] * bg_[e] + k2[e] * cg[e], vl = vb[e] + v0[e] * av[e] + v1[e] * bv_[e] + v2[e] * cv[e]; o[e] = gt * sigmoid_f(gt) * vl; }
        u32x2 w; w.x = cvtpk(o[0], o[1]); w.y = cvtpk(o[2], o[3]);
        *(u32x2*)(ACT + (size_t)(g * 64 + rr) * DFF + c) = w;
    }
}
#ifdef SELFCHECK
constexpr int CW_CHK = 20480;
__device__ __forceinline__ unsigned chk_hash(unsigned x) { x ^= x >> 16; x *= 0x7feb352du; x ^= x >> 15; x *= 0x846ca68bu; x ^= x >> 16; return x; }
__device__ __forceinline__ int chk_t(int i) {
    int r = 0;
    switch (i & 31) { case 0: r = 0; break; case 1: r = 1; break; case 2: r = 15; break; case 3: r = 16; break; case 4: r = 30; break; case 5: r = 31; break; case 6: r = 32; break; case 7: r = 47; break;
        case 8: r = 63; break; case 9: r = 64; break; case 10: r = 65; break; case 11: r = 127; break; case 12: r = 128; break; case 13: r = 129; break; case 14: r = 255; break; case 15: r = 256; break;
        case 16: r = 257; break; case 17: r = 511; break; case 18: r = 512; break; case 19: r = 513; break; case 20: r = 575; break; case 21: r = 1023; break; case 22: r = 1024; break; case 23: r = 1599; break;
        case 24: r = 1600; break; case 25: r = 2047; break; case 26: r = 2048; break; case 27: r = 2111; break; case 28: r = 3000; break; case 29: r = 4031; break; case 30: r = 4032; break; default: r = 4095; break; }
    return (i < 64) ? r : (int)(chk_hash(i * 7919u + 13u) & 4095u);
}
__device__ __forceinline__ bool chk_bad(float got, float ref, float scale) { const float d = fabsf(got - ref); return !(d <= 0.02f * fabsf(ref) + 0.02f * scale); }
__device__ __forceinline__ float bfr(float x) { return bf2f((unsigned short)f2bf(x)); }
__device__ __forceinline__ void chk_flag(Frame& F, int bit, bool bad, int allow) {
    LAS unsigned* cnt = (LAS unsigned*)(F.lds + 65536);
    __syncthreads(); if (threadIdx.x == 0) *cnt = 0u; __syncthreads();
    if (bad) atomicAdd((unsigned*)cnt, 1u);
    __syncthreads();
    if (threadIdx.x == 0 && *cnt > (unsigned)allow) atomicOr((unsigned*)(F.ctl + CW_CHK), 1u << bit);
    __syncthreads();
}
__device__ __forceinline__ int chk_bucket_ref(int dist) {
    if (dist < 0) dist = 0; if (dist < 16) return dist;
    const float d = (float)dist; int large = 16 + (int)(logf(d / 16.0f) / 4.852030263919617f * 16.0f); return large < 31 ? large : 31;
}
__device__ __forceinline__ bool chk_fox(Frame& F, int b, int h, int t) {
    const bf16_t* P = WSP(const bf16_t, WS_P);
    { const size_t row = (size_t)b * SEQ + t; const bf16_t* q = P + row * PW + PC_CQ + h * 64; const float* kb = WSP(const float, WS_KB) + ((size_t)b * 4 + h) * SEQ;
      float m = -INFINITY; for (int j = 0; j <= t; ++j) { const bf16_t* k = P + ((size_t)b * SEQ + j) * PW + PC_CK + h * 64; float s = 0.f; for (int d = 0; d < 64; ++d) s += bf2f(q[d]) * bf2f(k[d]); s += kb[j]; m = fmaxf(m, s); }
      float lsum = 0.f, dummy0_ = 0.f; f32x4 o = {0.f, 0.f, 0.f, 0.f};
      for (int j = 0; j <= t; ++j) { const bf16_t* k = P + ((size_t)b * SEQ + j) * PW + PC_CK + h * 64; const bf16_t* v = P + ((size_t)b * SEQ + j) * PW + PC_CV + h * 64; float s = 0.f; for (int d = 0; d < 64; ++d) s += bf2f(q[d]) * bf2f(k[d]); s += kb[j];
          const float p = exp2f(s - m); lsum += p; _Pragma("unroll") for (int e = 0; e < 4; ++e) o[e] += p * bf2f(v[21 * e]); }
      bool bad = false; _Pragma("unroll") for (int e = 0; e < 4; ++e) bad |= chk_bad(bf2f(WSP(const bf16_t, WS_OCAT)[row * OCW + 384 + h * 64 + 21 * e]), o[e] / lsum, 0.5f);
      return bad; }
}
__device__ __forceinline__ bool chk_dil(Frame& F, int b, int hh, int t) {
    const bf16_t* P = WSP(const bf16_t, WS_P); const float* rel = F.in[1];
    { const size_t row = (size_t)b * SEQ + t;
      float m = -INFINITY;
      for (int g = 0; g < 3; ++g) { const int dil = 1 << (2 * g), head = 2 * g + hh; const bf16_t* q = P + row * PW + PC_BQ + head * 64;
          for (int j = 0; j <= 128; ++j) { const int idx = t - dil * j; if (idx < 0) break; const bf16_t* k = P + ((size_t)b * SEQ + idx) * PW + PC_BK + head * 64; float s = 0.f; for (int d = 0; d < 64; ++d) s += bf2f(q[d]) * bf2f(k[d]);
              s += rel[chk_bucket_ref(dil * j) * 10 + 4 + head] * LOG2E; m = fmaxf(m, s); } }
      float lsum = 0.f, dummy0_ = 0.f; f32x4 o = {0.f, 0.f, 0.f, 0.f};
      for (int g = 0; g < 3; ++g) { const int dil = 1 << (2 * g), head = 2 * g + hh; const bf16_t* q = P + row * PW + PC_BQ + head * 64;
          for (int j = 0; j <= 128; ++j) { const int idx = t - dil * j; if (idx < 0) break; const bf16_t* k = P + ((size_t)b * SEQ + idx) * PW + PC_BK + head * 64; const bf16_t* v = P + ((size_t)b * SEQ + idx) * PW + PC_BV + head * 64; float s = 0.f; for (int d = 0; d < 64; ++d) s += bf2f(q[d]) * bf2f(k[d]);
              s += rel[chk_bucket_ref(dil * j) * 10 + 4 + head] * LOG2E; const float p = exp2f(s - m); lsum += p; _Pragma("unroll") for (int e = 0; e < 4; ++e) o[e] += p * bf2f(v[21 * e]); } }
      bool bad = false; _Pragma("unroll") for (int e = 0; e < 4; ++e) bad |= chk_bad(bf2f(WSP(const bf16_t, WS_OCAT)[row * OCW + 256 + hh * 64 + 21 * e]), o[e] / lsum, 0.5f);
      return bad; }
}
__device__ __forceinline__ bool chk_nsa(Frame& F, int b, int h, int t, int i) {
    const bf16_t* P = WSP(const bf16_t, WS_P); const float* rel = F.in[1];
    { bool bad = false;
      { const size_t row = (size_t)b * SEQ + t; const size_t rb = (size_t)b * SEQ;
      const bf16_t* KC = WSP(const bf16_t, WS_KC) + (size_t)b * 256 * 64; const bf16_t* VC = WSP(const bf16_t, WS_VC) + (size_t)b * 256 * 64;
      const int cmax = (t >= 31) ? (t - 31) / 16 : -1, cur = t >> 6;
      LAS float* imp = (LAS float*)(F.lds + 70000) + i * 65; for (int j = 0; j < 64; ++j) imp[j] = 0.f;
      f32x4 oc = {0.f, 0.f, 0.f, 0.f};
      for (int hh = 0; hh < 4; ++hh) { const bf16_t* q = P + row * PW + PC_AQ + hh * 64; float m = -INFINITY;
          for (int c = 0; c <= cmax; ++c) { float s = 0.f; for (int d = 0; d < 64; ++d) s += bf2f(q[d]) * bf2f(KC[c * 64 + d]); m = fmaxf(m, s); }
          float ls = 0.f; for (int c = 0; c <= cmax; ++c) { float s = 0.f; for (int d = 0; d < 64; ++d) s += bf2f(q[d]) * bf2f(KC[c * 64 + d]); ls += exp2f(s - m); }
          for (int c = 0; c <= cmax; ++c) { float s = 0.f; for (int d = 0; d < 64; ++d) s += bf2f(q[d]) * bf2f(KC[c * 64 + d]); const float p = exp2f(s - m) / ls;
              for (int j = 0; j < 64; ++j) if (16 * c <= 64 * j + 63 && 16 * c + 31 >= 64 * j) imp[j] += p;
              if (hh == h) _Pragma("unroll") for (int e = 0; e < 4; ++e) oc[e] += p * bf2f(VC[c * 64 + 21 * e]); } }
      for (int j = 0; j < 64; ++j) imp[j] = (j == 0 || j == cur || j == cur - 1) ? 1e9f : (j > cur ? -1e9f : imp[j]);
      unsigned long long selm = 0ull;
      for (int j = 0; j < 64; ++j) { int rank = 0; for (int k = 0; k < 64; ++k) rank += (imp[k] > imp[j] || (imp[k] == imp[j] && k < j)) ? 1 : 0; if (rank < 16) selm |= 1ull << j; }
      const bf16_t* q = P + row * PW + PC_AQ + h * 64;
      f32x4 os = {0.f, 0.f, 0.f, 0.f}, ow = {0.f, 0.f, 0.f, 0.f};
      { float m = -INFINITY; for (int pos = 0; pos <= t; ++pos) { if (!((selm >> (pos >> 6)) & 1ull)) continue; const bf16_t* k = P + (rb + pos) * PW + PC_KSLC; float s = 0.f; for (int d = 0; d < 64; ++d) s += bf2f(q[d]) * bf2f(k[d]); s += rel[chk_bucket_ref(t - pos) * 10 + h] * LOG2E; m = fmaxf(m, s); }
        float ls = 0.f; for (int pos = 0; pos <= t; ++pos) { if (!((selm >> (pos >> 6)) & 1ull)) continue; const bf16_t* k = P + (rb + pos) * PW + PC_KSLC; const bf16_t* v = P + (rb + pos) * PW + PC_VSLC; float s = 0.f; for (int d = 0; d < 64; ++d) s += bf2f(q[d]) * bf2f(k[d]); s += rel[chk_bucket_ref(t - pos) * 10 + h] * LOG2E;
            const float p = exp2f(s - m); ls += p; _Pragma("unroll") for (int e = 0; e < 4; ++e) os[e] += p * bf2f(v[21 * e]); }
        _Pragma("unroll") for (int e = 0; e < 4; ++e) os[e] /= ls; }
      { const int lo = t - 511 > 0 ? t - 511 : 0; float m = -INFINITY; for (int pos = lo; pos <= t; ++pos) { const bf16_t* k = P + (rb + pos) * PW + PC_KWIN; float s = 0.f; for (int d = 0; d < 64; ++d) s += bf2f(q[d]) * bf2f(k[d]); s += rel[chk_bucket_ref(t - pos) * 10 + h] * LOG2E; m = fmaxf(m, s); }
        float ls = 0.f; for (int pos = lo; pos <= t; ++pos) { const bf16_t* k = P + (rb + pos) * PW + PC_KWIN; const bf16_t* v = P + (rb + pos) * PW + PC_VWIN; float s = 0.f; for (int d = 0; d < 64; ++d) s += bf2f(q[d]) * bf2f(k[d]); s += rel[chk_bucket_ref(t - pos) * 10 + h] * LOG2E;
            const float p = exp2f(s - m); ls += p; _Pragma("unroll") for (int e = 0; e < 4; ++e) ow[e] += p * bf2f(v[21 * e]); }
        _Pragma("unroll") for (int e = 0; e < 4; ++e) ow[e] /= ls; }
      const float* sd = WSP(const float, WS_SIDE) + row * 16 + h * 3; const float g0 = 1.f / (1.f + expf(-sd[0])), g1 = 1.f / (1.f + expf(-sd[1])), g2 = 1.f / (1.f + expf(-sd[2]));
      _Pragma("unroll") for (int e = 0; e < 4; ++e) bad |= chk_bad(bf2f(WSP(const bf16_t, WS_OCAT)[row * OCW + h * 64 + 21 * e]), g0 * oc[e] + g1 * os[e] + g2 * ow[e], 0.3f); }
      return bad; }
}
__device__ __forceinline__ void selfcheck_a(Frame& F, int l) {
    const int i = threadIdx.x;
    const float* x = F.in[0];
    const bf16_t* H = WSP(const bf16_t, WS_H); const bf16_t* P = WSP(const bf16_t, WS_P);
    const float* rel = F.in[1];
    { const int row = (int)(chk_hash(i) % M), col = (int)(chk_hash(i + 999) & 1023); float s = 0.f; for (int k = 0; k < DM; ++k) { const float v = x[(size_t)row * DM + k]; s += v * v; }
      const float ref = x[(size_t)row * DM + col] * (1.0f / sqrtf(s / DM + RMS_EPS)) * F.in[2][l * DM + col];
      chk_flag(F, 0, chk_bad(bf2f(H[(size_t)row * DM + col]), ref, 1.0f), 0); }
    { const int row = (int)(chk_hash(i + 5) % M); int c = (i * 37 + 5) % PW; if (i < 32) c = 640 + (i & 15); else if (i < 96) c = 672 + (i & 31); else if (i < 160) c = 256 + ((i * 3) & 127);
      const float* W = F.in[6] + (size_t)l * DM * DIN; bool bad = false;
#define DOTC(dst, cc) do { float sc_; const int src_ = inproj_src((cc), sc_); float a_ = 0.f; if (src_ >= 0) for (int k = 0; k < DM; ++k) a_ += bf2f(H[(size_t)row * DM + k]) * bfr(W[(size_t)k * DIN + src_] * sc_); dst = a_; } while (0)
      float ref; DOTC(ref, c);
      if (c >= 672 && c < 704) { const int p = c - 672, ip = p >> 1; float oth; DOTC(oth, c ^ 1); const float x1 = (p & 1) ? oth : ref, x2 = (p & 1) ? ref : oth;
          const float inv = powf(10000.0f, -(float)(2 * ip) / 32.0f), ang = (float)(row & (SEQ - 1)) * inv, cs = cosf(ang), sn = sinf(ang);
          ref = (p & 1) ? (x2 * cs + x1 * sn) : (x1 * cs - x2 * sn);
          bad |= chk_bad(bf2f(WSP(const bf16_t, WS_KROT)[(size_t)row * 32 + p]), ref, 1.0f); }
      bad |= chk_bad(bf2f(P[(size_t)row * PW + c]), ref, 1.0f);
      if (c >= 640 && c < 656) bad |= chk_bad(WSP(const float, WS_SIDE)[(size_t)row * 16 + (c - 640)], ref, 1.0f);
      if (c >= 256 && c < 320) bad |= chk_bad(bf2f(WSP(const bf16_t, WS_KCMP)[(size_t)row * 64 + (c - 256)]), ref, 1.0f);
      if (c >= 320 && c < 384) bad |= chk_bad(bf2f(WSP(const bf16_t, WS_VCMP)[(size_t)row * 64 + (c - 320)]), ref, 1.0f);
      if (i >= 160 && i < 192) { float sq = 0.f, skv = 0.f; for (int k = 0; k < 256; ++k) { const float v = bf2f(P[(size_t)row * PW + PC_DQL + k]); sq += v * v; } for (int k = 0; k < 128; ++k) { const float v = bf2f(P[(size_t)row * PW + PC_DKV + k]); skv += v * v; }
          const float* a = WSP(const float, WS_SSQQ) + (size_t)row * 4; const float* b = WSP(const float, WS_SSQKV) + (size_t)row * 4;
          bad |= chk_bad(a[0] + a[1] + a[2] + a[3], sq, 10.f) || chk_bad(b[0] + b[1] + b[2] + b[3], skv, 5.f); }
      chk_flag(F, 1, bad, 0); }
    { const int b = i & 15, h = (i >> 4) & 3, t = chk_t(i >> 6); float a = 0.f; for (int j = 0; j <= t; ++j) { const float xx = WSP(const float, WS_SIDE)[((size_t)b * SEQ + j) * 16 + 12 + h] + F.in[12][l * 4 + h]; a += (xx >= 0.f) ? -log1pf(expf(-xx)) : (xx - log1pf(expf(xx))); }
      chk_flag(F, 2, chk_bad(WSP(const float, WS_KB)[((size_t)b * 4 + h) * SEQ + t], -a * LOG2E, 1.0f + fabsf(a) * 0.05f), 0); }
    chk_flag(F, 3, chk_fox(F, (i * 5) & 15, i & 3, chk_t(i >> 2)), 0);
    { const int row = (int)(chk_hash(i + 77) % M); bool bad = false;
      float sq = 0.f, skv = 0.f; for (int k = 0; k < 256; ++k) { const float v = bf2f(P[(size_t)row * PW + PC_DQL + k]); sq += v * v; } for (int k = 0; k < 128; ++k) { const float v = bf2f(P[(size_t)row * PW + PC_DKV + k]); skv += v * v; }
      const float rq = 1.0f / sqrtf(sq / 256.0f + RMS_EPS), rkv = 1.0f / sqrtf(skv / 128.0f + RMS_EPS);
      const float* wq = F.in[15] + (size_t)l * 256 * 384; const float* gq = F.in[13] + l * 256; const float* wkv = F.in[16] + (size_t)l * 128 * 512; const float* gkv = F.in[14] + l * 128;
#define QDOT(dst, src) do { float a_ = 0.f; for (int k = 0; k < 256; ++k) a_ += bf2f(P[(size_t)row * PW + PC_DQL + k]) * bfr(wq[(size_t)k * 384 + (src)] * C2D * gq[k]); dst = a_ * rq; } while (0)
      const int r = (i * 11) % 384, hd = r / 96, w = r % 96; float ref;
      if (w < 64) QDOT(ref, hd * 96 + w);
      else { const int p = w - 64, ip = p >> 1; float x1, x2; QDOT(x1, hd * 96 + 64 + ip); QDOT(x2, hd * 96 + 64 + 16 + ip); const float inv = powf(10000.0f, -(float)(2 * ip) / 32.0f), ang = (float)(row & (SEQ - 1)) * inv, cs = cosf(ang), sn = sinf(ang);
          ref = (p & 1) ? (x2 * cs + x1 * sn) : (x1 * cs - x2 * sn); }
      bad |= chk_bad(bf2f(WSP(const bf16_t, WS_QM)[(size_t)row * 512 + r]), ref, 1.5f);
      { const int c = (i * 13) & 511; float a = 0.f; for (int k = 0; k < 128; ++k) a += bf2f(P[(size_t)row * PW + PC_DKV + k]) * bfr(wkv[(size_t)k * 512 + c] * gkv[k]); bad |= chk_bad(bf2f(WSP(const bf16_t, WS_KVM)[(size_t)row * 512 + c]), a * rkv, 1.0f); }
      chk_flag(F, 4, bad, 0); }
    { const int b = (i * 3) & 15, h = i & 3, t = chk_t(i >> 2); const size_t row = (size_t)b * SEQ + t; const bf16_t* q = WSP(const bf16_t, WS_QM) + row * 512 + h * 96; const bf16_t* KV = WSP(const bf16_t, WS_KVM); const bf16_t* KR = WSP(const bf16_t, WS_KROT);
      float m = -INFINITY; for (int j = 0; j <= t; ++j) { const size_t rj = (size_t)b * SEQ + j; float s = 0.f; for (int d = 0; d < 64; ++d) s += bf2f(q[d]) * bf2f(KV[rj * 512 + h * 128 + d]); for (int d = 0; d < 32; ++d) s += bf2f(q[64 + d]) * bf2f(KR[rj * 32 + d]); m = fmaxf(m, s); }
      float lsum = 0.f, dummy0_ = 0.f; f32x4 o = {0.f, 0.f, 0.f, 0.f};
      for (int j = 0; j <= t; ++j) { const size_t rj = (size_t)b * SEQ + j; float s = 0.f; for (int d = 0; d < 64; ++d) s += bf2f(q[d]) * bf2f(KV[rj * 512 + h * 128 + d]); for (int d = 0; d < 32; ++d) s += bf2f(q[64 + d]) * bf2f(KR[rj * 32 + d]);
          const float p = exp2f(s - m); lsum += p; _Pragma("unroll") for (int e = 0; e < 4; ++e) o[e] += p * bf2f(KV[rj * 512 + h * 128 + 64 + 21 * e]); }
      bool bad = false; _Pragma("unroll") for (int e = 0; e < 4; ++e) bad |= chk_bad(bf2f(WSP(const bf16_t, WS_OCAT)[row * OCW + 640 + h * 64 + 21 * e]), o[e] / lsum, 0.5f);
      chk_flag(F, 5, bad, 0); }
    chk_flag(F, 6, chk_dil(F, (i * 7) & 15, i & 1, chk_t(i >> 1)), 0);
    { const int b = i & 15, which = (i >> 4) & 1, c = (int)(chk_hash(i + 31) % 255), d = (i * 5) & 63; const bf16_t* src = (which ? WSP(const bf16_t, WS_VCMP) : WSP(const bf16_t, WS_KCMP)) + ((size_t)b * SEQ + 16 * c) * 64;
      const float *pk1 = F.in[8], *pv1 = F.in[10], *pk2 = F.in[9], *pv2 = F.in[11]; asm volatile("" : "+s"(pk1), "+s"(pv1), "+s"(pk2), "+s"(pv2));
      const float* w1 = (which ? pv1 : pk1) + (size_t)l * 2048 * 128; const float* w2 = (which ? pv2 : pk2) + (size_t)l * 128 * 64; const float* cp = F.in[7] + (size_t)l * 2048;
      float out = 0.f;
      for (int n = 0; n < 128; ++n) { float a = 0.f, bsum = 0.f; for (int p = 0; p < 2048; ++p) { a += bf2f(src[p]) * bfr(w1[(size_t)p * 128 + n]); bsum += cp[p] * w1[(size_t)p * 128 + n]; }
          const float xx = a + bsum, g = 0.5f * xx * (1.0f + tanhf(0.7978845608028654f * (xx + 0.044715f * xx * xx * xx))); out += bfr(g) * w2[n * 64 + d]; }
      chk_flag(F, 7, chk_bad(bf2f((which ? WSP(const bf16_t, WS_VC) : WSP(const bf16_t, WS_KC))[((size_t)b * 256 + c) * 64 + d]), out, 0.5f), 0); }
    { bool bad = false; if (i < 128) bad = chk_nsa(F, (i * 9) & 15, i & 3, chk_t(i >> 2), i); chk_flag(F, 8, bad, 4); }
}
__device__ __forceinline__ void selfcheck_b(Frame& F, int l) {
    const int i = threadIdx.x; const int row = (int)(chk_hash(i + 3) % M), n = (i * 29 + 7) & 1023;
    const bf16_t* H = WSP(const bf16_t, WS_H); const bf16_t* OC = WSP(const bf16_t, WS_OCAT);
    float acc = 0.f;
    for (int br = 0; br < 4; ++br) { const float* wg = F.in[21] + ((size_t)l * 4 + br) * DM * DM; float g = 0.f; for (int k = 0; k < DM; ++k) g += bf2f(H[(size_t)row * DM + k]) * bfr(wg[(size_t)k * DM + n]);
        const int kk = (br == 1) ? 128 : 256, co = (br == 0) ? 0 : (br == 1 ? 256 : (br == 2 ? 384 : 640)); const float *pb0 = F.in[17], *pb1 = F.in[18], *pb2 = F.in[19], *pb3 = F.in[20]; asm volatile("" : "+s"(pb0), "+s"(pb1), "+s"(pb2), "+s"(pb3)); const float* wb = (br == 0 ? pb0 : (br == 1 ? pb1 : (br == 2 ? pb2 : pb3))) + (size_t)l * kk * DM; float t = 0.f; for (int k = 0; k < kk; ++k) t += bf2f(OC[(size_t)row * OCW + co + k]) * bfr(wb[(size_t)k * DM + n]);
        acc += (1.f / (1.f + expf(-g))) * bfr(t); }
    chk_flag(F, 9, chk_bad(bf2f(WSP(const bf16_t, WS_MERGED)[(size_t)row * DM + n]), acc, 0.5f), 0);
}
__device__ __forceinline__ void selfcheck_c(Frame& F, int l, const float* xin) {
    const int i = threadIdx.x; const int row = (int)(chk_hash(i + 11) % M), n = (i * 29 + 7) & 1023;
    const bf16_t* MG = WSP(const bf16_t, WS_MERGED); const float* wo = F.in[22] + (size_t)l * DM * DM; const float* Y = WSP(const float, WS_Y);
    float a = 0.f; for (int k = 0; k < DM; ++k) a += bf2f(MG[(size_t)row * DM + k]) * bfr(wo[(size_t)k * DM + n]);
    chk_flag(F, 0, chk_bad(Y[(size_t)row * DM + n], a, 1.0f), 0);
    float s = 0.f; for (int k = 0; k < DM; ++k) { const float v = Y[(size_t)row * DM + k]; s += v * v; }
    const float rstd = 1.0f / sqrtf(s / DM + RMS_EPS); float s2 = 0.f;
    for (int k = 0; k < DM; ++k) { const float v = xin[(size_t)row * DM + k] + Y[(size_t)row * DM + k] * rstd * F.in[3][l * DM + k]; s2 += v * v; }
    const float x1 = xin[(size_t)row * DM + n] + Y[(size_t)row * DM + n] * rstd * F.in[3][l * DM + n];
    const float h2 = x1 * (1.0f / sqrtf(s2 / DM + RMS_EPS)) * F.in[4][l * DM + n];
    chk_flag(F, 1, chk_bad(F.out[(size_t)row * DM + n], x1, 1.0f) || chk_bad(bf2f(WSP(const bf16_t, WS_H2)[(size_t)row * DM + n]), h2, 1.0f), 0);
}
__device__ __forceinline__ void selfcheck_d(Frame& F, int l) {
    const int i = threadIdx.x; const int row = (int)(chk_hash(i + 17) % (M / 2)); const bf16_t* H2 = WSP(const bf16_t, WS_H2); const bf16_t* U = WSP(const bf16_t, WS_U); const bf16_t* A = WSP(const bf16_t, WS_ACT);
    { const int c = (i * 41 + 3) % DFF2; const float* wu = F.in[23] + (size_t)l * DM * DFF2; float a = 0.f; for (int k = 0; k < DM; ++k) a += bf2f(H2[(size_t)row * DM + k]) * bfr(wu[(size_t)k * DFF2 + c]);
      chk_flag(F, 2, chk_bad(bf2f(U[(size_t)row * DFF2 + c]), a, 1.0f), 0); }
    { const int c = (i * 23 + 1) % DFF; const int t = row & (SEQ - 1); const float* cw = F.in[24] + (size_t)l * 3 * DFF2; const float* cb = F.in[25] + (size_t)l * DFF2; float g = cb[c], v = cb[DFF + c];
      for (int j = 0; j < 3; ++j) { const int tt = t - 2 + j; if (tt < 0) continue; g += cw[j * DFF2 + c] * bf2f(U[(size_t)(row - 2 + j) * DFF2 + c]); v += cw[j * DFF2 + DFF + c] * bf2f(U[(size_t)(row - 2 + j) * DFF2 + DFF + c]); }
      chk_flag(F, 3, chk_bad(bf2f(A[(size_t)row * DFF + c]), g / (1.f + expf(-g)) * v, 0.3f), 0); }
    { const int n = (i * 29 + 7) & 1023; const float* wd = F.in[26] + (size_t)l * DFF * DM; float a = 0.f; for (int k = 0; k < DFF; ++k) a += bf2f(A[(size_t)row * DFF + k]) * bfr(wd[(size_t)k * DM + n]);
      chk_flag(F, 4, chk_bad(WSP(const float, WS_Y2)[(size_t)row * DM + n], a, 1.0f), 0); }
}

__device__ __forceinline__ void selfcheck_e(Frame& F, int l) {
    const int i = threadIdx.x; const bf16_t* H = WSP(const bf16_t, WS_H); const bf16_t* P = WSP(const bf16_t, WS_P);
    const float* W = F.in[6] + (size_t)l * DM * DIN; const int row = (int)(chk_hash(i + 5) % M);
#define DOTC(dst, cc) do { float sc_; const int src_ = inproj_src((cc), sc_); float a_ = 0.f; if (src_ >= 0) for (int k = 0; k < DM; ++k) a_ += bf2f(H[(size_t)row * DM + k]) * bfr(W[(size_t)k * DIN + src_] * sc_); dst = a_; } while (0)
    { int c = (i * 37 + 5) % PW; if ((c >= 640 && c < 768)) c = 100; float ref; DOTC(ref, c); chk_flag(F, 0, chk_bad(bf2f(P[(size_t)row * PW + c]), ref, 1.0f), 0); }
    { const int c = 672 + (i & 31), p = c - 672, ip = p >> 1; float ref, oth; DOTC(ref, c); DOTC(oth, c ^ 1); const float x1 = (p & 1) ? oth : ref, x2 = (p & 1) ? ref : oth;
      const float inv = powf(10000.0f, -(float)(2 * ip) / 32.0f), ang = (float)(row & (SEQ - 1)) * inv, cs = cosf(ang), sn = sinf(ang); const float r = (p & 1) ? (x2 * cs + x1 * sn) : (x1 * cs - x2 * sn);
      chk_flag(F, 1, chk_bad(bf2f(WSP(const bf16_t, WS_KROT)[(size_t)row * 32 + p]), r, 1.0f), 0); }
    { const int c = 640 + (i & 15); float ref; DOTC(ref, c); chk_flag(F, 2, chk_bad(WSP(const float, WS_SIDE)[(size_t)row * 16 + (c - 640)], ref, 1.0f), 0); }
    { const int c = 256 + (i & 127); float ref; DOTC(ref, c); const float got = (c < 320) ? bf2f(WSP(const bf16_t, WS_KCMP)[(size_t)row * 64 + (c - 256)]) : bf2f(WSP(const bf16_t, WS_VCMP)[(size_t)row * 64 + (c - 320)]); chk_flag(F, 3, chk_bad(got, ref, 1.0f), 0); }
    float sq = 0.f, skv = 0.f; for (int k = 0; k < 256; ++k) { const float v = bf2f(P[(size_t)row * PW + PC_DQL + k]); sq += v * v; } for (int k = 0; k < 128; ++k) { const float v = bf2f(P[(size_t)row * PW + PC_DKV + k]); skv += v * v; }
    { const float* a = WSP(const float, WS_SSQQ) + (size_t)row * 4; const float* b = WSP(const float, WS_SSQKV) + (size_t)row * 4; chk_flag(F, 4, chk_bad(a[0] + a[1] + a[2] + a[3], sq, 10.f) || chk_bad(b[0] + b[1] + b[2] + b[3], skv, 5.f), 0); }
    const float rq = 1.0f / sqrtf(sq / 256.0f + RMS_EPS), rkv = 1.0f / sqrtf(skv / 128.0f + RMS_EPS);
    const float* wq = F.in[15] + (size_t)l * 256 * 384; const float* gq = F.in[13] + l * 256; const float* wkv = F.in[16] + (size_t)l * 128 * 512; const float* gkv = F.in[14] + l * 128;
#define QDOT(dst, src) do { float a_ = 0.f; for (int k = 0; k < 256; ++k) a_ += bf2f(P[(size_t)row * PW + PC_DQL + k]) * bfr(wq[(size_t)k * 384 + (src)] * C2D * gq[k]); dst = a_ * rq; } while (0)
    { const int hd = i & 3, w = (i >> 2) & 63; float ref; QDOT(ref, hd * 96 + w); chk_flag(F, 5, chk_bad(bf2f(WSP(const bf16_t, WS_QM)[(size_t)row * 512 + hd * 96 + w]), ref, 1.5f), 0); }
    { const int hd = i & 3, p = (i >> 2) & 31, ip = p >> 1; float x1, x2; QDOT(x1, hd * 96 + 64 + ip); QDOT(x2, hd * 96 + 64 + 16 + ip); const float inv = powf(10000.0f, -(float)(2 * ip) / 32.0f), ang = (float)(row & (SEQ - 1)) * inv, cs = cosf(ang), sn = sinf(ang);
      const float r = (p & 1) ? (x2 * cs + x1 * sn) : (x1 * cs - x2 * sn); chk_flag(F, 6, chk_bad(bf2f(WSP(const bf16_t, WS_QM)[(size_t)row * 512 + hd * 96 + 64 + p]), r, 1.5f), 0); }
    { const int c = (i * 13) & 511; float a = 0.f; for (int k = 0; k < 128; ++k) a += bf2f(P[(size_t)row * PW + PC_DKV + k]) * bfr(wkv[(size_t)k * 512 + c] * gkv[k]); chk_flag(F, 7, chk_bad(bf2f(WSP(const bf16_t, WS_KVM)[(size_t)row * 512 + c]), a * rkv, 1.0f), 0); }
    { const int b = i & 15, which = (i >> 4) & 1, c = (int)(chk_hash(i + 31) % 255), n = (i * 5) & 127; const bf16_t* src = (which ? WSP(const bf16_t, WS_VCMP) : WSP(const bf16_t, WS_KCMP)) + ((size_t)b * SEQ + 16 * c) * 64;
      const float *pk1 = F.in[8], *pv1 = F.in[10], *pk2 = F.in[9], *pv2 = F.in[11]; asm volatile("" : "+s"(pk1), "+s"(pv1), "+s"(pk2), "+s"(pv2));
      const float* w1 = (which ? pv1 : pk1) + (size_t)l * 2048 * 128; const float* w2 = (which ? pv2 : pk2) + (size_t)l * 128 * 64; const float* cp = F.in[7] + (size_t)l * 2048;
      float a = 0.f, bsum = 0.f; for (int p = 0; p < 2048; ++p) { a += bf2f(src[p]) * bfr(w1[(size_t)p * 128 + n]); bsum += cp[p] * w1[(size_t)p * 128 + n]; }
      const float xx = a + bsum, g = 0.5f * xx * (1.0f + tanhf(0.7978845608028654f * (xx + 0.044715f * xx * xx * xx)));
      const bf16_t* hid = WSP(const bf16_t, WS_HID) + (size_t)(which * 4096 + b * 256 + c) * 256 + which * 128;
      chk_flag(F, 8, chk_bad(bf2f(hid[n]), g, 0.5f), 0);
      const int d = (i * 5) & 63; float o2 = 0.f; for (int nn = 0; nn < 128; ++nn) o2 += bf2f(hid[nn]) * w2[nn * 64 + d];
      chk_flag(F, 9, chk_bad(bf2f((which ? WSP(const bf16_t, WS_VC) : WSP(const bf16_t, WS_KC))[((size_t)b * 256 + c) * 64 + d]), o2, 0.5f), 0); }
#undef DOTC
#undef QDOT
}

constexpr int CW_CNT = 20544;
__device__ __forceinline__ void selfcheck_g(Frame& F, int l) {
    const int gi = blockIdx.x * 512 + threadIdx.x; const bf16_t* H = WSP(const bf16_t, WS_H); const bf16_t* P = WSP(const bf16_t, WS_P); const float* W = F.in[6] + (size_t)l * DM * DIN;
    const int row = gi & (M - 1); unsigned nbad = 0u;
    for (int k4 = 0; k4 < 4; ++k4) { int c = (int)(chk_hash(gi * 4 + k4 + 12345u) % PW); if (c >= 640 && c < 768) c -= 200;
        float sc_; const int src_ = inproj_src(c, sc_); float a_ = 0.f; for (int k = 0; k < DM; ++k) a_ += bf2f(H[(size_t)row * DM + k]) * bfr(W[(size_t)k * DIN + src_] * sc_);
        if (chk_bad(bf2f(P[(size_t)row * PW + c]), a_, 1.0f)) ++nbad; }
    if (nbad) atomicAdd((unsigned*)(F.ctl + CW_CNT), nbad);
}
__device__ __forceinline__ void selfcheck_g_fin(Frame& F) {
    if (blockIdx.x == 0 && threadIdx.x == 0) { const unsigned cnt = __hip_atomic_load(F.ctl + CW_CNT, __ATOMIC_RELAXED, __HIP_MEMORY_SCOPE_AGENT); unsigned lg = 0; while ((1u << lg) <= cnt && lg < 15) ++lg;
        atomicOr((unsigned*)(F.ctl + CW_CHK), (cnt > 63u ? 63u : cnt) | (lg << 6)); }
}

__device__ __forceinline__ void selfcheck_f(Frame& F, int l) {
    const int i = threadIdx.x; const unsigned hsh = chk_hash(i + 4242u);
    chk_flag(F, 0, chk_fox(F, i & 15, (i >> 4) & 3, (i >> 6) * 8 + (hsh & 7)), 0);
    chk_flag(F, 1, chk_fox(F, i & 15, (i >> 4) & 3, 64 + (int)(hsh % 192u)), 0);
    chk_flag(F, 2, chk_fox(F, i & 15, (i >> 4) & 3, 256 + (int)(hsh % 3840u)), 0);
    chk_flag(F, 3, chk_dil(F, i & 15, (i >> 4) & 1, (int)(hsh & 127u)), 0);
    chk_flag(F, 4, chk_dil(F, i & 15, (i >> 4) & 1, 128 + (int)(hsh % 3968u)), 0);
    { bool bad = false; if (i < 128) bad = chk_nsa(F, i & 15, (i >> 4) & 3, (int)(hsh % 31u), i); chk_flag(F, 5, bad, 0); }
    { bool bad = false; if (i < 128) bad = chk_nsa(F, i & 15, (i >> 4) & 3, 31 + (int)(hsh % 33u), i); chk_flag(F, 6, bad, 0); }
    { bool bad = false; if (i < 128) bad = chk_nsa(F, i & 15, (i >> 4) & 3, 64 + (int)(hsh % 960u), i); chk_flag(F, 7, bad, 0); }
    { bool bad = false; if (i < 128) bad = chk_nsa(F, i & 15, (i >> 4) & 3, 1024 + (int)(hsh % 3072u), i); chk_flag(F, 8, bad, 4); }
}
__device__ __forceinline__ void selfcheck_report(Frame& F) {
    const unsigned mask = __hip_atomic_load(F.ctl + CW_CHK, __ATOMIC_RELAXED, __HIP_MEMORY_SCOPE_AGENT);
    float V = (float)(10u + (mask & 63u)); const unsigned e = 2u + ((mask >> 6) & 15u); for (unsigned k = 0; k < e; ++k) V *= 10.0f;
    for (size_t idx = (size_t)blockIdx.x * 512 + threadIdx.x; idx < (size_t)M * DM; idx += (size_t)F.G * 512) F.out[idx] = V;
}
#endif
struct SchedSimple {
    pg8::TileOrder T; const char* A; const char* B; int lda, ldb, nt; int dup = 0;
    __device__ __forceinline__ bool next(int i, GUnit& u) const { int pm, pn; if (!T.tile(i >> dup, pm, pn)) return false;
        u.A = A + (size_t)pm * 256 * lda; u.B = B + (size_t)pn * 256 * ldb; u.lda = lda; u.ldb = ldb; u.nt = nt; u.pm = pm; u.pn = pn; u.id = 0; return true; }
};
struct SchedCmp1 {
    int c; const char* kc; const char* vc; const char* B;
    __device__ __forceinline__ bool next(int i, GUnit& u) const { if (i > 0 || c >= 32) return false;
        u.A = (c < 16 ? kc : vc) + (size_t)(c & 15) * 256 * 2048; u.B = B; u.lda = 2048; u.ldb = 4096; u.nt = 32; u.pm = c; u.pn = 0; u.id = 0; return true; }
};
struct SchedMerge {
    pg8::TileOrder T; const char* ocat; const char* h; const char* wbr; const char* wg; int dup = 0;
    __device__ __forceinline__ bool next(int i0, GUnit& u) const { const int i = i0 >> dup; int pm, pn; if (!T.tile(i >> 3, pm, pn)) return false;
        const int sub = i & 7; u.pm = pm; u.pn = pn; u.id = sub;
        if (sub >= 4) { u.A = h + (size_t)pm * 256 * 1024; u.lda = 1024; u.B = wg + (size_t)((pn * 4 + (sub - 4)) * 256) * 1024; u.ldb = 1024; u.nt = 8; }
        else { const int br = sub; const int kk = (br == 1) ? 128 : 256; const size_t co = (br == 0) ? 0 : (br == 1 ? 256 : (br == 2 ? 384 : 640)), wo = (br == 0) ? BR_A : (br == 1 ? BR_B : (br == 2 ? BR_C : BR_D));
            u.A = ocat + (size_t)pm * 256 * (OCW * 2) + co * 2; u.lda = OCW * 2; u.B = wbr + wo + (size_t)pn * 256 * kk * 2; u.ldb = kk * 2; u.nt = kk / 64; }
        return true; }
};

#ifndef SDUP_INPROJ
#define SDUP_INPROJ 0
#endif
#ifndef SDUP_MERGE
#define SDUP_MERGE 0
#endif
#ifndef SDUP_WO
#define SDUP_WO 0
#endif
#ifndef SDUP_UP
#define SDUP_UP 0
#endif
#ifndef SDUP_DN
#define SDUP_DN 0
#endif
#ifndef DUP_ATTN
#define DUP_ATTN 1
#endif
#ifndef DUP_GEMM
#define DUP_GEMM 1
#endif
#ifndef DUP_MERGE
#define DUP_MERGE 1
#endif
#ifndef DUP_FFN
#define DUP_FFN 1
#endif
#ifdef ONLY_PHASE
#define PH(k) ((k) == ONLY_PHASE)
#else
#define PH(k) true
#endif
struct Args { const float* in[27]; float* out; unsigned char* ws; };
__global__ void __launch_bounds__(512, 2) hybrid_fwd(Args args) {
    extern __shared__ __attribute__((aligned(16))) unsigned char lds_raw[];
    Frame F;
    F.lds = (LAS unsigned char*)lds_raw; F.MISC = (volatile LAS unsigned*)(F.lds + MISC_OFF);
    F.tid = threadIdx.x; F.lane = F.tid & 63; F.wave = __builtin_amdgcn_readfirstlane(F.tid >> 6); F.G = gridDim.x;
#pragma unroll
    for (int i = 0; i < 27; ++i) F.in[i] = args.in[i];
    F.out = args.out; F.ws = args.ws; F.ctl = (gu32*)(args.ws + WS_CTL);
    for (int u = F.tid; u < (LDS_BYTES - LDSCTL_OFF) / 4; u += 512) ((LAS unsigned*)(F.lds + LDSCTL_OFF))[u] = 0u;
    __syncthreads();
    XcdBarrier bar = xcd_barrier_post((unsigned*)(F.ctl + CW_BAR), F.MISC + 8);
    const int c = (int)blockIdx.x;
#if defined(TIMEPROBE)
    if (threadIdx.x == 0) *(volatile LAS unsigned long long*)(F.lds + MISC_OFF + 64) = __builtin_amdgcn_s_memrealtime();
#define TSTAMP(id) do { if (blockIdx.x == 0 && threadIdx.x == 0) { volatile LAS unsigned long long* tp_ = (volatile LAS unsigned long long*)(F.lds + MISC_OFF + 64); const unsigned long long now_ = __builtin_amdgcn_s_memrealtime(); unsigned long long* a_ = (unsigned long long*)(F.ws + 90000) + (id); *a_ = *a_ + (now_ - *tp_); *tp_ = now_; } } while (0)
#else
#define TSTAMP(id) do { } while (0)
#endif

#ifndef DUP_P0
#define DUP_P0 1
#endif
    for (int rep = 0; rep < DUP_P0; ++rep) { if (rep) xcd_barrier(bar); if (PH(0)) p0_prologue(F); }
    xcd_barrier(bar); TSTAMP(0);

#ifndef XTRA_BAR
#define XTRA_BAR 0
#endif
    _Pragma("unroll") for (int xb = 0; xb < XTRA_BAR; ++xb) xcd_barrier(bar);
#define PHASE_FRESH() do { int t_ = threadIdx.x; asm volatile("" : "+v"(t_)); F.tid = t_; F.lane = t_ & 63; } while (0)
    for (int l = 0; l < DEPTH; ++l) {
        unsigned char* wl = F.ws + WS_WT + (size_t)l * LW;
        const float* xin = (l == 0) ? F.in[0] : F.out;
        PHASE_FRESH();
#ifndef DUP_RP0
#define DUP_RP0 1
#endif
        if (l == 0) { if (c == 0) cmpb_reduce(F);
          _Pragma("unroll") for (int rep = 0; rep < DUP_RP0; ++rep) { if (rep) xcd_barrier(bar); if (PH(1)) rowpass<0, false, false, true>(F, F.in[0], nullptr, 0, nullptr, WSP(bf16_t, WS_H), F.in[2] + l * DM, nullptr, 0, M, (unsigned char*)F.out + H8_OFF); }
          xcd_barrier(bar); TSTAMP(1); }
        for (int rep = 0; rep < DUP_GEMM; ++rep) if (PH(2)) { if (rep) xcd_barrier(bar); SchedSimple S; S.T.init(256, 12, F.G, c); S.A = (const char*)(F.ws + WS_H); S.B = (const char*)(wl + LW_IN); S.lda = 2048; S.ldb = 2048; S.nt = 16; S.dup = SDUP_INPROJ;
          pg8::EpiInProj E{WSP(bf16_t, WS_P), WSP(bf16_t, WS_KCMP), WSP(bf16_t, WS_VCMP), WSP(float, WS_SIDE), WSP(bf16_t, WS_KROT), WSP(const float, WS_ROPE), WSP(float, WS_SSQQ), WSP(float, WS_SSQKV), F.in[12] + l * 4, WSP(float, WS_LF)};
          pg8::gemm_phase<pg8::EpiInProj, SchedSimple, true>(F.lds, S, E); }
        xcd_barrier(bar); TSTAMP(2);
#ifndef DUP_L2A
#define DUP_L2A 1
#endif
        _Pragma("unroll") for (int rep2 = 0; rep2 < DUP_L2A; ++rep2) { if (rep2) xcd_barrier(bar);
        if (PH(3)) { SchedCmp1 S{c, (const char*)(F.ws + WS_KCMP), (const char*)(F.ws + WS_VCMP), (const char*)(wl + LW_PHI)};
          pg8::EpiCmp1 E{WSP(bf16_t, WS_HID), WSP(const float, WS_CMPB) + l * 256};
          pg8::gemm_phase<pg8::EpiCmp1, SchedCmp1, false>(F.lds, S, E);
          if (c < 32) {
              __syncthreads(); const int which = c >> 4, b = c & 15;
              int ln_ = threadIdx.x & 63; asm volatile("" : "+v"(ln_)); const int r32 = ln_ & 31, hi = ln_ >> 5;
              const bf16_t* hrow = WSP(const bf16_t, WS_HID) + ((size_t)c * 256 + F.wave * 32 + r32) * 256 + which * 128;
              const float *pk2 = F.in[9], *pv2 = F.in[11]; asm volatile("" : "+s"(pk2), "+s"(pv2)); const float* w2 = (which ? pv2 : pk2) + (size_t)l * 128 * 64;
              f32x16 o0, o1;
#pragma unroll
              for (int r = 0; r < 16; ++r) { o0[r] = 0.f; o1[r] = 0.f; }
#pragma unroll
              for (int ks = 0; ks < 8; ++ks) { const bf16x8 a = *(const bf16x8*)(hrow + ks * 16 + hi * 8);
                  const float* wp = w2 + (size_t)(ks * 16 + hi * 8) * 64 + r32; u32x4 b0, b1;
#pragma unroll
                  for (int jj = 0; jj < 4; ++jj) { b0[jj] = cvtpk(wp[(2 * jj) * 64], wp[(2 * jj + 1) * 64]); b1[jj] = cvtpk(wp[(2 * jj) * 64 + 32], wp[(2 * jj + 1) * 64 + 32]); }
                  o0 = MFMA32(a, __builtin_bit_cast(bf16x8, b0), o0); o1 = MFMA32(a, __builtin_bit_cast(bf16x8, b1), o1); }
              bf16_t* dst = (which ? WSP(bf16_t, WS_VC) : WSP(bf16_t, WS_KC)) + ((size_t)b * 256 + F.wave * 32) * 64 + r32;
#pragma unroll
              for (int r = 0; r < 16; ++r) { const int rw = crow(r, hi); dst[(size_t)rw * 64] = (bf16_t)f2bf(o0[r]); dst[(size_t)rw * 64 + 32] = (bf16_t)f2bf(o1[r]); } } }
        if (PH(4)) { int G2_ = F.G; asm volatile("" : "+s"(G2_)); const bool split = G2_ > 64; const int g2 = split ? F.G - 32 : F.G, c2 = split ? c - 32 : c;
          { SchedSimple S; S.T.init(256, 2, g2, c2 < 0 ? (1 << 28) : c2); S.A = (const char*)(F.ws + WS_P) + PC_DQL * 2; S.B = (const char*)(wl + LW_UQ); S.lda = PW * 2; S.ldb = 512; S.nt = 4;
            pg8::EpiQup E{WSP(bf16_t, WS_QM), WSP(const float, WS_SSQQ), WSP(const float, WS_ROPE)};
            pg8::gemm_phase<pg8::EpiQup, SchedSimple, true>(F.lds, S, E); }
          { SchedSimple S; S.T.init(256, 2, g2, c2 < 0 ? (1 << 28) : c2); S.A = (const char*)(F.ws + WS_P) + PC_DKV * 2; S.B = (const char*)(wl + LW_UKV); S.lda = PW * 2; S.ldb = 256; S.nt = 2;
            pg8::EpiKVup E{WSP(bf16_t, WS_KVM), WSP(const float, WS_SSQKV), (unsigned*)(F.ctl + CW_KMLA + 256 * l)};
            pg8::gemm_phase<pg8::EpiKVup, SchedSimple, true>(F.lds, S, E); } }
        PHASE_FRESH();
        if (PH(5)) {
          int G_ = F.G; asm volatile("" : "+s"(G_)); const int cb = (G_ >= 48) ? c - 32 : c;
          if (cb >= 0 && cb < BATCH) { const int b = cb, tid = F.tid; const float* fl = WSP(const float, WS_SIDE) + ((size_t)b * SEQ + 8 * tid) * 16 + 12; const f32x4 fb = *(const f32x4*)(F.in[12] + l * 4);
              f32x4 v[8];
#pragma unroll
              for (int i = 0; i < 8; ++i) { const f32x4 z = *(const f32x4*)(fl + 16 * i);
#pragma unroll
                  for (int e = 0; e < 4; ++e) { const float x = z[e] + fb[e]; v[i][e] = (x >= 0.f) ? -log1pf(expf(-x)) : (x - log1pf(expf(x))); } }
#pragma unroll
              for (int i = 1; i < 8; ++i) v[i] = v[i] + v[i - 1];
              LAS f32x4* sc = (LAS f32x4*)F.lds; f32x4 run = v[7];
              sc[tid] = run; __syncthreads();
              for (int off = 1, cur = 0; off < 512; off <<= 1, cur ^= 1) { f32x4 t = sc[cur * 512 + tid]; if (tid >= off) t = t + sc[cur * 512 + tid - off]; sc[(cur ^ 1) * 512 + tid] = t; __syncthreads(); run = t; }
              const f32x4 ex = run - v[7];
              float* kb = WSP(float, WS_KB) + (size_t)b * 4 * SEQ + 8 * tid;
#pragma unroll
              for (int e = 0; e < 4; ++e) { f32x4 lo, hi4;
#pragma unroll
                  for (int i = 0; i < 4; ++i) { lo[i] = -(ex[e] + v[i][e]) * LOG2E; hi4[i] = -(ex[e] + v[4 + i][e]) * LOG2E; }
                  *(f32x4*)(kb + (size_t)e * SEQ) = lo; *(f32x4*)(kb + (size_t)e * SEQ + 4) = hi4; }
              __syncthreads();
          } }
        }
        if (PH(5)) {
          const int gt2 = c * 512 + F.tid, hp = gt2 & 1;
          for (int t2 = gt2 >> 1; t2 < M; t2 += F.G * 256) { const bf16_t* Kp = WSP(const bf16_t, WS_P) + (size_t)t2 * PW + PC_CK + hp * 128; float s0 = 0.f, s1 = 0.f, s2 = 0.f;
              if (hp == 0) { const bf16_t* Rp = WSP(const bf16_t, WS_KROT) + (size_t)t2 * 32;
#pragma unroll
                  for (int q8 = 0; q8 < 4; ++q8) { const bf16x8 ra = *(const bf16x8*)(Rp + q8 * 8);
#pragma unroll
                      for (int e = 0; e < 8; ++e) { const float xa = bf2f((unsigned short)ra[e]); s2 += xa * xa; } } }
#pragma unroll
              for (int q8 = 0; q8 < 8; ++q8) { const bf16x8 ka = *(const bf16x8*)(Kp + q8 * 8), kb2 = *(const bf16x8*)(Kp + 64 + q8 * 8);
#pragma unroll
                  for (int e = 0; e < 8; ++e) { const float xa = bf2f((unsigned short)ka[e]), xb = bf2f((unsigned short)kb2[e]); s0 += xa * xa; s1 += xb * xb; } }
              s0 = fmaxf(s0, xor_lane_lt32<2>(s0)); s0 = fmaxf(s0, xor_lane_lt32<4>(s0)); s0 = fmaxf(s0, xor_lane_lt32<8>(s0)); s0 = fmaxf(s0, xor_lane_lt32<16>(s0));
              s1 = fmaxf(s1, xor_lane_lt32<2>(s1)); s1 = fmaxf(s1, xor_lane_lt32<4>(s1)); s1 = fmaxf(s1, xor_lane_lt32<8>(s1)); s1 = fmaxf(s1, xor_lane_lt32<16>(s1));
              { auto r0 = __builtin_amdgcn_permlane32_swap(__float_as_uint(s0), __float_as_uint(s0), false, false); s0 = fmaxf(__uint_as_float(r0[0]), __uint_as_float(r0[1]));
                auto r1 = __builtin_amdgcn_permlane32_swap(__float_as_uint(s1), __float_as_uint(s1), false, false); s1 = fmaxf(__uint_as_float(r1[0]), __uint_as_float(r1[1])); }
              s2 = fmaxf(s2, xor_lane_lt32<2>(s2)); s2 = fmaxf(s2, xor_lane_lt32<4>(s2)); s2 = fmaxf(s2, xor_lane_lt32<8>(s2)); s2 = fmaxf(s2, xor_lane_lt32<16>(s2));
              { auto r2 = __builtin_amdgcn_permlane32_swap(__float_as_uint(s2), __float_as_uint(s2), false, false); s2 = fmaxf(__uint_as_float(r2[0]), __uint_as_float(r2[1])); }
              if (F.lane < 2) { unsigned* kw = (unsigned*)(F.ctl + CW_KMAX + 64 * l) + (t2 >> 12) * 4 + 2 * hp; atomicMax(kw, __float_as_uint(s0)); atomicMax(kw + 1, __float_as_uint(s1));
                  if (hp == 0) atomicMax((unsigned*)(F.ctl + CW_KROT + 16 * l) + (t2 >> 12), __float_as_uint(s2)); } } }
        xcd_barrier(bar); TSTAMP(3);
        PHASE_FRESH();
        for (int rep = 0; rep < DUP_ATTN; ++rep) { gu32* ctr = F.ctl + CW_Q + 64 * l + 16 * rep;
          if (rep) xcd_barrier(bar);
          unsigned nxtq = 0u; if (F.tid == 0) nxtq = __hip_atomic_fetch_add(ctr, 1u, __ATOMIC_RELAXED, __HIP_MEMORY_SCOPE_AGENT);
          for (;;) { if (F.tid == 0) F.MISC[0] = nxtq; __syncthreads(); const int iq = (int)F.MISC[0]; __syncthreads(); if (iq >= ATT_UNITS) break;
              if (F.tid == 0) nxtq = __hip_atomic_fetch_add(ctr, 1u, __ATOMIC_RELAXED, __HIP_MEMORY_SCOPE_AGENT);
              const int it = __builtin_amdgcn_readfirstlane(WSP(const int, WS_ORDER)[iq]);
              if (it < 2048 && PH(7)) { const int qb = 15 - (it >> 7), mla = (it >> 6) & 1, bh = it & 63; if (mla) { const gu32* km = F.ctl + CW_KMLA + 256 * l + bh * 4; const float k2 = __uint_as_float(__hip_atomic_load(km, __ATOMIC_RELAXED, __HIP_MEMORY_SCOPE_AGENT)) + __uint_as_float(__hip_atomic_load(km + 1, __ATOMIC_RELAXED, __HIP_MEMORY_SCOPE_AGENT)) + __uint_as_float(__hip_atomic_load(F.ctl + CW_KROT + 16 * l + (bh >> 2), __ATOMIC_RELAXED, __HIP_MEMORY_SCOPE_AGENT)); causal_unit<false>(F, bh >> 2, bh & 3, qb, sqrtf(k2) * 1.01f); } else causal_unit<true>(F, bh >> 2, bh & 3, qb, sqrtf(__uint_as_float(__hip_atomic_load(F.ctl + CW_KMAX + 64 * l + bh, __ATOMIC_RELAXED, __HIP_MEMORY_SCOPE_AGENT)))); }
              else if (it < 3072 && PH(8)) { const int r = it - 2048; nsa_unit(F, r & 15, 63 - (r >> 4)); }
              else if (it < 3328 && PH(9)) { const int r = it - 3072; dil_unit(F, r & 15, (r >> 4) & 1, r >> 5); } } }
        xcd_barrier(bar); TSTAMP(5);
#if defined(SELFCHECK) && SELFCHECK == 1
        if (c == 0) selfcheck_a(F, l);
#endif
#if defined(SELFCHECK) && SELFCHECK == 3
        if (c == 0) selfcheck_e(F, l);
        xcd_barrier(bar); selfcheck_report(F); return;
#endif
#if defined(SELFCHECK) && SELFCHECK == 5
        selfcheck_g(F, l); xcd_barrier(bar); selfcheck_g_fin(F);
        xcd_barrier(bar); selfcheck_report(F); return;
#endif
#if defined(SELFCHECK) && SELFCHECK == 4
        if (c == 0) selfcheck_f(F, l);
        xcd_barrier(bar); selfcheck_report(F); return;
#endif
        for (int rep = 0; rep < DUP_MERGE; ++rep) if (PH(10)) { if (rep) xcd_barrier(bar); SchedMerge S; S.T.init(256, 4, F.G, c); S.ocat = (const char*)(F.ws + WS_OCAT); S.h = (const char*)F.out + H8_OFF; S.wbr = (const char*)(wl + LW_BR); S.wg = (const char*)(wl + LW_G); S.dup = SDUP_MERGE;
          unsigned char* scr = F.ws + WS_MSCR + (size_t)c * MSCR_PER_WG;
          pg8::EpiMerge E{WSP(bf16_t, WS_MERGED), scr};
          pg8::gemm_phase<pg8::EpiMerge, SchedMerge, true, true>(F.lds, S, E); }
        xcd_barrier(bar); TSTAMP(6);
#if defined(SELFCHECK) && SELFCHECK == 1
        if (c == 0) selfcheck_b(F, l);
        xcd_barrier(bar); selfcheck_report(F); return;
#endif
        if (PH(11)) { SchedSimple S; S.T.init(256, 4, F.G, c); S.A = (const char*)(F.ws + WS_MERGED); S.B = (const char*)(wl + LW_O); S.lda = 2048; S.ldb = 2048; S.nt = 16; S.dup = SDUP_WO;
          pg8::EpiBf16 E{WSP(bf16_t, WS_Y), DM};
          pg8::gemm_phase<pg8::EpiBf16, SchedSimple, true>(F.lds, S, E); }
        xcd_barrier(bar); TSTAMP(7);
        PHASE_FRESH();
        if (PH(12)) { if (l == 0) rowpass<1, false, true>(F, F.in[0], WSP(const bf16_t, WS_Y), 0, F.out, WSP(bf16_t, WS_H2), F.in[3] + l * DM, F.in[4] + l * DM, 0, M);
                      else rowpass<1, true, true>(F, F.out, WSP(const bf16_t, WS_Y), 0, WSP(bf16_t, WS_X3), WSP(bf16_t, WS_H2), F.in[3] + l * DM, F.in[4] + l * DM, 0, M); }
        xcd_barrier(bar); TSTAMP(8);
#ifndef DUP_UP
#define DUP_UP 1
#endif
        _Pragma("unroll") for (int rep = 0; rep < DUP_UP; ++rep) if (PH(13)) { if (rep) xcd_barrier(bar); SchedSimple S; S.T.init(256, 22, F.G, c); S.A = (const char*)(F.ws + WS_H2); S.B = (const char*)(wl + LW_UP); S.lda = 2048; S.ldb = 2048; S.nt = 16; S.dup = SDUP_UP;
          pg8::EpiUpConv E{WSP(bf16_t, WS_ACT), WSP(float, WS_HB), F.in[24] + (size_t)l * 3 * DFF2, F.in[25] + (size_t)l * DFF2};
          pg8::gemm_phase<pg8::EpiUpConv, SchedSimple, true>(F.lds, S, E); }
        xcd_barrier(bar); TSTAMP(9);
        PHASE_FRESH();
        if (PH(15)) { SchedSimple S; S.T.init(256, 4, F.G, c); S.A = (const char*)(F.ws + WS_ACT); S.B = (const char*)(wl + LW_DN); S.lda = DFF * 2; S.ldb = DFF * 2; S.nt = DFF / 64; S.dup = SDUP_DN;
          { int pm, pn; for (int i = 0; S.T.tile(i, pm, pn); ++i) ffn_fix_panel(F, pm, WSP(const float, WS_HB), WSP(bf16_t, WS_ACT), F.in[24] + (size_t)l * 3 * DFF2, F.in[25] + (size_t)l * DFF2); }
          VM_WAIT(); __syncthreads();
          pg8::EpiBf16 E{WSP(bf16_t, WS_Y2), DM};
          pg8::gemm_phase<pg8::EpiBf16, SchedSimple, true>(F.lds, S, E); }
        xcd_barrier(bar); TSTAMP(11);
        PHASE_FRESH();
        if (PH(16)) { if (l + 1 < DEPTH) rowpass<1, true, true, true>(F, F.out, WSP(const bf16_t, WS_Y2), 0, F.out, WSP(bf16_t, WS_H), F.in[5] + l * DM, F.in[2] + (l + 1) * DM, 0, M, (unsigned char*)F.out + H8_OFF);
                      else rowpass<2, true, false>(F, WSP(const bf16_t, WS_X3), WSP(const bf16_t, WS_Y2), 0, F.out, nullptr, F.in[5] + l * DM, nullptr, 0, M); }
        xcd_barrier(bar); TSTAMP(12);
    }
#if defined(TIMEPROBE)
    { xcd_barrier(bar); const unsigned long long* a_ = (const unsigned long long*)(F.ws + 90000); const float V1 = (float)a_[TIMEPROBE_A] * 0.01f, V2 = (float)a_[TIMEPROBE_B] * 0.01f * 1000.0f;
      for (size_t idx = (size_t)blockIdx.x * 512 + threadIdx.x; idx < (size_t)M * DM; idx += (size_t)F.G * 512) F.out[idx] = (idx == 12345) ? V2 : V1; }
#endif
}

extern "C" void kernel_launch(void* const* d_in, const int* in_sizes, int n_in, void* d_out, int out_size, void* d_ws, size_t ws_size, hipStream_t stream) {
    static int grid = 0;
    if (grid == 0) {
        if (n_in != 27 || in_sizes[0] != M * DM || out_size != M * DM || ws_size < WS_END) { fprintf(stderr, "kernel_launch: unexpected shapes (n_in %d, in0 %d, out %d, ws %zu)\n", n_in, n_in > 0 ? in_sizes[0] : -1, out_size, ws_size); grid = -1; return; }
        int dev = 0, cus = 0, per_cu = 0;
        if (hipGetDevice(&dev) != hipSuccess || hipDeviceGetAttribute(&cus, hipDeviceAttributeMultiprocessorCount, dev) != hipSuccess) { grid = -1; return; }
        if (hipFuncSetAttribute((const void*)hybrid_fwd, hipFuncAttributeMaxDynamicSharedMemorySize, LDS_BYTES) != hipSuccess) { fprintf(stderr, "kernel_launch: hipFuncSetAttribute failed\n"); grid = -1; return; }
        if (hipOccupancyMaxActiveBlocksPerMultiprocessor(&per_cu, (const void*)hybrid_fwd, 512, LDS_BYTES) != hipSuccess || per_cu < 1) fprintf(stderr, "kernel_launch: occupancy query says %d\n", per_cu);
        (void)hipGetLastError();
        grid = cus;
    }
    if (grid < 0) return;
    if (hipMemsetAsync((char*)d_ws + WS_CTL, 0, CTL_ZERO_BYTES, stream) != hipSuccess) return;
    Args a{};
    for (int i = 0; i < 27; ++i) a.in[i] = (const float*)d_in[i];
    a.out = (float*)d_out; a.ws = (unsigned char*)d_ws;
    hipLaunchKernelGGL(hybrid_fwd, dim3(grid), dim3(512), LDS_BYTES, stream, a);
}
```

```cpp
#include <hip/hip_runtime.h>
#include <hip/hip_bf16.h>
#include <cstdio>
#include <cstdint>
#include <cmath>

#define GAS __attribute__((address_space(1)))
#define LAS __attribute__((address_space(3)))
typedef unsigned short bf16_t;
typedef short bf16x8 __attribute__((ext_vector_type(8)));
typedef short s16x4 __attribute__((ext_vector_type(4)));
typedef float f32x4 __attribute__((ext_vector_type(4)));
typedef float f32x2 __attribute__((ext_vector_type(2)));
typedef float f32x16 __attribute__((ext_vector_type(16)));
typedef unsigned u32x4 __attribute__((ext_vector_type(4)));
typedef unsigned u32x2 __attribute__((ext_vector_type(2)));
typedef GAS unsigned gu32;

constexpr int BATCH = 16, SEQ = 4096, DM = 1024, M = BATCH * SEQ, DEPTH = 2;
constexpr int DIN = 2992, PW = 3072;
constexpr int DFF = 2816, DFF2 = 5632;
constexpr float LOG2E = 1.4426950408889634f;
constexpr float C2A = 0.125f * LOG2E;
constexpr float C2D = 0.10206207261596575f * LOG2E;
constexpr float RMS_EPS = 1e-6f;
constexpr float H8_SCALE = 8.0f, WG8_SCALE = 64.0f, GATE_UNSCALE = 1.0f / (H8_SCALE * WG8_SCALE);
constexpr int PC_AQ = 0, PC_KCMP = 256, PC_VCMP = 320, PC_KSLC = 384, PC_VSLC = 448, PC_KWIN = 512, PC_VWIN = 576,
              PC_MISC = 640, PC_KROPE = 672, PC_BQ = 768, PC_BK = 1152, PC_BV = 1536, PC_DKV = 1920,
              PC_CQ = 2048, PC_CK = 2304, PC_CV = 2560, PC_DQL = 2816;
constexpr int OCW = 896;
constexpr int NSA_DFAR = 1536, NSA_DMAX = 1664, NSA_TL = 1728;

__device__ __forceinline__ unsigned f2bf(float f) { unsigned u = __float_as_uint(f); return (u + 0x7fffu + ((u >> 16) & 1u)) >> 16; }
__device__ __forceinline__ unsigned pk2(float lo, float hi) { return f2bf(lo) | (f2bf(hi) << 16); }
__device__ __forceinline__ float bf2f(unsigned short b) { return __uint_as_float((unsigned)b << 16); }
typedef __bf16 bf16x2_t __attribute__((ext_vector_type(2)));
__device__ __forceinline__ unsigned cvtpk(float lo, float hi) { f32x2 v = {lo, hi}; bf16x2_t b = __builtin_convertvector(v, bf16x2_t); return __builtin_bit_cast(unsigned, b); }
__device__ __forceinline__ unsigned pk4_fp8(float a, float b, float c, float d) { int w = 0; w = __builtin_amdgcn_cvt_pk_fp8_f32(a, b, w, false); w = __builtin_amdgcn_cvt_pk_fp8_f32(c, d, w, true); return (unsigned)w; }
__device__ __forceinline__ float fast_exp2(float x) { return __builtin_amdgcn_exp2f(x); }
__device__ __forceinline__ float fast_rcp(float x) { return __builtin_amdgcn_rcpf(x); }
template <int MASK> __device__ __forceinline__ float xor_lane_lt32(float v) { return __uint_as_float(__builtin_amdgcn_ds_swizzle((int)__float_as_uint(v), (MASK << 10) | 0x1f)); }
__device__ __forceinline__ float sum_halves(float v) { auto rr = __builtin_amdgcn_permlane32_swap(__float_as_uint(v), __float_as_uint(v), false, false); return __uint_as_float(rr[0]) + __uint_as_float(rr[1]); }
__device__ __forceinline__ float sigmoid_f(float x) { return fast_rcp(1.0f + fast_exp2(-x * LOG2E)); }

namespace pg8 {
constexpr int BM = 256, BK = 64, HALF = 128, HTB = HALF * BK * 2  , STAGE_BYTES = 8 * HTB, NXCD = 8, WGM = 8;
__host__ __device__ __forceinline__ int lds_byte(int r, int c) { const int st = (r >> 4) * 2 + (c >> 5), rr = r & 15, cc = c & 31, ob = rr * 64 + cc * 2; return st * 1024 + (ob ^ (((ob >> 9) & 1) << 5)); }
__host__ __device__ __forceinline__ void stage_rc(int b, int& R, int& C) { const int st = b / 1024, sb = b % 1024, swz = sb ^ (((sb >> 9) & 1) << 5); R = (st >> 1) * 16 + swz / 64; C = (st & 1) * 32 + (swz % 64) / 2; }
__host__ __device__ __forceinline__ int perm32(int rho) { const int n = rho >> 4, i = rho & 15; return 8 * (i >> 2) + 4 * n + (i & 3); }

typedef int v8i_t __attribute__((ext_vector_type(8)));
typedef int v4i_t __attribute__((ext_vector_type(4)));
__device__ __forceinline__ v8i_t cat8(const bf16x8 lo, const bf16x8 hi) { const v4i_t a = __builtin_bit_cast(v4i_t, lo), b = __builtin_bit_cast(v4i_t, hi); return __builtin_shufflevector(a, b, 0, 1, 2, 3, 4, 5, 6, 7); }
struct GUnit { const char* A; const char* B; int lda, ldb, nt, pm, pn, id; };

struct TileOrder {
    int nM, nN, nwg, G, c;
    __device__ __forceinline__ void init(int nM_, int nN_, int G_, int c_) { nM = nM_; nN = nN_; nwg = nM * nN; G = G_; c = c_; }
    __device__ __forceinline__ bool tile(int i, int& pm, int& pn) const {
        const long L = (long)i * G + c; if (L >= nwg) return false;
        int wgid = (int)L; { const int q = nwg / NXCD, r = nwg % NXCD, xcd = wgid % NXCD, off = wgid / NXCD; wgid = (xcd < r ? xcd * (q + 1) : r * (q + 1) + (xcd - r) * q) + off; }
        const int nig = WGM * nN, gid = wgid / nig, fm = gid * WGM, gsz = (nM - fm) < WGM ? (nM - fm) : WGM;
        pm = fm + ((wgid % nig) % gsz); pn = (wgid % nig) / gsz; return true;
    }
};

template <class Epi, class Sched, bool ALIGN_EPI, bool F8 = false>
__device__ __forceinline__ void gemm_phase(LAS unsigned char* lds, const Sched& S, const Epi& E) {
    int tid_o = threadIdx.x; asm volatile("" : "+v"(tid_o));
    const int tid = tid_o, wid = __builtin_amdgcn_readfirstlane(tid >> 6), lane = tid & 63, wr = wid >> 2, wc = wid & 3; int fr = lane & 15, fq = lane >> 4;
    int sR[2], sC[2], sRb[2];
#pragma unroll
    for (int i = 0; i < 2; ++i) { stage_rc(tid * 16 + i * 8192, sR[i], sC[i]); sRb[i] = Epi::PERM ? ((sR[i] & ~31) + perm32(sR[i] & 31)) : sR[i]; sC[i] *= 2; }
    const size_t kstep = (size_t)(BK * 2);
    const unsigned ldsw = (unsigned)wid * 1024u;
    const int aoff = lds_byte(wr * 64 + fr, fq * 8), boff = lds_byte(wc * 32 + fr, fq * 8);
#define PG8_SA(b, h) (((b) * 2 + (h)) * HTB)
#define PG8_SB(b, h) ((4 + (b) * 2 + (h)) * HTB)
#define PG8_STAGE(bufoff, gbase, rows, ld) do { _Pragma("unroll") for (int _i = 0; _i < 2; ++_i) \
        __builtin_amdgcn_global_load_lds((const unsigned*)((const char*)(gbase) + (unsigned)((rows)[_i] * (ld) + sC[_i])), (LAS unsigned*)(lds + (bufoff) + ldsw + _i * 8192), 16, 0, 0); } while (0)
#define PG8_LDA(dst, b, h) do { _Pragma("unroll") for (int m = 0; m < 4; ++m) _Pragma("unroll") for (int k = 0; k < 2; ++k) dst[m][k] = *(const LAS bf16x8*)(lds + PG8_SA(b, h) + aoff + m * 2048 + k * 1024); } while (0)
#define PG8_LDB(dst, b, h) do { _Pragma("unroll") for (int n = 0; n < 2; ++n) _Pragma("unroll") for (int k = 0; k < 2; ++k) dst[n][k] = *(const LAS bf16x8*)(lds + PG8_SB(b, h) + boff + n * 2048 + k * 1024); } while (0)
#define PG8_MMA(ai, bj, At, Bt) do { __builtin_amdgcn_s_setprio(1); _Pragma("unroll") for (int m = 0; m < 4; ++m) _Pragma("unroll") for (int n = 0; n < 2; ++n) _Pragma("unroll") for (int k = 0; k < 2; ++k) \
        acc[ai][bj][m][n] = __builtin_amdgcn_mfma_f32_16x16x32_bf16(Bt[n][k], At[m][k], acc[ai][bj][m][n], 0, 0, 0); __builtin_amdgcn_s_setprio(0); } while (0)
#define PG8_LDA8(dst, b, h) do { _Pragma("unroll") for (int m = 0; m < 4; ++m) { dst[m].lo = *(const LAS v4i_t*)(lds + PG8_SA(b, h) + aoff + m * 2048); dst[m].hi = *(const LAS v4i_t*)(lds + PG8_SA(b, h) + aoff + m * 2048 + 1024); } } while (0)
#define PG8_LDB8(dst, b, h) do { _Pragma("unroll") for (int n = 0; n < 2; ++n) { dst[n].lo = *(const LAS v4i_t*)(lds + PG8_SB(b, h) + boff + n * 2048); dst[n].hi = *(const LAS v4i_t*)(lds + PG8_SB(b, h) + boff + n * 2048 + 1024); } } while (0)
#define PG8_MMA8(ai, bj, At, Bt) do { __builtin_amdgcn_s_setprio(1); _Pragma("unroll") for (int m = 0; m < 4; ++m) _Pragma("unroll") for (int n = 0; n < 2; ++n) \
        asm volatile("v_mfma_f32_16x16x128_f8f6f4 %0, %1, %2, %0" : "+v"(acc[ai][bj][m][n]) : "v"(Bt[n]), "v"(At[m])); __builtin_amdgcn_s_setprio(0); } while (0)
#define PG8_WAIT_V(n) asm volatile("s_waitcnt vmcnt(" #n ")" ::: "memory")
#define PG8_WAIT_L(n) asm volatile("s_waitcnt lgkmcnt(" #n ")" ::: "memory")
#define PG8_BAR __builtin_amdgcn_s_barrier()
#define PG8_SCHED __builtin_amdgcn_sched_barrier(0)
#define PG8_KLOOP(MM, LDA_, LDB_, At, B0, B1) for (int t = 0; t < nt; t += 2) { \
            const bool last = (t == nt - 2); \
            const char* a1 = cA + (size_t)(t + 1) * kstep; \
            const char* a2 = last ? nA : cA + (size_t)(t + 2) * kstep; const char* b2 = last ? nB : cB + (size_t)(t + 2) * kstep; \
            const char* a3 = a2 + kstep; const char* b3 = b2 + kstep; \
            const int ldA2 = last ? ldAn : ldAc, ldB2 = last ? ldBn : ldBc; \
            const size_t hA2 = last ? hAn : hAc, hB2 = last ? hBn : hBc; \
              \
            LDB_(B0, 0, 0); LDB_(B1, 0, 1); PG8_SCHED; LDA_(At, 0, 0); PG8_STAGE(PG8_SA(1, 1), a1 + hAc, sR, ldAc); \
            PG8_WAIT_V(8); PG8_WAIT_L(0); PG8_BAR; MM(0, 0, At, B0); MM(0, 1, At, B1); PG8_BAR; PG8_SCHED; \
              \
            LDA_(At, 0, 1); PG8_STAGE(PG8_SB(0, 0), b2, sRb, ldB2); PG8_STAGE(PG8_SB(0, 1), b2 + hB2, sRb, ldB2); PG8_STAGE(PG8_SA(0, 0), a2, sR, ldA2); \
            PG8_WAIT_V(8); PG8_WAIT_L(0); PG8_BAR; MM(1, 0, At, B0); MM(1, 1, At, B1); PG8_BAR; PG8_SCHED; \
              \
            LDB_(B0, 1, 0); LDB_(B1, 1, 1); PG8_SCHED; LDA_(At, 1, 0); PG8_STAGE(PG8_SA(0, 1), a2 + hA2, sR, ldA2); \
            PG8_WAIT_V(8); PG8_WAIT_L(0); PG8_BAR; MM(0, 0, At, B0); MM(0, 1, At, B1); PG8_BAR; PG8_SCHED; \
              \
            LDA_(At, 1, 1); PG8_STAGE(PG8_SB(1, 0), b3, sRb, ldB2); PG8_STAGE(PG8_SB(1, 1), b3 + hB2, sRb, ldB2); PG8_STAGE(PG8_SA(1, 0), a3, sR, ldA2); \
            PG8_WAIT_V(8); PG8_WAIT_L(0); PG8_BAR; MM(1, 0, At, B0); MM(1, 1, At, B1); PG8_BAR; PG8_SCHED; \
        }
    GUnit cur, nxt; int ui = 0;
    if (!S.next(0, cur)) return;
    f32x4 acc[2][2][4][2];
#pragma unroll
    for (int a = 0; a < 2; ++a)
#pragma unroll
        for (int b = 0; b < 2; ++b)
#pragma unroll
            for (int m = 0; m < 4; ++m)
#pragma unroll
                for (int n = 0; n < 2; ++n) acc[a][b][m][n] = (f32x4){0.f, 0.f, 0.f, 0.f};
    bf16x8 At[4][2], B0[2][2], B1[2][2]; v8i_t At8[4], B08[2], B18[2];
    int ldAc = cur.lda, ldBc = cur.ldb; size_t hAc = (size_t)HALF * ldAc, hBc = (size_t)HALF * ldBc;
    const char* cA = cur.A; const char* cB = cur.B;
    PG8_STAGE(PG8_SB(0, 0), cB, sRb, ldBc); PG8_STAGE(PG8_SB(0, 1), cB + hBc, sRb, ldBc); PG8_STAGE(PG8_SA(0, 0), cA, sR, ldAc); PG8_STAGE(PG8_SA(0, 1), cA + hAc, sR, ldAc);
    if (wr == 1) PG8_BAR;
    PG8_WAIT_V(2); PG8_BAR;
    PG8_STAGE(PG8_SB(1, 0), cB + kstep, sRb, ldBc); PG8_STAGE(PG8_SA(1, 0), cA + kstep, sR, ldAc); PG8_STAGE(PG8_SB(1, 1), cB + hBc + kstep, sRb, ldBc);
    PG8_WAIT_V(6); PG8_BAR;
    for (;;) {
        const bool has_next = S.next(ui + 1, nxt);
        int ldAn, ldBn; const char* nA; const char* nB;
        if (has_next) { ldAn = nxt.lda; ldBn = nxt.ldb; nA = nxt.A; nB = nxt.B; } else { ldAn = ldAc; ldBn = ldBc; nA = cA; nB = cB; }
        const size_t hAn = (size_t)HALF * ldAn, hBn = (size_t)HALF * ldBn;
        int nt = cur.nt; asm volatile("" : "+s"(nt));
        bool f8u = false; if constexpr (F8) f8u = Epi::f8(cur);
        if (F8 && f8u) { PG8_KLOOP(PG8_MMA8, PG8_LDA8, PG8_LDB8, At8, B08, B18) asm volatile("s_nop 15\n\ts_nop 15" ::: "memory"); }
        else { PG8_KLOOP(PG8_MMA, PG8_LDA, PG8_LDB, At, B0, B1) }
        if constexpr (ALIGN_EPI) { if (wr == 0) PG8_BAR; }
        E(acc, cur, wr, wc, fr, fq);
        if (!has_next) break;
#pragma unroll
        for (int a = 0; a < 2; ++a)
#pragma unroll
            for (int b = 0; b < 2; ++b)
#pragma unroll
                for (int m = 0; m < 4; ++m)
#pragma unroll
                    for (int n = 0; n < 2; ++n) acc[a][b][m][n] = (f32x4){0.f, 0.f, 0.f, 0.f};
        cur = nxt; cA = nA; cB = nB; ++ui;
        ldAc = ldAn; ldBc = ldBn; hAc = hAn; hBc = hBn;
        if constexpr (ALIGN_EPI) { if (wr == 1) PG8_BAR; }
    }
    PG8_WAIT_V(0);
    if constexpr (!ALIGN_EPI) { if (wr == 0) PG8_BAR; }
    PG8_BAR;
#undef PG8_SA
#undef PG8_SB
#undef PG8_STAGE
#undef PG8_LDA
#undef PG8_LDB
#undef PG8_MMA
#undef PG8_MMA8
#undef PG8_LDA8
#undef PG8_LDB8
#undef PG8_KLOOP
#undef PG8_WAIT_V
#undef PG8_WAIT_L
#undef PG8_BAR
#undef PG8_SCHED
}
}
using pg8::GUnit;
namespace pg8 {
#define EPI_OPAQUE() asm volatile("" : "+v"(fr), "+v"(fq))
struct EpiBf16 {
    static constexpr bool PERM = true;
    bf16_t* O; int ldc;
    __device__ __forceinline__ void operator()(const f32x4 (&acc)[2][2][4][2], const GUnit& u, int wr, int wc, int fr, int fq) const {
        EPI_OPAQUE();
        const int row0 = u.pm * BM + wr * 64 + fr, col0 = u.pn * BM + wc * 32 + 8 * fq;
#pragma unroll
        for (int ai = 0; ai < 2; ++ai)
#pragma unroll
            for (int m = 0; m < 4; ++m) { bf16_t* rowp = O + (size_t)(row0 + ai * HALF + m * 16) * ldc + col0;
#pragma unroll
                for (int bj = 0; bj < 2; ++bj) { const f32x4 v0 = acc[ai][bj][m][0], v1 = acc[ai][bj][m][1];
                    u32x4 w; w.x = cvtpk(v0[0], v0[1]); w.y = cvtpk(v0[2], v0[3]); w.z = cvtpk(v1[0], v1[1]); w.w = cvtpk(v1[2], v1[3]);
                    *(u32x4*)(rowp + bj * HALF) = w; } }
    }
};
struct EpiF32 {
    static constexpr bool PERM = false;
    float* O; int ldc;
    __device__ __forceinline__ void operator()(const f32x4 (&acc)[2][2][4][2], const GUnit& u, int wr, int wc, int fr, int fq) const {
        EPI_OPAQUE();
        const int row0 = u.pm * BM + wr * 64 + fr, col0 = u.pn * BM + wc * 32 + 4 * fq;
#pragma unroll
        for (int ai = 0; ai < 2; ++ai)
#pragma unroll
            for (int m = 0; m < 4; ++m) { float* rowp = O + (size_t)(row0 + ai * HALF + m * 16) * ldc + col0;
#pragma unroll
                for (int bj = 0; bj < 2; ++bj)
#pragma unroll
                    for (int n = 0; n < 2; ++n) *(f32x4*)(rowp + bj * HALF + n * 16) = acc[ai][bj][m][n]; }
    }
};
__device__ __forceinline__ void rope8(f32x4& v0, f32x4& v1, const float* cs  ) {
    const f32x4 a = *(const f32x4*)cs, b = *(const f32x4*)(cs + 4);
    f32x4 r0, r1;
    r0[0] = v0[0] * a[0] - v0[1] * a[1]; r0[1] = v0[1] * a[0] + v0[0] * a[1];
    r0[2] = v0[2] * a[2] - v0[3] * a[3]; r0[3] = v0[3] * a[2] + v0[2] * a[3];
    r1[0] = v1[0] * b[0] - v1[1] * b[1]; r1[1] = v1[1] * b[0] + v1[0] * b[1];
    r1[2] = v1[2] * b[2] - v1[3] * b[3]; r1[3] = v1[3] * b[2] + v1[2] * b[3];
    v0 = r0; v1 = r1;
}
struct EpiInProj {
    static constexpr bool PERM = true;
    bf16_t* P; bf16_t* kcmp; bf16_t* vcmp; float* side; bf16_t* krot; const float* rope; float* ssq_q; float* ssq_kv; const float* fbias; float* lf;
    __device__ __forceinline__ void operator()(const f32x4 (&acc)[2][2][4][2], const GUnit& u, int wr, int wc, int fr, int fq) const {
        EPI_OPAQUE();
        const int row0 = u.pm * BM + wr * 64 + fr, col0 = u.pn * BM + wc * 32 + 8 * fq;
#pragma unroll
        for (int ai = 0; ai < 2; ++ai)
#pragma unroll
            for (int m = 0; m < 4; ++m) { const int row = row0 + ai * HALF + m * 16; bf16_t* rowp = P + (size_t)row * PW + col0;
                float ssq = 0.f;
#pragma unroll
                for (int bj = 0; bj < 2; ++bj) { f32x4 v0 = acc[ai][bj][m][0], v1 = acc[ai][bj][m][1];
                    if (u.pn == 2 && bj == 1) {
                        if (wc == 0 && fq < 2) { float* sp = side + (size_t)row * 16 + 8 * fq; *(f32x4*)sp = v0; *(f32x4*)(sp + 4) = v1; }
                        if (wc == 1) { rope8(v0, v1, rope + (size_t)(row & (SEQ - 1)) * 32 + 8 * fq);
                            u32x4 w; w.x = cvtpk(v0[0], v0[1]); w.y = cvtpk(v0[2], v0[3]); w.z = cvtpk(v1[0], v1[1]); w.w = cvtpk(v1[2], v1[3]);
                            *(u32x4*)(krot + (size_t)row * 32 + 8 * fq) = w; }
                    }
                    u32x4 w; w.x = cvtpk(v0[0], v0[1]); w.y = cvtpk(v0[2], v0[3]); w.z = cvtpk(v1[0], v1[1]); w.w = cvtpk(v1[2], v1[3]);
                    *(u32x4*)(rowp + bj * HALF) = w;
                    if (u.pn == 1 && bj == 0) { bf16_t* cp = (wc < 2 ? kcmp : vcmp) + (size_t)row * 64 + (wc & 1) * 32 + 8 * fq; *(u32x4*)cp = w; }
                    if (u.pn == 11 || (u.pn == 7 && bj == 1)) ssq += (v0[0] * v0[0] + v0[1] * v0[1]) + (v0[2] * v0[2] + v0[3] * v0[3]) + (v1[0] * v1[0] + v1[1] * v1[1]) + (v1[2] * v1[2] + v1[3] * v1[3]);
                }
                if (u.pn == 11 || u.pn == 7) { ssq += xor_lane_lt32<16>(ssq); ssq = sum_halves(ssq);
                    if (fq == 0) (u.pn == 11 ? ssq_q : ssq_kv)[(size_t)row * 4 + wc] = ssq; }
                asm volatile("" ::: "memory");
            }
    }
};
struct EpiQup {
    static constexpr bool PERM = true;
    bf16_t* O; const float* ssq_q; const float* rope;
    __device__ __forceinline__ void operator()(const f32x4 (&acc)[2][2][4][2], const GUnit& u, int wr, int wc, int fr, int fq) const {
        EPI_OPAQUE();
        const int row0 = u.pm * BM + wr * 64 + fr, col0 = u.pn * BM + wc * 32 + 8 * fq;
#pragma unroll
        for (int ai = 0; ai < 2; ++ai)
#pragma unroll
            for (int m = 0; m < 4; ++m) { const int row = row0 + ai * HALF + m * 16; bf16_t* rowp = O + (size_t)row * 512 + col0;
                const f32x4 pq = *(const f32x4*)(ssq_q + (size_t)row * 4);
                const float rstd = 1.0f / sqrtf(((pq[0] + pq[1]) + (pq[2] + pq[3])) * (1.0f / 256.0f) + RMS_EPS);
#pragma unroll
                for (int bj = 0; bj < 2; ++bj) { f32x4 v0 = acc[ai][bj][m][0] * rstd, v1 = acc[ai][bj][m][1] * rstd;
                    const int c8 = col0 + bj * HALF, within = c8 % 96;
                    if (c8 < 384 && within >= 64) rope8(v0, v1, rope + (size_t)(row & (SEQ - 1)) * 32 + (within - 64));
                    u32x4 w; w.x = cvtpk(v0[0], v0[1]); w.y = cvtpk(v0[2], v0[3]); w.z = cvtpk(v1[0], v1[1]); w.w = cvtpk(v1[2], v1[3]);
                    *(u32x4*)(rowp + bj * HALF) = w; }
                asm volatile("" ::: "memory"); }
    }
};
struct EpiKVup {
    static constexpr bool PERM = true;
    bf16_t* O; const float* ssq_kv; unsigned* kmx;
    __device__ __forceinline__ void operator()(const f32x4 (&acc)[2][2][4][2], const GUnit& u, int wr, int wc, int fr, int fq) const {
        EPI_OPAQUE();
        const int row0 = u.pm * BM + wr * 64 + fr, col0 = u.pn * BM + wc * 32 + 8 * fq;
        float mk0 = 0.f, mk1 = 0.f;
#pragma unroll
        for (int ai = 0; ai < 2; ++ai)
#pragma unroll
            for (int m = 0; m < 4; ++m) { const int row = row0 + ai * HALF + m * 16; bf16_t* rowp = O + (size_t)row * 512 + col0;
                const f32x4 pq = *(const f32x4*)(ssq_kv + (size_t)row * 4);
                const float rstd = 1.0f / sqrtf(((pq[0] + pq[1]) + (pq[2] + pq[3])) * (1.0f / 128.0f) + RMS_EPS);
#pragma unroll
                for (int bj = 0; bj < 2; ++bj) { const f32x4 v0 = acc[ai][bj][m][0] * rstd, v1 = acc[ai][bj][m][1] * rstd;
                    u32x4 w; w.x = cvtpk(v0[0], v0[1]); w.y = cvtpk(v0[2], v0[3]); w.z = cvtpk(v1[0], v1[1]); w.w = cvtpk(v1[2], v1[3]);
                    *(u32x4*)(rowp + bj * HALF) = w;
                    if (wc < 2) { float ss = ((v0[0] * v0[0] + v0[1] * v0[1]) + (v0[2] * v0[2] + v0[3] * v0[3])) + ((v1[0] * v1[0] + v1[1] * v1[1]) + (v1[2] * v1[2] + v1[3] * v1[3]));
                        ss += xor_lane_lt32<16>(ss); ss = sum_halves(ss); if (bj == 0) mk0 = fmaxf(mk0, ss); else mk1 = fmaxf(mk1, ss); } }
                asm volatile("" ::: "memory"); }
        if (wc < 2) {
            mk0 = fmaxf(mk0, xor_lane_lt32<1>(mk0)); mk0 = fmaxf(mk0, xor_lane_lt32<2>(mk0)); mk0 = fmaxf(mk0, xor_lane_lt32<4>(mk0)); mk0 = fmaxf(mk0, xor_lane_lt32<8>(mk0));
            mk1 = fmaxf(mk1, xor_lane_lt32<1>(mk1)); mk1 = fmaxf(mk1, xor_lane_lt32<2>(mk1)); mk1 = fmaxf(mk1, xor_lane_lt32<4>(mk1)); mk1 = fmaxf(mk1, xor_lane_lt32<8>(mk1));
            if (fr == 0 && fq == 0) { unsigned* kw = kmx + ((u.pm >> 4) * 4 + 2 * u.pn) * 4 + wc; atomicMax(kw, __float_as_uint(mk0)); atomicMax(kw + 4, __float_as_uint(mk1)); }
        }
    }
};
__device__ __forceinline__ float gelu_tanh(float x) { const float u2 = 2.0f * 0.7978845608028654f * (x + 0.044715f * x * x * x); return x * fast_rcp(1.0f + fast_exp2(-u2 * LOG2E)); }
struct EpiCmp1 {
    static constexpr bool PERM = true;
    bf16_t* O; const float* bias1;
    __device__ __forceinline__ void operator()(const f32x4 (&acc)[2][2][4][2], const GUnit& u, int wr, int wc, int fr, int fq) const {
        EPI_OPAQUE();
        const int row0 = u.pm * BM + wr * 64 + fr, col0 = wc * 32 + 8 * fq;
        f32x4 bv[2][2];
#pragma unroll
        for (int bj = 0; bj < 2; ++bj)
#pragma unroll
            for (int n = 0; n < 2; ++n) bv[bj][n] = *(const f32x4*)(bias1 + col0 + bj * HALF + 4 * n);
#pragma unroll
        for (int ai = 0; ai < 2; ++ai)
#pragma unroll
            for (int m = 0; m < 4; ++m) { bf16_t* rowp = O + (size_t)(row0 + ai * HALF + m * 16) * 256 + col0;
#pragma unroll
                for (int bj = 0; bj < 2; ++bj) { f32x4 v0 = acc[ai][bj][m][0] + bv[bj][0], v1 = acc[ai][bj][m][1] + bv[bj][1];
#pragma unroll
                    for (int e = 0; e < 4; ++e) { v0[e] = gelu_tanh(v0[e]); v1[e] = gelu_tanh(v1[e]); }
                    u32x4 w; w.x = cvtpk(v0[0], v0[1]); w.y = cvtpk(v0[2], v0[3]); w.z = cvtpk(v1[0], v1[1]); w.w = cvtpk(v1[2], v1[3]);
                    *(u32x4*)(rowp + bj * HALF) = w; } }
    }
};
typedef __amdgpu_buffer_rsrc_t rsrc_t;
struct EpiMerge {
    __device__ static __forceinline__ bool f8(const GUnit& u) { return u.id >= 4; }
    static constexpr bool PERM = true;
    bf16_t* O;
    unsigned char* scr;
    __device__ __forceinline__ void operator()(const f32x4 (&acc)[2][2][4][2], const GUnit& u, int wr, int wc, int fr, int fq) const {
        EPI_OPAQUE();
        const int tid = (wr * 4 + wc) * 64 + fq * 16 + fr;
        const int sub = u.id;
        const rsrc_t rs = __builtin_amdgcn_make_buffer_rsrc(scr, 0, 524288, 0x00020000);
        if (sub < 4) {
#pragma unroll
            for (int ai = 0; ai < 2; ++ai)
#pragma unroll
                for (int bj = 0; bj < 2; ++bj)
#pragma unroll
                    for (int m = 0; m < 4; ++m)
#pragma unroll
                        for (int n = 0; n < 2; ++n) { const int q = ((ai * 2 + bj) * 4 + m) * 2 + n; const f32x4 v = acc[ai][bj][m][n];
                            u32x2 w; w.x = cvtpk(v[0], v[1]); w.y = cvtpk(v[2], v[3]);
                            __builtin_amdgcn_raw_buffer_store_b64(w, rs, tid * 8, (sub * 32 + q) * 4096, 0); }
            return;
        }
        const int j = sub - 4;
        const int row0 = u.pm * BM + wr * 64 + fr, col0 = u.pn * BM + 64 * j + wc * 16 + 4 * fq;
#pragma unroll
        for (int ai = 0; ai < 2; ++ai) {
            u32x2 sv[4][4];
#pragma unroll
            for (int m = 0; m < 4; ++m)
#pragma unroll
                for (int g = 0; g < 4; ++g) { const int qb = (ai * 16 + m * 2);
                    sv[m][g] = (j == 0) ? __builtin_amdgcn_raw_buffer_load_b64(rs, tid * 8, (g * 32 + qb) * 4096, 0)
                             : (j == 1) ? __builtin_amdgcn_raw_buffer_load_b64(rs, tid * 8, (g * 32 + qb + 1) * 4096, 0)
                             : (j == 2) ? __builtin_amdgcn_raw_buffer_load_b64(rs, tid * 8, (g * 32 + qb + 8) * 4096, 0)
                                        : __builtin_amdgcn_raw_buffer_load_b64(rs, tid * 8, (g * 32 + qb + 9) * 4096, 0); }
#pragma unroll
            for (int m = 0; m < 4; ++m) { bf16_t* rowp = O + (size_t)(row0 + ai * HALF + m * 16) * DM + col0;
                f32x4 t = {0.f, 0.f, 0.f, 0.f};
#pragma unroll
                for (int g = 0; g < 4; ++g) { const f32x4 gt = acc[ai][g >> 1][m][g & 1]; const u32x2 s = sv[m][g];
                    constexpr float GS = -GATE_UNSCALE * LOG2E;
                    t[0] += fast_rcp(1.0f + fast_exp2(gt[0] * GS)) * __uint_as_float(s.x << 16); t[1] += fast_rcp(1.0f + fast_exp2(gt[1] * GS)) * __uint_as_float(s.x & 0xffff0000u);
                    t[2] += fast_rcp(1.0f + fast_exp2(gt[2] * GS)) * __uint_as_float(s.y << 16); t[3] += fast_rcp(1.0f + fast_exp2(gt[3] * GS)) * __uint_as_float(s.y & 0xffff0000u); }
                u32x2 w; w.x = cvtpk(t[0], t[1]); w.y = cvtpk(t[2], t[3]);
                *(u32x2*)rowp = w; }
            asm volatile("" ::: "memory"); }
    }
};
__device__ __forceinline__ float dpp_ror1(float v) { return __uint_as_float((unsigned)__builtin_amdgcn_mov_dpp((int)__float_as_uint(v), 0x121, 0xf, 0xf, false)); }
__device__ __forceinline__ float dpp_ror2(float v) { return __uint_as_float((unsigned)__builtin_amdgcn_mov_dpp((int)__float_as_uint(v), 0x122, 0xf, 0xf, false)); }
struct EpiUpConv {
    static constexpr int KIND = 8;
    static constexpr bool PERM = true;
    bf16_t* ACT; float* HB; const float* cw; const float* cb;
    __device__ __forceinline__ void operator()(const f32x4 (&acc)[2][2][4][2], const GUnit& u, int wr, int wc, int fr, int fq) const {
        EPI_OPAQUE();
        const int colL = wc * 32 + 8 * fq;
        const bool l0 = (fr == 0), l01 = (fr < 2);
#pragma unroll
        for (int n = 0; n < 2; ++n) {
            const int cl = colL + 4 * n, c0 = u.pn * 128 + cl;
            const f32x4 bg = *(const f32x4*)(cb + c0), w0g = *(const f32x4*)(cw + c0), w1g = *(const f32x4*)(cw + DFF2 + c0), w2g = *(const f32x4*)(cw + 2 * DFF2 + c0);
            const f32x4 bv = *(const f32x4*)(cb + DFF + c0), w0v = *(const f32x4*)(cw + DFF + c0), w1v = *(const f32x4*)(cw + DFF2 + DFF + c0), w2v = *(const f32x4*)(cw + 2 * DFF2 + DFF + c0);
            f32x4 w1ga, w1gb, w0ga, w0gb, w1va, w1vb, w0va, w0vb;
#pragma unroll
            for (int e = 0; e < 4; ++e) { w1ga[e] = l0 ? 0.f : w1g[e]; w1gb[e] = l0 ? w1g[e] : 0.f; w0ga[e] = l01 ? 0.f : w0g[e]; w0gb[e] = l01 ? w0g[e] : 0.f;
                                          w1va[e] = l0 ? 0.f : w1v[e]; w1vb[e] = l0 ? w1v[e] : 0.f; w0va[e] = l01 ? 0.f : w0v[e]; w0vb[e] = l01 ? w0v[e] : 0.f; }
#pragma unroll
            for (int ai = 0; ai < 2; ++ai) {
                const int rowg = u.pm * BM + ai * HALF + wr * 64, g = rowg >> 6;
#pragma unroll
                for (int m = 0; m < 4; ++m) {
                    const f32x4 cg = acc[ai][0][m][n], cv = acc[ai][1][m][n];
                    f32x4 o;
#pragma unroll
                    for (int e = 0; e < 4; ++e) {
                        float gt = fmaf(w2g[e], cg[e], bg[e]), vl = fmaf(w2v[e], cv[e], bv[e]);
                        gt = fmaf(dpp_ror1(cg[e]), w1ga[e], gt); gt = fmaf(dpp_ror2(cg[e]), w0ga[e], gt);
                        vl = fmaf(dpp_ror1(cv[e]), w1va[e], vl); vl = fmaf(dpp_ror2(cv[e]), w0va[e], vl);
                        if (m > 0) { const float pg = acc[ai][0][m - 1][n][e], pv = acc[ai][1][m - 1][n][e];
                            gt = fmaf(dpp_ror1(pg), w1gb[e], gt); gt = fmaf(dpp_ror2(pg), w0gb[e], gt);
                            vl = fmaf(dpp_ror1(pv), w1vb[e], vl); vl = fmaf(dpp_ror2(pv), w0vb[e], vl); }
                        o[e] = gt * sigmoid_f(gt) * vl; }
                    const int row = rowg + m * 16 + fr;
                    if (!(m == 0 && fr < 2)) { u32x2 w; w.x = cvtpk(o[0], o[1]); w.y = cvtpk(o[2], o[3]); *(u32x2*)(ACT + (size_t)row * DFF + c0) = w; }
                    if (m == 0 && fr < 2) { float* hp = HB + ((size_t)((g * 4 + fr) * 22 + u.pn) * 256 + cl); *(f32x4*)hp = cg; *(f32x4*)(hp + 128) = cv; }
                    if (m == 3 && fr >= 14) { float* hp = HB + ((size_t)((g * 4 + fr - 12) * 22 + u.pn) * 256 + cl); *(f32x4*)hp = cg; *(f32x4*)(hp + 128) = cv; }
                }
            }
            asm volatile("" ::: "memory");
        }
    }
};
}
#define XB_TMO      128
#define XB_XCNT(j)  (256  + 64 * (j))
#define XB_XSUB(j)  (1280 + 64 * (j))
#define XB_XGEN(j)  (2304 + 64 * (j))
#define XB_TOP      3328
#define XB_TOPGEN   3392
#define XCD_BAR_WORDS 3456
#define XB_SPIN_CAP (1u << 22)
__device__ __forceinline__ unsigned xb_ld(unsigned* p)              { return __hip_atomic_load(p, __ATOMIC_RELAXED, __HIP_MEMORY_SCOPE_AGENT); }
__device__ __forceinline__ unsigned xb_add(unsigned* p, unsigned v) { return __hip_atomic_fetch_add(p, v, __ATOMIC_RELAXED, __HIP_MEMORY_SCOPE_AGENT); }
__device__ __forceinline__ unsigned xb_xcc_id() { return (unsigned)__builtin_amdgcn_s_getreg((3 << 11) | 20) & 0xFu; }
#define XB_SPIN(cond, bar) do { unsigned _sp = 0; while (cond) { __builtin_amdgcn_s_sleep(1); \
    if ((++_sp & 255u) == 0u) { if (xb_ld(&(bar)[XB_TMO])) break; if (_sp > XB_SPIN_CAP) { atomicAdd(&(bar)[XB_TMO], 1u); break; } } } } while (0)
struct XcdBarrier { unsigned* bar; unsigned x; volatile LAS unsigned* st; };
__device__ __forceinline__ XcdBarrier xcd_barrier_post(unsigned* bar, volatile LAS unsigned* st) {
    XcdBarrier b; b.bar = bar; b.x = xb_xcc_id(); b.st = st;
    if (threadIdx.x == 0) (void)xb_add(&bar[XB_XCNT(b.x)], 1u);
    return b;
}
__device__ __forceinline__ void xcd_barrier_complete(unsigned* bar, unsigned x, unsigned& nloc, unsigned& nx) {
    const unsigned G = gridDim.x * gridDim.y * gridDim.z;
    unsigned sum, cnt, mine, sp = 0u;
    for (;;) {
        sum = 0u; cnt = 0u; mine = 0u;
#pragma unroll
        for (unsigned j = 0; j < 16; ++j) { const unsigned c = xb_ld(&bar[XB_XCNT(j)]); sum += c; cnt += (c > 0u) ? 1u : 0u; mine = (j == x) ? c : mine; }
        if (sum == G) break;
        __builtin_amdgcn_s_sleep(1);
        if ((++sp & 255u) == 0u) { if (xb_ld(&bar[XB_TMO])) break; if (sp > XB_SPIN_CAP) { atomicAdd(&bar[XB_TMO], 1u); break; } }
    }
    nloc = mine > 0u ? mine : 1u; nx = cnt > 0u ? cnt : 1u;
}
__device__ __forceinline__ void xcd_barrier(const XcdBarrier& b) {
    asm volatile("s_waitcnt vmcnt(0)" ::: "memory");
    __syncthreads();
    if (threadIdx.x == 0) {
        unsigned* bar = b.bar; unsigned bx = b.x;
        asm volatile("" : "+s"(bx));
        __builtin_amdgcn_s_waitcnt(0);
        unsigned nloc = b.st[0], nx = b.st[1];
        if (nloc == 0u) { xcd_barrier_complete(bar, bx, nloc, nx); b.st[0] = nloc; b.st[1] = nx; }
        const unsigned old = xb_add(&bar[XB_XSUB(bx)], 1u);
        const unsigned gen = old / nloc;
        if (old + 1u == (gen + 1u) * nloc) {
            __builtin_amdgcn_fence(__ATOMIC_RELEASE, "agent");
            asm volatile("s_waitcnt vmcnt(0)" ::: "memory");
            const unsigned og = xb_add(&bar[XB_TOP], 1u);
            const unsigned tg = og / nx;
            if (og + 1u == (tg + 1u) * nx) xb_add(&bar[XB_TOPGEN], 1u);
            else XB_SPIN(xb_ld(&bar[XB_TOPGEN]) == tg, bar);
            __builtin_amdgcn_fence(__ATOMIC_ACQUIRE, "agent");
            xb_add(&bar[XB_XGEN(bx)], 1u);
            asm volatile("s_waitcnt vmcnt(0)" ::: "memory");
        } else {
            XB_SPIN(xb_ld(&bar[XB_XGEN(bx)]) == gen, bar);
            __builtin_amdgcn_fence(__ATOMIC_ACQUIRE, "agent");
            asm volatile("s_waitcnt vmcnt(0)" ::: "memory");
        }
    }
    __syncthreads();
}

#define MFMA32(a, b, c) __builtin_amdgcn_mfma_f32_32x32x16_bf16(a, b, c, 0, 0, 0)
typedef short v4i16_t __attribute__((ext_vector_type(4)));
typedef LAS const char* lds_cptr;
typedef LAS char* lds_ptr;
__device__ __forceinline__ int crow(int r, int hi) { return (r & 3) + 8 * (r >> 2) + 4 * hi; }
__device__ __forceinline__ s16x4 vtr(lds_cptr p) { return __builtin_bit_cast(s16x4, __builtin_amdgcn_ds_read_tr16_b64_v4i16((LAS v4i16_t*)p)); }
__device__ __forceinline__ float other_half(float x, int hi) { auto rr = __builtin_amdgcn_permlane32_swap(__float_as_uint(x), __float_as_uint(x), false, false); return __uint_as_float(hi ? rr[0] : rr[1]); }
constexpr float NEG_INF = -INFINITY;

constexpr int TB_V = 12288, TB_KB = 20480, TB_SIZE = 20992;
struct Stg { u32x4 k, k2, v; float kb; };

template <int NKS> __device__ __forceinline__ void qk64(lds_cptr kbuf, const bf16x8* qf, int r32, int hi, f32x16& p0, f32x16& p1) {
    lds_cptr kp = kbuf + hi * 1024 + r32 * 16;
#pragma unroll
    for (int ks = 0; ks < NKS; ++ks) {
        const bf16x8 a0 = *(const LAS bf16x8*)(kp + ks * 2048), a1 = *(const LAS bf16x8*)(kp + ks * 2048 + 512);
        p0 = MFMA32(a0, qf[ks], p0); p1 = MFMA32(a1, qf[ks], p1);
    }
}
template <int NKS> __device__ __forceinline__ void qk64c(lds_cptr kbuf, const bf16x8* qf, int r32, int hi, const f32x16& c, f32x16& p0, f32x16& p1) {
    lds_cptr kp = kbuf + hi * 1024 + r32 * 16;
    { const bf16x8 a0 = *(const LAS bf16x8*)(kp), a1 = *(const LAS bf16x8*)(kp + 512); p0 = MFMA32(a0, qf[0], c); p1 = MFMA32(a1, qf[0], c); }
#pragma unroll
    for (int ks = 1; ks < NKS; ++ks) {
        const bf16x8 a0 = *(const LAS bf16x8*)(kp + ks * 2048), a1 = *(const LAS bf16x8*)(kp + ks * 2048 + 512);
        p0 = MFMA32(a0, qf[ks], p0); p1 = MFMA32(a1, qf[ks], p1);
    }
}
struct AState { f32x16 o0, o1; float m, l; };
__device__ __forceinline__ void astate_init(AState& s) {
#pragma unroll
    for (int r = 0; r < 16; ++r) { s.o0[r] = 0.f; s.o1[r] = 0.f; }
    s.m = NEG_INF; s.l = 0.f;
}
__device__ __forceinline__ void pv64(f32x16& o0, f32x16& o1, lds_cptr vp, const bf16x8 (&pf)[4]) {
#pragma unroll
    for (int ks = 0; ks < 4; ++ks) {
        const s16x4 l0 = vtr(vp + ks * 1024), h0 = vtr(vp + ks * 1024 + 512), l1 = vtr(vp + 4096 + ks * 1024), h1 = vtr(vp + 4096 + ks * 1024 + 512);
        const bf16x8 v0 = (bf16x8){l0[0], l0[1], l0[2], l0[3], h0[0], h0[1], h0[2], h0[3]}, v1 = (bf16x8){l1[0], l1[1], l1[2], l1[3], h1[0], h1[1], h1[2], h1[3]};
        o0 = MFMA32(v0, pf[ks], o0); o1 = MFMA32(v1, pf[ks], o1);
    }
}
struct VFrag { bf16x8 v0[4], v1[4]; };
__device__ __forceinline__ void v_load64(VFrag& f, lds_cptr vp) {
#pragma unroll
    for (int ks = 0; ks < 4; ++ks) {
        const s16x4 l0 = vtr(vp + ks * 1024), h0 = vtr(vp + ks * 1024 + 512), l1 = vtr(vp + 4096 + ks * 1024), h1 = vtr(vp + 4096 + ks * 1024 + 512);
        f.v0[ks] = (bf16x8){l0[0], l0[1], l0[2], l0[3], h0[0], h0[1], h0[2], h0[3]}; f.v1[ks] = (bf16x8){l1[0], l1[1], l1[2], l1[3], h1[0], h1[1], h1[2], h1[3]};
    }
}
__device__ __forceinline__ void pv64f(f32x16& o0, f32x16& o1, const VFrag& f, const bf16x8 (&pf)[4]) {
#pragma unroll
    for (int ks = 0; ks < 4; ++ks) { o0 = MFMA32(f.v0[ks], pf[ks], o0); o1 = MFMA32(f.v1[ks], pf[ks], o1); }
}
__device__ __forceinline__ void pack_p(const f32x16& p0, const f32x16& p1, bf16x8 (&pf)[4]) {
    u32x4 w0, w1, w2, w3;
    w0.x = cvtpk(p0[0], p0[1]); w0.y = cvtpk(p0[2], p0[3]); w0.z = cvtpk(p0[4], p0[5]); w0.w = cvtpk(p0[6], p0[7]);
    w1.x = cvtpk(p0[8], p0[9]); w1.y = cvtpk(p0[10], p0[11]); w1.z = cvtpk(p0[12], p0[13]); w1.w = cvtpk(p0[14], p0[15]);
    w2.x = cvtpk(p1[0], p1[1]); w2.y = cvtpk(p1[2], p1[3]); w2.z = cvtpk(p1[4], p1[5]); w2.w = cvtpk(p1[6], p1[7]);
    w3.x = cvtpk(p1[8], p1[9]); w3.y = cvtpk(p1[10], p1[11]); w3.z = cvtpk(p1[12], p1[13]); w3.w = cvtpk(p1[14], p1[15]);
    pf[0] = __builtin_bit_cast(bf16x8, w0); pf[1] = __builtin_bit_cast(bf16x8, w1); pf[2] = __builtin_bit_cast(bf16x8, w2); pf[3] = __builtin_bit_cast(bf16x8, w3);
}
__device__ __forceinline__ void softmax_pv64(f32x16& p0, f32x16& p1, AState& s, lds_cptr vp, int hi) {
    VFrag vf; v_load64(vf, vp); __builtin_amdgcn_sched_barrier(0);
    float mx = fmaxf(p0[0], p1[0]);
#pragma unroll
    for (int r = 1; r < 16; ++r) mx = fmaxf(mx, fmaxf(p0[r], p1[r]));
    mx = fmaxf(mx, other_half(mx, hi));
    const float mn = fmaxf(s.m, mx), ms = (mn == NEG_INF) ? 0.f : mn;
    const float alpha = fast_exp2(s.m - ms);
    float rs = 0.f;
#pragma unroll
    for (int r = 0; r < 16; ++r) { p0[r] = fast_exp2(p0[r] - ms); p1[r] = fast_exp2(p1[r] - ms); rs += p0[r] + p1[r]; }
    rs += other_half(rs, hi);
    s.l = s.l * alpha + rs; s.m = mn;
#pragma unroll
    for (int r = 0; r < 16; ++r) { s.o0[r] *= alpha; s.o1[r] *= alpha; }
    bf16x8 pf[4]; pack_p(p0, p1, pf);
    pv64f(s.o0, s.o1, vf, pf);
}
__device__ __forceinline__ void softmax_fixed_pv64(f32x16& p0, f32x16& p1, AState& s, lds_cptr vp) {
    VFrag vf; v_load64(vf, vp); __builtin_amdgcn_sched_barrier(0);
    float rs = 0.f;
#pragma unroll
    for (int r = 0; r < 16; ++r) { p0[r] = fast_exp2(p0[r]); p1[r] = fast_exp2(p1[r]); rs += p0[r] + p1[r]; }
    s.l += rs;
    bf16x8 pf[4]; pack_p(p0, p1, pf);
    pv64f(s.o0, s.o1, vf, pf);
}
__device__ __forceinline__ void mask_causal(f32x16& p0, f32x16& p1, int kpos0, int tq, int hi) {
#pragma unroll
    for (int r = 0; r < 16; ++r) { const int kp = kpos0 + crow(r, hi); if (kp > tq) p0[r] = NEG_INF; if (kp + 32 > tq) p1[r] = NEG_INF; }
}
__device__ __forceinline__ void add_table(f32x16& p0, f32x16& p1, const LAS float* tb) {
#pragma unroll
    for (int r = 0; r < 16; ++r) { const int o = (r & 3) + 8 * (r >> 2); p0[r] += tb[o]; p1[r] += tb[o + 32]; }
}
__device__ __forceinline__ void store_o_bf16(bf16_t* orow, const f32x16& o0, const f32x16& o1, float sc, int hi) {
#pragma unroll
    for (int g = 0; g < 4; ++g) {
        u32x2 w0, w1; w0.x = cvtpk(o0[4 * g] * sc, o0[4 * g + 1] * sc); w0.y = cvtpk(o0[4 * g + 2] * sc, o0[4 * g + 3] * sc);
        w1.x = cvtpk(o1[4 * g] * sc, o1[4 * g + 1] * sc); w1.y = cvtpk(o1[4 * g + 2] * sc, o1[4 * g + 3] * sc);
        *(u32x2*)(orow + 8 * g + 4 * hi) = w0; *(u32x2*)(orow + 32 + 8 * g + 4 * hi) = w1;
    }
}
constexpr size_t MiB = 1u << 20, KiB = 1u << 10;
constexpr size_t WS_CTL = 0, CTL_ZERO_BYTES = 1 * MiB;
constexpr size_t WS_ROPE = 1 * MiB, WS_NSATAB = WS_ROPE + 512 * KiB, WS_DILTAB = WS_NSATAB + 32 * KiB, WS_CMPB = WS_DILTAB + 8 * KiB, WS_FARB = WS_CMPB + 4 * KiB;
constexpr size_t WS_WT = 4 * MiB, LW = 38 * MiB;
constexpr size_t LW_IN = 0, LW_G = 6 * MiB, LW_BR = 14 * MiB, LW_O = 16 * MiB, LW_UP = 18 * MiB, LW_DN = 29 * MiB, LW_UQ = 35 * MiB, LW_UKV = 35 * MiB + 256 * KiB, LW_PHI = 36 * MiB;
constexpr size_t BR_A = 0, BR_B = 512 * KiB, BR_C = 768 * KiB, BR_D = 1280 * KiB;
constexpr size_t WS_SIDE = 80 * MiB, WS_SSQQ = 84 * MiB, WS_SSQKV = 85 * MiB, WS_KB = 86 * MiB, WS_KROT = 87 * MiB, WS_KCMP = 91 * MiB, WS_VCMP = 100 * MiB,
                 WS_HID = 109 * MiB, WS_KMAX = 3 * MiB + 128 * KiB  , WS_LF = 2 * MiB  , WS_CMPP = 3 * MiB  , WS_ORDER = 3 * MiB + 64 * KiB  , WS_KC = 113 * MiB, WS_VC = 113 * MiB + 512 * KiB, WS_DLSE = 114 * MiB, WS_DOG = 116 * MiB;
constexpr size_t WS_H = 164 * MiB, WS_OCAT = 292 * MiB, WS_QM = 404 * MiB, WS_KVM = 468 * MiB, WS_P = 532 * MiB;
constexpr size_t WS_MERGED = 532 * MiB, WS_MSCR = 660 * MiB, WS_Y = 164 * MiB  , WS_H2 = 756 * MiB, WS_ACT = 164 * MiB  , WS_HB = 532 * MiB  , WS_Y2 = 884 * MiB  , WS_X3 = 620 * MiB  , WS_END = 1024 * MiB;
constexpr size_t MSCR_PER_WG = 512 * KiB;
constexpr size_t H8_OFF = 128 * MiB;
static_assert(WS_WT + 2 * LW <= WS_SIDE && WS_DOG + 48 * MiB <= WS_H && WS_P + 384 * MiB <= WS_END && WS_MSCR + 256 * MSCR_PER_WG <= WS_P + 384 * MiB && WS_H2 + 128 * MiB <= WS_Y2 && WS_Y2 + 128 * MiB <= WS_END, "ws map");
static_assert(WS_ACT + 352 * MiB <= WS_HB && WS_HB + 88 * MiB <= WS_X3 && WS_X3 + 128 * MiB <= WS_H2 && WS_Y + 128 * MiB <= WS_OCAT, "ws overlays");
constexpr int CW_BAR = 4096;
constexpr int CW_KMAX = 24576;
constexpr int CW_KMLA = 24832;
constexpr int CW_KROT = 25344;
constexpr int CW_Q = 16384;

constexpr int RING_BYTES = 131072, LDSCTL_OFF = RING_BYTES, MISC_OFF = LDSCTL_OFF + 320, LDS_BYTES = 147456;
constexpr int NSA_SLAB = 49152, NSA_SLAB_BYTES = 4 * 64 * 65 * 4, NSA_SEL = NSA_SLAB + NSA_SLAB_BYTES;
static_assert(NSA_SEL + 512 <= RING_BYTES && 4 * NSA_TL * 4 <= NSA_SLAB_BYTES && 2 * TB_SIZE <= NSA_SLAB, "NSA LDS map");

struct Frame {
    LAS unsigned char* lds; volatile LAS unsigned* MISC; gu32* ctl;
    int tid, lane, wave, G;
    const float* in[27]; float* out; unsigned char* ws;
};
#define WSP(T, off) ((T*)(F.ws + (off)))
#define VM_WAIT() asm volatile("s_waitcnt vmcnt(0)" ::: "memory")
#define LDS_WAIT() asm volatile("s_waitcnt lgkmcnt(0)" ::: "memory")

__device__ __forceinline__ int queue_grab(Frame& F, gu32* ctr) {
    if (F.tid == 0) F.MISC[0] = __hip_atomic_fetch_add(ctr, 1u, __ATOMIC_RELAXED, __HIP_MEMORY_SCOPE_AGENT);
    __syncthreads();
    const int v = (int)F.MISC[0];
    __syncthreads();
    return v;
}

template <bool FOX> __device__ __forceinline__ void causal_unit(Frame& F, int b, int h, int qb, float kmax_in) {
    constexpr int NKS = FOX ? 4 : 6;
    int lane_o = F.lane; asm volatile("" : "+v"(lane_o));
    const int wid = F.wave, lane = lane_o, r32 = lane & 31, hi = lane >> 5;
    const size_t rowbase = (size_t)b * SEQ;
    const int q0 = qb * 256, tq = q0 + wid * 32 + r32, NT = qb * 4 + 4;
    const bf16_t* P = WSP(const bf16_t, WS_P);
    const bf16_t *Kb, *Vb, *Qrow; int kpitch, vpitch;
    const bf16_t* Kr = WSP(const bf16_t, WS_KROT) + rowbase * 32;
    const float* kbsrc = WSP(const float, WS_KB) + (size_t)(b * 4 + h) * SEQ;
    if (FOX) { Kb = P + rowbase * PW + PC_CK + h * 64; Vb = P + rowbase * PW + PC_CV + h * 64; kpitch = PW; vpitch = PW; Qrow = P + (rowbase + tq) * PW + PC_CQ + h * 64; }
    else { const bf16_t* KV = WSP(const bf16_t, WS_KVM) + rowbase * 512 + h * 128; Kb = KV; Vb = KV + 64; kpitch = 512; vpitch = 512; Qrow = WSP(const bf16_t, WS_QM) + (rowbase + tq) * 512 + h * 96; }
    bf16x8 qf[NKS];
#pragma unroll
    for (int ks = 0; ks < NKS; ++ks) qf[ks] = *(const bf16x8*)(Qrow + ks * 16 + hi * 8);
    AState st; astate_init(st);
    lds_ptr lds = (lds_ptr)F.lds;
    const int vpo = ((lane >> 4) & 1) * 32 + (lane & 3) * 8 + (4 * hi + ((lane & 15) >> 2)) * 64;
    Stg sA, sB;
#define CU_LOAD(S, t) do { S.k = *(const u32x4*)(Kb + (size_t)((t) * 64 + lane) * kpitch + wid * 8); \
        if (!FOX) { if (wid < 4) S.k2 = *(const u32x4*)(Kr + (size_t)((t) * 64 + lane) * 32 + wid * 8); } \
        S.v = *(const u32x4*)(Vb + (size_t)((t) * 64 + 16 * (wid & 3) + (lane >> 2)) * vpitch + (wid >> 2) * 32 + (lane & 3) * 8); \
        if (FOX) { if (wid == 0) S.kb = kbsrc[(t) * 64 + lane]; else if (wid == 1) S.kb = kbsrc[(t) > 0 ? (t) * 64 - 1 : 0]; } } while (0)
#define CU_WRITE(S, bi) do { lds_ptr bp = lds + (bi) * TB_SIZE; *(LAS u32x4*)(bp + wid * 1024 + lane * 16) = S.k; \
        if (!FOX) { if (wid < 4) *(LAS u32x4*)(bp + (8 + wid) * 1024 + lane * 16) = S.k2; } \
        *(LAS u32x4*)(bp + TB_V + wid * 1024 + lane * 16) = S.v; \
        if (FOX) { if (wid == 0) *(LAS float*)(bp + TB_KB + lane * 4) = S.kb; else if (wid == 1 && lane == 0) *(LAS float*)(bp + TB_KB + 256) = S.kb; } } while (0)
    const int tq_lo = q0 + wid * 32;
    float qn = 0.f; const float kmax = kmax_in;
#pragma unroll
    for (int ks = 0; ks < NKS; ++ks)
#pragma unroll
        for (int e = 0; e < 8; ++e) { const float x = bf2f((unsigned short)qf[ks][e]); qn += x * x; }
    qn += other_half(qn, hi); qn = sqrtf(qn);
    const float bnd = qn * kmax * 1.002f + 0.05f;
    const bool fast = __all(bnd <= 50.0f);
    const float kbi = FOX ? kbsrc[tq] : 0.f;
    f32x16 cinit;
    { const float c0 = -(bnd + kbi);
#pragma unroll
      for (int r = 0; r < 16; ++r) cinit[r] = c0; }
    LAS volatile unsigned* dflag = (LAS volatile unsigned*)(lds + 2 * TB_SIZE + 64);
    const int t_first = FOX ? NT - 1 : 0, t_step = FOX ? -1 : 1;
#define CU_STEP(TT, BI, SL, SW) { const int tt = (TT), t = t_first + tt * t_step; \
        if (tt + 2 < NT) CU_LOAD(SL, t + 2 * t_step); \
        lds_cptr bp = (lds_cptr)(lds + (BI) * TB_SIZE); \
        if (64 * t <= tq_lo + 31) {                                \
            f32x16 p0, p1; \
            if (fast) qk64c<NKS>(bp, qf, r32, hi, cinit, p0, p1); \
            else { _Pragma("unroll") for (int r = 0; r < 16; ++r) { p0[r] = 0.f; p1[r] = 0.f; } qk64<NKS>(bp, qf, r32, hi, p0, p1); } \
            if (FOX) { const LAS float* kbt = (const LAS float*)(bp + TB_KB) + 4 * hi; \
                _Pragma("unroll") for (int g = 0; g < 4; ++g) { const f32x4 a = *(const LAS f32x4*)(kbt + 8 * g), c = *(const LAS f32x4*)(kbt + 32 + 8 * g); \
                    _Pragma("unroll") for (int e = 0; e < 4; ++e) { p0[4 * g + e] += a[e]; p1[4 * g + e] += c[e]; } } } \
            if (64 * t + 63 > tq_lo) mask_causal(p0, p1, 64 * t, tq, hi); \
            if (fast) softmax_fixed_pv64(p0, p1, st, bp + TB_V + vpo); else softmax_pv64(p0, p1, st, bp + TB_V + vpo, hi); \
        } \
          \
        if (FOX) { if (t > 0) { const float kb_last = *(const LAS float*)(bp + TB_KB + 256); const bool done = fast ? ((kb_last - kbi) < -150.0f) : ((qn * kmax + kb_last - st.m) < -130.0f); const unsigned alld = __all(done) ? 1u : 0u; if (lane == 0) dflag[(BI) * 8 + wid] = alld; } } \
        if (tt + 1 < NT) CU_WRITE(SW, (BI) ^ 1); \
        __syncthreads(); \
        if (FOX) { if (t > 0) { unsigned all = 1u; _Pragma("unroll") for (int w = 0; w < 8; ++w) all &= dflag[(BI) * 8 + w]; if (all) break; } } }
    CU_LOAD(sA, t_first); CU_WRITE(sA, 0);
    CU_LOAD(sA, t_first + t_step);
    __syncthreads();
    for (int t2 = 0; t2 < NT; t2 += 2) {
        CU_STEP(t2, 0, sB, sA)
        CU_STEP(t2 + 1, 1, sA, sB)
    }
#undef CU_STEP
#undef CU_LOAD
#undef CU_WRITE
    bf16_t* orow = WSP(bf16_t, WS_OCAT) + (rowbase + tq) * OCW + (FOX ? 384 : 640) + h * 64;
    const float ltot = fast ? st.l + other_half(st.l, hi) : st.l;
    store_o_bf16(orow, st.o0, st.o1, 1.0f / ltot, hi);
}
__device__ __forceinline__ void nsa_unit(Frame& F, int b, int qblk) {
    int lane_o = F.lane; asm volatile("" : "+v"(lane_o));
    const int wid = F.wave, lane = lane_o, r32 = lane & 31, hi = lane >> 5, tid = wid * 64 + lane;
    const int h = wid & 3, qs = wid >> 2;
    const int q0 = qblk * 64, cur = qblk, tq = q0 + 32 * qs + r32, tq_lo = q0 + 32 * qs;
    const size_t rowbase = (size_t)b * SEQ, row = rowbase + tq;
    const bf16_t* P = WSP(const bf16_t, WS_P);
    lds_ptr lds = (lds_ptr)F.lds;
    const int vpo = ((lane >> 4) & 1) * 32 + (lane & 3) * 8 + (4 * hi + ((lane & 15) >> 2)) * 64;
    bf16x8 qf[4];
    { const bf16_t* Qrow = P + row * PW + PC_AQ + h * 64;
#pragma unroll
      for (int ks = 0; ks < 4; ++ks) qf[ks] = *(const bf16x8*)(Qrow + ks * 16 + hi * 8); }
    Stg s; int ln;
#define NS_LOAD(Kb, kp, Vb, vp_, t) do { s.k = *(const u32x4*)((Kb) + (size_t)((t) * 64 + ln) * (kp) + wid * 8); \
        s.v = *(const u32x4*)((Vb) + (size_t)((t) * 64 + 16 * (wid & 3) + (ln >> 2)) * (vp_) + (wid >> 2) * 32 + (ln & 3) * 8); } while (0)
#define NS_FRESH() do { ln = lane; asm volatile("" : "+v"(ln)); } while (0)
#define NS_WRITE(bi) do { lds_ptr bp_ = lds + (bi) * TB_SIZE; *(LAS u32x4*)(bp_ + wid * 1024 + lane * 16) = s.k; *(LAS u32x4*)(bp_ + TB_V + wid * 1024 + lane * 16) = s.v; } while (0)
    const bf16_t* KC = WSP(const bf16_t, WS_KC) + (size_t)b * 256 * 64; const bf16_t* VC = WSP(const bf16_t, WS_VC) + (size_t)b * 256 * 64;
    const int cmax_u = (q0 + 63 - 31) >> 4, NTc = (cmax_u >> 6) + 1;
    const int cmax = (tq - 31) >> 4;
    float cm = NEG_INF, cl = 0.f;
    NS_FRESH(); NS_LOAD(KC, 64, VC, 64, 0); NS_WRITE(0);
    __syncthreads();
    for (int t = 0; t < NTc; ++t) {
        const int bi = t & 1;
        if (t + 1 < NTc) NS_LOAD(KC, 64, VC, 64, t + 1);
        { lds_cptr bp = (lds_cptr)(lds + bi * TB_SIZE); f32x16 p0, p1;
#pragma unroll
          for (int r = 0; r < 16; ++r) { p0[r] = 0.f; p1[r] = 0.f; }
          qk64<4>(bp, qf, r32, hi, p0, p1);
          float mx = NEG_INF;
#pragma unroll
          for (int r = 0; r < 16; ++r) { const int c = 64 * t + crow(r, hi); if (c > cmax) p0[r] = NEG_INF; if (c + 32 > cmax) p1[r] = NEG_INF; mx = fmaxf(mx, fmaxf(p0[r], p1[r])); }
          mx = fmaxf(mx, other_half(mx, hi));
          const float mn = fmaxf(cm, mx), ms = (mn == NEG_INF) ? 0.f : mn; float rs = 0.f;
#pragma unroll
          for (int r = 0; r < 16; ++r) rs += fast_exp2(p0[r] - ms) + fast_exp2(p1[r] - ms);
          rs += other_half(rs, hi);
          cl = cl * fast_exp2(cm - ms) + rs; cm = mn; }
        if (t + 1 < NTc) NS_WRITE(bi ^ 1);
        __syncthreads();
    }
    const float cms = (cm == NEG_INF) ? 0.f : cm, cinv = 1.0f / fmaxf(cl, 1e-30f);
    f32x16 oc0, oc1;
#pragma unroll
    for (int r = 0; r < 16; ++r) { oc0[r] = 0.f; oc1[r] = 0.f; }
    float G[32]; float carry = 0.f;
#pragma unroll
    for (int i = 0; i < 32; ++i) G[i] = 0.f;
    NS_FRESH(); NS_LOAD(KC, 64, VC, 64, 0); NS_WRITE(0);
    __syncthreads();
#pragma unroll
    for (int t = 0; t < 4; ++t) {
        if (t < NTc) {
            const int bi = t & 1;
            if (t + 1 < NTc) NS_LOAD(KC, 64, VC, 64, t + 1);
            { lds_cptr bp = (lds_cptr)(lds + bi * TB_SIZE); f32x16 p0, p1;
#pragma unroll
              for (int r = 0; r < 16; ++r) { p0[r] = 0.f; p1[r] = 0.f; }
              qk64<4>(bp, qf, r32, hi, p0, p1);
#pragma unroll
              for (int r = 0; r < 16; ++r) { const int c = 64 * t + crow(r, hi);
                  p0[r] = (c > cmax) ? 0.f : fast_exp2(p0[r] - cms) * cinv; p1[r] = (c + 32 > cmax) ? 0.f : fast_exp2(p1[r] - cms) * cinv; }
#pragma unroll
              for (int g = 0; g < 4; ++g) { const float oth = other_half(p0[4 * g + 3], hi);
                  G[t * 8 + g] = ((p0[4 * g] + p0[4 * g + 1]) + (p0[4 * g + 2] + p0[4 * g + 3])) + (hi ? oth : carry); carry = oth; }
#pragma unroll
              for (int g = 0; g < 4; ++g) { const float oth = other_half(p1[4 * g + 3], hi);
                  G[t * 8 + 4 + g] = ((p1[4 * g] + p1[4 * g + 1]) + (p1[4 * g + 2] + p1[4 * g + 3])) + (hi ? oth : carry); carry = oth; }
              bf16x8 pf[4]; pack_p(p0, p1, pf);
              pv64(oc0, oc1, bp + TB_V + vpo, pf); }
            if (t + 1 < NTc) NS_WRITE(bi ^ 1);
            __syncthreads();
        }
    }
    { LAS float* slab = (LAS float*)(lds + NSA_SLAB) + (size_t)(h * 64 + 32 * qs + r32) * 65;
#pragma unroll
      for (int i = 0; i < 32; ++i) slab[2 * i + hi] = G[i]; }
    __syncthreads();
    u32x4 tbr[4]; { const u32x4* src = WSP(const u32x4, WS_NSATAB);
#pragma unroll
      for (int i = 0; i < 4; ++i) { const int idx = tid + 512 * i; tbr[i] = (idx < 4 * NSA_TL / 4) ? src[idx] : (u32x4){0u, 0u, 0u, 0u}; } }
    float gl0, gl1, gl2; { const float* sd = WSP(const float, WS_SIDE) + row * 16 + h * 3; gl0 = sd[0]; gl1 = sd[1]; gl2 = sd[2]; }
    { const int q = tid >> 3, jg = tid & 7;
      const LAS float* s0 = (const LAS float*)(lds + NSA_SLAB) + (size_t)q * 65;
      float v[64];
#pragma unroll
      for (int k = 0; k < 64; ++k) { const float x = (s0[k] + s0[64 * 65 + k]) + (s0[2 * 64 * 65 + k] + s0[3 * 64 * 65 + k]);
          v[k] = (k == 0 || k == cur || k == cur - 1) ? 1e9f : ((k > cur) ? -1e9f : x); if ((k & 7) == 7) asm volatile("" ::: "memory"); }
      unsigned bits = 0u;
#pragma unroll
      for (int e = 0; e < 8; ++e) { const int j = 8 * jg + e;
          const float xj = (s0[j] + s0[64 * 65 + j]) + (s0[2 * 64 * 65 + j] + s0[3 * 64 * 65 + j]);
          const float vj = (j == 0 || j == cur || j == cur - 1) ? 1e9f : ((j > cur) ? -1e9f : xj);
          int rank = 0;
#pragma unroll
          for (int k = 0; k < 64; ++k) rank += (v[k] > vj || (v[k] == vj && k < j)) ? 1 : 0;
          bits |= (rank < 16 ? 1u : 0u) << e; }
      *((LAS unsigned char*)(lds + NSA_SEL) + q * 8 + jg) = (unsigned char)bits; }
    __syncthreads();
    const unsigned mlo = *(const LAS unsigned*)(lds + NSA_SEL + (32 * qs + r32) * 8), mhi = *(const LAS unsigned*)(lds + NSA_SEL + (32 * qs + r32) * 8 + 4);
    { LAS u32x4* dst = (LAS u32x4*)(lds + NSA_SLAB);
#pragma unroll
      for (int i = 0; i < 4; ++i) { const int idx = tid + 512 * i; if (idx < 4 * NSA_TL / 4) dst[idx] = tbr[i]; } }
    const LAS float* tabh = (const LAS float*)(lds + NSA_SLAB) + h * NSA_TL;
    const float farb = WSP(const float, WS_FARB)[h];
    const float g0 = sigmoid_f(gl0), g1 = sigmoid_f(gl1), g2 = sigmoid_f(gl2);
    AState st; astate_init(st);
    { const bf16_t* Kb = P + rowbase * PW + PC_KSLC; const bf16_t* Vb = P + rowbase * PW + PC_VSLC;
      NS_FRESH(); NS_LOAD(Kb, PW, Vb, PW, 0); NS_WRITE(0);
      __syncthreads();
      for (int j = 0; j <= cur; ++j) {
          const int bi = j & 1;
          if (j < cur) NS_LOAD(Kb, PW, Vb, PW, j + 1);
          const bool mine = ((j < 32) ? (mlo >> j) : (mhi >> (j - 32))) & 1u;
          if (__any(mine)) {
              lds_cptr bp = (lds_cptr)(lds + bi * TB_SIZE); f32x16 p0, p1;
#pragma unroll
              for (int r = 0; r < 16; ++r) { p0[r] = 0.f; p1[r] = 0.f; }
              qk64<4>(bp, qf, r32, hi, p0, p1);
              if (q0 - 64 * j - 63 >= NSA_DFAR) {
#pragma unroll
                  for (int r = 0; r < 16; ++r) { p0[r] += farb; p1[r] += farb; }
              } else add_table(p0, p1, tabh + (NSA_DMAX - tq + 64 * j + 4 * hi));
              if (j == cur) mask_causal(p0, p1, 64 * j, tq, hi);
              if (!mine) {
#pragma unroll
                  for (int r = 0; r < 16; ++r) { p0[r] = NEG_INF; p1[r] = NEG_INF; } }
              softmax_pv64(p0, p1, st, bp + TB_V + vpo, hi);
          }
          if (j < cur) NS_WRITE(bi ^ 1);
          __syncthreads();
      } }
    f32x16 oa0, oa1;
    { const float sc = g1 / st.l;
#pragma unroll
      for (int r = 0; r < 16; ++r) { oa0[r] = g0 * oc0[r] + sc * st.o0[r]; oa1[r] = g0 * oc1[r] + sc * st.o1[r]; } }
    astate_init(st);
    { const bf16_t* Kb = P + rowbase * PW + PC_KWIN; const bf16_t* Vb = P + rowbase * PW + PC_VWIN;
      const int jlo = cur >= 8 ? cur - 8 : 0;
      NS_FRESH(); NS_LOAD(Kb, PW, Vb, PW, jlo); NS_WRITE(0);
      __syncthreads();
      for (int j = jlo; j <= cur; ++j) {
          const int bi = (j - jlo) & 1;
          if (j < cur) NS_LOAD(Kb, PW, Vb, PW, j + 1);
          if (tq_lo - 64 * j - 63 < 512) {
              lds_cptr bp = (lds_cptr)(lds + bi * TB_SIZE); f32x16 p0, p1;
#pragma unroll
              for (int r = 0; r < 16; ++r) { p0[r] = 0.f; p1[r] = 0.f; }
              qk64<4>(bp, qf, r32, hi, p0, p1);
              add_table(p0, p1, tabh + (NSA_DMAX - tq + 64 * j + 4 * hi));
              if (!(tq_lo - 64 * j - 63 >= 0 && tq_lo + 31 - 64 * j < 512)) {
                  const int d0 = tq - 64 * j - 4 * hi;
#pragma unroll
                  for (int r = 0; r < 16; ++r) { const int d = d0 - ((r & 3) + 8 * (r >> 2)); if (d < 0 || d >= 512) p0[r] = NEG_INF; if (d - 32 < 0 || d - 32 >= 512) p1[r] = NEG_INF; }
              }
              softmax_pv64(p0, p1, st, bp + TB_V + vpo, hi);
          }
          if (j < cur) NS_WRITE(bi ^ 1);
          __syncthreads();
      } }
    { const float sc = g2 / st.l;
#pragma unroll
      for (int r = 0; r < 16; ++r) { oa0[r] += sc * st.o0[r]; oa1[r] += sc * st.o1[r]; } }
    { int tq_ = tq; asm volatile("" : "+v"(tq_)); store_o_bf16(WSP(bf16_t, WS_OCAT) + (rowbase + tq_) * OCW + h * 64, oa0, oa1, 1.0f, hi); }
#undef NS_LOAD
#undef NS_FRESH
#undef NS_WRITE
}
__device__ __forceinline__ void dil_unit(Frame& F, int b, int hh, int span) {
    int lane_o = F.lane; asm volatile("" : "+v"(lane_o));
    const int wid = F.wave, lane = lane_o, r32 = lane & 31, hi = lane >> 5, tid = wid * 64 + lane;
    const int T0 = span * 512;
    const size_t rowbase = (size_t)b * SEQ;
    const bf16_t* P = WSP(const bf16_t, WS_P) + rowbase * PW;
    lds_ptr lds = (lds_ptr)F.lds;
    LAS float* dtab = (LAS float*)(lds + 32768);
    for (int i = tid; i < 3 * 192; i += 512) dtab[i] = WSP(const float, WS_DILTAB)[((i / 192) * 2 + hh) * 192 + (i % 192)];
    __syncthreads();
    lds_ptr vst = lds + wid * 4096;
    const int vpo = ((lane >> 4) & 1) * 32 + (lane & 3) * 8 + (4 * hi + ((lane & 15) >> 2)) * 64;
    bf16_t* DOG = WSP(bf16_t, WS_DOG); float* DLSE = WSP(float, WS_DLSE);
    for (int g = 0; g < 3; ++g) {
        const int sh = 2 * g, head = 2 * g + hh;
        for (int rep = 0; rep < 2; ++rep) {
            const int wt = wid + 8 * rep;
            const int res = (g == 0) ? 0 : (g == 1 ? (wt & 3) : wt);
            const int i0 = (g == 0) ? 32 * wt : (g == 1 ? 32 * (wt >> 2) : 0);
            const int n0 = (T0 >> sh) + i0;
            const int tokq = res + ((n0 + r32) << sh);
            bf16x8 qf[4];
            { const bf16_t* Qrow = P + (size_t)tokq * PW + PC_BQ + head * 64;
#pragma unroll
              for (int ks = 0; ks < 4; ++ks) qf[ks] = *(const bf16x8*)(Qrow + ks * 16 + hi * 8); }
            f32x16 o0, o1; float m = NEG_INF, l = 0.f;
#pragma unroll
            for (int r = 0; r < 16; ++r) { o0[r] = 0.f; o1[r] = 0.f; }
#define DIL_LOAD(cc, KF, VR) do { const int nk0_ = n0 - 128 + 32 * (cc); int nk_ = nk0_ + r32; nk_ = nk_ < 0 ? 0 : nk_; const bf16_t* Krow_ = P + (size_t)(res + (nk_ << sh)) * PW + PC_BK + head * 64; \
        _Pragma("unroll") for (int ks = 0; ks < 4; ++ks) KF[ks] = *(const bf16x8*)(Krow_ + ks * 16 + hi * 8); \
        _Pragma("unroll") for (int i = 0; i < 4; ++i) { const int pc_ = lane + 64 * i, vrow_ = pc_ >> 3, c16_ = pc_ & 7; int nv_ = nk0_ + vrow_; nv_ = nv_ < 0 ? 0 : nv_; \
            VR[i] = *(const u32x4*)(P + (size_t)(res + (nv_ << sh)) * PW + PC_BV + head * 64 + c16_ * 8); } } while (0)
            int cfirst = 0; while (cfirst < 4 && n0 - 128 + 32 * cfirst + 31 < 0) ++cfirst;
            bf16x8 kfn[4]; u32x4 vrn[4];
            DIL_LOAD(cfirst, kfn, vrn);
            for (int c = cfirst; c < 5; ++c) {
                const int nk0 = n0 - 128 + 32 * c;
                { bf16x8 kf[4]; u32x4 vr[4];
#pragma unroll
                  for (int i = 0; i < 4; ++i) { kf[i] = kfn[i]; vr[i] = vrn[i]; }
                  if (c < 4) DIL_LOAD(c + 1, kfn, vrn);
#pragma unroll
                  for (int i = 0; i < 4; ++i) { const int pc = lane + 64 * i, vrow = pc >> 3, c16 = pc & 7;
                      *(LAS u32x4*)(vst + (c16 >> 2) * 2048 + vrow * 64 + (c16 & 3) * 16) = vr[i]; }
                  asm volatile("s_waitcnt lgkmcnt(0)" ::: "memory");
                  f32x16 p;
#pragma unroll
                  for (int r = 0; r < 16; ++r) p[r] = 0.f;
#pragma unroll
                  for (int ks = 0; ks < 4; ++ks) p = MFMA32(kf[ks], qf[ks], p);
                  const LAS float* tb = dtab + g * 192 + (32 - r32 + 4 * hi + 32 * c);
                  float mx = NEG_INF;
#pragma unroll
                  for (int r = 0; r < 16; ++r) { const int o = (r & 3) + 8 * (r >> 2), kk = o + 4 * hi, j = 128 + r32 - 32 * c - kk;
                      const bool ok = (j >= 0) && (j <= 128) && (nk0 + kk >= 0);
                      p[r] = ok ? p[r] + tb[o] : NEG_INF; mx = fmaxf(mx, p[r]); }
                  mx = fmaxf(mx, other_half(mx, hi));
                  const float mn = fmaxf(m, mx), ms = (mn == NEG_INF) ? 0.f : mn, alpha = fast_exp2(m - ms);
                  float rs = 0.f;
#pragma unroll
                  for (int r = 0; r < 16; ++r) { p[r] = fast_exp2(p[r] - ms); rs += p[r]; }
                  rs += other_half(rs, hi);
                  l = l * alpha + rs; m = mn;
#pragma unroll
                  for (int r = 0; r < 16; ++r) { o0[r] *= alpha; o1[r] *= alpha; }
                  u32x4 w0, w1;
                  w0.x = cvtpk(p[0], p[1]); w0.y = cvtpk(p[2], p[3]); w0.z = cvtpk(p[4], p[5]); w0.w = cvtpk(p[6], p[7]);
                  w1.x = cvtpk(p[8], p[9]); w1.y = cvtpk(p[10], p[11]); w1.z = cvtpk(p[12], p[13]); w1.w = cvtpk(p[14], p[15]);
                  const bf16x8 pf0 = __builtin_bit_cast(bf16x8, w0), pf1 = __builtin_bit_cast(bf16x8, w1);
                  lds_cptr vp = (lds_cptr)(vst + vpo);
#pragma unroll
                  for (int ks = 0; ks < 2; ++ks) {
                      const s16x4 l0 = vtr(vp + ks * 1024), h0 = vtr(vp + ks * 1024 + 512), l1 = vtr(vp + 2048 + ks * 1024), h1 = vtr(vp + 2048 + ks * 1024 + 512);
                      const bf16x8 v0 = (bf16x8){l0[0], l0[1], l0[2], l0[3], h0[0], h0[1], h0[2], h0[3]}, v1 = (bf16x8){l1[0], l1[1], l1[2], l1[3], h1[0], h1[1], h1[2], h1[3]};
                      o0 = MFMA32(v0, ks == 0 ? pf0 : pf1, o0); o1 = MFMA32(v1, ks == 0 ? pf0 : pf1, o1);
                  }
                  asm volatile("s_waitcnt lgkmcnt(0)" ::: "memory"); }
            }
#undef DIL_LOAD
            const size_t orow = rowbase + tokq;
            store_o_bf16(DOG + ((size_t)g * M + orow) * 128 + hh * 64, o0, o1, 1.0f / l, hi);
            if (hi == 0) DLSE[((size_t)g * M + orow) * 2 + hh] = m + log2f(l);
        }
    }
    VM_WAIT();
    __syncthreads();
    bf16_t* OC = WSP(bf16_t, WS_OCAT);
    for (int it = 0; it < 8; ++it) {
        const int item = tid + 512 * it, tl = item >> 3, pc = item & 7; const size_t orow = rowbase + T0 + tl;
        const float l0 = DLSE[((size_t)0 * M + orow) * 2 + hh], l1 = DLSE[((size_t)1 * M + orow) * 2 + hh], l2 = DLSE[((size_t)2 * M + orow) * 2 + hh];
        const float mx = fmaxf(l0, fmaxf(l1, l2)); float w0 = fast_exp2(l0 - mx), w1 = fast_exp2(l1 - mx), w2 = fast_exp2(l2 - mx);
        const float inv = 1.0f / (w0 + w1 + w2); w0 *= inv; w1 *= inv; w2 *= inv;
        const u32x4 a = *(const u32x4*)(DOG + ((size_t)0 * M + orow) * 128 + hh * 64 + pc * 8), bb = *(const u32x4*)(DOG + ((size_t)1 * M + orow) * 128 + hh * 64 + pc * 8),
                    cc = *(const u32x4*)(DOG + ((size_t)2 * M + orow) * 128 + hh * 64 + pc * 8);
        u32x4 w;
#pragma unroll
        for (int e = 0; e < 4; ++e) {
            const float lo = w0 * __uint_as_float(a[e] << 16) + w1 * __uint_as_float(bb[e] << 16) + w2 * __uint_as_float(cc[e] << 16);
            const float hv = w0 * __uint_as_float(a[e] & 0xffff0000u) + w1 * __uint_as_float(bb[e] & 0xffff0000u) + w2 * __uint_as_float(cc[e] & 0xffff0000u);
            w[e] = cvtpk(lo, hv); }
        *(u32x4*)(OC + orow * OCW + 256 + hh * 64 + pc * 8) = w;
    }
    __syncthreads();
}
__device__ __forceinline__ float wave_sum(float v) {
    v += xor_lane_lt32<1>(v); v += xor_lane_lt32<2>(v); v += xor_lane_lt32<4>(v); v += xor_lane_lt32<8>(v); v += xor_lane_lt32<16>(v);
    return sum_halves(v);
}
__device__ __forceinline__ int rel_bucket(int dist) {
    if (dist < 0) dist = 0;
    if (dist < 16) return dist;
    const int thr[15] = {22, 30, 40, 54, 73, 99, 134, 182, 246, 332, 450, 609, 825, 1117, 1513};
    int bkt = 16;
#pragma unroll
    for (int i = 0; i < 15; ++i) bkt += (dist >= thr[i]) ? 1 : 0;
    return bkt;
}
__device__ __forceinline__ int inproj_src(int c, float& sc) {
    sc = 1.f;
    if (c < 256) { sc = C2A; return c; }
    if (c < 652) return c;
    if (c < 656) return 2572 + (c - 652);
    if (c < 672) return -1;
    if (c < 704) { const int p = c - 672; return 2960 + (p >> 1) + 16 * (p & 1); }
    if (c < 768) return -1;
    if (c < 1920) { const int r = c - 768; if (r < 384) sc = C2A; return 652 + r; }
    if (c < 2048) return 2832 + (c - 1920);
    if (c < 2816) { const int r = c - 2048; if (r < 256) sc = C2A; return 1804 + r; }
    return 2576 + (c - 2816);
}
__device__ __forceinline__ int quq_src(int r, float& sc) {
    sc = C2D;
    if (r >= 384) return -1;
    const int hd = r / 96, w = r % 96;
    if (w < 64) return hd * 96 + w;
    const int p = w - 64; return hd * 96 + 64 + (p >> 1) + 16 * (p & 1);
}
__device__ __forceinline__ int gateperm_src(int r) {
    const int T = r >> 8, c = r & 255, pn = T >> 2, j = T & 3, bj = c >> 7, wc = (c >> 5) & 3, fq = (c >> 3) & 3, n = (c >> 2) & 1, e = c & 3;
    return (2 * bj + n) * DM * DM + 256 * pn + 64 * j + 16 * wc + 4 * fq + e;
}
__device__ __forceinline__ int branchperm_src(int r) {
    const int pn = r >> 8, c = r & 255, bj = c >> 7, wc = (c >> 5) & 3, fq = (c >> 3) & 3, n = (c >> 2) & 1, e = c & 3;
    return 256 * pn + 64 * (2 * bj + n) + 16 * wc + 4 * fq + e;
}
__device__ __forceinline__ int upperm_src(int r) { const int pn = r >> 8, c = r & 255; return (c & 128) ? DFF + 128 * pn + (c & 127) : 128 * pn + c; }
__device__ __forceinline__ void wconv_item(const float* W, int Nsrc, bf16_t* WT, int ldt, const float* kgain, int kind, LAS float* scr, int item, int nblk, int lane, bool f8out = false) {
    const int kb = item / nblk, nb = item % nblk, k0 = 64 * kb, n0 = 32 * nb;
    const int n = n0 + (lane & 31); float sc = 1.f; int src = n;
    if (kind == 1) src = inproj_src(n, sc); else if (kind == 2) src = quq_src(n, sc); else if (kind == 3) src = gateperm_src(n); else if (kind == 4) src = branchperm_src(n); else if (kind == 5) src = upperm_src(n);
    float wv[32];
#pragma unroll
    for (int i = 0; i < 32; ++i) { const int kk = 2 * i + (lane >> 5); wv[i] = (src >= 0) ? W[(size_t)(k0 + kk) * Nsrc + src] : 0.f; }
#pragma unroll
    for (int i = 0; i < 32; ++i) { const int kk = 2 * i + (lane >> 5); float v = wv[i] * sc; if (kgain) v *= kgain[k0 + kk]; scr[kk * 33 + (lane & 31)] = v; }
    LDS_WAIT(); asm volatile("" ::: "memory");
    if (f8out) {
        const int nn = lane >> 1, hh = lane & 1; const LAS float* s = scr + (32 * hh) * 33 + nn; unsigned char* dst = (unsigned char*)WT + (size_t)(n0 + nn) * ldt + k0 + 32 * hh;
#pragma unroll
        for (int j = 0; j < 2; ++j) { u32x4 o;
#pragma unroll
            for (int e = 0; e < 4; ++e) { const LAS float* q = s + (16 * j + 4 * e) * 33; o[e] = pk4_fp8(q[0] * WG8_SCALE, q[33] * WG8_SCALE, q[66] * WG8_SCALE, q[99] * WG8_SCALE); }
            *(u32x4*)(dst + 16 * j) = o; }
        LDS_WAIT(); asm volatile("" ::: "memory");
        return;
    }
    const int c = lane & 7;
#pragma unroll
    for (int j = 0; j < 4; ++j) { const int nn = (lane >> 3) + 8 * j; const LAS float* s = scr + (8 * c) * 33 + nn;
        u32x4 o; o.x = pk2(s[0 * 33], s[1 * 33]); o.y = pk2(s[2 * 33], s[3 * 33]); o.z = pk2(s[4 * 33], s[5 * 33]); o.w = pk2(s[6 * 33], s[7 * 33]);
        *(u32x4*)(WT + (size_t)(n0 + nn) * ldt + k0 + 8 * c) = o; }
    LDS_WAIT(); asm volatile("" ::: "memory");
}
constexpr int ATT_UNITS = 3328;
__device__ __forceinline__ int att_cost(int id) {
    if (id < 2048) { const int qb = 15 - (id >> 7), mla = (id >> 6) & 1; return (mla ? 5 : 4) * (qb + 1); }
    if (id < 3072) return (63 - ((id - 2048) >> 4)) + 20;
    return 30;
}
__device__ __forceinline__ int clampi(int x, int lo, int hi) { return x < lo ? lo : (x > hi ? hi : x); }
__device__ __forceinline__ int att_rank(int i) {
    const int c = att_cost(i);
    int r = clampi(16 - c / 4, 0, 16) * 64 + clampi(16 - c / 5, 0, 16) * 64 + clampi(83 - c, 0, 64) * 16 + (c < 30 ? 256 : 0);
    if (c % 4 == 0 && c / 4 >= 1 && c / 4 <= 16) r += clampi(i - (16 - c / 4) * 128, 0, 64);
    if (c % 5 == 0 && c / 5 >= 1 && c / 5 <= 16) r += clampi(i - ((16 - c / 5) * 128 + 64), 0, 64);
    if (c >= 20 && c <= 83) r += clampi(i - (2048 + (63 - (c - 20)) * 16), 0, 16);
    if (c == 30) r += clampi(i - 3072, 0, 256);
    return r;
}
__device__ __forceinline__ void p0_prologue(Frame& F) {
    LAS float* scr = (LAS float*)(F.lds + F.wave * 16384);
    const int gw = blockIdx.x * 8 + F.wave, NGW = F.G * 8, lane = F.lane;
    constexpr int I_IN = 16 * 96, I_G = 16 * 32, I_BA = 4 * 32, I_BB = 2 * 32, I_O = 16 * 32, I_UP = 16 * 176, I_DN = 44 * 32, I_UQ = 4 * 16, I_UKV = 2 * 16, I_PHI = 32 * 4;
    constexpr int I_L = I_IN + 4 * I_G + 3 * I_BA + I_BB + I_O + I_UP + I_DN + I_UQ + I_UKV + 2 * I_PHI;
    for (int it = gw; it < DEPTH * I_L; it += NGW) {
        const int l = it / I_L; int r = it % I_L;
        unsigned char* wl = F.ws + WS_WT + (size_t)l * LW;
        if (r < I_IN) { wconv_item(F.in[6] + (size_t)l * DM * DIN, DIN, (bf16_t*)(wl + LW_IN), DM, nullptr, 1, scr, r, 96, lane); continue; } r -= I_IN;
        if (r < 4 * I_G) { wconv_item(F.in[21] + (size_t)l * 4 * DM * DM, DM, (bf16_t*)(wl + LW_G), DM, nullptr, 3, scr, r, 128, lane, true); continue; } r -= 4 * I_G;
        if (r < I_BA) { wconv_item(F.in[17] + (size_t)l * 256 * DM, DM, (bf16_t*)(wl + LW_BR + BR_A), 256, nullptr, 4, scr, r, 32, lane); continue; } r -= I_BA;
        if (r < I_BB) { wconv_item(F.in[18] + (size_t)l * 128 * DM, DM, (bf16_t*)(wl + LW_BR + BR_B), 128, nullptr, 4, scr, r, 32, lane); continue; } r -= I_BB;
        if (r < I_BA) { wconv_item(F.in[19] + (size_t)l * 256 * DM, DM, (bf16_t*)(wl + LW_BR + BR_C), 256, nullptr, 4, scr, r, 32, lane); continue; } r -= I_BA;
        if (r < I_BA) { wconv_item(F.in[20] + (size_t)l * 256 * DM, DM, (bf16_t*)(wl + LW_BR + BR_D), 256, nullptr, 4, scr, r, 32, lane); continue; } r -= I_BA;
        if (r < I_O) { wconv_item(F.in[22] + (size_t)l * DM * DM, DM, (bf16_t*)(wl + LW_O), DM, nullptr, 0, scr, r, 32, lane); continue; } r -= I_O;
        if (r < I_UP) { wconv_item(F.in[23] + (size_t)l * DM * DFF2, DFF2, (bf16_t*)(wl + LW_UP), DM, nullptr, 5, scr, r, 176, lane); continue; } r -= I_UP;
        if (r < I_DN) { wconv_item(F.in[26] + (size_t)l * DFF * DM, DM, (bf16_t*)(wl + LW_DN), DFF, nullptr, 0, scr, r, 32, lane); continue; } r -= I_DN;
        if (r < I_UQ) { wconv_item(F.in[15] + (size_t)l * 256 * 384, 384, (bf16_t*)(wl + LW_UQ), 256, F.in[13] + l * 256, 2, scr, r, 16, lane); continue; } r -= I_UQ;
        if (r < I_UKV) { wconv_item(F.in[16] + (size_t)l * 128 * 512, 512, (bf16_t*)(wl + LW_UKV), 128, F.in[14] + l * 128, 0, scr, r, 16, lane); continue; } r -= I_UKV;
        if (r < I_PHI) { wconv_item(F.in[8] + (size_t)l * 2048 * 128, 128, (bf16_t*)(wl + LW_PHI), 2048, nullptr, 0, scr, r, 4, lane); continue; } r -= I_PHI;
        wconv_item(F.in[10] + (size_t)l * 2048 * 128, 128, (bf16_t*)(wl + LW_PHI) + (size_t)128 * 2048, 2048, nullptr, 0, scr, r, 4, lane);
    }
    const int gt = blockIdx.x * 512 + F.tid, NGT = F.G * 512;
    const float* rel = F.in[1];
    float* rope = WSP(float, WS_ROPE);
    for (int i = gt; i < SEQ * 16; i += NGT) { const int t = i >> 4, k = i & 15; const float inv = powf(10000.0f, -(float)(2 * k) / 32.0f); const float ang = (float)t * inv;
        float sn, cs; sincosf(ang, &sn, &cs); rope[2 * i] = cs; rope[2 * i + 1] = sn; }
    float* ntab = WSP(float, WS_NSATAB);
    for (int i = gt; i < 4 * NSA_TL; i += NGT) { const int hd = i / NSA_TL, k = i % NSA_TL, dist = NSA_DMAX - k; ntab[i] = dist >= 0 ? rel[rel_bucket(dist) * 10 + hd] * LOG2E : 0.f; }
    float* dtab = WSP(float, WS_DILTAB);
    for (int i = gt; i < 6 * 192; i += NGT) { const int gh = i / 192, k = i % 192, g = gh >> 1, hh = gh & 1, j = 160 - k; dtab[i] = (j >= 0 && j <= 128) ? rel[rel_bucket(j << (2 * g)) * 10 + 4 + 2 * g + hh] * LOG2E : 0.f; }
    if (gt < 4) WSP(float, WS_FARB)[gt] = rel[31 * 10 + gt] * LOG2E;
    if (gw < 128) { const int mi = gw >> 5, pc = gw & 31, l = mi >> 1; const float *pk1 = F.in[8], *pv1 = F.in[10]; asm volatile("" : "+s"(pk1), "+s"(pv1));
        const float* w1 = ((mi & 1) ? pv1 : pk1) + (size_t)l * 2048 * 128 + (size_t)(64 * pc) * 128 + 2 * lane; const float* cp = F.in[7] + (size_t)l * 2048 + 64 * pc;
        f32x2 a = {0.f, 0.f};
#pragma unroll 8
        for (int p = 0; p < 64; ++p) { const f32x2 w = *(const f32x2*)(w1 + (size_t)p * 128); const float cpp = cp[p]; a[0] += cpp * w[0]; a[1] += cpp * w[1]; }
        *(f32x2*)(WSP(float, WS_CMPP) + ((size_t)mi * 32 + pc) * 128 + 2 * lane) = a; }
    if (gt < ATT_UNITS) WSP(int, WS_ORDER)[att_rank(gt)] = gt;
}
__device__ __forceinline__ void cmpb_reduce(Frame& F) {
    const int i = F.tid; if (i < DEPTH * 256) { const int l = i >> 8, n = i & 255, mi = l * 2 + (n >> 7); const float* pp = WSP(const float, WS_CMPP) + (size_t)mi * 32 * 128 + (n & 127); float a = 0.f;
        for (int pc = 0; pc < 32; ++pc) a += pp[pc * 128]; WSP(float, WS_CMPB)[i] = a; }
}

template <int MODE, bool XIB, bool XOB, bool H8 = false> __device__ __forceinline__ void rowpass(Frame& F, const void* x, const bf16_t* y, size_t yrow0, void* xout, bf16_t* hout, const float* g1, const float* g2, int row_lo, int row_hi, unsigned char* h8out = nullptr) {
    int gw = blockIdx.x * 8 + F.wave; asm volatile("" : "+s"(gw));
    const int NGW = F.G * 8, lane = F.lane;
    f32x4 ga[4], gb[4];
#pragma unroll
    for (int j = 0; j < 4; ++j) { ga[j] = *(const f32x4*)(g1 + 4 * lane + 256 * j); if (MODE == 1) gb[j] = *(const f32x4*)(g2 + 4 * lane + 256 * j); }
    f32x4 xf[4], xfn[4]; u32x2 xb[4], xbn[4], yb[4], ybn[4];
#define RP_LOAD(XF, XB, YB, mm) do { if (XIB) { const u32x2* xr_ = (const u32x2*)((const bf16_t*)x + (size_t)(mm) * DM) + lane; _Pragma("unroll") for (int j = 0; j < 4; ++j) XB[j] = xr_[64 * j]; } \
        else { const f32x4* xr_ = (const f32x4*)((const float*)x + (size_t)(mm) * DM) + lane; _Pragma("unroll") for (int j = 0; j < 4; ++j) XF[j] = xr_[64 * j]; } \
        if (MODE != 0) { const u32x2* yr_ = (const u32x2*)(y + ((size_t)(mm) - yrow0) * DM) + lane; _Pragma("unroll") for (int j = 0; j < 4; ++j) YB[j] = yr_[64 * j]; } } while (0)
    int m = row_lo + gw;
    if (m < row_hi) RP_LOAD(xf, xb, yb, m);
    for (; m < row_hi; m += NGW) {
        const int mn = m + NGW;
        if (mn < row_hi) RP_LOAD(xfn, xbn, ybn, mn);
        f32x4 v[4];
#pragma unroll
        for (int j = 0; j < 4; ++j) { if (XIB) { v[j][0] = __uint_as_float(xb[j].x << 16); v[j][1] = __uint_as_float(xb[j].x & 0xffff0000u); v[j][2] = __uint_as_float(xb[j].y << 16); v[j][3] = __uint_as_float(xb[j].y & 0xffff0000u); } else v[j] = xf[j]; }
        if (MODE != 0) {
            f32x4 w[4]; float s = 0.f;
#pragma unroll
            for (int j = 0; j < 4; ++j) { const u32x2 yy = yb[j]; w[j][0] = __uint_as_float(yy.x << 16); w[j][1] = __uint_as_float(yy.x & 0xffff0000u); w[j][2] = __uint_as_float(yy.y << 16); w[j][3] = __uint_as_float(yy.y & 0xffff0000u);
                s += (w[j][0] * w[j][0] + w[j][1] * w[j][1]) + (w[j][2] * w[j][2] + w[j][3] * w[j][3]); }
            const float rstd = 1.0f / sqrtf(wave_sum(s) * (1.0f / DM) + RMS_EPS);
#pragma unroll
            for (int j = 0; j < 4; ++j) v[j] = v[j] + w[j] * rstd * ga[j];
            if (XOB) { u32x2* xo = (u32x2*)((bf16_t*)xout + (size_t)m * DM) + lane;
#pragma unroll
                for (int j = 0; j < 4; ++j) { u32x2 w2; w2.x = cvtpk(v[j][0], v[j][1]); w2.y = cvtpk(v[j][2], v[j][3]); xo[64 * j] = w2; } }
            else { f32x4* xo = (f32x4*)((float*)xout + (size_t)m * DM) + lane;
#pragma unroll
                for (int j = 0; j < 4; ++j) xo[64 * j] = v[j]; }
        }
        if (MODE != 2) {
            float s = 0.f;
#pragma unroll
            for (int j = 0; j < 4; ++j) s += (v[j][0] * v[j][0] + v[j][1] * v[j][1]) + (v[j][2] * v[j][2] + v[j][3] * v[j][3]);
            const float rstd = 1.0f / sqrtf(wave_sum(s) * (1.0f / DM) + RMS_EPS);
            u32x2* ho = (u32x2*)(hout + (size_t)m * DM) + lane;
#pragma unroll
            for (int j = 0; j < 4; ++j) { const f32x4 gg = (MODE == 1) ? gb[j] : ga[j]; const f32x4 o = v[j] * rstd * gg; u32x2 w; w.x = cvtpk(o[0], o[1]); w.y = cvtpk(o[2], o[3]); ho[64 * j] = w;
                if (H8) ((unsigned*)(h8out + (size_t)m * DM))[lane + 64 * j] = pk4_fp8(o[0] * H8_SCALE, o[1] * H8_SCALE, o[2] * H8_SCALE, o[3] * H8_SCALE); }
        }
#pragma unroll
        for (int j = 0; j < 4; ++j) { if (XIB) xb[j] = xbn[j]; else xf[j] = xfn[j]; if (MODE != 0) yb[j] = ybn[j]; }
    }
#undef RP_LOAD
}

__device__ __forceinline__ void ffn_fix_panel(Frame& F, int pm, const float* HB, bf16_t* ACT, const float* cw, const float* cb) {
#pragma unroll 2
    for (int it = F.tid; it < 4 * 2 * (DFF / 4); it += 512) {
        const int c4 = it % (DFF / 4), rr = (it / (DFF / 4)) & 1, g = pm * 4 + it / (2 * (DFF / 4)), c = c4 * 4, pn = c >> 7, cl = c & 127;
        const bool first = ((g * 64) & (SEQ - 1)) == 0;
#define HBV(gg, s, bj) (*(const f32x4*)(HB + ((size_t)(((gg) * 4 + (s)) * 22 + pn) * 256 + (bj) * 128 + cl)))
        const f32x4 z = {0.f, 0.f, 0.f, 0.f};
        const f32x4 u0g = HBV(g, 0, 0), u0v = HBV(g, 0, 1);
        f32x4 ag, bg_, cg, av, bv_, cv;
        if (rr == 0) { ag = first ? z : HBV(g - 1, 2, 0); bg_ = first ? z : HBV(g - 1, 3, 0); cg = u0g; av = first ? z : HBV(g - 1, 2, 1); bv_ = first ? z : HBV(g - 1, 3, 1); cv = u0v; }
        else { ag = first ? z : HBV(g - 1, 3, 0); bg_ = u0g; cg = HBV(g, 1, 0); av = first ? z : HBV(g - 1, 3, 1); bv_ = u0v; cv = HBV(g, 1, 1); }
#undef HBV
        const f32x4 kb = *(const f32x4*)(cb + c), k0 = *(const f32x4*)(cw + c), k1 = *(const f32x4*)(cw + DFF2 + c), k2 = *(const f32x4*)(cw + 2 * DFF2 + c);
        const f32x4 vb = *(const f32x4*)(cb + DFF + c), v0 = *(const f32x4*)(cw + DFF + c), v1 = *(const f32x4*)(cw + DFF2 + DFF + c), v2 = *(const f32x4*)(cw + 2 * DFF2 + DFF + c);
        float o[4];
#pragma unroll
        for (int e = 0; e < 4; ++e) { const float gt = kb[e] + k0[e] * ag[e] + k1[e] * bg_[e] + k2[e] * cg[e], vl = vb[e] + v0[e] * av[e] + v1[e] * bv_[e] + v2[e] * cv[e]; o[e] = gt * sigmoid_f(gt) * vl; }
        u32x2 w; w.x = cvtpk(o[0], o[1]); w.y = cvtpk(o[2], o[3]);
        *(u32x2*)(ACT + (size_t)(g * 64 + rr) * DFF + c) = w;
    }
}
struct SchedSimple {
    pg8::TileOrder T; const char* A; const char* B; int lda, ldb, nt; int dup = 0;
    __device__ __forceinline__ bool next(int i, GUnit& u) const { int pm, pn; if (!T.tile(i >> dup, pm, pn)) return false;
        u.A = A + (size_t)pm * 256 * lda; u.B = B + (size_t)pn * 256 * ldb; u.lda = lda; u.ldb = ldb; u.nt = nt; u.pm = pm; u.pn = pn; u.id = 0; return true; }
};
struct SchedCmp1 {
    int c; const char* kc; const char* vc; const char* B;
    __device__ __forceinline__ bool next(int i, GUnit& u) const { if (i > 0 || c >= 32) return false;
        u.A = (c < 16 ? kc : vc) + (size_t)(c & 15) * 256 * 2048; u.B = B; u.lda = 2048; u.ldb = 4096; u.nt = 32; u.pm = c; u.pn = 0; u.id = 0; return true; }
};
struct SchedMerge {
    pg8::TileOrder T; const char* ocat; const char* h; const char* wbr; const char* wg; int dup = 0;
    __device__ __forceinline__ bool next(int i0, GUnit& u) const { const int i = i0 >> dup; int pm, pn; if (!T.tile(i >> 3, pm, pn)) return false;
        const int sub = i & 7; u.pm = pm; u.pn = pn; u.id = sub;
        if (sub >= 4) { u.A = h + (size_t)pm * 256 * 1024; u.lda = 1024; u.B = wg + (size_t)((pn * 4 + (sub - 4)) * 256) * 1024; u.ldb = 1024; u.nt = 8; }
        else { const int br = sub; const int kk = (br == 1) ? 128 : 256; const size_t co = (br == 0) ? 0 : (br == 1 ? 256 : (br == 2 ? 384 : 640)), wo = (br == 0) ? BR_A : (br == 1 ? BR_B : (br == 2 ? BR_C : BR_D));
            u.A = ocat + (size_t)pm * 256 * (OCW * 2) + co * 2; u.lda = OCW * 2; u.B = wbr + wo + (size_t)pn * 256 * kk * 2; u.ldb = kk * 2; u.nt = kk / 64; }
        return true; }
};

#ifndef SDUP_INPROJ
#define SDUP_INPROJ 0
#endif
#ifndef SDUP_MERGE
#define SDUP_MERGE 0
#endif
#ifndef SDUP_WO
#define SDUP_WO 0
#endif
#ifndef SDUP_UP
#define SDUP_UP 0
#endif
#ifndef SDUP_DN
#define SDUP_DN 0
#endif
#ifndef DUP_ATTN
#define DUP_ATTN 1
#endif
#ifndef DUP_GEMM
#define DUP_GEMM 1
#endif
#ifndef DUP_MERGE
#define DUP_MERGE 1
#endif
#ifndef DUP_FFN
#define DUP_FFN 1
#endif
#ifdef ONLY_PHASE
#define PH(k) ((k) == ONLY_PHASE)
#else
#define PH(k) true
#endif
struct Args { const float* in[27]; float* out; unsigned char* ws; };
__global__ void __launch_bounds__(512, 2) hybrid_fwd(Args args) {
    extern __shared__ __attribute__((aligned(16))) unsigned char lds_raw[];
    Frame F;
    F.lds = (LAS unsigned char*)lds_raw; F.MISC = (volatile LAS unsigned*)(F.lds + MISC_OFF);
    F.tid = threadIdx.x; F.lane = F.tid & 63; F.wave = __builtin_amdgcn_readfirstlane(F.tid >> 6); F.G = gridDim.x;
#pragma unroll
    for (int i = 0; i < 27; ++i) F.in[i] = args.in[i];
    F.out = args.out; F.ws = args.ws; F.ctl = (gu32*)(args.ws + WS_CTL);
    for (int u = F.tid; u < (LDS_BYTES - LDSCTL_OFF) / 4; u += 512) ((LAS unsigned*)(F.lds + LDSCTL_OFF))[u] = 0u;
    __syncthreads();
    XcdBarrier bar = xcd_barrier_post((unsigned*)(F.ctl + CW_BAR), F.MISC + 8);
    const int c = (int)blockIdx.x;
#define TSTAMP(id) do { } while (0)

#ifndef DUP_P0
#define DUP_P0 1
#endif
    for (int rep = 0; rep < DUP_P0; ++rep) { if (rep) xcd_barrier(bar); if (PH(0)) p0_prologue(F); }
    xcd_barrier(bar); TSTAMP(0);

#ifndef XTRA_BAR
#define XTRA_BAR 0
#endif
    _Pragma("unroll") for (int xb = 0; xb < XTRA_BAR; ++xb) xcd_barrier(bar);
#define PHASE_FRESH() do { int t_ = threadIdx.x; asm volatile("" : "+v"(t_)); F.tid = t_; F.lane = t_ & 63; } while (0)
    for (int l = 0; l < DEPTH; ++l) {
        unsigned char* wl = F.ws + WS_WT + (size_t)l * LW;
        const float* xin = (l == 0) ? F.in[0] : F.out;
        PHASE_FRESH();
#ifndef DUP_RP0
#define DUP_RP0 1
#endif
        if (l == 0) { if (c == 0) cmpb_reduce(F);
          _Pragma("unroll") for (int rep = 0; rep < DUP_RP0; ++rep) { if (rep) xcd_barrier(bar); if (PH(1)) rowpass<0, false, false, true>(F, F.in[0], nullptr, 0, nullptr, WSP(bf16_t, WS_H), F.in[2] + l * DM, nullptr, 0, M, (unsigned char*)F.out + H8_OFF); }
          xcd_barrier(bar); TSTAMP(1); }
        for (int rep = 0; rep < DUP_GEMM; ++rep) if (PH(2)) { if (rep) xcd_barrier(bar); SchedSimple S; S.T.init(256, 12, F.G, c); S.A = (const char*)(F.ws + WS_H); S.B = (const char*)(wl + LW_IN); S.lda = 2048; S.ldb = 2048; S.nt = 16; S.dup = SDUP_INPROJ;
          pg8::EpiInProj E{WSP(bf16_t, WS_P), WSP(bf16_t, WS_KCMP), WSP(bf16_t, WS_VCMP), WSP(float, WS_SIDE), WSP(bf16_t, WS_KROT), WSP(const float, WS_ROPE), WSP(float, WS_SSQQ), WSP(float, WS_SSQKV), F.in[12] + l * 4, WSP(float, WS_LF)};
          pg8::gemm_phase<pg8::EpiInProj, SchedSimple, true>(F.lds, S, E); }
        xcd_barrier(bar); TSTAMP(2);
#ifndef DUP_L2A
#define DUP_L2A 1
#endif
        _Pragma("unroll") for (int rep2 = 0; rep2 < DUP_L2A; ++rep2) { if (rep2) xcd_barrier(bar);
        if (PH(3)) { SchedCmp1 S{c, (const char*)(F.ws + WS_KCMP), (const char*)(F.ws + WS_VCMP), (const char*)(wl + LW_PHI)};
          pg8::EpiCmp1 E{WSP(bf16_t, WS_HID), WSP(const float, WS_CMPB) + l * 256};
          pg8::gemm_phase<pg8::EpiCmp1, SchedCmp1, false>(F.lds, S, E);
          if (c < 32) {
              __syncthreads(); const int which = c >> 4, b = c & 15;
              int ln_ = threadIdx.x & 63; asm volatile("" : "+v"(ln_)); const int r32 = ln_ & 31, hi = ln_ >> 5;
              const bf16_t* hrow = WSP(const bf16_t, WS_HID) + ((size_t)c * 256 + F.wave * 32 + r32) * 256 + which * 128;
              const float *pk2 = F.in[9], *pv2 = F.in[11]; asm volatile("" : "+s"(pk2), "+s"(pv2)); const float* w2 = (which ? pv2 : pk2) + (size_t)l * 128 * 64;
              f32x16 o0, o1;
#pragma unroll
              for (int r = 0; r < 16; ++r) { o0[r] = 0.f; o1[r] = 0.f; }
#pragma unroll
              for (int ks = 0; ks < 8; ++ks) { const bf16x8 a = *(const bf16x8*)(hrow + ks * 16 + hi * 8);
                  const float* wp = w2 + (size_t)(ks * 16 + hi * 8) * 64 + r32; u32x4 b0, b1;
#pragma unroll
                  for (int jj = 0; jj < 4; ++jj) { b0[jj] = cvtpk(wp[(2 * jj) * 64], wp[(2 * jj + 1) * 64]); b1[jj] = cvtpk(wp[(2 * jj) * 64 + 32], wp[(2 * jj + 1) * 64 + 32]); }
                  o0 = MFMA32(a, __builtin_bit_cast(bf16x8, b0), o0); o1 = MFMA32(a, __builtin_bit_cast(bf16x8, b1), o1); }
              bf16_t* dst = (which ? WSP(bf16_t, WS_VC) : WSP(bf16_t, WS_KC)) + ((size_t)b * 256 + F.wave * 32) * 64 + r32;
#pragma unroll
              for (int r = 0; r < 16; ++r) { const int rw = crow(r, hi); dst[(size_t)rw * 64] = (bf16_t)f2bf(o0[r]); dst[(size_t)rw * 64 + 32] = (bf16_t)f2bf(o1[r]); } } }
        if (PH(4)) { int G2_ = F.G; asm volatile("" : "+s"(G2_)); const bool split = G2_ > 64; const int g2 = split ? F.G - 32 : F.G, c2 = split ? c - 32 : c;
          { SchedSimple S; S.T.init(256, 2, g2, c2 < 0 ? (1 << 28) : c2); S.A = (const char*)(F.ws + WS_P) + PC_DQL * 2; S.B = (const char*)(wl + LW_UQ); S.lda = PW * 2; S.ldb = 512; S.nt = 4;
            pg8::EpiQup E{WSP(bf16_t, WS_QM), WSP(const float, WS_SSQQ), WSP(const float, WS_ROPE)};
            pg8::gemm_phase<pg8::EpiQup, SchedSimple, true>(F.lds, S, E); }
          { SchedSimple S; S.T.init(256, 2, g2, c2 < 0 ? (1 << 28) : c2); S.A = (const char*)(F.ws + WS_P) + PC_DKV * 2; S.B = (const char*)(wl + LW_UKV); S.lda = PW * 2; S.ldb = 256; S.nt = 2;
            pg8::EpiKVup E{WSP(bf16_t, WS_KVM), WSP(const float, WS_SSQKV), (unsigned*)(F.ctl + CW_KMLA + 256 * l)};
            pg8::gemm_phase<pg8::EpiKVup, SchedSimple, true>(F.lds, S, E); } }
        PHASE_FRESH();
        if (PH(5)) {
          int G_ = F.G; asm volatile("" : "+s"(G_)); const int cb = (G_ >= 48) ? c - 32 : c;
          if (cb >= 0 && cb < BATCH) { const int b = cb, tid = F.tid; const float* fl = WSP(const float, WS_SIDE) + ((size_t)b * SEQ + 8 * tid) * 16 + 12; const f32x4 fb = *(const f32x4*)(F.in[12] + l * 4);
              f32x4 v[8];
#pragma unroll
              for (int i = 0; i < 8; ++i) { const f32x4 z = *(const f32x4*)(fl + 16 * i);
#pragma unroll
                  for (int e = 0; e < 4; ++e) { const float x = z[e] + fb[e], t = fast_exp2(-fabsf(x) * LOG2E), lg = __builtin_amdgcn_logf(1.0f + t) * 0.6931471805599453f; v[i][e] = fminf(x, 0.f) - lg; } }
#pragma unroll
              for (int i = 1; i < 8; ++i) v[i] = v[i] + v[i - 1];
              LAS f32x4* sc = (LAS f32x4*)F.lds; f32x4 run = v[7];
              sc[tid] = run; __syncthreads();
              for (int off = 1, cur = 0; off < 512; off <<= 1, cur ^= 1) { f32x4 t = sc[cur * 512 + tid]; if (tid >= off) t = t + sc[cur * 512 + tid - off]; sc[(cur ^ 1) * 512 + tid] = t; __syncthreads(); run = t; }
              const f32x4 ex = run - v[7];
              float* kb = WSP(float, WS_KB) + (size_t)b * 4 * SEQ + 8 * tid;
#pragma unroll
              for (int e = 0; e < 4; ++e) { f32x4 lo, hi4;
#pragma unroll
                  for (int i = 0; i < 4; ++i) { lo[i] = -(ex[e] + v[i][e]) * LOG2E; hi4[i] = -(ex[e] + v[4 + i][e]) * LOG2E; }
                  *(f32x4*)(kb + (size_t)e * SEQ) = lo; *(f32x4*)(kb + (size_t)e * SEQ + 4) = hi4; }
              __syncthreads();
          } }
        }
        if (PH(5)) {
          const int gt2 = c * 512 + F.tid, hp = gt2 & 1;
          for (int t2 = gt2 >> 1; t2 < M; t2 += F.G * 256) { const bf16_t* Kp = WSP(const bf16_t, WS_P) + (size_t)t2 * PW + PC_CK + hp * 128; float s0 = 0.f, s1 = 0.f, s2 = 0.f;
              if (hp == 0) { const bf16_t* Rp = WSP(const bf16_t, WS_KROT) + (size_t)t2 * 32;
#pragma unroll
                  for (int q8 = 0; q8 < 4; ++q8) { const bf16x8 ra = *(const bf16x8*)(Rp + q8 * 8);
#pragma unroll
                      for (int e = 0; e < 8; ++e) { const float xa = bf2f((unsigned short)ra[e]); s2 += xa * xa; } } }
#pragma unroll
              for (int q8 = 0; q8 < 8; ++q8) { const bf16x8 ka = *(const bf16x8*)(Kp + q8 * 8), kb2 = *(const bf16x8*)(Kp + 64 + q8 * 8);
#pragma unroll
                  for (int e = 0; e < 8; ++e) { const float xa = bf2f((unsigned short)ka[e]), xb = bf2f((unsigned short)kb2[e]); s0 += xa * xa; s1 += xb * xb; } }
              s0 = fmaxf(s0, xor_lane_lt32<2>(s0)); s0 = fmaxf(s0, xor_lane_lt32<4>(s0)); s0 = fmaxf(s0, xor_lane_lt32<8>(s0)); s0 = fmaxf(s0, xor_lane_lt32<16>(s0));
              s1 = fmaxf(s1, xor_lane_lt32<2>(s1)); s1 = fmaxf(s1, xor_lane_lt32<4>(s1)); s1 = fmaxf(s1, xor_lane_lt32<8>(s1)); s1 = fmaxf(s1, xor_lane_lt32<16>(s1));
              { auto r0 = __builtin_amdgcn_permlane32_swap(__float_as_uint(s0), __float_as_uint(s0), false, false); s0 = fmaxf(__uint_as_float(r0[0]), __uint_as_float(r0[1]));
                auto r1 = __builtin_amdgcn_permlane32_swap(__float_as_uint(s1), __float_as_uint(s1), false, false); s1 = fmaxf(__uint_as_float(r1[0]), __uint_as_float(r1[1])); }
              s2 = fmaxf(s2, xor_lane_lt32<2>(s2)); s2 = fmaxf(s2, xor_lane_lt32<4>(s2)); s2 = fmaxf(s2, xor_lane_lt32<8>(s2)); s2 = fmaxf(s2, xor_lane_lt32<16>(s2));
              { auto r2 = __builtin_amdgcn_permlane32_swap(__float_as_uint(s2), __float_as_uint(s2), false, false); s2 = fmaxf(__uint_as_float(r2[0]), __uint_as_float(r2[1])); }
              if (F.lane < 2) { unsigned* kw = (unsigned*)(F.ctl + CW_KMAX + 64 * l) + (t2 >> 12) * 4 + 2 * hp; atomicMax(kw, __float_as_uint(s0)); atomicMax(kw + 1, __float_as_uint(s1));
                  if (hp == 0) atomicMax((unsigned*)(F.ctl + CW_KROT + 16 * l) + (t2 >> 12), __float_as_uint(s2)); } } }
        xcd_barrier(bar); TSTAMP(3);
        PHASE_FRESH();
        for (int rep = 0; rep < DUP_ATTN; ++rep) { gu32* ctr = F.ctl + CW_Q + 64 * l + 16 * rep;
          if (rep) xcd_barrier(bar);
          unsigned nxtq = 0u; if (F.tid == 0) nxtq = __hip_atomic_fetch_add(ctr, 1u, __ATOMIC_RELAXED, __HIP_MEMORY_SCOPE_AGENT);
          for (;;) { if (F.tid == 0) F.MISC[0] = nxtq; __syncthreads(); const int iq = (int)F.MISC[0]; __syncthreads(); if (iq >= ATT_UNITS) break;
              if (F.tid == 0) nxtq = __hip_atomic_fetch_add(ctr, 1u, __ATOMIC_RELAXED, __HIP_MEMORY_SCOPE_AGENT);
              const int it = __builtin_amdgcn_readfirstlane(WSP(const int, WS_ORDER)[iq]);
              if (it < 2048 && PH(7)) { const int qb = 15 - (it >> 7), mla = (it >> 6) & 1, bh = it & 63; if (mla) { const gu32* km = F.ctl + CW_KMLA + 256 * l + bh * 4; const float k2 = __uint_as_float(__hip_atomic_load(km, __ATOMIC_RELAXED, __HIP_MEMORY_SCOPE_AGENT)) + __uint_as_float(__hip_atomic_load(km + 1, __ATOMIC_RELAXED, __HIP_MEMORY_SCOPE_AGENT)) + __uint_as_float(__hip_atomic_load(F.ctl + CW_KROT + 16 * l + (bh >> 2), __ATOMIC_RELAXED, __HIP_MEMORY_SCOPE_AGENT)); causal_unit<false>(F, bh >> 2, bh & 3, qb, sqrtf(k2) * 1.01f); } else causal_unit<true>(F, bh >> 2, bh & 3, qb, sqrtf(__uint_as_float(__hip_atomic_load(F.ctl + CW_KMAX + 64 * l + bh, __ATOMIC_RELAXED, __HIP_MEMORY_SCOPE_AGENT)))); }
              else if (it < 3072 && PH(8)) { const int r = it - 2048; nsa_unit(F, r & 15, 63 - (r >> 4)); }
              else if (it < 3328 && PH(9)) { const int r = it - 3072; dil_unit(F, r & 15, (r >> 4) & 1, r >> 5); } } }
        xcd_barrier(bar); TSTAMP(5);
        for (int rep = 0; rep < DUP_MERGE; ++rep) if (PH(10)) { if (rep) xcd_barrier(bar); SchedMerge S; S.T.init(256, 4, F.G, c); S.ocat = (const char*)(F.ws + WS_OCAT); S.h = (const char*)F.out + H8_OFF; S.wbr = (const char*)(wl + LW_BR); S.wg = (const char*)(wl + LW_G); S.dup = SDUP_MERGE;
          unsigned char* scr = F.ws + WS_MSCR + (size_t)c * MSCR_PER_WG;
          pg8::EpiMerge E{WSP(bf16_t, WS_MERGED), scr};
          pg8::gemm_phase<pg8::EpiMerge, SchedMerge, true, true>(F.lds, S, E); }
        xcd_barrier(bar); TSTAMP(6);
        if (PH(11)) { SchedSimple S; S.T.init(256, 4, F.G, c); S.A = (const char*)(F.ws + WS_MERGED); S.B = (const char*)(wl + LW_O); S.lda = 2048; S.ldb = 2048; S.nt = 16; S.dup = SDUP_WO;
          pg8::EpiBf16 E{WSP(bf16_t, WS_Y), DM};
          pg8::gemm_phase<pg8::EpiBf16, SchedSimple, true>(F.lds, S, E); }
        xcd_barrier(bar); TSTAMP(7);
        PHASE_FRESH();
        if (PH(12)) { if (l == 0) rowpass<1, false, true>(F, F.in[0], WSP(const bf16_t, WS_Y), 0, F.out, WSP(bf16_t, WS_H2), F.in[3] + l * DM, F.in[4] + l * DM, 0, M);
                      else rowpass<1, true, true>(F, F.out, WSP(const bf16_t, WS_Y), 0, WSP(bf16_t, WS_X3), WSP(bf16_t, WS_H2), F.in[3] + l * DM, F.in[4] + l * DM, 0, M); }
        xcd_barrier(bar); TSTAMP(8);
#ifndef DUP_UP
#define DUP_UP 1
#endif
        _Pragma("unroll") for (int rep = 0; rep < DUP_UP; ++rep) if (PH(13)) { if (rep) xcd_barrier(bar); SchedSimple S; S.T.init(256, 22, F.G, c); S.A = (const char*)(F.ws + WS_H2); S.B = (const char*)(wl + LW_UP); S.lda = 2048; S.ldb = 2048; S.nt = 16; S.dup = SDUP_UP;
          pg8::EpiUpConv E{WSP(bf16_t, WS_ACT), WSP(float, WS_HB), F.in[24] + (size_t)l * 3 * DFF2, F.in[25] + (size_t)l * DFF2};
          pg8::gemm_phase<pg8::EpiUpConv, SchedSimple, true>(F.lds, S, E); }
        xcd_barrier(bar); TSTAMP(9);
        PHASE_FRESH();
        if (PH(15)) { SchedSimple S; S.T.init(256, 4, F.G, c); S.A = (const char*)(F.ws + WS_ACT); S.B = (const char*)(wl + LW_DN); S.lda = DFF * 2; S.ldb = DFF * 2; S.nt = DFF / 64; S.dup = SDUP_DN;
          { int pm, pn; for (int i = 0; S.T.tile(i, pm, pn); ++i) ffn_fix_panel(F, pm, WSP(const float, WS_HB), WSP(bf16_t, WS_ACT), F.in[24] + (size_t)l * 3 * DFF2, F.in[25] + (size_t)l * DFF2); }
          VM_WAIT(); __syncthreads();
          pg8::EpiBf16 E{WSP(bf16_t, WS_Y2), DM};
          pg8::gemm_phase<pg8::EpiBf16, SchedSimple, true>(F.lds, S, E); }
        xcd_barrier(bar); TSTAMP(11);
        PHASE_FRESH();
        if (PH(16)) { if (l + 1 < DEPTH) rowpass<1, true, true, true>(F, F.out, WSP(const bf16_t, WS_Y2), 0, F.out, WSP(bf16_t, WS_H), F.in[5] + l * DM, F.in[2] + (l + 1) * DM, 0, M, (unsigned char*)F.out + H8_OFF);
                      else rowpass<2, true, false>(F, WSP(const bf16_t, WS_X3), WSP(const bf16_t, WS_Y2), 0, F.out, nullptr, F.in[5] + l * DM, nullptr, 0, M); }
        xcd_barrier(bar); TSTAMP(12);
    }
}

extern "C" void kernel_launch(void* const* d_in, const int* in_sizes, int n_in, void* d_out, int out_size, void* d_ws, size_t ws_size, hipStream_t stream) {
    static int grid = 0;
    if (grid == 0) {
        if (n_in != 27 || in_sizes[0] != M * DM || out_size != M * DM || ws_size < WS_END) { fprintf(stderr, "kernel_launch: unexpected shapes (n_in %d, in0 %d, out %d, ws %zu)\n", n_in, n_in > 0 ? in_sizes[0] : -1, out_size, ws_size); grid = -1; return; }
        int dev = 0, cus = 0, per_cu = 0;
        if (hipGetDevice(&dev) != hipSuccess || hipDeviceGetAttribute(&cus, hipDeviceAttributeMultiprocessorCount, dev) != hipSuccess) { grid = -1; return; }
        if (hipFuncSetAttribute((const void*)hybrid_fwd, hipFuncAttributeMaxDynamicSharedMemorySize, LDS_BYTES) != hipSuccess) { fprintf(stderr, "kernel_launch: hipFuncSetAttribute failed\n"); grid = -1; return; }
        if (hipOccupancyMaxActiveBlocksPerMultiprocessor(&per_cu, (const void*)hybrid_fwd, 512, LDS_BYTES) != hipSuccess || per_cu < 1) fprintf(stderr, "kernel_launch: occupancy query says %d\n", per_cu);
        (void)hipGetLastError();
        grid = cus;
    }
    if (grid < 0) return;
    if (hipMemsetAsync((char*)d_ws + WS_CTL, 0, CTL_ZERO_BYTES, stream) != hipSuccess) return;
    Args a{};
    for (int i = 0; i < 27; ++i) a.in[i] = (const float*)d_in[i];
    a.out = (float*)d_out; a.ws = (unsigned char*)d_ws;
    hipLaunchKernelGGL(hybrid_fwd, dim3(grid), dim3(512), LDS_BYTES, stream, a);
}
```

```cpp
#include <hip/hip_runtime.h>
#include <hip/hip_bf16.h>
#include <cstdio>
#include <cstdint>
#include <cmath>

#define GAS __attribute__((address_space(1)))
#define LAS __attribute__((address_space(3)))
typedef unsigned short bf16_t;
typedef short bf16x8 __attribute__((ext_vector_type(8)));
typedef short s16x4 __attribute__((ext_vector_type(4)));
typedef float f32x4 __attribute__((ext_vector_type(4)));
typedef float f32x2 __attribute__((ext_vector_type(2)));
typedef float f32x16 __attribute__((ext_vector_type(16)));
typedef unsigned u32x4 __attribute__((ext_vector_type(4)));
typedef unsigned u32x2 __attribute__((ext_vector_type(2)));
typedef GAS unsigned gu32;

constexpr int BATCH = 16, SEQ = 4096, DM = 1024, M = BATCH * SEQ, DEPTH = 2;
constexpr int DIN = 2992, PW = 3072;
constexpr int DFF = 2816, DFF2 = 5632;
constexpr float LOG2E = 1.4426950408889634f;
constexpr float C2A = 0.125f * LOG2E;
constexpr float C2D = 0.10206207261596575f * LOG2E;
constexpr float RMS_EPS = 1e-6f;
constexpr float H8_SCALE = 8.0f, WG8_SCALE = 64.0f, GATE_UNSCALE = 1.0f / (H8_SCALE * WG8_SCALE);
constexpr int PC_AQ = 0, PC_KCMP = 256, PC_VCMP = 320, PC_KSLC = 384, PC_VSLC = 448, PC_KWIN = 512, PC_VWIN = 576,
              PC_MISC = 640, PC_KROPE = 672, PC_BQ = 768, PC_BK = 1152, PC_BV = 1536, PC_DKV = 1920,
              PC_CQ = 2048, PC_CK = 2304, PC_CV = 2560, PC_DQL = 2816;
constexpr int OCW = 896;
constexpr int NSA_DFAR = 1536, NSA_DMAX = 1664, NSA_TL = 1728;

__device__ __forceinline__ unsigned f2bf(float f) { unsigned u = __float_as_uint(f); return (u + 0x7fffu + ((u >> 16) & 1u)) >> 16; }
__device__ __forceinline__ unsigned pk2(float lo, float hi) { return f2bf(lo) | (f2bf(hi) << 16); }
__device__ __forceinline__ float bf2f(unsigned short b) { return __uint_as_float((unsigned)b << 16); }
typedef __bf16 bf16x2_t __attribute__((ext_vector_type(2)));
__device__ __forceinline__ unsigned cvtpk(float lo, float hi) { f32x2 v = {lo, hi}; bf16x2_t b = __builtin_convertvector(v, bf16x2_t); return __builtin_bit_cast(unsigned, b); }
__device__ __forceinline__ unsigned pk4_fp8(float a, float b, float c, float d) { int w = 0; w = __builtin_amdgcn_cvt_pk_fp8_f32(a, b, w, false); w = __builtin_amdgcn_cvt_pk_fp8_f32(c, d, w, true); return (unsigned)w; }
__device__ __forceinline__ float fast_exp2(float x) { return __builtin_amdgcn_exp2f(x); }
__device__ __forceinline__ float fast_rcp(float x) { return __builtin_amdgcn_rcpf(x); }
template <int MASK> __device__ __forceinline__ float xor_lane_lt32(float v) { return __uint_as_float(__builtin_amdgcn_ds_swizzle((int)__float_as_uint(v), (MASK << 10) | 0x1f)); }
__device__ __forceinline__ float sum_halves(float v) { auto rr = __builtin_amdgcn_permlane32_swap(__float_as_uint(v), __float_as_uint(v), false, false); return __uint_as_float(rr[0]) + __uint_as_float(rr[1]); }
__device__ __forceinline__ float sigmoid_f(float x) { return fast_rcp(1.0f + fast_exp2(-x * LOG2E)); }

namespace pg8 {
constexpr int BM = 256, BK = 64, HALF = 128, HTB = HALF * BK * 2  , STAGE_BYTES = 8 * HTB, NXCD = 8, WGM = 8;
__host__ __device__ __forceinline__ int lds_byte(int r, int c) { const int st = (r >> 4) * 2 + (c >> 5), rr = r & 15, cc = c & 31, ob = rr * 64 + cc * 2; return st * 1024 + (ob ^ (((ob >> 9) & 1) << 5)); }
__host__ __device__ __forceinline__ void stage_rc(int b, int& R, int& C) { const int st = b / 1024, sb = b % 1024, swz = sb ^ (((sb >> 9) & 1) << 5); R = (st >> 1) * 16 + swz / 64; C = (st & 1) * 32 + (swz % 64) / 2; }
__host__ __device__ __forceinline__ int perm32(int rho) { const int n = rho >> 4, i = rho & 15; return 8 * (i >> 2) + 4 * n + (i & 3); }

typedef int v8i_t __attribute__((ext_vector_type(8)));
typedef int v4i_t __attribute__((ext_vector_type(4)));
__device__ __forceinline__ v8i_t cat8(const bf16x8 lo, const bf16x8 hi) { const v4i_t a = __builtin_bit_cast(v4i_t, lo), b = __builtin_bit_cast(v4i_t, hi); return __builtin_shufflevector(a, b, 0, 1, 2, 3, 4, 5, 6, 7); }
struct GUnit { const char* A; const char* B; int lda, ldb, nt, pm, pn, id; };

struct TileOrder {
    int nM, nN, nwg, G, c;
    __device__ __forceinline__ void init(int nM_, int nN_, int G_, int c_) { nM = nM_; nN = nN_; nwg = nM * nN; G = G_; c = c_; }
    __device__ __forceinline__ bool tile(int i, int& pm, int& pn) const {
        const long L = (long)i * G + c; if (L >= nwg) return false;
        int wgid = (int)L; { const int q = nwg / NXCD, r = nwg % NXCD, xcd = wgid % NXCD, off = wgid / NXCD; wgid = (xcd < r ? xcd * (q + 1) : r * (q + 1) + (xcd - r) * q) + off; }
        const int nig = WGM * nN, gid = wgid / nig, fm = gid * WGM, gsz = (nM - fm) < WGM ? (nM - fm) : WGM;
        pm = fm + ((wgid % nig) % gsz); pn = (wgid % nig) / gsz; return true;
    }
};

template <class Epi, class Sched, bool ALIGN_EPI, bool F8 = false>
__device__ __forceinline__ void gemm_phase(LAS unsigned char* lds, const Sched& S, const Epi& E) {
    int tid_o = threadIdx.x; asm volatile("" : "+v"(tid_o));
    const int tid = tid_o, wid = __builtin_amdgcn_readfirstlane(tid >> 6), lane = tid & 63, wr = wid >> 2, wc = wid & 3; int fr = lane & 15, fq = lane >> 4;
    int sR[2], sC[2], sRb[2];
#pragma unroll
    for (int i = 0; i < 2; ++i) { stage_rc(tid * 16 + i * 8192, sR[i], sC[i]); sRb[i] = Epi::PERM ? ((sR[i] & ~31) + perm32(sR[i] & 31)) : sR[i]; sC[i] *= 2; }
    const size_t kstep = (size_t)(BK * 2);
    const unsigned ldsw = (unsigned)wid * 1024u;
    const int aoff = lds_byte(wr * 64 + fr, fq * 8), boff = lds_byte(wc * 32 + fr, fq * 8);
#define PG8_SA(b, h) (((b) * 2 + (h)) * HTB)
#define PG8_SB(b, h) ((4 + (b) * 2 + (h)) * HTB)
#define PG8_STAGE(bufoff, gbase, rows, ld) do { _Pragma("unroll") for (int _i = 0; _i < 2; ++_i) \
        __builtin_amdgcn_global_load_lds((const unsigned*)((const char*)(gbase) + (unsigned)((rows)[_i] * (ld) + sC[_i])), (LAS unsigned*)(lds + (bufoff) + ldsw + _i * 8192), 16, 0, 0); } while (0)
#define PG8_LDA(dst, b, h) do { _Pragma("unroll") for (int m = 0; m < 4; ++m) _Pragma("unroll") for (int k = 0; k < 2; ++k) dst[m][k] = *(const LAS bf16x8*)(lds + PG8_SA(b, h) + aoff + m * 2048 + k * 1024); } while (0)
#define PG8_LDB(dst, b, h) do { _Pragma("unroll") for (int n = 0; n < 2; ++n) _Pragma("unroll") for (int k = 0; k < 2; ++k) dst[n][k] = *(const LAS bf16x8*)(lds + PG8_SB(b, h) + boff + n * 2048 + k * 1024); } while (0)
#define PG8_MMA(ai, bj, At, Bt) do { __builtin_amdgcn_s_setprio(1); _Pragma("unroll") for (int m = 0; m < 4; ++m) _Pragma("unroll") for (int n = 0; n < 2; ++n) _Pragma("unroll") for (int k = 0; k < 2; ++k) \
        acc[ai][bj][m][n] = __builtin_amdgcn_mfma_f32_16x16x32_bf16(Bt[n][k], At[m][k], acc[ai][bj][m][n], 0, 0, 0); __builtin_amdgcn_s_setprio(0); } while (0)
#define PG8_LDA8(dst, b, h) do { _Pragma("unroll") for (int m = 0; m < 4; ++m) { dst[m].lo = *(const LAS v4i_t*)(lds + PG8_SA(b, h) + aoff + m * 2048); dst[m].hi = *(const LAS v4i_t*)(lds + PG8_SA(b, h) + aoff + m * 2048 + 1024); } } while (0)
#define PG8_LDB8(dst, b, h) do { _Pragma("unroll") for (int n = 0; n < 2; ++n) { dst[n].lo = *(const LAS v4i_t*)(lds + PG8_SB(b, h) + boff + n * 2048); dst[n].hi = *(const LAS v4i_t*)(lds + PG8_SB(b, h) + boff + n * 2048 + 1024); } } while (0)
#define PG8_MMA8(ai, bj, At, Bt) do { __builtin_amdgcn_s_setprio(1); _Pragma("unroll") for (int m = 0; m < 4; ++m) _Pragma("unroll") for (int n = 0; n < 2; ++n) \
        asm volatile("v_mfma_f32_16x16x128_f8f6f4 %0, %1, %2, %0" : "+v"(acc[ai][bj][m][n]) : "v"(Bt[n]), "v"(At[m])); __builtin_amdgcn_s_setprio(0); } while (0)
#define PG8_WAIT_V(n) asm volatile("s_waitcnt vmcnt(" #n ")" ::: "memory")
#define PG8_WAIT_L(n) asm volatile("s_waitcnt lgkmcnt(" #n ")" ::: "memory")
#define PG8_BAR __builtin_amdgcn_s_barrier()
#define PG8_SCHED __builtin_amdgcn_sched_barrier(0)
#define PG8_KLOOP(MM, LDA_, LDB_, At, B0, B1) for (int t = 0; t < nt; t += 2) { \
            const bool last = (t == nt - 2); \
            const char* a1 = cA + (size_t)(t + 1) * kstep; \
            const char* a2 = last ? nA : cA + (size_t)(t + 2) * kstep; const char* b2 = last ? nB : cB + (size_t)(t + 2) * kstep; \
            const char* a3 = a2 + kstep; const char* b3 = b2 + kstep; \
            const int ldA2 = last ? ldAn : ldAc, ldB2 = last ? ldBn : ldBc; \
            const size_t hA2 = last ? hAn : hAc, hB2 = last ? hBn : hBc; \
              \
            LDB_(B0, 0, 0); LDB_(B1, 0, 1); PG8_SCHED; LDA_(At, 0, 0); PG8_STAGE(PG8_SA(1, 1), a1 + hAc, sR, ldAc); \
            PG8_WAIT_V(8); PG8_WAIT_L(0); PG8_BAR; MM(0, 0, At, B0); MM(0, 1, At, B1); PG8_BAR; PG8_SCHED; \
              \
            LDA_(At, 0, 1); PG8_STAGE(PG8_SB(0, 0), b2, sRb, ldB2); PG8_STAGE(PG8_SB(0, 1), b2 + hB2, sRb, ldB2); PG8_STAGE(PG8_SA(0, 0), a2, sR, ldA2); \
            PG8_WAIT_V(8); PG8_WAIT_L(0); PG8_BAR; MM(1, 0, At, B0); MM(1, 1, At, B1); PG8_BAR; PG8_SCHED; \
              \
            LDB_(B0, 1, 0); LDB_(B1, 1, 1); PG8_SCHED; LDA_(At, 1, 0); PG8_STAGE(PG8_SA(0, 1), a2 + hA2, sR, ldA2); \
            PG8_WAIT_V(8); PG8_WAIT_L(0); PG8_BAR; MM(0, 0, At, B0); MM(0, 1, At, B1); PG8_BAR; PG8_SCHED; \
              \
            LDA_(At, 1, 1); PG8_STAGE(PG8_SB(1, 0), b3, sRb, ldB2); PG8_STAGE(PG8_SB(1, 1), b3 + hB2, sRb, ldB2); PG8_STAGE(PG8_SA(1, 0), a3, sR, ldA2); \
            PG8_WAIT_V(8); PG8_WAIT_L(0); PG8_BAR; MM(1, 0, At, B0); MM(1, 1, At, B1); PG8_BAR; PG8_SCHED; \
        }
    GUnit cur, nxt; int ui = 0;
    if (!S.next(0, cur)) return;
    f32x4 acc[2][2][4][2];
#pragma unroll
    for (int a = 0; a < 2; ++a)
#pragma unroll
        for (int b = 0; b < 2; ++b)
#pragma unroll
            for (int m = 0; m < 4; ++m)
#pragma unroll
                for (int n = 0; n < 2; ++n) acc[a][b][m][n] = (f32x4){0.f, 0.f, 0.f, 0.f};
    bf16x8 At[4][2], B0[2][2], B1[2][2]; v8i_t At8[4], B08[2], B18[2];
    int ldAc = cur.lda, ldBc = cur.ldb; size_t hAc = (size_t)HALF * ldAc, hBc = (size_t)HALF * ldBc;
    const char* cA = cur.A; const char* cB = cur.B;
    PG8_STAGE(PG8_SB(0, 0), cB, sRb, ldBc); PG8_STAGE(PG8_SB(0, 1), cB + hBc, sRb, ldBc); PG8_STAGE(PG8_SA(0, 0), cA, sR, ldAc); PG8_STAGE(PG8_SA(0, 1), cA + hAc, sR, ldAc);
    if (wr == 1) PG8_BAR;
    PG8_WAIT_V(2); PG8_BAR;
    PG8_STAGE(PG8_SB(1, 0), cB + kstep, sRb, ldBc); PG8_STAGE(PG8_SA(1, 0), cA + kstep, sR, ldAc); PG8_STAGE(PG8_SB(1, 1), cB + hBc + kstep, sRb, ldBc);
    PG8_WAIT_V(6); PG8_BAR;
    for (;;) {
        const bool has_next = S.next(ui + 1, nxt);
        int ldAn, ldBn; const char* nA; const char* nB;
        if (has_next) { ldAn = nxt.lda; ldBn = nxt.ldb; nA = nxt.A; nB = nxt.B; } else { ldAn = ldAc; ldBn = ldBc; nA = cA; nB = cB; }
        const size_t hAn = (size_t)HALF * ldAn, hBn = (size_t)HALF * ldBn;
        int nt = cur.nt; asm volatile("" : "+s"(nt));
        bool f8u = false; if constexpr (F8) f8u = Epi::f8(cur);
        if (F8 && f8u) { PG8_KLOOP(PG8_MMA8, PG8_LDA8, PG8_LDB8, At8, B08, B18) asm volatile("s_nop 15\n\ts_nop 15" ::: "memory"); }
        else { PG8_KLOOP(PG8_MMA, PG8_LDA, PG8_LDB, At, B0, B1) }
        if constexpr (ALIGN_EPI) { if (wr == 0) PG8_BAR; }
        E(acc, cur, wr, wc, fr, fq);
        if (!has_next) break;
#pragma unroll
        for (int a = 0; a < 2; ++a)
#pragma unroll
            for (int b = 0; b < 2; ++b)
#pragma unroll
                for (int m = 0; m < 4; ++m)
#pragma unroll
                    for (int n = 0; n < 2; ++n) acc[a][b][m][n] = (f32x4){0.f, 0.f, 0.f, 0.f};
        cur = nxt; cA = nA; cB = nB; ++ui;
        ldAc = ldAn; ldBc = ldBn; hAc = hAn; hBc = hBn;
        if constexpr (ALIGN_EPI) { if (wr == 1) PG8_BAR; }
    }
    PG8_WAIT_V(0);
    if constexpr (!ALIGN_EPI) { if (wr == 0) PG8_BAR; }
    PG8_BAR;
#undef PG8_SA
#undef PG8_SB
#undef PG8_STAGE
#undef PG8_LDA
#undef PG8_LDB
#undef PG8_MMA
#undef PG8_MMA8
#undef PG8_LDA8
#undef PG8_LDB8
#undef PG8_KLOOP
#undef PG8_WAIT_V
#undef PG8_WAIT_L
#undef PG8_BAR
#undef PG8_SCHED
}
}
using pg8::GUnit;
namespace pg8 {
#define EPI_OPAQUE() asm volatile("" : "+v"(fr), "+v"(fq))
struct EpiBf16 {
    static constexpr bool PERM = true;
    bf16_t* O; int ldc;
    __device__ __forceinline__ void operator()(const f32x4 (&acc)[2][2][4][2], const GUnit& u, int wr, int wc, int fr, int fq) const {
        EPI_OPAQUE();
        const int row0 = u.pm * BM + wr * 64 + fr, col0 = u.pn * BM + wc * 32 + 8 * fq;
#pragma unroll
        for (int ai = 0; ai < 2; ++ai)
#pragma unroll
            for (int m = 0; m < 4; ++m) { bf16_t* rowp = O + (size_t)(row0 + ai * HALF + m * 16) * ldc + col0;
#pragma unroll
                for (int bj = 0; bj < 2; ++bj) { const f32x4 v0 = acc[ai][bj][m][0], v1 = acc[ai][bj][m][1];
                    u32x4 w; w.x = cvtpk(v0[0], v0[1]); w.y = cvtpk(v0[2], v0[3]); w.z = cvtpk(v1[0], v1[1]); w.w = cvtpk(v1[2], v1[3]);
                    *(u32x4*)(rowp + bj * HALF) = w; } }
    }
};
struct EpiF32 {
    static constexpr bool PERM = false;
    float* O; int ldc;
    __device__ __forceinline__ void operator()(const f32x4 (&acc)[2][2][4][2], const GUnit& u, int wr, int wc, int fr, int fq) const {
        EPI_OPAQUE();
        const int row0 = u.pm * BM + wr * 64 + fr, col0 = u.pn * BM + wc * 32 + 4 * fq;
#pragma unroll
        for (int ai = 0; ai < 2; ++ai)
#pragma unroll
            for (int m = 0; m < 4; ++m) { float* rowp = O + (size_t)(row0 + ai * HALF + m * 16) * ldc + col0;
#pragma unroll
                for (int bj = 0; bj < 2; ++bj)
#pragma unroll
                    for (int n = 0; n < 2; ++n) *(f32x4*)(rowp + bj * HALF + n * 16) = acc[ai][bj][m][n]; }
    }
};
__device__ __forceinline__ void rope8(f32x4& v0, f32x4& v1, const float* cs  ) {
    const f32x4 a = *(const f32x4*)cs, b = *(const f32x4*)(cs + 4);
    f32x4 r0, r1;
    r0[0] = v0[0] * a[0] - v0[1] * a[1]; r0[1] = v0[1] * a[0] + v0[0] * a[1];
    r0[2] = v0[2] * a[2] - v0[3] * a[3]; r0[3] = v0[3] * a[2] + v0[2] * a[3];
    r1[0] = v1[0] * b[0] - v1[1] * b[1]; r1[1] = v1[1] * b[0] + v1[0] * b[1];
    r1[2] = v1[2] * b[2] - v1[3] * b[3]; r1[3] = v1[3] * b[2] + v1[2] * b[3];
    v0 = r0; v1 = r1;
}
struct EpiInProj {
    static constexpr bool PERM = true;
    bf16_t* P; bf16_t* kcmp; bf16_t* vcmp; float* side; bf16_t* krot; const float* rope; float* ssq_q; float* ssq_kv; const float* fbias; float* lf;
    __device__ __forceinline__ void operator()(const f32x4 (&acc)[2][2][4][2], const GUnit& u, int wr, int wc, int fr, int fq) const {
        EPI_OPAQUE();
        const int row0 = u.pm * BM + wr * 64 + fr, col0 = u.pn * BM + wc * 32 + 8 * fq;
#pragma unroll
        for (int ai = 0; ai < 2; ++ai)
#pragma unroll
            for (int m = 0; m < 4; ++m) { const int row = row0 + ai * HALF + m * 16; bf16_t* rowp = P + (size_t)row * PW + col0;
                float ssq = 0.f;
#pragma unroll
                for (int bj = 0; bj < 2; ++bj) { f32x4 v0 = acc[ai][bj][m][0], v1 = acc[ai][bj][m][1];
                    if (u.pn == 2 && bj == 1) {
                        if (wc == 0 && fq < 2) { float* sp = side + (size_t)row * 16 + 8 * fq; *(f32x4*)sp = v0; *(f32x4*)(sp + 4) = v1; }
                        if (wc == 1) { rope8(v0, v1, rope + (size_t)(row & (SEQ - 1)) * 32 + 8 * fq);
                            u32x4 w; w.x = cvtpk(v0[0], v0[1]); w.y = cvtpk(v0[2], v0[3]); w.z = cvtpk(v1[0], v1[1]); w.w = cvtpk(v1[2], v1[3]);
                            *(u32x4*)(krot + (size_t)row * 32 + 8 * fq) = w; }
                    }
                    u32x4 w; w.x = cvtpk(v0[0], v0[1]); w.y = cvtpk(v0[2], v0[3]); w.z = cvtpk(v1[0], v1[1]); w.w = cvtpk(v1[2], v1[3]);
                    *(u32x4*)(rowp + bj * HALF) = w;
                    if (u.pn == 1 && bj == 0) { bf16_t* cp = (wc < 2 ? kcmp : vcmp) + (size_t)row * 64 + (wc & 1) * 32 + 8 * fq; *(u32x4*)cp = w; }
                    if (u.pn == 11 || (u.pn == 7 && bj == 1)) ssq += (v0[0] * v0[0] + v0[1] * v0[1]) + (v0[2] * v0[2] + v0[3] * v0[3]) + (v1[0] * v1[0] + v1[1] * v1[1]) + (v1[2] * v1[2] + v1[3] * v1[3]);
                }
                if (u.pn == 11 || u.pn == 7) { ssq += xor_lane_lt32<16>(ssq); ssq = sum_halves(ssq);
                    if (fq == 0) (u.pn == 11 ? ssq_q : ssq_kv)[(size_t)row * 4 + wc] = ssq; }
                asm volatile("" ::: "memory");
            }
    }
};
struct EpiQup {
    static constexpr bool PERM = true;
    bf16_t* O; const float* ssq_q; const float* rope;
    __device__ __forceinline__ void operator()(const f32x4 (&acc)[2][2][4][2], const GUnit& u, int wr, int wc, int fr, int fq) const {
        EPI_OPAQUE();
        const int row0 = u.pm * BM + wr * 64 + fr, col0 = u.pn * BM + wc * 32 + 8 * fq;
#pragma unroll
        for (int ai = 0; ai < 2; ++ai)
#pragma unroll
            for (int m = 0; m < 4; ++m) { const int row = row0 + ai * HALF + m * 16; bf16_t* rowp = O + (size_t)row * 512 + col0;
                const f32x4 pq = *(const f32x4*)(ssq_q + (size_t)row * 4);
                const float rstd = 1.0f / sqrtf(((pq[0] + pq[1]) + (pq[2] + pq[3])) * (1.0f / 256.0f) + RMS_EPS);
#pragma unroll
                for (int bj = 0; bj < 2; ++bj) { f32x4 v0 = acc[ai][bj][m][0] * rstd, v1 = acc[ai][bj][m][1] * rstd;
                    const int c8 = col0 + bj * HALF, within = c8 % 96;
                    if (c8 < 384 && within >= 64) rope8(v0, v1, rope + (size_t)(row & (SEQ - 1)) * 32 + (within - 64));
                    u32x4 w; w.x = cvtpk(v0[0], v0[1]); w.y = cvtpk(v0[2], v0[3]); w.z = cvtpk(v1[0], v1[1]); w.w = cvtpk(v1[2], v1[3]);
                    *(u32x4*)(rowp + bj * HALF) = w; }
                asm volatile("" ::: "memory"); }
    }
};
struct EpiKVup {
    static constexpr bool PERM = true;
    bf16_t* O; const float* ssq_kv; unsigned* kmx;
    __device__ __forceinline__ void operator()(const f32x4 (&acc)[2][2][4][2], const GUnit& u, int wr, int wc, int fr, int fq) const {
        EPI_OPAQUE();
        const int row0 = u.pm * BM + wr * 64 + fr, col0 = u.pn * BM + wc * 32 + 8 * fq;
        float mk0 = 0.f, mk1 = 0.f;
#pragma unroll
        for (int ai = 0; ai < 2; ++ai)
#pragma unroll
            for (int m = 0; m < 4; ++m) { const int row = row0 + ai * HALF + m * 16; bf16_t* rowp = O + (size_t)row * 512 + col0;
                const f32x4 pq = *(const f32x4*)(ssq_kv + (size_t)row * 4);
                const float rstd = 1.0f / sqrtf(((pq[0] + pq[1]) + (pq[2] + pq[3])) * (1.0f / 128.0f) + RMS_EPS);
#pragma unroll
                for (int bj = 0; bj < 2; ++bj) { const f32x4 v0 = acc[ai][bj][m][0] * rstd, v1 = acc[ai][bj][m][1] * rstd;
                    u32x4 w; w.x = cvtpk(v0[0], v0[1]); w.y = cvtpk(v0[2], v0[3]); w.z = cvtpk(v1[0], v1[1]); w.w = cvtpk(v1[2], v1[3]);
                    *(u32x4*)(rowp + bj * HALF) = w;
                    if (wc < 2) { float ss = ((v0[0] * v0[0] + v0[1] * v0[1]) + (v0[2] * v0[2] + v0[3] * v0[3])) + ((v1[0] * v1[0] + v1[1] * v1[1]) + (v1[2] * v1[2] + v1[3] * v1[3]));
                        ss += xor_lane_lt32<16>(ss); ss = sum_halves(ss); if (bj == 0) mk0 = fmaxf(mk0, ss); else mk1 = fmaxf(mk1, ss); } }
                asm volatile("" ::: "memory"); }
        if (wc < 2) {
            mk0 = fmaxf(mk0, xor_lane_lt32<1>(mk0)); mk0 = fmaxf(mk0, xor_lane_lt32<2>(mk0)); mk0 = fmaxf(mk0, xor_lane_lt32<4>(mk0)); mk0 = fmaxf(mk0, xor_lane_lt32<8>(mk0));
            mk1 = fmaxf(mk1, xor_lane_lt32<1>(mk1)); mk1 = fmaxf(mk1, xor_lane_lt32<2>(mk1)); mk1 = fmaxf(mk1, xor_lane_lt32<4>(mk1)); mk1 = fmaxf(mk1, xor_lane_lt32<8>(mk1));
            if (fr == 0 && fq == 0) { unsigned* kw = kmx + ((u.pm >> 4) * 4 + 2 * u.pn) * 4 + wc; atomicMax(kw, __float_as_uint(mk0)); atomicMax(kw + 4, __float_as_uint(mk1)); }
        }
    }
};
__device__ __forceinline__ float gelu_tanh(float x) { const float u2 = 2.0f * 0.7978845608028654f * (x + 0.044715f * x * x * x); return x * fast_rcp(1.0f + fast_exp2(-u2 * LOG2E)); }
struct EpiCmp1 {
    static constexpr bool PERM = true;
    bf16_t* O; const float* bias1;
    __device__ __forceinline__ void operator()(const f32x4 (&acc)[2][2][4][2], const GUnit& u, int wr, int wc, int fr, int fq) const {
        EPI_OPAQUE();
        const int row0 = u.pm * BM + wr * 64 + fr, col0 = wc * 32 + 8 * fq;
        f32x4 bv[2][2];
#pragma unroll
        for (int bj = 0; bj < 2; ++bj)
#pragma unroll
            for (int n = 0; n < 2; ++n) bv[bj][n] = *(const f32x4*)(bias1 + col0 + bj * HALF + 4 * n);
#pragma unroll
        for (int ai = 0; ai < 2; ++ai)
#pragma unroll
            for (int m = 0; m < 4; ++m) { bf16_t* rowp = O + (size_t)(row0 + ai * HALF + m * 16) * 256 + col0;
#pragma unroll
                for (int bj = 0; bj < 2; ++bj) { f32x4 v0 = acc[ai][bj][m][0] + bv[bj][0], v1 = acc[ai][bj][m][1] + bv[bj][1];
#pragma unroll
                    for (int e = 0; e < 4; ++e) { v0[e] = gelu_tanh(v0[e]); v1[e] = gelu_tanh(v1[e]); }
                    u32x4 w; w.x = cvtpk(v0[0], v0[1]); w.y = cvtpk(v0[2], v0[3]); w.z = cvtpk(v1[0], v1[1]); w.w = cvtpk(v1[2], v1[3]);
                    *(u32x4*)(rowp + bj * HALF) = w; } }
    }
};
typedef __amdgpu_buffer_rsrc_t rsrc_t;
struct EpiMerge {
    __device__ static __forceinline__ bool f8(const GUnit& u) { return u.id >= 4; }
    static constexpr bool PERM = true;
    bf16_t* O;
    unsigned char* scr;
    __device__ __forceinline__ void operator()(const f32x4 (&acc)[2][2][4][2], const GUnit& u, int wr, int wc, int fr, int fq) const {
        EPI_OPAQUE();
        const int tid = (wr * 4 + wc) * 64 + fq * 16 + fr;
        const int sub = u.id;
        const rsrc_t rs = __builtin_amdgcn_make_buffer_rsrc(scr, 0, 524288, 0x00020000);
        if (sub < 4) {
#pragma unroll
            for (int ai = 0; ai < 2; ++ai)
#pragma unroll
                for (int bj = 0; bj < 2; ++bj)
#pragma unroll
                    for (int m = 0; m < 4; ++m)
#pragma unroll
                        for (int n = 0; n < 2; ++n) { const int q = ((ai * 2 + bj) * 4 + m) * 2 + n; const f32x4 v = acc[ai][bj][m][n];
                            u32x2 w; w.x = cvtpk(v[0], v[1]); w.y = cvtpk(v[2], v[3]);
                            __builtin_amdgcn_raw_buffer_store_b64(w, rs, tid * 8, (sub * 32 + q) * 4096, 0); }
            return;
        }
        const int j = sub - 4;
        const int row0 = u.pm * BM + wr * 64 + fr, col0 = u.pn * BM + 64 * j + wc * 16 + 4 * fq;
#pragma unroll
        for (int ai = 0; ai < 2; ++ai) {
            u32x2 sv[4][4];
#pragma unroll
            for (int m = 0; m < 4; ++m)
#pragma unroll
                for (int g = 0; g < 4; ++g) { const int qb = (ai * 16 + m * 2);
                    sv[m][g] = (j == 0) ? __builtin_amdgcn_raw_buffer_load_b64(rs, tid * 8, (g * 32 + qb) * 4096, 0)
                             : (j == 1) ? __builtin_amdgcn_raw_buffer_load_b64(rs, tid * 8, (g * 32 + qb + 1) * 4096, 0)
                             : (j == 2) ? __builtin_amdgcn_raw_buffer_load_b64(rs, tid * 8, (g * 32 + qb + 8) * 4096, 0)
                                        : __builtin_amdgcn_raw_buffer_load_b64(rs, tid * 8, (g * 32 + qb + 9) * 4096, 0); }
#pragma unroll
            for (int m = 0; m < 4; ++m) { bf16_t* rowp = O + (size_t)(row0 + ai * HALF + m * 16) * DM + col0;
                f32x4 t = {0.f, 0.f, 0.f, 0.f};
#pragma unroll
                for (int g = 0; g < 4; ++g) { const f32x4 gt = acc[ai][g >> 1][m][g & 1]; const u32x2 s = sv[m][g];
                    constexpr float GS = -GATE_UNSCALE * LOG2E;
                    t[0] += fast_rcp(1.0f + fast_exp2(gt[0] * GS)) * __uint_as_float(s.x << 16); t[1] += fast_rcp(1.0f + fast_exp2(gt[1] * GS)) * __uint_as_float(s.x & 0xffff0000u);
                    t[2] += fast_rcp(1.0f + fast_exp2(gt[2] * GS)) * __uint_as_float(s.y << 16); t[3] += fast_rcp(1.0f + fast_exp2(gt[3] * GS)) * __uint_as_float(s.y & 0xffff0000u); }
                u32x2 w; w.x = cvtpk(t[0], t[1]); w.y = cvtpk(t[2], t[3]);
                *(u32x2*)rowp = w; }
            asm volatile("" ::: "memory"); }
    }
};
__device__ __forceinline__ float dpp_ror1(float v) { return __uint_as_float((unsigned)__builtin_amdgcn_mov_dpp((int)__float_as_uint(v), 0x121, 0xf, 0xf, false)); }
__device__ __forceinline__ float dpp_ror2(float v) { return __uint_as_float((unsigned)__builtin_amdgcn_mov_dpp((int)__float_as_uint(v), 0x122, 0xf, 0xf, false)); }
struct EpiUpConv {
    static constexpr int KIND = 8;
    static constexpr bool PERM = true;
    bf16_t* ACT; float* HB; const float* cw; const float* cb;
    __device__ __forceinline__ void operator()(const f32x4 (&acc)[2][2][4][2], const GUnit& u, int wr, int wc, int fr, int fq) const {
        EPI_OPAQUE();
        const int colL = wc * 32 + 8 * fq;
        const bool l0 = (fr == 0), l01 = (fr < 2);
#pragma unroll
        for (int n = 0; n < 2; ++n) {
            const int cl = colL + 4 * n, c0 = u.pn * 128 + cl;
            const f32x4 bg = *(const f32x4*)(cb + c0), w0g = *(const f32x4*)(cw + c0), w1g = *(const f32x4*)(cw + DFF2 + c0), w2g = *(const f32x4*)(cw + 2 * DFF2 + c0);
            const f32x4 bv = *(const f32x4*)(cb + DFF + c0), w0v = *(const f32x4*)(cw + DFF + c0), w1v = *(const f32x4*)(cw + DFF2 + DFF + c0), w2v = *(const f32x4*)(cw + 2 * DFF2 + DFF + c0);
            f32x4 w1ga, w1gb, w0ga, w0gb, w1va, w1vb, w0va, w0vb;
#pragma unroll
            for (int e = 0; e < 4; ++e) { w1ga[e] = l0 ? 0.f : w1g[e]; w1gb[e] = l0 ? w1g[e] : 0.f; w0ga[e] = l01 ? 0.f : w0g[e]; w0gb[e] = l01 ? w0g[e] : 0.f;
                                          w1va[e] = l0 ? 0.f : w1v[e]; w1vb[e] = l0 ? w1v[e] : 0.f; w0va[e] = l01 ? 0.f : w0v[e]; w0vb[e] = l01 ? w0v[e] : 0.f; }
#pragma unroll
            for (int ai = 0; ai < 2; ++ai) {
                const int rowg = u.pm * BM + ai * HALF + wr * 64, g = rowg >> 6;
#pragma unroll
                for (int m = 0; m < 4; ++m) {
                    const f32x4 cg = acc[ai][0][m][n], cv = acc[ai][1][m][n];
                    f32x4 o;
#pragma unroll
                    for (int e = 0; e < 4; ++e) {
                        float gt = fmaf(w2g[e], cg[e], bg[e]), vl = fmaf(w2v[e], cv[e], bv[e]);
                        gt = fmaf(dpp_ror1(cg[e]), w1ga[e], gt); gt = fmaf(dpp_ror2(cg[e]), w0ga[e], gt);
                        vl = fmaf(dpp_ror1(cv[e]), w1va[e], vl); vl = fmaf(dpp_ror2(cv[e]), w0va[e], vl);
                        if (m > 0) { const float pg = acc[ai][0][m - 1][n][e], pv = acc[ai][1][m - 1][n][e];
                            gt = fmaf(dpp_ror1(pg), w1gb[e], gt); gt = fmaf(dpp_ror2(pg), w0gb[e], gt);
                            vl = fmaf(dpp_ror1(pv), w1vb[e], vl); vl = fmaf(dpp_ror2(pv), w0vb[e], vl); }
                        o[e] = gt * sigmoid_f(gt) * vl; }
                    const int row = rowg + m * 16 + fr;
                    if (!(m == 0 && fr < 2)) { u32x2 w; w.x = cvtpk(o[0], o[1]); w.y = cvtpk(o[2], o[3]); *(u32x2*)(ACT + (size_t)row * DFF + c0) = w; }
                    if (m == 0 && fr < 2) { float* hp = HB + ((size_t)((g * 4 + fr) * 22 + u.pn) * 256 + cl); *(f32x4*)hp = cg; *(f32x4*)(hp + 128) = cv; }
                    if (m == 3 && fr >= 14) { float* hp = HB + ((size_t)((g * 4 + fr - 12) * 22 + u.pn) * 256 + cl); *(f32x4*)hp = cg; *(f32x4*)(hp + 128) = cv; }
                }
            }
            asm volatile("" ::: "memory");
        }
    }
};
}
#define XB_TMO      128
#define XB_XCNT(j)  (256  + 64 * (j))
#define XB_XSUB(j)  (1280 + 64 * (j))
#define XB_XGEN(j)  (2304 + 64 * (j))
#define XB_TOP      3328
#define XB_TOPGEN   3392
#define XCD_BAR_WORDS 3456
#define XB_SPIN_CAP (1u << 22)
__device__ __forceinline__ unsigned xb_ld(unsigned* p)              { return __hip_atomic_load(p, __ATOMIC_RELAXED, __HIP_MEMORY_SCOPE_AGENT); }
__device__ __forceinline__ unsigned xb_add(unsigned* p, unsigned v) { return __hip_atomic_fetch_add(p, v, __ATOMIC_RELAXED, __HIP_MEMORY_SCOPE_AGENT); }
__device__ __forceinline__ unsigned xb_xcc_id() { return (unsigned)__builtin_amdgcn_s_getreg((3 << 11) | 20) & 0xFu; }
#define XB_SPIN(cond, bar) do { unsigned _sp = 0; while (cond) { __builtin_amdgcn_s_sleep(1); \
    if ((++_sp & 255u) == 0u) { if (xb_ld(&(bar)[XB_TMO])) break; if (_sp > XB_SPIN_CAP) { atomicAdd(&(bar)[XB_TMO], 1u); break; } } } } while (0)
struct XcdBarrier { unsigned* bar; unsigned x; volatile LAS unsigned* st; };
__device__ __forceinline__ XcdBarrier xcd_barrier_post(unsigned* bar, volatile LAS unsigned* st) {
    XcdBarrier b; b.bar = bar; b.x = xb_xcc_id(); b.st = st;
    if (threadIdx.x == 0) (void)xb_add(&bar[XB_XCNT(b.x)], 1u);
    return b;
}
__device__ __forceinline__ void xcd_barrier_complete(unsigned* bar, unsigned x, unsigned& nloc, unsigned& nx) {
    const unsigned G = gridDim.x * gridDim.y * gridDim.z;
    unsigned sum, cnt, mine, sp = 0u;
    for (;;) {
        sum = 0u; cnt = 0u; mine = 0u;
#pragma unroll
        for (unsigned j = 0; j < 16; ++j) { const unsigned c = xb_ld(&bar[XB_XCNT(j)]); sum += c; cnt += (c > 0u) ? 1u : 0u; mine = (j == x) ? c : mine; }
        if (sum == G) break;
        __builtin_amdgcn_s_sleep(1);
        if ((++sp & 255u) == 0u) { if (xb_ld(&bar[XB_TMO])) break; if (sp > XB_SPIN_CAP) { atomicAdd(&bar[XB_TMO], 1u); break; } }
    }
    nloc = mine > 0u ? mine : 1u; nx = cnt > 0u ? cnt : 1u;
}
__device__ __forceinline__ void xcd_barrier(const XcdBarrier& b) {
    asm volatile("s_waitcnt vmcnt(0)" ::: "memory");
    __syncthreads();
    if (threadIdx.x == 0) {
        unsigned* bar = b.bar; unsigned bx = b.x;
        asm volatile("" : "+s"(bx));
        __builtin_amdgcn_s_waitcnt(0);
        unsigned nloc = b.st[0], nx = b.st[1];
        if (nloc == 0u) { xcd_barrier_complete(bar, bx, nloc, nx); b.st[0] = nloc; b.st[1] = nx; }
        const unsigned old = xb_add(&bar[XB_XSUB(bx)], 1u);
        const unsigned gen = old / nloc;
        if (old + 1u == (gen + 1u) * nloc) {
            __builtin_amdgcn_fence(__ATOMIC_RELEASE, "agent");
            asm volatile("s_waitcnt vmcnt(0)" ::: "memory");
            const unsigned og = xb_add(&bar[XB_TOP], 1u);
            const unsigned tg = og / nx;
            if (og + 1u == (tg + 1u) * nx) xb_add(&bar[XB_TOPGEN], 1u);
            else XB_SPIN(xb_ld(&bar[XB_TOPGEN]) == tg, bar);
            __builtin_amdgcn_fence(__ATOMIC_ACQUIRE, "agent");
            xb_add(&bar[XB_XGEN(bx)], 1u);
            asm volatile("s_waitcnt vmcnt(0)" ::: "memory");
        } else {
            XB_SPIN(xb_ld(&bar[XB_XGEN(bx)]) == gen, bar);
            __builtin_amdgcn_fence(__ATOMIC_ACQUIRE, "agent");
            asm volatile("s_waitcnt vmcnt(0)" ::: "memory");
        }
    }
    __syncthreads();
}

#define MFMA32(a, b, c) __builtin_amdgcn_mfma_f32_32x32x16_bf16(a, b, c, 0, 0, 0)
typedef short v4i16_t __attribute__((ext_vector_type(4)));
typedef LAS const char* lds_cptr;
typedef LAS char* lds_ptr;
__device__ __forceinline__ int crow(int r, int hi) { return (r & 3) + 8 * (r >> 2) + 4 * hi; }
__device__ __forceinline__ s16x4 vtr(lds_cptr p) { return __builtin_bit_cast(s16x4, __builtin_amdgcn_ds_read_tr16_b64_v4i16((LAS v4i16_t*)p)); }
__device__ __forceinline__ float other_half(float x, int hi) { auto rr = __builtin_amdgcn_permlane32_swap(__float_as_uint(x), __float_as_uint(x), false, false); return __uint_as_float(hi ? rr[0] : rr[1]); }
constexpr float NEG_INF = -INFINITY;

constexpr int TB_V = 12288, TB_KB = 20480, TB_SIZE = 20992;
struct Stg { u32x4 k, k2, v; float kb; };

template <int NKS> __device__ __forceinline__ void qk64(lds_cptr kbuf, const bf16x8* qf, int r32, int hi, f32x16& p0, f32x16& p1) {
    lds_cptr kp = kbuf + hi * 1024 + r32 * 16;
#pragma unroll
    for (int ks = 0; ks < NKS; ++ks) {
        const bf16x8 a0 = *(const LAS bf16x8*)(kp + ks * 2048), a1 = *(const LAS bf16x8*)(kp + ks * 2048 + 512);
        p0 = MFMA32(a0, qf[ks], p0); p1 = MFMA32(a1, qf[ks], p1);
    }
}
template <int NKS> __device__ __forceinline__ void qk64c(lds_cptr kbuf, const bf16x8* qf, int r32, int hi, const f32x16& c, f32x16& p0, f32x16& p1) {
    lds_cptr kp = kbuf + hi * 1024 + r32 * 16;
    { const bf16x8 a0 = *(const LAS bf16x8*)(kp), a1 = *(const LAS bf16x8*)(kp + 512); p0 = MFMA32(a0, qf[0], c); p1 = MFMA32(a1, qf[0], c); }
#pragma unroll
    for (int ks = 1; ks < NKS; ++ks) {
        const bf16x8 a0 = *(const LAS bf16x8*)(kp + ks * 2048), a1 = *(const LAS bf16x8*)(kp + ks * 2048 + 512);
        p0 = MFMA32(a0, qf[ks], p0); p1 = MFMA32(a1, qf[ks], p1);
    }
}
struct AState { f32x16 o0, o1; float m, l; };
__device__ __forceinline__ void astate_init(AState& s) {
#pragma unroll
    for (int r = 0; r < 16; ++r) { s.o0[r] = 0.f; s.o1[r] = 0.f; }
    s.m = NEG_INF; s.l = 0.f;
}
__device__ __forceinline__ void pv64(f32x16& o0, f32x16& o1, lds_cptr vp, const bf16x8 (&pf)[4]) {
#pragma unroll
    for (int ks = 0; ks < 4; ++ks) {
        const s16x4 l0 = vtr(vp + ks * 1024), h0 = vtr(vp + ks * 1024 + 512), l1 = vtr(vp + 4096 + ks * 1024), h1 = vtr(vp + 4096 + ks * 1024 + 512);
        const bf16x8 v0 = (bf16x8){l0[0], l0[1], l0[2], l0[3], h0[0], h0[1], h0[2], h0[3]}, v1 = (bf16x8){l1[0], l1[1], l1[2], l1[3], h1[0], h1[1], h1[2], h1[3]};
        o0 = MFMA32(v0, pf[ks], o0); o1 = MFMA32(v1, pf[ks], o1);
    }
}
struct VFrag { bf16x8 v0[4], v1[4]; };
__device__ __forceinline__ void v_load64(VFrag& f, lds_cptr vp) {
#pragma unroll
    for (int ks = 0; ks < 4; ++ks) {
        const s16x4 l0 = vtr(vp + ks * 1024), h0 = vtr(vp + ks * 1024 + 512), l1 = vtr(vp + 4096 + ks * 1024), h1 = vtr(vp + 4096 + ks * 1024 + 512);
        f.v0[ks] = (bf16x8){l0[0], l0[1], l0[2], l0[3], h0[0], h0[1], h0[2], h0[3]}; f.v1[ks] = (bf16x8){l1[0], l1[1], l1[2], l1[3], h1[0], h1[1], h1[2], h1[3]};
    }
}
__device__ __forceinline__ void pv64f(f32x16& o0, f32x16& o1, const VFrag& f, const bf16x8 (&pf)[4]) {
#pragma unroll
    for (int ks = 0; ks < 4; ++ks) { o0 = MFMA32(f.v0[ks], pf[ks], o0); o1 = MFMA32(f.v1[ks], pf[ks], o1); }
}
__device__ __forceinline__ void pack_p(const f32x16& p0, const f32x16& p1, bf16x8 (&pf)[4]) {
    u32x4 w0, w1, w2, w3;
    w0.x = cvtpk(p0[0], p0[1]); w0.y = cvtpk(p0[2], p0[3]); w0.z = cvtpk(p0[4], p0[5]); w0.w = cvtpk(p0[6], p0[7]);
    w1.x = cvtpk(p0[8], p0[9]); w1.y = cvtpk(p0[10], p0[11]); w1.z = cvtpk(p0[12], p0[13]); w1.w = cvtpk(p0[14], p0[15]);
    w2.x = cvtpk(p1[0], p1[1]); w2.y = cvtpk(p1[2], p1[3]); w2.z = cvtpk(p1[4], p1[5]); w2.w = cvtpk(p1[6], p1[7]);
    w3.x = cvtpk(p1[8], p1[9]); w3.y = cvtpk(p1[10], p1[11]); w3.z = cvtpk(p1[12], p1[13]); w3.w = cvtpk(p1[14], p1[15]);
    pf[0] = __builtin_bit_cast(bf16x8, w0); pf[1] = __builtin_bit_cast(bf16x8, w1); pf[2] = __builtin_bit_cast(bf16x8, w2); pf[3] = __builtin_bit_cast(bf16x8, w3);
}
__device__ __forceinline__ void softmax_pv64(f32x16& p0, f32x16& p1, AState& s, lds_cptr vp, int hi) {
    VFrag vf; v_load64(vf, vp); __builtin_amdgcn_sched_barrier(0);
    float mx = fmaxf(p0[0], p1[0]);
#pragma unroll
    for (int r = 1; r < 16; ++r) mx = fmaxf(mx, fmaxf(p0[r], p1[r]));
    mx = fmaxf(mx, other_half(mx, hi));
    const float mn = fmaxf(s.m, mx), ms = (mn == NEG_INF) ? 0.f : mn;
    const float alpha = fast_exp2(s.m - ms);
    float rs = 0.f;
#pragma unroll
    for (int r = 0; r < 16; ++r) { p0[r] = fast_exp2(p0[r] - ms); p1[r] = fast_exp2(p1[r] - ms); rs += p0[r] + p1[r]; }
    rs += other_half(rs, hi);
    s.l = s.l * alpha + rs; s.m = mn;
#pragma unroll
    for (int r = 0; r < 16; ++r) { s.o0[r] *= alpha; s.o1[r] *= alpha; }
    bf16x8 pf[4]; pack_p(p0, p1, pf);
    pv64f(s.o0, s.o1, vf, pf);
}
__device__ __forceinline__ void softmax_fixed_pv64(f32x16& p0, f32x16& p1, AState& s, lds_cptr vp) {
    VFrag vf; v_load64(vf, vp); __builtin_amdgcn_sched_barrier(0);
    float rs = 0.f;
#pragma unroll
    for (int r = 0; r < 16; ++r) { p0[r] = fast_exp2(p0[r]); p1[r] = fast_exp2(p1[r]); rs += p0[r] + p1[r]; }
    s.l += rs;
    bf16x8 pf[4]; pack_p(p0, p1, pf);
    pv64f(s.o0, s.o1, vf, pf);
}
__device__ __forceinline__ void mask_causal(f32x16& p0, f32x16& p1, int kpos0, int tq, int hi) {
#pragma unroll
    for (int r = 0; r < 16; ++r) { const int kp = kpos0 + crow(r, hi); if (kp > tq) p0[r] = NEG_INF; if (kp + 32 > tq) p1[r] = NEG_INF; }
}
__device__ __forceinline__ void add_table(f32x16& p0, f32x16& p1, const LAS float* tb) {
#pragma unroll
    for (int r = 0; r < 16; ++r) { const int o = (r & 3) + 8 * (r >> 2); p0[r] += tb[o]; p1[r] += tb[o + 32]; }
}
__device__ __forceinline__ void store_o_bf16(bf16_t* orow, const f32x16& o0, const f32x16& o1, float sc, int hi) {
#pragma unroll
    for (int g = 0; g < 4; ++g) {
        u32x2 w0, w1; w0.x = cvtpk(o0[4 * g] * sc, o0[4 * g + 1] * sc); w0.y = cvtpk(o0[4 * g + 2] * sc, o0[4 * g + 3] * sc);
        w1.x = cvtpk(o1[4 * g] * sc, o1[4 * g + 1] * sc); w1.y = cvtpk(o1[4 * g + 2] * sc, o1[4 * g + 3] * sc);
        *(u32x2*)(orow + 8 * g + 4 * hi) = w0; *(u32x2*)(orow + 32 + 8 * g + 4 * hi) = w1;
    }
}
constexpr size_t MiB = 1u << 20, KiB = 1u << 10;
constexpr size_t WS_CTL = 0, CTL_ZERO_BYTES = 1 * MiB;
constexpr size_t WS_ROPE = 1 * MiB, WS_NSATAB = WS_ROPE + 512 * KiB, WS_DILTAB = WS_NSATAB + 32 * KiB, WS_CMPB = WS_DILTAB + 8 * KiB, WS_FARB = WS_CMPB + 4 * KiB;
constexpr size_t WS_WT = 4 * MiB, LW = 38 * MiB;
constexpr size_t LW_IN = 0, LW_G = 6 * MiB, LW_BR = 14 * MiB, LW_O = 16 * MiB, LW_UP = 18 * MiB, LW_DN = 29 * MiB, LW_UQ = 35 * MiB, LW_UKV = 35 * MiB + 256 * KiB, LW_PHI = 36 * MiB;
constexpr size_t BR_A = 0, BR_B = 512 * KiB, BR_C = 768 * KiB, BR_D = 1280 * KiB;
constexpr size_t WS_SIDE = 80 * MiB, WS_SSQQ = 84 * MiB, WS_SSQKV = 85 * MiB, WS_KB = 86 * MiB, WS_KROT = 87 * MiB, WS_KCMP = 91 * MiB, WS_VCMP = 100 * MiB,
                 WS_HID = 109 * MiB, WS_KMAX = 3 * MiB + 128 * KiB  , WS_LF = 2 * MiB  , WS_CMPP = 3 * MiB  , WS_ORDER = 3 * MiB + 64 * KiB  , WS_KC = 113 * MiB, WS_VC = 113 * MiB + 512 * KiB, WS_DLSE = 114 * MiB, WS_DOG = 116 * MiB;
constexpr size_t WS_H = 164 * MiB, WS_OCAT = 292 * MiB, WS_QM = 404 * MiB, WS_KVM = 468 * MiB, WS_P = 532 * MiB;
constexpr size_t WS_MERGED = 532 * MiB, WS_MSCR = 660 * MiB, WS_Y = 164 * MiB  , WS_H2 = 756 * MiB, WS_ACT = 164 * MiB  , WS_HB = 532 * MiB  , WS_Y2 = 884 * MiB  , WS_X3 = 620 * MiB  , WS_END = 1024 * MiB;
constexpr size_t MSCR_PER_WG = 512 * KiB;
constexpr size_t H8_OFF = 128 * MiB;
static_assert(WS_WT + 2 * LW <= WS_SIDE && WS_DOG + 48 * MiB <= WS_H && WS_P + 384 * MiB <= WS_END && WS_MSCR + 256 * MSCR_PER_WG <= WS_P + 384 * MiB && WS_H2 + 128 * MiB <= WS_Y2 && WS_Y2 + 128 * MiB <= WS_END, "ws map");
static_assert(WS_ACT + 352 * MiB <= WS_HB && WS_HB + 88 * MiB <= WS_X3 && WS_X3 + 128 * MiB <= WS_H2 && WS_Y + 128 * MiB <= WS_OCAT, "ws overlays");
constexpr int CW_BAR = 4096;
constexpr int CW_KMAX = 24576;
constexpr int CW_KMLA = 24832;
constexpr int CW_KROT = 25344;
constexpr int CW_Q = 16384;

constexpr int RING_BYTES = 131072, LDSCTL_OFF = RING_BYTES, MISC_OFF = LDSCTL_OFF + 320, LDS_BYTES = 147456;
constexpr int NSA_SLAB = 49152, NSA_SLAB_BYTES = 4 * 64 * 65 * 4, NSA_SEL = NSA_SLAB + NSA_SLAB_BYTES;
static_assert(NSA_SEL + 512 <= RING_BYTES && 4 * NSA_TL * 4 <= NSA_SLAB_BYTES && 2 * TB_SIZE <= NSA_SLAB, "NSA LDS map");

struct Frame {
    LAS unsigned char* lds; volatile LAS unsigned* MISC; gu32* ctl;
    int tid, lane, wave, G;
    const float* in[27]; float* out; unsigned char* ws;
};
#define WSP(T, off) ((T*)(F.ws + (off)))
#define VM_WAIT() asm volatile("s_waitcnt vmcnt(0)" ::: "memory")
#define LDS_WAIT() asm volatile("s_waitcnt lgkmcnt(0)" ::: "memory")

__device__ __forceinline__ int queue_grab(Frame& F, gu32* ctr) {
    if (F.tid == 0) F.MISC[0] = __hip_atomic_fetch_add(ctr, 1u, __ATOMIC_RELAXED, __HIP_MEMORY_SCOPE_AGENT);
    __syncthreads();
    const int v = (int)F.MISC[0];
    __syncthreads();
    return v;
}

template <bool FOX> __device__ __forceinline__ void causal_unit(Frame& F, int b, int h, int qb, float kmax_in) {
    constexpr int NKS = FOX ? 4 : 6;
    int lane_o = F.lane; asm volatile("" : "+v"(lane_o));
    const int wid = F.wave, lane = lane_o, r32 = lane & 31, hi = lane >> 5;
    const size_t rowbase = (size_t)b * SEQ;
    const int q0 = qb * 256, tq = q0 + wid * 32 + r32, NT = qb * 4 + 4;
    const bf16_t* P = WSP(const bf16_t, WS_P);
    const bf16_t *Kb, *Vb, *Qrow; int kpitch, vpitch;
    const bf16_t* Kr = WSP(const bf16_t, WS_KROT) + rowbase * 32;
    const float* kbsrc = WSP(const float, WS_KB) + (size_t)(b * 4 + h) * SEQ;
    if (FOX) { Kb = P + rowbase * PW + PC_CK + h * 64; Vb = P + rowbase * PW + PC_CV + h * 64; kpitch = PW; vpitch = PW; Qrow = P + (rowbase + tq) * PW + PC_CQ + h * 64; }
    else { const bf16_t* KV = WSP(const bf16_t, WS_KVM) + rowbase * 512 + h * 128; Kb = KV; Vb = KV + 64; kpitch = 512; vpitch = 512; Qrow = WSP(const bf16_t, WS_QM) + (rowbase + tq) * 512 + h * 96; }
    bf16x8 qf[NKS];
#pragma unroll
    for (int ks = 0; ks < NKS; ++ks) qf[ks] = *(const bf16x8*)(Qrow + ks * 16 + hi * 8);
    AState st; astate_init(st);
    lds_ptr lds = (lds_ptr)F.lds;
    const int vpo = ((lane >> 4) & 1) * 32 + (lane & 3) * 8 + (4 * hi + ((lane & 15) >> 2)) * 64;
    Stg sA, sB;
#define CU_LOAD(S, t) do { S.k = *(const u32x4*)(Kb + (size_t)((t) * 64 + lane) * kpitch + wid * 8); \
        if (!FOX) { if (wid < 4) S.k2 = *(const u32x4*)(Kr + (size_t)((t) * 64 + lane) * 32 + wid * 8); } \
        S.v = *(const u32x4*)(Vb + (size_t)((t) * 64 + 16 * (wid & 3) + (lane >> 2)) * vpitch + (wid >> 2) * 32 + (lane & 3) * 8); \
        if (FOX) { if (wid == 0) S.kb = kbsrc[(t) * 64 + lane]; else if (wid == 1) S.kb = kbsrc[(t) > 0 ? (t) * 64 - 1 : 0]; } } while (0)
#define CU_WRITE(S, bofs) do { lds_ptr bp = lds + (bofs); *(LAS u32x4*)(bp + wid * 1024 + lane * 16) = S.k; \
        if (!FOX) { if (wid < 4) *(LAS u32x4*)(bp + (8 + wid) * 1024 + lane * 16) = S.k2; } \
        *(LAS u32x4*)(bp + TB_V + wid * 1024 + lane * 16) = S.v; \
        if (FOX) { if (wid == 0) *(LAS float*)(bp + TB_KB + lane * 4) = S.kb; else if (wid == 1 && lane == 0) *(LAS float*)(bp + TB_KB + 256) = S.kb; } } while (0)
    const int tq_lo = q0 + wid * 32;
    float qn = 0.f; const float kmax = kmax_in;
#pragma unroll
    for (int ks = 0; ks < NKS; ++ks)
#pragma unroll
        for (int e = 0; e < 8; ++e) { const float x = bf2f((unsigned short)qf[ks][e]); qn += x * x; }
    qn += other_half(qn, hi); qn = sqrtf(qn);
    const float bnd = qn * kmax * 1.002f + 0.05f;
    const bool fast = __all(bnd <= 50.0f);
    const float kbi = FOX ? kbsrc[tq] : 0.f;
    f32x16 cinit;
    { const float c0 = -(bnd + kbi);
#pragma unroll
      for (int r = 0; r < 16; ++r) cinit[r] = c0; }
    LAS volatile unsigned* dflag = (LAS volatile unsigned*)(lds + 4 * TB_SIZE + 64);
#define CU_TILE(T, BOFS) { const int t = (T); lds_cptr bp = (lds_cptr)(lds + (BOFS)); \
        if (64 * t <= tq_lo + 31) {                                \
            f32x16 p0, p1; \
            if (fast) qk64c<NKS>(bp, qf, r32, hi, cinit, p0, p1); \
            else { _Pragma("unroll") for (int r = 0; r < 16; ++r) { p0[r] = 0.f; p1[r] = 0.f; } qk64<NKS>(bp, qf, r32, hi, p0, p1); } \
            if (FOX) { const LAS float* kbt = (const LAS float*)(bp + TB_KB) + 4 * hi; \
                _Pragma("unroll") for (int g = 0; g < 4; ++g) { const f32x4 a = *(const LAS f32x4*)(kbt + 8 * g), c = *(const LAS f32x4*)(kbt + 32 + 8 * g); \
                    _Pragma("unroll") for (int e = 0; e < 4; ++e) { p0[4 * g + e] += a[e]; p1[4 * g + e] += c[e]; } } } \
            if (64 * t + 63 > tq_lo) mask_causal(p0, p1, 64 * t, tq, hi); \
            if (fast) softmax_fixed_pv64(p0, p1, st, bp + TB_V + vpo); else softmax_pv64(p0, p1, st, bp + TB_V + vpo, hi); \
        } }
    const int NP = NT >> 1;
#define CU_TA(p) (FOX ? NT - 1 - 2 * (p) : 2 * (p))
#define CU_TB(p) (FOX ? NT - 2 - 2 * (p) : 2 * (p) + 1)
    CU_LOAD(sA, CU_TA(0)); CU_LOAD(sB, CU_TB(0)); CU_WRITE(sA, 0); CU_WRITE(sB, TB_SIZE);
    __syncthreads();
    for (int p = 0; p < NP; ++p) {
        const int pofs = (p & 1) * 2 * TB_SIZE, nofs = ((p & 1) ^ 1) * 2 * TB_SIZE;
        if (p + 1 < NP) { CU_LOAD(sA, CU_TA(p + 1)); CU_LOAD(sB, CU_TB(p + 1)); }
        { const int ta_ = CU_TA(p), tbb_ = CU_TB(p), tmax_ = ta_ > tbb_ ? ta_ : tbb_;
          if (fast && 64 * tmax_ + 63 <= tq_lo) {
              lds_cptr bpa = (lds_cptr)(lds + pofs), bpb = (lds_cptr)(lds + pofs + TB_SIZE);
              f32x16 a0, a1, b0, b1;
              qk64c<NKS>(bpa, qf, r32, hi, cinit, a0, a1);
              qk64c<NKS>(bpb, qf, r32, hi, cinit, b0, b1);
              if (FOX) { const LAS float* ka = (const LAS float*)(bpa + TB_KB) + 4 * hi; const LAS float* kb2 = (const LAS float*)(bpb + TB_KB) + 4 * hi;
#pragma unroll
                  for (int g = 0; g < 4; ++g) { const f32x4 x = *(const LAS f32x4*)(ka + 8 * g), y = *(const LAS f32x4*)(ka + 32 + 8 * g), z = *(const LAS f32x4*)(kb2 + 8 * g), w = *(const LAS f32x4*)(kb2 + 32 + 8 * g);
#pragma unroll
                      for (int e = 0; e < 4; ++e) { a0[4 * g + e] += x[e]; a1[4 * g + e] += y[e]; b0[4 * g + e] += z[e]; b1[4 * g + e] += w[e]; } } }
              VFrag va; v_load64(va, bpa + TB_V + vpo);
              float rs = 0.f;
#pragma unroll
              for (int r = 0; r < 16; ++r) { a0[r] = fast_exp2(a0[r]); a1[r] = fast_exp2(a1[r]); rs += a0[r] + a1[r]; }
              bf16x8 pfa[4]; pack_p(a0, a1, pfa);
              pv64f(st.o0, st.o1, va, pfa);
              VFrag vb; v_load64(vb, bpb + TB_V + vpo);
#pragma unroll
              for (int r = 0; r < 16; ++r) { b0[r] = fast_exp2(b0[r]); b1[r] = fast_exp2(b1[r]); rs += b0[r] + b1[r]; }
              st.l += rs;
              bf16x8 pfb[4]; pack_p(b0, b1, pfb);
              pv64f(st.o0, st.o1, vb, pfb);
          } else {
              CU_TILE(ta_, pofs)
              CU_TILE(tbb_, pofs + TB_SIZE)
          } }
        const int tb_ = CU_TB(p);
        if (FOX) { if (tb_ > 0) { const float kb_last = *(const LAS float*)(lds + pofs + TB_SIZE + TB_KB + 256); const bool done = fast ? ((kb_last - kbi) < -150.0f) : ((qn * kmax + kb_last - st.m) < -130.0f); const unsigned alld = __all(done) ? 1u : 0u; if (lane == 0) dflag[(p & 1) * 8 + wid] = alld; } }
        if (p + 1 < NP) { CU_WRITE(sA, nofs); CU_WRITE(sB, nofs + TB_SIZE); }
        __syncthreads();
        if (FOX) { if (tb_ > 0) { unsigned all = 1u;
#pragma unroll
                for (int w = 0; w < 8; ++w) all &= dflag[(p & 1) * 8 + w];
                if (all) break; } }
    }
#undef CU_TA
#undef CU_TB
#undef CU_TILE
#undef CU_LOAD
#undef CU_WRITE
    bf16_t* orow = WSP(bf16_t, WS_OCAT) + (rowbase + tq) * OCW + (FOX ? 384 : 640) + h * 64;
    const float ltot = fast ? st.l + other_half(st.l, hi) : st.l;
    store_o_bf16(orow, st.o0, st.o1, 1.0f / ltot, hi);
}
__device__ __forceinline__ void nsa_unit(Frame& F, int b, int qblk) {
    int lane_o = F.lane; asm volatile("" : "+v"(lane_o));
    const int wid = F.wave, lane = lane_o, r32 = lane & 31, hi = lane >> 5, tid = wid * 64 + lane;
    const int h = wid & 3, qs = wid >> 2;
    const int q0 = qblk * 64, cur = qblk, tq = q0 + 32 * qs + r32, tq_lo = q0 + 32 * qs;
    const size_t rowbase = (size_t)b * SEQ, row = rowbase + tq;
    const bf16_t* P = WSP(const bf16_t, WS_P);
    lds_ptr lds = (lds_ptr)F.lds;
    const int vpo = ((lane >> 4) & 1) * 32 + (lane & 3) * 8 + (4 * hi + ((lane & 15) >> 2)) * 64;
    bf16x8 qf[4];
    { const bf16_t* Qrow = P + row * PW + PC_AQ + h * 64;
#pragma unroll
      for (int ks = 0; ks < 4; ++ks) qf[ks] = *(const bf16x8*)(Qrow + ks * 16 + hi * 8); }
    Stg s; int ln;
#define NS_LOAD(Kb, kp, Vb, vp_, t) do { s.k = *(const u32x4*)((Kb) + (size_t)((t) * 64 + ln) * (kp) + wid * 8); \
        s.v = *(const u32x4*)((Vb) + (size_t)((t) * 64 + 16 * (wid & 3) + (ln >> 2)) * (vp_) + (wid >> 2) * 32 + (ln & 3) * 8); } while (0)
#define NS_FRESH() do { ln = lane; asm volatile("" : "+v"(ln)); } while (0)
#define NS_WRITE(bi) do { lds_ptr bp_ = lds + (bi) * TB_SIZE; *(LAS u32x4*)(bp_ + wid * 1024 + lane * 16) = s.k; *(LAS u32x4*)(bp_ + TB_V + wid * 1024 + lane * 16) = s.v; } while (0)
    const bf16_t* KC = WSP(const bf16_t, WS_KC) + (size_t)b * 256 * 64; const bf16_t* VC = WSP(const bf16_t, WS_VC) + (size_t)b * 256 * 64;
    const int cmax_u = (q0 + 63 - 31) >> 4, NTc = (cmax_u >> 6) + 1;
    const int cmax = (tq - 31) >> 4;
    float cm = NEG_INF, cl = 0.f;
    NS_FRESH(); NS_LOAD(KC, 64, VC, 64, 0); NS_WRITE(0);
    __syncthreads();
    for (int t = 0; t < NTc; ++t) {
        const int bi = t & 1;
        if (t + 1 < NTc) NS_LOAD(KC, 64, VC, 64, t + 1);
        { lds_cptr bp = (lds_cptr)(lds + bi * TB_SIZE); f32x16 p0, p1;
#pragma unroll
          for (int r = 0; r < 16; ++r) { p0[r] = 0.f; p1[r] = 0.f; }
          qk64<4>(bp, qf, r32, hi, p0, p1);
          float mx = NEG_INF;
#pragma unroll
          for (int r = 0; r < 16; ++r) { const int c = 64 * t + crow(r, hi); if (c > cmax) p0[r] = NEG_INF; if (c + 32 > cmax) p1[r] = NEG_INF; mx = fmaxf(mx, fmaxf(p0[r], p1[r])); }
          mx = fmaxf(mx, other_half(mx, hi));
          const float mn = fmaxf(cm, mx), ms = (mn == NEG_INF) ? 0.f : mn; float rs = 0.f;
#pragma unroll
          for (int r = 0; r < 16; ++r) rs += fast_exp2(p0[r] - ms) + fast_exp2(p1[r] - ms);
          rs += other_half(rs, hi);
          cl = cl * fast_exp2(cm - ms) + rs; cm = mn; }
        if (t + 1 < NTc) NS_WRITE(bi ^ 1);
        __syncthreads();
    }
    const float cms = (cm == NEG_INF) ? 0.f : cm, cinv = 1.0f / fmaxf(cl, 1e-30f);
    f32x16 oc0, oc1;
#pragma unroll
    for (int r = 0; r < 16; ++r) { oc0[r] = 0.f; oc1[r] = 0.f; }
    float G[32]; float carry = 0.f;
#pragma unroll
    for (int i = 0; i < 32; ++i) G[i] = 0.f;
    NS_FRESH(); NS_LOAD(KC, 64, VC, 64, 0); NS_WRITE(0);
    __syncthreads();
#pragma unroll
    for (int t = 0; t < 4; ++t) {
        if (t < NTc) {
            const int bi = t & 1;
            if (t + 1 < NTc) NS_LOAD(KC, 64, VC, 64, t + 1);
            { lds_cptr bp = (lds_cptr)(lds + bi * TB_SIZE); f32x16 p0, p1;
#pragma unroll
              for (int r = 0; r < 16; ++r) { p0[r] = 0.f; p1[r] = 0.f; }
              qk64<4>(bp, qf, r32, hi, p0, p1);
#pragma unroll
              for (int r = 0; r < 16; ++r) { const int c = 64 * t + crow(r, hi);
                  p0[r] = (c > cmax) ? 0.f : fast_exp2(p0[r] - cms) * cinv; p1[r] = (c + 32 > cmax) ? 0.f : fast_exp2(p1[r] - cms) * cinv; }
#pragma unroll
              for (int g = 0; g < 4; ++g) { const float oth = other_half(p0[4 * g + 3], hi);
                  G[t * 8 + g] = ((p0[4 * g] + p0[4 * g + 1]) + (p0[4 * g + 2] + p0[4 * g + 3])) + (hi ? oth : carry); carry = oth; }
#pragma unroll
              for (int g = 0; g < 4; ++g) { const float oth = other_half(p1[4 * g + 3], hi);
                  G[t * 8 + 4 + g] = ((p1[4 * g] + p1[4 * g + 1]) + (p1[4 * g + 2] + p1[4 * g + 3])) + (hi ? oth : carry); carry = oth; }
              bf16x8 pf[4]; pack_p(p0, p1, pf);
              pv64(oc0, oc1, bp + TB_V + vpo, pf); }
            if (t + 1 < NTc) NS_WRITE(bi ^ 1);
            __syncthreads();
        }
    }
    { LAS float* slab = (LAS float*)(lds + NSA_SLAB) + (size_t)(h * 64 + 32 * qs + r32) * 65;
#pragma unroll
      for (int i = 0; i < 32; ++i) slab[2 * i + hi] = G[i]; }
    __syncthreads();
    u32x4 tbr[4]; { const u32x4* src = WSP(const u32x4, WS_NSATAB);
#pragma unroll
      for (int i = 0; i < 4; ++i) { const int idx = tid + 512 * i; tbr[i] = (idx < 4 * NSA_TL / 4) ? src[idx] : (u32x4){0u, 0u, 0u, 0u}; } }
    float gl0, gl1, gl2; { const float* sd = WSP(const float, WS_SIDE) + row * 16 + h * 3; gl0 = sd[0]; gl1 = sd[1]; gl2 = sd[2]; }
    { const int q = tid >> 3, jg = tid & 7;
      const LAS float* s0 = (const LAS float*)(lds + NSA_SLAB) + (size_t)q * 65;
      float v[64];
#pragma unroll
      for (int k = 0; k < 64; ++k) { const float x = (s0[k] + s0[64 * 65 + k]) + (s0[2 * 64 * 65 + k] + s0[3 * 64 * 65 + k]);
          v[k] = (k == 0 || k == cur || k == cur - 1) ? 1e9f : ((k > cur) ? -1e9f : x); if ((k & 7) == 7) asm volatile("" ::: "memory"); }
      unsigned bits = 0u;
#pragma unroll
      for (int e = 0; e < 8; ++e) { const int j = 8 * jg + e;
          const float xj = (s0[j] + s0[64 * 65 + j]) + (s0[2 * 64 * 65 + j] + s0[3 * 64 * 65 + j]);
          const float vj = (j == 0 || j == cur || j == cur - 1) ? 1e9f : ((j > cur) ? -1e9f : xj);
          int rank = 0;
#pragma unroll
          for (int k = 0; k < 64; ++k) rank += (v[k] > vj || (v[k] == vj && k < j)) ? 1 : 0;
          bits |= (rank < 16 ? 1u : 0u) << e; }
      *((LAS unsigned char*)(lds + NSA_SEL) + q * 8 + jg) = (unsigned char)bits; }
    __syncthreads();
    const unsigned mlo = *(const LAS unsigned*)(lds + NSA_SEL + (32 * qs + r32) * 8), mhi = *(const LAS unsigned*)(lds + NSA_SEL + (32 * qs + r32) * 8 + 4);
    { LAS u32x4* dst = (LAS u32x4*)(lds + NSA_SLAB);
#pragma unroll
      for (int i = 0; i < 4; ++i) { const int idx = tid + 512 * i; if (idx < 4 * NSA_TL / 4) dst[idx] = tbr[i]; } }
    const LAS float* tabh = (const LAS float*)(lds + NSA_SLAB) + h * NSA_TL;
    const float farb = WSP(const float, WS_FARB)[h];
    const float g0 = sigmoid_f(gl0), g1 = sigmoid_f(gl1), g2 = sigmoid_f(gl2);
    AState st; astate_init(st);
    { const bf16_t* Kb = P + rowbase * PW + PC_KSLC; const bf16_t* Vb = P + rowbase * PW + PC_VSLC;
      NS_FRESH(); NS_LOAD(Kb, PW, Vb, PW, 0); NS_WRITE(0);
      __syncthreads();
      for (int j = 0; j <= cur; ++j) {
          const int bi = j & 1;
          if (j < cur) NS_LOAD(Kb, PW, Vb, PW, j + 1);
          const bool mine = ((j < 32) ? (mlo >> j) : (mhi >> (j - 32))) & 1u;
          if (__any(mine)) {
              lds_cptr bp = (lds_cptr)(lds + bi * TB_SIZE); f32x16 p0, p1;
#pragma unroll
              for (int r = 0; r < 16; ++r) { p0[r] = 0.f; p1[r] = 0.f; }
              qk64<4>(bp, qf, r32, hi, p0, p1);
              if (q0 - 64 * j - 63 >= NSA_DFAR) {
#pragma unroll
                  for (int r = 0; r < 16; ++r) { p0[r] += farb; p1[r] += farb; }
              } else add_table(p0, p1, tabh + (NSA_DMAX - tq + 64 * j + 4 * hi));
              if (j == cur) mask_causal(p0, p1, 64 * j, tq, hi);
              if (!mine) {
#pragma unroll
                  for (int r = 0; r < 16; ++r) { p0[r] = NEG_INF; p1[r] = NEG_INF; } }
              softmax_pv64(p0, p1, st, bp + TB_V + vpo, hi);
          }
          if (j < cur) NS_WRITE(bi ^ 1);
          __syncthreads();
      } }
    f32x16 oa0, oa1;
    { const float sc = g1 / st.l;
#pragma unroll
      for (int r = 0; r < 16; ++r) { oa0[r] = g0 * oc0[r] + sc * st.o0[r]; oa1[r] = g0 * oc1[r] + sc * st.o1[r]; } }
    astate_init(st);
    { const bf16_t* Kb = P + rowbase * PW + PC_KWIN; const bf16_t* Vb = P + rowbase * PW + PC_VWIN;
      const int jlo = cur >= 8 ? cur - 8 : 0;
      NS_FRESH(); NS_LOAD(Kb, PW, Vb, PW, jlo); NS_WRITE(0);
      __syncthreads();
      for (int j = jlo; j <= cur; ++j) {
          const int bi = (j - jlo) & 1;
          if (j < cur) NS_LOAD(Kb, PW, Vb, PW, j + 1);
          if (tq_lo - 64 * j - 63 < 512) {
              lds_cptr bp = (lds_cptr)(lds + bi * TB_SIZE); f32x16 p0, p1;
#pragma unroll
              for (int r = 0; r < 16; ++r) { p0[r] = 0.f; p1[r] = 0.f; }
              qk64<4>(bp, qf, r32, hi, p0, p1);
              add_table(p0, p1, tabh + (NSA_DMAX - tq + 64 * j + 4 * hi));
              if (!(tq_lo - 64 * j - 63 >= 0 && tq_lo + 31 - 64 * j < 512)) {
                  const int d0 = tq - 64 * j - 4 * hi;
#pragma unroll
                  for (int r = 0; r < 16; ++r) { const int d = d0 - ((r & 3) + 8 * (r >> 2)); if (d < 0 || d >= 512) p0[r] = NEG_INF; if (d - 32 < 0 || d - 32 >= 512) p1[r] = NEG_INF; }
              }
              softmax_pv64(p0, p1, st, bp + TB_V + vpo, hi);
          }
          if (j < cur) NS_WRITE(bi ^ 1);
          __syncthreads();
      } }
    { const float sc = g2 / st.l;
#pragma unroll
      for (int r = 0; r < 16; ++r) { oa0[r] += sc * st.o0[r]; oa1[r] += sc * st.o1[r]; } }
    { int tq_ = tq; asm volatile("" : "+v"(tq_)); store_o_bf16(WSP(bf16_t, WS_OCAT) + (rowbase + tq_) * OCW + h * 64, oa0, oa1, 1.0f, hi); }
#undef NS_LOAD
#undef NS_FRESH
#undef NS_WRITE
}
__device__ __forceinline__ void dil_unit(Frame& F, int b, int hh, int span) {
    int lane_o = F.lane; asm volatile("" : "+v"(lane_o));
    const int wid = F.wave, lane = lane_o, r32 = lane & 31, hi = lane >> 5, tid = wid * 64 + lane;
    const int T0 = span * 512;
    const size_t rowbase = (size_t)b * SEQ;
    const bf16_t* P = WSP(const bf16_t, WS_P) + rowbase * PW;
    lds_ptr lds = (lds_ptr)F.lds;
    LAS float* dtab = (LAS float*)(lds + 32768);
    for (int i = tid; i < 3 * 192; i += 512) dtab[i] = WSP(const float, WS_DILTAB)[((i / 192) * 2 + hh) * 192 + (i % 192)];
    __syncthreads();
    lds_ptr vst = lds + wid * 4096;
    const int vpo = ((lane >> 4) & 1) * 32 + (lane & 3) * 8 + (4 * hi + ((lane & 15) >> 2)) * 64;
    bf16_t* DOG = WSP(bf16_t, WS_DOG); float* DLSE = WSP(float, WS_DLSE);
    for (int g = 0; g < 3; ++g) {
        const int sh = 2 * g, head = 2 * g + hh;
        for (int rep = 0; rep < 2; ++rep) {
            const int wt = wid + 8 * rep;
            const int res = (g == 0) ? 0 : (g == 1 ? (wt & 3) : wt);
            const int i0 = (g == 0) ? 32 * wt : (g == 1 ? 32 * (wt >> 2) : 0);
            const int n0 = (T0 >> sh) + i0;
            const int tokq = res + ((n0 + r32) << sh);
            bf16x8 qf[4];
            { const bf16_t* Qrow = P + (size_t)tokq * PW + PC_BQ + head * 64;
#pragma unroll
              for (int ks = 0; ks < 4; ++ks) qf[ks] = *(const bf16x8*)(Qrow + ks * 16 + hi * 8); }
            f32x16 o0, o1; float m = NEG_INF, l = 0.f;
#pragma unroll
            for (int r = 0; r < 16; ++r) { o0[r] = 0.f; o1[r] = 0.f; }
#define DIL_LOAD(cc, KF, VR) do { const int nk0_ = n0 - 128 + 32 * (cc); int nk_ = nk0_ + r32; nk_ = nk_ < 0 ? 0 : nk_; const bf16_t* Krow_ = P + (size_t)(res + (nk_ << sh)) * PW + PC_BK + head * 64; \
        _Pragma("unroll") for (int ks = 0; ks < 4; ++ks) KF[ks] = *(const bf16x8*)(Krow_ + ks * 16 + hi * 8); \
        _Pragma("unroll") for (int i = 0; i < 4; ++i) { const int pc_ = lane + 64 * i, vrow_ = pc_ >> 3, c16_ = pc_ & 7; int nv_ = nk0_ + vrow_; nv_ = nv_ < 0 ? 0 : nv_; \
            VR[i] = *(const u32x4*)(P + (size_t)(res + (nv_ << sh)) * PW + PC_BV + head * 64 + c16_ * 8); } } while (0)
            int cfirst = 0; while (cfirst < 4 && n0 - 128 + 32 * cfirst + 31 < 0) ++cfirst;
            bf16x8 kfn[4]; u32x4 vrn[4];
            DIL_LOAD(cfirst, kfn, vrn);
            for (int c = cfirst; c < 5; ++c) {
                const int nk0 = n0 - 128 + 32 * c;
                { bf16x8 kf[4]; u32x4 vr[4];
#pragma unroll
                  for (int i = 0; i < 4; ++i) { kf[i] = kfn[i]; vr[i] = vrn[i]; }
                  if (c < 4) DIL_LOAD(c + 1, kfn, vrn);
#pragma unroll
                  for (int i = 0; i < 4; ++i) { const int pc = lane + 64 * i, vrow = pc >> 3, c16 = pc & 7;
                      *(LAS u32x4*)(vst + (c16 >> 2) * 2048 + vrow * 64 + (c16 & 3) * 16) = vr[i]; }
                  asm volatile("s_waitcnt lgkmcnt(0)" ::: "memory");
                  f32x16 p;
#pragma unroll
                  for (int r = 0; r < 16; ++r) p[r] = 0.f;
#pragma unroll
                  for (int ks = 0; ks < 4; ++ks) p = MFMA32(kf[ks], qf[ks], p);
                  const LAS float* tb = dtab + g * 192 + (32 - r32 + 4 * hi + 32 * c);
                  float mx = NEG_INF;
#pragma unroll
                  for (int r = 0; r < 16; ++r) { const int o = (r & 3) + 8 * (r >> 2), kk = o + 4 * hi, j = 128 + r32 - 32 * c - kk;
                      const bool ok = (j >= 0) && (j <= 128) && (nk0 + kk >= 0);
                      p[r] = ok ? p[r] + tb[o] : NEG_INF; mx = fmaxf(mx, p[r]); }
                  mx = fmaxf(mx, other_half(mx, hi));
                  const float mn = fmaxf(m, mx), ms = (mn == NEG_INF) ? 0.f : mn, alpha = fast_exp2(m - ms);
                  float rs = 0.f;
#pragma unroll
                  for (int r = 0; r < 16; ++r) { p[r] = fast_exp2(p[r] - ms); rs += p[r]; }
                  rs += other_half(rs, hi);
                  l = l * alpha + rs; m = mn;
#pragma unroll
                  for (int r = 0; r < 16; ++r) { o0[r] *= alpha; o1[r] *= alpha; }
                  u32x4 w0, w1;
                  w0.x = cvtpk(p[0], p[1]); w0.y = cvtpk(p[2], p[3]); w0.z = cvtpk(p[4], p[5]); w0.w = cvtpk(p[6], p[7]);
                  w1.x = cvtpk(p[8], p[9]); w1.y = cvtpk(p[10], p[11]); w1.z = cvtpk(p[12], p[13]); w1.w = cvtpk(p[14], p[15]);
                  const bf16x8 pf0 = __builtin_bit_cast(bf16x8, w0), pf1 = __builtin_bit_cast(bf16x8, w1);
                  lds_cptr vp = (lds_cptr)(vst + vpo);
#pragma unroll
                  for (int ks = 0; ks < 2; ++ks) {
                      const s16x4 l0 = vtr(vp + ks * 1024), h0 = vtr(vp + ks * 1024 + 512), l1 = vtr(vp + 2048 + ks * 1024), h1 = vtr(vp + 2048 + ks * 1024 + 512);
                      const bf16x8 v0 = (bf16x8){l0[0], l0[1], l0[2], l0[3], h0[0], h0[1], h0[2], h0[3]}, v1 = (bf16x8){l1[0], l1[1], l1[2], l1[3], h1[0], h1[1], h1[2], h1[3]};
                      o0 = MFMA32(v0, ks == 0 ? pf0 : pf1, o0); o1 = MFMA32(v1, ks == 0 ? pf0 : pf1, o1);
                  }
                  asm volatile("s_waitcnt lgkmcnt(0)" ::: "memory"); }
            }
#undef DIL_LOAD
            const size_t orow = rowbase + tokq;
            store_o_bf16(DOG + ((size_t)g * M + orow) * 128 + hh * 64, o0, o1, 1.0f / l, hi);
            if (hi == 0) DLSE[((size_t)g * M + orow) * 2 + hh] = m + log2f(l);
        }
    }
    VM_WAIT();
    __syncthreads();
    bf16_t* OC = WSP(bf16_t, WS_OCAT);
    for (int it = 0; it < 8; ++it) {
        const int item = tid + 512 * it, tl = item >> 3, pc = item & 7; const size_t orow = rowbase + T0 + tl;
        const float l0 = DLSE[((size_t)0 * M + orow) * 2 + hh], l1 = DLSE[((size_t)1 * M + orow) * 2 + hh], l2 = DLSE[((size_t)2 * M + orow) * 2 + hh];
        const float mx = fmaxf(l0, fmaxf(l1, l2)); float w0 = fast_exp2(l0 - mx), w1 = fast_exp2(l1 - mx), w2 = fast_exp2(l2 - mx);
        const float inv = 1.0f / (w0 + w1 + w2); w0 *= inv; w1 *= inv; w2 *= inv;
        const u32x4 a = *(const u32x4*)(DOG + ((size_t)0 * M + orow) * 128 + hh * 64 + pc * 8), bb = *(const u32x4*)(DOG + ((size_t)1 * M + orow) * 128 + hh * 64 + pc * 8),
                    cc = *(const u32x4*)(DOG + ((size_t)2 * M + orow) * 128 + hh * 64 + pc * 8);
        u32x4 w;
#pragma unroll
        for (int e = 0; e < 4; ++e) {
            const float lo = w0 * __uint_as_float(a[e] << 16) + w1 * __uint_as_float(bb[e] << 16) + w2 * __uint_as_float(cc[e] << 16);
            const float hv = w0 * __uint_as_float(a[e] & 0xffff0000u) + w1 * __uint_as_float(bb[e] & 0xffff0000u) + w2 * __uint_as_float(cc[e] & 0xffff0000u);
            w[e] = cvtpk(lo, hv); }
        *(u32x4*)(OC + orow * OCW + 256 + hh * 64 + pc * 8) = w;
    }
    __syncthreads();
}
__device__ __forceinline__ float wave_sum(float v) {
    v += xor_lane_lt32<1>(v); v += xor_lane_lt32<2>(v); v += xor_lane_lt32<4>(v); v += xor_lane_lt32<8>(v); v += xor_lane_lt32<16>(v);
    return sum_halves(v);
}
__device__ __forceinline__ int rel_bucket(int dist) {
    if (dist < 0) dist = 0;
    if (dist < 16) return dist;
    const int thr[15] = {22, 30, 40, 54, 73, 99, 134, 182, 246, 332, 450, 609, 825, 1117, 1513};
    int bkt = 16;
#pragma unroll
    for (int i = 0; i < 15; ++i) bkt += (dist >= thr[i]) ? 1 : 0;
    return bkt;
}
__device__ __forceinline__ int inproj_src(int c, float& sc) {
    sc = 1.f;
    if (c < 256) { sc = C2A; return c; }
    if (c < 652) return c;
    if (c < 656) return 2572 + (c - 652);
    if (c < 672) return -1;
    if (c < 704) { const int p = c - 672; return 2960 + (p >> 1) + 16 * (p & 1); }
    if (c < 768) return -1;
    if (c < 1920) { const int r = c - 768; if (r < 384) sc = C2A; return 652 + r; }
    if (c < 2048) return 2832 + (c - 1920);
    if (c < 2816) { const int r = c - 2048; if (r < 256) sc = C2A; return 1804 + r; }
    return 2576 + (c - 2816);
}
__device__ __forceinline__ int quq_src(int r, float& sc) {
    sc = C2D;
    if (r >= 384) return -1;
    const int hd = r / 96, w = r % 96;
    if (w < 64) return hd * 96 + w;
    const int p = w - 64; return hd * 96 + 64 + (p >> 1) + 16 * (p & 1);
}
__device__ __forceinline__ int gateperm_src(int r) {
    const int T = r >> 8, c = r & 255, pn = T >> 2, j = T & 3, bj = c >> 7, wc = (c >> 5) & 3, fq = (c >> 3) & 3, n = (c >> 2) & 1, e = c & 3;
    return (2 * bj + n) * DM * DM + 256 * pn + 64 * j + 16 * wc + 4 * fq + e;
}
__device__ __forceinline__ int branchperm_src(int r) {
    const int pn = r >> 8, c = r & 255, bj = c >> 7, wc = (c >> 5) & 3, fq = (c >> 3) & 3, n = (c >> 2) & 1, e = c & 3;
    return 256 * pn + 64 * (2 * bj + n) + 16 * wc + 4 * fq + e;
}
__device__ __forceinline__ int upperm_src(int r) { const int pn = r >> 8, c = r & 255; return (c & 128) ? DFF + 128 * pn + (c & 127) : 128 * pn + c; }
__device__ __forceinline__ void wconv_item(const float* W, int Nsrc, bf16_t* WT, int ldt, const float* kgain, int kind, LAS float* scr, int item, int nblk, int lane, bool f8out = false) {
    const int kb = item / nblk, nb = item % nblk, k0 = 64 * kb, n0 = 32 * nb;
    const int n = n0 + (lane & 31); float sc = 1.f; int src = n;
    if (kind == 1) src = inproj_src(n, sc); else if (kind == 2) src = quq_src(n, sc); else if (kind == 3) src = gateperm_src(n); else if (kind == 4) src = branchperm_src(n); else if (kind == 5) src = upperm_src(n);
    float wv[32];
#pragma unroll
    for (int i = 0; i < 32; ++i) { const int kk = 2 * i + (lane >> 5); wv[i] = (src >= 0) ? W[(size_t)(k0 + kk) * Nsrc + src] : 0.f; }
#pragma unroll
    for (int i = 0; i < 32; ++i) { const int kk = 2 * i + (lane >> 5); float v = wv[i] * sc; if (kgain) v *= kgain[k0 + kk]; scr[kk * 33 + (lane & 31)] = v; }
    LDS_WAIT(); asm volatile("" ::: "memory");
    if (f8out) {
        const int nn = lane >> 1, hh = lane & 1; const LAS float* s = scr + (32 * hh) * 33 + nn; unsigned char* dst = (unsigned char*)WT + (size_t)(n0 + nn) * ldt + k0 + 32 * hh;
#pragma unroll
        for (int j = 0; j < 2; ++j) { u32x4 o;
#pragma unroll
            for (int e = 0; e < 4; ++e) { const LAS float* q = s + (16 * j + 4 * e) * 33; o[e] = pk4_fp8(q[0] * WG8_SCALE, q[33] * WG8_SCALE, q[66] * WG8_SCALE, q[99] * WG8_SCALE); }
            *(u32x4*)(dst + 16 * j) = o; }
        LDS_WAIT(); asm volatile("" ::: "memory");
        return;
    }
    const int c = lane & 7;
#pragma unroll
    for (int j = 0; j < 4; ++j) { const int nn = (lane >> 3) + 8 * j; const LAS float* s = scr + (8 * c) * 33 + nn;
        u32x4 o; o.x = pk2(s[0 * 33], s[1 * 33]); o.y = pk2(s[2 * 33], s[3 * 33]); o.z = pk2(s[4 * 33], s[5 * 33]); o.w = pk2(s[6 * 33], s[7 * 33]);
        *(u32x4*)(WT + (size_t)(n0 + nn) * ldt + k0 + 8 * c) = o; }
    LDS_WAIT(); asm volatile("" ::: "memory");
}
constexpr int ATT_UNITS = 3328;
__device__ __forceinline__ int att_cost(int id) {
    if (id < 2048) { const int qb = 15 - (id >> 7), mla = (id >> 6) & 1; return (mla ? 5 : 4) * (qb + 1); }
    if (id < 3072) return (63 - ((id - 2048) >> 4)) + 20;
    return 30;
}
__device__ __forceinline__ int clampi(int x, int lo, int hi) { return x < lo ? lo : (x > hi ? hi : x); }
__device__ __forceinline__ int att_rank(int i) {
    const int c = att_cost(i);
    int r = clampi(16 - c / 4, 0, 16) * 64 + clampi(16 - c / 5, 0, 16) * 64 + clampi(83 - c, 0, 64) * 16 + (c < 30 ? 256 : 0);
    if (c % 4 == 0 && c / 4 >= 1 && c / 4 <= 16) r += clampi(i - (16 - c / 4) * 128, 0, 64);
    if (c % 5 == 0 && c / 5 >= 1 && c / 5 <= 16) r += clampi(i - ((16 - c / 5) * 128 + 64), 0, 64);
    if (c >= 20 && c <= 83) r += clampi(i - (2048 + (63 - (c - 20)) * 16), 0, 16);
    if (c == 30) r += clampi(i - 3072, 0, 256);
    return r;
}
__device__ __forceinline__ void p0_prologue(Frame& F) {
    LAS float* scr = (LAS float*)(F.lds + F.wave * 16384);
    const int gw = blockIdx.x * 8 + F.wave, NGW = F.G * 8, lane = F.lane;
    constexpr int I_IN = 16 * 96, I_G = 16 * 32, I_BA = 4 * 32, I_BB = 2 * 32, I_O = 16 * 32, I_UP = 16 * 176, I_DN = 44 * 32, I_UQ = 4 * 16, I_UKV = 2 * 16, I_PHI = 32 * 4;
    constexpr int I_L = I_IN + 4 * I_G + 3 * I_BA + I_BB + I_O + I_UP + I_DN + I_UQ + I_UKV + 2 * I_PHI;
    for (int it = gw; it < DEPTH * I_L; it += NGW) {
        const int l = it / I_L; int r = it % I_L;
        unsigned char* wl = F.ws + WS_WT + (size_t)l * LW;
        if (r < I_IN) { wconv_item(F.in[6] + (size_t)l * DM * DIN, DIN, (bf16_t*)(wl + LW_IN), DM, nullptr, 1, scr, r, 96, lane); continue; } r -= I_IN;
        if (r < 4 * I_G) { wconv_item(F.in[21] + (size_t)l * 4 * DM * DM, DM, (bf16_t*)(wl + LW_G), DM, nullptr, 3, scr, r, 128, lane, true); continue; } r -= 4 * I_G;
        if (r < I_BA) { wconv_item(F.in[17] + (size_t)l * 256 * DM, DM, (bf16_t*)(wl + LW_BR + BR_A), 256, nullptr, 4, scr, r, 32, lane); continue; } r -= I_BA;
        if (r < I_BB) { wconv_item(F.in[18] + (size_t)l * 128 * DM, DM, (bf16_t*)(wl + LW_BR + BR_B), 128, nullptr, 4, scr, r, 32, lane); continue; } r -= I_BB;
        if (r < I_BA) { wconv_item(F.in[19] + (size_t)l * 256 * DM, DM, (bf16_t*)(wl + LW_BR + BR_C), 256, nullptr, 4, scr, r, 32, lane); continue; } r -= I_BA;
        if (r < I_BA) { wconv_item(F.in[20] + (size_t)l * 256 * DM, DM, (bf16_t*)(wl + LW_BR + BR_D), 256, nullptr, 4, scr, r, 32, lane); continue; } r -= I_BA;
        if (r < I_O) { wconv_item(F.in[22] + (size_t)l * DM * DM, DM, (bf16_t*)(wl + LW_O), DM, nullptr, 0, scr, r, 32, lane); continue; } r -= I_O;
        if (r < I_UP) { wconv_item(F.in[23] + (size_t)l * DM * DFF2, DFF2, (bf16_t*)(wl + LW_UP), DM, nullptr, 5, scr, r, 176, lane); continue; } r -= I_UP;
        if (r < I_DN) { wconv_item(F.in[26] + (size_t)l * DFF * DM, DM, (bf16_t*)(wl + LW_DN), DFF, nullptr, 0, scr, r, 32, lane); continue; } r -= I_DN;
        if (r < I_UQ) { wconv_item(F.in[15] + (size_t)l * 256 * 384, 384, (bf16_t*)(wl + LW_UQ), 256, F.in[13] + l * 256, 2, scr, r, 16, lane); continue; } r -= I_UQ;
        if (r < I_UKV) { wconv_item(F.in[16] + (size_t)l * 128 * 512, 512, (bf16_t*)(wl + LW_UKV), 128, F.in[14] + l * 128, 0, scr, r, 16, lane); continue; } r -= I_UKV;
        if (r < I_PHI) { wconv_item(F.in[8] + (size_t)l * 2048 * 128, 128, (bf16_t*)(wl + LW_PHI), 2048, nullptr, 0, scr, r, 4, lane); continue; } r -= I_PHI;
        wconv_item(F.in[10] + (size_t)l * 2048 * 128, 128, (bf16_t*)(wl + LW_PHI) + (size_t)128 * 2048, 2048, nullptr, 0, scr, r, 4, lane);
    }
    const int gt = blockIdx.x * 512 + F.tid, NGT = F.G * 512;
    const float* rel = F.in[1];
    float* rope = WSP(float, WS_ROPE);
    for (int i = gt; i < SEQ * 16; i += NGT) { const int t = i >> 4, k = i & 15; const float inv = powf(10000.0f, -(float)(2 * k) / 32.0f); const float ang = (float)t * inv;
        float sn, cs; sincosf(ang, &sn, &cs); rope[2 * i] = cs; rope[2 * i + 1] = sn; }
    float* ntab = WSP(float, WS_NSATAB);
    for (int i = gt; i < 4 * NSA_TL; i += NGT) { const int hd = i / NSA_TL, k = i % NSA_TL, dist = NSA_DMAX - k; ntab[i] = dist >= 0 ? rel[rel_bucket(dist) * 10 + hd] * LOG2E : 0.f; }
    float* dtab = WSP(float, WS_DILTAB);
    for (int i = gt; i < 6 * 192; i += NGT) { const int gh = i / 192, k = i % 192, g = gh >> 1, hh = gh & 1, j = 160 - k; dtab[i] = (j >= 0 && j <= 128) ? rel[rel_bucket(j << (2 * g)) * 10 + 4 + 2 * g + hh] * LOG2E : 0.f; }
    if (gt < 4) WSP(float, WS_FARB)[gt] = rel[31 * 10 + gt] * LOG2E;
    if (gw < 128) { const int mi = gw >> 5, pc = gw & 31, l = mi >> 1; const float *pk1 = F.in[8], *pv1 = F.in[10]; asm volatile("" : "+s"(pk1), "+s"(pv1));
        const float* w1 = ((mi & 1) ? pv1 : pk1) + (size_t)l * 2048 * 128 + (size_t)(64 * pc) * 128 + 2 * lane; const float* cp = F.in[7] + (size_t)l * 2048 + 64 * pc;
        f32x2 a = {0.f, 0.f};
#pragma unroll 8
        for (int p = 0; p < 64; ++p) { const f32x2 w = *(const f32x2*)(w1 + (size_t)p * 128); const float cpp = cp[p]; a[0] += cpp * w[0]; a[1] += cpp * w[1]; }
        *(f32x2*)(WSP(float, WS_CMPP) + ((size_t)mi * 32 + pc) * 128 + 2 * lane) = a; }
    if (gt < ATT_UNITS) WSP(int, WS_ORDER)[att_rank(gt)] = gt;
}
__device__ __forceinline__ void cmpb_reduce(Frame& F) {
    const int i = F.tid; if (i < DEPTH * 256) { const int l = i >> 8, n = i & 255, mi = l * 2 + (n >> 7); const float* pp = WSP(const float, WS_CMPP) + (size_t)mi * 32 * 128 + (n & 127); float a = 0.f;
        for (int pc = 0; pc < 32; ++pc) a += pp[pc * 128]; WSP(float, WS_CMPB)[i] = a; }
}

template <int MODE, bool XIB, bool XOB, bool H8 = false> __device__ __forceinline__ void rowpass(Frame& F, const void* x, const bf16_t* y, size_t yrow0, void* xout, bf16_t* hout, const float* g1, const float* g2, int row_lo, int row_hi, unsigned char* h8out = nullptr) {
    int gw = blockIdx.x * 8 + F.wave; asm volatile("" : "+s"(gw));
    const int NGW = F.G * 8, lane = F.lane;
    f32x4 ga[4], gb[4];
#pragma unroll
    for (int j = 0; j < 4; ++j) { ga[j] = *(const f32x4*)(g1 + 4 * lane + 256 * j); if (MODE == 1) gb[j] = *(const f32x4*)(g2 + 4 * lane + 256 * j); }
    f32x4 xf[4], xfn[4]; u32x2 xb[4], xbn[4], yb[4], ybn[4];
#define RP_LOAD(XF, XB, YB, mm) do { if (XIB) { const u32x2* xr_ = (const u32x2*)((const bf16_t*)x + (size_t)(mm) * DM) + lane; _Pragma("unroll") for (int j = 0; j < 4; ++j) XB[j] = xr_[64 * j]; } \
        else { const f32x4* xr_ = (const f32x4*)((const float*)x + (size_t)(mm) * DM) + lane; _Pragma("unroll") for (int j = 0; j < 4; ++j) XF[j] = xr_[64 * j]; } \
        if (MODE != 0) { const u32x2* yr_ = (const u32x2*)(y + ((size_t)(mm) - yrow0) * DM) + lane; _Pragma("unroll") for (int j = 0; j < 4; ++j) YB[j] = yr_[64 * j]; } } while (0)
    int m = row_lo + gw;
    if (m < row_hi) RP_LOAD(xf, xb, yb, m);
    for (; m < row_hi; m += NGW) {
        const int mn = m + NGW;
        if (mn < row_hi) RP_LOAD(xfn, xbn, ybn, mn);
        f32x4 v[4];
#pragma unroll
        for (int j = 0; j < 4; ++j) { if (XIB) { v[j][0] = __uint_as_float(xb[j].x << 16); v[j][1] = __uint_as_float(xb[j].x & 0xffff0000u); v[j][2] = __uint_as_float(xb[j].y << 16); v[j][3] = __uint_as_float(xb[j].y & 0xffff0000u); } else v[j] = xf[j]; }
        if (MODE != 0) {
            f32x4 w[4]; float s = 0.f;
#pragma unroll
            for (int j = 0; j < 4; ++j) { const u32x2 yy = yb[j]; w[j][0] = __uint_as_float(yy.x << 16); w[j][1] = __uint_as_float(yy.x & 0xffff0000u); w[j][2] = __uint_as_float(yy.y << 16); w[j][3] = __uint_as_float(yy.y & 0xffff0000u);
                s += (w[j][0] * w[j][0] + w[j][1] * w[j][1]) + (w[j][2] * w[j][2] + w[j][3] * w[j][3]); }
            const float rstd = 1.0f / sqrtf(wave_sum(s) * (1.0f / DM) + RMS_EPS);
#pragma unroll
            for (int j = 0; j < 4; ++j) v[j] = v[j] + w[j] * rstd * ga[j];
            if (XOB) { u32x2* xo = (u32x2*)((bf16_t*)xout + (size_t)m * DM) + lane;
#pragma unroll
                for (int j = 0; j < 4; ++j) { u32x2 w2; w2.x = cvtpk(v[j][0], v[j][1]); w2.y = cvtpk(v[j][2], v[j][3]); xo[64 * j] = w2; } }
            else { f32x4* xo = (f32x4*)((float*)xout + (size_t)m * DM) + lane;
#pragma unroll
                for (int j = 0; j < 4; ++j) xo[64 * j] = v[j]; }
        }
        if (MODE != 2) {
            float s = 0.f;
#pragma unroll
            for (int j = 0; j < 4; ++j) s += (v[j][0] * v[j][0] + v[j][1] * v[j][1]) + (v[j][2] * v[j][2] + v[j][3] * v[j][3]);
            const float rstd = 1.0f / sqrtf(wave_sum(s) * (1.0f / DM) + RMS_EPS);
            u32x2* ho = (u32x2*)(hout + (size_t)m * DM) + lane;
#pragma unroll
            for (int j = 0; j < 4; ++j) { const f32x4 gg = (MODE == 1) ? gb[j] : ga[j]; const f32x4 o = v[j] * rstd * gg; u32x2 w; w.x = cvtpk(o[0], o[1]); w.y = cvtpk(o[2], o[3]); ho[64 * j] = w;
                if (H8) ((unsigned*)(h8out + (size_t)m * DM))[lane + 64 * j] = pk4_fp8(o[0] * H8_SCALE, o[1] * H8_SCALE, o[2] * H8_SCALE, o[3] * H8_SCALE); }
        }
#pragma unroll
        for (int j = 0; j < 4; ++j) { if (XIB) xb[j] = xbn[j]; else xf[j] = xfn[j]; if (MODE != 0) yb[j] = ybn[j]; }
    }
#undef RP_LOAD
}

__device__ __forceinline__ void ffn_fix_panel(Frame& F, int pm, const float* HB, bf16_t* ACT, const float* cw, const float* cb) {
#pragma unroll 2
    for (int it = F.tid; it < 4 * 2 * (DFF / 4); it += 512) {
        const int c4 = it % (DFF / 4), rr = (it / (DFF / 4)) & 1, g = pm * 4 + it / (2 * (DFF / 4)), c = c4 * 4, pn = c >> 7, cl = c & 127;
        const bool first = ((g * 64) & (SEQ - 1)) == 0;
#define HBV(gg, s, bj) (*(const f32x4*)(HB + ((size_t)(((gg) * 4 + (s)) * 22 + pn) * 256 + (bj) * 128 + cl)))
        const f32x4 z = {0.f, 0.f, 0.f, 0.f};
        const f32x4 u0g = HBV(g, 0, 0), u0v = HBV(g, 0, 1);
        f32x4 ag, bg_, cg, av, bv_, cv;
        if (rr == 0) { ag = first ? z : HBV(g - 1, 2, 0); bg_ = first ? z : HBV(g - 1, 3, 0); cg = u0g; av = first ? z : HBV(g - 1, 2, 1); bv_ = first ? z : HBV(g - 1, 3, 1); cv = u0v; }
        else { ag = first ? z : HBV(g - 1, 3, 0); bg_ = u0g; cg = HBV(g, 1, 0); av = first ? z : HBV(g - 1, 3, 1); bv_ = u0v; cv = HBV(g, 1, 1); }
#undef HBV
        const f32x4 kb = *(const f32x4*)(cb + c), k0 = *(const f32x4*)(cw + c), k1 = *(const f32x4*)(cw + DFF2 + c), k2 = *(const f32x4*)(cw + 2 * DFF2 + c);
        const f32x4 vb = *(const f32x4*)(cb + DFF + c), v0 = *(const f32x4*)(cw + DFF + c), v1 = *(const f32x4*)(cw + DFF2 + DFF + c), v2 = *(const f32x4*)(cw + 2 * DFF2 + DFF + c);
        float o[4];
#pragma unroll
        for (int e = 0; e < 4; ++e) { const float gt = kb[e] + k0[e] * ag[e] + k1[e] * bg_[e] + k2[e] * cg[e], vl = vb[e] + v0[e] * av[e] + v1[e] * bv_[e] + v2[e] * cv[e]; o[e] = gt * sigmoid_f(gt) * vl; }
        u32x2 w; w.x = cvtpk(o[0], o[1]); w.y = cvtpk(o[2], o[3]);
        *(u32x2*)(ACT + (size_t)(g * 64 + rr) * DFF + c) = w;
    }
}
struct SchedSimple {
    pg8::TileOrder T; const char* A; const char* B; int lda, ldb, nt; int dup = 0;
    __device__ __forceinline__ bool next(int i, GUnit& u) const { int pm, pn; if (!T.tile(i >> dup, pm, pn)) return false;
        u.A = A + (size_t)pm * 256 * lda; u.B = B + (size_t)pn * 256 * ldb; u.lda = lda; u.ldb = ldb; u.nt = nt; u.pm = pm; u.pn = pn; u.id = 0; return true; }
};
struct SchedCmp1 {
    int c; const char* kc; const char* vc; const char* B;
    __device__ __forceinline__ bool next(int i, GUnit& u) const { if (i > 0 || c >= 32) return false;
        u.A = (c < 16 ? kc : vc) + (size_t)(c & 15) * 256 * 2048; u.B = B; u.lda = 2048; u.ldb = 4096; u.nt = 32; u.pm = c; u.pn = 0; u.id = 0; return true; }
};
struct SchedMerge {
    pg8::TileOrder T; const char* ocat; const char* h; const char* wbr; const char* wg; int dup = 0;
    __device__ __forceinline__ bool next(int i0, GUnit& u) const { const int i = i0 >> dup; int pm, pn; if (!T.tile(i >> 3, pm, pn)) return false;
        const int sub = i & 7; u.pm = pm; u.pn = pn; u.id = sub;
        if (sub >= 4) { u.A = h + (size_t)pm * 256 * 1024; u.lda = 1024; u.B = wg + (size_t)((pn * 4 + (sub - 4)) * 256) * 1024; u.ldb = 1024; u.nt = 8; }
        else { const int br = sub; const int kk = (br == 1) ? 128 : 256; const size_t co = (br == 0) ? 0 : (br == 1 ? 256 : (br == 2 ? 384 : 640)), wo = (br == 0) ? BR_A : (br == 1 ? BR_B : (br == 2 ? BR_C : BR_D));
            u.A = ocat + (size_t)pm * 256 * (OCW * 2) + co * 2; u.lda = OCW * 2; u.B = wbr + wo + (size_t)pn * 256 * kk * 2; u.ldb = kk * 2; u.nt = kk / 64; }
        return true; }
};

#ifndef SDUP_INPROJ
#define SDUP_INPROJ 0
#endif
#ifndef SDUP_MERGE
#define SDUP_MERGE 0
#endif
#ifndef SDUP_WO
#define SDUP_WO 0
#endif
#ifndef SDUP_UP
#define SDUP_UP 0
#endif
#ifndef SDUP_DN
#define SDUP_DN 0
#endif
#ifndef DUP_ATTN
#define DUP_ATTN 1
#endif
#ifndef DUP_GEMM
#define DUP_GEMM 1
#endif
#ifndef DUP_MERGE
#define DUP_MERGE 1
#endif
#ifndef DUP_FFN
#define DUP_FFN 1
#endif
#ifdef ONLY_PHASE
#define PH(k) ((k) == ONLY_PHASE)
#else
#define PH(k) true
#endif
struct Args { const float* in[27]; float* out; unsigned char* ws; };
__global__ void __launch_bounds__(512, 2) hybrid_fwd(Args args) {
    extern __shared__ __attribute__((aligned(16))) unsigned char lds_raw[];
    Frame F;
    F.lds = (LAS unsigned char*)lds_raw; F.MISC = (volatile LAS unsigned*)(F.lds + MISC_OFF);
    F.tid = threadIdx.x; F.lane = F.tid & 63; F.wave = __builtin_amdgcn_readfirstlane(F.tid >> 6); F.G = gridDim.x;
#pragma unroll
    for (int i = 0; i < 27; ++i) F.in[i] = args.in[i];
    F.out = args.out; F.ws = args.ws; F.ctl = (gu32*)(args.ws + WS_CTL);
    for (int u = F.tid; u < (LDS_BYTES - LDSCTL_OFF) / 4; u += 512) ((LAS unsigned*)(F.lds + LDSCTL_OFF))[u] = 0u;
    __syncthreads();
    XcdBarrier bar = xcd_barrier_post((unsigned*)(F.ctl + CW_BAR), F.MISC + 8);
    const int c = (int)blockIdx.x;
#define TSTAMP(id) do { } while (0)

#ifndef DUP_P0
#define DUP_P0 1
#endif
    for (int rep = 0; rep < DUP_P0; ++rep) { if (rep) xcd_barrier(bar); if (PH(0)) p0_prologue(F); }
    xcd_barrier(bar); TSTAMP(0);

#ifndef XTRA_BAR
#define XTRA_BAR 0
#endif
    _Pragma("unroll") for (int xb = 0; xb < XTRA_BAR; ++xb) xcd_barrier(bar);
#define PHASE_FRESH() do { int t_ = threadIdx.x; asm volatile("" : "+v"(t_)); F.tid = t_; F.lane = t_ & 63; } while (0)
    for (int l = 0; l < DEPTH; ++l) {
        unsigned char* wl = F.ws + WS_WT + (size_t)l * LW;
        const float* xin = (l == 0) ? F.in[0] : F.out;
        PHASE_FRESH();
#ifndef DUP_RP0
#define DUP_RP0 1
#endif
        if (l == 0) { if (c == 0) cmpb_reduce(F);
          _Pragma("unroll") for (int rep = 0; rep < DUP_RP0; ++rep) { if (rep) xcd_barrier(bar); if (PH(1)) rowpass<0, false, false, true>(F, F.in[0], nullptr, 0, nullptr, WSP(bf16_t, WS_H), F.in[2] + l * DM, nullptr, 0, M, (unsigned char*)F.out + H8_OFF); }
          xcd_barrier(bar); TSTAMP(1); }
        for (int rep = 0; rep < DUP_GEMM; ++rep) if (PH(2)) { if (rep) xcd_barrier(bar); SchedSimple S; S.T.init(256, 12, F.G, c); S.A = (const char*)(F.ws + WS_H); S.B = (const char*)(wl + LW_IN); S.lda = 2048; S.ldb = 2048; S.nt = 16; S.dup = SDUP_INPROJ;
          pg8::EpiInProj E{WSP(bf16_t, WS_P), WSP(bf16_t, WS_KCMP), WSP(bf16_t, WS_VCMP), WSP(float, WS_SIDE), WSP(bf16_t, WS_KROT), WSP(const float, WS_ROPE), WSP(float, WS_SSQQ), WSP(float, WS_SSQKV), F.in[12] + l * 4, WSP(float, WS_LF)};
          pg8::gemm_phase<pg8::EpiInProj, SchedSimple, true>(F.lds, S, E); }
        xcd_barrier(bar); TSTAMP(2);
#ifndef DUP_L2A
#define DUP_L2A 1
#endif
        _Pragma("unroll") for (int rep2 = 0; rep2 < DUP_L2A; ++rep2) { if (rep2) xcd_barrier(bar);
        if (PH(3)) { SchedCmp1 S{c, (const char*)(F.ws + WS_KCMP), (const char*)(F.ws + WS_VCMP), (const char*)(wl + LW_PHI)};
          pg8::EpiCmp1 E{WSP(bf16_t, WS_HID), WSP(const float, WS_CMPB) + l * 256};
          pg8::gemm_phase<pg8::EpiCmp1, SchedCmp1, false>(F.lds, S, E);
          if (c < 32) {
              __syncthreads(); const int which = c >> 4, b = c & 15;
              int ln_ = threadIdx.x & 63; asm volatile("" : "+v"(ln_)); const int r32 = ln_ & 31, hi = ln_ >> 5;
              const bf16_t* hrow = WSP(const bf16_t, WS_HID) + ((size_t)c * 256 + F.wave * 32 + r32) * 256 + which * 128;
              const float *pk2 = F.in[9], *pv2 = F.in[11]; asm volatile("" : "+s"(pk2), "+s"(pv2)); const float* w2 = (which ? pv2 : pk2) + (size_t)l * 128 * 64;
              f32x16 o0, o1;
#pragma unroll
              for (int r = 0; r < 16; ++r) { o0[r] = 0.f; o1[r] = 0.f; }
#pragma unroll
              for (int ks = 0; ks < 8; ++ks) { const bf16x8 a = *(const bf16x8*)(hrow + ks * 16 + hi * 8);
                  const float* wp = w2 + (size_t)(ks * 16 + hi * 8) * 64 + r32; u32x4 b0, b1;
#pragma unroll
                  for (int jj = 0; jj < 4; ++jj) { b0[jj] = cvtpk(wp[(2 * jj) * 64], wp[(2 * jj + 1) * 64]); b1[jj] = cvtpk(wp[(2 * jj) * 64 + 32], wp[(2 * jj + 1) * 64 + 32]); }
                  o0 = MFMA32(a, __builtin_bit_cast(bf16x8, b0), o0); o1 = MFMA32(a, __builtin_bit_cast(bf16x8, b1), o1); }
              bf16_t* dst = (which ? WSP(bf16_t, WS_VC) : WSP(bf16_t, WS_KC)) + ((size_t)b * 256 + F.wave * 32) * 64 + r32;
#pragma unroll
              for (int r = 0; r < 16; ++r) { const int rw = crow(r, hi); dst[(size_t)rw * 64] = (bf16_t)f2bf(o0[r]); dst[(size_t)rw * 64 + 32] = (bf16_t)f2bf(o1[r]); } } }
        if (PH(4)) { int G2_ = F.G; asm volatile("" : "+s"(G2_)); const bool split = G2_ > 64; const int g2 = split ? F.G - 32 : F.G, c2 = split ? c - 32 : c;
          { SchedSimple S; S.T.init(256, 2, g2, c2 < 0 ? (1 << 28) : c2); S.A = (const char*)(F.ws + WS_P) + PC_DQL * 2; S.B = (const char*)(wl + LW_UQ); S.lda = PW * 2; S.ldb = 512; S.nt = 4;
            pg8::EpiQup E{WSP(bf16_t, WS_QM), WSP(const float, WS_SSQQ), WSP(const float, WS_ROPE)};
            pg8::gemm_phase<pg8::EpiQup, SchedSimple, true>(F.lds, S, E); }
          { SchedSimple S; S.T.init(256, 2, g2, c2 < 0 ? (1 << 28) : c2); S.A = (const char*)(F.ws + WS_P) + PC_DKV * 2; S.B = (const char*)(wl + LW_UKV); S.lda = PW * 2; S.ldb = 256; S.nt = 2;
            pg8::EpiKVup E{WSP(bf16_t, WS_KVM), WSP(const float, WS_SSQKV), (unsigned*)(F.ctl + CW_KMLA + 256 * l)};
            pg8::gemm_phase<pg8::EpiKVup, SchedSimple, true>(F.lds, S, E); } }
        PHASE_FRESH();
        if (PH(5)) {
          int G_ = F.G; asm volatile("" : "+s"(G_)); const int cb = (G_ >= 48) ? c - 32 : c;
          if (cb >= 0 && cb < BATCH) { const int b = cb, tid = F.tid; const float* fl = WSP(const float, WS_SIDE) + ((size_t)b * SEQ + 8 * tid) * 16 + 12; const f32x4 fb = *(const f32x4*)(F.in[12] + l * 4);
              f32x4 v[8];
#pragma unroll
              for (int i = 0; i < 8; ++i) { const f32x4 z = *(const f32x4*)(fl + 16 * i);
#pragma unroll
                  for (int e = 0; e < 4; ++e) { const float x = z[e] + fb[e], t = fast_exp2(-fabsf(x) * LOG2E), lg = __builtin_amdgcn_logf(1.0f + t) * 0.6931471805599453f; v[i][e] = fminf(x, 0.f) - lg; } }
#pragma unroll
              for (int i = 1; i < 8; ++i) v[i] = v[i] + v[i - 1];
              LAS f32x4* sc = (LAS f32x4*)F.lds; f32x4 run = v[7];
              sc[tid] = run; __syncthreads();
              for (int off = 1, cur = 0; off < 512; off <<= 1, cur ^= 1) { f32x4 t = sc[cur * 512 + tid]; if (tid >= off) t = t + sc[cur * 512 + tid - off]; sc[(cur ^ 1) * 512 + tid] = t; __syncthreads(); run = t; }
              const f32x4 ex = run - v[7];
              float* kb = WSP(float, WS_KB) + (size_t)b * 4 * SEQ + 8 * tid;
#pragma unroll
              for (int e = 0; e < 4; ++e) { f32x4 lo, hi4;
#pragma unroll
                  for (int i = 0; i < 4; ++i) { lo[i] = -(ex[e] + v[i][e]) * LOG2E; hi4[i] = -(ex[e] + v[4 + i][e]) * LOG2E; }
                  *(f32x4*)(kb + (size_t)e * SEQ) = lo; *(f32x4*)(kb + (size_t)e * SEQ + 4) = hi4; }
              __syncthreads();
          } }
        }
        if (PH(5)) {
          const int gt2 = c * 512 + F.tid, hp = gt2 & 1;
          for (int t2 = gt2 >> 1; t2 < M; t2 += F.G * 256) { const bf16_t* Kp = WSP(const bf16_t, WS_P) + (size_t)t2 * PW + PC_CK + hp * 128; float s0 = 0.f, s1 = 0.f, s2 = 0.f;
              if (hp == 0) { const bf16_t* Rp = WSP(const bf16_t, WS_KROT) + (size_t)t2 * 32;
#pragma unroll
                  for (int q8 = 0; q8 < 4; ++q8) { const bf16x8 ra = *(const bf16x8*)(Rp + q8 * 8);
#pragma unroll
                      for (int e = 0; e < 8; ++e) { const float xa = bf2f((unsigned short)ra[e]); s2 += xa * xa; } } }
#pragma unroll
              for (int q8 = 0; q8 < 8; ++q8) { const bf16x8 ka = *(const bf16x8*)(Kp + q8 * 8), kb2 = *(const bf16x8*)(Kp + 64 + q8 * 8);
#pragma unroll
                  for (int e = 0; e < 8; ++e) { const float xa = bf2f((unsigned short)ka[e]), xb = bf2f((unsigned short)kb2[e]); s0 += xa * xa; s1 += xb * xb; } }
              s0 = fmaxf(s0, xor_lane_lt32<2>(s0)); s0 = fmaxf(s0, xor_lane_lt32<4>(s0)); s0 = fmaxf(s0, xor_lane_lt32<8>(s0)); s0 = fmaxf(s0, xor_lane_lt32<16>(s0));
              s1 = fmaxf(s1, xor_lane_lt32<2>(s1)); s1 = fmaxf(s1, xor_lane_lt32<4>(s1)); s1 = fmaxf(s1, xor_lane_lt32<8>(s1)); s1 = fmaxf(s1, xor_lane_lt32<16>(s1));
              { auto r0 = __builtin_amdgcn_permlane32_swap(__float_as_uint(s0), __float_as_uint(s0), false, false); s0 = fmaxf(__uint_as_float(r0[0]), __uint_as_float(r0[1]));
                auto r1 = __builtin_amdgcn_permlane32_swap(__float_as_uint(s1), __float_as_uint(s1), false, false); s1 = fmaxf(__uint_as_float(r1[0]), __uint_as_float(r1[1])); }
              s2 = fmaxf(s2, xor_lane_lt32<2>(s2)); s2 = fmaxf(s2, xor_lane_lt32<4>(s2)); s2 = fmaxf(s2, xor_lane_lt32<8>(s2)); s2 = fmaxf(s2, xor_lane_lt32<16>(s2));
              { auto r2 = __builtin_amdgcn_permlane32_swap(__float_as_uint(s2), __float_as_uint(s2), false, false); s2 = fmaxf(__uint_as_float(r2[0]), __uint_as_float(r2[1])); }
              if (F.lane < 2) { unsigned* kw = (unsigned*)(F.ctl + CW_KMAX + 64 * l) + (t2 >> 12) * 4 + 2 * hp; atomicMax(kw, __float_as_uint(s0)); atomicMax(kw + 1, __float_as_uint(s1));
                  if (hp == 0) atomicMax((unsigned*)(F.ctl + CW_KROT + 16 * l) + (t2 >> 12), __float_as_uint(s2)); } } }
        xcd_barrier(bar); TSTAMP(3);
        PHASE_FRESH();
        for (int rep = 0; rep < DUP_ATTN; ++rep) { gu32* ctr = F.ctl + CW_Q + 64 * l + 16 * rep;
          if (rep) xcd_barrier(bar);
          unsigned nxtq = 0u; if (F.tid == 0) nxtq = __hip_atomic_fetch_add(ctr, 1u, __ATOMIC_RELAXED, __HIP_MEMORY_SCOPE_AGENT);
          for (;;) { if (F.tid == 0) F.MISC[0] = nxtq; __syncthreads(); const int iq = (int)F.MISC[0]; __syncthreads(); if (iq >= ATT_UNITS) break;
              if (F.tid == 0) nxtq = __hip_atomic_fetch_add(ctr, 1u, __ATOMIC_RELAXED, __HIP_MEMORY_SCOPE_AGENT);
              const int it = __builtin_amdgcn_readfirstlane(WSP(const int, WS_ORDER)[iq]);
              if (it < 2048 && PH(7)) { const int qb = 15 - (it >> 7), mla = (it >> 6) & 1, bh = it & 63; if (mla) { const gu32* km = F.ctl + CW_KMLA + 256 * l + bh * 4; const float k2 = __uint_as_float(__hip_atomic_load(km, __ATOMIC_RELAXED, __HIP_MEMORY_SCOPE_AGENT)) + __uint_as_float(__hip_atomic_load(km + 1, __ATOMIC_RELAXED, __HIP_MEMORY_SCOPE_AGENT)) + __uint_as_float(__hip_atomic_load(F.ctl + CW_KROT + 16 * l + (bh >> 2), __ATOMIC_RELAXED, __HIP_MEMORY_SCOPE_AGENT)); causal_unit<false>(F, bh >> 2, bh & 3, qb, sqrtf(k2) * 1.01f); } else causal_unit<true>(F, bh >> 2, bh & 3, qb, sqrtf(__uint_as_float(__hip_atomic_load(F.ctl + CW_KMAX + 64 * l + bh, __ATOMIC_RELAXED, __HIP_MEMORY_SCOPE_AGENT)))); }
              else if (it < 3072 && PH(8)) { const int r = it - 2048; nsa_unit(F, r & 15, 63 - (r >> 4)); }
              else if (it < 3328 && PH(9)) { const int r = it - 3072; dil_unit(F, r & 15, (r >> 4) & 1, r >> 5); } } }
        xcd_barrier(bar); TSTAMP(5);
        for (int rep = 0; rep < DUP_MERGE; ++rep) if (PH(10)) { if (rep) xcd_barrier(bar); SchedMerge S; S.T.init(256, 4, F.G, c); S.ocat = (const char*)(F.ws + WS_OCAT); S.h = (const char*)F.out + H8_OFF; S.wbr = (const char*)(wl + LW_BR); S.wg = (const char*)(wl + LW_G); S.dup = SDUP_MERGE;
          unsigned char* scr = F.ws + WS_MSCR + (size_t)c * MSCR_PER_WG;
          pg8::EpiMerge E{WSP(bf16_t, WS_MERGED), scr};
          pg8::gemm_phase<pg8::EpiMerge, SchedMerge, true, true>(F.lds, S, E); }
        xcd_barrier(bar); TSTAMP(6);
        if (PH(11)) { SchedSimple S; S.T.init(256, 4, F.G, c); S.A = (const char*)(F.ws + WS_MERGED); S.B = (const char*)(wl + LW_O); S.lda = 2048; S.ldb = 2048; S.nt = 16; S.dup = SDUP_WO;
          pg8::EpiBf16 E{WSP(bf16_t, WS_Y), DM};
          pg8::gemm_phase<pg8::EpiBf16, SchedSimple, true>(F.lds, S, E); }
        xcd_barrier(bar); TSTAMP(7);
        PHASE_FRESH();
        if (PH(12)) { if (l == 0) rowpass<1, false, true>(F, F.in[0], WSP(const bf16_t, WS_Y), 0, F.out, WSP(bf16_t, WS_H2), F.in[3] + l * DM, F.in[4] + l * DM, 0, M);
                      else rowpass<1, true, true>(F, F.out, WSP(const bf16_t, WS_Y), 0, WSP(bf16_t, WS_X3), WSP(bf16_t, WS_H2), F.in[3] + l * DM, F.in[4] + l * DM, 0, M); }
        xcd_barrier(bar); TSTAMP(8);
#ifndef DUP_UP
#define DUP_UP 1
#endif
        _Pragma("unroll") for (int rep = 0; rep < DUP_UP; ++rep) if (PH(13)) { if (rep) xcd_barrier(bar); SchedSimple S; S.T.init(256, 22, F.G, c); S.A = (const char*)(F.ws + WS_H2); S.B = (const char*)(wl + LW_UP); S.lda = 2048; S.ldb = 2048; S.nt = 16; S.dup = SDUP_UP;
          pg8::EpiUpConv E{WSP(bf16_t, WS_ACT), WSP(float, WS_HB), F.in[24] + (size_t)l * 3 * DFF2, F.in[25] + (size_t)l * DFF2};
          pg8::gemm_phase<pg8::EpiUpConv, SchedSimple, true>(F.lds, S, E); }
        xcd_barrier(bar); TSTAMP(9);
        PHASE_FRESH();
        if (PH(15)) { SchedSimple S; S.T.init(256, 4, F.G, c); S.A = (const char*)(F.ws + WS_ACT); S.B = (const char*)(wl + LW_DN); S.lda = DFF * 2; S.ldb = DFF * 2; S.nt = DFF / 64; S.dup = SDUP_DN;
          { int pm, pn; for (int i = 0; S.T.tile(i, pm, pn); ++i) ffn_fix_panel(F, pm, WSP(const float, WS_HB), WSP(bf16_t, WS_ACT), F.in[24] + (size_t)l * 3 * DFF2, F.in[25] + (size_t)l * DFF2); }
          VM_WAIT(); __syncthreads();
          pg8::EpiBf16 E{WSP(bf16_t, WS_Y2), DM};
          pg8::gemm_phase<pg8::EpiBf16, SchedSimple, true>(F.lds, S, E); }
        xcd_barrier(bar); TSTAMP(11);
        PHASE_FRESH();
        if (PH(16)) { if (l + 1 < DEPTH) rowpass<1, true, true, true>(F, F.out, WSP(const bf16_t, WS_Y2), 0, F.out, WSP(bf16_t, WS_H), F.in[5] + l * DM, F.in[2] + (l + 1) * DM, 0, M, (unsigned char*)F.out + H8_OFF);
                      else rowpass<2, true, false>(F, WSP(const bf16_t, WS_X3), WSP(const bf16_t, WS_Y2), 0, F.out, nullptr, F.in[5] + l * DM, nullptr, 0, M); }
        xcd_barrier(bar); TSTAMP(12);
    }
}

extern "C" void kernel_launch(void* const* d_in, const int* in_sizes, int n_in, void* d_out, int out_size, void* d_ws, size_t ws_size, hipStream_t stream) {
    static int grid = 0;
    if (grid == 0) {
        if (n_in != 27 || in_sizes[0] != M * DM || out_size != M * DM || ws_size < WS_END) { fprintf(stderr, "kernel_launch: unexpected shapes (n_in %d, in0 %d, out %d, ws %zu)\n", n_in, n_in > 0 ? in_sizes[0] : -1, out_size, ws_size); grid = -1; return; }
        int dev = 0, cus = 0, per_cu = 0;
        if (hipGetDevice(&dev) != hipSuccess || hipDeviceGetAttribute(&cus, hipDeviceAttributeMultiprocessorCount, dev) != hipSuccess) { grid = -1; return; }
        if (hipFuncSetAttribute((const void*)hybrid_fwd, hipFuncAttributeMaxDynamicSharedMemorySize, LDS_BYTES) != hipSuccess) { fprintf(stderr, "kernel_launch: hipFuncSetAttribute failed\n"); grid = -1; return; }
        if (hipOccupancyMaxActiveBlocksPerMultiprocessor(&per_cu, (const void*)hybrid_fwd, 512, LDS_BYTES) != hipSuccess || per_cu < 1) fprintf(stderr, "kernel_launch: occupancy query says %d\n", per_cu);
        (void)hipGetLastError();
        grid = cus;
    }
    if (grid < 0) return;
    if (hipMemsetAsync((char*)d_ws + WS_CTL, 0, CTL_ZERO_BYTES, stream) != hipSuccess) return;
    Args a{};
    for (int i = 0; i < 27; ++i) a.in[i] = (const float*)d_in[i];
    a.out = (float*)d_out; a.ws = (unsigned char*)d_ws;
    hipLaunchKernelGGL(hybrid_fwd, dim3(grid), dim3(512), LDS_BYTES, stream, a);
}
```

```cpp
#include <hip/hip_runtime.h>
#include <hip/hip_bf16.h>
#include <cstdio>
#include <cstdint>
#include <cmath>

#define GAS __attribute__((address_space(1)))
#define LAS __attribute__((address_space(3)))
typedef unsigned short bf16_t;
typedef short bf16x8 __attribute__((ext_vector_type(8)));
typedef short s16x4 __attribute__((ext_vector_type(4)));
typedef float f32x4 __attribute__((ext_vector_type(4)));
typedef float f32x2 __attribute__((ext_vector_type(2)));
typedef float f32x16 __attribute__((ext_vector_type(16)));
typedef unsigned u32x4 __attribute__((ext_vector_type(4)));
typedef unsigned u32x2 __attribute__((ext_vector_type(2)));
typedef GAS unsigned gu32;

constexpr int BATCH = 16, SEQ = 4096, DM = 1024, M = BATCH * SEQ, DEPTH = 2;
constexpr int DIN = 2992, PW = 3072;
constexpr int DFF = 2816, DFF2 = 5632;
constexpr float LOG2E = 1.4426950408889634f;
constexpr float C2A = 0.125f * LOG2E;
constexpr float C2D = 0.10206207261596575f * LOG2E;
constexpr float RMS_EPS = 1e-6f;
constexpr float H8_SCALE = 0.5f, WG8_SCALE = -2.8853900817779268f;
constexpr int PC_AQ = 0, PC_KCMP = 256, PC_VCMP = 320, PC_KSLC = 384, PC_VSLC = 448, PC_KWIN = 512, PC_VWIN = 576,
              PC_MISC = 640, PC_KROPE = 672, PC_BQ = 768, PC_BK = 1152, PC_BV = 1536, PC_DKV = 1920,
              PC_CQ = 2048, PC_CK = 2304, PC_CV = 2560, PC_DQL = 2816;
constexpr int OCW = 896;
constexpr int NSA_DFAR = 1536, NSA_DMAX = 1664, NSA_TL = 1728;

__device__ __forceinline__ unsigned f2bf(float f) { unsigned u = __float_as_uint(f); return (u + 0x7fffu + ((u >> 16) & 1u)) >> 16; }
__device__ __forceinline__ unsigned pk2(float lo, float hi) { return f2bf(lo) | (f2bf(hi) << 16); }
__device__ __forceinline__ float bf2f(unsigned short b) { return __uint_as_float((unsigned)b << 16); }
typedef __bf16 bf16x2_t __attribute__((ext_vector_type(2)));
__device__ __forceinline__ unsigned cvtpk(float lo, float hi) { f32x2 v = {lo, hi}; bf16x2_t b = __builtin_convertvector(v, bf16x2_t); return __builtin_bit_cast(unsigned, b); }
__device__ __forceinline__ unsigned pk4_fp8(float a, float b, float c, float d) { int w = 0; w = __builtin_amdgcn_cvt_pk_fp8_f32(a, b, w, false); w = __builtin_amdgcn_cvt_pk_fp8_f32(c, d, w, true); return (unsigned)w; }
__device__ __forceinline__ float fast_exp2(float x) { return __builtin_amdgcn_exp2f(x); }
__device__ __forceinline__ float fast_rcp(float x) { return __builtin_amdgcn_rcpf(x); }
template <int MASK> __device__ __forceinline__ float xor_lane_lt32(float v) { return __uint_as_float(__builtin_amdgcn_ds_swizzle((int)__float_as_uint(v), (MASK << 10) | 0x1f)); }
__device__ __forceinline__ float sum_halves(float v) { auto rr = __builtin_amdgcn_permlane32_swap(__float_as_uint(v), __float_as_uint(v), false, false); return __uint_as_float(rr[0]) + __uint_as_float(rr[1]); }
__device__ __forceinline__ float sigmoid_f(float x) { return fast_rcp(1.0f + fast_exp2(-x * LOG2E)); }

__device__ __forceinline__ int lane_now() { int l; asm volatile("v_mbcnt_lo_u32_b32 %0, -1, 0\n\tv_mbcnt_hi_u32_b32 %0, -1, %0" : "=v"(l)); return l; }
namespace pg8 {
constexpr int BM = 256, BK = 64, HALF = 128, HTB = HALF * BK * 2  , STAGE_BYTES = 8 * HTB, NXCD = 8, WGM = 8;
__host__ __device__ __forceinline__ int lds_byte(int r, int c) { const int st = (r >> 4) * 2 + (c >> 5), rr = r & 15, cc = c & 31, ob = rr * 64 + cc * 2; return st * 1024 + (ob ^ (((ob >> 9) & 1) << 5)); }
__host__ __device__ __forceinline__ void stage_rc(int b, int& R, int& C) { const int st = b / 1024, sb = b % 1024, swz = sb ^ (((sb >> 9) & 1) << 5); R = (st >> 1) * 16 + swz / 64; C = (st & 1) * 32 + (swz % 64) / 2; }
__host__ __device__ __forceinline__ int perm32(int rho) { const int n = rho >> 4, i = rho & 15; return 8 * (i >> 2) + 4 * n + (i & 3); }

typedef int v8i_t __attribute__((ext_vector_type(8)));
typedef int v4i_t __attribute__((ext_vector_type(4)));
__device__ __forceinline__ v8i_t cat8(const bf16x8 lo, const bf16x8 hi) { const v4i_t a = __builtin_bit_cast(v4i_t, lo), b = __builtin_bit_cast(v4i_t, hi); return __builtin_shufflevector(a, b, 0, 1, 2, 3, 4, 5, 6, 7); }
struct GUnit { const char* A; const char* B; int lda, ldb, nt, pm, pn, id; };

struct TileOrder {
    int nM, nN, nwg, G, c;
    __device__ __forceinline__ void init(int nM_, int nN_, int G_, int c_) { nM = nM_; nN = nN_; nwg = nM * nN; G = G_; c = c_; }
    __device__ __forceinline__ bool tile(int i, int& pm, int& pn) const {
        const long L = (long)i * G + c; if (L >= nwg) return false;
        int wgid = (int)L; { const int q = nwg / NXCD, r = nwg % NXCD, xcd = wgid % NXCD, off = wgid / NXCD; wgid = (xcd < r ? xcd * (q + 1) : r * (q + 1) + (xcd - r) * q) + off; }
        const int nig = WGM * nN, gid = wgid / nig, fm = gid * WGM, gsz = (nM - fm) < WGM ? (nM - fm) : WGM;
        pm = fm + ((wgid % nig) % gsz); pn = (wgid % nig) / gsz; return true;
    }
};

template <class Epi, class Sched, bool ALIGN_EPI, bool F8 = false>
__device__ __forceinline__ void gemm_phase(LAS unsigned char* lds, const Sched& S, const Epi& E, int wave_id) {
    int tid_o = wave_id * 64 + lane_now();
    const int tid = tid_o, wid = __builtin_amdgcn_readfirstlane(tid >> 6), lane = tid & 63, wr = wid >> 2, wc = wid & 3; int fr = lane & 15, fq = lane >> 4;
    int sR[2], sC[2], sRb[2];
#pragma unroll
    for (int i = 0; i < 2; ++i) { stage_rc(tid * 16 + i * 8192, sR[i], sC[i]); sRb[i] = Epi::PERM ? ((sR[i] & ~31) + perm32(sR[i] & 31)) : sR[i]; sC[i] *= 2; }
    const size_t kstep = (size_t)(BK * 2);
    const unsigned ldsw = (unsigned)wid * 1024u;
    const int aoff = lds_byte(wr * 64 + fr, fq * 8), boff = lds_byte(wc * 32 + fr, fq * 8);
#define PG8_SA(b, h) (((b) * 2 + (h)) * HTB)
#define PG8_SB(b, h) ((4 + (b) * 2 + (h)) * HTB)
#define PG8_STAGE(bufoff, gbase, rows, ld) do { _Pragma("unroll") for (int _i = 0; _i < 2; ++_i) \
        __builtin_amdgcn_global_load_lds((const unsigned*)((const char*)(gbase) + (unsigned)((rows)[_i] * (ld) + sC[_i])), (LAS unsigned*)(lds + (bufoff) + ldsw + _i * 8192), 16, 0, 0); } while (0)
#define PG8_LDA(dst, b, h) do { _Pragma("unroll") for (int m = 0; m < 4; ++m) _Pragma("unroll") for (int k = 0; k < 2; ++k) dst[m][k] = *(const LAS bf16x8*)(lds + PG8_SA(b, h) + aoff + m * 2048 + k * 1024); } while (0)
#define PG8_LDB(dst, b, h) do { _Pragma("unroll") for (int n = 0; n < 2; ++n) _Pragma("unroll") for (int k = 0; k < 2; ++k) dst[n][k] = *(const LAS bf16x8*)(lds + PG8_SB(b, h) + boff + n * 2048 + k * 1024); } while (0)
#define PG8_MMA(ai, bj, At, Bt) do { __builtin_amdgcn_s_setprio(1); _Pragma("unroll") for (int m = 0; m < 4; ++m) _Pragma("unroll") for (int n = 0; n < 2; ++n) _Pragma("unroll") for (int k = 0; k < 2; ++k) \
        acc[ai][bj][m][n] = __builtin_amdgcn_mfma_f32_16x16x32_bf16(Bt[n][k], At[m][k], acc[ai][bj][m][n], 0, 0, 0); __builtin_amdgcn_s_setprio(0); } while (0)
#define PG8_LDA8(dst, b, h) do { _Pragma("unroll") for (int m = 0; m < 4; ++m) { dst[m].lo = *(const LAS v4i_t*)(lds + PG8_SA(b, h) + aoff + m * 2048); dst[m].hi = *(const LAS v4i_t*)(lds + PG8_SA(b, h) + aoff + m * 2048 + 1024); } } while (0)
#define PG8_LDB8(dst, b, h) do { _Pragma("unroll") for (int n = 0; n < 2; ++n) { dst[n].lo = *(const LAS v4i_t*)(lds + PG8_SB(b, h) + boff + n * 2048); dst[n].hi = *(const LAS v4i_t*)(lds + PG8_SB(b, h) + boff + n * 2048 + 1024); } } while (0)
#define PG8_MMA8(ai, bj, At, Bt) do { __builtin_amdgcn_s_setprio(1); _Pragma("unroll") for (int m = 0; m < 4; ++m) _Pragma("unroll") for (int n = 0; n < 2; ++n) \
        asm volatile("v_mfma_f32_16x16x128_f8f6f4 %0, %1, %2, %0" : "+v"(acc[ai][bj][m][n]) : "v"(Bt[n]), "v"(At[m])); __builtin_amdgcn_s_setprio(0); } while (0)
#define PG8_WAIT_V(n) asm volatile("s_waitcnt vmcnt(" #n ")" ::: "memory")
#define PG8_WAIT_L(n) asm volatile("s_waitcnt lgkmcnt(" #n ")" ::: "memory")
#define PG8_BAR __builtin_amdgcn_s_barrier()
#define PG8_SCHED __builtin_amdgcn_sched_barrier(0)
#define PG8_KLOOP(MM, LDA_, LDB_, At, B0, B1) for (int t = 0; t < nt; t += 2) { \
            const bool last = (t == nt - 2); \
            const char* a1 = cA + (size_t)(t + 1) * kstep; \
            const char* a2 = last ? nA : cA + (size_t)(t + 2) * kstep; const char* b2 = last ? nB : cB + (size_t)(t + 2) * kstep; \
            const char* a3 = a2 + kstep; const char* b3 = b2 + kstep; \
            const int ldA2 = last ? ldAn : ldAc, ldB2 = last ? ldBn : ldBc; \
            const size_t hA2 = last ? hAn : hAc, hB2 = last ? hBn : hBc; \
              \
            LDB_(B0, 0, 0); LDB_(B1, 0, 1); PG8_SCHED; LDA_(At, 0, 0); PG8_STAGE(PG8_SA(1, 1), a1 + hAc, sR, ldAc); \
            PG8_WAIT_V(8); PG8_WAIT_L(0); PG8_BAR; MM(0, 0, At, B0); MM(0, 1, At, B1); PG8_BAR; PG8_SCHED; \
              \
            LDA_(At, 0, 1); PG8_STAGE(PG8_SB(0, 0), b2, sRb, ldB2); PG8_STAGE(PG8_SB(0, 1), b2 + hB2, sRb, ldB2); PG8_STAGE(PG8_SA(0, 0), a2, sR, ldA2); \
            PG8_WAIT_V(8); PG8_WAIT_L(0); PG8_BAR; MM(1, 0, At, B0); MM(1, 1, At, B1); PG8_BAR; PG8_SCHED; \
              \
            LDB_(B0, 1, 0); LDB_(B1, 1, 1); PG8_SCHED; LDA_(At, 1, 0); PG8_STAGE(PG8_SA(0, 1), a2 + hA2, sR, ldA2); \
            PG8_WAIT_V(8); PG8_WAIT_L(0); PG8_BAR; MM(0, 0, At, B0); MM(0, 1, At, B1); PG8_BAR; PG8_SCHED; \
              \
            LDA_(At, 1, 1); PG8_STAGE(PG8_SB(1, 0), b3, sRb, ldB2); PG8_STAGE(PG8_SB(1, 1), b3 + hB2, sRb, ldB2); PG8_STAGE(PG8_SA(1, 0), a3, sR, ldA2); \
            PG8_WAIT_V(8); PG8_WAIT_L(0); PG8_BAR; MM(1, 0, At, B0); MM(1, 1, At, B1); PG8_BAR; PG8_SCHED; \
        }
    GUnit cur, nxt; int ui = 0;
    if (!S.next(0, cur)) return;
    f32x4 acc[2][2][4][2];
#pragma unroll
    for (int a = 0; a < 2; ++a)
#pragma unroll
        for (int b = 0; b < 2; ++b)
#pragma unroll
            for (int m = 0; m < 4; ++m)
#pragma unroll
                for (int n = 0; n < 2; ++n) acc[a][b][m][n] = (f32x4){0.f, 0.f, 0.f, 0.f};
    bf16x8 At[4][2], B0[2][2], B1[2][2]; v8i_t At8[4], B08[2], B18[2];
    int ldAc = cur.lda, ldBc = cur.ldb; size_t hAc = (size_t)HALF * ldAc, hBc = (size_t)HALF * ldBc;
    const char* cA = cur.A; const char* cB = cur.B;
    PG8_STAGE(PG8_SB(0, 0), cB, sRb, ldBc); PG8_STAGE(PG8_SB(0, 1), cB + hBc, sRb, ldBc); PG8_STAGE(PG8_SA(0, 0), cA, sR, ldAc); PG8_STAGE(PG8_SA(0, 1), cA + hAc, sR, ldAc);
    if (wr == 1) PG8_BAR;
    PG8_WAIT_V(2); PG8_BAR;
    PG8_STAGE(PG8_SB(1, 0), cB + kstep, sRb, ldBc); PG8_STAGE(PG8_SA(1, 0), cA + kstep, sR, ldAc); PG8_STAGE(PG8_SB(1, 1), cB + hBc + kstep, sRb, ldBc);
    PG8_WAIT_V(6); PG8_BAR;
    for (;;) {
        const bool has_next = S.next(ui + 1, nxt);
        int ldAn, ldBn; const char* nA; const char* nB;
        if (has_next) { ldAn = nxt.lda; ldBn = nxt.ldb; nA = nxt.A; nB = nxt.B; } else { ldAn = ldAc; ldBn = ldBc; nA = cA; nB = cB; }
        const size_t hAn = (size_t)HALF * ldAn, hBn = (size_t)HALF * ldBn;
        int nt = cur.nt; asm volatile("" : "+s"(nt));
        bool f8u = false; if constexpr (F8) f8u = Epi::f8(cur);
        if (F8 && f8u) { PG8_KLOOP(PG8_MMA8, PG8_LDA8, PG8_LDB8, At8, B08, B18) asm volatile("s_nop 15\n\ts_nop 15" ::: "memory"); }
        else { PG8_KLOOP(PG8_MMA, PG8_LDA, PG8_LDB, At, B0, B1) }
        if constexpr (ALIGN_EPI) { if (wr == 0) PG8_BAR; }
        E(acc, cur, wr, wc, fr, fq);
        if (!has_next) break;
#pragma unroll
        for (int a = 0; a < 2; ++a)
#pragma unroll
            for (int b = 0; b < 2; ++b)
#pragma unroll
                for (int m = 0; m < 4; ++m)
#pragma unroll
                    for (int n = 0; n < 2; ++n) acc[a][b][m][n] = (f32x4){0.f, 0.f, 0.f, 0.f};
        cur = nxt; cA = nA; cB = nB; ++ui;
        ldAc = ldAn; ldBc = ldBn; hAc = hAn; hBc = hBn;
        if constexpr (ALIGN_EPI) { if (wr == 1) PG8_BAR; }
    }
    PG8_WAIT_V(0);
    if constexpr (!ALIGN_EPI) { if (wr == 0) PG8_BAR; }
    PG8_BAR;
#undef PG8_SA
#undef PG8_SB
#undef PG8_STAGE
#undef PG8_LDA
#undef PG8_LDB
#undef PG8_MMA
#undef PG8_MMA8
#undef PG8_LDA8
#undef PG8_LDB8
#undef PG8_KLOOP
#undef PG8_WAIT_V
#undef PG8_WAIT_L
#undef PG8_BAR
#undef PG8_SCHED
}
}
using pg8::GUnit;
namespace pg8 {
#define EPI_OPAQUE() asm volatile("" : "+v"(fr), "+v"(fq))
struct EpiBf16 {
    static constexpr bool PERM = true;
    bf16_t* O; int ldc;
    __device__ __forceinline__ void operator()(const f32x4 (&acc)[2][2][4][2], const GUnit& u, int wr, int wc, int fr, int fq) const {
        EPI_OPAQUE();
        const int row0 = u.pm * BM + wr * 64 + fr, col0 = u.pn * BM + wc * 32 + 8 * fq;
#pragma unroll
        for (int ai = 0; ai < 2; ++ai)
#pragma unroll
            for (int m = 0; m < 4; ++m) { bf16_t* rowp = O + (size_t)(row0 + ai * HALF + m * 16) * ldc + col0;
#pragma unroll
                for (int bj = 0; bj < 2; ++bj) { const f32x4 v0 = acc[ai][bj][m][0], v1 = acc[ai][bj][m][1];
                    u32x4 w; w.x = cvtpk(v0[0], v0[1]); w.y = cvtpk(v0[2], v0[3]); w.z = cvtpk(v1[0], v1[1]); w.w = cvtpk(v1[2], v1[3]);
                    *(u32x4*)(rowp + bj * HALF) = w; } }
    }
};
struct EpiF32 {
    static constexpr bool PERM = false;
    float* O; int ldc;
    __device__ __forceinline__ void operator()(const f32x4 (&acc)[2][2][4][2], const GUnit& u, int wr, int wc, int fr, int fq) const {
        EPI_OPAQUE();
        const int row0 = u.pm * BM + wr * 64 + fr, col0 = u.pn * BM + wc * 32 + 4 * fq;
#pragma unroll
        for (int ai = 0; ai < 2; ++ai)
#pragma unroll
            for (int m = 0; m < 4; ++m) { float* rowp = O + (size_t)(row0 + ai * HALF + m * 16) * ldc + col0;
#pragma unroll
                for (int bj = 0; bj < 2; ++bj)
#pragma unroll
                    for (int n = 0; n < 2; ++n) *(f32x4*)(rowp + bj * HALF + n * 16) = acc[ai][bj][m][n]; }
    }
};
__device__ __forceinline__ void rope8(f32x4& v0, f32x4& v1, const float* cs  ) {
    const f32x4 a = *(const f32x4*)cs, b = *(const f32x4*)(cs + 4);
    f32x4 r0, r1;
    r0[0] = v0[0] * a[0] - v0[1] * a[1]; r0[1] = v0[1] * a[0] + v0[0] * a[1];
    r0[2] = v0[2] * a[2] - v0[3] * a[3]; r0[3] = v0[3] * a[2] + v0[2] * a[3];
    r1[0] = v1[0] * b[0] - v1[1] * b[1]; r1[1] = v1[1] * b[0] + v1[0] * b[1];
    r1[2] = v1[2] * b[2] - v1[3] * b[3]; r1[3] = v1[3] * b[2] + v1[2] * b[3];
    v0 = r0; v1 = r1;
}
struct EpiInProj {
    static constexpr bool PERM = true;
    bf16_t* P; bf16_t* kcmp; bf16_t* vcmp; float* side; bf16_t* krot; const float* rope; float* ssq_q; float* ssq_kv; const float* fbias; float* lf;
    __device__ __forceinline__ void operator()(const f32x4 (&acc)[2][2][4][2], const GUnit& u, int wr, int wc, int fr, int fq) const {
        EPI_OPAQUE();
        const int row0 = u.pm * BM + wr * 64 + fr, col0 = u.pn * BM + wc * 32 + 8 * fq;
#pragma unroll
        for (int ai = 0; ai < 2; ++ai)
#pragma unroll
            for (int m = 0; m < 4; ++m) { const int row = row0 + ai * HALF + m * 16; bf16_t* rowp = P + (size_t)row * PW + col0;
                float ssq = 0.f;
#pragma unroll
                for (int bj = 0; bj < 2; ++bj) { f32x4 v0 = acc[ai][bj][m][0], v1 = acc[ai][bj][m][1];
                    if (u.pn == 2 && bj == 1) {
                        if (wc == 0 && fq < 2) { float* sp = side + (size_t)row * 16 + 8 * fq; *(f32x4*)sp = v0; *(f32x4*)(sp + 4) = v1; }
                        if (wc == 1) { rope8(v0, v1, rope + (size_t)(row & (SEQ - 1)) * 32 + 8 * fq);
                            u32x4 w; w.x = cvtpk(v0[0], v0[1]); w.y = cvtpk(v0[2], v0[3]); w.z = cvtpk(v1[0], v1[1]); w.w = cvtpk(v1[2], v1[3]);
                            *(u32x4*)(krot + (size_t)row * 32 + 8 * fq) = w; }
                    }
                    u32x4 w; w.x = cvtpk(v0[0], v0[1]); w.y = cvtpk(v0[2], v0[3]); w.z = cvtpk(v1[0], v1[1]); w.w = cvtpk(v1[2], v1[3]);
                    *(u32x4*)(rowp + bj * HALF) = w;
                    if (u.pn == 1 && bj == 0) { bf16_t* cp = (wc < 2 ? kcmp : vcmp) + (size_t)row * 64 + (wc & 1) * 32 + 8 * fq; *(u32x4*)cp = w; }
                    if (u.pn == 11 || (u.pn == 7 && bj == 1)) ssq += (v0[0] * v0[0] + v0[1] * v0[1]) + (v0[2] * v0[2] + v0[3] * v0[3]) + (v1[0] * v1[0] + v1[1] * v1[1]) + (v1[2] * v1[2] + v1[3] * v1[3]);
                }
                if (u.pn == 11 || u.pn == 7) { ssq += xor_lane_lt32<16>(ssq); ssq = sum_halves(ssq);
                    if (fq == 0) (u.pn == 11 ? ssq_q : ssq_kv)[(size_t)row * 4 + wc] = ssq; }
                asm volatile("" ::: "memory");
            }
    }
};
struct EpiQup {
    static constexpr bool PERM = true;
    bf16_t* O; const float* ssq_q; const float* rope;
    __device__ __forceinline__ void operator()(const f32x4 (&acc)[2][2][4][2], const GUnit& u, int wr, int wc, int fr, int fq) const {
        EPI_OPAQUE();
        const int row0 = u.pm * BM + wr * 64 + fr, col0 = u.pn * BM + wc * 32 + 8 * fq;
#pragma unroll
        for (int ai = 0; ai < 2; ++ai)
#pragma unroll
            for (int m = 0; m < 4; ++m) { const int row = row0 + ai * HALF + m * 16; bf16_t* rowp = O + (size_t)row * 512 + col0;
                const f32x4 pq = *(const f32x4*)(ssq_q + (size_t)row * 4);
                const float rstd = 1.0f / sqrtf(((pq[0] + pq[1]) + (pq[2] + pq[3])) * (1.0f / 256.0f) + RMS_EPS);
#pragma unroll
                for (int bj = 0; bj < 2; ++bj) { f32x4 v0 = acc[ai][bj][m][0] * rstd, v1 = acc[ai][bj][m][1] * rstd;
                    const int c8 = col0 + bj * HALF, within = c8 % 96;
                    if (c8 < 384 && within >= 64) rope8(v0, v1, rope + (size_t)(row & (SEQ - 1)) * 32 + (within - 64));
                    u32x4 w; w.x = cvtpk(v0[0], v0[1]); w.y = cvtpk(v0[2], v0[3]); w.z = cvtpk(v1[0], v1[1]); w.w = cvtpk(v1[2], v1[3]);
                    *(u32x4*)(rowp + bj * HALF) = w; }
                asm volatile("" ::: "memory"); }
    }
};
struct EpiKVup {
    static constexpr bool PERM = true;
    bf16_t* O; const float* ssq_kv; unsigned* kmx;
    __device__ __forceinline__ void operator()(const f32x4 (&acc)[2][2][4][2], const GUnit& u, int wr, int wc, int fr, int fq) const {
        EPI_OPAQUE();
        const int row0 = u.pm * BM + wr * 64 + fr, col0 = u.pn * BM + wc * 32 + 8 * fq;
        float mk0 = 0.f, mk1 = 0.f;
#pragma unroll
        for (int ai = 0; ai < 2; ++ai)
#pragma unroll
            for (int m = 0; m < 4; ++m) { const int row = row0 + ai * HALF + m * 16; bf16_t* rowp = O + (size_t)row * 512 + col0;
                const f32x4 pq = *(const f32x4*)(ssq_kv + (size_t)row * 4);
                const float rstd = 1.0f / sqrtf(((pq[0] + pq[1]) + (pq[2] + pq[3])) * (1.0f / 128.0f) + RMS_EPS);
#pragma unroll
                for (int bj = 0; bj < 2; ++bj) { const f32x4 v0 = acc[ai][bj][m][0] * rstd, v1 = acc[ai][bj][m][1] * rstd;
                    u32x4 w; w.x = cvtpk(v0[0], v0[1]); w.y = cvtpk(v0[2], v0[3]); w.z = cvtpk(v1[0], v1[1]); w.w = cvtpk(v1[2], v1[3]);
                    *(u32x4*)(rowp + bj * HALF) = w;
                    if (wc < 2) { float ss = ((v0[0] * v0[0] + v0[1] * v0[1]) + (v0[2] * v0[2] + v0[3] * v0[3])) + ((v1[0] * v1[0] + v1[1] * v1[1]) + (v1[2] * v1[2] + v1[3] * v1[3]));
                        ss += xor_lane_lt32<16>(ss); ss = sum_halves(ss); if (bj == 0) mk0 = fmaxf(mk0, ss); else mk1 = fmaxf(mk1, ss); } }
                asm volatile("" ::: "memory"); }
        if (wc < 2) {
            mk0 = fmaxf(mk0, xor_lane_lt32<1>(mk0)); mk0 = fmaxf(mk0, xor_lane_lt32<2>(mk0)); mk0 = fmaxf(mk0, xor_lane_lt32<4>(mk0)); mk0 = fmaxf(mk0, xor_lane_lt32<8>(mk0));
            mk1 = fmaxf(mk1, xor_lane_lt32<1>(mk1)); mk1 = fmaxf(mk1, xor_lane_lt32<2>(mk1)); mk1 = fmaxf(mk1, xor_lane_lt32<4>(mk1)); mk1 = fmaxf(mk1, xor_lane_lt32<8>(mk1));
            if (fr == 0 && fq == 0) { unsigned* kw = kmx + ((u.pm >> 4) * 4 + 2 * u.pn) * 4 + wc; atomicMax(kw, __float_as_uint(mk0)); atomicMax(kw + 4, __float_as_uint(mk1)); }
        }
    }
};
__device__ __forceinline__ float gelu_tanh(float x) { const float u2 = 2.0f * 0.7978845608028654f * (x + 0.044715f * x * x * x); return x * fast_rcp(1.0f + fast_exp2(-u2 * LOG2E)); }
struct EpiCmp1 {
    static constexpr bool PERM = true;
    bf16_t* O; const float* bias1;
    __device__ __forceinline__ void operator()(const f32x4 (&acc)[2][2][4][2], const GUnit& u, int wr, int wc, int fr, int fq) const {
        EPI_OPAQUE();
        const int row0 = u.pm * BM + wr * 64 + fr, col0 = wc * 32 + 8 * fq;
        f32x4 bv[2][2];
#pragma unroll
        for (int bj = 0; bj < 2; ++bj)
#pragma unroll
            for (int n = 0; n < 2; ++n) bv[bj][n] = *(const f32x4*)(bias1 + col0 + bj * HALF + 4 * n);
#pragma unroll
        for (int ai = 0; ai < 2; ++ai)
#pragma unroll
            for (int m = 0; m < 4; ++m) { bf16_t* rowp = O + (size_t)(row0 + ai * HALF + m * 16) * 256 + col0;
#pragma unroll
                for (int bj = 0; bj < 2; ++bj) { f32x4 v0 = acc[ai][bj][m][0] + bv[bj][0], v1 = acc[ai][bj][m][1] + bv[bj][1];
#pragma unroll
                    for (int e = 0; e < 4; ++e) { v0[e] = gelu_tanh(v0[e]); v1[e] = gelu_tanh(v1[e]); }
                    u32x4 w; w.x = cvtpk(v0[0], v0[1]); w.y = cvtpk(v0[2], v0[3]); w.z = cvtpk(v1[0], v1[1]); w.w = cvtpk(v1[2], v1[3]);
                    *(u32x4*)(rowp + bj * HALF) = w; } }
    }
};
typedef __amdgpu_buffer_rsrc_t rsrc_t;
struct EpiMerge {
    __device__ static __forceinline__ bool f8(const GUnit& u) { return u.id >= 4; }
    static constexpr bool PERM = true;
    bf16_t* O;
    unsigned char* scr;
    __device__ __forceinline__ void operator()(const f32x4 (&acc)[2][2][4][2], const GUnit& u, int wr, int wc, int fr, int fq) const {
        EPI_OPAQUE();
        const int tid = (wr * 4 + wc) * 64 + fq * 16 + fr;
        const int sub = u.id;
        const rsrc_t rs = __builtin_amdgcn_make_buffer_rsrc(scr, 0, 524288, 0x00020000);
        if (sub < 4) {
#pragma unroll
            for (int ai = 0; ai < 2; ++ai)
#pragma unroll
                for (int bj = 0; bj < 2; ++bj)
#pragma unroll
                    for (int m = 0; m < 4; ++m)
#pragma unroll
                        for (int n = 0; n < 2; ++n) { const int q = ((ai * 2 + bj) * 4 + m) * 2 + n; const f32x4 v = acc[ai][bj][m][n];
                            u32x2 w; w.x = cvtpk(v[0], v[1]); w.y = cvtpk(v[2], v[3]);
                            __builtin_amdgcn_raw_buffer_store_b64(w, rs, tid * 8, (sub * 32 + q) * 4096, 0); }
            return;
        }
        const int j = sub - 4;
        const int row0 = u.pm * BM + wr * 64 + fr, col0 = u.pn * BM + 64 * j + wc * 16 + 4 * fq;
#pragma unroll
        for (int ai = 0; ai < 2; ++ai) {
            u32x2 sv[4][4];
#pragma unroll
            for (int m = 0; m < 4; ++m)
#pragma unroll
                for (int g = 0; g < 4; ++g) { const int qb = (ai * 16 + m * 2);
                    sv[m][g] = (j == 0) ? __builtin_amdgcn_raw_buffer_load_b64(rs, tid * 8, (g * 32 + qb) * 4096, 0)
                             : (j == 1) ? __builtin_amdgcn_raw_buffer_load_b64(rs, tid * 8, (g * 32 + qb + 1) * 4096, 0)
                             : (j == 2) ? __builtin_amdgcn_raw_buffer_load_b64(rs, tid * 8, (g * 32 + qb + 8) * 4096, 0)
                                        : __builtin_amdgcn_raw_buffer_load_b64(rs, tid * 8, (g * 32 + qb + 9) * 4096, 0); }
#pragma unroll
            for (int m = 0; m < 4; ++m) { bf16_t* rowp = O + (size_t)(row0 + ai * HALF + m * 16) * DM + col0;
                f32x4 t = {0.f, 0.f, 0.f, 0.f};
#pragma unroll
                for (int g = 0; g < 4; ++g) { const f32x4 gt = acc[ai][g >> 1][m][g & 1]; const u32x2 s = sv[m][g];
                    t[0] += fast_rcp(1.0f + fast_exp2(gt[0])) * __uint_as_float(s.x << 16); t[1] += fast_rcp(1.0f + fast_exp2(gt[1])) * __uint_as_float(s.x & 0xffff0000u);
                    t[2] += fast_rcp(1.0f + fast_exp2(gt[2])) * __uint_as_float(s.y << 16); t[3] += fast_rcp(1.0f + fast_exp2(gt[3])) * __uint_as_float(s.y & 0xffff0000u); }
                u32x2 w; w.x = cvtpk(t[0], t[1]); w.y = cvtpk(t[2], t[3]);
                *(u32x2*)rowp = w; }
            asm volatile("" ::: "memory"); }
    }
};
__device__ __forceinline__ float dpp_ror1(float v) { return __uint_as_float((unsigned)__builtin_amdgcn_mov_dpp((int)__float_as_uint(v), 0x121, 0xf, 0xf, false)); }
__device__ __forceinline__ float dpp_ror2(float v) { return __uint_as_float((unsigned)__builtin_amdgcn_mov_dpp((int)__float_as_uint(v), 0x122, 0xf, 0xf, false)); }
struct EpiUpConv {
    static constexpr int KIND = 8;
    static constexpr bool PERM = true;
    bf16_t* ACT; float* HB; const float* cw; const float* cb;
    __device__ __forceinline__ void operator()(const f32x4 (&acc)[2][2][4][2], const GUnit& u, int wr, int wc, int fr, int fq) const {
        EPI_OPAQUE();
        const int colL = wc * 32 + 8 * fq;
        const bool l0 = (fr == 0), l01 = (fr < 2);
#pragma unroll
        for (int n = 0; n < 2; ++n) {
            const int cl = colL + 4 * n, c0 = u.pn * 128 + cl;
            const f32x4 bg = *(const f32x4*)(cb + c0), w0g = *(const f32x4*)(cw + c0), w1g = *(const f32x4*)(cw + DFF2 + c0), w2g = *(const f32x4*)(cw + 2 * DFF2 + c0);
            const f32x4 bv = *(const f32x4*)(cb + DFF + c0), w0v = *(const f32x4*)(cw + DFF + c0), w1v = *(const f32x4*)(cw + DFF2 + DFF + c0), w2v = *(const f32x4*)(cw + 2 * DFF2 + DFF + c0);
            f32x4 w1ga, w1gb, w0ga, w0gb, w1va, w1vb, w0va, w0vb;
#pragma unroll
            for (int e = 0; e < 4; ++e) { w1ga[e] = l0 ? 0.f : w1g[e]; w1gb[e] = l0 ? w1g[e] : 0.f; w0ga[e] = l01 ? 0.f : w0g[e]; w0gb[e] = l01 ? w0g[e] : 0.f;
                                          w1va[e] = l0 ? 0.f : w1v[e]; w1vb[e] = l0 ? w1v[e] : 0.f; w0va[e] = l01 ? 0.f : w0v[e]; w0vb[e] = l01 ? w0v[e] : 0.f; }
#pragma unroll
            for (int ai = 0; ai < 2; ++ai) {
                const int rowg = u.pm * BM + ai * HALF + wr * 64, g = rowg >> 6;
#pragma unroll
                for (int m = 0; m < 4; ++m) {
                    const f32x4 cg = acc[ai][0][m][n], cv = acc[ai][1][m][n];
                    f32x4 o;
#pragma unroll
                    for (int e = 0; e < 4; ++e) {
                        float gt = fmaf(w2g[e], cg[e], bg[e]), vl = fmaf(w2v[e], cv[e], bv[e]);
                        gt = fmaf(dpp_ror1(cg[e]), w1ga[e], gt); gt = fmaf(dpp_ror2(cg[e]), w0ga[e], gt);
                        vl = fmaf(dpp_ror1(cv[e]), w1va[e], vl); vl = fmaf(dpp_ror2(cv[e]), w0va[e], vl);
                        if (m > 0) { const float pg = acc[ai][0][m - 1][n][e], pv = acc[ai][1][m - 1][n][e];
                            gt = fmaf(dpp_ror1(pg), w1gb[e], gt); gt = fmaf(dpp_ror2(pg), w0gb[e], gt);
                            vl = fmaf(dpp_ror1(pv), w1vb[e], vl); vl = fmaf(dpp_ror2(pv), w0vb[e], vl); }
                        o[e] = (gt * vl) * fast_rcp(1.0f + fast_exp2(gt)); }
                    const int row = rowg + m * 16 + fr;
                    if (!(m == 0 && fr < 2)) { u32x2 w; w.x = cvtpk(o[0], o[1]); w.y = cvtpk(o[2], o[3]); *(u32x2*)(ACT + (size_t)row * DFF + c0) = w; }
                    if (m == 0 && fr < 2) { float* hp = HB + ((size_t)((g * 4 + fr) * 22 + u.pn) * 256 + cl); *(f32x4*)hp = cg; *(f32x4*)(hp + 128) = cv; }
                    if (m == 3 && fr >= 14) { float* hp = HB + ((size_t)((g * 4 + fr - 12) * 22 + u.pn) * 256 + cl); *(f32x4*)hp = cg; *(f32x4*)(hp + 128) = cv; }
                }
            }
            asm volatile("" ::: "memory");
        }
    }
};
}
#define XB_TMO      128
#define XB_XCNT(j)  (256  + 64 * (j))
#define XB_XSUB(j)  (1280 + 64 * (j))
#define XB_XGEN(j)  (2304 + 64 * (j))
#define XB_TOP      3328
#define XB_TOPGEN   3392
#define XCD_BAR_WORDS 3456
#define XB_SPIN_CAP (1u << 22)
__device__ __forceinline__ unsigned xb_ld(unsigned* p)              { return __hip_atomic_load(p, __ATOMIC_RELAXED, __HIP_MEMORY_SCOPE_AGENT); }
__device__ __forceinline__ unsigned xb_add(unsigned* p, unsigned v) { return __hip_atomic_fetch_add(p, v, __ATOMIC_RELAXED, __HIP_MEMORY_SCOPE_AGENT); }
__device__ __forceinline__ unsigned xb_xcc_id() { return (unsigned)__builtin_amdgcn_s_getreg((3 << 11) | 20) & 0xFu; }
#define XB_SPIN(cond, bar) do { unsigned _sp = 0; while (cond) { __builtin_amdgcn_s_sleep(1); \
    if ((++_sp & 255u) == 0u) { if (xb_ld(&(bar)[XB_TMO])) break; if (_sp > XB_SPIN_CAP) { atomicAdd(&(bar)[XB_TMO], 1u); break; } } } } while (0)
struct XcdBarrier { unsigned* bar; unsigned x; volatile LAS unsigned* st; };
__device__ __forceinline__ XcdBarrier xcd_barrier_post(unsigned* bar, volatile LAS unsigned* st) {
    XcdBarrier b; b.bar = bar; b.x = xb_xcc_id(); b.st = st;
    if (threadIdx.x == 0) (void)xb_add(&bar[XB_XCNT(b.x)], 1u);
    return b;
}
__device__ __forceinline__ void xcd_barrier_complete(unsigned* bar, unsigned x, unsigned& nloc, unsigned& nx) {
    const unsigned G = gridDim.x * gridDim.y * gridDim.z;
    unsigned sum, cnt, mine, sp = 0u;
    for (;;) {
        sum = 0u; cnt = 0u; mine = 0u;
#pragma unroll
        for (unsigned j = 0; j < 16; ++j) { const unsigned c = xb_ld(&bar[XB_XCNT(j)]); sum += c; cnt += (c > 0u) ? 1u : 0u; mine = (j == x) ? c : mine; }
        if (sum == G) break;
        __builtin_amdgcn_s_sleep(1);
        if ((++sp & 255u) == 0u) { if (xb_ld(&bar[XB_TMO])) break; if (sp > XB_SPIN_CAP) { atomicAdd(&bar[XB_TMO], 1u); break; } }
    }
    nloc = mine > 0u ? mine : 1u; nx = cnt > 0u ? cnt : 1u;
}
__device__ __forceinline__ void xcd_barrier(const XcdBarrier& b, int wave_id) {
    asm volatile("s_waitcnt vmcnt(0)" ::: "memory");
    __syncthreads();
    if (wave_id == 0 && lane_now() == 0) {
        unsigned* bar = b.bar; unsigned bx = b.x;
        asm volatile("" : "+s"(bx));
        __builtin_amdgcn_s_waitcnt(0);
        unsigned nloc = b.st[0], nx = b.st[1];
        if (nloc == 0u) { xcd_barrier_complete(bar, bx, nloc, nx); b.st[0] = nloc; b.st[1] = nx; }
        const unsigned old = xb_add(&bar[XB_XSUB(bx)], 1u);
        const unsigned gen = old / nloc;
        if (old + 1u == (gen + 1u) * nloc) {
            __builtin_amdgcn_fence(__ATOMIC_RELEASE, "agent");
            asm volatile("s_waitcnt vmcnt(0)" ::: "memory");
            const unsigned og = xb_add(&bar[XB_TOP], 1u);
            const unsigned tg = og / nx;
            if (og + 1u == (tg + 1u) * nx) xb_add(&bar[XB_TOPGEN], 1u);
            else XB_SPIN(xb_ld(&bar[XB_TOPGEN]) == tg, bar);
            __builtin_amdgcn_fence(__ATOMIC_ACQUIRE, "agent");
            xb_add(&bar[XB_XGEN(bx)], 1u);
            asm volatile("s_waitcnt vmcnt(0)" ::: "memory");
        } else {
            XB_SPIN(xb_ld(&bar[XB_XGEN(bx)]) == gen, bar);
            __builtin_amdgcn_fence(__ATOMIC_ACQUIRE, "agent");
            asm volatile("s_waitcnt vmcnt(0)" ::: "memory");
        }
    }
    __syncthreads();
}

#define MFMA32(a, b, c) __builtin_amdgcn_mfma_f32_32x32x16_bf16(a, b, c, 0, 0, 0)
typedef short v4i16_t __attribute__((ext_vector_type(4)));
typedef LAS const char* lds_cptr;
typedef LAS char* lds_ptr;
__device__ __forceinline__ int crow(int r, int hi) { return (r & 3) + 8 * (r >> 2) + 4 * hi; }
__device__ __forceinline__ s16x4 vtr(lds_cptr p) { return __builtin_bit_cast(s16x4, __builtin_amdgcn_ds_read_tr16_b64_v4i16((LAS v4i16_t*)p)); }
__device__ __forceinline__ float other_half(float x, int hi) { auto rr = __builtin_amdgcn_permlane32_swap(__float_as_uint(x), __float_as_uint(x), false, false); return __uint_as_float(hi ? rr[0] : rr[1]); }
constexpr float NEG_INF = -INFINITY;

constexpr int TB_V = 12288, TB_KB = 20480, TB_SIZE = 20992;
struct Stg { u32x4 k, k2, v; float kb; };

template <int NKS> __device__ __forceinline__ void qk64(lds_cptr kbuf, const bf16x8* qf, int r32, int hi, f32x16& p0, f32x16& p1) {
    lds_cptr kp = kbuf + hi * 1024 + r32 * 16;
#pragma unroll
    for (int ks = 0; ks < NKS; ++ks) {
        const bf16x8 a0 = *(const LAS bf16x8*)(kp + ks * 2048), a1 = *(const LAS bf16x8*)(kp + ks * 2048 + 512);
        p0 = MFMA32(a0, qf[ks], p0); p1 = MFMA32(a1, qf[ks], p1);
    }
}
template <int NKS> __device__ __forceinline__ void qk64c(lds_cptr kbuf, const bf16x8* qf, int r32, int hi, const f32x16& c, f32x16& p0, f32x16& p1) {
    lds_cptr kp = kbuf + hi * 1024 + r32 * 16;
    { const bf16x8 a0 = *(const LAS bf16x8*)(kp), a1 = *(const LAS bf16x8*)(kp + 512); p0 = MFMA32(a0, qf[0], c); p1 = MFMA32(a1, qf[0], c); }
#pragma unroll
    for (int ks = 1; ks < NKS; ++ks) {
        const bf16x8 a0 = *(const LAS bf16x8*)(kp + ks * 2048), a1 = *(const LAS bf16x8*)(kp + ks * 2048 + 512);
        p0 = MFMA32(a0, qf[ks], p0); p1 = MFMA32(a1, qf[ks], p1);
    }
}
struct AState { f32x16 o0, o1; float m, l; };
__device__ __forceinline__ void astate_init(AState& s) {
#pragma unroll
    for (int r = 0; r < 16; ++r) { s.o0[r] = 0.f; s.o1[r] = 0.f; }
    s.m = NEG_INF; s.l = 0.f;
}
__device__ __forceinline__ void pv64(f32x16& o0, f32x16& o1, lds_cptr vp, const bf16x8 (&pf)[4]) {
#pragma unroll
    for (int ks = 0; ks < 4; ++ks) {
        const s16x4 l0 = vtr(vp + ks * 1024), h0 = vtr(vp + ks * 1024 + 512), l1 = vtr(vp + 4096 + ks * 1024), h1 = vtr(vp + 4096 + ks * 1024 + 512);
        const bf16x8 v0 = (bf16x8){l0[0], l0[1], l0[2], l0[3], h0[0], h0[1], h0[2], h0[3]}, v1 = (bf16x8){l1[0], l1[1], l1[2], l1[3], h1[0], h1[1], h1[2], h1[3]};
        o0 = MFMA32(v0, pf[ks], o0); o1 = MFMA32(v1, pf[ks], o1);
    }
}
struct VFrag { bf16x8 v0[4], v1[4]; };
__device__ __forceinline__ void v_load64(VFrag& f, lds_cptr vp) {
#pragma unroll
    for (int ks = 0; ks < 4; ++ks) {
        const s16x4 l0 = vtr(vp + ks * 1024), h0 = vtr(vp + ks * 1024 + 512), l1 = vtr(vp + 4096 + ks * 1024), h1 = vtr(vp + 4096 + ks * 1024 + 512);
        f.v0[ks] = (bf16x8){l0[0], l0[1], l0[2], l0[3], h0[0], h0[1], h0[2], h0[3]}; f.v1[ks] = (bf16x8){l1[0], l1[1], l1[2], l1[3], h1[0], h1[1], h1[2], h1[3]};
    }
}
__device__ __forceinline__ void pv64f(f32x16& o0, f32x16& o1, const VFrag& f, const bf16x8 (&pf)[4]) {
#pragma unroll
    for (int ks = 0; ks < 4; ++ks) { o0 = MFMA32(f.v0[ks], pf[ks], o0); o1 = MFMA32(f.v1[ks], pf[ks], o1); }
}
__device__ __forceinline__ void pack_p(const f32x16& p0, const f32x16& p1, bf16x8 (&pf)[4]) {
    u32x4 w0, w1, w2, w3;
    w0.x = cvtpk(p0[0], p0[1]); w0.y = cvtpk(p0[2], p0[3]); w0.z = cvtpk(p0[4], p0[5]); w0.w = cvtpk(p0[6], p0[7]);
    w1.x = cvtpk(p0[8], p0[9]); w1.y = cvtpk(p0[10], p0[11]); w1.z = cvtpk(p0[12], p0[13]); w1.w = cvtpk(p0[14], p0[15]);
    w2.x = cvtpk(p1[0], p1[1]); w2.y = cvtpk(p1[2], p1[3]); w2.z = cvtpk(p1[4], p1[5]); w2.w = cvtpk(p1[6], p1[7]);
    w3.x = cvtpk(p1[8], p1[9]); w3.y = cvtpk(p1[10], p1[11]); w3.z = cvtpk(p1[12], p1[13]); w3.w = cvtpk(p1[14], p1[15]);
    pf[0] = __builtin_bit_cast(bf16x8, w0); pf[1] = __builtin_bit_cast(bf16x8, w1); pf[2] = __builtin_bit_cast(bf16x8, w2); pf[3] = __builtin_bit_cast(bf16x8, w3);
}
template <bool HOIST = true> __device__ __forceinline__ void softmax_pv64(f32x16& p0, f32x16& p1, AState& s, lds_cptr vp, int hi) {
    VFrag vf; if (HOIST) { v_load64(vf, vp); __builtin_amdgcn_sched_barrier(0); }
    float mx = fmaxf(p0[0], p1[0]);
#pragma unroll
    for (int r = 1; r < 16; ++r) mx = fmaxf(mx, fmaxf(p0[r], p1[r]));
    mx = fmaxf(mx, other_half(mx, hi));
    const float mn = fmaxf(s.m, mx), ms = (mn == NEG_INF) ? 0.f : mn;
    const float alpha = fast_exp2(s.m - ms);
    float rs = 0.f;
#pragma unroll
    for (int r = 0; r < 16; ++r) { p0[r] = fast_exp2(p0[r] - ms); p1[r] = fast_exp2(p1[r] - ms); rs += p0[r] + p1[r]; }
    rs += other_half(rs, hi);
    s.l = s.l * alpha + rs; s.m = mn;
#pragma unroll
    for (int r = 0; r < 16; ++r) { s.o0[r] *= alpha; s.o1[r] *= alpha; }
    bf16x8 pf[4]; pack_p(p0, p1, pf);
    if (HOIST) pv64f(s.o0, s.o1, vf, pf); else pv64(s.o0, s.o1, vp, pf);
}
__device__ __forceinline__ void softmax_fixed_pv64(f32x16& p0, f32x16& p1, AState& s, lds_cptr vp) {
    VFrag vf; v_load64(vf, vp); __builtin_amdgcn_sched_barrier(0);
    float rs = 0.f;
#pragma unroll
    for (int r = 0; r < 16; ++r) { p0[r] = fast_exp2(p0[r]); p1[r] = fast_exp2(p1[r]); rs += p0[r] + p1[r]; }
    s.l += rs;
    bf16x8 pf[4]; pack_p(p0, p1, pf);
    pv64f(s.o0, s.o1, vf, pf);
}
template <bool HOIST> __device__ __forceinline__ void softmax_shift_pv64(f32x16& p0, f32x16& p1, AState& s, lds_cptr vp, float bnd) {
    VFrag vf; if (HOIST) { v_load64(vf, vp); __builtin_amdgcn_sched_barrier(0); }
    float rs = 0.f;
#pragma unroll
    for (int r = 0; r < 16; ++r) { p0[r] = fast_exp2(p0[r] - bnd); p1[r] = fast_exp2(p1[r] - bnd); rs += p0[r] + p1[r]; }
    s.l += rs;
    bf16x8 pf[4]; pack_p(p0, p1, pf);
    if (HOIST) pv64f(s.o0, s.o1, vf, pf); else pv64(s.o0, s.o1, vp, pf);
}
template <bool MASK> __device__ __forceinline__ void softmax_raw_pv64(f32x16& p0, f32x16& p1, AState& s, lds_cptr vp, bool keep) {
    float rs = 0.f;
#pragma unroll
    for (int r = 0; r < 16; ++r) { p0[r] = fast_exp2(p0[r]); p1[r] = fast_exp2(p1[r]); rs += p0[r] + p1[r]; }
    bf16x8 pf[4]; pack_p(p0, p1, pf);
    if (MASK) { const unsigned km = keep ? 0xffffffffu : 0u; rs = keep ? rs : 0.f;
#pragma unroll
        for (int k = 0; k < 4; ++k) { u32x4 w = __builtin_bit_cast(u32x4, pf[k]); w.x &= km; w.y &= km; w.z &= km; w.w &= km; pf[k] = __builtin_bit_cast(bf16x8, w); } }
    s.l += rs;
    pv64(s.o0, s.o1, vp, pf);
}
__device__ __forceinline__ void mask_causal(f32x16& p0, f32x16& p1, int kpos0, int tq, int hi) {
#pragma unroll
    for (int r = 0; r < 16; ++r) { const int kp = kpos0 + crow(r, hi); if (kp > tq) p0[r] = NEG_INF; if (kp + 32 > tq) p1[r] = NEG_INF; }
}
__device__ __forceinline__ void add_table(f32x16& p0, f32x16& p1, const LAS float* tb) {
#pragma unroll
    for (int r = 0; r < 16; ++r) { const int o = (r & 3) + 8 * (r >> 2); p0[r] += tb[o]; p1[r] += tb[o + 32]; }
}
__device__ __forceinline__ void store_o_bf16(bf16_t* orow, const f32x16& o0, const f32x16& o1, float sc, int hi) {
#pragma unroll
    for (int g = 0; g < 4; ++g) {
        u32x2 w0, w1; w0.x = cvtpk(o0[4 * g] * sc, o0[4 * g + 1] * sc); w0.y = cvtpk(o0[4 * g + 2] * sc, o0[4 * g + 3] * sc);
        w1.x = cvtpk(o1[4 * g] * sc, o1[4 * g + 1] * sc); w1.y = cvtpk(o1[4 * g + 2] * sc, o1[4 * g + 3] * sc);
        *(u32x2*)(orow + 8 * g + 4 * hi) = w0; *(u32x2*)(orow + 32 + 8 * g + 4 * hi) = w1;
    }
}
constexpr int OST_OFF = 90112, OST_PITCH = 144, OST_WAVE = 32 * OST_PITCH;
template <class RowPtr> __device__ __forceinline__ void store_o_staged(lds_ptr lds, int wid, int lane, const f32x16& o0, const f32x16& o1, float sc, const RowPtr& rowp) {
    const int r32 = lane & 31, hi = lane >> 5;
    lds_ptr stg = lds + OST_OFF + wid * OST_WAVE;
#pragma unroll
    for (int g = 0; g < 4; ++g) {
        u32x2 w0, w1; w0.x = cvtpk(o0[4 * g] * sc, o0[4 * g + 1] * sc); w0.y = cvtpk(o0[4 * g + 2] * sc, o0[4 * g + 3] * sc);
        w1.x = cvtpk(o1[4 * g] * sc, o1[4 * g + 1] * sc); w1.y = cvtpk(o1[4 * g + 2] * sc, o1[4 * g + 3] * sc);
        *(LAS u32x2*)(stg + r32 * OST_PITCH + (8 * g + 4 * hi) * 2) = w0; *(LAS u32x2*)(stg + r32 * OST_PITCH + 64 + (8 * g + 4 * hi) * 2) = w1;
    }
    asm volatile("" ::: "memory");
#pragma unroll
    for (int i = 0; i < 4; ++i) { const int row = i * 8 + (lane >> 3), ch = lane & 7;
        const u32x4 v = *(const LAS u32x4*)(stg + row * OST_PITCH + ch * 16);
        *(u32x4*)(rowp(row) + ch * 8) = v; }
    asm volatile("" ::: "memory");
}
constexpr size_t MiB = 1u << 20, KiB = 1u << 10;
constexpr size_t WS_CTL = 0, CTL_ZERO_BYTES = 1 * MiB;
constexpr size_t WS_ROPE = 1 * MiB, WS_NSATAB = WS_ROPE + 512 * KiB, WS_DILTAB = WS_NSATAB + 32 * KiB, WS_CMPB = WS_DILTAB + 8 * KiB, WS_FARB = WS_CMPB + 4 * KiB;
constexpr size_t WS_WT = 4 * MiB, LW = 38 * MiB;
constexpr size_t LW_IN = 0, LW_G = 6 * MiB, LW_BR = 14 * MiB, LW_O = 16 * MiB, LW_UP = 18 * MiB, LW_DN = 29 * MiB, LW_UQ = 35 * MiB, LW_UKV = 35 * MiB + 256 * KiB, LW_PHI = 36 * MiB;
constexpr size_t BR_A = 0, BR_B = 512 * KiB, BR_C = 768 * KiB, BR_D = 1280 * KiB;
constexpr size_t WS_SIDE = 80 * MiB, WS_SSQQ = 84 * MiB, WS_SSQKV = 85 * MiB, WS_KB = 86 * MiB, WS_KROT = 87 * MiB, WS_KCMP = 91 * MiB, WS_VCMP = 100 * MiB,
                 WS_HID = 109 * MiB, WS_KMAX = 3 * MiB + 128 * KiB  , WS_LF = 2 * MiB  , WS_CMPP = 3 * MiB  , WS_ORDER = 3 * MiB + 64 * KiB  , WS_KC = 113 * MiB, WS_VC = 113 * MiB + 512 * KiB, WS_DLSE = 114 * MiB, WS_DOG = 116 * MiB;
constexpr size_t WS_H = 164 * MiB, WS_OCAT = 292 * MiB, WS_QM = 404 * MiB, WS_KVM = 468 * MiB, WS_P = 532 * MiB;
constexpr size_t WS_MERGED = 532 * MiB, WS_MSCR = 660 * MiB, WS_Y = 164 * MiB  , WS_H2 = 756 * MiB, WS_ACT = 164 * MiB  , WS_HB = 532 * MiB  , WS_Y2 = 884 * MiB  , WS_X3 = 620 * MiB  , WS_END = 1024 * MiB;
constexpr size_t MSCR_PER_WG = 512 * KiB;
constexpr size_t WS_CWS = 3 * MiB + 256 * KiB;
constexpr size_t H8_OFF = 128 * MiB;
static_assert(WS_WT + 2 * LW <= WS_SIDE && WS_DOG + 48 * MiB <= WS_H && WS_P + 384 * MiB <= WS_END && WS_MSCR + 256 * MSCR_PER_WG <= WS_P + 384 * MiB && WS_H2 + 128 * MiB <= WS_Y2 && WS_Y2 + 128 * MiB <= WS_END, "ws map");
static_assert(WS_ACT + 352 * MiB <= WS_HB && WS_HB + 88 * MiB <= WS_X3 && WS_X3 + 128 * MiB <= WS_H2 && WS_Y + 128 * MiB <= WS_OCAT, "ws overlays");
constexpr int CW_BAR = 4096;
constexpr int CW_KMAX = 24576;
constexpr int CW_KMLA = 24832;
constexpr int CW_KROT = 25344;
constexpr int CW_KCMX = 25856;
constexpr int CW_QNSA = 25792;
constexpr int CW_KNSA = 25664;
constexpr int CW_Q = 16384;

constexpr int RING_BYTES = 131072, LDSCTL_OFF = RING_BYTES, MISC_OFF = LDSCTL_OFF + 320, LDS_BYTES = 147456;
constexpr int NSA_SLAB = 49152, NSA_SLAB_BYTES = 4 * 64 * 65 * 4, NSA_SEL = NSA_SLAB + NSA_SLAB_BYTES;
static_assert(NSA_SEL + 512 <= RING_BYTES && 4 * NSA_TL * 4 <= NSA_SLAB_BYTES && 2 * TB_SIZE <= NSA_SLAB, "NSA LDS map");

struct Frame {
    LAS unsigned char* lds; volatile LAS unsigned* MISC; gu32* ctl;
    int tid, lane, wave, G;
    const float* in[27]; float* out; unsigned char* ws;
};
#define WSP(T, off) ((T*)(F.ws + (off)))
#define VM_WAIT() asm volatile("s_waitcnt vmcnt(0)" ::: "memory")
#define LDS_WAIT() asm volatile("s_waitcnt lgkmcnt(0)" ::: "memory")

__device__ __forceinline__ int queue_grab(Frame& F, gu32* ctr) {
    if (F.tid == 0) F.MISC[0] = __hip_atomic_fetch_add(ctr, 1u, __ATOMIC_RELAXED, __HIP_MEMORY_SCOPE_AGENT);
    __syncthreads();
    const int v = (int)F.MISC[0];
    __syncthreads();
    return v;
}

template <bool FOX> __device__ __forceinline__ void causal_unit(Frame& F, int b, int h, int qb, float kmax_in) {
    constexpr int NKS = FOX ? 4 : 6;
    int lane_o = lane_now();
    const int wid = F.wave, lane = lane_o, r32 = lane & 31, hi = lane >> 5;
    const size_t rowbase = (size_t)b * SEQ;
    const int q0 = qb * 256, tq = q0 + wid * 32 + r32, NT = qb * 4 + 4;
    const bf16_t* P = WSP(const bf16_t, WS_P);
    const bf16_t *Kb, *Vb, *Qrow; int kpitch, vpitch;
    const bf16_t* Kr = WSP(const bf16_t, WS_KROT) + rowbase * 32;
    const float* kbsrc = WSP(const float, WS_KB) + (size_t)(b * 4 + h) * SEQ;
    if (FOX) { Kb = P + rowbase * PW + PC_CK + h * 64; Vb = P + rowbase * PW + PC_CV + h * 64; kpitch = PW; vpitch = PW; Qrow = P + (rowbase + tq) * PW + PC_CQ + h * 64; }
    else { const bf16_t* KV = WSP(const bf16_t, WS_KVM) + rowbase * 512 + h * 128; Kb = KV; Vb = KV + 64; kpitch = 512; vpitch = 512; Qrow = WSP(const bf16_t, WS_QM) + (rowbase + tq) * 512 + h * 96; }
    bf16x8 qf[NKS];
#pragma unroll
    for (int ks = 0; ks < NKS; ++ks) qf[ks] = *(const bf16x8*)(Qrow + ks * 16 + hi * 8);
    AState st; astate_init(st);
    lds_ptr lds = (lds_ptr)F.lds;
    const int vpo = ((lane >> 4) & 1) * 32 + (lane & 3) * 8 + (4 * hi + ((lane & 15) >> 2)) * 64;
    Stg sA, sB;
#define CU_LOAD(S, t) do { S.k = *(const u32x4*)(Kb + (size_t)((t) * 64 + lane) * kpitch + wid * 8); \
        if (!FOX) { if (wid < 4) S.k2 = *(const u32x4*)(Kr + (size_t)((t) * 64 + lane) * 32 + wid * 8); } \
        S.v = *(const u32x4*)(Vb + (size_t)((t) * 64 + 16 * (wid & 3) + (lane >> 2)) * vpitch + (wid >> 2) * 32 + (lane & 3) * 8); \
        if (FOX) { if (wid == 0) S.kb = kbsrc[(t) * 64 + lane]; else if (wid == 1) S.kb = kbsrc[(t) > 0 ? (t) * 64 - 1 : 0]; } } while (0)
#define CU_WRITE(S, bofs) do { lds_ptr bp = lds + (bofs); *(LAS u32x4*)(bp + wid * 1024 + lane * 16) = S.k; \
        if (!FOX) { if (wid < 4) *(LAS u32x4*)(bp + (8 + wid) * 1024 + lane * 16) = S.k2; } \
        *(LAS u32x4*)(bp + TB_V + wid * 1024 + lane * 16) = S.v; \
        if (FOX) { if (wid == 0) *(LAS float*)(bp + TB_KB + lane * 4) = S.kb; else if (wid == 1 && lane == 0) *(LAS float*)(bp + TB_KB + 256) = S.kb; } } while (0)
    const int tq_lo = q0 + wid * 32;
    float qn = 0.f; const float kmax = kmax_in;
#pragma unroll
    for (int ks = 0; ks < NKS; ++ks)
#pragma unroll
        for (int e = 0; e < 8; ++e) { const float x = bf2f((unsigned short)qf[ks][e]); qn += x * x; }
    qn += other_half(qn, hi); qn = sqrtf(qn);
    const float bnd = qn * kmax * 1.002f + 0.05f;
    const bool fast = __all(bnd <= 50.0f);
    const float kbi = FOX ? kbsrc[tq] : 0.f;
    f32x16 cinit;
    { const float c0 = -(bnd + kbi);
#pragma unroll
      for (int r = 0; r < 16; ++r) cinit[r] = c0; }
    LAS volatile unsigned* dflag = (LAS volatile unsigned*)(lds + 4 * TB_SIZE + 64);
#define CU_TILE(T, BOFS) { const int t = (T); lds_cptr bp = (lds_cptr)(lds + (BOFS)); \
        if (64 * t <= tq_lo + 31) {                                \
            f32x16 p0, p1; \
            if (fast) qk64c<NKS>(bp, qf, r32, hi, cinit, p0, p1); \
            else { _Pragma("unroll") for (int r = 0; r < 16; ++r) { p0[r] = 0.f; p1[r] = 0.f; } qk64<NKS>(bp, qf, r32, hi, p0, p1); } \
            if (FOX) { const LAS float* kbt = (const LAS float*)(bp + TB_KB) + 4 * hi; \
                _Pragma("unroll") for (int g = 0; g < 4; ++g) { const f32x4 a = *(const LAS f32x4*)(kbt + 8 * g), c = *(const LAS f32x4*)(kbt + 32 + 8 * g); \
                    _Pragma("unroll") for (int e = 0; e < 4; ++e) { p0[4 * g + e] += a[e]; p1[4 * g + e] += c[e]; } } } \
            if (64 * t + 63 > tq_lo) mask_causal(p0, p1, 64 * t, tq, hi); \
            if (fast) softmax_fixed_pv64(p0, p1, st, bp + TB_V + vpo); else softmax_pv64(p0, p1, st, bp + TB_V + vpo, hi); \
        } }
    const int NP = NT >> 1;
#define CU_TA(p) (FOX ? NT - 1 - 2 * (p) : 2 * (p))
#define CU_TB(p) (FOX ? NT - 2 - 2 * (p) : 2 * (p) + 1)
    CU_LOAD(sA, CU_TA(0)); CU_LOAD(sB, CU_TB(0)); CU_WRITE(sA, 0); CU_WRITE(sB, TB_SIZE);
    __syncthreads();
    for (int p = 0; p < NP; ++p) {
        const int pofs = (p & 1) * 2 * TB_SIZE, nofs = ((p & 1) ^ 1) * 2 * TB_SIZE;
        if (p + 1 < NP) { CU_LOAD(sA, CU_TA(p + 1)); CU_LOAD(sB, CU_TB(p + 1)); }
        { const int ta_ = CU_TA(p), tbb_ = CU_TB(p), tmax_ = ta_ > tbb_ ? ta_ : tbb_;
          if (fast && 64 * tmax_ + 63 <= tq_lo) {
              lds_cptr bpa = (lds_cptr)(lds + pofs), bpb = (lds_cptr)(lds + pofs + TB_SIZE);
              f32x16 a0, a1, b0, b1;
              qk64c<NKS>(bpa, qf, r32, hi, cinit, a0, a1);
              qk64c<NKS>(bpb, qf, r32, hi, cinit, b0, b1);
              if (FOX) { const LAS float* ka = (const LAS float*)(bpa + TB_KB) + 4 * hi; const LAS float* kb2 = (const LAS float*)(bpb + TB_KB) + 4 * hi;
#pragma unroll
                  for (int g = 0; g < 4; ++g) { const f32x4 x = *(const LAS f32x4*)(ka + 8 * g), y = *(const LAS f32x4*)(ka + 32 + 8 * g), z = *(const LAS f32x4*)(kb2 + 8 * g), w = *(const LAS f32x4*)(kb2 + 32 + 8 * g);
#pragma unroll
                      for (int e = 0; e < 4; ++e) { a0[4 * g + e] += x[e]; a1[4 * g + e] += y[e]; b0[4 * g + e] += z[e]; b1[4 * g + e] += w[e]; } } }
              VFrag va; v_load64(va, bpa + TB_V + vpo);
              float rs = 0.f;
#pragma unroll
              for (int r = 0; r < 16; ++r) { a0[r] = fast_exp2(a0[r]); a1[r] = fast_exp2(a1[r]); rs += a0[r] + a1[r]; }
              bf16x8 pfa[4]; pack_p(a0, a1, pfa);
              pv64f(st.o0, st.o1, va, pfa);
              VFrag vb; v_load64(vb, bpb + TB_V + vpo);
#pragma unroll
              for (int r = 0; r < 16; ++r) { b0[r] = fast_exp2(b0[r]); b1[r] = fast_exp2(b1[r]); rs += b0[r] + b1[r]; }
              st.l += rs;
              bf16x8 pfb[4]; pack_p(b0, b1, pfb);
              pv64f(st.o0, st.o1, vb, pfb);
          } else {
              CU_TILE(ta_, pofs)
              CU_TILE(tbb_, pofs + TB_SIZE)
          } }
        const int tb_ = CU_TB(p);
        if (FOX) { if (tb_ > 0) { const float kb_last = *(const LAS float*)(lds + pofs + TB_SIZE + TB_KB + 256); const bool done = fast ? ((kb_last - kbi) < -150.0f) : ((qn * kmax + kb_last - st.m) < -130.0f); const unsigned alld = __all(done) ? 1u : 0u; if (lane == 0) dflag[(p & 1) * 8 + wid] = alld; } }
        if (p + 1 < NP) { CU_WRITE(sA, nofs); CU_WRITE(sB, nofs + TB_SIZE); }
        __syncthreads();
        if (FOX) { if (tb_ > 0) { unsigned all = 1u;
#pragma unroll
                for (int w = 0; w < 8; ++w) all &= dflag[(p & 1) * 8 + w];
                if (all) break; } }
    }
#undef CU_TA
#undef CU_TB
#undef CU_TILE
#undef CU_LOAD
#undef CU_WRITE
    bf16_t* obase = WSP(bf16_t, WS_OCAT) + (rowbase + tq_lo) * OCW + (FOX ? 384 : 640) + h * 64;
    const float ltot = fast ? st.l + other_half(st.l, hi) : st.l;
    store_o_staged(lds, wid, lane, st.o0, st.o1, 1.0f / ltot, [&](int r) { return obase + (size_t)r * OCW; });
}
template <bool FAST> __device__ __forceinline__ void nsa_unit(Frame& F, int b, int qblk, int l) {
    int lane_o = lane_now();
    const int wid = F.wave, lane = lane_o, r32 = lane & 31, hi = lane >> 5, tid = wid * 64 + lane;
    const int h = wid & 3, qs = wid >> 2;
    const int q0 = qblk * 64, cur = qblk, tq = q0 + 32 * qs + r32, tq_lo = q0 + 32 * qs;
    const size_t rowbase = (size_t)b * SEQ, row = rowbase + tq;
    const bf16_t* P = WSP(const bf16_t, WS_P);
    lds_ptr lds = (lds_ptr)F.lds;
    const int vpo = ((lane >> 4) & 1) * 32 + (lane & 3) * 8 + (4 * hi + ((lane & 15) >> 2)) * 64;
    bf16x8 qf[4];
    { const bf16_t* Qrow = P + row * PW + PC_AQ + h * 64;
#pragma unroll
      for (int ks = 0; ks < 4; ++ks) qf[ks] = *(const bf16x8*)(Qrow + ks * 16 + hi * 8); }
    Stg s; int ln;
#define NS_LOAD(Kb, kp, Vb, vp_, t) do { s.k = *(const u32x4*)((Kb) + (size_t)((t) * 64 + ln) * (kp) + wid * 8); \
        s.v = *(const u32x4*)((Vb) + (size_t)((t) * 64 + 16 * (wid & 3) + (ln >> 2)) * (vp_) + (wid >> 2) * 32 + (ln & 3) * 8); } while (0)
#define NS_FRESH() do { ln = lane; asm volatile("" : "+v"(ln)); } while (0)
#define NS_WRITE(bi) do { lds_ptr bp_ = lds + (bi) * TB_SIZE; *(LAS u32x4*)(bp_ + wid * 1024 + lane * 16) = s.k; *(LAS u32x4*)(bp_ + TB_V + wid * 1024 + lane * 16) = s.v; } while (0)
    const bf16_t* KC = WSP(const bf16_t, WS_KC) + (size_t)b * 256 * 64; const bf16_t* VC = WSP(const bf16_t, WS_VC) + (size_t)b * 256 * 64;
    const int cmax_u = (q0 + 63 - 31) >> 4, NTc = (cmax_u >> 6) + 1;
    const int cmax = (tq - 31) >> 4;
    float cm = NEG_INF, cl = 0.f;
    if constexpr (!FAST) {
    NS_FRESH(); NS_LOAD(KC, 64, VC, 64, 0); NS_WRITE(0);
    __syncthreads();
    for (int t = 0; t < NTc; ++t) {
        const int bi = t & 1;
        if (t + 1 < NTc) NS_LOAD(KC, 64, VC, 64, t + 1);
        { lds_cptr bp = (lds_cptr)(lds + bi * TB_SIZE); f32x16 p0, p1;
#pragma unroll
          for (int r = 0; r < 16; ++r) { p0[r] = 0.f; p1[r] = 0.f; }
          qk64<4>(bp, qf, r32, hi, p0, p1);
          float mx = NEG_INF;
#pragma unroll
          for (int r = 0; r < 16; ++r) { const int c = 64 * t + crow(r, hi); if (c > cmax) p0[r] = NEG_INF; if (c + 32 > cmax) p1[r] = NEG_INF; mx = fmaxf(mx, fmaxf(p0[r], p1[r])); }
          mx = fmaxf(mx, other_half(mx, hi));
          const float mn = fmaxf(cm, mx), ms = (mn == NEG_INF) ? 0.f : mn; float rs = 0.f;
#pragma unroll
          for (int r = 0; r < 16; ++r) rs += fast_exp2(p0[r] - ms) + fast_exp2(p1[r] - ms);
          rs += other_half(rs, hi);
          cl = cl * fast_exp2(cm - ms) + rs; cm = mn; }
        if (t + 1 < NTc) NS_WRITE(bi ^ 1);
        __syncthreads();
    }
    }
    const float cms = (cm == NEG_INF) ? 0.f : cm; float cinv = FAST ? 1.0f : 1.0f / fmaxf(cl, 1e-30f);
    f32x16 oc0, oc1;
#pragma unroll
    for (int r = 0; r < 16; ++r) { oc0[r] = 0.f; oc1[r] = 0.f; }
    float G[32]; float carry = 0.f;
#pragma unroll
    for (int i = 0; i < 32; ++i) G[i] = 0.f;
    NS_FRESH(); NS_LOAD(KC, 64, VC, 64, 0); NS_WRITE(0);
    __syncthreads();
#pragma unroll
    for (int t = 0; t < 4; ++t) {
        if (t < NTc) {
            const int bi = t & 1;
            if (t + 1 < NTc) NS_LOAD(KC, 64, VC, 64, t + 1);
            { lds_cptr bp = (lds_cptr)(lds + bi * TB_SIZE); f32x16 p0, p1;
#pragma unroll
              for (int r = 0; r < 16; ++r) { p0[r] = 0.f; p1[r] = 0.f; }
              qk64<4>(bp, qf, r32, hi, p0, p1);
#pragma unroll
              for (int r = 0; r < 16; ++r) { const int c = 64 * t + crow(r, hi);
                  if constexpr (FAST) { p0[r] = (c > cmax) ? 0.f : fast_exp2(p0[r]); p1[r] = (c + 32 > cmax) ? 0.f : fast_exp2(p1[r]); cl += p0[r] + p1[r]; }
                  else { p0[r] = (c > cmax) ? 0.f : fast_exp2(p0[r] - cms) * cinv; p1[r] = (c + 32 > cmax) ? 0.f : fast_exp2(p1[r] - cms) * cinv; } }
#pragma unroll
              for (int g = 0; g < 4; ++g) { const float oth = other_half(p0[4 * g + 3], hi);
                  G[t * 8 + g] = ((p0[4 * g] + p0[4 * g + 1]) + (p0[4 * g + 2] + p0[4 * g + 3])) + (hi ? oth : carry); carry = oth; }
#pragma unroll
              for (int g = 0; g < 4; ++g) { const float oth = other_half(p1[4 * g + 3], hi);
                  G[t * 8 + 4 + g] = ((p1[4 * g] + p1[4 * g + 1]) + (p1[4 * g + 2] + p1[4 * g + 3])) + (hi ? oth : carry); carry = oth; }
              bf16x8 pf[4]; pack_p(p0, p1, pf);
              pv64(oc0, oc1, bp + TB_V + vpo, pf); }
            if (t + 1 < NTc) NS_WRITE(bi ^ 1);
            __syncthreads();
        }
    }
    if constexpr (FAST) {
        cl += other_half(cl, hi); cinv = 1.0f / fmaxf(cl, 1e-30f);
#pragma unroll
        for (int i = 0; i < 32; ++i) G[i] *= cinv;
#pragma unroll
        for (int r = 0; r < 16; ++r) { oc0[r] *= cinv; oc1[r] *= cinv; } }
    { LAS float* slab = (LAS float*)(lds + NSA_SLAB) + (size_t)(h * 64 + 32 * qs + r32) * 65;
#pragma unroll
      for (int i = 0; i < 32; ++i) slab[2 * i + hi] = G[i]; }
    __syncthreads();
    u32x4 tbr[4]; { const u32x4* src = WSP(const u32x4, WS_NSATAB);
#pragma unroll
      for (int i = 0; i < 4; ++i) { const int idx = tid + 512 * i; tbr[i] = (idx < 4 * NSA_TL / 4) ? src[idx] : (u32x4){0u, 0u, 0u, 0u}; } }
    { const int q = tid >> 3, jg = tid & 7;
      LAS float* s0 = (LAS float*)(lds + NSA_SLAB) + (size_t)q * 65;
      float xs[8];
#pragma unroll
      for (int e = 0; e < 8; ++e) { const int j = 8 * jg + e; xs[e] = (s0[j] + s0[64 * 65 + j]) + (s0[2 * 64 * 65 + j] + s0[3 * 64 * 65 + j]); }
#pragma unroll
      for (int e = 0; e < 8; ++e) s0[8 * jg + e] = xs[e];
      asm volatile("s_waitcnt lgkmcnt(0)" ::: "memory");
      float v[64];
#pragma unroll
      for (int k = 0; k < 64; ++k) { const float x = s0[k];
          v[k] = (k == 0 || k == cur || k == cur - 1) ? 1e9f : ((k > cur) ? -1e9f : x); if ((k & 7) == 7) asm volatile("" ::: "memory"); }
      unsigned bits = 0u;
#pragma unroll
      for (int e = 0; e < 8; ++e) { const int j = 8 * jg + e;
          const float xj = xs[e];
          const float vj = (j == 0 || j == cur || j == cur - 1) ? 1e9f : ((j > cur) ? -1e9f : xj);
          int rank = 0;
#pragma unroll
          for (int k = 0; k < 64; ++k) rank += (v[k] > vj || (v[k] == vj && k < j)) ? 1 : 0;
          bits |= (rank < 16 ? 1u : 0u) << e; }
      *((LAS unsigned char*)(lds + NSA_SEL) + q * 8 + jg) = (unsigned char)bits; }
    __syncthreads();
    const unsigned mlo = *(const LAS unsigned*)(lds + NSA_SEL + (32 * qs + r32) * 8), mhi = *(const LAS unsigned*)(lds + NSA_SEL + (32 * qs + r32) * 8 + 4);
    { LAS u32x4* dst = (LAS u32x4*)(lds + NSA_SLAB);
#pragma unroll
      for (int i = 0; i < 4; ++i) { const int idx = tid + 512 * i; if (idx < 4 * NSA_TL / 4) dst[idx] = tbr[i]; } }
    const LAS float* tabh = (const LAS float*)(lds + NSA_SLAB) + h * NSA_TL;
    AState st; astate_init(st);
    { const bf16_t* Kb = P + rowbase * PW + PC_KSLC; const bf16_t* Vb = P + rowbase * PW + PC_VSLC;
      NS_FRESH(); NS_LOAD(Kb, PW, Vb, PW, 0); NS_WRITE(0);
      __syncthreads();
      for (int j = 0; j <= cur; ++j) {
          const int bi = j & 1;
          if (j < cur) NS_LOAD(Kb, PW, Vb, PW, j + 1);
          const bool mine = ((j < 32) ? (mlo >> j) : (mhi >> (j - 32))) & 1u;
          if (__any(mine)) {
              lds_cptr bp = (lds_cptr)(lds + bi * TB_SIZE); f32x16 p0, p1;
#pragma unroll
              for (int r = 0; r < 16; ++r) { p0[r] = 0.f; p1[r] = 0.f; }
              qk64<4>(bp, qf, r32, hi, p0, p1);
              const bool farj = (q0 - 64 * j - 63 >= NSA_DFAR);
              if constexpr (FAST) {
                  if (!farj) add_table(p0, p1, tabh + (NSA_DMAX - tq + 64 * j + 4 * hi));
                  if (j == cur) mask_causal(p0, p1, 64 * j, tq, hi);
                  softmax_raw_pv64<true>(p0, p1, st, bp + TB_V + vpo, mine);
              } else {
                  if (!farj) add_table(p0, p1, tabh + (NSA_DMAX - tq + 64 * j + 4 * hi));
                  if (j == cur) mask_causal(p0, p1, 64 * j, tq, hi);
                  if (!mine) {
#pragma unroll
                      for (int r = 0; r < 16; ++r) { p0[r] = NEG_INF; p1[r] = NEG_INF; } }
                  softmax_pv64<false>(p0, p1, st, bp + TB_V + vpo, hi);
              }
          }
          if (j < cur) NS_WRITE(bi ^ 1);
          __syncthreads();
      } }
    f32x16 oa0, oa1;
    { int rw_ = (int)row; asm volatile("" : "+v"(rw_)); const float* sd = WSP(const float, WS_SIDE) + (size_t)rw_ * 16 + h * 3;
      const float g0 = sigmoid_f(sd[0]), sc = sigmoid_f(sd[1]) / (FAST ? st.l + other_half(st.l, hi) : st.l);
#pragma unroll
      for (int r = 0; r < 16; ++r) { oa0[r] = g0 * oc0[r] + sc * st.o0[r]; oa1[r] = g0 * oc1[r] + sc * st.o1[r]; } }
    astate_init(st);
    { const bf16_t* Kb = P + rowbase * PW + PC_KWIN; const bf16_t* Vb = P + rowbase * PW + PC_VWIN;
      const int jlo = cur >= 8 ? cur - 8 : 0;
      NS_FRESH(); NS_LOAD(Kb, PW, Vb, PW, jlo); NS_WRITE(0);
      __syncthreads();
      for (int j = jlo; j <= cur; ++j) {
          const int bi = (j - jlo) & 1;
          if (j < cur) NS_LOAD(Kb, PW, Vb, PW, j + 1);
          if (tq_lo - 64 * j - 63 < 512) {
              lds_cptr bp = (lds_cptr)(lds + bi * TB_SIZE); f32x16 p0, p1;
#pragma unroll
              for (int r = 0; r < 16; ++r) { p0[r] = 0.f; p1[r] = 0.f; }
              qk64<4>(bp, qf, r32, hi, p0, p1);
              add_table(p0, p1, tabh + (NSA_DMAX - tq + 64 * j + 4 * hi));
              if (!(tq_lo - 64 * j - 63 >= 0 && tq_lo + 31 - 64 * j < 512)) {
                  const int d0 = tq - 64 * j - 4 * hi;
#pragma unroll
                  for (int r = 0; r < 16; ++r) { const int d = d0 - ((r & 3) + 8 * (r >> 2)); if (d < 0 || d >= 512) p0[r] = NEG_INF; if (d - 32 < 0 || d - 32 >= 512) p1[r] = NEG_INF; }
              }
              if constexpr (FAST) softmax_raw_pv64<false>(p0, p1, st, bp + TB_V + vpo, true); else softmax_pv64<false>(p0, p1, st, bp + TB_V + vpo, hi);
          }
          if (j < cur) NS_WRITE(bi ^ 1);
          __syncthreads();
      } }
    { int rw_ = (int)row; asm volatile("" : "+v"(rw_)); const float sc = sigmoid_f(WSP(const float, WS_SIDE)[(size_t)rw_ * 16 + h * 3 + 2]) / (FAST ? st.l + other_half(st.l, hi) : st.l);
#pragma unroll
      for (int r = 0; r < 16; ++r) { oa0[r] += sc * st.o0[r]; oa1[r] += sc * st.o1[r]; } }
    { int tl_ = tq_lo; asm volatile("" : "+s"(tl_)); bf16_t* obase = WSP(bf16_t, WS_OCAT) + (rowbase + tl_) * OCW + h * 64;
      store_o_staged(lds, wid, lane, oa0, oa1, 1.0f, [&](int r) { return obase + (size_t)r * OCW; }); }
#undef NS_LOAD
#undef NS_FRESH
#undef NS_WRITE
}
__device__ __forceinline__ void dil_unit(Frame& F, int b, int hh, int span) {
    int lane_o = lane_now();
    const int wid = F.wave, lane = lane_o, r32 = lane & 31, hi = lane >> 5, tid = wid * 64 + lane;
    const int T0 = span * 512;
    const size_t rowbase = (size_t)b * SEQ;
    const bf16_t* P = WSP(const bf16_t, WS_P) + rowbase * PW;
    lds_ptr lds = (lds_ptr)F.lds;
    LAS float* dtab = (LAS float*)(lds + 32768);
    for (int i = tid; i < 3 * 192; i += 512) dtab[i] = WSP(const float, WS_DILTAB)[((i / 192) * 2 + hh) * 192 + (i % 192)];
    __syncthreads();
    lds_ptr vst = lds + wid * 4096;
    const int vpo = ((lane >> 4) & 1) * 32 + (lane & 3) * 8 + (4 * hi + ((lane & 15) >> 2)) * 64;
    bf16_t* DOG = WSP(bf16_t, WS_DOG); float* DLSE = WSP(float, WS_DLSE);
    for (int g = 0; g < 3; ++g) {
        const int sh = 2 * g, head = 2 * g + hh;
        for (int rep = 0; rep < 2; ++rep) {
            const int wt = wid + 8 * rep;
            const int res = (g == 0) ? 0 : (g == 1 ? (wt & 3) : wt);
            const int i0 = (g == 0) ? 32 * wt : (g == 1 ? 32 * (wt >> 2) : 0);
            const int n0 = (T0 >> sh) + i0;
            const int tokq = res + ((n0 + r32) << sh);
            bf16x8 qf[4];
            { const bf16_t* Qrow = P + (size_t)tokq * PW + PC_BQ + head * 64;
#pragma unroll
              for (int ks = 0; ks < 4; ++ks) qf[ks] = *(const bf16x8*)(Qrow + ks * 16 + hi * 8); }
            f32x16 o0, o1; float m = NEG_INF, l = 0.f;
#pragma unroll
            for (int r = 0; r < 16; ++r) { o0[r] = 0.f; o1[r] = 0.f; }
#define DIL_LOAD(cc, KF, VR) do { const int nk0_ = n0 - 128 + 32 * (cc); int nk_ = nk0_ + r32; nk_ = nk_ < 0 ? 0 : nk_; const bf16_t* Krow_ = P + (size_t)(res + (nk_ << sh)) * PW + PC_BK + head * 64; \
        _Pragma("unroll") for (int ks = 0; ks < 4; ++ks) KF[ks] = *(const bf16x8*)(Krow_ + ks * 16 + hi * 8); \
        _Pragma("unroll") for (int i = 0; i < 4; ++i) { const int pc_ = lane + 64 * i, vrow_ = pc_ >> 3, c16_ = pc_ & 7; int nv_ = nk0_ + vrow_; nv_ = nv_ < 0 ? 0 : nv_; \
            VR[i] = *(const u32x4*)(P + (size_t)(res + (nv_ << sh)) * PW + PC_BV + head * 64 + c16_ * 8); } } while (0)
            int cfirst = 0; while (cfirst < 4 && n0 - 128 + 32 * cfirst + 31 < 0) ++cfirst;
            bf16x8 kfn[4]; u32x4 vrn[4];
            DIL_LOAD(cfirst, kfn, vrn);
            for (int c = cfirst; c < 5; ++c) {
                const int nk0 = n0 - 128 + 32 * c;
                { bf16x8 kf[4]; u32x4 vr[4];
#pragma unroll
                  for (int i = 0; i < 4; ++i) { kf[i] = kfn[i]; vr[i] = vrn[i]; }
                  if (c < 4) DIL_LOAD(c + 1, kfn, vrn);
#pragma unroll
                  for (int i = 0; i < 4; ++i) { const int pc = lane + 64 * i, vrow = pc >> 3, c16 = pc & 7;
                      *(LAS u32x4*)(vst + (c16 >> 2) * 2048 + vrow * 64 + (c16 & 3) * 16) = vr[i]; }
                  asm volatile("s_waitcnt lgkmcnt(0)" ::: "memory");
                  f32x16 p;
#pragma unroll
                  for (int r = 0; r < 16; ++r) p[r] = 0.f;
#pragma unroll
                  for (int ks = 0; ks < 4; ++ks) p = MFMA32(kf[ks], qf[ks], p);
                  const LAS float* tb = dtab + g * 192 + (32 - r32 + 4 * hi + 32 * c);
                  float mx = NEG_INF;
#pragma unroll
                  for (int r = 0; r < 16; ++r) { const int o = (r & 3) + 8 * (r >> 2), kk = o + 4 * hi, j = 128 + r32 - 32 * c - kk;
                      const bool ok = (j >= 0) && (j <= 128) && (nk0 + kk >= 0);
                      p[r] = ok ? p[r] + tb[o] : NEG_INF; mx = fmaxf(mx, p[r]); }
                  mx = fmaxf(mx, other_half(mx, hi));
                  if (__any(mx > m + 8.0f)) { const float mn = fmaxf(m, mx), msn = (mn == NEG_INF) ? 0.f : mn, alpha = fast_exp2(m - msn);
                      l *= alpha; m = mn;
#pragma unroll
                      for (int r = 0; r < 16; ++r) { o0[r] *= alpha; o1[r] *= alpha; } }
                  const float ms = (m == NEG_INF) ? 0.f : m;
                  float rs = 0.f;
#pragma unroll
                  for (int r = 0; r < 16; ++r) { p[r] = fast_exp2(p[r] - ms); rs += p[r]; }
                  rs += other_half(rs, hi);
                  l += rs;
                  u32x4 w0, w1;
                  w0.x = cvtpk(p[0], p[1]); w0.y = cvtpk(p[2], p[3]); w0.z = cvtpk(p[4], p[5]); w0.w = cvtpk(p[6], p[7]);
                  w1.x = cvtpk(p[8], p[9]); w1.y = cvtpk(p[10], p[11]); w1.z = cvtpk(p[12], p[13]); w1.w = cvtpk(p[14], p[15]);
                  const bf16x8 pf0 = __builtin_bit_cast(bf16x8, w0), pf1 = __builtin_bit_cast(bf16x8, w1);
                  lds_cptr vp = (lds_cptr)(vst + vpo);
#pragma unroll
                  for (int ks = 0; ks < 2; ++ks) {
                      const s16x4 l0 = vtr(vp + ks * 1024), h0 = vtr(vp + ks * 1024 + 512), l1 = vtr(vp + 2048 + ks * 1024), h1 = vtr(vp + 2048 + ks * 1024 + 512);
                      const bf16x8 v0 = (bf16x8){l0[0], l0[1], l0[2], l0[3], h0[0], h0[1], h0[2], h0[3]}, v1 = (bf16x8){l1[0], l1[1], l1[2], l1[3], h1[0], h1[1], h1[2], h1[3]};
                      o0 = MFMA32(v0, ks == 0 ? pf0 : pf1, o0); o1 = MFMA32(v1, ks == 0 ? pf0 : pf1, o1);
                  }
                  asm volatile("s_waitcnt lgkmcnt(0)" ::: "memory"); }
            }
#undef DIL_LOAD
            const size_t orow = rowbase + tokq;
            store_o_staged(lds, wid, lane, o0, o1, 1.0f / l, [&](int r) { return DOG + ((size_t)g * M + rowbase + (size_t)(res + ((n0 + r) << sh))) * 128 + hh * 64; });
            if (hi == 0) DLSE[((size_t)g * M + orow) * 2 + hh] = m + log2f(l);
        }
    }
    VM_WAIT();
    __syncthreads();
    bf16_t* OC = WSP(bf16_t, WS_OCAT);
    for (int it = 0; it < 8; ++it) {
        const int item = tid + 512 * it, tl = item >> 3, pc = item & 7; const size_t orow = rowbase + T0 + tl;
        const float l0 = DLSE[((size_t)0 * M + orow) * 2 + hh], l1 = DLSE[((size_t)1 * M + orow) * 2 + hh], l2 = DLSE[((size_t)2 * M + orow) * 2 + hh];
        const float mx = fmaxf(l0, fmaxf(l1, l2)); float w0 = fast_exp2(l0 - mx), w1 = fast_exp2(l1 - mx), w2 = fast_exp2(l2 - mx);
        const float inv = 1.0f / (w0 + w1 + w2); w0 *= inv; w1 *= inv; w2 *= inv;
        const u32x4 a = *(const u32x4*)(DOG + ((size_t)0 * M + orow) * 128 + hh * 64 + pc * 8), bb = *(const u32x4*)(DOG + ((size_t)1 * M + orow) * 128 + hh * 64 + pc * 8),
                    cc = *(const u32x4*)(DOG + ((size_t)2 * M + orow) * 128 + hh * 64 + pc * 8);
        u32x4 w;
#pragma unroll
        for (int e = 0; e < 4; ++e) {
            const float lo = w0 * __uint_as_float(a[e] << 16) + w1 * __uint_as_float(bb[e] << 16) + w2 * __uint_as_float(cc[e] << 16);
            const float hv = w0 * __uint_as_float(a[e] & 0xffff0000u) + w1 * __uint_as_float(bb[e] & 0xffff0000u) + w2 * __uint_as_float(cc[e] & 0xffff0000u);
            w[e] = cvtpk(lo, hv); }
        *(u32x4*)(OC + orow * OCW + 256 + hh * 64 + pc * 8) = w;
    }
    __syncthreads();
}
__device__ __forceinline__ float wave_sum(float v) {
    v += xor_lane_lt32<1>(v); v += xor_lane_lt32<2>(v); v += xor_lane_lt32<4>(v); v += xor_lane_lt32<8>(v); v += xor_lane_lt32<16>(v);
    return sum_halves(v);
}
__device__ __forceinline__ int rel_bucket(int dist) {
    if (dist < 0) dist = 0;
    if (dist < 16) return dist;
    const int thr[15] = {22, 30, 40, 54, 73, 99, 134, 182, 246, 332, 450, 609, 825, 1117, 1513};
    int bkt = 16;
#pragma unroll
    for (int i = 0; i < 15; ++i) bkt += (dist >= thr[i]) ? 1 : 0;
    return bkt;
}
__device__ __forceinline__ int inproj_src(int c, float& sc) {
    sc = 1.f;
    if (c < 256) { sc = C2A; return c; }
    if (c < 652) return c;
    if (c < 656) return 2572 + (c - 652);
    if (c < 672) return -1;
    if (c < 704) { const int p = c - 672; return 2960 + (p >> 1) + 16 * (p & 1); }
    if (c < 768) return -1;
    if (c < 1920) { const int r = c - 768; if (r < 384) sc = C2A; return 652 + r; }
    if (c < 2048) return 2832 + (c - 1920);
    if (c < 2816) { const int r = c - 2048; if (r < 256) sc = C2A; return 1804 + r; }
    return 2576 + (c - 2816);
}
__device__ __forceinline__ int quq_src(int r, float& sc) {
    sc = C2D;
    if (r >= 384) return -1;
    const int hd = r / 96, w = r % 96;
    if (w < 64) return hd * 96 + w;
    const int p = w - 64; return hd * 96 + 64 + (p >> 1) + 16 * (p & 1);
}
__device__ __forceinline__ int gateperm_src(int r) {
    const int T = r >> 8, c = r & 255, pn = T >> 2, j = T & 3, bj = c >> 7, wc = (c >> 5) & 3, fq = (c >> 3) & 3, n = (c >> 2) & 1, e = c & 3;
    return (2 * bj + n) * DM * DM + 256 * pn + 64 * j + 16 * wc + 4 * fq + e;
}
__device__ __forceinline__ int branchperm_src(int r) {
    const int pn = r >> 8, c = r & 255, bj = c >> 7, wc = (c >> 5) & 3, fq = (c >> 3) & 3, n = (c >> 2) & 1, e = c & 3;
    return 256 * pn + 64 * (2 * bj + n) + 16 * wc + 4 * fq + e;
}
__device__ __forceinline__ int upperm_src(int r) { const int pn = r >> 8, c = r & 255; return (c & 128) ? DFF + 128 * pn + (c & 127) : 128 * pn + c; }
__device__ __forceinline__ void wconv_item(const float* W, int Nsrc, bf16_t* WT, int ldt, const float* kgain, int kind, LAS float* scr, int item, int nblk, int lane, bool f8out = false) {
    const int kb = item / nblk, nb = item % nblk, k0 = 64 * kb, n0 = 32 * nb;
    const int n = n0 + (lane & 31); float sc = 1.f; int src = n;
    if (kind == 1) src = inproj_src(n, sc); else if (kind == 2) src = quq_src(n, sc); else if (kind == 3) src = gateperm_src(n); else if (kind == 4) src = branchperm_src(n); else if (kind == 5) src = upperm_src(n);
    float wv[32];
#pragma unroll
    for (int i = 0; i < 32; ++i) { const int kk = 2 * i + (lane >> 5); wv[i] = (src >= 0) ? W[(size_t)(k0 + kk) * Nsrc + src] : 0.f; }
#pragma unroll
    for (int i = 0; i < 32; ++i) { const int kk = 2 * i + (lane >> 5); float v = wv[i] * sc; if (kgain) v *= kgain[k0 + kk]; scr[kk * 33 + (lane & 31)] = v; }
    LDS_WAIT(); asm volatile("" ::: "memory");
    if (f8out) {
        const int nn = lane >> 1, hh = lane & 1; const LAS float* s = scr + (32 * hh) * 33 + nn; unsigned char* dst = (unsigned char*)WT + (size_t)(n0 + nn) * ldt + k0 + 32 * hh;
#pragma unroll
        for (int j = 0; j < 2; ++j) { u32x4 o;
#pragma unroll
            for (int e = 0; e < 4; ++e) { const LAS float* q = s + (16 * j + 4 * e) * 33; o[e] = pk4_fp8(q[0] * WG8_SCALE, q[33] * WG8_SCALE, q[66] * WG8_SCALE, q[99] * WG8_SCALE); }
            *(u32x4*)(dst + 16 * j) = o; }
        LDS_WAIT(); asm volatile("" ::: "memory");
        return;
    }
    const int c = lane & 7;
#pragma unroll
    for (int j = 0; j < 4; ++j) { const int nn = (lane >> 3) + 8 * j; const LAS float* s = scr + (8 * c) * 33 + nn;
        u32x4 o; o.x = pk2(s[0 * 33], s[1 * 33]); o.y = pk2(s[2 * 33], s[3 * 33]); o.z = pk2(s[4 * 33], s[5 * 33]); o.w = pk2(s[6 * 33], s[7 * 33]);
        *(u32x4*)(WT + (size_t)(n0 + nn) * ldt + k0 + 8 * c) = o; }
    LDS_WAIT(); asm volatile("" ::: "memory");
}
constexpr int ATT_UNITS = 3328;
__device__ __forceinline__ int att_cost(int id) {
    if (id < 2048) { const int qb = 15 - (id >> 7), mla = (id >> 6) & 1; return (mla ? 5 : 4) * (qb + 1); }
    if (id < 3072) return (63 - ((id - 2048) >> 4)) + 20;
    return 30;
}
__device__ __forceinline__ int clampi(int x, int lo, int hi) { return x < lo ? lo : (x > hi ? hi : x); }
__device__ __forceinline__ int att_rank(int i) {
    const int c = att_cost(i);
    int r = clampi(16 - c / 4, 0, 16) * 64 + clampi(16 - c / 5, 0, 16) * 64 + clampi(83 - c, 0, 64) * 16 + (c < 30 ? 256 : 0);
    if (c % 4 == 0 && c / 4 >= 1 && c / 4 <= 16) r += clampi(i - (16 - c / 4) * 128, 0, 64);
    if (c % 5 == 0 && c / 5 >= 1 && c / 5 <= 16) r += clampi(i - ((16 - c / 5) * 128 + 64), 0, 64);
    if (c >= 20 && c <= 83) r += clampi(i - (2048 + (63 - (c - 20)) * 16), 0, 16);
    if (c == 30) r += clampi(i - 3072, 0, 256);
    return r;
}
__device__ __forceinline__ void p0_prologue(Frame& F) {
    LAS float* scr = (LAS float*)(F.lds + F.wave * 16384);
    const int gw = blockIdx.x * 8 + F.wave, NGW = F.G * 8, lane = F.lane;
    constexpr int I_IN = 16 * 96, I_G = 16 * 32, I_BA = 4 * 32, I_BB = 2 * 32, I_O = 16 * 32, I_UP = 16 * 176, I_DN = 44 * 32, I_UQ = 4 * 16, I_UKV = 2 * 16, I_PHI = 32 * 4;
    constexpr int I_L = I_IN + 4 * I_G + 3 * I_BA + I_BB + I_O + I_UP + I_DN + I_UQ + I_UKV + 2 * I_PHI;
    for (int it = gw; it < DEPTH * I_L; it += NGW) {
        const int l = it / I_L; int r = it % I_L;
        unsigned char* wl = F.ws + WS_WT + (size_t)l * LW;
        if (r < I_IN) { wconv_item(F.in[6] + (size_t)l * DM * DIN, DIN, (bf16_t*)(wl + LW_IN), DM, nullptr, 1, scr, r, 96, lane); continue; } r -= I_IN;
        if (r < 4 * I_G) { wconv_item(F.in[21] + (size_t)l * 4 * DM * DM, DM, (bf16_t*)(wl + LW_G), DM, nullptr, 3, scr, r, 128, lane, true); continue; } r -= 4 * I_G;
        if (r < I_BA) { wconv_item(F.in[17] + (size_t)l * 256 * DM, DM, (bf16_t*)(wl + LW_BR + BR_A), 256, nullptr, 4, scr, r, 32, lane); continue; } r -= I_BA;
        if (r < I_BB) { wconv_item(F.in[18] + (size_t)l * 128 * DM, DM, (bf16_t*)(wl + LW_BR + BR_B), 128, nullptr, 4, scr, r, 32, lane); continue; } r -= I_BB;
        if (r < I_BA) { wconv_item(F.in[19] + (size_t)l * 256 * DM, DM, (bf16_t*)(wl + LW_BR + BR_C), 256, nullptr, 4, scr, r, 32, lane); continue; } r -= I_BA;
        if (r < I_BA) { wconv_item(F.in[20] + (size_t)l * 256 * DM, DM, (bf16_t*)(wl + LW_BR + BR_D), 256, nullptr, 4, scr, r, 32, lane); continue; } r -= I_BA;
        if (r < I_O) { wconv_item(F.in[22] + (size_t)l * DM * DM, DM, (bf16_t*)(wl + LW_O), DM, nullptr, 0, scr, r, 32, lane); continue; } r -= I_O;
        if (r < I_UP) { wconv_item(F.in[23] + (size_t)l * DM * DFF2, DFF2, (bf16_t*)(wl + LW_UP), DM, nullptr, 5, scr, r, 176, lane); continue; } r -= I_UP;
        if (r < I_DN) { wconv_item(F.in[26] + (size_t)l * DFF * DM, DM, (bf16_t*)(wl + LW_DN), DFF, nullptr, 0, scr, r, 32, lane); continue; } r -= I_DN;
        if (r < I_UQ) { wconv_item(F.in[15] + (size_t)l * 256 * 384, 384, (bf16_t*)(wl + LW_UQ), 256, F.in[13] + l * 256, 2, scr, r, 16, lane); continue; } r -= I_UQ;
        if (r < I_UKV) { wconv_item(F.in[16] + (size_t)l * 128 * 512, 512, (bf16_t*)(wl + LW_UKV), 128, F.in[14] + l * 128, 0, scr, r, 16, lane); continue; } r -= I_UKV;
        if (r < I_PHI) { wconv_item(F.in[8] + (size_t)l * 2048 * 128, 128, (bf16_t*)(wl + LW_PHI), 2048, nullptr, 0, scr, r, 4, lane); continue; } r -= I_PHI;
        wconv_item(F.in[10] + (size_t)l * 2048 * 128, 128, (bf16_t*)(wl + LW_PHI) + (size_t)128 * 2048, 2048, nullptr, 0, scr, r, 4, lane);
    }
    const int gt = blockIdx.x * 512 + F.tid, NGT = F.G * 512;
    const float* rel = F.in[1];
    float* rope = WSP(float, WS_ROPE);
    for (int i = gt; i < SEQ * 16; i += NGT) { const int t = i >> 4, k = i & 15; const float inv = powf(10000.0f, -(float)(2 * k) / 32.0f); const float ang = (float)t * inv;
        float sn, cs; sincosf(ang, &sn, &cs); rope[2 * i] = cs; rope[2 * i + 1] = sn; }
    float* ntab = WSP(float, WS_NSATAB);
    for (int i = gt; i < 4 * NSA_TL; i += NGT) { const int hd = i / NSA_TL, k = i % NSA_TL, dist = NSA_DMAX - k; ntab[i] = dist >= 0 ? (rel[rel_bucket(dist) * 10 + hd] - rel[31 * 10 + hd]) * LOG2E : 0.f; }
    { float* cws = WSP(float, WS_CWS);
      for (int i = gt; i < DEPTH * 4 * DFF2; i += NGT) { const int l = i / (4 * DFF2), r = i % (4 * DFF2), row = r / DFF2, col = r % DFF2;
          const float s = row < 3 ? F.in[24][(size_t)l * 3 * DFF2 + row * DFF2 + col] : F.in[25][(size_t)l * DFF2 + col];
          cws[i] = s * (col < DFF ? -LOG2E : -0.6931471805599453f); } }
    float* dtab = WSP(float, WS_DILTAB);
    for (int i = gt; i < 6 * 192; i += NGT) { const int gh = i / 192, k = i % 192, g = gh >> 1, hh = gh & 1, j = 160 - k; dtab[i] = (j >= 0 && j <= 128) ? rel[rel_bucket(j << (2 * g)) * 10 + 4 + 2 * g + hh] * LOG2E : 0.f; }
    if (gt < 4) { WSP(float, WS_FARB)[gt] = rel[31 * 10 + gt] * LOG2E; float tm = 0.f; for (int bk = 0; bk < 32; ++bk) tm = fmaxf(tm, fabsf(rel[bk * 10 + gt] - rel[31 * 10 + gt])); WSP(float, WS_FARB)[4 + gt] = tm * LOG2E; }
    if (gw < 128) { const int mi = gw >> 5, pc = gw & 31, l = mi >> 1; const float *pk1 = F.in[8], *pv1 = F.in[10]; asm volatile("" : "+s"(pk1), "+s"(pv1));
        const float* w1 = ((mi & 1) ? pv1 : pk1) + (size_t)l * 2048 * 128 + (size_t)(64 * pc) * 128 + 2 * lane; const float* cp = F.in[7] + (size_t)l * 2048 + 64 * pc;
        f32x2 a = {0.f, 0.f};
#pragma unroll 8
        for (int p = 0; p < 64; ++p) { const f32x2 w = *(const f32x2*)(w1 + (size_t)p * 128); const float cpp = cp[p]; a[0] += cpp * w[0]; a[1] += cpp * w[1]; }
        *(f32x2*)(WSP(float, WS_CMPP) + ((size_t)mi * 32 + pc) * 128 + 2 * lane) = a; }
    if (gt < ATT_UNITS) WSP(int, WS_ORDER)[att_rank(gt)] = gt;
}
__device__ __forceinline__ void cmpb_reduce(Frame& F) {
    const int i = F.tid; if (i < DEPTH * 256) { const int l = i >> 8, n = i & 255, mi = l * 2 + (n >> 7); const float* pp = WSP(const float, WS_CMPP) + (size_t)mi * 32 * 128 + (n & 127); float a = 0.f;
        for (int pc = 0; pc < 32; ++pc) a += pp[pc * 128]; WSP(float, WS_CMPB)[i] = a; }
}

template <int MODE, bool XIB, bool XOB, bool H8 = false> __device__ __forceinline__ void rowpass(Frame& F, const void* x, const bf16_t* y, size_t yrow0, void* xout, bf16_t* hout, const float* g1, const float* g2, int row_lo, int row_hi, unsigned char* h8out = nullptr) {
    int gw = blockIdx.x * 8 + F.wave; asm volatile("" : "+s"(gw));
    const int NGW = F.G * 8, lane = F.lane;
    f32x4 ga[4], gb[4];
#pragma unroll
    for (int j = 0; j < 4; ++j) { ga[j] = *(const f32x4*)(g1 + 4 * lane + 256 * j); if (MODE == 1) gb[j] = *(const f32x4*)(g2 + 4 * lane + 256 * j); }
    f32x4 xf[4], xfn[4]; u32x2 xb[4], xbn[4], yb[4], ybn[4];
#define RP_LOAD(XF, XB, YB, mm) do { if (XIB) { const u32x2* xr_ = (const u32x2*)((const bf16_t*)x + (size_t)(mm) * DM) + lane; _Pragma("unroll") for (int j = 0; j < 4; ++j) XB[j] = xr_[64 * j]; } \
        else { const f32x4* xr_ = (const f32x4*)((const float*)x + (size_t)(mm) * DM) + lane; _Pragma("unroll") for (int j = 0; j < 4; ++j) XF[j] = xr_[64 * j]; } \
        if (MODE != 0) { const u32x2* yr_ = (const u32x2*)(y + ((size_t)(mm) - yrow0) * DM) + lane; _Pragma("unroll") for (int j = 0; j < 4; ++j) YB[j] = yr_[64 * j]; } } while (0)
    int m = row_lo + gw;
    if (m < row_hi) RP_LOAD(xf, xb, yb, m);
    for (; m < row_hi; m += NGW) {
        const int mn = m + NGW;
        if (mn < row_hi) RP_LOAD(xfn, xbn, ybn, mn);
        f32x4 v[4];
#pragma unroll
        for (int j = 0; j < 4; ++j) { if (XIB) { v[j][0] = __uint_as_float(xb[j].x << 16); v[j][1] = __uint_as_float(xb[j].x & 0xffff0000u); v[j][2] = __uint_as_float(xb[j].y << 16); v[j][3] = __uint_as_float(xb[j].y & 0xffff0000u); } else v[j] = xf[j]; }
        if (MODE != 0) {
            f32x4 w[4]; float s = 0.f;
#pragma unroll
            for (int j = 0; j < 4; ++j) { const u32x2 yy = yb[j]; w[j][0] = __uint_as_float(yy.x << 16); w[j][1] = __uint_as_float(yy.x & 0xffff0000u); w[j][2] = __uint_as_float(yy.y << 16); w[j][3] = __uint_as_float(yy.y & 0xffff0000u);
                s += (w[j][0] * w[j][0] + w[j][1] * w[j][1]) + (w[j][2] * w[j][2] + w[j][3] * w[j][3]); }
            const float rstd = 1.0f / sqrtf(wave_sum(s) * (1.0f / DM) + RMS_EPS);
#pragma unroll
            for (int j = 0; j < 4; ++j) v[j] = v[j] + w[j] * rstd * ga[j];
            if (XOB) { u32x2* xo = (u32x2*)((bf16_t*)xout + (size_t)m * DM) + lane;
#pragma unroll
                for (int j = 0; j < 4; ++j) { u32x2 w2; w2.x = cvtpk(v[j][0], v[j][1]); w2.y = cvtpk(v[j][2], v[j][3]); xo[64 * j] = w2; } }
            else { f32x4* xo = (f32x4*)((float*)xout + (size_t)m * DM) + lane;
#pragma unroll
                for (int j = 0; j < 4; ++j) xo[64 * j] = v[j]; }
        }
        if (MODE != 2) {
            float s = 0.f;
#pragma unroll
            for (int j = 0; j < 4; ++j) s += (v[j][0] * v[j][0] + v[j][1] * v[j][1]) + (v[j][2] * v[j][2] + v[j][3] * v[j][3]);
            const float rstd = 1.0f / sqrtf(wave_sum(s) * (1.0f / DM) + RMS_EPS);
            u32x2* ho = (u32x2*)(hout + (size_t)m * DM) + lane;
#pragma unroll
            for (int j = 0; j < 4; ++j) { const f32x4 gg = (MODE == 1) ? gb[j] : ga[j]; const f32x4 o = v[j] * rstd * gg; u32x2 w; w.x = cvtpk(o[0], o[1]); w.y = cvtpk(o[2], o[3]); ho[64 * j] = w;
                if (H8) ((unsigned*)(h8out + (size_t)m * DM))[lane + 64 * j] = pk4_fp8(o[0] * H8_SCALE, o[1] * H8_SCALE, o[2] * H8_SCALE, o[3] * H8_SCALE); }
        }
#pragma unroll
        for (int j = 0; j < 4; ++j) { if (XIB) xb[j] = xbn[j]; else xf[j] = xfn[j]; if (MODE != 0) yb[j] = ybn[j]; }
    }
#undef RP_LOAD
}

__device__ __forceinline__ void ffn_fix_panel(Frame& F, int pm, const float* HB, bf16_t* ACT, const float* cw, const float* cb) {
#pragma unroll 2
    for (int it = F.tid; it < 4 * 2 * (DFF / 4); it += 512) {
        const int c4 = it % (DFF / 4), rr = (it / (DFF / 4)) & 1, g = pm * 4 + it / (2 * (DFF / 4)), c = c4 * 4, pn = c >> 7, cl = c & 127;
        const bool first = ((g * 64) & (SEQ - 1)) == 0;
#define HBV(gg, s, bj) (*(const f32x4*)(HB + ((size_t)(((gg) * 4 + (s)) * 22 + pn) * 256 + (bj) * 128 + cl)))
        const f32x4 z = {0.f, 0.f, 0.f, 0.f};
        const f32x4 u0g = HBV(g, 0, 0), u0v = HBV(g, 0, 1);
        f32x4 ag, bg_, cg, av, bv_, cv;
        if (rr == 0) { ag = first ? z : HBV(g - 1, 2, 0); bg_ = first ? z : HBV(g - 1, 3, 0); cg = u0g; av = first ? z : HBV(g - 1, 2, 1); bv_ = first ? z : HBV(g - 1, 3, 1); cv = u0v; }
        else { ag = first ? z : HBV(g - 1, 3, 0); bg_ = u0g; cg = HBV(g, 1, 0); av = first ? z : HBV(g - 1, 3, 1); bv_ = u0v; cv = HBV(g, 1, 1); }
#undef HBV
        const f32x4 kb = *(const f32x4*)(cb + c), k0 = *(const f32x4*)(cw + c), k1 = *(const f32x4*)(cw + DFF2 + c), k2 = *(const f32x4*)(cw + 2 * DFF2 + c);
        const f32x4 vb = *(const f32x4*)(cb + DFF + c), v0 = *(const f32x4*)(cw + DFF + c), v1 = *(const f32x4*)(cw + DFF2 + DFF + c), v2 = *(const f32x4*)(cw + 2 * DFF2 + DFF + c);
        float o[4];
#pragma unroll
        for (int e = 0; e < 4; ++e) { const float gt = kb[e] + k0[e] * ag[e] + k1[e] * bg_[e] + k2[e] * cg[e], vl = vb[e] + v0[e] * av[e] + v1[e] * bv_[e] + v2[e] * cv[e]; o[e] = gt * sigmoid_f(gt) * vl; }
        u32x2 w; w.x = cvtpk(o[0], o[1]); w.y = cvtpk(o[2], o[3]);
        *(u32x2*)(ACT + (size_t)(g * 64 + rr) * DFF + c) = w;
    }
}
struct SchedSimple {
    pg8::TileOrder T; const char* A; const char* B; int lda, ldb, nt; int dup = 0;
    __device__ __forceinline__ bool next(int i, GUnit& u) const { int pm, pn; if (!T.tile(i >> dup, pm, pn)) return false;
        u.A = A + (size_t)pm * 256 * lda; u.B = B + (size_t)pn * 256 * ldb; u.lda = lda; u.ldb = ldb; u.nt = nt; u.pm = pm; u.pn = pn; u.id = 0; return true; }
};
struct SchedCmp1 {
    int c; const char* kc; const char* vc; const char* B;
    __device__ __forceinline__ bool next(int i, GUnit& u) const { if (i > 0 || c >= 32) return false;
        u.A = (c < 16 ? kc : vc) + (size_t)(c & 15) * 256 * 2048; u.B = B; u.lda = 2048; u.ldb = 4096; u.nt = 32; u.pm = c; u.pn = 0; u.id = 0; return true; }
};
struct SchedMerge {
    pg8::TileOrder T; const char* ocat; const char* h; const char* wbr; const char* wg; int dup = 0;
    __device__ __forceinline__ bool next(int i0, GUnit& u) const { const int i = i0 >> dup; int pm, pn; if (!T.tile(i >> 3, pm, pn)) return false;
        const int sub = i & 7; u.pm = pm; u.pn = pn; u.id = sub;
        if (sub >= 4) { u.A = h + (size_t)pm * 256 * 1024; u.lda = 1024; u.B = wg + (size_t)((pn * 4 + (sub - 4)) * 256) * 1024; u.ldb = 1024; u.nt = 8; }
        else { const int br = sub; const int kk = (br == 1) ? 128 : 256; const size_t co = (br == 0) ? 0 : (br == 1 ? 256 : (br == 2 ? 384 : 640)), wo = (br == 0) ? BR_A : (br == 1 ? BR_B : (br == 2 ? BR_C : BR_D));
            u.A = ocat + (size_t)pm * 256 * (OCW * 2) + co * 2; u.lda = OCW * 2; u.B = wbr + wo + (size_t)pn * 256 * kk * 2; u.ldb = kk * 2; u.nt = kk / 64; }
        return true; }
};

#ifndef SDUP_INPROJ
#define SDUP_INPROJ 0
#endif
#ifndef SDUP_MERGE
#define SDUP_MERGE 0
#endif
#ifndef SDUP_WO
#define SDUP_WO 0
#endif
#ifndef SDUP_UP
#define SDUP_UP 0
#endif
#ifndef SDUP_DN
#define SDUP_DN 0
#endif
#ifndef DUP_ATTN
#define DUP_ATTN 1
#endif
#ifndef DUP_GEMM
#define DUP_GEMM 1
#endif
#ifndef DUP_MERGE
#define DUP_MERGE 1
#endif
#ifndef DUP_FFN
#define DUP_FFN 1
#endif
#ifdef ONLY_PHASE
#define PH(k) ((k) == ONLY_PHASE)
#else
#define PH(k) true
#endif
struct Args { const float* in[27]; float* out; unsigned char* ws; };
__global__ void __launch_bounds__(512, 2) hybrid_fwd(Args args) {
    extern __shared__ __attribute__((aligned(16))) unsigned char lds_raw[];
    Frame F;
    F.lds = (LAS unsigned char*)lds_raw; F.MISC = (volatile LAS unsigned*)(F.lds + MISC_OFF);
    F.tid = threadIdx.x; F.lane = F.tid & 63; F.wave = __builtin_amdgcn_readfirstlane(F.tid >> 6); F.G = gridDim.x;
#pragma unroll
    for (int i = 0; i < 27; ++i) F.in[i] = args.in[i];
    F.out = args.out; F.ws = args.ws; F.ctl = (gu32*)(args.ws + WS_CTL);
    for (int u = F.tid; u < (LDS_BYTES - LDSCTL_OFF) / 4; u += 512) ((LAS unsigned*)(F.lds + LDSCTL_OFF))[u] = 0u;
    __syncthreads();
    XcdBarrier bar = xcd_barrier_post((unsigned*)(F.ctl + CW_BAR), F.MISC + 8);
    const int c = (int)blockIdx.x;
#define TSTAMP(id) do { } while (0)

#ifndef DUP_P0
#define DUP_P0 1
#endif
    for (int rep = 0; rep < DUP_P0; ++rep) { if (rep) xcd_barrier(bar, F.wave); if (PH(0)) p0_prologue(F); }

#ifndef XTRA_BAR
#define XTRA_BAR 0
#endif
    _Pragma("unroll") for (int xb = 0; xb < XTRA_BAR; ++xb) xcd_barrier(bar, F.wave);
#define PHASE_FRESH() do { const int l_ = lane_now(); F.tid = F.wave * 64 + l_; F.lane = l_; } while (0)
    for (int l = 0; l < DEPTH; ++l) {
        unsigned char* wl = F.ws + WS_WT + (size_t)l * LW;
        const float* xin = (l == 0) ? F.in[0] : F.out;
        PHASE_FRESH();
#ifndef DUP_RP0
#define DUP_RP0 1
#endif
        if (l == 0) {
          _Pragma("unroll") for (int rep = 0; rep < DUP_RP0; ++rep) { if (rep) xcd_barrier(bar, F.wave); if (PH(1)) rowpass<0, false, false, true>(F, F.in[0], nullptr, 0, nullptr, WSP(bf16_t, WS_H), F.in[2] + l * DM, nullptr, 0, M, (unsigned char*)F.out + H8_OFF); }
          xcd_barrier(bar, F.wave); TSTAMP(1);
          if (c == 0) cmpb_reduce(F); }
        for (int rep = 0; rep < DUP_GEMM; ++rep) if (PH(2)) { if (rep) xcd_barrier(bar, F.wave); SchedSimple S; S.T.init(256, 12, F.G, c); S.A = (const char*)(F.ws + WS_H); S.B = (const char*)(wl + LW_IN); S.lda = 2048; S.ldb = 2048; S.nt = 16; S.dup = SDUP_INPROJ;
          pg8::EpiInProj E{WSP(bf16_t, WS_P), WSP(bf16_t, WS_KCMP), WSP(bf16_t, WS_VCMP), WSP(float, WS_SIDE), WSP(bf16_t, WS_KROT), WSP(const float, WS_ROPE), WSP(float, WS_SSQQ), WSP(float, WS_SSQKV), F.in[12] + l * 4, WSP(float, WS_LF)};
          pg8::gemm_phase<pg8::EpiInProj, SchedSimple, true>(F.lds, S, E, F.wave); }
        xcd_barrier(bar, F.wave); TSTAMP(2);
#ifndef DUP_L2A
#define DUP_L2A 1
#endif
        _Pragma("unroll") for (int rep2 = 0; rep2 < DUP_L2A; ++rep2) { if (rep2) xcd_barrier(bar, F.wave);
        if (PH(3)) { SchedCmp1 S{c, (const char*)(F.ws + WS_KCMP), (const char*)(F.ws + WS_VCMP), (const char*)(wl + LW_PHI)};
          pg8::EpiCmp1 E{WSP(bf16_t, WS_HID), WSP(const float, WS_CMPB) + l * 256};
          pg8::gemm_phase<pg8::EpiCmp1, SchedCmp1, false>(F.lds, S, E, F.wave);
          if (c < 32) {
              __syncthreads(); const int which = c >> 4, b = c & 15;
              const int ln_ = lane_now(); const int r32 = ln_ & 31, hi = ln_ >> 5;
              const bf16_t* hrow = WSP(const bf16_t, WS_HID) + ((size_t)c * 256 + F.wave * 32 + r32) * 256 + which * 128;
              const float *pk2 = F.in[9], *pv2 = F.in[11]; asm volatile("" : "+s"(pk2), "+s"(pv2)); const float* w2 = (which ? pv2 : pk2) + (size_t)l * 128 * 64;
              f32x16 o0, o1;
#pragma unroll
              for (int r = 0; r < 16; ++r) { o0[r] = 0.f; o1[r] = 0.f; }
#pragma unroll
              for (int ks = 0; ks < 8; ++ks) { const bf16x8 a = *(const bf16x8*)(hrow + ks * 16 + hi * 8);
                  const float* wp = w2 + (size_t)(ks * 16 + hi * 8) * 64 + r32; u32x4 b0, b1;
#pragma unroll
                  for (int jj = 0; jj < 4; ++jj) { b0[jj] = cvtpk(wp[(2 * jj) * 64], wp[(2 * jj + 1) * 64]); b1[jj] = cvtpk(wp[(2 * jj) * 64 + 32], wp[(2 * jj + 1) * 64 + 32]); }
                  o0 = MFMA32(a, __builtin_bit_cast(bf16x8, b0), o0); o1 = MFMA32(a, __builtin_bit_cast(bf16x8, b1), o1); }
              bf16_t* dst = (which ? WSP(bf16_t, WS_VC) : WSP(bf16_t, WS_KC)) + ((size_t)b * 256 + F.wave * 32) * 64 + r32;
#pragma unroll
              for (int r = 0; r < 16; ++r) { const int rw = crow(r, hi); dst[(size_t)rw * 64] = (bf16_t)f2bf(o0[r]); dst[(size_t)rw * 64 + 32] = (bf16_t)f2bf(o1[r]); }
              if (which == 0) {
                  float mxn = 0.f;
#pragma unroll
                  for (int r = 0; r < 16; ++r) { float sq = o0[r] * o0[r] + o1[r] * o1[r]; sq += xor_lane_lt32<1>(sq); sq += xor_lane_lt32<2>(sq); sq += xor_lane_lt32<4>(sq); sq += xor_lane_lt32<8>(sq); sq += xor_lane_lt32<16>(sq); mxn = fmaxf(mxn, sq); }
                  mxn = fmaxf(mxn, other_half(mxn, hi));
                  if (ln_ == 0) atomicMax((unsigned*)(F.ctl + CW_KCMX + 16 * l) + b, __float_as_uint(mxn)); } } }
        if (PH(4)) { int G2_ = F.G; asm volatile("" : "+s"(G2_)); const bool split = G2_ > 64; const int g2 = split ? F.G - 32 : F.G, c2 = split ? c - 32 : c;
          { SchedSimple S; S.T.init(256, 2, g2, c2 < 0 ? (1 << 28) : c2); S.A = (const char*)(F.ws + WS_P) + PC_DQL * 2; S.B = (const char*)(wl + LW_UQ); S.lda = PW * 2; S.ldb = 512; S.nt = 4;
            pg8::EpiQup E{WSP(bf16_t, WS_QM), WSP(const float, WS_SSQQ), WSP(const float, WS_ROPE)};
            pg8::gemm_phase<pg8::EpiQup, SchedSimple, true>(F.lds, S, E, F.wave); }
          { SchedSimple S; S.T.init(256, 2, g2, c2 < 0 ? (1 << 28) : c2); S.A = (const char*)(F.ws + WS_P) + PC_DKV * 2; S.B = (const char*)(wl + LW_UKV); S.lda = PW * 2; S.ldb = 256; S.nt = 2;
            pg8::EpiKVup E{WSP(bf16_t, WS_KVM), WSP(const float, WS_SSQKV), (unsigned*)(F.ctl + CW_KMLA + 256 * l)};
            pg8::gemm_phase<pg8::EpiKVup, SchedSimple, true>(F.lds, S, E, F.wave); } }
        PHASE_FRESH();
        if (PH(5)) {
          int G_ = F.G; asm volatile("" : "+s"(G_)); const int cb = (G_ >= 48) ? c - 32 : c;
          if (cb >= 0 && cb < BATCH) { const int b = cb, tid = F.tid; const float* fl = WSP(const float, WS_SIDE) + ((size_t)b * SEQ + 8 * tid) * 16 + 12; const f32x4 fb = *(const f32x4*)(F.in[12] + l * 4);
              f32x4 v[8];
#pragma unroll
              for (int i = 0; i < 8; ++i) { const f32x4 z = *(const f32x4*)(fl + 16 * i);
#pragma unroll
                  for (int e = 0; e < 4; ++e) { const float x = z[e] + fb[e], t = fast_exp2(-fabsf(x) * LOG2E), lg = __builtin_amdgcn_logf(1.0f + t) * 0.6931471805599453f; v[i][e] = fminf(x, 0.f) - lg; } }
#pragma unroll
              for (int i = 1; i < 8; ++i) v[i] = v[i] + v[i - 1];
              LAS f32x4* sc = (LAS f32x4*)F.lds; f32x4 run = v[7];
              sc[tid] = run; __syncthreads();
              for (int off = 1, cur = 0; off < 512; off <<= 1, cur ^= 1) { f32x4 t = sc[cur * 512 + tid]; if (tid >= off) t = t + sc[cur * 512 + tid - off]; sc[(cur ^ 1) * 512 + tid] = t; __syncthreads(); run = t; }
              const f32x4 ex = run - v[7];
              float* kb = WSP(float, WS_KB) + (size_t)b * 4 * SEQ + 8 * tid;
#pragma unroll
              for (int e = 0; e < 4; ++e) { f32x4 lo, hi4;
#pragma unroll
                  for (int i = 0; i < 4; ++i) { lo[i] = -(ex[e] + v[i][e]) * LOG2E; hi4[i] = -(ex[e] + v[4 + i][e]) * LOG2E; }
                  *(f32x4*)(kb + (size_t)e * SEQ) = lo; *(f32x4*)(kb + (size_t)e * SEQ + 4) = hi4; }
              __syncthreads();
          } }
        }
        if (PH(5)) {
          const int gt2 = c * 512 + F.tid, hp = gt2 & 1;
          for (int t2 = gt2 >> 1; t2 < M; t2 += F.G * 256) { const bf16_t* Kp = WSP(const bf16_t, WS_P) + (size_t)t2 * PW + PC_CK + hp * 128; float s0 = 0.f, s1 = 0.f, s2 = 0.f;
              if (hp == 0) { const bf16_t* Rp = WSP(const bf16_t, WS_KROT) + (size_t)t2 * 32;
#pragma unroll
                  for (int q8 = 0; q8 < 4; ++q8) { const bf16x8 ra = *(const bf16x8*)(Rp + q8 * 8);
#pragma unroll
                      for (int e = 0; e < 8; ++e) { const float xa = bf2f((unsigned short)ra[e]); s2 += xa * xa; } } }
#pragma unroll
              for (int q8 = 0; q8 < 8; ++q8) { const bf16x8 ka = *(const bf16x8*)(Kp + q8 * 8), kb2 = *(const bf16x8*)(Kp + 64 + q8 * 8);
#pragma unroll
                  for (int e = 0; e < 8; ++e) { const float xa = bf2f((unsigned short)ka[e]), xb = bf2f((unsigned short)kb2[e]); s0 += xa * xa; s1 += xb * xb; } }
              s0 = fmaxf(s0, xor_lane_lt32<2>(s0)); s0 = fmaxf(s0, xor_lane_lt32<4>(s0)); s0 = fmaxf(s0, xor_lane_lt32<8>(s0)); s0 = fmaxf(s0, xor_lane_lt32<16>(s0));
              s1 = fmaxf(s1, xor_lane_lt32<2>(s1)); s1 = fmaxf(s1, xor_lane_lt32<4>(s1)); s1 = fmaxf(s1, xor_lane_lt32<8>(s1)); s1 = fmaxf(s1, xor_lane_lt32<16>(s1));
              { auto r0 = __builtin_amdgcn_permlane32_swap(__float_as_uint(s0), __float_as_uint(s0), false, false); s0 = fmaxf(__uint_as_float(r0[0]), __uint_as_float(r0[1]));
                auto r1 = __builtin_amdgcn_permlane32_swap(__float_as_uint(s1), __float_as_uint(s1), false, false); s1 = fmaxf(__uint_as_float(r1[0]), __uint_as_float(r1[1])); }
              float s3 = 0.f; { const bf16_t* Np = WSP(const bf16_t, WS_P) + (size_t)t2 * PW + (hp ? PC_KWIN : PC_KSLC);
#pragma unroll
                  for (int q8 = 0; q8 < 8; ++q8) { const bf16x8 na = *(const bf16x8*)(Np + q8 * 8);
#pragma unroll
                      for (int e = 0; e < 8; ++e) { const float xa = bf2f((unsigned short)na[e]); s3 += xa * xa; } } }
              float s4 = 0.f; { const bf16_t* Qp = WSP(const bf16_t, WS_P) + (size_t)t2 * PW + PC_AQ + hp * 128;
                  float sa = 0.f, sb = 0.f;
#pragma unroll
                  for (int q8 = 0; q8 < 8; ++q8) { const bf16x8 qa = *(const bf16x8*)(Qp + q8 * 8), qb2 = *(const bf16x8*)(Qp + 64 + q8 * 8);
#pragma unroll
                      for (int e = 0; e < 8; ++e) { const float xa = bf2f((unsigned short)qa[e]), xb = bf2f((unsigned short)qb2[e]); sa += xa * xa; sb += xb * xb; } }
                  s4 = fmaxf(sa, sb); }
              s4 = fmaxf(s4, xor_lane_lt32<1>(s4)); s4 = fmaxf(s4, xor_lane_lt32<2>(s4)); s4 = fmaxf(s4, xor_lane_lt32<4>(s4)); s4 = fmaxf(s4, xor_lane_lt32<8>(s4)); s4 = fmaxf(s4, xor_lane_lt32<16>(s4));
              { auto r4 = __builtin_amdgcn_permlane32_swap(__float_as_uint(s4), __float_as_uint(s4), false, false); s4 = fmaxf(__uint_as_float(r4[0]), __uint_as_float(r4[1])); }
              s3 = fmaxf(s3, xor_lane_lt32<2>(s3)); s3 = fmaxf(s3, xor_lane_lt32<4>(s3)); s3 = fmaxf(s3, xor_lane_lt32<8>(s3)); s3 = fmaxf(s3, xor_lane_lt32<16>(s3));
              { auto r3 = __builtin_amdgcn_permlane32_swap(__float_as_uint(s3), __float_as_uint(s3), false, false); s3 = fmaxf(__uint_as_float(r3[0]), __uint_as_float(r3[1])); }
              s2 = fmaxf(s2, xor_lane_lt32<2>(s2)); s2 = fmaxf(s2, xor_lane_lt32<4>(s2)); s2 = fmaxf(s2, xor_lane_lt32<8>(s2)); s2 = fmaxf(s2, xor_lane_lt32<16>(s2));
              { auto r2 = __builtin_amdgcn_permlane32_swap(__float_as_uint(s2), __float_as_uint(s2), false, false); s2 = fmaxf(__uint_as_float(r2[0]), __uint_as_float(r2[1])); }
              if (F.lane < 2) { unsigned* kw = (unsigned*)(F.ctl + CW_KMAX + 64 * l) + (t2 >> 12) * 4 + 2 * hp; atomicMax(kw, __float_as_uint(s0)); atomicMax(kw + 1, __float_as_uint(s1));
                  if (hp == 0) atomicMax((unsigned*)(F.ctl + CW_KROT + 16 * l) + (t2 >> 12), __float_as_uint(s2));
                  atomicMax((unsigned*)(F.ctl + CW_KNSA + 32 * l) + (t2 >> 12) * 2 + hp, __float_as_uint(s3));
                  if (hp == 0) atomicMax((unsigned*)(F.ctl + CW_QNSA + 16 * l) + (t2 >> 12), __float_as_uint(s4)); } } }
        xcd_barrier(bar, F.wave); TSTAMP(3);
        PHASE_FRESH();
        for (int rep = 0; rep < DUP_ATTN; ++rep) { gu32* ctr = F.ctl + CW_Q + 64 * l + 16 * rep;
          if (rep) xcd_barrier(bar, F.wave);
#define Q_T0 (F.wave == 0 && lane_now() == 0)
          unsigned nxtq = 0u; if (Q_T0) nxtq = __hip_atomic_fetch_add(ctr, 1u, __ATOMIC_RELAXED, __HIP_MEMORY_SCOPE_AGENT);
          for (;;) { if (Q_T0) F.MISC[0] = nxtq; __syncthreads(); const int iq = (int)F.MISC[0]; __syncthreads(); if (iq >= ATT_UNITS) break;
              if (Q_T0) nxtq = __hip_atomic_fetch_add(ctr, 1u, __ATOMIC_RELAXED, __HIP_MEMORY_SCOPE_AGENT);
              const int it = __builtin_amdgcn_readfirstlane(WSP(const int, WS_ORDER)[iq]);
              if (it < 2048 && PH(7)) { const int qb = 15 - (it >> 7), mla = (it >> 6) & 1, bh = it & 63; if (mla) { const gu32* km = F.ctl + CW_KMLA + 256 * l + bh * 4; const float k2 = __uint_as_float(__hip_atomic_load(km, __ATOMIC_RELAXED, __HIP_MEMORY_SCOPE_AGENT)) + __uint_as_float(__hip_atomic_load(km + 1, __ATOMIC_RELAXED, __HIP_MEMORY_SCOPE_AGENT)) + __uint_as_float(__hip_atomic_load(F.ctl + CW_KROT + 16 * l + (bh >> 2), __ATOMIC_RELAXED, __HIP_MEMORY_SCOPE_AGENT)); causal_unit<false>(F, bh >> 2, bh & 3, qb, sqrtf(k2) * 1.01f); } else causal_unit<true>(F, bh >> 2, bh & 3, qb, sqrtf(__uint_as_float(__hip_atomic_load(F.ctl + CW_KMAX + 64 * l + bh, __ATOMIC_RELAXED, __HIP_MEMORY_SCOPE_AGENT)))); }
              else if (it < 3072 && PH(8)) { const int r = it - 2048; const int bN = r & 15; const float qm2 = __uint_as_float(__hip_atomic_load(F.ctl + CW_QNSA + 16 * l + bN, __ATOMIC_RELAXED, __HIP_MEMORY_SCOPE_AGENT)), ka2 = __uint_as_float(__hip_atomic_load(F.ctl + CW_KNSA + 32 * l + bN * 2, __ATOMIC_RELAXED, __HIP_MEMORY_SCOPE_AGENT)), kb2 = __uint_as_float(__hip_atomic_load(F.ctl + CW_KNSA + 32 * l + bN * 2 + 1, __ATOMIC_RELAXED, __HIP_MEMORY_SCOPE_AGENT));
                  const float tmx = fmaxf(fmaxf(WSP(const float, WS_FARB)[4], WSP(const float, WS_FARB)[5]), fmaxf(WSP(const float, WS_FARB)[6], WSP(const float, WS_FARB)[7]));
                  const float kc2 = __uint_as_float(__hip_atomic_load(F.ctl + CW_KCMX + 16 * l + bN, __ATOMIC_RELAXED, __HIP_MEMORY_SCOPE_AGENT));
                  const bool fastB = (sqrtf(qm2) * sqrtf(fmaxf(ka2, kb2)) * 1.002f + tmx + 0.05f) <= 50.0f && (sqrtf(qm2) * sqrtf(kc2) * 1.02f + 0.05f) <= 50.0f;
                  if (__builtin_amdgcn_readfirstlane(fastB ? 1 : 0)) nsa_unit<true>(F, bN, 63 - (r >> 4), l); else nsa_unit<false>(F, bN, 63 - (r >> 4), l); }
              else if (it < 3328 && PH(9)) { const int r = it - 3072; dil_unit(F, r & 15, (r >> 4) & 1, r >> 5); } } }
        xcd_barrier(bar, F.wave); TSTAMP(5);
        for (int rep = 0; rep < DUP_MERGE; ++rep) if (PH(10)) { if (rep) xcd_barrier(bar, F.wave); SchedMerge S; S.T.init(256, 4, F.G, c); S.ocat = (const char*)(F.ws + WS_OCAT); S.h = (const char*)F.out + H8_OFF; S.wbr = (const char*)(wl + LW_BR); S.wg = (const char*)(wl + LW_G); S.dup = SDUP_MERGE;
          unsigned char* scr = F.ws + WS_MSCR + (size_t)c * MSCR_PER_WG;
          pg8::EpiMerge E{WSP(bf16_t, WS_MERGED), scr};
          pg8::gemm_phase<pg8::EpiMerge, SchedMerge, true, true>(F.lds, S, E, F.wave); }
        xcd_barrier(bar, F.wave); TSTAMP(6);
        if (PH(11)) { SchedSimple S; S.T.init(256, 4, F.G, c); S.A = (const char*)(F.ws + WS_MERGED); S.B = (const char*)(wl + LW_O); S.lda = 2048; S.ldb = 2048; S.nt = 16; S.dup = SDUP_WO;
          pg8::EpiBf16 E{WSP(bf16_t, WS_Y), DM};
          pg8::gemm_phase<pg8::EpiBf16, SchedSimple, true>(F.lds, S, E, F.wave); }
        xcd_barrier(bar, F.wave); TSTAMP(7);
        PHASE_FRESH();
        if (PH(12)) { if (l == 0) rowpass<1, false, true>(F, F.in[0], WSP(const bf16_t, WS_Y), 0, F.out, WSP(bf16_t, WS_H2), F.in[3] + l * DM, F.in[4] + l * DM, 0, M);
                      else rowpass<1, true, true>(F, F.out, WSP(const bf16_t, WS_Y), 0, WSP(bf16_t, WS_X3), WSP(bf16_t, WS_H2), F.in[3] + l * DM, F.in[4] + l * DM, 0, M); }
        xcd_barrier(bar, F.wave); TSTAMP(8);
#ifndef DUP_UP
#define DUP_UP 1
#endif
        _Pragma("unroll") for (int rep = 0; rep < DUP_UP; ++rep) if (PH(13)) { if (rep) xcd_barrier(bar, F.wave); SchedSimple S; S.T.init(256, 22, F.G, c); S.A = (const char*)(F.ws + WS_H2); S.B = (const char*)(wl + LW_UP); S.lda = 2048; S.ldb = 2048; S.nt = 16; S.dup = SDUP_UP;
          pg8::EpiUpConv E{WSP(bf16_t, WS_ACT), WSP(float, WS_HB), WSP(const float, WS_CWS) + (size_t)l * 4 * DFF2, WSP(const float, WS_CWS) + (size_t)l * 4 * DFF2 + 3 * DFF2};
          pg8::gemm_phase<pg8::EpiUpConv, SchedSimple, true>(F.lds, S, E, F.wave); }
        xcd_barrier(bar, F.wave); TSTAMP(9);
        PHASE_FRESH();
        if (PH(15)) { SchedSimple S; S.T.init(256, 4, F.G, c); S.A = (const char*)(F.ws + WS_ACT); S.B = (const char*)(wl + LW_DN); S.lda = DFF * 2; S.ldb = DFF * 2; S.nt = DFF / 64; S.dup = SDUP_DN;
          { int pm, pn; for (int i = 0; S.T.tile(i, pm, pn); ++i) ffn_fix_panel(F, pm, WSP(const float, WS_HB), WSP(bf16_t, WS_ACT), F.in[24] + (size_t)l * 3 * DFF2, F.in[25] + (size_t)l * DFF2); }
          VM_WAIT(); __syncthreads();
          pg8::EpiBf16 E{WSP(bf16_t, WS_Y2), DM};
          pg8::gemm_phase<pg8::EpiBf16, SchedSimple, true>(F.lds, S, E, F.wave); }
        xcd_barrier(bar, F.wave); TSTAMP(11);
        PHASE_FRESH();
        if (PH(16)) { if (l + 1 < DEPTH) rowpass<1, true, true, true>(F, F.out, WSP(const bf16_t, WS_Y2), 0, F.out, WSP(bf16_t, WS_H), F.in[5] + l * DM, F.in[2] + (l + 1) * DM, 0, M, (unsigned char*)F.out + H8_OFF);
                      else rowpass<2, true, false>(F, WSP(const bf16_t, WS_X3), WSP(const bf16_t, WS_Y2), 0, F.out, nullptr, F.in[5] + l * DM, nullptr, 0, M); }
        if (l + 1 < DEPTH) xcd_barrier(bar, F.wave);
        TSTAMP(12);
    }
}

extern "C" void kernel_launch(void* const* d_in, const int* in_sizes, int n_in, void* d_out, int out_size, void* d_ws, size_t ws_size, hipStream_t stream) {
    static int grid = 0;
    if (grid == 0) {
        if (n_in != 27 || in_sizes[0] != M * DM || out_size != M * DM || ws_size < WS_END) { fprintf(stderr, "kernel_launch: unexpected shapes (n_in %d, in0 %d, out %d, ws %zu)\n", n_in, n_in > 0 ? in_sizes[0] : -1, out_size, ws_size); grid = -1; return; }
        int dev = 0, cus = 0, per_cu = 0;
        if (hipGetDevice(&dev) != hipSuccess || hipDeviceGetAttribute(&cus, hipDeviceAttributeMultiprocessorCount, dev) != hipSuccess) { grid = -1; return; }
        if (hipFuncSetAttribute((const void*)hybrid_fwd, hipFuncAttributeMaxDynamicSharedMemorySize, LDS_BYTES) != hipSuccess) { fprintf(stderr, "kernel_launch: hipFuncSetAttribute failed\n"); grid = -1; return; }
        if (hipOccupancyMaxActiveBlocksPerMultiprocessor(&per_cu, (const void*)hybrid_fwd, 512, LDS_BYTES) != hipSuccess || per_cu < 1) fprintf(stderr, "kernel_launch: occupancy query says %d\n", per_cu);
        (void)hipGetLastError();
        grid = cus;
    }
    if (grid < 0) return;
    if (hipMemsetAsync((char*)d_ws + WS_CTL, 0, CTL_ZERO_BYTES, stream) != hipSuccess) return;
    Args a{};
    for (int i = 0; i < 27; ++i) a.in[i] = (const float*)d_in[i];
    a.out = (float*)d_out; a.ws = (unsigned char*)d_ws;
    hipLaunchKernelGGL(hybrid_fwd, dim3(grid), dim3(512), LDS_BYTES, stream, a);
}
```

```cpp
#include <hip/hip_runtime.h>
#include <hip/hip_bf16.h>
#include <cstdio>
#include <cstdint>
#include <cmath>

#define GAS __attribute__((address_space(1)))
#define LAS __attribute__((address_space(3)))
typedef unsigned short bf16_t;
typedef short bf16x8 __attribute__((ext_vector_type(8)));
typedef short s16x4 __attribute__((ext_vector_type(4)));
typedef float f32x4 __attribute__((ext_vector_type(4)));
typedef float f32x2 __attribute__((ext_vector_type(2)));
typedef float f32x16 __attribute__((ext_vector_type(16)));
typedef unsigned u32x4 __attribute__((ext_vector_type(4)));
typedef unsigned u32x2 __attribute__((ext_vector_type(2)));
typedef GAS unsigned gu32;

constexpr int BATCH = 16, SEQ = 4096, DM = 1024, M = BATCH * SEQ, DEPTH = 2;
constexpr int DIN = 2992, PW = 3072;
constexpr int DFF = 2816, DFF2 = 5632;
constexpr float LOG2E = 1.4426950408889634f;
constexpr float C2A = 0.125f * LOG2E;
constexpr float C2D = 0.10206207261596575f * LOG2E;
constexpr float RMS_EPS = 1e-6f;
constexpr float H8_SCALE = 0.5f, WG8_SCALE = -2.8853900817779268f;
constexpr int PC_AQ = 0, PC_KCMP = 256, PC_VCMP = 320, PC_KSLC = 384, PC_VSLC = 448, PC_KWIN = 512, PC_VWIN = 576,
              PC_MISC = 640, PC_KROPE = 672, PC_BQ = 768, PC_BK = 1152, PC_BV = 1536, PC_DKV = 1920,
              PC_CQ = 2048, PC_CK = 2304, PC_CV = 2560, PC_DQL = 2816;
constexpr int OCW = 896;
constexpr int NSA_DFAR = 1536, NSA_DMAX = 1664, NSA_TL = 1728;

__device__ __forceinline__ unsigned f2bf(float f) { unsigned u = __float_as_uint(f); return (u + 0x7fffu + ((u >> 16) & 1u)) >> 16; }
__device__ __forceinline__ unsigned pk2(float lo, float hi) { return f2bf(lo) | (f2bf(hi) << 16); }
__device__ __forceinline__ float bf2f(unsigned short b) { return __uint_as_float((unsigned)b << 16); }
typedef __bf16 bf16x2_t __attribute__((ext_vector_type(2)));
__device__ __forceinline__ unsigned cvtpk(float lo, float hi) { f32x2 v = {lo, hi}; bf16x2_t b = __builtin_convertvector(v, bf16x2_t); return __builtin_bit_cast(unsigned, b); }
__device__ __forceinline__ unsigned pk4_fp8(float a, float b, float c, float d) { int w = 0; w = __builtin_amdgcn_cvt_pk_fp8_f32(a, b, w, false); w = __builtin_amdgcn_cvt_pk_fp8_f32(c, d, w, true); return (unsigned)w; }
__device__ __forceinline__ float fast_exp2(float x) { return __builtin_amdgcn_exp2f(x); }
__device__ __forceinline__ float fast_rcp(float x) { return __builtin_amdgcn_rcpf(x); }
template <int MASK> __device__ __forceinline__ float xor_lane_lt32(float v) { return __uint_as_float(__builtin_amdgcn_ds_swizzle((int)__float_as_uint(v), (MASK << 10) | 0x1f)); }
__device__ __forceinline__ float sum_halves(float v) { auto rr = __builtin_amdgcn_permlane32_swap(__float_as_uint(v), __float_as_uint(v), false, false); return __uint_as_float(rr[0]) + __uint_as_float(rr[1]); }
__device__ __forceinline__ float sigmoid_f(float x) { return fast_rcp(1.0f + fast_exp2(-x * LOG2E)); }

__device__ __forceinline__ int lane_now() { int l; asm volatile("v_mbcnt_lo_u32_b32 %0, -1, 0\n\tv_mbcnt_hi_u32_b32 %0, -1, %0" : "=v"(l)); return l; }
namespace pg8 {
constexpr int BM = 256, BK = 64, HALF = 128, HTB = HALF * BK * 2  , STAGE_BYTES = 8 * HTB, NXCD = 8, WGM = 8;
__host__ __device__ __forceinline__ int lds_byte(int r, int c) { const int st = (r >> 4) * 2 + (c >> 5), rr = r & 15, cc = c & 31, ob = rr * 64 + cc * 2; return st * 1024 + (ob ^ (((ob >> 9) & 1) << 5)); }
__host__ __device__ __forceinline__ void stage_rc(int b, int& R, int& C) { const int st = b / 1024, sb = b % 1024, swz = sb ^ (((sb >> 9) & 1) << 5); R = (st >> 1) * 16 + swz / 64; C = (st & 1) * 32 + (swz % 64) / 2; }
__host__ __device__ __forceinline__ int perm32(int rho) { const int n = rho >> 4, i = rho & 15; return 8 * (i >> 2) + 4 * n + (i & 3); }

typedef int v8i_t __attribute__((ext_vector_type(8)));
typedef int v4i_t __attribute__((ext_vector_type(4)));
__device__ __forceinline__ v8i_t cat8(const bf16x8 lo, const bf16x8 hi) { const v4i_t a = __builtin_bit_cast(v4i_t, lo), b = __builtin_bit_cast(v4i_t, hi); return __builtin_shufflevector(a, b, 0, 1, 2, 3, 4, 5, 6, 7); }
struct GUnit { const char* A; const char* B; int lda, ldb, nt, pm, pn, id; };

struct TileOrder {
    int nM, nN, nwg, G, c;
    __device__ __forceinline__ void init(int nM_, int nN_, int G_, int c_) { nM = nM_; nN = nN_; nwg = nM * nN; G = G_; c = c_; }
    __device__ __forceinline__ bool tile(int i, int& pm, int& pn) const {
        const long L = (long)i * G + c; if (L >= nwg) return false;
        int wgid = (int)L; { const int q = nwg / NXCD, r = nwg % NXCD, xcd = wgid % NXCD, off = wgid / NXCD; wgid = (xcd < r ? xcd * (q + 1) : r * (q + 1) + (xcd - r) * q) + off; }
        const int nig = WGM * nN, gid = wgid / nig, fm = gid * WGM, gsz = (nM - fm) < WGM ? (nM - fm) : WGM;
        pm = fm + ((wgid % nig) % gsz); pn = (wgid % nig) / gsz; return true;
    }
};

template <class Epi, class Sched, bool ALIGN_EPI, bool F8 = false>
__device__ __forceinline__ void gemm_phase(LAS unsigned char* lds, const Sched& S, const Epi& E, int wave_id) {
    int tid_o = wave_id * 64 + lane_now();
    const int tid = tid_o, wid = __builtin_amdgcn_readfirstlane(tid >> 6), lane = tid & 63, wr = wid >> 2, wc = wid & 3; int fr = lane & 15, fq = lane >> 4;
    int sR[2], sC[2], sRb[2];
#pragma unroll
    for (int i = 0; i < 2; ++i) { stage_rc(tid * 16 + i * 8192, sR[i], sC[i]); sRb[i] = Epi::PERM ? ((sR[i] & ~31) + perm32(sR[i] & 31)) : sR[i]; sC[i] *= 2; }
    const size_t kstep = (size_t)(BK * 2);
    const unsigned ldsw = (unsigned)wid * 1024u;
    const int aoff = lds_byte(wr * 64 + fr, fq * 8), boff = lds_byte(wc * 32 + fr, fq * 8);
#define PG8_SA(b, h) (((b) * 2 + (h)) * HTB)
#define PG8_SB(b, h) ((4 + (b) * 2 + (h)) * HTB)
#define PG8_STAGE(bufoff, gbase, rows, ld) do { _Pragma("unroll") for (int _i = 0; _i < 2; ++_i) \
        __builtin_amdgcn_global_load_lds((const unsigned*)((const char*)(gbase) + (unsigned)((rows)[_i] * (ld) + sC[_i])), (LAS unsigned*)(lds + (bufoff) + ldsw + _i * 8192), 16, 0, 0); } while (0)
#define PG8_LDA(dst, b, h) do { _Pragma("unroll") for (int m = 0; m < 4; ++m) _Pragma("unroll") for (int k = 0; k < 2; ++k) dst[m][k] = *(const LAS bf16x8*)(lds + PG8_SA(b, h) + aoff + m * 2048 + k * 1024); } while (0)
#define PG8_LDB(dst, b, h) do { _Pragma("unroll") for (int n = 0; n < 2; ++n) _Pragma("unroll") for (int k = 0; k < 2; ++k) dst[n][k] = *(const LAS bf16x8*)(lds + PG8_SB(b, h) + boff + n * 2048 + k * 1024); } while (0)
#define PG8_MMA(ai, bj, At, Bt) do { __builtin_amdgcn_s_setprio(1); _Pragma("unroll") for (int m = 0; m < 4; ++m) _Pragma("unroll") for (int n = 0; n < 2; ++n) _Pragma("unroll") for (int k = 0; k < 2; ++k) \
        acc[ai][bj][m][n] = __builtin_amdgcn_mfma_f32_16x16x32_bf16(Bt[n][k], At[m][k], acc[ai][bj][m][n], 0, 0, 0); __builtin_amdgcn_s_setprio(0); } while (0)
#define PG8_LDA8(dst, b, h) do { _Pragma("unroll") for (int m = 0; m < 4; ++m) { dst[m].lo = *(const LAS v4i_t*)(lds + PG8_SA(b, h) + aoff + m * 2048); dst[m].hi = *(const LAS v4i_t*)(lds + PG8_SA(b, h) + aoff + m * 2048 + 1024); } } while (0)
#define PG8_LDB8(dst, b, h) do { _Pragma("unroll") for (int n = 0; n < 2; ++n) { dst[n].lo = *(const LAS v4i_t*)(lds + PG8_SB(b, h) + boff + n * 2048); dst[n].hi = *(const LAS v4i_t*)(lds + PG8_SB(b, h) + boff + n * 2048 + 1024); } } while (0)
#define PG8_MMA8(ai, bj, At, Bt) do { __builtin_amdgcn_s_setprio(1); _Pragma("unroll") for (int m = 0; m < 4; ++m) _Pragma("unroll") for (int n = 0; n < 2; ++n) \
        asm volatile("v_mfma_f32_16x16x128_f8f6f4 %0, %1, %2, %0" : "+v"(acc[ai][bj][m][n]) : "v"(Bt[n]), "v"(At[m])); __builtin_amdgcn_s_setprio(0); } while (0)
#define PG8_WAIT_V(n) asm volatile("s_waitcnt vmcnt(" #n ")" ::: "memory")
#define PG8_WAIT_L(n) asm volatile("s_waitcnt lgkmcnt(" #n ")" ::: "memory")
#define PG8_BAR __builtin_amdgcn_s_barrier()
#define PG8_SCHED __builtin_amdgcn_sched_barrier(0)
#define PG8_KLOOP(MM, LDA_, LDB_, At, B0, B1) for (int t = 0; t < nt; t += 2) { \
            const bool last = (t == nt - 2); \
            const char* a1 = cA + (size_t)(t + 1) * kstep; \
            const char* a2 = last ? nA : cA + (size_t)(t + 2) * kstep; const char* b2 = last ? nB : cB + (size_t)(t + 2) * kstep; \
            const char* a3 = a2 + kstep; const char* b3 = b2 + kstep; \
            const int ldA2 = last ? ldAn : ldAc, ldB2 = last ? ldBn : ldBc; \
            const size_t hA2 = last ? hAn : hAc, hB2 = last ? hBn : hBc; \
              \
            LDB_(B0, 0, 0); LDB_(B1, 0, 1); PG8_SCHED; LDA_(At, 0, 0); PG8_STAGE(PG8_SA(1, 1), a1 + hAc, sR, ldAc); \
            PG8_WAIT_V(8); PG8_WAIT_L(0); PG8_BAR; MM(0, 0, At, B0); MM(0, 1, At, B1); PG8_BAR; PG8_SCHED; \
              \
            LDA_(At, 0, 1); PG8_STAGE(PG8_SB(0, 0), b2, sRb, ldB2); PG8_STAGE(PG8_SB(0, 1), b2 + hB2, sRb, ldB2); PG8_STAGE(PG8_SA(0, 0), a2, sR, ldA2); \
            PG8_WAIT_V(8); PG8_WAIT_L(0); PG8_BAR; MM(1, 0, At, B0); MM(1, 1, At, B1); PG8_BAR; PG8_SCHED; \
              \
            LDB_(B0, 1, 0); LDB_(B1, 1, 1); PG8_SCHED; LDA_(At, 1, 0); PG8_STAGE(PG8_SA(0, 1), a2 + hA2, sR, ldA2); \
            PG8_WAIT_V(8); PG8_WAIT_L(0); PG8_BAR; MM(0, 0, At, B0); MM(0, 1, At, B1); PG8_BAR; PG8_SCHED; \
              \
            LDA_(At, 1, 1); PG8_STAGE(PG8_SB(1, 0), b3, sRb, ldB2); PG8_STAGE(PG8_SB(1, 1), b3 + hB2, sRb, ldB2); PG8_STAGE(PG8_SA(1, 0), a3, sR, ldA2); \
            PG8_WAIT_V(8); PG8_WAIT_L(0); PG8_BAR; MM(1, 0, At, B0); MM(1, 1, At, B1); PG8_BAR; PG8_SCHED; \
        }
    GUnit cur, nxt; int ui = 0;
    if (!S.next(0, cur)) return;
    f32x4 acc[2][2][4][2];
#pragma unroll
    for (int a = 0; a < 2; ++a)
#pragma unroll
        for (int b = 0; b < 2; ++b)
#pragma unroll
            for (int m = 0; m < 4; ++m)
#pragma unroll
                for (int n = 0; n < 2; ++n) acc[a][b][m][n] = (f32x4){0.f, 0.f, 0.f, 0.f};
    bf16x8 At[4][2], B0[2][2], B1[2][2]; v8i_t At8[4], B08[2], B18[2];
    int ldAc = cur.lda, ldBc = cur.ldb; size_t hAc = (size_t)HALF * ldAc, hBc = (size_t)HALF * ldBc;
    const char* cA = cur.A; const char* cB = cur.B;
    PG8_STAGE(PG8_SB(0, 0), cB, sRb, ldBc); PG8_STAGE(PG8_SB(0, 1), cB + hBc, sRb, ldBc); PG8_STAGE(PG8_SA(0, 0), cA, sR, ldAc); PG8_STAGE(PG8_SA(0, 1), cA + hAc, sR, ldAc);
    if (wr == 1) PG8_BAR;
    PG8_WAIT_V(2); PG8_BAR;
    PG8_STAGE(PG8_SB(1, 0), cB + kstep, sRb, ldBc); PG8_STAGE(PG8_SA(1, 0), cA + kstep, sR, ldAc); PG8_STAGE(PG8_SB(1, 1), cB + hBc + kstep, sRb, ldBc);
    PG8_WAIT_V(6); PG8_BAR;
    for (;;) {
        const bool has_next = S.next(ui + 1, nxt);
        int ldAn, ldBn; const char* nA; const char* nB;
        if (has_next) { ldAn = nxt.lda; ldBn = nxt.ldb; nA = nxt.A; nB = nxt.B; } else { ldAn = ldAc; ldBn = ldBc; nA = cA; nB = cB; }
        const size_t hAn = (size_t)HALF * ldAn, hBn = (size_t)HALF * ldBn;
        int nt = cur.nt; asm volatile("" : "+s"(nt));
        bool f8u = false; if constexpr (F8) f8u = Epi::f8(cur);
        if (F8 && f8u) { PG8_KLOOP(PG8_MMA8, PG8_LDA8, PG8_LDB8, At8, B08, B18) asm volatile("s_nop 15\n\ts_nop 15" ::: "memory"); }
        else { PG8_KLOOP(PG8_MMA, PG8_LDA, PG8_LDB, At, B0, B1) }
        if constexpr (ALIGN_EPI) { if (wr == 0) PG8_BAR; }
        E(acc, cur, wr, wc, fr, fq);
        if (!has_next) break;
#pragma unroll
        for (int a = 0; a < 2; ++a)
#pragma unroll
            for (int b = 0; b < 2; ++b)
#pragma unroll
                for (int m = 0; m < 4; ++m)
#pragma unroll
                    for (int n = 0; n < 2; ++n) acc[a][b][m][n] = (f32x4){0.f, 0.f, 0.f, 0.f};
        cur = nxt; cA = nA; cB = nB; ++ui;
        ldAc = ldAn; ldBc = ldBn; hAc = hAn; hBc = hBn;
        if constexpr (ALIGN_EPI) { if (wr == 1) PG8_BAR; }
    }
    PG8_WAIT_V(0);
    if constexpr (!ALIGN_EPI) { if (wr == 0) PG8_BAR; }
    PG8_BAR;
#undef PG8_SA
#undef PG8_SB
#undef PG8_STAGE
#undef PG8_LDA
#undef PG8_LDB
#undef PG8_MMA
#undef PG8_MMA8
#undef PG8_LDA8
#undef PG8_LDB8
#undef PG8_KLOOP
#undef PG8_WAIT_V
#undef PG8_WAIT_L
#undef PG8_BAR
#undef PG8_SCHED
}
}
using pg8::GUnit;
namespace pg8 {
#define EPI_OPAQUE() asm volatile("" : "+v"(fr), "+v"(fq))
struct EpiBf16 {
    static constexpr bool PERM = true;
    bf16_t* O; int ldc;
    __device__ __forceinline__ void operator()(const f32x4 (&acc)[2][2][4][2], const GUnit& u, int wr, int wc, int fr, int fq) const {
        EPI_OPAQUE();
        const int row0 = u.pm * BM + wr * 64 + fr, col0 = u.pn * BM + wc * 32 + 8 * fq;
#pragma unroll
        for (int ai = 0; ai < 2; ++ai)
#pragma unroll
            for (int m = 0; m < 4; ++m) { bf16_t* rowp = O + (size_t)(row0 + ai * HALF + m * 16) * ldc + col0;
#pragma unroll
                for (int bj = 0; bj < 2; ++bj) { const f32x4 v0 = acc[ai][bj][m][0], v1 = acc[ai][bj][m][1];
                    u32x4 w; w.x = cvtpk(v0[0], v0[1]); w.y = cvtpk(v0[2], v0[3]); w.z = cvtpk(v1[0], v1[1]); w.w = cvtpk(v1[2], v1[3]);
                    *(u32x4*)(rowp + bj * HALF) = w; } }
    }
};
struct EpiF32 {
    static constexpr bool PERM = false;
    float* O; int ldc;
    __device__ __forceinline__ void operator()(const f32x4 (&acc)[2][2][4][2], const GUnit& u, int wr, int wc, int fr, int fq) const {
        EPI_OPAQUE();
        const int row0 = u.pm * BM + wr * 64 + fr, col0 = u.pn * BM + wc * 32 + 4 * fq;
#pragma unroll
        for (int ai = 0; ai < 2; ++ai)
#pragma unroll
            for (int m = 0; m < 4; ++m) { float* rowp = O + (size_t)(row0 + ai * HALF + m * 16) * ldc + col0;
#pragma unroll
                for (int bj = 0; bj < 2; ++bj)
#pragma unroll
                    for (int n = 0; n < 2; ++n) *(f32x4*)(rowp + bj * HALF + n * 16) = acc[ai][bj][m][n]; }
    }
};
__device__ __forceinline__ void rope8(f32x4& v0, f32x4& v1, const float* cs  ) {
    const f32x4 a = *(const f32x4*)cs, b = *(const f32x4*)(cs + 4);
    f32x4 r0, r1;
    r0[0] = v0[0] * a[0] - v0[1] * a[1]; r0[1] = v0[1] * a[0] + v0[0] * a[1];
    r0[2] = v0[2] * a[2] - v0[3] * a[3]; r0[3] = v0[3] * a[2] + v0[2] * a[3];
    r1[0] = v1[0] * b[0] - v1[1] * b[1]; r1[1] = v1[1] * b[0] + v1[0] * b[1];
    r1[2] = v1[2] * b[2] - v1[3] * b[3]; r1[3] = v1[3] * b[2] + v1[2] * b[3];
    v0 = r0; v1 = r1;
}
struct EpiInProj {
    static constexpr bool PERM = true;
    bf16_t* P; bf16_t* kcmp; bf16_t* vcmp; float* side; bf16_t* krot; const float* rope; float* ssq_q; float* ssq_kv; const float* fbias; float* lf;
    __device__ __forceinline__ void operator()(const f32x4 (&acc)[2][2][4][2], const GUnit& u, int wr, int wc, int fr, int fq) const {
        EPI_OPAQUE();
        const int row0 = u.pm * BM + wr * 64 + fr, col0 = u.pn * BM + wc * 32 + 8 * fq;
#pragma unroll
        for (int ai = 0; ai < 2; ++ai)
#pragma unroll
            for (int m = 0; m < 4; ++m) { const int row = row0 + ai * HALF + m * 16; bf16_t* rowp = P + (size_t)row * PW + col0;
                float ssq = 0.f;
#pragma unroll
                for (int bj = 0; bj < 2; ++bj) { f32x4 v0 = acc[ai][bj][m][0], v1 = acc[ai][bj][m][1];
                    if (u.pn == 2 && bj == 1) {
                        if (wc == 0 && fq < 2) { float* sp = side + (size_t)row * 16 + 8 * fq; *(f32x4*)sp = v0; *(f32x4*)(sp + 4) = v1; }
                        if (wc == 1) { rope8(v0, v1, rope + (size_t)(row & (SEQ - 1)) * 32 + 8 * fq);
                            u32x4 w; w.x = cvtpk(v0[0], v0[1]); w.y = cvtpk(v0[2], v0[3]); w.z = cvtpk(v1[0], v1[1]); w.w = cvtpk(v1[2], v1[3]);
                            *(u32x4*)(krot + (size_t)row * 32 + 8 * fq) = w; }
                    }
                    u32x4 w; w.x = cvtpk(v0[0], v0[1]); w.y = cvtpk(v0[2], v0[3]); w.z = cvtpk(v1[0], v1[1]); w.w = cvtpk(v1[2], v1[3]);
                    *(u32x4*)(rowp + bj * HALF) = w;
                    if (u.pn == 1 && bj == 0) { bf16_t* cp = (wc < 2 ? kcmp : vcmp) + (size_t)row * 64 + (wc & 1) * 32 + 8 * fq; *(u32x4*)cp = w; }
                    if (u.pn == 11 || (u.pn == 7 && bj == 1)) ssq += (v0[0] * v0[0] + v0[1] * v0[1]) + (v0[2] * v0[2] + v0[3] * v0[3]) + (v1[0] * v1[0] + v1[1] * v1[1]) + (v1[2] * v1[2] + v1[3] * v1[3]);
                }
                if (u.pn == 11 || u.pn == 7) { ssq += xor_lane_lt32<16>(ssq); ssq = sum_halves(ssq);
                    if (fq == 0) (u.pn == 11 ? ssq_q : ssq_kv)[(size_t)row * 4 + wc] = ssq; }
                asm volatile("" ::: "memory");
            }
    }
};
struct EpiQup {
    static constexpr bool PERM = true;
    bf16_t* O; const float* ssq_q; const float* rope;
    __device__ __forceinline__ void operator()(const f32x4 (&acc)[2][2][4][2], const GUnit& u, int wr, int wc, int fr, int fq) const {
        EPI_OPAQUE();
        const int row0 = u.pm * BM + wr * 64 + fr, col0 = u.pn * BM + wc * 32 + 8 * fq;
#pragma unroll
        for (int ai = 0; ai < 2; ++ai)
#pragma unroll
            for (int m = 0; m < 4; ++m) { const int row = row0 + ai * HALF + m * 16; bf16_t* rowp = O + (size_t)row * 512 + col0;
                const f32x4 pq = *(const f32x4*)(ssq_q + (size_t)row * 4);
                const float rstd = 1.0f / sqrtf(((pq[0] + pq[1]) + (pq[2] + pq[3])) * (1.0f / 256.0f) + RMS_EPS);
#pragma unroll
                for (int bj = 0; bj < 2; ++bj) { f32x4 v0 = acc[ai][bj][m][0] * rstd, v1 = acc[ai][bj][m][1] * rstd;
                    const int c8 = col0 + bj * HALF, within = c8 % 96;
                    if (c8 < 384 && within >= 64) rope8(v0, v1, rope + (size_t)(row & (SEQ - 1)) * 32 + (within - 64));
                    u32x4 w; w.x = cvtpk(v0[0], v0[1]); w.y = cvtpk(v0[2], v0[3]); w.z = cvtpk(v1[0], v1[1]); w.w = cvtpk(v1[2], v1[3]);
                    *(u32x4*)(rowp + bj * HALF) = w; }
                asm volatile("" ::: "memory"); }
    }
};
struct EpiKVup {
    static constexpr bool PERM = true;
    bf16_t* O; const float* ssq_kv; unsigned* kmx;
    __device__ __forceinline__ void operator()(const f32x4 (&acc)[2][2][4][2], const GUnit& u, int wr, int wc, int fr, int fq) const {
        EPI_OPAQUE();
        const int row0 = u.pm * BM + wr * 64 + fr, col0 = u.pn * BM + wc * 32 + 8 * fq;
        float mk0 = 0.f, mk1 = 0.f;
#pragma unroll
        for (int ai = 0; ai < 2; ++ai)
#pragma unroll
            for (int m = 0; m < 4; ++m) { const int row = row0 + ai * HALF + m * 16; bf16_t* rowp = O + (size_t)row * 512 + col0;
                const f32x4 pq = *(const f32x4*)(ssq_kv + (size_t)row * 4);
                const float rstd = 1.0f / sqrtf(((pq[0] + pq[1]) + (pq[2] + pq[3])) * (1.0f / 128.0f) + RMS_EPS);
#pragma unroll
                for (int bj = 0; bj < 2; ++bj) { const f32x4 v0 = acc[ai][bj][m][0] * rstd, v1 = acc[ai][bj][m][1] * rstd;
                    u32x4 w; w.x = cvtpk(v0[0], v0[1]); w.y = cvtpk(v0[2], v0[3]); w.z = cvtpk(v1[0], v1[1]); w.w = cvtpk(v1[2], v1[3]);
                    *(u32x4*)(rowp + bj * HALF) = w;
                    if (wc < 2) { float ss = ((v0[0] * v0[0] + v0[1] * v0[1]) + (v0[2] * v0[2] + v0[3] * v0[3])) + ((v1[0] * v1[0] + v1[1] * v1[1]) + (v1[2] * v1[2] + v1[3] * v1[3]));
                        ss += xor_lane_lt32<16>(ss); ss = sum_halves(ss); if (bj == 0) mk0 = fmaxf(mk0, ss); else mk1 = fmaxf(mk1, ss); } }
                asm volatile("" ::: "memory"); }
        if (wc < 2) {
            mk0 = fmaxf(mk0, xor_lane_lt32<1>(mk0)); mk0 = fmaxf(mk0, xor_lane_lt32<2>(mk0)); mk0 = fmaxf(mk0, xor_lane_lt32<4>(mk0)); mk0 = fmaxf(mk0, xor_lane_lt32<8>(mk0));
            mk1 = fmaxf(mk1, xor_lane_lt32<1>(mk1)); mk1 = fmaxf(mk1, xor_lane_lt32<2>(mk1)); mk1 = fmaxf(mk1, xor_lane_lt32<4>(mk1)); mk1 = fmaxf(mk1, xor_lane_lt32<8>(mk1));
            if (fr == 0 && fq == 0) { unsigned* kw = kmx + ((u.pm >> 4) * 4 + 2 * u.pn) * 4 + wc; atomicMax(kw, __float_as_uint(mk0)); atomicMax(kw + 4, __float_as_uint(mk1)); }
        }
    }
};
__device__ __forceinline__ float gelu_tanh(float x) { const float u2 = 2.0f * 0.7978845608028654f * (x + 0.044715f * x * x * x); return x * fast_rcp(1.0f + fast_exp2(-u2 * LOG2E)); }
struct EpiCmp1 {
    static constexpr bool PERM = true;
    bf16_t* O; const float* bias1;
    __device__ __forceinline__ void operator()(const f32x4 (&acc)[2][2][4][2], const GUnit& u, int wr, int wc, int fr, int fq) const {
        EPI_OPAQUE();
        const int row0 = u.pm * BM + wr * 64 + fr, col0 = wc * 32 + 8 * fq;
        f32x4 bv[2][2];
#pragma unroll
        for (int bj = 0; bj < 2; ++bj)
#pragma unroll
            for (int n = 0; n < 2; ++n) bv[bj][n] = *(const f32x4*)(bias1 + col0 + bj * HALF + 4 * n);
#pragma unroll
        for (int ai = 0; ai < 2; ++ai)
#pragma unroll
            for (int m = 0; m < 4; ++m) { bf16_t* rowp = O + (size_t)(row0 + ai * HALF + m * 16) * 256 + col0;
#pragma unroll
                for (int bj = 0; bj < 2; ++bj) { f32x4 v0 = acc[ai][bj][m][0] + bv[bj][0], v1 = acc[ai][bj][m][1] + bv[bj][1];
#pragma unroll
                    for (int e = 0; e < 4; ++e) { v0[e] = gelu_tanh(v0[e]); v1[e] = gelu_tanh(v1[e]); }
                    u32x4 w; w.x = cvtpk(v0[0], v0[1]); w.y = cvtpk(v0[2], v0[3]); w.z = cvtpk(v1[0], v1[1]); w.w = cvtpk(v1[2], v1[3]);
                    *(u32x4*)(rowp + bj * HALF) = w; } }
    }
};
typedef __amdgpu_buffer_rsrc_t rsrc_t;
struct EpiMerge {
    __device__ static __forceinline__ bool f8(const GUnit& u) { return u.id >= 4; }
    static constexpr bool PERM = true;
    bf16_t* O;
    unsigned char* scr;
    __device__ __forceinline__ void operator()(const f32x4 (&acc)[2][2][4][2], const GUnit& u, int wr, int wc, int fr, int fq) const {
        EPI_OPAQUE();
        const int tid = (wr * 4 + wc) * 64 + fq * 16 + fr;
        const int sub = u.id;
        const rsrc_t rs = __builtin_amdgcn_make_buffer_rsrc(scr, 0, 524288, 0x00020000);
        if (sub < 4) {
#pragma unroll
            for (int ai = 0; ai < 2; ++ai)
#pragma unroll
                for (int bj = 0; bj < 2; ++bj)
#pragma unroll
                    for (int m = 0; m < 4; ++m)
#pragma unroll
                        for (int n = 0; n < 2; ++n) { const int q = ((ai * 2 + bj) * 4 + m) * 2 + n; const f32x4 v = acc[ai][bj][m][n];
                            u32x2 w; w.x = cvtpk(v[0], v[1]); w.y = cvtpk(v[2], v[3]);
                            __builtin_amdgcn_raw_buffer_store_b64(w, rs, tid * 8, (sub * 32 + q) * 4096, 0); }
            return;
        }
        const int j = sub - 4;
        const int row0 = u.pm * BM + wr * 64 + fr, col0 = u.pn * BM + 64 * j + wc * 16 + 4 * fq;
#pragma unroll
        for (int ai = 0; ai < 2; ++ai) {
            u32x2 sv[4][4];
#pragma unroll
            for (int m = 0; m < 4; ++m)
#pragma unroll
                for (int g = 0; g < 4; ++g) { const int qb = (ai * 16 + m * 2);
                    sv[m][g] = (j == 0) ? __builtin_amdgcn_raw_buffer_load_b64(rs, tid * 8, (g * 32 + qb) * 4096, 0)
                             : (j == 1) ? __builtin_amdgcn_raw_buffer_load_b64(rs, tid * 8, (g * 32 + qb + 1) * 4096, 0)
                             : (j == 2) ? __builtin_amdgcn_raw_buffer_load_b64(rs, tid * 8, (g * 32 + qb + 8) * 4096, 0)
                                        : __builtin_amdgcn_raw_buffer_load_b64(rs, tid * 8, (g * 32 + qb + 9) * 4096, 0); }
#pragma unroll
            for (int m = 0; m < 4; ++m) { bf16_t* rowp = O + (size_t)(row0 + ai * HALF + m * 16) * DM + col0;
                f32x4 t = {0.f, 0.f, 0.f, 0.f};
#pragma unroll
                for (int g = 0; g < 4; ++g) { const f32x4 gt = acc[ai][g >> 1][m][g & 1]; const u32x2 s = sv[m][g];
                    t[0] += fast_rcp(1.0f + fast_exp2(gt[0])) * __uint_as_float(s.x << 16); t[1] += fast_rcp(1.0f + fast_exp2(gt[1])) * __uint_as_float(s.x & 0xffff0000u);
                    t[2] += fast_rcp(1.0f + fast_exp2(gt[2])) * __uint_as_float(s.y << 16); t[3] += fast_rcp(1.0f + fast_exp2(gt[3])) * __uint_as_float(s.y & 0xffff0000u); }
                u32x2 w; w.x = cvtpk(t[0], t[1]); w.y = cvtpk(t[2], t[3]);
                *(u32x2*)rowp = w; }
            asm volatile("" ::: "memory"); }
    }
};
__device__ __forceinline__ float dpp_ror1(float v) { return __uint_as_float((unsigned)__builtin_amdgcn_mov_dpp((int)__float_as_uint(v), 0x121, 0xf, 0xf, false)); }
__device__ __forceinline__ float dpp_ror2(float v) { return __uint_as_float((unsigned)__builtin_amdgcn_mov_dpp((int)__float_as_uint(v), 0x122, 0xf, 0xf, false)); }
struct EpiUpConv {
    static constexpr int KIND = 8;
    static constexpr bool PERM = true;
    bf16_t* ACT; float* HB; const float* cw; const float* cb;
    __device__ __forceinline__ void operator()(const f32x4 (&acc)[2][2][4][2], const GUnit& u, int wr, int wc, int fr, int fq) const {
        EPI_OPAQUE();
        const int colL = wc * 32 + 8 * fq;
        const bool l0 = (fr == 0), l01 = (fr < 2);
#pragma unroll
        for (int n = 0; n < 2; ++n) {
            const int cl = colL + 4 * n, c0 = u.pn * 128 + cl;
            const f32x4 bg = *(const f32x4*)(cb + c0), w0g = *(const f32x4*)(cw + c0), w1g = *(const f32x4*)(cw + DFF2 + c0), w2g = *(const f32x4*)(cw + 2 * DFF2 + c0);
            const f32x4 bv = *(const f32x4*)(cb + DFF + c0), w0v = *(const f32x4*)(cw + DFF + c0), w1v = *(const f32x4*)(cw + DFF2 + DFF + c0), w2v = *(const f32x4*)(cw + 2 * DFF2 + DFF + c0);
            f32x4 w1ga, w1gb, w0ga, w0gb, w1va, w1vb, w0va, w0vb;
#pragma unroll
            for (int e = 0; e < 4; ++e) { w1ga[e] = l0 ? 0.f : w1g[e]; w1gb[e] = l0 ? w1g[e] : 0.f; w0ga[e] = l01 ? 0.f : w0g[e]; w0gb[e] = l01 ? w0g[e] : 0.f;
                                          w1va[e] = l0 ? 0.f : w1v[e]; w1vb[e] = l0 ? w1v[e] : 0.f; w0va[e] = l01 ? 0.f : w0v[e]; w0vb[e] = l01 ? w0v[e] : 0.f; }
#pragma unroll
            for (int ai = 0; ai < 2; ++ai) {
                const int rowg = u.pm * BM + ai * HALF + wr * 64, g = rowg >> 6;
#pragma unroll
                for (int m = 0; m < 4; ++m) {
                    const f32x4 cg = acc[ai][0][m][n], cv = acc[ai][1][m][n];
                    f32x4 o;
#pragma unroll
                    for (int e = 0; e < 4; ++e) {
                        float gt = fmaf(w2g[e], cg[e], bg[e]), vl = fmaf(w2v[e], cv[e], bv[e]);
                        gt = fmaf(dpp_ror1(cg[e]), w1ga[e], gt); gt = fmaf(dpp_ror2(cg[e]), w0ga[e], gt);
                        vl = fmaf(dpp_ror1(cv[e]), w1va[e], vl); vl = fmaf(dpp_ror2(cv[e]), w0va[e], vl);
                        if (m > 0) { const float pg = acc[ai][0][m - 1][n][e], pv = acc[ai][1][m - 1][n][e];
                            gt = fmaf(dpp_ror1(pg), w1gb[e], gt); gt = fmaf(dpp_ror2(pg), w0gb[e], gt);
                            vl = fmaf(dpp_ror1(pv), w1vb[e], vl); vl = fmaf(dpp_ror2(pv), w0vb[e], vl); }
                        o[e] = (gt * vl) * fast_rcp(1.0f + fast_exp2(gt)); }
                    const int row = rowg + m * 16 + fr;
                    if (!(m == 0 && fr < 2)) { u32x2 w; w.x = cvtpk(o[0], o[1]); w.y = cvtpk(o[2], o[3]); *(u32x2*)(ACT + (size_t)row * DFF + c0) = w; }
                    if (m == 0 && fr < 2) { float* hp = HB + ((size_t)((g * 4 + fr) * 22 + u.pn) * 256 + cl); *(f32x4*)hp = cg; *(f32x4*)(hp + 128) = cv; }
                    if (m == 3 && fr >= 14) { float* hp = HB + ((size_t)((g * 4 + fr - 12) * 22 + u.pn) * 256 + cl); *(f32x4*)hp = cg; *(f32x4*)(hp + 128) = cv; }
                }
            }
            asm volatile("" ::: "memory");
        }
    }
};
}
#define XB_TMO      128
#define XB_XCNT(j)  (256  + 64 * (j))
#define XB_XSUB(j)  (1280 + 64 * (j))
#define XB_XGEN(j)  (2304 + 64 * (j))
#define XB_TOP      3328
#define XB_TOPGEN   3392
#define XCD_BAR_WORDS 3456
#define XB_SPIN_CAP (1u << 22)
__device__ __forceinline__ unsigned xb_ld(unsigned* p)              { return __hip_atomic_load(p, __ATOMIC_RELAXED, __HIP_MEMORY_SCOPE_AGENT); }
__device__ __forceinline__ unsigned xb_add(unsigned* p, unsigned v) { return __hip_atomic_fetch_add(p, v, __ATOMIC_RELAXED, __HIP_MEMORY_SCOPE_AGENT); }
__device__ __forceinline__ unsigned xb_xcc_id() { return (unsigned)__builtin_amdgcn_s_getreg((3 << 11) | 20) & 0xFu; }
#define XB_SPIN(cond, bar) do { unsigned _sp = 0; while (cond) { __builtin_amdgcn_s_sleep(1); \
    if ((++_sp & 255u) == 0u) { if (xb_ld(&(bar)[XB_TMO])) break; if (_sp > XB_SPIN_CAP) { atomicAdd(&(bar)[XB_TMO], 1u); break; } } } } while (0)
struct XcdBarrier { unsigned* bar; unsigned x; volatile LAS unsigned* st; };
__device__ __forceinline__ XcdBarrier xcd_barrier_post(unsigned* bar, volatile LAS unsigned* st) {
    XcdBarrier b; b.bar = bar; b.x = xb_xcc_id(); b.st = st;
    if (threadIdx.x == 0) (void)xb_add(&bar[XB_XCNT(b.x)], 1u);
    return b;
}
__device__ __forceinline__ void xcd_barrier_complete(unsigned* bar, unsigned x, unsigned& nloc, unsigned& nx) {
    const unsigned G = gridDim.x * gridDim.y * gridDim.z;
    unsigned sum, cnt, mine, sp = 0u;
    for (;;) {
        sum = 0u; cnt = 0u; mine = 0u;
#pragma unroll
        for (unsigned j = 0; j < 16; ++j) { const unsigned c = xb_ld(&bar[XB_XCNT(j)]); sum += c; cnt += (c > 0u) ? 1u : 0u; mine = (j == x) ? c : mine; }
        if (sum == G) break;
        __builtin_amdgcn_s_sleep(1);
        if ((++sp & 255u) == 0u) { if (xb_ld(&bar[XB_TMO])) break; if (sp > XB_SPIN_CAP) { atomicAdd(&bar[XB_TMO], 1u); break; } }
    }
    nloc = mine > 0u ? mine : 1u; nx = cnt > 0u ? cnt : 1u;
}
__device__ __forceinline__ void xcd_barrier(const XcdBarrier& b, int wave_id) {
    asm volatile("s_waitcnt vmcnt(0)" ::: "memory");
    __syncthreads();
    if (wave_id == 0 && lane_now() == 0) {
        unsigned* bar = b.bar; unsigned bx = b.x;
        asm volatile("" : "+s"(bx));
        __builtin_amdgcn_s_waitcnt(0);
        unsigned nloc = b.st[0], nx = b.st[1];
        if (nloc == 0u) { xcd_barrier_complete(bar, bx, nloc, nx); b.st[0] = nloc; b.st[1] = nx; }
        const unsigned old = xb_add(&bar[XB_XSUB(bx)], 1u);
        const unsigned gen = old / nloc;
        if (old + 1u == (gen + 1u) * nloc) {
            __builtin_amdgcn_fence(__ATOMIC_RELEASE, "agent");
            asm volatile("s_waitcnt vmcnt(0)" ::: "memory");
            const unsigned og = xb_add(&bar[XB_TOP], 1u);
            const unsigned tg = og / nx;
            if (og + 1u == (tg + 1u) * nx) xb_add(&bar[XB_TOPGEN], 1u);
            else XB_SPIN(xb_ld(&bar[XB_TOPGEN]) == tg, bar);
            __builtin_amdgcn_fence(__ATOMIC_ACQUIRE, "agent");
            xb_add(&bar[XB_XGEN(bx)], 1u);
            asm volatile("s_waitcnt vmcnt(0)" ::: "memory");
        } else {
            XB_SPIN(xb_ld(&bar[XB_XGEN(bx)]) == gen, bar);
            __builtin_amdgcn_fence(__ATOMIC_ACQUIRE, "agent");
            asm volatile("s_waitcnt vmcnt(0)" ::: "memory");
        }
    }
    __syncthreads();
}

#define MFMA32(a, b, c) __builtin_amdgcn_mfma_f32_32x32x16_bf16(a, b, c, 0, 0, 0)
typedef short v4i16_t __attribute__((ext_vector_type(4)));
typedef LAS const char* lds_cptr;
typedef LAS char* lds_ptr;
__device__ __forceinline__ int crow(int r, int hi) { return (r & 3) + 8 * (r >> 2) + 4 * hi; }
__device__ __forceinline__ s16x4 vtr(lds_cptr p) { return __builtin_bit_cast(s16x4, __builtin_amdgcn_ds_read_tr16_b64_v4i16((LAS v4i16_t*)p)); }
__device__ __forceinline__ float other_half(float x, int hi) { auto rr = __builtin_amdgcn_permlane32_swap(__float_as_uint(x), __float_as_uint(x), false, false); return __uint_as_float(hi ? rr[0] : rr[1]); }
constexpr float NEG_INF = -INFINITY;

constexpr int TB_V = 12288, TB_KB = 20480, TB_SIZE = 20992;
struct Stg { u32x4 k, k2, v; float kb; };

template <int NKS> __device__ __forceinline__ void qk64(lds_cptr kbuf, const bf16x8* qf, int r32, int hi, f32x16& p0, f32x16& p1) {
    lds_cptr kp = kbuf + hi * 1024 + r32 * 16;
#pragma unroll
    for (int ks = 0; ks < NKS; ++ks) {
        const bf16x8 a0 = *(const LAS bf16x8*)(kp + ks * 2048), a1 = *(const LAS bf16x8*)(kp + ks * 2048 + 512);
        p0 = MFMA32(a0, qf[ks], p0); p1 = MFMA32(a1, qf[ks], p1);
    }
}
template <int NKS> __device__ __forceinline__ void qk64c(lds_cptr kbuf, const bf16x8* qf, int r32, int hi, const f32x16& c, f32x16& p0, f32x16& p1) {
    lds_cptr kp = kbuf + hi * 1024 + r32 * 16;
    { const bf16x8 a0 = *(const LAS bf16x8*)(kp), a1 = *(const LAS bf16x8*)(kp + 512); p0 = MFMA32(a0, qf[0], c); p1 = MFMA32(a1, qf[0], c); }
#pragma unroll
    for (int ks = 1; ks < NKS; ++ks) {
        const bf16x8 a0 = *(const LAS bf16x8*)(kp + ks * 2048), a1 = *(const LAS bf16x8*)(kp + ks * 2048 + 512);
        p0 = MFMA32(a0, qf[ks], p0); p1 = MFMA32(a1, qf[ks], p1);
    }
}
struct AState { f32x16 o0, o1; float m, l; };
__device__ __forceinline__ void astate_init(AState& s) {
#pragma unroll
    for (int r = 0; r < 16; ++r) { s.o0[r] = 0.f; s.o1[r] = 0.f; }
    s.m = NEG_INF; s.l = 0.f;
}
__device__ __forceinline__ void pv64(f32x16& o0, f32x16& o1, lds_cptr vp, const bf16x8 (&pf)[4]) {
#pragma unroll
    for (int ks = 0; ks < 4; ++ks) {
        const s16x4 l0 = vtr(vp + ks * 1024), h0 = vtr(vp + ks * 1024 + 512), l1 = vtr(vp + 4096 + ks * 1024), h1 = vtr(vp + 4096 + ks * 1024 + 512);
        const bf16x8 v0 = (bf16x8){l0[0], l0[1], l0[2], l0[3], h0[0], h0[1], h0[2], h0[3]}, v1 = (bf16x8){l1[0], l1[1], l1[2], l1[3], h1[0], h1[1], h1[2], h1[3]};
        o0 = MFMA32(v0, pf[ks], o0); o1 = MFMA32(v1, pf[ks], o1);
    }
}
struct VFrag { bf16x8 v0[4], v1[4]; };
__device__ __forceinline__ void v_load64(VFrag& f, lds_cptr vp) {
#pragma unroll
    for (int ks = 0; ks < 4; ++ks) {
        const s16x4 l0 = vtr(vp + ks * 1024), h0 = vtr(vp + ks * 1024 + 512), l1 = vtr(vp + 4096 + ks * 1024), h1 = vtr(vp + 4096 + ks * 1024 + 512);
        f.v0[ks] = (bf16x8){l0[0], l0[1], l0[2], l0[3], h0[0], h0[1], h0[2], h0[3]}; f.v1[ks] = (bf16x8){l1[0], l1[1], l1[2], l1[3], h1[0], h1[1], h1[2], h1[3]};
    }
}
__device__ __forceinline__ void pv64f(f32x16& o0, f32x16& o1, const VFrag& f, const bf16x8 (&pf)[4]) {
#pragma unroll
    for (int ks = 0; ks < 4; ++ks) { o0 = MFMA32(f.v0[ks], pf[ks], o0); o1 = MFMA32(f.v1[ks], pf[ks], o1); }
}
__device__ __forceinline__ void pack_p(const f32x16& p0, const f32x16& p1, bf16x8 (&pf)[4]) {
    u32x4 w0, w1, w2, w3;
    w0.x = cvtpk(p0[0], p0[1]); w0.y = cvtpk(p0[2], p0[3]); w0.z = cvtpk(p0[4], p0[5]); w0.w = cvtpk(p0[6], p0[7]);
    w1.x = cvtpk(p0[8], p0[9]); w1.y = cvtpk(p0[10], p0[11]); w1.z = cvtpk(p0[12], p0[13]); w1.w = cvtpk(p0[14], p0[15]);
    w2.x = cvtpk(p1[0], p1[1]); w2.y = cvtpk(p1[2], p1[3]); w2.z = cvtpk(p1[4], p1[5]); w2.w = cvtpk(p1[6], p1[7]);
    w3.x = cvtpk(p1[8], p1[9]); w3.y = cvtpk(p1[10], p1[11]); w3.z = cvtpk(p1[12], p1[13]); w3.w = cvtpk(p1[14], p1[15]);
    pf[0] = __builtin_bit_cast(bf16x8, w0); pf[1] = __builtin_bit_cast(bf16x8, w1); pf[2] = __builtin_bit_cast(bf16x8, w2); pf[3] = __builtin_bit_cast(bf16x8, w3);
}
template <bool HOIST = true> __device__ __forceinline__ void softmax_pv64(f32x16& p0, f32x16& p1, AState& s, lds_cptr vp, int hi) {
    VFrag vf; if (HOIST) { v_load64(vf, vp); __builtin_amdgcn_sched_barrier(0); }
    float mx = fmaxf(p0[0], p1[0]);
#pragma unroll
    for (int r = 1; r < 16; ++r) mx = fmaxf(mx, fmaxf(p0[r], p1[r]));
    mx = fmaxf(mx, other_half(mx, hi));
    const float mn = fmaxf(s.m, mx), ms = (mn == NEG_INF) ? 0.f : mn;
    const float alpha = fast_exp2(s.m - ms);
    float rs = 0.f;
#pragma unroll
    for (int r = 0; r < 16; ++r) { p0[r] = fast_exp2(p0[r] - ms); p1[r] = fast_exp2(p1[r] - ms); rs += p0[r] + p1[r]; }
    rs += other_half(rs, hi);
    s.l = s.l * alpha + rs; s.m = mn;
#pragma unroll
    for (int r = 0; r < 16; ++r) { s.o0[r] *= alpha; s.o1[r] *= alpha; }
    bf16x8 pf[4]; pack_p(p0, p1, pf);
    if (HOIST) pv64f(s.o0, s.o1, vf, pf); else pv64(s.o0, s.o1, vp, pf);
}
__device__ __forceinline__ void softmax_fixed_pv64(f32x16& p0, f32x16& p1, AState& s, lds_cptr vp) {
    VFrag vf; v_load64(vf, vp); __builtin_amdgcn_sched_barrier(0);
    float rs = 0.f;
#pragma unroll
    for (int r = 0; r < 16; ++r) { p0[r] = fast_exp2(p0[r]); p1[r] = fast_exp2(p1[r]); rs += p0[r] + p1[r]; }
    s.l += rs;
    bf16x8 pf[4]; pack_p(p0, p1, pf);
    pv64f(s.o0, s.o1, vf, pf);
}
template <bool HOIST> __device__ __forceinline__ void softmax_shift_pv64(f32x16& p0, f32x16& p1, AState& s, lds_cptr vp, float bnd) {
    VFrag vf; if (HOIST) { v_load64(vf, vp); __builtin_amdgcn_sched_barrier(0); }
    float rs = 0.f;
#pragma unroll
    for (int r = 0; r < 16; ++r) { p0[r] = fast_exp2(p0[r] - bnd); p1[r] = fast_exp2(p1[r] - bnd); rs += p0[r] + p1[r]; }
    s.l += rs;
    bf16x8 pf[4]; pack_p(p0, p1, pf);
    if (HOIST) pv64f(s.o0, s.o1, vf, pf); else pv64(s.o0, s.o1, vp, pf);
}
template <bool MASK> __device__ __forceinline__ void softmax_raw_pv64(f32x16& p0, f32x16& p1, AState& s, lds_cptr vp, bool keep) {
    float rs = 0.f;
#pragma unroll
    for (int r = 0; r < 16; ++r) { p0[r] = fast_exp2(p0[r]); p1[r] = fast_exp2(p1[r]); rs += p0[r] + p1[r]; }
    bf16x8 pf[4]; pack_p(p0, p1, pf);
    if (MASK) { const unsigned km = keep ? 0xffffffffu : 0u; rs = keep ? rs : 0.f;
#pragma unroll
        for (int k = 0; k < 4; ++k) { u32x4 w = __builtin_bit_cast(u32x4, pf[k]); w.x &= km; w.y &= km; w.z &= km; w.w &= km; pf[k] = __builtin_bit_cast(bf16x8, w); } }
    s.l += rs;
    pv64(s.o0, s.o1, vp, pf);
}
__device__ __forceinline__ void mask_causal(f32x16& p0, f32x16& p1, int kpos0, int tq, int hi) {
#pragma unroll
    for (int r = 0; r < 16; ++r) { const int kp = kpos0 + crow(r, hi); if (kp > tq) p0[r] = NEG_INF; if (kp + 32 > tq) p1[r] = NEG_INF; }
}
__device__ __forceinline__ void add_table(f32x16& p0, f32x16& p1, const LAS float* tb) {
#pragma unroll
    for (int r = 0; r < 16; ++r) { const int o = (r & 3) + 8 * (r >> 2); p0[r] += tb[o]; p1[r] += tb[o + 32]; }
}
__device__ __forceinline__ void store_o_bf16(bf16_t* orow, const f32x16& o0, const f32x16& o1, float sc, int hi) {
#pragma unroll
    for (int g = 0; g < 4; ++g) {
        u32x2 w0, w1; w0.x = cvtpk(o0[4 * g] * sc, o0[4 * g + 1] * sc); w0.y = cvtpk(o0[4 * g + 2] * sc, o0[4 * g + 3] * sc);
        w1.x = cvtpk(o1[4 * g] * sc, o1[4 * g + 1] * sc); w1.y = cvtpk(o1[4 * g + 2] * sc, o1[4 * g + 3] * sc);
        *(u32x2*)(orow + 8 * g + 4 * hi) = w0; *(u32x2*)(orow + 32 + 8 * g + 4 * hi) = w1;
    }
}
constexpr int OST_OFF = 90112, OST_PITCH = 144, OST_WAVE = 32 * OST_PITCH;
template <class RowPtr> __device__ __forceinline__ void store_o_staged(lds_ptr lds, int wid, int lane, const f32x16& o0, const f32x16& o1, float sc, const RowPtr& rowp) {
    const int r32 = lane & 31, hi = lane >> 5;
    lds_ptr stg = lds + OST_OFF + wid * OST_WAVE;
#pragma unroll
    for (int g = 0; g < 4; ++g) {
        u32x2 w0, w1; w0.x = cvtpk(o0[4 * g] * sc, o0[4 * g + 1] * sc); w0.y = cvtpk(o0[4 * g + 2] * sc, o0[4 * g + 3] * sc);
        w1.x = cvtpk(o1[4 * g] * sc, o1[4 * g + 1] * sc); w1.y = cvtpk(o1[4 * g + 2] * sc, o1[4 * g + 3] * sc);
        *(LAS u32x2*)(stg + r32 * OST_PITCH + (8 * g + 4 * hi) * 2) = w0; *(LAS u32x2*)(stg + r32 * OST_PITCH + 64 + (8 * g + 4 * hi) * 2) = w1;
    }
    asm volatile("" ::: "memory");
#pragma unroll
    for (int i = 0; i < 4; ++i) { const int row = i * 8 + (lane >> 3), ch = lane & 7;
        const u32x4 v = *(const LAS u32x4*)(stg + row * OST_PITCH + ch * 16);
        *(u32x4*)(rowp(row) + ch * 8) = v; }
    asm volatile("" ::: "memory");
}
constexpr size_t MiB = 1u << 20, KiB = 1u << 10;
constexpr size_t WS_CTL = 0, CTL_ZERO_BYTES = 1 * MiB;
constexpr size_t WS_ROPE = 1 * MiB, WS_NSATAB = WS_ROPE + 512 * KiB, WS_DILTAB = WS_NSATAB + 32 * KiB, WS_CMPB = WS_DILTAB + 8 * KiB, WS_FARB = WS_CMPB + 4 * KiB;
constexpr size_t WS_WT = 4 * MiB, LW = 38 * MiB;
constexpr size_t LW_IN = 0, LW_G = 6 * MiB, LW_BR = 14 * MiB, LW_O = 16 * MiB, LW_UP = 18 * MiB, LW_DN = 29 * MiB, LW_UQ = 35 * MiB, LW_UKV = 35 * MiB + 256 * KiB, LW_PHI = 36 * MiB;
constexpr size_t BR_A = 0, BR_B = 512 * KiB, BR_C = 768 * KiB, BR_D = 1280 * KiB;
constexpr size_t WS_SIDE = 80 * MiB, WS_SSQQ = 84 * MiB, WS_SSQKV = 85 * MiB, WS_KB = 86 * MiB, WS_KROT = 87 * MiB, WS_KCMP = 91 * MiB, WS_VCMP = 100 * MiB,
                 WS_HID = 109 * MiB, WS_KMAX = 3 * MiB + 128 * KiB  , WS_LF = 2 * MiB  , WS_CMPP = 3 * MiB  , WS_ORDER = 3 * MiB + 64 * KiB  , WS_KC = 113 * MiB, WS_VC = 113 * MiB + 512 * KiB, WS_DLSE = 114 * MiB, WS_DOG = 116 * MiB;
constexpr size_t WS_H = 164 * MiB, WS_OCAT = 292 * MiB, WS_QM = 404 * MiB, WS_KVM = 468 * MiB, WS_P = 532 * MiB;
constexpr size_t WS_MERGED = 532 * MiB, WS_MSCR = 660 * MiB, WS_Y = 164 * MiB  , WS_H2 = 756 * MiB, WS_ACT = 164 * MiB  , WS_HB = 532 * MiB  , WS_Y2 = 884 * MiB  , WS_X3 = 620 * MiB  , WS_END = 1024 * MiB;
constexpr size_t MSCR_PER_WG = 512 * KiB;
constexpr size_t WS_CWS = 3 * MiB + 256 * KiB;
constexpr size_t H8_OFF = 128 * MiB;
static_assert(WS_WT + 2 * LW <= WS_SIDE && WS_DOG + 48 * MiB <= WS_H && WS_P + 384 * MiB <= WS_END && WS_MSCR + 256 * MSCR_PER_WG <= WS_P + 384 * MiB && WS_H2 + 128 * MiB <= WS_Y2 && WS_Y2 + 128 * MiB <= WS_END, "ws map");
static_assert(WS_ACT + 352 * MiB <= WS_HB && WS_HB + 88 * MiB <= WS_X3 && WS_X3 + 128 * MiB <= WS_H2 && WS_Y + 128 * MiB <= WS_OCAT, "ws overlays");
constexpr int CW_BAR = 4096;
constexpr int CW_KMAX = 24576;
constexpr int CW_KMLA = 24832;
constexpr int CW_KROT = 25344;
constexpr int CW_KCMX = 25856;
constexpr int CW_QNSA = 25792;
constexpr int CW_KNSA = 25664;
constexpr int CW_Q = 16384;

constexpr int RING_BYTES = 131072, LDSCTL_OFF = RING_BYTES, MISC_OFF = LDSCTL_OFF + 320, LDS_BYTES = 147456;
constexpr int NSA_SLAB = 49152, NSA_SLAB_BYTES = 4 * 64 * 65 * 4, NSA_SEL = NSA_SLAB + NSA_SLAB_BYTES;
static_assert(NSA_SEL + 512 <= RING_BYTES && 4 * NSA_TL * 4 <= NSA_SLAB_BYTES && 2 * TB_SIZE <= NSA_SLAB, "NSA LDS map");

struct Frame {
    LAS unsigned char* lds; volatile LAS unsigned* MISC; gu32* ctl;
    int tid, lane, wave, G;
    const float* in[27]; float* out; unsigned char* ws;
};
#define WSP(T, off) ((T*)(F.ws + (off)))
#define VM_WAIT() asm volatile("s_waitcnt vmcnt(0)" ::: "memory")
#define LDS_WAIT() asm volatile("s_waitcnt lgkmcnt(0)" ::: "memory")

__device__ __forceinline__ int queue_grab(Frame& F, gu32* ctr) {
    if (F.tid == 0) F.MISC[0] = __hip_atomic_fetch_add(ctr, 1u, __ATOMIC_RELAXED, __HIP_MEMORY_SCOPE_AGENT);
    __syncthreads();
    const int v = (int)F.MISC[0];
    __syncthreads();
    return v;
}

template <bool FOX> __device__ __forceinline__ void causal_unit(Frame& F, int b, int h, int qb, float kmax_in) {
    constexpr int NKS = FOX ? 4 : 6;
    int lane_o = lane_now();
    const int wid = F.wave, lane = lane_o, r32 = lane & 31, hi = lane >> 5;
    const size_t rowbase = (size_t)b * SEQ;
    const int q0 = qb * 256, tq = q0 + wid * 32 + r32, NT = qb * 4 + 4;
    const bf16_t* P = WSP(const bf16_t, WS_P);
    const bf16_t *Kb, *Vb, *Qrow; int kpitch, vpitch;
    const bf16_t* Kr = WSP(const bf16_t, WS_KROT) + rowbase * 32;
    const float* kbsrc = WSP(const float, WS_KB) + (size_t)(b * 4 + h) * SEQ;
    if (FOX) { Kb = P + rowbase * PW + PC_CK + h * 64; Vb = P + rowbase * PW + PC_CV + h * 64; kpitch = PW; vpitch = PW; Qrow = P + (rowbase + tq) * PW + PC_CQ + h * 64; }
    else { const bf16_t* KV = WSP(const bf16_t, WS_KVM) + rowbase * 512 + h * 128; Kb = KV; Vb = KV + 64; kpitch = 512; vpitch = 512; Qrow = WSP(const bf16_t, WS_QM) + (rowbase + tq) * 512 + h * 96; }
    bf16x8 qf[NKS];
#pragma unroll
    for (int ks = 0; ks < NKS; ++ks) qf[ks] = *(const bf16x8*)(Qrow + ks * 16 + hi * 8);
    AState st; astate_init(st);
    lds_ptr lds = (lds_ptr)F.lds;
    const int vpo = ((lane >> 4) & 1) * 32 + (lane & 3) * 8 + (4 * hi + ((lane & 15) >> 2)) * 64;
    Stg sA, sB;
#define CU_LOAD(S, t) do { S.k = *(const u32x4*)(Kb + (size_t)((t) * 64 + lane) * kpitch + wid * 8); \
        if (!FOX) { if (wid < 4) S.k2 = *(const u32x4*)(Kr + (size_t)((t) * 64 + lane) * 32 + wid * 8); } \
        S.v = *(const u32x4*)(Vb + (size_t)((t) * 64 + 16 * (wid & 3) + (lane >> 2)) * vpitch + (wid >> 2) * 32 + (lane & 3) * 8); \
        if (FOX) { if (wid == 0) S.kb = kbsrc[(t) * 64 + lane]; else if (wid == 1) S.kb = kbsrc[(t) > 0 ? (t) * 64 - 1 : 0]; } } while (0)
#define CU_WRITE(S, bofs) do { lds_ptr bp = lds + (bofs); *(LAS u32x4*)(bp + wid * 1024 + lane * 16) = S.k; \
        if (!FOX) { if (wid < 4) *(LAS u32x4*)(bp + (8 + wid) * 1024 + lane * 16) = S.k2; } \
        *(LAS u32x4*)(bp + TB_V + wid * 1024 + lane * 16) = S.v; \
        if (FOX) { if (wid == 0) *(LAS float*)(bp + TB_KB + lane * 4) = S.kb; else if (wid == 1 && lane == 0) *(LAS float*)(bp + TB_KB + 256) = S.kb; } } while (0)
    const int tq_lo = q0 + wid * 32;
    float qn = 0.f; const float kmax = kmax_in;
#pragma unroll
    for (int ks = 0; ks < NKS; ++ks)
#pragma unroll
        for (int e = 0; e < 8; ++e) { const float x = bf2f((unsigned short)qf[ks][e]); qn += x * x; }
    qn += other_half(qn, hi); qn = sqrtf(qn);
    const float bnd = qn * kmax * 1.002f + 0.05f;
    const bool fast = __all(bnd <= 50.0f);
    const float kbi = FOX ? kbsrc[tq] : 0.f;
    f32x16 cinit;
    { const float c0 = -(bnd + kbi);
#pragma unroll
      for (int r = 0; r < 16; ++r) cinit[r] = c0; }
    LAS volatile unsigned* dflag = (LAS volatile unsigned*)(lds + 4 * TB_SIZE + 64);
#define CU_TILE(T, BOFS) { const int t = (T); lds_cptr bp = (lds_cptr)(lds + (BOFS)); \
        if (64 * t <= tq_lo + 31) {                                \
            f32x16 p0, p1; \
            if (fast) qk64c<NKS>(bp, qf, r32, hi, cinit, p0, p1); \
            else { _Pragma("unroll") for (int r = 0; r < 16; ++r) { p0[r] = 0.f; p1[r] = 0.f; } qk64<NKS>(bp, qf, r32, hi, p0, p1); } \
            if (FOX) { const LAS float* kbt = (const LAS float*)(bp + TB_KB) + 4 * hi; \
                _Pragma("unroll") for (int g = 0; g < 4; ++g) { const f32x4 a = *(const LAS f32x4*)(kbt + 8 * g), c = *(const LAS f32x4*)(kbt + 32 + 8 * g); \
                    _Pragma("unroll") for (int e = 0; e < 4; ++e) { p0[4 * g + e] += a[e]; p1[4 * g + e] += c[e]; } } } \
            if (64 * t + 63 > tq_lo) mask_causal(p0, p1, 64 * t, tq, hi); \
            if (fast) softmax_fixed_pv64(p0, p1, st, bp + TB_V + vpo); else softmax_pv64(p0, p1, st, bp + TB_V + vpo, hi); \
        } }
    const int NP = NT >> 1;
#define CU_TA(p) (FOX ? NT - 1 - 2 * (p) : 2 * (p))
#define CU_TB(p) (FOX ? NT - 2 - 2 * (p) : 2 * (p) + 1)
    CU_LOAD(sA, CU_TA(0)); CU_LOAD(sB, CU_TB(0)); CU_WRITE(sA, 0); CU_WRITE(sB, TB_SIZE);
    __syncthreads();
    for (int p = 0; p < NP; ++p) {
        const int pofs = (p & 1) * 2 * TB_SIZE, nofs = ((p & 1) ^ 1) * 2 * TB_SIZE;
        if (p + 1 < NP) { CU_LOAD(sA, CU_TA(p + 1)); CU_LOAD(sB, CU_TB(p + 1)); }
        { const int ta_ = CU_TA(p), tbb_ = CU_TB(p), tmax_ = ta_ > tbb_ ? ta_ : tbb_;
          if (fast && 64 * tmax_ + 63 <= tq_lo) {
              lds_cptr bpa = (lds_cptr)(lds + pofs), bpb = (lds_cptr)(lds + pofs + TB_SIZE);
              f32x16 a0, a1, b0, b1;
              qk64c<NKS>(bpa, qf, r32, hi, cinit, a0, a1);
              qk64c<NKS>(bpb, qf, r32, hi, cinit, b0, b1);
              if (FOX) { const LAS float* ka = (const LAS float*)(bpa + TB_KB) + 4 * hi; const LAS float* kb2 = (const LAS float*)(bpb + TB_KB) + 4 * hi;
#pragma unroll
                  for (int g = 0; g < 4; ++g) { const f32x4 x = *(const LAS f32x4*)(ka + 8 * g), y = *(const LAS f32x4*)(ka + 32 + 8 * g), z = *(const LAS f32x4*)(kb2 + 8 * g), w = *(const LAS f32x4*)(kb2 + 32 + 8 * g);
#pragma unroll
                      for (int e = 0; e < 4; ++e) { a0[4 * g + e] += x[e]; a1[4 * g + e] += y[e]; b0[4 * g + e] += z[e]; b1[4 * g + e] += w[e]; } } }
              VFrag va; v_load64(va, bpa + TB_V + vpo);
              float rs = 0.f;
#pragma unroll
              for (int r = 0; r < 16; ++r) { a0[r] = fast_exp2(a0[r]); a1[r] = fast_exp2(a1[r]); rs += a0[r] + a1[r]; }
              bf16x8 pfa[4]; pack_p(a0, a1, pfa);
              pv64f(st.o0, st.o1, va, pfa);
              VFrag vb; v_load64(vb, bpb + TB_V + vpo);
#pragma unroll
              for (int r = 0; r < 16; ++r) { b0[r] = fast_exp2(b0[r]); b1[r] = fast_exp2(b1[r]); rs += b0[r] + b1[r]; }
              st.l += rs;
              bf16x8 pfb[4]; pack_p(b0, b1, pfb);
              pv64f(st.o0, st.o1, vb, pfb);
          } else {
              CU_TILE(ta_, pofs)
              CU_TILE(tbb_, pofs + TB_SIZE)
          } }
        const int tb_ = CU_TB(p);
        if (FOX) { if (tb_ > 0) { const float kb_last = *(const LAS float*)(lds + pofs + TB_SIZE + TB_KB + 256); const bool done = fast ? ((kb_last - kbi) < -150.0f) : ((qn * kmax + kb_last - st.m) < -130.0f); const unsigned alld = __all(done) ? 1u : 0u; if (lane == 0) dflag[(p & 1) * 8 + wid] = alld; } }
        if (p + 1 < NP) { CU_WRITE(sA, nofs); CU_WRITE(sB, nofs + TB_SIZE); }
        __syncthreads();
        if (FOX) { if (tb_ > 0) { unsigned all = 1u;
#pragma unroll
                for (int w = 0; w < 8; ++w) all &= dflag[(p & 1) * 8 + w];
                if (all) break; } }
    }
#undef CU_TA
#undef CU_TB
#undef CU_TILE
#undef CU_LOAD
#undef CU_WRITE
    bf16_t* obase = WSP(bf16_t, WS_OCAT) + (rowbase + tq_lo) * OCW + (FOX ? 384 : 640) + h * 64;
    const float ltot = fast ? st.l + other_half(st.l, hi) : st.l;
    store_o_staged(lds, wid, lane, st.o0, st.o1, 1.0f / ltot, [&](int r) { return obase + (size_t)r * OCW; });
}
template <bool FAST> __device__ __forceinline__ void nsa_unit(Frame& F, int b, int qblk, int l) {
    int lane_o = lane_now();
    const int wid = F.wave, lane = lane_o, r32 = lane & 31, hi = lane >> 5, tid = wid * 64 + lane;
    const int h = wid & 3, qs = wid >> 2;
    const int q0 = qblk * 64, cur = qblk, tq = q0 + 32 * qs + r32, tq_lo = q0 + 32 * qs;
    const size_t rowbase = (size_t)b * SEQ, row = rowbase + tq;
    const bf16_t* P = WSP(const bf16_t, WS_P);
    lds_ptr lds = (lds_ptr)F.lds;
    const int vpo = ((lane >> 4) & 1) * 32 + (lane & 3) * 8 + (4 * hi + ((lane & 15) >> 2)) * 64;
    bf16x8 qf[4];
    { const bf16_t* Qrow = P + row * PW + PC_AQ + h * 64;
#pragma unroll
      for (int ks = 0; ks < 4; ++ks) qf[ks] = *(const bf16x8*)(Qrow + ks * 16 + hi * 8); }
    Stg s; int ln;
#define NS_LOAD(Kb, kp, Vb, vp_, t) do { s.k = *(const u32x4*)((Kb) + (size_t)((t) * 64 + ln) * (kp) + wid * 8); \
        s.v = *(const u32x4*)((Vb) + (size_t)((t) * 64 + 16 * (wid & 3) + (ln >> 2)) * (vp_) + (wid >> 2) * 32 + (ln & 3) * 8); } while (0)
#define NS_FRESH() do { ln = lane; asm volatile("" : "+v"(ln)); } while (0)
#define NS_WRITE(bi) do { lds_ptr bp_ = lds + (bi) * TB_SIZE; *(LAS u32x4*)(bp_ + wid * 1024 + lane * 16) = s.k; *(LAS u32x4*)(bp_ + TB_V + wid * 1024 + lane * 16) = s.v; } while (0)
    const bf16_t* KC = WSP(const bf16_t, WS_KC) + (size_t)b * 256 * 64; const bf16_t* VC = WSP(const bf16_t, WS_VC) + (size_t)b * 256 * 64;
    const int cmax_u = (q0 + 63 - 31) >> 4, NTc = (cmax_u >> 6) + 1;
    const int cmax = (tq - 31) >> 4;
    float cm = NEG_INF, cl = 0.f;
    if constexpr (!FAST) {
    NS_FRESH(); NS_LOAD(KC, 64, VC, 64, 0); NS_WRITE(0);
    __syncthreads();
    for (int t = 0; t < NTc; ++t) {
        const int bi = t & 1;
        if (t + 1 < NTc) NS_LOAD(KC, 64, VC, 64, t + 1);
        { lds_cptr bp = (lds_cptr)(lds + bi * TB_SIZE); f32x16 p0, p1;
#pragma unroll
          for (int r = 0; r < 16; ++r) { p0[r] = 0.f; p1[r] = 0.f; }
          qk64<4>(bp, qf, r32, hi, p0, p1);
          float mx = NEG_INF;
#pragma unroll
          for (int r = 0; r < 16; ++r) { const int c = 64 * t + crow(r, hi); if (c > cmax) p0[r] = NEG_INF; if (c + 32 > cmax) p1[r] = NEG_INF; mx = fmaxf(mx, fmaxf(p0[r], p1[r])); }
          mx = fmaxf(mx, other_half(mx, hi));
          const float mn = fmaxf(cm, mx), ms = (mn == NEG_INF) ? 0.f : mn; float rs = 0.f;
#pragma unroll
          for (int r = 0; r < 16; ++r) rs += fast_exp2(p0[r] - ms) + fast_exp2(p1[r] - ms);
          rs += other_half(rs, hi);
          cl = cl * fast_exp2(cm - ms) + rs; cm = mn; }
        if (t + 1 < NTc) NS_WRITE(bi ^ 1);
        __syncthreads();
    }
    }
    const float cms = (cm == NEG_INF) ? 0.f : cm; float cinv = FAST ? 1.0f : 1.0f / fmaxf(cl, 1e-30f);
    f32x16 oc0, oc1;
#pragma unroll
    for (int r = 0; r < 16; ++r) { oc0[r] = 0.f; oc1[r] = 0.f; }
    float G[32]; float carry = 0.f;
#pragma unroll
    for (int i = 0; i < 32; ++i) G[i] = 0.f;
    NS_FRESH(); NS_LOAD(KC, 64, VC, 64, 0); NS_WRITE(0);
    __syncthreads();
#pragma unroll
    for (int t = 0; t < 4; ++t) {
        if (t < NTc) {
            const int bi = t & 1;
            if (t + 1 < NTc) NS_LOAD(KC, 64, VC, 64, t + 1);
            { lds_cptr bp = (lds_cptr)(lds + bi * TB_SIZE); f32x16 p0, p1;
#pragma unroll
              for (int r = 0; r < 16; ++r) { p0[r] = 0.f; p1[r] = 0.f; }
              qk64<4>(bp, qf, r32, hi, p0, p1);
#pragma unroll
              for (int r = 0; r < 16; ++r) { const int c = 64 * t + crow(r, hi);
                  if constexpr (FAST) { p0[r] = (c > cmax) ? 0.f : fast_exp2(p0[r]); p1[r] = (c + 32 > cmax) ? 0.f : fast_exp2(p1[r]); cl += p0[r] + p1[r]; }
                  else { p0[r] = (c > cmax) ? 0.f : fast_exp2(p0[r] - cms) * cinv; p1[r] = (c + 32 > cmax) ? 0.f : fast_exp2(p1[r] - cms) * cinv; } }
#pragma unroll
              for (int g = 0; g < 4; ++g) { const float oth = other_half(p0[4 * g + 3], hi);
                  G[t * 8 + g] = ((p0[4 * g] + p0[4 * g + 1]) + (p0[4 * g + 2] + p0[4 * g + 3])) + (hi ? oth : carry); carry = oth; }
#pragma unroll
              for (int g = 0; g < 4; ++g) { const float oth = other_half(p1[4 * g + 3], hi);
                  G[t * 8 + 4 + g] = ((p1[4 * g] + p1[4 * g + 1]) + (p1[4 * g + 2] + p1[4 * g + 3])) + (hi ? oth : carry); carry = oth; }
              bf16x8 pf[4]; pack_p(p0, p1, pf);
              pv64(oc0, oc1, bp + TB_V + vpo, pf); }
            if (t + 1 < NTc) NS_WRITE(bi ^ 1);
            __syncthreads();
        }
    }
    if constexpr (FAST) {
        cl += other_half(cl, hi); cinv = 1.0f / fmaxf(cl, 1e-30f);
#pragma unroll
        for (int i = 0; i < 32; ++i) G[i] *= cinv;
#pragma unroll
        for (int r = 0; r < 16; ++r) { oc0[r] *= cinv; oc1[r] *= cinv; } }
    { LAS float* slab = (LAS float*)(lds + NSA_SLAB) + (size_t)(h * 64 + 32 * qs + r32) * 65;
#pragma unroll
      for (int i = 0; i < 32; ++i) slab[2 * i + hi] = G[i]; }
    __syncthreads();
    u32x4 tbr[4]; { const u32x4* src = WSP(const u32x4, WS_NSATAB);
#pragma unroll
      for (int i = 0; i < 4; ++i) { const int idx = tid + 512 * i; tbr[i] = (idx < 4 * NSA_TL / 4) ? src[idx] : (u32x4){0u, 0u, 0u, 0u}; } }
    { const int q = tid >> 3, jg = tid & 7;
      LAS float* s0 = (LAS float*)(lds + NSA_SLAB) + (size_t)q * 65;
      float xs[8];
#pragma unroll
      for (int e = 0; e < 8; ++e) { const int j = 8 * jg + e; xs[e] = (s0[j] + s0[64 * 65 + j]) + (s0[2 * 64 * 65 + j] + s0[3 * 64 * 65 + j]); }
#pragma unroll
      for (int e = 0; e < 8; ++e) s0[8 * jg + e] = xs[e];
      asm volatile("s_waitcnt lgkmcnt(0)" ::: "memory");
      float v[64];
#pragma unroll
      for (int k = 0; k < 64; ++k) { const float x = s0[k];
          v[k] = (k == 0 || k == cur || k == cur - 1) ? 1e9f : ((k > cur) ? -1e9f : x); if ((k & 7) == 7) asm volatile("" ::: "memory"); }
      unsigned bits = 0u;
#pragma unroll
      for (int e = 0; e < 8; ++e) { const int j = 8 * jg + e;
          const float xj = xs[e];
          const float vj = (j == 0 || j == cur || j == cur - 1) ? 1e9f : ((j > cur) ? -1e9f : xj);
          int rank = 0;
#pragma unroll
          for (int k = 0; k < 64; ++k) rank += (v[k] > vj || (v[k] == vj && k < j)) ? 1 : 0;
          bits |= (rank < 16 ? 1u : 0u) << e; }
      *((LAS unsigned char*)(lds + NSA_SEL) + q * 8 + jg) = (unsigned char)bits; }
    __syncthreads();
    const unsigned mlo = *(const LAS unsigned*)(lds + NSA_SEL + (32 * qs + r32) * 8), mhi = *(const LAS unsigned*)(lds + NSA_SEL + (32 * qs + r32) * 8 + 4);
    { LAS u32x4* dst = (LAS u32x4*)(lds + NSA_SLAB);
#pragma unroll
      for (int i = 0; i < 4; ++i) { const int idx = tid + 512 * i; if (idx < 4 * NSA_TL / 4) dst[idx] = tbr[i]; } }
    const LAS float* tabh = (const LAS float*)(lds + NSA_SLAB) + h * NSA_TL;
    AState st; astate_init(st);
    { const bf16_t* Kb = P + rowbase * PW + PC_KSLC; const bf16_t* Vb = P + rowbase * PW + PC_VSLC;
      NS_FRESH(); NS_LOAD(Kb, PW, Vb, PW, 0); NS_WRITE(0);
      __syncthreads();
      for (int j = 0; j <= cur; ++j) {
          const int bi = j & 1;
          if (j < cur) NS_LOAD(Kb, PW, Vb, PW, j + 1);
          const bool mine = ((j < 32) ? (mlo >> j) : (mhi >> (j - 32))) & 1u;
          if (__any(mine)) {
              lds_cptr bp = (lds_cptr)(lds + bi * TB_SIZE); f32x16 p0, p1;
#pragma unroll
              for (int r = 0; r < 16; ++r) { p0[r] = 0.f; p1[r] = 0.f; }
              qk64<4>(bp, qf, r32, hi, p0, p1);
              const bool farj = (q0 - 64 * j - 63 >= NSA_DFAR);
              if constexpr (FAST) {
                  if (!farj) add_table(p0, p1, tabh + (NSA_DMAX - tq + 64 * j + 4 * hi));
                  if (j == cur) mask_causal(p0, p1, 64 * j, tq, hi);
                  softmax_raw_pv64<true>(p0, p1, st, bp + TB_V + vpo, mine);
              } else {
                  if (!farj) add_table(p0, p1, tabh + (NSA_DMAX - tq + 64 * j + 4 * hi));
                  if (j == cur) mask_causal(p0, p1, 64 * j, tq, hi);
                  if (!mine) {
#pragma unroll
                      for (int r = 0; r < 16; ++r) { p0[r] = NEG_INF; p1[r] = NEG_INF; } }
                  softmax_pv64<false>(p0, p1, st, bp + TB_V + vpo, hi);
              }
          }
          if (j < cur) NS_WRITE(bi ^ 1);
          __syncthreads();
      } }
    f32x16 oa0, oa1;
    { int rw_ = (int)row; asm volatile("" : "+v"(rw_)); const float* sd = WSP(const float, WS_SIDE) + (size_t)rw_ * 16 + h * 3;
      const float g0 = sigmoid_f(sd[0]), sc = sigmoid_f(sd[1]) / (FAST ? st.l + other_half(st.l, hi) : st.l);
#pragma unroll
      for (int r = 0; r < 16; ++r) { oa0[r] = g0 * oc0[r] + sc * st.o0[r]; oa1[r] = g0 * oc1[r] + sc * st.o1[r]; } }
    astate_init(st);
    { const bf16_t* Kb = P + rowbase * PW + PC_KWIN; const bf16_t* Vb = P + rowbase * PW + PC_VWIN;
      const int jlo = cur >= 8 ? cur - 8 : 0;
      NS_FRESH(); NS_LOAD(Kb, PW, Vb, PW, jlo); NS_WRITE(0);
      __syncthreads();
      for (int j = jlo; j <= cur; ++j) {
          const int bi = (j - jlo) & 1;
          if (j < cur) NS_LOAD(Kb, PW, Vb, PW, j + 1);
          if (tq_lo - 64 * j - 63 < 512) {
              lds_cptr bp = (lds_cptr)(lds + bi * TB_SIZE); f32x16 p0, p1;
#pragma unroll
              for (int r = 0; r < 16; ++r) { p0[r] = 0.f; p1[r] = 0.f; }
              qk64<4>(bp, qf, r32, hi, p0, p1);
              add_table(p0, p1, tabh + (NSA_DMAX - tq + 64 * j + 4 * hi));
              if (!(tq_lo - 64 * j - 63 >= 0 && tq_lo + 31 - 64 * j < 512)) {
                  const int d0 = tq - 64 * j - 4 * hi;
#pragma unroll
                  for (int r = 0; r < 16; ++r) { const int d = d0 - ((r & 3) + 8 * (r >> 2)); if (d < 0 || d >= 512) p0[r] = NEG_INF; if (d - 32 < 0 || d - 32 >= 512) p1[r] = NEG_INF; }
              }
              if constexpr (FAST) softmax_raw_pv64<false>(p0, p1, st, bp + TB_V + vpo, true); else softmax_pv64<false>(p0, p1, st, bp + TB_V + vpo, hi);
          }
          if (j < cur) NS_WRITE(bi ^ 1);
          __syncthreads();
      } }
    { int rw_ = (int)row; asm volatile("" : "+v"(rw_)); const float sc = sigmoid_f(WSP(const float, WS_SIDE)[(size_t)rw_ * 16 + h * 3 + 2]) / (FAST ? st.l + other_half(st.l, hi) : st.l);
#pragma unroll
      for (int r = 0; r < 16; ++r) { oa0[r] += sc * st.o0[r]; oa1[r] += sc * st.o1[r]; } }
    { int tl_ = tq_lo; asm volatile("" : "+s"(tl_)); bf16_t* obase = WSP(bf16_t, WS_OCAT) + (rowbase + tl_) * OCW + h * 64;
      store_o_staged(lds, wid, lane, oa0, oa1, 1.0f, [&](int r) { return obase + (size_t)r * OCW; }); }
#undef NS_LOAD
#undef NS_FRESH
#undef NS_WRITE
}
__device__ __forceinline__ void dil_unit(Frame& F, int b, int hh, int span) {
    int lane_o = lane_now();
    const int wid = F.wave, lane = lane_o, r32 = lane & 31, hi = lane >> 5, tid = wid * 64 + lane;
    const int T0 = span * 512;
    const size_t rowbase = (size_t)b * SEQ;
    const bf16_t* P = WSP(const bf16_t, WS_P) + rowbase * PW;
    lds_ptr lds = (lds_ptr)F.lds;
    LAS float* dtab = (LAS float*)(lds + 32768);
    for (int i = tid; i < 3 * 192; i += 512) dtab[i] = WSP(const float, WS_DILTAB)[((i / 192) * 2 + hh) * 192 + (i % 192)];
    __syncthreads();
    lds_ptr vst = lds + wid * 4096;
    const int vpo = ((lane >> 4) & 1) * 32 + (lane & 3) * 8 + (4 * hi + ((lane & 15) >> 2)) * 64;
    bf16_t* DOG = WSP(bf16_t, WS_DOG); float* DLSE = WSP(float, WS_DLSE);
    for (int g = 0; g < 3; ++g) {
        const int sh = 2 * g, head = 2 * g + hh;
        for (int rep = 0; rep < 2; ++rep) {
            const int wt = wid + 8 * rep;
            const int res = (g == 0) ? 0 : (g == 1 ? (wt & 3) : wt);
            const int i0 = (g == 0) ? 32 * wt : (g == 1 ? 32 * (wt >> 2) : 0);
            const int n0 = (T0 >> sh) + i0;
            const int tokq = res + ((n0 + r32) << sh);
            bf16x8 qf[4];
            { const bf16_t* Qrow = P + (size_t)tokq * PW + PC_BQ + head * 64;
#pragma unroll
              for (int ks = 0; ks < 4; ++ks) qf[ks] = *(const bf16x8*)(Qrow + ks * 16 + hi * 8); }
            f32x16 o0, o1; float m = NEG_INF, l = 0.f;
#pragma unroll
            for (int r = 0; r < 16; ++r) { o0[r] = 0.f; o1[r] = 0.f; }
#define DIL_LOAD(cc, KF, VR) do { const int nk0_ = n0 - 128 + 32 * (cc); int nk_ = nk0_ + r32; nk_ = nk_ < 0 ? 0 : nk_; const bf16_t* Krow_ = P + (size_t)(res + (nk_ << sh)) * PW + PC_BK + head * 64; \
        _Pragma("unroll") for (int ks = 0; ks < 4; ++ks) KF[ks] = *(const bf16x8*)(Krow_ + ks * 16 + hi * 8); \
        _Pragma("unroll") for (int i = 0; i < 4; ++i) { const int pc_ = lane + 64 * i, vrow_ = pc_ >> 3, c16_ = pc_ & 7; int nv_ = nk0_ + vrow_; nv_ = nv_ < 0 ? 0 : nv_; \
            VR[i] = *(const u32x4*)(P + (size_t)(res + (nv_ << sh)) * PW + PC_BV + head * 64 + c16_ * 8); } } while (0)
            int cfirst = 0; while (cfirst < 4 && n0 - 128 + 32 * cfirst + 31 < 0) ++cfirst;
            bf16x8 kfn[4]; u32x4 vrn[4];
            DIL_LOAD(cfirst, kfn, vrn);
            for (int c = cfirst; c < 5; ++c) {
                const int nk0 = n0 - 128 + 32 * c;
                { bf16x8 kf[4]; u32x4 vr[4];
#pragma unroll
                  for (int i = 0; i < 4; ++i) { kf[i] = kfn[i]; vr[i] = vrn[i]; }
                  if (c < 4) DIL_LOAD(c + 1, kfn, vrn);
#pragma unroll
                  for (int i = 0; i < 4; ++i) { const int pc = lane + 64 * i, vrow = pc >> 3, c16 = pc & 7;
                      *(LAS u32x4*)(vst + (c16 >> 2) * 2048 + vrow * 64 + (c16 & 3) * 16) = vr[i]; }
                  asm volatile("s_waitcnt lgkmcnt(0)" ::: "memory");
                  f32x16 p;
#pragma unroll
                  for (int r = 0; r < 16; ++r) p[r] = 0.f;
#pragma unroll
                  for (int ks = 0; ks < 4; ++ks) p = MFMA32(kf[ks], qf[ks], p);
                  const LAS float* tb = dtab + g * 192 + (32 - r32 + 4 * hi + 32 * c);
                  float mx = NEG_INF;
#pragma unroll
                  for (int r = 0; r < 16; ++r) { const int o = (r & 3) + 8 * (r >> 2), kk = o + 4 * hi, j = 128 + r32 - 32 * c - kk;
                      const bool ok = (j >= 0) && (j <= 128) && (nk0 + kk >= 0);
                      p[r] = ok ? p[r] + tb[o] : NEG_INF; mx = fmaxf(mx, p[r]); }
                  mx = fmaxf(mx, other_half(mx, hi));
                  if (__any(mx > m + 8.0f)) { const float mn = fmaxf(m, mx), msn = (mn == NEG_INF) ? 0.f : mn, alpha = fast_exp2(m - msn);
                      l *= alpha; m = mn;
#pragma unroll
                      for (int r = 0; r < 16; ++r) { o0[r] *= alpha; o1[r] *= alpha; } }
                  const float ms = (m == NEG_INF) ? 0.f : m;
                  float rs = 0.f;
#pragma unroll
                  for (int r = 0; r < 16; ++r) { p[r] = fast_exp2(p[r] - ms); rs += p[r]; }
                  rs += other_half(rs, hi);
                  l += rs;
                  u32x4 w0, w1;
                  w0.x = cvtpk(p[0], p[1]); w0.y = cvtpk(p[2], p[3]); w0.z = cvtpk(p[4], p[5]); w0.w = cvtpk(p[6], p[7]);
                  w1.x = cvtpk(p[8], p[9]); w1.y = cvtpk(p[10], p[11]); w1.z = cvtpk(p[12], p[13]); w1.w = cvtpk(p[14], p[15]);
                  const bf16x8 pf0 = __builtin_bit_cast(bf16x8, w0), pf1 = __builtin_bit_cast(bf16x8, w1);
                  lds_cptr vp = (lds_cptr)(vst + vpo);
#pragma unroll
                  for (int ks = 0; ks < 2; ++ks) {
                      const s16x4 l0 = vtr(vp + ks * 1024), h0 = vtr(vp + ks * 1024 + 512), l1 = vtr(vp + 2048 + ks * 1024), h1 = vtr(vp + 2048 + ks * 1024 + 512);
                      const bf16x8 v0 = (bf16x8){l0[0], l0[1], l0[2], l0[3], h0[0], h0[1], h0[2], h0[3]}, v1 = (bf16x8){l1[0], l1[1], l1[2], l1[3], h1[0], h1[1], h1[2], h1[3]};
                      o0 = MFMA32(v0, ks == 0 ? pf0 : pf1, o0); o1 = MFMA32(v1, ks == 0 ? pf0 : pf1, o1);
                  }
                  asm volatile("s_waitcnt lgkmcnt(0)" ::: "memory"); }
            }
#undef DIL_LOAD
            const size_t orow = rowbase + tokq;
            store_o_staged(lds, wid, lane, o0, o1, 1.0f / l, [&](int r) { return DOG + ((size_t)g * M + rowbase + (size_t)(res + ((n0 + r) << sh))) * 128 + hh * 64; });
            if (hi == 0) DLSE[((size_t)g * M + orow) * 2 + hh] = m + log2f(l);
        }
    }
    VM_WAIT();
    __syncthreads();
    bf16_t* OC = WSP(bf16_t, WS_OCAT);
    for (int it = 0; it < 8; ++it) {
        const int item = tid + 512 * it, tl = item >> 3, pc = item & 7; const size_t orow = rowbase + T0 + tl;
        const float l0 = DLSE[((size_t)0 * M + orow) * 2 + hh], l1 = DLSE[((size_t)1 * M + orow) * 2 + hh], l2 = DLSE[((size_t)2 * M + orow) * 2 + hh];
        const float mx = fmaxf(l0, fmaxf(l1, l2)); float w0 = fast_exp2(l0 - mx), w1 = fast_exp2(l1 - mx), w2 = fast_exp2(l2 - mx);
        const float inv = 1.0f / (w0 + w1 + w2); w0 *= inv; w1 *= inv; w2 *= inv;
        const u32x4 a = *(const u32x4*)(DOG + ((size_t)0 * M + orow) * 128 + hh * 64 + pc * 8), bb = *(const u32x4*)(DOG + ((size_t)1 * M + orow) * 128 + hh * 64 + pc * 8),
                    cc = *(const u32x4*)(DOG + ((size_t)2 * M + orow) * 128 + hh * 64 + pc * 8);
        u32x4 w;
#pragma unroll
        for (int e = 0; e < 4; ++e) {
            const float lo = w0 * __uint_as_float(a[e] << 16) + w1 * __uint_as_float(bb[e] << 16) + w2 * __uint_as_float(cc[e] << 16);
            const float hv = w0 * __uint_as_float(a[e] & 0xffff0000u) + w1 * __uint_as_float(bb[e] & 0xffff0000u) + w2 * __uint_as_float(cc[e] & 0xffff0000u);
            w[e] = cvtpk(lo, hv); }
        *(u32x4*)(OC + orow * OCW + 256 + hh * 64 + pc * 8) = w;
    }
    __syncthreads();
}
__device__ __forceinline__ float wave_sum(float v) {
    v += xor_lane_lt32<1>(v); v += xor_lane_lt32<2>(v); v += xor_lane_lt32<4>(v); v += xor_lane_lt32<8>(v); v += xor_lane_lt32<16>(v);
    return sum_halves(v);
}
__device__ __forceinline__ int rel_bucket(int dist) {
    if (dist < 0) dist = 0;
    if (dist < 16) return dist;
    const int thr[15] = {22, 30, 40, 54, 73, 99, 134, 182, 246, 332, 450, 609, 825, 1117, 1513};
    int bkt = 16;
#pragma unroll
    for (int i = 0; i < 15; ++i) bkt += (dist >= thr[i]) ? 1 : 0;
    return bkt;
}
__device__ __forceinline__ int inproj_src(int c, float& sc) {
    sc = 1.f;
    if (c < 256) { sc = C2A; return c; }
    if (c < 652) return c;
    if (c < 656) return 2572 + (c - 652);
    if (c < 672) return -1;
    if (c < 704) { const int p = c - 672; return 2960 + (p >> 1) + 16 * (p & 1); }
    if (c < 768) return -1;
    if (c < 1920) { const int r = c - 768; if (r < 384) sc = C2A; return 652 + r; }
    if (c < 2048) return 2832 + (c - 1920);
    if (c < 2816) { const int r = c - 2048; if (r < 256) sc = C2A; return 1804 + r; }
    return 2576 + (c - 2816);
}
__device__ __forceinline__ int quq_src(int r, float& sc) {
    sc = C2D;
    if (r >= 384) return -1;
    const int hd = r / 96, w = r % 96;
    if (w < 64) return hd * 96 + w;
    const int p = w - 64; return hd * 96 + 64 + (p >> 1) + 16 * (p & 1);
}
__device__ __forceinline__ int gateperm_src(int r) {
    const int T = r >> 8, c = r & 255, pn = T >> 2, j = T & 3, bj = c >> 7, wc = (c >> 5) & 3, fq = (c >> 3) & 3, n = (c >> 2) & 1, e = c & 3;
    return (2 * bj + n) * DM * DM + 256 * pn + 64 * j + 16 * wc + 4 * fq + e;
}
__device__ __forceinline__ int branchperm_src(int r) {
    const int pn = r >> 8, c = r & 255, bj = c >> 7, wc = (c >> 5) & 3, fq = (c >> 3) & 3, n = (c >> 2) & 1, e = c & 3;
    return 256 * pn + 64 * (2 * bj + n) + 16 * wc + 4 * fq + e;
}
__device__ __forceinline__ int upperm_src(int r) { const int pn = r >> 8, c = r & 255; return (c & 128) ? DFF + 128 * pn + (c & 127) : 128 * pn + c; }
__device__ __forceinline__ void wconv_item(const float* W, int Nsrc, bf16_t* WT, int ldt, const float* kgain, int kind, LAS float* scr, int item, int nblk, int lane, bool f8out = false) {
    const int kb = item / nblk, nb = item % nblk, k0 = 64 * kb, n0 = 32 * nb;
    const int n = n0 + (lane & 31); float sc = 1.f; int src = n;
    if (kind == 1) src = inproj_src(n, sc); else if (kind == 2) src = quq_src(n, sc); else if (kind == 3) src = gateperm_src(n); else if (kind == 4) src = branchperm_src(n); else if (kind == 5) src = upperm_src(n);
    float wv[32];
#pragma unroll
    for (int i = 0; i < 32; ++i) { const int kk = 2 * i + (lane >> 5); wv[i] = (src >= 0) ? W[(size_t)(k0 + kk) * Nsrc + src] : 0.f; }
#pragma unroll
    for (int i = 0; i < 32; ++i) { const int kk = 2 * i + (lane >> 5); float v = wv[i] * sc; if (kgain) v *= kgain[k0 + kk]; scr[kk * 33 + (lane & 31)] = v; }
    LDS_WAIT(); asm volatile("" ::: "memory");
    if (f8out) {
        const int nn = lane >> 1, hh = lane & 1; const LAS float* s = scr + (32 * hh) * 33 + nn; unsigned char* dst = (unsigned char*)WT + (size_t)(n0 + nn) * ldt + k0 + 32 * hh;
#pragma unroll
        for (int j = 0; j < 2; ++j) { u32x4 o;
#pragma unroll
            for (int e = 0; e < 4; ++e) { const LAS float* q = s + (16 * j + 4 * e) * 33; o[e] = pk4_fp8(q[0] * WG8_SCALE, q[33] * WG8_SCALE, q[66] * WG8_SCALE, q[99] * WG8_SCALE); }
            *(u32x4*)(dst + 16 * j) = o; }
        LDS_WAIT(); asm volatile("" ::: "memory");
        return;
    }
    const int c = lane & 7;
#pragma unroll
    for (int j = 0; j < 4; ++j) { const int nn = (lane >> 3) + 8 * j; const LAS float* s = scr + (8 * c) * 33 + nn;
        u32x4 o; o.x = pk2(s[0 * 33], s[1 * 33]); o.y = pk2(s[2 * 33], s[3 * 33]); o.z = pk2(s[4 * 33], s[5 * 33]); o.w = pk2(s[6 * 33], s[7 * 33]);
        *(u32x4*)(WT + (size_t)(n0 + nn) * ldt + k0 + 8 * c) = o; }
    LDS_WAIT(); asm volatile("" ::: "memory");
}
constexpr int ATT_UNITS = 3328;
__device__ __forceinline__ int att_cost(int id) {
    if (id < 2048) { const int qb = 15 - (id >> 7), mla = (id >> 6) & 1; return (mla ? 5 : 4) * (qb + 1); }
    if (id < 3072) return (63 - ((id - 2048) >> 4)) + 20;
    return 30;
}
__device__ __forceinline__ int clampi(int x, int lo, int hi) { return x < lo ? lo : (x > hi ? hi : x); }
__device__ __forceinline__ int att_rank(int i) {
    const int c = att_cost(i);
    int r = clampi(16 - c / 4, 0, 16) * 64 + clampi(16 - c / 5, 0, 16) * 64 + clampi(83 - c, 0, 64) * 16 + (c < 30 ? 256 : 0);
    if (c % 4 == 0 && c / 4 >= 1 && c / 4 <= 16) r += clampi(i - (16 - c / 4) * 128, 0, 64);
    if (c % 5 == 0 && c / 5 >= 1 && c / 5 <= 16) r += clampi(i - ((16 - c / 5) * 128 + 64), 0, 64);
    if (c >= 20 && c <= 83) r += clampi(i - (2048 + (63 - (c - 20)) * 16), 0, 16);
    if (c == 30) r += clampi(i - 3072, 0, 256);
    return r;
}
__device__ __forceinline__ void p0_prologue(Frame& F) {
    LAS float* scr = (LAS float*)(F.lds + F.wave * 16384);
    const int gw = blockIdx.x * 8 + F.wave, NGW = F.G * 8, lane = F.lane;
    constexpr int I_IN = 16 * 96, I_G = 16 * 32, I_BA = 4 * 32, I_BB = 2 * 32, I_O = 16 * 32, I_UP = 16 * 176, I_DN = 44 * 32, I_UQ = 4 * 16, I_UKV = 2 * 16, I_PHI = 32 * 4;
    constexpr int I_L = I_IN + 4 * I_G + 3 * I_BA + I_BB + I_O + I_UP + I_DN + I_UQ + I_UKV + 2 * I_PHI;
    for (int it = gw; it < DEPTH * I_L; it += NGW) {
        const int l = it / I_L; int r = it % I_L;
        unsigned char* wl = F.ws + WS_WT + (size_t)l * LW;
        if (r < I_IN) { wconv_item(F.in[6] + (size_t)l * DM * DIN, DIN, (bf16_t*)(wl + LW_IN), DM, nullptr, 1, scr, r, 96, lane); continue; } r -= I_IN;
        if (r < 4 * I_G) { wconv_item(F.in[21] + (size_t)l * 4 * DM * DM, DM, (bf16_t*)(wl + LW_G), DM, nullptr, 3, scr, r, 128, lane, true); continue; } r -= 4 * I_G;
        if (r < I_BA) { wconv_item(F.in[17] + (size_t)l * 256 * DM, DM, (bf16_t*)(wl + LW_BR + BR_A), 256, nullptr, 4, scr, r, 32, lane); continue; } r -= I_BA;
        if (r < I_BB) { wconv_item(F.in[18] + (size_t)l * 128 * DM, DM, (bf16_t*)(wl + LW_BR + BR_B), 128, nullptr, 4, scr, r, 32, lane); continue; } r -= I_BB;
        if (r < I_BA) { wconv_item(F.in[19] + (size_t)l * 256 * DM, DM, (bf16_t*)(wl + LW_BR + BR_C), 256, nullptr, 4, scr, r, 32, lane); continue; } r -= I_BA;
        if (r < I_BA) { wconv_item(F.in[20] + (size_t)l * 256 * DM, DM, (bf16_t*)(wl + LW_BR + BR_D), 256, nullptr, 4, scr, r, 32, lane); continue; } r -= I_BA;
        if (r < I_O) { wconv_item(F.in[22] + (size_t)l * DM * DM, DM, (bf16_t*)(wl + LW_O), DM, nullptr, 0, scr, r, 32, lane); continue; } r -= I_O;
        if (r < I_UP) { wconv_item(F.in[23] + (size_t)l * DM * DFF2, DFF2, (bf16_t*)(wl + LW_UP), DM, nullptr, 5, scr, r, 176, lane); continue; } r -= I_UP;
        if (r < I_DN) { wconv_item(F.in[26] + (size_t)l * DFF * DM, DM, (bf16_t*)(wl + LW_DN), DFF, nullptr, 0, scr, r, 32, lane); continue; } r -= I_DN;
        if (r < I_UQ) { wconv_item(F.in[15] + (size_t)l * 256 * 384, 384, (bf16_t*)(wl + LW_UQ), 256, F.in[13] + l * 256, 2, scr, r, 16, lane); continue; } r -= I_UQ;
        if (r < I_UKV) { wconv_item(F.in[16] + (size_t)l * 128 * 512, 512, (bf16_t*)(wl + LW_UKV), 128, F.in[14] + l * 128, 0, scr, r, 16, lane); continue; } r -= I_UKV;
        if (r < I_PHI) { wconv_item(F.in[8] + (size_t)l * 2048 * 128, 128, (bf16_t*)(wl + LW_PHI), 2048, nullptr, 0, scr, r, 4, lane); continue; } r -= I_PHI;
        wconv_item(F.in[10] + (size_t)l * 2048 * 128, 128, (bf16_t*)(wl + LW_PHI) + (size_t)128 * 2048, 2048, nullptr, 0, scr, r, 4, lane);
    }
    const int gt = blockIdx.x * 512 + F.tid, NGT = F.G * 512;
    const float* rel = F.in[1];
    float* rope = WSP(float, WS_ROPE);
    for (int i = gt; i < SEQ * 16; i += NGT) { const int t = i >> 4, k = i & 15; const float inv = powf(10000.0f, -(float)(2 * k) / 32.0f); const float ang = (float)t * inv;
        float sn, cs; sincosf(ang, &sn, &cs); rope[2 * i] = cs; rope[2 * i + 1] = sn; }
    float* ntab = WSP(float, WS_NSATAB);
    for (int i = gt; i < 4 * NSA_TL; i += NGT) { const int hd = i / NSA_TL, k = i % NSA_TL, dist = NSA_DMAX - k; ntab[i] = dist >= 0 ? (rel[rel_bucket(dist) * 10 + hd] - rel[31 * 10 + hd]) * LOG2E : 0.f; }
    { float* cws = WSP(float, WS_CWS);
      for (int i = gt; i < DEPTH * 4 * DFF2; i += NGT) { const int l = i / (4 * DFF2), r = i % (4 * DFF2), row = r / DFF2, col = r % DFF2;
          const float s = row < 3 ? F.in[24][(size_t)l * 3 * DFF2 + row * DFF2 + col] : F.in[25][(size_t)l * DFF2 + col];
          cws[i] = s * (col < DFF ? -LOG2E : -0.6931471805599453f); } }
    float* dtab = WSP(float, WS_DILTAB);
    for (int i = gt; i < 6 * 192; i += NGT) { const int gh = i / 192, k = i % 192, g = gh >> 1, hh = gh & 1, j = 160 - k; dtab[i] = (j >= 0 && j <= 128) ? rel[rel_bucket(j << (2 * g)) * 10 + 4 + 2 * g + hh] * LOG2E : 0.f; }
    if (gt < 4) { WSP(float, WS_FARB)[gt] = rel[31 * 10 + gt] * LOG2E; float tm = 0.f; for (int bk = 0; bk < 32; ++bk) tm = fmaxf(tm, fabsf(rel[bk * 10 + gt] - rel[31 * 10 + gt])); WSP(float, WS_FARB)[4 + gt] = tm * LOG2E; }
    if (gw < 128) { const int mi = gw >> 5, pc = gw & 31, l = mi >> 1; const float *pk1 = F.in[8], *pv1 = F.in[10]; asm volatile("" : "+s"(pk1), "+s"(pv1));
        const float* w1 = ((mi & 1) ? pv1 : pk1) + (size_t)l * 2048 * 128 + (size_t)(64 * pc) * 128 + 2 * lane; const float* cp = F.in[7] + (size_t)l * 2048 + 64 * pc;
        f32x2 a = {0.f, 0.f};
#pragma unroll 8
        for (int p = 0; p < 64; ++p) { const f32x2 w = *(const f32x2*)(w1 + (size_t)p * 128); const float cpp = cp[p]; a[0] += cpp * w[0]; a[1] += cpp * w[1]; }
        *(f32x2*)(WSP(float, WS_CMPP) + ((size_t)mi * 32 + pc) * 128 + 2 * lane) = a; }
    if (gt < ATT_UNITS) {
        const int i = gt; int pos, cls, pic;
        if (i < 2048) { const int bh = i & 63; pos = bh; cls = (bh >> 2) & 7; pic = ((bh >> 5) << 2) | (bh & 3); }
        else if (i < 3072) { const int bN = (i - 2048) & 15; pos = bN; cls = bN & 7; pic = bN >> 3; }
        else { const int r = i - 3072, b = r & 15; pos = r; cls = b & 7; pic = (r >> 4) * 2 + (b >> 3); }
        WSP(int, WS_ORDER)[cls * (ATT_UNITS / 8) + (att_rank(i) - pos) / 8 + pic] = i; }
}
__device__ __forceinline__ void cmpb_reduce(Frame& F) {
    const int i = F.tid; if (i < DEPTH * 256) { const int l = i >> 8, n = i & 255, mi = l * 2 + (n >> 7); const float* pp = WSP(const float, WS_CMPP) + (size_t)mi * 32 * 128 + (n & 127); float a = 0.f;
        for (int pc = 0; pc < 32; ++pc) a += pp[pc * 128]; WSP(float, WS_CMPB)[i] = a; }
}

template <int MODE, bool XIB, bool XOB, bool H8 = false> __device__ __forceinline__ void rowpass(Frame& F, const void* x, const bf16_t* y, size_t yrow0, void* xout, bf16_t* hout, const float* g1, const float* g2, int row_lo, int row_hi, unsigned char* h8out = nullptr) {
    int gw = blockIdx.x * 8 + F.wave; asm volatile("" : "+s"(gw));
    const int NGW = F.G * 8, lane = F.lane;
    f32x4 ga[4], gb[4];
#pragma unroll
    for (int j = 0; j < 4; ++j) { ga[j] = *(const f32x4*)(g1 + 4 * lane + 256 * j); if (MODE == 1) gb[j] = *(const f32x4*)(g2 + 4 * lane + 256 * j); }
    f32x4 xf[4], xfn[4]; u32x2 xb[4], xbn[4], yb[4], ybn[4];
#define RP_LOAD(XF, XB, YB, mm) do { if (XIB) { const u32x2* xr_ = (const u32x2*)((const bf16_t*)x + (size_t)(mm) * DM) + lane; _Pragma("unroll") for (int j = 0; j < 4; ++j) XB[j] = xr_[64 * j]; } \
        else { const f32x4* xr_ = (const f32x4*)((const float*)x + (size_t)(mm) * DM) + lane; _Pragma("unroll") for (int j = 0; j < 4; ++j) XF[j] = xr_[64 * j]; } \
        if (MODE != 0) { const u32x2* yr_ = (const u32x2*)(y + ((size_t)(mm) - yrow0) * DM) + lane; _Pragma("unroll") for (int j = 0; j < 4; ++j) YB[j] = yr_[64 * j]; } } while (0)
    int m = row_lo + gw;
    if (m < row_hi) RP_LOAD(xf, xb, yb, m);
    for (; m < row_hi; m += NGW) {
        const int mn = m + NGW;
        if (mn < row_hi) RP_LOAD(xfn, xbn, ybn, mn);
        f32x4 v[4];
#pragma unroll
        for (int j = 0; j < 4; ++j) { if (XIB) { v[j][0] = __uint_as_float(xb[j].x << 16); v[j][1] = __uint_as_float(xb[j].x & 0xffff0000u); v[j][2] = __uint_as_float(xb[j].y << 16); v[j][3] = __uint_as_float(xb[j].y & 0xffff0000u); } else v[j] = xf[j]; }
        if (MODE != 0) {
            f32x4 w[4]; float s = 0.f;
#pragma unroll
            for (int j = 0; j < 4; ++j) { const u32x2 yy = yb[j]; w[j][0] = __uint_as_float(yy.x << 16); w[j][1] = __uint_as_float(yy.x & 0xffff0000u); w[j][2] = __uint_as_float(yy.y << 16); w[j][3] = __uint_as_float(yy.y & 0xffff0000u);
                s += (w[j][0] * w[j][0] + w[j][1] * w[j][1]) + (w[j][2] * w[j][2] + w[j][3] * w[j][3]); }
            const float rstd = 1.0f / sqrtf(wave_sum(s) * (1.0f / DM) + RMS_EPS);
#pragma unroll
            for (int j = 0; j < 4; ++j) v[j] = v[j] + w[j] * rstd * ga[j];
            if (XOB) { u32x2* xo = (u32x2*)((bf16_t*)xout + (size_t)m * DM) + lane;
#pragma unroll
                for (int j = 0; j < 4; ++j) { u32x2 w2; w2.x = cvtpk(v[j][0], v[j][1]); w2.y = cvtpk(v[j][2], v[j][3]); xo[64 * j] = w2; } }
            else { f32x4* xo = (f32x4*)((float*)xout + (size_t)m * DM) + lane;
#pragma unroll
                for (int j = 0; j < 4; ++j) xo[64 * j] = v[j]; }
        }
        if (MODE != 2) {
            float s = 0.f;
#pragma unroll
            for (int j = 0; j < 4; ++j) s += (v[j][0] * v[j][0] + v[j][1] * v[j][1]) + (v[j][2] * v[j][2] + v[j][3] * v[j][3]);
            const float rstd = 1.0f / sqrtf(wave_sum(s) * (1.0f / DM) + RMS_EPS);
            u32x2* ho = (u32x2*)(hout + (size_t)m * DM) + lane;
#pragma unroll
            for (int j = 0; j < 4; ++j) { const f32x4 gg = (MODE == 1) ? gb[j] : ga[j]; const f32x4 o = v[j] * rstd * gg; u32x2 w; w.x = cvtpk(o[0], o[1]); w.y = cvtpk(o[2], o[3]); ho[64 * j] = w;
                if (H8) ((unsigned*)(h8out + (size_t)m * DM))[lane + 64 * j] = pk4_fp8(o[0] * H8_SCALE, o[1] * H8_SCALE, o[2] * H8_SCALE, o[3] * H8_SCALE); }
        }
#pragma unroll
        for (int j = 0; j < 4; ++j) { if (XIB) xb[j] = xbn[j]; else xf[j] = xfn[j]; if (MODE != 0) yb[j] = ybn[j]; }
    }
#undef RP_LOAD
}

__device__ __forceinline__ void ffn_fix_panel(Frame& F, int pm, const float* HB, bf16_t* ACT, const float* cw, const float* cb) {
#pragma unroll 2
    for (int it = F.tid; it < 4 * 2 * (DFF / 4); it += 512) {
        const int c4 = it % (DFF / 4), rr = (it / (DFF / 4)) & 1, g = pm * 4 + it / (2 * (DFF / 4)), c = c4 * 4, pn = c >> 7, cl = c & 127;
        const bool first = ((g * 64) & (SEQ - 1)) == 0;
#define HBV(gg, s, bj) (*(const f32x4*)(HB + ((size_t)(((gg) * 4 + (s)) * 22 + pn) * 256 + (bj) * 128 + cl)))
        const f32x4 z = {0.f, 0.f, 0.f, 0.f};
        const f32x4 u0g = HBV(g, 0, 0), u0v = HBV(g, 0, 1);
        f32x4 ag, bg_, cg, av, bv_, cv;
        if (rr == 0) { ag = first ? z : HBV(g - 1, 2, 0); bg_ = first ? z : HBV(g - 1, 3, 0); cg = u0g; av = first ? z : HBV(g - 1, 2, 1); bv_ = first ? z : HBV(g - 1, 3, 1); cv = u0v; }
        else { ag = first ? z : HBV(g - 1, 3, 0); bg_ = u0g; cg = HBV(g, 1, 0); av = first ? z : HBV(g - 1, 3, 1); bv_ = u0v; cv = HBV(g, 1, 1); }
#undef HBV
        const f32x4 kb = *(const f32x4*)(cb + c), k0 = *(const f32x4*)(cw + c), k1 = *(const f32x4*)(cw + DFF2 + c), k2 = *(const f32x4*)(cw + 2 * DFF2 + c);
        const f32x4 vb = *(const f32x4*)(cb + DFF + c), v0 = *(const f32x4*)(cw + DFF + c), v1 = *(const f32x4*)(cw + DFF2 + DFF + c), v2 = *(const f32x4*)(cw + 2 * DFF2 + DFF + c);
        float o[4];
#pragma unroll
        for (int e = 0; e < 4; ++e) { const float gt = kb[e] + k0[e] * ag[e] + k1[e] * bg_[e] + k2[e] * cg[e], vl = vb[e] + v0[e] * av[e] + v1[e] * bv_[e] + v2[e] * cv[e]; o[e] = gt * sigmoid_f(gt) * vl; }
        u32x2 w; w.x = cvtpk(o[0], o[1]); w.y = cvtpk(o[2], o[3]);
        *(u32x2*)(ACT + (size_t)(g * 64 + rr) * DFF + c) = w;
    }
}
struct SchedSimple {
    pg8::TileOrder T; const char* A; const char* B; int lda, ldb, nt; int dup = 0;
    __device__ __forceinline__ bool next(int i, GUnit& u) const { int pm, pn; if (!T.tile(i >> dup, pm, pn)) return false;
        u.A = A + (size_t)pm * 256 * lda; u.B = B + (size_t)pn * 256 * ldb; u.lda = lda; u.ldb = ldb; u.nt = nt; u.pm = pm; u.pn = pn; u.id = 0; return true; }
};
struct SchedCmp1 {
    int c; const char* kc; const char* vc; const char* B;
    __device__ __forceinline__ bool next(int i, GUnit& u) const { if (i > 0 || c >= 32) return false;
        u.A = (c < 16 ? kc : vc) + (size_t)(c & 15) * 256 * 2048; u.B = B; u.lda = 2048; u.ldb = 4096; u.nt = 32; u.pm = c; u.pn = 0; u.id = 0; return true; }
};
struct SchedMerge {
    pg8::TileOrder T; const char* ocat; const char* h; const char* wbr; const char* wg; int dup = 0;
    __device__ __forceinline__ bool next(int i0, GUnit& u) const { const int i = i0 >> dup; int pm, pn; if (!T.tile(i >> 3, pm, pn)) return false;
        const int sub = i & 7; u.pm = pm; u.pn = pn; u.id = sub;
        if (sub >= 4) { u.A = h + (size_t)pm * 256 * 1024; u.lda = 1024; u.B = wg + (size_t)((pn * 4 + (sub - 4)) * 256) * 1024; u.ldb = 1024; u.nt = 8; }
        else { const int br = sub; const int kk = (br == 1) ? 128 : 256; const size_t co = (br == 0) ? 0 : (br == 1 ? 256 : (br == 2 ? 384 : 640)), wo = (br == 0) ? BR_A : (br == 1 ? BR_B : (br == 2 ? BR_C : BR_D));
            u.A = ocat + (size_t)pm * 256 * (OCW * 2) + co * 2; u.lda = OCW * 2; u.B = wbr + wo + (size_t)pn * 256 * kk * 2; u.ldb = kk * 2; u.nt = kk / 64; }
        return true; }
};

#ifndef SDUP_INPROJ
#define SDUP_INPROJ 0
#endif
#ifndef SDUP_MERGE
#define SDUP_MERGE 0
#endif
#ifndef SDUP_WO
#define SDUP_WO 0
#endif
#ifndef SDUP_UP
#define SDUP_UP 0
#endif
#ifndef SDUP_DN
#define SDUP_DN 0
#endif
#ifndef DUP_ATTN
#define DUP_ATTN 1
#endif
#ifndef DUP_GEMM
#define DUP_GEMM 1
#endif
#ifndef DUP_MERGE
#define DUP_MERGE 1
#endif
#ifndef DUP_FFN
#define DUP_FFN 1
#endif
#ifdef ONLY_PHASE
#define PH(k) ((k) == ONLY_PHASE)
#else
#define PH(k) true
#endif
struct Args { const float* in[27]; float* out; unsigned char* ws; };
__global__ void __launch_bounds__(512, 2) hybrid_fwd(Args args) {
    extern __shared__ __attribute__((aligned(16))) unsigned char lds_raw[];
    Frame F;
    F.lds = (LAS unsigned char*)lds_raw; F.MISC = (volatile LAS unsigned*)(F.lds + MISC_OFF);
    F.tid = threadIdx.x; F.lane = F.tid & 63; F.wave = __builtin_amdgcn_readfirstlane(F.tid >> 6); F.G = gridDim.x;
#pragma unroll
    for (int i = 0; i < 27; ++i) F.in[i] = args.in[i];
    F.out = args.out; F.ws = args.ws; F.ctl = (gu32*)(args.ws + WS_CTL);
    for (int u = F.tid; u < (LDS_BYTES - LDSCTL_OFF) / 4; u += 512) ((LAS unsigned*)(F.lds + LDSCTL_OFF))[u] = 0u;
    __syncthreads();
    XcdBarrier bar = xcd_barrier_post((unsigned*)(F.ctl + CW_BAR), F.MISC + 8);
    const int c = (int)blockIdx.x;
#define TSTAMP(id) do { } while (0)

#ifndef DUP_P0
#define DUP_P0 1
#endif
    for (int rep = 0; rep < DUP_P0; ++rep) { if (rep) xcd_barrier(bar, F.wave); if (PH(0)) p0_prologue(F); }

#ifndef XTRA_BAR
#define XTRA_BAR 0
#endif
    _Pragma("unroll") for (int xb = 0; xb < XTRA_BAR; ++xb) xcd_barrier(bar, F.wave);
#define PHASE_FRESH() do { const int l_ = lane_now(); F.tid = F.wave * 64 + l_; F.lane = l_; } while (0)
    for (int l = 0; l < DEPTH; ++l) {
        unsigned char* wl = F.ws + WS_WT + (size_t)l * LW;
        const float* xin = (l == 0) ? F.in[0] : F.out;
        PHASE_FRESH();
#ifndef DUP_RP0
#define DUP_RP0 1
#endif
        if (l == 0) {
          _Pragma("unroll") for (int rep = 0; rep < DUP_RP0; ++rep) { if (rep) xcd_barrier(bar, F.wave); if (PH(1)) rowpass<0, false, false, true>(F, F.in[0], nullptr, 0, nullptr, WSP(bf16_t, WS_H), F.in[2] + l * DM, nullptr, 0, M, (unsigned char*)F.out + H8_OFF); }
          xcd_barrier(bar, F.wave); TSTAMP(1);
          if (c == 0) cmpb_reduce(F); }
        for (int rep = 0; rep < DUP_GEMM; ++rep) if (PH(2)) { if (rep) xcd_barrier(bar, F.wave); SchedSimple S; S.T.init(256, 12, F.G, c); S.A = (const char*)(F.ws + WS_H); S.B = (const char*)(wl + LW_IN); S.lda = 2048; S.ldb = 2048; S.nt = 16; S.dup = SDUP_INPROJ;
          pg8::EpiInProj E{WSP(bf16_t, WS_P), WSP(bf16_t, WS_KCMP), WSP(bf16_t, WS_VCMP), WSP(float, WS_SIDE), WSP(bf16_t, WS_KROT), WSP(const float, WS_ROPE), WSP(float, WS_SSQQ), WSP(float, WS_SSQKV), F.in[12] + l * 4, WSP(float, WS_LF)};
          pg8::gemm_phase<pg8::EpiInProj, SchedSimple, true>(F.lds, S, E, F.wave); }
        xcd_barrier(bar, F.wave); TSTAMP(2);
#ifndef DUP_L2A
#define DUP_L2A 1
#endif
        _Pragma("unroll") for (int rep2 = 0; rep2 < DUP_L2A; ++rep2) { if (rep2) xcd_barrier(bar, F.wave);
        if (PH(3)) { SchedCmp1 S{c, (const char*)(F.ws + WS_KCMP), (const char*)(F.ws + WS_VCMP), (const char*)(wl + LW_PHI)};
          pg8::EpiCmp1 E{WSP(bf16_t, WS_HID), WSP(const float, WS_CMPB) + l * 256};
          pg8::gemm_phase<pg8::EpiCmp1, SchedCmp1, false>(F.lds, S, E, F.wave);
          if (c < 32) {
              __syncthreads(); const int which = c >> 4, b = c & 15;
              const int ln_ = lane_now(); const int r32 = ln_ & 31, hi = ln_ >> 5;
              const bf16_t* hrow = WSP(const bf16_t, WS_HID) + ((size_t)c * 256 + F.wave * 32 + r32) * 256 + which * 128;
              const float *pk2 = F.in[9], *pv2 = F.in[11]; asm volatile("" : "+s"(pk2), "+s"(pv2)); const float* w2 = (which ? pv2 : pk2) + (size_t)l * 128 * 64;
              f32x16 o0, o1;
#pragma unroll
              for (int r = 0; r < 16; ++r) { o0[r] = 0.f; o1[r] = 0.f; }
#pragma unroll
              for (int ks = 0; ks < 8; ++ks) { const bf16x8 a = *(const bf16x8*)(hrow + ks * 16 + hi * 8);
                  const float* wp = w2 + (size_t)(ks * 16 + hi * 8) * 64 + r32; u32x4 b0, b1;
#pragma unroll
                  for (int jj = 0; jj < 4; ++jj) { b0[jj] = cvtpk(wp[(2 * jj) * 64], wp[(2 * jj + 1) * 64]); b1[jj] = cvtpk(wp[(2 * jj) * 64 + 32], wp[(2 * jj + 1) * 64 + 32]); }
                  o0 = MFMA32(a, __builtin_bit_cast(bf16x8, b0), o0); o1 = MFMA32(a, __builtin_bit_cast(bf16x8, b1), o1); }
              bf16_t* dst = (which ? WSP(bf16_t, WS_VC) : WSP(bf16_t, WS_KC)) + ((size_t)b * 256 + F.wave * 32) * 64 + r32;
#pragma unroll
              for (int r = 0; r < 16; ++r) { const int rw = crow(r, hi); dst[(size_t)rw * 64] = (bf16_t)f2bf(o0[r]); dst[(size_t)rw * 64 + 32] = (bf16_t)f2bf(o1[r]); }
              if (which == 0) {
                  float mxn = 0.f;
#pragma unroll
                  for (int r = 0; r < 16; ++r) { float sq = o0[r] * o0[r] + o1[r] * o1[r]; sq += xor_lane_lt32<1>(sq); sq += xor_lane_lt32<2>(sq); sq += xor_lane_lt32<4>(sq); sq += xor_lane_lt32<8>(sq); sq += xor_lane_lt32<16>(sq); mxn = fmaxf(mxn, sq); }
                  mxn = fmaxf(mxn, other_half(mxn, hi));
                  if (ln_ == 0) atomicMax((unsigned*)(F.ctl + CW_KCMX + 16 * l) + b, __float_as_uint(mxn)); } } }
        if (PH(4)) { int G2_ = F.G; asm volatile("" : "+s"(G2_)); const bool split = G2_ > 64; const int g2 = split ? F.G - 32 : F.G, c2 = split ? c - 32 : c;
          { SchedSimple S; S.T.init(256, 2, g2, c2 < 0 ? (1 << 28) : c2); S.A = (const char*)(F.ws + WS_P) + PC_DQL * 2; S.B = (const char*)(wl + LW_UQ); S.lda = PW * 2; S.ldb = 512; S.nt = 4;
            pg8::EpiQup E{WSP(bf16_t, WS_QM), WSP(const float, WS_SSQQ), WSP(const float, WS_ROPE)};
            pg8::gemm_phase<pg8::EpiQup, SchedSimple, true>(F.lds, S, E, F.wave); }
          { SchedSimple S; S.T.init(256, 2, g2, c2 < 0 ? (1 << 28) : c2); S.A = (const char*)(F.ws + WS_P) + PC_DKV * 2; S.B = (const char*)(wl + LW_UKV); S.lda = PW * 2; S.ldb = 256; S.nt = 2;
            pg8::EpiKVup E{WSP(bf16_t, WS_KVM), WSP(const float, WS_SSQKV), (unsigned*)(F.ctl + CW_KMLA + 256 * l)};
            pg8::gemm_phase<pg8::EpiKVup, SchedSimple, true>(F.lds, S, E, F.wave); } }
        PHASE_FRESH();
        if (PH(5)) {
          int G_ = F.G; asm volatile("" : "+s"(G_)); const int cb = (G_ >= 48) ? c - 32 : c;
          if (cb >= 0 && cb < BATCH) { const int b = cb, tid = F.tid; const float* fl = WSP(const float, WS_SIDE) + ((size_t)b * SEQ + 8 * tid) * 16 + 12; const f32x4 fb = *(const f32x4*)(F.in[12] + l * 4);
              f32x4 v[8];
#pragma unroll
              for (int i = 0; i < 8; ++i) { const f32x4 z = *(const f32x4*)(fl + 16 * i);
#pragma unroll
                  for (int e = 0; e < 4; ++e) { const float x = z[e] + fb[e], t = fast_exp2(-fabsf(x) * LOG2E), lg = __builtin_amdgcn_logf(1.0f + t) * 0.6931471805599453f; v[i][e] = fminf(x, 0.f) - lg; } }
#pragma unroll
              for (int i = 1; i < 8; ++i) v[i] = v[i] + v[i - 1];
              LAS f32x4* sc = (LAS f32x4*)F.lds; f32x4 run = v[7];
              sc[tid] = run; __syncthreads();
              for (int off = 1, cur = 0; off < 512; off <<= 1, cur ^= 1) { f32x4 t = sc[cur * 512 + tid]; if (tid >= off) t = t + sc[cur * 512 + tid - off]; sc[(cur ^ 1) * 512 + tid] = t; __syncthreads(); run = t; }
              const f32x4 ex = run - v[7];
              float* kb = WSP(float, WS_KB) + (size_t)b * 4 * SEQ + 8 * tid;
#pragma unroll
              for (int e = 0; e < 4; ++e) { f32x4 lo, hi4;
#pragma unroll
                  for (int i = 0; i < 4; ++i) { lo[i] = -(ex[e] + v[i][e]) * LOG2E; hi4[i] = -(ex[e] + v[4 + i][e]) * LOG2E; }
                  *(f32x4*)(kb + (size_t)e * SEQ) = lo; *(f32x4*)(kb + (size_t)e * SEQ + 4) = hi4; }
              __syncthreads();
          } }
        }
        if (PH(5)) {
          const int gt2 = c * 512 + F.tid, hp = gt2 & 1;
          for (int t2 = gt2 >> 1; t2 < M; t2 += F.G * 256) { const bf16_t* Kp = WSP(const bf16_t, WS_P) + (size_t)t2 * PW + PC_CK + hp * 128; float s0 = 0.f, s1 = 0.f, s2 = 0.f;
              if (hp == 0) { const bf16_t* Rp = WSP(const bf16_t, WS_KROT) + (size_t)t2 * 32;
#pragma unroll
                  for (int q8 = 0; q8 < 4; ++q8) { const bf16x8 ra = *(const bf16x8*)(Rp + q8 * 8);
#pragma unroll
                      for (int e = 0; e < 8; ++e) { const float xa = bf2f((unsigned short)ra[e]); s2 += xa * xa; } } }
#pragma unroll
              for (int q8 = 0; q8 < 8; ++q8) { const bf16x8 ka = *(const bf16x8*)(Kp + q8 * 8), kb2 = *(const bf16x8*)(Kp + 64 + q8 * 8);
#pragma unroll
                  for (int e = 0; e < 8; ++e) { const float xa = bf2f((unsigned short)ka[e]), xb = bf2f((unsigned short)kb2[e]); s0 += xa * xa; s1 += xb * xb; } }
              s0 = fmaxf(s0, xor_lane_lt32<2>(s0)); s0 = fmaxf(s0, xor_lane_lt32<4>(s0)); s0 = fmaxf(s0, xor_lane_lt32<8>(s0)); s0 = fmaxf(s0, xor_lane_lt32<16>(s0));
              s1 = fmaxf(s1, xor_lane_lt32<2>(s1)); s1 = fmaxf(s1, xor_lane_lt32<4>(s1)); s1 = fmaxf(s1, xor_lane_lt32<8>(s1)); s1 = fmaxf(s1, xor_lane_lt32<16>(s1));
              { auto r0 = __builtin_amdgcn_permlane32_swap(__float_as_uint(s0), __float_as_uint(s0), false, false); s0 = fmaxf(__uint_as_float(r0[0]), __uint_as_float(r0[1]));
                auto r1 = __builtin_amdgcn_permlane32_swap(__float_as_uint(s1), __float_as_uint(s1), false, false); s1 = fmaxf(__uint_as_float(r1[0]), __uint_as_float(r1[1])); }
              float s3 = 0.f; { const bf16_t* Np = WSP(const bf16_t, WS_P) + (size_t)t2 * PW + (hp ? PC_KWIN : PC_KSLC);
#pragma unroll
                  for (int q8 = 0; q8 < 8; ++q8) { const bf16x8 na = *(const bf16x8*)(Np + q8 * 8);
#pragma unroll
                      for (int e = 0; e < 8; ++e) { const float xa = bf2f((unsigned short)na[e]); s3 += xa * xa; } } }
              float s4 = 0.f; { const bf16_t* Qp = WSP(const bf16_t, WS_P) + (size_t)t2 * PW + PC_AQ + hp * 128;
                  float sa = 0.f, sb = 0.f;
#pragma unroll
                  for (int q8 = 0; q8 < 8; ++q8) { const bf16x8 qa = *(const bf16x8*)(Qp + q8 * 8), qb2 = *(const bf16x8*)(Qp + 64 + q8 * 8);
#pragma unroll
                      for (int e = 0; e < 8; ++e) { const float xa = bf2f((unsigned short)qa[e]), xb = bf2f((unsigned short)qb2[e]); sa += xa * xa; sb += xb * xb; } }
                  s4 = fmaxf(sa, sb); }
              s4 = fmaxf(s4, xor_lane_lt32<1>(s4)); s4 = fmaxf(s4, xor_lane_lt32<2>(s4)); s4 = fmaxf(s4, xor_lane_lt32<4>(s4)); s4 = fmaxf(s4, xor_lane_lt32<8>(s4)); s4 = fmaxf(s4, xor_lane_lt32<16>(s4));
              { auto r4 = __builtin_amdgcn_permlane32_swap(__float_as_uint(s4), __float_as_uint(s4), false, false); s4 = fmaxf(__uint_as_float(r4[0]), __uint_as_float(r4[1])); }
              s3 = fmaxf(s3, xor_lane_lt32<2>(s3)); s3 = fmaxf(s3, xor_lane_lt32<4>(s3)); s3 = fmaxf(s3, xor_lane_lt32<8>(s3)); s3 = fmaxf(s3, xor_lane_lt32<16>(s3));
              { auto r3 = __builtin_amdgcn_permlane32_swap(__float_as_uint(s3), __float_as_uint(s3), false, false); s3 = fmaxf(__uint_as_float(r3[0]), __uint_as_float(r3[1])); }
              s2 = fmaxf(s2, xor_lane_lt32<2>(s2)); s2 = fmaxf(s2, xor_lane_lt32<4>(s2)); s2 = fmaxf(s2, xor_lane_lt32<8>(s2)); s2 = fmaxf(s2, xor_lane_lt32<16>(s2));
              { auto r2 = __builtin_amdgcn_permlane32_swap(__float_as_uint(s2), __float_as_uint(s2), false, false); s2 = fmaxf(__uint_as_float(r2[0]), __uint_as_float(r2[1])); }
              if (F.lane < 2) { unsigned* kw = (unsigned*)(F.ctl + CW_KMAX + 64 * l) + (t2 >> 12) * 4 + 2 * hp; atomicMax(kw, __float_as_uint(s0)); atomicMax(kw + 1, __float_as_uint(s1));
                  if (hp == 0) atomicMax((unsigned*)(F.ctl + CW_KROT + 16 * l) + (t2 >> 12), __float_as_uint(s2));
                  atomicMax((unsigned*)(F.ctl + CW_KNSA + 32 * l) + (t2 >> 12) * 2 + hp, __float_as_uint(s3));
                  if (hp == 0) atomicMax((unsigned*)(F.ctl + CW_QNSA + 16 * l) + (t2 >> 12), __float_as_uint(s4)); } } }
        xcd_barrier(bar, F.wave); TSTAMP(3);
        PHASE_FRESH();
        for (int rep = 0; rep < DUP_ATTN; ++rep) { gu32* ctr = F.ctl + CW_Q + 64 * l + 16 * rep;
          if (rep) xcd_barrier(bar, F.wave);
#define Q_T0 (F.wave == 0 && lane_now() == 0)
          const unsigned xq = xb_xcc_id() & 7u; unsigned kx = 0u;
#define Q_TAKE(dst) do { dst = 0xffffffffu; while (kx < 8u) { const unsigned li_ = (xq + kx) & 7u; const unsigned t_ = __hip_atomic_fetch_add(ctr + li_, 1u, __ATOMIC_RELAXED, __HIP_MEMORY_SCOPE_AGENT); \
              if (t_ < (unsigned)(ATT_UNITS / 8)) { dst = li_ * (unsigned)(ATT_UNITS / 8) + t_; break; } ++kx; } } while (0)
          unsigned nxtq = 0u; if (Q_T0) Q_TAKE(nxtq);
          for (;;) { if (Q_T0) F.MISC[0] = nxtq; __syncthreads(); const int iq = (int)F.MISC[0]; __syncthreads(); if ((unsigned)iq >= (unsigned)ATT_UNITS) break;
              if (Q_T0) Q_TAKE(nxtq);
              const int it = __builtin_amdgcn_readfirstlane(WSP(const int, WS_ORDER)[iq]);
              if (it < 2048 && PH(7)) { const int qb = 15 - (it >> 7), mla = (it >> 6) & 1, bh = it & 63; if (mla) { const gu32* km = F.ctl + CW_KMLA + 256 * l + bh * 4; const float k2 = __uint_as_float(__hip_atomic_load(km, __ATOMIC_RELAXED, __HIP_MEMORY_SCOPE_AGENT)) + __uint_as_float(__hip_atomic_load(km + 1, __ATOMIC_RELAXED, __HIP_MEMORY_SCOPE_AGENT)) + __uint_as_float(__hip_atomic_load(F.ctl + CW_KROT + 16 * l + (bh >> 2), __ATOMIC_RELAXED, __HIP_MEMORY_SCOPE_AGENT)); causal_unit<false>(F, bh >> 2, bh & 3, qb, sqrtf(k2) * 1.01f); } else causal_unit<true>(F, bh >> 2, bh & 3, qb, sqrtf(__uint_as_float(__hip_atomic_load(F.ctl + CW_KMAX + 64 * l + bh, __ATOMIC_RELAXED, __HIP_MEMORY_SCOPE_AGENT)))); }
              else if (it < 3072 && PH(8)) { const int r = it - 2048; const int bN = r & 15; const float qm2 = __uint_as_float(__hip_atomic_load(F.ctl + CW_QNSA + 16 * l + bN, __ATOMIC_RELAXED, __HIP_MEMORY_SCOPE_AGENT)), ka2 = __uint_as_float(__hip_atomic_load(F.ctl + CW_KNSA + 32 * l + bN * 2, __ATOMIC_RELAXED, __HIP_MEMORY_SCOPE_AGENT)), kb2 = __uint_as_float(__hip_atomic_load(F.ctl + CW_KNSA + 32 * l + bN * 2 + 1, __ATOMIC_RELAXED, __HIP_MEMORY_SCOPE_AGENT));
                  const float tmx = fmaxf(fmaxf(WSP(const float, WS_FARB)[4], WSP(const float, WS_FARB)[5]), fmaxf(WSP(const float, WS_FARB)[6], WSP(const float, WS_FARB)[7]));
                  const float kc2 = __uint_as_float(__hip_atomic_load(F.ctl + CW_KCMX + 16 * l + bN, __ATOMIC_RELAXED, __HIP_MEMORY_SCOPE_AGENT));
                  const bool fastB = (sqrtf(qm2) * sqrtf(fmaxf(ka2, kb2)) * 1.002f + tmx + 0.05f) <= 50.0f && (sqrtf(qm2) * sqrtf(kc2) * 1.02f + 0.05f) <= 50.0f;
                  if (__builtin_amdgcn_readfirstlane(fastB ? 1 : 0)) nsa_unit<true>(F, bN, 63 - (r >> 4), l); else nsa_unit<false>(F, bN, 63 - (r >> 4), l); }
              else if (it < 3328 && PH(9)) { const int r = it - 3072; dil_unit(F, r & 15, (r >> 4) & 1, r >> 5); } } }
        xcd_barrier(bar, F.wave); TSTAMP(5);
        for (int rep = 0; rep < DUP_MERGE; ++rep) if (PH(10)) { if (rep) xcd_barrier(bar, F.wave); SchedMerge S; S.T.init(256, 4, F.G, c); S.ocat = (const char*)(F.ws + WS_OCAT); S.h = (const char*)F.out + H8_OFF; S.wbr = (const char*)(wl + LW_BR); S.wg = (const char*)(wl + LW_G); S.dup = SDUP_MERGE;
          unsigned char* scr = F.ws + WS_MSCR + (size_t)c * MSCR_PER_WG;
          pg8::EpiMerge E{WSP(bf16_t, WS_MERGED), scr};
          pg8::gemm_phase<pg8::EpiMerge, SchedMerge, true, true>(F.lds, S, E, F.wave); }
        xcd_barrier(bar, F.wave); TSTAMP(6);
        if (PH(11)) { SchedSimple S; S.T.init(256, 4, F.G, c); S.A = (const char*)(F.ws + WS_MERGED); S.B = (const char*)(wl + LW_O); S.lda = 2048; S.ldb = 2048; S.nt = 16; S.dup = SDUP_WO;
          pg8::EpiBf16 E{WSP(bf16_t, WS_Y), DM};
          pg8::gemm_phase<pg8::EpiBf16, SchedSimple, true>(F.lds, S, E, F.wave); }
        xcd_barrier(bar, F.wave); TSTAMP(7);
        PHASE_FRESH();
        if (PH(12)) { if (l == 0) rowpass<1, false, true>(F, F.in[0], WSP(const bf16_t, WS_Y), 0, F.out, WSP(bf16_t, WS_H2), F.in[3] + l * DM, F.in[4] + l * DM, 0, M);
                      else rowpass<1, true, true>(F, F.out, WSP(const bf16_t, WS_Y), 0, WSP(bf16_t, WS_X3), WSP(bf16_t, WS_H2), F.in[3] + l * DM, F.in[4] + l * DM, 0, M); }
        xcd_barrier(bar, F.wave); TSTAMP(8);
#ifndef DUP_UP
#define DUP_UP 1
#endif
        _Pragma("unroll") for (int rep = 0; rep < DUP_UP; ++rep) if (PH(13)) { if (rep) xcd_barrier(bar, F.wave); SchedSimple S; S.T.init(256, 22, F.G, c); S.A = (const char*)(F.ws + WS_H2); S.B = (const char*)(wl + LW_UP); S.lda = 2048; S.ldb = 2048; S.nt = 16; S.dup = SDUP_UP;
          pg8::EpiUpConv E{WSP(bf16_t, WS_ACT), WSP(float, WS_HB), WSP(const float, WS_CWS) + (size_t)l * 4 * DFF2, WSP(const float, WS_CWS) + (size_t)l * 4 * DFF2 + 3 * DFF2};
          pg8::gemm_phase<pg8::EpiUpConv, SchedSimple, true>(F.lds, S, E, F.wave); }
        xcd_barrier(bar, F.wave); TSTAMP(9);
        PHASE_FRESH();
        if (PH(15)) { SchedSimple S; S.T.init(256, 4, F.G, c); S.A = (const char*)(F.ws + WS_ACT); S.B = (const char*)(wl + LW_DN); S.lda = DFF * 2; S.ldb = DFF * 2; S.nt = DFF / 64; S.dup = SDUP_DN;
          { int pm, pn; for (int i = 0; S.T.tile(i, pm, pn); ++i) ffn_fix_panel(F, pm, WSP(const float, WS_HB), WSP(bf16_t, WS_ACT), F.in[24] + (size_t)l * 3 * DFF2, F.in[25] + (size_t)l * DFF2); }
          VM_WAIT(); __syncthreads();
          pg8::EpiBf16 E{WSP(bf16_t, WS_Y2), DM};
          pg8::gemm_phase<pg8::EpiBf16, SchedSimple, true>(F.lds, S, E, F.wave); }
        xcd_barrier(bar, F.wave); TSTAMP(11);
        PHASE_FRESH();
        if (PH(16)) { if (l + 1 < DEPTH) rowpass<1, true, true, true>(F, F.out, WSP(const bf16_t, WS_Y2), 0, F.out, WSP(bf16_t, WS_H), F.in[5] + l * DM, F.in[2] + (l + 1) * DM, 0, M, (unsigned char*)F.out + H8_OFF);
                      else rowpass<2, true, false>(F, WSP(const bf16_t, WS_X3), WSP(const bf16_t, WS_Y2), 0, F.out, nullptr, F.in[5] + l * DM, nullptr, 0, M); }
        if (l + 1 < DEPTH) xcd_barrier(bar, F.wave);
        TSTAMP(12);
    }
}

extern "C" void kernel_launch(void* const* d_in, const int* in_sizes, int n_in, void* d_out, int out_size, void* d_ws, size_t ws_size, hipStream_t stream) {
    static int grid = 0;
    if (grid == 0) {
        if (n_in != 27 || in_sizes[0] != M * DM || out_size != M * DM || ws_size < WS_END) { fprintf(stderr, "kernel_launch: unexpected shapes (n_in %d, in0 %d, out %d, ws %zu)\n", n_in, n_in > 0 ? in_sizes[0] : -1, out_size, ws_size); grid = -1; return; }
        int dev = 0, cus = 0, per_cu = 0;
        if (hipGetDevice(&dev) != hipSuccess || hipDeviceGetAttribute(&cus, hipDeviceAttributeMultiprocessorCount, dev) != hipSuccess) { grid = -1; return; }
        if (hipFuncSetAttribute((const void*)hybrid_fwd, hipFuncAttributeMaxDynamicSharedMemorySize, LDS_BYTES) != hipSuccess) { fprintf(stderr, "kernel_launch: hipFuncSetAttribute failed\n"); grid = -1; return; }
        if (hipOccupancyMaxActiveBlocksPerMultiprocessor(&per_cu, (const void*)hybrid_fwd, 512, LDS_BYTES) != hipSuccess || per_cu < 1) fprintf(stderr, "kernel_launch: occupancy query says %d\n", per_cu);
        (void)hipGetLastError();
        grid = cus;
    }
    if (grid < 0) return;
    if (hipMemsetAsync((char*)d_ws + WS_CTL, 0, CTL_ZERO_BYTES, stream) != hipSuccess) return;
    Args a{};
    for (int i = 0; i < 27; ++i) a.in[i] = (const float*)d_in[i];
    a.out = (float*)d_out; a.ws = (unsigned char*)d_ws;
    hipLaunchKernelGGL(hybrid_fwd, dim3(grid), dim3(512), LDS_BYTES, stream, a);
}
```

```cpp
#include <hip/hip_runtime.h>
#include <hip/hip_bf16.h>
#include <cstdio>
#include <cstdint>
#include <cmath>

#define GAS __attribute__((address_space(1)))
#define LAS __attribute__((address_space(3)))
typedef unsigned short bf16_t;
typedef short bf16x8 __attribute__((ext_vector_type(8)));
typedef short s16x4 __attribute__((ext_vector_type(4)));
typedef float f32x4 __attribute__((ext_vector_type(4)));
typedef float f32x2 __attribute__((ext_vector_type(2)));
typedef float f32x16 __attribute__((ext_vector_type(16)));
typedef unsigned u32x4 __attribute__((ext_vector_type(4)));
typedef unsigned u32x2 __attribute__((ext_vector_type(2)));
typedef GAS unsigned gu32;

constexpr int BATCH = 16, SEQ = 4096, DM = 1024, M = BATCH * SEQ, DEPTH = 2;
constexpr int DIN = 2992, PW = 3072;
constexpr int DFF = 2816, DFF2 = 5632;
constexpr float LOG2E = 1.4426950408889634f;
constexpr float C2A = 0.125f * LOG2E;
constexpr float C2D = 0.10206207261596575f * LOG2E;
constexpr float RMS_EPS = 1e-6f;
constexpr float H8_SCALE = 0.5f, WG8_SCALE = -2.8853900817779268f;
constexpr int PC_AQ = 0, PC_KCMP = 256, PC_VCMP = 320, PC_KSLC = 384, PC_VSLC = 448, PC_KWIN = 512, PC_VWIN = 576,
              PC_MISC = 640, PC_KROPE = 672, PC_BQ = 768, PC_BK = 1152, PC_BV = 1536, PC_DKV = 1920,
              PC_CQ = 2048, PC_CK = 2304, PC_CV = 2560, PC_DQL = 2816;
constexpr int OCW = 896;
constexpr int NSA_DFAR = 1536, NSA_DMAX = 1664, NSA_TL = 1728;

__device__ __forceinline__ unsigned f2bf(float f) { unsigned u = __float_as_uint(f); return (u + 0x7fffu + ((u >> 16) & 1u)) >> 16; }
__device__ __forceinline__ unsigned pk2(float lo, float hi) { return f2bf(lo) | (f2bf(hi) << 16); }
__device__ __forceinline__ float bf2f(unsigned short b) { return __uint_as_float((unsigned)b << 16); }
typedef __bf16 bf16x2_t __attribute__((ext_vector_type(2)));
__device__ __forceinline__ unsigned cvtpk(float lo, float hi) { f32x2 v = {lo, hi}; bf16x2_t b = __builtin_convertvector(v, bf16x2_t); return __builtin_bit_cast(unsigned, b); }
__device__ __forceinline__ unsigned pk4_fp8(float a, float b, float c, float d) { int w = 0; w = __builtin_amdgcn_cvt_pk_fp8_f32(a, b, w, false); w = __builtin_amdgcn_cvt_pk_fp8_f32(c, d, w, true); return (unsigned)w; }
__device__ __forceinline__ float fast_exp2(float x) { return __builtin_amdgcn_exp2f(x); }
__device__ __forceinline__ float fast_rcp(float x) { return __builtin_amdgcn_rcpf(x); }
template <int MASK> __device__ __forceinline__ float xor_lane_lt32(float v) { return __uint_as_float(__builtin_amdgcn_ds_swizzle((int)__float_as_uint(v), (MASK << 10) | 0x1f)); }
__device__ __forceinline__ float sum_halves(float v) { auto rr = __builtin_amdgcn_permlane32_swap(__float_as_uint(v), __float_as_uint(v), false, false); return __uint_as_float(rr[0]) + __uint_as_float(rr[1]); }
__device__ __forceinline__ float sigmoid_f(float x) { return fast_rcp(1.0f + fast_exp2(-x * LOG2E)); }

__device__ __forceinline__ int lane_now() { int l; asm volatile("v_mbcnt_lo_u32_b32 %0, -1, 0\n\tv_mbcnt_hi_u32_b32 %0, -1, %0" : "=v"(l)); return l; }
namespace pg8 {
constexpr int BM = 256, BK = 64, HALF = 128, HTB = HALF * BK * 2  , STAGE_BYTES = 8 * HTB, NXCD = 8, WGM = 8;
__host__ __device__ __forceinline__ int lds_byte(int r, int c) { const int st = (r >> 4) * 2 + (c >> 5), rr = r & 15, cc = c & 31, ob = rr * 64 + cc * 2; return st * 1024 + (ob ^ (((ob >> 9) & 1) << 5)); }
__host__ __device__ __forceinline__ void stage_rc(int b, int& R, int& C) { const int st = b / 1024, sb = b % 1024, swz = sb ^ (((sb >> 9) & 1) << 5); R = (st >> 1) * 16 + swz / 64; C = (st & 1) * 32 + (swz % 64) / 2; }
__host__ __device__ __forceinline__ int perm32(int rho) { const int n = rho >> 4, i = rho & 15; return 8 * (i >> 2) + 4 * n + (i & 3); }

typedef int v8i_t __attribute__((ext_vector_type(8)));
typedef int v4i_t __attribute__((ext_vector_type(4)));
__device__ __forceinline__ v8i_t cat8(const bf16x8 lo, const bf16x8 hi) { const v4i_t a = __builtin_bit_cast(v4i_t, lo), b = __builtin_bit_cast(v4i_t, hi); return __builtin_shufflevector(a, b, 0, 1, 2, 3, 4, 5, 6, 7); }
struct GUnit { const char* A; const char* B; int lda, ldb, nt, pm, pn, id; };

struct TileOrder {
    int nM, nN, nwg, G, c;
    __device__ __forceinline__ void init(int nM_, int nN_, int G_, int c_) { nM = nM_; nN = nN_; nwg = nM * nN; G = G_; c = c_; }
    __device__ __forceinline__ bool tile(int i, int& pm, int& pn) const {
        const long L = (long)i * G + c; if (L >= nwg) return false;
        int wgid = (int)L; { const int q = nwg / NXCD, r = nwg % NXCD, xcd = wgid % NXCD, off = wgid / NXCD; wgid = (xcd < r ? xcd * (q + 1) : r * (q + 1) + (xcd - r) * q) + off; }
        const int nig = WGM * nN, gid = wgid / nig, fm = gid * WGM, gsz = (nM - fm) < WGM ? (nM - fm) : WGM;
        pm = fm + ((wgid % nig) % gsz); pn = (wgid % nig) / gsz; return true;
    }
};

template <class Epi, class Sched, bool ALIGN_EPI, bool F8 = false>
__device__ __forceinline__ void gemm_phase(LAS unsigned char* lds, const Sched& S, const Epi& E, int wave_id) {
    int tid_o = wave_id * 64 + lane_now();
    const int tid = tid_o, wid = __builtin_amdgcn_readfirstlane(tid >> 6), lane = tid & 63, wr = wid >> 2, wc = wid & 3; int fr = lane & 15, fq = lane >> 4;
    int sR[2], sC[2], sRb[2];
#pragma unroll
    for (int i = 0; i < 2; ++i) { stage_rc(tid * 16 + i * 8192, sR[i], sC[i]); sRb[i] = Epi::PERM ? ((sR[i] & ~31) + perm32(sR[i] & 31)) : sR[i]; sC[i] *= 2; }
    const size_t kstep = (size_t)(BK * 2);
    const unsigned ldsw = (unsigned)wid * 1024u;
    const int aoff = lds_byte(wr * 64 + fr, fq * 8), boff = lds_byte(wc * 32 + fr, fq * 8);
#define PG8_SA(b, h) (((b) * 2 + (h)) * HTB)
#define PG8_SB(b, h) ((4 + (b) * 2 + (h)) * HTB)
#define PG8_STAGE(bufoff, gbase, rows, ld) do { _Pragma("unroll") for (int _i = 0; _i < 2; ++_i) \
        __builtin_amdgcn_global_load_lds((const unsigned*)((const char*)(gbase) + (unsigned)((rows)[_i] * (ld) + sC[_i])), (LAS unsigned*)(lds + (bufoff) + ldsw + _i * 8192), 16, 0, 0); } while (0)
#define PG8_LDA(dst, b, h) do { _Pragma("unroll") for (int m = 0; m < 4; ++m) _Pragma("unroll") for (int k = 0; k < 2; ++k) dst[m][k] = *(const LAS bf16x8*)(lds + PG8_SA(b, h) + aoff + m * 2048 + k * 1024); } while (0)
#define PG8_LDB(dst, b, h) do { _Pragma("unroll") for (int n = 0; n < 2; ++n) _Pragma("unroll") for (int k = 0; k < 2; ++k) dst[n][k] = *(const LAS bf16x8*)(lds + PG8_SB(b, h) + boff + n * 2048 + k * 1024); } while (0)
#define PG8_MMA(ai, bj, At, Bt) do { __builtin_amdgcn_s_setprio(1); _Pragma("unroll") for (int m = 0; m < 4; ++m) _Pragma("unroll") for (int n = 0; n < 2; ++n) _Pragma("unroll") for (int k = 0; k < 2; ++k) \
        acc[ai][bj][m][n] = __builtin_amdgcn_mfma_f32_16x16x32_bf16(Bt[n][k], At[m][k], acc[ai][bj][m][n], 0, 0, 0); __builtin_amdgcn_s_setprio(0); } while (0)
#define PG8_LDA8(dst, b, h) do { _Pragma("unroll") for (int m = 0; m < 4; ++m) { dst[m].lo = *(const LAS v4i_t*)(lds + PG8_SA(b, h) + aoff + m * 2048); dst[m].hi = *(const LAS v4i_t*)(lds + PG8_SA(b, h) + aoff + m * 2048 + 1024); } } while (0)
#define PG8_LDB8(dst, b, h) do { _Pragma("unroll") for (int n = 0; n < 2; ++n) { dst[n].lo = *(const LAS v4i_t*)(lds + PG8_SB(b, h) + boff + n * 2048); dst[n].hi = *(const LAS v4i_t*)(lds + PG8_SB(b, h) + boff + n * 2048 + 1024); } } while (0)
#define PG8_MMA8(ai, bj, At, Bt) do { __builtin_amdgcn_s_setprio(1); _Pragma("unroll") for (int m = 0; m < 4; ++m) _Pragma("unroll") for (int n = 0; n < 2; ++n) \
        asm volatile("v_mfma_f32_16x16x128_f8f6f4 %0, %1, %2, %0" : "+v"(acc[ai][bj][m][n]) : "v"(Bt[n]), "v"(At[m])); __builtin_amdgcn_s_setprio(0); } while (0)
#define PG8_WAIT_V(n) asm volatile("s_waitcnt vmcnt(" #n ")" ::: "memory")
#define PG8_WAIT_L(n) asm volatile("s_waitcnt lgkmcnt(" #n ")" ::: "memory")
#define PG8_BAR __builtin_amdgcn_s_barrier()
#define PG8_SCHED __builtin_amdgcn_sched_barrier(0)
#define PG8_KLOOP(MM, LDA_, LDB_, At, B0, B1) for (int t = 0; t < nt; t += 2) { \
            const bool last = (t == nt - 2); \
            const char* a1 = cA + (size_t)(t + 1) * kstep; \
            const char* a2 = last ? nA : cA + (size_t)(t + 2) * kstep; const char* b2 = last ? nB : cB + (size_t)(t + 2) * kstep; \
            const char* a3 = a2 + kstep; const char* b3 = b2 + kstep; \
            const int ldA2 = last ? ldAn : ldAc, ldB2 = last ? ldBn : ldBc; \
            const size_t hA2 = last ? hAn : hAc, hB2 = last ? hBn : hBc; \
              \
            LDB_(B0, 0, 0); LDB_(B1, 0, 1); PG8_SCHED; LDA_(At, 0, 0); PG8_STAGE(PG8_SA(1, 1), a1 + hAc, sR, ldAc); \
            PG8_WAIT_V(8); PG8_WAIT_L(0); PG8_BAR; MM(0, 0, At, B0); MM(0, 1, At, B1); PG8_BAR; PG8_SCHED; \
              \
            LDA_(At, 0, 1); PG8_STAGE(PG8_SB(0, 0), b2, sRb, ldB2); PG8_STAGE(PG8_SB(0, 1), b2 + hB2, sRb, ldB2); PG8_STAGE(PG8_SA(0, 0), a2, sR, ldA2); \
            PG8_WAIT_V(8); PG8_WAIT_L(0); PG8_BAR; MM(1, 0, At, B0); MM(1, 1, At, B1); PG8_BAR; PG8_SCHED; \
              \
            LDB_(B0, 1, 0); LDB_(B1, 1, 1); PG8_SCHED; LDA_(At, 1, 0); PG8_STAGE(PG8_SA(0, 1), a2 + hA2, sR, ldA2); \
            PG8_WAIT_V(8); PG8_WAIT_L(0); PG8_BAR; MM(0, 0, At, B0); MM(0, 1, At, B1); PG8_BAR; PG8_SCHED; \
              \
            LDA_(At, 1, 1); PG8_STAGE(PG8_SB(1, 0), b3, sRb, ldB2); PG8_STAGE(PG8_SB(1, 1), b3 + hB2, sRb, ldB2); PG8_STAGE(PG8_SA(1, 0), a3, sR, ldA2); \
            PG8_WAIT_V(8); PG8_WAIT_L(0); PG8_BAR; MM(1, 0, At, B0); MM(1, 1, At, B1); PG8_BAR; PG8_SCHED; \
        }
    GUnit cur, nxt; int ui = 0;
    if (!S.next(0, cur)) return;
    f32x4 acc[2][2][4][2];
#pragma unroll
    for (int a = 0; a < 2; ++a)
#pragma unroll
        for (int b = 0; b < 2; ++b)
#pragma unroll
            for (int m = 0; m < 4; ++m)
#pragma unroll
                for (int n = 0; n < 2; ++n) acc[a][b][m][n] = (f32x4){0.f, 0.f, 0.f, 0.f};
    bf16x8 At[4][2], B0[2][2], B1[2][2]; v8i_t At8[4], B08[2], B18[2];
    int ldAc = cur.lda, ldBc = cur.ldb; size_t hAc = (size_t)HALF * ldAc, hBc = (size_t)HALF * ldBc;
    const char* cA = cur.A; const char* cB = cur.B;
    PG8_STAGE(PG8_SB(0, 0), cB, sRb, ldBc); PG8_STAGE(PG8_SB(0, 1), cB + hBc, sRb, ldBc); PG8_STAGE(PG8_SA(0, 0), cA, sR, ldAc); PG8_STAGE(PG8_SA(0, 1), cA + hAc, sR, ldAc);
    if (wr == 1) PG8_BAR;
    PG8_WAIT_V(2); PG8_BAR;
    PG8_STAGE(PG8_SB(1, 0), cB + kstep, sRb, ldBc); PG8_STAGE(PG8_SA(1, 0), cA + kstep, sR, ldAc); PG8_STAGE(PG8_SB(1, 1), cB + hBc + kstep, sRb, ldBc);
    PG8_WAIT_V(6); PG8_BAR;
    for (;;) {
        const bool has_next = S.next(ui + 1, nxt);
        int ldAn, ldBn; const char* nA; const char* nB;
        if (has_next) { ldAn = nxt.lda; ldBn = nxt.ldb; nA = nxt.A; nB = nxt.B; } else { ldAn = ldAc; ldBn = ldBc; nA = cA; nB = cB; }
        const size_t hAn = (size_t)HALF * ldAn, hBn = (size_t)HALF * ldBn;
        int nt = cur.nt; asm volatile("" : "+s"(nt));
        bool f8u = false; if constexpr (F8) f8u = Epi::f8(cur);
        if (F8 && f8u) { PG8_KLOOP(PG8_MMA8, PG8_LDA8, PG8_LDB8, At8, B08, B18) asm volatile("s_nop 15\n\ts_nop 15" ::: "memory"); }
        else { PG8_KLOOP(PG8_MMA, PG8_LDA, PG8_LDB, At, B0, B1) }
        if constexpr (ALIGN_EPI) { if (wr == 0) PG8_BAR; }
        E(acc, cur, wr, wc, fr, fq);
        if (!has_next) break;
#pragma unroll
        for (int a = 0; a < 2; ++a)
#pragma unroll
            for (int b = 0; b < 2; ++b)
#pragma unroll
                for (int m = 0; m < 4; ++m)
#pragma unroll
                    for (int n = 0; n < 2; ++n) acc[a][b][m][n] = (f32x4){0.f, 0.f, 0.f, 0.f};
        cur = nxt; cA = nA; cB = nB; ++ui;
        ldAc = ldAn; ldBc = ldBn; hAc = hAn; hBc = hBn;
        if constexpr (ALIGN_EPI) { if (wr == 1) PG8_BAR; }
    }
    PG8_WAIT_V(0);
    if constexpr (!ALIGN_EPI) { if (wr == 0) PG8_BAR; }
    PG8_BAR;
#undef PG8_SA
#undef PG8_SB
#undef PG8_STAGE
#undef PG8_LDA
#undef PG8_LDB
#undef PG8_MMA
#undef PG8_MMA8
#undef PG8_LDA8
#undef PG8_LDB8
#undef PG8_KLOOP
#undef PG8_WAIT_V
#undef PG8_WAIT_L
#undef PG8_BAR
#undef PG8_SCHED
}
}
using pg8::GUnit;
namespace pg8 {
#define EPI_OPAQUE() asm volatile("" : "+v"(fr), "+v"(fq))
struct EpiBf16 {
    static constexpr bool PERM = true;
    bf16_t* O; int ldc;
    __device__ __forceinline__ void operator()(const f32x4 (&acc)[2][2][4][2], const GUnit& u, int wr, int wc, int fr, int fq) const {
        EPI_OPAQUE();
        const int row0 = u.pm * BM + wr * 64 + fr, col0 = u.pn * BM + wc * 32 + 8 * fq;
#pragma unroll
        for (int ai = 0; ai < 2; ++ai)
#pragma unroll
            for (int m = 0; m < 4; ++m) { bf16_t* rowp = O + (size_t)(row0 + ai * HALF + m * 16) * ldc + col0;
#pragma unroll
                for (int bj = 0; bj < 2; ++bj) { const f32x4 v0 = acc[ai][bj][m][0], v1 = acc[ai][bj][m][1];
                    u32x4 w; w.x = cvtpk(v0[0], v0[1]); w.y = cvtpk(v0[2], v0[3]); w.z = cvtpk(v1[0], v1[1]); w.w = cvtpk(v1[2], v1[3]);
                    *(u32x4*)(rowp + bj * HALF) = w; } }
    }
};
struct EpiF32 {
    static constexpr bool PERM = false;
    float* O; int ldc;
    __device__ __forceinline__ void operator()(const f32x4 (&acc)[2][2][4][2], const GUnit& u, int wr, int wc, int fr, int fq) const {
        EPI_OPAQUE();
        const int row0 = u.pm * BM + wr * 64 + fr, col0 = u.pn * BM + wc * 32 + 4 * fq;
#pragma unroll
        for (int ai = 0; ai < 2; ++ai)
#pragma unroll
            for (int m = 0; m < 4; ++m) { float* rowp = O + (size_t)(row0 + ai * HALF + m * 16) * ldc + col0;
#pragma unroll
                for (int bj = 0; bj < 2; ++bj)
#pragma unroll
                    for (int n = 0; n < 2; ++n) *(f32x4*)(rowp + bj * HALF + n * 16) = acc[ai][bj][m][n]; }
    }
};
__device__ __forceinline__ void rope8(f32x4& v0, f32x4& v1, const float* cs  ) {
    const f32x4 a = *(const f32x4*)cs, b = *(const f32x4*)(cs + 4);
    f32x4 r0, r1;
    r0[0] = v0[0] * a[0] - v0[1] * a[1]; r0[1] = v0[1] * a[0] + v0[0] * a[1];
    r0[2] = v0[2] * a[2] - v0[3] * a[3]; r0[3] = v0[3] * a[2] + v0[2] * a[3];
    r1[0] = v1[0] * b[0] - v1[1] * b[1]; r1[1] = v1[1] * b[0] + v1[0] * b[1];
    r1[2] = v1[2] * b[2] - v1[3] * b[3]; r1[3] = v1[3] * b[2] + v1[2] * b[3];
    v0 = r0; v1 = r1;
}
struct EpiInProj {
    static constexpr bool PERM = true;
    bf16_t* P; bf16_t* kcmp; bf16_t* vcmp; float* side; bf16_t* krot; const float* rope; float* ssq_q; float* ssq_kv; const float* fbias; float* lf;
    __device__ __forceinline__ void operator()(const f32x4 (&acc)[2][2][4][2], const GUnit& u, int wr, int wc, int fr, int fq) const {
        EPI_OPAQUE();
        const int row0 = u.pm * BM + wr * 64 + fr, col0 = u.pn * BM + wc * 32 + 8 * fq;
#pragma unroll
        for (int ai = 0; ai < 2; ++ai)
#pragma unroll
            for (int m = 0; m < 4; ++m) { const int row = row0 + ai * HALF + m * 16; bf16_t* rowp = P + (size_t)row * PW + col0;
                float ssq = 0.f;
#pragma unroll
                for (int bj = 0; bj < 2; ++bj) { f32x4 v0 = acc[ai][bj][m][0], v1 = acc[ai][bj][m][1];
                    if (u.pn == 2 && bj == 1) {
                        if (wc == 0 && fq < 2) { float* sp = side + (size_t)row * 16 + 8 * fq; *(f32x4*)sp = v0; *(f32x4*)(sp + 4) = v1; }
                        if (wc == 1) { rope8(v0, v1, rope + (size_t)(row & (SEQ - 1)) * 32 + 8 * fq);
                            u32x4 w; w.x = cvtpk(v0[0], v0[1]); w.y = cvtpk(v0[2], v0[3]); w.z = cvtpk(v1[0], v1[1]); w.w = cvtpk(v1[2], v1[3]);
                            *(u32x4*)(krot + (size_t)row * 32 + 8 * fq) = w; }
                    }
                    u32x4 w; w.x = cvtpk(v0[0], v0[1]); w.y = cvtpk(v0[2], v0[3]); w.z = cvtpk(v1[0], v1[1]); w.w = cvtpk(v1[2], v1[3]);
                    *(u32x4*)(rowp + bj * HALF) = w;
                    if (u.pn == 1 && bj == 0) { bf16_t* cp = (wc < 2 ? kcmp : vcmp) + (size_t)row * 64 + (wc & 1) * 32 + 8 * fq; *(u32x4*)cp = w; }
                    if (u.pn == 11 || (u.pn == 7 && bj == 1)) ssq += (v0[0] * v0[0] + v0[1] * v0[1]) + (v0[2] * v0[2] + v0[3] * v0[3]) + (v1[0] * v1[0] + v1[1] * v1[1]) + (v1[2] * v1[2] + v1[3] * v1[3]);
                }
                if (u.pn == 11 || u.pn == 7) { ssq += xor_lane_lt32<16>(ssq); ssq = sum_halves(ssq);
                    if (fq == 0) (u.pn == 11 ? ssq_q : ssq_kv)[(size_t)row * 4 + wc] = ssq; }
                asm volatile("" ::: "memory");
            }
    }
};
struct EpiQup {
    static constexpr bool PERM = true;
    bf16_t* O; const float* ssq_q; const float* rope;
    __device__ __forceinline__ void operator()(const f32x4 (&acc)[2][2][4][2], const GUnit& u, int wr, int wc, int fr, int fq) const {
        EPI_OPAQUE();
        const int row0 = u.pm * BM + wr * 64 + fr, col0 = u.pn * BM + wc * 32 + 8 * fq;
#pragma unroll
        for (int ai = 0; ai < 2; ++ai)
#pragma unroll
            for (int m = 0; m < 4; ++m) { const int row = row0 + ai * HALF + m * 16; bf16_t* rowp = O + (size_t)row * 512 + col0;
                const f32x4 pq = *(const f32x4*)(ssq_q + (size_t)row * 4);
                const float rstd = 1.0f / sqrtf(((pq[0] + pq[1]) + (pq[2] + pq[3])) * (1.0f / 256.0f) + RMS_EPS);
#pragma unroll
                for (int bj = 0; bj < 2; ++bj) { f32x4 v0 = acc[ai][bj][m][0] * rstd, v1 = acc[ai][bj][m][1] * rstd;
                    const int c8 = col0 + bj * HALF, within = c8 % 96;
                    if (c8 < 384 && within >= 64) rope8(v0, v1, rope + (size_t)(row & (SEQ - 1)) * 32 + (within - 64));
                    u32x4 w; w.x = cvtpk(v0[0], v0[1]); w.y = cvtpk(v0[2], v0[3]); w.z = cvtpk(v1[0], v1[1]); w.w = cvtpk(v1[2], v1[3]);
                    *(u32x4*)(rowp + bj * HALF) = w; }
                asm volatile("" ::: "memory"); }
    }
};
struct EpiKVup {
    static constexpr bool PERM = true;
    bf16_t* O; const float* ssq_kv; unsigned* kmx;
    __device__ __forceinline__ void operator()(const f32x4 (&acc)[2][2][4][2], const GUnit& u, int wr, int wc, int fr, int fq) const {
        EPI_OPAQUE();
        const int row0 = u.pm * BM + wr * 64 + fr, col0 = u.pn * BM + wc * 32 + 8 * fq;
        float mk0 = 0.f, mk1 = 0.f;
#pragma unroll
        for (int ai = 0; ai < 2; ++ai)
#pragma unroll
            for (int m = 0; m < 4; ++m) { const int row = row0 + ai * HALF + m * 16; bf16_t* rowp = O + (size_t)row * 512 + col0;
                const f32x4 pq = *(const f32x4*)(ssq_kv + (size_t)row * 4);
                const float rstd = 1.0f / sqrtf(((pq[0] + pq[1]) + (pq[2] + pq[3])) * (1.0f / 128.0f) + RMS_EPS);
#pragma unroll
                for (int bj = 0; bj < 2; ++bj) { const f32x4 v0 = acc[ai][bj][m][0] * rstd, v1 = acc[ai][bj][m][1] * rstd;
                    u32x4 w; w.x = cvtpk(v0[0], v0[1]); w.y = cvtpk(v0[2], v0[3]); w.z = cvtpk(v1[0], v1[1]); w.w = cvtpk(v1[2], v1[3]);
                    *(u32x4*)(rowp + bj * HALF) = w;
                    if (wc < 2) { float ss = ((v0[0] * v0[0] + v0[1] * v0[1]) + (v0[2] * v0[2] + v0[3] * v0[3])) + ((v1[0] * v1[0] + v1[1] * v1[1]) + (v1[2] * v1[2] + v1[3] * v1[3]));
                        ss += xor_lane_lt32<16>(ss); ss = sum_halves(ss); if (bj == 0) mk0 = fmaxf(mk0, ss); else mk1 = fmaxf(mk1, ss); } }
                asm volatile("" ::: "memory"); }
        if (wc < 2) {
            mk0 = fmaxf(mk0, xor_lane_lt32<1>(mk0)); mk0 = fmaxf(mk0, xor_lane_lt32<2>(mk0)); mk0 = fmaxf(mk0, xor_lane_lt32<4>(mk0)); mk0 = fmaxf(mk0, xor_lane_lt32<8>(mk0));
            mk1 = fmaxf(mk1, xor_lane_lt32<1>(mk1)); mk1 = fmaxf(mk1, xor_lane_lt32<2>(mk1)); mk1 = fmaxf(mk1, xor_lane_lt32<4>(mk1)); mk1 = fmaxf(mk1, xor_lane_lt32<8>(mk1));
            if (fr == 0 && fq == 0) { unsigned* kw = kmx + ((u.pm >> 4) * 4 + 2 * u.pn) * 4 + wc; atomicMax(kw, __float_as_uint(mk0)); atomicMax(kw + 4, __float_as_uint(mk1)); }
        }
    }
};
__device__ __forceinline__ float gelu_tanh(float x) { const float u2 = 2.0f * 0.7978845608028654f * (x + 0.044715f * x * x * x); return x * fast_rcp(1.0f + fast_exp2(-u2 * LOG2E)); }
struct EpiCmp1 {
    static constexpr bool PERM = true;
    bf16_t* O; const float* bias1;
    __device__ __forceinline__ void operator()(const f32x4 (&acc)[2][2][4][2], const GUnit& u, int wr, int wc, int fr, int fq) const {
        EPI_OPAQUE();
        const int row0 = u.pm * BM + wr * 64 + fr, col0 = wc * 32 + 8 * fq;
        f32x4 bv[2][2];
#pragma unroll
        for (int bj = 0; bj < 2; ++bj)
#pragma unroll
            for (int n = 0; n < 2; ++n) bv[bj][n] = *(const f32x4*)(bias1 + col0 + bj * HALF + 4 * n);
#pragma unroll
        for (int ai = 0; ai < 2; ++ai)
#pragma unroll
            for (int m = 0; m < 4; ++m) { bf16_t* rowp = O + (size_t)(row0 + ai * HALF + m * 16) * 256 + col0;
#pragma unroll
                for (int bj = 0; bj < 2; ++bj) { f32x4 v0 = acc[ai][bj][m][0] + bv[bj][0], v1 = acc[ai][bj][m][1] + bv[bj][1];
#pragma unroll
                    for (int e = 0; e < 4; ++e) { v0[e] = gelu_tanh(v0[e]); v1[e] = gelu_tanh(v1[e]); }
                    u32x4 w; w.x = cvtpk(v0[0], v0[1]); w.y = cvtpk(v0[2], v0[3]); w.z = cvtpk(v1[0], v1[1]); w.w = cvtpk(v1[2], v1[3]);
                    *(u32x4*)(rowp + bj * HALF) = w; } }
    }
};
typedef __amdgpu_buffer_rsrc_t rsrc_t;
struct EpiMerge {
    __device__ static __forceinline__ bool f8(const GUnit& u) { return u.id >= 4; }
    static constexpr bool PERM = true;
    bf16_t* O;
    unsigned char* scr;
    __device__ __forceinline__ void operator()(const f32x4 (&acc)[2][2][4][2], const GUnit& u, int wr, int wc, int fr, int fq) const {
        EPI_OPAQUE();
        const int tid = (wr * 4 + wc) * 64 + fq * 16 + fr;
        const int sub = u.id;
        const rsrc_t rs = __builtin_amdgcn_make_buffer_rsrc(scr, 0, 524288, 0x00020000);
        if (sub < 4) {
#pragma unroll
            for (int ai = 0; ai < 2; ++ai)
#pragma unroll
                for (int bj = 0; bj < 2; ++bj)
#pragma unroll
                    for (int m = 0; m < 4; ++m)
#pragma unroll
                        for (int n = 0; n < 2; ++n) { const int q = ((ai * 2 + bj) * 4 + m) * 2 + n; const f32x4 v = acc[ai][bj][m][n];
                            u32x2 w; w.x = cvtpk(v[0], v[1]); w.y = cvtpk(v[2], v[3]);
                            __builtin_amdgcn_raw_buffer_store_b64(w, rs, tid * 8, (sub * 32 + q) * 4096, 0); }
            return;
        }
        const int j = sub - 4;
        const int row0 = u.pm * BM + wr * 64 + fr, col0 = u.pn * BM + 64 * j + wc * 16 + 4 * fq;
#pragma unroll
        for (int ai = 0; ai < 2; ++ai) {
            u32x2 sv[4][4];
#pragma unroll
            for (int m = 0; m < 4; ++m)
#pragma unroll
                for (int g = 0; g < 4; ++g) { const int qb = (ai * 16 + m * 2);
                    sv[m][g] = (j == 0) ? __builtin_amdgcn_raw_buffer_load_b64(rs, tid * 8, (g * 32 + qb) * 4096, 0)
                             : (j == 1) ? __builtin_amdgcn_raw_buffer_load_b64(rs, tid * 8, (g * 32 + qb + 1) * 4096, 0)
                             : (j == 2) ? __builtin_amdgcn_raw_buffer_load_b64(rs, tid * 8, (g * 32 + qb + 8) * 4096, 0)
                                        : __builtin_amdgcn_raw_buffer_load_b64(rs, tid * 8, (g * 32 + qb + 9) * 4096, 0); }
#pragma unroll
            for (int m = 0; m < 4; ++m) { bf16_t* rowp = O + (size_t)(row0 + ai * HALF + m * 16) * DM + col0;
                f32x4 t = {0.f, 0.f, 0.f, 0.f};
#pragma unroll
                for (int g = 0; g < 4; ++g) { const f32x4 gt = acc[ai][g >> 1][m][g & 1]; const u32x2 s = sv[m][g];
                    t[0] += fast_rcp(1.0f + fast_exp2(gt[0])) * __uint_as_float(s.x << 16); t[1] += fast_rcp(1.0f + fast_exp2(gt[1])) * __uint_as_float(s.x & 0xffff0000u);
                    t[2] += fast_rcp(1.0f + fast_exp2(gt[2])) * __uint_as_float(s.y << 16); t[3] += fast_rcp(1.0f + fast_exp2(gt[3])) * __uint_as_float(s.y & 0xffff0000u); }
                u32x2 w; w.x = cvtpk(t[0], t[1]); w.y = cvtpk(t[2], t[3]);
                *(u32x2*)rowp = w; }
            asm volatile("" ::: "memory"); }
    }
};
__device__ __forceinline__ float dpp_ror1(float v) { return __uint_as_float((unsigned)__builtin_amdgcn_mov_dpp((int)__float_as_uint(v), 0x121, 0xf, 0xf, false)); }
__device__ __forceinline__ float dpp_ror2(float v) { return __uint_as_float((unsigned)__builtin_amdgcn_mov_dpp((int)__float_as_uint(v), 0x122, 0xf, 0xf, false)); }
struct EpiUpConv {
    static constexpr int KIND = 8;
    static constexpr bool PERM = true;
    bf16_t* ACT; float* HB; const float* cw; const float* cb;
    __device__ __forceinline__ void operator()(const f32x4 (&acc)[2][2][4][2], const GUnit& u, int wr, int wc, int fr, int fq) const {
        EPI_OPAQUE();
        const int colL = wc * 32 + 8 * fq;
        const bool l0 = (fr == 0), l01 = (fr < 2);
#pragma unroll
        for (int n = 0; n < 2; ++n) {
            const int cl = colL + 4 * n, c0 = u.pn * 128 + cl;
            const f32x4 bg = *(const f32x4*)(cb + c0), w0g = *(const f32x4*)(cw + c0), w1g = *(const f32x4*)(cw + DFF2 + c0), w2g = *(const f32x4*)(cw + 2 * DFF2 + c0);
            const f32x4 bv = *(const f32x4*)(cb + DFF + c0), w0v = *(const f32x4*)(cw + DFF + c0), w1v = *(const f32x4*)(cw + DFF2 + DFF + c0), w2v = *(const f32x4*)(cw + 2 * DFF2 + DFF + c0);
            f32x4 w1ga, w1gb, w0ga, w0gb, w1va, w1vb, w0va, w0vb;
#pragma unroll
            for (int e = 0; e < 4; ++e) { w1ga[e] = l0 ? 0.f : w1g[e]; w1gb[e] = l0 ? w1g[e] : 0.f; w0ga[e] = l01 ? 0.f : w0g[e]; w0gb[e] = l01 ? w0g[e] : 0.f;
                                          w1va[e] = l0 ? 0.f : w1v[e]; w1vb[e] = l0 ? w1v[e] : 0.f; w0va[e] = l01 ? 0.f : w0v[e]; w0vb[e] = l01 ? w0v[e] : 0.f; }
#pragma unroll
            for (int ai = 0; ai < 2; ++ai) {
                const int rowg = u.pm * BM + ai * HALF + wr * 64, g = rowg >> 6;
#pragma unroll
                for (int m = 0; m < 4; ++m) {
                    const f32x4 cg = acc[ai][0][m][n], cv = acc[ai][1][m][n];
                    f32x4 o;
#pragma unroll
                    for (int e = 0; e < 4; ++e) {
                        float gt = fmaf(w2g[e], cg[e], bg[e]), vl = fmaf(w2v[e], cv[e], bv[e]);
                        gt = fmaf(dpp_ror1(cg[e]), w1ga[e], gt); gt = fmaf(dpp_ror2(cg[e]), w0ga[e], gt);
                        vl = fmaf(dpp_ror1(cv[e]), w1va[e], vl); vl = fmaf(dpp_ror2(cv[e]), w0va[e], vl);
                        if (m > 0) { const float pg = acc[ai][0][m - 1][n][e], pv = acc[ai][1][m - 1][n][e];
                            gt = fmaf(dpp_ror1(pg), w1gb[e], gt); gt = fmaf(dpp_ror2(pg), w0gb[e], gt);
                            vl = fmaf(dpp_ror1(pv), w1vb[e], vl); vl = fmaf(dpp_ror2(pv), w0vb[e], vl); }
                        o[e] = (gt * vl) * fast_rcp(1.0f + fast_exp2(gt)); }
                    const int row = rowg + m * 16 + fr;
                    if (!(m == 0 && fr < 2)) { u32x2 w; w.x = cvtpk(o[0], o[1]); w.y = cvtpk(o[2], o[3]); *(u32x2*)(ACT + (size_t)row * DFF + c0) = w; }
                    if (m == 0 && fr < 2) { float* hp = HB + ((size_t)((g * 4 + fr) * 22 + u.pn) * 256 + cl); *(f32x4*)hp = cg; *(f32x4*)(hp + 128) = cv; }
                    if (m == 3 && fr >= 14) { float* hp = HB + ((size_t)((g * 4 + fr - 12) * 22 + u.pn) * 256 + cl); *(f32x4*)hp = cg; *(f32x4*)(hp + 128) = cv; }
                }
            }
            asm volatile("" ::: "memory");
        }
    }
};
}
#define XB_TMO      128
#define XB_XCNT(j)  (256  + 64 * (j))
#define XB_XSUB(j)  (1280 + 64 * (j))
#define XB_XGEN(j)  (2304 + 64 * (j))
#define XB_TOP      3328
#define XB_TOPGEN   3392
#define XCD_BAR_WORDS 3456
#define XB_SPIN_CAP (1u << 22)
__device__ __forceinline__ unsigned xb_ld(unsigned* p)              { return __hip_atomic_load(p, __ATOMIC_RELAXED, __HIP_MEMORY_SCOPE_AGENT); }
__device__ __forceinline__ unsigned xb_add(unsigned* p, unsigned v) { return __hip_atomic_fetch_add(p, v, __ATOMIC_RELAXED, __HIP_MEMORY_SCOPE_AGENT); }
__device__ __forceinline__ unsigned xb_xcc_id() { return (unsigned)__builtin_amdgcn_s_getreg((3 << 11) | 20) & 0xFu; }
#define XB_SPIN(cond, bar) do { unsigned _sp = 0; while (cond) { __builtin_amdgcn_s_sleep(1); \
    if ((++_sp & 255u) == 0u) { if (xb_ld(&(bar)[XB_TMO])) break; if (_sp > XB_SPIN_CAP) { atomicAdd(&(bar)[XB_TMO], 1u); break; } } } } while (0)
struct XcdBarrier { unsigned* bar; unsigned x; volatile LAS unsigned* st; };
__device__ __forceinline__ XcdBarrier xcd_barrier_post(unsigned* bar, volatile LAS unsigned* st) {
    XcdBarrier b; b.bar = bar; b.x = xb_xcc_id(); b.st = st;
    if (threadIdx.x == 0) (void)xb_add(&bar[XB_XCNT(b.x)], 1u);
    return b;
}
__device__ __forceinline__ void xcd_barrier_complete(unsigned* bar, unsigned x, unsigned& nloc, unsigned& nx) {
    const unsigned G = gridDim.x * gridDim.y * gridDim.z;
    unsigned sum, cnt, mine, sp = 0u;
    for (;;) {
        sum = 0u; cnt = 0u; mine = 0u;
#pragma unroll
        for (unsigned j = 0; j < 16; ++j) { const unsigned c = xb_ld(&bar[XB_XCNT(j)]); sum += c; cnt += (c > 0u) ? 1u : 0u; mine = (j == x) ? c : mine; }
        if (sum == G) break;
        __builtin_amdgcn_s_sleep(1);
        if ((++sp & 255u) == 0u) { if (xb_ld(&bar[XB_TMO])) break; if (sp > XB_SPIN_CAP) { atomicAdd(&bar[XB_TMO], 1u); break; } }
    }
    nloc = mine > 0u ? mine : 1u; nx = cnt > 0u ? cnt : 1u;
}
__device__ __forceinline__ void xcd_barrier(const XcdBarrier& b, int wave_id) {
    asm volatile("s_waitcnt vmcnt(0)" ::: "memory");
    __syncthreads();
    if (wave_id == 0 && lane_now() == 0) {
        unsigned* bar = b.bar; unsigned bx = b.x;
        asm volatile("" : "+s"(bx));
        __builtin_amdgcn_s_waitcnt(0);
        unsigned nloc = b.st[0], nx = b.st[1];
        if (nloc == 0u) { xcd_barrier_complete(bar, bx, nloc, nx); b.st[0] = nloc; b.st[1] = nx; }
        const unsigned old = xb_add(&bar[XB_XSUB(bx)], 1u);
        const unsigned gen = old / nloc;
        if (old + 1u == (gen + 1u) * nloc) {
            __builtin_amdgcn_fence(__ATOMIC_RELEASE, "agent");
            asm volatile("s_waitcnt vmcnt(0)" ::: "memory");
            const unsigned og = xb_add(&bar[XB_TOP], 1u);
            const unsigned tg = og / nx;
            if (og + 1u == (tg + 1u) * nx) xb_add(&bar[XB_TOPGEN], 1u);
            else XB_SPIN(xb_ld(&bar[XB_TOPGEN]) == tg, bar);
            __builtin_amdgcn_fence(__ATOMIC_ACQUIRE, "agent");
            xb_add(&bar[XB_XGEN(bx)], 1u);
            asm volatile("s_waitcnt vmcnt(0)" ::: "memory");
        } else {
            XB_SPIN(xb_ld(&bar[XB_XGEN(bx)]) == gen, bar);
            __builtin_amdgcn_fence(__ATOMIC_ACQUIRE, "agent");
            asm volatile("s_waitcnt vmcnt(0)" ::: "memory");
        }
    }
    __syncthreads();
}

#define MFMA32(a, b, c) __builtin_amdgcn_mfma_f32_32x32x16_bf16(a, b, c, 0, 0, 0)
typedef short v4i16_t __attribute__((ext_vector_type(4)));
typedef LAS const char* lds_cptr;
typedef LAS char* lds_ptr;
__device__ __forceinline__ int crow(int r, int hi) { return (r & 3) + 8 * (r >> 2) + 4 * hi; }
__device__ __forceinline__ s16x4 vtr(lds_cptr p) { return __builtin_bit_cast(s16x4, __builtin_amdgcn_ds_read_tr16_b64_v4i16((LAS v4i16_t*)p)); }
__device__ __forceinline__ float other_half(float x, int hi) { auto rr = __builtin_amdgcn_permlane32_swap(__float_as_uint(x), __float_as_uint(x), false, false); return __uint_as_float(hi ? rr[0] : rr[1]); }
constexpr float NEG_INF = -INFINITY;

constexpr int TB_V = 12288, TB_KB = 20480, TB_SIZE = 20992;
struct Stg { u32x4 k, k2, v; float kb; };

template <int NKS> __device__ __forceinline__ void qk64(lds_cptr kbuf, const bf16x8* qf, int r32, int hi, f32x16& p0, f32x16& p1) {
    lds_cptr kp = kbuf + hi * 1024 + r32 * 16;
#pragma unroll
    for (int ks = 0; ks < NKS; ++ks) {
        const bf16x8 a0 = *(const LAS bf16x8*)(kp + ks * 2048), a1 = *(const LAS bf16x8*)(kp + ks * 2048 + 512);
        p0 = MFMA32(a0, qf[ks], p0); p1 = MFMA32(a1, qf[ks], p1);
    }
}
template <int NKS> __device__ __forceinline__ void qk64c(lds_cptr kbuf, const bf16x8* qf, int r32, int hi, const f32x16& c, f32x16& p0, f32x16& p1) {
    lds_cptr kp = kbuf + hi * 1024 + r32 * 16;
    { const bf16x8 a0 = *(const LAS bf16x8*)(kp), a1 = *(const LAS bf16x8*)(kp + 512); p0 = MFMA32(a0, qf[0], c); p1 = MFMA32(a1, qf[0], c); }
#pragma unroll
    for (int ks = 1; ks < NKS; ++ks) {
        const bf16x8 a0 = *(const LAS bf16x8*)(kp + ks * 2048), a1 = *(const LAS bf16x8*)(kp + ks * 2048 + 512);
        p0 = MFMA32(a0, qf[ks], p0); p1 = MFMA32(a1, qf[ks], p1);
    }
}
struct AState { f32x16 o0, o1; float m, l; };
__device__ __forceinline__ void astate_init(AState& s) {
#pragma unroll
    for (int r = 0; r < 16; ++r) { s.o0[r] = 0.f; s.o1[r] = 0.f; }
    s.m = NEG_INF; s.l = 0.f;
}
__device__ __forceinline__ void pv64(f32x16& o0, f32x16& o1, lds_cptr vp, const bf16x8 (&pf)[4]) {
#pragma unroll
    for (int ks = 0; ks < 4; ++ks) {
        const s16x4 l0 = vtr(vp + ks * 1024), h0 = vtr(vp + ks * 1024 + 512), l1 = vtr(vp + 4096 + ks * 1024), h1 = vtr(vp + 4096 + ks * 1024 + 512);
        const bf16x8 v0 = (bf16x8){l0[0], l0[1], l0[2], l0[3], h0[0], h0[1], h0[2], h0[3]}, v1 = (bf16x8){l1[0], l1[1], l1[2], l1[3], h1[0], h1[1], h1[2], h1[3]};
        o0 = MFMA32(v0, pf[ks], o0); o1 = MFMA32(v1, pf[ks], o1);
    }
}
struct VFrag { bf16x8 v0[4], v1[4]; };
__device__ __forceinline__ void v_load64(VFrag& f, lds_cptr vp) {
#pragma unroll
    for (int ks = 0; ks < 4; ++ks) {
        const s16x4 l0 = vtr(vp + ks * 1024), h0 = vtr(vp + ks * 1024 + 512), l1 = vtr(vp + 4096 + ks * 1024), h1 = vtr(vp + 4096 + ks * 1024 + 512);
        f.v0[ks] = (bf16x8){l0[0], l0[1], l0[2], l0[3], h0[0], h0[1], h0[2], h0[3]}; f.v1[ks] = (bf16x8){l1[0], l1[1], l1[2], l1[3], h1[0], h1[1], h1[2], h1[3]};
    }
}
__device__ __forceinline__ void pv64f(f32x16& o0, f32x16& o1, const VFrag& f, const bf16x8 (&pf)[4]) {
#pragma unroll
    for (int ks = 0; ks < 4; ++ks) { o0 = MFMA32(f.v0[ks], pf[ks], o0); o1 = MFMA32(f.v1[ks], pf[ks], o1); }
}
__device__ __forceinline__ void pack_p(const f32x16& p0, const f32x16& p1, bf16x8 (&pf)[4]) {
    u32x4 w0, w1, w2, w3;
    w0.x = cvtpk(p0[0], p0[1]); w0.y = cvtpk(p0[2], p0[3]); w0.z = cvtpk(p0[4], p0[5]); w0.w = cvtpk(p0[6], p0[7]);
    w1.x = cvtpk(p0[8], p0[9]); w1.y = cvtpk(p0[10], p0[11]); w1.z = cvtpk(p0[12], p0[13]); w1.w = cvtpk(p0[14], p0[15]);
    w2.x = cvtpk(p1[0], p1[1]); w2.y = cvtpk(p1[2], p1[3]); w2.z = cvtpk(p1[4], p1[5]); w2.w = cvtpk(p1[6], p1[7]);
    w3.x = cvtpk(p1[8], p1[9]); w3.y = cvtpk(p1[10], p1[11]); w3.z = cvtpk(p1[12], p1[13]); w3.w = cvtpk(p1[14], p1[15]);
    pf[0] = __builtin_bit_cast(bf16x8, w0); pf[1] = __builtin_bit_cast(bf16x8, w1); pf[2] = __builtin_bit_cast(bf16x8, w2); pf[3] = __builtin_bit_cast(bf16x8, w3);
}
template <bool HOIST = true> __device__ __forceinline__ void softmax_pv64(f32x16& p0, f32x16& p1, AState& s, lds_cptr vp, int hi) {
    VFrag vf; if (HOIST) { v_load64(vf, vp); __builtin_amdgcn_sched_barrier(0); }
    float mx = fmaxf(p0[0], p1[0]);
#pragma unroll
    for (int r = 1; r < 16; ++r) mx = fmaxf(mx, fmaxf(p0[r], p1[r]));
    mx = fmaxf(mx, other_half(mx, hi));
    const float mn = fmaxf(s.m, mx), ms = (mn == NEG_INF) ? 0.f : mn;
    const float alpha = fast_exp2(s.m - ms);
    float rs = 0.f;
#pragma unroll
    for (int r = 0; r < 16; ++r) { p0[r] = fast_exp2(p0[r] - ms); p1[r] = fast_exp2(p1[r] - ms); rs += p0[r] + p1[r]; }
    rs += other_half(rs, hi);
    s.l = s.l * alpha + rs; s.m = mn;
#pragma unroll
    for (int r = 0; r < 16; ++r) { s.o0[r] *= alpha; s.o1[r] *= alpha; }
    bf16x8 pf[4]; pack_p(p0, p1, pf);
    if (HOIST) pv64f(s.o0, s.o1, vf, pf); else pv64(s.o0, s.o1, vp, pf);
}
__device__ __forceinline__ void softmax_fixed_pv64(f32x16& p0, f32x16& p1, AState& s, lds_cptr vp) {
    VFrag vf; v_load64(vf, vp); __builtin_amdgcn_sched_barrier(0);
    float rs = 0.f;
#pragma unroll
    for (int r = 0; r < 16; ++r) { p0[r] = fast_exp2(p0[r]); p1[r] = fast_exp2(p1[r]); rs += p0[r] + p1[r]; }
    s.l += rs;
    bf16x8 pf[4]; pack_p(p0, p1, pf);
    pv64f(s.o0, s.o1, vf, pf);
}
template <bool HOIST> __device__ __forceinline__ void softmax_shift_pv64(f32x16& p0, f32x16& p1, AState& s, lds_cptr vp, float bnd) {
    VFrag vf; if (HOIST) { v_load64(vf, vp); __builtin_amdgcn_sched_barrier(0); }
    float rs = 0.f;
#pragma unroll
    for (int r = 0; r < 16; ++r) { p0[r] = fast_exp2(p0[r] - bnd); p1[r] = fast_exp2(p1[r] - bnd); rs += p0[r] + p1[r]; }
    s.l += rs;
    bf16x8 pf[4]; pack_p(p0, p1, pf);
    if (HOIST) pv64f(s.o0, s.o1, vf, pf); else pv64(s.o0, s.o1, vp, pf);
}
template <bool MASK> __device__ __forceinline__ void softmax_raw_pv64(f32x16& p0, f32x16& p1, AState& s, lds_cptr vp, bool keep) {
    float rs = 0.f;
#pragma unroll
    for (int r = 0; r < 16; ++r) { p0[r] = fast_exp2(p0[r]); p1[r] = fast_exp2(p1[r]); rs += p0[r] + p1[r]; }
    bf16x8 pf[4]; pack_p(p0, p1, pf);
    if (MASK) { const unsigned km = keep ? 0xffffffffu : 0u; rs = keep ? rs : 0.f;
#pragma unroll
        for (int k = 0; k < 4; ++k) { u32x4 w = __builtin_bit_cast(u32x4, pf[k]); w.x &= km; w.y &= km; w.z &= km; w.w &= km; pf[k] = __builtin_bit_cast(bf16x8, w); } }
    s.l += rs;
    pv64(s.o0, s.o1, vp, pf);
}
__device__ __forceinline__ void mask_causal(f32x16& p0, f32x16& p1, int kpos0, int tq, int hi) {
#pragma unroll
    for (int r = 0; r < 16; ++r) { const int kp = kpos0 + crow(r, hi); if (kp > tq) p0[r] = NEG_INF; if (kp + 32 > tq) p1[r] = NEG_INF; }
}
__device__ __forceinline__ void add_table(f32x16& p0, f32x16& p1, const LAS float* tb) {
#pragma unroll
    for (int r = 0; r < 16; ++r) { const int o = (r & 3) + 8 * (r >> 2); p0[r] += tb[o]; p1[r] += tb[o + 32]; }
}
__device__ __forceinline__ void store_o_bf16(bf16_t* orow, const f32x16& o0, const f32x16& o1, float sc, int hi) {
#pragma unroll
    for (int g = 0; g < 4; ++g) {
        u32x2 w0, w1; w0.x = cvtpk(o0[4 * g] * sc, o0[4 * g + 1] * sc); w0.y = cvtpk(o0[4 * g + 2] * sc, o0[4 * g + 3] * sc);
        w1.x = cvtpk(o1[4 * g] * sc, o1[4 * g + 1] * sc); w1.y = cvtpk(o1[4 * g + 2] * sc, o1[4 * g + 3] * sc);
        *(u32x2*)(orow + 8 * g + 4 * hi) = w0; *(u32x2*)(orow + 32 + 8 * g + 4 * hi) = w1;
    }
}
constexpr int OST_OFF = 90112, OST_PITCH = 144, OST_WAVE = 32 * OST_PITCH;
template <class RowPtr> __device__ __forceinline__ void store_o_staged(lds_ptr lds, int wid, int lane, const f32x16& o0, const f32x16& o1, float sc, const RowPtr& rowp) {
    const int r32 = lane & 31, hi = lane >> 5;
    lds_ptr stg = lds + OST_OFF + wid * OST_WAVE;
#pragma unroll
    for (int g = 0; g < 4; ++g) {
        u32x2 w0, w1; w0.x = cvtpk(o0[4 * g] * sc, o0[4 * g + 1] * sc); w0.y = cvtpk(o0[4 * g + 2] * sc, o0[4 * g + 3] * sc);
        w1.x = cvtpk(o1[4 * g] * sc, o1[4 * g + 1] * sc); w1.y = cvtpk(o1[4 * g + 2] * sc, o1[4 * g + 3] * sc);
        *(LAS u32x2*)(stg + r32 * OST_PITCH + (8 * g + 4 * hi) * 2) = w0; *(LAS u32x2*)(stg + r32 * OST_PITCH + 64 + (8 * g + 4 * hi) * 2) = w1;
    }
    asm volatile("" ::: "memory");
#pragma unroll
    for (int i = 0; i < 4; ++i) { const int row = i * 8 + (lane >> 3), ch = lane & 7;
        const u32x4 v = *(const LAS u32x4*)(stg + row * OST_PITCH + ch * 16);
        *(u32x4*)(rowp(row) + ch * 8) = v; }
    asm volatile("" ::: "memory");
}
constexpr size_t MiB = 1u << 20, KiB = 1u << 10;
constexpr size_t WS_CTL = 0, CTL_ZERO_BYTES = 1 * MiB;
constexpr size_t WS_ROPE = 1 * MiB, WS_NSATAB = WS_ROPE + 512 * KiB, WS_DILTAB = WS_NSATAB + 32 * KiB, WS_CMPB = WS_DILTAB + 8 * KiB, WS_FARB = WS_CMPB + 4 * KiB;
constexpr size_t WS_WT = 4 * MiB, LW = 38 * MiB;
constexpr size_t LW_IN = 0, LW_G = 6 * MiB, LW_BR = 14 * MiB, LW_O = 16 * MiB, LW_UP = 18 * MiB, LW_DN = 29 * MiB, LW_UQ = 35 * MiB, LW_UKV = 35 * MiB + 256 * KiB, LW_PHI = 36 * MiB;
constexpr size_t BR_A = 0, BR_B = 512 * KiB, BR_C = 768 * KiB, BR_D = 1280 * KiB;
constexpr size_t WS_SIDE = 80 * MiB, WS_SSQQ = 84 * MiB, WS_SSQKV = 85 * MiB, WS_KB = 86 * MiB, WS_KROT = 87 * MiB, WS_KCMP = 91 * MiB, WS_VCMP = 100 * MiB,
                 WS_HID = 109 * MiB, WS_KMAX = 3 * MiB + 128 * KiB  , WS_LF = 2 * MiB  , WS_CMPP = 3 * MiB  , WS_ORDER = 3 * MiB + 64 * KiB  , WS_KC = 113 * MiB, WS_VC = 113 * MiB + 512 * KiB, WS_DLSE = 114 * MiB, WS_DOG = 116 * MiB;
constexpr size_t WS_H = 164 * MiB, WS_OCAT = 292 * MiB, WS_QM = 404 * MiB, WS_KVM = 468 * MiB, WS_P = 532 * MiB;
constexpr size_t WS_MERGED = 532 * MiB, WS_MSCR = 660 * MiB, WS_Y = 164 * MiB  , WS_H2 = 756 * MiB, WS_ACT = 164 * MiB  , WS_HB = 532 * MiB  , WS_Y2 = 884 * MiB  , WS_X3 = 620 * MiB  , WS_END = 1024 * MiB;
constexpr size_t MSCR_PER_WG = 512 * KiB;
constexpr size_t WS_CWS = 3 * MiB + 256 * KiB;
constexpr size_t H8_OFF = 128 * MiB;
static_assert(WS_WT + 2 * LW <= WS_SIDE && WS_DOG + 48 * MiB <= WS_H && WS_P + 384 * MiB <= WS_END && WS_MSCR + 256 * MSCR_PER_WG <= WS_P + 384 * MiB && WS_H2 + 128 * MiB <= WS_Y2 && WS_Y2 + 128 * MiB <= WS_END, "ws map");
static_assert(WS_ACT + 352 * MiB <= WS_HB && WS_HB + 88 * MiB <= WS_X3 && WS_X3 + 128 * MiB <= WS_H2 && WS_Y + 128 * MiB <= WS_OCAT, "ws overlays");
constexpr int CW_BAR = 4096;
constexpr int CW_KMAX = 24576;
constexpr int CW_KMLA = 24832;
constexpr int CW_KROT = 25344;
constexpr int CW_KCMX = 25856;
constexpr int CW_QNSA = 25792;
constexpr int CW_KNSA = 25664;
constexpr int CW_Q = 16384;

constexpr int RING_BYTES = 131072, LDSCTL_OFF = RING_BYTES, MISC_OFF = LDSCTL_OFF + 320, LDS_BYTES = 147456;
constexpr int NSA_SLAB = 49152, NSA_SLAB_BYTES = 4 * 64 * 65 * 4, NSA_SEL = NSA_SLAB + NSA_SLAB_BYTES;
static_assert(NSA_SEL + 512 <= RING_BYTES && 4 * NSA_TL * 4 <= NSA_SLAB_BYTES && 2 * TB_SIZE <= NSA_SLAB, "NSA LDS map");

struct Frame {
    LAS unsigned char* lds; volatile LAS unsigned* MISC; gu32* ctl;
    int tid, lane, wave, G;
    const float* in[27]; float* out; unsigned char* ws;
};
#define WSP(T, off) ((T*)(F.ws + (off)))
#define VM_WAIT() asm volatile("s_waitcnt vmcnt(0)" ::: "memory")
#define LDS_WAIT() asm volatile("s_waitcnt lgkmcnt(0)" ::: "memory")

__device__ __forceinline__ int queue_grab(Frame& F, gu32* ctr) {
    if (F.tid == 0) F.MISC[0] = __hip_atomic_fetch_add(ctr, 1u, __ATOMIC_RELAXED, __HIP_MEMORY_SCOPE_AGENT);
    __syncthreads();
    const int v = (int)F.MISC[0];
    __syncthreads();
    return v;
}

template <bool FOX> __device__ __forceinline__ void causal_unit(Frame& F, int b, int h, int qb, float kmax_in) {
    constexpr int NKS = FOX ? 4 : 6;
    int lane_o = lane_now();
    const int wid = F.wave, lane = lane_o, r32 = lane & 31, hi = lane >> 5;
    const size_t rowbase = (size_t)b * SEQ;
    const int q0 = qb * 256, tq = q0 + wid * 32 + r32, NT = qb * 4 + 4;
    const bf16_t* P = WSP(const bf16_t, WS_P);
    const bf16_t *Kb, *Vb, *Qrow; int kpitch, vpitch;
    const bf16_t* Kr = WSP(const bf16_t, WS_KROT) + rowbase * 32;
    const float* kbsrc = WSP(const float, WS_KB) + (size_t)(b * 4 + h) * SEQ;
    if (FOX) { Kb = P + rowbase * PW + PC_CK + h * 64; Vb = P + rowbase * PW + PC_CV + h * 64; kpitch = PW; vpitch = PW; Qrow = P + (rowbase + tq) * PW + PC_CQ + h * 64; }
    else { const bf16_t* KV = WSP(const bf16_t, WS_KVM) + rowbase * 512 + h * 128; Kb = KV; Vb = KV + 64; kpitch = 512; vpitch = 512; Qrow = WSP(const bf16_t, WS_QM) + (rowbase + tq) * 512 + h * 96; }
    bf16x8 qf[NKS];
#pragma unroll
    for (int ks = 0; ks < NKS; ++ks) qf[ks] = *(const bf16x8*)(Qrow + ks * 16 + hi * 8);
    AState st; astate_init(st);
    lds_ptr lds = (lds_ptr)F.lds;
    const int vpo = ((lane >> 4) & 1) * 32 + (lane & 3) * 8 + (4 * hi + ((lane & 15) >> 2)) * 64;
    Stg sA, sB;
#define CU_LOAD(S, t) do { S.k = *(const u32x4*)(Kb + (size_t)((t) * 64 + lane) * kpitch + wid * 8); \
        if (!FOX) { if (wid < 4) S.k2 = *(const u32x4*)(Kr + (size_t)((t) * 64 + lane) * 32 + wid * 8); } \
        S.v = *(const u32x4*)(Vb + (size_t)((t) * 64 + 16 * (wid & 3) + (lane >> 2)) * vpitch + (wid >> 2) * 32 + (lane & 3) * 8); \
        if (FOX) { if (wid == 0) S.kb = kbsrc[(t) * 64 + lane]; else if (wid == 1) S.kb = kbsrc[(t) > 0 ? (t) * 64 - 1 : 0]; } } while (0)
#define CU_WRITE(S, bofs) do { lds_ptr bp = lds + (bofs); *(LAS u32x4*)(bp + wid * 1024 + lane * 16) = S.k; \
        if (!FOX) { if (wid < 4) *(LAS u32x4*)(bp + (8 + wid) * 1024 + lane * 16) = S.k2; } \
        *(LAS u32x4*)(bp + TB_V + wid * 1024 + lane * 16) = S.v; \
        if (FOX) { if (wid == 0) *(LAS float*)(bp + TB_KB + lane * 4) = S.kb; else if (wid == 1 && lane == 0) *(LAS float*)(bp + TB_KB + 256) = S.kb; } } while (0)
    const int tq_lo = q0 + wid * 32;
    float qn = 0.f; const float kmax = kmax_in;
#pragma unroll
    for (int ks = 0; ks < NKS; ++ks)
#pragma unroll
        for (int e = 0; e < 8; ++e) { const float x = bf2f((unsigned short)qf[ks][e]); qn += x * x; }
    qn += other_half(qn, hi); qn = sqrtf(qn);
    const float bnd = qn * kmax * 1.002f + 0.05f;
    const bool fast = __all(bnd <= 50.0f);
    const float kbi = FOX ? kbsrc[tq] : 0.f;
    f32x16 cinit;
    { const float c0 = -(bnd + kbi);
#pragma unroll
      for (int r = 0; r < 16; ++r) cinit[r] = c0; }
    LAS volatile unsigned* dflag = (LAS volatile unsigned*)(lds + 4 * TB_SIZE + 64);
#define CU_TILE(T, BOFS) { const int t = (T); lds_cptr bp = (lds_cptr)(lds + (BOFS)); \
        if (64 * t <= tq_lo + 31) {                                \
            f32x16 p0, p1; \
            if (fast) qk64c<NKS>(bp, qf, r32, hi, cinit, p0, p1); \
            else { _Pragma("unroll") for (int r = 0; r < 16; ++r) { p0[r] = 0.f; p1[r] = 0.f; } qk64<NKS>(bp, qf, r32, hi, p0, p1); } \
            if (FOX) { const LAS float* kbt = (const LAS float*)(bp + TB_KB) + 4 * hi; \
                _Pragma("unroll") for (int g = 0; g < 4; ++g) { const f32x4 a = *(const LAS f32x4*)(kbt + 8 * g), c = *(const LAS f32x4*)(kbt + 32 + 8 * g); \
                    _Pragma("unroll") for (int e = 0; e < 4; ++e) { p0[4 * g + e] += a[e]; p1[4 * g + e] += c[e]; } } } \
            if (64 * t + 63 > tq_lo) mask_causal(p0, p1, 64 * t, tq, hi); \
            if (fast) softmax_fixed_pv64(p0, p1, st, bp + TB_V + vpo); else softmax_pv64(p0, p1, st, bp + TB_V + vpo, hi); \
        } }
    const int NP = NT >> 1;
#define CU_TA(p) (FOX ? NT - 1 - 2 * (p) : 2 * (p))
#define CU_TB(p) (FOX ? NT - 2 - 2 * (p) : 2 * (p) + 1)
    CU_LOAD(sA, CU_TA(0)); CU_LOAD(sB, CU_TB(0)); CU_WRITE(sA, 0); CU_WRITE(sB, TB_SIZE);
    __syncthreads();
    for (int p = 0; p < NP; ++p) {
        const int pofs = (p & 1) * 2 * TB_SIZE, nofs = ((p & 1) ^ 1) * 2 * TB_SIZE;
        if (p + 1 < NP) { CU_LOAD(sA, CU_TA(p + 1)); CU_LOAD(sB, CU_TB(p + 1)); }
        { const int ta_ = CU_TA(p), tbb_ = CU_TB(p), tmax_ = ta_ > tbb_ ? ta_ : tbb_;
          if (fast && 64 * tmax_ + 63 <= tq_lo) {
              lds_cptr bpa = (lds_cptr)(lds + pofs), bpb = (lds_cptr)(lds + pofs + TB_SIZE);
              f32x16 a0, a1, b0, b1;
              qk64c<NKS>(bpa, qf, r32, hi, cinit, a0, a1);
              qk64c<NKS>(bpb, qf, r32, hi, cinit, b0, b1);
              if (FOX) { const LAS float* ka = (const LAS float*)(bpa + TB_KB) + 4 * hi; const LAS float* kb2 = (const LAS float*)(bpb + TB_KB) + 4 * hi;
#pragma unroll
                  for (int g = 0; g < 4; ++g) { const f32x4 x = *(const LAS f32x4*)(ka + 8 * g), y = *(const LAS f32x4*)(ka + 32 + 8 * g), z = *(const LAS f32x4*)(kb2 + 8 * g), w = *(const LAS f32x4*)(kb2 + 32 + 8 * g);
#pragma unroll
                      for (int e = 0; e < 4; ++e) { a0[4 * g + e] += x[e]; a1[4 * g + e] += y[e]; b0[4 * g + e] += z[e]; b1[4 * g + e] += w[e]; } } }
              VFrag va; v_load64(va, bpa + TB_V + vpo);
              float rs = 0.f;
#pragma unroll
              for (int r = 0; r < 16; ++r) { a0[r] = fast_exp2(a0[r]); a1[r] = fast_exp2(a1[r]); rs += a0[r] + a1[r]; }
              bf16x8 pfa[4]; pack_p(a0, a1, pfa);
              pv64f(st.o0, st.o1, va, pfa);
              VFrag vb; v_load64(vb, bpb + TB_V + vpo);
#pragma unroll
              for (int r = 0; r < 16; ++r) { b0[r] = fast_exp2(b0[r]); b1[r] = fast_exp2(b1[r]); rs += b0[r] + b1[r]; }
              st.l += rs;
              bf16x8 pfb[4]; pack_p(b0, b1, pfb);
              pv64f(st.o0, st.o1, vb, pfb);
          } else {
              CU_TILE(ta_, pofs)
              CU_TILE(tbb_, pofs + TB_SIZE)
          } }
        const int tb_ = CU_TB(p);
        if (FOX) { if (tb_ > 0) { const float kb_last = *(const LAS float*)(lds + pofs + TB_SIZE + TB_KB + 256); const bool done = fast ? ((kb_last - kbi) < -150.0f) : ((qn * kmax + kb_last - st.m) < -130.0f); const unsigned alld = __all(done) ? 1u : 0u; if (lane == 0) dflag[(p & 1) * 8 + wid] = alld; } }
        if (p + 1 < NP) { CU_WRITE(sA, nofs); CU_WRITE(sB, nofs + TB_SIZE); }
        __syncthreads();
        if (FOX) { if (tb_ > 0) { unsigned all = 1u;
#pragma unroll
                for (int w = 0; w < 8; ++w) all &= dflag[(p & 1) * 8 + w];
                if (all) break; } }
    }
#undef CU_TA
#undef CU_TB
#undef CU_TILE
#undef CU_LOAD
#undef CU_WRITE
    bf16_t* obase = WSP(bf16_t, WS_OCAT) + (rowbase + tq_lo) * OCW + (FOX ? 384 : 640) + h * 64;
    const float ltot = fast ? st.l + other_half(st.l, hi) : st.l;
    store_o_staged(lds, wid, lane, st.o0, st.o1, 1.0f / ltot, [&](int r) { return obase + (size_t)r * OCW; });
}
template <bool FAST> __device__ __forceinline__ void nsa_unit(Frame& F, int b, int qblk, int l) {
    int lane_o = lane_now();
    const int wid = F.wave, lane = lane_o, r32 = lane & 31, hi = lane >> 5, tid = wid * 64 + lane;
    const int h = wid & 3, qs = wid >> 2;
    const int q0 = qblk * 64, cur = qblk, tq = q0 + 32 * qs + r32, tq_lo = q0 + 32 * qs;
    const size_t rowbase = (size_t)b * SEQ, row = rowbase + tq;
    const bf16_t* P = WSP(const bf16_t, WS_P);
    lds_ptr lds = (lds_ptr)F.lds;
    const int vpo = ((lane >> 4) & 1) * 32 + (lane & 3) * 8 + (4 * hi + ((lane & 15) >> 2)) * 64;
    bf16x8 qf[4];
    { const bf16_t* Qrow = P + row * PW + PC_AQ + h * 64;
#pragma unroll
      for (int ks = 0; ks < 4; ++ks) qf[ks] = *(const bf16x8*)(Qrow + ks * 16 + hi * 8); }
    Stg s; int ln;
#define NS_LOAD(Kb, kp, Vb, vp_, t) do { s.k = *(const u32x4*)((Kb) + (size_t)((t) * 64 + ln) * (kp) + wid * 8); \
        s.v = *(const u32x4*)((Vb) + (size_t)((t) * 64 + 16 * (wid & 3) + (ln >> 2)) * (vp_) + (wid >> 2) * 32 + (ln & 3) * 8); } while (0)
#define NS_FRESH() do { ln = lane; asm volatile("" : "+v"(ln)); } while (0)
#define NS_WRITE(bi) do { lds_ptr bp_ = lds + (bi) * TB_SIZE; *(LAS u32x4*)(bp_ + wid * 1024 + lane * 16) = s.k; *(LAS u32x4*)(bp_ + TB_V + wid * 1024 + lane * 16) = s.v; } while (0)
    const bf16_t* KC = WSP(const bf16_t, WS_KC) + (size_t)b * 256 * 64; const bf16_t* VC = WSP(const bf16_t, WS_VC) + (size_t)b * 256 * 64;
    const int cmax_u = (q0 + 63 - 31) >> 4, NTc = (cmax_u >> 6) + 1;
    const int cmax = (tq - 31) >> 4;
    float cm = NEG_INF, cl = 0.f;
    if constexpr (!FAST) {
    NS_FRESH(); NS_LOAD(KC, 64, VC, 64, 0); NS_WRITE(0);
    __syncthreads();
    for (int t = 0; t < NTc; ++t) {
        const int bi = t & 1;
        if (t + 1 < NTc) NS_LOAD(KC, 64, VC, 64, t + 1);
        { lds_cptr bp = (lds_cptr)(lds + bi * TB_SIZE); f32x16 p0, p1;
#pragma unroll
          for (int r = 0; r < 16; ++r) { p0[r] = 0.f; p1[r] = 0.f; }
          qk64<4>(bp, qf, r32, hi, p0, p1);
          float mx = NEG_INF;
#pragma unroll
          for (int r = 0; r < 16; ++r) { const int c = 64 * t + crow(r, hi); if (c > cmax) p0[r] = NEG_INF; if (c + 32 > cmax) p1[r] = NEG_INF; mx = fmaxf(mx, fmaxf(p0[r], p1[r])); }
          mx = fmaxf(mx, other_half(mx, hi));
          const float mn = fmaxf(cm, mx), ms = (mn == NEG_INF) ? 0.f : mn; float rs = 0.f;
#pragma unroll
          for (int r = 0; r < 16; ++r) rs += fast_exp2(p0[r] - ms) + fast_exp2(p1[r] - ms);
          rs += other_half(rs, hi);
          cl = cl * fast_exp2(cm - ms) + rs; cm = mn; }
        if (t + 1 < NTc) NS_WRITE(bi ^ 1);
        __syncthreads();
    }
    }
    const float cms = (cm == NEG_INF) ? 0.f : cm; float cinv = FAST ? 1.0f : 1.0f / fmaxf(cl, 1e-30f);
    f32x16 oc0, oc1;
#pragma unroll
    for (int r = 0; r < 16; ++r) { oc0[r] = 0.f; oc1[r] = 0.f; }
    float G[32]; float carry = 0.f;
#pragma unroll
    for (int i = 0; i < 32; ++i) G[i] = 0.f;
    NS_FRESH(); NS_LOAD(KC, 64, VC, 64, 0); NS_WRITE(0);
    __syncthreads();
#pragma unroll
    for (int t = 0; t < 4; ++t) {
        if (t < NTc) {
            const int bi = t & 1;
            if (t + 1 < NTc) NS_LOAD(KC, 64, VC, 64, t + 1);
            { lds_cptr bp = (lds_cptr)(lds + bi * TB_SIZE); f32x16 p0, p1;
#pragma unroll
              for (int r = 0; r < 16; ++r) { p0[r] = 0.f; p1[r] = 0.f; }
              qk64<4>(bp, qf, r32, hi, p0, p1);
#pragma unroll
              for (int r = 0; r < 16; ++r) { const int c = 64 * t + crow(r, hi);
                  if constexpr (FAST) { p0[r] = (c > cmax) ? 0.f : fast_exp2(p0[r]); p1[r] = (c + 32 > cmax) ? 0.f : fast_exp2(p1[r]); cl += p0[r] + p1[r]; }
                  else { p0[r] = (c > cmax) ? 0.f : fast_exp2(p0[r] - cms) * cinv; p1[r] = (c + 32 > cmax) ? 0.f : fast_exp2(p1[r] - cms) * cinv; } }
#pragma unroll
              for (int g = 0; g < 4; ++g) { const float oth = other_half(p0[4 * g + 3], hi);
                  G[t * 8 + g] = ((p0[4 * g] + p0[4 * g + 1]) + (p0[4 * g + 2] + p0[4 * g + 3])) + (hi ? oth : carry); carry = oth; }
#pragma unroll
              for (int g = 0; g < 4; ++g) { const float oth = other_half(p1[4 * g + 3], hi);
                  G[t * 8 + 4 + g] = ((p1[4 * g] + p1[4 * g + 1]) + (p1[4 * g + 2] + p1[4 * g + 3])) + (hi ? oth : carry); carry = oth; }
              bf16x8 pf[4]; pack_p(p0, p1, pf);
              pv64(oc0, oc1, bp + TB_V + vpo, pf); }
            if (t + 1 < NTc) NS_WRITE(bi ^ 1);
            __syncthreads();
        }
    }
    if constexpr (FAST) {
        cl += other_half(cl, hi); cinv = 1.0f / fmaxf(cl, 1e-30f);
#pragma unroll
        for (int i = 0; i < 32; ++i) G[i] *= cinv;
#pragma unroll
        for (int r = 0; r < 16; ++r) { oc0[r] *= cinv; oc1[r] *= cinv; } }
    { LAS float* slab = (LAS float*)(lds + NSA_SLAB) + (size_t)(h * 64 + 32 * qs + r32) * 65;
#pragma unroll
      for (int i = 0; i < 32; ++i) slab[2 * i + hi] = G[i]; }
    __syncthreads();
    u32x4 tbr[4]; { const u32x4* src = WSP(const u32x4, WS_NSATAB);
#pragma unroll
      for (int i = 0; i < 4; ++i) { const int idx = tid + 512 * i; tbr[i] = (idx < 4 * NSA_TL / 4) ? src[idx] : (u32x4){0u, 0u, 0u, 0u}; } }
    { const int q = tid >> 3, jg = tid & 7;
      LAS float* s0 = (LAS float*)(lds + NSA_SLAB) + (size_t)q * 65;
      float xs[8];
#pragma unroll
      for (int e = 0; e < 8; ++e) { const int j = 8 * jg + e; xs[e] = (s0[j] + s0[64 * 65 + j]) + (s0[2 * 64 * 65 + j] + s0[3 * 64 * 65 + j]); }
#pragma unroll
      for (int e = 0; e < 8; ++e) s0[8 * jg + e] = xs[e];
      asm volatile("s_waitcnt lgkmcnt(0)" ::: "memory");
      float v[64];
#pragma unroll
      for (int k = 0; k < 64; ++k) { const float x = s0[k];
          v[k] = (k == 0 || k == cur || k == cur - 1) ? 1e9f : ((k > cur) ? -1e9f : x); if ((k & 7) == 7) asm volatile("" ::: "memory"); }
      unsigned bits = 0u;
#pragma unroll
      for (int e = 0; e < 8; ++e) { const int j = 8 * jg + e;
          const float xj = xs[e];
          const float vj = (j == 0 || j == cur || j == cur - 1) ? 1e9f : ((j > cur) ? -1e9f : xj);
          int rank = 0;
#pragma unroll
          for (int k = 0; k < 64; ++k) rank += (v[k] > vj || (v[k] == vj && k < j)) ? 1 : 0;
          bits |= (rank < 16 ? 1u : 0u) << e; }
      *((LAS unsigned char*)(lds + NSA_SEL) + q * 8 + jg) = (unsigned char)bits; }
    __syncthreads();
    const unsigned mlo = *(const LAS unsigned*)(lds + NSA_SEL + (32 * qs + r32) * 8), mhi = *(const LAS unsigned*)(lds + NSA_SEL + (32 * qs + r32) * 8 + 4);
    { LAS u32x4* dst = (LAS u32x4*)(lds + NSA_SLAB);
#pragma unroll
      for (int i = 0; i < 4; ++i) { const int idx = tid + 512 * i; if (idx < 4 * NSA_TL / 4) dst[idx] = tbr[i]; } }
    const LAS float* tabh = (const LAS float*)(lds + NSA_SLAB) + h * NSA_TL;
    AState st; astate_init(st);
    { const bf16_t* Kb = P + rowbase * PW + PC_KSLC; const bf16_t* Vb = P + rowbase * PW + PC_VSLC;
      NS_FRESH(); NS_LOAD(Kb, PW, Vb, PW, 0); NS_WRITE(0);
      __syncthreads();
      for (int j = 0; j <= cur; ++j) {
          const int bi = j & 1;
          if (j < cur) NS_LOAD(Kb, PW, Vb, PW, j + 1);
          const bool mine = ((j < 32) ? (mlo >> j) : (mhi >> (j - 32))) & 1u;
          if (__any(mine)) {
              lds_cptr bp = (lds_cptr)(lds + bi * TB_SIZE); f32x16 p0, p1;
#pragma unroll
              for (int r = 0; r < 16; ++r) { p0[r] = 0.f; p1[r] = 0.f; }
              qk64<4>(bp, qf, r32, hi, p0, p1);
              const bool farj = (q0 - 64 * j - 63 >= NSA_DFAR);
              if constexpr (FAST) {
                  if (!farj) add_table(p0, p1, tabh + (NSA_DMAX - tq + 64 * j + 4 * hi));
                  if (j == cur) mask_causal(p0, p1, 64 * j, tq, hi);
                  softmax_raw_pv64<true>(p0, p1, st, bp + TB_V + vpo, mine);
              } else {
                  if (!farj) add_table(p0, p1, tabh + (NSA_DMAX - tq + 64 * j + 4 * hi));
                  if (j == cur) mask_causal(p0, p1, 64 * j, tq, hi);
                  if (!mine) {
#pragma unroll
                      for (int r = 0; r < 16; ++r) { p0[r] = NEG_INF; p1[r] = NEG_INF; } }
                  softmax_pv64<false>(p0, p1, st, bp + TB_V + vpo, hi);
              }
          }
          if (j < cur) NS_WRITE(bi ^ 1);
          __syncthreads();
      } }
    f32x16 oa0, oa1;
    { int rw_ = (int)row; asm volatile("" : "+v"(rw_)); const float* sd = WSP(const float, WS_SIDE) + (size_t)rw_ * 16 + h * 3;
      const float g0 = sigmoid_f(sd[0]), sc = sigmoid_f(sd[1]) / (FAST ? st.l + other_half(st.l, hi) : st.l);
#pragma unroll
      for (int r = 0; r < 16; ++r) { oa0[r] = g0 * oc0[r] + sc * st.o0[r]; oa1[r] = g0 * oc1[r] + sc * st.o1[r]; } }
    astate_init(st);
    { const bf16_t* Kb = P + rowbase * PW + PC_KWIN; const bf16_t* Vb = P + rowbase * PW + PC_VWIN;
      const int jlo = cur >= 8 ? cur - 8 : 0;
      NS_FRESH(); NS_LOAD(Kb, PW, Vb, PW, jlo); NS_WRITE(0);
      __syncthreads();
      for (int j = jlo; j <= cur; ++j) {
          const int bi = (j - jlo) & 1;
          if (j < cur) NS_LOAD(Kb, PW, Vb, PW, j + 1);
          if (tq_lo - 64 * j - 63 < 512) {
              lds_cptr bp = (lds_cptr)(lds + bi * TB_SIZE); f32x16 p0, p1;
#pragma unroll
              for (int r = 0; r < 16; ++r) { p0[r] = 0.f; p1[r] = 0.f; }
              qk64<4>(bp, qf, r32, hi, p0, p1);
              add_table(p0, p1, tabh + (NSA_DMAX - tq + 64 * j + 4 * hi));
              if (!(tq_lo - 64 * j - 63 >= 0 && tq_lo + 31 - 64 * j < 512)) {
                  const int d0 = tq - 64 * j - 4 * hi;
#pragma unroll
                  for (int r = 0; r < 16; ++r) { const int d = d0 - ((r & 3) + 8 * (r >> 2)); if (d < 0 || d >= 512) p0[r] = NEG_INF; if (d - 32 < 0 || d - 32 >= 512) p1[r] = NEG_INF; }
              }
              if constexpr (FAST) softmax_raw_pv64<false>(p0, p1, st, bp + TB_V + vpo, true); else softmax_pv64<false>(p0, p1, st, bp + TB_V + vpo, hi);
          }
          if (j < cur) NS_WRITE(bi ^ 1);
          __syncthreads();
      } }
    { int rw_ = (int)row; asm volatile("" : "+v"(rw_)); const float sc = sigmoid_f(WSP(const float, WS_SIDE)[(size_t)rw_ * 16 + h * 3 + 2]) / (FAST ? st.l + other_half(st.l, hi) : st.l);
#pragma unroll
      for (int r = 0; r < 16; ++r) { oa0[r] += sc * st.o0[r]; oa1[r] += sc * st.o1[r]; } }
    { int tl_ = tq_lo; asm volatile("" : "+s"(tl_)); bf16_t* obase = WSP(bf16_t, WS_OCAT) + (rowbase + tl_) * OCW + h * 64;
      store_o_staged(lds, wid, lane, oa0, oa1, 1.0f, [&](int r) { return obase + (size_t)r * OCW; }); }
#undef NS_LOAD
#undef NS_FRESH
#undef NS_WRITE
}
__device__ __forceinline__ void dil_unit(Frame& F, int b, int hh, int span) {
    int lane_o = lane_now();
    const int wid = F.wave, lane = lane_o, r32 = lane & 31, hi = lane >> 5, tid = wid * 64 + lane;
    const int T0 = span * 512;
    const size_t rowbase = (size_t)b * SEQ;
    const bf16_t* P = WSP(const bf16_t, WS_P) + rowbase * PW;
    lds_ptr lds = (lds_ptr)F.lds;
    LAS float* dtab = (LAS float*)(lds + 32768);
    for (int i = tid; i < 3 * 192; i += 512) dtab[i] = WSP(const float, WS_DILTAB)[((i / 192) * 2 + hh) * 192 + (i % 192)];
    __syncthreads();
    lds_ptr vst = lds + wid * 4096;
    const int vpo = ((lane >> 4) & 1) * 32 + (lane & 3) * 8 + (4 * hi + ((lane & 15) >> 2)) * 64;
    bf16_t* DOG = WSP(bf16_t, WS_DOG); float* DLSE = WSP(float, WS_DLSE);
    for (int g = 0; g < 3; ++g) {
        const int sh = 2 * g, head = 2 * g + hh;
        for (int rep = 0; rep < 2; ++rep) {
            const int wt = wid + 8 * rep;
            const int res = (g == 0) ? 0 : (g == 1 ? (wt & 3) : wt);
            const int i0 = (g == 0) ? 32 * wt : (g == 1 ? 32 * (wt >> 2) : 0);
            const int n0 = (T0 >> sh) + i0;
            const int tokq = res + ((n0 + r32) << sh);
            bf16x8 qf[4];
            { const bf16_t* Qrow = P + (size_t)tokq * PW + PC_BQ + head * 64;
#pragma unroll
              for (int ks = 0; ks < 4; ++ks) qf[ks] = *(const bf16x8*)(Qrow + ks * 16 + hi * 8); }
            f32x16 o0, o1; float m = NEG_INF, l = 0.f;
#pragma unroll
            for (int r = 0; r < 16; ++r) { o0[r] = 0.f; o1[r] = 0.f; }
#define DIL_LOAD(cc, KF, VR) do { const int nk0_ = n0 - 128 + 32 * (cc); int nk_ = nk0_ + r32; nk_ = nk_ < 0 ? 0 : nk_; const bf16_t* Krow_ = P + (size_t)(res + (nk_ << sh)) * PW + PC_BK + head * 64; \
        _Pragma("unroll") for (int ks = 0; ks < 4; ++ks) KF[ks] = *(const bf16x8*)(Krow_ + ks * 16 + hi * 8); \
        _Pragma("unroll") for (int i = 0; i < 4; ++i) { const int pc_ = lane + 64 * i, vrow_ = pc_ >> 3, c16_ = pc_ & 7; int nv_ = nk0_ + vrow_; nv_ = nv_ < 0 ? 0 : nv_; \
            VR[i] = *(const u32x4*)(P + (size_t)(res + (nv_ << sh)) * PW + PC_BV + head * 64 + c16_ * 8); } } while (0)
            int cfirst = 0; while (cfirst < 4 && n0 - 128 + 32 * cfirst + 31 < 0) ++cfirst;
            bf16x8 kfn[4]; u32x4 vrn[4];
            DIL_LOAD(cfirst, kfn, vrn);
            for (int c = cfirst; c < 5; ++c) {
                const int nk0 = n0 - 128 + 32 * c;
                { bf16x8 kf[4]; u32x4 vr[4];
#pragma unroll
                  for (int i = 0; i < 4; ++i) { kf[i] = kfn[i]; vr[i] = vrn[i]; }
                  if (c < 4) DIL_LOAD(c + 1, kfn, vrn);
#pragma unroll
                  for (int i = 0; i < 4; ++i) { const int pc = lane + 64 * i, vrow = pc >> 3, c16 = pc & 7;
                      *(LAS u32x4*)(vst + (c16 >> 2) * 2048 + vrow * 64 + (c16 & 3) * 16) = vr[i]; }
                  asm volatile("s_waitcnt lgkmcnt(0)" ::: "memory");
                  f32x16 p;
#pragma unroll
                  for (int r = 0; r < 16; ++r) p[r] = 0.f;
#pragma unroll
                  for (int ks = 0; ks < 4; ++ks) p = MFMA32(kf[ks], qf[ks], p);
                  const LAS float* tb = dtab + g * 192 + (32 - r32 + 4 * hi + 32 * c);
                  float mx = NEG_INF;
#pragma unroll
                  for (int r = 0; r < 16; ++r) { const int o = (r & 3) + 8 * (r >> 2), kk = o + 4 * hi, j = 128 + r32 - 32 * c - kk;
                      const bool ok = (j >= 0) && (j <= 128) && (nk0 + kk >= 0);
                      p[r] = ok ? p[r] + tb[o] : NEG_INF; mx = fmaxf(mx, p[r]); }
                  mx = fmaxf(mx, other_half(mx, hi));
                  if (__any(mx > m + 8.0f)) { const float mn = fmaxf(m, mx), msn = (mn == NEG_INF) ? 0.f : mn, alpha = fast_exp2(m - msn);
                      l *= alpha; m = mn;
#pragma unroll
                      for (int r = 0; r < 16; ++r) { o0[r] *= alpha; o1[r] *= alpha; } }
                  const float ms = (m == NEG_INF) ? 0.f : m;
                  float rs = 0.f;
#pragma unroll
                  for (int r = 0; r < 16; ++r) { p[r] = fast_exp2(p[r] - ms); rs += p[r]; }
                  rs += other_half(rs, hi);
                  l += rs;
                  u32x4 w0, w1;
                  w0.x = cvtpk(p[0], p[1]); w0.y = cvtpk(p[2], p[3]); w0.z = cvtpk(p[4], p[5]); w0.w = cvtpk(p[6], p[7]);
                  w1.x = cvtpk(p[8], p[9]); w1.y = cvtpk(p[10], p[11]); w1.z = cvtpk(p[12], p[13]); w1.w = cvtpk(p[14], p[15]);
                  const bf16x8 pf0 = __builtin_bit_cast(bf16x8, w0), pf1 = __builtin_bit_cast(bf16x8, w1);
                  lds_cptr vp = (lds_cptr)(vst + vpo);
#pragma unroll
                  for (int ks = 0; ks < 2; ++ks) {
                      const s16x4 l0 = vtr(vp + ks * 1024), h0 = vtr(vp + ks * 1024 + 512), l1 = vtr(vp + 2048 + ks * 1024), h1 = vtr(vp + 2048 + ks * 1024 + 512);
                      const bf16x8 v0 = (bf16x8){l0[0], l0[1], l0[2], l0[3], h0[0], h0[1], h0[2], h0[3]}, v1 = (bf16x8){l1[0], l1[1], l1[2], l1[3], h1[0], h1[1], h1[2], h1[3]};
                      o0 = MFMA32(v0, ks == 0 ? pf0 : pf1, o0); o1 = MFMA32(v1, ks == 0 ? pf0 : pf1, o1);
                  }
                  asm volatile("s_waitcnt lgkmcnt(0)" ::: "memory"); }
            }
#undef DIL_LOAD
            const size_t orow = rowbase + tokq;
            store_o_staged(lds, wid, lane, o0, o1, 1.0f / l, [&](int r) { return DOG + ((size_t)g * M + rowbase + (size_t)(res + ((n0 + r) << sh))) * 128 + hh * 64; });
            if (hi == 0) DLSE[((size_t)g * M + orow) * 2 + hh] = m + log2f(l);
        }
    }
    VM_WAIT();
    __syncthreads();
    bf16_t* OC = WSP(bf16_t, WS_OCAT);
    for (int it = 0; it < 8; ++it) {
        const int item = tid + 512 * it, tl = item >> 3, pc = item & 7; const size_t orow = rowbase + T0 + tl;
        const float l0 = DLSE[((size_t)0 * M + orow) * 2 + hh], l1 = DLSE[((size_t)1 * M + orow) * 2 + hh], l2 = DLSE[((size_t)2 * M + orow) * 2 + hh];
        const float mx = fmaxf(l0, fmaxf(l1, l2)); float w0 = fast_exp2(l0 - mx), w1 = fast_exp2(l1 - mx), w2 = fast_exp2(l2 - mx);
        const float inv = 1.0f / (w0 + w1 + w2); w0 *= inv; w1 *= inv; w2 *= inv;
        const u32x4 a = *(const u32x4*)(DOG + ((size_t)0 * M + orow) * 128 + hh * 64 + pc * 8), bb = *(const u32x4*)(DOG + ((size_t)1 * M + orow) * 128 + hh * 64 + pc * 8),
                    cc = *(const u32x4*)(DOG + ((size_t)2 * M + orow) * 128 + hh * 64 + pc * 8);
        u32x4 w;
#pragma unroll
        for (int e = 0; e < 4; ++e) {
            const float lo = w0 * __uint_as_float(a[e] << 16) + w1 * __uint_as_float(bb[e] << 16) + w2 * __uint_as_float(cc[e] << 16);
            const float hv = w0 * __uint_as_float(a[e] & 0xffff0000u) + w1 * __uint_as_float(bb[e] & 0xffff0000u) + w2 * __uint_as_float(cc[e] & 0xffff0000u);
            w[e] = cvtpk(lo, hv); }
        *(u32x4*)(OC + orow * OCW + 256 + hh * 64 + pc * 8) = w;
    }
    __syncthreads();
}
__device__ __forceinline__ float wave_sum(float v) {
    v += xor_lane_lt32<1>(v); v += xor_lane_lt32<2>(v); v += xor_lane_lt32<4>(v); v += xor_lane_lt32<8>(v); v += xor_lane_lt32<16>(v);
    return sum_halves(v);
}
__device__ __forceinline__ int rel_bucket(int dist) {
    if (dist < 0) dist = 0;
    if (dist < 16) return dist;
    const int thr[15] = {22, 30, 40, 54, 73, 99, 134, 182, 246, 332, 450, 609, 825, 1117, 1513};
    int bkt = 16;
#pragma unroll
    for (int i = 0; i < 15; ++i) bkt += (dist >= thr[i]) ? 1 : 0;
    return bkt;
}
__device__ __forceinline__ int inproj_src(int c, float& sc) {
    sc = 1.f;
    if (c < 256) { sc = C2A; return c; }
    if (c < 652) return c;
    if (c < 656) return 2572 + (c - 652);
    if (c < 672) return -1;
    if (c < 704) { const int p = c - 672; return 2960 + (p >> 1) + 16 * (p & 1); }
    if (c < 768) return -1;
    if (c < 1920) { const int r = c - 768; if (r < 384) sc = C2A; return 652 + r; }
    if (c < 2048) return 2832 + (c - 1920);
    if (c < 2816) { const int r = c - 2048; if (r < 256) sc = C2A; return 1804 + r; }
    return 2576 + (c - 2816);
}
__device__ __forceinline__ int quq_src(int r, float& sc) {
    sc = C2D;
    if (r >= 384) return -1;
    const int hd = r / 96, w = r % 96;
    if (w < 64) return hd * 96 + w;
    const int p = w - 64; return hd * 96 + 64 + (p >> 1) + 16 * (p & 1);
}
__device__ __forceinline__ int gateperm_src(int r) {
    const int T = r >> 8, c = r & 255, pn = T >> 2, j = T & 3, bj = c >> 7, wc = (c >> 5) & 3, fq = (c >> 3) & 3, n = (c >> 2) & 1, e = c & 3;
    return (2 * bj + n) * DM * DM + 256 * pn + 64 * j + 16 * wc + 4 * fq + e;
}
__device__ __forceinline__ int branchperm_src(int r) {
    const int pn = r >> 8, c = r & 255, bj = c >> 7, wc = (c >> 5) & 3, fq = (c >> 3) & 3, n = (c >> 2) & 1, e = c & 3;
    return 256 * pn + 64 * (2 * bj + n) + 16 * wc + 4 * fq + e;
}
__device__ __forceinline__ int upperm_src(int r) { const int pn = r >> 8, c = r & 255; return (c & 128) ? DFF + 128 * pn + (c & 127) : 128 * pn + c; }
__device__ __forceinline__ void wconv_item(const float* W, int Nsrc, bf16_t* WT, int ldt, const float* kgain, int kind, LAS float* scr, int item, int nblk, int lane, bool f8out = false) {
    const int kb = item / nblk, nb = item % nblk, k0 = 64 * kb, n0 = 32 * nb;
    const int n = n0 + (lane & 31); float sc = 1.f; int src = n;
    if (kind == 1) src = inproj_src(n, sc); else if (kind == 2) src = quq_src(n, sc); else if (kind == 3) src = gateperm_src(n); else if (kind == 4) src = branchperm_src(n); else if (kind == 5) src = upperm_src(n);
    float wv[32];
#pragma unroll
    for (int i = 0; i < 32; ++i) { const int kk = 2 * i + (lane >> 5); wv[i] = (src >= 0) ? W[(size_t)(k0 + kk) * Nsrc + src] : 0.f; }
#pragma unroll
    for (int i = 0; i < 32; ++i) { const int kk = 2 * i + (lane >> 5); float v = wv[i] * sc; if (kgain) v *= kgain[k0 + kk]; scr[kk * 33 + (lane & 31)] = v; }
    LDS_WAIT(); asm volatile("" ::: "memory");
    if (f8out) {
        const int nn = lane >> 1, hh = lane & 1; const LAS float* s = scr + (32 * hh) * 33 + nn; unsigned char* dst = (unsigned char*)WT + (size_t)(n0 + nn) * ldt + k0 + 32 * hh;
#pragma unroll
        for (int j = 0; j < 2; ++j) { u32x4 o;
#pragma unroll
            for (int e = 0; e < 4; ++e) { const LAS float* q = s + (16 * j + 4 * e) * 33; o[e] = pk4_fp8(q[0] * WG8_SCALE, q[33] * WG8_SCALE, q[66] * WG8_SCALE, q[99] * WG8_SCALE); }
            *(u32x4*)(dst + 16 * j) = o; }
        LDS_WAIT(); asm volatile("" ::: "memory");
        return;
    }
    const int c = lane & 7;
#pragma unroll
    for (int j = 0; j < 4; ++j) { const int nn = (lane >> 3) + 8 * j; const LAS float* s = scr + (8 * c) * 33 + nn;
        u32x4 o; o.x = pk2(s[0 * 33], s[1 * 33]); o.y = pk2(s[2 * 33], s[3 * 33]); o.z = pk2(s[4 * 33], s[5 * 33]); o.w = pk2(s[6 * 33], s[7 * 33]);
        *(u32x4*)(WT + (size_t)(n0 + nn) * ldt + k0 + 8 * c) = o; }
    LDS_WAIT(); asm volatile("" ::: "memory");
}
constexpr int ATT_UNITS = 3328;
__device__ __forceinline__ int att_cost(int id) {
    if (id < 2048) { const int qb = 15 - (id >> 7), mla = (id >> 6) & 1; return (mla ? 5 : 4) * (qb + 1); }
    if (id < 3072) return (63 - ((id - 2048) >> 4)) + 20;
    return 30;
}
__device__ __forceinline__ int clampi(int x, int lo, int hi) { return x < lo ? lo : (x > hi ? hi : x); }
__device__ __forceinline__ int att_rank(int i) {
    const int c = att_cost(i);
    int r = clampi(16 - c / 4, 0, 16) * 64 + clampi(16 - c / 5, 0, 16) * 64 + clampi(83 - c, 0, 64) * 16 + (c < 30 ? 256 : 0);
    if (c % 4 == 0 && c / 4 >= 1 && c / 4 <= 16) r += clampi(i - (16 - c / 4) * 128, 0, 64);
    if (c % 5 == 0 && c / 5 >= 1 && c / 5 <= 16) r += clampi(i - ((16 - c / 5) * 128 + 64), 0, 64);
    if (c >= 20 && c <= 83) r += clampi(i - (2048 + (63 - (c - 20)) * 16), 0, 16);
    if (c == 30) r += clampi(i - 3072, 0, 256);
    return r;
}
__device__ __forceinline__ void p0_prologue(Frame& F) {
    LAS float* scr = (LAS float*)(F.lds + F.wave * 16384);
    const int gw = blockIdx.x * 8 + F.wave, NGW = F.G * 8, lane = F.lane;
    constexpr int I_IN = 16 * 96, I_G = 16 * 32, I_BA = 4 * 32, I_BB = 2 * 32, I_O = 16 * 32, I_UP = 16 * 176, I_DN = 44 * 32, I_UQ = 4 * 16, I_UKV = 2 * 16, I_PHI = 32 * 4;
    constexpr int I_L = I_IN + 4 * I_G + 3 * I_BA + I_BB + I_O + I_UP + I_DN + I_UQ + I_UKV + 2 * I_PHI;
    for (int it = gw; it < DEPTH * I_L; it += NGW) {
        const int l = it / I_L; int r = it % I_L;
        unsigned char* wl = F.ws + WS_WT + (size_t)l * LW;
        if (r < I_IN) { wconv_item(F.in[6] + (size_t)l * DM * DIN, DIN, (bf16_t*)(wl + LW_IN), DM, nullptr, 1, scr, r, 96, lane); continue; } r -= I_IN;
        if (r < 4 * I_G) { wconv_item(F.in[21] + (size_t)l * 4 * DM * DM, DM, (bf16_t*)(wl + LW_G), DM, nullptr, 3, scr, r, 128, lane, true); continue; } r -= 4 * I_G;
        if (r < I_BA) { wconv_item(F.in[17] + (size_t)l * 256 * DM, DM, (bf16_t*)(wl + LW_BR + BR_A), 256, nullptr, 4, scr, r, 32, lane); continue; } r -= I_BA;
        if (r < I_BB) { wconv_item(F.in[18] + (size_t)l * 128 * DM, DM, (bf16_t*)(wl + LW_BR + BR_B), 128, nullptr, 4, scr, r, 32, lane); continue; } r -= I_BB;
        if (r < I_BA) { wconv_item(F.in[19] + (size_t)l * 256 * DM, DM, (bf16_t*)(wl + LW_BR + BR_C), 256, nullptr, 4, scr, r, 32, lane); continue; } r -= I_BA;
        if (r < I_BA) { wconv_item(F.in[20] + (size_t)l * 256 * DM, DM, (bf16_t*)(wl + LW_BR + BR_D), 256, nullptr, 4, scr, r, 32, lane); continue; } r -= I_BA;
        if (r < I_O) { wconv_item(F.in[22] + (size_t)l * DM * DM, DM, (bf16_t*)(wl + LW_O), DM, nullptr, 0, scr, r, 32, lane); continue; } r -= I_O;
        if (r < I_UP) { wconv_item(F.in[23] + (size_t)l * DM * DFF2, DFF2, (bf16_t*)(wl + LW_UP), DM, nullptr, 5, scr, r, 176, lane); continue; } r -= I_UP;
        if (r < I_DN) { wconv_item(F.in[26] + (size_t)l * DFF * DM, DM, (bf16_t*)(wl + LW_DN), DFF, nullptr, 0, scr, r, 32, lane); continue; } r -= I_DN;
        if (r < I_UQ) { wconv_item(F.in[15] + (size_t)l * 256 * 384, 384, (bf16_t*)(wl + LW_UQ), 256, F.in[13] + l * 256, 2, scr, r, 16, lane); continue; } r -= I_UQ;
        if (r < I_UKV) { wconv_item(F.in[16] + (size_t)l * 128 * 512, 512, (bf16_t*)(wl + LW_UKV), 128, F.in[14] + l * 128, 0, scr, r, 16, lane); continue; } r -= I_UKV;
        if (r < I_PHI) { wconv_item(F.in[8] + (size_t)l * 2048 * 128, 128, (bf16_t*)(wl + LW_PHI), 2048, nullptr, 0, scr, r, 4, lane); continue; } r -= I_PHI;
        wconv_item(F.in[10] + (size_t)l * 2048 * 128, 128, (bf16_t*)(wl + LW_PHI) + (size_t)128 * 2048, 2048, nullptr, 0, scr, r, 4, lane);
    }
    const int gt = blockIdx.x * 512 + F.tid, NGT = F.G * 512;
    const float* rel = F.in[1];
    float* rope = WSP(float, WS_ROPE);
    for (int i = gt; i < SEQ * 16; i += NGT) { const int t = i >> 4, k = i & 15; const float inv = powf(10000.0f, -(float)(2 * k) / 32.0f); const float ang = (float)t * inv;
        float sn, cs; sincosf(ang, &sn, &cs); rope[2 * i] = cs; rope[2 * i + 1] = sn; }
    float* ntab = WSP(float, WS_NSATAB);
    for (int i = gt; i < 4 * NSA_TL; i += NGT) { const int hd = i / NSA_TL, k = i % NSA_TL, dist = NSA_DMAX - k; ntab[i] = dist >= 0 ? (rel[rel_bucket(dist) * 10 + hd] - rel[31 * 10 + hd]) * LOG2E : 0.f; }
    { float* cws = WSP(float, WS_CWS);
      for (int i = gt; i < DEPTH * 4 * DFF2; i += NGT) { const int l = i / (4 * DFF2), r = i % (4 * DFF2), row = r / DFF2, col = r % DFF2;
          const float s = row < 3 ? F.in[24][(size_t)l * 3 * DFF2 + row * DFF2 + col] : F.in[25][(size_t)l * DFF2 + col];
          cws[i] = s * (col < DFF ? -LOG2E : -0.6931471805599453f); } }
    float* dtab = WSP(float, WS_DILTAB);
    for (int i = gt; i < 6 * 192; i += NGT) { const int gh = i / 192, k = i % 192, g = gh >> 1, hh = gh & 1, j = 160 - k; dtab[i] = (j >= 0 && j <= 128) ? rel[rel_bucket(j << (2 * g)) * 10 + 4 + 2 * g + hh] * LOG2E : 0.f; }
    if (gt < 4) { WSP(float, WS_FARB)[gt] = rel[31 * 10 + gt] * LOG2E; float tm = 0.f; for (int bk = 0; bk < 32; ++bk) tm = fmaxf(tm, fabsf(rel[bk * 10 + gt] - rel[31 * 10 + gt])); WSP(float, WS_FARB)[4 + gt] = tm * LOG2E; }
    if (gw < 128) { const int mi = gw >> 5, pc = gw & 31, l = mi >> 1; const float *pk1 = F.in[8], *pv1 = F.in[10]; asm volatile("" : "+s"(pk1), "+s"(pv1));
        const float* w1 = ((mi & 1) ? pv1 : pk1) + (size_t)l * 2048 * 128 + (size_t)(64 * pc) * 128 + 2 * lane; const float* cp = F.in[7] + (size_t)l * 2048 + 64 * pc;
        f32x2 a = {0.f, 0.f};
#pragma unroll 8
        for (int p = 0; p < 64; ++p) { const f32x2 w = *(const f32x2*)(w1 + (size_t)p * 128); const float cpp = cp[p]; a[0] += cpp * w[0]; a[1] += cpp * w[1]; }
        *(f32x2*)(WSP(float, WS_CMPP) + ((size_t)mi * 32 + pc) * 128 + 2 * lane) = a; }
    if (gt < ATT_UNITS) {
        const int i = gt; int cls, slot;
        if (i < 2048) { const int bh = i & 63, mla = (i >> 6) & 1; cls = (bh >> 2) & 7; slot = (mla ? 128 : 288) + (i >> 7) * 8 + (((bh >> 5) << 2) | (bh & 3)); }
        else if (i < 3072) { const int r = i - 2048, bN = r & 15; cls = bN & 7; slot = (r >> 4) * 2 + (bN >> 3); }
        else { const int r = i - 3072, b = r & 15; cls = b & 7; slot = 256 + (r >> 4) * 2 + (b >> 3); }
        WSP(int, WS_ORDER)[cls * (ATT_UNITS / 8) + slot] = i; }
}
__device__ __forceinline__ void cmpb_reduce(Frame& F) {
    const int i = F.tid; if (i < DEPTH * 256) { const int l = i >> 8, n = i & 255, mi = l * 2 + (n >> 7); const float* pp = WSP(const float, WS_CMPP) + (size_t)mi * 32 * 128 + (n & 127); float a = 0.f;
        for (int pc = 0; pc < 32; ++pc) a += pp[pc * 128]; WSP(float, WS_CMPB)[i] = a; }
}

template <int MODE, bool XIB, bool XOB, bool H8 = false> __device__ __forceinline__ void rowpass(Frame& F, const void* x, const bf16_t* y, size_t yrow0, void* xout, bf16_t* hout, const float* g1, const float* g2, int row_lo, int row_hi, unsigned char* h8out = nullptr) {
    int gw = blockIdx.x * 8 + F.wave; asm volatile("" : "+s"(gw));
    const int NGW = F.G * 8, lane = F.lane;
    f32x4 ga[4], gb[4];
#pragma unroll
    for (int j = 0; j < 4; ++j) { ga[j] = *(const f32x4*)(g1 + 4 * lane + 256 * j); if (MODE == 1) gb[j] = *(const f32x4*)(g2 + 4 * lane + 256 * j); }
    f32x4 xf[4], xfn[4]; u32x2 xb[4], xbn[4], yb[4], ybn[4];
#define RP_LOAD(XF, XB, YB, mm) do { if (XIB) { const u32x2* xr_ = (const u32x2*)((const bf16_t*)x + (size_t)(mm) * DM) + lane; _Pragma("unroll") for (int j = 0; j < 4; ++j) XB[j] = xr_[64 * j]; } \
        else { const f32x4* xr_ = (const f32x4*)((const float*)x + (size_t)(mm) * DM) + lane; _Pragma("unroll") for (int j = 0; j < 4; ++j) XF[j] = xr_[64 * j]; } \
        if (MODE != 0) { const u32x2* yr_ = (const u32x2*)(y + ((size_t)(mm) - yrow0) * DM) + lane; _Pragma("unroll") for (int j = 0; j < 4; ++j) YB[j] = yr_[64 * j]; } } while (0)
    int m = row_lo + gw;
    if (m < row_hi) RP_LOAD(xf, xb, yb, m);
    for (; m < row_hi; m += NGW) {
        const int mn = m + NGW;
        if (mn < row_hi) RP_LOAD(xfn, xbn, ybn, mn);
        f32x4 v[4];
#pragma unroll
        for (int j = 0; j < 4; ++j) { if (XIB) { v[j][0] = __uint_as_float(xb[j].x << 16); v[j][1] = __uint_as_float(xb[j].x & 0xffff0000u); v[j][2] = __uint_as_float(xb[j].y << 16); v[j][3] = __uint_as_float(xb[j].y & 0xffff0000u); } else v[j] = xf[j]; }
        if (MODE != 0) {
            f32x4 w[4]; float s = 0.f;
#pragma unroll
            for (int j = 0; j < 4; ++j) { const u32x2 yy = yb[j]; w[j][0] = __uint_as_float(yy.x << 16); w[j][1] = __uint_as_float(yy.x & 0xffff0000u); w[j][2] = __uint_as_float(yy.y << 16); w[j][3] = __uint_as_float(yy.y & 0xffff0000u);
                s += (w[j][0] * w[j][0] + w[j][1] * w[j][1]) + (w[j][2] * w[j][2] + w[j][3] * w[j][3]); }
            const float rstd = 1.0f / sqrtf(wave_sum(s) * (1.0f / DM) + RMS_EPS);
#pragma unroll
            for (int j = 0; j < 4; ++j) v[j] = v[j] + w[j] * rstd * ga[j];
            if (XOB) { u32x2* xo = (u32x2*)((bf16_t*)xout + (size_t)m * DM) + lane;
#pragma unroll
                for (int j = 0; j < 4; ++j) { u32x2 w2; w2.x = cvtpk(v[j][0], v[j][1]); w2.y = cvtpk(v[j][2], v[j][3]); xo[64 * j] = w2; } }
            else { f32x4* xo = (f32x4*)((float*)xout + (size_t)m * DM) + lane;
#pragma unroll
                for (int j = 0; j < 4; ++j) xo[64 * j] = v[j]; }
        }
        if (MODE != 2) {
            float s = 0.f;
#pragma unroll
            for (int j = 0; j < 4; ++j) s += (v[j][0] * v[j][0] + v[j][1] * v[j][1]) + (v[j][2] * v[j][2] + v[j][3] * v[j][3]);
            const float rstd = 1.0f / sqrtf(wave_sum(s) * (1.0f / DM) + RMS_EPS);
            u32x2* ho = (u32x2*)(hout + (size_t)m * DM) + lane;
#pragma unroll
            for (int j = 0; j < 4; ++j) { const f32x4 gg = (MODE == 1) ? gb[j] : ga[j]; const f32x4 o = v[j] * rstd * gg; u32x2 w; w.x = cvtpk(o[0], o[1]); w.y = cvtpk(o[2], o[3]); ho[64 * j] = w;
                if (H8) ((unsigned*)(h8out + (size_t)m * DM))[lane + 64 * j] = pk4_fp8(o[0] * H8_SCALE, o[1] * H8_SCALE, o[2] * H8_SCALE, o[3] * H8_SCALE); }
        }
#pragma unroll
        for (int j = 0; j < 4; ++j) { if (XIB) xb[j] = xbn[j]; else xf[j] = xfn[j]; if (MODE != 0) yb[j] = ybn[j]; }
    }
#undef RP_LOAD
}

__device__ __forceinline__ void ffn_fix_panel(Frame& F, int pm, const float* HB, bf16_t* ACT, const float* cw, const float* cb) {
#pragma unroll 2
    for (int it = F.tid; it < 4 * 2 * (DFF / 4); it += 512) {
        const int c4 = it % (DFF / 4), rr = (it / (DFF / 4)) & 1, g = pm * 4 + it / (2 * (DFF / 4)), c = c4 * 4, pn = c >> 7, cl = c & 127;
        const bool first = ((g * 64) & (SEQ - 1)) == 0;
#define HBV(gg, s, bj) (*(const f32x4*)(HB + ((size_t)(((gg) * 4 + (s)) * 22 + pn) * 256 + (bj) * 128 + cl)))
        const f32x4 z = {0.f, 0.f, 0.f, 0.f};
        const f32x4 u0g = HBV(g, 0, 0), u0v = HBV(g, 0, 1);
        f32x4 ag, bg_, cg, av, bv_, cv;
        if (rr == 0) { ag = first ? z : HBV(g - 1, 2, 0); bg_ = first ? z : HBV(g - 1, 3, 0); cg = u0g; av = first ? z : HBV(g - 1, 2, 1); bv_ = first ? z : HBV(g - 1, 3, 1); cv = u0v; }
        else { ag = first ? z : HBV(g - 1, 3, 0); bg_ = u0g; cg = HBV(g, 1, 0); av = first ? z : HBV(g - 1, 3, 1); bv_ = u0v; cv = HBV(g, 1, 1); }
#undef HBV
        const f32x4 kb = *(const f32x4*)(cb + c), k0 = *(const f32x4*)(cw + c), k1 = *(const f32x4*)(cw + DFF2 + c), k2 = *(const f32x4*)(cw + 2 * DFF2 + c);
        const f32x4 vb = *(const f32x4*)(cb + DFF + c), v0 = *(const f32x4*)(cw + DFF + c), v1 = *(const f32x4*)(cw + DFF2 + DFF + c), v2 = *(const f32x4*)(cw + 2 * DFF2 + DFF + c);
        float o[4];
#pragma unroll
        for (int e = 0; e < 4; ++e) { const float gt = kb[e] + k0[e] * ag[e] + k1[e] * bg_[e] + k2[e] * cg[e], vl = vb[e] + v0[e] * av[e] + v1[e] * bv_[e] + v2[e] * cv[e]; o[e] = gt * sigmoid_f(gt) * vl; }
        u32x2 w; w.x = cvtpk(o[0], o[1]); w.y = cvtpk(o[2], o[3]);
        *(u32x2*)(ACT + (size_t)(g * 64 + rr) * DFF + c) = w;
    }
}
struct SchedSimple {
    pg8::TileOrder T; const char* A; const char* B; int lda, ldb, nt; int dup = 0;
    __device__ __forceinline__ bool next(int i, GUnit& u) const { int pm, pn; if (!T.tile(i >> dup, pm, pn)) return false;
        u.A = A + (size_t)pm * 256 * lda; u.B = B + (size_t)pn * 256 * ldb; u.lda = lda; u.ldb = ldb; u.nt = nt; u.pm = pm; u.pn = pn; u.id = 0; return true; }
};
struct SchedCmp1 {
    int c; const char* kc; const char* vc; const char* B;
    __device__ __forceinline__ bool next(int i, GUnit& u) const { if (i > 0 || c >= 32) return false;
        u.A = (c < 16 ? kc : vc) + (size_t)(c & 15) * 256 * 2048; u.B = B; u.lda = 2048; u.ldb = 4096; u.nt = 32; u.pm = c; u.pn = 0; u.id = 0; return true; }
};
struct SchedMerge {
    pg8::TileOrder T; const char* ocat; const char* h; const char* wbr; const char* wg; int dup = 0;
    __device__ __forceinline__ bool next(int i0, GUnit& u) const { const int i = i0 >> dup; int pm, pn; if (!T.tile(i >> 3, pm, pn)) return false;
        const int sub = i & 7; u.pm = pm; u.pn = pn; u.id = sub;
        if (sub >= 4) { u.A = h + (size_t)pm * 256 * 1024; u.lda = 1024; u.B = wg + (size_t)((pn * 4 + (sub - 4)) * 256) * 1024; u.ldb = 1024; u.nt = 8; }
        else { const int br = sub; const int kk = (br == 1) ? 128 : 256; const size_t co = (br == 0) ? 0 : (br == 1 ? 256 : (br == 2 ? 384 : 640)), wo = (br == 0) ? BR_A : (br == 1 ? BR_B : (br == 2 ? BR_C : BR_D));
            u.A = ocat + (size_t)pm * 256 * (OCW * 2) + co * 2; u.lda = OCW * 2; u.B = wbr + wo + (size_t)pn * 256 * kk * 2; u.ldb = kk * 2; u.nt = kk / 64; }
        return true; }
};

#ifndef SDUP_INPROJ
#define SDUP_INPROJ 0
#endif
#ifndef SDUP_MERGE
#define SDUP_MERGE 0
#endif
#ifndef SDUP_WO
#define SDUP_WO 0
#endif
#ifndef SDUP_UP
#define SDUP_UP 0
#endif
#ifndef SDUP_DN
#define SDUP_DN 0
#endif
#ifndef DUP_ATTN
#define DUP_ATTN 1
#endif
#ifndef DUP_GEMM
#define DUP_GEMM 1
#endif
#ifndef DUP_MERGE
#define DUP_MERGE 1
#endif
#ifndef DUP_FFN
#define DUP_FFN 1
#endif
#ifdef ONLY_PHASE
#define PH(k) ((k) == ONLY_PHASE)
#else
#define PH(k) true
#endif
struct Args { const float* in[27]; float* out; unsigned char* ws; };
__global__ void __launch_bounds__(512, 2) hybrid_fwd(Args args) {
    extern __shared__ __attribute__((aligned(16))) unsigned char lds_raw[];
    Frame F;
    F.lds = (LAS unsigned char*)lds_raw; F.MISC = (volatile LAS unsigned*)(F.lds + MISC_OFF);
    F.tid = threadIdx.x; F.lane = F.tid & 63; F.wave = __builtin_amdgcn_readfirstlane(F.tid >> 6); F.G = gridDim.x;
#pragma unroll
    for (int i = 0; i < 27; ++i) F.in[i] = args.in[i];
    F.out = args.out; F.ws = args.ws; F.ctl = (gu32*)(args.ws + WS_CTL);
    for (int u = F.tid; u < (LDS_BYTES - LDSCTL_OFF) / 4; u += 512) ((LAS unsigned*)(F.lds + LDSCTL_OFF))[u] = 0u;
    __syncthreads();
    XcdBarrier bar = xcd_barrier_post((unsigned*)(F.ctl + CW_BAR), F.MISC + 8);
    const int c = (int)blockIdx.x;
#define TSTAMP(id) do { } while (0)

#ifndef DUP_P0
#define DUP_P0 1
#endif
    for (int rep = 0; rep < DUP_P0; ++rep) { if (rep) xcd_barrier(bar, F.wave); if (PH(0)) p0_prologue(F); }

#ifndef XTRA_BAR
#define XTRA_BAR 0
#endif
    _Pragma("unroll") for (int xb = 0; xb < XTRA_BAR; ++xb) xcd_barrier(bar, F.wave);
#define PHASE_FRESH() do { const int l_ = lane_now(); F.tid = F.wave * 64 + l_; F.lane = l_; } while (0)
    for (int l = 0; l < DEPTH; ++l) {
        unsigned char* wl = F.ws + WS_WT + (size_t)l * LW;
        const float* xin = (l == 0) ? F.in[0] : F.out;
        PHASE_FRESH();
#ifndef DUP_RP0
#define DUP_RP0 1
#endif
        if (l == 0) {
          _Pragma("unroll") for (int rep = 0; rep < DUP_RP0; ++rep) { if (rep) xcd_barrier(bar, F.wave); if (PH(1)) rowpass<0, false, false, true>(F, F.in[0], nullptr, 0, nullptr, WSP(bf16_t, WS_H), F.in[2] + l * DM, nullptr, 0, M, (unsigned char*)F.out + H8_OFF); }
          xcd_barrier(bar, F.wave); TSTAMP(1);
          if (c == 0) cmpb_reduce(F); }
        for (int rep = 0; rep < DUP_GEMM; ++rep) if (PH(2)) { if (rep) xcd_barrier(bar, F.wave); SchedSimple S; S.T.init(256, 12, F.G, c); S.A = (const char*)(F.ws + WS_H); S.B = (const char*)(wl + LW_IN); S.lda = 2048; S.ldb = 2048; S.nt = 16; S.dup = SDUP_INPROJ;
          pg8::EpiInProj E{WSP(bf16_t, WS_P), WSP(bf16_t, WS_KCMP), WSP(bf16_t, WS_VCMP), WSP(float, WS_SIDE), WSP(bf16_t, WS_KROT), WSP(const float, WS_ROPE), WSP(float, WS_SSQQ), WSP(float, WS_SSQKV), F.in[12] + l * 4, WSP(float, WS_LF)};
          pg8::gemm_phase<pg8::EpiInProj, SchedSimple, true>(F.lds, S, E, F.wave); }
        xcd_barrier(bar, F.wave); TSTAMP(2);
#ifndef DUP_L2A
#define DUP_L2A 1
#endif
        _Pragma("unroll") for (int rep2 = 0; rep2 < DUP_L2A; ++rep2) { if (rep2) xcd_barrier(bar, F.wave);
        if (PH(3)) { SchedCmp1 S{c, (const char*)(F.ws + WS_KCMP), (const char*)(F.ws + WS_VCMP), (const char*)(wl + LW_PHI)};
          pg8::EpiCmp1 E{WSP(bf16_t, WS_HID), WSP(const float, WS_CMPB) + l * 256};
          pg8::gemm_phase<pg8::EpiCmp1, SchedCmp1, false>(F.lds, S, E, F.wave);
          if (c < 32) {
              __syncthreads(); const int which = c >> 4, b = c & 15;
              const int ln_ = lane_now(); const int r32 = ln_ & 31, hi = ln_ >> 5;
              const bf16_t* hrow = WSP(const bf16_t, WS_HID) + ((size_t)c * 256 + F.wave * 32 + r32) * 256 + which * 128;
              const float *pk2 = F.in[9], *pv2 = F.in[11]; asm volatile("" : "+s"(pk2), "+s"(pv2)); const float* w2 = (which ? pv2 : pk2) + (size_t)l * 128 * 64;
              f32x16 o0, o1;
#pragma unroll
              for (int r = 0; r < 16; ++r) { o0[r] = 0.f; o1[r] = 0.f; }
#pragma unroll
              for (int ks = 0; ks < 8; ++ks) { const bf16x8 a = *(const bf16x8*)(hrow + ks * 16 + hi * 8);
                  const float* wp = w2 + (size_t)(ks * 16 + hi * 8) * 64 + r32; u32x4 b0, b1;
#pragma unroll
                  for (int jj = 0; jj < 4; ++jj) { b0[jj] = cvtpk(wp[(2 * jj) * 64], wp[(2 * jj + 1) * 64]); b1[jj] = cvtpk(wp[(2 * jj) * 64 + 32], wp[(2 * jj + 1) * 64 + 32]); }
                  o0 = MFMA32(a, __builtin_bit_cast(bf16x8, b0), o0); o1 = MFMA32(a, __builtin_bit_cast(bf16x8, b1), o1); }
              bf16_t* dst = (which ? WSP(bf16_t, WS_VC) : WSP(bf16_t, WS_KC)) + ((size_t)b * 256 + F.wave * 32) * 64 + r32;
#pragma unroll
              for (int r = 0; r < 16; ++r) { const int rw = crow(r, hi); dst[(size_t)rw * 64] = (bf16_t)f2bf(o0[r]); dst[(size_t)rw * 64 + 32] = (bf16_t)f2bf(o1[r]); }
              if (which == 0) {
                  float mxn = 0.f;
#pragma unroll
                  for (int r = 0; r < 16; ++r) { float sq = o0[r] * o0[r] + o1[r] * o1[r]; sq += xor_lane_lt32<1>(sq); sq += xor_lane_lt32<2>(sq); sq += xor_lane_lt32<4>(sq); sq += xor_lane_lt32<8>(sq); sq += xor_lane_lt32<16>(sq); mxn = fmaxf(mxn, sq); }
                  mxn = fmaxf(mxn, other_half(mxn, hi));
                  if (ln_ == 0) atomicMax((unsigned*)(F.ctl + CW_KCMX + 16 * l) + b, __float_as_uint(mxn)); } } }
        if (PH(4)) { int G2_ = F.G; asm volatile("" : "+s"(G2_)); const bool split = G2_ > 64; const int g2 = split ? F.G - 32 : F.G, c2 = split ? c - 32 : c;
          { SchedSimple S; S.T.init(256, 2, g2, c2 < 0 ? (1 << 28) : c2); S.A = (const char*)(F.ws + WS_P) + PC_DQL * 2; S.B = (const char*)(wl + LW_UQ); S.lda = PW * 2; S.ldb = 512; S.nt = 4;
            pg8::EpiQup E{WSP(bf16_t, WS_QM), WSP(const float, WS_SSQQ), WSP(const float, WS_ROPE)};
            pg8::gemm_phase<pg8::EpiQup, SchedSimple, true>(F.lds, S, E, F.wave); }
          { SchedSimple S; S.T.init(256, 2, g2, c2 < 0 ? (1 << 28) : c2); S.A = (const char*)(F.ws + WS_P) + PC_DKV * 2; S.B = (const char*)(wl + LW_UKV); S.lda = PW * 2; S.ldb = 256; S.nt = 2;
            pg8::EpiKVup E{WSP(bf16_t, WS_KVM), WSP(const float, WS_SSQKV), (unsigned*)(F.ctl + CW_KMLA + 256 * l)};
            pg8::gemm_phase<pg8::EpiKVup, SchedSimple, true>(F.lds, S, E, F.wave); } }
        PHASE_FRESH();
        if (PH(5)) {
          int G_ = F.G; asm volatile("" : "+s"(G_)); const int cb = (G_ >= 48) ? c - 32 : c;
          if (cb >= 0 && cb < BATCH) { const int b = cb, tid = F.tid; const float* fl = WSP(const float, WS_SIDE) + ((size_t)b * SEQ + 8 * tid) * 16 + 12; const f32x4 fb = *(const f32x4*)(F.in[12] + l * 4);
              f32x4 v[8];
#pragma unroll
              for (int i = 0; i < 8; ++i) { const f32x4 z = *(const f32x4*)(fl + 16 * i);
#pragma unroll
                  for (int e = 0; e < 4; ++e) { const float x = z[e] + fb[e], t = fast_exp2(-fabsf(x) * LOG2E), lg = __builtin_amdgcn_logf(1.0f + t) * 0.6931471805599453f; v[i][e] = fminf(x, 0.f) - lg; } }
#pragma unroll
              for (int i = 1; i < 8; ++i) v[i] = v[i] + v[i - 1];
              LAS f32x4* sc = (LAS f32x4*)F.lds; f32x4 run = v[7];
              sc[tid] = run; __syncthreads();
              for (int off = 1, cur = 0; off < 512; off <<= 1, cur ^= 1) { f32x4 t = sc[cur * 512 + tid]; if (tid >= off) t = t + sc[cur * 512 + tid - off]; sc[(cur ^ 1) * 512 + tid] = t; __syncthreads(); run = t; }
              const f32x4 ex = run - v[7];
              float* kb = WSP(float, WS_KB) + (size_t)b * 4 * SEQ + 8 * tid;
#pragma unroll
              for (int e = 0; e < 4; ++e) { f32x4 lo, hi4;
#pragma unroll
                  for (int i = 0; i < 4; ++i) { lo[i] = -(ex[e] + v[i][e]) * LOG2E; hi4[i] = -(ex[e] + v[4 + i][e]) * LOG2E; }
                  *(f32x4*)(kb + (size_t)e * SEQ) = lo; *(f32x4*)(kb + (size_t)e * SEQ + 4) = hi4; }
              __syncthreads();
          } }
        }
        if (PH(5)) {
          const int gt2 = c * 512 + F.tid, hp = gt2 & 1;
          for (int t2 = gt2 >> 1; t2 < M; t2 += F.G * 256) { const bf16_t* Kp = WSP(const bf16_t, WS_P) + (size_t)t2 * PW + PC_CK + hp * 128; float s0 = 0.f, s1 = 0.f, s2 = 0.f;
              if (hp == 0) { const bf16_t* Rp = WSP(const bf16_t, WS_KROT) + (size_t)t2 * 32;
#pragma unroll
                  for (int q8 = 0; q8 < 4; ++q8) { const bf16x8 ra = *(const bf16x8*)(Rp + q8 * 8);
#pragma unroll
                      for (int e = 0; e < 8; ++e) { const float xa = bf2f((unsigned short)ra[e]); s2 += xa * xa; } } }
#pragma unroll
              for (int q8 = 0; q8 < 8; ++q8) { const bf16x8 ka = *(const bf16x8*)(Kp + q8 * 8), kb2 = *(const bf16x8*)(Kp + 64 + q8 * 8);
#pragma unroll
                  for (int e = 0; e < 8; ++e) { const float xa = bf2f((unsigned short)ka[e]), xb = bf2f((unsigned short)kb2[e]); s0 += xa * xa; s1 += xb * xb; } }
              s0 = fmaxf(s0, xor_lane_lt32<2>(s0)); s0 = fmaxf(s0, xor_lane_lt32<4>(s0)); s0 = fmaxf(s0, xor_lane_lt32<8>(s0)); s0 = fmaxf(s0, xor_lane_lt32<16>(s0));
              s1 = fmaxf(s1, xor_lane_lt32<2>(s1)); s1 = fmaxf(s1, xor_lane_lt32<4>(s1)); s1 = fmaxf(s1, xor_lane_lt32<8>(s1)); s1 = fmaxf(s1, xor_lane_lt32<16>(s1));
              { auto r0 = __builtin_amdgcn_permlane32_swap(__float_as_uint(s0), __float_as_uint(s0), false, false); s0 = fmaxf(__uint_as_float(r0[0]), __uint_as_float(r0[1]));
                auto r1 = __builtin_amdgcn_permlane32_swap(__float_as_uint(s1), __float_as_uint(s1), false, false); s1 = fmaxf(__uint_as_float(r1[0]), __uint_as_float(r1[1])); }
              float s3 = 0.f; { const bf16_t* Np = WSP(const bf16_t, WS_P) + (size_t)t2 * PW + (hp ? PC_KWIN : PC_KSLC);
#pragma unroll
                  for (int q8 = 0; q8 < 8; ++q8) { const bf16x8 na = *(const bf16x8*)(Np + q8 * 8);
#pragma unroll
                      for (int e = 0; e < 8; ++e) { const float xa = bf2f((unsigned short)na[e]); s3 += xa * xa; } } }
              float s4 = 0.f; { const bf16_t* Qp = WSP(const bf16_t, WS_P) + (size_t)t2 * PW + PC_AQ + hp * 128;
                  float sa = 0.f, sb = 0.f;
#pragma unroll
                  for (int q8 = 0; q8 < 8; ++q8) { const bf16x8 qa = *(const bf16x8*)(Qp + q8 * 8), qb2 = *(const bf16x8*)(Qp + 64 + q8 * 8);
#pragma unroll
                      for (int e = 0; e < 8; ++e) { const float xa = bf2f((unsigned short)qa[e]), xb = bf2f((unsigned short)qb2[e]); sa += xa * xa; sb += xb * xb; } }
                  s4 = fmaxf(sa, sb); }
              s4 = fmaxf(s4, xor_lane_lt32<1>(s4)); s4 = fmaxf(s4, xor_lane_lt32<2>(s4)); s4 = fmaxf(s4, xor_lane_lt32<4>(s4)); s4 = fmaxf(s4, xor_lane_lt32<8>(s4)); s4 = fmaxf(s4, xor_lane_lt32<16>(s4));
              { auto r4 = __builtin_amdgcn_permlane32_swap(__float_as_uint(s4), __float_as_uint(s4), false, false); s4 = fmaxf(__uint_as_float(r4[0]), __uint_as_float(r4[1])); }
              s3 = fmaxf(s3, xor_lane_lt32<2>(s3)); s3 = fmaxf(s3, xor_lane_lt32<4>(s3)); s3 = fmaxf(s3, xor_lane_lt32<8>(s3)); s3 = fmaxf(s3, xor_lane_lt32<16>(s3));
              { auto r3 = __builtin_amdgcn_permlane32_swap(__float_as_uint(s3), __float_as_uint(s3), false, false); s3 = fmaxf(__uint_as_float(r3[0]), __uint_as_float(r3[1])); }
              s2 = fmaxf(s2, xor_lane_lt32<2>(s2)); s2 = fmaxf(s2, xor_lane_lt32<4>(s2)); s2 = fmaxf(s2, xor_lane_lt32<8>(s2)); s2 = fmaxf(s2, xor_lane_lt32<16>(s2));
              { auto r2 = __builtin_amdgcn_permlane32_swap(__float_as_uint(s2), __float_as_uint(s2), false, false); s2 = fmaxf(__uint_as_float(r2[0]), __uint_as_float(r2[1])); }
              if (F.lane < 2) { unsigned* kw = (unsigned*)(F.ctl + CW_KMAX + 64 * l) + (t2 >> 12) * 4 + 2 * hp; atomicMax(kw, __float_as_uint(s0)); atomicMax(kw + 1, __float_as_uint(s1));
                  if (hp == 0) atomicMax((unsigned*)(F.ctl + CW_KROT + 16 * l) + (t2 >> 12), __float_as_uint(s2));
                  atomicMax((unsigned*)(F.ctl + CW_KNSA + 32 * l) + (t2 >> 12) * 2 + hp, __float_as_uint(s3));
                  if (hp == 0) atomicMax((unsigned*)(F.ctl + CW_QNSA + 16 * l) + (t2 >> 12), __float_as_uint(s4)); } } }
        xcd_barrier(bar, F.wave); TSTAMP(3);
        PHASE_FRESH();
        for (int rep = 0; rep < DUP_ATTN; ++rep) { gu32* ctr = F.ctl + CW_Q + 64 * l + 16 * rep;
          if (rep) xcd_barrier(bar, F.wave);
#define Q_T0 (F.wave == 0 && lane_now() == 0)
          const unsigned xq = xb_xcc_id() & 7u; unsigned kx = 0u;
#define Q_TAKE(dst) do { dst = 0xffffffffu; while (kx < 8u) { const unsigned li_ = (xq + kx) & 7u; const unsigned t_ = __hip_atomic_fetch_add(ctr + li_, 1u, __ATOMIC_RELAXED, __HIP_MEMORY_SCOPE_AGENT); \
              if (t_ < (unsigned)(ATT_UNITS / 8)) { dst = li_ * (unsigned)(ATT_UNITS / 8) + t_; break; } ++kx; } } while (0)
          unsigned nxtq = 0u; if (Q_T0) Q_TAKE(nxtq);
          for (;;) { if (Q_T0) F.MISC[0] = nxtq; __syncthreads(); const int iq = (int)F.MISC[0]; __syncthreads(); if ((unsigned)iq >= (unsigned)ATT_UNITS) break;
              if (Q_T0) Q_TAKE(nxtq);
              const int it = __builtin_amdgcn_readfirstlane(WSP(const int, WS_ORDER)[iq]);
              if (it < 2048 && PH(7)) { const int qb = 15 - (it >> 7), mla = (it >> 6) & 1, bh = it & 63; if (mla) { const gu32* km = F.ctl + CW_KMLA + 256 * l + bh * 4; const float k2 = __uint_as_float(__hip_atomic_load(km, __ATOMIC_RELAXED, __HIP_MEMORY_SCOPE_AGENT)) + __uint_as_float(__hip_atomic_load(km + 1, __ATOMIC_RELAXED, __HIP_MEMORY_SCOPE_AGENT)) + __uint_as_float(__hip_atomic_load(F.ctl + CW_KROT + 16 * l + (bh >> 2), __ATOMIC_RELAXED, __HIP_MEMORY_SCOPE_AGENT)); causal_unit<false>(F, bh >> 2, bh & 3, qb, sqrtf(k2) * 1.01f); } else causal_unit<true>(F, bh >> 2, bh & 3, qb, sqrtf(__uint_as_float(__hip_atomic_load(F.ctl + CW_KMAX + 64 * l + bh, __ATOMIC_RELAXED, __HIP_MEMORY_SCOPE_AGENT)))); }
              else if (it < 3072 && PH(8)) { const int r = it - 2048; const int bN = r & 15; const float qm2 = __uint_as_float(__hip_atomic_load(F.ctl + CW_QNSA + 16 * l + bN, __ATOMIC_RELAXED, __HIP_MEMORY_SCOPE_AGENT)), ka2 = __uint_as_float(__hip_atomic_load(F.ctl + CW_KNSA + 32 * l + bN * 2, __ATOMIC_RELAXED, __HIP_MEMORY_SCOPE_AGENT)), kb2 = __uint_as_float(__hip_atomic_load(F.ctl + CW_KNSA + 32 * l + bN * 2 + 1, __ATOMIC_RELAXED, __HIP_MEMORY_SCOPE_AGENT));
                  const float tmx = fmaxf(fmaxf(WSP(const float, WS_FARB)[4], WSP(const float, WS_FARB)[5]), fmaxf(WSP(const float, WS_FARB)[6], WSP(const float, WS_FARB)[7]));
                  const float kc2 = __uint_as_float(__hip_atomic_load(F.ctl + CW_KCMX + 16 * l + bN, __ATOMIC_RELAXED, __HIP_MEMORY_SCOPE_AGENT));
                  const bool fastB = (sqrtf(qm2) * sqrtf(fmaxf(ka2, kb2)) * 1.002f + tmx + 0.05f) <= 50.0f && (sqrtf(qm2) * sqrtf(kc2) * 1.02f + 0.05f) <= 50.0f;
                  if (__builtin_amdgcn_readfirstlane(fastB ? 1 : 0)) nsa_unit<true>(F, bN, 63 - (r >> 4), l); else nsa_unit<false>(F, bN, 63 - (r >> 4), l); }
              else if (it < 3328 && PH(9)) { const int r = it - 3072; dil_unit(F, r & 15, (r >> 4) & 1, r >> 5); } } }
        xcd_barrier(bar, F.wave); TSTAMP(5);
        for (int rep = 0; rep < DUP_MERGE; ++rep) if (PH(10)) { if (rep) xcd_barrier(bar, F.wave); SchedMerge S; S.T.init(256, 4, F.G, c); S.ocat = (const char*)(F.ws + WS_OCAT); S.h = (const char*)F.out + H8_OFF; S.wbr = (const char*)(wl + LW_BR); S.wg = (const char*)(wl + LW_G); S.dup = SDUP_MERGE;
          unsigned char* scr = F.ws + WS_MSCR + (size_t)c * MSCR_PER_WG;
          pg8::EpiMerge E{WSP(bf16_t, WS_MERGED), scr};
          pg8::gemm_phase<pg8::EpiMerge, SchedMerge, true, true>(F.lds, S, E, F.wave); }
        xcd_barrier(bar, F.wave); TSTAMP(6);
        if (PH(11)) { SchedSimple S; S.T.init(256, 4, F.G, c); S.A = (const char*)(F.ws + WS_MERGED); S.B = (const char*)(wl + LW_O); S.lda = 2048; S.ldb = 2048; S.nt = 16; S.dup = SDUP_WO;
          pg8::EpiBf16 E{WSP(bf16_t, WS_Y), DM};
          pg8::gemm_phase<pg8::EpiBf16, SchedSimple, true>(F.lds, S, E, F.wave); }
        xcd_barrier(bar, F.wave); TSTAMP(7);
        PHASE_FRESH();
        if (PH(12)) { if (l == 0) rowpass<1, false, true>(F, F.in[0], WSP(const bf16_t, WS_Y), 0, F.out, WSP(bf16_t, WS_H2), F.in[3] + l * DM, F.in[4] + l * DM, 0, M);
                      else rowpass<1, true, true>(F, F.out, WSP(const bf16_t, WS_Y), 0, WSP(bf16_t, WS_X3), WSP(bf16_t, WS_H2), F.in[3] + l * DM, F.in[4] + l * DM, 0, M); }
        xcd_barrier(bar, F.wave); TSTAMP(8);
#ifndef DUP_UP
#define DUP_UP 1
#endif
        _Pragma("unroll") for (int rep = 0; rep < DUP_UP; ++rep) if (PH(13)) { if (rep) xcd_barrier(bar, F.wave); SchedSimple S; S.T.init(256, 22, F.G, c); S.A = (const char*)(F.ws + WS_H2); S.B = (const char*)(wl + LW_UP); S.lda = 2048; S.ldb = 2048; S.nt = 16; S.dup = SDUP_UP;
          pg8::EpiUpConv E{WSP(bf16_t, WS_ACT), WSP(float, WS_HB), WSP(const float, WS_CWS) + (size_t)l * 4 * DFF2, WSP(const float, WS_CWS) + (size_t)l * 4 * DFF2 + 3 * DFF2};
          pg8::gemm_phase<pg8::EpiUpConv, SchedSimple, true>(F.lds, S, E, F.wave); }
        xcd_barrier(bar, F.wave); TSTAMP(9);
        PHASE_FRESH();
        if (PH(15)) { SchedSimple S; S.T.init(256, 4, F.G, c); S.A = (const char*)(F.ws + WS_ACT); S.B = (const char*)(wl + LW_DN); S.lda = DFF * 2; S.ldb = DFF * 2; S.nt = DFF / 64; S.dup = SDUP_DN;
          { int pm, pn; for (int i = 0; S.T.tile(i, pm, pn); ++i) ffn_fix_panel(F, pm, WSP(const float, WS_HB), WSP(bf16_t, WS_ACT), F.in[24] + (size_t)l * 3 * DFF2, F.in[25] + (size_t)l * DFF2); }
          VM_WAIT(); __syncthreads();
          pg8::EpiBf16 E{WSP(bf16_t, WS_Y2), DM};
          pg8::gemm_phase<pg8::EpiBf16, SchedSimple, true>(F.lds, S, E, F.wave); }
        xcd_barrier(bar, F.wave); TSTAMP(11);
        PHASE_FRESH();
        if (PH(16)) { if (l + 1 < DEPTH) rowpass<1, true, true, true>(F, F.out, WSP(const bf16_t, WS_Y2), 0, F.out, WSP(bf16_t, WS_H), F.in[5] + l * DM, F.in[2] + (l + 1) * DM, 0, M, (unsigned char*)F.out + H8_OFF);
                      else rowpass<2, true, false>(F, WSP(const bf16_t, WS_X3), WSP(const bf16_t, WS_Y2), 0, F.out, nullptr, F.in[5] + l * DM, nullptr, 0, M); }
        if (l + 1 < DEPTH) xcd_barrier(bar, F.wave);
        TSTAMP(12);
    }
}

extern "C" void kernel_launch(void* const* d_in, const int* in_sizes, int n_in, void* d_out, int out_size, void* d_ws, size_t ws_size, hipStream_t stream) {
    static int grid = 0;
    if (grid == 0) {
        if (n_in != 27 || in_sizes[0] != M * DM || out_size != M * DM || ws_size < WS_END) { fprintf(stderr, "kernel_launch: unexpected shapes (n_in %d, in0 %d, out %d, ws %zu)\n", n_in, n_in > 0 ? in_sizes[0] : -1, out_size, ws_size); grid = -1; return; }
        int dev = 0, cus = 0, per_cu = 0;
        if (hipGetDevice(&dev) != hipSuccess || hipDeviceGetAttribute(&cus, hipDeviceAttributeMultiprocessorCount, dev) != hipSuccess) { grid = -1; return; }
        if (hipFuncSetAttribute((const void*)hybrid_fwd, hipFuncAttributeMaxDynamicSharedMemorySize, LDS_BYTES) != hipSuccess) { fprintf(stderr, "kernel_launch: hipFuncSetAttribute failed\n"); grid = -1; return; }
        if (hipOccupancyMaxActiveBlocksPerMultiprocessor(&per_cu, (const void*)hybrid_fwd, 512, LDS_BYTES) != hipSuccess || per_cu < 1) fprintf(stderr, "kernel_launch: occupancy query says %d\n", per_cu);
        (void)hipGetLastError();
        grid = cus;
    }
    if (grid < 0) return;
    if (hipMemsetAsync((char*)d_ws + WS_CTL, 0, CTL_ZERO_BYTES, stream) != hipSuccess) return;
    Args a{};
    for (int i = 0; i < 27; ++i) a.in[i] = (const float*)d_in[i];
    a.out = (float*)d_out; a.ws = (unsigned char*)d_ws;
    hipLaunchKernelGGL(hybrid_fwd, dim3(grid), dim3(512), LDS_BYTES, stream, a);
}
```

```cpp
#include <hip/hip_runtime.h>
#include <hip/hip_bf16.h>
#include <cstdio>
#include <cstdint>
#include <cmath>

#define GAS __attribute__((address_space(1)))
#define LAS __attribute__((address_space(3)))
typedef unsigned short bf16_t;
typedef short bf16x8 __attribute__((ext_vector_type(8)));
typedef short s16x4 __attribute__((ext_vector_type(4)));
typedef float f32x4 __attribute__((ext_vector_type(4)));
typedef float f32x2 __attribute__((ext_vector_type(2)));
typedef float f32x16 __attribute__((ext_vector_type(16)));
typedef unsigned u32x4 __attribute__((ext_vector_type(4)));
typedef unsigned u32x2 __attribute__((ext_vector_type(2)));
typedef GAS unsigned gu32;

constexpr int BATCH = 16, SEQ = 4096, DM = 1024, M = BATCH * SEQ, DEPTH = 2;
constexpr int DIN = 2992, PW = 3072;
constexpr int DFF = 2816, DFF2 = 5632;
constexpr float LOG2E = 1.4426950408889634f;
constexpr float C2A = 0.125f * LOG2E;
constexpr float C2D = 0.10206207261596575f * LOG2E;
constexpr float RMS_EPS = 1e-6f;
constexpr float H8_SCALE = 0.5f, WG8_SCALE = -2.8853900817779268f;
constexpr int PC_AQ = 0, PC_KCMP = 256, PC_VCMP = 320, PC_KSLC = 384, PC_VSLC = 448, PC_KWIN = 512, PC_VWIN = 576,
              PC_MISC = 640, PC_KROPE = 672, PC_BQ = 768, PC_BK = 1152, PC_BV = 1536, PC_DKV = 1920,
              PC_CQ = 2048, PC_CK = 2304, PC_CV = 2560, PC_DQL = 2816;
constexpr int OCW = 896;
constexpr int NSA_DFAR = 1536, NSA_DMAX = 1664, NSA_TL = 1728;

__device__ __forceinline__ unsigned f2bf(float f) { unsigned u = __float_as_uint(f); return (u + 0x7fffu + ((u >> 16) & 1u)) >> 16; }
__device__ __forceinline__ unsigned pk2(float lo, float hi) { return f2bf(lo) | (f2bf(hi) << 16); }
__device__ __forceinline__ float bf2f(unsigned short b) { return __uint_as_float((unsigned)b << 16); }
typedef __bf16 bf16x2_t __attribute__((ext_vector_type(2)));
__device__ __forceinline__ unsigned cvtpk(float lo, float hi) { f32x2 v = {lo, hi}; bf16x2_t b = __builtin_convertvector(v, bf16x2_t); return __builtin_bit_cast(unsigned, b); }
__device__ __forceinline__ unsigned pk4_fp8(float a, float b, float c, float d) { int w = 0; w = __builtin_amdgcn_cvt_pk_fp8_f32(a, b, w, false); w = __builtin_amdgcn_cvt_pk_fp8_f32(c, d, w, true); return (unsigned)w; }
__device__ __forceinline__ float fast_exp2(float x) { return __builtin_amdgcn_exp2f(x); }
__device__ __forceinline__ float fast_rcp(float x) { return __builtin_amdgcn_rcpf(x); }
template <int MASK> __device__ __forceinline__ float xor_lane_lt32(float v) { return __uint_as_float(__builtin_amdgcn_ds_swizzle((int)__float_as_uint(v), (MASK << 10) | 0x1f)); }
__device__ __forceinline__ float sum_halves(float v) { auto rr = __builtin_amdgcn_permlane32_swap(__float_as_uint(v), __float_as_uint(v), false, false); return __uint_as_float(rr[0]) + __uint_as_float(rr[1]); }
__device__ __forceinline__ float sigmoid_f(float x) { return fast_rcp(1.0f + fast_exp2(-x * LOG2E)); }

__device__ __forceinline__ int lane_now() { int l; asm volatile("v_mbcnt_lo_u32_b32 %0, -1, 0\n\tv_mbcnt_hi_u32_b32 %0, -1, %0" : "=v"(l)); return l; }
namespace pg8 {
constexpr int BM = 256, BK = 64, HALF = 128, HTB = HALF * BK * 2  , STAGE_BYTES = 8 * HTB, NXCD = 8, WGM = 8;
__host__ __device__ __forceinline__ int lds_byte(int r, int c) { const int st = (r >> 4) * 2 + (c >> 5), rr = r & 15, cc = c & 31, ob = rr * 64 + cc * 2; return st * 1024 + (ob ^ (((ob >> 9) & 1) << 5)); }
__host__ __device__ __forceinline__ void stage_rc(int b, int& R, int& C) { const int st = b / 1024, sb = b % 1024, swz = sb ^ (((sb >> 9) & 1) << 5); R = (st >> 1) * 16 + swz / 64; C = (st & 1) * 32 + (swz % 64) / 2; }
__host__ __device__ __forceinline__ int perm32(int rho) { const int n = rho >> 4, i = rho & 15; return 8 * (i >> 2) + 4 * n + (i & 3); }

typedef int v8i_t __attribute__((ext_vector_type(8)));
typedef int v4i_t __attribute__((ext_vector_type(4)));
__device__ __forceinline__ v8i_t cat8(const bf16x8 lo, const bf16x8 hi) { const v4i_t a = __builtin_bit_cast(v4i_t, lo), b = __builtin_bit_cast(v4i_t, hi); return __builtin_shufflevector(a, b, 0, 1, 2, 3, 4, 5, 6, 7); }
struct GUnit { const char* A; const char* B; int lda, ldb, nt, pm, pn, id; };

struct TileOrder {
    int nM, nN, nwg, G, c;
    __device__ __forceinline__ void init(int nM_, int nN_, int G_, int c_) { nM = nM_; nN = nN_; nwg = nM * nN; G = G_; c = c_; }
    __device__ __forceinline__ bool tile(int i, int& pm, int& pn) const {
        const long L = (long)i * G + c; if (L >= nwg) return false;
        int wgid = (int)L; { const int q = nwg / NXCD, r = nwg % NXCD, xcd = wgid % NXCD, off = wgid / NXCD; wgid = (xcd < r ? xcd * (q + 1) : r * (q + 1) + (xcd - r) * q) + off; }
        const int nig = WGM * nN, gid = wgid / nig, fm = gid * WGM, gsz = (nM - fm) < WGM ? (nM - fm) : WGM;
        pm = fm + ((wgid % nig) % gsz); pn = (wgid % nig) / gsz; return true;
    }
};

template <class Epi, class Sched, bool ALIGN_EPI, bool F8 = false>
__device__ __forceinline__ void gemm_phase(LAS unsigned char* lds, const Sched& S, const Epi& E, int wave_id) {
    int tid_o = wave_id * 64 + lane_now();
    const int tid = tid_o, wid = __builtin_amdgcn_readfirstlane(tid >> 6), lane = tid & 63, wr = wid >> 2, wc = wid & 3; int fr = lane & 15, fq = lane >> 4;
    int sR[2], sC[2], sRb[2];
#pragma unroll
    for (int i = 0; i < 2; ++i) { stage_rc(tid * 16 + i * 8192, sR[i], sC[i]); sRb[i] = Epi::PERM ? ((sR[i] & ~31) + perm32(sR[i] & 31)) : sR[i]; sC[i] *= 2; }
    const size_t kstep = (size_t)(BK * 2);
    const unsigned ldsw = (unsigned)wid * 1024u;
    const int aoff = lds_byte(wr * 64 + fr, fq * 8), boff = lds_byte(wc * 32 + fr, fq * 8);
#define PG8_SA(b, h) (((b) * 2 + (h)) * HTB)
#define PG8_SB(b, h) ((4 + (b) * 2 + (h)) * HTB)
#define PG8_STAGE(bufoff, gbase, rows, ld) do { _Pragma("unroll") for (int _i = 0; _i < 2; ++_i) \
        __builtin_amdgcn_global_load_lds((const unsigned*)((const char*)(gbase) + (unsigned)((rows)[_i] * (ld) + sC[_i])), (LAS unsigned*)(lds + (bufoff) + ldsw + _i * 8192), 16, 0, 0); } while (0)
#define PG8_LDA(dst, b, h) do { _Pragma("unroll") for (int m = 0; m < 4; ++m) _Pragma("unroll") for (int k = 0; k < 2; ++k) dst[m][k] = *(const LAS bf16x8*)(lds + PG8_SA(b, h) + aoff + m * 2048 + k * 1024); } while (0)
#define PG8_LDB(dst, b, h) do { _Pragma("unroll") for (int n = 0; n < 2; ++n) _Pragma("unroll") for (int k = 0; k < 2; ++k) dst[n][k] = *(const LAS bf16x8*)(lds + PG8_SB(b, h) + boff + n * 2048 + k * 1024); } while (0)
#define PG8_MMA(ai, bj, At, Bt) do { __builtin_amdgcn_s_setprio(1); _Pragma("unroll") for (int m = 0; m < 4; ++m) _Pragma("unroll") for (int n = 0; n < 2; ++n) _Pragma("unroll") for (int k = 0; k < 2; ++k) \
        acc[ai][bj][m][n] = __builtin_amdgcn_mfma_f32_16x16x32_bf16(Bt[n][k], At[m][k], acc[ai][bj][m][n], 0, 0, 0); __builtin_amdgcn_s_setprio(0); } while (0)
#define PG8_LDA8(dst, b, h) do { _Pragma("unroll") for (int m = 0; m < 4; ++m) { dst[m].lo = *(const LAS v4i_t*)(lds + PG8_SA(b, h) + aoff + m * 2048); dst[m].hi = *(const LAS v4i_t*)(lds + PG8_SA(b, h) + aoff + m * 2048 + 1024); } } while (0)
#define PG8_LDB8(dst, b, h) do { _Pragma("unroll") for (int n = 0; n < 2; ++n) { dst[n].lo = *(const LAS v4i_t*)(lds + PG8_SB(b, h) + boff + n * 2048); dst[n].hi = *(const LAS v4i_t*)(lds + PG8_SB(b, h) + boff + n * 2048 + 1024); } } while (0)
#define PG8_MMA8(ai, bj, At, Bt) do { __builtin_amdgcn_s_setprio(1); _Pragma("unroll") for (int m = 0; m < 4; ++m) _Pragma("unroll") for (int n = 0; n < 2; ++n) \
        asm volatile("v_mfma_f32_16x16x128_f8f6f4 %0, %1, %2, %0" : "+v"(acc[ai][bj][m][n]) : "v"(Bt[n]), "v"(At[m])); __builtin_amdgcn_s_setprio(0); } while (0)
#define PG8_WAIT_V(n) asm volatile("s_waitcnt vmcnt(" #n ")" ::: "memory")
#define PG8_WAIT_L(n) asm volatile("s_waitcnt lgkmcnt(" #n ")" ::: "memory")
#define PG8_BAR __builtin_amdgcn_s_barrier()
#define PG8_SCHED __builtin_amdgcn_sched_barrier(0)
#define PG8_KLOOP(MM, LDA_, LDB_, At, B0, B1) for (int t = 0; t < nt; t += 2) { \
            const bool last = (t == nt - 2); \
            const char* a1 = cA + (size_t)(t + 1) * kstep; \
            const char* a2 = last ? nA : cA + (size_t)(t + 2) * kstep; const char* b2 = last ? nB : cB + (size_t)(t + 2) * kstep; \
            const char* a3 = a2 + kstep; const char* b3 = b2 + kstep; \
            const int ldA2 = last ? ldAn : ldAc, ldB2 = last ? ldBn : ldBc; \
            const size_t hA2 = last ? hAn : hAc, hB2 = last ? hBn : hBc; \
              \
            LDB_(B0, 0, 0); LDB_(B1, 0, 1); PG8_SCHED; LDA_(At, 0, 0); PG8_STAGE(PG8_SA(1, 1), a1 + hAc, sR, ldAc); \
            PG8_WAIT_V(8); PG8_WAIT_L(0); PG8_BAR; MM(0, 0, At, B0); MM(0, 1, At, B1); PG8_BAR; PG8_SCHED; \
              \
            LDA_(At, 0, 1); PG8_STAGE(PG8_SB(0, 0), b2, sRb, ldB2); PG8_STAGE(PG8_SB(0, 1), b2 + hB2, sRb, ldB2); PG8_STAGE(PG8_SA(0, 0), a2, sR, ldA2); \
            PG8_WAIT_V(8); PG8_WAIT_L(0); PG8_BAR; MM(1, 0, At, B0); MM(1, 1, At, B1); PG8_BAR; PG8_SCHED; \
              \
            LDB_(B0, 1, 0); LDB_(B1, 1, 1); PG8_SCHED; LDA_(At, 1, 0); PG8_STAGE(PG8_SA(0, 1), a2 + hA2, sR, ldA2); \
            PG8_WAIT_V(8); PG8_WAIT_L(0); PG8_BAR; MM(0, 0, At, B0); MM(0, 1, At, B1); PG8_BAR; PG8_SCHED; \
              \
            LDA_(At, 1, 1); PG8_STAGE(PG8_SB(1, 0), b3, sRb, ldB2); PG8_STAGE(PG8_SB(1, 1), b3 + hB2, sRb, ldB2); PG8_STAGE(PG8_SA(1, 0), a3, sR, ldA2); \
            PG8_WAIT_V(8); PG8_WAIT_L(0); PG8_BAR; MM(1, 0, At, B0); MM(1, 1, At, B1); PG8_BAR; PG8_SCHED; \
        }
    GUnit cur, nxt; int ui = 0;
    if (!S.next(0, cur)) return;
    f32x4 acc[2][2][4][2];
#pragma unroll
    for (int a = 0; a < 2; ++a)
#pragma unroll
        for (int b = 0; b < 2; ++b)
#pragma unroll
            for (int m = 0; m < 4; ++m)
#pragma unroll
                for (int n = 0; n < 2; ++n) acc[a][b][m][n] = (f32x4){0.f, 0.f, 0.f, 0.f};
    bf16x8 At[4][2], B0[2][2], B1[2][2]; v8i_t At8[4], B08[2], B18[2];
    int ldAc = cur.lda, ldBc = cur.ldb; size_t hAc = (size_t)HALF * ldAc, hBc = (size_t)HALF * ldBc;
    const char* cA = cur.A; const char* cB = cur.B;
    PG8_STAGE(PG8_SB(0, 0), cB, sRb, ldBc); PG8_STAGE(PG8_SB(0, 1), cB + hBc, sRb, ldBc); PG8_STAGE(PG8_SA(0, 0), cA, sR, ldAc); PG8_STAGE(PG8_SA(0, 1), cA + hAc, sR, ldAc);
    if (wr == 1) PG8_BAR;
    PG8_WAIT_V(2); PG8_BAR;
    PG8_STAGE(PG8_SB(1, 0), cB + kstep, sRb, ldBc); PG8_STAGE(PG8_SA(1, 0), cA + kstep, sR, ldAc); PG8_STAGE(PG8_SB(1, 1), cB + hBc + kstep, sRb, ldBc);
    PG8_WAIT_V(6); PG8_BAR;
    for (;;) {
        const bool has_next = S.next(ui + 1, nxt);
        int ldAn, ldBn; const char* nA; const char* nB;
        if (has_next) { ldAn = nxt.lda; ldBn = nxt.ldb; nA = nxt.A; nB = nxt.B; } else { ldAn = ldAc; ldBn = ldBc; nA = cA; nB = cB; }
        const size_t hAn = (size_t)HALF * ldAn, hBn = (size_t)HALF * ldBn;
        int nt = cur.nt; asm volatile("" : "+s"(nt));
        bool f8u = false; if constexpr (F8) f8u = Epi::f8(cur);
        if (F8 && f8u) { PG8_KLOOP(PG8_MMA8, PG8_LDA8, PG8_LDB8, At8, B08, B18) asm volatile("s_nop 15\n\ts_nop 15" ::: "memory"); }
        else { PG8_KLOOP(PG8_MMA, PG8_LDA, PG8_LDB, At, B0, B1) }
        if constexpr (ALIGN_EPI) { if (wr == 0) PG8_BAR; }
        E(acc, cur, wr, wc, fr, fq);
        if (!has_next) break;
#pragma unroll
        for (int a = 0; a < 2; ++a)
#pragma unroll
            for (int b = 0; b < 2; ++b)
#pragma unroll
                for (int m = 0; m < 4; ++m)
#pragma unroll
                    for (int n = 0; n < 2; ++n) acc[a][b][m][n] = (f32x4){0.f, 0.f, 0.f, 0.f};
        cur = nxt; cA = nA; cB = nB; ++ui;
        ldAc = ldAn; ldBc = ldBn; hAc = hAn; hBc = hBn;
        if constexpr (ALIGN_EPI) { if (wr == 1) PG8_BAR; }
    }
    PG8_WAIT_V(0);
    if constexpr (!ALIGN_EPI) { if (wr == 0) PG8_BAR; }
    PG8_BAR;
#undef PG8_SA
#undef PG8_SB
#undef PG8_STAGE
#undef PG8_LDA
#undef PG8_LDB
#undef PG8_MMA
#undef PG8_MMA8
#undef PG8_LDA8
#undef PG8_LDB8
#undef PG8_KLOOP
#undef PG8_WAIT_V
#undef PG8_WAIT_L
#undef PG8_BAR
#undef PG8_SCHED
}
}
using pg8::GUnit;
namespace pg8 {
#define EPI_OPAQUE() asm volatile("" : "+v"(fr), "+v"(fq))
struct EpiBf16 {
    static constexpr bool PERM = true;
    bf16_t* O; int ldc;
    __device__ __forceinline__ void operator()(const f32x4 (&acc)[2][2][4][2], const GUnit& u, int wr, int wc, int fr, int fq) const {
        EPI_OPAQUE();
        const int row0 = u.pm * BM + wr * 64 + fr, col0 = u.pn * BM + wc * 32 + 8 * fq;
#pragma unroll
        for (int ai = 0; ai < 2; ++ai)
#pragma unroll
            for (int m = 0; m < 4; ++m) { bf16_t* rowp = O + (size_t)(row0 + ai * HALF + m * 16) * ldc + col0;
#pragma unroll
                for (int bj = 0; bj < 2; ++bj) { const f32x4 v0 = acc[ai][bj][m][0], v1 = acc[ai][bj][m][1];
                    u32x4 w; w.x = cvtpk(v0[0], v0[1]); w.y = cvtpk(v0[2], v0[3]); w.z = cvtpk(v1[0], v1[1]); w.w = cvtpk(v1[2], v1[3]);
                    *(u32x4*)(rowp + bj * HALF) = w; } }
    }
};
struct EpiF32 {
    static constexpr bool PERM = false;
    float* O; int ldc;
    __device__ __forceinline__ void operator()(const f32x4 (&acc)[2][2][4][2], const GUnit& u, int wr, int wc, int fr, int fq) const {
        EPI_OPAQUE();
        const int row0 = u.pm * BM + wr * 64 + fr, col0 = u.pn * BM + wc * 32 + 4 * fq;
#pragma unroll
        for (int ai = 0; ai < 2; ++ai)
#pragma unroll
            for (int m = 0; m < 4; ++m) { float* rowp = O + (size_t)(row0 + ai * HALF + m * 16) * ldc + col0;
#pragma unroll
                for (int bj = 0; bj < 2; ++bj)
#pragma unroll
                    for (int n = 0; n < 2; ++n) *(f32x4*)(rowp + bj * HALF + n * 16) = acc[ai][bj][m][n]; }
    }
};
__device__ __forceinline__ void rope8(f32x4& v0, f32x4& v1, const float* cs  ) {
    const f32x4 a = *(const f32x4*)cs, b = *(const f32x4*)(cs + 4);
    f32x4 r0, r1;
    r0[0] = v0[0] * a[0] - v0[1] * a[1]; r0[1] = v0[1] * a[0] + v0[0] * a[1];
    r0[2] = v0[2] * a[2] - v0[3] * a[3]; r0[3] = v0[3] * a[2] + v0[2] * a[3];
    r1[0] = v1[0] * b[0] - v1[1] * b[1]; r1[1] = v1[1] * b[0] + v1[0] * b[1];
    r1[2] = v1[2] * b[2] - v1[3] * b[3]; r1[3] = v1[3] * b[2] + v1[2] * b[3];
    v0 = r0; v1 = r1;
}
struct EpiInProj {
    static constexpr bool PERM = true;
    bf16_t* P; bf16_t* kcmp; bf16_t* vcmp; float* side; bf16_t* krot; const float* rope; float* ssq_q; float* ssq_kv; const float* fbias; float* lf;
    __device__ __forceinline__ void operator()(const f32x4 (&acc)[2][2][4][2], const GUnit& u, int wr, int wc, int fr, int fq) const {
        EPI_OPAQUE();
        const int row0 = u.pm * BM + wr * 64 + fr, col0 = u.pn * BM + wc * 32 + 8 * fq;
#pragma unroll
        for (int ai = 0; ai < 2; ++ai)
#pragma unroll
            for (int m = 0; m < 4; ++m) { const int row = row0 + ai * HALF + m * 16; bf16_t* rowp = P + (size_t)row * PW + col0;
                float ssq = 0.f;
#pragma unroll
                for (int bj = 0; bj < 2; ++bj) { f32x4 v0 = acc[ai][bj][m][0], v1 = acc[ai][bj][m][1];
                    if (u.pn == 2 && bj == 1) {
                        if (wc == 0 && fq < 2) { float* sp = side + (size_t)row * 16 + 8 * fq; *(f32x4*)sp = v0; *(f32x4*)(sp + 4) = v1; }
                        if (wc == 1) { rope8(v0, v1, rope + (size_t)(row & (SEQ - 1)) * 32 + 8 * fq);
                            u32x4 w; w.x = cvtpk(v0[0], v0[1]); w.y = cvtpk(v0[2], v0[3]); w.z = cvtpk(v1[0], v1[1]); w.w = cvtpk(v1[2], v1[3]);
                            *(u32x4*)(krot + (size_t)row * 32 + 8 * fq) = w; }
                    }
                    u32x4 w; w.x = cvtpk(v0[0], v0[1]); w.y = cvtpk(v0[2], v0[3]); w.z = cvtpk(v1[0], v1[1]); w.w = cvtpk(v1[2], v1[3]);
                    *(u32x4*)(rowp + bj * HALF) = w;
                    if (u.pn == 1 && bj == 0) { bf16_t* cp = (wc < 2 ? kcmp : vcmp) + (size_t)row * 64 + (wc & 1) * 32 + 8 * fq; *(u32x4*)cp = w; }
                    if (u.pn == 11 || (u.pn == 7 && bj == 1)) ssq += (v0[0] * v0[0] + v0[1] * v0[1]) + (v0[2] * v0[2] + v0[3] * v0[3]) + (v1[0] * v1[0] + v1[1] * v1[1]) + (v1[2] * v1[2] + v1[3] * v1[3]);
                }
                if (u.pn == 11 || u.pn == 7) { ssq += xor_lane_lt32<16>(ssq); ssq = sum_halves(ssq);
                    if (fq == 0) (u.pn == 11 ? ssq_q : ssq_kv)[(size_t)row * 4 + wc] = ssq; }
                asm volatile("" ::: "memory");
            }
    }
};
struct EpiQup {
    static constexpr bool PERM = true;
    bf16_t* O; const float* ssq_q; const float* rope;
    __device__ __forceinline__ void operator()(const f32x4 (&acc)[2][2][4][2], const GUnit& u, int wr, int wc, int fr, int fq) const {
        EPI_OPAQUE();
        const int row0 = u.pm * BM + wr * 64 + fr, col0 = u.pn * BM + wc * 32 + 8 * fq;
#pragma unroll
        for (int ai = 0; ai < 2; ++ai)
#pragma unroll
            for (int m = 0; m < 4; ++m) { const int row = row0 + ai * HALF + m * 16; bf16_t* rowp = O + (size_t)row * 512 + col0;
                const f32x4 pq = *(const f32x4*)(ssq_q + (size_t)row * 4);
                const float rstd = 1.0f / sqrtf(((pq[0] + pq[1]) + (pq[2] + pq[3])) * (1.0f / 256.0f) + RMS_EPS);
#pragma unroll
                for (int bj = 0; bj < 2; ++bj) { f32x4 v0 = acc[ai][bj][m][0] * rstd, v1 = acc[ai][bj][m][1] * rstd;
                    const int c8 = col0 + bj * HALF, within = c8 % 96;
                    if (c8 < 384 && within >= 64) rope8(v0, v1, rope + (size_t)(row & (SEQ - 1)) * 32 + (within - 64));
                    u32x4 w; w.x = cvtpk(v0[0], v0[1]); w.y = cvtpk(v0[2], v0[3]); w.z = cvtpk(v1[0], v1[1]); w.w = cvtpk(v1[2], v1[3]);
                    *(u32x4*)(rowp + bj * HALF) = w; }
                asm volatile("" ::: "memory"); }
    }
};
struct EpiKVup {
    static constexpr bool PERM = true;
    bf16_t* O; const float* ssq_kv; unsigned* kmx;
    __device__ __forceinline__ void operator()(const f32x4 (&acc)[2][2][4][2], const GUnit& u, int wr, int wc, int fr, int fq) const {
        EPI_OPAQUE();
        const int row0 = u.pm * BM + wr * 64 + fr, col0 = u.pn * BM + wc * 32 + 8 * fq;
        float mk0 = 0.f, mk1 = 0.f;
#pragma unroll
        for (int ai = 0; ai < 2; ++ai)
#pragma unroll
            for (int m = 0; m < 4; ++m) { const int row = row0 + ai * HALF + m * 16; bf16_t* rowp = O + (size_t)row * 512 + col0;
                const f32x4 pq = *(const f32x4*)(ssq_kv + (size_t)row * 4);
                const float rstd = 1.0f / sqrtf(((pq[0] + pq[1]) + (pq[2] + pq[3])) * (1.0f / 128.0f) + RMS_EPS);
#pragma unroll
                for (int bj = 0; bj < 2; ++bj) { const f32x4 v0 = acc[ai][bj][m][0] * rstd, v1 = acc[ai][bj][m][1] * rstd;
                    u32x4 w; w.x = cvtpk(v0[0], v0[1]); w.y = cvtpk(v0[2], v0[3]); w.z = cvtpk(v1[0], v1[1]); w.w = cvtpk(v1[2], v1[3]);
                    *(u32x4*)(rowp + bj * HALF) = w;
                    if (wc < 2) { float ss = ((v0[0] * v0[0] + v0[1] * v0[1]) + (v0[2] * v0[2] + v0[3] * v0[3])) + ((v1[0] * v1[0] + v1[1] * v1[1]) + (v1[2] * v1[2] + v1[3] * v1[3]));
                        ss += xor_lane_lt32<16>(ss); ss = sum_halves(ss); if (bj == 0) mk0 = fmaxf(mk0, ss); else mk1 = fmaxf(mk1, ss); } }
                asm volatile("" ::: "memory"); }
        if (wc < 2) {
            mk0 = fmaxf(mk0, xor_lane_lt32<1>(mk0)); mk0 = fmaxf(mk0, xor_lane_lt32<2>(mk0)); mk0 = fmaxf(mk0, xor_lane_lt32<4>(mk0)); mk0 = fmaxf(mk0, xor_lane_lt32<8>(mk0));
            mk1 = fmaxf(mk1, xor_lane_lt32<1>(mk1)); mk1 = fmaxf(mk1, xor_lane_lt32<2>(mk1)); mk1 = fmaxf(mk1, xor_lane_lt32<4>(mk1)); mk1 = fmaxf(mk1, xor_lane_lt32<8>(mk1));
            if (fr == 0 && fq == 0) { unsigned* kw = kmx + ((u.pm >> 4) * 4 + 2 * u.pn) * 4 + wc; atomicMax(kw, __float_as_uint(mk0)); atomicMax(kw + 4, __float_as_uint(mk1)); }
        }
    }
};
__device__ __forceinline__ float gelu_tanh(float x) { const float u2 = 2.0f * 0.7978845608028654f * (x + 0.044715f * x * x * x); return x * fast_rcp(1.0f + fast_exp2(-u2 * LOG2E)); }
struct EpiCmp1 {
    static constexpr bool PERM = true;
    bf16_t* O; const float* bias1;
    __device__ __forceinline__ void operator()(const f32x4 (&acc)[2][2][4][2], const GUnit& u, int wr, int wc, int fr, int fq) const {
        EPI_OPAQUE();
        const int row0 = u.pm * BM + wr * 64 + fr, col0 = wc * 32 + 8 * fq;
        f32x4 bv[2][2];
#pragma unroll
        for (int bj = 0; bj < 2; ++bj)
#pragma unroll
            for (int n = 0; n < 2; ++n) bv[bj][n] = *(const f32x4*)(bias1 + col0 + bj * HALF + 4 * n);
#pragma unroll
        for (int ai = 0; ai < 2; ++ai)
#pragma unroll
            for (int m = 0; m < 4; ++m) { bf16_t* rowp = O + (size_t)(row0 + ai * HALF + m * 16) * 256 + col0;
#pragma unroll
                for (int bj = 0; bj < 2; ++bj) { f32x4 v0 = acc[ai][bj][m][0] + bv[bj][0], v1 = acc[ai][bj][m][1] + bv[bj][1];
#pragma unroll
                    for (int e = 0; e < 4; ++e) { v0[e] = gelu_tanh(v0[e]); v1[e] = gelu_tanh(v1[e]); }
                    u32x4 w; w.x = cvtpk(v0[0], v0[1]); w.y = cvtpk(v0[2], v0[3]); w.z = cvtpk(v1[0], v1[1]); w.w = cvtpk(v1[2], v1[3]);
                    *(u32x4*)(rowp + bj * HALF) = w; } }
    }
};
typedef __amdgpu_buffer_rsrc_t rsrc_t;
struct EpiMerge {
    __device__ static __forceinline__ bool f8(const GUnit& u) { return u.id >= 4; }
    static constexpr bool PERM = true;
    bf16_t* O;
    unsigned char* scr;
    __device__ __forceinline__ void operator()(const f32x4 (&acc)[2][2][4][2], const GUnit& u, int wr, int wc, int fr, int fq) const {
        EPI_OPAQUE();
        const int tid = (wr * 4 + wc) * 64 + fq * 16 + fr;
        const int sub = u.id;
        const rsrc_t rs = __builtin_amdgcn_make_buffer_rsrc(scr, 0, 524288, 0x00020000);
        if (sub < 4) {
#pragma unroll
            for (int ai = 0; ai < 2; ++ai)
#pragma unroll
                for (int bj = 0; bj < 2; ++bj)
#pragma unroll
                    for (int m = 0; m < 4; ++m)
#pragma unroll
                        for (int n = 0; n < 2; ++n) { const int q = ((ai * 2 + bj) * 4 + m) * 2 + n; const f32x4 v = acc[ai][bj][m][n];
                            u32x2 w; w.x = cvtpk(v[0], v[1]); w.y = cvtpk(v[2], v[3]);
                            __builtin_amdgcn_raw_buffer_store_b64(w, rs, tid * 8, (sub * 32 + q) * 4096, 0); }
            return;
        }
        const int j = sub - 4;
        const int row0 = u.pm * BM + wr * 64 + fr, col0 = u.pn * BM + 64 * j + wc * 16 + 4 * fq;
#pragma unroll
        for (int ai = 0; ai < 2; ++ai) {
            u32x2 sv[4][4];
#pragma unroll
            for (int m = 0; m < 4; ++m)
#pragma unroll
                for (int g = 0; g < 4; ++g) { const int qb = (ai * 16 + m * 2);
                    sv[m][g] = (j == 0) ? __builtin_amdgcn_raw_buffer_load_b64(rs, tid * 8, (g * 32 + qb) * 4096, 0)
                             : (j == 1) ? __builtin_amdgcn_raw_buffer_load_b64(rs, tid * 8, (g * 32 + qb + 1) * 4096, 0)
                             : (j == 2) ? __builtin_amdgcn_raw_buffer_load_b64(rs, tid * 8, (g * 32 + qb + 8) * 4096, 0)
                                        : __builtin_amdgcn_raw_buffer_load_b64(rs, tid * 8, (g * 32 + qb + 9) * 4096, 0); }
#pragma unroll
            for (int m = 0; m < 4; ++m) { bf16_t* rowp = O + (size_t)(row0 + ai * HALF + m * 16) * DM + col0;
                f32x4 t = {0.f, 0.f, 0.f, 0.f};
#pragma unroll
                for (int g = 0; g < 4; ++g) { const f32x4 gt = acc[ai][g >> 1][m][g & 1]; const u32x2 s = sv[m][g];
                    t[0] += fast_rcp(1.0f + fast_exp2(gt[0])) * __uint_as_float(s.x << 16); t[1] += fast_rcp(1.0f + fast_exp2(gt[1])) * __uint_as_float(s.x & 0xffff0000u);
                    t[2] += fast_rcp(1.0f + fast_exp2(gt[2])) * __uint_as_float(s.y << 16); t[3] += fast_rcp(1.0f + fast_exp2(gt[3])) * __uint_as_float(s.y & 0xffff0000u); }
                u32x2 w; w.x = cvtpk(t[0], t[1]); w.y = cvtpk(t[2], t[3]);
                *(u32x2*)rowp = w; }
            asm volatile("" ::: "memory"); }
    }
};
__device__ __forceinline__ float dpp_ror1(float v) { return __uint_as_float((unsigned)__builtin_amdgcn_mov_dpp((int)__float_as_uint(v), 0x121, 0xf, 0xf, false)); }
__device__ __forceinline__ float dpp_ror2(float v) { return __uint_as_float((unsigned)__builtin_amdgcn_mov_dpp((int)__float_as_uint(v), 0x122, 0xf, 0xf, false)); }
struct EpiUpConv {
    static constexpr int KIND = 8;
    static constexpr bool PERM = true;
    bf16_t* ACT; float* HB; const float* cw; const float* cb;
    __device__ __forceinline__ void operator()(const f32x4 (&acc)[2][2][4][2], const GUnit& u, int wr, int wc, int fr, int fq) const {
        EPI_OPAQUE();
        const int colL = wc * 32 + 8 * fq;
        const bool l0 = (fr == 0), l01 = (fr < 2);
#pragma unroll
        for (int n = 0; n < 2; ++n) {
            const int cl = colL + 4 * n, c0 = u.pn * 128 + cl;
            const f32x4 bg = *(const f32x4*)(cb + c0), w0g = *(const f32x4*)(cw + c0), w1g = *(const f32x4*)(cw + DFF2 + c0), w2g = *(const f32x4*)(cw + 2 * DFF2 + c0);
            const f32x4 bv = *(const f32x4*)(cb + DFF + c0), w0v = *(const f32x4*)(cw + DFF + c0), w1v = *(const f32x4*)(cw + DFF2 + DFF + c0), w2v = *(const f32x4*)(cw + 2 * DFF2 + DFF + c0);
            f32x4 w1ga, w1gb, w0ga, w0gb, w1va, w1vb, w0va, w0vb;
#pragma unroll
            for (int e = 0; e < 4; ++e) { w1ga[e] = l0 ? 0.f : w1g[e]; w1gb[e] = l0 ? w1g[e] : 0.f; w0ga[e] = l01 ? 0.f : w0g[e]; w0gb[e] = l01 ? w0g[e] : 0.f;
                                          w1va[e] = l0 ? 0.f : w1v[e]; w1vb[e] = l0 ? w1v[e] : 0.f; w0va[e] = l01 ? 0.f : w0v[e]; w0vb[e] = l01 ? w0v[e] : 0.f; }
#pragma unroll
            for (int ai = 0; ai < 2; ++ai) {
                const int rowg = u.pm * BM + ai * HALF + wr * 64, g = rowg >> 6;
#pragma unroll
                for (int m = 0; m < 4; ++m) {
                    const f32x4 cg = acc[ai][0][m][n], cv = acc[ai][1][m][n];
                    f32x4 o;
#pragma unroll
                    for (int e = 0; e < 4; ++e) {
                        float gt = fmaf(w2g[e], cg[e], bg[e]), vl = fmaf(w2v[e], cv[e], bv[e]);
                        gt = fmaf(dpp_ror1(cg[e]), w1ga[e], gt); gt = fmaf(dpp_ror2(cg[e]), w0ga[e], gt);
                        vl = fmaf(dpp_ror1(cv[e]), w1va[e], vl); vl = fmaf(dpp_ror2(cv[e]), w0va[e], vl);
                        if (m > 0) { const float pg = acc[ai][0][m - 1][n][e], pv = acc[ai][1][m - 1][n][e];
                            gt = fmaf(dpp_ror1(pg), w1gb[e], gt); gt = fmaf(dpp_ror2(pg), w0gb[e], gt);
                            vl = fmaf(dpp_ror1(pv), w1vb[e], vl); vl = fmaf(dpp_ror2(pv), w0vb[e], vl); }
                        o[e] = (gt * vl) * fast_rcp(1.0f + fast_exp2(gt)); }
                    const int row = rowg + m * 16 + fr;
                    if (!(m == 0 && fr < 2)) { u32x2 w; w.x = cvtpk(o[0], o[1]); w.y = cvtpk(o[2], o[3]); *(u32x2*)(ACT + (size_t)row * DFF + c0) = w; }
                    if (m == 0 && fr < 2) { float* hp = HB + ((size_t)((g * 4 + fr) * 22 + u.pn) * 256 + cl); *(f32x4*)hp = cg; *(f32x4*)(hp + 128) = cv; }
                    if (m == 3 && fr >= 14) { float* hp = HB + ((size_t)((g * 4 + fr - 12) * 22 + u.pn) * 256 + cl); *(f32x4*)hp = cg; *(f32x4*)(hp + 128) = cv; }
                }
            }
            asm volatile("" ::: "memory");
        }
    }
};
}
#define XB_TMO      128
#define XB_XCNT(j)  (256  + 64 * (j))
#define XB_XSUB(j)  (1280 + 64 * (j))
#define XB_XGEN(j)  (2304 + 64 * (j))
#define XB_TOP      3328
#define XB_TOPGEN   3392
#define XCD_BAR_WORDS 3456
#define XB_SPIN_CAP (1u << 22)
__device__ __forceinline__ unsigned xb_ld(unsigned* p)              { return __hip_atomic_load(p, __ATOMIC_RELAXED, __HIP_MEMORY_SCOPE_AGENT); }
__device__ __forceinline__ unsigned xb_add(unsigned* p, unsigned v) { return __hip_atomic_fetch_add(p, v, __ATOMIC_RELAXED, __HIP_MEMORY_SCOPE_AGENT); }
__device__ __forceinline__ unsigned xb_xcc_id() { return (unsigned)__builtin_amdgcn_s_getreg((3 << 11) | 20) & 0xFu; }
#define XB_SPIN(cond, bar) do { unsigned _sp = 0; while (cond) { __builtin_amdgcn_s_sleep(1); \
    if ((++_sp & 255u) == 0u) { if (xb_ld(&(bar)[XB_TMO])) break; if (_sp > XB_SPIN_CAP) { atomicAdd(&(bar)[XB_TMO], 1u); break; } } } } while (0)
struct XcdBarrier { unsigned* bar; unsigned x; volatile LAS unsigned* st; };
__device__ __forceinline__ XcdBarrier xcd_barrier_post(unsigned* bar, volatile LAS unsigned* st) {
    XcdBarrier b; b.bar = bar; b.x = xb_xcc_id(); b.st = st;
    if (threadIdx.x == 0) (void)xb_add(&bar[XB_XCNT(b.x)], 1u);
    return b;
}
__device__ __forceinline__ void xcd_barrier_complete(unsigned* bar, unsigned x, unsigned& nloc, unsigned& nx) {
    const unsigned G = gridDim.x * gridDim.y * gridDim.z;
    unsigned sum, cnt, mine, sp = 0u;
    for (;;) {
        sum = 0u; cnt = 0u; mine = 0u;
#pragma unroll
        for (unsigned j = 0; j < 16; ++j) { const unsigned c = xb_ld(&bar[XB_XCNT(j)]); sum += c; cnt += (c > 0u) ? 1u : 0u; mine = (j == x) ? c : mine; }
        if (sum == G) break;
        __builtin_amdgcn_s_sleep(1);
        if ((++sp & 255u) == 0u) { if (xb_ld(&bar[XB_TMO])) break; if (sp > XB_SPIN_CAP) { atomicAdd(&bar[XB_TMO], 1u); break; } }
    }
    nloc = mine > 0u ? mine : 1u; nx = cnt > 0u ? cnt : 1u;
}
__device__ __forceinline__ void xcd_barrier(const XcdBarrier& b, int wave_id) {
    asm volatile("s_waitcnt vmcnt(0)" ::: "memory");
    __syncthreads();
    if (wave_id == 0 && lane_now() == 0) {
        unsigned* bar = b.bar; unsigned bx = b.x;
        asm volatile("" : "+s"(bx));
        __builtin_amdgcn_s_waitcnt(0);
        unsigned nloc = b.st[0], nx = b.st[1];
        if (nloc == 0u) { xcd_barrier_complete(bar, bx, nloc, nx); b.st[0] = nloc; b.st[1] = nx; }
        const unsigned old = xb_add(&bar[XB_XSUB(bx)], 1u);
        const unsigned gen = old / nloc;
        if (old + 1u == (gen + 1u) * nloc) {
            __builtin_amdgcn_fence(__ATOMIC_RELEASE, "agent");
            asm volatile("s_waitcnt vmcnt(0)" ::: "memory");
            const unsigned og = xb_add(&bar[XB_TOP], 1u);
            const unsigned tg = og / nx;
            if (og + 1u == (tg + 1u) * nx) xb_add(&bar[XB_TOPGEN], 1u);
            else XB_SPIN(xb_ld(&bar[XB_TOPGEN]) == tg, bar);
            __builtin_amdgcn_fence(__ATOMIC_ACQUIRE, "agent");
            xb_add(&bar[XB_XGEN(bx)], 1u);
            asm volatile("s_waitcnt vmcnt(0)" ::: "memory");
        } else {
            XB_SPIN(xb_ld(&bar[XB_XGEN(bx)]) == gen, bar);
            __builtin_amdgcn_fence(__ATOMIC_ACQUIRE, "agent");
            asm volatile("s_waitcnt vmcnt(0)" ::: "memory");
        }
    }
    __syncthreads();
}

#define MFMA32(a, b, c) __builtin_amdgcn_mfma_f32_32x32x16_bf16(a, b, c, 0, 0, 0)
typedef short v4i16_t __attribute__((ext_vector_type(4)));
typedef LAS const char* lds_cptr;
typedef LAS char* lds_ptr;
__device__ __forceinline__ int crow(int r, int hi) { return (r & 3) + 8 * (r >> 2) + 4 * hi; }
__device__ __forceinline__ s16x4 vtr(lds_cptr p) { return __builtin_bit_cast(s16x4, __builtin_amdgcn_ds_read_tr16_b64_v4i16((LAS v4i16_t*)p)); }
__device__ __forceinline__ float other_half(float x, int hi) { auto rr = __builtin_amdgcn_permlane32_swap(__float_as_uint(x), __float_as_uint(x), false, false); return __uint_as_float(hi ? rr[0] : rr[1]); }
constexpr float NEG_INF = -INFINITY;

constexpr int TB_V = 12288, TB_KB = 20480, TB_SIZE = 20992;
struct Stg { u32x4 k, k2, v; float kb; };

template <int NKS> __device__ __forceinline__ void qk64(lds_cptr kbuf, const bf16x8* qf, int r32, int hi, f32x16& p0, f32x16& p1) {
    lds_cptr kp = kbuf + hi * 1024 + r32 * 16;
#pragma unroll
    for (int ks = 0; ks < NKS; ++ks) {
        const bf16x8 a0 = *(const LAS bf16x8*)(kp + ks * 2048), a1 = *(const LAS bf16x8*)(kp + ks * 2048 + 512);
        p0 = MFMA32(a0, qf[ks], p0); p1 = MFMA32(a1, qf[ks], p1);
    }
}
template <int NKS> __device__ __forceinline__ void qk64c(lds_cptr kbuf, const bf16x8* qf, int r32, int hi, const f32x16& c, f32x16& p0, f32x16& p1) {
    lds_cptr kp = kbuf + hi * 1024 + r32 * 16;
    { const bf16x8 a0 = *(const LAS bf16x8*)(kp), a1 = *(const LAS bf16x8*)(kp + 512); p0 = MFMA32(a0, qf[0], c); p1 = MFMA32(a1, qf[0], c); }
#pragma unroll
    for (int ks = 1; ks < NKS; ++ks) {
        const bf16x8 a0 = *(const LAS bf16x8*)(kp + ks * 2048), a1 = *(const LAS bf16x8*)(kp + ks * 2048 + 512);
        p0 = MFMA32(a0, qf[ks], p0); p1 = MFMA32(a1, qf[ks], p1);
    }
}
struct AState { f32x16 o0, o1; float m, l; };
__device__ __forceinline__ void astate_init(AState& s) {
#pragma unroll
    for (int r = 0; r < 16; ++r) { s.o0[r] = 0.f; s.o1[r] = 0.f; }
    s.m = NEG_INF; s.l = 0.f;
}
__device__ __forceinline__ void pv64(f32x16& o0, f32x16& o1, lds_cptr vp, const bf16x8 (&pf)[4]) {
#pragma unroll
    for (int ks = 0; ks < 4; ++ks) {
        const s16x4 l0 = vtr(vp + ks * 1024), h0 = vtr(vp + ks * 1024 + 512), l1 = vtr(vp + 4096 + ks * 1024), h1 = vtr(vp + 4096 + ks * 1024 + 512);
        const bf16x8 v0 = (bf16x8){l0[0], l0[1], l0[2], l0[3], h0[0], h0[1], h0[2], h0[3]}, v1 = (bf16x8){l1[0], l1[1], l1[2], l1[3], h1[0], h1[1], h1[2], h1[3]};
        o0 = MFMA32(v0, pf[ks], o0); o1 = MFMA32(v1, pf[ks], o1);
    }
}
struct VFrag { bf16x8 v0[4], v1[4]; };
__device__ __forceinline__ void v_load64(VFrag& f, lds_cptr vp) {
#pragma unroll
    for (int ks = 0; ks < 4; ++ks) {
        const s16x4 l0 = vtr(vp + ks * 1024), h0 = vtr(vp + ks * 1024 + 512), l1 = vtr(vp + 4096 + ks * 1024), h1 = vtr(vp + 4096 + ks * 1024 + 512);
        f.v0[ks] = (bf16x8){l0[0], l0[1], l0[2], l0[3], h0[0], h0[1], h0[2], h0[3]}; f.v1[ks] = (bf16x8){l1[0], l1[1], l1[2], l1[3], h1[0], h1[1], h1[2], h1[3]};
    }
}
__device__ __forceinline__ void pv64f(f32x16& o0, f32x16& o1, const VFrag& f, const bf16x8 (&pf)[4]) {
#pragma unroll
    for (int ks = 0; ks < 4; ++ks) { o0 = MFMA32(f.v0[ks], pf[ks], o0); o1 = MFMA32(f.v1[ks], pf[ks], o1); }
}
__device__ __forceinline__ void pack_p(const f32x16& p0, const f32x16& p1, bf16x8 (&pf)[4]) {
    u32x4 w0, w1, w2, w3;
    w0.x = cvtpk(p0[0], p0[1]); w0.y = cvtpk(p0[2], p0[3]); w0.z = cvtpk(p0[4], p0[5]); w0.w = cvtpk(p0[6], p0[7]);
    w1.x = cvtpk(p0[8], p0[9]); w1.y = cvtpk(p0[10], p0[11]); w1.z = cvtpk(p0[12], p0[13]); w1.w = cvtpk(p0[14], p0[15]);
    w2.x = cvtpk(p1[0], p1[1]); w2.y = cvtpk(p1[2], p1[3]); w2.z = cvtpk(p1[4], p1[5]); w2.w = cvtpk(p1[6], p1[7]);
    w3.x = cvtpk(p1[8], p1[9]); w3.y = cvtpk(p1[10], p1[11]); w3.z = cvtpk(p1[12], p1[13]); w3.w = cvtpk(p1[14], p1[15]);
    pf[0] = __builtin_bit_cast(bf16x8, w0); pf[1] = __builtin_bit_cast(bf16x8, w1); pf[2] = __builtin_bit_cast(bf16x8, w2); pf[3] = __builtin_bit_cast(bf16x8, w3);
}
template <bool HOIST = true> __device__ __forceinline__ void softmax_pv64(f32x16& p0, f32x16& p1, AState& s, lds_cptr vp, int hi) {
    VFrag vf; if (HOIST) { v_load64(vf, vp); __builtin_amdgcn_sched_barrier(0); }
    float mx = fmaxf(p0[0], p1[0]);
#pragma unroll
    for (int r = 1; r < 16; ++r) mx = fmaxf(mx, fmaxf(p0[r], p1[r]));
    mx = fmaxf(mx, other_half(mx, hi));
    const float mn = fmaxf(s.m, mx), ms = (mn == NEG_INF) ? 0.f : mn;
    const float alpha = fast_exp2(s.m - ms);
    float rs = 0.f;
#pragma unroll
    for (int r = 0; r < 16; ++r) { p0[r] = fast_exp2(p0[r] - ms); p1[r] = fast_exp2(p1[r] - ms); rs += p0[r] + p1[r]; }
    rs += other_half(rs, hi);
    s.l = s.l * alpha + rs; s.m = mn;
#pragma unroll
    for (int r = 0; r < 16; ++r) { s.o0[r] *= alpha; s.o1[r] *= alpha; }
    bf16x8 pf[4]; pack_p(p0, p1, pf);
    if (HOIST) pv64f(s.o0, s.o1, vf, pf); else pv64(s.o0, s.o1, vp, pf);
}
__device__ __forceinline__ void softmax_fixed_pv64(f32x16& p0, f32x16& p1, AState& s, lds_cptr vp) {
    VFrag vf; v_load64(vf, vp); __builtin_amdgcn_sched_barrier(0);
    float rs = 0.f;
#pragma unroll
    for (int r = 0; r < 16; ++r) { p0[r] = fast_exp2(p0[r]); p1[r] = fast_exp2(p1[r]); rs += p0[r] + p1[r]; }
    s.l += rs;
    bf16x8 pf[4]; pack_p(p0, p1, pf);
    pv64f(s.o0, s.o1, vf, pf);
}
template <bool HOIST> __device__ __forceinline__ void softmax_shift_pv64(f32x16& p0, f32x16& p1, AState& s, lds_cptr vp, float bnd) {
    VFrag vf; if (HOIST) { v_load64(vf, vp); __builtin_amdgcn_sched_barrier(0); }
    float rs = 0.f;
#pragma unroll
    for (int r = 0; r < 16; ++r) { p0[r] = fast_exp2(p0[r] - bnd); p1[r] = fast_exp2(p1[r] - bnd); rs += p0[r] + p1[r]; }
    s.l += rs;
    bf16x8 pf[4]; pack_p(p0, p1, pf);
    if (HOIST) pv64f(s.o0, s.o1, vf, pf); else pv64(s.o0, s.o1, vp, pf);
}
template <bool MASK> __device__ __forceinline__ void softmax_raw_pv64(f32x16& p0, f32x16& p1, AState& s, lds_cptr vp, bool keep) {
    float rs = 0.f;
#pragma unroll
    for (int r = 0; r < 16; ++r) { p0[r] = fast_exp2(p0[r]); p1[r] = fast_exp2(p1[r]); rs += p0[r] + p1[r]; }
    bf16x8 pf[4]; pack_p(p0, p1, pf);
    if (MASK) { const unsigned km = keep ? 0xffffffffu : 0u; rs = keep ? rs : 0.f;
#pragma unroll
        for (int k = 0; k < 4; ++k) { u32x4 w = __builtin_bit_cast(u32x4, pf[k]); w.x &= km; w.y &= km; w.z &= km; w.w &= km; pf[k] = __builtin_bit_cast(bf16x8, w); } }
    s.l += rs;
    pv64(s.o0, s.o1, vp, pf);
}
__device__ __forceinline__ void mask_causal(f32x16& p0, f32x16& p1, int kpos0, int tq, int hi) {
#pragma unroll
    for (int r = 0; r < 16; ++r) { const int kp = kpos0 + crow(r, hi); if (kp > tq) p0[r] = NEG_INF; if (kp + 32 > tq) p1[r] = NEG_INF; }
}
__device__ __forceinline__ void add_table(f32x16& p0, f32x16& p1, const LAS float* tb) {
#pragma unroll
    for (int r = 0; r < 16; ++r) { const int o = (r & 3) + 8 * (r >> 2); p0[r] += tb[o]; p1[r] += tb[o + 32]; }
}
__device__ __forceinline__ void store_o_bf16(bf16_t* orow, const f32x16& o0, const f32x16& o1, float sc, int hi) {
#pragma unroll
    for (int g = 0; g < 4; ++g) {
        u32x2 w0, w1; w0.x = cvtpk(o0[4 * g] * sc, o0[4 * g + 1] * sc); w0.y = cvtpk(o0[4 * g + 2] * sc, o0[4 * g + 3] * sc);
        w1.x = cvtpk(o1[4 * g] * sc, o1[4 * g + 1] * sc); w1.y = cvtpk(o1[4 * g + 2] * sc, o1[4 * g + 3] * sc);
        *(u32x2*)(orow + 8 * g + 4 * hi) = w0; *(u32x2*)(orow + 32 + 8 * g + 4 * hi) = w1;
    }
}
constexpr int OST_OFF = 90112, OST_PITCH = 144, OST_WAVE = 32 * OST_PITCH;
template <class RowPtr> __device__ __forceinline__ void store_o_staged(lds_ptr lds, int wid, int lane, const f32x16& o0, const f32x16& o1, float sc, const RowPtr& rowp) {
    const int r32 = lane & 31, hi = lane >> 5;
    lds_ptr stg = lds + OST_OFF + wid * OST_WAVE;
#pragma unroll
    for (int g = 0; g < 4; ++g) {
        u32x2 w0, w1; w0.x = cvtpk(o0[4 * g] * sc, o0[4 * g + 1] * sc); w0.y = cvtpk(o0[4 * g + 2] * sc, o0[4 * g + 3] * sc);
        w1.x = cvtpk(o1[4 * g] * sc, o1[4 * g + 1] * sc); w1.y = cvtpk(o1[4 * g + 2] * sc, o1[4 * g + 3] * sc);
        *(LAS u32x2*)(stg + r32 * OST_PITCH + (8 * g + 4 * hi) * 2) = w0; *(LAS u32x2*)(stg + r32 * OST_PITCH + 64 + (8 * g + 4 * hi) * 2) = w1;
    }
    asm volatile("" ::: "memory");
#pragma unroll
    for (int i = 0; i < 4; ++i) { const int row = i * 8 + (lane >> 3), ch = lane & 7;
        const u32x4 v = *(const LAS u32x4*)(stg + row * OST_PITCH + ch * 16);
        *(u32x4*)(rowp(row) + ch * 8) = v; }
    asm volatile("" ::: "memory");
}
constexpr size_t MiB = 1u << 20, KiB = 1u << 10;
constexpr size_t WS_CTL = 0, CTL_ZERO_BYTES = 1 * MiB;
constexpr size_t WS_ROPE = 1 * MiB, WS_NSATAB = WS_ROPE + 512 * KiB, WS_DILTAB = WS_NSATAB + 32 * KiB, WS_CMPB = WS_DILTAB + 8 * KiB, WS_FARB = WS_CMPB + 4 * KiB;
constexpr size_t WS_WT = 4 * MiB, LW = 38 * MiB;
constexpr size_t LW_IN = 0, LW_G = 6 * MiB, LW_BR = 14 * MiB, LW_O = 16 * MiB, LW_UP = 18 * MiB, LW_DN = 29 * MiB, LW_UQ = 35 * MiB, LW_UKV = 35 * MiB + 256 * KiB, LW_PHI = 36 * MiB;
constexpr size_t BR_A = 0, BR_B = 512 * KiB, BR_C = 768 * KiB, BR_D = 1280 * KiB;
constexpr size_t WS_SIDE = 80 * MiB, WS_SSQQ = 84 * MiB, WS_SSQKV = 85 * MiB, WS_KB = 86 * MiB, WS_KROT = 87 * MiB, WS_KCMP = 91 * MiB, WS_VCMP = 100 * MiB,
                 WS_HID = 109 * MiB, WS_KMAX = 3 * MiB + 128 * KiB  , WS_LF = 2 * MiB  , WS_CMPP = 3 * MiB  , WS_ORDER = 3 * MiB + 64 * KiB  , WS_KC = 113 * MiB, WS_VC = 113 * MiB + 512 * KiB, WS_DLSE = 114 * MiB, WS_DOG = 116 * MiB;
constexpr size_t WS_H = 164 * MiB, WS_OCAT = 292 * MiB, WS_QM = 404 * MiB, WS_KVM = 468 * MiB, WS_P = 532 * MiB;
constexpr size_t WS_MERGED = 532 * MiB, WS_MSCR = 660 * MiB, WS_Y = 164 * MiB  , WS_H2 = 756 * MiB, WS_ACT = 164 * MiB  , WS_HB = 532 * MiB  , WS_Y2 = 884 * MiB  , WS_X3 = 620 * MiB  , WS_END = 1024 * MiB;
constexpr size_t MSCR_PER_WG = 512 * KiB;
constexpr size_t WS_CWS = 3 * MiB + 256 * KiB;
constexpr size_t H8_OFF = 128 * MiB;
static_assert(WS_WT + 2 * LW <= WS_SIDE && WS_DOG + 48 * MiB <= WS_H && WS_P + 384 * MiB <= WS_END && WS_MSCR + 256 * MSCR_PER_WG <= WS_P + 384 * MiB && WS_H2 + 128 * MiB <= WS_Y2 && WS_Y2 + 128 * MiB <= WS_END, "ws map");
static_assert(WS_ACT + 352 * MiB <= WS_HB && WS_HB + 88 * MiB <= WS_X3 && WS_X3 + 128 * MiB <= WS_H2 && WS_Y + 128 * MiB <= WS_OCAT, "ws overlays");
constexpr int CW_BAR = 4096;
constexpr int CW_KMAX = 24576;
constexpr int CW_KMLA = 24832;
constexpr int CW_KROT = 25344;
constexpr int CW_KCMX = 25856;
constexpr int CW_QNSA = 25792;
constexpr int CW_KNSA = 25664;
constexpr int CW_Q = 16384;

constexpr int RING_BYTES = 131072, LDSCTL_OFF = RING_BYTES, MISC_OFF = LDSCTL_OFF + 320, LDS_BYTES = 147456;
constexpr int NSA_SLAB = 49152, NSA_SLAB_BYTES = 4 * 64 * 65 * 4, NSA_SEL = NSA_SLAB + NSA_SLAB_BYTES;
static_assert(NSA_SEL + 512 <= RING_BYTES && 4 * NSA_TL * 4 <= NSA_SLAB_BYTES && 2 * TB_SIZE <= NSA_SLAB, "NSA LDS map");

struct Frame {
    LAS unsigned char* lds; volatile LAS unsigned* MISC; gu32* ctl;
    int tid, lane, wave, G;
    const float* in[27]; float* out; unsigned char* ws;
};
#define WSP(T, off) ((T*)(F.ws + (off)))
#define VM_WAIT() asm volatile("s_waitcnt vmcnt(0)" ::: "memory")
#define LDS_WAIT() asm volatile("s_waitcnt lgkmcnt(0)" ::: "memory")

__device__ __forceinline__ int queue_grab(Frame& F, gu32* ctr) {
    if (F.tid == 0) F.MISC[0] = __hip_atomic_fetch_add(ctr, 1u, __ATOMIC_RELAXED, __HIP_MEMORY_SCOPE_AGENT);
    __syncthreads();
    const int v = (int)F.MISC[0];
    __syncthreads();
    return v;
}

template <bool FOX> __device__ __forceinline__ void causal_unit(Frame& F, int b, int h, int qb, float kmax_in) {
    constexpr int NKS = FOX ? 4 : 6;
    int lane_o = lane_now();
    const int wid = F.wave, lane = lane_o, r32 = lane & 31, hi = lane >> 5;
    const size_t rowbase = (size_t)b * SEQ;
    const int q0 = qb * 256, tq = q0 + wid * 32 + r32, NT = qb * 4 + 4;
    const bf16_t* P = WSP(const bf16_t, WS_P);
    const bf16_t *Kb, *Vb, *Qrow; int kpitch, vpitch;
    const bf16_t* Kr = WSP(const bf16_t, WS_KROT) + rowbase * 32;
    const float* kbsrc = WSP(const float, WS_KB) + (size_t)(b * 4 + h) * SEQ;
    if (FOX) { Kb = P + rowbase * PW + PC_CK + h * 64; Vb = P + rowbase * PW + PC_CV + h * 64; kpitch = PW; vpitch = PW; Qrow = P + (rowbase + tq) * PW + PC_CQ + h * 64; }
    else { const bf16_t* KV = WSP(const bf16_t, WS_KVM) + rowbase * 512 + h * 128; Kb = KV; Vb = KV + 64; kpitch = 512; vpitch = 512; Qrow = WSP(const bf16_t, WS_QM) + (rowbase + tq) * 512 + h * 96; }
    bf16x8 qf[NKS];
#pragma unroll
    for (int ks = 0; ks < NKS; ++ks) qf[ks] = *(const bf16x8*)(Qrow + ks * 16 + hi * 8);
    AState st; astate_init(st);
    lds_ptr lds = (lds_ptr)F.lds;
    const int vpo = ((lane >> 4) & 1) * 32 + (lane & 3) * 8 + (4 * hi + ((lane & 15) >> 2)) * 64;
    Stg sA, sB;
#define CU_LOAD(S, t) do { S.k = *(const u32x4*)(Kb + (size_t)((t) * 64 + lane) * kpitch + wid * 8); \
        if (!FOX) { if (wid < 4) S.k2 = *(const u32x4*)(Kr + (size_t)((t) * 64 + lane) * 32 + wid * 8); } \
        S.v = *(const u32x4*)(Vb + (size_t)((t) * 64 + 16 * (wid & 3) + (lane >> 2)) * vpitch + (wid >> 2) * 32 + (lane & 3) * 8); \
        if (FOX) { if (wid == 0) S.kb = kbsrc[(t) * 64 + lane]; else if (wid == 1) S.kb = kbsrc[(t) > 0 ? (t) * 64 - 1 : 0]; } } while (0)
#define CU_WRITE(S, bofs) do { lds_ptr bp = lds + (bofs); *(LAS u32x4*)(bp + wid * 1024 + lane * 16) = S.k; \
        if (!FOX) { if (wid < 4) *(LAS u32x4*)(bp + (8 + wid) * 1024 + lane * 16) = S.k2; } \
        *(LAS u32x4*)(bp + TB_V + wid * 1024 + lane * 16) = S.v; \
        if (FOX) { if (wid == 0) *(LAS float*)(bp + TB_KB + lane * 4) = S.kb; else if (wid == 1 && lane == 0) *(LAS float*)(bp + TB_KB + 256) = S.kb; } } while (0)
    const int tq_lo = q0 + wid * 32;
    float qn = 0.f; const float kmax = kmax_in;
#pragma unroll
    for (int ks = 0; ks < NKS; ++ks)
#pragma unroll
        for (int e = 0; e < 8; ++e) { const float x = bf2f((unsigned short)qf[ks][e]); qn += x * x; }
    qn += other_half(qn, hi); qn = sqrtf(qn);
    const float bnd = qn * kmax * 1.002f + 0.05f;
    const bool fast = __all(bnd <= 50.0f);
    const float kbi = FOX ? kbsrc[tq] : 0.f;
    f32x16 cinit;
    { const float c0 = -(bnd + kbi);
#pragma unroll
      for (int r = 0; r < 16; ++r) cinit[r] = c0; }
    LAS volatile unsigned* dflag = (LAS volatile unsigned*)(lds + 4 * TB_SIZE + 64);
#define CU_TILE(T, BOFS) { const int t = (T); lds_cptr bp = (lds_cptr)(lds + (BOFS)); \
        if (64 * t <= tq_lo + 31) {                                \
            f32x16 p0, p1; \
            if (fast) qk64c<NKS>(bp, qf, r32, hi, cinit, p0, p1); \
            else { _Pragma("unroll") for (int r = 0; r < 16; ++r) { p0[r] = 0.f; p1[r] = 0.f; } qk64<NKS>(bp, qf, r32, hi, p0, p1); } \
            if (FOX) { const LAS float* kbt = (const LAS float*)(bp + TB_KB) + 4 * hi; \
                _Pragma("unroll") for (int g = 0; g < 4; ++g) { const f32x4 a = *(const LAS f32x4*)(kbt + 8 * g), c = *(const LAS f32x4*)(kbt + 32 + 8 * g); \
                    _Pragma("unroll") for (int e = 0; e < 4; ++e) { p0[4 * g + e] += a[e]; p1[4 * g + e] += c[e]; } } } \
            if (64 * t + 63 > tq_lo) mask_causal(p0, p1, 64 * t, tq, hi); \
            if (fast) softmax_fixed_pv64(p0, p1, st, bp + TB_V + vpo); else softmax_pv64(p0, p1, st, bp + TB_V + vpo, hi); \
        } }
    const int NP = NT >> 1;
#define CU_TA(p) (FOX ? NT - 1 - 2 * (p) : 2 * (p))
#define CU_TB(p) (FOX ? NT - 2 - 2 * (p) : 2 * (p) + 1)
    CU_LOAD(sA, CU_TA(0)); CU_LOAD(sB, CU_TB(0)); CU_WRITE(sA, 0); CU_WRITE(sB, TB_SIZE);
    __syncthreads();
    for (int p = 0; p < NP; ++p) {
        const int pofs = (p & 1) * 2 * TB_SIZE, nofs = ((p & 1) ^ 1) * 2 * TB_SIZE;
        if (p + 1 < NP) { CU_LOAD(sA, CU_TA(p + 1)); CU_LOAD(sB, CU_TB(p + 1)); }
        { const int ta_ = CU_TA(p), tbb_ = CU_TB(p), tmax_ = ta_ > tbb_ ? ta_ : tbb_;
          if (fast && 64 * tmax_ + 63 <= tq_lo) {
              lds_cptr bpa = (lds_cptr)(lds + pofs), bpb = (lds_cptr)(lds + pofs + TB_SIZE);
              f32x16 a0, a1, b0, b1;
              qk64c<NKS>(bpa, qf, r32, hi, cinit, a0, a1);
              qk64c<NKS>(bpb, qf, r32, hi, cinit, b0, b1);
              if (FOX) { const LAS float* ka = (const LAS float*)(bpa + TB_KB) + 4 * hi; const LAS float* kb2 = (const LAS float*)(bpb + TB_KB) + 4 * hi;
#pragma unroll
                  for (int g = 0; g < 4; ++g) { const f32x4 x = *(const LAS f32x4*)(ka + 8 * g), y = *(const LAS f32x4*)(ka + 32 + 8 * g), z = *(const LAS f32x4*)(kb2 + 8 * g), w = *(const LAS f32x4*)(kb2 + 32 + 8 * g);
#pragma unroll
                      for (int e = 0; e < 4; ++e) { a0[4 * g + e] += x[e]; a1[4 * g + e] += y[e]; b0[4 * g + e] += z[e]; b1[4 * g + e] += w[e]; } } }
              VFrag va; v_load64(va, bpa + TB_V + vpo);
              float rs = 0.f;
#pragma unroll
              for (int r = 0; r < 16; ++r) { a0[r] = fast_exp2(a0[r]); a1[r] = fast_exp2(a1[r]); rs += a0[r] + a1[r]; }
              bf16x8 pfa[4]; pack_p(a0, a1, pfa);
              pv64f(st.o0, st.o1, va, pfa);
              VFrag vb; v_load64(vb, bpb + TB_V + vpo);
#pragma unroll
              for (int r = 0; r < 16; ++r) { b0[r] = fast_exp2(b0[r]); b1[r] = fast_exp2(b1[r]); rs += b0[r] + b1[r]; }
              st.l += rs;
              bf16x8 pfb[4]; pack_p(b0, b1, pfb);
              pv64f(st.o0, st.o1, vb, pfb);
          } else {
              CU_TILE(ta_, pofs)
              CU_TILE(tbb_, pofs + TB_SIZE)
          } }
        const int tb_ = CU_TB(p);
        if (FOX) { if (tb_ > 0) { const float kb_last = *(const LAS float*)(lds + pofs + TB_SIZE + TB_KB + 256); const bool done = fast ? ((kb_last - kbi) < -150.0f) : ((qn * kmax + kb_last - st.m) < -130.0f); const unsigned alld = __all(done) ? 1u : 0u; if (lane == 0) dflag[(p & 1) * 8 + wid] = alld; } }
        if (p + 1 < NP) { CU_WRITE(sA, nofs); CU_WRITE(sB, nofs + TB_SIZE); }
        __syncthreads();
        if (FOX) { if (tb_ > 0) { unsigned all = 1u;
#pragma unroll
                for (int w = 0; w < 8; ++w) all &= dflag[(p & 1) * 8 + w];
                if (all) break; } }
    }
#undef CU_TA
#undef CU_TB
#undef CU_TILE
#undef CU_LOAD
#undef CU_WRITE
    bf16_t* obase = WSP(bf16_t, WS_OCAT) + (rowbase + tq_lo) * OCW + (FOX ? 384 : 640) + h * 64;
    const float ltot = fast ? st.l + other_half(st.l, hi) : st.l;
    store_o_staged(lds, wid, lane, st.o0, st.o1, 1.0f / ltot, [&](int r) { return obase + (size_t)r * OCW; });
}
template <bool FAST> __device__ __forceinline__ void nsa_unit(Frame& F, int b, int qblk, int l) {
    int lane_o = lane_now();
    const int wid = F.wave, lane = lane_o, r32 = lane & 31, hi = lane >> 5, tid = wid * 64 + lane;
    const int h = wid & 3, qs = wid >> 2;
    const int q0 = qblk * 64, cur = qblk, tq = q0 + 32 * qs + r32, tq_lo = q0 + 32 * qs;
    const size_t rowbase = (size_t)b * SEQ, row = rowbase + tq;
    const bf16_t* P = WSP(const bf16_t, WS_P);
    lds_ptr lds = (lds_ptr)F.lds;
    const int vpo = ((lane >> 4) & 1) * 32 + (lane & 3) * 8 + (4 * hi + ((lane & 15) >> 2)) * 64;
    bf16x8 qf[4];
    { const bf16_t* Qrow = P + row * PW + PC_AQ + h * 64;
#pragma unroll
      for (int ks = 0; ks < 4; ++ks) qf[ks] = *(const bf16x8*)(Qrow + ks * 16 + hi * 8); }
    Stg s; int ln;
#define NS_LOAD(Kb, kp, Vb, vp_, t) do { s.k = *(const u32x4*)((Kb) + (size_t)((t) * 64 + ln) * (kp) + wid * 8); \
        s.v = *(const u32x4*)((Vb) + (size_t)((t) * 64 + 16 * (wid & 3) + (ln >> 2)) * (vp_) + (wid >> 2) * 32 + (ln & 3) * 8); } while (0)
#define NS_FRESH() do { ln = lane; asm volatile("" : "+v"(ln)); } while (0)
#define NS_WRITE(bi) do { lds_ptr bp_ = lds + (bi) * TB_SIZE; *(LAS u32x4*)(bp_ + wid * 1024 + lane * 16) = s.k; *(LAS u32x4*)(bp_ + TB_V + wid * 1024 + lane * 16) = s.v; } while (0)
    const bf16_t* KC = WSP(const bf16_t, WS_KC) + (size_t)b * 256 * 64; const bf16_t* VC = WSP(const bf16_t, WS_VC) + (size_t)b * 256 * 64;
    const int cmax_u = (q0 + 63 - 31) >> 4, NTc = (cmax_u >> 6) + 1;
    const int cmax = (tq - 31) >> 4;
    float cm = NEG_INF, cl = 0.f;
    if constexpr (!FAST) {
    NS_FRESH(); NS_LOAD(KC, 64, VC, 64, 0); NS_WRITE(0);
    __syncthreads();
    for (int t = 0; t < NTc; ++t) {
        const int bi = t & 1;
        if (t + 1 < NTc) NS_LOAD(KC, 64, VC, 64, t + 1);
        { lds_cptr bp = (lds_cptr)(lds + bi * TB_SIZE); f32x16 p0, p1;
#pragma unroll
          for (int r = 0; r < 16; ++r) { p0[r] = 0.f; p1[r] = 0.f; }
          qk64<4>(bp, qf, r32, hi, p0, p1);
          float mx = NEG_INF;
#pragma unroll
          for (int r = 0; r < 16; ++r) { const int c = 64 * t + crow(r, hi); if (c > cmax) p0[r] = NEG_INF; if (c + 32 > cmax) p1[r] = NEG_INF; mx = fmaxf(mx, fmaxf(p0[r], p1[r])); }
          mx = fmaxf(mx, other_half(mx, hi));
          const float mn = fmaxf(cm, mx), ms = (mn == NEG_INF) ? 0.f : mn; float rs = 0.f;
#pragma unroll
          for (int r = 0; r < 16; ++r) rs += fast_exp2(p0[r] - ms) + fast_exp2(p1[r] - ms);
          rs += other_half(rs, hi);
          cl = cl * fast_exp2(cm - ms) + rs; cm = mn; }
        if (t + 1 < NTc) NS_WRITE(bi ^ 1);
        __syncthreads();
    }
    }
    const float cms = (cm == NEG_INF) ? 0.f : cm; float cinv = FAST ? 1.0f : 1.0f / fmaxf(cl, 1e-30f);
    f32x16 oc0, oc1;
#pragma unroll
    for (int r = 0; r < 16; ++r) { oc0[r] = 0.f; oc1[r] = 0.f; }
    float G[32]; float carry = 0.f;
#pragma unroll
    for (int i = 0; i < 32; ++i) G[i] = 0.f;
    NS_FRESH(); NS_LOAD(KC, 64, VC, 64, 0); NS_WRITE(0);
    __syncthreads();
#pragma unroll
    for (int t = 0; t < 4; ++t) {
        if (t < NTc) {
            const int bi = t & 1;
            if (t + 1 < NTc) NS_LOAD(KC, 64, VC, 64, t + 1);
            { lds_cptr bp = (lds_cptr)(lds + bi * TB_SIZE); f32x16 p0, p1;
#pragma unroll
              for (int r = 0; r < 16; ++r) { p0[r] = 0.f; p1[r] = 0.f; }
              qk64<4>(bp, qf, r32, hi, p0, p1);
#pragma unroll
              for (int r = 0; r < 16; ++r) { const int c = 64 * t + crow(r, hi);
                  if constexpr (FAST) { p0[r] = (c > cmax) ? 0.f : fast_exp2(p0[r]); p1[r] = (c + 32 > cmax) ? 0.f : fast_exp2(p1[r]); cl += p0[r] + p1[r]; }
                  else { p0[r] = (c > cmax) ? 0.f : fast_exp2(p0[r] - cms) * cinv; p1[r] = (c + 32 > cmax) ? 0.f : fast_exp2(p1[r] - cms) * cinv; } }
#pragma unroll
              for (int g = 0; g < 4; ++g) { const float oth = other_half(p0[4 * g + 3], hi);
                  G[t * 8 + g] = ((p0[4 * g] + p0[4 * g + 1]) + (p0[4 * g + 2] + p0[4 * g + 3])) + (hi ? oth : carry); carry = oth; }
#pragma unroll
              for (int g = 0; g < 4; ++g) { const float oth = other_half(p1[4 * g + 3], hi);
                  G[t * 8 + 4 + g] = ((p1[4 * g] + p1[4 * g + 1]) + (p1[4 * g + 2] + p1[4 * g + 3])) + (hi ? oth : carry); carry = oth; }
              bf16x8 pf[4]; pack_p(p0, p1, pf);
              pv64(oc0, oc1, bp + TB_V + vpo, pf); }
            if (t + 1 < NTc) NS_WRITE(bi ^ 1);
            __syncthreads();
        }
    }
    if constexpr (FAST) {
        cl += other_half(cl, hi); cinv = 1.0f / fmaxf(cl, 1e-30f);
#pragma unroll
        for (int i = 0; i < 32; ++i) G[i] *= cinv;
#pragma unroll
        for (int r = 0; r < 16; ++r) { oc0[r] *= cinv; oc1[r] *= cinv; } }
    { LAS float* slab = (LAS float*)(lds + NSA_SLAB) + (size_t)(h * 64 + 32 * qs + r32) * 65;
#pragma unroll
      for (int i = 0; i < 32; ++i) slab[2 * i + hi] = G[i]; }
    __syncthreads();
    u32x4 tbr[4]; { const u32x4* src = WSP(const u32x4, WS_NSATAB);
#pragma unroll
      for (int i = 0; i < 4; ++i) { const int idx = tid + 512 * i; tbr[i] = (idx < 4 * NSA_TL / 4) ? src[idx] : (u32x4){0u, 0u, 0u, 0u}; } }
    { const int q = tid >> 3, jg = tid & 7;
      LAS float* s0 = (LAS float*)(lds + NSA_SLAB) + (size_t)q * 65;
      float xs[8];
#pragma unroll
      for (int e = 0; e < 8; ++e) { const int j = 8 * jg + e; xs[e] = (s0[j] + s0[64 * 65 + j]) + (s0[2 * 64 * 65 + j] + s0[3 * 64 * 65 + j]); }
#pragma unroll
      for (int e = 0; e < 8; ++e) s0[8 * jg + e] = xs[e];
      asm volatile("s_waitcnt lgkmcnt(0)" ::: "memory");
      float v[64];
#pragma unroll
      for (int k = 0; k < 64; ++k) { const float x = s0[k];
          v[k] = (k == 0 || k == cur || k == cur - 1) ? 1e9f : ((k > cur) ? -1e9f : x); if ((k & 7) == 7) asm volatile("" ::: "memory"); }
      unsigned bits = 0u;
#pragma unroll
      for (int e = 0; e < 8; ++e) { const int j = 8 * jg + e;
          const float xj = xs[e];
          const float vj = (j == 0 || j == cur || j == cur - 1) ? 1e9f : ((j > cur) ? -1e9f : xj);
          int rank = 0;
#pragma unroll
          for (int k = 0; k < 64; ++k) rank += (v[k] > vj || (v[k] == vj && k < j)) ? 1 : 0;
          bits |= (rank < 16 ? 1u : 0u) << e; }
      *((LAS unsigned char*)(lds + NSA_SEL) + q * 8 + jg) = (unsigned char)bits; }
    __syncthreads();
    const unsigned mlo = *(const LAS unsigned*)(lds + NSA_SEL + (32 * qs + r32) * 8), mhi = *(const LAS unsigned*)(lds + NSA_SEL + (32 * qs + r32) * 8 + 4);
    { LAS u32x4* dst = (LAS u32x4*)(lds + NSA_SLAB);
#pragma unroll
      for (int i = 0; i < 4; ++i) { const int idx = tid + 512 * i; if (idx < 4 * NSA_TL / 4) dst[idx] = tbr[i]; } }
    const LAS float* tabh = (const LAS float*)(lds + NSA_SLAB) + h * NSA_TL;
    AState st; astate_init(st);
    { const bf16_t* Kb = P + rowbase * PW + PC_KSLC; const bf16_t* Vb = P + rowbase * PW + PC_VSLC;
      NS_FRESH(); NS_LOAD(Kb, PW, Vb, PW, 0); NS_WRITE(0);
      __syncthreads();
      for (int j = 0; j <= cur; ++j) {
          const int bi = j & 1;
          if (j < cur) NS_LOAD(Kb, PW, Vb, PW, j + 1);
          const bool mine = ((j < 32) ? (mlo >> j) : (mhi >> (j - 32))) & 1u;
          if (__any(mine)) {
              lds_cptr bp = (lds_cptr)(lds + bi * TB_SIZE); f32x16 p0, p1;
#pragma unroll
              for (int r = 0; r < 16; ++r) { p0[r] = 0.f; p1[r] = 0.f; }
              qk64<4>(bp, qf, r32, hi, p0, p1);
              const bool farj = (q0 - 64 * j - 63 >= NSA_DFAR);
              if constexpr (FAST) {
                  if (!farj) add_table(p0, p1, tabh + (NSA_DMAX - tq + 64 * j + 4 * hi));
                  if (j == cur) mask_causal(p0, p1, 64 * j, tq, hi);
                  softmax_raw_pv64<true>(p0, p1, st, bp + TB_V + vpo, mine);
              } else {
                  if (!farj) add_table(p0, p1, tabh + (NSA_DMAX - tq + 64 * j + 4 * hi));
                  if (j == cur) mask_causal(p0, p1, 64 * j, tq, hi);
                  if (!mine) {
#pragma unroll
                      for (int r = 0; r < 16; ++r) { p0[r] = NEG_INF; p1[r] = NEG_INF; } }
                  softmax_pv64<false>(p0, p1, st, bp + TB_V + vpo, hi);
              }
          }
          if (j < cur) NS_WRITE(bi ^ 1);
          __syncthreads();
      } }
    f32x16 oa0, oa1;
    { int rw_ = (int)row; asm volatile("" : "+v"(rw_)); const float* sd = WSP(const float, WS_SIDE) + (size_t)rw_ * 16 + h * 3;
      const float g0 = sigmoid_f(sd[0]), sc = sigmoid_f(sd[1]) / (FAST ? st.l + other_half(st.l, hi) : st.l);
#pragma unroll
      for (int r = 0; r < 16; ++r) { oa0[r] = g0 * oc0[r] + sc * st.o0[r]; oa1[r] = g0 * oc1[r] + sc * st.o1[r]; } }
    astate_init(st);
    { const bf16_t* Kb = P + rowbase * PW + PC_KWIN; const bf16_t* Vb = P + rowbase * PW + PC_VWIN;
      const int jlo = cur >= 8 ? cur - 8 : 0;
      NS_FRESH(); NS_LOAD(Kb, PW, Vb, PW, jlo); NS_WRITE(0);
      __syncthreads();
      for (int j = jlo; j <= cur; ++j) {
          const int bi = (j - jlo) & 1;
          if (j < cur) NS_LOAD(Kb, PW, Vb, PW, j + 1);
          if (tq_lo - 64 * j - 63 < 512) {
              lds_cptr bp = (lds_cptr)(lds + bi * TB_SIZE); f32x16 p0, p1;
#pragma unroll
              for (int r = 0; r < 16; ++r) { p0[r] = 0.f; p1[r] = 0.f; }
              qk64<4>(bp, qf, r32, hi, p0, p1);
              add_table(p0, p1, tabh + (NSA_DMAX - tq + 64 * j + 4 * hi));
              if (!(tq_lo - 64 * j - 63 >= 0 && tq_lo + 31 - 64 * j < 512)) {
                  const int d0 = tq - 64 * j - 4 * hi;
#pragma unroll
                  for (int r = 0; r < 16; ++r) { const int d = d0 - ((r & 3) + 8 * (r >> 2)); if (d < 0 || d >= 512) p0[r] = NEG_INF; if (d - 32 < 0 || d - 32 >= 512) p1[r] = NEG_INF; }
              }
              if constexpr (FAST) softmax_raw_pv64<false>(p0, p1, st, bp + TB_V + vpo, true); else softmax_pv64<false>(p0, p1, st, bp + TB_V + vpo, hi);
          }
          if (j < cur) NS_WRITE(bi ^ 1);
          __syncthreads();
      } }
    { int rw_ = (int)row; asm volatile("" : "+v"(rw_)); const float sc = sigmoid_f(WSP(const float, WS_SIDE)[(size_t)rw_ * 16 + h * 3 + 2]) / (FAST ? st.l + other_half(st.l, hi) : st.l);
#pragma unroll
      for (int r = 0; r < 16; ++r) { oa0[r] += sc * st.o0[r]; oa1[r] += sc * st.o1[r]; } }
    { int tl_ = tq_lo; asm volatile("" : "+s"(tl_)); bf16_t* obase = WSP(bf16_t, WS_OCAT) + (rowbase + tl_) * OCW + h * 64;
      store_o_staged(lds, wid, lane, oa0, oa1, 1.0f, [&](int r) { return obase + (size_t)r * OCW; }); }
#undef NS_LOAD
#undef NS_FRESH
#undef NS_WRITE
}
__device__ __forceinline__ void dil_unit(Frame& F, int b, int hh, int span) {
    int lane_o = lane_now();
    const int wid = F.wave, lane = lane_o, r32 = lane & 31, hi = lane >> 5, tid = wid * 64 + lane;
    const int T0 = span * 512;
    const size_t rowbase = (size_t)b * SEQ;
    const bf16_t* P = WSP(const bf16_t, WS_P) + rowbase * PW;
    lds_ptr lds = (lds_ptr)F.lds;
    LAS float* dtab = (LAS float*)(lds + 32768);
    for (int i = tid; i < 3 * 192; i += 512) dtab[i] = WSP(const float, WS_DILTAB)[((i / 192) * 2 + hh) * 192 + (i % 192)];
    __syncthreads();
    lds_ptr vst = lds + wid * 4096;
    const int vpo = ((lane >> 4) & 1) * 32 + (lane & 3) * 8 + (4 * hi + ((lane & 15) >> 2)) * 64;
    bf16_t* DOG = WSP(bf16_t, WS_DOG); float* DLSE = WSP(float, WS_DLSE);
    for (int g = 0; g < 3; ++g) {
        const int sh = 2 * g, head = 2 * g + hh;
        for (int rep = 0; rep < 2; ++rep) {
            const int wt = wid + 8 * rep;
            const int res = (g == 0) ? 0 : (g == 1 ? (wt & 3) : wt);
            const int i0 = (g == 0) ? 32 * wt : (g == 1 ? 32 * (wt >> 2) : 0);
            const int n0 = (T0 >> sh) + i0;
            const int tokq = res + ((n0 + r32) << sh);
            bf16x8 qf[4];
            { const bf16_t* Qrow = P + (size_t)tokq * PW + PC_BQ + head * 64;
#pragma unroll
              for (int ks = 0; ks < 4; ++ks) qf[ks] = *(const bf16x8*)(Qrow + ks * 16 + hi * 8); }
            f32x16 o0, o1; float m = NEG_INF, l = 0.f;
#pragma unroll
            for (int r = 0; r < 16; ++r) { o0[r] = 0.f; o1[r] = 0.f; }
#define DIL_LOAD(cc, KF, VR) do { const int nk0_ = n0 - 128 + 32 * (cc); int nk_ = nk0_ + r32; nk_ = nk_ < 0 ? 0 : nk_; const bf16_t* Krow_ = P + (size_t)(res + (nk_ << sh)) * PW + PC_BK + head * 64; \
        _Pragma("unroll") for (int ks = 0; ks < 4; ++ks) KF[ks] = *(const bf16x8*)(Krow_ + ks * 16 + hi * 8); \
        _Pragma("unroll") for (int i = 0; i < 4; ++i) { const int pc_ = lane + 64 * i, vrow_ = pc_ >> 3, c16_ = pc_ & 7; int nv_ = nk0_ + vrow_; nv_ = nv_ < 0 ? 0 : nv_; \
            VR[i] = *(const u32x4*)(P + (size_t)(res + (nv_ << sh)) * PW + PC_BV + head * 64 + c16_ * 8); } } while (0)
            int cfirst = 0; while (cfirst < 4 && n0 - 128 + 32 * cfirst + 31 < 0) ++cfirst;
            bf16x8 kfn[4]; u32x4 vrn[4];
            DIL_LOAD(cfirst, kfn, vrn);
            for (int c = cfirst; c < 5; ++c) {
                const int nk0 = n0 - 128 + 32 * c;
                { bf16x8 kf[4]; u32x4 vr[4];
#pragma unroll
                  for (int i = 0; i < 4; ++i) { kf[i] = kfn[i]; vr[i] = vrn[i]; }
                  if (c < 4) DIL_LOAD(c + 1, kfn, vrn);
#pragma unroll
                  for (int i = 0; i < 4; ++i) { const int pc = lane + 64 * i, vrow = pc >> 3, c16 = pc & 7;
                      *(LAS u32x4*)(vst + (c16 >> 2) * 2048 + vrow * 64 + (c16 & 3) * 16) = vr[i]; }
                  asm volatile("s_waitcnt lgkmcnt(0)" ::: "memory");
                  f32x16 p;
#pragma unroll
                  for (int r = 0; r < 16; ++r) p[r] = 0.f;
#pragma unroll
                  for (int ks = 0; ks < 4; ++ks) p = MFMA32(kf[ks], qf[ks], p);
                  const LAS float* tb = dtab + g * 192 + (32 - r32 + 4 * hi + 32 * c);
                  float mx = NEG_INF;
#pragma unroll
                  for (int r = 0; r < 16; ++r) { const int o = (r & 3) + 8 * (r >> 2), kk = o + 4 * hi, j = 128 + r32 - 32 * c - kk;
                      const bool ok = (j >= 0) && (j <= 128) && (nk0 + kk >= 0);
                      p[r] = ok ? p[r] + tb[o] : NEG_INF; mx = fmaxf(mx, p[r]); }
                  mx = fmaxf(mx, other_half(mx, hi));
                  if (__any(mx > m + 8.0f)) { const float mn = fmaxf(m, mx), msn = (mn == NEG_INF) ? 0.f : mn, alpha = fast_exp2(m - msn);
                      l *= alpha; m = mn;
#pragma unroll
                      for (int r = 0; r < 16; ++r) { o0[r] *= alpha; o1[r] *= alpha; } }
                  const float ms = (m == NEG_INF) ? 0.f : m;
                  float rs = 0.f;
#pragma unroll
                  for (int r = 0; r < 16; ++r) { p[r] = fast_exp2(p[r] - ms); rs += p[r]; }
                  rs += other_half(rs, hi);
                  l += rs;
                  u32x4 w0, w1;
                  w0.x = cvtpk(p[0], p[1]); w0.y = cvtpk(p[2], p[3]); w0.z = cvtpk(p[4], p[5]); w0.w = cvtpk(p[6], p[7]);
                  w1.x = cvtpk(p[8], p[9]); w1.y = cvtpk(p[10], p[11]); w1.z = cvtpk(p[12], p[13]); w1.w = cvtpk(p[14], p[15]);
                  const bf16x8 pf0 = __builtin_bit_cast(bf16x8, w0), pf1 = __builtin_bit_cast(bf16x8, w1);
                  lds_cptr vp = (lds_cptr)(vst + vpo);
#pragma unroll
                  for (int ks = 0; ks < 2; ++ks) {
                      const s16x4 l0 = vtr(vp + ks * 1024), h0 = vtr(vp + ks * 1024 + 512), l1 = vtr(vp + 2048 + ks * 1024), h1 = vtr(vp + 2048 + ks * 1024 + 512);
                      const bf16x8 v0 = (bf16x8){l0[0], l0[1], l0[2], l0[3], h0[0], h0[1], h0[2], h0[3]}, v1 = (bf16x8){l1[0], l1[1], l1[2], l1[3], h1[0], h1[1], h1[2], h1[3]};
                      o0 = MFMA32(v0, ks == 0 ? pf0 : pf1, o0); o1 = MFMA32(v1, ks == 0 ? pf0 : pf1, o1);
                  }
                  asm volatile("s_waitcnt lgkmcnt(0)" ::: "memory"); }
            }
#undef DIL_LOAD
            const size_t orow = rowbase + tokq;
            store_o_staged(lds, wid, lane, o0, o1, 1.0f / l, [&](int r) { return DOG + ((size_t)g * M + rowbase + (size_t)(res + ((n0 + r) << sh))) * 128 + hh * 64; });
            if (hi == 0) DLSE[((size_t)g * M + orow) * 2 + hh] = m + log2f(l);
        }
    }
    VM_WAIT();
    __syncthreads();
    bf16_t* OC = WSP(bf16_t, WS_OCAT);
    for (int it = 0; it < 8; ++it) {
        const int item = tid + 512 * it, tl = item >> 3, pc = item & 7; const size_t orow = rowbase + T0 + tl;
        const float l0 = DLSE[((size_t)0 * M + orow) * 2 + hh], l1 = DLSE[((size_t)1 * M + orow) * 2 + hh], l2 = DLSE[((size_t)2 * M + orow) * 2 + hh];
        const float mx = fmaxf(l0, fmaxf(l1, l2)); float w0 = fast_exp2(l0 - mx), w1 = fast_exp2(l1 - mx), w2 = fast_exp2(l2 - mx);
        const float inv = 1.0f / (w0 + w1 + w2); w0 *= inv; w1 *= inv; w2 *= inv;
        const u32x4 a = *(const u32x4*)(DOG + ((size_t)0 * M + orow) * 128 + hh * 64 + pc * 8), bb = *(const u32x4*)(DOG + ((size_t)1 * M + orow) * 128 + hh * 64 + pc * 8),
                    cc = *(const u32x4*)(DOG + ((size_t)2 * M + orow) * 128 + hh * 64 + pc * 8);
        u32x4 w;
#pragma unroll
        for (int e = 0; e < 4; ++e) {
            const float lo = w0 * __uint_as_float(a[e] << 16) + w1 * __uint_as_float(bb[e] << 16) + w2 * __uint_as_float(cc[e] << 16);
            const float hv = w0 * __uint_as_float(a[e] & 0xffff0000u) + w1 * __uint_as_float(bb[e] & 0xffff0000u) + w2 * __uint_as_float(cc[e] & 0xffff0000u);
            w[e] = cvtpk(lo, hv); }
        *(u32x4*)(OC + orow * OCW + 256 + hh * 64 + pc * 8) = w;
    }
    __syncthreads();
}
__device__ __forceinline__ float wave_sum(float v) {
    v += xor_lane_lt32<1>(v); v += xor_lane_lt32<2>(v); v += xor_lane_lt32<4>(v); v += xor_lane_lt32<8>(v); v += xor_lane_lt32<16>(v);
    return sum_halves(v);
}
__device__ __forceinline__ int rel_bucket(int dist) {
    if (dist < 0) dist = 0;
    if (dist < 16) return dist;
    const int thr[15] = {22, 30, 40, 54, 73, 99, 134, 182, 246, 332, 450, 609, 825, 1117, 1513};
    int bkt = 16;
#pragma unroll
    for (int i = 0; i < 15; ++i) bkt += (dist >= thr[i]) ? 1 : 0;
    return bkt;
}
__device__ __forceinline__ int inproj_src(int c, float& sc) {
    sc = 1.f;
    if (c < 256) { sc = C2A; return c; }
    if (c < 652) return c;
    if (c < 656) return 2572 + (c - 652);
    if (c < 672) return -1;
    if (c < 704) { const int p = c - 672; return 2960 + (p >> 1) + 16 * (p & 1); }
    if (c < 768) return -1;
    if (c < 1920) { const int r = c - 768; if (r < 384) sc = C2A; return 652 + r; }
    if (c < 2048) return 2832 + (c - 1920);
    if (c < 2816) { const int r = c - 2048; if (r < 256) sc = C2A; return 1804 + r; }
    return 2576 + (c - 2816);
}
__device__ __forceinline__ int quq_src(int r, float& sc) {
    sc = C2D;
    if (r >= 384) return -1;
    const int hd = r / 96, w = r % 96;
    if (w < 64) return hd * 96 + w;
    const int p = w - 64; return hd * 96 + 64 + (p >> 1) + 16 * (p & 1);
}
__device__ __forceinline__ int gateperm_src(int r) {
    const int T = r >> 8, c = r & 255, pn = T >> 2, j = T & 3, bj = c >> 7, wc = (c >> 5) & 3, fq = (c >> 3) & 3, n = (c >> 2) & 1, e = c & 3;
    return (2 * bj + n) * DM * DM + 256 * pn + 64 * j + 16 * wc + 4 * fq + e;
}
__device__ __forceinline__ int branchperm_src(int r) {
    const int pn = r >> 8, c = r & 255, bj = c >> 7, wc = (c >> 5) & 3, fq = (c >> 3) & 3, n = (c >> 2) & 1, e = c & 3;
    return 256 * pn + 64 * (2 * bj + n) + 16 * wc + 4 * fq + e;
}
__device__ __forceinline__ int upperm_src(int r) { const int pn = r >> 8, c = r & 255; return (c & 128) ? DFF + 128 * pn + (c & 127) : 128 * pn + c; }
__device__ __forceinline__ void wconv_item(const float* W, int Nsrc, bf16_t* WT, int ldt, const float* kgain, int kind, LAS float* scr, int item, int nblk, int lane, bool f8out = false) {
    const int kb = item / nblk, nb = item % nblk, k0 = 64 * kb, n0 = 32 * nb;
    const int n = n0 + (lane & 31); float sc = 1.f; int src = n;
    if (kind == 1) src = inproj_src(n, sc); else if (kind == 2) src = quq_src(n, sc); else if (kind == 3) src = gateperm_src(n); else if (kind == 4) src = branchperm_src(n); else if (kind == 5) src = upperm_src(n);
    float wv[32];
#pragma unroll
    for (int i = 0; i < 32; ++i) { const int kk = 2 * i + (lane >> 5); wv[i] = (src >= 0) ? W[(size_t)(k0 + kk) * Nsrc + src] : 0.f; }
#pragma unroll
    for (int i = 0; i < 32; ++i) { const int kk = 2 * i + (lane >> 5); float v = wv[i] * sc; if (kgain) v *= kgain[k0 + kk]; scr[kk * 33 + (lane & 31)] = v; }
    LDS_WAIT(); asm volatile("" ::: "memory");
    if (f8out) {
        const int nn = lane >> 1, hh = lane & 1; const LAS float* s = scr + (32 * hh) * 33 + nn; unsigned char* dst = (unsigned char*)WT + (size_t)(n0 + nn) * ldt + k0 + 32 * hh;
#pragma unroll
        for (int j = 0; j < 2; ++j) { u32x4 o;
#pragma unroll
            for (int e = 0; e < 4; ++e) { const LAS float* q = s + (16 * j + 4 * e) * 33; o[e] = pk4_fp8(q[0] * WG8_SCALE, q[33] * WG8_SCALE, q[66] * WG8_SCALE, q[99] * WG8_SCALE); }
            *(u32x4*)(dst + 16 * j) = o; }
        LDS_WAIT(); asm volatile("" ::: "memory");
        return;
    }
    const int c = lane & 7;
#pragma unroll
    for (int j = 0; j < 4; ++j) { const int nn = (lane >> 3) + 8 * j; const LAS float* s = scr + (8 * c) * 33 + nn;
        u32x4 o; o.x = pk2(s[0 * 33], s[1 * 33]); o.y = pk2(s[2 * 33], s[3 * 33]); o.z = pk2(s[4 * 33], s[5 * 33]); o.w = pk2(s[6 * 33], s[7 * 33]);
        *(u32x4*)(WT + (size_t)(n0 + nn) * ldt + k0 + 8 * c) = o; }
    LDS_WAIT(); asm volatile("" ::: "memory");
}
constexpr int ATT_UNITS = 3328;
__device__ __forceinline__ int att_cost(int id) {
    if (id < 2048) { const int qb = 15 - (id >> 7), mla = (id >> 6) & 1; return (mla ? 5 : 4) * (qb + 1); }
    if (id < 3072) return (63 - ((id - 2048) >> 4)) + 20;
    return 30;
}
__device__ __forceinline__ int clampi(int x, int lo, int hi) { return x < lo ? lo : (x > hi ? hi : x); }
__device__ __forceinline__ int att_rank(int i) {
    const int c = att_cost(i);
    int r = clampi(16 - c / 4, 0, 16) * 64 + clampi(16 - c / 5, 0, 16) * 64 + clampi(83 - c, 0, 64) * 16 + (c < 30 ? 256 : 0);
    if (c % 4 == 0 && c / 4 >= 1 && c / 4 <= 16) r += clampi(i - (16 - c / 4) * 128, 0, 64);
    if (c % 5 == 0 && c / 5 >= 1 && c / 5 <= 16) r += clampi(i - ((16 - c / 5) * 128 + 64), 0, 64);
    if (c >= 20 && c <= 83) r += clampi(i - (2048 + (63 - (c - 20)) * 16), 0, 16);
    if (c == 30) r += clampi(i - 3072, 0, 256);
    return r;
}
__device__ __forceinline__ void p0_prologue(Frame& F) {
    LAS float* scr = (LAS float*)(F.lds + F.wave * 16384);
    const int gw = blockIdx.x * 8 + F.wave, NGW = F.G * 8, lane = F.lane;
    constexpr int I_IN = 16 * 96, I_G = 16 * 32, I_BA = 4 * 32, I_BB = 2 * 32, I_O = 16 * 32, I_UP = 16 * 176, I_DN = 44 * 32, I_UQ = 4 * 16, I_UKV = 2 * 16, I_PHI = 32 * 4;
    constexpr int I_L = I_IN + 4 * I_G + 3 * I_BA + I_BB + I_O + I_UP + I_DN + I_UQ + I_UKV + 2 * I_PHI;
    for (int it = gw; it < DEPTH * I_L; it += NGW) {
        const int l = it / I_L; int r = it % I_L;
        unsigned char* wl = F.ws + WS_WT + (size_t)l * LW;
        if (r < I_IN) { wconv_item(F.in[6] + (size_t)l * DM * DIN, DIN, (bf16_t*)(wl + LW_IN), DM, nullptr, 1, scr, r, 96, lane); continue; } r -= I_IN;
        if (r < 4 * I_G) { wconv_item(F.in[21] + (size_t)l * 4 * DM * DM, DM, (bf16_t*)(wl + LW_G), DM, nullptr, 3, scr, r, 128, lane, true); continue; } r -= 4 * I_G;
        if (r < I_BA) { wconv_item(F.in[17] + (size_t)l * 256 * DM, DM, (bf16_t*)(wl + LW_BR + BR_A), 256, nullptr, 4, scr, r, 32, lane); continue; } r -= I_BA;
        if (r < I_BB) { wconv_item(F.in[18] + (size_t)l * 128 * DM, DM, (bf16_t*)(wl + LW_BR + BR_B), 128, nullptr, 4, scr, r, 32, lane); continue; } r -= I_BB;
        if (r < I_BA) { wconv_item(F.in[19] + (size_t)l * 256 * DM, DM, (bf16_t*)(wl + LW_BR + BR_C), 256, nullptr, 4, scr, r, 32, lane); continue; } r -= I_BA;
        if (r < I_BA) { wconv_item(F.in[20] + (size_t)l * 256 * DM, DM, (bf16_t*)(wl + LW_BR + BR_D), 256, nullptr, 4, scr, r, 32, lane); continue; } r -= I_BA;
        if (r < I_O) { wconv_item(F.in[22] + (size_t)l * DM * DM, DM, (bf16_t*)(wl + LW_O), DM, nullptr, 0, scr, r, 32, lane); continue; } r -= I_O;
        if (r < I_UP) { wconv_item(F.in[23] + (size_t)l * DM * DFF2, DFF2, (bf16_t*)(wl + LW_UP), DM, nullptr, 5, scr, r, 176, lane); continue; } r -= I_UP;
        if (r < I_DN) { wconv_item(F.in[26] + (size_t)l * DFF * DM, DM, (bf16_t*)(wl + LW_DN), DFF, nullptr, 0, scr, r, 32, lane); continue; } r -= I_DN;
        if (r < I_UQ) { wconv_item(F.in[15] + (size_t)l * 256 * 384, 384, (bf16_t*)(wl + LW_UQ), 256, F.in[13] + l * 256, 2, scr, r, 16, lane); continue; } r -= I_UQ;
        if (r < I_UKV) { wconv_item(F.in[16] + (size_t)l * 128 * 512, 512, (bf16_t*)(wl + LW_UKV), 128, F.in[14] + l * 128, 0, scr, r, 16, lane); continue; } r -= I_UKV;
        if (r < I_PHI) { wconv_item(F.in[8] + (size_t)l * 2048 * 128, 128, (bf16_t*)(wl + LW_PHI), 2048, nullptr, 0, scr, r, 4, lane); continue; } r -= I_PHI;
        wconv_item(F.in[10] + (size_t)l * 2048 * 128, 128, (bf16_t*)(wl + LW_PHI) + (size_t)128 * 2048, 2048, nullptr, 0, scr, r, 4, lane);
    }
    const int gt = blockIdx.x * 512 + F.tid, NGT = F.G * 512;
    const float* rel = F.in[1];
    float* rope = WSP(float, WS_ROPE);
    for (int i = gt; i < SEQ * 16; i += NGT) { const int t = i >> 4, k = i & 15; const float inv = powf(10000.0f, -(float)(2 * k) / 32.0f); const float ang = (float)t * inv;
        float sn, cs; sincosf(ang, &sn, &cs); rope[2 * i] = cs; rope[2 * i + 1] = sn; }
    float* ntab = WSP(float, WS_NSATAB);
    for (int i = gt; i < 4 * NSA_TL; i += NGT) { const int hd = i / NSA_TL, k = i % NSA_TL, dist = NSA_DMAX - k; ntab[i] = dist >= 0 ? (rel[rel_bucket(dist) * 10 + hd] - rel[31 * 10 + hd]) * LOG2E : 0.f; }
    { float* cws = WSP(float, WS_CWS);
      for (int i = gt; i < DEPTH * 4 * DFF2; i += NGT) { const int l = i / (4 * DFF2), r = i % (4 * DFF2), row = r / DFF2, col = r % DFF2;
          const float s = row < 3 ? F.in[24][(size_t)l * 3 * DFF2 + row * DFF2 + col] : F.in[25][(size_t)l * DFF2 + col];
          cws[i] = s * (col < DFF ? -LOG2E : -0.6931471805599453f); } }
    float* dtab = WSP(float, WS_DILTAB);
    for (int i = gt; i < 6 * 192; i += NGT) { const int gh = i / 192, k = i % 192, g = gh >> 1, hh = gh & 1, j = 160 - k; dtab[i] = (j >= 0 && j <= 128) ? rel[rel_bucket(j << (2 * g)) * 10 + 4 + 2 * g + hh] * LOG2E : 0.f; }
    if (gt < 4) { WSP(float, WS_FARB)[gt] = rel[31 * 10 + gt] * LOG2E; float tm = 0.f; for (int bk = 0; bk < 32; ++bk) tm = fmaxf(tm, fabsf(rel[bk * 10 + gt] - rel[31 * 10 + gt])); WSP(float, WS_FARB)[4 + gt] = tm * LOG2E; }
    if (gw < 128) { const int mi = gw >> 5, pc = gw & 31, l = mi >> 1; const float *pk1 = F.in[8], *pv1 = F.in[10]; asm volatile("" : "+s"(pk1), "+s"(pv1));
        const float* w1 = ((mi & 1) ? pv1 : pk1) + (size_t)l * 2048 * 128 + (size_t)(64 * pc) * 128 + 2 * lane; const float* cp = F.in[7] + (size_t)l * 2048 + 64 * pc;
        f32x2 a = {0.f, 0.f};
#pragma unroll 8
        for (int p = 0; p < 64; ++p) { const f32x2 w = *(const f32x2*)(w1 + (size_t)p * 128); const float cpp = cp[p]; a[0] += cpp * w[0]; a[1] += cpp * w[1]; }
        *(f32x2*)(WSP(float, WS_CMPP) + ((size_t)mi * 32 + pc) * 128 + 2 * lane) = a; }
    if (gt < ATT_UNITS) {
        const int i = gt; int cls, slot;
        if (i < 2048) { const int bh = i & 63, mla = (i >> 6) & 1, pic = ((bh >> 5) << 2) | (bh & 3); cls = (bh >> 2) & 7;
            slot = mla ? 128 + (pic >> 1) * 32 + (i >> 7) * 2 + (pic & 1)
                       : 288 + (i >> 7) * 8 + pic; }
        else if (i < 3072) { const int r = i - 2048, bN = r & 15; cls = bN & 7; slot = (bN >> 3) * 64 + (r >> 4); }
        else { const int r = i - 3072, b = r & 15; cls = b & 7; slot = 256 + (r >> 4) * 2 + (b >> 3); }
        WSP(int, WS_ORDER)[cls * (ATT_UNITS / 8) + slot] = i; }
}
__device__ __forceinline__ void cmpb_reduce(Frame& F) {
    const int i = F.tid; if (i < DEPTH * 256) { const int l = i >> 8, n = i & 255, mi = l * 2 + (n >> 7); const float* pp = WSP(const float, WS_CMPP) + (size_t)mi * 32 * 128 + (n & 127); float a = 0.f;
        for (int pc = 0; pc < 32; ++pc) a += pp[pc * 128]; WSP(float, WS_CMPB)[i] = a; }
}

template <int MODE, bool XIB, bool XOB, bool H8 = false> __device__ __forceinline__ void rowpass(Frame& F, const void* x, const bf16_t* y, size_t yrow0, void* xout, bf16_t* hout, const float* g1, const float* g2, int row_lo, int row_hi, unsigned char* h8out = nullptr) {
    int gw = blockIdx.x * 8 + F.wave; asm volatile("" : "+s"(gw));
    const int NGW = F.G * 8, lane = F.lane;
    f32x4 ga[4], gb[4];
#pragma unroll
    for (int j = 0; j < 4; ++j) { ga[j] = *(const f32x4*)(g1 + 4 * lane + 256 * j); if (MODE == 1) gb[j] = *(const f32x4*)(g2 + 4 * lane + 256 * j); }
    f32x4 xf[4], xfn[4]; u32x2 xb[4], xbn[4], yb[4], ybn[4];
#define RP_LOAD(XF, XB, YB, mm) do { if (XIB) { const u32x2* xr_ = (const u32x2*)((const bf16_t*)x + (size_t)(mm) * DM) + lane; _Pragma("unroll") for (int j = 0; j < 4; ++j) XB[j] = xr_[64 * j]; } \
        else { const f32x4* xr_ = (const f32x4*)((const float*)x + (size_t)(mm) * DM) + lane; _Pragma("unroll") for (int j = 0; j < 4; ++j) XF[j] = xr_[64 * j]; } \
        if (MODE != 0) { const u32x2* yr_ = (const u32x2*)(y + ((size_t)(mm) - yrow0) * DM) + lane; _Pragma("unroll") for (int j = 0; j < 4; ++j) YB[j] = yr_[64 * j]; } } while (0)
    int m = row_lo + gw;
    if (m < row_hi) RP_LOAD(xf, xb, yb, m);
    for (; m < row_hi; m += NGW) {
        const int mn = m + NGW;
        if (mn < row_hi) RP_LOAD(xfn, xbn, ybn, mn);
        f32x4 v[4];
#pragma unroll
        for (int j = 0; j < 4; ++j) { if (XIB) { v[j][0] = __uint_as_float(xb[j].x << 16); v[j][1] = __uint_as_float(xb[j].x & 0xffff0000u); v[j][2] = __uint_as_float(xb[j].y << 16); v[j][3] = __uint_as_float(xb[j].y & 0xffff0000u); } else v[j] = xf[j]; }
        if (MODE != 0) {
            f32x4 w[4]; float s = 0.f;
#pragma unroll
            for (int j = 0; j < 4; ++j) { const u32x2 yy = yb[j]; w[j][0] = __uint_as_float(yy.x << 16); w[j][1] = __uint_as_float(yy.x & 0xffff0000u); w[j][2] = __uint_as_float(yy.y << 16); w[j][3] = __uint_as_float(yy.y & 0xffff0000u);
                s += (w[j][0] * w[j][0] + w[j][1] * w[j][1]) + (w[j][2] * w[j][2] + w[j][3] * w[j][3]); }
            const float rstd = 1.0f / sqrtf(wave_sum(s) * (1.0f / DM) + RMS_EPS);
#pragma unroll
            for (int j = 0; j < 4; ++j) v[j] = v[j] + w[j] * rstd * ga[j];
            if (XOB) { u32x2* xo = (u32x2*)((bf16_t*)xout + (size_t)m * DM) + lane;
#pragma unroll
                for (int j = 0; j < 4; ++j) { u32x2 w2; w2.x = cvtpk(v[j][0], v[j][1]); w2.y = cvtpk(v[j][2], v[j][3]); xo[64 * j] = w2; } }
            else { f32x4* xo = (f32x4*)((float*)xout + (size_t)m * DM) + lane;
#pragma unroll
                for (int j = 0; j < 4; ++j) xo[64 * j] = v[j]; }
        }
        if (MODE != 2) {
            float s = 0.f;
#pragma unroll
            for (int j = 0; j < 4; ++j) s += (v[j][0] * v[j][0] + v[j][1] * v[j][1]) + (v[j][2] * v[j][2] + v[j][3] * v[j][3]);
            const float rstd = 1.0f / sqrtf(wave_sum(s) * (1.0f / DM) + RMS_EPS);
            u32x2* ho = (u32x2*)(hout + (size_t)m * DM) + lane;
#pragma unroll
            for (int j = 0; j < 4; ++j) { const f32x4 gg = (MODE == 1) ? gb[j] : ga[j]; const f32x4 o = v[j] * rstd * gg; u32x2 w; w.x = cvtpk(o[0], o[1]); w.y = cvtpk(o[2], o[3]); ho[64 * j] = w;
                if (H8) ((unsigned*)(h8out + (size_t)m * DM))[lane + 64 * j] = pk4_fp8(o[0] * H8_SCALE, o[1] * H8_SCALE, o[2] * H8_SCALE, o[3] * H8_SCALE); }
        }
#pragma unroll
        for (int j = 0; j < 4; ++j) { if (XIB) xb[j] = xbn[j]; else xf[j] = xfn[j]; if (MODE != 0) yb[j] = ybn[j]; }
    }
#undef RP_LOAD
}

__device__ __forceinline__ void ffn_fix_panel(Frame& F, int pm, const float* HB, bf16_t* ACT, const float* cw, const float* cb) {
#pragma unroll 2
    for (int it = F.tid; it < 4 * 2 * (DFF / 4); it += 512) {
        const int c4 = it % (DFF / 4), rr = (it / (DFF / 4)) & 1, g = pm * 4 + it / (2 * (DFF / 4)), c = c4 * 4, pn = c >> 7, cl = c & 127;
        const bool first = ((g * 64) & (SEQ - 1)) == 0;
#define HBV(gg, s, bj) (*(const f32x4*)(HB + ((size_t)(((gg) * 4 + (s)) * 22 + pn) * 256 + (bj) * 128 + cl)))
        const f32x4 z = {0.f, 0.f, 0.f, 0.f};
        const f32x4 u0g = HBV(g, 0, 0), u0v = HBV(g, 0, 1);
        f32x4 ag, bg_, cg, av, bv_, cv;
        if (rr == 0) { ag = first ? z : HBV(g - 1, 2, 0); bg_ = first ? z : HBV(g - 1, 3, 0); cg = u0g; av = first ? z : HBV(g - 1, 2, 1); bv_ = first ? z : HBV(g - 1, 3, 1); cv = u0v; }
        else { ag = first ? z : HBV(g - 1, 3, 0); bg_ = u0g; cg = HBV(g, 1, 0); av = first ? z : HBV(g - 1, 3, 1); bv_ = u0v; cv = HBV(g, 1, 1); }
#undef HBV
        const f32x4 kb = *(const f32x4*)(cb + c), k0 = *(const f32x4*)(cw + c), k1 = *(const f32x4*)(cw + DFF2 + c), k2 = *(const f32x4*)(cw + 2 * DFF2 + c);
        const f32x4 vb = *(const f32x4*)(cb + DFF + c), v0 = *(const f32x4*)(cw + DFF + c), v1 = *(const f32x4*)(cw + DFF2 + DFF + c), v2 = *(const f32x4*)(cw + 2 * DFF2 + DFF + c);
        float o[4];
#pragma unroll
        for (int e = 0; e < 4; ++e) { const float gt = kb[e] + k0[e] * ag[e] + k1[e] * bg_[e] + k2[e] * cg[e], vl = vb[e] + v0[e] * av[e] + v1[e] * bv_[e] + v2[e] * cv[e]; o[e] = gt * sigmoid_f(gt) * vl; }
        u32x2 w; w.x = cvtpk(o[0], o[1]); w.y = cvtpk(o[2], o[3]);
        *(u32x2*)(ACT + (size_t)(g * 64 + rr) * DFF + c) = w;
    }
}
struct SchedSimple {
    pg8::TileOrder T; const char* A; const char* B; int lda, ldb, nt; int dup = 0;
    __device__ __forceinline__ bool next(int i, GUnit& u) const { int pm, pn; if (!T.tile(i >> dup, pm, pn)) return false;
        u.A = A + (size_t)pm * 256 * lda; u.B = B + (size_t)pn * 256 * ldb; u.lda = lda; u.ldb = ldb; u.nt = nt; u.pm = pm; u.pn = pn; u.id = 0; return true; }
};
struct SchedCmp1 {
    int c; const char* kc; const char* vc; const char* B;
    __device__ __forceinline__ bool next(int i, GUnit& u) const { if (i > 0 || c >= 32) return false;
        u.A = (c < 16 ? kc : vc) + (size_t)(c & 15) * 256 * 2048; u.B = B; u.lda = 2048; u.ldb = 4096; u.nt = 32; u.pm = c; u.pn = 0; u.id = 0; return true; }
};
struct SchedMerge {
    pg8::TileOrder T; const char* ocat; const char* h; const char* wbr; const char* wg; int dup = 0;
    __device__ __forceinline__ bool next(int i0, GUnit& u) const { const int i = i0 >> dup; int pm, pn; if (!T.tile(i >> 3, pm, pn)) return false;
        const int sub = i & 7; u.pm = pm; u.pn = pn; u.id = sub;
        if (sub >= 4) { u.A = h + (size_t)pm * 256 * 1024; u.lda = 1024; u.B = wg + (size_t)((pn * 4 + (sub - 4)) * 256) * 1024; u.ldb = 1024; u.nt = 8; }
        else { const int br = sub; const int kk = (br == 1) ? 128 : 256; const size_t co = (br == 0) ? 0 : (br == 1 ? 256 : (br == 2 ? 384 : 640)), wo = (br == 0) ? BR_A : (br == 1 ? BR_B : (br == 2 ? BR_C : BR_D));
            u.A = ocat + (size_t)pm * 256 * (OCW * 2) + co * 2; u.lda = OCW * 2; u.B = wbr + wo + (size_t)pn * 256 * kk * 2; u.ldb = kk * 2; u.nt = kk / 64; }
        return true; }
};

#ifndef SDUP_INPROJ
#define SDUP_INPROJ 0
#endif
#ifndef SDUP_MERGE
#define SDUP_MERGE 0
#endif
#ifndef SDUP_WO
#define SDUP_WO 0
#endif
#ifndef SDUP_UP
#define SDUP_UP 0
#endif
#ifndef SDUP_DN
#define SDUP_DN 0
#endif
#ifndef DUP_ATTN
#define DUP_ATTN 1
#endif
#ifndef DUP_GEMM
#define DUP_GEMM 1
#endif
#ifndef DUP_MERGE
#define DUP_MERGE 1
#endif
#ifndef DUP_FFN
#define DUP_FFN 1
#endif
#ifdef ONLY_PHASE
#define PH(k) ((k) == ONLY_PHASE)
#else
#define PH(k) true
#endif
struct Args { const float* in[27]; float* out; unsigned char* ws; };
__global__ void __launch_bounds__(512, 2) hybrid_fwd(Args args) {
    extern __shared__ __attribute__((aligned(16))) unsigned char lds_raw[];
    Frame F;
    F.lds = (LAS unsigned char*)lds_raw; F.MISC = (volatile LAS unsigned*)(F.lds + MISC_OFF);
    F.tid = threadIdx.x; F.lane = F.tid & 63; F.wave = __builtin_amdgcn_readfirstlane(F.tid >> 6); F.G = gridDim.x;
#pragma unroll
    for (int i = 0; i < 27; ++i) F.in[i] = args.in[i];
    F.out = args.out; F.ws = args.ws; F.ctl = (gu32*)(args.ws + WS_CTL);
    for (int u = F.tid; u < (LDS_BYTES - LDSCTL_OFF) / 4; u += 512) ((LAS unsigned*)(F.lds + LDSCTL_OFF))[u] = 0u;
    __syncthreads();
    XcdBarrier bar = xcd_barrier_post((unsigned*)(F.ctl + CW_BAR), F.MISC + 8);
    const int c = (int)blockIdx.x;
#define TSTAMP(id) do { } while (0)

#ifndef DUP_P0
#define DUP_P0 1
#endif
    for (int rep = 0; rep < DUP_P0; ++rep) { if (rep) xcd_barrier(bar, F.wave); if (PH(0)) p0_prologue(F); }

#ifndef XTRA_BAR
#define XTRA_BAR 0
#endif
    _Pragma("unroll") for (int xb = 0; xb < XTRA_BAR; ++xb) xcd_barrier(bar, F.wave);
#define PHASE_FRESH() do { const int l_ = lane_now(); F.tid = F.wave * 64 + l_; F.lane = l_; } while (0)
    for (int l = 0; l < DEPTH; ++l) {
        unsigned char* wl = F.ws + WS_WT + (size_t)l * LW;
        const float* xin = (l == 0) ? F.in[0] : F.out;
        PHASE_FRESH();
#ifndef DUP_RP0
#define DUP_RP0 1
#endif
        if (l == 0) {
          _Pragma("unroll") for (int rep = 0; rep < DUP_RP0; ++rep) { if (rep) xcd_barrier(bar, F.wave); if (PH(1)) rowpass<0, false, false, true>(F, F.in[0], nullptr, 0, nullptr, WSP(bf16_t, WS_H), F.in[2] + l * DM, nullptr, 0, M, (unsigned char*)F.out + H8_OFF); }
          xcd_barrier(bar, F.wave); TSTAMP(1);
          if (c == 0) cmpb_reduce(F); }
        for (int rep = 0; rep < DUP_GEMM; ++rep) if (PH(2)) { if (rep) xcd_barrier(bar, F.wave); SchedSimple S; S.T.init(256, 12, F.G, c); S.A = (const char*)(F.ws + WS_H); S.B = (const char*)(wl + LW_IN); S.lda = 2048; S.ldb = 2048; S.nt = 16; S.dup = SDUP_INPROJ;
          pg8::EpiInProj E{WSP(bf16_t, WS_P), WSP(bf16_t, WS_KCMP), WSP(bf16_t, WS_VCMP), WSP(float, WS_SIDE), WSP(bf16_t, WS_KROT), WSP(const float, WS_ROPE), WSP(float, WS_SSQQ), WSP(float, WS_SSQKV), F.in[12] + l * 4, WSP(float, WS_LF)};
          pg8::gemm_phase<pg8::EpiInProj, SchedSimple, true>(F.lds, S, E, F.wave); }
        xcd_barrier(bar, F.wave); TSTAMP(2);
#ifndef DUP_L2A
#define DUP_L2A 1
#endif
        _Pragma("unroll") for (int rep2 = 0; rep2 < DUP_L2A; ++rep2) { if (rep2) xcd_barrier(bar, F.wave);
        if (PH(3)) { SchedCmp1 S{c, (const char*)(F.ws + WS_KCMP), (const char*)(F.ws + WS_VCMP), (const char*)(wl + LW_PHI)};
          pg8::EpiCmp1 E{WSP(bf16_t, WS_HID), WSP(const float, WS_CMPB) + l * 256};
          pg8::gemm_phase<pg8::EpiCmp1, SchedCmp1, false>(F.lds, S, E, F.wave);
          if (c < 32) {
              __syncthreads(); const int which = c >> 4, b = c & 15;
              const int ln_ = lane_now(); const int r32 = ln_ & 31, hi = ln_ >> 5;
              const bf16_t* hrow = WSP(const bf16_t, WS_HID) + ((size_t)c * 256 + F.wave * 32 + r32) * 256 + which * 128;
              const float *pk2 = F.in[9], *pv2 = F.in[11]; asm volatile("" : "+s"(pk2), "+s"(pv2)); const float* w2 = (which ? pv2 : pk2) + (size_t)l * 128 * 64;
              f32x16 o0, o1;
#pragma unroll
              for (int r = 0; r < 16; ++r) { o0[r] = 0.f; o1[r] = 0.f; }
#pragma unroll
              for (int ks = 0; ks < 8; ++ks) { const bf16x8 a = *(const bf16x8*)(hrow + ks * 16 + hi * 8);
                  const float* wp = w2 + (size_t)(ks * 16 + hi * 8) * 64 + r32; u32x4 b0, b1;
#pragma unroll
                  for (int jj = 0; jj < 4; ++jj) { b0[jj] = cvtpk(wp[(2 * jj) * 64], wp[(2 * jj + 1) * 64]); b1[jj] = cvtpk(wp[(2 * jj) * 64 + 32], wp[(2 * jj + 1) * 64 + 32]); }
                  o0 = MFMA32(a, __builtin_bit_cast(bf16x8, b0), o0); o1 = MFMA32(a, __builtin_bit_cast(bf16x8, b1), o1); }
              bf16_t* dst = (which ? WSP(bf16_t, WS_VC) : WSP(bf16_t, WS_KC)) + ((size_t)b * 256 + F.wave * 32) * 64 + r32;
#pragma unroll
              for (int r = 0; r < 16; ++r) { const int rw = crow(r, hi); dst[(size_t)rw * 64] = (bf16_t)f2bf(o0[r]); dst[(size_t)rw * 64 + 32] = (bf16_t)f2bf(o1[r]); }
              if (which == 0) {
                  float mxn = 0.f;
#pragma unroll
                  for (int r = 0; r < 16; ++r) { float sq = o0[r] * o0[r] + o1[r] * o1[r]; sq += xor_lane_lt32<1>(sq); sq += xor_lane_lt32<2>(sq); sq += xor_lane_lt32<4>(sq); sq += xor_lane_lt32<8>(sq); sq += xor_lane_lt32<16>(sq); mxn = fmaxf(mxn, sq); }
                  mxn = fmaxf(mxn, other_half(mxn, hi));
                  if (ln_ == 0) atomicMax((unsigned*)(F.ctl + CW_KCMX + 16 * l) + b, __float_as_uint(mxn)); } } }
        if (PH(4)) { int G2_ = F.G; asm volatile("" : "+s"(G2_)); const bool split = G2_ > 64; const int g2 = split ? F.G - 32 : F.G, c2 = split ? c - 32 : c;
          { SchedSimple S; S.T.init(256, 2, g2, c2 < 0 ? (1 << 28) : c2); S.A = (const char*)(F.ws + WS_P) + PC_DQL * 2; S.B = (const char*)(wl + LW_UQ); S.lda = PW * 2; S.ldb = 512; S.nt = 4;
            pg8::EpiQup E{WSP(bf16_t, WS_QM), WSP(const float, WS_SSQQ), WSP(const float, WS_ROPE)};
            pg8::gemm_phase<pg8::EpiQup, SchedSimple, true>(F.lds, S, E, F.wave); }
          { SchedSimple S; S.T.init(256, 2, g2, c2 < 0 ? (1 << 28) : c2); S.A = (const char*)(F.ws + WS_P) + PC_DKV * 2; S.B = (const char*)(wl + LW_UKV); S.lda = PW * 2; S.ldb = 256; S.nt = 2;
            pg8::EpiKVup E{WSP(bf16_t, WS_KVM), WSP(const float, WS_SSQKV), (unsigned*)(F.ctl + CW_KMLA + 256 * l)};
            pg8::gemm_phase<pg8::EpiKVup, SchedSimple, true>(F.lds, S, E, F.wave); } }
        PHASE_FRESH();
        if (PH(5)) {
          int G_ = F.G; asm volatile("" : "+s"(G_)); const int cb = (G_ >= 48) ? c - 32 : c;
          if (cb >= 0 && cb < BATCH) { const int b = cb, tid = F.tid; const float* fl = WSP(const float, WS_SIDE) + ((size_t)b * SEQ + 8 * tid) * 16 + 12; const f32x4 fb = *(const f32x4*)(F.in[12] + l * 4);
              f32x4 v[8];
#pragma unroll
              for (int i = 0; i < 8; ++i) { const f32x4 z = *(const f32x4*)(fl + 16 * i);
#pragma unroll
                  for (int e = 0; e < 4; ++e) { const float x = z[e] + fb[e], t = fast_exp2(-fabsf(x) * LOG2E), lg = __builtin_amdgcn_logf(1.0f + t) * 0.6931471805599453f; v[i][e] = fminf(x, 0.f) - lg; } }
#pragma unroll
              for (int i = 1; i < 8; ++i) v[i] = v[i] + v[i - 1];
              LAS f32x4* sc = (LAS f32x4*)F.lds; f32x4 run = v[7];
              sc[tid] = run; __syncthreads();
              for (int off = 1, cur = 0; off < 512; off <<= 1, cur ^= 1) { f32x4 t = sc[cur * 512 + tid]; if (tid >= off) t = t + sc[cur * 512 + tid - off]; sc[(cur ^ 1) * 512 + tid] = t; __syncthreads(); run = t; }
              const f32x4 ex = run - v[7];
              float* kb = WSP(float, WS_KB) + (size_t)b * 4 * SEQ + 8 * tid;
#pragma unroll
              for (int e = 0; e < 4; ++e) { f32x4 lo, hi4;
#pragma unroll
                  for (int i = 0; i < 4; ++i) { lo[i] = -(ex[e] + v[i][e]) * LOG2E; hi4[i] = -(ex[e] + v[4 + i][e]) * LOG2E; }
                  *(f32x4*)(kb + (size_t)e * SEQ) = lo; *(f32x4*)(kb + (size_t)e * SEQ + 4) = hi4; }
              __syncthreads();
          } }
        }
        if (PH(5)) {
          const int gt2 = c * 512 + F.tid, hp = gt2 & 1;
          for (int t2 = gt2 >> 1; t2 < M; t2 += F.G * 256) { const bf16_t* Kp = WSP(const bf16_t, WS_P) + (size_t)t2 * PW + PC_CK + hp * 128; float s0 = 0.f, s1 = 0.f, s2 = 0.f;
              if (hp == 0) { const bf16_t* Rp = WSP(const bf16_t, WS_KROT) + (size_t)t2 * 32;
#pragma unroll
                  for (int q8 = 0; q8 < 4; ++q8) { const bf16x8 ra = *(const bf16x8*)(Rp + q8 * 8);
#pragma unroll
                      for (int e = 0; e < 8; ++e) { const float xa = bf2f((unsigned short)ra[e]); s2 += xa * xa; } } }
#pragma unroll
              for (int q8 = 0; q8 < 8; ++q8) { const bf16x8 ka = *(const bf16x8*)(Kp + q8 * 8), kb2 = *(const bf16x8*)(Kp + 64 + q8 * 8);
#pragma unroll
                  for (int e = 0; e < 8; ++e) { const float xa = bf2f((unsigned short)ka[e]), xb = bf2f((unsigned short)kb2[e]); s0 += xa * xa; s1 += xb * xb; } }
              s0 = fmaxf(s0, xor_lane_lt32<2>(s0)); s0 = fmaxf(s0, xor_lane_lt32<4>(s0)); s0 = fmaxf(s0, xor_lane_lt32<8>(s0)); s0 = fmaxf(s0, xor_lane_lt32<16>(s0));
              s1 = fmaxf(s1, xor_lane_lt32<2>(s1)); s1 = fmaxf(s1, xor_lane_lt32<4>(s1)); s1 = fmaxf(s1, xor_lane_lt32<8>(s1)); s1 = fmaxf(s1, xor_lane_lt32<16>(s1));
              { auto r0 = __builtin_amdgcn_permlane32_swap(__float_as_uint(s0), __float_as_uint(s0), false, false); s0 = fmaxf(__uint_as_float(r0[0]), __uint_as_float(r0[1]));
                auto r1 = __builtin_amdgcn_permlane32_swap(__float_as_uint(s1), __float_as_uint(s1), false, false); s1 = fmaxf(__uint_as_float(r1[0]), __uint_as_float(r1[1])); }
              float s3 = 0.f; { const bf16_t* Np = WSP(const bf16_t, WS_P) + (size_t)t2 * PW + (hp ? PC_KWIN : PC_KSLC);
#pragma unroll
                  for (int q8 = 0; q8 < 8; ++q8) { const bf16x8 na = *(const bf16x8*)(Np + q8 * 8);
#pragma unroll
                      for (int e = 0; e < 8; ++e) { const float xa = bf2f((unsigned short)na[e]); s3 += xa * xa; } } }
              float s4 = 0.f; { const bf16_t* Qp = WSP(const bf16_t, WS_P) + (size_t)t2 * PW + PC_AQ + hp * 128;
                  float sa = 0.f, sb = 0.f;
#pragma unroll
                  for (int q8 = 0; q8 < 8; ++q8) { const bf16x8 qa = *(const bf16x8*)(Qp + q8 * 8), qb2 = *(const bf16x8*)(Qp + 64 + q8 * 8);
#pragma unroll
                      for (int e = 0; e < 8; ++e) { const float xa = bf2f((unsigned short)qa[e]), xb = bf2f((unsigned short)qb2[e]); sa += xa * xa; sb += xb * xb; } }
                  s4 = fmaxf(sa, sb); }
              s4 = fmaxf(s4, xor_lane_lt32<1>(s4)); s4 = fmaxf(s4, xor_lane_lt32<2>(s4)); s4 = fmaxf(s4, xor_lane_lt32<4>(s4)); s4 = fmaxf(s4, xor_lane_lt32<8>(s4)); s4 = fmaxf(s4, xor_lane_lt32<16>(s4));
              { auto r4 = __builtin_amdgcn_permlane32_swap(__float_as_uint(s4), __float_as_uint(s4), false, false); s4 = fmaxf(__uint_as_float(r4[0]), __uint_as_float(r4[1])); }
              s3 = fmaxf(s3, xor_lane_lt32<2>(s3)); s3 = fmaxf(s3, xor_lane_lt32<4>(s3)); s3 = fmaxf(s3, xor_lane_lt32<8>(s3)); s3 = fmaxf(s3, xor_lane_lt32<16>(s3));
              { auto r3 = __builtin_amdgcn_permlane32_swap(__float_as_uint(s3), __float_as_uint(s3), false, false); s3 = fmaxf(__uint_as_float(r3[0]), __uint_as_float(r3[1])); }
              s2 = fmaxf(s2, xor_lane_lt32<2>(s2)); s2 = fmaxf(s2, xor_lane_lt32<4>(s2)); s2 = fmaxf(s2, xor_lane_lt32<8>(s2)); s2 = fmaxf(s2, xor_lane_lt32<16>(s2));
              { auto r2 = __builtin_amdgcn_permlane32_swap(__float_as_uint(s2), __float_as_uint(s2), false, false); s2 = fmaxf(__uint_as_float(r2[0]), __uint_as_float(r2[1])); }
              if (F.lane < 2) { unsigned* kw = (unsigned*)(F.ctl + CW_KMAX + 64 * l) + (t2 >> 12) * 4 + 2 * hp; atomicMax(kw, __float_as_uint(s0)); atomicMax(kw + 1, __float_as_uint(s1));
                  if (hp == 0) atomicMax((unsigned*)(F.ctl + CW_KROT + 16 * l) + (t2 >> 12), __float_as_uint(s2));
                  atomicMax((unsigned*)(F.ctl + CW_KNSA + 32 * l) + (t2 >> 12) * 2 + hp, __float_as_uint(s3));
                  if (hp == 0) atomicMax((unsigned*)(F.ctl + CW_QNSA + 16 * l) + (t2 >> 12), __float_as_uint(s4)); } } }
        xcd_barrier(bar, F.wave); TSTAMP(3);
        PHASE_FRESH();
        for (int rep = 0; rep < DUP_ATTN; ++rep) { gu32* ctr = F.ctl + CW_Q + 64 * l + 16 * rep;
          if (rep) xcd_barrier(bar, F.wave);
#define Q_T0 (F.wave == 0 && lane_now() == 0)
          const unsigned xq = xb_xcc_id() & 7u; unsigned kx = 0u;
#define Q_TAKE(dst) do { dst = 0xffffffffu; while (kx < 8u) { const unsigned li_ = (xq + kx) & 7u; const unsigned t_ = __hip_atomic_fetch_add(ctr + li_, 1u, __ATOMIC_RELAXED, __HIP_MEMORY_SCOPE_AGENT); \
              if (t_ < (unsigned)(ATT_UNITS / 8)) { dst = li_ * (unsigned)(ATT_UNITS / 8) + t_; break; } ++kx; } } while (0)
          unsigned nxtq = 0u; if (Q_T0) Q_TAKE(nxtq);
          for (;;) { if (Q_T0) F.MISC[0] = nxtq; __syncthreads(); const int iq = (int)F.MISC[0]; __syncthreads(); if ((unsigned)iq >= (unsigned)ATT_UNITS) break;
              if (Q_T0) Q_TAKE(nxtq);
              const int it = __builtin_amdgcn_readfirstlane(WSP(const int, WS_ORDER)[iq]);
              if (it < 2048 && PH(7)) { const int qb = 15 - (it >> 7), mla = (it >> 6) & 1, bh = it & 63; if (mla) { const gu32* km = F.ctl + CW_KMLA + 256 * l + bh * 4; const float k2 = __uint_as_float(__hip_atomic_load(km, __ATOMIC_RELAXED, __HIP_MEMORY_SCOPE_AGENT)) + __uint_as_float(__hip_atomic_load(km + 1, __ATOMIC_RELAXED, __HIP_MEMORY_SCOPE_AGENT)) + __uint_as_float(__hip_atomic_load(F.ctl + CW_KROT + 16 * l + (bh >> 2), __ATOMIC_RELAXED, __HIP_MEMORY_SCOPE_AGENT)); causal_unit<false>(F, bh >> 2, bh & 3, qb, sqrtf(k2) * 1.01f); } else causal_unit<true>(F, bh >> 2, bh & 3, qb, sqrtf(__uint_as_float(__hip_atomic_load(F.ctl + CW_KMAX + 64 * l + bh, __ATOMIC_RELAXED, __HIP_MEMORY_SCOPE_AGENT)))); }
              else if (it < 3072 && PH(8)) { const int r = it - 2048; const int bN = r & 15; const float qm2 = __uint_as_float(__hip_atomic_load(F.ctl + CW_QNSA + 16 * l + bN, __ATOMIC_RELAXED, __HIP_MEMORY_SCOPE_AGENT)), ka2 = __uint_as_float(__hip_atomic_load(F.ctl + CW_KNSA + 32 * l + bN * 2, __ATOMIC_RELAXED, __HIP_MEMORY_SCOPE_AGENT)), kb2 = __uint_as_float(__hip_atomic_load(F.ctl + CW_KNSA + 32 * l + bN * 2 + 1, __ATOMIC_RELAXED, __HIP_MEMORY_SCOPE_AGENT));
                  const float tmx = fmaxf(fmaxf(WSP(const float, WS_FARB)[4], WSP(const float, WS_FARB)[5]), fmaxf(WSP(const float, WS_FARB)[6], WSP(const float, WS_FARB)[7]));
                  const float kc2 = __uint_as_float(__hip_atomic_load(F.ctl + CW_KCMX + 16 * l + bN, __ATOMIC_RELAXED, __HIP_MEMORY_SCOPE_AGENT));
                  const bool fastB = (sqrtf(qm2) * sqrtf(fmaxf(ka2, kb2)) * 1.002f + tmx + 0.05f) <= 50.0f && (sqrtf(qm2) * sqrtf(kc2) * 1.02f + 0.05f) <= 50.0f;
                  if (__builtin_amdgcn_readfirstlane(fastB ? 1 : 0)) nsa_unit<true>(F, bN, 63 - (r >> 4), l); else nsa_unit<false>(F, bN, 63 - (r >> 4), l); }
              else if (it < 3328 && PH(9)) { const int r = it - 3072; dil_unit(F, r & 15, (r >> 4) & 1, r >> 5); } } }
        xcd_barrier(bar, F.wave); TSTAMP(5);
        for (int rep = 0; rep < DUP_MERGE; ++rep) if (PH(10)) { if (rep) xcd_barrier(bar, F.wave); SchedMerge S; S.T.init(256, 4, F.G, c); S.ocat = (const char*)(F.ws + WS_OCAT); S.h = (const char*)F.out + H8_OFF; S.wbr = (const char*)(wl + LW_BR); S.wg = (const char*)(wl + LW_G); S.dup = SDUP_MERGE;
          unsigned char* scr = F.ws + WS_MSCR + (size_t)c * MSCR_PER_WG;
          pg8::EpiMerge E{WSP(bf16_t, WS_MERGED), scr};
          pg8::gemm_phase<pg8::EpiMerge, SchedMerge, true, true>(F.lds, S, E, F.wave); }
        xcd_barrier(bar, F.wave); TSTAMP(6);
        if (PH(11)) { SchedSimple S; S.T.init(256, 4, F.G, c); S.A = (const char*)(F.ws + WS_MERGED); S.B = (const char*)(wl + LW_O); S.lda = 2048; S.ldb = 2048; S.nt = 16; S.dup = SDUP_WO;
          pg8::EpiBf16 E{WSP(bf16_t, WS_Y), DM};
          pg8::gemm_phase<pg8::EpiBf16, SchedSimple, true>(F.lds, S, E, F.wave); }
        xcd_barrier(bar, F.wave); TSTAMP(7);
        PHASE_FRESH();
        if (PH(12)) { if (l == 0) rowpass<1, false, true>(F, F.in[0], WSP(const bf16_t, WS_Y), 0, F.out, WSP(bf16_t, WS_H2), F.in[3] + l * DM, F.in[4] + l * DM, 0, M);
                      else rowpass<1, true, true>(F, F.out, WSP(const bf16_t, WS_Y), 0, WSP(bf16_t, WS_X3), WSP(bf16_t, WS_H2), F.in[3] + l * DM, F.in[4] + l * DM, 0, M); }
        xcd_barrier(bar, F.wave); TSTAMP(8);
#ifndef DUP_UP
#define DUP_UP 1
#endif
        _Pragma("unroll") for (int rep = 0; rep < DUP_UP; ++rep) if (PH(13)) { if (rep) xcd_barrier(bar, F.wave); SchedSimple S; S.T.init(256, 22, F.G, c); S.A = (const char*)(F.ws + WS_H2); S.B = (const char*)(wl + LW_UP); S.lda = 2048; S.ldb = 2048; S.nt = 16; S.dup = SDUP_UP;
          pg8::EpiUpConv E{WSP(bf16_t, WS_ACT), WSP(float, WS_HB), WSP(const float, WS_CWS) + (size_t)l * 4 * DFF2, WSP(const float, WS_CWS) + (size_t)l * 4 * DFF2 + 3 * DFF2};
          pg8::gemm_phase<pg8::EpiUpConv, SchedSimple, true>(F.lds, S, E, F.wave); }
        xcd_barrier(bar, F.wave); TSTAMP(9);
        PHASE_FRESH();
        if (PH(15)) { SchedSimple S; S.T.init(256, 4, F.G, c); S.A = (const char*)(F.ws + WS_ACT); S.B = (const char*)(wl + LW_DN); S.lda = DFF * 2; S.ldb = DFF * 2; S.nt = DFF / 64; S.dup = SDUP_DN;
          { int pm, pn; for (int i = 0; S.T.tile(i, pm, pn); ++i) ffn_fix_panel(F, pm, WSP(const float, WS_HB), WSP(bf16_t, WS_ACT), F.in[24] + (size_t)l * 3 * DFF2, F.in[25] + (size_t)l * DFF2); }
          VM_WAIT(); __syncthreads();
          pg8::EpiBf16 E{WSP(bf16_t, WS_Y2), DM};
          pg8::gemm_phase<pg8::EpiBf16, SchedSimple, true>(F.lds, S, E, F.wave); }
        xcd_barrier(bar, F.wave); TSTAMP(11);
        PHASE_FRESH();
        if (PH(16)) { if (l + 1 < DEPTH) rowpass<1, true, true, true>(F, F.out, WSP(const bf16_t, WS_Y2), 0, F.out, WSP(bf16_t, WS_H), F.in[5] + l * DM, F.in[2] + (l + 1) * DM, 0, M, (unsigned char*)F.out + H8_OFF);
                      else rowpass<2, true, false>(F, WSP(const bf16_t, WS_X3), WSP(const bf16_t, WS_Y2), 0, F.out, nullptr, F.in[5] + l * DM, nullptr, 0, M); }
        if (l + 1 < DEPTH) xcd_barrier(bar, F.wave);
        TSTAMP(12);
    }
}

extern "C" void kernel_launch(void* const* d_in, const int* in_sizes, int n_in, void* d_out, int out_size, void* d_ws, size_t ws_size, hipStream_t stream) {
    static int grid = 0;
    if (grid == 0) {
        if (n_in != 27 || in_sizes[0] != M * DM || out_size != M * DM || ws_size < WS_END) { fprintf(stderr, "kernel_launch: unexpected shapes (n_in %d, in0 %d, out %d, ws %zu)\n", n_in, n_in > 0 ? in_sizes[0] : -1, out_size, ws_size); grid = -1; return; }
        int dev = 0, cus = 0, per_cu = 0;
        if (hipGetDevice(&dev) != hipSuccess || hipDeviceGetAttribute(&cus, hipDeviceAttributeMultiprocessorCount, dev) != hipSuccess) { grid = -1; return; }
        if (hipFuncSetAttribute((const void*)hybrid_fwd, hipFuncAttributeMaxDynamicSharedMemorySize, LDS_BYTES) != hipSuccess) { fprintf(stderr, "kernel_launch: hipFuncSetAttribute failed\n"); grid = -1; return; }
        if (hipOccupancyMaxActiveBlocksPerMultiprocessor(&per_cu, (const void*)hybrid_fwd, 512, LDS_BYTES) != hipSuccess || per_cu < 1) fprintf(stderr, "kernel_launch: occupancy query says %d\n", per_cu);
        (void)hipGetLastError();
        grid = cus;
    }
    if (grid < 0) return;
    if (hipMemsetAsync((char*)d_ws + WS_CTL, 0, CTL_ZERO_BYTES, stream) != hipSuccess) return;
    Args a{};
    for (int i = 0; i < 27; ++i) a.in[i] = (const float*)d_in[i];
    a.out = (float*)d_out; a.ws = (unsigned char*)d_ws;
    hipLaunchKernelGGL(hybrid_fwd, dim3(grid), dim3(512), LDS_BYTES, stream, a);
}
```
